# Optimizing an MI355X kernel written in HIP

```python
import jax
import jax.numpy as jnp
from jax import lax
import numpy as np


D_MODEL = 1024
BATCH = 8
SEQ = 8192
DEPTH = 2

GRID_W = 64
CTX_LEN = 256
N_BRANCH = 4
BRANCH_W = 256
EPS = 1e-6

ML_HEADS = 4
ML_DH = BRANCH_W // ML_HEADS
ML_CHUNK = 128
ML_COLS = 4 * BRANCH_W + 4 * ML_HEADS

MLA_HEADS = 4
Q_LORA = 256
KV_LORA = 128
QK_NOPE = 64
QK_ROPE = 32
V_DIM = BRANCH_W // MLA_HEADS
ATT_BLOCK = 128
ROPE_THETA = 10000.0
MLA_COLS = Q_LORA + KV_LORA + QK_ROPE

POOL_WINDOWS = (2, 4, 8, 16)
POOL_GROUP = BRANCH_W // len(POOL_WINDOWS)
POOL_COLS = BRANCH_W

CONV_WIDTH = 3
CONV_COLS = 3 * BRANCH_W

IN_COLS = ML_COLS + MLA_COLS + POOL_COLS + CONV_COLS

N_EXPERTS = 64
TOP_K = 6
EXPERT_FF = 256
SHARED_FF = 256
ROUTE_SCALE = 2.5
MOE_BLOCK = 128

kernel_name = 'hybrid_gated_mlstm_mla_pool_conv_moe_dit'


def rms_norm(x, g):
    xf = x.astype(jnp.float32)
    y = xf * lax.rsqrt(jnp.mean(xf * xf, axis=-1, keepdims=True) + EPS)
    return (y * g.astype(jnp.float32)).astype(x.dtype)


def rope_angles(rows):
    row = jnp.repeat(jnp.arange(rows), GRID_W).astype(jnp.float32)
    col = jnp.tile(jnp.arange(GRID_W), rows).astype(jnp.float32)
    n_freq = QK_ROPE // 4
    inv = ROPE_THETA ** (-jnp.arange(n_freq, dtype=jnp.float32) / n_freq)
    return row[:, None] * inv, col[:, None] * inv


def rotate_half(x, ang):
    n = ang.shape[-1]
    cos = jnp.cos(ang)[None, :, None, :]
    sin = jnp.sin(ang)[None, :, None, :]
    x1, x2 = x[..., :n], x[..., n:]
    return jnp.concatenate([x1 * cos - x2 * sin, x2 * cos + x1 * sin], axis=-1).astype(x.dtype)


def axial_rope(x, ang):
    half = x.shape[-1] // 2
    return jnp.concatenate([rotate_half(x[..., :half], ang[0]), rotate_half(x[..., half:], ang[1])], axis=-1)


def mlstm_scan(q, k, v, li, lf, state, emit):
    bsz, nh, t_len, dh = q.shape
    n_chunks = t_len // ML_CHUNK

    def to_chunks(a):
        a = a.reshape(a.shape[:2] + (n_chunks, ML_CHUNK) + a.shape[3:])
        return jnp.moveaxis(a, 2, 0)

    tril = jnp.tril(jnp.ones((ML_CHUNK, ML_CHUNK), dtype=bool))

    def step(carry, inp):
        c_st, n_st, m_st = carry
        qc, kc, vc, lic, lfc = inp
        b = jnp.cumsum(lfc, axis=-1)
        b_end = b[..., -1]
        w_log = b_end[..., None] - b + lic
        m_new = jnp.maximum(b_end + m_st, jnp.max(w_log, axis=-1))
        decay = jnp.exp(b_end + m_st - m_new)
        w_s = jnp.exp(w_log - m_new[..., None])
        c_new = decay[..., None, None] * c_st + jnp.einsum('bhs,bhsd,bhse->bhde', w_s, kc, vc)
        n_new = decay[..., None] * n_st + jnp.einsum('bhs,bhsd->bhd', w_s, kc)
        if not emit:
            return (c_new, n_new, m_new), None
        d_log = jnp.where(tril, b[..., :, None] - b[..., None, :] + lic[..., None, :], -jnp.inf)
        inter = b + m_st[..., None]
        m_t = jnp.maximum(inter, jnp.max(d_log, axis=-1))
        a_inter = jnp.exp(inter - m_t)
        w_ts = jnp.exp(d_log - m_t[..., None]) * jnp.einsum('bhtd,bhsd->bhts', qc, kc)
        num = a_inter[..., None] * jnp.einsum('bhtd,bhde->bhte', qc, c_st) + jnp.einsum('bhts,bhse->bhte', w_ts, vc)
        den = a_inter * jnp.einsum('bhtd,bhd->bht', qc, n_st) + jnp.sum(w_ts, axis=-1)
        h = num / jnp.maximum(jnp.abs(den), jnp.exp(-m_t))[..., None]
        return (c_new, n_new, m_new), h

    state, hs = lax.scan(step, state, tuple(to_chunks(a) for a in (q, k, v, li, lf)))
    if not emit:
        return state, None
    return state, jnp.moveaxis(hs, 0, 2).reshape(bsz, nh, t_len, dh)


def mlstm_branch(p_lat, p_ctx, gate_bias, head_gain, emit_ctx):
    def prep(p):
        bsz, t_len, _ = p.shape
        q, k, v, o, g = jnp.split(p, [BRANCH_W, 2 * BRANCH_W, 3 * BRANCH_W, 4 * BRANCH_W], axis=-1)

        def heads(a):
            return a.reshape(bsz, t_len, ML_HEADS, ML_DH).transpose(0, 2, 1, 3).astype(jnp.float32)

        g = (g.astype(jnp.float32) + gate_bias).reshape(bsz, t_len, 4, ML_HEADS).transpose(2, 0, 3, 1)
        return heads(q), heads(k) * (ML_DH ** -0.5), heads(v), o, g

    ql, kl, vl, ol, gl = prep(p_lat)
    qc, kc, vc, oc, gc = prep(p_ctx)
    bsz = ql.shape[0]
    zero_state = (jnp.zeros((bsz, ML_HEADS, ML_DH, ML_DH), jnp.float32),
                  jnp.zeros((bsz, ML_HEADS, ML_DH), jnp.float32),
                  jnp.zeros((bsz, ML_HEADS), jnp.float32))
    h_lat, h_ctx = None, None
    for rev in (False, True):
        gi, gf = (2, 3) if rev else (0, 1)
        tf = (lambda a: jnp.flip(a, axis=2)) if rev else (lambda a: a)
        st_ctx, hc = mlstm_scan(tf(qc), tf(kc), tf(vc), tf(gc[gi]), tf(jax.nn.log_sigmoid(gc[gf])), zero_state, emit_ctx)
        _, hl = mlstm_scan(tf(ql), tf(kl), tf(vl), tf(gl[gi]), tf(jax.nn.log_sigmoid(gl[gf])), st_ctx, True)
        h_lat = tf(hl) if h_lat is None else h_lat + tf(hl)
        if emit_ctx:
            h_ctx = tf(hc) if h_ctx is None else h_ctx + tf(hc)

    def finish(h, o):
        bsz_, nh, t_len, dh = h.shape
        h = rms_norm(h.transpose(0, 2, 1, 3), head_gain.reshape(ML_HEADS, ML_DH)).reshape(bsz_, t_len, BRANCH_W)
        return (h * jax.nn.sigmoid(o.astype(jnp.float32))).astype(o.dtype)

    y_lat = finish(h_lat, ol)
    y_ctx = finish(h_ctx, oc) if emit_ctx else None
    return y_lat, y_ctx


def mla_project(p, ang, want_q, g_cq, g_ckv, w_uq, w_ukv, g_qn, g_kn):
    bsz, t_len, _ = p.shape
    cq, ckv, kr = jnp.split(p, [Q_LORA, Q_LORA + KV_LORA], axis=-1)
    kv = (rms_norm(ckv, g_ckv) @ w_ukv).reshape(bsz, t_len, MLA_HEADS, QK_NOPE + V_DIM)
    k_nope, v = kv[..., :QK_NOPE], kv[..., QK_NOPE:]
    k_rope = jnp.broadcast_to(kr[:, :, None, :], (bsz, t_len, MLA_HEADS, QK_ROPE))
    k = rms_norm(jnp.concatenate([k_nope, k_rope], axis=-1), g_kn)
    if ang is not None:
        k = jnp.concatenate([k[..., :QK_NOPE], axial_rope(k[..., QK_NOPE:], ang)], axis=-1)
    q = None
    if want_q:
        q = (rms_norm(cq, g_cq) @ w_uq).reshape(bsz, t_len, MLA_HEADS, QK_NOPE + QK_ROPE)
        q = rms_norm(q, g_qn)
        if ang is not None:
            q = jnp.concatenate([q[..., :QK_NOPE], axial_rope(q[..., QK_NOPE:], ang)], axis=-1)
    return q, k, v


def attend_blocks(q, k, v):
    bsz, tq, nh, dq = q.shape
    nb = tq // ATT_BLOCK
    qb = jnp.moveaxis(q.reshape(bsz, nb, ATT_BLOCK, nh, dq), 1, 0)
    scale = dq ** -0.5

    def one(q_blk):
        s = jnp.einsum('bqhd,bkhd->bhqk', q_blk, k, preferred_element_type=jnp.float32) * scale
        p = jax.nn.softmax(s, axis=-1).astype(v.dtype)
        return jnp.einsum('bhqk,bkhd->bqhd', p, v)

    out = lax.map(one, qb)
    return jnp.moveaxis(out, 0, 1).reshape(bsz, tq, nh, v.shape[-1])


def pool_mix(u, w_pool, pool_scale):
    bsz, t_len, cw = u.shape
    uf = u.astype(jnp.float32)
    cs = jnp.concatenate([jnp.zeros((bsz, 1, cw), jnp.float32), jnp.cumsum(uf, axis=1)], axis=1)
    t = jnp.arange(t_len)
    outs = []
    for gi, w in enumerate(POOL_WINDOWS):
        lo = jnp.clip(t - w // 2, 0, t_len)
        hi = jnp.clip(t + w // 2, 0, t_len)
        sl = slice(gi * POOL_GROUP, (gi + 1) * POOL_GROUP)
        seg = cs[:, :, sl]
        mean = (seg[:, hi] - seg[:, lo]) / (hi - lo).astype(jnp.float32)[None, :, None]
        outs.append(mean - uf[:, :, sl])
    y = jnp.stack(outs, axis=2)
    y = jnp.einsum('btgc,gcd->btgd', y, w_pool.astype(jnp.float32)).reshape(bsz, t_len, cw)
    return (y * pool_scale).astype(u.dtype)


def short_conv_mix(u, gate_b, gate_c, w_conv, b_conv):
    t_len = u.shape[1]
    pad = CONV_WIDTH // 2
    z = jnp.pad(gate_c * u, ((0, 0), (pad, pad), (0, 0)))
    y = b_conv
    for j in range(CONV_WIDTH):
        y = y + z[:, j:j + t_len] * w_conv[j]
    return gate_b * y


def gated_merge(h, ys, w_gate, b_gate, w_branch, w_out):
    acc = None
    for i, y in enumerate(ys):
        term = jax.nn.sigmoid(h @ w_gate[i] + b_gate[i]) * (y @ w_branch[i])
        acc = term if acc is None else acc + term
    return acc @ w_out


def moe_ffn(h, w_router, b_router, w1, w3, w2, ws1, ws3, ws2):
    n_tok, d = h.shape
    scores = jax.nn.sigmoid((h @ w_router).astype(jnp.float32))
    _, idx = lax.top_k(scores + b_router.astype(jnp.float32), TOP_K)
    s_sel = jnp.take_along_axis(scores, idx, axis=-1)
    wts = s_sel / jnp.sum(s_sel, axis=-1, keepdims=True) * ROUTE_SCALE

    n_assign = n_tok * TOP_K
    e_flat = idx.reshape(-1)
    tok_flat = jnp.repeat(jnp.arange(n_tok, dtype=jnp.int32), TOP_K)
    order = jnp.argsort(e_flat)
    e_s, tok_s, w_s = e_flat[order], tok_flat[order], wts.reshape(-1)[order]
    counts = jnp.bincount(e_flat, length=N_EXPERTS)
    padded = (counts + MOE_BLOCK - 1) // MOE_BLOCK * MOE_BLOCK
    pad_end = jnp.cumsum(padded)
    pad_start = pad_end - padded
    grp_start = jnp.cumsum(counts) - counts
    dest = pad_start[e_s] + (jnp.arange(n_assign) - grp_start[e_s])
    n_blocks = -(-n_assign // MOE_BLOCK) + N_EXPERTS
    n_rows = n_blocks * MOE_BLOCK
    row_tok = jnp.full((n_rows,), n_tok, jnp.int32).at[dest].set(tok_s)
    row_w = jnp.zeros((n_rows,), jnp.float32).at[dest].set(w_s)
    blk_e = jnp.clip(jnp.searchsorted(pad_end, jnp.arange(n_blocks) * MOE_BLOCK, side='right'), 0, N_EXPERTS - 1)
    h_pad = jnp.concatenate([h, jnp.zeros((1, d), h.dtype)], axis=0)

    def step(acc, inp):
        toks, wr, e = inp
        xb = h_pad[toks]
        a = jax.nn.silu(xb @ w1[e]) * (xb @ w3[e])
        yb = (a @ w2[e]) * wr[:, None]
        return acc.at[toks].add(yb.astype(jnp.float32)), None

    acc0 = jnp.zeros((n_tok + 1, d), jnp.float32)
    acc, _ = lax.scan(step, acc0, (row_tok.reshape(n_blocks, MOE_BLOCK), row_w.reshape(n_blocks, MOE_BLOCK), blk_e))
    shared = (jax.nn.silu(h @ ws1) * (h @ ws3)) @ ws2
    return (acc[:n_tok] + shared.astype(jnp.float32)).astype(h.dtype)


def hybrid_layer(x, ctx, c, c_ctx, ang, emit_ctx, lp):
    bsz, t_len, d = x.shape
    mod = (jax.nn.silu(c) @ lp['w_mod'] + lp['b_mod'])[:, None, :]
    mod_c = (jax.nn.silu(c_ctx) @ lp['w_mod'] + lp['b_mod'])[None, None, :]
    sh1, sc1, gt1, sh2, sc2, gt2 = jnp.split(mod, 6, axis=-1)
    csh1, csc1, cgt1, csh2, csc2, cgt2 = jnp.split(mod_c, 6, axis=-1)

    hx = rms_norm(x, lp['g_mix']) * (1 + sc1) + sh1
    hc = rms_norm(ctx, lp['g_mix']) * (1 + csc1) + csh1
    px = hx @ lp['w_in']
    pc = hc @ lp['w_in']
    cuts = [ML_COLS, ML_COLS + MLA_COLS, ML_COLS + MLA_COLS + POOL_COLS]
    ml_x, mla_x, pool_x, conv_x = jnp.split(px, cuts, axis=-1)
    ml_c, mla_c, pool_c, conv_c = jnp.split(pc, cuts, axis=-1)

    y_ml, yc_ml = mlstm_branch(ml_x, ml_c, lp['ml_gate_bias'], lp['ml_head_gain'], emit_ctx)

    mla_w = (lp['mla_g_cq'], lp['mla_g_ckv'], lp['mla_w_uq'], lp['mla_w_ukv'], lp['mla_g_qn'], lp['mla_g_kn'])
    q_l, k_l, v_l = mla_project(mla_x, ang, True, *mla_w)
    q_c, k_c, v_c = mla_project(mla_c, None, emit_ctx, *mla_w)
    k_all = jnp.concatenate([k_c, k_l], axis=1)
    v_all = jnp.concatenate([v_c, v_l], axis=1)
    y_mla = attend_blocks(q_l, k_all, v_all).reshape(bsz, t_len, BRANCH_W)

    y_pool = pool_mix(pool_x, lp['pool_w'], lp['pool_scale'])
    u_x, b_x, c_x = jnp.split(conv_x, 3, axis=-1)
    y_conv = short_conv_mix(u_x, b_x, c_x, lp['conv_w'], lp['conv_b'])

    merge_w = (lp['w_gate'], lp['b_gate'], lp['w_branch'], lp['w_out'])
    x = x + gt1 * gated_merge(hx, (y_ml, y_mla, y_pool, y_conv), *merge_w)
    if emit_ctx:
        yc_mla = attend_blocks(q_c, k_c, v_c).reshape(bsz, -1, BRANCH_W)
        yc_pool = pool_mix(pool_c, lp['pool_w'], lp['pool_scale'])
        u_c, b_c, c_c = jnp.split(conv_c, 3, axis=-1)
        yc_conv = short_conv_mix(u_c, b_c, c_c, lp['conv_w'], lp['conv_b'])
        ctx = ctx + cgt1 * gated_merge(hc, (yc_ml, yc_mla, yc_pool, yc_conv), *merge_w)

    hx2 = rms_norm(x, lp['g_ffn']) * (1 + sc2) + sh2
    tokens = hx2.reshape(-1, d)
    if emit_ctx:
        hc2 = rms_norm(ctx, lp['g_ffn']) * (1 + csc2) + csh2
        tokens = jnp.concatenate([tokens, hc2.reshape(-1, d)], axis=0)
    f = moe_ffn(tokens, lp['moe_w_router'], lp['moe_b_router'], lp['moe_w1'], lp['moe_w3'], lp['moe_w2'],
                lp['moe_ws1'], lp['moe_ws3'], lp['moe_ws2'])
    x = x + gt2 * f[:bsz * t_len].reshape(bsz, t_len, d)
    if emit_ctx:
        ctx = ctx + cgt2 * f[bsz * t_len:].reshape(ctx.shape)
    return x, ctx


def setup_inputs(seed: int = 0) -> dict:
    key = jax.random.key(seed)
    ks = iter(jax.random.split(key, 40))

    def nrm(shape, scale):
        return jax.random.normal(next(ks), shape, jnp.float32) * scale

    def gain(shape):
        return 1.0 + nrm(shape, 0.02)

    L, D = DEPTH, D_MODEL
    f_bias = jnp.linspace(3.0, 6.0, ML_HEADS, dtype=jnp.float32)
    z_bias = jnp.zeros((ML_HEADS,), jnp.float32)
    gate_base = jnp.concatenate([z_bias, f_bias, z_bias, f_bias])
    return {
        'x': nrm((BATCH, SEQ, D), 1.0),
        'c': nrm((BATCH, D), 1.0),
        'ctx': nrm((BATCH, CTX_LEN, D), 1.0),
        'c_ctx': nrm((D,), 1.0),
        'w_mod': nrm((L, D, 6 * D), 0.5 * D ** -0.5),
        'b_mod': nrm((L, 6 * D), 0.02),
        'g_mix': gain((L, D)),
        'g_ffn': gain((L, D)),
        'w_in': nrm((L, D, IN_COLS), D ** -0.5),
        'ml_gate_bias': gate_base + nrm((L, 4 * ML_HEADS), 0.1),
        'ml_head_gain': gain((L, BRANCH_W)),
        'mla_g_cq': gain((L, Q_LORA)),
        'mla_g_ckv': gain((L, KV_LORA)),
        'mla_w_uq': nrm((L, Q_LORA, MLA_HEADS * (QK_NOPE + QK_ROPE)), Q_LORA ** -0.5),
        'mla_w_ukv': nrm((L, KV_LORA, MLA_HEADS * (QK_NOPE + V_DIM)), KV_LORA ** -0.5),
        'mla_g_qn': gain((L, QK_NOPE + QK_ROPE)),
        'mla_g_kn': gain((L, QK_NOPE + QK_ROPE)),
        'pool_w': nrm((L, len(POOL_WINDOWS), POOL_GROUP, POOL_GROUP), POOL_GROUP ** -0.5),
        'pool_scale': gain((L, BRANCH_W)),
        'conv_w': nrm((L, CONV_WIDTH, BRANCH_W), CONV_WIDTH ** -0.5),
        'conv_b': nrm((L, BRANCH_W), 0.02),
        'w_gate': nrm((L, N_BRANCH, D, D), D ** -0.5),
        'b_gate': nrm((L, N_BRANCH, D), 0.02),
        'w_branch': nrm((L, N_BRANCH, BRANCH_W, D), BRANCH_W ** -0.5),
        'w_out': nrm((L, D, D), D ** -0.5),
        'moe_w_router': nrm((L, D, N_EXPERTS), D ** -0.5),
        'moe_b_router': nrm((L, N_EXPERTS), 0.01),
        'moe_w1': nrm((L, N_EXPERTS, D, EXPERT_FF), D ** -0.5),
        'moe_w3': nrm((L, N_EXPERTS, D, EXPERT_FF), D ** -0.5),
        'moe_w2': nrm((L, N_EXPERTS, EXPERT_FF, D), EXPERT_FF ** -0.5),
        'moe_ws1': nrm((L, D, SHARED_FF), D ** -0.5),
        'moe_ws3': nrm((L, D, SHARED_FF), D ** -0.5),
        'moe_ws2': nrm((L, SHARED_FF, D), SHARED_FF ** -0.5),
    }


def reference(x, c, ctx, c_ctx, w_mod, b_mod, g_mix, g_ffn, w_in, ml_gate_bias, ml_head_gain,
              mla_g_cq, mla_g_ckv, mla_w_uq, mla_w_ukv, mla_g_qn, mla_g_kn, pool_w, pool_scale,
              conv_w, conv_b, w_gate, b_gate, w_branch, w_out, moe_w_router, moe_b_router,
              moe_w1, moe_w3, moe_w2, moe_ws1, moe_ws3, moe_ws2):
    rows = x.shape[1] // GRID_W
    ang = rope_angles(rows)
    for l in range(DEPTH):
        emit_ctx = l < DEPTH - 1
        lp = {
            'w_mod': w_mod[l], 'b_mod': b_mod[l], 'g_mix': g_mix[l], 'g_ffn': g_ffn[l], 'w_in': w_in[l],
            'ml_gate_bias': ml_gate_bias[l], 'ml_head_gain': ml_head_gain[l],
            'mla_g_cq': mla_g_cq[l], 'mla_g_ckv': mla_g_ckv[l], 'mla_w_uq': mla_w_uq[l], 'mla_w_ukv': mla_w_ukv[l],
            'mla_g_qn': mla_g_qn[l], 'mla_g_kn': mla_g_kn[l],
            'pool_w': pool_w[l], 'pool_scale': pool_scale[l], 'conv_w': conv_w[l], 'conv_b': conv_b[l],
            'w_gate': w_gate[l], 'b_gate': b_gate[l], 'w_branch': w_branch[l], 'w_out': w_out[l],
            'moe_w_router': moe_w_router[l], 'moe_b_router': moe_b_router[l],
            'moe_w1': moe_w1[l], 'moe_w3': moe_w3[l], 'moe_w2': moe_w2[l],
            'moe_ws1': moe_ws1[l], 'moe_ws3': moe_ws3[l], 'moe_ws2': moe_ws2[l],
        }
        x, ctx = hybrid_layer(x, ctx, c, c_ctx, ang, emit_ctx, lp)
    return x
```

```cpp
#include <hip/hip_runtime.h>
#include <stdint.h>
#include <stdio.h>
#include <math.h>

#ifndef MK_ONE_LAUNCH
#define MK_ONE_LAUNCH 0
#endif

#define LAS __attribute__((address_space(3)))
#define GAS __attribute__((address_space(1)))
typedef unsigned short bf16_t;
typedef short bf16x8 __attribute__((ext_vector_type(8)));
typedef short s16x4 __attribute__((ext_vector_type(4)));
typedef float f32x2 __attribute__((ext_vector_type(2)));
typedef float f32x4 __attribute__((ext_vector_type(4)));
typedef float f32x16 __attribute__((ext_vector_type(16)));
typedef unsigned u32x2 __attribute__((ext_vector_type(2)));
typedef unsigned u32x4 __attribute__((ext_vector_type(4)));

constexpr int DM = 1024, NB = 8, SEQ = 8192, CTXL = 256, GRIDW = 64;
constexpr int NLAT = NB * SEQ, NCTX = NB * CTXL, NTOK = NLAT + NCTX;
constexpr int INC = 2480, INCP = 2560;
constexpr int C_ML = 0, C_G = 1024, C_MLA = 1040, C_POOL = 1456, C_CONV = 1712;
constexpr int NE = 64, NE1 = 65, TOPK = 6, NSLOT7 = 7, EFF = 256;
constexpr int NCHK = 66;
constexpr int NKT = 132;
constexpr float EPS = 1e-6f;
constexpr int NWAVES = 8, NTHR = 512;
constexpr int MOE_ROWS_MAX = 253184;
constexpr int MOE_TILES_MAX = MOE_ROWS_MAX / 256;

constexpr size_t MiB = 1u << 20;
constexpr size_t WS_CTL = 0, CTL_ZERO_BYTES = 1 * MiB;
constexpr size_t WS_MOD = 128 * 1024;
constexpr size_t WS_TAB = 1 * MiB;
constexpr size_t T_ROPE = WS_TAB;
constexpr size_t T_HIST = T_ROPE + 16384;
constexpr size_t T_TILEE = T_HIST + 65536;
constexpr size_t T_EIDX = T_TILEE + 8192;
constexpr size_t T_EW = T_EIDX + (size_t)NTOK * 6 * 4;
constexpr size_t T_SLOT = T_EW + (size_t)NTOK * 6 * 4;
constexpr size_t T_RTOK = T_SLOT + (size_t)NTOK * 8 * 4;
constexpr size_t T_RW = T_RTOK + (size_t)MOE_ROWS_MAX * 4;
constexpr size_t T_GATE = T_RW + (size_t)MOE_ROWS_MAX * 4;
constexpr size_t T_DN = T_GATE + (size_t)NTOK * 16 * 4;
constexpr size_t T_NST = T_DN + (size_t)4224 * 64 * 4;
constexpr size_t T_MLOC = T_NST + (size_t)4224 * 64 * 4;
constexpr size_t T_BEND = T_MLOC + 4224 * 4;
constexpr size_t T_MST = T_BEND + 4224 * 4;
constexpr size_t T_END = T_MST + 4224 * 4;
static_assert(T_END <= 17 * MiB, "tables");
constexpr size_t WS_WB = 17 * MiB;
constexpr size_t W_IN = WS_WB;
constexpr size_t W_GATE = W_IN + (size_t)INCP * 1024 * 2;
constexpr size_t W_BR = W_GATE + (size_t)4 * 1024 * 1024 * 2;
constexpr size_t W_OUT = W_BR + (size_t)4 * 1024 * 256 * 2;
constexpr size_t W_13 = W_OUT + (size_t)1024 * 1024 * 2;
constexpr size_t W_2 = W_13 + (size_t)NE1 * 512 * 1024 * 2;
constexpr size_t W_UQ = W_2 + (size_t)NE1 * 1024 * 256 * 2;
constexpr size_t W_UKV = W_UQ + (size_t)384 * 256 * 2;
constexpr size_t W_POOL = W_UKV + (size_t)512 * 128 * 2;
constexpr size_t W_RT = W_POOL + (size_t)4 * 64 * 64 * 2;
constexpr size_t W_END = W_RT + (size_t)64 * 1024 * 2;
static_assert(W_END <= 133 * MiB, "weights");
constexpr size_t WS_CTXS = 133 * MiB;
constexpr size_t WS_HX = 141 * MiB;
constexpr size_t WS_PX = 273 * MiB;
constexpr size_t WS_QB = 593 * MiB;
constexpr size_t WS_KT = 643 * MiB;
constexpr size_t WS_VT = 693 * MiB;
constexpr size_t WS_YC = 726 * MiB;
constexpr size_t WS_DC = 858 * MiB;
constexpr size_t WS_CST = 924 * MiB;
constexpr size_t WS_END = 957 * MiB;
constexpr size_t WS_ACCM = WS_PX;
constexpr size_t WS_MSCR = WS_PX + 132 * MiB;
constexpr size_t WS_AMOE = WS_PX;
constexpr size_t WS_YS = WS_PX + 124 * MiB;
static_assert(WS_YS + (size_t)MOE_ROWS_MAX * 2048 <= WS_END, "moe overlay");
static_assert(WS_MSCR + 64 * MiB <= WS_QB, "merge scratch overlay");

constexpr int CW_BAR = 4096;

constexpr int RING_BYTES = 131072;
constexpr int MISC_OFF = 160 * 1024 - 256;
constexpr int LDS_BYTES = 160 * 1024;

__device__ __forceinline__ unsigned f2bf(float f) { unsigned u = __builtin_bit_cast(unsigned, f); return (u + 0x7fffu + ((u >> 16) & 1u)) >> 16; }
__device__ __forceinline__ unsigned pk2(float lo, float hi) { return f2bf(lo) | (f2bf(hi) << 16); }
__device__ __forceinline__ float bf2f(unsigned short b) { return __builtin_bit_cast(float, ((unsigned)b) << 16); }
__device__ __forceinline__ float bflo(unsigned w) { return __builtin_bit_cast(float, w << 16); }
__device__ __forceinline__ float bfhi(unsigned w) { return __builtin_bit_cast(float, w & 0xffff0000u); }
__device__ __forceinline__ unsigned cvt_pk_bf16(float lo, float hi) { unsigned r; asm volatile("v_cvt_pk_bf16_f32 %0, %1, %2" : "=v"(r) : "v"(lo), "v"(hi)); return r; }
__device__ __forceinline__ float sigmoidf_(float x) { return 1.0f / (1.0f + __expf(-x)); }
template <int O> __device__ __forceinline__ float xor_lane(float v) { return __builtin_bit_cast(float, __builtin_amdgcn_ds_swizzle(__builtin_bit_cast(int, v), 0x1f | (O << 10))); }
__device__ __forceinline__ float half_sum(float v) { v += xor_lane<1>(v); v += xor_lane<2>(v); v += xor_lane<4>(v); v += xor_lane<8>(v); v += xor_lane<16>(v); return v; }
__device__ __forceinline__ float half_max(float v) { v = fmaxf(v, xor_lane<1>(v)); v = fmaxf(v, xor_lane<2>(v)); v = fmaxf(v, xor_lane<4>(v)); v = fmaxf(v, xor_lane<8>(v)); v = fmaxf(v, xor_lane<16>(v)); return v; }
__device__ __forceinline__ float wave_sum(float v) { v = half_sum(v); auto rr = __builtin_amdgcn_permlane32_swap(__builtin_bit_cast(unsigned, v), __builtin_bit_cast(unsigned, v), false, false);
    return __builtin_bit_cast(float, (unsigned)rr[0]) + __builtin_bit_cast(float, (unsigned)rr[1]); }
__device__ __forceinline__ float wave_max(float v) { v = half_max(v); auto rr = __builtin_amdgcn_permlane32_swap(__builtin_bit_cast(unsigned, v), __builtin_bit_cast(unsigned, v), false, false);
    return fmaxf(__builtin_bit_cast(float, (unsigned)rr[0]), __builtin_bit_cast(float, (unsigned)rr[1])); }
__device__ __forceinline__ float lane_up(float v, int o, int lane) { return __builtin_bit_cast(float, __builtin_amdgcn_ds_bpermute(((lane - o) & 63) << 2, __builtin_bit_cast(int, v))); }
__device__ __forceinline__ float lane_bcast(float v, int src) { return __builtin_bit_cast(float, __builtin_amdgcn_readlane(__builtin_bit_cast(int, v), src)); }
#define LDS_WAIT() asm volatile("s_waitcnt lgkmcnt(0)" ::: "memory")
#define VM_WAIT() asm volatile("s_waitcnt vmcnt(0)" ::: "memory")

#define XB_TMO      128
#define XB_XCNT(j)  (256  + 64 * (j))
#define XB_XSUB(j)  (1280 + 64 * (j))
#define XB_XGEN(j)  (2304 + 64 * (j))
#define XB_TOP      3328
#define XB_TOPGEN   3392
#define XCD_BAR_WORDS 3456
#define XB_SPIN_CAP (1u << 22)

__device__ __forceinline__ unsigned xb_ld(unsigned* p)              { return __hip_atomic_load(p, __ATOMIC_RELAXED, __HIP_MEMORY_SCOPE_AGENT); }
__device__ __forceinline__ unsigned xb_add(unsigned* p, unsigned v) { return __hip_atomic_fetch_add(p, v, __ATOMIC_RELAXED, __HIP_MEMORY_SCOPE_AGENT); }
__device__ __forceinline__ unsigned xb_xcc_id() { return (unsigned)__builtin_amdgcn_s_getreg((3 << 11) | 20) & 0xFu; }
#define XB_SPIN(cond, bar) do { unsigned _sp = 0; while (cond) { __builtin_amdgcn_s_sleep(1); \
    if ((++_sp & 255u) == 0u) { if (xb_ld(&(bar)[XB_TMO])) break; if (_sp > XB_SPIN_CAP) { atomicAdd(&(bar)[XB_TMO], 1u); break; } } } } while (0)

struct XcdBarrier { unsigned* bar; unsigned x; volatile LAS unsigned* st; };

__device__ __forceinline__ XcdBarrier xcd_barrier_post(unsigned* bar, volatile LAS unsigned* st) {
    XcdBarrier b; b.bar = bar; b.x = xb_xcc_id(); b.st = st;
    if (threadIdx.x == 0) (void)xb_add(&bar[XB_XCNT(b.x)], 1u);
    return b;
}
__device__ __forceinline__ void xcd_barrier_complete(unsigned* bar, unsigned x, unsigned& nloc, unsigned& nx) {
    const unsigned G = gridDim.x * gridDim.y * gridDim.z;
    unsigned sum, cnt, mine, sp = 0u;
    for (;;) {
        sum = 0u; cnt = 0u; mine = 0u;
#pragma unroll
        for (unsigned j = 0; j < 16; ++j) { const unsigned c = xb_ld(&bar[XB_XCNT(j)]); sum += c; cnt += (c > 0u) ? 1u : 0u; mine = (j == x) ? c : mine; }
        if (sum == G) break;
        __builtin_amdgcn_s_sleep(1);
        if ((++sp & 255u) == 0u) { if (xb_ld(&bar[XB_TMO])) break; if (sp > XB_SPIN_CAP) { atomicAdd(&bar[XB_TMO], 1u); break; } }
    }
    nloc = mine > 0u ? mine : 1u; nx = cnt > 0u ? cnt : 1u;
}
__device__ __forceinline__ void xcd_barrier(const XcdBarrier& b) {
    asm volatile("s_waitcnt vmcnt(0)" ::: "memory");
    __syncthreads();
    if (threadIdx.x == 0) {
        unsigned* bar = b.bar;
        __builtin_amdgcn_s_waitcnt(0);
        unsigned nloc = b.st[0], nx = b.st[1];
        if (nloc == 0u) { xcd_barrier_complete(bar, b.x, nloc, nx); b.st[0] = nloc; b.st[1] = nx; }
        const unsigned old = xb_add(&bar[XB_XSUB(b.x)], 1u);
        const unsigned gen = old / nloc;
        if (old + 1u == (gen + 1u) * nloc) {
            __builtin_amdgcn_fence(__ATOMIC_RELEASE, "agent");
            asm volatile("s_waitcnt vmcnt(0)" ::: "memory");
            const unsigned og = xb_add(&bar[XB_TOP], 1u);
            const unsigned tg = og / nx;
            if (og + 1u == (tg + 1u) * nx) xb_add(&bar[XB_TOPGEN], 1u);
            else XB_SPIN(xb_ld(&bar[XB_TOPGEN]) == tg, bar);
            __builtin_amdgcn_fence(__ATOMIC_ACQUIRE, "agent");
            xb_add(&bar[XB_XGEN(b.x)], 1u);
            asm volatile("s_waitcnt vmcnt(0)" ::: "memory");
        } else {
            XB_SPIN(xb_ld(&bar[XB_XGEN(b.x)]) == gen, bar);
            __builtin_amdgcn_fence(__ATOMIC_ACQUIRE, "agent");
            asm volatile("s_waitcnt vmcnt(0)" ::: "memory");
        }
    }
    __syncthreads();
}

struct Params { const float* in[33]; float* out; unsigned char* ws; int ph_lo, ph_hi; };

struct Frame {
    LAS unsigned char* lds;
    unsigned char* ws;
    const float* const* in;
    float* out;
    int tid, lane, wave, bx, G;
};
enum { I_X = 0, I_C, I_CTX, I_CCTX, I_WMOD, I_BMOD, I_GMIX, I_GFFN, I_WIN, I_MLGB, I_MLHG, I_GCQ, I_GCKV, I_WUQ, I_WUKV, I_GQN, I_GKN, I_POOLW, I_POOLS,
       I_CONVW, I_CONVB, I_WGATE, I_BGATE, I_WBR, I_WOUT, I_WRT, I_BRT, I_W1, I_W3, I_W2, I_WS1, I_WS3, I_WS2 };

__device__ __forceinline__ const float* modp(const Frame& F, int l, int r, int which) { return (const float*)(F.ws + WS_MOD) + ((size_t)(l * 9 + r)) * 6144 + which * 1024; }
__device__ __forceinline__ int mod_row_of(int row) { return row < NLAT ? (row >> 13) : 8; }

namespace gg {
constexpr int BM = 256, BK = 64, HALF = 128, HTB = HALF * BK * 2, STAGE_BYTES = 8 * HTB;
__device__ __forceinline__ int lds_byte(int r, int c) { const int st = (r >> 4) * 2 + (c >> 5), rr = r & 15, cc = c & 31, ob = rr * 64 + cc * 2; return st * 1024 + (ob ^ (((ob >> 9) & 1) << 5)); }
__device__ __forceinline__ void stage_rc(int b, int& R, int& C) { const int st = b / 1024, sb = b % 1024, swz = sb ^ (((sb >> 9) & 1) << 5); R = (st >> 1) * 16 + swz / 64; C = (st & 1) * 32 + (swz % 64) / 2; }
__device__ __forceinline__ int perm32(int rho) { const int n = rho >> 4, i = rho & 15; return 8 * (i >> 2) + 4 * n + (i & 3); }

struct Unit {
    const char* A; const char* B;
    unsigned lda, ldb;
    int nt;
    const int* ridx;
    int p0, p1, p2;
};

template <class Epi, class Sched>
__device__ __forceinline__ void gemm_phase(LAS unsigned char* lds, const Sched& S, const Epi& E) {
    int tid_ = threadIdx.x; asm volatile("" : "+v"(tid_));
    const int tid = tid_, wid = __builtin_amdgcn_readfirstlane(tid >> 6), lane = tid & 63, wr = wid >> 2, wc = wid & 3, fr = lane & 15, fq = lane >> 4;
    const size_t kstep = (size_t)(BK * 2);
    const unsigned ldsw = (unsigned)wid * 1024u;
    const int aoff = lds_byte(wr * 64 + fr, fq * 8), boff = lds_byte(wc * 32 + fr, fq * 8);
#define GG_SA(b, h) (((b) * 2 + (h)) * HTB)
#define GG_SB(b, h) ((4 + (b) * 2 + (h)) * HTB)
#define GG_STAGE(bufoff, gbase, v0, v1) do { \
        __builtin_amdgcn_global_load_lds((const unsigned*)((const char*)(gbase) + (v0)), (LAS unsigned*)(lds + (bufoff) + ldsw), 16, 0, 0); \
        __builtin_amdgcn_global_load_lds((const unsigned*)((const char*)(gbase) + (v1)), (LAS unsigned*)(lds + (bufoff) + ldsw + 8192), 16, 0, 0); } while (0)
#define GG_LDA(dst, b, h) do { _Pragma("unroll") for (int m = 0; m < 4; ++m) _Pragma("unroll") for (int k = 0; k < 2; ++k) dst[m][k] = *(const LAS bf16x8*)(lds + GG_SA(b, h) + aoff + m * 2048 + k * 1024); } while (0)
#define GG_LDB(dst, b, h) do { _Pragma("unroll") for (int n = 0; n < 2; ++n) _Pragma("unroll") for (int k = 0; k < 2; ++k) dst[n][k] = *(const LAS bf16x8*)(lds + GG_SB(b, h) + boff + n * 2048 + k * 1024); } while (0)
#define GG_MMA(ai, bj, At, Bt) do { __builtin_amdgcn_s_setprio(1); _Pragma("unroll") for (int m = 0; m < 4; ++m) _Pragma("unroll") for (int n = 0; n < 2; ++n) _Pragma("unroll") for (int k = 0; k < 2; ++k) \
        acc[ai][bj][m][n] = __builtin_amdgcn_mfma_f32_16x16x32_bf16(Bt[n][k], At[m][k], acc[ai][bj][m][n], 0, 0, 0); __builtin_amdgcn_s_setprio(0); } while (0)
#define GG_WAIT_V(n) asm volatile("s_waitcnt vmcnt(" #n ")" ::: "memory")
#define GG_WAIT_L(n) asm volatile("s_waitcnt lgkmcnt(" #n ")" ::: "memory")
#define GG_BAR __builtin_amdgcn_s_barrier()
#define GG_SCHED __builtin_amdgcn_sched_barrier(0)
#define GG_OFFS(u) do { int R0_, C0_, R1_, C1_; stage_rc(tid * 16, R0_, C0_); stage_rc(tid * 16 + 8192, R1_, C1_); \
        if (Sched::GATHER) { vA0 = (unsigned)(u).ridx[R0_] * (u).lda + C0_ * 2; vA1 = (unsigned)(u).ridx[R1_] * (u).lda + C1_ * 2; \
                             vA2 = (unsigned)(u).ridx[128 + R0_] * (u).lda + C0_ * 2; vA3 = (unsigned)(u).ridx[128 + R1_] * (u).lda + C1_ * 2; hA = 0; } \
        else { vA0 = (unsigned)R0_ * (u).lda + C0_ * 2; vA1 = (unsigned)R1_ * (u).lda + C1_ * 2; vA2 = vA0; vA3 = vA1; hA = (size_t)128 * (u).lda; } \
        const int Rb0_ = Epi::PERM ? ((R0_ & ~31) + perm32(R0_ & 31)) : R0_, Rb1_ = Epi::PERM ? ((R1_ & ~31) + perm32(R1_ & 31)) : R1_; \
        vB0 = (unsigned)Rb0_ * (u).ldb + C0_ * 2; vB1 = (unsigned)Rb1_ * (u).ldb + C1_ * 2; hB = (size_t)128 * (u).ldb; } while (0)
    Unit cur, nxt; int ui = 0;
    if (!S.next(0, cur)) return;
    f32x4 acc[2][2][4][2];
#pragma unroll
    for (int a = 0; a < 2; ++a)
#pragma unroll
        for (int b = 0; b < 2; ++b)
#pragma unroll
            for (int m = 0; m < 4; ++m)
#pragma unroll
                for (int n = 0; n < 2; ++n) acc[a][b][m][n] = (f32x4){0.f, 0.f, 0.f, 0.f};
    bf16x8 At[4][2], B0[2][2], B1[2][2];
    unsigned vA0, vA1, vA2, vA3, vB0, vB1; size_t hA, hB;
    GG_OFFS(cur);
    const char* cA = cur.A; const char* cB = cur.B;
    GG_STAGE(GG_SB(0, 0), cB, vB0, vB1); GG_STAGE(GG_SB(0, 1), cB + hB, vB0, vB1); GG_STAGE(GG_SA(0, 0), cA, vA0, vA1); GG_STAGE(GG_SA(0, 1), cA + hA, vA2, vA3);
    if (wr == 1) GG_BAR;
    GG_WAIT_V(2); GG_BAR;
    GG_STAGE(GG_SB(1, 0), cB + kstep, vB0, vB1); GG_STAGE(GG_SA(1, 0), cA + kstep, vA0, vA1); GG_STAGE(GG_SB(1, 1), cB + hB + kstep, vB0, vB1);
    GG_WAIT_V(6); GG_BAR;
    for (;;) {
        const bool has_next = S.next(ui + 1, nxt);
        const int nt = cur.nt;
#pragma unroll 1
        for (int t = 0; t < nt; t += 2) {
            const bool last = (t == nt - 2);
            const char* a1 = cA + (size_t)(t + 1) * kstep;
            GG_LDB(B0, 0, 0); GG_LDB(B1, 0, 1); GG_SCHED; GG_LDA(At, 0, 0); GG_STAGE(GG_SA(1, 1), a1 + hA, vA2, vA3);
            GG_WAIT_V(8); GG_WAIT_L(0); GG_BAR; GG_MMA(0, 0, At, B0); GG_MMA(0, 1, At, B1); GG_BAR; GG_SCHED;
            if (last) { if (has_next) { GG_OFFS(nxt); cA = nxt.A - (size_t)nt * kstep; cB = nxt.B - (size_t)nt * kstep; } else { cA -= (size_t)nt * kstep; cB -= (size_t)nt * kstep; } }
            const char* a2 = cA + (size_t)(t + 2) * kstep; const char* b2 = cB + (size_t)(t + 2) * kstep; const char* a3 = a2 + kstep; const char* b3 = b2 + kstep;
            GG_LDA(At, 0, 1); GG_STAGE(GG_SB(0, 0), b2, vB0, vB1); GG_STAGE(GG_SB(0, 1), b2 + hB, vB0, vB1); GG_STAGE(GG_SA(0, 0), a2, vA0, vA1);
            GG_WAIT_V(8); GG_WAIT_L(0); GG_BAR; GG_MMA(1, 0, At, B0); GG_MMA(1, 1, At, B1); GG_BAR; GG_SCHED;
            GG_LDB(B0, 1, 0); GG_LDB(B1, 1, 1); GG_SCHED; GG_LDA(At, 1, 0); GG_STAGE(GG_SA(0, 1), a2 + hA, vA2, vA3);
            GG_WAIT_V(8); GG_WAIT_L(0); GG_BAR; GG_MMA(0, 0, At, B0); GG_MMA(0, 1, At, B1); GG_BAR; GG_SCHED;
            GG_LDA(At, 1, 1); GG_STAGE(GG_SB(1, 0), b3, vB0, vB1); GG_STAGE(GG_SB(1, 1), b3 + hB, vB0, vB1); GG_STAGE(GG_SA(1, 0), a3, vA0, vA1);
            GG_WAIT_V(8); GG_WAIT_L(0); GG_BAR; GG_MMA(1, 0, At, B0); GG_MMA(1, 1, At, B1); GG_BAR; GG_SCHED;
        }
        cA += (size_t)nt * kstep; cB += (size_t)nt * kstep;
        if (wr == 0) GG_BAR;
        E(acc, cur, wr, wc, fr, fq);
        if (!has_next) break;
#pragma unroll
        for (int a = 0; a < 2; ++a)
#pragma unroll
            for (int b = 0; b < 2; ++b)
#pragma unroll
                for (int m = 0; m < 4; ++m)
#pragma unroll
                    for (int n = 0; n < 2; ++n) acc[a][b][m][n] = (f32x4){0.f, 0.f, 0.f, 0.f};
        cur = nxt; ++ui;
        if (wr == 1) GG_BAR;
    }
    GG_WAIT_V(0);
    GG_BAR;
#undef GG_SA
#undef GG_SB
#undef GG_STAGE
#undef GG_LDA
#undef GG_LDB
#undef GG_MMA
#undef GG_WAIT_V
#undef GG_WAIT_L
#undef GG_BAR
#undef GG_SCHED
#undef GG_OFFS
}
}

__device__ __forceinline__ int ld_i32_uniform(const int* p) { return __builtin_amdgcn_readfirstlane(__hip_atomic_load(p, __ATOMIC_RELAXED, __HIP_MEMORY_SCOPE_AGENT)); }
__device__ __forceinline__ void tile_order(int L, int nM, int nN, int& pm, int& pn) {
    const int nwg = nM * nN; int wgid = L;
    { const int q = nwg / 8, r = nwg % 8, xcd = wgid % 8, off = wgid / 8; wgid = (xcd < r ? xcd * (q + 1) : r * (q + 1) + (xcd - r) * q) + off; }
    const int nig = 8 * nN, gid = wgid / nig, fm = gid * 8, gsz = (nM - fm) < 8 ? (nM - fm) : 8;
    pm = fm + ((wgid % nig) % gsz); pn = (wgid % nig) / gsz;
}
struct SchedPlain {
    static constexpr bool GATHER = false;
    const char* A; const char* B; unsigned lda, ldb; int nt, nM, nN, G, c;
    __device__ __forceinline__ bool next(int i, gg::Unit& u) const {
        const int L = i * G + c; if (L >= nM * nN) return false;
        int pm, pn; tile_order(L, nM, nN, pm, pn);
        u.A = A + (size_t)pm * 256 * lda; u.B = B + (size_t)pn * 256 * ldb; u.lda = lda; u.ldb = ldb; u.nt = nt; u.ridx = nullptr; u.p0 = pm; u.p1 = pn; u.p2 = 0; return true;
    }
};
struct EpiWin {
    static constexpr bool PERM = true;
    bf16_t* px; float* gate;
    __device__ __forceinline__ void operator()(const f32x4 (&acc)[2][2][4][2], const gg::Unit& u, int wr, int wc, int fr, int fq) const {
        const int row0 = u.p0 * 256 + wr * 64 + fr;
#pragma unroll
        for (int bj = 0; bj < 2; ++bj) {
            const int c0 = u.p1 * 256 + bj * 128 + wc * 32 + 8 * fq;
            if (c0 < INC) {
                const bool isg = (c0 >= C_G && c0 < C_MLA);
#pragma unroll
                for (int ai = 0; ai < 2; ++ai)
#pragma unroll
                    for (int m = 0; m < 4; ++m) { const int row = row0 + ai * 128 + m * 16; const f32x4 v0 = acc[ai][bj][m][0], v1 = acc[ai][bj][m][1];
                        u32x4 w; w.x = cvt_pk_bf16(v0[0], v0[1]); w.y = cvt_pk_bf16(v0[2], v0[3]); w.z = cvt_pk_bf16(v1[0], v1[1]); w.w = cvt_pk_bf16(v1[2], v1[3]);
                        *(u32x4*)(px + (size_t)row * INC + c0) = w;
                        if (isg) { float* gp = gate + (size_t)row * 16 + (c0 - C_G); *(f32x4*)gp = v0; *(f32x4*)(gp + 4) = v1; } }
            }
        }
    }
};
struct SchedMerge {
    static constexpr bool GATHER = false;
    const char* hx; const char* yc; const char* wg; const char* wb; int nM, G, c;
    __device__ __forceinline__ bool next(int i, gg::Unit& u) const {
        const int k = i >> 3, s = i & 7, br = s >> 1; const int L = k * G + c; if (L >= nM * 4) return false;
        int pm, pn; tile_order(L, nM, 4, pm, pn);
        if (s & 1) { u.A = hx + (size_t)pm * 256 * 2048; u.lda = 2048; u.B = wg + (size_t)br * (1024 * 2048) + (size_t)pn * 256 * 2048; u.ldb = 2048; u.nt = 16; }
        else       { u.A = yc + (size_t)pm * 256 * 2048 + br * 512; u.lda = 2048; u.B = wb + (size_t)br * (1024 * 512) + (size_t)pn * 256 * 512; u.ldb = 512; u.nt = 4; }
        u.ridx = nullptr; u.p0 = pm; u.p1 = pn; u.p2 = s; return true;
    }
};
struct EpiMerge {
    static constexpr bool PERM = true;
    unsigned char* scr; const float* bgate; bf16_t* accm;
    __device__ __forceinline__ void operator()(const f32x4 (&acc)[2][2][4][2], const gg::Unit& u, int wr, int wc, int fr, int fq) const {
        const int s = u.p2, br = s >> 1; int tid = threadIdx.x; asm volatile("" : "+v"(tid));
        u32x4* SY = (u32x4*)scr; u32x4* ST = (u32x4*)(scr + 131072);
        if (!(s & 1)) {
#pragma unroll
            for (int ai = 0; ai < 2; ++ai)
#pragma unroll
                for (int m = 0; m < 4; ++m)
#pragma unroll
                    for (int bj = 0; bj < 2; ++bj) { const f32x4 v0 = acc[ai][bj][m][0], v1 = acc[ai][bj][m][1];
                        u32x4 w; w.x = cvt_pk_bf16(v0[0], v0[1]); w.y = cvt_pk_bf16(v0[2], v0[3]); w.z = cvt_pk_bf16(v1[0], v1[1]); w.w = cvt_pk_bf16(v1[2], v1[3]);
                        SY[((ai * 4 + m) * 2 + bj) * 512 + tid] = w; }
        } else {
            const int row0 = u.p0 * 256 + wr * 64 + fr;
#pragma unroll
            for (int bj = 0; bj < 2; ++bj) {
                const int col = u.p1 * 256 + bj * 128 + wc * 32 + 8 * fq;
                const f32x4 b0 = *(const f32x4*)(bgate + br * 1024 + col), b1 = *(const f32x4*)(bgate + br * 1024 + col + 4);
#pragma unroll
                for (int ai = 0; ai < 2; ++ai)
#pragma unroll
                    for (int m = 0; m < 4; ++m) { const int q = ((ai * 4 + m) * 2 + bj) * 512 + tid;
                        const u32x4 y = SY[q]; const f32x4 g0 = acc[ai][bj][m][0] + b0, g1 = acc[ai][bj][m][1] + b1;
                        float t[8];
                        t[0] = sigmoidf_(g0[0]) * bflo(y.x); t[1] = sigmoidf_(g0[1]) * bfhi(y.x); t[2] = sigmoidf_(g0[2]) * bflo(y.y); t[3] = sigmoidf_(g0[3]) * bfhi(y.y);
                        t[4] = sigmoidf_(g1[0]) * bflo(y.z); t[5] = sigmoidf_(g1[1]) * bfhi(y.z); t[6] = sigmoidf_(g1[2]) * bflo(y.w); t[7] = sigmoidf_(g1[3]) * bfhi(y.w);
                        if (br > 0) { const u32x4 p = ST[q]; t[0] += bflo(p.x); t[1] += bfhi(p.x); t[2] += bflo(p.y); t[3] += bfhi(p.y); t[4] += bflo(p.z); t[5] += bfhi(p.z); t[6] += bflo(p.w); t[7] += bfhi(p.w); }
                        u32x4 w; w.x = cvt_pk_bf16(t[0], t[1]); w.y = cvt_pk_bf16(t[2], t[3]); w.z = cvt_pk_bf16(t[4], t[5]); w.w = cvt_pk_bf16(t[6], t[7]);
                        if (br < 3) ST[q] = w; else *(u32x4*)(accm + (size_t)(row0 + ai * 128 + m * 16) * 1024 + col) = w; }
            }
        }
    }
};
struct EpiWout {
    static constexpr bool PERM = false;
    const float* src_lat; float* dst_lat; const float* src_ctx; float* dst_ctx; const float* gt;
    __device__ __forceinline__ void operator()(const f32x4 (&acc)[2][2][4][2], const gg::Unit& u, int wr, int wc, int fr, int fq) const {
        const int pm = u.p0; const bool isctx = pm >= 256; const int mrow = isctx ? 8 : (pm >> 5);
        const float* src = isctx ? src_ctx + (size_t)(pm - 256) * 256 * 1024 : src_lat + (size_t)pm * 256 * 1024;
        float* dst = isctx ? dst_ctx + (size_t)(pm - 256) * 256 * 1024 : dst_lat + (size_t)pm * 256 * 1024;
        const float* g = gt + (size_t)mrow * 6144;
        const int r0 = wr * 64 + fr, c0 = u.p1 * 256 + wc * 32 + 4 * fq;
        f32x4 gv[2][2];
#pragma unroll
        for (int bj = 0; bj < 2; ++bj)
#pragma unroll
            for (int n = 0; n < 2; ++n) gv[bj][n] = *(const f32x4*)(g + c0 + bj * 128 + n * 16);
#pragma unroll
        for (int ai = 0; ai < 2; ++ai)
#pragma unroll
            for (int m = 0; m < 4; ++m) { const size_t off = (size_t)(r0 + ai * 128 + m * 16) * 1024 + c0;
#pragma unroll
                for (int bj = 0; bj < 2; ++bj)
#pragma unroll
                    for (int n = 0; n < 2; ++n) { const f32x4 xv = *(const f32x4*)(src + off + bj * 128 + n * 16); *(f32x4*)(dst + off + bj * 128 + n * 16) = xv + gv[bj][n] * acc[ai][bj][m][n]; }
                asm volatile("" ::: "memory"); }
    }
};
struct SchedMoe1 {
    static constexpr bool GATHER = true;
    const char* hx2; const char* w13; const int* rtok; const int* tile_e; int ntiles, G, c;
    __device__ __forceinline__ bool next(int i, gg::Unit& u) const {
        const int L = i * G + c; if (L >= ntiles * 2) return false;
        const int tile = L >> 1, pn = L & 1, e = ld_i32_uniform(tile_e + tile);
        u.A = hx2; u.lda = 2048; u.ridx = rtok + tile * 256; u.B = w13 + (size_t)e * (512 * 2048) + (size_t)pn * 256 * 2048; u.ldb = 2048; u.nt = 16; u.p0 = tile; u.p1 = pn; u.p2 = e; return true;
    }
};
struct EpiMoe1 {
    static constexpr bool PERM = true;
    bf16_t* a; const float* roww;
    __device__ __forceinline__ void operator()(const f32x4 (&acc)[2][2][4][2], const gg::Unit& u, int wr, int wc, int fr, int fq) const {
        const int row0 = u.p0 * 256 + wr * 64 + fr, col = u.p1 * 128 + wc * 32 + 8 * fq;
#pragma unroll
        for (int ai = 0; ai < 2; ++ai)
#pragma unroll
            for (int m = 0; m < 4; ++m) { const int row = row0 + ai * 128 + m * 16; const float rw = roww[row];
                float t[8];
#pragma unroll
                for (int n = 0; n < 2; ++n)
#pragma unroll
                    for (int j = 0; j < 4; ++j) { const float g1 = acc[ai][0][m][n][j], g3 = acc[ai][1][m][n][j]; t[n * 4 + j] = g1 * sigmoidf_(g1) * g3 * rw; }
                u32x4 w; w.x = cvt_pk_bf16(t[0], t[1]); w.y = cvt_pk_bf16(t[2], t[3]); w.z = cvt_pk_bf16(t[4], t[5]); w.w = cvt_pk_bf16(t[6], t[7]);
                *(u32x4*)(a + (size_t)row * 256 + col) = w; }
    }
};
struct SchedMoe2 {
    static constexpr bool GATHER = false;
    const char* a; const char* w2; const int* tile_e; int ntiles, G, c;
    __device__ __forceinline__ bool next(int i, gg::Unit& u) const {
        const int L = i * G + c; if (L >= ntiles * 4) return false;
        const int tile = L >> 2, pn = L & 3, e = ld_i32_uniform(tile_e + tile);
        u.A = a + (size_t)tile * 256 * 512; u.lda = 512; u.ridx = nullptr; u.B = w2 + (size_t)e * (1024 * 512) + (size_t)pn * 256 * 512; u.ldb = 512; u.nt = 4; u.p0 = tile; u.p1 = pn; u.p2 = e; return true;
    }
};
struct EpiBf16Plain {
    static constexpr bool PERM = true;
    bf16_t* O; int ldc;
    __device__ __forceinline__ void operator()(const f32x4 (&acc)[2][2][4][2], const gg::Unit& u, int wr, int wc, int fr, int fq) const {
        const int row0 = u.p0 * 256 + wr * 64 + fr, col0 = u.p1 * 256 + wc * 32 + 8 * fq;
#pragma unroll
        for (int ai = 0; ai < 2; ++ai)
#pragma unroll
            for (int m = 0; m < 4; ++m)
#pragma unroll
                for (int bj = 0; bj < 2; ++bj) { const f32x4 v0 = acc[ai][bj][m][0], v1 = acc[ai][bj][m][1];
                    u32x4 w; w.x = cvt_pk_bf16(v0[0], v0[1]); w.y = cvt_pk_bf16(v0[2], v0[3]); w.z = cvt_pk_bf16(v1[0], v1[1]); w.w = cvt_pk_bf16(v1[2], v1[3]);
                    *(u32x4*)(O + (size_t)(row0 + ai * 128 + m * 16) * ldc + col0 + bj * 128) = w; }
    }
};

__device__ __forceinline__ int crow(int r, int hi) { return (r & 3) + 8 * (r >> 2) + 4 * hi; }
__device__ __forceinline__ f32x16 mma32_ll(f32x16 acc, const LAS bf16_t* A, int lda, const LAS bf16_t* B, int ldb, int ksteps, int lane) {
    const int r32 = lane & 31, hi = lane >> 5;
    for (int ks = 0; ks < ksteps; ++ks) {
        const bf16x8 a = *(const LAS bf16x8*)(A + r32 * lda + ks * 16 + hi * 8);
        const bf16x8 b = *(const LAS bf16x8*)(B + r32 * ldb + ks * 16 + hi * 8);
        acc = __builtin_amdgcn_mfma_f32_32x32x16_bf16(a, b, acc, 0, 0, 0);
    }
    return acc;
}
__device__ __forceinline__ f32x16 mma32_lg(f32x16 acc, const LAS bf16_t* A, int lda, const bf16_t* B, int ldb, int ksteps, int lane) {
    const int r32 = lane & 31, hi = lane >> 5;
    for (int ks = 0; ks < ksteps; ++ks) {
        const bf16x8 a = *(const LAS bf16x8*)(A + r32 * lda + ks * 16 + hi * 8);
        const bf16x8 b = *(const bf16x8*)(B + (size_t)r32 * ldb + ks * 16 + hi * 8);
        acc = __builtin_amdgcn_mfma_f32_32x32x16_bf16(a, b, acc, 0, 0, 0);
    }
    return acc;
}

__device__ __forceinline__ void ph_pre(const Frame& F) {
    LAS float* sv = (LAS float*)F.lds;
    LAS float* part = sv + 9 * 1024;
    float* mod = (float*)(F.ws + WS_MOD);
    for (int i = F.tid; i < 9 * 1024; i += NTHR) { const int r = i >> 10, k = i & 1023; const float c = (r < 8) ? F.in[I_C][r * 1024 + k] : F.in[I_CCTX][k]; sv[i] = c * sigmoidf_(c); }
    __syncthreads();
    for (int it = F.bx; it < 2 * 96; it += F.G) {
        const int l = it / 96, jc = it % 96, j = jc * 64 + F.lane, k0 = F.wave * 128;
        const float* w = F.in[I_WMOD] + ((size_t)l * 1024 + k0) * 6144 + j;
        float a[9];
#pragma unroll
        for (int r = 0; r < 9; ++r) a[r] = 0.f;
#pragma unroll 4
        for (int k = 0; k < 128; ++k) { const float wv = w[(size_t)k * 6144];
#pragma unroll
            for (int r = 0; r < 9; ++r) a[r] += sv[r * 1024 + k0 + k] * wv; }
#pragma unroll
        for (int r = 0; r < 9; ++r) part[(F.wave * 9 + r) * 64 + F.lane] = a[r];
        __syncthreads();
        for (int i = F.tid; i < 9 * 64; i += NTHR) { const int r = i >> 6, jj = i & 63; float s = F.in[I_BMOD][l * 6144 + jc * 64 + jj];
#pragma unroll
            for (int w8 = 0; w8 < 8; ++w8) s += part[(w8 * 9 + r) * 64 + jj];
            mod[((size_t)(l * 9 + r)) * 6144 + jc * 64 + jj] = s; }
        __syncthreads();
    }
    if (F.bx == F.G - 1) {
        float* rt = (float*)(F.ws + T_ROPE);
        for (int i = F.tid; i < 1024; i += NTHR) { const int pos = i >> 3, f = i & 7; const float inv = powf(10000.0f, -(float)f / 8.0f); const float ang = (float)pos * inv; rt[2 * i] = cosf(ang); rt[2 * i + 1] = sinf(ang); }
    }
}

struct ConvCursor { int base; int gw, ngw; };
__device__ __forceinline__ void conv_mat(const Frame& F, ConvCursor& cc, const float* src, int K, int N, bf16_t* dst, int ldd, int rbase, int rstep, int nbatch, size_t sbs, size_t dbs) {
    const int ktl = K / 64, ntl = (N + 63) / 64, per = ktl * ntl, total = per * nbatch;
    LAS float* scr = (LAS float*)(F.lds + F.wave * 16640);
    int t = cc.base + ((cc.gw - cc.base) % cc.ngw + cc.ngw) % cc.ngw;
    for (; t < cc.base + total; t += cc.ngw) {
        const int li = t - cc.base, bt = li / per, rem = li % per, kb = rem / ntl, nb = rem % ntl, k0 = kb * 64, n0 = nb * 64;
        const float* s = src + bt * sbs; bf16_t* d = dst + bt * dbs;
        const int n = n0 + F.lane;
#pragma unroll 8
        for (int i = 0; i < 64; ++i) scr[i * 65 + F.lane] = (n < N) ? s[(size_t)(k0 + i) * N + n] : 0.f;
        LDS_WAIT(); asm volatile("" ::: "memory");
#pragma unroll
        for (int it = 0; it < 8; ++it) { const int q = it * 64 + F.lane, nl = q >> 3, c = q & 7, nn = n0 + nl;
            if (nn < N) { const LAS float* p = scr + (8 * c) * 65 + nl;
                u32x4 o; o.x = pk2(p[0], p[65]); o.y = pk2(p[130], p[195]); o.z = pk2(p[260], p[325]); o.w = pk2(p[390], p[455]);
                *(u32x4*)(d + (size_t)(rbase + (nn >> 7) * rstep + (nn & 127)) * ldd + k0 + 8 * c) = o; } }
        LDS_WAIT(); asm volatile("" ::: "memory");
    }
    cc.base += total;
}
__device__ __forceinline__ void ph_convert(const Frame& F, int l) {
    ConvCursor cc; cc.base = 0; cc.gw = F.bx * NWAVES + F.wave; cc.ngw = F.G * NWAVES;
    unsigned char* ws = F.ws;
    conv_mat(F, cc, F.in[I_WIN] + (size_t)l * 1024 * INC, 1024, INC, (bf16_t*)(ws + W_IN), 1024, 0, 128, 1, 0, 0);
    conv_mat(F, cc, F.in[I_WGATE] + (size_t)l * 4 * 1024 * 1024, 1024, 1024, (bf16_t*)(ws + W_GATE), 1024, 0, 128, 4, (size_t)1024 * 1024, (size_t)1024 * 1024);
    conv_mat(F, cc, F.in[I_WBR] + (size_t)l * 4 * 256 * 1024, 256, 1024, (bf16_t*)(ws + W_BR), 256, 0, 128, 4, (size_t)256 * 1024, (size_t)1024 * 256);
    conv_mat(F, cc, F.in[I_WOUT] + (size_t)l * 1024 * 1024, 1024, 1024, (bf16_t*)(ws + W_OUT), 1024, 0, 128, 1, 0, 0);
    conv_mat(F, cc, F.in[I_W1] + (size_t)l * 64 * 1024 * 256, 1024, 256, (bf16_t*)(ws + W_13), 1024, 0, 256, 64, (size_t)1024 * 256, (size_t)512 * 1024);
    conv_mat(F, cc, F.in[I_W3] + (size_t)l * 64 * 1024 * 256, 1024, 256, (bf16_t*)(ws + W_13), 1024, 128, 256, 64, (size_t)1024 * 256, (size_t)512 * 1024);
    conv_mat(F, cc, F.in[I_W2] + (size_t)l * 64 * 256 * 1024, 256, 1024, (bf16_t*)(ws + W_2), 256, 0, 128, 64, (size_t)256 * 1024, (size_t)1024 * 256);
    conv_mat(F, cc, F.in[I_WS1] + (size_t)l * 1024 * 256, 1024, 256, (bf16_t*)(ws + W_13) + (size_t)64 * 512 * 1024, 1024, 0, 256, 1, 0, 0);
    conv_mat(F, cc, F.in[I_WS3] + (size_t)l * 1024 * 256, 1024, 256, (bf16_t*)(ws + W_13) + (size_t)64 * 512 * 1024, 1024, 128, 256, 1, 0, 0);
    conv_mat(F, cc, F.in[I_WS2] + (size_t)l * 256 * 1024, 256, 1024, (bf16_t*)(ws + W_2) + (size_t)64 * 1024 * 256, 256, 0, 128, 1, 0, 0);
    conv_mat(F, cc, F.in[I_WUQ] + (size_t)l * 256 * 384, 256, 384, (bf16_t*)(ws + W_UQ), 256, 0, 128, 1, 0, 0);
    conv_mat(F, cc, F.in[I_WUKV] + (size_t)l * 128 * 512, 128, 512, (bf16_t*)(ws + W_UKV), 128, 0, 128, 1, 0, 0);
    conv_mat(F, cc, F.in[I_POOLW] + (size_t)l * 4 * 64 * 64, 64, 64, (bf16_t*)(ws + W_POOL), 64, 0, 128, 4, (size_t)64 * 64, (size_t)64 * 64);
    conv_mat(F, cc, F.in[I_WRT] + (size_t)l * 1024 * 64, 1024, 64, (bf16_t*)(ws + W_RT), 1024, 0, 128, 1, 0, 0);
    { u32x4* z = (u32x4*)((bf16_t*)(ws + W_IN) + (size_t)INC * 1024); const int n16 = (INCP - INC) * 1024 * 2 / 16;
      for (int i = F.bx * NTHR + F.tid; i < n16; i += F.G * NTHR) z[i] = (u32x4){0u, 0u, 0u, 0u}; }
}

__device__ __forceinline__ void normmod_row(int lane, const float* xrow, const float* g, const float* sc, const float* sh, f32x4 (&y)[4]) {
    const f32x4* xr = (const f32x4*)xrow + lane; f32x4 v[4]; float s = 0.f;
#pragma unroll
    for (int j = 0; j < 4; ++j) { v[j] = xr[64 * j]; s += (v[j].x * v[j].x + v[j].y * v[j].y) + (v[j].z * v[j].z + v[j].w * v[j].w); }
    const float rstd = 1.0f / sqrtf(wave_sum(s) * (1.f / 1024.f) + EPS);
#pragma unroll
    for (int j = 0; j < 4; ++j) { const f32x4 gv = ((const f32x4*)g)[lane + 64 * j], scv = ((const f32x4*)sc)[lane + 64 * j], shv = ((const f32x4*)sh)[lane + 64 * j];
        y[j] = v[j] * rstd * gv * (scv + 1.0f) + shv; }
}
__device__ __forceinline__ const float* stream_row(const Frame& F, int l, int row) {
    if (row < NLAT) return (l == 0 ? F.in[I_X] : F.out) + (size_t)row * 1024;
    return (l == 0 ? F.in[I_CTX] : (const float*)(F.ws + WS_CTXS)) + (size_t)(row - NLAT) * 1024;
}
__device__ __forceinline__ void ph_norm1(const Frame& F, int l) {
    const int gw = F.bx * NWAVES + F.wave, ngw = F.G * NWAVES;
    bf16_t* hx = (bf16_t*)(F.ws + WS_HX);
    for (int row = gw; row < NTOK; row += ngw) {
        const int mr = mod_row_of(row); f32x4 y[4];
        normmod_row(F.lane, stream_row(F, l, row), F.in[I_GMIX] + l * 1024, modp(F, l, mr, 1), modp(F, l, mr, 0), y);
        u32x2* o = (u32x2*)(hx + (size_t)row * 1024) + F.lane;
#pragma unroll
        for (int j = 0; j < 4; ++j) o[64 * j] = (u32x2){pk2(y[j].x, y[j].y), pk2(y[j].z, y[j].w)};
    }
}

constexpr float QSCALE = 0.10206207261596577f * 1.4426950408889634f;
__device__ __forceinline__ void mla_unit(const Frame& F, int l, int unit, bool want_q) {
    LAS unsigned char* lds = F.lds;
    LAS bf16_t* AQ = (LAS bf16_t*)lds;
    LAS bf16_t* AKV = (LAS bf16_t*)(lds + 16896);
    LAS float* KR = (LAS float*)(lds + 25600);
    LAS float* OUT = (LAS float*)(lds + 29696);
    LAS bf16_t* KB = (LAS bf16_t*)(lds + 96256);
    const int row0 = unit * 32, lane = F.lane, wave = F.wave, tid = F.tid;
    const bool isctx = row0 >= NLAT;
    const int b = isctx ? (row0 - NLAT) >> 8 : row0 >> 13, pos0 = isctx ? (row0 - NLAT) & 255 : row0 & 8191;
    const bf16_t* px = (const bf16_t*)(F.ws + WS_PX);
    const float* gcq = F.in[I_GCQ] + l * 256; const float* gckv = F.in[I_GCKV] + l * 128; const float* gqn = F.in[I_GQN] + l * 96; const float* gkn = F.in[I_GKN] + l * 96;
    const float* rope = (const float*)(F.ws + T_ROPE);
    __syncthreads();
    for (int rr = 0; rr < 4; ++rr) { const int r = wave * 4 + rr; const bf16_t* p = px + (size_t)(row0 + r) * INC + C_MLA;
        { const u32x2 w = *(const u32x2*)(p + 4 * lane); const float x0 = bflo(w.x), x1 = bfhi(w.x), x2 = bflo(w.y), x3 = bfhi(w.y);
          const float sc = 1.0f / sqrtf(wave_sum(x0 * x0 + x1 * x1 + x2 * x2 + x3 * x3) * (1.f / 256.f) + EPS); const f32x4 g = *(const f32x4*)(gcq + 4 * lane);
          *(LAS u32x2*)(AQ + r * 264 + 4 * lane) = (u32x2){pk2(x0 * sc * g.x, x1 * sc * g.y), pk2(x2 * sc * g.z, x3 * sc * g.w)}; }
        { const unsigned w = *(const unsigned*)(p + 256 + 2 * lane); const float x0 = bflo(w), x1 = bfhi(w);
          const float sc = 1.0f / sqrtf(wave_sum(x0 * x0 + x1 * x1) * (1.f / 128.f) + EPS); const f32x2 g = *(const f32x2*)(gckv + 2 * lane);
          *(LAS unsigned*)(AKV + r * 136 + 2 * lane) = pk2(x0 * sc * g.x, x1 * sc * g.y); }
        if (lane < 32) KR[r * 32 + lane] = bf2f(p[384 + lane]); }
    __syncthreads();
    const int r32 = lane & 31, hi = lane >> 5;
    if (want_q) {
        for (int nt = wave; nt < 12; nt += 8) { f32x16 acc = {}; acc = mma32_lg(acc, AQ, 264, (const bf16_t*)(F.ws + W_UQ) + (size_t)nt * 32 * 256, 256, 16, lane);
#pragma unroll
            for (int r = 0; r < 16; ++r) OUT[crow(r, hi) * 520 + nt * 32 + r32] = acc[r]; }
        __syncthreads();
        bf16_t* qb = (bf16_t*)(F.ws + WS_QB);
        for (int it = 0; it < 8; ++it) { const int pr = wave * 16 + it * 2 + hi, r = pr >> 2, h = pr & 3; const LAS float* o = OUT + r * 520 + h * 96;
            float v0 = o[r32], v1 = o[32 + r32], v2 = o[64 + r32]; const float ss = half_sum(v0 * v0 + v1 * v1 + v2 * v2);
            const float sc = 1.0f / sqrtf(ss * (1.f / 96.f) + EPS);
            v0 *= sc * gqn[r32]; v1 *= sc * gqn[32 + r32]; v2 *= sc * gqn[64 + r32];
            const float pv = xor_lane<8>(v2);
            if (!isctx) { const int pos = pos0 + r, pp = (r32 < 16) ? (pos >> 6) : (pos & 63); const float cs = rope[(pp * 8 + (r32 & 7)) * 2], sn = rope[(pp * 8 + (r32 & 7)) * 2 + 1];
                v2 = (r32 & 8) ? (v2 * cs + pv * sn) : (v2 * cs - pv * sn); }
            bf16_t* q = qb + (size_t)(row0 + r) * 384 + h * 96;
            q[r32] = (bf16_t)f2bf(v0 * QSCALE); q[32 + r32] = (bf16_t)f2bf(v1 * QSCALE); q[64 + r32] = (bf16_t)f2bf(v2 * QSCALE); }
        __syncthreads();
    }
    for (int nt = wave * 2; nt < wave * 2 + 2; ++nt) { f32x16 acc = {}; acc = mma32_lg(acc, AKV, 136, (const bf16_t*)(F.ws + W_UKV) + (size_t)nt * 32 * 128, 128, 8, lane);
#pragma unroll
        for (int r = 0; r < 16; ++r) OUT[crow(r, hi) * 520 + nt * 32 + r32] = acc[r]; }
    __syncthreads();
    for (int it = 0; it < 8; ++it) { const int pr = wave * 16 + it * 2 + hi, r = pr >> 2, h = pr & 3; const LAS float* o = OUT + r * 520 + h * 128;
        float v0 = o[r32], v1 = o[32 + r32], v2 = KR[r * 32 + r32]; const float ss = half_sum(v0 * v0 + v1 * v1 + v2 * v2);
        const float sc = 1.0f / sqrtf(ss * (1.f / 96.f) + EPS);
        v0 *= sc * gkn[r32]; v1 *= sc * gkn[32 + r32]; v2 *= sc * gkn[64 + r32];
        const float pv = xor_lane<8>(v2);
        if (!isctx) { const int pos = pos0 + r, pp = (r32 < 16) ? (pos >> 6) : (pos & 63); const float cs = rope[(pp * 8 + (r32 & 7)) * 2], sn = rope[(pp * 8 + (r32 & 7)) * 2 + 1];
            v2 = (r32 & 8) ? (v2 * cs + pv * sn) : (v2 * cs - pv * sn); }
        LAS bf16_t* kb = KB + (r * 4 + h) * 104;
        kb[r32] = (bf16_t)f2bf(v0); kb[32 + r32] = (bf16_t)f2bf(v1); kb[64 + r32] = (bf16_t)f2bf(v2); }
    __syncthreads();
    const int key0 = isctx ? pos0 : 256 + pos0, tile = key0 >> 6, kin = key0 & 63;
    for (int i = tid; i < 1536; i += NTHR) { const int r = i & 31, c = (i >> 5) % 12, h = i / 384;
        const u32x4 v = *(const LAS u32x4*)(KB + (r * 4 + h) * 104 + c * 8);
        *(u32x4*)((bf16_t*)(F.ws + WS_KT) + ((size_t)((b * 4 + h) * NKT + tile) * 12 + c) * 512 + (kin + r) * 8) = v; }
    for (int i = tid; i < 1024; i += NTHR) { const int p = i & 3, r = (i >> 2) & 31, dh = (i >> 7) & 1, h = i >> 8; const LAS float* o = OUT + r * 520 + h * 128 + 64 + dh * 32 + p * 8;
        u32x4 v; v.x = pk2(o[0], o[1]); v.y = pk2(o[2], o[3]); v.z = pk2(o[4], o[5]); v.w = pk2(o[6], o[7]);
        *(u32x4*)((bf16_t*)(F.ws + WS_VT) + ((size_t)((b * 4 + h) * NKT + tile) * 2 + dh) * 2048 + (kin + r) * 32 + p * 8) = v; }
}

__device__ __forceinline__ void ml_chunk_pos(int dir, int j, bool& isctx, int& p0) {
    if (j < 2) { isctx = true; p0 = (dir == 0 ? j : 1 - j) * 128; } else { isctx = false; p0 = (dir == 0 ? (j - 2) : (63 - (j - 2))) * 128; }
}
__device__ __forceinline__ int ml_row(int b, bool isctx, int pos) { return isctx ? NLAT + b * 256 + pos : b * 8192 + pos; }
__device__ __forceinline__ float log_sigmoidf_(float x) { return fminf(x, 0.f) - log1pf(__expf(-fabsf(x))); }

__device__ __forceinline__ void ml_pass1_unit(const Frame& F, int l, int unit) {
    LAS float* LI = (LAS float*)F.lds; LAS float* LF = LI + 128; LAS float* WV = LI + 256;
    LAS bf16_t* KT = (LAS bf16_t*)(F.lds + 2048); LAS bf16_t* VT = KT + 64 * 136;
    const int j = unit % NCHK, dir = (unit / NCHK) & 1, h = (unit / (NCHK * 2)) & 3, b = unit / (NCHK * 8);
    bool isctx; int p0; ml_chunk_pos(dir, j, isctx, p0);
    const int tid = F.tid, lane = F.lane, wave = F.wave;
    const float* gate = (const float*)(F.ws + T_GATE); const float* gb = F.in[I_MLGB] + l * 16;
    const bf16_t* px = (const bf16_t*)(F.ws + WS_PX);
    __syncthreads();
    if (tid < 128) { const int pos = dir ? p0 + 127 - tid : p0 + tid; const float* g = gate + (size_t)ml_row(b, isctx, pos) * 16;
        LI[tid] = g[dir * 8 + h] + gb[dir * 8 + h]; LF[tid] = log_sigmoidf_(g[dir * 8 + 4 + h] + gb[dir * 8 + 4 + h]); }
    __syncthreads();
    if (wave == 0) {
        const float a0 = LF[2 * lane], a1 = LF[2 * lane + 1]; float s = a0 + a1;
#pragma unroll
        for (int o = 1; o < 64; o <<= 1) { const float t = lane_up(s, o, lane); if (lane >= o) s += t; }
        const float bend = lane_bcast(s, 63);
        const float w0 = bend - (s - a1) + LI[2 * lane], w1 = bend - s + LI[2 * lane + 1];
        const float mloc = wave_max(fmaxf(w0, w1));
        WV[2 * lane] = __expf(w0 - mloc); WV[2 * lane + 1] = __expf(w1 - mloc);
        if (lane == 0) { ((float*)(F.ws + T_MLOC))[unit] = mloc; ((float*)(F.ws + T_BEND))[unit] = bend; }
    }
    __syncthreads();
    for (int it = tid; it < 2048; it += NTHR) { const int i = it & 127, c = (it >> 7) & 7, isv = it >> 10; const int pos = dir ? p0 + 127 - i : p0 + i;
        const u32x4 v = *(const u32x4*)(px + (size_t)ml_row(b, isctx, pos) * INC + (isv ? 512 : 256) + h * 64 + c * 8);
        const float sc = isv ? 1.0f : 0.125f * WV[i]; LAS bf16_t* d = (isv ? VT : KT) + (c * 8) * 136 + i;
        d[0] = (bf16_t)f2bf(bflo(v.x) * sc); d[136] = (bf16_t)f2bf(bfhi(v.x) * sc); d[272] = (bf16_t)f2bf(bflo(v.y) * sc); d[408] = (bf16_t)f2bf(bfhi(v.y) * sc);
        d[544] = (bf16_t)f2bf(bflo(v.z) * sc); d[680] = (bf16_t)f2bf(bfhi(v.z) * sc); d[816] = (bf16_t)f2bf(bflo(v.w) * sc); d[952] = (bf16_t)f2bf(bfhi(v.w) * sc); }
    __syncthreads();
    if (wave < 4) { const int et = wave >> 1, dt = wave & 1; f32x16 acc = {}; acc = mma32_ll(acc, VT + et * 32 * 136, 136, KT + dt * 32 * 136, 136, 8, lane);
        float* dc = (float*)(F.ws + WS_DC) + (size_t)unit * 4096; const int r32 = lane & 31, hi = lane >> 5;
#pragma unroll
        for (int r = 0; r < 16; ++r) dc[(et * 32 + crow(r, hi)) * 64 + dt * 32 + r32] = acc[r];
    } else if (wave == 4) { float s = 0.f; for (int i = 0; i < 128; ++i) s += bf2f(KT[lane * 136 + i]); ((float*)(F.ws + T_DN))[(size_t)unit * 64 + lane] = s; }
}

__device__ __forceinline__ void ml_pass2(const Frame& F) {
    const float* dc = (const float*)(F.ws + WS_DC); const float* dn = (const float*)(F.ws + T_DN);
    const float* mloc = (const float*)(F.ws + T_MLOC); const float* bend = (const float*)(F.ws + T_BEND);
    bf16_t* cst = (bf16_t*)(F.ws + WS_CST); float* nst = (float*)(F.ws + T_NST); float* mst = (float*)(F.ws + T_MST);
    for (int it = F.bx; it < 64 * 8; it += F.G) { const int bhd = it >> 3, part = it & 7, u0 = bhd * NCHK, el = part * 512 + F.tid;
        float C = 0.f, n = 0.f, m = 0.f; const bool don = (part == 0 && F.tid < 64);
#pragma unroll 2
        for (int j = 0; j < NCHK; ++j) { const int u = u0 + j;
            const float dcv = dc[(size_t)u * 4096 + el], ml = mloc[u], be = bend[u]; const float dnv = don ? dn[(size_t)u * 64 + F.tid] : 0.f;
            cst[(size_t)u * 4096 + el] = (bf16_t)f2bf(C); if (don) nst[(size_t)u * 64 + F.tid] = n; if (part == 0 && F.tid == 0) mst[u] = m;
            const float mn = fmaxf(be + m, ml), dcy = __expf(be + m - mn), sc = __expf(ml - mn);
            C = dcy * C + sc * dcv; n = dcy * n + sc * dnv; m = mn; }
    }
}

__device__ __forceinline__ void ml_pass3_unit(const Frame& F, int l, int b, int h, int pc) {
    LAS unsigned char* lds = F.lds;
    LAS bf16_t* Qs = (LAS bf16_t*)lds;
    LAS bf16_t* Ks = (LAS bf16_t*)(lds + 18432);
    LAS bf16_t* VTs = (LAS bf16_t*)(lds + 36864);
    LAS bf16_t* CTs = (LAS bf16_t*)(lds + 62976);
    LAS bf16_t* Wm = (LAS bf16_t*)(lds + 76800);
    LAS float* HS = (LAS float*)(lds + 111616);
    LAS float* LI = (LAS float*)(lds + 144384); LAS float* LF = LI + 128; LAS float* COLV = LI + 256; LAS float* MV = LI + 384; LAS float* AIN = LI + 512; LAS float* EINV = LI + 640; LAS float* DEN = LI + 768;
    const int tid = F.tid, lane = F.lane, wave = F.wave, r32 = lane & 31, hi = lane >> 5;
    const bool isctx = pc < 2; const int p0 = isctx ? pc * 128 : (pc - 2) * 128;
    const float* gate = (const float*)(F.ws + T_GATE); const float* gb = F.in[I_MLGB] + l * 16;
    const bf16_t* px = (const bf16_t*)(F.ws + WS_PX);
    for (int dir = 0; dir < 2; ++dir) {
        const int j = isctx ? (dir == 0 ? pc : 1 - pc) : (dir == 0 ? pc : 2 + 63 - (pc - 2));
        const int unit = ((b * 4 + h) * 2 + dir) * NCHK + j;
        const float mst = ((const float*)(F.ws + T_MST))[unit];
        __syncthreads();
        if (tid < 128) { const int pos = dir ? p0 + 127 - tid : p0 + tid; const float* g = gate + (size_t)ml_row(b, isctx, pos) * 16;
            LI[tid] = g[dir * 8 + h] + gb[dir * 8 + h]; LF[tid] = log_sigmoidf_(g[dir * 8 + 4 + h] + gb[dir * 8 + 4 + h]); }
        __syncthreads();
        if (wave == 0) {
            const float a0 = LF[2 * lane], a1 = LF[2 * lane + 1]; float s = a0 + a1;
#pragma unroll
            for (int o = 1; o < 64; o <<= 1) { const float t = lane_up(s, o, lane); if (lane >= o) s += t; }
            const float b0 = s - a1, b1 = s, c0 = LI[2 * lane] - b0, c1 = LI[2 * lane + 1] - b1;
            float pm = fmaxf(c0, c1);
#pragma unroll
            for (int o = 1; o < 64; o <<= 1) { const float t = lane_up(pm, o, lane); if (lane >= o) pm = fmaxf(pm, t); }
            float pprev = lane_up(pm, 1, lane); if (lane == 0) pprev = -INFINITY;
            const float M0 = fmaxf(mst, fmaxf(pprev, c0)), M1 = fmaxf(mst, pm);
            COLV[2 * lane] = c0; COLV[2 * lane + 1] = c1; MV[2 * lane] = M0; MV[2 * lane + 1] = M1;
            AIN[2 * lane] = __expf(mst - M0); AIN[2 * lane + 1] = __expf(mst - M1); EINV[2 * lane] = __expf(-b0 - M0); EINV[2 * lane + 1] = __expf(-b1 - M1);
        }
        for (int it = tid; it < 3072; it += NTHR) { const int i = it & 127, c = (it >> 7) & 7, which = it >> 10; const int pos = dir ? p0 + 127 - i : p0 + i;
            const u32x4 v = *(const u32x4*)(px + (size_t)ml_row(b, isctx, pos) * INC + which * 256 + h * 64 + c * 8);
            if (which == 0) *(LAS u32x4*)(Qs + i * 72 + c * 8) = v;
            else if (which == 1) { u32x4 w; w.x = pk2(bflo(v.x) * 0.125f, bfhi(v.x) * 0.125f); w.y = pk2(bflo(v.y) * 0.125f, bfhi(v.y) * 0.125f); w.z = pk2(bflo(v.z) * 0.125f, bfhi(v.z) * 0.125f); w.w = pk2(bflo(v.w) * 0.125f, bfhi(v.w) * 0.125f);
                *(LAS u32x4*)(Ks + i * 72 + c * 8) = w; }
            else { LAS bf16_t* d = VTs + (c * 8) * 136 + i; d[0] = (bf16_t)(v.x & 0xffff); d[136] = (bf16_t)(v.x >> 16); d[272] = (bf16_t)(v.y & 0xffff); d[408] = (bf16_t)(v.y >> 16);
                d[544] = (bf16_t)(v.z & 0xffff); d[680] = (bf16_t)(v.z >> 16); d[816] = (bf16_t)(v.w & 0xffff); d[952] = (bf16_t)(v.w >> 16); } }
        for (int it = tid; it < 32 * 136; it += NTHR) VTs[64 * 136 + it] = (it < 128) ? (bf16_t)0x3f80 : (bf16_t)0;
        { const bf16_t* cs = (const bf16_t*)(F.ws + WS_CST) + (size_t)unit * 4096; const u32x4 v = *(const u32x4*)(cs + tid * 8); *(LAS u32x4*)(CTs + (tid >> 3) * 72 + (tid & 7) * 8) = v; }
        for (int it = tid; it < 32 * 72; it += NTHR) CTs[64 * 72 + it] = (it < 64) ? (bf16_t)f2bf(((const float*)(F.ws + T_NST))[(size_t)unit * 64 + it]) : (bf16_t)0;
        __syncthreads();
        for (int q = wave; q < 16; q += 8) { const int ti = q >> 2, si = q & 3; const int s = si * 32 + r32;
            if (si > ti) {
#pragma unroll
                for (int r = 0; r < 16; ++r) Wm[(ti * 32 + crow(r, hi)) * 136 + s] = 0;
            } else { f32x16 acc = {}; acc = mma32_ll(acc, Qs + ti * 32 * 72, 72, Ks + si * 32 * 72, 72, 4, lane); const float cv = COLV[s];
#pragma unroll
                for (int r = 0; r < 16; ++r) { const int t = ti * 32 + crow(r, hi); const float w = (s <= t) ? acc[r] * __expf(cv - MV[t]) : 0.f; Wm[t * 136 + s] = (bf16_t)f2bf(w); } }
        }
        __syncthreads();
        f32x16 tot[2];
        for (int k = 0; k < 2; ++k) { const int q = wave + 8 * k; if (q < 12) { const int ti = q / 3, nt = q % 3;
            f32x16 a1 = {}; a1 = mma32_ll(a1, Wm + ti * 32 * 136, 136, VTs + nt * 32 * 136, 136, (ti + 1) * 2, lane);
            f32x16 a2 = {}; a2 = mma32_ll(a2, Qs + ti * 32 * 72, 72, CTs + nt * 32 * 72, 72, 4, lane);
#pragma unroll
            for (int r = 0; r < 16; ++r) a1[r] += AIN[ti * 32 + crow(r, hi)] * a2[r];
            tot[k] = a1;
            if (nt == 2 && r32 == 0) {
#pragma unroll
                for (int r = 0; r < 16; ++r) DEN[ti * 32 + crow(r, hi)] = a1[r]; } } }
        __syncthreads();
        for (int k = 0; k < 2; ++k) { const int q = wave + 8 * k; if (q < 12) { const int ti = q / 3, nt = q % 3; if (nt < 2) {
#pragma unroll
            for (int r = 0; r < 16; ++r) { const int t = ti * 32 + crow(r, hi); const float hv = tot[k][r] / fmaxf(fabsf(DEN[t]), EINV[t]); const int p = dir ? 127 - t : t;
                if (dir == 0) HS[p * 64 + nt * 32 + r32] = hv; else HS[p * 64 + nt * 32 + r32] += hv; } } } }
    }
    __syncthreads();
    const float hg = F.in[I_MLHG][l * 256 + h * 64 + lane]; bf16_t* yc = (bf16_t*)(F.ws + WS_YC);
    for (int pp = 0; pp < 16; ++pp) { const int p = wave * 16 + pp; const int row = ml_row(b, isctx, p0 + p); const float v = HS[p * 64 + lane];
        const float sc = 1.0f / sqrtf(wave_sum(v * v) * (1.f / 64.f) + EPS); const float o = bf2f(px[(size_t)row * INC + 768 + h * 64 + lane]);
        yc[(size_t)row * 1024 + h * 64 + lane] = (bf16_t)f2bf(v * sc * hg * sigmoidf_(o)); }
}

__device__ __forceinline__ void pool_unit(const Frame& F, int l, int unit) {
    LAS float* U = (LAS float*)F.lds;
    LAS bf16_t* D = (LAS bf16_t*)(F.lds + 81920);
    const int row0 = unit * 64, tid = F.tid, lane = F.lane, wave = F.wave;
    const bool isctx = row0 >= NLAT; const int T = isctx ? 256 : 8192, t0 = isctx ? (row0 - NLAT) & 255 : row0 & 8191, rbase = row0 - t0;
    const bf16_t* px = (const bf16_t*)(F.ws + WS_PX);
    __syncthreads();
    for (int it = tid; it < 80 * 32; it += NTHR) { const int rr = it >> 5, c = it & 31, t = t0 - 8 + rr;
        u32x4 v = {0u, 0u, 0u, 0u}; if (t >= 0 && t < T) v = *(const u32x4*)(px + (size_t)(rbase + t) * INC + C_POOL + c * 8);
        LAS float* d = U + rr * 256 + c * 8; d[0] = bflo(v.x); d[1] = bfhi(v.x); d[2] = bflo(v.y); d[3] = bfhi(v.y); d[4] = bflo(v.z); d[5] = bfhi(v.z); d[6] = bflo(v.w); d[7] = bfhi(v.w); }
    __syncthreads();
    for (int it = tid; it < 64 * 256; it += NTHR) { const int tt = it >> 8, c = it & 255, g = c >> 6, hw = 1 << g, t = t0 + tt;
        const int lo = max(t - hw, 0), hi = min(t + hw, T); float s = 0.f;
        for (int u = lo; u < hi; ++u) s += U[(u - t0 + 8) * 256 + c];
        D[tt * 264 + c] = (bf16_t)f2bf(s / (float)(hi - lo) - U[(tt + 8) * 256 + c]); }
    __syncthreads();
    { const int g = wave >> 1, rt = wave & 1, r32 = lane & 31, hi = lane >> 5; bf16_t* yc = (bf16_t*)(F.ws + WS_YC); const float* ps = F.in[I_POOLS] + l * 256;
      for (int nt = 0; nt < 2; ++nt) { f32x16 acc = {}; acc = mma32_lg(acc, D + rt * 32 * 264 + g * 64, 264, (const bf16_t*)(F.ws + W_POOL) + (size_t)(g * 64 + nt * 32) * 64, 64, 4, lane);
          const int col = g * 64 + nt * 32 + r32; const float sc = ps[col];
#pragma unroll
          for (int r = 0; r < 16; ++r) yc[(size_t)(row0 + rt * 32 + crow(r, hi)) * 1024 + 512 + col] = (bf16_t)f2bf(acc[r] * sc); } }
}
__device__ __forceinline__ void conv_all(const Frame& F, int l, int nrows) {
    const bf16_t* px = (const bf16_t*)(F.ws + WS_PX); bf16_t* yc = (bf16_t*)(F.ws + WS_YC);
    const float* cw = F.in[I_CONVW] + l * 768; const float* cb = F.in[I_CONVB] + l * 256;
    for (int it = F.bx * NTHR + F.tid; it < nrows * 32; it += F.G * NTHR) { const int row = it >> 5, c = (it & 31) * 8;
        const bool isctx = row >= NLAT; const int T = isctx ? 256 : 8192, t = isctx ? (row - NLAT) & 255 : row & 8191;
        const bf16_t* p = px + (size_t)row * INC + C_CONV + c;
        float z[3][8];
#pragma unroll
        for (int j = 0; j < 3; ++j) { const int tt = t + j - 1;
            if (tt >= 0 && tt < T) { const bf16_t* q = p + (ptrdiff_t)(j - 1) * INC; const u32x4 u = *(const u32x4*)q, cc = *(const u32x4*)(q + 512);
                z[j][0] = bflo(u.x) * bflo(cc.x); z[j][1] = bfhi(u.x) * bfhi(cc.x); z[j][2] = bflo(u.y) * bflo(cc.y); z[j][3] = bfhi(u.y) * bfhi(cc.y);
                z[j][4] = bflo(u.z) * bflo(cc.z); z[j][5] = bfhi(u.z) * bfhi(cc.z); z[j][6] = bflo(u.w) * bflo(cc.w); z[j][7] = bfhi(u.w) * bfhi(cc.w); }
            else {
#pragma unroll
                for (int e = 0; e < 8; ++e) z[j][e] = 0.f; } }
        const u32x4 bw = *(const u32x4*)(p + 256); float bx[8] = {bflo(bw.x), bfhi(bw.x), bflo(bw.y), bfhi(bw.y), bflo(bw.z), bfhi(bw.z), bflo(bw.w), bfhi(bw.w)};
        float y[8];
#pragma unroll
        for (int e = 0; e < 8; ++e) y[e] = bx[e] * (cb[c + e] + cw[c + e] * z[0][e] + cw[256 + c + e] * z[1][e] + cw[512 + c + e] * z[2][e]);
        u32x4 o; o.x = pk2(y[0], y[1]); o.y = pk2(y[2], y[3]); o.z = pk2(y[4], y[5]); o.w = pk2(y[6], y[7]);
        *(u32x4*)(yc + (size_t)row * 1024 + 768 + c) = o; }
}

namespace att {
constexpr int STAGE_B = 40960, KSUB = 12288, VOFF = 24576, VSUB = 8192, LDS_WS = 3 * STAGE_B, LDS_OST = LDS_WS + 2048;
constexpr float THR = 8.0f;
__device__ __forceinline__ void glds16(const void* gsrc, unsigned lds_dst) { unsigned keep;
    asm volatile("s_mov_b32 %0, m0\n\ts_mov_b32 m0, %2\n\ts_nop 0\n\tglobal_load_lds_dwordx4 %1, off\n\ts_mov_b32 m0, %0" : "=&s"(keep) : "v"(gsrc), "s"(lds_dst) : "memory"); }
#define ATT_WAIT_BAR(N) asm volatile("s_waitcnt vmcnt(" #N ") lgkmcnt(0)\n\ts_barrier" ::: "memory")
__device__ __forceinline__ void qkt(f32x16& p0, f32x16& p1, const LAS char* Kslot, const bf16x8* qr, int r32, int hi) {
    const LAS char* kb = Kslot + hi * 1024 + r32 * 16; p0 = f32x16{}; p1 = f32x16{};
#pragma unroll
    for (int d0 = 0; d0 < 6; ++d0) {
        const bf16x8 b0 = *(const LAS bf16x8*)(kb + d0 * 2048), b1 = *(const LAS bf16x8*)(kb + d0 * 2048 + 512);
        p0 = __builtin_amdgcn_mfma_f32_32x32x16_bf16(b0, qr[d0], p0, 0, 0, 0); p1 = __builtin_amdgcn_mfma_f32_32x32x16_bf16(b1, qr[d0], p1, 0, 0, 0); }
}
__device__ __forceinline__ float rowmax(const f32x16& p0, const f32x16& p1) {
    float a = fmaxf(p0[0], p1[0]);
#pragma unroll
    for (int r = 1; r < 16; ++r) a = fmaxf(a, fmaxf(p0[r], p1[r]));
    auto rr = __builtin_amdgcn_permlane32_swap(__float_as_uint(a), __float_as_uint(a), false, false);
    return fmaxf(__uint_as_float(rr[0]), __uint_as_float(rr[1]));
}
__device__ __forceinline__ void pv(f32x16* o, int vb, bf16x8 pa0, bf16x8 pa1, bf16x8 pa2, bf16x8 pa3) {
#pragma unroll
    for (int d0 = 0; d0 < 2; ++d0) { s16x4 lo[4], hi[4];
#pragma unroll
        for (int ks = 0; ks < 4; ++ks) {
            asm volatile("ds_read_b64_tr_b16 %0,%1 offset:%c2" : "=&v"(lo[ks]) : "v"(vb), "i"(d0 * 4096 + ks * 1024) : "memory");
            asm volatile("ds_read_b64_tr_b16 %0,%1 offset:%c2" : "=&v"(hi[ks]) : "v"(vb), "i"(d0 * 4096 + ks * 1024 + 512) : "memory"); }
        asm volatile("s_waitcnt lgkmcnt(0)" ::: "memory"); __builtin_amdgcn_sched_barrier(0);
#define ATT_PK(k) (bf16x8){lo[k][0], lo[k][1], lo[k][2], lo[k][3], hi[k][0], hi[k][1], hi[k][2], hi[k][3]}
        o[d0] = __builtin_amdgcn_mfma_f32_32x32x16_bf16(pa0, ATT_PK(0), o[d0], 0, 0, 0);
        o[d0] = __builtin_amdgcn_mfma_f32_32x32x16_bf16(pa1, ATT_PK(1), o[d0], 0, 0, 0);
        o[d0] = __builtin_amdgcn_mfma_f32_32x32x16_bf16(pa2, ATT_PK(2), o[d0], 0, 0, 0);
        o[d0] = __builtin_amdgcn_mfma_f32_32x32x16_bf16(pa3, ATT_PK(3), o[d0], 0, 0, 0);
#undef ATT_PK
    }
}
__device__ __forceinline__ void unit(const Frame& F, int bh, int qrow, int orow, int nst) {
    const int tid = F.tid, lane = F.lane, wid = F.wave, r32 = lane & 31, hi = lane >> 5, h = bh & 3;
    const unsigned lds0 = (unsigned)(uintptr_t)F.lds;
    const LAS char* ring = (const LAS char*)F.lds;
    LAS float* wsf = (LAS float*)(F.lds + LDS_WS) + wid * 64;
    const char* kg = (const char*)(F.ws + WS_KT) + (size_t)bh * NKT * 12288; const char* vg = (const char*)(F.ws + WS_VT) + (size_t)bh * NKT * 8192;
    const bf16_t* Qw = (const bf16_t*)(F.ws + WS_QB) + (size_t)(qrow + wid * 32) * 384 + h * 96;
#define ATT_DMA(t, slot) do { const char* ks_ = kg + (size_t)(t) * 24576 + wid * 1024 + lane * 16; const char* vs_ = vg + (size_t)(t) * 16384 + wid * 1024 + lane * 16; \
        const unsigned kd_ = lds0 + (slot) * STAGE_B + wid * 1024, vd_ = kd_ + VOFF; \
        glds16(ks_, (unsigned)__builtin_amdgcn_readfirstlane(kd_)); glds16(ks_ + 8192, (unsigned)__builtin_amdgcn_readfirstlane(kd_ + 8192)); glds16(ks_ + 16384, (unsigned)__builtin_amdgcn_readfirstlane(kd_ + 16384)); \
        glds16(vs_, (unsigned)__builtin_amdgcn_readfirstlane(vd_)); glds16(vs_ + 8192, (unsigned)__builtin_amdgcn_readfirstlane(vd_ + 8192)); } while (0)
    ATT_DMA(0, 0); if (nst > 1) ATT_DMA(1, 1);
    bf16x8 qr[6];
#pragma unroll
    for (int d0 = 0; d0 < 6; ++d0) qr[d0] = *(const bf16x8*)(Qw + (size_t)r32 * 384 + d0 * 16 + hi * 8);
    float mhat = 0.f, l_reg = 0.f; f32x16 o[2]; o[0] = f32x16{}; o[1] = f32x16{};
    const int vb0 = (int)lds0 + VOFF + ((lane >> 4) & 1) * 32 + (lane & 3) * 8 + (4 * hi + ((lane & 15) >> 2)) * 64;
    int slot = 0; bool first = true;
    for (int t = 0; t < nst; ++t) {
        if (t + 1 < nst) ATT_WAIT_BAR(5); else ATT_WAIT_BAR(0);
        if (t + 2 < nst) { const int s2 = (slot == 0) ? 2 : slot - 1; ATT_DMA(t + 2, s2); }
#pragma unroll
        for (int s = 0; s < 2; ++s) {
            f32x16 p0, p1; qkt(p0, p1, ring + slot * STAGE_B + s * KSUB, qr, r32, hi);
            const float rm = rowmax(p0, p1);
            if (first) { mhat = rm; first = false; }
            else if (__any(rm - mhat > THR)) { const float dl = fmaxf(rm - mhat, 0.f); mhat += dl; const float f = __builtin_amdgcn_exp2f(-dl); l_reg *= f;
                if (hi == 0) wsf[r32] = f; LDS_WAIT();
#pragma unroll
                for (int r = 0; r < 16; ++r) { const float fr_ = wsf[crow(r, hi)]; o[0][r] *= fr_; o[1][r] *= fr_; } }
            float sacc = 0.f;
#pragma unroll
            for (int r = 0; r < 16; ++r) { p0[r] = __builtin_amdgcn_exp2f(p0[r] - mhat); p1[r] = __builtin_amdgcn_exp2f(p1[r] - mhat); sacc += p0[r] + p1[r]; }
            l_reg += sacc;
            u32x4 pw0, pw1, pw2, pw3;
            pw0 = (u32x4){cvt_pk_bf16(p0[0], p0[1]), cvt_pk_bf16(p0[2], p0[3]), cvt_pk_bf16(p0[4], p0[5]), cvt_pk_bf16(p0[6], p0[7])};
            pw1 = (u32x4){cvt_pk_bf16(p0[8], p0[9]), cvt_pk_bf16(p0[10], p0[11]), cvt_pk_bf16(p0[12], p0[13]), cvt_pk_bf16(p0[14], p0[15])};
            pw2 = (u32x4){cvt_pk_bf16(p1[0], p1[1]), cvt_pk_bf16(p1[2], p1[3]), cvt_pk_bf16(p1[4], p1[5]), cvt_pk_bf16(p1[6], p1[7])};
            pw3 = (u32x4){cvt_pk_bf16(p1[8], p1[9]), cvt_pk_bf16(p1[10], p1[11]), cvt_pk_bf16(p1[12], p1[13]), cvt_pk_bf16(p1[14], p1[15])};
            __builtin_amdgcn_sched_barrier(0);
            pv(o, vb0 + slot * STAGE_B + s * VSUB, __builtin_bit_cast(bf16x8, pw0), __builtin_bit_cast(bf16x8, pw1), __builtin_bit_cast(bf16x8, pw2), __builtin_bit_cast(bf16x8, pw3));
        }
        slot = (slot == 2) ? 0 : slot + 1;
    }
    { auto rr = __builtin_amdgcn_permlane32_swap(__float_as_uint(l_reg), __float_as_uint(l_reg), false, false); l_reg = __uint_as_float(rr[0]) + __uint_as_float(rr[1]); }
    if (hi == 0) wsf[32 + r32] = l_reg; LDS_WAIT();
    float rli[16];
#pragma unroll
    for (int r = 0; r < 16; ++r) rli[r] = 1.0f / wsf[32 + crow(r, hi)];
    LAS bf16_t* stg = (LAS bf16_t*)(F.lds + LDS_OST) + wid * 2048;
#pragma unroll
    for (int r = 0; r < 16; ++r) { const int orow_ = crow(r, hi);
#pragma unroll
        for (int d0 = 0; d0 < 2; ++d0) stg[orow_ * 64 + d0 * 32 + r32] = (bf16_t)f2bf(o[d0][r] * rli[r]); }
    LDS_WAIT();
    bf16_t* Ow = (bf16_t*)(F.ws + WS_YC) + (size_t)(orow + wid * 32) * 1024 + 256 + h * 64;
#pragma unroll
    for (int i = 0; i < 4; ++i) { const int row = i * 8 + (lane >> 3), ch = lane & 7; const u32x4 v = *(const LAS u32x4*)(stg + row * 64 + ch * 8); *(u32x4*)(Ow + (size_t)row * 1024 + ch * 8) = v; }
    asm volatile("s_waitcnt lgkmcnt(0)\n\ts_barrier" ::: "memory");
#undef ATT_DMA
}
}

__device__ __forceinline__ void ph_norm2_route(const Frame& F, int l, int ntok) {
    LAS bf16_t* A = (LAS bf16_t*)F.lds;
    LAS float* PART = (LAS float*)(F.lds + 66048);
    LAS float* LOG = (LAS float*)(F.lds + 131584);
    LAS int* HIST = (LAS int*)(F.lds + 139776);
    const int tid = F.tid, lane = F.lane, wave = F.wave, r32 = lane & 31, hi = lane >> 5;
    const int tpb = ntok / F.G, tok0 = F.bx * tpb;
    bf16_t* hx2 = (bf16_t*)(F.ws + WS_HX); int* eidx = (int*)(F.ws + T_EIDX); float* ew = (float*)(F.ws + T_EW);
    const float* brt = F.in[I_BRT] + l * 64;
    if (tid < 64) HIST[tid] = 0;
    for (int b0 = 0; b0 < tpb; b0 += 32) {
        __syncthreads();
        for (int rr = 0; rr < 4; ++rr) { const int r = wave * 4 + rr, t = b0 + r; LAS u32x2* a = (LAS u32x2*)(A + r * 1032) + lane;
            if (t < tpb) { const int row = tok0 + t, mr = mod_row_of(row); f32x4 y[4];
                normmod_row(lane, stream_row(F, 1, row), F.in[I_GFFN] + l * 1024, modp(F, l, mr, 4), modp(F, l, mr, 3), y);
                u32x2* o = (u32x2*)(hx2 + (size_t)row * 1024) + lane;
#pragma unroll
                for (int j = 0; j < 4; ++j) { const u32x2 w = (u32x2){pk2(y[j].x, y[j].y), pk2(y[j].z, y[j].w)}; o[64 * j] = w; a[64 * j] = w; }
            } else {
#pragma unroll
                for (int j = 0; j < 4; ++j) a[64 * j] = (u32x2){0u, 0u}; } }
        __syncthreads();
#pragma unroll
        for (int nt = 0; nt < 2; ++nt) { f32x16 acc = {}; acc = mma32_lg(acc, A + wave * 128, 1032, (const bf16_t*)(F.ws + W_RT) + (size_t)nt * 32 * 1024 + wave * 128, 1024, 8, lane);
#pragma unroll
            for (int r = 0; r < 16; ++r) PART[(wave * 32 + crow(r, hi)) * 64 + nt * 32 + r32] = acc[r]; }
        __syncthreads();
        for (int i = tid; i < 2048; i += NTHR) { float s = 0.f;
#pragma unroll
            for (int w = 0; w < 8; ++w) s += PART[w * 2048 + i];
            LOG[i] = s; }
        __syncthreads();
        for (int rr = 0; rr < 4; ++rr) { const int r = wave * 4 + rr, t = b0 + r; if (t >= tpb) continue;
            const float sc = sigmoidf_(LOG[r * 64 + lane]); float v = sc + brt[lane]; float ssel = 0.f, mys = 0.f; int myi = 0;
#pragma unroll
            for (int k = 0; k < TOPK; ++k) { const float mx = wave_max(v); const unsigned long long bal = __ballot(v == mx); const int win = __ffsll((long long)bal) - 1;
                const float sw = lane_bcast(sc, win); ssel += sw; if (lane == k) { mys = sw; myi = win; } if (lane == win) v = -INFINITY; }
            if (lane < TOPK) { eidx[(size_t)(tok0 + t) * 6 + lane] = myi; ew[(size_t)(tok0 + t) * 6 + lane] = mys / ssel * 2.5f; __hip_atomic_fetch_add(&HIST[myi], 1, __ATOMIC_RELAXED, __HIP_MEMORY_SCOPE_WORKGROUP); } }
    }
    __syncthreads();
    if (tid < 64) ((int*)(F.ws + T_HIST))[F.bx * 64 + tid] = HIST[tid];
}

__device__ __forceinline__ void ph_assign(const Frame& F, int c, int ntok) {
    LAS int* BASE = (LAS int*)F.lds; LAS int* CUR = BASE + 64; LAS int* START = BASE + 128; LAS int* TOT = BASE + 192; LAS int* MISC = BASE + 256;
    const int tid = F.tid, hb = F.G / 2, tpb = ntok / F.G, ctok0 = c * hb * tpb, ctoks = hb * tpb;
    const int* hist = (const int*)(F.ws + T_HIST); int* rtok = (int*)(F.ws + T_RTOK); float* rw = (float*)(F.ws + T_RW); int* slot = (int*)(F.ws + T_SLOT);
    int* tile_e = (int*)(F.ws + T_TILEE) + c * 1024;
    if (F.bx / hb != c) return;
    __syncthreads();
    if (tid < 64) { int tot = 0, bef = 0; for (int b = c * hb; b < (c + 1) * hb; ++b) { const int v = hist[b * 64 + tid]; tot += v; if (b < F.bx) bef += v; } TOT[tid] = tot; BASE[tid] = bef; CUR[tid] = 0; }
    __syncthreads();
    if (tid == 0) { int s = 0; for (int e = 0; e < 64; ++e) { START[e] = s; s += (TOT[e] + 255) / 256 * 256; } MISC[0] = s; }
    __syncthreads();
    const int sstart = MISC[0];
    const int* eidx = (const int*)(F.ws + T_EIDX); const float* ew = (const float*)(F.ws + T_EW);
    for (int i = tid; i < tpb * 6; i += NTHR) { const int tok = F.bx * tpb + i / 6, k = i % 6; const int e = eidx[(size_t)tok * 6 + k];
        const int pos = START[e] + BASE[e] + __hip_atomic_fetch_add(&CUR[e], 1, __ATOMIC_RELAXED, __HIP_MEMORY_SCOPE_WORKGROUP); rtok[pos] = tok; rw[pos] = ew[(size_t)tok * 6 + k]; slot[(size_t)tok * 8 + k] = pos; }
    for (int i = tid; i < tpb; i += NTHR) { const int tok = F.bx * tpb + i, pos = sstart + (tok - ctok0); rtok[pos] = tok; rw[pos] = 1.0f; slot[(size_t)tok * 8 + 6] = pos; }
    if (F.bx == c * hb) {
        for (int e = 0; e < 64; ++e) { const int p0 = START[e] + TOT[e], p1 = START[e] + (TOT[e] + 255) / 256 * 256;
            for (int p = p0 + tid; p < p1; p += NTHR) { rtok[p] = ctok0; rw[p] = 0.f; }
            for (int tl = START[e] / 256 + tid; tl < p1 / 256; tl += NTHR) tile_e[tl] = e; }
        for (int tl = sstart / 256 + tid; tl < (sstart + ctoks) / 256; tl += NTHR) tile_e[tl] = 64;
        if (tid == 0) tile_e[1023] = (sstart + ctoks) / 256;
    }
}

__device__ __forceinline__ void ph_combine(const Frame& F, int l, int c, int ntok) {
    const int gw = F.bx * NWAVES + F.wave, ngw = F.G * NWAVES, lane = F.lane; const int ctoks = ntok / 2, ctok0 = c * ctoks;
    const int* slot = (const int*)(F.ws + T_SLOT); const bf16_t* ys = (const bf16_t*)(F.ws + WS_YS);
    for (int t = gw; t < ctoks; t += ngw) { const int tok = ctok0 + t, mr = mod_row_of(tok);
        float* xr = (tok < NLAT) ? F.out + (size_t)tok * 1024 : (float*)(F.ws + WS_CTXS) + (size_t)(tok - NLAT) * 1024;
        const float* gt = modp(F, l, mr, 5);
        f32x4 a[4];
#pragma unroll
        for (int j = 0; j < 4; ++j) a[j] = (f32x4){0.f, 0.f, 0.f, 0.f};
#pragma unroll
        for (int k = 0; k < 7; ++k) { const int s = slot[(size_t)tok * 8 + k]; const u32x2* yr = (const u32x2*)(ys + (size_t)s * 1024) + lane;
#pragma unroll
            for (int j = 0; j < 4; ++j) { const u32x2 w = yr[64 * j]; a[j] += (f32x4){bflo(w.x), bfhi(w.x), bflo(w.y), bfhi(w.y)}; } }
#pragma unroll
        for (int j = 0; j < 4; ++j) { f32x4* p = (f32x4*)xr + lane + 64 * j; *p = *p + ((const f32x4*)gt)[lane + 64 * j] * a[j]; }
    }
}

__device__ __forceinline__ Frame phase_frame(const Frame& F) {
    Frame Q = F; int t = threadIdx.x; asm volatile("" : "+v"(t)); Q.tid = t; Q.lane = t & 63; Q.wave = __builtin_amdgcn_readfirstlane(t >> 6);
    unsigned long long w = (unsigned long long)F.ws; asm volatile("" : "+s"(w)); Q.ws = (unsigned char*)(GAS unsigned char*)w;
    return Q;
}
constexpr int PH_PER_LAYER = 16, PH_TOTAL = 1 + 2 * PH_PER_LAYER;
__global__ void __launch_bounds__(NTHR, 2) mk_fwd(Params p) {
    extern __shared__ __attribute__((aligned(16))) unsigned char lds_raw[];
    Frame F0;
    F0.lds = (LAS unsigned char*)lds_raw; F0.ws = p.ws; F0.in = p.in; F0.out = p.out;
    F0.tid = threadIdx.x; F0.lane = F0.tid & 63; F0.wave = __builtin_amdgcn_readfirstlane(F0.tid >> 6); F0.bx = blockIdx.x; F0.G = gridDim.x;
    volatile LAS unsigned* MISC = (volatile LAS unsigned*)(F0.lds + MISC_OFF);
    if (F0.tid < 64) MISC[F0.tid] = 0u;
    __syncthreads();
    const int lo = p.ph_lo, hi = p.ph_hi;
    XcdBarrier bar; bar.bar = (unsigned*)(F0.ws + WS_CTL) + CW_BAR; bar.x = 0; bar.st = MISC + 8;
    if (hi - lo > 1) bar = xcd_barrier_post((unsigned*)(F0.ws + WS_CTL) + CW_BAR, MISC + 8);
#ifndef MK_SITE
#define MK_SITE -1
#endif
#define SITE(n) (MK_SITE < 0 || MK_SITE == (n))
#define RUN(k) (lo <= (k) && (k) < hi)
#define SEAM(k) do { if (RUN(k) && RUN((k) + 1)) xcd_barrier(bar); } while (0)
    int ph = 0;
    if (SITE(0) && RUN(ph)) { const Frame F = phase_frame(F0); ph_pre(F); }
    SEAM(ph); ++ph;
    for (int l = 0; l < 2; ++l) {
        const int ntok = (l == 0) ? NTOK : NLAT, nM = ntok / 256;
        if (SITE(1) && RUN(ph)) { const Frame F = phase_frame(F0); ph_convert(F, l); __syncthreads(); ph_norm1(F, l); }
        SEAM(ph); ++ph;
        if (SITE(2) && RUN(ph)) { const Frame F = phase_frame(F0);
            SchedPlain S{(const char*)(F.ws + WS_HX), (const char*)(F.ws + W_IN), 2048u, 2048u, 16, NTOK / 256, INCP / 256, F.G, F.bx};
            EpiWin E{(bf16_t*)(F.ws + WS_PX), (float*)(F.ws + T_GATE)};
            gg::gemm_phase(F.lds, S, E);
        }
        SEAM(ph); ++ph;
        if (SITE(3) && RUN(ph)) { const Frame F = phase_frame(F0);
            for (int u = F.bx; u < NTOK / 32; u += F.G) mla_unit(F, l, u, (u * 32 < NLAT) || l == 0);
            for (int u = F.bx; u < 64 * NCHK; u += F.G) ml_pass1_unit(F, l, u);
            for (int u = F.bx; u < ntok / 64; u += F.G) pool_unit(F, l, u);
            conv_all(F, l, ntok);
            __syncthreads();
        }
        SEAM(ph); ++ph;
        if (SITE(4) && RUN(ph)) { const Frame F = phase_frame(F0);
            ml_pass2(F);
            const int nunits = 1024 + (l == 0 ? 32 : 0);
            for (int i = 0; ; ++i) { const int L = i * F.G + F.bx; if (L >= nunits) break;
                if (L < 1024) { const int bh = (L >> 8) * 8 + (L & 7), qb = (L & 255) >> 3, b = bh >> 2; att::unit(F, bh, b * 8192 + qb * 256, b * 8192 + qb * 256, 66); }
                else { const int bh = L - 1024, b = bh >> 2; att::unit(F, bh, NLAT + b * 256, NLAT + b * 256, 2); } }
        }
        SEAM(ph); ++ph;
        if (SITE(5) && RUN(ph)) { const Frame F = phase_frame(F0);
            const int npc = (l == 0) ? 66 : 64, nun = 32 * npc;
            for (int u = F.bx; u < nun; u += F.G) { const int bh = u / npc, pc = u % npc + (l == 0 ? 0 : 2); ml_pass3_unit(F, l, bh >> 2, bh & 3, pc); }
            __syncthreads();
        }
        SEAM(ph); ++ph;
        if (SITE(6) && RUN(ph)) { const Frame F = phase_frame(F0);
            SchedMerge S{(const char*)(F.ws + WS_HX), (const char*)(F.ws + WS_YC), (const char*)(F.ws + W_GATE), (const char*)(F.ws + W_BR), nM, F.G, F.bx};
            EpiMerge E{F.ws + WS_MSCR + (size_t)F.bx * 262144, F.in[I_BGATE] + l * 4096, (bf16_t*)(F.ws + WS_ACCM)};
            gg::gemm_phase(F.lds, S, E);
        }
        SEAM(ph); ++ph;
        if (SITE(7) && RUN(ph)) { const Frame F = phase_frame(F0);
            SchedPlain S{(const char*)(F.ws + WS_ACCM), (const char*)(F.ws + W_OUT), 2048u, 2048u, 16, nM, 4, F.G, F.bx};
            EpiWout E{l == 0 ? F.in[I_X] : (const float*)F.out, F.out, F.in[I_CTX], (float*)(F.ws + WS_CTXS), modp(F, l, 0, 2)};
            gg::gemm_phase(F.lds, S, E);
        }
        SEAM(ph); ++ph;
        if (SITE(8) && RUN(ph)) { const Frame F = phase_frame(F0); ph_norm2_route(F, l, ntok); }
        SEAM(ph); ++ph;
        for (int c = 0; c < 2; ++c) {

            if (SITE(9) && RUN(ph)) { const Frame F = phase_frame(F0); ph_assign(F, c, ntok); }
            SEAM(ph); ++ph;
            if (SITE(10) && RUN(ph)) { const Frame F = phase_frame(F0);
                int* tile_e = (int*)(F.ws + T_TILEE) + c * 1024; const int ntiles = ld_i32_uniform(tile_e + 1023);
                SchedMoe1 S{(const char*)(F.ws + WS_HX), (const char*)(F.ws + W_13), (const int*)(F.ws + T_RTOK), tile_e, ntiles, F.G, F.bx};
                EpiMoe1 E{(bf16_t*)(F.ws + WS_AMOE), (const float*)(F.ws + T_RW)};
                gg::gemm_phase(F.lds, S, E);
            }
            SEAM(ph); ++ph;
            if (SITE(11) && RUN(ph)) { const Frame F = phase_frame(F0);
                int* tile_e = (int*)(F.ws + T_TILEE) + c * 1024; const int ntiles = ld_i32_uniform(tile_e + 1023);
                SchedMoe2 S{(const char*)(F.ws + WS_AMOE), (const char*)(F.ws + W_2), tile_e, ntiles, F.G, F.bx};
                EpiBf16Plain E{(bf16_t*)(F.ws + WS_YS), 1024};
                gg::gemm_phase(F.lds, S, E);
            }
            SEAM(ph); ++ph;
            if (SITE(12) && RUN(ph)) { const Frame F = phase_frame(F0); ph_combine(F, l, c, ntok); }
            SEAM(ph); ++ph;
        }
    }
#undef RUN
#undef SEAM
}

extern "C" void kernel_launch(void* const* d_in, const int* in_sizes, int n_in, void* d_out, int out_size, void* d_ws, size_t ws_size, hipStream_t stream) {
    static int grid = 0;
    if (grid == 0) {
        if (n_in != 33 || out_size != NLAT * DM || ws_size < WS_END) { fprintf(stderr, "kernel_launch: unexpected shapes (n_in %d, out %d, ws %zu < %zu)\n", n_in, out_size, ws_size, (size_t)WS_END); grid = -1; return; }
        int dev = 0, cus = 0;
        if (hipGetDevice(&dev) != hipSuccess || hipDeviceGetAttribute(&cus, hipDeviceAttributeMultiprocessorCount, dev) != hipSuccess) { grid = -1; return; }
        if (hipFuncSetAttribute((const void*)mk_fwd, hipFuncAttributeMaxDynamicSharedMemorySize, LDS_BYTES) != hipSuccess) { fprintf(stderr, "kernel_launch: hipFuncSetAttribute failed\n"); grid = -1; return; }
        int per_cu = 0;
        if (hipOccupancyMaxActiveBlocksPerMultiprocessor(&per_cu, (const void*)mk_fwd, NTHR, LDS_BYTES) != hipSuccess || per_cu < 1) fprintf(stderr, "kernel_launch: occupancy query says %d\n", per_cu);
        (void)hipGetLastError();
        grid = cus;
    }
    if (grid < 0) return;
    (void)hipMemsetAsync((char*)d_ws + WS_CTL, 0, CTL_ZERO_BYTES, stream);
    Params p{};
    for (int i = 0; i < 33; ++i) p.in[i] = (const float*)d_in[i];
    p.out = (float*)d_out; p.ws = (unsigned char*)d_ws;
#if MK_ONE_LAUNCH
    p.ph_lo = 0; p.ph_hi = PH_TOTAL;
    hipLaunchKernelGGL(mk_fwd, dim3(grid), dim3(NTHR), LDS_BYTES, stream, p);
#else
    for (int k = 0; k < PH_TOTAL; ++k) { p.ph_lo = k; p.ph_hi = k + 1; hipLaunchKernelGGL(mk_fwd, dim3(grid), dim3(NTHR), LDS_BYTES, stream, p); }
#endif
}
```

```cpp
#include <hip/hip_runtime.h>
#include <stdint.h>
#include <stdio.h>
#include <math.h>

#ifndef MK_ONE_LAUNCH
#define MK_ONE_LAUNCH 1
#endif

#define LAS __attribute__((address_space(3)))
#define GAS __attribute__((address_space(1)))
typedef unsigned short bf16_t;
typedef short bf16x8 __attribute__((ext_vector_type(8)));
typedef short s16x4 __attribute__((ext_vector_type(4)));
typedef float f32x2 __attribute__((ext_vector_type(2)));
typedef float f32x4 __attribute__((ext_vector_type(4)));
typedef float f32x16 __attribute__((ext_vector_type(16)));
typedef unsigned u32x2 __attribute__((ext_vector_type(2)));
typedef unsigned u32x4 __attribute__((ext_vector_type(4)));

constexpr int DM = 1024, NB = 8, SEQ = 8192, CTXL = 256, GRIDW = 64;
constexpr int NLAT = NB * SEQ, NCTX = NB * CTXL, NTOK = NLAT + NCTX;
constexpr int INC = 2480, INCP = 2560;
constexpr int C_ML = 0, C_G = 1024, C_MLA = 1040, C_POOL = 1456, C_CONV = 1712;
constexpr int NE = 64, NE1 = 65, TOPK = 6, NSLOT7 = 7, EFF = 256;
constexpr int NCHK = 66;
constexpr int NKT = 132;
constexpr float EPS = 1e-6f;
constexpr int NWAVES = 8, NTHR = 512;
constexpr int MOE_ROWS_MAX = 253184;
constexpr int MOE_TILES_MAX = MOE_ROWS_MAX / 256;

constexpr size_t MiB = 1u << 20;
constexpr size_t WS_CTL = 0, CTL_ZERO_BYTES = 1 * MiB;
constexpr size_t WS_MOD = 128 * 1024;
constexpr size_t WS_TAB = 1 * MiB;
constexpr size_t T_ROPE = WS_TAB;
constexpr size_t T_HIST = T_ROPE + 16384;
constexpr size_t T_TILEE = T_HIST + 65536;
constexpr size_t T_EIDX = T_TILEE + 8192;
constexpr size_t T_EW = T_EIDX + (size_t)NTOK * 6 * 4;
constexpr size_t T_SLOT = T_EW + (size_t)NTOK * 6 * 4;
constexpr size_t T_RTOK = T_SLOT + (size_t)NTOK * 8 * 4;
constexpr size_t T_RW = T_RTOK + (size_t)MOE_ROWS_MAX * 4;
constexpr size_t T_GATE = T_RW + (size_t)MOE_ROWS_MAX * 4;
constexpr size_t T_DN = T_GATE + (size_t)NTOK * 16 * 4;
constexpr size_t T_NST = T_DN + (size_t)4224 * 64 * 4;
constexpr size_t T_MLOC = T_NST + (size_t)4224 * 64 * 4;
constexpr size_t T_BEND = T_MLOC + 4224 * 4;
constexpr size_t T_MST = T_BEND + 4224 * 4;
constexpr size_t T_END = T_MST + 4224 * 4;
static_assert(T_END <= 17 * MiB, "tables");
constexpr size_t WS_WB = 17 * MiB;
constexpr size_t W_IN = WS_WB;
constexpr size_t W_GATE = W_IN + (size_t)INCP * 1024 * 2;
constexpr size_t W_BR = W_GATE + (size_t)4 * 1024 * 1024 * 2;
constexpr size_t W_OUT = W_BR + (size_t)4 * 1024 * 256 * 2;
constexpr size_t W_13 = W_OUT + (size_t)1024 * 1024 * 2;
constexpr size_t W_2 = W_13 + (size_t)NE1 * 512 * 1024 * 2;
constexpr size_t W_UQ = W_2 + (size_t)NE1 * 1024 * 256 * 2;
constexpr size_t W_UKV = W_UQ + (size_t)384 * 256 * 2;
constexpr size_t W_POOL = W_UKV + (size_t)512 * 128 * 2;
constexpr size_t W_RT = W_POOL + (size_t)4 * 64 * 64 * 2;
constexpr size_t W_END = W_RT + (size_t)64 * 1024 * 2;
static_assert(W_END <= 133 * MiB, "weights");
constexpr size_t WS_CTXS = 133 * MiB;
constexpr size_t WS_HX = 141 * MiB;
constexpr size_t WS_PX = 273 * MiB;
constexpr size_t WS_QB = 593 * MiB;
constexpr size_t WS_KT = 643 * MiB;
constexpr size_t WS_VT = 693 * MiB;
constexpr size_t WS_YC = 726 * MiB;
constexpr size_t WS_DC = 858 * MiB;
constexpr size_t WS_CST = 924 * MiB;
constexpr size_t WS_END = 957 * MiB;
constexpr size_t WS_ACCM = WS_PX;
constexpr size_t WS_MSCR = WS_PX + 132 * MiB;
constexpr size_t WS_AMOE = WS_PX;
constexpr size_t WS_YS = WS_PX + 124 * MiB;
static_assert(WS_YS + (size_t)MOE_ROWS_MAX * 2048 <= WS_END, "moe overlay");
static_assert(WS_MSCR + 64 * MiB <= WS_QB, "merge scratch overlay");

constexpr int CW_BAR = 4096;

constexpr int RING_BYTES = 131072;
constexpr int MISC_OFF = 160 * 1024 - 256;
constexpr int LDS_BYTES = 160 * 1024;

__device__ __forceinline__ unsigned f2bf(float f) { unsigned u = __builtin_bit_cast(unsigned, f); return (u + 0x7fffu + ((u >> 16) & 1u)) >> 16; }
__device__ __forceinline__ unsigned pk2(float lo, float hi) { return f2bf(lo) | (f2bf(hi) << 16); }
__device__ __forceinline__ float bf2f(unsigned short b) { return __builtin_bit_cast(float, ((unsigned)b) << 16); }
__device__ __forceinline__ float bflo(unsigned w) { return __builtin_bit_cast(float, w << 16); }
__device__ __forceinline__ float bfhi(unsigned w) { return __builtin_bit_cast(float, w & 0xffff0000u); }
__device__ __forceinline__ unsigned cvt_pk_bf16(float lo, float hi) { unsigned r; asm volatile("v_cvt_pk_bf16_f32 %0, %1, %2" : "=v"(r) : "v"(lo), "v"(hi)); return r; }
__device__ __forceinline__ float sigmoidf_(float x) { return 1.0f / (1.0f + __expf(-x)); }
template <int O> __device__ __forceinline__ float xor_lane(float v) { return __builtin_bit_cast(float, __builtin_amdgcn_ds_swizzle(__builtin_bit_cast(int, v), 0x1f | (O << 10))); }
__device__ __forceinline__ float half_sum(float v) { v += xor_lane<1>(v); v += xor_lane<2>(v); v += xor_lane<4>(v); v += xor_lane<8>(v); v += xor_lane<16>(v); return v; }
__device__ __forceinline__ float half_max(float v) { v = fmaxf(v, xor_lane<1>(v)); v = fmaxf(v, xor_lane<2>(v)); v = fmaxf(v, xor_lane<4>(v)); v = fmaxf(v, xor_lane<8>(v)); v = fmaxf(v, xor_lane<16>(v)); return v; }
__device__ __forceinline__ float wave_sum(float v) { v = half_sum(v); auto rr = __builtin_amdgcn_permlane32_swap(__builtin_bit_cast(unsigned, v), __builtin_bit_cast(unsigned, v), false, false);
    return __builtin_bit_cast(float, (unsigned)rr[0]) + __builtin_bit_cast(float, (unsigned)rr[1]); }
__device__ __forceinline__ float wave_max(float v) { v = half_max(v); auto rr = __builtin_amdgcn_permlane32_swap(__builtin_bit_cast(unsigned, v), __builtin_bit_cast(unsigned, v), false, false);
    return fmaxf(__builtin_bit_cast(float, (unsigned)rr[0]), __builtin_bit_cast(float, (unsigned)rr[1])); }
__device__ __forceinline__ float lane_up(float v, int o, int lane) { return __builtin_bit_cast(float, __builtin_amdgcn_ds_bpermute(((lane - o) & 63) << 2, __builtin_bit_cast(int, v))); }
__device__ __forceinline__ float lane_bcast(float v, int src) { return __builtin_bit_cast(float, __builtin_amdgcn_readlane(__builtin_bit_cast(int, v), src)); }
#define LDS_WAIT() asm volatile("s_waitcnt lgkmcnt(0)" ::: "memory")
#define VM_WAIT() asm volatile("s_waitcnt vmcnt(0)" ::: "memory")

#define XB_TMO      128
#define XB_XCNT(j)  (256  + 64 * (j))
#define XB_XSUB(j)  (1280 + 64 * (j))
#define XB_XGEN(j)  (2304 + 64 * (j))
#define XB_TOP      3328
#define XB_TOPGEN   3392
#define XCD_BAR_WORDS 3456
#define XB_SPIN_CAP (1u << 22)

__device__ __forceinline__ unsigned xb_ld(unsigned* p)              { return __hip_atomic_load(p, __ATOMIC_RELAXED, __HIP_MEMORY_SCOPE_AGENT); }
__device__ __forceinline__ unsigned xb_add(unsigned* p, unsigned v) { return __hip_atomic_fetch_add(p, v, __ATOMIC_RELAXED, __HIP_MEMORY_SCOPE_AGENT); }
__device__ __forceinline__ unsigned xb_xcc_id() { return (unsigned)__builtin_amdgcn_s_getreg((3 << 11) | 20) & 0xFu; }
#define XB_SPIN(cond, bar) do { unsigned _sp = 0; while (cond) { __builtin_amdgcn_s_sleep(1); \
    if ((++_sp & 255u) == 0u) { if (xb_ld(&(bar)[XB_TMO])) break; if (_sp > XB_SPIN_CAP) { atomicAdd(&(bar)[XB_TMO], 1u); break; } } } } while (0)

struct XcdBarrier { unsigned* bar; unsigned x; volatile LAS unsigned* st; };

__device__ __forceinline__ XcdBarrier xcd_barrier_post(unsigned* bar, volatile LAS unsigned* st) {
    XcdBarrier b; b.bar = bar; b.x = xb_xcc_id(); b.st = st;
    if (threadIdx.x == 0) (void)xb_add(&bar[XB_XCNT(b.x)], 1u);
    return b;
}
__device__ __forceinline__ void xcd_barrier_complete(unsigned* bar, unsigned x, unsigned& nloc, unsigned& nx) {
    const unsigned G = gridDim.x * gridDim.y * gridDim.z;
    unsigned sum, cnt, mine, sp = 0u;
    for (;;) {
        sum = 0u; cnt = 0u; mine = 0u;
#pragma unroll
        for (unsigned j = 0; j < 16; ++j) { const unsigned c = xb_ld(&bar[XB_XCNT(j)]); sum += c; cnt += (c > 0u) ? 1u : 0u; mine = (j == x) ? c : mine; }
        if (sum == G) break;
        __builtin_amdgcn_s_sleep(1);
        if ((++sp & 255u) == 0u) { if (xb_ld(&bar[XB_TMO])) break; if (sp > XB_SPIN_CAP) { atomicAdd(&bar[XB_TMO], 1u); break; } }
    }
    nloc = mine > 0u ? mine : 1u; nx = cnt > 0u ? cnt : 1u;
}
__device__ __forceinline__ void xcd_barrier(const XcdBarrier& b) {
    asm volatile("s_waitcnt vmcnt(0)" ::: "memory");
    __syncthreads();
    if (threadIdx.x == 0) {
        unsigned* bar = b.bar;
        __builtin_amdgcn_s_waitcnt(0);
        unsigned nloc = b.st[0], nx = b.st[1];
        if (nloc == 0u) { xcd_barrier_complete(bar, b.x, nloc, nx); b.st[0] = nloc; b.st[1] = nx; }
        const unsigned old = xb_add(&bar[XB_XSUB(b.x)], 1u);
        const unsigned gen = old / nloc;
        if (old + 1u == (gen + 1u) * nloc) {
            __builtin_amdgcn_fence(__ATOMIC_RELEASE, "agent");
            asm volatile("s_waitcnt vmcnt(0)" ::: "memory");
            const unsigned og = xb_add(&bar[XB_TOP], 1u);
            const unsigned tg = og / nx;
            if (og + 1u == (tg + 1u) * nx) xb_add(&bar[XB_TOPGEN], 1u);
            else XB_SPIN(xb_ld(&bar[XB_TOPGEN]) == tg, bar);
            __builtin_amdgcn_fence(__ATOMIC_ACQUIRE, "agent");
            xb_add(&bar[XB_XGEN(b.x)], 1u);
            asm volatile("s_waitcnt vmcnt(0)" ::: "memory");
        } else {
            XB_SPIN(xb_ld(&bar[XB_XGEN(b.x)]) == gen, bar);
            __builtin_amdgcn_fence(__ATOMIC_ACQUIRE, "agent");
            asm volatile("s_waitcnt vmcnt(0)" ::: "memory");
        }
    }
    __syncthreads();
}

struct Params { const float* in[33]; float* out; unsigned char* ws; int ph_lo, ph_hi; };

struct Frame {
    LAS unsigned char* lds;
    unsigned char* ws;
    const float* const* in;
    float* out;
    int tid, lane, wave, bx, G;
};
enum { I_X = 0, I_C, I_CTX, I_CCTX, I_WMOD, I_BMOD, I_GMIX, I_GFFN, I_WIN, I_MLGB, I_MLHG, I_GCQ, I_GCKV, I_WUQ, I_WUKV, I_GQN, I_GKN, I_POOLW, I_POOLS,
       I_CONVW, I_CONVB, I_WGATE, I_BGATE, I_WBR, I_WOUT, I_WRT, I_BRT, I_W1, I_W3, I_W2, I_WS1, I_WS3, I_WS2 };

__device__ __forceinline__ const float* modp(const Frame& F, int l, int r, int which) { return (const float*)(F.ws + WS_MOD) + ((size_t)(l * 9 + r)) * 6144 + which * 1024; }
__device__ __forceinline__ int mod_row_of(int row) { return row < NLAT ? (row >> 13) : 8; }

namespace gg {
constexpr int BM = 256, BK = 64, HALF = 128, HTB = HALF * BK * 2, STAGE_BYTES = 8 * HTB;
__device__ __forceinline__ int lds_byte(int r, int c) { const int st = (r >> 4) * 2 + (c >> 5), rr = r & 15, cc = c & 31, ob = rr * 64 + cc * 2; return st * 1024 + (ob ^ (((ob >> 9) & 1) << 5)); }
__device__ __forceinline__ void stage_rc(int b, int& R, int& C) { const int st = b / 1024, sb = b % 1024, swz = sb ^ (((sb >> 9) & 1) << 5); R = (st >> 1) * 16 + swz / 64; C = (st & 1) * 32 + (swz % 64) / 2; }
__device__ __forceinline__ int perm32(int rho) { const int n = rho >> 4, i = rho & 15; return 8 * (i >> 2) + 4 * n + (i & 3); }

struct Unit {
    const char* A; const char* B;
    unsigned lda, ldb;
    int nt;
    const int* ridx;
    int p0, p1, p2;
};

template <class Epi, class Sched>
__device__ __forceinline__ void gemm_phase(LAS unsigned char* lds, const Sched& S, const Epi& E) {
    int tid_ = threadIdx.x; asm volatile("" : "+v"(tid_));
    const int tid = tid_, wid = __builtin_amdgcn_readfirstlane(tid >> 6), lane = tid & 63, wr = wid >> 2, wc = wid & 3, fr = lane & 15, fq = lane >> 4;
    const size_t kstep = (size_t)(BK * 2);
    const unsigned ldsw = (unsigned)wid * 1024u;
    const int aoff = lds_byte(wr * 64 + fr, fq * 8), boff = lds_byte(wc * 32 + fr, fq * 8);
#define GG_SA(b, h) (((b) * 2 + (h)) * HTB)
#define GG_SB(b, h) ((4 + (b) * 2 + (h)) * HTB)
#define GG_STAGE(bufoff, gbase, v0, v1) do { \
        __builtin_amdgcn_global_load_lds((const unsigned*)((const char*)(gbase) + (v0)), (LAS unsigned*)(lds + (bufoff) + ldsw), 16, 0, 0); \
        __builtin_amdgcn_global_load_lds((const unsigned*)((const char*)(gbase) + (v1)), (LAS unsigned*)(lds + (bufoff) + ldsw + 8192), 16, 0, 0); } while (0)
#define GG_LDA(dst, b, h) do { _Pragma("unroll") for (int m = 0; m < 4; ++m) _Pragma("unroll") for (int k = 0; k < 2; ++k) dst[m][k] = *(const LAS bf16x8*)(lds + GG_SA(b, h) + aoff + m * 2048 + k * 1024); } while (0)
#define GG_LDB(dst, b, h) do { _Pragma("unroll") for (int n = 0; n < 2; ++n) _Pragma("unroll") for (int k = 0; k < 2; ++k) dst[n][k] = *(const LAS bf16x8*)(lds + GG_SB(b, h) + boff + n * 2048 + k * 1024); } while (0)
#define GG_MMA(ai, bj, At, Bt) do { __builtin_amdgcn_s_setprio(1); _Pragma("unroll") for (int m = 0; m < 4; ++m) _Pragma("unroll") for (int n = 0; n < 2; ++n) _Pragma("unroll") for (int k = 0; k < 2; ++k) \
        acc[ai][bj][m][n] = __builtin_amdgcn_mfma_f32_16x16x32_bf16(Bt[n][k], At[m][k], acc[ai][bj][m][n], 0, 0, 0); __builtin_amdgcn_s_setprio(0); } while (0)
#define GG_WAIT_V(n) asm volatile("s_waitcnt vmcnt(" #n ")" ::: "memory")
#define GG_WAIT_L(n) asm volatile("s_waitcnt lgkmcnt(" #n ")" ::: "memory")
#define GG_BAR __builtin_amdgcn_s_barrier()
#define GG_SCHED __builtin_amdgcn_sched_barrier(0)
#define GG_OFFS(u) do { int R0_, C0_, R1_, C1_; stage_rc(tid * 16, R0_, C0_); stage_rc(tid * 16 + 8192, R1_, C1_); \
        if (Sched::GATHER) { vA0 = (unsigned)(u).ridx[R0_] * (u).lda + C0_ * 2; vA1 = (unsigned)(u).ridx[R1_] * (u).lda + C1_ * 2; \
                             vA2 = (unsigned)(u).ridx[128 + R0_] * (u).lda + C0_ * 2; vA3 = (unsigned)(u).ridx[128 + R1_] * (u).lda + C1_ * 2; hA = 0; } \
        else { vA0 = (unsigned)R0_ * (u).lda + C0_ * 2; vA1 = (unsigned)R1_ * (u).lda + C1_ * 2; vA2 = vA0; vA3 = vA1; hA = (size_t)128 * (u).lda; } \
        const int Rb0_ = Epi::PERM ? ((R0_ & ~31) + perm32(R0_ & 31)) : R0_, Rb1_ = Epi::PERM ? ((R1_ & ~31) + perm32(R1_ & 31)) : R1_; \
        vB0 = (unsigned)Rb0_ * (u).ldb + C0_ * 2; vB1 = (unsigned)Rb1_ * (u).ldb + C1_ * 2; hB = (size_t)128 * (u).ldb; } while (0)
    Unit cur, nxt; int ui = 0;
    if (!S.next(0, cur)) return;
    f32x4 acc[2][2][4][2];
#pragma unroll
    for (int a = 0; a < 2; ++a)
#pragma unroll
        for (int b = 0; b < 2; ++b)
#pragma unroll
            for (int m = 0; m < 4; ++m)
#pragma unroll
                for (int n = 0; n < 2; ++n) acc[a][b][m][n] = (f32x4){0.f, 0.f, 0.f, 0.f};
    bf16x8 At[4][2], B0[2][2], B1[2][2];
    unsigned vA0, vA1, vA2, vA3, vB0, vB1; size_t hA, hB;
    GG_OFFS(cur);
    const char* cA = cur.A; const char* cB = cur.B;
    GG_STAGE(GG_SB(0, 0), cB, vB0, vB1); GG_STAGE(GG_SB(0, 1), cB + hB, vB0, vB1); GG_STAGE(GG_SA(0, 0), cA, vA0, vA1); GG_STAGE(GG_SA(0, 1), cA + hA, vA2, vA3);
    if (wr == 1) GG_BAR;
    GG_WAIT_V(2); GG_BAR;
    GG_STAGE(GG_SB(1, 0), cB + kstep, vB0, vB1); GG_STAGE(GG_SA(1, 0), cA + kstep, vA0, vA1); GG_STAGE(GG_SB(1, 1), cB + hB + kstep, vB0, vB1);
    GG_WAIT_V(6); GG_BAR;
    for (;;) {
        const bool has_next = S.next(ui + 1, nxt);
        const int nt = cur.nt;
#pragma unroll 1
        for (int t = 0; t < nt; t += 2) {
            const bool last = (t == nt - 2);
            const char* a1 = cA + (size_t)(t + 1) * kstep;
            GG_LDB(B0, 0, 0); GG_LDB(B1, 0, 1); GG_SCHED; GG_LDA(At, 0, 0); GG_STAGE(GG_SA(1, 1), a1 + hA, vA2, vA3);
            GG_WAIT_V(8); GG_WAIT_L(0); GG_BAR; GG_MMA(0, 0, At, B0); GG_MMA(0, 1, At, B1); GG_BAR; GG_SCHED;
            if (last) { if (has_next) { GG_OFFS(nxt); cA = nxt.A - (size_t)nt * kstep; cB = nxt.B - (size_t)nt * kstep; } else { cA -= (size_t)nt * kstep; cB -= (size_t)nt * kstep; } }
            const char* a2 = cA + (size_t)(t + 2) * kstep; const char* b2 = cB + (size_t)(t + 2) * kstep; const char* a3 = a2 + kstep; const char* b3 = b2 + kstep;
            GG_LDA(At, 0, 1); GG_STAGE(GG_SB(0, 0), b2, vB0, vB1); GG_STAGE(GG_SB(0, 1), b2 + hB, vB0, vB1); GG_STAGE(GG_SA(0, 0), a2, vA0, vA1);
            GG_WAIT_V(8); GG_WAIT_L(0); GG_BAR; GG_MMA(1, 0, At, B0); GG_MMA(1, 1, At, B1); GG_BAR; GG_SCHED;
            GG_LDB(B0, 1, 0); GG_LDB(B1, 1, 1); GG_SCHED; GG_LDA(At, 1, 0); GG_STAGE(GG_SA(0, 1), a2 + hA, vA2, vA3);
            GG_WAIT_V(8); GG_WAIT_L(0); GG_BAR; GG_MMA(0, 0, At, B0); GG_MMA(0, 1, At, B1); GG_BAR; GG_SCHED;
            GG_LDA(At, 1, 1); GG_STAGE(GG_SB(1, 0), b3, vB0, vB1); GG_STAGE(GG_SB(1, 1), b3 + hB, vB0, vB1); GG_STAGE(GG_SA(1, 0), a3, vA0, vA1);
            GG_WAIT_V(8); GG_WAIT_L(0); GG_BAR; GG_MMA(1, 0, At, B0); GG_MMA(1, 1, At, B1); GG_BAR; GG_SCHED;
        }
        cA += (size_t)nt * kstep; cB += (size_t)nt * kstep;
        if (wr == 0) GG_BAR;
        E(acc, cur, wr, wc, fr, fq);
        if (!has_next) break;
#pragma unroll
        for (int a = 0; a < 2; ++a)
#pragma unroll
            for (int b = 0; b < 2; ++b)
#pragma unroll
                for (int m = 0; m < 4; ++m)
#pragma unroll
                    for (int n = 0; n < 2; ++n) acc[a][b][m][n] = (f32x4){0.f, 0.f, 0.f, 0.f};
        cur = nxt; ++ui;
        if (wr == 1) GG_BAR;
    }
    GG_WAIT_V(0);
    GG_BAR;
#undef GG_SA
#undef GG_SB
#undef GG_STAGE
#undef GG_LDA
#undef GG_LDB
#undef GG_MMA
#undef GG_WAIT_V
#undef GG_WAIT_L
#undef GG_BAR
#undef GG_SCHED
#undef GG_OFFS
}
}

__device__ __forceinline__ int ld_i32_uniform(const int* p) { return __builtin_amdgcn_readfirstlane(__hip_atomic_load(p, __ATOMIC_RELAXED, __HIP_MEMORY_SCOPE_AGENT)); }
__device__ __forceinline__ void tile_order(int L, int nM, int nN, int& pm, int& pn) {
    const int nwg = nM * nN; int wgid = L;
    { const int q = nwg / 8, r = nwg % 8, xcd = wgid % 8, off = wgid / 8; wgid = (xcd < r ? xcd * (q + 1) : r * (q + 1) + (xcd - r) * q) + off; }
    const int nig = 8 * nN, gid = wgid / nig, fm = gid * 8, gsz = (nM - fm) < 8 ? (nM - fm) : 8;
    pm = fm + ((wgid % nig) % gsz); pn = (wgid % nig) / gsz;
}
struct SchedPlain {
    static constexpr bool GATHER = false;
    const char* A; const char* B; unsigned lda, ldb; int nt, nM, nN, G, c;
    __device__ __forceinline__ bool next(int i, gg::Unit& u) const {
        const int L = i * G + c; if (L >= nM * nN) return false;
        int pm, pn; tile_order(L, nM, nN, pm, pn);
        u.A = A + (size_t)pm * 256 * lda; u.B = B + (size_t)pn * 256 * ldb; u.lda = lda; u.ldb = ldb; u.nt = nt; u.ridx = nullptr; u.p0 = pm; u.p1 = pn; u.p2 = 0; return true;
    }
};
struct EpiWin {
    static constexpr bool PERM = true;
    bf16_t* px; float* gate;
    __device__ __forceinline__ void operator()(const f32x4 (&acc)[2][2][4][2], const gg::Unit& u, int wr, int wc, int fr, int fq) const {
        const int row0 = u.p0 * 256 + wr * 64 + fr;
#pragma unroll
        for (int bj = 0; bj < 2; ++bj) {
            const int c0 = u.p1 * 256 + bj * 128 + wc * 32 + 8 * fq;
            if (c0 < INC) {
                const bool isg = (c0 >= C_G && c0 < C_MLA);
#pragma unroll
                for (int ai = 0; ai < 2; ++ai)
#pragma unroll
                    for (int m = 0; m < 4; ++m) { const int row = row0 + ai * 128 + m * 16; const f32x4 v0 = acc[ai][bj][m][0], v1 = acc[ai][bj][m][1];
                        u32x4 w; w.x = cvt_pk_bf16(v0[0], v0[1]); w.y = cvt_pk_bf16(v0[2], v0[3]); w.z = cvt_pk_bf16(v1[0], v1[1]); w.w = cvt_pk_bf16(v1[2], v1[3]);
                        *(u32x4*)(px + (size_t)row * INC + c0) = w;
                        if (isg) { float* gp = gate + (size_t)row * 16 + (c0 - C_G); *(f32x4*)gp = v0; *(f32x4*)(gp + 4) = v1; } }
            }
        }
    }
};
struct SchedMerge {
    static constexpr bool GATHER = false;
    const char* hx; const char* yc; const char* wg; const char* wb; int nM, G, c;
    __device__ __forceinline__ bool next(int i, gg::Unit& u) const {
        const int k = i >> 3, s = i & 7, br = s >> 1; const int L = k * G + c; if (L >= nM * 4) return false;
        int pm, pn; tile_order(L, nM, 4, pm, pn);
        if (s & 1) { u.A = hx + (size_t)pm * 256 * 2048; u.lda = 2048; u.B = wg + (size_t)br * (1024 * 2048) + (size_t)pn * 256 * 2048; u.ldb = 2048; u.nt = 16; }
        else       { u.A = yc + (size_t)pm * 256 * 2048 + br * 512; u.lda = 2048; u.B = wb + (size_t)br * (1024 * 512) + (size_t)pn * 256 * 512; u.ldb = 512; u.nt = 4; }
        u.ridx = nullptr; u.p0 = pm; u.p1 = pn; u.p2 = s; return true;
    }
};
struct EpiMerge {
    static constexpr bool PERM = true;
    unsigned char* scr; const float* bgate; bf16_t* accm;
    __device__ __forceinline__ void operator()(const f32x4 (&acc)[2][2][4][2], const gg::Unit& u, int wr, int wc, int fr, int fq) const {
        const int s = u.p2, br = s >> 1; int tid = threadIdx.x; asm volatile("" : "+v"(tid));
        u32x4* SY = (u32x4*)scr; u32x4* ST = (u32x4*)(scr + 131072);
        if (!(s & 1)) {
#pragma unroll
            for (int ai = 0; ai < 2; ++ai)
#pragma unroll
                for (int m = 0; m < 4; ++m)
#pragma unroll
                    for (int bj = 0; bj < 2; ++bj) { const f32x4 v0 = acc[ai][bj][m][0], v1 = acc[ai][bj][m][1];
                        u32x4 w; w.x = cvt_pk_bf16(v0[0], v0[1]); w.y = cvt_pk_bf16(v0[2], v0[3]); w.z = cvt_pk_bf16(v1[0], v1[1]); w.w = cvt_pk_bf16(v1[2], v1[3]);
                        SY[((ai * 4 + m) * 2 + bj) * 512 + tid] = w; }
        } else {
            const int row0 = u.p0 * 256 + wr * 64 + fr;
#pragma unroll
            for (int bj = 0; bj < 2; ++bj) {
                const int col = u.p1 * 256 + bj * 128 + wc * 32 + 8 * fq;
                const f32x4 b0 = *(const f32x4*)(bgate + br * 1024 + col), b1 = *(const f32x4*)(bgate + br * 1024 + col + 4);
#pragma unroll
                for (int ai = 0; ai < 2; ++ai)
#pragma unroll
                    for (int m = 0; m < 4; ++m) { const int q = ((ai * 4 + m) * 2 + bj) * 512 + tid;
                        const u32x4 y = SY[q]; const f32x4 g0 = acc[ai][bj][m][0] + b0, g1 = acc[ai][bj][m][1] + b1;
                        float t[8];
                        t[0] = sigmoidf_(g0[0]) * bflo(y.x); t[1] = sigmoidf_(g0[1]) * bfhi(y.x); t[2] = sigmoidf_(g0[2]) * bflo(y.y); t[3] = sigmoidf_(g0[3]) * bfhi(y.y);
                        t[4] = sigmoidf_(g1[0]) * bflo(y.z); t[5] = sigmoidf_(g1[1]) * bfhi(y.z); t[6] = sigmoidf_(g1[2]) * bflo(y.w); t[7] = sigmoidf_(g1[3]) * bfhi(y.w);
                        if (br > 0) { const u32x4 p = ST[q]; t[0] += bflo(p.x); t[1] += bfhi(p.x); t[2] += bflo(p.y); t[3] += bfhi(p.y); t[4] += bflo(p.z); t[5] += bfhi(p.z); t[6] += bflo(p.w); t[7] += bfhi(p.w); }
                        u32x4 w; w.x = cvt_pk_bf16(t[0], t[1]); w.y = cvt_pk_bf16(t[2], t[3]); w.z = cvt_pk_bf16(t[4], t[5]); w.w = cvt_pk_bf16(t[6], t[7]);
                        if (br < 3) ST[q] = w; else *(u32x4*)(accm + (size_t)(row0 + ai * 128 + m * 16) * 1024 + col) = w; }
            }
        }
    }
};
struct EpiWout {
    static constexpr bool PERM = false;
    const float* src_lat; float* dst_lat; const float* src_ctx; float* dst_ctx; const float* gt;
    __device__ __forceinline__ void operator()(const f32x4 (&acc)[2][2][4][2], const gg::Unit& u, int wr, int wc, int fr, int fq) const {
        const int pm = u.p0; const bool isctx = pm >= 256; const int mrow = isctx ? 8 : (pm >> 5);
        const float* src = isctx ? src_ctx + (size_t)(pm - 256) * 256 * 1024 : src_lat + (size_t)pm * 256 * 1024;
        float* dst = isctx ? dst_ctx + (size_t)(pm - 256) * 256 * 1024 : dst_lat + (size_t)pm * 256 * 1024;
        const float* g = gt + (size_t)mrow * 6144;
        const int r0 = wr * 64 + fr, c0 = u.p1 * 256 + wc * 32 + 4 * fq;
        f32x4 gv[2][2];
#pragma unroll
        for (int bj = 0; bj < 2; ++bj)
#pragma unroll
            for (int n = 0; n < 2; ++n) gv[bj][n] = *(const f32x4*)(g + c0 + bj * 128 + n * 16);
#pragma unroll
        for (int ai = 0; ai < 2; ++ai)
#pragma unroll
            for (int m = 0; m < 4; ++m) { const size_t off = (size_t)(r0 + ai * 128 + m * 16) * 1024 + c0;
#pragma unroll
                for (int bj = 0; bj < 2; ++bj)
#pragma unroll
                    for (int n = 0; n < 2; ++n) { const f32x4 xv = *(const f32x4*)(src + off + bj * 128 + n * 16); *(f32x4*)(dst + off + bj * 128 + n * 16) = xv + gv[bj][n] * acc[ai][bj][m][n]; }
                asm volatile("" ::: "memory"); }
    }
};
struct SchedMoe1 {
    static constexpr bool GATHER = true;
    const char* hx2; const char* w13; const int* rtok; const int* tile_e; int ntiles, G, c;
    __device__ __forceinline__ bool next(int i, gg::Unit& u) const {
        const int L = i * G + c; if (L >= ntiles * 2) return false;
        const int tile = L >> 1, pn = L & 1, e = ld_i32_uniform(tile_e + tile);
        u.A = hx2; u.lda = 2048; u.ridx = rtok + tile * 256; u.B = w13 + (size_t)e * (512 * 2048) + (size_t)pn * 256 * 2048; u.ldb = 2048; u.nt = 16; u.p0 = tile; u.p1 = pn; u.p2 = e; return true;
    }
};
struct EpiMoe1 {
    static constexpr bool PERM = true;
    bf16_t* a; const float* roww;
    __device__ __forceinline__ void operator()(const f32x4 (&acc)[2][2][4][2], const gg::Unit& u, int wr, int wc, int fr, int fq) const {
        const int row0 = u.p0 * 256 + wr * 64 + fr, col = u.p1 * 128 + wc * 32 + 8 * fq;
#pragma unroll
        for (int ai = 0; ai < 2; ++ai)
#pragma unroll
            for (int m = 0; m < 4; ++m) { const int row = row0 + ai * 128 + m * 16; const float rw = roww[row];
                float t[8];
#pragma unroll
                for (int n = 0; n < 2; ++n)
#pragma unroll
                    for (int j = 0; j < 4; ++j) { const float g1 = acc[ai][0][m][n][j], g3 = acc[ai][1][m][n][j]; t[n * 4 + j] = g1 * sigmoidf_(g1) * g3 * rw; }
                u32x4 w; w.x = cvt_pk_bf16(t[0], t[1]); w.y = cvt_pk_bf16(t[2], t[3]); w.z = cvt_pk_bf16(t[4], t[5]); w.w = cvt_pk_bf16(t[6], t[7]);
                *(u32x4*)(a + (size_t)row * 256 + col) = w; }
    }
};
struct SchedMoe2 {
    static constexpr bool GATHER = false;
    const char* a; const char* w2; const int* tile_e; int ntiles, G, c;
    __device__ __forceinline__ bool next(int i, gg::Unit& u) const {
        const int L = i * G + c; if (L >= ntiles * 4) return false;
        const int tile = L >> 2, pn = L & 3, e = ld_i32_uniform(tile_e + tile);
        u.A = a + (size_t)tile * 256 * 512; u.lda = 512; u.ridx = nullptr; u.B = w2 + (size_t)e * (1024 * 512) + (size_t)pn * 256 * 512; u.ldb = 512; u.nt = 4; u.p0 = tile; u.p1 = pn; u.p2 = e; return true;
    }
};
struct EpiBf16Plain {
    static constexpr bool PERM = true;
    bf16_t* O; int ldc;
    __device__ __forceinline__ void operator()(const f32x4 (&acc)[2][2][4][2], const gg::Unit& u, int wr, int wc, int fr, int fq) const {
        const int row0 = u.p0 * 256 + wr * 64 + fr, col0 = u.p1 * 256 + wc * 32 + 8 * fq;
#pragma unroll
        for (int ai = 0; ai < 2; ++ai)
#pragma unroll
            for (int m = 0; m < 4; ++m)
#pragma unroll
                for (int bj = 0; bj < 2; ++bj) { const f32x4 v0 = acc[ai][bj][m][0], v1 = acc[ai][bj][m][1];
                    u32x4 w; w.x = cvt_pk_bf16(v0[0], v0[1]); w.y = cvt_pk_bf16(v0[2], v0[3]); w.z = cvt_pk_bf16(v1[0], v1[1]); w.w = cvt_pk_bf16(v1[2], v1[3]);
                    *(u32x4*)(O + (size_t)(row0 + ai * 128 + m * 16) * ldc + col0 + bj * 128) = w; }
    }
};

__device__ __forceinline__ int crow(int r, int hi) { return (r & 3) + 8 * (r >> 2) + 4 * hi; }
__device__ __forceinline__ f32x16 mma32_ll(f32x16 acc, const LAS bf16_t* A, int lda, const LAS bf16_t* B, int ldb, int ksteps, int lane) {
    const int r32 = lane & 31, hi = lane >> 5;
    for (int ks = 0; ks < ksteps; ++ks) {
        const bf16x8 a = *(const LAS bf16x8*)(A + r32 * lda + ks * 16 + hi * 8);
        const bf16x8 b = *(const LAS bf16x8*)(B + r32 * ldb + ks * 16 + hi * 8);
        acc = __builtin_amdgcn_mfma_f32_32x32x16_bf16(a, b, acc, 0, 0, 0);
    }
    return acc;
}
__device__ __forceinline__ f32x16 mma32_lg(f32x16 acc, const LAS bf16_t* A, int lda, const bf16_t* B, int ldb, int ksteps, int lane) {
    const int r32 = lane & 31, hi = lane >> 5;
    for (int ks = 0; ks < ksteps; ++ks) {
        const bf16x8 a = *(const LAS bf16x8*)(A + r32 * lda + ks * 16 + hi * 8);
        const bf16x8 b = *(const bf16x8*)(B + (size_t)r32 * ldb + ks * 16 + hi * 8);
        acc = __builtin_amdgcn_mfma_f32_32x32x16_bf16(a, b, acc, 0, 0, 0);
    }
    return acc;
}

__device__ __forceinline__ void ph_pre(const Frame& F) {
    LAS float* sv = (LAS float*)F.lds;
    LAS float* part = sv + 9 * 1024;
    float* mod = (float*)(F.ws + WS_MOD);
    for (int i = F.tid; i < 9 * 1024; i += NTHR) { const int r = i >> 10, k = i & 1023; const float c = (r < 8) ? F.in[I_C][r * 1024 + k] : F.in[I_CCTX][k]; sv[i] = c * sigmoidf_(c); }
    __syncthreads();
    for (int it = F.bx; it < 2 * 96; it += F.G) {
        const int l = it / 96, jc = it % 96, j = jc * 64 + F.lane, k0 = F.wave * 128;
        const float* w = F.in[I_WMOD] + ((size_t)l * 1024 + k0) * 6144 + j;
        float a[9];
#pragma unroll
        for (int r = 0; r < 9; ++r) a[r] = 0.f;
#pragma unroll 4
        for (int k = 0; k < 128; ++k) { const float wv = w[(size_t)k * 6144];
#pragma unroll
            for (int r = 0; r < 9; ++r) a[r] += sv[r * 1024 + k0 + k] * wv; }
#pragma unroll
        for (int r = 0; r < 9; ++r) part[(F.wave * 9 + r) * 64 + F.lane] = a[r];
        __syncthreads();
        for (int i = F.tid; i < 9 * 64; i += NTHR) { const int r = i >> 6, jj = i & 63; float s = F.in[I_BMOD][l * 6144 + jc * 64 + jj];
#pragma unroll
            for (int w8 = 0; w8 < 8; ++w8) s += part[(w8 * 9 + r) * 64 + jj];
            mod[((size_t)(l * 9 + r)) * 6144 + jc * 64 + jj] = s; }
        __syncthreads();
    }
    if (F.bx == F.G - 1) {
        float* rt = (float*)(F.ws + T_ROPE);
        for (int i = F.tid; i < 1024; i += NTHR) { const int pos = i >> 3, f = i & 7; const float inv = powf(10000.0f, -(float)f / 8.0f); const float ang = (float)pos * inv; rt[2 * i] = cosf(ang); rt[2 * i + 1] = sinf(ang); }
    }
}

struct ConvCursor { int base; int gw, ngw; };
__device__ __forceinline__ void conv_mat(const Frame& F, ConvCursor& cc, const float* src, int K, int N, bf16_t* dst, int ldd, int rbase, int rstep, int nbatch, size_t sbs, size_t dbs) {
    const int ktl = K / 64, ntl = (N + 63) / 64, per = ktl * ntl, total = per * nbatch;
    LAS float* scr = (LAS float*)(F.lds + F.wave * 16640);
    int t = cc.base + ((cc.gw - cc.base) % cc.ngw + cc.ngw) % cc.ngw;
    for (; t < cc.base + total; t += cc.ngw) {
        const int li = t - cc.base, bt = li / per, rem = li % per, kb = rem / ntl, nb = rem % ntl, k0 = kb * 64, n0 = nb * 64;
        const float* s = src + bt * sbs; bf16_t* d = dst + bt * dbs;
        const int n = n0 + F.lane;
#pragma unroll 8
        for (int i = 0; i < 64; ++i) scr[i * 65 + F.lane] = (n < N) ? s[(size_t)(k0 + i) * N + n] : 0.f;
        LDS_WAIT(); asm volatile("" ::: "memory");
#pragma unroll
        for (int it = 0; it < 8; ++it) { const int q = it * 64 + F.lane, nl = q >> 3, c = q & 7, nn = n0 + nl;
            if (nn < N) { const LAS float* p = scr + (8 * c) * 65 + nl;
                u32x4 o; o.x = pk2(p[0], p[65]); o.y = pk2(p[130], p[195]); o.z = pk2(p[260], p[325]); o.w = pk2(p[390], p[455]);
                *(u32x4*)(d + (size_t)(rbase + (nn >> 7) * rstep + (nn & 127)) * ldd + k0 + 8 * c) = o; } }
        LDS_WAIT(); asm volatile("" ::: "memory");
    }
    cc.base += total;
}
__device__ __forceinline__ void ph_convert(const Frame& F, int l) {
    ConvCursor cc; cc.base = 0; cc.gw = F.bx * NWAVES + F.wave; cc.ngw = F.G * NWAVES;
    unsigned char* ws = F.ws;
    conv_mat(F, cc, F.in[I_WIN] + (size_t)l * 1024 * INC, 1024, INC, (bf16_t*)(ws + W_IN), 1024, 0, 128, 1, 0, 0);
    conv_mat(F, cc, F.in[I_WGATE] + (size_t)l * 4 * 1024 * 1024, 1024, 1024, (bf16_t*)(ws + W_GATE), 1024, 0, 128, 4, (size_t)1024 * 1024, (size_t)1024 * 1024);
    conv_mat(F, cc, F.in[I_WBR] + (size_t)l * 4 * 256 * 1024, 256, 1024, (bf16_t*)(ws + W_BR), 256, 0, 128, 4, (size_t)256 * 1024, (size_t)1024 * 256);
    conv_mat(F, cc, F.in[I_WOUT] + (size_t)l * 1024 * 1024, 1024, 1024, (bf16_t*)(ws + W_OUT), 1024, 0, 128, 1, 0, 0);
    conv_mat(F, cc, F.in[I_W1] + (size_t)l * 64 * 1024 * 256, 1024, 256, (bf16_t*)(ws + W_13), 1024, 0, 256, 64, (size_t)1024 * 256, (size_t)512 * 1024);
    conv_mat(F, cc, F.in[I_W3] + (size_t)l * 64 * 1024 * 256, 1024, 256, (bf16_t*)(ws + W_13), 1024, 128, 256, 64, (size_t)1024 * 256, (size_t)512 * 1024);
    conv_mat(F, cc, F.in[I_W2] + (size_t)l * 64 * 256 * 1024, 256, 1024, (bf16_t*)(ws + W_2), 256, 0, 128, 64, (size_t)256 * 1024, (size_t)1024 * 256);
    conv_mat(F, cc, F.in[I_WS1] + (size_t)l * 1024 * 256, 1024, 256, (bf16_t*)(ws + W_13) + (size_t)64 * 512 * 1024, 1024, 0, 256, 1, 0, 0);
    conv_mat(F, cc, F.in[I_WS3] + (size_t)l * 1024 * 256, 1024, 256, (bf16_t*)(ws + W_13) + (size_t)64 * 512 * 1024, 1024, 128, 256, 1, 0, 0);
    conv_mat(F, cc, F.in[I_WS2] + (size_t)l * 256 * 1024, 256, 1024, (bf16_t*)(ws + W_2) + (size_t)64 * 1024 * 256, 256, 0, 128, 1, 0, 0);
    conv_mat(F, cc, F.in[I_WUQ] + (size_t)l * 256 * 384, 256, 384, (bf16_t*)(ws + W_UQ), 256, 0, 128, 1, 0, 0);
    conv_mat(F, cc, F.in[I_WUKV] + (size_t)l * 128 * 512, 128, 512, (bf16_t*)(ws + W_UKV), 128, 0, 128, 1, 0, 0);
    conv_mat(F, cc, F.in[I_POOLW] + (size_t)l * 4 * 64 * 64, 64, 64, (bf16_t*)(ws + W_POOL), 64, 0, 128, 4, (size_t)64 * 64, (size_t)64 * 64);
    conv_mat(F, cc, F.in[I_WRT] + (size_t)l * 1024 * 64, 1024, 64, (bf16_t*)(ws + W_RT), 1024, 0, 128, 1, 0, 0);
    { u32x4* z = (u32x4*)((bf16_t*)(ws + W_IN) + (size_t)INC * 1024); const int n16 = (INCP - INC) * 1024 * 2 / 16;
      for (int i = F.bx * NTHR + F.tid; i < n16; i += F.G * NTHR) z[i] = (u32x4){0u, 0u, 0u, 0u}; }
}

__device__ __forceinline__ void normmod_row(int lane, const float* xrow, const float* g, const float* sc, const float* sh, f32x4 (&y)[4]) {
    const f32x4* xr = (const f32x4*)xrow + lane; f32x4 v[4]; float s = 0.f;
#pragma unroll
    for (int j = 0; j < 4; ++j) { v[j] = xr[64 * j]; s += (v[j].x * v[j].x + v[j].y * v[j].y) + (v[j].z * v[j].z + v[j].w * v[j].w); }
    const float rstd = 1.0f / sqrtf(wave_sum(s) * (1.f / 1024.f) + EPS);
#pragma unroll
    for (int j = 0; j < 4; ++j) { const f32x4 gv = ((const f32x4*)g)[lane + 64 * j], scv = ((const f32x4*)sc)[lane + 64 * j], shv = ((const f32x4*)sh)[lane + 64 * j];
        y[j] = v[j] * rstd * gv * (scv + 1.0f) + shv; }
}
__device__ __forceinline__ const float* stream_row(const Frame& F, int l, int row) {
    if (row < NLAT) return (l == 0 ? F.in[I_X] : F.out) + (size_t)row * 1024;
    return (l == 0 ? F.in[I_CTX] : (const float*)(F.ws + WS_CTXS)) + (size_t)(row - NLAT) * 1024;
}
__device__ __forceinline__ void ph_norm1(const Frame& F, int l) {
    const int gw = F.bx * NWAVES + F.wave, ngw = F.G * NWAVES;
    bf16_t* hx = (bf16_t*)(F.ws + WS_HX);
    for (int row = gw; row < NTOK; row += ngw) {
        const int mr = mod_row_of(row); f32x4 y[4];
        normmod_row(F.lane, stream_row(F, l, row), F.in[I_GMIX] + l * 1024, modp(F, l, mr, 1), modp(F, l, mr, 0), y);
        u32x2* o = (u32x2*)(hx + (size_t)row * 1024) + F.lane;
#pragma unroll
        for (int j = 0; j < 4; ++j) o[64 * j] = (u32x2){pk2(y[j].x, y[j].y), pk2(y[j].z, y[j].w)};
    }
}

constexpr float QSCALE = 0.10206207261596577f * 1.4426950408889634f;
__device__ __forceinline__ void mla_unit(const Frame& F, int l, int unit, bool want_q) {
    LAS unsigned char* lds = F.lds;
    LAS bf16_t* AQ = (LAS bf16_t*)lds;
    LAS bf16_t* AKV = (LAS bf16_t*)(lds + 16896);
    LAS float* KR = (LAS float*)(lds + 25600);
    LAS float* OUT = (LAS float*)(lds + 29696);
    LAS bf16_t* KB = (LAS bf16_t*)(lds + 96256);
    const int row0 = unit * 32, lane = F.lane, wave = F.wave, tid = F.tid;
    const bool isctx = row0 >= NLAT;
    const int b = isctx ? (row0 - NLAT) >> 8 : row0 >> 13, pos0 = isctx ? (row0 - NLAT) & 255 : row0 & 8191;
    const bf16_t* px = (const bf16_t*)(F.ws + WS_PX);
    const float* gcq = F.in[I_GCQ] + l * 256; const float* gckv = F.in[I_GCKV] + l * 128; const float* gqn = F.in[I_GQN] + l * 96; const float* gkn = F.in[I_GKN] + l * 96;
    const float* rope = (const float*)(F.ws + T_ROPE);
    __syncthreads();
    for (int rr = 0; rr < 4; ++rr) { const int r = wave * 4 + rr; const bf16_t* p = px + (size_t)(row0 + r) * INC + C_MLA;
        { const u32x2 w = *(const u32x2*)(p + 4 * lane); const float x0 = bflo(w.x), x1 = bfhi(w.x), x2 = bflo(w.y), x3 = bfhi(w.y);
          const float sc = 1.0f / sqrtf(wave_sum(x0 * x0 + x1 * x1 + x2 * x2 + x3 * x3) * (1.f / 256.f) + EPS); const f32x4 g = *(const f32x4*)(gcq + 4 * lane);
          *(LAS u32x2*)(AQ + r * 264 + 4 * lane) = (u32x2){pk2(x0 * sc * g.x, x1 * sc * g.y), pk2(x2 * sc * g.z, x3 * sc * g.w)}; }
        { const unsigned w = *(const unsigned*)(p + 256 + 2 * lane); const float x0 = bflo(w), x1 = bfhi(w);
          const float sc = 1.0f / sqrtf(wave_sum(x0 * x0 + x1 * x1) * (1.f / 128.f) + EPS); const f32x2 g = *(const f32x2*)(gckv + 2 * lane);
          *(LAS unsigned*)(AKV + r * 136 + 2 * lane) = pk2(x0 * sc * g.x, x1 * sc * g.y); }
        if (lane < 32) KR[r * 32 + lane] = bf2f(p[384 + lane]); }
    __syncthreads();
    const int r32 = lane & 31, hi = lane >> 5;
    if (want_q) {
        for (int nt = wave; nt < 12; nt += 8) { f32x16 acc = {}; acc = mma32_lg(acc, AQ, 264, (const bf16_t*)(F.ws + W_UQ) + (size_t)nt * 32 * 256, 256, 16, lane);
#pragma unroll
            for (int r = 0; r < 16; ++r) OUT[crow(r, hi) * 520 + nt * 32 + r32] = acc[r]; }
        __syncthreads();
        bf16_t* qb = (bf16_t*)(F.ws + WS_QB);
        for (int it = 0; it < 8; ++it) { const int pr = wave * 16 + it * 2 + hi, r = pr >> 2, h = pr & 3; const LAS float* o = OUT + r * 520 + h * 96;
            float v0 = o[r32], v1 = o[32 + r32], v2 = o[64 + r32]; const float ss = half_sum(v0 * v0 + v1 * v1 + v2 * v2);
            const float sc = 1.0f / sqrtf(ss * (1.f / 96.f) + EPS);
            v0 *= sc * gqn[r32]; v1 *= sc * gqn[32 + r32]; v2 *= sc * gqn[64 + r32];
            const float pv = xor_lane<8>(v2);
            if (!isctx) { const int pos = pos0 + r, pp = (r32 < 16) ? (pos >> 6) : (pos & 63); const float cs = rope[(pp * 8 + (r32 & 7)) * 2], sn = rope[(pp * 8 + (r32 & 7)) * 2 + 1];
                v2 = (r32 & 8) ? (v2 * cs + pv * sn) : (v2 * cs - pv * sn); }
            bf16_t* q = qb + (size_t)(row0 + r) * 384 + h * 96;
            q[r32] = (bf16_t)f2bf(v0 * QSCALE); q[32 + r32] = (bf16_t)f2bf(v1 * QSCALE); q[64 + r32] = (bf16_t)f2bf(v2 * QSCALE); }
        __syncthreads();
    }
    for (int nt = wave * 2; nt < wave * 2 + 2; ++nt) { f32x16 acc = {}; acc = mma32_lg(acc, AKV, 136, (const bf16_t*)(F.ws + W_UKV) + (size_t)nt * 32 * 128, 128, 8, lane);
#pragma unroll
        for (int r = 0; r < 16; ++r) OUT[crow(r, hi) * 520 + nt * 32 + r32] = acc[r]; }
    __syncthreads();
    for (int it = 0; it < 8; ++it) { const int pr = wave * 16 + it * 2 + hi, r = pr >> 2, h = pr & 3; const LAS float* o = OUT + r * 520 + h * 128;
        float v0 = o[r32], v1 = o[32 + r32], v2 = KR[r * 32 + r32]; const float ss = half_sum(v0 * v0 + v1 * v1 + v2 * v2);
        const float sc = 1.0f / sqrtf(ss * (1.f / 96.f) + EPS);
        v0 *= sc * gkn[r32]; v1 *= sc * gkn[32 + r32]; v2 *= sc * gkn[64 + r32];
        const float pv = xor_lane<8>(v2);
        if (!isctx) { const int pos = pos0 + r, pp = (r32 < 16) ? (pos >> 6) : (pos & 63); const float cs = rope[(pp * 8 + (r32 & 7)) * 2], sn = rope[(pp * 8 + (r32 & 7)) * 2 + 1];
            v2 = (r32 & 8) ? (v2 * cs + pv * sn) : (v2 * cs - pv * sn); }
        LAS bf16_t* kb = KB + (r * 4 + h) * 104;
        kb[r32] = (bf16_t)f2bf(v0); kb[32 + r32] = (bf16_t)f2bf(v1); kb[64 + r32] = (bf16_t)f2bf(v2); }
    __syncthreads();
    const int key0 = isctx ? pos0 : 256 + pos0, tile = key0 >> 6, kin = key0 & 63;
    for (int i = tid; i < 1536; i += NTHR) { const int r = i & 31, c = (i >> 5) % 12, h = i / 384;
        const u32x4 v = *(const LAS u32x4*)(KB + (r * 4 + h) * 104 + c * 8);
        *(u32x4*)((bf16_t*)(F.ws + WS_KT) + ((size_t)((b * 4 + h) * NKT + tile) * 12 + c) * 512 + (kin + r) * 8) = v; }
    for (int i = tid; i < 1024; i += NTHR) { const int p = i & 3, r = (i >> 2) & 31, dh = (i >> 7) & 1, h = i >> 8; const LAS float* o = OUT + r * 520 + h * 128 + 64 + dh * 32 + p * 8;
        u32x4 v; v.x = pk2(o[0], o[1]); v.y = pk2(o[2], o[3]); v.z = pk2(o[4], o[5]); v.w = pk2(o[6], o[7]);
        *(u32x4*)((bf16_t*)(F.ws + WS_VT) + ((size_t)((b * 4 + h) * NKT + tile) * 2 + dh) * 2048 + (kin + r) * 32 + p * 8) = v; }
}

__device__ __forceinline__ void ml_chunk_pos(int dir, int j, bool& isctx, int& p0) {
    if (j < 2) { isctx = true; p0 = (dir == 0 ? j : 1 - j) * 128; } else { isctx = false; p0 = (dir == 0 ? (j - 2) : (63 - (j - 2))) * 128; }
}
__device__ __forceinline__ int ml_row(int b, bool isctx, int pos) { return isctx ? NLAT + b * 256 + pos : b * 8192 + pos; }
__device__ __forceinline__ float log_sigmoidf_(float x) { return fminf(x, 0.f) - log1pf(__expf(-fabsf(x))); }

__device__ __forceinline__ void ml_pass1_unit(const Frame& F, int l, int unit) {
    LAS float* LI = (LAS float*)F.lds; LAS float* LF = LI + 128; LAS float* WV = LI + 256;
    LAS bf16_t* KT = (LAS bf16_t*)(F.lds + 2048); LAS bf16_t* VT = KT + 64 * 136;
    const int j = unit % NCHK, dir = (unit / NCHK) & 1, h = (unit / (NCHK * 2)) & 3, b = unit / (NCHK * 8);
    bool isctx; int p0; ml_chunk_pos(dir, j, isctx, p0);
    const int tid = F.tid, lane = F.lane, wave = F.wave;
    const float* gate = (const float*)(F.ws + T_GATE); const float* gb = F.in[I_MLGB] + l * 16;
    const bf16_t* px = (const bf16_t*)(F.ws + WS_PX);
    __syncthreads();
    if (tid < 128) { const int pos = dir ? p0 + 127 - tid : p0 + tid; const float* g = gate + (size_t)ml_row(b, isctx, pos) * 16;
        LI[tid] = g[dir * 8 + h] + gb[dir * 8 + h]; LF[tid] = log_sigmoidf_(g[dir * 8 + 4 + h] + gb[dir * 8 + 4 + h]); }
    __syncthreads();
    if (wave == 0) {
        const float a0 = LF[2 * lane], a1 = LF[2 * lane + 1]; float s = a0 + a1;
#pragma unroll
        for (int o = 1; o < 64; o <<= 1) { const float t = lane_up(s, o, lane); if (lane >= o) s += t; }
        const float bend = lane_bcast(s, 63);
        const float w0 = bend - (s - a1) + LI[2 * lane], w1 = bend - s + LI[2 * lane + 1];
        const float mloc = wave_max(fmaxf(w0, w1));
        WV[2 * lane] = __expf(w0 - mloc); WV[2 * lane + 1] = __expf(w1 - mloc);
        if (lane == 0) { ((float*)(F.ws + T_MLOC))[unit] = mloc; ((float*)(F.ws + T_BEND))[unit] = bend; }
    }
    __syncthreads();
    for (int it = tid; it < 2048; it += NTHR) { const int i = it & 127, c = (it >> 7) & 7, isv = it >> 10; const int pos = dir ? p0 + 127 - i : p0 + i;
        const u32x4 v = *(const u32x4*)(px + (size_t)ml_row(b, isctx, pos) * INC + (isv ? 512 : 256) + h * 64 + c * 8);
        const float sc = isv ? 1.0f : 0.125f * WV[i]; LAS bf16_t* d = (isv ? VT : KT) + (c * 8) * 136 + i;
        d[0] = (bf16_t)f2bf(bflo(v.x) * sc); d[136] = (bf16_t)f2bf(bfhi(v.x) * sc); d[272] = (bf16_t)f2bf(bflo(v.y) * sc); d[408] = (bf16_t)f2bf(bfhi(v.y) * sc);
        d[544] = (bf16_t)f2bf(bflo(v.z) * sc); d[680] = (bf16_t)f2bf(bfhi(v.z) * sc); d[816] = (bf16_t)f2bf(bflo(v.w) * sc); d[952] = (bf16_t)f2bf(bfhi(v.w) * sc); }
    __syncthreads();
    if (wave < 4) { const int et = wave >> 1, dt = wave & 1; f32x16 acc = {}; acc = mma32_ll(acc, VT + et * 32 * 136, 136, KT + dt * 32 * 136, 136, 8, lane);
        float* dc = (float*)(F.ws + WS_DC) + (size_t)unit * 4096; const int r32 = lane & 31, hi = lane >> 5;
#pragma unroll
        for (int r = 0; r < 16; ++r) dc[(et * 32 + crow(r, hi)) * 64 + dt * 32 + r32] = acc[r];
    } else if (wave == 4) { float s = 0.f; for (int i = 0; i < 128; ++i) s += bf2f(KT[lane * 136 + i]); ((float*)(F.ws + T_DN))[(size_t)unit * 64 + lane] = s; }
}

__device__ __forceinline__ void ml_pass2(const Frame& F) {
    const float* dc = (const float*)(F.ws + WS_DC); const float* dn = (const float*)(F.ws + T_DN);
    const float* mloc = (const float*)(F.ws + T_MLOC); const float* bend = (const float*)(F.ws + T_BEND);
    bf16_t* cst = (bf16_t*)(F.ws + WS_CST); float* nst = (float*)(F.ws + T_NST); float* mst = (float*)(F.ws + T_MST);
    for (int it = F.bx; it < 64 * 8; it += F.G) { const int bhd = it >> 3, part = it & 7, u0 = bhd * NCHK, el = part * 512 + F.tid;
        float C = 0.f, n = 0.f, m = 0.f; const bool don = (part == 0 && F.tid < 64);
#pragma unroll 2
        for (int j = 0; j < NCHK; ++j) { const int u = u0 + j;
            const float dcv = dc[(size_t)u * 4096 + el], ml = mloc[u], be = bend[u]; const float dnv = don ? dn[(size_t)u * 64 + F.tid] : 0.f;
            cst[(size_t)u * 4096 + el] = (bf16_t)f2bf(C); if (don) nst[(size_t)u * 64 + F.tid] = n; if (part == 0 && F.tid == 0) mst[u] = m;
            const float mn = fmaxf(be + m, ml), dcy = __expf(be + m - mn), sc = __expf(ml - mn);
            C = dcy * C + sc * dcv; n = dcy * n + sc * dnv; m = mn; }
    }
}

__device__ __forceinline__ void ml_pass3_unit(const Frame& F, int l, int b, int h, int pc) {
    LAS unsigned char* lds = F.lds;
    LAS bf16_t* Qs = (LAS bf16_t*)lds;
    LAS bf16_t* Ks = (LAS bf16_t*)(lds + 18432);
    LAS bf16_t* VTs = (LAS bf16_t*)(lds + 36864);
    LAS bf16_t* CTs = (LAS bf16_t*)(lds + 62976);
    LAS bf16_t* Wm = (LAS bf16_t*)(lds + 76800);
    LAS float* HS = (LAS float*)(lds + 111616);
    LAS float* LI = (LAS float*)(lds + 144384); LAS float* LF = LI + 128; LAS float* COLV = LI + 256; LAS float* MV = LI + 384; LAS float* AIN = LI + 512; LAS float* EINV = LI + 640; LAS float* DEN = LI + 768;
    const int tid = F.tid, lane = F.lane, wave = F.wave, r32 = lane & 31, hi = lane >> 5;
    const bool isctx = pc < 2; const int p0 = isctx ? pc * 128 : (pc - 2) * 128;
    const float* gate = (const float*)(F.ws + T_GATE); const float* gb = F.in[I_MLGB] + l * 16;
    const bf16_t* px = (const bf16_t*)(F.ws + WS_PX);
    for (int dir = 0; dir < 2; ++dir) {
        const int j = isctx ? (dir == 0 ? pc : 1 - pc) : (dir == 0 ? pc : 2 + 63 - (pc - 2));
        const int unit = ((b * 4 + h) * 2 + dir) * NCHK + j;
        const float mst = ((const float*)(F.ws + T_MST))[unit];
        __syncthreads();
        if (tid < 128) { const int pos = dir ? p0 + 127 - tid : p0 + tid; const float* g = gate + (size_t)ml_row(b, isctx, pos) * 16;
            LI[tid] = g[dir * 8 + h] + gb[dir * 8 + h]; LF[tid] = log_sigmoidf_(g[dir * 8 + 4 + h] + gb[dir * 8 + 4 + h]); }
        __syncthreads();
        if (wave == 0) {
            const float a0 = LF[2 * lane], a1 = LF[2 * lane + 1]; float s = a0 + a1;
#pragma unroll
            for (int o = 1; o < 64; o <<= 1) { const float t = lane_up(s, o, lane); if (lane >= o) s += t; }
            const float b0 = s - a1, b1 = s, c0 = LI[2 * lane] - b0, c1 = LI[2 * lane + 1] - b1;
            float pm = fmaxf(c0, c1);
#pragma unroll
            for (int o = 1; o < 64; o <<= 1) { const float t = lane_up(pm, o, lane); if (lane >= o) pm = fmaxf(pm, t); }
            float pprev = lane_up(pm, 1, lane); if (lane == 0) pprev = -INFINITY;
            const float M0 = fmaxf(mst, fmaxf(pprev, c0)), M1 = fmaxf(mst, pm);
            COLV[2 * lane] = c0; COLV[2 * lane + 1] = c1; MV[2 * lane] = M0; MV[2 * lane + 1] = M1;
            AIN[2 * lane] = __expf(mst - M0); AIN[2 * lane + 1] = __expf(mst - M1); EINV[2 * lane] = __expf(-b0 - M0); EINV[2 * lane + 1] = __expf(-b1 - M1);
        }
        for (int it = tid; it < 3072; it += NTHR) { const int i = it & 127, c = (it >> 7) & 7, which = it >> 10; const int pos = dir ? p0 + 127 - i : p0 + i;
            const u32x4 v = *(const u32x4*)(px + (size_t)ml_row(b, isctx, pos) * INC + which * 256 + h * 64 + c * 8);
            if (which == 0) *(LAS u32x4*)(Qs + i * 72 + c * 8) = v;
            else if (which == 1) { u32x4 w; w.x = pk2(bflo(v.x) * 0.125f, bfhi(v.x) * 0.125f); w.y = pk2(bflo(v.y) * 0.125f, bfhi(v.y) * 0.125f); w.z = pk2(bflo(v.z) * 0.125f, bfhi(v.z) * 0.125f); w.w = pk2(bflo(v.w) * 0.125f, bfhi(v.w) * 0.125f);
                *(LAS u32x4*)(Ks + i * 72 + c * 8) = w; }
            else { LAS bf16_t* d = VTs + (c * 8) * 136 + i; d[0] = (bf16_t)(v.x & 0xffff); d[136] = (bf16_t)(v.x >> 16); d[272] = (bf16_t)(v.y & 0xffff); d[408] = (bf16_t)(v.y >> 16);
                d[544] = (bf16_t)(v.z & 0xffff); d[680] = (bf16_t)(v.z >> 16); d[816] = (bf16_t)(v.w & 0xffff); d[952] = (bf16_t)(v.w >> 16); } }
        for (int it = tid; it < 32 * 136; it += NTHR) VTs[64 * 136 + it] = (it < 128) ? (bf16_t)0x3f80 : (bf16_t)0;
        { const bf16_t* cs = (const bf16_t*)(F.ws + WS_CST) + (size_t)unit * 4096; const u32x4 v = *(const u32x4*)(cs + tid * 8); *(LAS u32x4*)(CTs + (tid >> 3) * 72 + (tid & 7) * 8) = v; }
        for (int it = tid; it < 32 * 72; it += NTHR) CTs[64 * 72 + it] = (it < 64) ? (bf16_t)f2bf(((const float*)(F.ws + T_NST))[(size_t)unit * 64 + it]) : (bf16_t)0;
        __syncthreads();
        for (int q = wave; q < 16; q += 8) { const int ti = q >> 2, si = q & 3; const int s = si * 32 + r32;
            if (si > ti) {
#pragma unroll
                for (int r = 0; r < 16; ++r) Wm[(ti * 32 + crow(r, hi)) * 136 + s] = 0;
            } else { f32x16 acc = {}; acc = mma32_ll(acc, Qs + ti * 32 * 72, 72, Ks + si * 32 * 72, 72, 4, lane); const float cv = COLV[s];
#pragma unroll
                for (int r = 0; r < 16; ++r) { const int t = ti * 32 + crow(r, hi); const float w = (s <= t) ? acc[r] * __expf(cv - MV[t]) : 0.f; Wm[t * 136 + s] = (bf16_t)f2bf(w); } }
        }
        __syncthreads();
        f32x16 tot[2];
        for (int k = 0; k < 2; ++k) { const int q = wave + 8 * k; if (q < 12) { const int ti = q / 3, nt = q % 3;
            f32x16 a1 = {}; a1 = mma32_ll(a1, Wm + ti * 32 * 136, 136, VTs + nt * 32 * 136, 136, (ti + 1) * 2, lane);
            f32x16 a2 = {}; a2 = mma32_ll(a2, Qs + ti * 32 * 72, 72, CTs + nt * 32 * 72, 72, 4, lane);
#pragma unroll
            for (int r = 0; r < 16; ++r) a1[r] += AIN[ti * 32 + crow(r, hi)] * a2[r];
            tot[k] = a1;
            if (nt == 2 && r32 == 0) {
#pragma unroll
                for (int r = 0; r < 16; ++r) DEN[ti * 32 + crow(r, hi)] = a1[r]; } } }
        __syncthreads();
        for (int k = 0; k < 2; ++k) { const int q = wave + 8 * k; if (q < 12) { const int ti = q / 3, nt = q % 3; if (nt < 2) {
#pragma unroll
            for (int r = 0; r < 16; ++r) { const int t = ti * 32 + crow(r, hi); const float hv = tot[k][r] / fmaxf(fabsf(DEN[t]), EINV[t]); const int p = dir ? 127 - t : t;
                if (dir == 0) HS[p * 64 + nt * 32 + r32] = hv; else HS[p * 64 + nt * 32 + r32] += hv; } } } }
    }
    __syncthreads();
    const float hg = F.in[I_MLHG][l * 256 + h * 64 + lane]; bf16_t* yc = (bf16_t*)(F.ws + WS_YC);
    for (int pp = 0; pp < 16; ++pp) { const int p = wave * 16 + pp; const int row = ml_row(b, isctx, p0 + p); const float v = HS[p * 64 + lane];
        const float sc = 1.0f / sqrtf(wave_sum(v * v) * (1.f / 64.f) + EPS); const float o = bf2f(px[(size_t)row * INC + 768 + h * 64 + lane]);
        yc[(size_t)row * 1024 + h * 64 + lane] = (bf16_t)f2bf(v * sc * hg * sigmoidf_(o)); }
}

__device__ __forceinline__ void pool_unit(const Frame& F, int l, int unit) {
    LAS float* U = (LAS float*)F.lds;
    LAS bf16_t* D = (LAS bf16_t*)(F.lds + 81920);
    const int row0 = unit * 64, tid = F.tid, lane = F.lane, wave = F.wave;
    const bool isctx = row0 >= NLAT; const int T = isctx ? 256 : 8192, t0 = isctx ? (row0 - NLAT) & 255 : row0 & 8191, rbase = row0 - t0;
    const bf16_t* px = (const bf16_t*)(F.ws + WS_PX);
    __syncthreads();
    for (int it = tid; it < 80 * 32; it += NTHR) { const int rr = it >> 5, c = it & 31, t = t0 - 8 + rr;
        u32x4 v = {0u, 0u, 0u, 0u}; if (t >= 0 && t < T) v = *(const u32x4*)(px + (size_t)(rbase + t) * INC + C_POOL + c * 8);
        LAS float* d = U + rr * 256 + c * 8; d[0] = bflo(v.x); d[1] = bfhi(v.x); d[2] = bflo(v.y); d[3] = bfhi(v.y); d[4] = bflo(v.z); d[5] = bfhi(v.z); d[6] = bflo(v.w); d[7] = bfhi(v.w); }
    __syncthreads();
    for (int it = tid; it < 64 * 256; it += NTHR) { const int tt = it >> 8, c = it & 255, g = c >> 6, hw = 1 << g, t = t0 + tt;
        const int lo = max(t - hw, 0), hi = min(t + hw, T); float s = 0.f;
        for (int u = lo; u < hi; ++u) s += U[(u - t0 + 8) * 256 + c];
        D[tt * 264 + c] = (bf16_t)f2bf(s / (float)(hi - lo) - U[(tt + 8) * 256 + c]); }
    __syncthreads();
    { const int g = wave >> 1, rt = wave & 1, r32 = lane & 31, hi = lane >> 5; bf16_t* yc = (bf16_t*)(F.ws + WS_YC); const float* ps = F.in[I_POOLS] + l * 256;
      for (int nt = 0; nt < 2; ++nt) { f32x16 acc = {}; acc = mma32_lg(acc, D + rt * 32 * 264 + g * 64, 264, (const bf16_t*)(F.ws + W_POOL) + (size_t)(g * 64 + nt * 32) * 64, 64, 4, lane);
          const int col = g * 64 + nt * 32 + r32; const float sc = ps[col];
#pragma unroll
          for (int r = 0; r < 16; ++r) yc[(size_t)(row0 + rt * 32 + crow(r, hi)) * 1024 + 512 + col] = (bf16_t)f2bf(acc[r] * sc); } }
}
__device__ __forceinline__ void conv_all(const Frame& F, int l, int nrows) {
    const bf16_t* px = (const bf16_t*)(F.ws + WS_PX); bf16_t* yc = (bf16_t*)(F.ws + WS_YC);
    const float* cw = F.in[I_CONVW] + l * 768; const float* cb = F.in[I_CONVB] + l * 256;
    for (int it = F.bx * NTHR + F.tid; it < nrows * 32; it += F.G * NTHR) { const int row = it >> 5, c = (it & 31) * 8;
        const bool isctx = row >= NLAT; const int T = isctx ? 256 : 8192, t = isctx ? (row - NLAT) & 255 : row & 8191;
        const bf16_t* p = px + (size_t)row * INC + C_CONV + c;
        float z[3][8];
#pragma unroll
        for (int j = 0; j < 3; ++j) { const int tt = t + j - 1;
            if (tt >= 0 && tt < T) { const bf16_t* q = p + (ptrdiff_t)(j - 1) * INC; const u32x4 u = *(const u32x4*)q, cc = *(const u32x4*)(q + 512);
                z[j][0] = bflo(u.x) * bflo(cc.x); z[j][1] = bfhi(u.x) * bfhi(cc.x); z[j][2] = bflo(u.y) * bflo(cc.y); z[j][3] = bfhi(u.y) * bfhi(cc.y);
                z[j][4] = bflo(u.z) * bflo(cc.z); z[j][5] = bfhi(u.z) * bfhi(cc.z); z[j][6] = bflo(u.w) * bflo(cc.w); z[j][7] = bfhi(u.w) * bfhi(cc.w); }
            else {
#pragma unroll
                for (int e = 0; e < 8; ++e) z[j][e] = 0.f; } }
        const u32x4 bw = *(const u32x4*)(p + 256); float bx[8] = {bflo(bw.x), bfhi(bw.x), bflo(bw.y), bfhi(bw.y), bflo(bw.z), bfhi(bw.z), bflo(bw.w), bfhi(bw.w)};
        float y[8];
#pragma unroll
        for (int e = 0; e < 8; ++e) y[e] = bx[e] * (cb[c + e] + cw[c + e] * z[0][e] + cw[256 + c + e] * z[1][e] + cw[512 + c + e] * z[2][e]);
        u32x4 o; o.x = pk2(y[0], y[1]); o.y = pk2(y[2], y[3]); o.z = pk2(y[4], y[5]); o.w = pk2(y[6], y[7]);
        *(u32x4*)(yc + (size_t)row * 1024 + 768 + c) = o; }
}

namespace att {
constexpr int STAGE_B = 40960, KSUB = 12288, VOFF = 24576, VSUB = 8192, LDS_WS = 3 * STAGE_B, LDS_OST = LDS_WS + 2048;
constexpr float THR = 8.0f;
__device__ __forceinline__ void glds16(const void* gsrc, unsigned lds_dst) { unsigned keep;
    asm volatile("s_mov_b32 %0, m0\n\ts_mov_b32 m0, %2\n\ts_nop 0\n\tglobal_load_lds_dwordx4 %1, off\n\ts_mov_b32 m0, %0" : "=&s"(keep) : "v"(gsrc), "s"(lds_dst) : "memory"); }
#define ATT_WAIT_BAR(N) asm volatile("s_waitcnt vmcnt(" #N ") lgkmcnt(0)\n\ts_barrier" ::: "memory")
__device__ __forceinline__ void qkt(f32x16& p0, f32x16& p1, const LAS char* Kslot, const bf16x8* qr, int r32, int hi) {
    const LAS char* kb = Kslot + hi * 1024 + r32 * 16; p0 = f32x16{}; p1 = f32x16{};
#pragma unroll
    for (int d0 = 0; d0 < 6; ++d0) {
        const bf16x8 b0 = *(const LAS bf16x8*)(kb + d0 * 2048), b1 = *(const LAS bf16x8*)(kb + d0 * 2048 + 512);
        p0 = __builtin_amdgcn_mfma_f32_32x32x16_bf16(b0, qr[d0], p0, 0, 0, 0); p1 = __builtin_amdgcn_mfma_f32_32x32x16_bf16(b1, qr[d0], p1, 0, 0, 0); }
}
__device__ __forceinline__ float rowmax(const f32x16& p0, const f32x16& p1) {
    float a = fmaxf(p0[0], p1[0]);
#pragma unroll
    for (int r = 1; r < 16; ++r) a = fmaxf(a, fmaxf(p0[r], p1[r]));
    auto rr = __builtin_amdgcn_permlane32_swap(__float_as_uint(a), __float_as_uint(a), false, false);
    return fmaxf(__uint_as_float(rr[0]), __uint_as_float(rr[1]));
}
__device__ __forceinline__ void pv(f32x16* o, int vb, bf16x8 pa0, bf16x8 pa1, bf16x8 pa2, bf16x8 pa3) {
#pragma unroll
    for (int d0 = 0; d0 < 2; ++d0) { s16x4 lo[4], hi[4];
#pragma unroll
        for (int ks = 0; ks < 4; ++ks) {
            asm volatile("ds_read_b64_tr_b16 %0,%1 offset:%c2" : "=&v"(lo[ks]) : "v"(vb), "i"(d0 * 4096 + ks * 1024) : "memory");
            asm volatile("ds_read_b64_tr_b16 %0,%1 offset:%c2" : "=&v"(hi[ks]) : "v"(vb), "i"(d0 * 4096 + ks * 1024 + 512) : "memory"); }
        asm volatile("s_waitcnt lgkmcnt(0)" ::: "memory"); __builtin_amdgcn_sched_barrier(0);
#define ATT_PK(k) (bf16x8){lo[k][0], lo[k][1], lo[k][2], lo[k][3], hi[k][0], hi[k][1], hi[k][2], hi[k][3]}
        o[d0] = __builtin_amdgcn_mfma_f32_32x32x16_bf16(pa0, ATT_PK(0), o[d0], 0, 0, 0);
        o[d0] = __builtin_amdgcn_mfma_f32_32x32x16_bf16(pa1, ATT_PK(1), o[d0], 0, 0, 0);
        o[d0] = __builtin_amdgcn_mfma_f32_32x32x16_bf16(pa2, ATT_PK(2), o[d0], 0, 0, 0);
        o[d0] = __builtin_amdgcn_mfma_f32_32x32x16_bf16(pa3, ATT_PK(3), o[d0], 0, 0, 0);
#undef ATT_PK
    }
}
__device__ __forceinline__ void unit(const Frame& F, int bh, int qrow, int orow, int nst) {
    const int tid = F.tid, lane = F.lane, wid = F.wave, r32 = lane & 31, hi = lane >> 5, h = bh & 3;
    const unsigned lds0 = (unsigned)(uintptr_t)F.lds;
    const LAS char* ring = (const LAS char*)F.lds;
    LAS float* wsf = (LAS float*)(F.lds + LDS_WS) + wid * 64;
    const char* kg = (const char*)(F.ws + WS_KT) + (size_t)bh * NKT * 12288; const char* vg = (const char*)(F.ws + WS_VT) + (size_t)bh * NKT * 8192;
    const bf16_t* Qw = (const bf16_t*)(F.ws + WS_QB) + (size_t)(qrow + wid * 32) * 384 + h * 96;
#define ATT_DMA(t, slot) do { const char* ks_ = kg + (size_t)(t) * 24576 + wid * 1024 + lane * 16; const char* vs_ = vg + (size_t)(t) * 16384 + wid * 1024 + lane * 16; \
        const unsigned kd_ = lds0 + (slot) * STAGE_B + wid * 1024, vd_ = kd_ + VOFF; \
        glds16(ks_, (unsigned)__builtin_amdgcn_readfirstlane(kd_)); glds16(ks_ + 8192, (unsigned)__builtin_amdgcn_readfirstlane(kd_ + 8192)); glds16(ks_ + 16384, (unsigned)__builtin_amdgcn_readfirstlane(kd_ + 16384)); \
        glds16(vs_, (unsigned)__builtin_amdgcn_readfirstlane(vd_)); glds16(vs_ + 8192, (unsigned)__builtin_amdgcn_readfirstlane(vd_ + 8192)); } while (0)
    ATT_DMA(0, 0); if (nst > 1) ATT_DMA(1, 1);
    bf16x8 qr[6];
#pragma unroll
    for (int d0 = 0; d0 < 6; ++d0) qr[d0] = *(const bf16x8*)(Qw + (size_t)r32 * 384 + d0 * 16 + hi * 8);
    float mhat = 0.f, l_reg = 0.f; f32x16 o[2]; o[0] = f32x16{}; o[1] = f32x16{};
    const int vb0 = (int)lds0 + VOFF + ((lane >> 4) & 1) * 32 + (lane & 3) * 8 + (4 * hi + ((lane & 15) >> 2)) * 64;
    int slot = 0; bool first = true;
    for (int t = 0; t < nst; ++t) {
        if (t + 1 < nst) ATT_WAIT_BAR(5); else ATT_WAIT_BAR(0);
        if (t + 2 < nst) { const int s2 = (slot == 0) ? 2 : slot - 1; ATT_DMA(t + 2, s2); }
#pragma unroll
        for (int s = 0; s < 2; ++s) {
            f32x16 p0, p1; qkt(p0, p1, ring + slot * STAGE_B + s * KSUB, qr, r32, hi);
            const float rm = rowmax(p0, p1);
            if (first) { mhat = rm; first = false; }
            else if (__any(rm - mhat > THR)) { const float dl = fmaxf(rm - mhat, 0.f); mhat += dl; const float f = __builtin_amdgcn_exp2f(-dl); l_reg *= f;
                if (hi == 0) wsf[r32] = f; LDS_WAIT();
#pragma unroll
                for (int r = 0; r < 16; ++r) { const float fr_ = wsf[crow(r, hi)]; o[0][r] *= fr_; o[1][r] *= fr_; } }
            float sacc = 0.f;
#pragma unroll
            for (int r = 0; r < 16; ++r) { p0[r] = __builtin_amdgcn_exp2f(p0[r] - mhat); p1[r] = __builtin_amdgcn_exp2f(p1[r] - mhat); sacc += p0[r] + p1[r]; }
            l_reg += sacc;
            u32x4 pw0, pw1, pw2, pw3;
            pw0 = (u32x4){cvt_pk_bf16(p0[0], p0[1]), cvt_pk_bf16(p0[2], p0[3]), cvt_pk_bf16(p0[4], p0[5]), cvt_pk_bf16(p0[6], p0[7])};
            pw1 = (u32x4){cvt_pk_bf16(p0[8], p0[9]), cvt_pk_bf16(p0[10], p0[11]), cvt_pk_bf16(p0[12], p0[13]), cvt_pk_bf16(p0[14], p0[15])};
            pw2 = (u32x4){cvt_pk_bf16(p1[0], p1[1]), cvt_pk_bf16(p1[2], p1[3]), cvt_pk_bf16(p1[4], p1[5]), cvt_pk_bf16(p1[6], p1[7])};
            pw3 = (u32x4){cvt_pk_bf16(p1[8], p1[9]), cvt_pk_bf16(p1[10], p1[11]), cvt_pk_bf16(p1[12], p1[13]), cvt_pk_bf16(p1[14], p1[15])};
            __builtin_amdgcn_sched_barrier(0);
            pv(o, vb0 + slot * STAGE_B + s * VSUB, __builtin_bit_cast(bf16x8, pw0), __builtin_bit_cast(bf16x8, pw1), __builtin_bit_cast(bf16x8, pw2), __builtin_bit_cast(bf16x8, pw3));
        }
        slot = (slot == 2) ? 0 : slot + 1;
    }
    { auto rr = __builtin_amdgcn_permlane32_swap(__float_as_uint(l_reg), __float_as_uint(l_reg), false, false); l_reg = __uint_as_float(rr[0]) + __uint_as_float(rr[1]); }
    if (hi == 0) wsf[32 + r32] = l_reg; LDS_WAIT();
    float rli[16];
#pragma unroll
    for (int r = 0; r < 16; ++r) rli[r] = 1.0f / wsf[32 + crow(r, hi)];
    LAS bf16_t* stg = (LAS bf16_t*)(F.lds + LDS_OST) + wid * 2048;
#pragma unroll
    for (int r = 0; r < 16; ++r) { const int orow_ = crow(r, hi);
#pragma unroll
        for (int d0 = 0; d0 < 2; ++d0) stg[orow_ * 64 + d0 * 32 + r32] = (bf16_t)f2bf(o[d0][r] * rli[r]); }
    LDS_WAIT();
    bf16_t* Ow = (bf16_t*)(F.ws + WS_YC) + (size_t)(orow + wid * 32) * 1024 + 256 + h * 64;
#pragma unroll
    for (int i = 0; i < 4; ++i) { const int row = i * 8 + (lane >> 3), ch = lane & 7; const u32x4 v = *(const LAS u32x4*)(stg + row * 64 + ch * 8); *(u32x4*)(Ow + (size_t)row * 1024 + ch * 8) = v; }
    asm volatile("s_waitcnt lgkmcnt(0)\n\ts_barrier" ::: "memory");
#undef ATT_DMA
}
}

__device__ __forceinline__ void ph_norm2_route(const Frame& F, int l, int ntok) {
    LAS bf16_t* A = (LAS bf16_t*)F.lds;
    LAS float* PART = (LAS float*)(F.lds + 66048);
    LAS float* LOG = (LAS float*)(F.lds + 131584);
    LAS int* HIST = (LAS int*)(F.lds + 139776);
    const int tid = F.tid, lane = F.lane, wave = F.wave, r32 = lane & 31, hi = lane >> 5;
    const int tpb = ntok / F.G, tok0 = F.bx * tpb;
    bf16_t* hx2 = (bf16_t*)(F.ws + WS_HX); int* eidx = (int*)(F.ws + T_EIDX); float* ew = (float*)(F.ws + T_EW);
    const float* brt = F.in[I_BRT] + l * 64;
    if (tid < 64) HIST[tid] = 0;
    for (int b0 = 0; b0 < tpb; b0 += 32) {
        __syncthreads();
        for (int rr = 0; rr < 4; ++rr) { const int r = wave * 4 + rr, t = b0 + r; LAS u32x2* a = (LAS u32x2*)(A + r * 1032) + lane;
            if (t < tpb) { const int row = tok0 + t, mr = mod_row_of(row); f32x4 y[4];
                normmod_row(lane, stream_row(F, 1, row), F.in[I_GFFN] + l * 1024, modp(F, l, mr, 4), modp(F, l, mr, 3), y);
                u32x2* o = (u32x2*)(hx2 + (size_t)row * 1024) + lane;
#pragma unroll
                for (int j = 0; j < 4; ++j) { const u32x2 w = (u32x2){pk2(y[j].x, y[j].y), pk2(y[j].z, y[j].w)}; o[64 * j] = w; a[64 * j] = w; }
            } else {
#pragma unroll
                for (int j = 0; j < 4; ++j) a[64 * j] = (u32x2){0u, 0u}; } }
        __syncthreads();
#pragma unroll
        for (int nt = 0; nt < 2; ++nt) { f32x16 acc = {}; acc = mma32_lg(acc, A + wave * 128, 1032, (const bf16_t*)(F.ws + W_RT) + (size_t)nt * 32 * 1024 + wave * 128, 1024, 8, lane);
#pragma unroll
            for (int r = 0; r < 16; ++r) PART[(wave * 32 + crow(r, hi)) * 64 + nt * 32 + r32] = acc[r]; }
        __syncthreads();
        for (int i = tid; i < 2048; i += NTHR) { float s = 0.f;
#pragma unroll
            for (int w = 0; w < 8; ++w) s += PART[w * 2048 + i];
            LOG[i] = s; }
        __syncthreads();
        for (int rr = 0; rr < 4; ++rr) { const int r = wave * 4 + rr, t = b0 + r; if (t >= tpb) continue;
            const float sc = sigmoidf_(LOG[r * 64 + lane]); float v = sc + brt[lane]; float ssel = 0.f, mys = 0.f; int myi = 0;
#pragma unroll
            for (int k = 0; k < TOPK; ++k) { const float mx = wave_max(v); const unsigned long long bal = __ballot(v == mx); const int win = __ffsll((long long)bal) - 1;
                const float sw = lane_bcast(sc, win); ssel += sw; if (lane == k) { mys = sw; myi = win; } if (lane == win) v = -INFINITY; }
            if (lane < TOPK) { eidx[(size_t)(tok0 + t) * 6 + lane] = myi; ew[(size_t)(tok0 + t) * 6 + lane] = mys / ssel * 2.5f; __hip_atomic_fetch_add(&HIST[myi], 1, __ATOMIC_RELAXED, __HIP_MEMORY_SCOPE_WORKGROUP); } }
    }
    __syncthreads();
    if (tid < 64) ((int*)(F.ws + T_HIST))[F.bx * 64 + tid] = HIST[tid];
}

__device__ __forceinline__ void ph_assign(const Frame& F, int c, int ntok) {
    LAS int* BASE = (LAS int*)F.lds; LAS int* CUR = BASE + 64; LAS int* START = BASE + 128; LAS int* TOT = BASE + 192; LAS int* MISC = BASE + 256;
    const int tid = F.tid, hb = F.G / 2, tpb = ntok / F.G, ctok0 = c * hb * tpb, ctoks = hb * tpb;
    const int* hist = (const int*)(F.ws + T_HIST); int* rtok = (int*)(F.ws + T_RTOK); float* rw = (float*)(F.ws + T_RW); int* slot = (int*)(F.ws + T_SLOT);
    int* tile_e = (int*)(F.ws + T_TILEE) + c * 1024;
    if (F.bx / hb != c) return;
    __syncthreads();
    if (tid < 64) { int tot = 0, bef = 0; for (int b = c * hb; b < (c + 1) * hb; ++b) { const int v = hist[b * 64 + tid]; tot += v; if (b < F.bx) bef += v; } TOT[tid] = tot; BASE[tid] = bef; CUR[tid] = 0; }
    __syncthreads();
    if (tid == 0) { int s = 0; for (int e = 0; e < 64; ++e) { START[e] = s; s += (TOT[e] + 255) / 256 * 256; } MISC[0] = s; }
    __syncthreads();
    const int sstart = MISC[0];
    const int* eidx = (const int*)(F.ws + T_EIDX); const float* ew = (const float*)(F.ws + T_EW);
    for (int i = tid; i < tpb * 6; i += NTHR) { const int tok = F.bx * tpb + i / 6, k = i % 6; const int e = eidx[(size_t)tok * 6 + k];
        const int pos = START[e] + BASE[e] + __hip_atomic_fetch_add(&CUR[e], 1, __ATOMIC_RELAXED, __HIP_MEMORY_SCOPE_WORKGROUP); rtok[pos] = tok; rw[pos] = ew[(size_t)tok * 6 + k]; slot[(size_t)tok * 8 + k] = pos; }
    for (int i = tid; i < tpb; i += NTHR) { const int tok = F.bx * tpb + i, pos = sstart + (tok - ctok0); rtok[pos] = tok; rw[pos] = 1.0f; slot[(size_t)tok * 8 + 6] = pos; }
    if (F.bx == c * hb) {
        for (int e = 0; e < 64; ++e) { const int p0 = START[e] + TOT[e], p1 = START[e] + (TOT[e] + 255) / 256 * 256;
            for (int p = p0 + tid; p < p1; p += NTHR) { rtok[p] = ctok0; rw[p] = 0.f; }
            for (int tl = START[e] / 256 + tid; tl < p1 / 256; tl += NTHR) tile_e[tl] = e; }
        for (int tl = sstart / 256 + tid; tl < (sstart + ctoks) / 256; tl += NTHR) tile_e[tl] = 64;
        if (tid == 0) tile_e[1023] = (sstart + ctoks) / 256;
    }
}

__device__ __forceinline__ void ph_combine(const Frame& F, int l, int c, int ntok) {
    const int gw = F.bx * NWAVES + F.wave, ngw = F.G * NWAVES, lane = F.lane; const int ctoks = ntok / 2, ctok0 = c * ctoks;
    const int* slot = (const int*)(F.ws + T_SLOT); const bf16_t* ys = (const bf16_t*)(F.ws + WS_YS);
    for (int t = gw; t < ctoks; t += ngw) { const int tok = ctok0 + t, mr = mod_row_of(tok);
        float* xr = (tok < NLAT) ? F.out + (size_t)tok * 1024 : (float*)(F.ws + WS_CTXS) + (size_t)(tok - NLAT) * 1024;
        const float* gt = modp(F, l, mr, 5);
        f32x4 a[4];
#pragma unroll
        for (int j = 0; j < 4; ++j) a[j] = (f32x4){0.f, 0.f, 0.f, 0.f};
#pragma unroll
        for (int k = 0; k < 7; ++k) { const int s = slot[(size_t)tok * 8 + k]; const u32x2* yr = (const u32x2*)(ys + (size_t)s * 1024) + lane;
#pragma unroll
            for (int j = 0; j < 4; ++j) { const u32x2 w = yr[64 * j]; a[j] += (f32x4){bflo(w.x), bfhi(w.x), bflo(w.y), bfhi(w.y)}; } }
#pragma unroll
        for (int j = 0; j < 4; ++j) { f32x4* p = (f32x4*)xr + lane + 64 * j; *p = *p + ((const f32x4*)gt)[lane + 64 * j] * a[j]; }
    }
}

__device__ __forceinline__ Frame phase_frame(const Frame& F) {
    Frame Q = F; int t = threadIdx.x; asm volatile("" : "+v"(t)); Q.tid = t; Q.lane = t & 63; Q.wave = __builtin_amdgcn_readfirstlane(t >> 6);
    unsigned long long w = (unsigned long long)F.ws; asm volatile("" : "+s"(w)); Q.ws = (unsigned char*)(GAS unsigned char*)w;
    return Q;
}
constexpr int PH_PER_LAYER = 16, PH_TOTAL = 1 + 2 * PH_PER_LAYER;
__global__ void __launch_bounds__(NTHR, 2) mk_fwd(Params p) {
    extern __shared__ __attribute__((aligned(16))) unsigned char lds_raw[];
    Frame F0;
    F0.lds = (LAS unsigned char*)lds_raw; F0.ws = p.ws; F0.in = p.in; F0.out = p.out;
    F0.tid = threadIdx.x; F0.lane = F0.tid & 63; F0.wave = __builtin_amdgcn_readfirstlane(F0.tid >> 6); F0.bx = blockIdx.x; F0.G = gridDim.x;
    volatile LAS unsigned* MISC = (volatile LAS unsigned*)(F0.lds + MISC_OFF);
    if (F0.tid < 64) MISC[F0.tid] = 0u;
    __syncthreads();
    const int lo = p.ph_lo, hi = p.ph_hi;
    XcdBarrier bar; bar.bar = (unsigned*)(F0.ws + WS_CTL) + CW_BAR; bar.x = 0; bar.st = MISC + 8;
    if (hi - lo > 1) bar = xcd_barrier_post((unsigned*)(F0.ws + WS_CTL) + CW_BAR, MISC + 8);
#ifndef MK_SITE
#define MK_SITE -1
#endif
#define SITE(n) (MK_SITE < 0 || MK_SITE == (n))
#define RUN(k) (lo <= (k) && (k) < hi)
#define SEAM(k) do { if (RUN(k) && RUN((k) + 1)) xcd_barrier(bar); } while (0)
    int ph = 0;
    if (SITE(0) && RUN(ph)) { const Frame F = phase_frame(F0); ph_pre(F); }
    SEAM(ph); ++ph;
    for (int l = 0; l < 2; ++l) {
        const int ntok = (l == 0) ? NTOK : NLAT, nM = ntok / 256;
        if (SITE(1) && RUN(ph)) { const Frame F = phase_frame(F0); ph_convert(F, l); __syncthreads(); ph_norm1(F, l); }
        SEAM(ph); ++ph;
        if (SITE(2) && RUN(ph)) { const Frame F = phase_frame(F0);
            SchedPlain S{(const char*)(F.ws + WS_HX), (const char*)(F.ws + W_IN), 2048u, 2048u, 16, NTOK / 256, INCP / 256, F.G, F.bx};
            EpiWin E{(bf16_t*)(F.ws + WS_PX), (float*)(F.ws + T_GATE)};
            gg::gemm_phase(F.lds, S, E);
        }
        SEAM(ph); ++ph;
        if (SITE(3) && RUN(ph)) { const Frame F = phase_frame(F0);
            for (int u = F.bx; u < NTOK / 32; u += F.G) mla_unit(F, l, u, (u * 32 < NLAT) || l == 0);
            for (int u = F.bx; u < 64 * NCHK; u += F.G) ml_pass1_unit(F, l, u);
            for (int u = F.bx; u < ntok / 64; u += F.G) pool_unit(F, l, u);
            conv_all(F, l, ntok);
            __syncthreads();
        }
        SEAM(ph); ++ph;
        if (SITE(4) && RUN(ph)) { const Frame F = phase_frame(F0);
            ml_pass2(F);
            const int nunits = 1024 + (l == 0 ? 32 : 0);
            for (int i = 0; ; ++i) { const int L = i * F.G + F.bx; if (L >= nunits) break;
                if (L < 1024) { const int bh = (L >> 8) * 8 + (L & 7), qb = (L & 255) >> 3, b = bh >> 2; att::unit(F, bh, b * 8192 + qb * 256, b * 8192 + qb * 256, 66); }
                else { const int bh = L - 1024, b = bh >> 2; att::unit(F, bh, NLAT + b * 256, NLAT + b * 256, 2); } }
        }
        SEAM(ph); ++ph;
        if (SITE(5) && RUN(ph)) { const Frame F = phase_frame(F0);
            const int npc = (l == 0) ? 66 : 64, nun = 32 * npc;
            for (int u = F.bx; u < nun; u += F.G) { const int bh = u / npc, pc = u % npc + (l == 0 ? 0 : 2); ml_pass3_unit(F, l, bh >> 2, bh & 3, pc); }
            __syncthreads();
        }
        SEAM(ph); ++ph;
        if (SITE(6) && RUN(ph)) { const Frame F = phase_frame(F0);
            SchedMerge S{(const char*)(F.ws + WS_HX), (const char*)(F.ws + WS_YC), (const char*)(F.ws + W_GATE), (const char*)(F.ws + W_BR), nM, F.G, F.bx};
            EpiMerge E{F.ws + WS_MSCR + (size_t)F.bx * 262144, F.in[I_BGATE] + l * 4096, (bf16_t*)(F.ws + WS_ACCM)};
            gg::gemm_phase(F.lds, S, E);
        }
        SEAM(ph); ++ph;
        if (SITE(7) && RUN(ph)) { const Frame F = phase_frame(F0);
            SchedPlain S{(const char*)(F.ws + WS_ACCM), (const char*)(F.ws + W_OUT), 2048u, 2048u, 16, nM, 4, F.G, F.bx};
            EpiWout E{l == 0 ? F.in[I_X] : (const float*)F.out, F.out, F.in[I_CTX], (float*)(F.ws + WS_CTXS), modp(F, l, 0, 2)};
            gg::gemm_phase(F.lds, S, E);
        }
        SEAM(ph); ++ph;
        if (SITE(8) && RUN(ph)) { const Frame F = phase_frame(F0); ph_norm2_route(F, l, ntok); }
        SEAM(ph); ++ph;
        for (int c = 0; c < 2; ++c) {

            if (SITE(9) && RUN(ph)) { const Frame F = phase_frame(F0); ph_assign(F, c, ntok); }
            SEAM(ph); ++ph;
            if (SITE(10) && RUN(ph)) { const Frame F = phase_frame(F0);
                int* tile_e = (int*)(F.ws + T_TILEE) + c * 1024; const int ntiles = ld_i32_uniform(tile_e + 1023);
                SchedMoe1 S{(const char*)(F.ws + WS_HX), (const char*)(F.ws + W_13), (const int*)(F.ws + T_RTOK), tile_e, ntiles, F.G, F.bx};
                EpiMoe1 E{(bf16_t*)(F.ws + WS_AMOE), (const float*)(F.ws + T_RW)};
                gg::gemm_phase(F.lds, S, E);
            }
            SEAM(ph); ++ph;
            if (SITE(11) && RUN(ph)) { const Frame F = phase_frame(F0);
                int* tile_e = (int*)(F.ws + T_TILEE) + c * 1024; const int ntiles = ld_i32_uniform(tile_e + 1023);
                SchedMoe2 S{(const char*)(F.ws + WS_AMOE), (const char*)(F.ws + W_2), tile_e, ntiles, F.G, F.bx};
                EpiBf16Plain E{(bf16_t*)(F.ws + WS_YS), 1024};
                gg::gemm_phase(F.lds, S, E);
            }
            SEAM(ph); ++ph;
            if (SITE(12) && RUN(ph)) { const Frame F = phase_frame(F0); ph_combine(F, l, c, ntok); }
            SEAM(ph); ++ph;
        }
    }
#undef RUN
#undef SEAM
}

extern "C" void kernel_launch(void* const* d_in, const int* in_sizes, int n_in, void* d_out, int out_size, void* d_ws, size_t ws_size, hipStream_t stream) {
    static int grid = 0;
    if (grid == 0) {
        if (n_in != 33 || out_size != NLAT * DM || ws_size < WS_END) { fprintf(stderr, "kernel_launch: unexpected shapes (n_in %d, out %d, ws %zu < %zu)\n", n_in, out_size, ws_size, (size_t)WS_END); grid = -1; return; }
        int dev = 0, cus = 0;
        if (hipGetDevice(&dev) != hipSuccess || hipDeviceGetAttribute(&cus, hipDeviceAttributeMultiprocessorCount, dev) != hipSuccess) { grid = -1; return; }
        if (hipFuncSetAttribute((const void*)mk_fwd, hipFuncAttributeMaxDynamicSharedMemorySize, LDS_BYTES) != hipSuccess) { fprintf(stderr, "kernel_launch: hipFuncSetAttribute failed\n"); grid = -1; return; }
        int per_cu = 0;
        if (hipOccupancyMaxActiveBlocksPerMultiprocessor(&per_cu, (const void*)mk_fwd, NTHR, LDS_BYTES) != hipSuccess || per_cu < 1) fprintf(stderr, "kernel_launch: occupancy query says %d\n", per_cu);
        (void)hipGetLastError();
        grid = cus;
    }
    if (grid < 0) return;
    (void)hipMemsetAsync((char*)d_ws + WS_CTL, 0, CTL_ZERO_BYTES, stream);
    Params p{};
    for (int i = 0; i < 33; ++i) p.in[i] = (const float*)d_in[i];
    p.out = (float*)d_out; p.ws = (unsigned char*)d_ws;
#if MK_ONE_LAUNCH
    p.ph_lo = 0; p.ph_hi = PH_TOTAL;
    hipLaunchKernelGGL(mk_fwd, dim3(grid), dim3(NTHR), LDS_BYTES, stream, p);
#else
    for (int k = 0; k < PH_TOTAL; ++k) { p.ph_lo = k; p.ph_hi = k + 1; hipLaunchKernelGGL(mk_fwd, dim3(grid), dim3(NTHR), LDS_BYTES, stream, p); }
#endif
}
```

```cpp
#include <hip/hip_runtime.h>
#include <stdint.h>
#include <stdio.h>
#include <math.h>

#ifndef MK_ONE_LAUNCH
#define MK_ONE_LAUNCH 1
#endif

#define LAS __attribute__((address_space(3)))
#define GAS __attribute__((address_space(1)))
typedef unsigned short bf16_t;
typedef short bf16x8 __attribute__((ext_vector_type(8)));
typedef short s16x4 __attribute__((ext_vector_type(4)));
typedef float f32x2 __attribute__((ext_vector_type(2)));
typedef float f32x4 __attribute__((ext_vector_type(4)));
typedef float f32x16 __attribute__((ext_vector_type(16)));
typedef unsigned u32x2 __attribute__((ext_vector_type(2)));
typedef unsigned u32x4 __attribute__((ext_vector_type(4)));

constexpr int DM = 1024, NB = 8, SEQ = 8192, CTXL = 256, GRIDW = 64;
constexpr int NLAT = NB * SEQ, NCTX = NB * CTXL, NTOK = NLAT + NCTX;
constexpr int INC = 2480, INCP = 2560;
constexpr int C_ML = 0, C_G = 1024, C_MLA = 1040, C_POOL = 1456, C_CONV = 1712;
constexpr int NE = 64, NE1 = 65, TOPK = 6, NSLOT7 = 7, EFF = 256;
constexpr int NCHK = 66;
constexpr int NKT = 132;
constexpr float EPS = 1e-6f;
constexpr int NWAVES = 8, NTHR = 512;
constexpr int MOE_ROWS_MAX = 253184;
constexpr int MOE_TILES_MAX = MOE_ROWS_MAX / 256;

constexpr size_t MiB = 1u << 20;
constexpr size_t WS_CTL = 0, CTL_ZERO_BYTES = 1 * MiB;
constexpr size_t WS_MOD = 128 * 1024;
constexpr size_t WS_TAB = 1 * MiB;
constexpr size_t T_ROPE = WS_TAB;
constexpr size_t T_HIST = T_ROPE + 16384;
constexpr size_t T_TILEE = T_HIST + 65536;
constexpr size_t T_EIDX = T_TILEE + 8192;
constexpr size_t T_EW = T_EIDX + (size_t)NTOK * 6 * 4;
constexpr size_t T_SLOT = T_EW + (size_t)NTOK * 6 * 4;
constexpr size_t T_RTOK = T_SLOT + (size_t)NTOK * 8 * 4;
constexpr size_t T_RW = T_RTOK + (size_t)MOE_ROWS_MAX * 4;
constexpr size_t T_GATE = T_RW + (size_t)MOE_ROWS_MAX * 4;
constexpr size_t T_DN = T_GATE + (size_t)NTOK * 16 * 4;
constexpr size_t T_NST = T_DN + (size_t)4224 * 64 * 4;
constexpr size_t T_MLOC = T_NST + (size_t)4224 * 64 * 4;
constexpr size_t T_BEND = T_MLOC + 4224 * 4;
constexpr size_t T_MST = T_BEND + 4224 * 4;
constexpr size_t T_END = T_MST + 4224 * 4;
static_assert(T_END <= 17 * MiB, "tables");
constexpr size_t WS_WB = 17 * MiB;
constexpr size_t W_IN = WS_WB;
constexpr size_t W_GATE = W_IN + (size_t)INCP * 1024 * 2;
constexpr size_t W_BR = W_GATE + (size_t)4 * 1024 * 1024 * 2;
constexpr size_t W_OUT = W_BR + (size_t)4 * 1024 * 256 * 2;
constexpr size_t W_13 = W_OUT + (size_t)1024 * 1024 * 2;
constexpr size_t W_2 = W_13 + (size_t)NE1 * 512 * 1024 * 2;
constexpr size_t W_UQ = W_2 + (size_t)NE1 * 1024 * 256 * 2;
constexpr size_t W_UKV = W_UQ + (size_t)384 * 256 * 2;
constexpr size_t W_POOL = W_UKV + (size_t)512 * 128 * 2;
constexpr size_t W_RT = W_POOL + (size_t)4 * 64 * 64 * 2;
constexpr size_t W_END = W_RT + (size_t)64 * 1024 * 2;
static_assert(W_END <= 133 * MiB, "weights");
constexpr size_t WS_CTXS = 133 * MiB;
constexpr size_t WS_HX = 141 * MiB;
constexpr size_t WS_PX = 273 * MiB;
constexpr size_t WS_QB = 593 * MiB;
constexpr size_t WS_KT = 643 * MiB;
constexpr size_t WS_VT = 693 * MiB;
constexpr size_t WS_YC = 726 * MiB;
constexpr size_t WS_DC = 858 * MiB;
constexpr size_t WS_CST = 924 * MiB;
constexpr size_t WS_HX8 = 957 * MiB;
constexpr size_t WS_END = 1023 * MiB;
constexpr size_t WS_ACCM = WS_QB;
constexpr size_t WS_YB = WS_PX;
constexpr size_t WS_AMOE = WS_PX;
constexpr size_t WS_YS = WS_PX + 124 * MiB;
static_assert(WS_YS + (size_t)MOE_ROWS_MAX * 2048 <= WS_END, "moe overlay");
static_assert(WS_YB + (size_t)33792 * 4096 * 2 <= WS_QB && WS_ACCM + (size_t)NTOK * 2048 <= WS_YC, "merge overlay");

constexpr int CW_BAR = 4096;

constexpr int RING_BYTES = 131072;
constexpr int MISC_OFF = 160 * 1024 - 256;
constexpr int LDS_BYTES = 160 * 1024;

__device__ __forceinline__ unsigned f2bf(float f) { unsigned u = __builtin_bit_cast(unsigned, f); return (u + 0x7fffu + ((u >> 16) & 1u)) >> 16; }
__device__ __forceinline__ unsigned pk2(float lo, float hi) { return f2bf(lo) | (f2bf(hi) << 16); }
__device__ __forceinline__ float bf2f(unsigned short b) { return __builtin_bit_cast(float, ((unsigned)b) << 16); }
__device__ __forceinline__ float bflo(unsigned w) { return __builtin_bit_cast(float, w << 16); }
__device__ __forceinline__ float bfhi(unsigned w) { return __builtin_bit_cast(float, w & 0xffff0000u); }
__device__ __forceinline__ unsigned cvt_pk_bf16(float lo, float hi) { unsigned r; asm volatile("v_cvt_pk_bf16_f32 %0, %1, %2" : "=v"(r) : "v"(lo), "v"(hi)); return r; }
__device__ __forceinline__ unsigned pk4_fp8(float a, float b, float c, float d) { int r = __builtin_amdgcn_cvt_pk_fp8_f32(a, b, 0, false); r = __builtin_amdgcn_cvt_pk_fp8_f32(c, d, r, true); return (unsigned)r; }
__device__ __forceinline__ float sigmoidf_(float x) { return 1.0f / (1.0f + __expf(-x)); }
template <int O> __device__ __forceinline__ float xor_lane(float v) { return __builtin_bit_cast(float, __builtin_amdgcn_ds_swizzle(__builtin_bit_cast(int, v), 0x1f | (O << 10))); }
__device__ __forceinline__ float half_sum(float v) { v += xor_lane<1>(v); v += xor_lane<2>(v); v += xor_lane<4>(v); v += xor_lane<8>(v); v += xor_lane<16>(v); return v; }
__device__ __forceinline__ float half_max(float v) { v = fmaxf(v, xor_lane<1>(v)); v = fmaxf(v, xor_lane<2>(v)); v = fmaxf(v, xor_lane<4>(v)); v = fmaxf(v, xor_lane<8>(v)); v = fmaxf(v, xor_lane<16>(v)); return v; }
__device__ __forceinline__ float wave_sum(float v) { v = half_sum(v); auto rr = __builtin_amdgcn_permlane32_swap(__builtin_bit_cast(unsigned, v), __builtin_bit_cast(unsigned, v), false, false);
    return __builtin_bit_cast(float, (unsigned)rr[0]) + __builtin_bit_cast(float, (unsigned)rr[1]); }
__device__ __forceinline__ float wave_max(float v) { v = half_max(v); auto rr = __builtin_amdgcn_permlane32_swap(__builtin_bit_cast(unsigned, v), __builtin_bit_cast(unsigned, v), false, false);
    return fmaxf(__builtin_bit_cast(float, (unsigned)rr[0]), __builtin_bit_cast(float, (unsigned)rr[1])); }
__device__ __forceinline__ float lane_up(float v, int o, int lane) { return __builtin_bit_cast(float, __builtin_amdgcn_ds_bpermute(((lane - o) & 63) << 2, __builtin_bit_cast(int, v))); }
__device__ __forceinline__ float lane_bcast(float v, int src) { return __builtin_bit_cast(float, __builtin_amdgcn_readlane(__builtin_bit_cast(int, v), src)); }
#define LDS_WAIT() asm volatile("s_waitcnt lgkmcnt(0)" ::: "memory")
#define VM_WAIT() asm volatile("s_waitcnt vmcnt(0)" ::: "memory")

#define XB_TMO      128
#define XB_XCNT(j)  (256  + 64 * (j))
#define XB_XSUB(j)  (1280 + 64 * (j))
#define XB_XGEN(j)  (2304 + 64 * (j))
#define XB_TOP      3328
#define XB_TOPGEN   3392
#define XCD_BAR_WORDS 3456
#define XB_SPIN_CAP (1u << 22)

__device__ __forceinline__ unsigned xb_ld(unsigned* p)              { return __hip_atomic_load(p, __ATOMIC_RELAXED, __HIP_MEMORY_SCOPE_AGENT); }
__device__ __forceinline__ unsigned xb_add(unsigned* p, unsigned v) { return __hip_atomic_fetch_add(p, v, __ATOMIC_RELAXED, __HIP_MEMORY_SCOPE_AGENT); }
__device__ __forceinline__ unsigned xb_xcc_id() { return (unsigned)__builtin_amdgcn_s_getreg((3 << 11) | 20) & 0xFu; }
#define XB_SPIN(cond, bar) do { unsigned _sp = 0; while (cond) { __builtin_amdgcn_s_sleep(1); \
    if ((++_sp & 255u) == 0u) { if (xb_ld(&(bar)[XB_TMO])) break; if (_sp > XB_SPIN_CAP) { atomicAdd(&(bar)[XB_TMO], 1u); break; } } } } while (0)

struct XcdBarrier { unsigned* bar; unsigned x; volatile LAS unsigned* st; };

__device__ __forceinline__ XcdBarrier xcd_barrier_post(unsigned* bar, volatile LAS unsigned* st) {
    XcdBarrier b; b.bar = bar; b.x = xb_xcc_id(); b.st = st;
    if (threadIdx.x == 0) (void)xb_add(&bar[XB_XCNT(b.x)], 1u);
    return b;
}
__device__ __forceinline__ void xcd_barrier_complete(unsigned* bar, unsigned x, unsigned& nloc, unsigned& nx) {
    const unsigned G = gridDim.x * gridDim.y * gridDim.z;
    unsigned sum, cnt, mine, sp = 0u;
    for (;;) {
        sum = 0u; cnt = 0u; mine = 0u;
#pragma unroll
        for (unsigned j = 0; j < 16; ++j) { const unsigned c = xb_ld(&bar[XB_XCNT(j)]); sum += c; cnt += (c > 0u) ? 1u : 0u; mine = (j == x) ? c : mine; }
        if (sum == G) break;
        __builtin_amdgcn_s_sleep(1);
        if ((++sp & 255u) == 0u) { if (xb_ld(&bar[XB_TMO])) break; if (sp > XB_SPIN_CAP) { atomicAdd(&bar[XB_TMO], 1u); break; } }
    }
    nloc = mine > 0u ? mine : 1u; nx = cnt > 0u ? cnt : 1u;
}
__device__ __forceinline__ void xcd_barrier(const XcdBarrier& b) {
    asm volatile("s_waitcnt vmcnt(0)" ::: "memory");
    __syncthreads();
    if (threadIdx.x == 0) {
        unsigned* bar = b.bar;
        __builtin_amdgcn_s_waitcnt(0);
        unsigned nloc = b.st[0], nx = b.st[1];
        if (nloc == 0u) { xcd_barrier_complete(bar, b.x, nloc, nx); b.st[0] = nloc; b.st[1] = nx; }
        const unsigned old = xb_add(&bar[XB_XSUB(b.x)], 1u);
        const unsigned gen = old / nloc;
        if (old + 1u == (gen + 1u) * nloc) {
            __builtin_amdgcn_fence(__ATOMIC_RELEASE, "agent");
            asm volatile("s_waitcnt vmcnt(0)" ::: "memory");
            const unsigned og = xb_add(&bar[XB_TOP], 1u);
            const unsigned tg = og / nx;
            if (og + 1u == (tg + 1u) * nx) xb_add(&bar[XB_TOPGEN], 1u);
            else XB_SPIN(xb_ld(&bar[XB_TOPGEN]) == tg, bar);
            __builtin_amdgcn_fence(__ATOMIC_ACQUIRE, "agent");
            xb_add(&bar[XB_XGEN(b.x)], 1u);
            asm volatile("s_waitcnt vmcnt(0)" ::: "memory");
        } else {
            XB_SPIN(xb_ld(&bar[XB_XGEN(b.x)]) == gen, bar);
            __builtin_amdgcn_fence(__ATOMIC_ACQUIRE, "agent");
            asm volatile("s_waitcnt vmcnt(0)" ::: "memory");
        }
    }
    __syncthreads();
}

struct Params { const float* in[33]; float* out; unsigned char* ws; int ph_lo, ph_hi; };

struct Frame {
    LAS unsigned char* lds;
    unsigned char* ws;
    const float* const* in;
    float* out;
    int tid, lane, wave, bx, G;
};
enum { I_X = 0, I_C, I_CTX, I_CCTX, I_WMOD, I_BMOD, I_GMIX, I_GFFN, I_WIN, I_MLGB, I_MLHG, I_GCQ, I_GCKV, I_WUQ, I_WUKV, I_GQN, I_GKN, I_POOLW, I_POOLS,
       I_CONVW, I_CONVB, I_WGATE, I_BGATE, I_WBR, I_WOUT, I_WRT, I_BRT, I_W1, I_W3, I_W2, I_WS1, I_WS3, I_WS2 };

__device__ __forceinline__ const float* modp(const Frame& F, int l, int r, int which) { return (const float*)(F.ws + WS_MOD) + ((size_t)(l * 9 + r)) * 6144 + which * 1024; }
__device__ __forceinline__ int mod_row_of(int row) { return row < NLAT ? (row >> 13) : 8; }

namespace gg {
typedef int v4i_t __attribute__((ext_vector_type(4)));
constexpr int BM = 256, BK = 64, HALF = 128, HTB = HALF * BK * 2, STAGE_BYTES = 8 * HTB;
__device__ __forceinline__ int lds_byte(int r, int c) { const int st = (r >> 4) * 2 + (c >> 5), rr = r & 15, cc = c & 31, ob = rr * 64 + cc * 2; return st * 1024 + (ob ^ (((ob >> 9) & 1) << 5)); }
__device__ __forceinline__ void stage_rc(int b, int& R, int& C) { const int st = b / 1024, sb = b % 1024, swz = sb ^ (((sb >> 9) & 1) << 5); R = (st >> 1) * 16 + swz / 64; C = (st & 1) * 32 + (swz % 64) / 2; }
__device__ __forceinline__ int perm32(int rho) { const int n = rho >> 4, i = rho & 15; return 8 * (i >> 2) + 4 * n + (i & 3); }

struct Unit {
    const char* A; const char* B;
    unsigned lda, ldb;
    int nt;
    const int* ridx;
    int p0, p1, p2;
};

template <class Epi, class Sched>
__device__ __forceinline__ void gemm_phase(LAS unsigned char* lds, const Sched& S, const Epi& E) {
    int tid_ = threadIdx.x; asm volatile("" : "+v"(tid_));
    const int tid = tid_, wid = __builtin_amdgcn_readfirstlane(tid >> 6), lane = tid & 63, wr = wid >> 2, wc = wid & 3, fr = lane & 15, fq = lane >> 4;
    const size_t kstep = (size_t)(BK * 2);
    const unsigned ldsw = (unsigned)wid * 1024u;
    const int aoff = lds_byte(wr * 64 + fr, fq * 8), boff = lds_byte(wc * 32 + fr, fq * 8);
#define GG_SA(b, h) (((b) * 2 + (h)) * HTB)
#define GG_SB(b, h) ((4 + (b) * 2 + (h)) * HTB)
#define GG_STAGE(bufoff, gbase, v0, v1) do { \
        __builtin_amdgcn_global_load_lds((const unsigned*)((const char*)(gbase) + (v0)), (LAS unsigned*)(lds + (bufoff) + ldsw), 16, 0, 0); \
        __builtin_amdgcn_global_load_lds((const unsigned*)((const char*)(gbase) + (v1)), (LAS unsigned*)(lds + (bufoff) + ldsw + 8192), 16, 0, 0); } while (0)
#define GG_LDA(dst, b, h) do { _Pragma("unroll") for (int m = 0; m < 4; ++m) _Pragma("unroll") for (int k = 0; k < 2; ++k) dst[m][k] = *(const LAS bf16x8*)(lds + GG_SA(b, h) + aoff + m * 2048 + k * 1024); } while (0)
#define GG_LDB(dst, b, h) do { _Pragma("unroll") for (int n = 0; n < 2; ++n) _Pragma("unroll") for (int k = 0; k < 2; ++k) dst[n][k] = *(const LAS bf16x8*)(lds + GG_SB(b, h) + boff + n * 2048 + k * 1024); } while (0)
#define GG_MMA(ai, bj, At, Bt) do { __builtin_amdgcn_s_setprio(1); _Pragma("unroll") for (int m = 0; m < 4; ++m) _Pragma("unroll") for (int n = 0; n < 2; ++n) _Pragma("unroll") for (int k = 0; k < 2; ++k) \
        acc[ai][bj][m][n] = __builtin_amdgcn_mfma_f32_16x16x32_bf16(Bt[n][k], At[m][k], acc[ai][bj][m][n], 0, 0, 0); __builtin_amdgcn_s_setprio(0); } while (0)
#define GG_CAT8(x, y) __builtin_shufflevector(__builtin_bit_cast(v4i_t, x), __builtin_bit_cast(v4i_t, y), 0, 1, 2, 3, 4, 5, 6, 7)
#define GG_MMA8(ai, bj, At, Bt) do { __builtin_amdgcn_s_setprio(1); _Pragma("unroll") for (int m = 0; m < 4; ++m) _Pragma("unroll") for (int n = 0; n < 2; ++n) \
        acc[ai][bj][m][n] = __builtin_amdgcn_mfma_scale_f32_16x16x128_f8f6f4(GG_CAT8(Bt[n][0], Bt[n][1]), GG_CAT8(At[m][0], At[m][1]), acc[ai][bj][m][n], 0, 0, 0, 0x7f7f7f7f, 0, 0x7f7f7f7f); __builtin_amdgcn_s_setprio(0); } while (0)
#define GG_MM(ai, bj, At, Bt) do { if constexpr (Epi::FP8) GG_MMA8(ai, bj, At, Bt); else GG_MMA(ai, bj, At, Bt); } while (0)
#define GG_WAIT_V(n) asm volatile("s_waitcnt vmcnt(" #n ")" ::: "memory")
#define GG_WAIT_L(n) asm volatile("s_waitcnt lgkmcnt(" #n ")" ::: "memory")
#define GG_BAR __builtin_amdgcn_s_barrier()
#define GG_SCHED __builtin_amdgcn_sched_barrier(0)
#define GG_OFFS(u) do { int R0_, C0_, R1_, C1_; stage_rc(tid * 16, R0_, C0_); stage_rc(tid * 16 + 8192, R1_, C1_); \
        if (Sched::GATHER) { vA0 = (unsigned)(u).ridx[R0_] * (u).lda + C0_ * 2; vA1 = (unsigned)(u).ridx[R1_] * (u).lda + C1_ * 2; \
                             vA2 = (unsigned)(u).ridx[128 + R0_] * (u).lda + C0_ * 2; vA3 = (unsigned)(u).ridx[128 + R1_] * (u).lda + C1_ * 2; hA = 0; } \
        else { vA0 = (unsigned)R0_ * (u).lda + C0_ * 2; vA1 = (unsigned)R1_ * (u).lda + C1_ * 2; vA2 = vA0; vA3 = vA1; hA = (size_t)128 * (u).lda; } \
        const int Rb0_ = Epi::PERM ? ((R0_ & ~31) + perm32(R0_ & 31)) : R0_, Rb1_ = Epi::PERM ? ((R1_ & ~31) + perm32(R1_ & 31)) : R1_; \
        vB0 = (unsigned)Rb0_ * (u).ldb + C0_ * 2; vB1 = (unsigned)Rb1_ * (u).ldb + C1_ * 2; hB = (size_t)128 * (u).ldb; } while (0)
    Unit cur, nxt; int ui = 0;
    if (!S.next(0, cur)) return;
    f32x4 acc[2][2][4][2];
#pragma unroll
    for (int a = 0; a < 2; ++a)
#pragma unroll
        for (int b = 0; b < 2; ++b)
#pragma unroll
            for (int m = 0; m < 4; ++m)
#pragma unroll
                for (int n = 0; n < 2; ++n) acc[a][b][m][n] = (f32x4){0.f, 0.f, 0.f, 0.f};
    bf16x8 At[4][2], B0[2][2], B1[2][2];
    unsigned vA0, vA1, vA2, vA3, vB0, vB1; size_t hA, hB;
    GG_OFFS(cur);
    const char* cA = cur.A; const char* cB = cur.B;
    GG_STAGE(GG_SB(0, 0), cB, vB0, vB1); GG_STAGE(GG_SB(0, 1), cB + hB, vB0, vB1); GG_STAGE(GG_SA(0, 0), cA, vA0, vA1); GG_STAGE(GG_SA(0, 1), cA + hA, vA2, vA3);
    if (wr == 1) GG_BAR;
    GG_WAIT_V(2); GG_BAR;
    GG_STAGE(GG_SB(1, 0), cB + kstep, vB0, vB1); GG_STAGE(GG_SA(1, 0), cA + kstep, vA0, vA1); GG_STAGE(GG_SB(1, 1), cB + hB + kstep, vB0, vB1);
    GG_WAIT_V(6); GG_BAR;
    for (;;) {
        const bool has_next = S.next(ui + 1, nxt);
        int nt_ = cur.nt; asm volatile("" : "+s"(nt_)); const int nt = nt_;
#pragma unroll 1
        for (int t = 0; t < nt; t += 2) {
            const bool last = (t == nt - 2);
            const char* a1 = cA + (size_t)(t + 1) * kstep;
            GG_LDB(B0, 0, 0); GG_LDB(B1, 0, 1); GG_SCHED; GG_LDA(At, 0, 0); GG_STAGE(GG_SA(1, 1), a1 + hA, vA2, vA3);
            GG_WAIT_V(8); GG_WAIT_L(0); GG_BAR; GG_MM(0, 0, At, B0); GG_MM(0, 1, At, B1); GG_BAR; GG_SCHED;
            if (last) { if (has_next) { GG_OFFS(nxt); cA = nxt.A - (size_t)nt * kstep; cB = nxt.B - (size_t)nt * kstep; } else { cA -= (size_t)nt * kstep; cB -= (size_t)nt * kstep; } }
            const char* a2 = cA + (size_t)(t + 2) * kstep; const char* b2 = cB + (size_t)(t + 2) * kstep; const char* a3 = a2 + kstep; const char* b3 = b2 + kstep;
            GG_LDA(At, 0, 1); GG_STAGE(GG_SB(0, 0), b2, vB0, vB1); GG_STAGE(GG_SB(0, 1), b2 + hB, vB0, vB1); GG_STAGE(GG_SA(0, 0), a2, vA0, vA1);
            GG_WAIT_V(8); GG_WAIT_L(0); GG_BAR; GG_MM(1, 0, At, B0); GG_MM(1, 1, At, B1); GG_BAR; GG_SCHED;
            GG_LDB(B0, 1, 0); GG_LDB(B1, 1, 1); GG_SCHED; GG_LDA(At, 1, 0); GG_STAGE(GG_SA(0, 1), a2 + hA, vA2, vA3);
            GG_WAIT_V(8); GG_WAIT_L(0); GG_BAR; GG_MM(0, 0, At, B0); GG_MM(0, 1, At, B1); GG_BAR; GG_SCHED;
            GG_LDA(At, 1, 1); GG_STAGE(GG_SB(1, 0), b3, vB0, vB1); GG_STAGE(GG_SB(1, 1), b3 + hB, vB0, vB1); GG_STAGE(GG_SA(1, 0), a3, vA0, vA1);
            GG_WAIT_V(8); GG_WAIT_L(0); GG_BAR; GG_MM(1, 0, At, B0); GG_MM(1, 1, At, B1); GG_BAR; GG_SCHED;
        }
        cA += (size_t)nt * kstep; cB += (size_t)nt * kstep;
        if (wr == 0) GG_BAR;
        E(acc, cur, wr, wc, fr, fq);
        if (!has_next) break;
#pragma unroll
        for (int a = 0; a < 2; ++a)
#pragma unroll
            for (int b = 0; b < 2; ++b)
#pragma unroll
                for (int m = 0; m < 4; ++m)
#pragma unroll
                    for (int n = 0; n < 2; ++n) acc[a][b][m][n] = (f32x4){0.f, 0.f, 0.f, 0.f};
        cur = nxt; ++ui;
        if (wr == 1) GG_BAR;
    }
    GG_WAIT_V(0);
    GG_BAR;
#undef GG_SA
#undef GG_SB
#undef GG_STAGE
#undef GG_LDA
#undef GG_LDB
#undef GG_MMA
#undef GG_MMA8
#undef GG_MM
#undef GG_CAT8
#undef GG_WAIT_V
#undef GG_WAIT_L
#undef GG_BAR
#undef GG_SCHED
#undef GG_OFFS
}
}

__device__ __forceinline__ int ld_i32_uniform(const int* p) { return __builtin_amdgcn_readfirstlane(__hip_atomic_load(p, __ATOMIC_RELAXED, __HIP_MEMORY_SCOPE_AGENT)); }
__device__ __forceinline__ void tile_order(int L, int nM, int nN, int& pm, int& pn) {
    const int nwg = nM * nN; int wgid = L;
    { const int q = nwg / 8, r = nwg % 8, xcd = wgid % 8, off = wgid / 8; wgid = (xcd < r ? xcd * (q + 1) : r * (q + 1) + (xcd - r) * q) + off; }
    const int nig = 8 * nN, gid = wgid / nig, fm = gid * 8, gsz = (nM - fm) < 8 ? (nM - fm) : 8;
    pm = fm + ((wgid % nig) % gsz); pn = (wgid % nig) / gsz;
}
struct SchedPlain {
    static constexpr bool GATHER = false;
    const char* A; const char* B; unsigned lda, ldb; int nt, nM, nN, G, c;
    __device__ __forceinline__ bool next(int i, gg::Unit& u) const {
        const int L = i * G + c; if (L >= nM * nN) return false;
        int pm, pn; tile_order(L, nM, nN, pm, pn);
        u.A = A + (size_t)pm * 256 * lda; u.B = B + (size_t)pn * 256 * ldb; u.lda = lda; u.ldb = ldb; u.nt = nt; u.ridx = nullptr; u.p0 = pm; u.p1 = pn; u.p2 = 0; return true;
    }
};
struct EpiWin {
    static constexpr bool PERM = true, FP8 = false;
    bf16_t* px; float* gate;
    __device__ __forceinline__ void operator()(const f32x4 (&acc)[2][2][4][2], const gg::Unit& u, int wr, int wc, int fr, int fq) const {
        const int row0 = u.p0 * 256 + wr * 64 + fr;
#pragma unroll
        for (int bj = 0; bj < 2; ++bj) {
            const int c0 = u.p1 * 256 + bj * 128 + wc * 32 + 8 * fq;
            if (c0 < INC) {
                const bool isg = (c0 >= C_G && c0 < C_MLA);
#pragma unroll
                for (int ai = 0; ai < 2; ++ai)
#pragma unroll
                    for (int m = 0; m < 4; ++m) { const int row = row0 + ai * 128 + m * 16; const f32x4 v0 = acc[ai][bj][m][0], v1 = acc[ai][bj][m][1];
                        u32x4 w; w.x = cvt_pk_bf16(v0[0], v0[1]); w.y = cvt_pk_bf16(v0[2], v0[3]); w.z = cvt_pk_bf16(v1[0], v1[1]); w.w = cvt_pk_bf16(v1[2], v1[3]);
                        *(u32x4*)(px + (size_t)row * INC + c0) = w;
                        if (isg) { float* gp = gate + (size_t)row * 16 + (c0 - C_G); *(f32x4*)gp = v0; *(f32x4*)(gp + 4) = v1; } }
            }
        }
    }
};
struct SchedYB {
    static constexpr bool GATHER = false;
    const char* yc; const char* wb; int pm0, nMh, G, c;
    __device__ __forceinline__ bool next(int i, gg::Unit& u) const {
        const int L = i * G + c; if (L >= nMh * 16) return false;
        int pm, q; tile_order(L, nMh, 16, pm, q); const int br = q >> 2, pn = q & 3;
        u.A = yc + (size_t)(pm0 + pm) * 256 * 2048 + br * 512; u.lda = 2048; u.B = wb + (size_t)br * (1024 * 512) + (size_t)pn * 256 * 512; u.ldb = 512; u.nt = 4; u.ridx = nullptr; u.p0 = pm; u.p1 = q; u.p2 = 0; return true;
    }
};
struct EpiMerge2 {
    static constexpr bool PERM = false, FP8 = true;
    const bf16_t* yb; const float* bgate; bf16_t* accm; int pm0;
    __device__ __forceinline__ void operator()(const f32x4 (&acc)[2][2][4][2], const gg::Unit& u, int wr, int wc, int fr, int fq) const {
        const int c = u.p1 * 64 + 16 * wc + 4 * fq, r0 = wr * 64 + fr;
        f32x4 bv[2][2];
#pragma unroll
        for (int bj = 0; bj < 2; ++bj)
#pragma unroll
            for (int n = 0; n < 2; ++n) bv[bj][n] = *(const f32x4*)(bgate + (2 * bj + n) * 1024 + c);
#pragma unroll
        for (int ai = 0; ai < 2; ++ai) {
#pragma unroll
            for (int m = 0; m < 4; ++m) { const int rl = (u.p0 - pm0) * 256 + r0 + ai * 128 + m * 16; const bf16_t* yr = yb + (size_t)rl * 4096 + c;
                f32x4 t = {0.f, 0.f, 0.f, 0.f};
#pragma unroll
                for (int bj = 0; bj < 2; ++bj)
#pragma unroll
                    for (int n = 0; n < 2; ++n) { const u32x2 w = *(const u32x2*)(yr + (2 * bj + n) * 1024); const f32x4 g = acc[ai][bj][m][n] * (1.0f / 64.0f) + bv[bj][n];
                        t[0] += sigmoidf_(g[0]) * bflo(w.x); t[1] += sigmoidf_(g[1]) * bfhi(w.x); t[2] += sigmoidf_(g[2]) * bflo(w.y); t[3] += sigmoidf_(g[3]) * bfhi(w.y); }
                *(u32x2*)(accm + (size_t)(u.p0 * 256 + r0 + ai * 128 + m * 16) * 1024 + c) = (u32x2){cvt_pk_bf16(t[0], t[1]), cvt_pk_bf16(t[2], t[3])}; } }
    }
};
struct EpiWout {
    static constexpr bool PERM = true, FP8 = false;
    bf16_t* mrg; const float* gt;
    __device__ __forceinline__ void operator()(const f32x4 (&acc)[2][2][4][2], const gg::Unit& u, int wr, int wc, int fr, int fq) const {
        const int pm = u.p0; const int mrow = pm >= 256 ? 8 : (pm >> 5);
        const float* g = gt + (size_t)mrow * 6144;
        const int row0 = pm * 256 + wr * 64 + fr, col0 = u.p1 * 256 + wc * 32 + 8 * fq;
#pragma unroll
        for (int bj = 0; bj < 2; ++bj) { const f32x4 g0 = *(const f32x4*)(g + col0 + bj * 128), g1 = *(const f32x4*)(g + col0 + bj * 128 + 4);
#pragma unroll
            for (int ai = 0; ai < 2; ++ai)
#pragma unroll
                for (int m = 0; m < 4; ++m) { const f32x4 v0 = acc[ai][bj][m][0] * g0, v1 = acc[ai][bj][m][1] * g1;
                    u32x4 w; w.x = cvt_pk_bf16(v0[0], v0[1]); w.y = cvt_pk_bf16(v0[2], v0[3]); w.z = cvt_pk_bf16(v1[0], v1[1]); w.w = cvt_pk_bf16(v1[2], v1[3]);
                    *(u32x4*)(mrg + (size_t)(row0 + ai * 128 + m * 16) * 1024 + col0 + bj * 128) = w; } }
    }
};
struct SchedMoe1 {
    static constexpr bool GATHER = true;
    const char* hx2; const char* w13; const int* rtok; const int* tile_e; int ntiles, G, c;
    __device__ __forceinline__ bool next(int i, gg::Unit& u) const {
        const int L = i * G + c; if (L >= ntiles * 2) return false;
        const int tile = L >> 1, pn = L & 1, e = ld_i32_uniform(tile_e + tile);
        u.A = hx2; u.lda = 1024; u.ridx = rtok + tile * 256; u.B = w13 + (size_t)e * (512 * 1024) + (size_t)pn * 256 * 1024; u.ldb = 1024; u.nt = 8; u.p0 = tile; u.p1 = pn; u.p2 = e; return true;
    }
};
struct EpiMoe1 {
    static constexpr bool PERM = true, FP8 = true;
    bf16_t* a; const float* roww;
    __device__ __forceinline__ void operator()(const f32x4 (&acc)[2][2][4][2], const gg::Unit& u, int wr, int wc, int fr, int fq) const {
        const int row0 = u.p0 * 256 + wr * 64 + fr, col = u.p1 * 128 + wc * 32 + 8 * fq;
#pragma unroll
        for (int ai = 0; ai < 2; ++ai)
#pragma unroll
            for (int m = 0; m < 4; ++m) { const int row = row0 + ai * 128 + m * 16; const float rw = roww[row];
                float t[8];
#pragma unroll
                for (int n = 0; n < 2; ++n)
#pragma unroll
                    for (int j = 0; j < 4; ++j) { const float g1 = acc[ai][0][m][n][j] * (1.0f / 64.0f), g3 = acc[ai][1][m][n][j] * (1.0f / 64.0f); t[n * 4 + j] = g1 * sigmoidf_(g1) * g3 * rw; }
                u32x4 w; w.x = cvt_pk_bf16(t[0], t[1]); w.y = cvt_pk_bf16(t[2], t[3]); w.z = cvt_pk_bf16(t[4], t[5]); w.w = cvt_pk_bf16(t[6], t[7]);
                *(u32x4*)(a + (size_t)row * 256 + col) = w; }
    }
};
struct SchedMoe2 {
    static constexpr bool GATHER = false;
    const char* a; const char* w2; const int* tile_e; int ntiles, G, c;
    __device__ __forceinline__ bool next(int i, gg::Unit& u) const {
        const int L = i * G + c; if (L >= ntiles * 4) return false;
        const int tile = L >> 2, pn = L & 3, e = ld_i32_uniform(tile_e + tile);
        u.A = a + (size_t)tile * 256 * 512; u.lda = 512; u.ridx = nullptr; u.B = w2 + (size_t)e * (1024 * 512) + (size_t)pn * 256 * 512; u.ldb = 512; u.nt = 4; u.p0 = tile; u.p1 = pn; u.p2 = e; return true;
    }
};
struct EpiBf16Plain {
    static constexpr bool PERM = true, FP8 = false;
    bf16_t* O; int ldc;
    __device__ __forceinline__ void operator()(const f32x4 (&acc)[2][2][4][2], const gg::Unit& u, int wr, int wc, int fr, int fq) const {
        const int row0 = u.p0 * 256 + wr * 64 + fr, col0 = u.p1 * 256 + wc * 32 + 8 * fq;
#pragma unroll
        for (int ai = 0; ai < 2; ++ai)
#pragma unroll
            for (int m = 0; m < 4; ++m)
#pragma unroll
                for (int bj = 0; bj < 2; ++bj) { const f32x4 v0 = acc[ai][bj][m][0], v1 = acc[ai][bj][m][1];
                    u32x4 w; w.x = cvt_pk_bf16(v0[0], v0[1]); w.y = cvt_pk_bf16(v0[2], v0[3]); w.z = cvt_pk_bf16(v1[0], v1[1]); w.w = cvt_pk_bf16(v1[2], v1[3]);
                    *(u32x4*)(O + (size_t)(row0 + ai * 128 + m * 16) * ldc + col0 + bj * 128) = w; }
    }
};
struct EpiBf16F8 {
    static constexpr bool PERM = true, FP8 = true;
    bf16_t* O; int ldc; float scale;
    __device__ __forceinline__ void operator()(const f32x4 (&acc)[2][2][4][2], const gg::Unit& u, int wr, int wc, int fr, int fq) const {
        const int row0 = u.p0 * 256 + wr * 64 + fr, col0 = u.p1 * 256 + wc * 32 + 8 * fq;
#pragma unroll
        for (int ai = 0; ai < 2; ++ai)
#pragma unroll
            for (int m = 0; m < 4; ++m)
#pragma unroll
                for (int bj = 0; bj < 2; ++bj) { const f32x4 v0 = acc[ai][bj][m][0] * scale, v1 = acc[ai][bj][m][1] * scale;
                    u32x4 w; w.x = cvt_pk_bf16(v0[0], v0[1]); w.y = cvt_pk_bf16(v0[2], v0[3]); w.z = cvt_pk_bf16(v1[0], v1[1]); w.w = cvt_pk_bf16(v1[2], v1[3]);
                    *(u32x4*)(O + (size_t)(row0 + ai * 128 + m * 16) * ldc + col0 + bj * 128) = w; }
    }
};

__device__ __forceinline__ int crow(int r, int hi) { return (r & 3) + 8 * (r >> 2) + 4 * hi; }
__device__ __forceinline__ f32x16 mma32_ll(f32x16 acc, const LAS bf16_t* A, int lda, const LAS bf16_t* B, int ldb, int ksteps, int lane) {
    const int r32 = lane & 31, hi = lane >> 5;
    for (int ks = 0; ks < ksteps; ++ks) {
        const bf16x8 a = *(const LAS bf16x8*)(A + r32 * lda + ks * 16 + hi * 8);
        const bf16x8 b = *(const LAS bf16x8*)(B + r32 * ldb + ks * 16 + hi * 8);
        acc = __builtin_amdgcn_mfma_f32_32x32x16_bf16(a, b, acc, 0, 0, 0);
    }
    return acc;
}
template <int KS> __device__ __forceinline__ f32x16 mma32_lg(f32x16 acc, const LAS bf16_t* A, int lda, const bf16_t* B, int ldb, int lane) {
    const int r32 = lane & 31, hi = lane >> 5;
    bf16x8 b[KS];
#pragma unroll
    for (int ks = 0; ks < KS; ++ks) b[ks] = *(const bf16x8*)(B + (size_t)r32 * ldb + ks * 16 + hi * 8);
#pragma unroll
    for (int ks = 0; ks < KS; ++ks) { const bf16x8 a = *(const LAS bf16x8*)(A + r32 * lda + ks * 16 + hi * 8); acc = __builtin_amdgcn_mfma_f32_32x32x16_bf16(a, b[ks], acc, 0, 0, 0); }
    return acc;
}

__device__ __forceinline__ void ph_pre(const Frame& F) {
    LAS float* sv = (LAS float*)F.lds;
    LAS float* part = sv + 9 * 1024;
    float* mod = (float*)(F.ws + WS_MOD);
    for (int i = F.tid; i < 9 * 1024; i += NTHR) { const int r = i >> 10, k = i & 1023; const float c = (r < 8) ? F.in[I_C][r * 1024 + k] : F.in[I_CCTX][k]; sv[i] = c * sigmoidf_(c); }
    __syncthreads();
    for (int it = F.bx; it < 2 * 96; it += F.G) {
        const int l = it / 96, jc = it % 96, j = jc * 64 + F.lane, k0 = F.wave * 128;
        const float* w = F.in[I_WMOD] + ((size_t)l * 1024 + k0) * 6144 + j;
        float a[9];
#pragma unroll
        for (int r = 0; r < 9; ++r) a[r] = 0.f;
#pragma unroll 4
        for (int k = 0; k < 128; ++k) { const float wv = w[(size_t)k * 6144];
#pragma unroll
            for (int r = 0; r < 9; ++r) a[r] += sv[r * 1024 + k0 + k] * wv; }
#pragma unroll
        for (int r = 0; r < 9; ++r) part[(F.wave * 9 + r) * 64 + F.lane] = a[r];
        __syncthreads();
        for (int i = F.tid; i < 9 * 64; i += NTHR) { const int r = i >> 6, jj = i & 63; float s = F.in[I_BMOD][l * 6144 + jc * 64 + jj];
#pragma unroll
            for (int w8 = 0; w8 < 8; ++w8) s += part[(w8 * 9 + r) * 64 + jj];
            mod[((size_t)(l * 9 + r)) * 6144 + jc * 64 + jj] = s; }
        __syncthreads();
    }
    if (F.bx == F.G - 1) {
        float* rt = (float*)(F.ws + T_ROPE);
        for (int i = F.tid; i < 1024; i += NTHR) { const int pos = i >> 3, f = i & 7; const float inv = powf(10000.0f, -(float)f / 8.0f); const float ang = (float)pos * inv; rt[2 * i] = cosf(ang); rt[2 * i + 1] = sinf(ang); }
    }
}

struct ConvCursor { int base; int gw, ngw; };
__device__ __forceinline__ void conv_mat(const Frame& F, ConvCursor& cc, const float* src, int K, int N, bf16_t* dst, int ldd, int rbase, int rstep, int nbatch, size_t sbs, size_t dbs, int rq = 128, bool gperm = false, float f8scale = 0.f) {
    const int ktl = K / 64, ntl = (N + 127) / 128, per = ktl * ntl, total = per * nbatch;
    int t = cc.base + ((cc.gw - cc.base) % cc.ngw + cc.ngw) % cc.ngw;
    for (; t < cc.base + total; t += cc.ngw) {
        const int li = t - cc.base, bt = li / per, rem = li % per, kb = rem / ntl, nb = rem % ntl, k0 = kb * 64, n = nb * 128 + 2 * F.lane;
        if (n < N) {
            const float* s = src + bt * sbs + (size_t)k0 * N + n; bf16_t* d = dst + bt * dbs;
            f32x2 v[64];
#pragma unroll
            for (int i = 0; i < 64; ++i) v[i] = *(const f32x2*)(s + (size_t)i * N);
#pragma unroll
            for (int q = 0; q < 2; ++q) { const int nn = n + q; const int drow = gperm ? ((nn >> 6) * 256 + ((nn >> 4) & 3) * 32 + (nn & 15) + 128 * (bt >> 1) + 16 * (bt & 1)) : (rbase + (nn / rq) * rstep + (nn % rq));
                if (f8scale != 0.f) { unsigned char* d8 = (unsigned char*)dst + bt * dbs + (size_t)drow * ldd + k0;
#pragma unroll
                    for (int p = 0; p < 4; ++p) { u32x4 o; o.x = pk4_fp8(v[16 * p][q] * f8scale, v[16 * p + 1][q] * f8scale, v[16 * p + 2][q] * f8scale, v[16 * p + 3][q] * f8scale);
                        o.y = pk4_fp8(v[16 * p + 4][q] * f8scale, v[16 * p + 5][q] * f8scale, v[16 * p + 6][q] * f8scale, v[16 * p + 7][q] * f8scale);
                        o.z = pk4_fp8(v[16 * p + 8][q] * f8scale, v[16 * p + 9][q] * f8scale, v[16 * p + 10][q] * f8scale, v[16 * p + 11][q] * f8scale);
                        o.w = pk4_fp8(v[16 * p + 12][q] * f8scale, v[16 * p + 13][q] * f8scale, v[16 * p + 14][q] * f8scale, v[16 * p + 15][q] * f8scale);
                        *(u32x4*)(d8 + 16 * p) = o; }
                    continue; }
                bf16_t* dr = d + (size_t)drow * ldd + k0;
#pragma unroll
                for (int p = 0; p < 8; ++p) { u32x4 o; o.x = pk2(v[8 * p][q], v[8 * p + 1][q]); o.y = pk2(v[8 * p + 2][q], v[8 * p + 3][q]); o.z = pk2(v[8 * p + 4][q], v[8 * p + 5][q]); o.w = pk2(v[8 * p + 6][q], v[8 * p + 7][q]);
                    *(u32x4*)(dr + 8 * p) = o; } }
        }
    }
    cc.base += total;
}
__device__ __forceinline__ void ph_convert(const Frame& F, int l) {
    ConvCursor cc; cc.base = 0; cc.gw = F.bx * NWAVES + F.wave; cc.ngw = F.G * NWAVES;
    unsigned char* ws = F.ws;
    conv_mat(F, cc, F.in[I_WIN] + (size_t)l * 1024 * INC, 1024, INC, (bf16_t*)(ws + W_IN), 1024, 0, 128, 1, 0, 0);
    conv_mat(F, cc, F.in[I_WGATE] + (size_t)l * 4 * 1024 * 1024, 1024, 1024, (bf16_t*)(ws + W_GATE), 1024, 0, 128, 4, (size_t)1024 * 1024, 0, 128, true, 64.0f);
    conv_mat(F, cc, F.in[I_WBR] + (size_t)l * 4 * 256 * 1024, 256, 1024, (bf16_t*)(ws + W_BR), 256, 0, 128, 4, (size_t)256 * 1024, (size_t)1024 * 256);
    conv_mat(F, cc, F.in[I_WOUT] + (size_t)l * 1024 * 1024, 1024, 1024, (bf16_t*)(ws + W_OUT), 1024, 0, 128, 1, 0, 0);
    conv_mat(F, cc, F.in[I_W1] + (size_t)l * 64 * 1024 * 256, 1024, 256, (bf16_t*)(ws + W_13), 1024, 0, 256, 64, (size_t)1024 * 256, (size_t)512 * 1024, 128, false, 64.0f);
    conv_mat(F, cc, F.in[I_W3] + (size_t)l * 64 * 1024 * 256, 1024, 256, (bf16_t*)(ws + W_13), 1024, 128, 256, 64, (size_t)1024 * 256, (size_t)512 * 1024, 128, false, 64.0f);
    conv_mat(F, cc, F.in[I_W2] + (size_t)l * 64 * 256 * 1024, 256, 1024, (bf16_t*)(ws + W_2), 256, 0, 128, 64, (size_t)256 * 1024, (size_t)1024 * 256);
    conv_mat(F, cc, F.in[I_WS1] + (size_t)l * 1024 * 256, 1024, 256, (bf16_t*)(ws + W_13 + (size_t)64 * 512 * 1024), 1024, 0, 256, 1, 0, 0, 128, false, 64.0f);
    conv_mat(F, cc, F.in[I_WS3] + (size_t)l * 1024 * 256, 1024, 256, (bf16_t*)(ws + W_13 + (size_t)64 * 512 * 1024), 1024, 128, 256, 1, 0, 0, 128, false, 64.0f);
    conv_mat(F, cc, F.in[I_WS2] + (size_t)l * 256 * 1024, 256, 1024, (bf16_t*)(ws + W_2) + (size_t)64 * 1024 * 256, 256, 0, 128, 1, 0, 0);
    conv_mat(F, cc, F.in[I_WUQ] + (size_t)l * 256 * 384, 256, 384, (bf16_t*)(ws + W_UQ), 256, 0, 128, 1, 0, 0);
    conv_mat(F, cc, F.in[I_WUKV] + (size_t)l * 128 * 512, 128, 512, (bf16_t*)(ws + W_UKV), 128, 0, 128, 1, 0, 0);
    conv_mat(F, cc, F.in[I_POOLW] + (size_t)l * 4 * 64 * 64, 64, 64, (bf16_t*)(ws + W_POOL), 64, 0, 128, 4, (size_t)64 * 64, (size_t)64 * 64);
    conv_mat(F, cc, F.in[I_WRT] + (size_t)l * 1024 * 64, 1024, 64, (bf16_t*)(ws + W_RT), 1024, 0, 128, 1, 0, 0);
    { u32x4* z = (u32x4*)((bf16_t*)(ws + W_IN) + (size_t)INC * 1024); const int n16 = (INCP - INC) * 1024 * 2 / 16;
      for (int i = F.bx * NTHR + F.tid; i < n16; i += F.G * NTHR) z[i] = (u32x4){0u, 0u, 0u, 0u}; }
}

__device__ __forceinline__ void normmod_vals(int lane, const f32x4 (&v)[4], const float* g, const float* sc, const float* sh, f32x4 (&y)[4]) {
    float s = 0.f;
#pragma unroll
    for (int j = 0; j < 4; ++j) s += (v[j].x * v[j].x + v[j].y * v[j].y) + (v[j].z * v[j].z + v[j].w * v[j].w);
    const float rstd = 1.0f / sqrtf(wave_sum(s) * (1.f / 1024.f) + EPS);
#pragma unroll
    for (int j = 0; j < 4; ++j) { const f32x4 gv = ((const f32x4*)g)[lane + 64 * j], scv = ((const f32x4*)sc)[lane + 64 * j], shv = ((const f32x4*)sh)[lane + 64 * j];
        y[j] = v[j] * rstd * gv * (scv + 1.0f) + shv; }
}
__device__ __forceinline__ void normmod_row(int lane, const float* xrow, const float* g, const float* sc, const float* sh, f32x4 (&y)[4]) {
    const f32x4* xr = (const f32x4*)xrow + lane; f32x4 v[4]; float s = 0.f;
#pragma unroll
    for (int j = 0; j < 4; ++j) { v[j] = xr[64 * j]; s += (v[j].x * v[j].x + v[j].y * v[j].y) + (v[j].z * v[j].z + v[j].w * v[j].w); }
    const float rstd = 1.0f / sqrtf(wave_sum(s) * (1.f / 1024.f) + EPS);
#pragma unroll
    for (int j = 0; j < 4; ++j) { const f32x4 gv = ((const f32x4*)g)[lane + 64 * j], scv = ((const f32x4*)sc)[lane + 64 * j], shv = ((const f32x4*)sh)[lane + 64 * j];
        y[j] = v[j] * rstd * gv * (scv + 1.0f) + shv; }
}
__device__ __forceinline__ const float* stream_row(const Frame& F, int l, int row) {
    if (row < NLAT) return (l == 0 ? F.in[I_X] : F.out) + (size_t)row * 1024;
    return (l == 0 ? F.in[I_CTX] : (const float*)(F.ws + WS_CTXS)) + (size_t)(row - NLAT) * 1024;
}
__device__ __forceinline__ void ph_norm1(const Frame& F, int l) {
    const int gw = F.bx * NWAVES + F.wave, ngw = F.G * NWAVES;
    bf16_t* hx = (bf16_t*)(F.ws + WS_HX);
    for (int row = gw; row < NTOK; row += ngw) {
        const int mr = mod_row_of(row); f32x4 y[4];
        normmod_row(F.lane, stream_row(F, l, row), F.in[I_GMIX] + l * 1024, modp(F, l, mr, 1), modp(F, l, mr, 0), y);
        u32x2* o = (u32x2*)(hx + (size_t)row * 1024) + F.lane; unsigned* o8 = (unsigned*)(F.ws + WS_HX8 + (size_t)row * 1024) + F.lane;
#pragma unroll
        for (int j = 0; j < 4; ++j) { o[64 * j] = (u32x2){pk2(y[j].x, y[j].y), pk2(y[j].z, y[j].w)}; o8[64 * j] = pk4_fp8(y[j].x, y[j].y, y[j].z, y[j].w); }
    }
}

constexpr float QSCALE = 0.10206207261596577f * 1.4426950408889634f;
__device__ __forceinline__ void mla_unit(const Frame& F, int l, int unit, bool want_q) {
    LAS unsigned char* lds = F.lds;
    LAS bf16_t* AQ = (LAS bf16_t*)lds;
    LAS bf16_t* AKV = (LAS bf16_t*)(lds + 16896);
    LAS float* KR = (LAS float*)(lds + 25600);
    LAS float* OUT = (LAS float*)(lds + 29696);
    LAS bf16_t* KB = (LAS bf16_t*)(lds + 96256);
    const int row0 = unit * 32, lane = F.lane, wave = F.wave, tid = F.tid;
    const bool isctx = row0 >= NLAT;
    const int b = isctx ? (row0 - NLAT) >> 8 : row0 >> 13, pos0 = isctx ? (row0 - NLAT) & 255 : row0 & 8191;
    const bf16_t* px = (const bf16_t*)(F.ws + WS_PX);
    const float* gcq = F.in[I_GCQ] + l * 256; const float* gckv = F.in[I_GCKV] + l * 128; const float* gqn = F.in[I_GQN] + l * 96; const float* gkn = F.in[I_GKN] + l * 96;
    const float* rope = (const float*)(F.ws + T_ROPE);
    __syncthreads();
    for (int rr = 0; rr < 4; ++rr) { const int r = wave * 4 + rr; const bf16_t* p = px + (size_t)(row0 + r) * INC + C_MLA;
        { const u32x2 w = *(const u32x2*)(p + 4 * lane); const float x0 = bflo(w.x), x1 = bfhi(w.x), x2 = bflo(w.y), x3 = bfhi(w.y);
          const float sc = 1.0f / sqrtf(wave_sum(x0 * x0 + x1 * x1 + x2 * x2 + x3 * x3) * (1.f / 256.f) + EPS); const f32x4 g = *(const f32x4*)(gcq + 4 * lane);
          *(LAS u32x2*)(AQ + r * 264 + 4 * lane) = (u32x2){pk2(x0 * sc * g.x, x1 * sc * g.y), pk2(x2 * sc * g.z, x3 * sc * g.w)}; }
        { const unsigned w = *(const unsigned*)(p + 256 + 2 * lane); const float x0 = bflo(w), x1 = bfhi(w);
          const float sc = 1.0f / sqrtf(wave_sum(x0 * x0 + x1 * x1) * (1.f / 128.f) + EPS); const f32x2 g = *(const f32x2*)(gckv + 2 * lane);
          *(LAS unsigned*)(AKV + r * 136 + 2 * lane) = pk2(x0 * sc * g.x, x1 * sc * g.y); }
        if (lane < 32) KR[r * 32 + lane] = bf2f(p[384 + lane]); }
    __syncthreads();
    const int r32 = lane & 31, hi = lane >> 5;
    if (want_q) {
        for (int nt = wave; nt < 12; nt += 8) { f32x16 acc = {}; acc = mma32_lg<16>(acc, AQ, 264, (const bf16_t*)(F.ws + W_UQ) + (size_t)nt * 32 * 256, 256, lane);
#pragma unroll
            for (int r = 0; r < 16; ++r) OUT[crow(r, hi) * 520 + nt * 32 + r32] = acc[r]; }
        __syncthreads();
        bf16_t* qb = (bf16_t*)(F.ws + WS_QB);
        for (int it = 0; it < 8; ++it) { const int pr = wave * 16 + it * 2 + hi, r = pr >> 2, h = pr & 3; const LAS float* o = OUT + r * 520 + h * 96;
            float v0 = o[r32], v1 = o[32 + r32], v2 = o[64 + r32]; const float ss = half_sum(v0 * v0 + v1 * v1 + v2 * v2);
            const float sc = 1.0f / sqrtf(ss * (1.f / 96.f) + EPS);
            v0 *= sc * gqn[r32]; v1 *= sc * gqn[32 + r32]; v2 *= sc * gqn[64 + r32];
            const float pv = xor_lane<8>(v2);
            if (!isctx) { const int pos = pos0 + r, pp = (r32 < 16) ? (pos >> 6) : (pos & 63); const float cs = rope[(pp * 8 + (r32 & 7)) * 2], sn = rope[(pp * 8 + (r32 & 7)) * 2 + 1];
                v2 = (r32 & 8) ? (v2 * cs + pv * sn) : (v2 * cs - pv * sn); }
            bf16_t* q = qb + (size_t)(row0 + r) * 384 + h * 96;
            q[r32] = (bf16_t)f2bf(v0 * QSCALE); q[32 + r32] = (bf16_t)f2bf(v1 * QSCALE); q[64 + r32] = (bf16_t)f2bf(v2 * QSCALE); }
        __syncthreads();
    }
    for (int nt = wave * 2; nt < wave * 2 + 2; ++nt) { f32x16 acc = {}; acc = mma32_lg<8>(acc, AKV, 136, (const bf16_t*)(F.ws + W_UKV) + (size_t)nt * 32 * 128, 128, lane);
#pragma unroll
        for (int r = 0; r < 16; ++r) OUT[crow(r, hi) * 520 + nt * 32 + r32] = acc[r]; }
    __syncthreads();
    for (int it = 0; it < 8; ++it) { const int pr = wave * 16 + it * 2 + hi, r = pr >> 2, h = pr & 3; const LAS float* o = OUT + r * 520 + h * 128;
        float v0 = o[r32], v1 = o[32 + r32], v2 = KR[r * 32 + r32]; const float ss = half_sum(v0 * v0 + v1 * v1 + v2 * v2);
        const float sc = 1.0f / sqrtf(ss * (1.f / 96.f) + EPS);
        v0 *= sc * gkn[r32]; v1 *= sc * gkn[32 + r32]; v2 *= sc * gkn[64 + r32];
        const float pv = xor_lane<8>(v2);
        if (!isctx) { const int pos = pos0 + r, pp = (r32 < 16) ? (pos >> 6) : (pos & 63); const float cs = rope[(pp * 8 + (r32 & 7)) * 2], sn = rope[(pp * 8 + (r32 & 7)) * 2 + 1];
            v2 = (r32 & 8) ? (v2 * cs + pv * sn) : (v2 * cs - pv * sn); }
        LAS bf16_t* kb = KB + (r * 4 + h) * 104;
        kb[r32] = (bf16_t)f2bf(v0); kb[32 + r32] = (bf16_t)f2bf(v1); kb[64 + r32] = (bf16_t)f2bf(v2); }
    __syncthreads();
    const int key0 = isctx ? pos0 : 256 + pos0, tile = key0 >> 6, kin = key0 & 63;
    for (int i = tid; i < 1536; i += NTHR) { const int r = i & 31, c = (i >> 5) % 12, h = i / 384;
        const u32x4 v = *(const LAS u32x4*)(KB + (r * 4 + h) * 104 + c * 8);
        *(u32x4*)((bf16_t*)(F.ws + WS_KT) + ((size_t)((b * 4 + h) * NKT + tile) * 12 + c) * 512 + (kin + r) * 8) = v; }
    for (int i = tid; i < 1024; i += NTHR) { const int p = i & 3, r = (i >> 2) & 31, dh = (i >> 7) & 1, h = i >> 8; const LAS float* o = OUT + r * 520 + h * 128 + 64 + dh * 32 + p * 8;
        u32x4 v; v.x = pk2(o[0], o[1]); v.y = pk2(o[2], o[3]); v.z = pk2(o[4], o[5]); v.w = pk2(o[6], o[7]);
        *(u32x4*)((bf16_t*)(F.ws + WS_VT) + ((size_t)((b * 4 + h) * NKT + tile) * 2 + dh) * 2048 + (kin + r) * 32 + p * 8) = v; }
}

__device__ __forceinline__ void ml_chunk_pos(int dir, int j, bool& isctx, int& p0) {
    if (j < 2) { isctx = true; p0 = (dir == 0 ? j : 1 - j) * 128; } else { isctx = false; p0 = (dir == 0 ? (j - 2) : (63 - (j - 2))) * 128; }
}
__device__ __forceinline__ int ml_row(int b, bool isctx, int pos) { return isctx ? NLAT + b * 256 + pos : b * 8192 + pos; }
__device__ __forceinline__ float log_sigmoidf_(float x) { return fminf(x, 0.f) - log1pf(__expf(-fabsf(x))); }

__device__ __forceinline__ void ml_pass1_unit(const Frame& F, int l, int unit) {
    LAS float* LI = (LAS float*)F.lds; LAS float* LF = LI + 128; LAS float* WV = LI + 256;
    LAS bf16_t* KT = (LAS bf16_t*)(F.lds + 2048); LAS bf16_t* VT = KT + 64 * 136;
    const int j = unit % NCHK, dir = (unit / NCHK) & 1, h = (unit / (NCHK * 2)) & 3, b = unit / (NCHK * 8);
    bool isctx; int p0; ml_chunk_pos(dir, j, isctx, p0);
    const int tid = F.tid, lane = F.lane, wave = F.wave;
    const float* gate = (const float*)(F.ws + T_GATE); const float* gb = F.in[I_MLGB] + l * 16;
    const bf16_t* px = (const bf16_t*)(F.ws + WS_PX);
    __syncthreads();
    if (tid < 128) { const int pos = dir ? p0 + 127 - tid : p0 + tid; const float* g = gate + (size_t)ml_row(b, isctx, pos) * 16;
        LI[tid] = g[dir * 8 + h] + gb[dir * 8 + h]; LF[tid] = log_sigmoidf_(g[dir * 8 + 4 + h] + gb[dir * 8 + 4 + h]); }
    __syncthreads();
    if (wave == 0) {
        const float a0 = LF[2 * lane], a1 = LF[2 * lane + 1]; float s = a0 + a1;
#pragma unroll
        for (int o = 1; o < 64; o <<= 1) { const float t = lane_up(s, o, lane); if (lane >= o) s += t; }
        const float bend = lane_bcast(s, 63);
        const float w0 = bend - (s - a1) + LI[2 * lane], w1 = bend - s + LI[2 * lane + 1];
        const float mloc = wave_max(fmaxf(w0, w1));
        WV[2 * lane] = __expf(w0 - mloc); WV[2 * lane + 1] = __expf(w1 - mloc);
        if (lane == 0) { ((float*)(F.ws + T_MLOC))[unit] = mloc; ((float*)(F.ws + T_BEND))[unit] = bend; }
    }
    __syncthreads();
    for (int it = tid; it < 2048; it += NTHR) { const int i = it & 127, c = (it >> 7) & 7, isv = it >> 10; const int pos = dir ? p0 + 127 - i : p0 + i;
        const u32x4 v = *(const u32x4*)(px + (size_t)ml_row(b, isctx, pos) * INC + (isv ? 512 : 256) + h * 64 + c * 8);
        const float sc = isv ? 1.0f : 0.125f * WV[i]; LAS bf16_t* d = (isv ? VT : KT) + (c * 8) * 136 + i;
        d[0] = (bf16_t)f2bf(bflo(v.x) * sc); d[136] = (bf16_t)f2bf(bfhi(v.x) * sc); d[272] = (bf16_t)f2bf(bflo(v.y) * sc); d[408] = (bf16_t)f2bf(bfhi(v.y) * sc);
        d[544] = (bf16_t)f2bf(bflo(v.z) * sc); d[680] = (bf16_t)f2bf(bfhi(v.z) * sc); d[816] = (bf16_t)f2bf(bflo(v.w) * sc); d[952] = (bf16_t)f2bf(bfhi(v.w) * sc); }
    __syncthreads();
    if (wave < 4) { const int et = wave >> 1, dt = wave & 1; f32x16 acc = {}; acc = mma32_ll(acc, VT + et * 32 * 136, 136, KT + dt * 32 * 136, 136, 8, lane);
        float* dc = (float*)(F.ws + WS_DC) + (size_t)unit * 4096; const int r32 = lane & 31, hi = lane >> 5;
#pragma unroll
        for (int r = 0; r < 16; ++r) dc[(et * 32 + crow(r, hi)) * 64 + dt * 32 + r32] = acc[r];
    } else if (wave == 4) { float s = 0.f; for (int i = 0; i < 128; ++i) s += bf2f(KT[lane * 136 + i]); ((float*)(F.ws + T_DN))[(size_t)unit * 64 + lane] = s; }
}

__device__ __forceinline__ void ml_pass2(const Frame& F) {
    const float* dc = (const float*)(F.ws + WS_DC); const float* dn = (const float*)(F.ws + T_DN);
    const float* mloc = (const float*)(F.ws + T_MLOC); const float* bend = (const float*)(F.ws + T_BEND);
    bf16_t* cst = (bf16_t*)(F.ws + WS_CST); float* nst = (float*)(F.ws + T_NST); float* mst = (float*)(F.ws + T_MST);
    for (int it = F.bx; it < 64 * 8; it += F.G) { const int bhd = it >> 3, part = it & 7, u0 = bhd * NCHK, el = part * 512 + F.tid;
        float C = 0.f, n = 0.f, m = 0.f; const bool don = (part == 0 && F.tid < 64);
#pragma unroll 2
        for (int j = 0; j < NCHK; ++j) { const int u = u0 + j;
            const float dcv = dc[(size_t)u * 4096 + el], ml = mloc[u], be = bend[u]; const float dnv = don ? dn[(size_t)u * 64 + F.tid] : 0.f;
            cst[(size_t)u * 4096 + el] = (bf16_t)f2bf(C); if (don) nst[(size_t)u * 64 + F.tid] = n; if (part == 0 && F.tid == 0) mst[u] = m;
            const float mn = fmaxf(be + m, ml), dcy = __expf(be + m - mn), sc = __expf(ml - mn);
            C = dcy * C + sc * dcv; n = dcy * n + sc * dnv; m = mn; }
    }
}

__device__ __forceinline__ void ml_pass3_unit(const Frame& F, int l, int b, int h, int pc) {
    LAS unsigned char* lds = F.lds;
    LAS bf16_t* Qs = (LAS bf16_t*)lds;
    LAS bf16_t* Ks = (LAS bf16_t*)(lds + 18432);
    LAS bf16_t* VTs = (LAS bf16_t*)(lds + 36864);
    LAS bf16_t* CTs = (LAS bf16_t*)(lds + 62976);
    LAS bf16_t* Wm = (LAS bf16_t*)(lds + 76800);
    LAS float* HS = (LAS float*)(lds + 111616);
    LAS float* LI = (LAS float*)(lds + 144384); LAS float* LF = LI + 128; LAS float* COLV = LI + 256; LAS float* MV = LI + 384; LAS float* AIN = LI + 512; LAS float* EINV = LI + 640; LAS float* DEN = LI + 768;
    const int tid = F.tid, lane = F.lane, wave = F.wave, r32 = lane & 31, hi = lane >> 5;
    const bool isctx = pc < 2; const int p0 = isctx ? pc * 128 : (pc - 2) * 128;
    const float* gate = (const float*)(F.ws + T_GATE); const float* gb = F.in[I_MLGB] + l * 16;
    const bf16_t* px = (const bf16_t*)(F.ws + WS_PX);
    for (int dir = 0; dir < 2; ++dir) {
        const int j = isctx ? (dir == 0 ? pc : 1 - pc) : (dir == 0 ? pc : 2 + 63 - (pc - 2));
        const int unit = ((b * 4 + h) * 2 + dir) * NCHK + j;
        const float mst = ((const float*)(F.ws + T_MST))[unit];
        __syncthreads();
        if (tid < 128) { const int pos = dir ? p0 + 127 - tid : p0 + tid; const float* g = gate + (size_t)ml_row(b, isctx, pos) * 16;
            LI[tid] = g[dir * 8 + h] + gb[dir * 8 + h]; LF[tid] = log_sigmoidf_(g[dir * 8 + 4 + h] + gb[dir * 8 + 4 + h]); }
        __syncthreads();
        if (wave == 0) {
            const float a0 = LF[2 * lane], a1 = LF[2 * lane + 1]; float s = a0 + a1;
#pragma unroll
            for (int o = 1; o < 64; o <<= 1) { const float t = lane_up(s, o, lane); if (lane >= o) s += t; }
            const float b0 = s - a1, b1 = s, c0 = LI[2 * lane] - b0, c1 = LI[2 * lane + 1] - b1;
            float pm = fmaxf(c0, c1);
#pragma unroll
            for (int o = 1; o < 64; o <<= 1) { const float t = lane_up(pm, o, lane); if (lane >= o) pm = fmaxf(pm, t); }
            float pprev = lane_up(pm, 1, lane); if (lane == 0) pprev = -INFINITY;
            const float M0 = fmaxf(mst, fmaxf(pprev, c0)), M1 = fmaxf(mst, pm);
            COLV[2 * lane] = c0; COLV[2 * lane + 1] = c1; MV[2 * lane] = M0; MV[2 * lane + 1] = M1;
            AIN[2 * lane] = __expf(mst - M0); AIN[2 * lane + 1] = __expf(mst - M1); EINV[2 * lane] = __expf(-b0 - M0); EINV[2 * lane + 1] = __expf(-b1 - M1);
        }
        for (int it = tid; it < 3072; it += NTHR) { const int i = it & 127, c = (it >> 7) & 7, which = it >> 10; const int pos = dir ? p0 + 127 - i : p0 + i;
            const u32x4 v = *(const u32x4*)(px + (size_t)ml_row(b, isctx, pos) * INC + which * 256 + h * 64 + c * 8);
            if (which == 0) *(LAS u32x4*)(Qs + i * 72 + c * 8) = v;
            else if (which == 1) { u32x4 w; w.x = pk2(bflo(v.x) * 0.125f, bfhi(v.x) * 0.125f); w.y = pk2(bflo(v.y) * 0.125f, bfhi(v.y) * 0.125f); w.z = pk2(bflo(v.z) * 0.125f, bfhi(v.z) * 0.125f); w.w = pk2(bflo(v.w) * 0.125f, bfhi(v.w) * 0.125f);
                *(LAS u32x4*)(Ks + i * 72 + c * 8) = w; }
            else { LAS bf16_t* d = VTs + (c * 8) * 136 + i; d[0] = (bf16_t)(v.x & 0xffff); d[136] = (bf16_t)(v.x >> 16); d[272] = (bf16_t)(v.y & 0xffff); d[408] = (bf16_t)(v.y >> 16);
                d[544] = (bf16_t)(v.z & 0xffff); d[680] = (bf16_t)(v.z >> 16); d[816] = (bf16_t)(v.w & 0xffff); d[952] = (bf16_t)(v.w >> 16); } }
        for (int it = tid; it < 32 * 136; it += NTHR) VTs[64 * 136 + it] = (it < 128) ? (bf16_t)0x3f80 : (bf16_t)0;
        { const bf16_t* cs = (const bf16_t*)(F.ws + WS_CST) + (size_t)unit * 4096; const u32x4 v = *(const u32x4*)(cs + tid * 8); *(LAS u32x4*)(CTs + (tid >> 3) * 72 + (tid & 7) * 8) = v; }
        for (int it = tid; it < 32 * 72; it += NTHR) CTs[64 * 72 + it] = (it < 64) ? (bf16_t)f2bf(((const float*)(F.ws + T_NST))[(size_t)unit * 64 + it]) : (bf16_t)0;
        __syncthreads();
        for (int q = wave; q < 16; q += 8) { const int ti = q >> 2, si = q & 3; const int s = si * 32 + r32;
            if (si > ti) {
#pragma unroll
                for (int r = 0; r < 16; ++r) Wm[(ti * 32 + crow(r, hi)) * 136 + s] = 0;
            } else { f32x16 acc = {}; acc = mma32_ll(acc, Qs + ti * 32 * 72, 72, Ks + si * 32 * 72, 72, 4, lane); const float cv = COLV[s];
#pragma unroll
                for (int r = 0; r < 16; ++r) { const int t = ti * 32 + crow(r, hi); const float w = (s <= t) ? acc[r] * __expf(cv - MV[t]) : 0.f; Wm[t * 136 + s] = (bf16_t)f2bf(w); } }
        }
        __syncthreads();
        f32x16 tot[2];
        for (int k = 0; k < 2; ++k) { const int q = wave + 8 * k; if (q < 12) { const int ti = q / 3, nt = q % 3;
            f32x16 a1 = {}; a1 = mma32_ll(a1, Wm + ti * 32 * 136, 136, VTs + nt * 32 * 136, 136, (ti + 1) * 2, lane);
            f32x16 a2 = {}; a2 = mma32_ll(a2, Qs + ti * 32 * 72, 72, CTs + nt * 32 * 72, 72, 4, lane);
#pragma unroll
            for (int r = 0; r < 16; ++r) a1[r] += AIN[ti * 32 + crow(r, hi)] * a2[r];
            tot[k] = a1;
            if (nt == 2 && r32 == 0) {
#pragma unroll
                for (int r = 0; r < 16; ++r) DEN[ti * 32 + crow(r, hi)] = a1[r]; } } }
        __syncthreads();
        for (int k = 0; k < 2; ++k) { const int q = wave + 8 * k; if (q < 12) { const int ti = q / 3, nt = q % 3; if (nt < 2) {
#pragma unroll
            for (int r = 0; r < 16; ++r) { const int t = ti * 32 + crow(r, hi); const float hv = tot[k][r] / fmaxf(fabsf(DEN[t]), EINV[t]); const int p = dir ? 127 - t : t;
                if (dir == 0) HS[p * 64 + nt * 32 + r32] = hv; else HS[p * 64 + nt * 32 + r32] += hv; } } } }
    }
    __syncthreads();
    const float hg = F.in[I_MLHG][l * 256 + h * 64 + lane]; bf16_t* yc = (bf16_t*)(F.ws + WS_YC);
    for (int pp = 0; pp < 16; ++pp) { const int p = wave * 16 + pp; const int row = ml_row(b, isctx, p0 + p); const float v = HS[p * 64 + lane];
        const float sc = 1.0f / sqrtf(wave_sum(v * v) * (1.f / 64.f) + EPS); const float o = bf2f(px[(size_t)row * INC + 768 + h * 64 + lane]);
        yc[(size_t)row * 1024 + h * 64 + lane] = (bf16_t)f2bf(v * sc * hg * sigmoidf_(o)); }
}

__device__ __forceinline__ void pool_unit(const Frame& F, int l, int unit) {
    LAS float* U = (LAS float*)F.lds;
    LAS bf16_t* D = (LAS bf16_t*)(F.lds + 81920);
    const int row0 = unit * 64, tid = F.tid, lane = F.lane, wave = F.wave;
    const bool isctx = row0 >= NLAT; const int T = isctx ? 256 : 8192, t0 = isctx ? (row0 - NLAT) & 255 : row0 & 8191, rbase = row0 - t0;
    const bf16_t* px = (const bf16_t*)(F.ws + WS_PX);
    __syncthreads();
    for (int it = tid; it < 80 * 32; it += NTHR) { const int rr = it >> 5, c = it & 31, t = t0 - 8 + rr;
        u32x4 v = {0u, 0u, 0u, 0u}; if (t >= 0 && t < T) v = *(const u32x4*)(px + (size_t)(rbase + t) * INC + C_POOL + c * 8);
        LAS float* d = U + rr * 256 + c * 8; d[0] = bflo(v.x); d[1] = bfhi(v.x); d[2] = bflo(v.y); d[3] = bfhi(v.y); d[4] = bflo(v.z); d[5] = bfhi(v.z); d[6] = bflo(v.w); d[7] = bfhi(v.w); }
    __syncthreads();
    for (int it = tid; it < 64 * 256; it += NTHR) { const int tt = it >> 8, c = it & 255, g = c >> 6, hw = 1 << g, t = t0 + tt;
        const int lo = max(t - hw, 0), hi = min(t + hw, T); float s = 0.f;
        for (int u = lo; u < hi; ++u) s += U[(u - t0 + 8) * 256 + c];
        D[tt * 264 + c] = (bf16_t)f2bf(s / (float)(hi - lo) - U[(tt + 8) * 256 + c]); }
    __syncthreads();
    { const int g = wave >> 1, rt = wave & 1, r32 = lane & 31, hi = lane >> 5; bf16_t* yc = (bf16_t*)(F.ws + WS_YC); const float* ps = F.in[I_POOLS] + l * 256;
      for (int nt = 0; nt < 2; ++nt) { f32x16 acc = {}; acc = mma32_lg<4>(acc, D + rt * 32 * 264 + g * 64, 264, (const bf16_t*)(F.ws + W_POOL) + (size_t)(g * 64 + nt * 32) * 64, 64, lane);
          const int col = g * 64 + nt * 32 + r32; const float sc = ps[col];
#pragma unroll
          for (int r = 0; r < 16; ++r) yc[(size_t)(row0 + rt * 32 + crow(r, hi)) * 1024 + 512 + col] = (bf16_t)f2bf(acc[r] * sc); } }
}
__device__ __forceinline__ void conv_all(const Frame& F, int l, int nrows) {
    const bf16_t* px = (const bf16_t*)(F.ws + WS_PX); bf16_t* yc = (bf16_t*)(F.ws + WS_YC);
    const float* cw = F.in[I_CONVW] + l * 768; const float* cb = F.in[I_CONVB] + l * 256;
    for (int it = F.bx * NTHR + F.tid; it < nrows * 32; it += F.G * NTHR) { const int row = it >> 5, c = (it & 31) * 8;
        const bool isctx = row >= NLAT; const int T = isctx ? 256 : 8192, t = isctx ? (row - NLAT) & 255 : row & 8191;
        const bf16_t* p = px + (size_t)row * INC + C_CONV + c;
        float z[3][8];
#pragma unroll
        for (int j = 0; j < 3; ++j) { const int tt = t + j - 1;
            if (tt >= 0 && tt < T) { const bf16_t* q = p + (ptrdiff_t)(j - 1) * INC; const u32x4 u = *(const u32x4*)q, cc = *(const u32x4*)(q + 512);
                z[j][0] = bflo(u.x) * bflo(cc.x); z[j][1] = bfhi(u.x) * bfhi(cc.x); z[j][2] = bflo(u.y) * bflo(cc.y); z[j][3] = bfhi(u.y) * bfhi(cc.y);
                z[j][4] = bflo(u.z) * bflo(cc.z); z[j][5] = bfhi(u.z) * bfhi(cc.z); z[j][6] = bflo(u.w) * bflo(cc.w); z[j][7] = bfhi(u.w) * bfhi(cc.w); }
            else {
#pragma unroll
                for (int e = 0; e < 8; ++e) z[j][e] = 0.f; } }
        const u32x4 bw = *(const u32x4*)(p + 256); float bx[8] = {bflo(bw.x), bfhi(bw.x), bflo(bw.y), bfhi(bw.y), bflo(bw.z), bfhi(bw.z), bflo(bw.w), bfhi(bw.w)};
        float y[8];
#pragma unroll
        for (int e = 0; e < 8; ++e) y[e] = bx[e] * (cb[c + e] + cw[c + e] * z[0][e] + cw[256 + c + e] * z[1][e] + cw[512 + c + e] * z[2][e]);
        u32x4 o; o.x = pk2(y[0], y[1]); o.y = pk2(y[2], y[3]); o.z = pk2(y[4], y[5]); o.w = pk2(y[6], y[7]);
        *(u32x4*)(yc + (size_t)row * 1024 + 768 + c) = o; }
}

namespace att {
constexpr int STAGE_B = 40960, KSUB = 12288, VOFF = 24576, VSUB = 8192, LDS_WS = 3 * STAGE_B, LDS_OST = LDS_WS + 2048;
constexpr float THR = 8.0f;
__device__ __forceinline__ void glds16(const void* gsrc, unsigned lds_dst) { unsigned keep;
    asm volatile("s_mov_b32 %0, m0\n\ts_mov_b32 m0, %2\n\ts_nop 0\n\tglobal_load_lds_dwordx4 %1, off\n\ts_mov_b32 m0, %0" : "=&s"(keep) : "v"(gsrc), "s"(lds_dst) : "memory"); }
#define ATT_WAIT_BAR(N) asm volatile("s_waitcnt vmcnt(" #N ") lgkmcnt(0)\n\ts_barrier" ::: "memory")
__device__ __forceinline__ void qkt(f32x16& p0, f32x16& p1, const LAS char* Kslot, const bf16x8* qr, int r32, int hi) {
    const LAS char* kb = Kslot + hi * 1024 + r32 * 16; p0 = f32x16{}; p1 = f32x16{};
#pragma unroll
    for (int d0 = 0; d0 < 6; ++d0) {
        const bf16x8 b0 = *(const LAS bf16x8*)(kb + d0 * 2048), b1 = *(const LAS bf16x8*)(kb + d0 * 2048 + 512);
        p0 = __builtin_amdgcn_mfma_f32_32x32x16_bf16(b0, qr[d0], p0, 0, 0, 0); p1 = __builtin_amdgcn_mfma_f32_32x32x16_bf16(b1, qr[d0], p1, 0, 0, 0); }
}
__device__ __forceinline__ float rowmax(const f32x16& p0, const f32x16& p1) {
    float a = fmaxf(p0[0], p1[0]);
#pragma unroll
    for (int r = 1; r < 16; ++r) a = fmaxf(a, fmaxf(p0[r], p1[r]));
    auto rr = __builtin_amdgcn_permlane32_swap(__float_as_uint(a), __float_as_uint(a), false, false);
    return fmaxf(__uint_as_float(rr[0]), __uint_as_float(rr[1]));
}
__device__ __forceinline__ void pv(f32x16* o, int vb, bf16x8 pa0, bf16x8 pa1, bf16x8 pa2, bf16x8 pa3) {
#pragma unroll
    for (int d0 = 0; d0 < 2; ++d0) { s16x4 lo[4], hi[4];
#pragma unroll
        for (int ks = 0; ks < 4; ++ks) {
            asm volatile("ds_read_b64_tr_b16 %0,%1 offset:%c2" : "=&v"(lo[ks]) : "v"(vb), "i"(d0 * 4096 + ks * 1024) : "memory");
            asm volatile("ds_read_b64_tr_b16 %0,%1 offset:%c2" : "=&v"(hi[ks]) : "v"(vb), "i"(d0 * 4096 + ks * 1024 + 512) : "memory"); }
        asm volatile("s_waitcnt lgkmcnt(0)" ::: "memory"); __builtin_amdgcn_sched_barrier(0);
#define ATT_PK(k) (bf16x8){lo[k][0], lo[k][1], lo[k][2], lo[k][3], hi[k][0], hi[k][1], hi[k][2], hi[k][3]}
        o[d0] = __builtin_amdgcn_mfma_f32_32x32x16_bf16(pa0, ATT_PK(0), o[d0], 0, 0, 0);
        o[d0] = __builtin_amdgcn_mfma_f32_32x32x16_bf16(pa1, ATT_PK(1), o[d0], 0, 0, 0);
        o[d0] = __builtin_amdgcn_mfma_f32_32x32x16_bf16(pa2, ATT_PK(2), o[d0], 0, 0, 0);
        o[d0] = __builtin_amdgcn_mfma_f32_32x32x16_bf16(pa3, ATT_PK(3), o[d0], 0, 0, 0);
#undef ATT_PK
    }
}
__device__ __forceinline__ void unit(const Frame& F, int bh, int qrow, int orow, int nst) {
    const int tid = F.tid, lane = F.lane, wid = F.wave, r32 = lane & 31, hi = lane >> 5, h = bh & 3;
    const unsigned lds0 = (unsigned)(uintptr_t)F.lds;
    const LAS char* ring = (const LAS char*)F.lds;
    LAS float* wsf = (LAS float*)(F.lds + LDS_WS) + wid * 64;
    const char* kg = (const char*)(F.ws + WS_KT) + (size_t)bh * NKT * 12288; const char* vg = (const char*)(F.ws + WS_VT) + (size_t)bh * NKT * 8192;
    const bf16_t* Qw = (const bf16_t*)(F.ws + WS_QB) + (size_t)(qrow + wid * 32) * 384 + h * 96;
#define ATT_DMA(t, slot) do { const char* ks_ = kg + (size_t)(t) * 24576 + wid * 1024 + lane * 16; const char* vs_ = vg + (size_t)(t) * 16384 + wid * 1024 + lane * 16; \
        const unsigned kd_ = lds0 + (slot) * STAGE_B + wid * 1024, vd_ = kd_ + VOFF; \
        glds16(ks_, (unsigned)__builtin_amdgcn_readfirstlane(kd_)); glds16(ks_ + 8192, (unsigned)__builtin_amdgcn_readfirstlane(kd_ + 8192)); glds16(ks_ + 16384, (unsigned)__builtin_amdgcn_readfirstlane(kd_ + 16384)); \
        glds16(vs_, (unsigned)__builtin_amdgcn_readfirstlane(vd_)); glds16(vs_ + 8192, (unsigned)__builtin_amdgcn_readfirstlane(vd_ + 8192)); } while (0)
    ATT_DMA(0, 0); if (nst > 1) ATT_DMA(1, 1);
    bf16x8 qr[6];
#pragma unroll
    for (int d0 = 0; d0 < 6; ++d0) qr[d0] = *(const bf16x8*)(Qw + (size_t)r32 * 384 + d0 * 16 + hi * 8);
    float mhat = 0.f, l_reg = 0.f; f32x16 o[2]; o[0] = f32x16{}; o[1] = f32x16{};
    const int vb0 = (int)lds0 + VOFF + ((lane >> 4) & 1) * 32 + (lane & 3) * 8 + (4 * hi + ((lane & 15) >> 2)) * 64;
    int slot = 0; bool first = true;
    for (int t = 0; t < nst; ++t) {
        if (t + 1 < nst) ATT_WAIT_BAR(5); else ATT_WAIT_BAR(0);
        if (t + 2 < nst) { const int s2 = (slot == 0) ? 2 : slot - 1; ATT_DMA(t + 2, s2); }
#pragma unroll
        for (int s = 0; s < 2; ++s) {
            f32x16 p0, p1; qkt(p0, p1, ring + slot * STAGE_B + s * KSUB, qr, r32, hi);
            const float rm = rowmax(p0, p1);
            if (first) { mhat = rm; first = false; }
            else if (__any(rm - mhat > THR)) { const float dl = fmaxf(rm - mhat, 0.f); mhat += dl; const float f = __builtin_amdgcn_exp2f(-dl); l_reg *= f;
                if (hi == 0) wsf[r32] = f; LDS_WAIT();
#pragma unroll
                for (int r = 0; r < 16; ++r) { const float fr_ = wsf[crow(r, hi)]; o[0][r] *= fr_; o[1][r] *= fr_; } }
            float sacc = 0.f;
#pragma unroll
            for (int r = 0; r < 16; ++r) { p0[r] = __builtin_amdgcn_exp2f(p0[r] - mhat); p1[r] = __builtin_amdgcn_exp2f(p1[r] - mhat); sacc += p0[r] + p1[r]; }
            l_reg += sacc;
            u32x4 pw0, pw1, pw2, pw3;
            pw0 = (u32x4){cvt_pk_bf16(p0[0], p0[1]), cvt_pk_bf16(p0[2], p0[3]), cvt_pk_bf16(p0[4], p0[5]), cvt_pk_bf16(p0[6], p0[7])};
            pw1 = (u32x4){cvt_pk_bf16(p0[8], p0[9]), cvt_pk_bf16(p0[10], p0[11]), cvt_pk_bf16(p0[12], p0[13]), cvt_pk_bf16(p0[14], p0[15])};
            pw2 = (u32x4){cvt_pk_bf16(p1[0], p1[1]), cvt_pk_bf16(p1[2], p1[3]), cvt_pk_bf16(p1[4], p1[5]), cvt_pk_bf16(p1[6], p1[7])};
            pw3 = (u32x4){cvt_pk_bf16(p1[8], p1[9]), cvt_pk_bf16(p1[10], p1[11]), cvt_pk_bf16(p1[12], p1[13]), cvt_pk_bf16(p1[14], p1[15])};
            __builtin_amdgcn_sched_barrier(0);
            pv(o, vb0 + slot * STAGE_B + s * VSUB, __builtin_bit_cast(bf16x8, pw0), __builtin_bit_cast(bf16x8, pw1), __builtin_bit_cast(bf16x8, pw2), __builtin_bit_cast(bf16x8, pw3));
        }
        slot = (slot == 2) ? 0 : slot + 1;
    }
    { auto rr = __builtin_amdgcn_permlane32_swap(__float_as_uint(l_reg), __float_as_uint(l_reg), false, false); l_reg = __uint_as_float(rr[0]) + __uint_as_float(rr[1]); }
    if (hi == 0) wsf[32 + r32] = l_reg; LDS_WAIT();
    float rli[16];
#pragma unroll
    for (int r = 0; r < 16; ++r) rli[r] = 1.0f / wsf[32 + crow(r, hi)];
    LAS bf16_t* stg = (LAS bf16_t*)(F.lds + LDS_OST) + wid * 2048;
#pragma unroll
    for (int r = 0; r < 16; ++r) { const int orow_ = crow(r, hi);
#pragma unroll
        for (int d0 = 0; d0 < 2; ++d0) stg[orow_ * 64 + d0 * 32 + r32] = (bf16_t)f2bf(o[d0][r] * rli[r]); }
    LDS_WAIT();
    bf16_t* Ow = (bf16_t*)(F.ws + WS_YC) + (size_t)(orow + wid * 32) * 1024 + 256 + h * 64;
#pragma unroll
    for (int i = 0; i < 4; ++i) { const int row = i * 8 + (lane >> 3), ch = lane & 7; const u32x4 v = *(const LAS u32x4*)(stg + row * 64 + ch * 8); *(u32x4*)(Ow + (size_t)row * 1024 + ch * 8) = v; }
    asm volatile("s_waitcnt lgkmcnt(0)\n\ts_barrier" ::: "memory");
#undef ATT_DMA
}
}

namespace att2 {
constexpr int KSL = 12288, VSL = 8192, LDS_K = 0, LDS_V = 3 * KSL, LDS_WS = LDS_V + 3 * VSL, LDS_OST = LDS_WS + 2048;
#define A2_SBAR() __builtin_amdgcn_sched_barrier(0)
#define A2_WAIT_BAR(N) asm volatile("s_waitcnt vmcnt(" #N ") lgkmcnt(0)\n\ts_barrier" ::: "memory")
__device__ __forceinline__ void glds16s(const void* sbase, unsigned voff, unsigned lds_dst) { unsigned keep;
    asm volatile("s_mov_b32 %0, m0\n\ts_mov_b32 m0, %3\n\ts_nop 4\n\tglobal_load_lds_dwordx4 %1, %2\n\ts_mov_b32 m0, %0" : "=&s"(keep) : "v"(voff), "s"(sbase), "s"(lds_dst) : "memory"); }
__device__ __forceinline__ unsigned cvtpk_s(float lo, float hi) { typedef float f2 __attribute__((ext_vector_type(2))); typedef __bf16 b2 __attribute__((ext_vector_type(2))); f2 v = {lo, hi}; b2 b = __builtin_convertvector(v, b2); return __builtin_bit_cast(unsigned, b); }
typedef short v4i16_t __attribute__((ext_vector_type(4)));
__device__ __forceinline__ s16x4 vtr(const LAS char* p) { return __builtin_bit_cast(s16x4, __builtin_amdgcn_ds_read_tr16_b64_v4i16((LAS v4i16_t*)p)); }
__device__ __forceinline__ void kload2(bf16x8* kf, const LAS char* kp, int j) { kf[2 * j] = *(const LAS bf16x8*)(kp + j * 2048); kf[2 * j + 1] = *(const LAS bf16x8*)(kp + j * 2048 + 512); }

__device__ __forceinline__ void unit(const Frame& F, int bh, int qrow, int orow, int NT) {
    const int lane = F.lane, wid = F.wave, r32 = lane & 31, hi = lane >> 5, h = bh & 3;
    const unsigned lds0 = (unsigned)(uintptr_t)F.lds;
    const LAS char* shm3 = (const LAS char*)F.lds;
    LAS float* wsf = (LAS float*)(F.lds + LDS_WS) + wid * 64;
    const char* kg = (const char*)(F.ws + WS_KT) + (size_t)bh * NKT * 12288; const char* vg = (const char*)(F.ws + WS_VT) + (size_t)bh * NKT * 8192 + wid * 1024; const unsigned l16 = lane * 16;
    const bf16_t* Qw = (const bf16_t*)(F.ws + WS_QB) + (size_t)(qrow + wid * 32) * 384 + h * 96;
    const int kp2 = 8 + (wid & 3);
#define A2_DMA_K(t, sl) do { const char* s_ = kg + (size_t)(t) * 12288; const unsigned d_ = lds0 + LDS_K + (sl) * KSL; \
        glds16s(s_ + wid * 1024, l16, (unsigned)__builtin_amdgcn_readfirstlane(d_ + wid * 1024)); glds16s(s_ + kp2 * 1024, l16, (unsigned)__builtin_amdgcn_readfirstlane(d_ + kp2 * 1024)); } while (0)
#define A2_DMA_V(t, sl) glds16s(vg + (size_t)(t) * 8192, l16, (unsigned)__builtin_amdgcn_readfirstlane(lds0 + LDS_V + (sl) * VSL + wid * 1024))
    const LAS char* kp0 = shm3 + LDS_K + hi * 1024 + r32 * 16;
    const LAS char* vp0 = shm3 + LDS_V + ((lane >> 4) & 1) * 32 + (lane & 3) * 8 + (4 * hi + ((lane & 15) >> 2)) * 64;
    bf16x8 kf[12];
    A2_DMA_K(0, 0); A2_DMA_V(0, 0); A2_DMA_K(1, 1);
    bf16x8 qr[6];
#pragma unroll
    for (int d0 = 0; d0 < 6; ++d0) qr[d0] = *(const bf16x8*)(Qw + (size_t)r32 * 384 + d0 * 16 + hi * 8);
    float mhat = 0.f, l_reg = 0.f; f32x16 o[2]; o[0] = f32x16{}; o[1] = f32x16{};
    bool resc = false;
    f32x16 pA0, pA1, pB0, pB1;
    int sl_prev = 0, sl_cur = 0, sl_next = 1;
#define A2_ROT() do { sl_prev = sl_cur; sl_cur = sl_next; sl_next = (sl_next == 2) ? 0 : sl_next + 1; } while (0)
#define A2_RESC() do { if (resc) { asm volatile("s_waitcnt lgkmcnt(0)" ::: "memory"); \
        _Pragma("unroll") for (int d_ = 0; d_ < 2; ++d_) _Pragma("unroll") for (int r = 0; r < 16; ++r) o[d_][r] *= wsf[crow(r, hi)]; } } while (0)
    A2_DMA_K(2, 2);
    A2_WAIT_BAR(5);
    { kload2(kf, kp0, 0); kload2(kf, kp0, 1); kload2(kf, kp0, 2); kload2(kf, kp0, 3); kload2(kf, kp0, 4); kload2(kf, kp0, 5);
      pA0 = f32x16{}; pA1 = f32x16{};
#pragma unroll
      for (int d0 = 0; d0 < 6; ++d0) { pA0 = __builtin_amdgcn_mfma_f32_32x32x16_bf16(kf[2 * d0], qr[d0], pA0, 0, 0, 0); pA1 = __builtin_amdgcn_mfma_f32_32x32x16_bf16(kf[2 * d0 + 1], qr[d0], pA1, 0, 0, 0); }
      float a = fmaxf(pA0[0], pA1[0]);
#pragma unroll
      for (int r = 1; r < 16; ++r) a = fmaxf(a, fmaxf(pA0[r], pA1[r]));
      { auto rr = __builtin_amdgcn_permlane32_swap(__float_as_uint(a), __float_as_uint(a), false, false); a = fmaxf(__uint_as_float(rr[0]), __uint_as_float(rr[1])); }
      mhat = a;
#pragma unroll
      for (int r = 0; r < 16; ++r) { pA0[r] = __builtin_amdgcn_exp2f(pA0[r] - mhat); pA1[r] = __builtin_amdgcn_exp2f(pA1[r] - mhat); } }
    A2_WAIT_BAR(0);
    A2_DMA_K(3, 0); A2_DMA_V(1, 1);
    A2_ROT();
    { const LAS char* kp = kp0 + sl_cur * KSL; kload2(kf, kp, 0); kload2(kf, kp, 1); kload2(kf, kp, 2); kload2(kf, kp, 3); kload2(kf, kp, 4); kload2(kf, kp, 5); }
    A2_WAIT_BAR(3);
    s16x4 vlo[8], vhi[8]; u32x4 pw0, pw1, pw2, pw3;
#define A2_PKW(P, B) cvtpk_s(P[B], P[B + 1])
#define A2_PAF(k) __builtin_bit_cast(bf16x8, pw##k)
#define A2_VFR(i) (bf16x8){vlo[i][0], vlo[i][1], vlo[i][2], vlo[i][3], vhi[i][0], vhi[i][1], vhi[i][2], vhi[i][3]}
#define A2_PIN(x) asm volatile("" : "+v"(x))
#define A2_MX3(a, b, c) __builtin_fmaxf(__builtin_fmaxf((a), (b)), (c))
#define A2_GAPA(MF, A0, A1, A2, A3, W0, W1, PW) do { MF; sacc += A0; sacc += A1; sacc += A2; sacc += A3; A2_PIN(sacc); W0; W1; A2_PIN(PW); A2_SBAR(); } while (0)
#define A2_GAPM(MF) do { MF; A2_SBAR(); } while (0)
#define A2_EX(v) __builtin_amdgcn_exp2f(v)
#define A2_GAPB(MF, X, B) do { MF; X[B] = A2_EX(X[B] - mhat); X[B + 1] = A2_EX(X[B + 1] - mhat); X[B + 2] = A2_EX(X[B + 2] - mhat); X[B + 3] = A2_EX(X[B + 3] - mhat); A2_PIN(X); A2_SBAR(); } while (0)
#define A2_VRD(i) do { vlo[i] = vtr(vp_ + (((i) >> 2) * 4096 + ((i) & 3) * 1024)); vhi[i] = vtr(vp_ + (((i) >> 2) * 4096 + ((i) & 3) * 1024 + 512)); } while (0)
#define A2_KRD(G, j) do { if (G) { kload2(kf, kp0 + sl_next * KSL, j); A2_SBAR(); } } while (0)
#define A2_MF(C, kk, qq, CI) C = __builtin_amdgcn_mfma_f32_32x32x16_bf16(kf[kk], qr[qq], CI, 0, 0, 0)
#define A2_STEP(C0, C1, P0, P1, t, GK, GV, GL) do { A2_SBAR(); \
    const LAS char* vp_ = vp0 + sl_prev * VSL; \
    A2_VRD(0); A2_SBAR(); float sacc = (P0[0] + P0[1]); \
    A2_GAPA(A2_MF(C0, 0, 0, (f32x16{})), P0[2], P0[3], P0[4], P0[5],     pw0[0] = A2_PKW(P0, 0), pw0[1] = A2_PKW(P0, 2), pw0); \
    A2_VRD(4); A2_SBAR(); A2_GAPA(A2_MF(C1, 1, 0, (f32x16{})), P0[6], P0[7], P0[8], P0[9],     pw0[2] = A2_PKW(P0, 4), pw0[3] = A2_PKW(P0, 6), pw0); \
    A2_VRD(1); A2_SBAR(); A2_GAPA(A2_MF(C0, 2, 1, C0),   P0[10], P0[11], P0[12], P0[13], pw1[0] = A2_PKW(P0, 8), pw1[1] = A2_PKW(P0, 10), pw1); \
    A2_VRD(5); A2_SBAR(); A2_GAPA(A2_MF(C1, 3, 1, C1),   P0[14], P0[15], P1[0], P1[1],   pw1[2] = A2_PKW(P0, 12), pw1[3] = A2_PKW(P0, 14), pw1); \
    A2_VRD(2); A2_SBAR(); A2_GAPA(A2_MF(C0, 4, 2, C0),   P1[2], P1[3], P1[4], P1[5],     pw2[0] = A2_PKW(P1, 0), pw2[1] = A2_PKW(P1, 2), pw2); \
    A2_VRD(6); A2_SBAR(); A2_GAPA(A2_MF(C1, 5, 2, C1),   P1[6], P1[7], P1[8], P1[9],     pw2[2] = A2_PKW(P1, 4), pw2[3] = A2_PKW(P1, 6), pw2); \
    A2_VRD(3); A2_SBAR(); A2_GAPA(A2_MF(C0, 6, 3, C0),   P1[10], P1[11], P1[12], P1[13], pw3[0] = A2_PKW(P1, 8), pw3[1] = A2_PKW(P1, 10), pw3); \
    A2_VRD(7); A2_SBAR(); A2_GAPA(A2_MF(C1, 7, 3, C1),   P1[14], P1[15], 0.f, 0.f,       pw3[2] = A2_PKW(P1, 12), pw3[3] = A2_PKW(P1, 14), pw3); \
    A2_GAPM(A2_MF(C0, 8, 4, C0)); A2_GAPM(A2_MF(C1, 9, 4, C1)); A2_GAPM(A2_MF(C0, 10, 5, C0)); A2_GAPM(A2_MF(C1, 11, 5, C1)); \
    l_reg += sacc; \
    if (GK) { A2_DMA_K((t) + 3, sl_cur); } if (GV) { A2_DMA_V((t) + 1, sl_next); } \
    { float a = A2_MX3(C0[0], C0[1], C1[0]), b = A2_MX3(C0[2], C0[3], C1[1]); a = A2_MX3(a, C1[2], C1[3]); \
      _Pragma("unroll") for (int r = 4; r < 16; r += 4) { a = A2_MX3(a, C0[r], C0[r + 1]); b = A2_MX3(b, C0[r + 2], C0[r + 3]); a = A2_MX3(a, C1[r], C1[r + 1]); b = A2_MX3(b, C1[r + 2], C1[r + 3]); } \
      float rm = __builtin_fmaxf(a, b); { auto rr = __builtin_amdgcn_permlane32_swap(__float_as_uint(rm), __float_as_uint(rm), false, false); rm = __builtin_fmaxf(__uint_as_float(rr[0]), __uint_as_float(rr[1])); } \
      resc = false; \
      if (__builtin_expect(__any(rm - mhat > 8.0f), 0)) { const float dl = __builtin_fmaxf(rm - mhat, 0.f); mhat += dl; \
        const float f = __builtin_amdgcn_exp2f(-dl); l_reg *= f; if (hi == 0) wsf[r32] = f; resc = true; } } \
    A2_SBAR(); \
    A2_GAPB(o[0] = __builtin_amdgcn_mfma_f32_32x32x16_bf16(A2_PAF(0), A2_VFR(0), o[0], 0, 0, 0), C0, 0); \
    A2_KRD(GL, 0); A2_GAPB(o[1] = __builtin_amdgcn_mfma_f32_32x32x16_bf16(A2_PAF(0), A2_VFR(4), o[1], 0, 0, 0), C0, 4); \
    A2_KRD(GL, 1); A2_GAPB(o[0] = __builtin_amdgcn_mfma_f32_32x32x16_bf16(A2_PAF(1), A2_VFR(1), o[0], 0, 0, 0), C0, 8); \
    A2_KRD(GL, 2); A2_GAPB(o[1] = __builtin_amdgcn_mfma_f32_32x32x16_bf16(A2_PAF(1), A2_VFR(5), o[1], 0, 0, 0), C0, 12); \
    A2_KRD(GL, 3); A2_GAPB(o[0] = __builtin_amdgcn_mfma_f32_32x32x16_bf16(A2_PAF(2), A2_VFR(2), o[0], 0, 0, 0), C1, 0); \
    A2_KRD(GL, 4); A2_GAPB(o[1] = __builtin_amdgcn_mfma_f32_32x32x16_bf16(A2_PAF(2), A2_VFR(6), o[1], 0, 0, 0), C1, 4); \
    A2_KRD(GL, 5); A2_GAPB(o[0] = __builtin_amdgcn_mfma_f32_32x32x16_bf16(A2_PAF(3), A2_VFR(3), o[0], 0, 0, 0), C1, 8); \
    A2_GAPB(o[1] = __builtin_amdgcn_mfma_f32_32x32x16_bf16(A2_PAF(3), A2_VFR(7), o[1], 0, 0, 0), C1, 12); \
    } while (0)
    int t = 1;
    for (; t + 5 < NT; t += 2) {
        A2_STEP(pB0, pB1, pA0, pA1, t, true, true, true);     A2_WAIT_BAR(3); A2_RESC(); A2_ROT();
        A2_STEP(pA0, pA1, pB0, pB1, t + 1, true, true, true); A2_WAIT_BAR(3); A2_RESC(); A2_ROT();
    }
#define A2_ENDW(tt) do { if ((tt) + 3 < NT) { A2_WAIT_BAR(3); } else if ((tt) + 2 < NT) { A2_WAIT_BAR(1); } else { A2_WAIT_BAR(0); } } while (0)
    for (; t + 1 < NT; t += 2) {
        A2_STEP(pB0, pB1, pA0, pA1, t, (t + 3 < NT), (t + 1 < NT), (t + 1 < NT));     A2_ENDW(t);     A2_RESC(); A2_ROT();
        A2_STEP(pA0, pA1, pB0, pB1, t + 1, (t + 4 < NT), (t + 2 < NT), (t + 2 < NT)); A2_ENDW(t + 1); A2_RESC(); A2_ROT();
    }
    A2_STEP(pB0, pB1, pA0, pA1, NT - 1, false, false, false); A2_RESC();
    { float sacc = pB0[0] + pB0[1];
#pragma unroll
      for (int r = 2; r < 16; ++r) sacc += pB0[r];
#pragma unroll
      for (int r = 0; r < 16; ++r) sacc += pB1[r];
      l_reg += sacc;
      pw0 = (u32x4){A2_PKW(pB0, 0), A2_PKW(pB0, 2), A2_PKW(pB0, 4), A2_PKW(pB0, 6)}; pw1 = (u32x4){A2_PKW(pB0, 8), A2_PKW(pB0, 10), A2_PKW(pB0, 12), A2_PKW(pB0, 14)};
      pw2 = (u32x4){A2_PKW(pB1, 0), A2_PKW(pB1, 2), A2_PKW(pB1, 4), A2_PKW(pB1, 6)}; pw3 = (u32x4){A2_PKW(pB1, 8), A2_PKW(pB1, 10), A2_PKW(pB1, 12), A2_PKW(pB1, 14)};
      A2_SBAR();
      const int vb = (int)lds0 + LDS_V + ((lane >> 4) & 1) * 32 + (lane & 3) * 8 + (4 * hi + ((lane & 15) >> 2)) * 64 + sl_cur * VSL;
      att::pv(o, vb, A2_PAF(0), A2_PAF(1), A2_PAF(2), A2_PAF(3)); }
    { auto rr = __builtin_amdgcn_permlane32_swap(__float_as_uint(l_reg), __float_as_uint(l_reg), false, false); l_reg = __uint_as_float(rr[0]) + __uint_as_float(rr[1]); }
    if (hi == 0) wsf[32 + r32] = l_reg; LDS_WAIT();
    float rli[16];
#pragma unroll
    for (int r = 0; r < 16; ++r) rli[r] = __builtin_amdgcn_rcpf(wsf[32 + crow(r, hi)]);
    LAS bf16_t* stg = (LAS bf16_t*)(F.lds + LDS_OST) + wid * 2048;
#pragma unroll
    for (int r = 0; r < 16; ++r) { const int orow_ = crow(r, hi);
#pragma unroll
        for (int d0 = 0; d0 < 2; ++d0) stg[orow_ * 64 + d0 * 32 + r32] = (bf16_t)f2bf(o[d0][r] * rli[r]); }
    LDS_WAIT();
    bf16_t* Ow = (bf16_t*)(F.ws + WS_YC) + (size_t)(orow + wid * 32) * 1024 + 256 + h * 64;
#pragma unroll
    for (int i = 0; i < 4; ++i) { const int row = i * 8 + (lane >> 3), ch = lane & 7; const u32x4 v = *(const LAS u32x4*)(stg + row * 64 + ch * 8); *(u32x4*)(Ow + (size_t)row * 1024 + ch * 8) = v; }
    asm volatile("s_waitcnt lgkmcnt(0)\n\ts_barrier" ::: "memory");
}
}

__device__ __forceinline__ void ph_norm2_route(const Frame& F, int l, int ntok) {
    LAS bf16_t* A = (LAS bf16_t*)F.lds;
    LAS float* PART = (LAS float*)(F.lds + 66048);
    LAS float* LOG = (LAS float*)(F.lds + 131584);
    LAS int* HIST = (LAS int*)(F.lds + 139776);
    const int tid = F.tid, lane = F.lane, wave = F.wave, r32 = lane & 31, hi = lane >> 5;
    const int tpb = ntok / F.G, tok0 = F.bx * tpb;
    int* eidx = (int*)(F.ws + T_EIDX); float* ew = (float*)(F.ws + T_EW);
    const float* brt = F.in[I_BRT] + l * 64;
    if (tid < 64) HIST[tid] = 0;
    for (int b0 = 0; b0 < tpb; b0 += 32) {
        __syncthreads();
        for (int rr = 0; rr < 4; ++rr) { const int r = wave * 4 + rr, t = b0 + r; LAS u32x2* a = (LAS u32x2*)(A + r * 1032) + lane;
            if (t < tpb) { const int row = tok0 + t, mr = mod_row_of(row); f32x4 y[4], v[4];
                { const f32x4* xr = (const f32x4*)stream_row(F, l, row) + lane; const u32x2* mg = (const u32x2*)((const bf16_t*)(F.ws + WS_YC) + (size_t)row * 1024) + lane;
                  f32x4* xo = (f32x4*)((row < NLAT) ? F.out + (size_t)row * 1024 : (float*)(F.ws + WS_CTXS) + (size_t)(row - NLAT) * 1024) + lane;
#pragma unroll
                  for (int j = 0; j < 4; ++j) { const u32x2 w = mg[64 * j]; v[j] = xr[64 * j] + (f32x4){bflo(w.x), bfhi(w.x), bflo(w.y), bfhi(w.y)}; xo[64 * j] = v[j]; } }
                normmod_vals(lane, v, F.in[I_GFFN] + l * 1024, modp(F, l, mr, 4), modp(F, l, mr, 3), y);
                unsigned* o8 = (unsigned*)(F.ws + WS_HX8 + (size_t)row * 1024) + lane;
#pragma unroll
                for (int j = 0; j < 4; ++j) { a[64 * j] = (u32x2){pk2(y[j].x, y[j].y), pk2(y[j].z, y[j].w)}; o8[64 * j] = pk4_fp8(y[j].x, y[j].y, y[j].z, y[j].w); }
            } else {
#pragma unroll
                for (int j = 0; j < 4; ++j) a[64 * j] = (u32x2){0u, 0u}; } }
        __syncthreads();
#pragma unroll
        for (int nt = 0; nt < 2; ++nt) { f32x16 acc = {}; acc = mma32_lg<8>(acc, A + wave * 128, 1032, (const bf16_t*)(F.ws + W_RT) + (size_t)nt * 32 * 1024 + wave * 128, 1024, lane);
#pragma unroll
            for (int r = 0; r < 16; ++r) PART[(wave * 32 + crow(r, hi)) * 64 + nt * 32 + r32] = acc[r]; }
        __syncthreads();
        for (int i = tid; i < 2048; i += NTHR) { float s = 0.f;
#pragma unroll
            for (int w = 0; w < 8; ++w) s += PART[w * 2048 + i];
            LOG[i] = s; }
        __syncthreads();
        for (int rr = 0; rr < 4; ++rr) { const int r = wave * 4 + rr, t = b0 + r; if (t >= tpb) continue;
            const float sc = sigmoidf_(LOG[r * 64 + lane]); float v = sc + brt[lane]; float ssel = 0.f, mys = 0.f; int myi = 0;
#pragma unroll
            for (int k = 0; k < TOPK; ++k) { const float mx = wave_max(v); const unsigned long long bal = __ballot(v == mx); const int win = __ffsll((long long)bal) - 1;
                const float sw = lane_bcast(sc, win); ssel += sw; if (lane == k) { mys = sw; myi = win; } if (lane == win) v = -INFINITY; }
            if (lane < TOPK) { eidx[(size_t)(tok0 + t) * 6 + lane] = myi; ew[(size_t)(tok0 + t) * 6 + lane] = mys / ssel * 2.5f; __hip_atomic_fetch_add(&HIST[myi], 1, __ATOMIC_RELAXED, __HIP_MEMORY_SCOPE_WORKGROUP); } }
    }
    __syncthreads();
    if (tid < 64) ((int*)(F.ws + T_HIST))[F.bx * 64 + tid] = HIST[tid];
}

__device__ __forceinline__ void ph_assign(const Frame& F, int c, int ntok) {
    LAS int* BASE = (LAS int*)F.lds; LAS int* CUR = BASE + 64; LAS int* START = BASE + 128; LAS int* TOT = BASE + 192; LAS int* MISC = BASE + 256;
    const int tid = F.tid, hb = F.G / 2, tpb = ntok / F.G, ctok0 = c * hb * tpb, ctoks = hb * tpb;
    const int* hist = (const int*)(F.ws + T_HIST); int* rtok = (int*)(F.ws + T_RTOK); float* rw = (float*)(F.ws + T_RW); int* slot = (int*)(F.ws + T_SLOT);
    int* tile_e = (int*)(F.ws + T_TILEE) + c * 1024;
    if (F.bx / hb != c) return;
    __syncthreads();
    if (tid < 64) { int tot = 0, bef = 0; for (int b = c * hb; b < (c + 1) * hb; ++b) { const int v = hist[b * 64 + tid]; tot += v; if (b < F.bx) bef += v; } TOT[tid] = tot; BASE[tid] = bef; CUR[tid] = 0; }
    __syncthreads();
    if (tid == 0) { int s = 0; for (int e = 0; e < 64; ++e) { START[e] = s; s += (TOT[e] + 255) / 256 * 256; } MISC[0] = s; }
    __syncthreads();
    const int sstart = MISC[0];
    const int* eidx = (const int*)(F.ws + T_EIDX); const float* ew = (const float*)(F.ws + T_EW);
    for (int i = tid; i < tpb * 6; i += NTHR) { const int tok = F.bx * tpb + i / 6, k = i % 6; const int e = eidx[(size_t)tok * 6 + k];
        const int pos = START[e] + BASE[e] + __hip_atomic_fetch_add(&CUR[e], 1, __ATOMIC_RELAXED, __HIP_MEMORY_SCOPE_WORKGROUP); rtok[pos] = tok; rw[pos] = ew[(size_t)tok * 6 + k]; slot[(size_t)tok * 8 + k] = pos; }
    for (int i = tid; i < tpb; i += NTHR) { const int tok = F.bx * tpb + i, pos = sstart + (tok - ctok0); rtok[pos] = tok; rw[pos] = 1.0f; slot[(size_t)tok * 8 + 6] = pos; }
    if (F.bx == c * hb) {
        for (int e = 0; e < 64; ++e) { const int p0 = START[e] + TOT[e], p1 = START[e] + (TOT[e] + 255) / 256 * 256;
            for (int p = p0 + tid; p < p1; p += NTHR) { rtok[p] = ctok0; rw[p] = 0.f; }
            for (int tl = START[e] / 256 + tid; tl < p1 / 256; tl += NTHR) tile_e[tl] = e; }
        for (int tl = sstart / 256 + tid; tl < (sstart + ctoks) / 256; tl += NTHR) tile_e[tl] = 64;
        if (tid == 0) tile_e[1023] = (sstart + ctoks) / 256;
    }
}

__device__ __forceinline__ void ph_combine(const Frame& F, int l, int c, int ntok) {
    const int gw = F.bx * NWAVES + F.wave, ngw = F.G * NWAVES, lane = F.lane; const int ctoks = ntok / 2, ctok0 = c * ctoks;
    const int* slot = (const int*)(F.ws + T_SLOT); const bf16_t* ys = (const bf16_t*)(F.ws + WS_YS);
    for (int t = gw; t < ctoks; t += ngw) { const int tok = ctok0 + t, mr = mod_row_of(tok);
        float* xr = (tok < NLAT) ? F.out + (size_t)tok * 1024 : (float*)(F.ws + WS_CTXS) + (size_t)(tok - NLAT) * 1024;
        const float* gt = modp(F, l, mr, 5);
        const int sv = slot[(size_t)tok * 8 + (lane & 7)];
        u32x4 y[7][2];
#pragma unroll
        for (int k = 0; k < 7; ++k) { const int sk = __builtin_amdgcn_readlane(sv, k); const u32x4* yr = (const u32x4*)(ys + (size_t)sk * 1024) + lane; y[k][0] = yr[0]; y[k][1] = yr[64]; }
        f32x4 xv[2][2];
#pragma unroll
        for (int j = 0; j < 2; ++j) { xv[j][0] = *(const f32x4*)(xr + 8 * lane + 512 * j); xv[j][1] = *(const f32x4*)(xr + 8 * lane + 512 * j + 4); }
#pragma unroll
        for (int j = 0; j < 2; ++j) { f32x4 a0 = {0.f, 0.f, 0.f, 0.f}, a1 = {0.f, 0.f, 0.f, 0.f};
#pragma unroll
            for (int k = 0; k < 7; ++k) { const u32x4 w = y[k][j]; a0 += (f32x4){bflo(w.x), bfhi(w.x), bflo(w.y), bfhi(w.y)}; a1 += (f32x4){bflo(w.z), bfhi(w.z), bflo(w.w), bfhi(w.w)}; }
            const f32x4 g0 = *(const f32x4*)(gt + 8 * lane + 512 * j), g1 = *(const f32x4*)(gt + 8 * lane + 512 * j + 4);
            *(f32x4*)(xr + 8 * lane + 512 * j) = xv[j][0] + g0 * a0; *(f32x4*)(xr + 8 * lane + 512 * j + 4) = xv[j][1] + g1 * a1; }
    }
}
__device__ __forceinline__ Frame phase_frame(const Frame& F) {
    Frame Q = F; int t = threadIdx.x; asm volatile("" : "+v"(t)); Q.tid = t; Q.lane = t & 63; Q.wave = __builtin_amdgcn_readfirstlane(t >> 6);
    unsigned long long w = (unsigned long long)F.ws; asm volatile("" : "+s"(w)); Q.ws = (unsigned char*)(GAS unsigned char*)w;
    return Q;
}
constexpr int PH_PER_LAYER = 19, PH_TOTAL = 1 + 2 * PH_PER_LAYER;
__global__ void __launch_bounds__(NTHR, 2) mk_fwd(Params p) {
    extern __shared__ __attribute__((aligned(16))) unsigned char lds_raw[];
    Frame F0;
    F0.lds = (LAS unsigned char*)lds_raw; F0.ws = p.ws; F0.in = p.in; F0.out = p.out;
    F0.tid = threadIdx.x; F0.lane = F0.tid & 63; F0.wave = __builtin_amdgcn_readfirstlane(F0.tid >> 6); F0.bx = blockIdx.x; F0.G = gridDim.x;
    volatile LAS unsigned* MISC = (volatile LAS unsigned*)(F0.lds + MISC_OFF);
    if (F0.tid < 64) MISC[F0.tid] = 0u;
    __syncthreads();
    const int lo = p.ph_lo, hi = p.ph_hi;
    XcdBarrier bar; bar.bar = (unsigned*)(F0.ws + WS_CTL) + CW_BAR; bar.x = 0; bar.st = MISC + 8;
    if (hi - lo > 1) bar = xcd_barrier_post((unsigned*)(F0.ws + WS_CTL) + CW_BAR, MISC + 8);
#ifndef MK_SITE
#define MK_SITE -1
#endif
#define SITE(n) (MK_SITE < 0 || MK_SITE == (n))
#ifndef MK_REP_MASK
#define MK_REP_MASK 0
#endif
#define NREP(n) (((MK_REP_MASK >> (n)) & 1) ? 2 : 1)
#define RUN(k) (lo <= (k) && (k) < hi)
#define SEAM(k) do { if (RUN(k) && RUN((k) + 1)) xcd_barrier(bar); } while (0)
    int ph = 0;
    if (SITE(0) && RUN(ph)) for (int rep_ = 0; rep_ < NREP(0); ++rep_) { const Frame F = phase_frame(F0); ph_pre(F); }
    SEAM(ph); ++ph;
    for (int l = 0; l < 2; ++l) {
        const int ntok = (l == 0) ? NTOK : NLAT, nM = ntok / 256;
        if (SITE(1) && RUN(ph)) for (int rep_ = 0; rep_ < NREP(1); ++rep_) { const Frame F = phase_frame(F0); ph_convert(F, l); __syncthreads(); ph_norm1(F, l); }
        SEAM(ph); ++ph;
        if (SITE(2) && RUN(ph)) for (int rep_ = 0; rep_ < NREP(2); ++rep_) { const Frame F = phase_frame(F0);
            SchedPlain S{(const char*)(F.ws + WS_HX), (const char*)(F.ws + W_IN), 2048u, 2048u, 16, NTOK / 256, INCP / 256, F.G, F.bx};
            EpiWin E{(bf16_t*)(F.ws + WS_PX), (float*)(F.ws + T_GATE)};
            gg::gemm_phase(F.lds, S, E);
        }
        SEAM(ph); ++ph;
        if (SITE(3) && RUN(ph)) for (int rep_ = 0; rep_ < NREP(3); ++rep_) { const Frame F = phase_frame(F0);
            for (int r2 = 0; r2 < NREP(16); ++r2) for (int u = F.bx; u < NTOK / 32; u += F.G) mla_unit(F, l, u, (u * 32 < NLAT) || l == 0);
            for (int r2 = 0; r2 < NREP(17); ++r2) for (int u = F.bx; u < 64 * NCHK; u += F.G) ml_pass1_unit(F, l, u);
            for (int r2 = 0; r2 < NREP(18); ++r2) for (int u = F.bx; u < ntok / 64; u += F.G) pool_unit(F, l, u);
            for (int r2 = 0; r2 < NREP(19); ++r2) conv_all(F, l, ntok);
            __syncthreads();
        }
        SEAM(ph); ++ph;
        if (SITE(4) && RUN(ph)) for (int rep_ = 0; rep_ < NREP(4); ++rep_) { const Frame F = phase_frame(F0);
            ml_pass2(F);
            const int nunits = 1024 + (l == 0 ? 32 : 0);
            for (int i = 0; ; ++i) { const int L = i * F.G + F.bx; if (L >= nunits) break;
                if (L < 1024) { const int bh = (L >> 8) * 8 + (L & 7), qb = (L & 255) >> 3, b = bh >> 2; att2::unit(F, bh, b * 8192 + qb * 256, b * 8192 + qb * 256, 132); }
                else { const int bh = L - 1024, b = bh >> 2; att2::unit(F, bh, NLAT + b * 256, NLAT + b * 256, 4); } }
        }
        SEAM(ph); ++ph;
        if (SITE(5) && RUN(ph)) for (int rep_ = 0; rep_ < NREP(5); ++rep_) { const Frame F = phase_frame(F0);
            const int npc = (l == 0) ? 66 : 64, nun = 32 * npc;
            for (int u = F.bx; u < nun; u += F.G) { const int bh = u / npc, pc = u % npc + (l == 0 ? 0 : 2); ml_pass3_unit(F, l, bh >> 2, bh & 3, pc); }
            __syncthreads();
        }
        SEAM(ph); ++ph;
        for (int hh = 0; hh < 2; ++hh) {
            const int nMh = nM / 2, pm0 = hh * nMh;
            if (SITE(6) && RUN(ph)) for (int rep_ = 0; rep_ < NREP(6); ++rep_) { const Frame F = phase_frame(F0);
                SchedYB S{(const char*)(F.ws + WS_YC), (const char*)(F.ws + W_BR), pm0, nMh, F.G, F.bx};
                EpiBf16Plain E{(bf16_t*)(F.ws + WS_YB), 4096};
                gg::gemm_phase(F.lds, S, E);
            }
            SEAM(ph); ++ph;
            if (SITE(13) && RUN(ph)) for (int rep_ = 0; rep_ < NREP(13); ++rep_) { const Frame F = phase_frame(F0);
                SchedPlain S{(const char*)(F.ws + WS_HX8) + (size_t)pm0 * 256 * 1024, (const char*)(F.ws + W_GATE), 1024u, 1024u, 8, nMh, 16, F.G, F.bx};
                EpiMerge2 E{(const bf16_t*)(F.ws + WS_YB), F.in[I_BGATE] + l * 4096, (bf16_t*)(F.ws + WS_ACCM) + (size_t)pm0 * 256 * 1024, 0};
                gg::gemm_phase(F.lds, S, E);
            }
            SEAM(ph); ++ph;
        }
        if (SITE(7) && RUN(ph)) for (int rep_ = 0; rep_ < NREP(7); ++rep_) { const Frame F = phase_frame(F0);
            SchedPlain S{(const char*)(F.ws + WS_ACCM), (const char*)(F.ws + W_OUT), 2048u, 2048u, 16, nM, 4, F.G, F.bx};
            EpiWout E{(bf16_t*)(F.ws + WS_YC), modp(F, l, 0, 2)};
            gg::gemm_phase(F.lds, S, E);
        }
        SEAM(ph); ++ph;
        if (SITE(8) && RUN(ph)) for (int rep_ = 0; rep_ < NREP(8); ++rep_) { const Frame F = phase_frame(F0); ph_norm2_route(F, l, ntok); }
        SEAM(ph); ++ph;
        for (int c = 0; c < 2; ++c) {

            if (SITE(9) && RUN(ph)) for (int rep_ = 0; rep_ < NREP(9); ++rep_) { const Frame F = phase_frame(F0); ph_assign(F, c, ntok); }
            SEAM(ph); ++ph;
            if (SITE(10) && RUN(ph)) for (int rep_ = 0; rep_ < NREP(10); ++rep_) { const Frame F = phase_frame(F0);
                int* tile_e = (int*)(F.ws + T_TILEE) + c * 1024; const int ntiles = ld_i32_uniform(tile_e + 1023);
                SchedMoe1 S{(const char*)(F.ws + WS_HX8), (const char*)(F.ws + W_13), (const int*)(F.ws + T_RTOK), tile_e, ntiles, F.G, F.bx};
                EpiMoe1 E{(bf16_t*)(F.ws + WS_AMOE), (const float*)(F.ws + T_RW)};
                gg::gemm_phase(F.lds, S, E);
            }
            SEAM(ph); ++ph;
            if (SITE(11) && RUN(ph)) for (int rep_ = 0; rep_ < NREP(11); ++rep_) { const Frame F = phase_frame(F0);
                int* tile_e = (int*)(F.ws + T_TILEE) + c * 1024; const int ntiles = ld_i32_uniform(tile_e + 1023);
                SchedMoe2 S{(const char*)(F.ws + WS_AMOE), (const char*)(F.ws + W_2), tile_e, ntiles, F.G, F.bx};
                EpiBf16Plain E{(bf16_t*)(F.ws + WS_YS), 1024};
                gg::gemm_phase(F.lds, S, E);
            }
            SEAM(ph); ++ph;
            if (SITE(12) && RUN(ph)) for (int rep_ = 0; rep_ < NREP(12); ++rep_) { const Frame F = phase_frame(F0); ph_combine(F, l, c, ntok); }
            SEAM(ph); ++ph;
        }
    }
#undef RUN
#undef SEAM
}

extern "C" void kernel_launch(void* const* d_in, const int* in_sizes, int n_in, void* d_out, int out_size, void* d_ws, size_t ws_size, hipStream_t stream) {
    static int grid = 0;
    if (grid == 0) {
        if (n_in != 33 || out_size != NLAT * DM || ws_size < WS_END) { fprintf(stderr, "kernel_launch: unexpected shapes (n_in %d, out %d, ws %zu < %zu)\n", n_in, out_size, ws_size, (size_t)WS_END); grid = -1; return; }
        int dev = 0, cus = 0;
        if (hipGetDevice(&dev) != hipSuccess || hipDeviceGetAttribute(&cus, hipDeviceAttributeMultiprocessorCount, dev) != hipSuccess) { grid = -1; return; }
        if (hipFuncSetAttribute((const void*)mk_fwd, hipFuncAttributeMaxDynamicSharedMemorySize, LDS_BYTES) != hipSuccess) { fprintf(stderr, "kernel_launch: hipFuncSetAttribute failed\n"); grid = -1; return; }
        int per_cu = 0;
        if (hipOccupancyMaxActiveBlocksPerMultiprocessor(&per_cu, (const void*)mk_fwd, NTHR, LDS_BYTES) != hipSuccess || per_cu < 1) fprintf(stderr, "kernel_launch: occupancy query says %d\n", per_cu);
        (void)hipGetLastError();
        grid = cus;
    }
    if (grid < 0) return;
    (void)hipMemsetAsync((char*)d_ws + WS_CTL, 0, CTL_ZERO_BYTES, stream);
    Params p{};
    for (int i = 0; i < 33; ++i) p.in[i] = (const float*)d_in[i];
    p.out = (float*)d_out; p.ws = (unsigned char*)d_ws;
#if MK_ONE_LAUNCH
    p.ph_lo = 0; p.ph_hi = PH_TOTAL;
    hipLaunchKernelGGL(mk_fwd, dim3(grid), dim3(NTHR), LDS_BYTES, stream, p);
#else
    for (int k = 0; k < PH_TOTAL; ++k) { p.ph_lo = k; p.ph_hi = k + 1; hipLaunchKernelGGL(mk_fwd, dim3(grid), dim3(NTHR), LDS_BYTES, stream, p); }
#endif
}
```

```cpp
#include <hip/hip_runtime.h>
#include <stdint.h>
#include <stdio.h>
#include <math.h>

#ifndef MK_ONE_LAUNCH
#define MK_ONE_LAUNCH 1
#endif

#define LAS __attribute__((address_space(3)))
#define GAS __attribute__((address_space(1)))
typedef unsigned short bf16_t;
typedef short bf16x8 __attribute__((ext_vector_type(8)));
typedef short s16x4 __attribute__((ext_vector_type(4)));
typedef float f32x2 __attribute__((ext_vector_type(2)));
typedef float f32x4 __attribute__((ext_vector_type(4)));
typedef float f32x16 __attribute__((ext_vector_type(16)));
typedef unsigned u32x2 __attribute__((ext_vector_type(2)));
typedef unsigned u32x4 __attribute__((ext_vector_type(4)));

constexpr int DM = 1024, NB = 8, SEQ = 8192, CTXL = 256, GRIDW = 64;
constexpr int NLAT = NB * SEQ, NCTX = NB * CTXL, NTOK = NLAT + NCTX;
constexpr int INC = 2480, INCP = 2560;
constexpr int C_ML = 0, C_G = 1024, C_MLA = 1040, C_POOL = 1456, C_CONV = 1712;
constexpr int NE = 64, NE1 = 65, TOPK = 6, NSLOT7 = 7, EFF = 256;
constexpr int NCHK = 66;
constexpr int NKT = 132;
constexpr float EPS = 1e-6f;
constexpr int NWAVES = 8, NTHR = 512;
constexpr int MOE_ROWS_MAX = 489472;
constexpr int MOE_TILES_MAX = MOE_ROWS_MAX / 256;

constexpr size_t MiB = 1u << 20;
constexpr size_t WS_CTL = 0, CTL_ZERO_BYTES = 1 * MiB;
constexpr size_t WS_MOD = 128 * 1024;
constexpr size_t WS_TAB = 1 * MiB;
constexpr size_t T_ROPE = WS_TAB;
constexpr size_t T_HIST = T_ROPE + 16384;
constexpr size_t T_TILEE = T_HIST + 65536;
constexpr size_t T_EIDX = T_TILEE + 8192;
constexpr size_t T_EW = T_EIDX + (size_t)NTOK * 6 * 4;
constexpr size_t T_SLOT = T_EW + (size_t)NTOK * 6 * 4;
constexpr size_t T_RTOK = T_SLOT + (size_t)NTOK * 8 * 4;
constexpr size_t T_RW = T_RTOK + (size_t)MOE_ROWS_MAX * 4;
constexpr size_t T_GATE = T_RW + (size_t)MOE_ROWS_MAX * 4;
constexpr size_t T_DN = T_GATE + (size_t)NTOK * 16 * 4;
constexpr size_t T_NST = T_DN + (size_t)4224 * 64 * 4;
constexpr size_t T_MLOC = T_NST + (size_t)4224 * 64 * 4;
constexpr size_t T_BEND = T_MLOC + 4224 * 4;
constexpr size_t T_MST = T_BEND + 4224 * 4;
constexpr size_t T_END = T_MST + 4224 * 4;
static_assert(T_END <= 17 * MiB, "tables");
constexpr size_t WS_WB = 17 * MiB;
constexpr size_t W_IN = WS_WB;
constexpr size_t W_GATE = W_IN + (size_t)INCP * 1024 * 2;
constexpr size_t W_BR = W_GATE + (size_t)4 * 1024 * 1024 * 2;
constexpr size_t W_OUT = W_BR + (size_t)4 * 1024 * 256 * 2;
constexpr size_t W_13 = W_OUT + (size_t)1024 * 1024 * 2;
constexpr size_t W_2 = W_13 + (size_t)NE1 * 512 * 1024 * 2;
constexpr size_t W_UQ = W_2 + (size_t)NE1 * 1024 * 256 * 2;
constexpr size_t W_UKV = W_UQ + (size_t)384 * 256 * 2;
constexpr size_t W_POOL = W_UKV + (size_t)512 * 128 * 2;
constexpr size_t W_RT = W_POOL + (size_t)4 * 64 * 64 * 2;
constexpr size_t W_END = W_RT + (size_t)64 * 1024 * 2;
static_assert(W_END <= 133 * MiB, "weights");
constexpr size_t WS_CTXS = 133 * MiB;
constexpr size_t WS_HX = 141 * MiB;
constexpr size_t WS_PX = 273 * MiB;
constexpr size_t WS_QB = 593 * MiB;
constexpr size_t WS_KT = 643 * MiB;
constexpr size_t WS_VT = 693 * MiB;
constexpr size_t WS_YC = 726 * MiB;
constexpr size_t WS_DC = 858 * MiB;
constexpr size_t WS_CST = 924 * MiB;
constexpr size_t WS_HX8 = 957 * MiB;
constexpr size_t WS_END = 1023 * MiB;
constexpr size_t WS_ACCM = WS_QB;
constexpr size_t WS_YB = WS_PX;
constexpr size_t WS_AMOE = WS_HX;
constexpr size_t WS_YS = WS_HX + 240 * MiB;
static_assert(WS_AMOE + (size_t)MOE_ROWS_MAX * 512 <= WS_YS && WS_YS + (size_t)MOE_ROWS_MAX * 1024 <= WS_HX8, "moe overlay");
static_assert(WS_YB + (size_t)NTOK * 4096 <= WS_QB && WS_ACCM + (size_t)NTOK * 2048 <= WS_YC, "merge overlay");

constexpr int CW_BAR = 4096;

constexpr int RING_BYTES = 131072;
constexpr int MISC_OFF = 160 * 1024 - 256;
constexpr int LDS_BYTES = 160 * 1024;

#ifndef MK_TSEC
#define MK_TSEC -1
#endif
#define TSEC_BEGIN(id, ldsb) do { if (MK_TSEC == (id) && blockIdx.x == 0 && threadIdx.x == 0) { volatile LAS unsigned long long* q_ = (volatile LAS unsigned long long*)((ldsb) + MISC_OFF + 128); q_[1] = __builtin_amdgcn_s_memrealtime(); } } while (0)
#define TSEC_END(id, ldsb) do { if ((MK_TSEC == (id) || ((id) == 499 && MK_TSEC >= 400 && MK_TSEC < 499)) && blockIdx.x == 0 && threadIdx.x == 0) { volatile LAS unsigned long long* q_ = (volatile LAS unsigned long long*)((ldsb) + MISC_OFF + 128); if (q_[1] != 0ull) { q_[0] += __builtin_amdgcn_s_memrealtime() - q_[1]; q_[1] = 0ull; } } } while (0)
typedef __bf16 bf16x2_t_ __attribute__((ext_vector_type(2)));
__device__ __forceinline__ unsigned pk2(float lo, float hi) { const f32x2 v = {lo, hi}; return __builtin_bit_cast(unsigned, __builtin_convertvector(v, bf16x2_t_)); }
__device__ __forceinline__ unsigned f2bf(float f) { return pk2(f, f) & 0xffffu; }
__device__ __forceinline__ float bf2f(unsigned short b) { return __builtin_bit_cast(float, ((unsigned)b) << 16); }
__device__ __forceinline__ float bflo(unsigned w) { return __builtin_bit_cast(float, w << 16); }
__device__ __forceinline__ float bfhi(unsigned w) { return __builtin_bit_cast(float, w & 0xffff0000u); }
__device__ __forceinline__ unsigned cvt_pk_bf16(float lo, float hi) { unsigned r; asm volatile("v_cvt_pk_bf16_f32 %0, %1, %2" : "=v"(r) : "v"(lo), "v"(hi)); return r; }
__device__ __forceinline__ unsigned pk4_fp8(float a, float b, float c, float d) { int r = __builtin_amdgcn_cvt_pk_fp8_f32(a, b, 0, false); r = __builtin_amdgcn_cvt_pk_fp8_f32(c, d, r, true); return (unsigned)r; }
__device__ __forceinline__ float sigmoidf_(float x) { return __builtin_amdgcn_rcpf(1.0f + __builtin_amdgcn_exp2f(x * -1.4426950408889634f)); }
template <int O> __device__ __forceinline__ float xor_lane(float v) { return __builtin_bit_cast(float, __builtin_amdgcn_ds_swizzle(__builtin_bit_cast(int, v), 0x1f | (O << 10))); }
__device__ __forceinline__ float half_sum(float v) { v += xor_lane<1>(v); v += xor_lane<2>(v); v += xor_lane<4>(v); v += xor_lane<8>(v); v += xor_lane<16>(v); return v; }
__device__ __forceinline__ float half_max(float v) { v = fmaxf(v, xor_lane<1>(v)); v = fmaxf(v, xor_lane<2>(v)); v = fmaxf(v, xor_lane<4>(v)); v = fmaxf(v, xor_lane<8>(v)); v = fmaxf(v, xor_lane<16>(v)); return v; }
__device__ __forceinline__ float wave_sum(float v) { v = half_sum(v); auto rr = __builtin_amdgcn_permlane32_swap(__builtin_bit_cast(unsigned, v), __builtin_bit_cast(unsigned, v), false, false);
    return __builtin_bit_cast(float, (unsigned)rr[0]) + __builtin_bit_cast(float, (unsigned)rr[1]); }
__device__ __forceinline__ float wave_max(float v) { v = half_max(v); auto rr = __builtin_amdgcn_permlane32_swap(__builtin_bit_cast(unsigned, v), __builtin_bit_cast(unsigned, v), false, false);
    return fmaxf(__builtin_bit_cast(float, (unsigned)rr[0]), __builtin_bit_cast(float, (unsigned)rr[1])); }
__device__ __forceinline__ float lane_up(float v, int o, int lane) { return __builtin_bit_cast(float, __builtin_amdgcn_ds_bpermute(((lane - o) & 63) << 2, __builtin_bit_cast(int, v))); }
__device__ __forceinline__ float lane_bcast(float v, int src) { return __builtin_bit_cast(float, __builtin_amdgcn_readlane(__builtin_bit_cast(int, v), src)); }
__device__ __forceinline__ float frcp(float x) { return __builtin_amdgcn_rcpf(x); }
__device__ __forceinline__ float frsq(float x) { return __builtin_amdgcn_rsqf(x); }
#define LDS_WAIT() asm volatile("s_waitcnt lgkmcnt(0)" ::: "memory")
#define LDS_BAR() asm volatile("s_waitcnt lgkmcnt(0)\n\ts_barrier" ::: "memory")
#define VM_WAIT() asm volatile("s_waitcnt vmcnt(0)" ::: "memory")

#define XB_TMO      128
#define XB_XCNT(j)  (256  + 64 * (j))
#define XB_XSUB(j)  (1280 + 64 * (j))
#define XB_XGEN(j)  (2304 + 64 * (j))
#define XB_TOP      3328
#define XB_TOPGEN   3392
#define XCD_BAR_WORDS 3456
#define XB_SPIN_CAP (1u << 22)

__device__ __forceinline__ unsigned xb_ld(unsigned* p)              { return __hip_atomic_load(p, __ATOMIC_RELAXED, __HIP_MEMORY_SCOPE_AGENT); }
__device__ __forceinline__ unsigned xb_add(unsigned* p, unsigned v) { return __hip_atomic_fetch_add(p, v, __ATOMIC_RELAXED, __HIP_MEMORY_SCOPE_AGENT); }
__device__ __forceinline__ unsigned xb_xcc_id() { return (unsigned)__builtin_amdgcn_s_getreg((3 << 11) | 20) & 0xFu; }
#define XB_SPIN(cond, bar) do { unsigned _sp = 0; while (cond) { __builtin_amdgcn_s_sleep(1); \
    if ((++_sp & 255u) == 0u) { if (xb_ld(&(bar)[XB_TMO])) break; if (_sp > XB_SPIN_CAP) { atomicAdd(&(bar)[XB_TMO], 1u); break; } } } } while (0)

struct XcdBarrier { unsigned* bar; unsigned x; volatile LAS unsigned* st; };

__device__ __forceinline__ XcdBarrier xcd_barrier_post(unsigned* bar, volatile LAS unsigned* st) {
    XcdBarrier b; b.bar = bar; b.x = xb_xcc_id(); b.st = st;
    if (threadIdx.x == 0) (void)xb_add(&bar[XB_XCNT(b.x)], 1u);
    return b;
}
__device__ __forceinline__ void xcd_barrier_complete(unsigned* bar, unsigned x, unsigned& nloc, unsigned& nx) {
    const unsigned G = gridDim.x * gridDim.y * gridDim.z;
    unsigned sum, cnt, mine, sp = 0u;
    for (;;) {
        sum = 0u; cnt = 0u; mine = 0u;
#pragma unroll
        for (unsigned j = 0; j < 16; ++j) { const unsigned c = xb_ld(&bar[XB_XCNT(j)]); sum += c; cnt += (c > 0u) ? 1u : 0u; mine = (j == x) ? c : mine; }
        if (sum == G) break;
        __builtin_amdgcn_s_sleep(1);
        if ((++sp & 255u) == 0u) { if (xb_ld(&bar[XB_TMO])) break; if (sp > XB_SPIN_CAP) { atomicAdd(&bar[XB_TMO], 1u); break; } }
    }
    nloc = mine > 0u ? mine : 1u; nx = cnt > 0u ? cnt : 1u;
}
__device__ __forceinline__ void xcd_barrier(const XcdBarrier& b) {
    asm volatile("s_waitcnt vmcnt(0)" ::: "memory");
    __syncthreads();
    if (threadIdx.x == 0) {
        unsigned* bar = b.bar;
        __builtin_amdgcn_s_waitcnt(0);
        unsigned nloc = b.st[0], nx = b.st[1];
        if (nloc == 0u) { xcd_barrier_complete(bar, b.x, nloc, nx); b.st[0] = nloc; b.st[1] = nx; }
        const unsigned old = xb_add(&bar[XB_XSUB(b.x)], 1u);
        const unsigned gen = old / nloc;
        if (old + 1u == (gen + 1u) * nloc) {
            __builtin_amdgcn_fence(__ATOMIC_RELEASE, "agent");
            asm volatile("s_waitcnt vmcnt(0)" ::: "memory");
            const unsigned og = xb_add(&bar[XB_TOP], 1u);
            const unsigned tg = og / nx;
            if (og + 1u == (tg + 1u) * nx) xb_add(&bar[XB_TOPGEN], 1u);
            else XB_SPIN(xb_ld(&bar[XB_TOPGEN]) == tg, bar);
            __builtin_amdgcn_fence(__ATOMIC_ACQUIRE, "agent");
            xb_add(&bar[XB_XGEN(b.x)], 1u);
            asm volatile("s_waitcnt vmcnt(0)" ::: "memory");
        } else {
            XB_SPIN(xb_ld(&bar[XB_XGEN(b.x)]) == gen, bar);
            __builtin_amdgcn_fence(__ATOMIC_ACQUIRE, "agent");
            asm volatile("s_waitcnt vmcnt(0)" ::: "memory");
        }
    }
    __syncthreads();
}

struct Params { const float* in[33]; float* out; unsigned char* ws; int ph_lo, ph_hi; };

struct Frame {
    LAS unsigned char* lds;
    unsigned char* ws;
    const float* const* in;
    float* out;
    int tid, lane, wave, bx, G;
};
enum { I_X = 0, I_C, I_CTX, I_CCTX, I_WMOD, I_BMOD, I_GMIX, I_GFFN, I_WIN, I_MLGB, I_MLHG, I_GCQ, I_GCKV, I_WUQ, I_WUKV, I_GQN, I_GKN, I_POOLW, I_POOLS,
       I_CONVW, I_CONVB, I_WGATE, I_BGATE, I_WBR, I_WOUT, I_WRT, I_BRT, I_W1, I_W3, I_W2, I_WS1, I_WS3, I_WS2 };

__device__ __forceinline__ const float* modp(const Frame& F, int l, int r, int which) { return (const float*)(F.ws + WS_MOD) + ((size_t)(l * 9 + r)) * 6144 + which * 1024; }
__device__ __forceinline__ int mod_row_of(int row) { return row < NLAT ? (row >> 13) : 8; }

__device__ __forceinline__ f32x4 up4_fp8(unsigned w) { const f32x2 lo = __builtin_amdgcn_cvt_pk_f32_fp8((int)w, false), hi = __builtin_amdgcn_cvt_pk_f32_fp8((int)w, true); return (f32x4){lo.x, lo.y, hi.x, hi.y}; }
namespace gg {
typedef int v4i_t __attribute__((ext_vector_type(4)));
constexpr int BM = 256, BK = 64, HALF = 128, HTB = HALF * BK * 2, STAGE_BYTES = 8 * HTB;
__device__ __forceinline__ int lds_byte(int r, int c) { const int st = (r >> 4) * 2 + (c >> 5), rr = r & 15, cc = c & 31, ob = rr * 64 + cc * 2; return st * 1024 + (ob ^ (((ob >> 9) & 1) << 5)); }
__device__ __forceinline__ void stage_rc(int b, int& R, int& C) { const int st = b / 1024, sb = b % 1024, swz = sb ^ (((sb >> 9) & 1) << 5); R = (st >> 1) * 16 + swz / 64; C = (st & 1) * 32 + (swz % 64) / 2; }
__device__ __forceinline__ int perm32(int rho) { const int n = rho >> 4, i = rho & 15; return 8 * (i >> 2) + 4 * n + (i & 3); }

struct Unit {
    const char* A; const char* B;
    unsigned lda, ldb;
    int nt;
    int ridx_off;
    int p0, p1, p2;
};

template <class Epi, class Sched>
__device__ __forceinline__ void gemm_phase(LAS unsigned char* lds, const Sched& S, const Epi& E) {
    int tid_ = threadIdx.x; asm volatile("" : "+v"(tid_));
    const int tid = tid_, wid = __builtin_amdgcn_readfirstlane(tid >> 6), lane = tid & 63, wr = wid >> 2, wc = wid & 3, fr = lane & 15, fq = lane >> 4;
    const size_t kstep = (size_t)(BK * 2);
    const unsigned ldsw = (unsigned)wid * 1024u;
    const int aoff = lds_byte(wr * 64 + fr, fq * 8), boff = lds_byte(wc * 32 + fr, fq * 8);
#define GG_SA(b, h) (((b) * 2 + (h)) * HTB)
#define GG_SB(b, h) ((4 + (b) * 2 + (h)) * HTB)
#define GG_STAGE(bufoff, gbase, v0, v1) do { \
        __builtin_amdgcn_global_load_lds((const unsigned*)((const char*)(gbase) + (v0)), (LAS unsigned*)(lds + (bufoff) + ldsw), 16, 0, 0); \
        __builtin_amdgcn_global_load_lds((const unsigned*)((const char*)(gbase) + (v1)), (LAS unsigned*)(lds + (bufoff) + ldsw + 8192), 16, 0, 0); } while (0)
#define GG_LDA(dst, b, h) do { _Pragma("unroll") for (int m = 0; m < 4; ++m) _Pragma("unroll") for (int k = 0; k < 2; ++k) dst[m][k] = *(const LAS bf16x8*)(lds + GG_SA(b, h) + aoff + m * 2048 + k * 1024); } while (0)
#define GG_LDB(dst, b, h) do { _Pragma("unroll") for (int n = 0; n < 2; ++n) _Pragma("unroll") for (int k = 0; k < 2; ++k) dst[n][k] = *(const LAS bf16x8*)(lds + GG_SB(b, h) + boff + n * 2048 + k * 1024); } while (0)
#define GG_MMA(ai, bj, At, Bt) do { __builtin_amdgcn_s_setprio(1); _Pragma("unroll") for (int m = 0; m < 4; ++m) _Pragma("unroll") for (int n = 0; n < 2; ++n) _Pragma("unroll") for (int k = 0; k < 2; ++k) \
        acc[ai][bj][m][n] = __builtin_amdgcn_mfma_f32_16x16x32_bf16(Bt[n][k], At[m][k], acc[ai][bj][m][n], 0, 0, 0); __builtin_amdgcn_s_setprio(0); } while (0)
#define GG_CAT8(x, y) __builtin_shufflevector(__builtin_bit_cast(v4i_t, x), __builtin_bit_cast(v4i_t, y), 0, 1, 2, 3, 4, 5, 6, 7)
#define GG_MMA8(ai, bj, At, Bt) do { __builtin_amdgcn_s_setprio(1); _Pragma("unroll") for (int m = 0; m < 4; ++m) _Pragma("unroll") for (int n = 0; n < 2; ++n) \
        acc[ai][bj][m][n] = __builtin_amdgcn_mfma_scale_f32_16x16x128_f8f6f4(GG_CAT8(Bt[n][0], Bt[n][1]), GG_CAT8(At[m][0], At[m][1]), acc[ai][bj][m][n], 0, 0, 0, (int)Epi::SCB, 0, 0x7f7f7f7f); __builtin_amdgcn_s_setprio(0); } while (0)
#define GG_MM(ai, bj, At, Bt) do { if constexpr (Epi::FP8) GG_MMA8(ai, bj, At, Bt); else GG_MMA(ai, bj, At, Bt); } while (0)
#define GG_WAIT_V(n) asm volatile("s_waitcnt vmcnt(" #n ")" ::: "memory")
#define GG_WAIT_L(n) asm volatile("s_waitcnt lgkmcnt(" #n ")" ::: "memory")
#define GG_BAR __builtin_amdgcn_s_barrier()
#define GG_SCHED __builtin_amdgcn_sched_barrier(0)
#define GG_OFFS(u) do { int R0_, C0_, R1_, C1_; stage_rc(tid * 16, R0_, C0_); stage_rc(tid * 16 + 8192, R1_, C1_); \
        if (Sched::GATHER) { const LAS int* rl_ = (const LAS int*)(lds + (u).ridx_off); vA0 = (unsigned)rl_[R0_] * (u).lda + C0_ * 2; vA1 = (unsigned)rl_[R1_] * (u).lda + C1_ * 2; \
                             vA2 = (unsigned)rl_[128 + R0_] * (u).lda + C0_ * 2; vA3 = (unsigned)rl_[128 + R1_] * (u).lda + C1_ * 2; hA = 0; } \
        else { vA0 = (unsigned)R0_ * (u).lda + C0_ * 2; vA1 = (unsigned)R1_ * (u).lda + C1_ * 2; vA2 = vA0; vA3 = vA1; hA = (size_t)128 * (u).lda; } \
        const int Rb0_ = Epi::PERM ? ((R0_ & ~31) + perm32(R0_ & 31)) : R0_, Rb1_ = Epi::PERM ? ((R1_ & ~31) + perm32(R1_ & 31)) : R1_; \
        vB0 = (unsigned)Rb0_ * (u).ldb + C0_ * 2; vB1 = (unsigned)Rb1_ * (u).ldb + C1_ * 2; hB = (size_t)128 * (u).ldb; } while (0)
    Unit cur, nxt; int ui = 0;
    if (!S.next(0, cur)) return;
    f32x4 acc[2][2][4][2];
#pragma unroll
    for (int a = 0; a < 2; ++a)
#pragma unroll
        for (int b = 0; b < 2; ++b)
#pragma unroll
            for (int m = 0; m < 4; ++m)
#pragma unroll
                for (int n = 0; n < 2; ++n) acc[a][b][m][n] = (f32x4){0.f, 0.f, 0.f, 0.f};
    bf16x8 At[4][2], B0[2][2], B1[2][2];
    unsigned vA0, vA1, vA2, vA3, vB0, vB1; size_t hA, hB;
    GG_OFFS(cur);
    const char* cA = cur.A; const char* cB = cur.B;
    GG_STAGE(GG_SB(0, 0), cB, vB0, vB1); GG_STAGE(GG_SB(0, 1), cB + hB, vB0, vB1); GG_STAGE(GG_SA(0, 0), cA, vA0, vA1); GG_STAGE(GG_SA(0, 1), cA + hA, vA2, vA3);
    if (wr == 1) GG_BAR;
    GG_WAIT_V(2); GG_BAR;
    GG_STAGE(GG_SB(1, 0), cB + kstep, vB0, vB1); GG_STAGE(GG_SA(1, 0), cA + kstep, vA0, vA1); GG_STAGE(GG_SB(1, 1), cB + hB + kstep, vB0, vB1);
    GG_WAIT_V(6); GG_BAR;
    for (;;) {
        const bool has_next = S.next(ui + 1, nxt);
        TSEC_BEGIN(100 + Epi::TID, lds);
        int nt_ = cur.nt; asm volatile("" : "+s"(nt_)); const int nt = nt_;
#pragma unroll 1
        for (int t = 0; t < nt; t += 2) {
            const bool last = (t == nt - 2);
            const char* a1 = cA + (size_t)(t + 1) * kstep;
            GG_LDB(B0, 0, 0); GG_LDB(B1, 0, 1); GG_SCHED; GG_LDA(At, 0, 0); GG_STAGE(GG_SA(1, 1), a1 + hA, vA2, vA3);
            GG_WAIT_V(8); GG_WAIT_L(0); GG_BAR; GG_MM(0, 0, At, B0); GG_MM(0, 1, At, B1); GG_BAR; GG_SCHED;
            if (last) { if (has_next) { GG_OFFS(nxt); cA = nxt.A - (size_t)nt * kstep; cB = nxt.B - (size_t)nt * kstep; } else { cA -= (size_t)nt * kstep; cB -= (size_t)nt * kstep; } }
            const char* a2 = cA + (size_t)(t + 2) * kstep; const char* b2 = cB + (size_t)(t + 2) * kstep; const char* a3 = a2 + kstep; const char* b3 = b2 + kstep;
            GG_LDA(At, 0, 1); GG_STAGE(GG_SB(0, 0), b2, vB0, vB1); GG_STAGE(GG_SB(0, 1), b2 + hB, vB0, vB1); GG_STAGE(GG_SA(0, 0), a2, vA0, vA1);
            GG_WAIT_V(8); GG_WAIT_L(0); GG_BAR; GG_MM(1, 0, At, B0); GG_MM(1, 1, At, B1); GG_BAR; GG_SCHED;
            GG_LDB(B0, 1, 0); GG_LDB(B1, 1, 1); GG_SCHED; GG_LDA(At, 1, 0); GG_STAGE(GG_SA(0, 1), a2 + hA, vA2, vA3);
            GG_WAIT_V(8); GG_WAIT_L(0); GG_BAR; GG_MM(0, 0, At, B0); GG_MM(0, 1, At, B1); GG_BAR; GG_SCHED;
            GG_LDA(At, 1, 1); GG_STAGE(GG_SB(1, 0), b3, vB0, vB1); GG_STAGE(GG_SB(1, 1), b3 + hB, vB0, vB1); GG_STAGE(GG_SA(1, 0), a3, vA0, vA1);
            GG_WAIT_V(8); GG_WAIT_L(0); GG_BAR; GG_MM(1, 0, At, B0); GG_MM(1, 1, At, B1); GG_BAR; GG_SCHED;
        }
        cA += (size_t)nt * kstep; cB += (size_t)nt * kstep;
        TSEC_END(100 + Epi::TID, lds);
        if (wr == 0) GG_BAR;
        TSEC_BEGIN(200 + Epi::TID, lds); { int t2_ = threadIdx.x; asm volatile("" : "+v"(t2_)); E(acc, cur, wr, wc, t2_ & 15, (t2_ & 63) >> 4); } TSEC_END(200 + Epi::TID, lds);
        if (!has_next) break;
#pragma unroll
        for (int a = 0; a < 2; ++a)
#pragma unroll
            for (int b = 0; b < 2; ++b)
#pragma unroll
                for (int m = 0; m < 4; ++m)
#pragma unroll
                    for (int n = 0; n < 2; ++n) acc[a][b][m][n] = (f32x4){0.f, 0.f, 0.f, 0.f};
        cur = nxt; ++ui;
        if (wr == 1) GG_BAR;
    }
    GG_WAIT_V(0);
    GG_BAR;
#undef GG_SA
#undef GG_SB
#undef GG_STAGE
#undef GG_LDA
#undef GG_LDB
#undef GG_MMA
#undef GG_MMA8
#undef GG_MM
#undef GG_CAT8
#undef GG_WAIT_V
#undef GG_WAIT_L
#undef GG_BAR
#undef GG_SCHED
#undef GG_OFFS
}
}

__device__ __forceinline__ int ld_i32_uniform(const int* p) { return __builtin_amdgcn_readfirstlane(__hip_atomic_load(p, __ATOMIC_RELAXED, __HIP_MEMORY_SCOPE_AGENT)); }
__device__ __forceinline__ void tile_order(int L, int nM, int nN, int& pm, int& pn) {
    const int nwg = nM * nN; int wgid = L;
    { const int q = nwg / 8, r = nwg % 8, xcd = wgid % 8, off = wgid / 8; wgid = (xcd < r ? xcd * (q + 1) : r * (q + 1) + (xcd - r) * q) + off; }
    const int nig = 8 * nN, gid = wgid / nig, fm = gid * 8, gsz = (nM - fm) < 8 ? (nM - fm) : 8;
    pm = fm + ((wgid % nig) % gsz); pn = (wgid % nig) / gsz;
}
struct SchedPlain {
    static constexpr bool GATHER = false;
    const char* A; const char* B; unsigned lda, ldb; int nt, nM, nN, G, c;
    __device__ __forceinline__ bool next(int i, gg::Unit& u) const {
        const int L = i * G + c; if (L >= nM * nN) return false;
        int pm, pn; tile_order(L, nM, nN, pm, pn);
        u.A = A + (size_t)pm * 256 * lda; u.B = B + (size_t)pn * 256 * ldb; u.lda = lda; u.ldb = ldb; u.nt = nt; u.ridx_off = 0; u.p0 = pm; u.p1 = pn; u.p2 = 0; return true;
    }
};
struct EpiWin {
    static constexpr bool PERM = true, FP8 = false; static constexpr int TID = 0; static constexpr unsigned SCB = 0x7f7f7f7fu;
    bf16_t* px; float* gate;
    __device__ __forceinline__ void operator()(const f32x4 (&acc)[2][2][4][2], const gg::Unit& u, int wr, int wc, int fr, int fq) const {
        const int row0 = u.p0 * 256 + wr * 64 + fr;
#pragma unroll
        for (int bj = 0; bj < 2; ++bj) {
            const int c0 = u.p1 * 256 + bj * 128 + wc * 32 + 8 * fq;
            if (c0 < INC) {
                const bool isg = (c0 >= C_G && c0 < C_MLA);
#pragma unroll
                for (int ai = 0; ai < 2; ++ai)
#pragma unroll
                    for (int m = 0; m < 4; ++m) { const int row = row0 + ai * 128 + m * 16; const f32x4 v0 = acc[ai][bj][m][0], v1 = acc[ai][bj][m][1];
                        u32x4 w; w.x = cvt_pk_bf16(v0[0], v0[1]); w.y = cvt_pk_bf16(v0[2], v0[3]); w.z = cvt_pk_bf16(v1[0], v1[1]); w.w = cvt_pk_bf16(v1[2], v1[3]);
                        *(u32x4*)(px + (size_t)row * INC + c0) = w;
                        if (isg) { float* gp = gate + (size_t)row * 16 + (c0 - C_G); *(f32x4*)gp = v0; *(f32x4*)(gp + 4) = v1; } }
            }
        }
    }
};
struct SchedYB {
    static constexpr bool GATHER = false;
    const char* yc; const char* wb; int pm0, nMh, G, c;
    __device__ __forceinline__ bool next(int i, gg::Unit& u) const {
        const int L = i * G + c; if (L >= nMh * 16) return false;
        int pm, q; tile_order(L, nMh, 16, pm, q); const int br = q >> 2, pn = q & 3;
        u.A = yc + (size_t)(pm0 + pm) * 256 * 2048 + br * 512; u.lda = 2048; u.B = wb + (size_t)br * (1024 * 512) + (size_t)pn * 256 * 512; u.ldb = 512; u.nt = 4; u.ridx_off = 0; u.p0 = pm; u.p1 = q; u.p2 = 0; return true;
    }
};
struct EpiMerge2 {
    static constexpr bool PERM = false, FP8 = true; static constexpr int TID = 4; static constexpr unsigned SCB = 0x79797979u;
    const unsigned char* yb; const float* bgate; bf16_t* accm; int pm0;
    __device__ __forceinline__ void operator()(const f32x4 (&acc)[2][2][4][2], const gg::Unit& u, int wr, int wc, int fr, int fq) const {
        const int c = u.p1 * 64 + 16 * wc + 4 * fq, r0 = wr * 64 + fr;
        f32x4 bv[2][2];
#pragma unroll
        for (int bj = 0; bj < 2; ++bj)
#pragma unroll
            for (int n = 0; n < 2; ++n) bv[bj][n] = *(const f32x4*)(bgate + (2 * bj + n) * 1024 + c);
#pragma unroll
        for (int ai = 0; ai < 2; ++ai) {
#pragma unroll
            for (int m = 0; m < 4; ++m) { const int rl = (u.p0 - pm0) * 256 + r0 + ai * 128 + m * 16; const unsigned char* yr = yb + (size_t)rl * 4096 + c;
                f32x4 t = {0.f, 0.f, 0.f, 0.f};
#pragma unroll
                for (int bj = 0; bj < 2; ++bj)
#pragma unroll
                    for (int n = 0; n < 2; ++n) { const f32x4 y = up4_fp8(*(const unsigned*)(yr + (2 * bj + n) * 1024)); const f32x4 g = acc[ai][bj][m][n] + bv[bj][n];
                        t[0] += sigmoidf_(g[0]) * y[0]; t[1] += sigmoidf_(g[1]) * y[1]; t[2] += sigmoidf_(g[2]) * y[2]; t[3] += sigmoidf_(g[3]) * y[3]; }
                *(u32x2*)(accm + (size_t)(u.p0 * 256 + r0 + ai * 128 + m * 16) * 1024 + c) = (u32x2){cvt_pk_bf16(t[0], t[1]), cvt_pk_bf16(t[2], t[3])}; } }
    }
};
struct EpiWout {
    static constexpr bool PERM = true, FP8 = false; static constexpr int TID = 1; static constexpr unsigned SCB = 0x7f7f7f7fu;
    bf16_t* mrg; const float* gt;
    __device__ __forceinline__ void operator()(const f32x4 (&acc)[2][2][4][2], const gg::Unit& u, int wr, int wc, int fr, int fq) const {
        const int pm = u.p0; const int mrow = pm >= 256 ? 8 : (pm >> 5);
        const float* g = gt + (size_t)mrow * 6144;
        const int row0 = pm * 256 + wr * 64 + fr, col0 = u.p1 * 256 + wc * 32 + 8 * fq;
#pragma unroll
        for (int bj = 0; bj < 2; ++bj) { const f32x4 g0 = *(const f32x4*)(g + col0 + bj * 128), g1 = *(const f32x4*)(g + col0 + bj * 128 + 4);
#pragma unroll
            for (int ai = 0; ai < 2; ++ai)
#pragma unroll
                for (int m = 0; m < 4; ++m) { const f32x4 v0 = acc[ai][bj][m][0] * g0, v1 = acc[ai][bj][m][1] * g1;
                    u32x4 w; w.x = cvt_pk_bf16(v0[0], v0[1]); w.y = cvt_pk_bf16(v0[2], v0[3]); w.z = cvt_pk_bf16(v1[0], v1[1]); w.w = cvt_pk_bf16(v1[2], v1[3]);
                    *(u32x4*)(mrg + (size_t)(row0 + ai * 128 + m * 16) * 1024 + col0 + bj * 128) = w; } }
    }
};
constexpr int MOE_TAB_OFF = RING_BYTES, MOE_RIDX_OFF = RING_BYTES + 1024;
struct SchedMoe1 {
    static constexpr bool GATHER = true;
    const char* hx2; const char* w13; const LAS int* tab; int ntiles, G, c;
    __device__ __forceinline__ bool next(int i, gg::Unit& u) const {
        const int L = i * G + c; if (L >= ntiles * 2) return false;
        const int tile = L >> 1, pn = L & 1, e = __builtin_amdgcn_readfirstlane(tab[i]);
        u.A = hx2; u.lda = 1024; u.ridx_off = MOE_RIDX_OFF + i * 1024; u.B = w13 + (size_t)e * (512 * 1024) + (size_t)pn * 256 * 1024; u.ldb = 1024; u.nt = 8; u.p0 = tile; u.p1 = pn; u.p2 = e; return true;
    }
};
struct EpiMoe1 {
    static constexpr bool PERM = true, FP8 = true; static constexpr int TID = 5; static constexpr unsigned SCB = 0x79797979u;
    bf16_t* a; const float* roww;
    __device__ __forceinline__ void operator()(const f32x4 (&acc)[2][2][4][2], const gg::Unit& u, int wr, int wc, int fr, int fq) const {
        const int row0 = u.p0 * 256 + wr * 64 + fr, col = u.p1 * 128 + wc * 32 + 8 * fq;
#pragma unroll
        for (int ai = 0; ai < 2; ++ai)
#pragma unroll
            for (int m = 0; m < 4; ++m) { const int row = row0 + ai * 128 + m * 16; const float rw = roww[row];
                float t[8];
#pragma unroll
                for (int n = 0; n < 2; ++n)
#pragma unroll
                    for (int j = 0; j < 4; ++j) { const float g1 = acc[ai][0][m][n][j], g3 = acc[ai][1][m][n][j]; t[n * 4 + j] = g1 * sigmoidf_(g1) * g3 * rw; }
                u32x4 w; w.x = cvt_pk_bf16(t[0], t[1]); w.y = cvt_pk_bf16(t[2], t[3]); w.z = cvt_pk_bf16(t[4], t[5]); w.w = cvt_pk_bf16(t[6], t[7]);
                *(u32x4*)(a + (size_t)row * 256 + col) = w; }
    }
};
struct SchedMoe2 {
    static constexpr bool GATHER = false;
    const char* a; const char* w2; const LAS int* tab; int ntiles, G, c;
    __device__ __forceinline__ bool next(int i, gg::Unit& u) const {
        const int L = i * G + c; if (L >= ntiles * 4) return false;
        const int tile = L >> 2, pn = L & 3, e = __builtin_amdgcn_readfirstlane(tab[i]);
        u.A = a + (size_t)tile * 256 * 512; u.lda = 512; u.ridx_off = 0; u.B = w2 + (size_t)e * (1024 * 512) + (size_t)pn * 256 * 512; u.ldb = 512; u.nt = 4; u.p0 = tile; u.p1 = pn; u.p2 = e; return true;
    }
};
struct EpiBf16Plain {
    static constexpr bool PERM = true, FP8 = false; static constexpr int TID = 2; static constexpr unsigned SCB = 0x7f7f7f7fu;
    bf16_t* O; int ldc;
    __device__ __forceinline__ void operator()(const f32x4 (&acc)[2][2][4][2], const gg::Unit& u, int wr, int wc, int fr, int fq) const {
        const int row0 = u.p0 * 256 + wr * 64 + fr, col0 = u.p1 * 256 + wc * 32 + 8 * fq;
#pragma unroll
        for (int ai = 0; ai < 2; ++ai)
#pragma unroll
            for (int m = 0; m < 4; ++m)
#pragma unroll
                for (int bj = 0; bj < 2; ++bj) { const f32x4 v0 = acc[ai][bj][m][0], v1 = acc[ai][bj][m][1];
                    u32x4 w; w.x = cvt_pk_bf16(v0[0], v0[1]); w.y = cvt_pk_bf16(v0[2], v0[3]); w.z = cvt_pk_bf16(v1[0], v1[1]); w.w = cvt_pk_bf16(v1[2], v1[3]);
                    *(u32x4*)(O + (size_t)(row0 + ai * 128 + m * 16) * ldc + col0 + bj * 128) = w; }
    }
};
struct EpiF8Out {
    static constexpr bool PERM = true, FP8 = false; static constexpr int TID = 6; static constexpr unsigned SCB = 0x7f7f7f7fu;
    unsigned char* O; int ldc;
    __device__ __forceinline__ void operator()(const f32x4 (&acc)[2][2][4][2], const gg::Unit& u, int wr, int wc, int fr, int fq) const {
        const int row0 = u.p0 * 256 + wr * 64 + fr, col0 = u.p1 * 256 + wc * 32 + 8 * fq;
#pragma unroll
        for (int ai = 0; ai < 2; ++ai)
#pragma unroll
            for (int m = 0; m < 4; ++m)
#pragma unroll
                for (int bj = 0; bj < 2; ++bj) { const f32x4 v0 = acc[ai][bj][m][0], v1 = acc[ai][bj][m][1];
                    *(u32x2*)(O + (size_t)(row0 + ai * 128 + m * 16) * ldc + col0 + bj * 128) = (u32x2){pk4_fp8(v0[0], v0[1], v0[2], v0[3]), pk4_fp8(v1[0], v1[1], v1[2], v1[3])}; }
    }
};
struct EpiBf16F8 {
    static constexpr bool PERM = true, FP8 = true; static constexpr int TID = 3; static constexpr unsigned SCB = 0x77777777u;
    bf16_t* O; static constexpr int ldc = 1024;
    __device__ __forceinline__ void operator()(const f32x4 (&acc)[2][2][4][2], const gg::Unit& u, int wr, int wc, int fr, int fq) const {
        bf16_t* p = O + (size_t)(u.p0 * 256 + wr * 64 + fr) * ldc + u.p1 * 256 + wc * 32 + 8 * fq;
#pragma unroll
        for (int ai = 0; ai < 2; ++ai) {
#pragma unroll
            for (int m = 0; m < 4; ++m) {
#pragma unroll
                for (int bj = 0; bj < 2; ++bj) { const f32x4 v0 = acc[ai][bj][m][0], v1 = acc[ai][bj][m][1];
                    u32x4 w; w.x = cvt_pk_bf16(v0[0], v0[1]); w.y = cvt_pk_bf16(v0[2], v0[3]); w.z = cvt_pk_bf16(v1[0], v1[1]); w.w = cvt_pk_bf16(v1[2], v1[3]);
                    *(u32x4*)(p + bj * 128) = w; }
                p += 16 * ldc; asm volatile("" : "+v"(p)); }
            p += 64 * ldc; }
    }
};

__device__ __forceinline__ int crow(int r, int hi) { return (r & 3) + 8 * (r >> 2) + 4 * hi; }
__device__ __forceinline__ f32x16 mma32_ll(f32x16 acc, const LAS bf16_t* A, int lda, const LAS bf16_t* B, int ldb, int ksteps, int lane, int ks0 = 0) {
    const int r32 = lane & 31, hi = lane >> 5;
    for (int ks = ks0; ks < ksteps; ++ks) {
        const bf16x8 a = *(const LAS bf16x8*)(A + r32 * lda + ks * 16 + hi * 8);
        const bf16x8 b = *(const LAS bf16x8*)(B + r32 * ldb + ks * 16 + hi * 8);
        acc = __builtin_amdgcn_mfma_f32_32x32x16_bf16(a, b, acc, 0, 0, 0);
    }
    return acc;
}
template <int KS> __device__ __forceinline__ f32x16 mma32_lg(f32x16 acc, const LAS bf16_t* A, int lda, const bf16_t* B, int ldb, int lane) {
    const int r32 = lane & 31, hi = lane >> 5;
    bf16x8 b[KS];
#pragma unroll
    for (int ks = 0; ks < KS; ++ks) b[ks] = *(const bf16x8*)(B + (size_t)r32 * ldb + ks * 16 + hi * 8);
#pragma unroll
    for (int ks = 0; ks < KS; ++ks) { const bf16x8 a = *(const LAS bf16x8*)(A + r32 * lda + ks * 16 + hi * 8); acc = __builtin_amdgcn_mfma_f32_32x32x16_bf16(a, b[ks], acc, 0, 0, 0); }
    return acc;
}

__device__ __forceinline__ void ph_pre(const Frame& F) {
    LAS float* sv = (LAS float*)F.lds;
    LAS float* part = sv + 9 * 1024;
    float* mod = (float*)(F.ws + WS_MOD);
    for (int i = F.tid; i < 9 * 1024; i += NTHR) { const int r = i >> 10, k = i & 1023; const float c = (r < 8) ? F.in[I_C][r * 1024 + k] : F.in[I_CCTX][k]; sv[i] = c * sigmoidf_(c); }
    __syncthreads();
    for (int it = F.bx; it < 2 * 96; it += F.G) {
        const int l = it / 96, jc = it % 96, j = jc * 64 + F.lane, k0 = F.wave * 128;
        const float* w = F.in[I_WMOD] + ((size_t)l * 1024 + k0) * 6144 + j;
        float a[9];
#pragma unroll
        for (int r = 0; r < 9; ++r) a[r] = 0.f;
#pragma unroll 4
        for (int k = 0; k < 128; ++k) { const float wv = w[(size_t)k * 6144];
#pragma unroll
            for (int r = 0; r < 9; ++r) a[r] += sv[r * 1024 + k0 + k] * wv; }
#pragma unroll
        for (int r = 0; r < 9; ++r) part[(F.wave * 9 + r) * 64 + F.lane] = a[r];
        __syncthreads();
        for (int i = F.tid; i < 9 * 64; i += NTHR) { const int r = i >> 6, jj = i & 63; float s = F.in[I_BMOD][l * 6144 + jc * 64 + jj];
#pragma unroll
            for (int w8 = 0; w8 < 8; ++w8) s += part[(w8 * 9 + r) * 64 + jj];
            mod[((size_t)(l * 9 + r)) * 6144 + jc * 64 + jj] = s; }
        __syncthreads();
    }
    if (F.bx == F.G - 1) {
        float* rt = (float*)(F.ws + T_ROPE);
        for (int i = F.tid; i < 1024; i += NTHR) { const int pos = i >> 3, f = i & 7; const float inv = powf(10000.0f, -(float)f / 8.0f); const float ang = (float)pos * inv; rt[2 * i] = cosf(ang); rt[2 * i + 1] = sinf(ang); }
    }
}

struct ConvCursor { int base; int gw, ngw; };
__device__ __forceinline__ void conv_mat(const Frame& F, ConvCursor& cc, const float* src, int K, int N, bf16_t* dst, int ldd, int rbase, int rstep, int nbatch, size_t sbs, size_t dbs, int rq = 128, bool gperm = false, float f8scale = 0.f) {
    const int ktl = K / 64, ntl = (N + 127) / 128, per = ktl * ntl, total = per * nbatch;
    int t = cc.base + ((cc.gw - cc.base) % cc.ngw + cc.ngw) % cc.ngw;
    for (; t < cc.base + total; t += cc.ngw) {
        const int li = t - cc.base, bt = li / per, rem = li % per, kb = rem / ntl, nb = rem % ntl, k0 = kb * 64, n = nb * 128 + 2 * F.lane;
        if (n < N) {
            const float* s = src + bt * sbs + (size_t)k0 * N + n; bf16_t* d = dst + bt * dbs;
            f32x2 v[64];
#pragma unroll
            for (int i = 0; i < 64; ++i) v[i] = *(const f32x2*)(s + (size_t)i * N);
#pragma unroll
            for (int q = 0; q < 2; ++q) { const int nn = n + q; const int drow = gperm ? ((nn >> 6) * 256 + ((nn >> 4) & 3) * 32 + (nn & 15) + 128 * (bt >> 1) + 16 * (bt & 1)) : (rbase + (nn / rq) * rstep + (nn % rq));
                if (f8scale != 0.f) { unsigned char* d8 = (unsigned char*)dst + bt * dbs + (size_t)drow * ldd + k0;
#pragma unroll
                    for (int p = 0; p < 4; ++p) { u32x4 o; o.x = pk4_fp8(v[16 * p][q] * f8scale, v[16 * p + 1][q] * f8scale, v[16 * p + 2][q] * f8scale, v[16 * p + 3][q] * f8scale);
                        o.y = pk4_fp8(v[16 * p + 4][q] * f8scale, v[16 * p + 5][q] * f8scale, v[16 * p + 6][q] * f8scale, v[16 * p + 7][q] * f8scale);
                        o.z = pk4_fp8(v[16 * p + 8][q] * f8scale, v[16 * p + 9][q] * f8scale, v[16 * p + 10][q] * f8scale, v[16 * p + 11][q] * f8scale);
                        o.w = pk4_fp8(v[16 * p + 12][q] * f8scale, v[16 * p + 13][q] * f8scale, v[16 * p + 14][q] * f8scale, v[16 * p + 15][q] * f8scale);
                        *(u32x4*)(d8 + 16 * p) = o; }
                    continue; }
                bf16_t* dr = d + (size_t)drow * ldd + k0;
#pragma unroll
                for (int p = 0; p < 8; ++p) { u32x4 o; o.x = pk2(v[8 * p][q], v[8 * p + 1][q]); o.y = pk2(v[8 * p + 2][q], v[8 * p + 3][q]); o.z = pk2(v[8 * p + 4][q], v[8 * p + 5][q]); o.w = pk2(v[8 * p + 6][q], v[8 * p + 7][q]);
                    *(u32x4*)(dr + 8 * p) = o; } }
        }
    }
    cc.base += total;
}
__device__ __forceinline__ void ph_convert(const Frame& F, int l) {
    ConvCursor cc; cc.base = 0; cc.gw = F.bx * NWAVES + F.wave; cc.ngw = F.G * NWAVES;
    unsigned char* ws = F.ws;
    conv_mat(F, cc, F.in[I_WIN] + (size_t)l * 1024 * INC, 1024, INC, (bf16_t*)(ws + W_IN), 1024, 0, 128, 1, 0, 0);
    conv_mat(F, cc, F.in[I_WGATE] + (size_t)l * 4 * 1024 * 1024, 1024, 1024, (bf16_t*)(ws + W_GATE), 1024, 0, 128, 4, (size_t)1024 * 1024, 0, 128, true, 64.0f);
    conv_mat(F, cc, F.in[I_WBR] + (size_t)l * 4 * 256 * 1024, 256, 1024, (bf16_t*)(ws + W_BR), 256, 0, 128, 4, (size_t)256 * 1024, (size_t)1024 * 256);
    conv_mat(F, cc, F.in[I_WOUT] + (size_t)l * 1024 * 1024, 1024, 1024, (bf16_t*)(ws + W_OUT), 1024, 0, 128, 1, 0, 0);
    conv_mat(F, cc, F.in[I_W1] + (size_t)l * 64 * 1024 * 256, 1024, 256, (bf16_t*)(ws + W_13), 1024, 0, 256, 64, (size_t)1024 * 256, (size_t)512 * 1024, 128, false, 64.0f);
    conv_mat(F, cc, F.in[I_W3] + (size_t)l * 64 * 1024 * 256, 1024, 256, (bf16_t*)(ws + W_13), 1024, 128, 256, 64, (size_t)1024 * 256, (size_t)512 * 1024, 128, false, 64.0f);
    conv_mat(F, cc, F.in[I_W2] + (size_t)l * 64 * 256 * 1024, 256, 1024, (bf16_t*)(ws + W_2), 256, 0, 128, 64, (size_t)256 * 1024, (size_t)1024 * 256);
    conv_mat(F, cc, F.in[I_WS1] + (size_t)l * 1024 * 256, 1024, 256, (bf16_t*)(ws + W_13 + (size_t)64 * 512 * 1024), 1024, 0, 256, 1, 0, 0, 128, false, 64.0f);
    conv_mat(F, cc, F.in[I_WS3] + (size_t)l * 1024 * 256, 1024, 256, (bf16_t*)(ws + W_13 + (size_t)64 * 512 * 1024), 1024, 128, 256, 1, 0, 0, 128, false, 64.0f);
    conv_mat(F, cc, F.in[I_WS2] + (size_t)l * 256 * 1024, 256, 1024, (bf16_t*)(ws + W_2) + (size_t)64 * 1024 * 256, 256, 0, 128, 1, 0, 0);
    conv_mat(F, cc, F.in[I_WUQ] + (size_t)l * 256 * 384, 256, 384, (bf16_t*)(ws + W_UQ), 256, 0, 128, 1, 0, 0);
    conv_mat(F, cc, F.in[I_WUKV] + (size_t)l * 128 * 512, 128, 512, (bf16_t*)(ws + W_UKV), 128, 0, 128, 1, 0, 0);
    conv_mat(F, cc, F.in[I_POOLW] + (size_t)l * 4 * 64 * 64, 64, 64, (bf16_t*)(ws + W_POOL), 64, 0, 128, 4, (size_t)64 * 64, (size_t)64 * 64);
    conv_mat(F, cc, F.in[I_WRT] + (size_t)l * 1024 * 64, 1024, 64, (bf16_t*)(ws + W_RT), 1024, 0, 128, 1, 0, 0);
    { u32x4* z = (u32x4*)((bf16_t*)(ws + W_IN) + (size_t)INC * 1024); const int n16 = (INCP - INC) * 1024 * 2 / 16;
      unsigned z0 = 0u; asm volatile("" : "+v"(z0));
      for (int i = F.bx * NTHR + F.tid; i < n16; i += F.G * NTHR) z[i] = (u32x4){z0, z0, z0, z0}; }
}

__device__ __forceinline__ void normmod_vals(int lane, const f32x4 (&v)[4], const float* g, const float* sc, const float* sh, f32x4 (&y)[4]) {
    float s = 0.f;
#pragma unroll
    for (int j = 0; j < 4; ++j) s += (v[j].x * v[j].x + v[j].y * v[j].y) + (v[j].z * v[j].z + v[j].w * v[j].w);
    const float rstd = frsq(wave_sum(s) * (1.f / 1024.f) + EPS);
#pragma unroll
    for (int j = 0; j < 4; ++j) { const f32x4 gv = ((const f32x4*)g)[lane + 64 * j], scv = ((const f32x4*)sc)[lane + 64 * j], shv = ((const f32x4*)sh)[lane + 64 * j];
        y[j] = v[j] * rstd * gv * (scv + 1.0f) + shv; }
}
__device__ __forceinline__ void normmod_row(int lane, const float* xrow, const float* g, const float* sc, const float* sh, f32x4 (&y)[4]) {
    const f32x4* xr = (const f32x4*)xrow + lane; f32x4 v[4]; float s = 0.f;
#pragma unroll
    for (int j = 0; j < 4; ++j) { v[j] = xr[64 * j]; s += (v[j].x * v[j].x + v[j].y * v[j].y) + (v[j].z * v[j].z + v[j].w * v[j].w); }
    const float rstd = frsq(wave_sum(s) * (1.f / 1024.f) + EPS);
#pragma unroll
    for (int j = 0; j < 4; ++j) { const f32x4 gv = ((const f32x4*)g)[lane + 64 * j], scv = ((const f32x4*)sc)[lane + 64 * j], shv = ((const f32x4*)sh)[lane + 64 * j];
        y[j] = v[j] * rstd * gv * (scv + 1.0f) + shv; }
}
__device__ __forceinline__ const float* stream_row(const Frame& F, int l, int row) {
    if (row < NLAT) return (l == 0 ? F.in[I_X] : F.out) + (size_t)row * 1024;
    return (l == 0 ? F.in[I_CTX] : (const float*)(F.ws + WS_CTXS)) + (size_t)(row - NLAT) * 1024;
}
__device__ __forceinline__ void ph_norm1(const Frame& F, int l) {
    const int gw = F.bx * NWAVES + F.wave, ngw = F.G * NWAVES;
    bf16_t* hx = (bf16_t*)(F.ws + WS_HX);
    for (int row0 = gw; row0 < NTOK; row0 += 2 * ngw) {
        const int row1 = row0 + ngw; const bool has1 = row1 < NTOK;
        f32x4 v0[4], v1[4];
        { const f32x4* x0 = (const f32x4*)stream_row(F, l, row0) + F.lane; const f32x4* x1 = (const f32x4*)stream_row(F, l, has1 ? row1 : row0) + F.lane;
#pragma unroll
          for (int j = 0; j < 4; ++j) { v0[j] = x0[64 * j]; v1[j] = x1[64 * j]; } }
#pragma unroll
        for (int k = 0; k < 2; ++k) { if (k == 1 && !has1) break; const int row = k ? row1 : row0; const int mr = mod_row_of(row); f32x4 y[4];
            normmod_vals(F.lane, k ? v1 : v0, F.in[I_GMIX] + l * 1024, modp(F, l, mr, 1), modp(F, l, mr, 0), y);
            u32x2* o = (u32x2*)(hx + (size_t)row * 1024) + F.lane; unsigned* o8 = (unsigned*)(F.ws + WS_HX8 + (size_t)row * 1024) + F.lane;
#pragma unroll
            for (int j = 0; j < 4; ++j) { o[64 * j] = (u32x2){pk2(y[j].x, y[j].y), pk2(y[j].z, y[j].w)}; o8[64 * j] = pk4_fp8(y[j].x, y[j].y, y[j].z, y[j].w); } }
    }
}

constexpr float QSCALE = 0.10206207261596577f * 1.4426950408889634f;
template <int KS> __device__ __forceinline__ void ld_bfrag(bf16x8* b, const bf16_t* B, int ldb, int lane) {
#pragma unroll
    for (int ks = 0; ks < KS; ++ks) b[ks] = *(const bf16x8*)(B + (size_t)(lane & 31) * ldb + ks * 16 + (lane >> 5) * 8);
}
template <int KS> __device__ __forceinline__ f32x16 mma32_lr(const LAS bf16_t* A, int lda, const bf16x8* b, int lane) {
    f32x16 acc = {};
#pragma unroll
    for (int ks = 0; ks < KS; ++ks) { const bf16x8 a = *(const LAS bf16x8*)(A + (lane & 31) * lda + ks * 16 + (lane >> 5) * 8); acc = __builtin_amdgcn_mfma_f32_32x32x16_bf16(a, b[ks], acc, 0, 0, 0); }
    return acc;
}
__device__ __forceinline__ f32x2 mla_rope_ld(const Frame& F, int unit) {
    const int row0 = unit * 32; const bool isctx = row0 >= NLAT; const int pos0 = isctx ? (row0 - NLAT) & 255 : row0 & 8191;
    const int pos = pos0 + (F.tid >> 4), pp = (F.tid & 8) ? (pos & 63) : (pos >> 6);
    return *(const f32x2*)((const float*)(F.ws + T_ROPE) + (pp * 8 + (F.tid & 7)) * 2);
}
struct MlaKvRegs { unsigned xk[4]; unsigned xr[4]; f32x2 rp; };
__device__ __forceinline__ MlaKvRegs mla_kv_load(const Frame& F, int unit) {
    MlaKvRegs R; const bf16_t* px = (const bf16_t*)(F.ws + WS_PX);
#pragma unroll
    for (int rr = 0; rr < 4; ++rr) { const bf16_t* p = px + (size_t)(unit * 32 + F.wave * 4 + rr) * INC + C_MLA;
        R.xk[rr] = *(const unsigned*)(p + 256 + 2 * F.lane); R.xr[rr] = *(const unsigned*)(p + 384 + 2 * (F.lane & 15)); }
    R.rp = mla_rope_ld(F, unit);
    return R;
}
__device__ __forceinline__ void mla_kv_unit(const Frame& F, int unit, const MlaKvRegs& R, const bf16x8* wkv, f32x2 gckv2, float g0, float g1, float g2) {
    LAS unsigned char* lds = F.lds;
    LAS bf16_t* AKV = (LAS bf16_t*)lds;
    LAS float* KR = (LAS float*)(lds + 8704);
    LAS f32x2* RP = (LAS f32x2*)(lds + 12800);
    LAS float* OUT = (LAS float*)(lds + 16896);
    LAS bf16_t* KB = (LAS bf16_t*)(lds + 83456);
    int tid_ = F.tid; asm volatile("" : "+v"(tid_));
    const int row0 = unit * 32, tid = tid_, lane = tid & 63, wave = F.wave, r32 = lane & 31, hi = lane >> 5;
    const bool isctx = row0 >= NLAT;
    const int b = isctx ? (row0 - NLAT) >> 8 : row0 >> 13, pos0 = isctx ? (row0 - NLAT) & 255 : row0 & 8191;
    LDS_BAR();
    RP[tid] = R.rp;
#pragma unroll
    for (int rr = 0; rr < 4; ++rr) { const int r = wave * 4 + rr; const unsigned w = R.xk[rr]; const float x0 = bflo(w), x1 = bfhi(w);
        const float sc = frsq(wave_sum(x0 * x0 + x1 * x1) * (1.f / 128.f) + EPS);
        *(LAS unsigned*)(AKV + r * 136 + 2 * lane) = pk2(x0 * sc * gckv2.x, x1 * sc * gckv2.y);
        if (lane < 16) *(LAS f32x2*)(KR + r * 32 + 2 * lane) = (f32x2){bflo(R.xr[rr]), bfhi(R.xr[rr])}; }
    LDS_BAR();
#pragma unroll
    for (int i = 0; i < 2; ++i) { const int nt = wave * 2 + i; const f32x16 acc = mma32_lr<8>(AKV, 136, wkv + 8 * i, lane);
#pragma unroll
        for (int r = 0; r < 16; ++r) OUT[crow(r, hi) * 520 + nt * 32 + r32] = acc[r]; }
    LDS_BAR();
#pragma unroll
    for (int it = 0; it < 8; ++it) { const int pr = wave * 16 + it * 2 + hi, r = pr >> 2, h = pr & 3; const LAS float* o = OUT + r * 520 + h * 128;
        float v0 = o[r32], v1 = o[32 + r32], v2 = KR[r * 32 + r32]; const float ss = half_sum(v0 * v0 + v1 * v1 + v2 * v2);
        const float sc = frsq(ss * (1.f / 96.f) + EPS);
        v0 *= sc * g0; v1 *= sc * g1; v2 *= sc * g2;
        const float pv = xor_lane<8>(v2);
        if (!isctx) { const f32x2 cssn = RP[(r * 2 + (r32 >> 4)) * 8 + (r32 & 7)]; v2 = (r32 & 8) ? (v2 * cssn.x + pv * cssn.y) : (v2 * cssn.x - pv * cssn.y); }
        LAS bf16_t* kb = KB + r * 392 + h * 96;
        kb[r32] = (bf16_t)f2bf(v0); kb[32 + r32] = (bf16_t)f2bf(v1); kb[64 + r32] = (bf16_t)f2bf(v2); }
    LDS_BAR();
    const int key0 = isctx ? pos0 : 256 + pos0, tile = key0 >> 6, kin = key0 & 63;
    for (int i = tid; i < 1536; i += NTHR) { const int r = i & 31, c = (i >> 5) % 12, h = i / 384;
        const u32x4 v = *(const LAS u32x4*)(KB + r * 392 + h * 96 + c * 8);
        *(u32x4*)((bf16_t*)(F.ws + WS_KT) + ((size_t)((b * 4 + h) * NKT + tile) * 12 + c) * 512 + (kin + r) * 8) = v; }
    for (int i = tid; i < 1024; i += NTHR) { const int p = i & 3, r = (i >> 2) & 31, dh = (i >> 7) & 1, h = i >> 8; const LAS float* o = OUT + r * 520 + h * 128 + 64 + dh * 32 + p * 8;
        u32x4 v; v.x = pk2(o[0], o[1]); v.y = pk2(o[2], o[3]); v.z = pk2(o[4], o[5]); v.w = pk2(o[6], o[7]);
        *(u32x4*)((bf16_t*)(F.ws + WS_VT) + ((size_t)((b * 4 + h) * NKT + tile) * 2 + dh) * 2048 + (kin + r) * 32 + p * 8) = v; }
}
struct MlaQRegs { u32x2 xq[4]; f32x2 rp; };
__device__ __forceinline__ MlaQRegs mla_q_load(const Frame& F, int unit) {
    MlaQRegs R; const bf16_t* px = (const bf16_t*)(F.ws + WS_PX);
#pragma unroll
    for (int rr = 0; rr < 4; ++rr) R.xq[rr] = *(const u32x2*)(px + (size_t)(unit * 32 + F.wave * 4 + rr) * INC + C_MLA + 4 * F.lane);
    R.rp = mla_rope_ld(F, unit);
    return R;
}
__device__ __forceinline__ void mla_q_unit(const Frame& F, int unit, const MlaQRegs& R, const bf16x8* wqf, f32x4 gcq4, float g0, float g1, float g2) {
    LAS unsigned char* lds = F.lds;
    LAS bf16_t* AQ = (LAS bf16_t*)lds;
    LAS f32x2* RP = (LAS f32x2*)(lds + 16896);
    LAS float* OQ = (LAS float*)(lds + 20992);
    int tid_ = F.tid; asm volatile("" : "+v"(tid_));
    const int row0 = unit * 32, tid = tid_, lane = tid & 63, wave = F.wave, r32 = lane & 31, hi = lane >> 5;
    const bool isctx = row0 >= NLAT;
    LDS_BAR();
    RP[tid] = R.rp;
#pragma unroll
    for (int rr = 0; rr < 4; ++rr) { const int r = wave * 4 + rr; const u32x2 w = R.xq[rr]; const float x0 = bflo(w.x), x1 = bfhi(w.x), x2 = bflo(w.y), x3 = bfhi(w.y);
        const float sc = frsq(wave_sum(x0 * x0 + x1 * x1 + x2 * x2 + x3 * x3) * (1.f / 256.f) + EPS);
        *(LAS u32x2*)(AQ + r * 264 + 4 * lane) = (u32x2){pk2(x0 * sc * gcq4.x, x1 * sc * gcq4.y), pk2(x2 * sc * gcq4.z, x3 * sc * gcq4.w)}; }
    LDS_BAR();
    { const f32x16 acc = mma32_lr<16>(AQ, 264, wqf, lane);
#pragma unroll
      for (int r = 0; r < 16; ++r) OQ[crow(r, hi) * 392 + wave * 32 + r32] = acc[r]; }
    if (wave < 4) { const f32x16 acc = mma32_lr<16>(AQ, 264, wqf + 16, lane);
#pragma unroll
      for (int r = 0; r < 16; ++r) OQ[crow(r, hi) * 392 + (8 + wave) * 32 + r32] = acc[r]; }
    LDS_BAR();
    bf16_t* qb = (bf16_t*)(F.ws + WS_QB);
#pragma unroll
    for (int it = 0; it < 8; ++it) { const int pr = wave * 16 + it * 2 + hi, r = pr >> 2, h = pr & 3; const LAS float* o = OQ + r * 392 + h * 96;
        float v0 = o[r32], v1 = o[32 + r32], v2 = o[64 + r32]; const float ss = half_sum(v0 * v0 + v1 * v1 + v2 * v2);
        const float sc = frsq(ss * (1.f / 96.f) + EPS);
        v0 *= sc * g0; v1 *= sc * g1; v2 *= sc * g2;
        const float pv = xor_lane<8>(v2);
        if (!isctx) { const f32x2 cssn = RP[(r * 2 + (r32 >> 4)) * 8 + (r32 & 7)]; v2 = (r32 & 8) ? (v2 * cssn.x + pv * cssn.y) : (v2 * cssn.x - pv * cssn.y); }
        bf16_t* q = qb + (size_t)(row0 + r) * 384 + h * 96;
        q[r32] = (bf16_t)f2bf(v0 * QSCALE); q[32 + r32] = (bf16_t)f2bf(v1 * QSCALE); q[64 + r32] = (bf16_t)f2bf(v2 * QSCALE); }
}
__device__ __forceinline__ void mla_prep(const Frame& F, int l) {
    const int lane = F.lane, wave = F.wave, r32 = lane & 31;
    { bf16x8 wkv[16]; const bf16_t* wukv = (const bf16_t*)(F.ws + W_UKV);
      ld_bfrag<8>(wkv, wukv + (size_t)(wave * 2) * 32 * 128, 128, lane); ld_bfrag<8>(wkv + 8, wukv + (size_t)(wave * 2 + 1) * 32 * 128, 128, lane);
      const f32x2 gckv2 = *(const f32x2*)(F.in[I_GCKV] + l * 128 + 2 * lane); const float* gkn = F.in[I_GKN] + l * 96; const float g0 = gkn[r32], g1 = gkn[32 + r32], g2 = gkn[64 + r32];
      const int nu = NTOK / 32;
      if (F.bx < nu) { MlaKvRegs R = mla_kv_load(F, F.bx);
          for (int u = F.bx; u < nu; u += F.G) { const MlaKvRegs Rn = mla_kv_load(F, (u + F.G < nu) ? u + F.G : u); mla_kv_unit(F, u, R, wkv, gckv2, g0, g1, g2); R = Rn; } } }
    { bf16x8 wqf[32]; const bf16_t* wuq = (const bf16_t*)(F.ws + W_UQ);
      ld_bfrag<16>(wqf, wuq + (size_t)wave * 32 * 256, 256, lane); if (wave < 4) ld_bfrag<16>(wqf + 16, wuq + (size_t)(8 + wave) * 32 * 256, 256, lane);
      const f32x4 gcq4 = *(const f32x4*)(F.in[I_GCQ] + l * 256 + 4 * lane); const float* gqn = F.in[I_GQN] + l * 96; const float g0 = gqn[r32], g1 = gqn[32 + r32], g2 = gqn[64 + r32];
      const int nu = (l == 0 ? NTOK : NLAT) / 32;
      if (F.bx < nu) { MlaQRegs R = mla_q_load(F, F.bx);
          for (int u = F.bx; u < nu; u += F.G) { const MlaQRegs Rn = mla_q_load(F, (u + F.G < nu) ? u + F.G : u); mla_q_unit(F, u, R, wqf, gcq4, g0, g1, g2); R = Rn; } } }
}

__device__ __forceinline__ void ml_chunk_pos(int dir, int j, bool& isctx, int& p0) {
    if (j < 2) { isctx = true; p0 = (dir == 0 ? j : 1 - j) * 128; } else { isctx = false; p0 = (dir == 0 ? (j - 2) : (63 - (j - 2))) * 128; }
}
__device__ __forceinline__ int ml_row(int b, bool isctx, int pos) { return isctx ? NLAT + b * 256 + pos : b * 8192 + pos; }
__device__ __forceinline__ float log_sigmoidf_(float x) { return fminf(x, 0.f) - log1pf(__expf(-fabsf(x))); }

struct P1Regs { u32x4 kv[4]; float gi, gf; };
__device__ __forceinline__ P1Regs ml_pass1_load(const Frame& F, int unit) {
    P1Regs R; const int j = unit % NCHK, dir = (unit / NCHK) & 1, h = (unit / (NCHK * 2)) & 3, b = unit / (NCHK * 8);
    bool isctx; int p0; ml_chunk_pos(dir, j, isctx, p0);
    const bf16_t* px = (const bf16_t*)(F.ws + WS_PX); const float* gate = (const float*)(F.ws + T_GATE); const int tid = F.tid;
#pragma unroll
    for (int q = 0; q < 4; ++q) { const int it = tid + q * NTHR, i = it & 127, c = (it >> 7) & 7, isv = it >> 10; const int pos = dir ? p0 + 127 - i : p0 + i;
        R.kv[q] = *(const u32x4*)(px + (size_t)ml_row(b, isctx, pos) * INC + (isv ? 512 : 256) + h * 64 + c * 8); }
    { const int i = tid & 127; const int pos = dir ? p0 + 127 - i : p0 + i; const float* g = gate + (size_t)ml_row(b, isctx, pos) * 16; R.gi = g[dir * 8 + h]; R.gf = g[dir * 8 + 4 + h]; }
    return R;
}
__device__ __forceinline__ void ml_pass1_unit(const Frame& F, int l, int unit, const P1Regs& R) {
    LAS float* LI = (LAS float*)F.lds; LAS float* LF = LI + 128; LAS float* WV = LI + 256;
    LAS bf16_t* KT = (LAS bf16_t*)(F.lds + 2048); LAS bf16_t* VT = KT + 64 * 136;
    const int dir = (unit / NCHK) & 1, h = (unit / (NCHK * 2)) & 3;
    const int tid = F.tid, lane = F.lane, wave = F.wave;
    const float* gb = F.in[I_MLGB] + l * 16;
    LDS_BAR();
    if (tid < 128) { LI[tid] = R.gi + gb[dir * 8 + h]; LF[tid] = log_sigmoidf_(R.gf + gb[dir * 8 + 4 + h]); }
    LDS_BAR();
    if (wave == 0) {
        const float a0 = LF[2 * lane], a1 = LF[2 * lane + 1]; float s = a0 + a1;
#pragma unroll
        for (int o = 1; o < 64; o <<= 1) { const float t = lane_up(s, o, lane); if (lane >= o) s += t; }
        const float bend = lane_bcast(s, 63);
        const float w0 = bend - (s - a1) + LI[2 * lane], w1 = bend - s + LI[2 * lane + 1];
        const float mloc = wave_max(fmaxf(w0, w1));
        WV[2 * lane] = __expf(w0 - mloc); WV[2 * lane + 1] = __expf(w1 - mloc);
        if (lane == 0) { ((float*)(F.ws + T_MLOC))[unit] = mloc; ((float*)(F.ws + T_BEND))[unit] = bend; }
    }
    LDS_BAR();
#pragma unroll
    for (int q = 0; q < 4; ++q) { const int it = tid + q * NTHR, i = it & 127, c = (it >> 7) & 7, isv = it >> 10; const u32x4 v = R.kv[q];
        const float sc = isv ? 1.0f : 0.125f * WV[i]; LAS bf16_t* d = (isv ? VT : KT) + (c * 8) * 136 + i;
        d[0] = (bf16_t)f2bf(bflo(v.x) * sc); d[136] = (bf16_t)f2bf(bfhi(v.x) * sc); d[272] = (bf16_t)f2bf(bflo(v.y) * sc); d[408] = (bf16_t)f2bf(bfhi(v.y) * sc);
        d[544] = (bf16_t)f2bf(bflo(v.z) * sc); d[680] = (bf16_t)f2bf(bfhi(v.z) * sc); d[816] = (bf16_t)f2bf(bflo(v.w) * sc); d[952] = (bf16_t)f2bf(bfhi(v.w) * sc); }
    LDS_BAR();
    if (wave < 4) { const int et = wave >> 1, dt = wave & 1; f32x16 acc = {}; acc = mma32_ll(acc, VT + et * 32 * 136, 136, KT + dt * 32 * 136, 136, 8, lane);
        float* dc = (float*)(F.ws + WS_DC) + (size_t)unit * 4096; const int r32 = lane & 31, hi = lane >> 5;
#pragma unroll
        for (int r = 0; r < 16; ++r) dc[(et * 32 + crow(r, hi)) * 64 + dt * 32 + r32] = acc[r];
    } else if (wave == 4) { float s = 0.f; for (int i = 0; i < 128; ++i) s += bf2f(KT[lane * 136 + i]); ((float*)(F.ws + T_DN))[(size_t)unit * 64 + lane] = s; }
}

__device__ __forceinline__ void ml_pass2(const Frame& F) {
    const float* dc = (const float*)(F.ws + WS_DC); const float* dn = (const float*)(F.ws + T_DN);
    const float* mloc = (const float*)(F.ws + T_MLOC); const float* bend = (const float*)(F.ws + T_BEND);
    bf16_t* cst = (bf16_t*)(F.ws + WS_CST); float* nst = (float*)(F.ws + T_NST); float* mst = (float*)(F.ws + T_MST);
    LAS float* ML = (LAS float*)F.lds; LAS float* BE = ML + 128;
    for (int it = F.bx; it < 64 * 8; it += F.G) { const int bhd = it >> 3, part = it & 7, u0 = bhd * NCHK, el = part * 512 + F.tid;
        const bool don = (part == 0 && F.tid < 64);
        float d[NCHK], dnv[NCHK];
#pragma unroll
        for (int j = 0; j < NCHK; ++j) d[j] = dc[(size_t)(u0 + j) * 4096 + el];
#pragma unroll
        for (int j = 0; j < NCHK; ++j) dnv[j] = don ? dn[(size_t)(u0 + j) * 64 + F.tid] : 0.f;
        __syncthreads();
        if (F.tid < NCHK) { ML[F.tid] = mloc[u0 + F.tid]; BE[F.tid] = bend[u0 + F.tid]; }
        __syncthreads();
        float C = 0.f, n = 0.f, m = 0.f;
#pragma unroll
        for (int j = 0; j < NCHK; ++j) { const int u = u0 + j; const float ml = ML[j], be = BE[j];
            cst[(size_t)u * 4096 + el] = (bf16_t)f2bf(C); if (don) nst[(size_t)u * 64 + F.tid] = n; if (part == 0 && F.tid == 0) mst[u] = m;
            const float mn = fmaxf(be + m, ml), dcy = __expf(be + m - mn), sc = __expf(ml - mn);
            C = dcy * C + sc * d[j]; n = dcy * n + sc * dnv[j]; m = mn; }
    }
    __syncthreads();
}

__device__ __forceinline__ void ml_pass3_unit(const Frame& F, int l, int b, int h, int pc) {
    LAS unsigned char* lds = F.lds;
    LAS bf16_t* Qs = (LAS bf16_t*)lds;
    LAS bf16_t* Ks = (LAS bf16_t*)(lds + 18432);
    LAS bf16_t* VTs = (LAS bf16_t*)(lds + 36864);
    LAS bf16_t* CTs = (LAS bf16_t*)(lds + 62976);
    LAS bf16_t* Wm = (LAS bf16_t*)(lds + 76800);
    LAS float* HS = (LAS float*)(lds + 111616);
    LAS float* VEC = (LAS float*)(lds + 144384);
    LAS float* DEN = VEC + 12 * 128;
    const int tid = F.tid, lane = F.lane, wave = F.wave, r32 = lane & 31, hi = lane >> 5;
    const bool isctx = pc < 2; const int p0 = isctx ? pc * 128 : (pc - 2) * 128;
    const float* gate = (const float*)(F.ws + T_GATE); const float* gb = F.in[I_MLGB] + l * 16;
    const bf16_t* px = (const bf16_t*)(F.ws + WS_PX);
    int unit_d[2];
#pragma unroll
    for (int dir = 0; dir < 2; ++dir) { const int j = isctx ? (dir == 0 ? pc : 1 - pc) : (dir == 0 ? pc : 2 + 63 - (pc - 2)); unit_d[dir] = ((b * 4 + h) * 2 + dir) * NCHK + j; }
    LDS_BAR();
    const u32x4 cst0 = *(const u32x4*)((const bf16_t*)(F.ws + WS_CST) + (size_t)unit_d[0] * 4096 + tid * 8), cst1 = *(const u32x4*)((const bf16_t*)(F.ws + WS_CST) + (size_t)unit_d[1] * 4096 + tid * 8);
    const float nv0 = (tid < 64) ? ((const float*)(F.ws + T_NST))[(size_t)unit_d[0] * 64 + tid] : 0.f, nv1 = (tid < 64) ? ((const float*)(F.ws + T_NST))[(size_t)unit_d[1] * 64 + tid] : 0.f;
    const float mst0 = ((const float*)(F.ws + T_MST))[unit_d[0]], mst1 = ((const float*)(F.ws + T_MST))[unit_d[1]];
    if (tid < 256) { const int dir = tid >> 7, i = tid & 127; const int pos = dir ? p0 + 127 - i : p0 + i; const float* g = gate + (size_t)ml_row(b, isctx, pos) * 16;
        VEC[(dir * 6 + 0) * 128 + i] = g[dir * 8 + h] + gb[dir * 8 + h]; VEC[(dir * 6 + 1) * 128 + i] = log_sigmoidf_(g[dir * 8 + 4 + h] + gb[dir * 8 + 4 + h]); }
    for (int it = tid; it < 3072; it += NTHR) { const int i = it & 127, c = (it >> 7) & 7, which = it >> 10;
        const u32x4 v = *(const u32x4*)(px + (size_t)ml_row(b, isctx, p0 + i) * INC + which * 256 + h * 64 + c * 8);
        if (which == 0) *(LAS u32x4*)(Qs + i * 72 + c * 8) = v;
        else if (which == 1) { u32x4 w; w.x = pk2(bflo(v.x) * 0.125f, bfhi(v.x) * 0.125f); w.y = pk2(bflo(v.y) * 0.125f, bfhi(v.y) * 0.125f); w.z = pk2(bflo(v.z) * 0.125f, bfhi(v.z) * 0.125f); w.w = pk2(bflo(v.w) * 0.125f, bfhi(v.w) * 0.125f);
            *(LAS u32x4*)(Ks + i * 72 + c * 8) = w; }
        else { LAS bf16_t* d = VTs + (c * 8) * 136 + i; d[0] = (bf16_t)(v.x & 0xffff); d[136] = (bf16_t)(v.x >> 16); d[272] = (bf16_t)(v.y & 0xffff); d[408] = (bf16_t)(v.y >> 16);
            d[544] = (bf16_t)(v.z & 0xffff); d[680] = (bf16_t)(v.z >> 16); d[816] = (bf16_t)(v.w & 0xffff); d[952] = (bf16_t)(v.w >> 16); } }
    for (int it = tid; it < 32 * 136; it += NTHR) VTs[64 * 136 + it] = (it < 128) ? (bf16_t)0x3f80 : (bf16_t)0;
    LDS_BAR();
    if (wave < 2) { const int dir = wave; LAS float* V0 = VEC + dir * 6 * 128; const float mst = dir ? mst1 : mst0;
        const float a0 = V0[128 + 2 * lane], a1 = V0[128 + 2 * lane + 1]; float s = a0 + a1;
#pragma unroll
        for (int o = 1; o < 64; o <<= 1) { const float t = lane_up(s, o, lane); if (lane >= o) s += t; }
        const float b0 = s - a1, b1 = s, c0 = V0[2 * lane] - b0, c1 = V0[2 * lane + 1] - b1;
        float pm = fmaxf(c0, c1);
#pragma unroll
        for (int o = 1; o < 64; o <<= 1) { const float t = lane_up(pm, o, lane); if (lane >= o) pm = fmaxf(pm, t); }
        float pprev = lane_up(pm, 1, lane); if (lane == 0) pprev = -INFINITY;
        const float M0 = fmaxf(mst, fmaxf(pprev, c0)), M1 = fmaxf(mst, pm);
        V0[256 + 2 * lane] = c0; V0[256 + 2 * lane + 1] = c1; V0[384 + 2 * lane] = M0; V0[384 + 2 * lane + 1] = M1;
        V0[512 + 2 * lane] = __expf(mst - M0); V0[512 + 2 * lane + 1] = __expf(mst - M1); V0[640 + 2 * lane] = __expf(-b0 - M0); V0[640 + 2 * lane + 1] = __expf(-b1 - M1);
    }
    const u32x4 og0 = *(const u32x4*)(px + (size_t)ml_row(b, isctx, p0 + (tid >> 3)) * INC + 768 + h * 64 + (tid & 7) * 8), og1 = *(const u32x4*)(px + (size_t)ml_row(b, isctx, p0 + 64 + (tid >> 3)) * INC + 768 + h * 64 + (tid & 7) * 8);
    for (int dir = 0; dir < 2; ++dir) {
        const LAS float* COLV = VEC + (dir * 6 + 2) * 128; const LAS float* MV = COLV + 128; const LAS float* AIN = COLV + 256; const LAS float* EINV = COLV + 384;
        const int rs = dir ? -72 : 72, rb = dir ? 127 : 0;
        LDS_BAR();
        *(LAS u32x4*)(CTs + (tid >> 3) * 72 + (tid & 7) * 8) = dir ? cst1 : cst0;
        if (tid < 72) CTs[64 * 72 + tid] = (tid < 64) ? (bf16_t)f2bf(dir ? nv1 : nv0) : (bf16_t)0;
        for (int q = wave; q < 16; q += 8) { const int ti = q >> 2, si = q & 3; const int sidx = si * 32 + r32, spos = dir ? 127 - sidx : sidx;
            if (si > ti) {
#pragma unroll
                for (int r = 0; r < 16; ++r) Wm[(ti * 32 + crow(r, hi)) * 136 + spos] = 0;
            } else { f32x16 acc = {}; acc = mma32_ll(acc, Qs + (rb + (dir ? -ti * 32 : ti * 32)) * 72, rs, Ks + (rb + (dir ? -si * 32 : si * 32)) * 72, rs, 4, lane); const float cv = COLV[sidx];
#pragma unroll
                for (int r = 0; r < 16; ++r) { const int t = ti * 32 + crow(r, hi); const float w = (sidx <= t) ? acc[r] * __expf(cv - MV[t]) : 0.f; Wm[t * 136 + spos] = (bf16_t)f2bf(w); } }
        }
        LDS_BAR();
        f32x16 tot[2];
#pragma unroll
        for (int k = 0; k < 2; ++k) { const int q = wave + 8 * k; if (q < 12) { const int ti = q / 3, nt = q % 3;
            f32x16 a1 = {}; a1 = mma32_ll(a1, Wm + ti * 32 * 136, 136, VTs + nt * 32 * 136, 136, dir ? 8 : (ti + 1) * 2, lane, dir ? 8 - (ti + 1) * 2 : 0);
            f32x16 a2 = {}; a2 = mma32_ll(a2, Qs + (rb + (dir ? -ti * 32 : ti * 32)) * 72, rs, CTs + nt * 32 * 72, 72, 4, lane);
#pragma unroll
            for (int r = 0; r < 16; ++r) a1[r] += AIN[ti * 32 + crow(r, hi)] * a2[r];
            tot[k] = a1;
            if (nt == 2 && r32 == 0) {
#pragma unroll
                for (int r = 0; r < 16; ++r) DEN[ti * 32 + crow(r, hi)] = a1[r]; } } }
        LDS_BAR();
#pragma unroll
        for (int k = 0; k < 2; ++k) { const int q = wave + 8 * k; if (q < 12) { const int ti = q / 3, nt = q % 3; if (nt < 2) {
#pragma unroll
            for (int r = 0; r < 16; ++r) { const int t = ti * 32 + crow(r, hi); const float hv = tot[k][r] * frcp(fmaxf(fabsf(DEN[t]), EINV[t])); const int p = dir ? 127 - t : t;
                if (dir == 0) HS[p * 64 + nt * 32 + r32] = hv; else HS[p * 64 + nt * 32 + r32] += hv; } } } }
    }
    LDS_BAR();
    { const int c8 = (tid & 7) * 8; bf16_t* yc = (bf16_t*)(F.ws + WS_YC);
      const f32x4 hg0 = *(const f32x4*)(F.in[I_MLHG] + l * 256 + h * 64 + c8), hg1 = *(const f32x4*)(F.in[I_MLHG] + l * 256 + h * 64 + c8 + 4);
#pragma unroll
      for (int half = 0; half < 2; ++half) { const int p = half * 64 + (tid >> 3); const u32x4 og = half ? og1 : og0;
        const f32x4 v0 = *(const LAS f32x4*)(HS + p * 64 + c8), v1 = *(const LAS f32x4*)(HS + p * 64 + c8 + 4);
        float ss = (v0.x * v0.x + v0.y * v0.y) + (v0.z * v0.z + v0.w * v0.w) + (v1.x * v1.x + v1.y * v1.y) + (v1.z * v1.z + v1.w * v1.w);
        ss += xor_lane<1>(ss); ss += xor_lane<2>(ss); ss += xor_lane<4>(ss);
        const float sc = frsq(ss * (1.f / 64.f) + EPS);
        const f32x4 y0 = v0 * sc * hg0 * (f32x4){sigmoidf_(bflo(og.x)), sigmoidf_(bfhi(og.x)), sigmoidf_(bflo(og.y)), sigmoidf_(bfhi(og.y))};
        const f32x4 y1 = v1 * sc * hg1 * (f32x4){sigmoidf_(bflo(og.z)), sigmoidf_(bfhi(og.z)), sigmoidf_(bflo(og.w)), sigmoidf_(bfhi(og.w))};
        *(u32x4*)(yc + (size_t)ml_row(b, isctx, p0 + p) * 1024 + h * 64 + c8) = (u32x4){pk2(y0.x, y0.y), pk2(y0.z, y0.w), pk2(y1.x, y1.y), pk2(y1.z, y1.w)}; } }
}

struct PoolRegs { u32x4 v[5]; };
__device__ __forceinline__ PoolRegs pool_load(const Frame& F, int unit) {
    PoolRegs R; const int row0 = unit * 64, tid = F.tid;
    const bool isctx = row0 >= NLAT; const int T = isctx ? 256 : 8192, t0 = isctx ? (row0 - NLAT) & 255 : row0 & 8191, rbase = row0 - t0;
    const bf16_t* px = (const bf16_t*)(F.ws + WS_PX);
#pragma unroll
    for (int q = 0; q < 5; ++q) { const int it = tid + q * NTHR, rr = it >> 5, c = it & 31, t = t0 - 8 + rr; R.v[q] = (u32x4){0u, 0u, 0u, 0u};
        if (t >= 0 && t < T) R.v[q] = *(const u32x4*)(px + (size_t)(rbase + t) * INC + C_POOL + c * 8); }
    return R;
}
__device__ __forceinline__ void pool_unit(const Frame& F, int l, int unit, const PoolRegs& R) {
    LAS float* U = (LAS float*)F.lds;
    LAS bf16_t* D = (LAS bf16_t*)(F.lds + 81920);
    const int row0 = unit * 64, tid = F.tid, lane = F.lane, wave = F.wave;
    const bool isctx = row0 >= NLAT; const int T = isctx ? 256 : 8192, t0 = isctx ? (row0 - NLAT) & 255 : row0 & 8191, rbase = row0 - t0;
    const bf16_t* px = (const bf16_t*)(F.ws + WS_PX);
    LDS_BAR();
    {
#pragma unroll
      for (int q = 0; q < 5; ++q) { const int it = tid + q * NTHR, rr = it >> 5, c = it & 31; LAS float* d = U + rr * 256 + c * 8; const u32x4 v = R.v[q];
          *(LAS f32x4*)d = (f32x4){bflo(v.x), bfhi(v.x), bflo(v.y), bfhi(v.y)}; *(LAS f32x4*)(d + 4) = (f32x4){bflo(v.z), bfhi(v.z), bflo(v.w), bfhi(v.w)}; } }
    LDS_BAR();
    { const int c = tid & 255, th = tid >> 8, g = c >> 6, hw = 1 << g, tt0 = th * 32;
      float sacc = 0.f;
      for (int u = tt0 - hw; u < tt0 + hw; ++u) sacc += U[(u + 8) * 256 + c];
#pragma unroll 4
      for (int k = 0; k < 32; ++k) { const int tt = tt0 + k, t = t0 + tt; const int lo = max(t - hw, 0), hi = min(t + hw, T);
          D[tt * 264 + c] = (bf16_t)f2bf(sacc * frcp((float)(hi - lo)) - U[(tt + 8) * 256 + c]);
          sacc += U[(tt + hw + 8) * 256 + c] - U[(tt - hw + 8) * 256 + c]; } }
    LDS_BAR();
    { const int g = wave >> 1, rt = wave & 1, r32 = lane & 31, hi = lane >> 5; bf16_t* yc = (bf16_t*)(F.ws + WS_YC); const float* ps = F.in[I_POOLS] + l * 256;
      for (int nt = 0; nt < 2; ++nt) { f32x16 acc = {}; acc = mma32_lg<4>(acc, D + rt * 32 * 264 + g * 64, 264, (const bf16_t*)(F.ws + W_POOL) + (size_t)(g * 64 + nt * 32) * 64, 64, lane);
          const int col = g * 64 + nt * 32 + r32; const float sc = ps[col];
#pragma unroll
          for (int r = 0; r < 16; ++r) yc[(size_t)(row0 + rt * 32 + crow(r, hi)) * 1024 + 512 + col] = (bf16_t)f2bf(acc[r] * sc); } }
}
__device__ __forceinline__ void conv_z(const bf16_t* p, float (&z)[8]) { const u32x4 u = *(const u32x4*)p, cc = *(const u32x4*)(p + 512);
    z[0] = bflo(u.x) * bflo(cc.x); z[1] = bfhi(u.x) * bfhi(cc.x); z[2] = bflo(u.y) * bflo(cc.y); z[3] = bfhi(u.y) * bfhi(cc.y);
    z[4] = bflo(u.z) * bflo(cc.z); z[5] = bfhi(u.z) * bfhi(cc.z); z[6] = bflo(u.w) * bflo(cc.w); z[7] = bfhi(u.w) * bfhi(cc.w); }
__device__ __forceinline__ void conv_all(const Frame& F, int l, int nrows) {
    const bf16_t* px = (const bf16_t*)(F.ws + WS_PX); bf16_t* yc = (bf16_t*)(F.ws + WS_YC);
    const int c = (F.tid & 31) * 8;
    float w0[8], w1[8], w2[8], cb[8];
#pragma unroll
    for (int e = 0; e < 8; ++e) { w0[e] = F.in[I_CONVW][l * 768 + c + e]; w1[e] = F.in[I_CONVW][l * 768 + 256 + c + e]; w2[e] = F.in[I_CONVW][l * 768 + 512 + c + e]; cb[e] = F.in[I_CONVB][l * 256 + c + e]; }
    for (int it = F.bx * NTHR + F.tid; it < (nrows / 16) * 32; it += F.G * NTHR) { const int row0 = (it >> 5) * 16;
        const bool isctx = row0 >= NLAT; const int T = isctx ? 256 : 8192, t0 = isctx ? (row0 - NLAT) & 255 : row0 & 8191;
        const bf16_t* p = px + (size_t)row0 * INC + C_CONV + c;
        float zp[8], zc[8], zn[8];
        if (t0 > 0) conv_z(p - INC, zp); else {
#pragma unroll
            for (int e = 0; e < 8; ++e) zp[e] = 0.f; }
        conv_z(p, zc);
#pragma unroll 4
        for (int r = 0; r < 16; ++r) { const bf16_t* pr = p + (size_t)r * INC;
            if (t0 + r + 1 < T) conv_z(pr + INC, zn); else {
#pragma unroll
                for (int e = 0; e < 8; ++e) zn[e] = 0.f; }
            const u32x4 bw = *(const u32x4*)(pr + 256); const float bx[8] = {bflo(bw.x), bfhi(bw.x), bflo(bw.y), bfhi(bw.y), bflo(bw.z), bfhi(bw.z), bflo(bw.w), bfhi(bw.w)};
            float y[8];
#pragma unroll
            for (int e = 0; e < 8; ++e) { y[e] = bx[e] * (cb[e] + w0[e] * zp[e] + w1[e] * zc[e] + w2[e] * zn[e]); zp[e] = zc[e]; zc[e] = zn[e]; }
            u32x4 o; o.x = pk2(y[0], y[1]); o.y = pk2(y[2], y[3]); o.z = pk2(y[4], y[5]); o.w = pk2(y[6], y[7]);
            *(u32x4*)(yc + (size_t)(row0 + r) * 1024 + 768 + c) = o; }
    }
}

namespace att {
constexpr int STAGE_B = 40960, KSUB = 12288, VOFF = 24576, VSUB = 8192, LDS_WS = 3 * STAGE_B, LDS_OST = LDS_WS + 2048;
constexpr float THR = 8.0f;
__device__ __forceinline__ void glds16(const void* gsrc, unsigned lds_dst) { unsigned keep;
    asm volatile("s_mov_b32 %0, m0\n\ts_mov_b32 m0, %2\n\ts_nop 0\n\tglobal_load_lds_dwordx4 %1, off\n\ts_mov_b32 m0, %0" : "=&s"(keep) : "v"(gsrc), "s"(lds_dst) : "memory"); }
#define ATT_WAIT_BAR(N) asm volatile("s_waitcnt vmcnt(" #N ") lgkmcnt(0)\n\ts_barrier" ::: "memory")
__device__ __forceinline__ void qkt(f32x16& p0, f32x16& p1, const LAS char* Kslot, const bf16x8* qr, int r32, int hi) {
    const LAS char* kb = Kslot + hi * 1024 + r32 * 16; p0 = f32x16{}; p1 = f32x16{};
#pragma unroll
    for (int d0 = 0; d0 < 6; ++d0) {
        const bf16x8 b0 = *(const LAS bf16x8*)(kb + d0 * 2048), b1 = *(const LAS bf16x8*)(kb + d0 * 2048 + 512);
        p0 = __builtin_amdgcn_mfma_f32_32x32x16_bf16(b0, qr[d0], p0, 0, 0, 0); p1 = __builtin_amdgcn_mfma_f32_32x32x16_bf16(b1, qr[d0], p1, 0, 0, 0); }
}
__device__ __forceinline__ float rowmax(const f32x16& p0, const f32x16& p1) {
    float a = fmaxf(p0[0], p1[0]);
#pragma unroll
    for (int r = 1; r < 16; ++r) a = fmaxf(a, fmaxf(p0[r], p1[r]));
    auto rr = __builtin_amdgcn_permlane32_swap(__float_as_uint(a), __float_as_uint(a), false, false);
    return fmaxf(__uint_as_float(rr[0]), __uint_as_float(rr[1]));
}
__device__ __forceinline__ void pv(f32x16* o, int vb, bf16x8 pa0, bf16x8 pa1, bf16x8 pa2, bf16x8 pa3) {
#pragma unroll
    for (int d0 = 0; d0 < 2; ++d0) { s16x4 lo[4], hi[4];
#pragma unroll
        for (int ks = 0; ks < 4; ++ks) {
            asm volatile("ds_read_b64_tr_b16 %0,%1 offset:%c2" : "=&v"(lo[ks]) : "v"(vb), "i"(d0 * 4096 + ks * 1024) : "memory");
            asm volatile("ds_read_b64_tr_b16 %0,%1 offset:%c2" : "=&v"(hi[ks]) : "v"(vb), "i"(d0 * 4096 + ks * 1024 + 512) : "memory"); }
        asm volatile("s_waitcnt lgkmcnt(0)" ::: "memory"); __builtin_amdgcn_sched_barrier(0);
#define ATT_PK(k) (bf16x8){lo[k][0], lo[k][1], lo[k][2], lo[k][3], hi[k][0], hi[k][1], hi[k][2], hi[k][3]}
        o[d0] = __builtin_amdgcn_mfma_f32_32x32x16_bf16(pa0, ATT_PK(0), o[d0], 0, 0, 0);
        o[d0] = __builtin_amdgcn_mfma_f32_32x32x16_bf16(pa1, ATT_PK(1), o[d0], 0, 0, 0);
        o[d0] = __builtin_amdgcn_mfma_f32_32x32x16_bf16(pa2, ATT_PK(2), o[d0], 0, 0, 0);
        o[d0] = __builtin_amdgcn_mfma_f32_32x32x16_bf16(pa3, ATT_PK(3), o[d0], 0, 0, 0);
#undef ATT_PK
    }
}
__device__ __forceinline__ void unit(const Frame& F, int bh, int qrow, int orow, int nst) {
    const int tid = F.tid, lane = F.lane, wid = F.wave, r32 = lane & 31, hi = lane >> 5, h = bh & 3;
    const unsigned lds0 = (unsigned)(uintptr_t)F.lds;
    const LAS char* ring = (const LAS char*)F.lds;
    LAS float* wsf = (LAS float*)(F.lds + LDS_WS) + wid * 64;
    const char* kg = (const char*)(F.ws + WS_KT) + (size_t)bh * NKT * 12288; const char* vg = (const char*)(F.ws + WS_VT) + (size_t)bh * NKT * 8192;
    const bf16_t* Qw = (const bf16_t*)(F.ws + WS_QB) + (size_t)(qrow + wid * 32) * 384 + h * 96;
#define ATT_DMA(t, slot) do { const char* ks_ = kg + (size_t)(t) * 24576 + wid * 1024 + lane * 16; const char* vs_ = vg + (size_t)(t) * 16384 + wid * 1024 + lane * 16; \
        const unsigned kd_ = lds0 + (slot) * STAGE_B + wid * 1024, vd_ = kd_ + VOFF; \
        glds16(ks_, (unsigned)__builtin_amdgcn_readfirstlane(kd_)); glds16(ks_ + 8192, (unsigned)__builtin_amdgcn_readfirstlane(kd_ + 8192)); glds16(ks_ + 16384, (unsigned)__builtin_amdgcn_readfirstlane(kd_ + 16384)); \
        glds16(vs_, (unsigned)__builtin_amdgcn_readfirstlane(vd_)); glds16(vs_ + 8192, (unsigned)__builtin_amdgcn_readfirstlane(vd_ + 8192)); } while (0)
    ATT_DMA(0, 0); if (nst > 1) ATT_DMA(1, 1);
    bf16x8 qr[6];
#pragma unroll
    for (int d0 = 0; d0 < 6; ++d0) qr[d0] = *(const bf16x8*)(Qw + (size_t)r32 * 384 + d0 * 16 + hi * 8);
    float mhat = 0.f, l_reg = 0.f; f32x16 o[2]; o[0] = f32x16{}; o[1] = f32x16{};
    const int vb0 = (int)lds0 + VOFF + ((lane >> 4) & 1) * 32 + (lane & 3) * 8 + (4 * hi + ((lane & 15) >> 2)) * 64;
    int slot = 0; bool first = true;
    for (int t = 0; t < nst; ++t) {
        if (t + 1 < nst) ATT_WAIT_BAR(5); else ATT_WAIT_BAR(0);
        if (t + 2 < nst) { const int s2 = (slot == 0) ? 2 : slot - 1; ATT_DMA(t + 2, s2); }
#pragma unroll
        for (int s = 0; s < 2; ++s) {
            f32x16 p0, p1; qkt(p0, p1, ring + slot * STAGE_B + s * KSUB, qr, r32, hi);
            const float rm = rowmax(p0, p1);
            if (first) { mhat = rm; first = false; }
            else if (__any(rm - mhat > THR)) { const float dl = fmaxf(rm - mhat, 0.f); mhat += dl; const float f = __builtin_amdgcn_exp2f(-dl); l_reg *= f;
                if (hi == 0) wsf[r32] = f; LDS_WAIT();
#pragma unroll
                for (int r = 0; r < 16; ++r) { const float fr_ = wsf[crow(r, hi)]; o[0][r] *= fr_; o[1][r] *= fr_; } }
            float sacc = 0.f;
#pragma unroll
            for (int r = 0; r < 16; ++r) { p0[r] = __builtin_amdgcn_exp2f(p0[r] - mhat); p1[r] = __builtin_amdgcn_exp2f(p1[r] - mhat); sacc += p0[r] + p1[r]; }
            l_reg += sacc;
            u32x4 pw0, pw1, pw2, pw3;
            pw0 = (u32x4){cvt_pk_bf16(p0[0], p0[1]), cvt_pk_bf16(p0[2], p0[3]), cvt_pk_bf16(p0[4], p0[5]), cvt_pk_bf16(p0[6], p0[7])};
            pw1 = (u32x4){cvt_pk_bf16(p0[8], p0[9]), cvt_pk_bf16(p0[10], p0[11]), cvt_pk_bf16(p0[12], p0[13]), cvt_pk_bf16(p0[14], p0[15])};
            pw2 = (u32x4){cvt_pk_bf16(p1[0], p1[1]), cvt_pk_bf16(p1[2], p1[3]), cvt_pk_bf16(p1[4], p1[5]), cvt_pk_bf16(p1[6], p1[7])};
            pw3 = (u32x4){cvt_pk_bf16(p1[8], p1[9]), cvt_pk_bf16(p1[10], p1[11]), cvt_pk_bf16(p1[12], p1[13]), cvt_pk_bf16(p1[14], p1[15])};
            __builtin_amdgcn_sched_barrier(0);
            pv(o, vb0 + slot * STAGE_B + s * VSUB, __builtin_bit_cast(bf16x8, pw0), __builtin_bit_cast(bf16x8, pw1), __builtin_bit_cast(bf16x8, pw2), __builtin_bit_cast(bf16x8, pw3));
        }
        slot = (slot == 2) ? 0 : slot + 1;
    }
    { auto rr = __builtin_amdgcn_permlane32_swap(__float_as_uint(l_reg), __float_as_uint(l_reg), false, false); l_reg = __uint_as_float(rr[0]) + __uint_as_float(rr[1]); }
    if (hi == 0) wsf[32 + r32] = l_reg; LDS_WAIT();
    float rli[16];
#pragma unroll
    for (int r = 0; r < 16; ++r) rli[r] = frcp(wsf[32 + crow(r, hi)]);
    LAS bf16_t* stg = (LAS bf16_t*)(F.lds + LDS_OST) + wid * 2048;
#pragma unroll
    for (int r = 0; r < 16; ++r) { const int orow_ = crow(r, hi);
#pragma unroll
        for (int d0 = 0; d0 < 2; ++d0) stg[orow_ * 64 + d0 * 32 + r32] = (bf16_t)f2bf(o[d0][r] * rli[r]); }
    LDS_WAIT();
    bf16_t* Ow = (bf16_t*)(F.ws + WS_YC) + (size_t)(orow + wid * 32) * 1024 + 256 + h * 64;
#pragma unroll
    for (int i = 0; i < 4; ++i) { const int row = i * 8 + (lane >> 3), ch = lane & 7; const u32x4 v = *(const LAS u32x4*)(stg + row * 64 + ch * 8); *(u32x4*)(Ow + (size_t)row * 1024 + ch * 8) = v; }
    asm volatile("s_waitcnt lgkmcnt(0)\n\ts_barrier" ::: "memory");
#undef ATT_DMA
}
}

namespace att2 {
constexpr int KSL = 12288, VSL = 8192, LDS_K = 0, LDS_V = 3 * KSL, LDS_WS = LDS_V + 3 * VSL, LDS_OST = LDS_WS + 2048;
#define A2_SBAR() __builtin_amdgcn_sched_barrier(0)
#define A2_WAIT_BAR(N) asm volatile("s_waitcnt vmcnt(" #N ") lgkmcnt(0)\n\ts_barrier" ::: "memory")
__device__ __forceinline__ void glds16s(const void* sbase, unsigned voff, unsigned lds_dst) { unsigned keep;
    asm volatile("s_mov_b32 %0, m0\n\ts_mov_b32 m0, %3\n\ts_nop 4\n\tglobal_load_lds_dwordx4 %1, %2\n\ts_mov_b32 m0, %0" : "=&s"(keep) : "v"(voff), "s"(sbase), "s"(lds_dst) : "memory"); }
__device__ __forceinline__ unsigned cvtpk_s(float lo, float hi) { typedef float f2 __attribute__((ext_vector_type(2))); typedef __bf16 b2 __attribute__((ext_vector_type(2))); f2 v = {lo, hi}; b2 b = __builtin_convertvector(v, b2); return __builtin_bit_cast(unsigned, b); }
typedef short v4i16_t __attribute__((ext_vector_type(4)));
__device__ __forceinline__ s16x4 vtr(const LAS char* p) { return __builtin_bit_cast(s16x4, __builtin_amdgcn_ds_read_tr16_b64_v4i16((LAS v4i16_t*)p)); }
__device__ __forceinline__ void kload2(bf16x8* kf, const LAS char* kp, int j) { kf[2 * j] = *(const LAS bf16x8*)(kp + j * 2048); kf[2 * j + 1] = *(const LAS bf16x8*)(kp + j * 2048 + 512); }

template <bool NOMAX> __device__ __forceinline__ void unit(const Frame& F, int bh, int qrow, int orow, int NT) {
    const int lane = F.lane, wid = F.wave, r32 = lane & 31, hi = lane >> 5, h = bh & 3;
    const unsigned lds0 = (unsigned)(uintptr_t)F.lds;
    const LAS char* shm3 = (const LAS char*)F.lds;
    LAS float* wsf = (LAS float*)(F.lds + LDS_WS) + wid * 64;
    const char* kg = (const char*)(F.ws + WS_KT) + (size_t)bh * NKT * 12288; const char* vg = (const char*)(F.ws + WS_VT) + (size_t)bh * NKT * 8192 + wid * 1024; const unsigned l16 = lane * 16;
    const bf16_t* Qw = (const bf16_t*)(F.ws + WS_QB) + (size_t)(qrow + wid * 32) * 384 + h * 96;
    const int kp2 = 8 + (wid & 3);
#define A2_DMA_K(t, sl) do { const char* s_ = kg + (size_t)(t) * 12288; const unsigned d_ = lds0 + LDS_K + (sl) * KSL; \
        glds16s(s_ + wid * 1024, l16, (unsigned)__builtin_amdgcn_readfirstlane(d_ + wid * 1024)); glds16s(s_ + kp2 * 1024, l16, (unsigned)__builtin_amdgcn_readfirstlane(d_ + kp2 * 1024)); } while (0)
#define A2_DMA_V(t, sl) glds16s(vg + (size_t)(t) * 8192, l16, (unsigned)__builtin_amdgcn_readfirstlane(lds0 + LDS_V + (sl) * VSL + wid * 1024))
    const LAS char* kp0 = shm3 + LDS_K + hi * 1024 + r32 * 16;
    const LAS char* vp0 = shm3 + LDS_V + ((lane >> 4) & 1) * 32 + (lane & 3) * 8 + (4 * hi + ((lane & 15) >> 2)) * 64;
    bf16x8 kf[12];
    A2_DMA_K(0, 0); A2_DMA_V(0, 0); A2_DMA_K(1, 1);
    bf16x8 qr[6];
#pragma unroll
    for (int d0 = 0; d0 < 6; ++d0) qr[d0] = *(const bf16x8*)(Qw + (size_t)r32 * 384 + d0 * 16 + hi * 8);
    float mhat = 0.f, l_reg = 0.f; f32x16 o[2]; o[0] = f32x16{}; o[1] = f32x16{};
    bool resc = false;
    f32x16 pA0, pA1, pB0, pB1;
    int sl_prev = 0, sl_cur = 0, sl_next = 1;
#define A2_ROT() do { sl_prev = sl_cur; sl_cur = sl_next; sl_next = (sl_next == 2) ? 0 : sl_next + 1; } while (0)
#define A2_RESC() do { if (!NOMAX && resc) { asm volatile("s_waitcnt lgkmcnt(0)" ::: "memory"); \
        _Pragma("unroll") for (int d_ = 0; d_ < 2; ++d_) _Pragma("unroll") for (int r = 0; r < 16; ++r) o[d_][r] *= wsf[crow(r, hi)]; } } while (0)
    A2_DMA_K(2, 2);
    A2_WAIT_BAR(5);
    { kload2(kf, kp0, 0); kload2(kf, kp0, 1); kload2(kf, kp0, 2); kload2(kf, kp0, 3); kload2(kf, kp0, 4); kload2(kf, kp0, 5);
      pA0 = f32x16{}; pA1 = f32x16{};
#pragma unroll
      for (int d0 = 0; d0 < 6; ++d0) { pA0 = __builtin_amdgcn_mfma_f32_32x32x16_bf16(kf[2 * d0], qr[d0], pA0, 0, 0, 0); pA1 = __builtin_amdgcn_mfma_f32_32x32x16_bf16(kf[2 * d0 + 1], qr[d0], pA1, 0, 0, 0); }
      if constexpr (!NOMAX) { float a = fmaxf(pA0[0], pA1[0]);
#pragma unroll
      for (int r = 1; r < 16; ++r) a = fmaxf(a, fmaxf(pA0[r], pA1[r]));
      { auto rr = __builtin_amdgcn_permlane32_swap(__float_as_uint(a), __float_as_uint(a), false, false); a = fmaxf(__uint_as_float(rr[0]), __uint_as_float(rr[1])); }
      mhat = a; }
#pragma unroll
      for (int r = 0; r < 16; ++r) { pA0[r] = __builtin_amdgcn_exp2f(pA0[r] - mhat); pA1[r] = __builtin_amdgcn_exp2f(pA1[r] - mhat); } }
    A2_WAIT_BAR(0);
    A2_DMA_K(3, 0); A2_DMA_V(1, 1);
    A2_ROT();
    { const LAS char* kp = kp0 + sl_cur * KSL; kload2(kf, kp, 0); kload2(kf, kp, 1); kload2(kf, kp, 2); kload2(kf, kp, 3); kload2(kf, kp, 4); kload2(kf, kp, 5); }
    A2_WAIT_BAR(3);
    s16x4 vlo[8], vhi[8]; u32x4 pw0, pw1, pw2, pw3;
#define A2_PKW(P, B) cvtpk_s(P[B], P[B + 1])
#define A2_PAF(k) __builtin_bit_cast(bf16x8, pw##k)
#define A2_VFR(i) (bf16x8){vlo[i][0], vlo[i][1], vlo[i][2], vlo[i][3], vhi[i][0], vhi[i][1], vhi[i][2], vhi[i][3]}
#define A2_PIN(x) asm volatile("" : "+v"(x))
#define A2_MX3(a, b, c) __builtin_fmaxf(__builtin_fmaxf((a), (b)), (c))
#define A2_GAPA(MF, A0, A1, A2, A3, W0, W1, PW) do { MF; sacc += A0; sacc += A1; sacc += A2; sacc += A3; A2_PIN(sacc); W0; W1; A2_PIN(PW); A2_SBAR(); } while (0)
#define A2_GAPM(MF) do { MF; A2_SBAR(); } while (0)
#define A2_EX(v) __builtin_amdgcn_exp2f(v)
#define A2_SH(v) (NOMAX ? (v) : (v) - mhat)
#define A2_GAPB(MF, X, B) do { MF; X[B] = A2_EX(A2_SH(X[B])); X[B + 1] = A2_EX(A2_SH(X[B + 1])); X[B + 2] = A2_EX(A2_SH(X[B + 2])); X[B + 3] = A2_EX(A2_SH(X[B + 3])); A2_PIN(X); A2_SBAR(); } while (0)
#define A2_VRD(i) do { vlo[i] = vtr(vp_ + (((i) >> 2) * 4096 + ((i) & 3) * 1024)); vhi[i] = vtr(vp_ + (((i) >> 2) * 4096 + ((i) & 3) * 1024 + 512)); } while (0)
#define A2_KRD(G, j) do { if (G) { kload2(kf, kp0 + sl_next * KSL, j); A2_SBAR(); } } while (0)
#define A2_MF(C, kk, qq, CI) C = __builtin_amdgcn_mfma_f32_32x32x16_bf16(kf[kk], qr[qq], CI, 0, 0, 0)
#define A2_STEP(C0, C1, P0, P1, t, GK, GV, GL) do { A2_SBAR(); \
    const LAS char* vp_ = vp0 + sl_prev * VSL; \
    A2_VRD(0); A2_SBAR(); float sacc = (P0[0] + P0[1]); \
    A2_GAPA(A2_MF(C0, 0, 0, (f32x16{})), P0[2], P0[3], P0[4], P0[5],     pw0[0] = A2_PKW(P0, 0), pw0[1] = A2_PKW(P0, 2), pw0); \
    A2_VRD(4); A2_SBAR(); A2_GAPA(A2_MF(C1, 1, 0, (f32x16{})), P0[6], P0[7], P0[8], P0[9],     pw0[2] = A2_PKW(P0, 4), pw0[3] = A2_PKW(P0, 6), pw0); \
    A2_VRD(1); A2_SBAR(); A2_GAPA(A2_MF(C0, 2, 1, C0),   P0[10], P0[11], P0[12], P0[13], pw1[0] = A2_PKW(P0, 8), pw1[1] = A2_PKW(P0, 10), pw1); \
    A2_VRD(5); A2_SBAR(); A2_GAPA(A2_MF(C1, 3, 1, C1),   P0[14], P0[15], P1[0], P1[1],   pw1[2] = A2_PKW(P0, 12), pw1[3] = A2_PKW(P0, 14), pw1); \
    A2_VRD(2); A2_SBAR(); A2_GAPA(A2_MF(C0, 4, 2, C0),   P1[2], P1[3], P1[4], P1[5],     pw2[0] = A2_PKW(P1, 0), pw2[1] = A2_PKW(P1, 2), pw2); \
    A2_VRD(6); A2_SBAR(); A2_GAPA(A2_MF(C1, 5, 2, C1),   P1[6], P1[7], P1[8], P1[9],     pw2[2] = A2_PKW(P1, 4), pw2[3] = A2_PKW(P1, 6), pw2); \
    A2_VRD(3); A2_SBAR(); A2_GAPA(A2_MF(C0, 6, 3, C0),   P1[10], P1[11], P1[12], P1[13], pw3[0] = A2_PKW(P1, 8), pw3[1] = A2_PKW(P1, 10), pw3); \
    A2_VRD(7); A2_SBAR(); A2_GAPA(A2_MF(C1, 7, 3, C1),   P1[14], P1[15], 0.f, 0.f,       pw3[2] = A2_PKW(P1, 12), pw3[3] = A2_PKW(P1, 14), pw3); \
    A2_GAPM(A2_MF(C0, 8, 4, C0)); A2_GAPM(A2_MF(C1, 9, 4, C1)); A2_GAPM(A2_MF(C0, 10, 5, C0)); A2_GAPM(A2_MF(C1, 11, 5, C1)); \
    l_reg += sacc; \
    if (GK) { A2_DMA_K((t) + 3, sl_cur); } if (GV) { A2_DMA_V((t) + 1, sl_next); } \
    if constexpr (!NOMAX) { float a = A2_MX3(C0[0], C0[1], C1[0]), b = A2_MX3(C0[2], C0[3], C1[1]); a = A2_MX3(a, C1[2], C1[3]); \
      _Pragma("unroll") for (int r = 4; r < 16; r += 4) { a = A2_MX3(a, C0[r], C0[r + 1]); b = A2_MX3(b, C0[r + 2], C0[r + 3]); a = A2_MX3(a, C1[r], C1[r + 1]); b = A2_MX3(b, C1[r + 2], C1[r + 3]); } \
      float rm = __builtin_fmaxf(a, b); { auto rr = __builtin_amdgcn_permlane32_swap(__float_as_uint(rm), __float_as_uint(rm), false, false); rm = __builtin_fmaxf(__uint_as_float(rr[0]), __uint_as_float(rr[1])); } \
      resc = false; \
      if (__builtin_expect(__any(rm - mhat > 8.0f), 0)) { const float dl = __builtin_fmaxf(rm - mhat, 0.f); mhat += dl; \
        const float f = __builtin_amdgcn_exp2f(-dl); l_reg *= f; if (hi == 0) wsf[r32] = f; resc = true; } } \
    A2_SBAR(); \
    A2_GAPB(o[0] = __builtin_amdgcn_mfma_f32_32x32x16_bf16(A2_PAF(0), A2_VFR(0), o[0], 0, 0, 0), C0, 0); \
    A2_KRD(GL, 0); A2_GAPB(o[1] = __builtin_amdgcn_mfma_f32_32x32x16_bf16(A2_PAF(0), A2_VFR(4), o[1], 0, 0, 0), C0, 4); \
    A2_KRD(GL, 1); A2_GAPB(o[0] = __builtin_amdgcn_mfma_f32_32x32x16_bf16(A2_PAF(1), A2_VFR(1), o[0], 0, 0, 0), C0, 8); \
    A2_KRD(GL, 2); A2_GAPB(o[1] = __builtin_amdgcn_mfma_f32_32x32x16_bf16(A2_PAF(1), A2_VFR(5), o[1], 0, 0, 0), C0, 12); \
    A2_KRD(GL, 3); A2_GAPB(o[0] = __builtin_amdgcn_mfma_f32_32x32x16_bf16(A2_PAF(2), A2_VFR(2), o[0], 0, 0, 0), C1, 0); \
    A2_KRD(GL, 4); A2_GAPB(o[1] = __builtin_amdgcn_mfma_f32_32x32x16_bf16(A2_PAF(2), A2_VFR(6), o[1], 0, 0, 0), C1, 4); \
    A2_KRD(GL, 5); A2_GAPB(o[0] = __builtin_amdgcn_mfma_f32_32x32x16_bf16(A2_PAF(3), A2_VFR(3), o[0], 0, 0, 0), C1, 8); \
    A2_GAPB(o[1] = __builtin_amdgcn_mfma_f32_32x32x16_bf16(A2_PAF(3), A2_VFR(7), o[1], 0, 0, 0), C1, 12); \
    } while (0)
    int t = 1;
    for (; t + 5 < NT; t += 2) {
        A2_STEP(pB0, pB1, pA0, pA1, t, true, true, true);     A2_WAIT_BAR(3); A2_RESC(); A2_ROT();
        A2_STEP(pA0, pA1, pB0, pB1, t + 1, true, true, true); A2_WAIT_BAR(3); A2_RESC(); A2_ROT();
    }
#define A2_ENDW(tt) do { if ((tt) + 3 < NT) { A2_WAIT_BAR(3); } else if ((tt) + 2 < NT) { A2_WAIT_BAR(1); } else { A2_WAIT_BAR(0); } } while (0)
    for (; t + 1 < NT; t += 2) {
        A2_STEP(pB0, pB1, pA0, pA1, t, (t + 3 < NT), (t + 1 < NT), (t + 1 < NT));     A2_ENDW(t);     A2_RESC(); A2_ROT();
        A2_STEP(pA0, pA1, pB0, pB1, t + 1, (t + 4 < NT), (t + 2 < NT), (t + 2 < NT)); A2_ENDW(t + 1); A2_RESC(); A2_ROT();
    }
    A2_STEP(pB0, pB1, pA0, pA1, NT - 1, false, false, false); A2_RESC();
    { float sacc = pB0[0] + pB0[1];
#pragma unroll
      for (int r = 2; r < 16; ++r) sacc += pB0[r];
#pragma unroll
      for (int r = 0; r < 16; ++r) sacc += pB1[r];
      l_reg += sacc;
      pw0 = (u32x4){A2_PKW(pB0, 0), A2_PKW(pB0, 2), A2_PKW(pB0, 4), A2_PKW(pB0, 6)}; pw1 = (u32x4){A2_PKW(pB0, 8), A2_PKW(pB0, 10), A2_PKW(pB0, 12), A2_PKW(pB0, 14)};
      pw2 = (u32x4){A2_PKW(pB1, 0), A2_PKW(pB1, 2), A2_PKW(pB1, 4), A2_PKW(pB1, 6)}; pw3 = (u32x4){A2_PKW(pB1, 8), A2_PKW(pB1, 10), A2_PKW(pB1, 12), A2_PKW(pB1, 14)};
      A2_SBAR();
      const int vb = (int)lds0 + LDS_V + ((lane >> 4) & 1) * 32 + (lane & 3) * 8 + (4 * hi + ((lane & 15) >> 2)) * 64 + sl_cur * VSL;
      att::pv(o, vb, A2_PAF(0), A2_PAF(1), A2_PAF(2), A2_PAF(3)); }
    { auto rr = __builtin_amdgcn_permlane32_swap(__float_as_uint(l_reg), __float_as_uint(l_reg), false, false); l_reg = __uint_as_float(rr[0]) + __uint_as_float(rr[1]); }
    if (hi == 0) wsf[32 + r32] = l_reg; LDS_WAIT();
    float rli[16];
#pragma unroll
    for (int r = 0; r < 16; ++r) rli[r] = __builtin_amdgcn_rcpf(wsf[32 + crow(r, hi)]);
    LAS bf16_t* stg = (LAS bf16_t*)(F.lds + LDS_OST) + wid * 2048;
#pragma unroll
    for (int r = 0; r < 16; ++r) { const int orow_ = crow(r, hi);
#pragma unroll
        for (int d0 = 0; d0 < 2; ++d0) stg[orow_ * 64 + d0 * 32 + r32] = (bf16_t)f2bf(o[d0][r] * rli[r]); }
    LDS_WAIT();
    bf16_t* Ow = (bf16_t*)(F.ws + WS_YC) + (size_t)(orow + wid * 32) * 1024 + 256 + h * 64;
#pragma unroll
    for (int i = 0; i < 4; ++i) { const int row = i * 8 + (lane >> 3), ch = lane & 7; const u32x4 v = *(const LAS u32x4*)(stg + row * 64 + ch * 8); *(u32x4*)(Ow + (size_t)row * 1024 + ch * 8) = v; }
    asm volatile("s_waitcnt lgkmcnt(0)\n\ts_barrier" ::: "memory");
}
}

__device__ __forceinline__ void ph_norm2_route(const Frame& F, int l, int ntok) {
    LAS bf16_t* A = (LAS bf16_t*)F.lds;
    LAS float* PART = (LAS float*)(F.lds + 66048);
    LAS float* LOG = (LAS float*)(F.lds + 131584);
    LAS int* HIST = (LAS int*)(F.lds + 139776);
    const int tid = F.tid, lane = F.lane, wave = F.wave, r32 = lane & 31, hi = lane >> 5;
    const int tpb = ntok / F.G, tok0 = F.bx * tpb;
    int* eidx = (int*)(F.ws + T_EIDX); float* ew = (float*)(F.ws + T_EW);
    const float* brt = F.in[I_BRT] + l * 64;
    if (tid < 64) HIST[tid] = 0;
    LAS f32x4* AV = (LAS f32x4*)(F.lds + 140288);
    LAS f32x4* SHV = AV + 512;
    const int mr_first = mod_row_of(tok0), mr_last = mod_row_of(tok0 + tpb - 1);
    { const int set = tid >> 8, idx = tid & 255, mrs = set ? mr_last : mr_first;
      const f32x4 gv = ((const f32x4*)(F.in[I_GFFN] + l * 1024))[idx], scv = ((const f32x4*)modp(F, l, mrs, 4))[idx];
      AV[tid] = gv * (scv + 1.0f); SHV[tid] = ((const f32x4*)modp(F, l, mrs, 3))[idx]; }
    bf16x8 wrt[2][8];
#pragma unroll
    for (int nt = 0; nt < 2; ++nt)
#pragma unroll
        for (int ks = 0; ks < 8; ++ks) wrt[nt][ks] = *(const bf16x8*)((const bf16_t*)(F.ws + W_RT) + (size_t)(nt * 32 + r32) * 1024 + wave * 128 + ks * 16 + hi * 8);
    f32x4 xn[4][4]; u32x2 mn[4][4];
#pragma unroll
    for (int rr = 0; rr < 4; ++rr) { const int t = min(wave * 4 + rr, tpb - 1); const f32x4* xr = (const f32x4*)stream_row(F, l, tok0 + t) + lane; const u32x2* mg = (const u32x2*)((const bf16_t*)(F.ws + WS_YC) + (size_t)(tok0 + t) * 1024) + lane;
#pragma unroll
        for (int j = 0; j < 4; ++j) { xn[rr][j] = xr[64 * j]; mn[rr][j] = mg[64 * j]; } }
    for (int b0 = 0; b0 < tpb; b0 += 32) {
        __syncthreads();
        { f32x4 v[4][4];
#pragma unroll
          for (int rr = 0; rr < 4; ++rr) {
#pragma unroll
                for (int j = 0; j < 4; ++j) { const u32x2 w = mn[rr][j]; v[rr][j] = xn[rr][j] + (f32x4){bflo(w.x), bfhi(w.x), bflo(w.y), bfhi(w.y)}; } }
#pragma unroll
          for (int rr = 0; rr < 4; ++rr) { const int r = wave * 4 + rr, t = b0 + r; LAS u32x2* a = (LAS u32x2*)(A + r * 1032) + lane;
            if (t < tpb) { const int row = tok0 + t, mr = mod_row_of(row); f32x4 y[4];
                f32x4* xo = (f32x4*)((row < NLAT) ? F.out + (size_t)row * 1024 : (float*)(F.ws + WS_CTXS) + (size_t)(row - NLAT) * 1024) + lane;
#pragma unroll
                for (int j = 0; j < 4; ++j) xo[64 * j] = v[rr][j];
                { float s2 = 0.f;
#pragma unroll
                  for (int j = 0; j < 4; ++j) s2 += (v[rr][j].x * v[rr][j].x + v[rr][j].y * v[rr][j].y) + (v[rr][j].z * v[rr][j].z + v[rr][j].w * v[rr][j].w);
                  const float rstd = frsq(wave_sum(s2) * (1.f / 1024.f) + EPS); const int vb = (mr == mr_first ? 0 : 256) + lane;
#pragma unroll
                  for (int j = 0; j < 4; ++j) y[j] = v[rr][j] * rstd * AV[vb + 64 * j] + SHV[vb + 64 * j]; }
                unsigned* o8 = (unsigned*)(F.ws + WS_HX8 + (size_t)row * 1024) + lane;
#pragma unroll
                for (int j = 0; j < 4; ++j) { a[64 * j] = (u32x2){pk2(y[j].x, y[j].y), pk2(y[j].z, y[j].w)}; o8[64 * j] = pk4_fp8(y[j].x, y[j].y, y[j].z, y[j].w); }
            } else {
#pragma unroll
                for (int j = 0; j < 4; ++j) a[64 * j] = (u32x2){0u, 0u}; } } }
        if (b0 + 32 < tpb) {
#pragma unroll
            for (int rr = 0; rr < 4; ++rr) { const int t = min(b0 + 32 + wave * 4 + rr, tpb - 1); const f32x4* xr = (const f32x4*)stream_row(F, l, tok0 + t) + lane; const u32x2* mg = (const u32x2*)((const bf16_t*)(F.ws + WS_YC) + (size_t)(tok0 + t) * 1024) + lane;
#pragma unroll
                for (int j = 0; j < 4; ++j) { xn[rr][j] = xr[64 * j]; mn[rr][j] = mg[64 * j]; } } }
        __syncthreads();
#pragma unroll
        for (int nt = 0; nt < 2; ++nt) { f32x16 acc = {};
#pragma unroll
            for (int ks = 0; ks < 8; ++ks) { const bf16x8 a = *(const LAS bf16x8*)(A + wave * 128 + r32 * 1032 + ks * 16 + hi * 8); acc = __builtin_amdgcn_mfma_f32_32x32x16_bf16(a, wrt[nt][ks], acc, 0, 0, 0); }
#pragma unroll
            for (int r = 0; r < 16; ++r) PART[(wave * 32 + crow(r, hi)) * 64 + nt * 32 + r32] = acc[r]; }
        __syncthreads();
        for (int i = tid; i < 2048; i += NTHR) { float s = 0.f;
#pragma unroll
            for (int w = 0; w < 8; ++w) s += PART[w * 2048 + i];
            LOG[i] = s; }
        __syncthreads();
        for (int rr = 0; rr < 4; ++rr) { const int r = wave * 4 + rr, t = b0 + r; if (t >= tpb) continue;
            const float sc = sigmoidf_(LOG[r * 64 + lane]); float v = sc + brt[lane]; float ssel = 0.f, mys = 0.f; int myi = 0;
#pragma unroll
            for (int k = 0; k < TOPK; ++k) { const float mx = wave_max(v); const unsigned long long bal = __ballot(v == mx); const int win = __ffsll((long long)bal) - 1;
                const float sw = lane_bcast(sc, win); ssel += sw; if (lane == k) { mys = sw; myi = win; } if (lane == win) v = -INFINITY; }
            if (lane < TOPK) { eidx[(size_t)(tok0 + t) * 6 + lane] = myi; ew[(size_t)(tok0 + t) * 6 + lane] = mys * frcp(ssel) * 2.5f; __hip_atomic_fetch_add(&HIST[myi], 1, __ATOMIC_RELAXED, __HIP_MEMORY_SCOPE_WORKGROUP); } }
    }
    __syncthreads();
    if (tid < 64) ((int*)(F.ws + T_HIST))[F.bx * 64 + tid] = HIST[tid];
}

__device__ __forceinline__ void ph_assign(const Frame& F, int ntok) {
    LAS int* BASE = (LAS int*)F.lds; LAS int* CUR = BASE + 64; LAS int* START = BASE + 128; LAS int* TOT = BASE + 192; LAS int* MISC = BASE + 256;
    const int tid = F.tid, hb = F.G, c = 0, tpb = ntok / F.G, ctok0 = 0, ctoks = ntok;
    const int* hist = (const int*)(F.ws + T_HIST); int* rtok = (int*)(F.ws + T_RTOK); float* rw = (float*)(F.ws + T_RW); int* slot = (int*)(F.ws + T_SLOT);
    int* tile_e = (int*)(F.ws + T_TILEE);
    __syncthreads();
    { LAS int* PT = BASE + 512; LAS int* PB = PT + 512;
      const int e = tid & 63, part = tid >> 6; int tot = 0, bef = 0;
#pragma unroll 8
      for (int k = 0; k < 32; ++k) { const int b = c * hb + part * 32 + k; if (b < (c + 1) * hb) { const int v = hist[b * 64 + e]; tot += v; if (b < F.bx) bef += v; } }
      PT[part * 64 + e] = tot; PB[part * 64 + e] = bef; }
    __syncthreads();
    if (tid < 64) { int tot = 0, bef = 0; for (int p8 = 0; p8 < 8; ++p8) { tot += BASE[512 + p8 * 64 + tid]; bef += BASE[1024 + p8 * 64 + tid]; } TOT[tid] = tot; BASE[tid] = bef; CUR[tid] = 0; }
    __syncthreads();
    if (tid == 0) { int s = 0; for (int e = 0; e < 64; ++e) { START[e] = s; s += (TOT[e] + 255) / 256 * 256; } MISC[0] = s; }
    __syncthreads();
    const int sstart = MISC[0];
    const int* eidx = (const int*)(F.ws + T_EIDX); const float* ew = (const float*)(F.ws + T_EW);
    for (int i = tid; i < tpb * 6; i += NTHR) { const int tok = F.bx * tpb + i / 6, k = i % 6; const int e = eidx[(size_t)tok * 6 + k];
        const int pos = START[e] + BASE[e] + __hip_atomic_fetch_add(&CUR[e], 1, __ATOMIC_RELAXED, __HIP_MEMORY_SCOPE_WORKGROUP); rtok[pos] = tok; rw[pos] = ew[(size_t)tok * 6 + k]; slot[(size_t)tok * 8 + k] = pos; }
    for (int i = tid; i < tpb; i += NTHR) { const int tok = F.bx * tpb + i, pos = sstart + (tok - ctok0); rtok[pos] = tok; rw[pos] = 1.0f; slot[(size_t)tok * 8 + 6] = pos; }
    if (F.bx == c * hb) {
        for (int e = 0; e < 64; ++e) { const int p0 = START[e] + TOT[e], p1 = START[e] + (TOT[e] + 255) / 256 * 256;
            for (int p = p0 + tid; p < p1; p += NTHR) { rtok[p] = ctok0; rw[p] = 0.f; }
            for (int tl = START[e] / 256 + tid; tl < p1 / 256; tl += NTHR) tile_e[tl] = e; }
        for (int tl = sstart / 256 + tid; tl < (sstart + ctoks) / 256; tl += NTHR) tile_e[tl] = 64;
        if (tid == 0) tile_e[2047] = (sstart + ctoks) / 256;
    }
}

template <bool FUSE_NORM> __device__ __forceinline__ void ph_combine(const Frame& F, int l, int c, int ntok) {
    const int lane = F.lane; const int tpb = ntok / F.G, tok0 = F.bx * tpb; (void)c;
    const int* slot = (const int*)(F.ws + T_SLOT); const unsigned char* ys = (const unsigned char*)(F.ws + WS_YS);
    int mr_cur = -1; f32x4 gtv[2][2], av[2][2], shv[2][2];
    for (int t = F.wave; t < tpb; t += NWAVES) { const int tok = tok0 + t, mr = mod_row_of(tok);
        if (mr != mr_cur) { mr_cur = mr; const float* gt = modp(F, l, mr, 5);
#pragma unroll
            for (int j = 0; j < 2; ++j)
#pragma unroll
                for (int h2 = 0; h2 < 2; ++h2) { const int c0 = 8 * lane + 512 * j + 4 * h2; gtv[j][h2] = *(const f32x4*)(gt + c0);
                    if constexpr (FUSE_NORM) { const f32x4 gv = *(const f32x4*)(F.in[I_GMIX] + 1024 + c0), scv = *(const f32x4*)(modp(F, 1, mr, 1) + c0); av[j][h2] = gv * (scv + 1.0f); shv[j][h2] = *(const f32x4*)(modp(F, 1, mr, 0) + c0); } } }
        float* xr = (tok < NLAT) ? F.out + (size_t)tok * 1024 : (float*)(F.ws + WS_CTXS) + (size_t)(tok - NLAT) * 1024;
        const int sv = slot[(size_t)tok * 8 + (lane & 7)];
        u32x2 y[7][2];
#pragma unroll
        for (int k = 0; k < 7; ++k) { const int sk = __builtin_amdgcn_readlane(sv, k); const u32x2* yr = (const u32x2*)(ys + (size_t)sk * 1024) + lane; y[k][0] = yr[0]; y[k][1] = yr[64]; }
        f32x4 xv[2][2];
#pragma unroll
        for (int j = 0; j < 2; ++j) { xv[j][0] = *(const f32x4*)(xr + 8 * lane + 512 * j); xv[j][1] = *(const f32x4*)(xr + 8 * lane + 512 * j + 4); }
#pragma unroll
        for (int j = 0; j < 2; ++j) { f32x4 a0 = {0.f, 0.f, 0.f, 0.f}, a1 = {0.f, 0.f, 0.f, 0.f};
#pragma unroll
            for (int k = 0; k < 7; ++k) { a0 += up4_fp8(y[k][j].x); a1 += up4_fp8(y[k][j].y); }
            xv[j][0] = xv[j][0] + gtv[j][0] * a0; xv[j][1] = xv[j][1] + gtv[j][1] * a1;
            *(f32x4*)(xr + 8 * lane + 512 * j) = xv[j][0]; *(f32x4*)(xr + 8 * lane + 512 * j + 4) = xv[j][1]; }
        if constexpr (FUSE_NORM) {
            float ss = 0.f;
#pragma unroll
            for (int j = 0; j < 2; ++j)
#pragma unroll
                for (int h2 = 0; h2 < 2; ++h2) { const f32x4 v = xv[j][h2]; ss += (v.x * v.x + v.y * v.y) + (v.z * v.z + v.w * v.w); }
            const float rstd = frsq(wave_sum(ss) * (1.f / 1024.f) + EPS);
            bf16_t* hx = (bf16_t*)(F.ws + WS_HX) + (size_t)tok * 1024; unsigned char* h8 = F.ws + WS_HX8 + (size_t)tok * 1024;
#pragma unroll
            for (int j = 0; j < 2; ++j) { const int c0 = 8 * lane + 512 * j; f32x4 y[2];
#pragma unroll
                for (int h2 = 0; h2 < 2; ++h2) y[h2] = xv[j][h2] * rstd * av[j][h2] + shv[j][h2];
                *(u32x4*)(hx + c0) = (u32x4){pk2(y[0].x, y[0].y), pk2(y[0].z, y[0].w), pk2(y[1].x, y[1].y), pk2(y[1].z, y[1].w)};
                *(u32x2*)(h8 + c0) = (u32x2){pk4_fp8(y[0].x, y[0].y, y[0].z, y[0].w), pk4_fp8(y[1].x, y[1].y, y[1].z, y[1].w)}; }
        }
    }
}
__device__ __forceinline__ Frame phase_frame(const Frame& F) {
    Frame Q = F; int t = threadIdx.x; asm volatile("" : "+v"(t)); Q.tid = t; Q.lane = t & 63; Q.wave = __builtin_amdgcn_readfirstlane(t >> 6);
    unsigned long long w = (unsigned long long)F.ws; asm volatile("" : "+s"(w)); Q.ws = (unsigned char*)(GAS unsigned char*)w;
    return Q;
}
constexpr int PH_PER_LAYER = 13, PH_TOTAL = 2 * PH_PER_LAYER;
__global__ void __launch_bounds__(NTHR, 2) mk_fwd(Params p) {
    extern __shared__ __attribute__((aligned(16))) unsigned char lds_raw[];
    Frame F0;
    F0.lds = (LAS unsigned char*)lds_raw; F0.ws = p.ws; F0.in = p.in; F0.out = p.out;
    F0.tid = threadIdx.x; F0.lane = F0.tid & 63; F0.wave = __builtin_amdgcn_readfirstlane(F0.tid >> 6); F0.bx = blockIdx.x; F0.G = gridDim.x;
    volatile LAS unsigned* MISC = (volatile LAS unsigned*)(F0.lds + MISC_OFF);
    if (F0.tid < 64) MISC[F0.tid] = 0u;
    __syncthreads();
    const int lo = p.ph_lo, hi = p.ph_hi;
    XcdBarrier bar; bar.bar = (unsigned*)(F0.ws + WS_CTL) + CW_BAR; bar.x = 0; bar.st = MISC + 8;
    if (hi - lo > 1) bar = xcd_barrier_post((unsigned*)(F0.ws + WS_CTL) + CW_BAR, MISC + 8);
#ifndef MK_SITE
#define MK_SITE -1
#endif
#define SITE(n) (MK_SITE < 0 || MK_SITE == (n))
#ifndef MK_REP_MASK
#define MK_REP_MASK 0
#endif
#define NREP(n) (((MK_REP_MASK >> (n)) & 1) ? 2 : 1)
#define RUN(k) (lo <= (k) && (k) < hi)
#define SEAM(k) do { if (RUN(k) && RUN((k) + 1)) { TSEC_BEGIN(300, F0.lds); xcd_barrier(bar); TSEC_END(300, F0.lds); } } while (0)
    int ph = 0;
    if (SITE(0) && RUN(ph)) TSEC_BEGIN(400 + 0, F0.lds); if (SITE(0) && RUN(ph)) for (int rep_ = 0; rep_ < NREP(0); ++rep_) { const Frame F = phase_frame(F0); ph_pre(F); ph_convert(F, 0); }
    TSEC_END(400 + 99, F0.lds); SEAM(ph); ++ph;
    for (int l = 0; l < 2; ++l) {
        const int ntok = (l == 0) ? NTOK : NLAT, nM = ntok / 256;
        if (l == 0) {
        if (SITE(1) && RUN(ph)) TSEC_BEGIN(400 + 1, F0.lds); if (SITE(1) && RUN(ph)) for (int rep_ = 0; rep_ < NREP(1); ++rep_) { const Frame F = phase_frame(F0); ph_norm1(F, l); }
        TSEC_END(400 + 99, F0.lds); SEAM(ph); ++ph;
        }
        if (SITE(2) && RUN(ph)) TSEC_BEGIN(400 + 2, F0.lds); if (SITE(2) && RUN(ph)) for (int rep_ = 0; rep_ < NREP(2); ++rep_) { const Frame F = phase_frame(F0);
            SchedPlain S{(const char*)(F.ws + WS_HX), (const char*)(F.ws + W_IN), 2048u, 2048u, 16, NTOK / 256, INCP / 256, F.G, F.bx};
            EpiWin E{(bf16_t*)(F.ws + WS_PX), (float*)(F.ws + T_GATE)};
            gg::gemm_phase(F.lds, S, E);
        }
        TSEC_END(400 + 99, F0.lds); SEAM(ph); ++ph;
        if (SITE(3) && RUN(ph)) TSEC_BEGIN(400 + 3, F0.lds); if (SITE(3) && RUN(ph)) for (int rep_ = 0; rep_ < NREP(3); ++rep_) { const Frame F = phase_frame(F0);
            for (int r2 = 0; r2 < NREP(16); ++r2) mla_prep(F, l);
            for (int r2 = 0; r2 < NREP(17); ++r2) { P1Regs R = ml_pass1_load(F, F.bx);
                for (int u = F.bx; u < 64 * NCHK; u += F.G) { const P1Regs Rn = ml_pass1_load(F, (u + F.G < 64 * NCHK) ? u + F.G : u); ml_pass1_unit(F, l, u, R); R = Rn; } }
            for (int r2 = 0; r2 < NREP(18); ++r2) { PoolRegs R = pool_load(F, F.bx);
                for (int u = F.bx; u < ntok / 64; u += F.G) { const PoolRegs Rn = pool_load(F, (u + F.G < ntok / 64) ? u + F.G : u); pool_unit(F, l, u, R); R = Rn; } }
            for (int r2 = 0; r2 < NREP(19); ++r2) conv_all(F, l, ntok);
            __syncthreads();
        }
        TSEC_END(400 + 99, F0.lds); SEAM(ph); ++ph;
        if (SITE(4) && RUN(ph)) TSEC_BEGIN(400 + 4, F0.lds); if (SITE(4) && RUN(ph)) for (int rep_ = 0; rep_ < NREP(4); ++rep_) { const Frame F = phase_frame(F0);
            ml_pass2(F);
            float gq = 0.f, gk = 0.f; for (int d = 0; d < 96; ++d) { gq = fmaxf(gq, fabsf(F.in[I_GQN][l * 96 + d])); gk = fmaxf(gk, fabsf(F.in[I_GKN][l * 96 + d])); }
            const bool nomax = (14.2f * gq * gk <= 64.0f);
            const int nunits = 1024 + (l == 0 ? 32 : 0);
#define ATT_UNITS(NM) for (int i = 0; ; ++i) { const int L = i * F.G + F.bx; if (L >= nunits) break; \
                if (L < 1024) { const int bh = (L >> 8) * 8 + (L & 7), qb = (L & 255) >> 3, b = bh >> 2; att2::unit<NM>(F, bh, b * 8192 + qb * 256, b * 8192 + qb * 256, 132); } \
                else { const int bh = L - 1024, b = bh >> 2; att2::unit<NM>(F, bh, NLAT + b * 256, NLAT + b * 256, 4); } }
            if (nomax) { ATT_UNITS(true) } else { ATT_UNITS(false) }
#undef ATT_UNITS
        }
        TSEC_END(400 + 99, F0.lds); SEAM(ph); ++ph;
        if (SITE(5) && RUN(ph)) TSEC_BEGIN(400 + 5, F0.lds); if (SITE(5) && RUN(ph)) for (int rep_ = 0; rep_ < NREP(5); ++rep_) { const Frame F = phase_frame(F0);
            const int npc = (l == 0) ? 66 : 64, nun = 32 * npc;
            for (int u = F.bx; u < nun; u += F.G) { const int bh = u / npc, pc = u % npc + (l == 0 ? 0 : 2); ml_pass3_unit(F, l, bh >> 2, bh & 3, pc); }
            __syncthreads();
        }
        TSEC_END(400 + 99, F0.lds); SEAM(ph); ++ph;
        {
            const int nMh = nM, pm0 = 0;
            if (SITE(6) && RUN(ph)) TSEC_BEGIN(400 + 6, F0.lds); if (SITE(6) && RUN(ph)) for (int rep_ = 0; rep_ < NREP(6); ++rep_) { const Frame F = phase_frame(F0);
                SchedYB S{(const char*)(F.ws + WS_YC), (const char*)(F.ws + W_BR), pm0, nMh, F.G, F.bx};
                EpiF8Out E{F.ws + WS_YB, 4096};
                gg::gemm_phase(F.lds, S, E);
            }
            TSEC_END(400 + 99, F0.lds); SEAM(ph); ++ph;
            if (SITE(13) && RUN(ph)) TSEC_BEGIN(400 + 13, F0.lds); if (SITE(13) && RUN(ph)) for (int rep_ = 0; rep_ < NREP(13); ++rep_) { const Frame F = phase_frame(F0);
                SchedPlain S{(const char*)(F.ws + WS_HX8) + (size_t)pm0 * 256 * 1024, (const char*)(F.ws + W_GATE), 1024u, 1024u, 8, nMh, 16, F.G, F.bx};
                EpiMerge2 E{(const unsigned char*)(F.ws + WS_YB), F.in[I_BGATE] + l * 4096, (bf16_t*)(F.ws + WS_ACCM) + (size_t)pm0 * 256 * 1024, 0};
                gg::gemm_phase(F.lds, S, E);
            }
            TSEC_END(400 + 99, F0.lds); SEAM(ph); ++ph;
        }
        if (SITE(7) && RUN(ph)) TSEC_BEGIN(400 + 7, F0.lds); if (SITE(7) && RUN(ph)) for (int rep_ = 0; rep_ < NREP(7); ++rep_) { const Frame F = phase_frame(F0);
            SchedPlain S{(const char*)(F.ws + WS_ACCM), (const char*)(F.ws + W_OUT), 2048u, 2048u, 16, nM, 4, F.G, F.bx};
            EpiWout E{(bf16_t*)(F.ws + WS_YC), modp(F, l, 0, 2)};
            gg::gemm_phase(F.lds, S, E);
        }
        TSEC_END(400 + 99, F0.lds); SEAM(ph); ++ph;
        if (SITE(8) && RUN(ph)) TSEC_BEGIN(400 + 8, F0.lds); if (SITE(8) && RUN(ph)) for (int rep_ = 0; rep_ < NREP(8); ++rep_) { const Frame F = phase_frame(F0); ph_norm2_route(F, l, ntok); }
        TSEC_END(400 + 99, F0.lds); SEAM(ph); ++ph;
        if (SITE(9) && RUN(ph)) TSEC_BEGIN(400 + 9, F0.lds); if (SITE(9) && RUN(ph)) for (int rep_ = 0; rep_ < NREP(9); ++rep_) { const Frame F = phase_frame(F0); ph_assign(F, ntok); }
        TSEC_END(400 + 99, F0.lds); SEAM(ph); ++ph;
        if (SITE(10) && RUN(ph)) TSEC_BEGIN(400 + 10, F0.lds); if (SITE(10) && RUN(ph)) for (int rep_ = 0; rep_ < NREP(10); ++rep_) { const Frame F = phase_frame(F0);
            int* tile_e = (int*)(F.ws + T_TILEE); const int ntiles = ld_i32_uniform(tile_e + 2047);
            LAS int* tab = (LAS int*)(F.lds + MOE_TAB_OFF); const int* rtok = (const int*)(F.ws + T_RTOK);
            __syncthreads();
            for (int i = 0; i < 28; ++i) { const int L = i * F.G + F.bx; if (L >= ntiles * 2) break; const int tile = L >> 1;
                if (F.tid == 0) tab[i] = tile_e[tile]; if (F.tid < 256) tab[256 + i * 256 + F.tid] = rtok[tile * 256 + F.tid]; }
            __syncthreads();
            SchedMoe1 S{(const char*)(F.ws + WS_HX8), (const char*)(F.ws + W_13), tab, ntiles, F.G, F.bx};
            EpiMoe1 E{(bf16_t*)(F.ws + WS_AMOE), (const float*)(F.ws + T_RW)};
            gg::gemm_phase(F.lds, S, E);
        }
        TSEC_END(400 + 99, F0.lds); SEAM(ph); ++ph;
        if (SITE(11) && RUN(ph)) TSEC_BEGIN(400 + 11, F0.lds); if (SITE(11) && RUN(ph)) for (int rep_ = 0; rep_ < NREP(11); ++rep_) { const Frame F = phase_frame(F0);
            int* tile_e = (int*)(F.ws + T_TILEE); const int ntiles = ld_i32_uniform(tile_e + 2047);
            LAS int* tab = (LAS int*)(F.lds + MOE_TAB_OFF);
            __syncthreads();
            for (int i = F.tid; i < 64; i += NTHR) { const int L = i * F.G + F.bx; if (L < ntiles * 4) tab[i] = tile_e[L >> 2]; }
            __syncthreads();
            SchedMoe2 S{(const char*)(F.ws + WS_AMOE), (const char*)(F.ws + W_2), tab, ntiles, F.G, F.bx};
            EpiF8Out E{(unsigned char*)(F.ws + WS_YS), 1024};
            gg::gemm_phase(F.lds, S, E);
        }
        TSEC_END(400 + 99, F0.lds); SEAM(ph); ++ph;
        if (SITE(12) && RUN(ph)) TSEC_BEGIN(400 + 12, F0.lds); if (SITE(12) && RUN(ph)) for (int rep_ = 0; rep_ < NREP(12); ++rep_) { const Frame F = phase_frame(F0); if (l == 0) { ph_combine<true>(F, l, 0, ntok); ph_convert(F, 1); } else ph_combine<false>(F, l, 0, ntok); }
        TSEC_END(400 + 99, F0.lds); SEAM(ph); ++ph;
    }
    if (MK_TSEC >= 0 && blockIdx.x == 0 && threadIdx.x == 0) { volatile LAS unsigned long long* q_ = (volatile LAS unsigned long long*)(F0.lds + MISC_OFF + 128);
        const unsigned long long t0 = __builtin_amdgcn_s_memrealtime(), d = q_[0] * 4ull; while (__builtin_amdgcn_s_memrealtime() - t0 < d) __builtin_amdgcn_s_sleep(8); }
#undef RUN
#undef SEAM
}

extern "C" void kernel_launch(void* const* d_in, const int* in_sizes, int n_in, void* d_out, int out_size, void* d_ws, size_t ws_size, hipStream_t stream) {
    static int grid = 0;
    if (grid == 0) {
        if (n_in != 33 || out_size != NLAT * DM || ws_size < WS_END) { fprintf(stderr, "kernel_launch: unexpected shapes (n_in %d, out %d, ws %zu < %zu)\n", n_in, out_size, ws_size, (size_t)WS_END); grid = -1; return; }
        int dev = 0, cus = 0;
        if (hipGetDevice(&dev) != hipSuccess || hipDeviceGetAttribute(&cus, hipDeviceAttributeMultiprocessorCount, dev) != hipSuccess) { grid = -1; return; }
        if (hipFuncSetAttribute((const void*)mk_fwd, hipFuncAttributeMaxDynamicSharedMemorySize, LDS_BYTES) != hipSuccess) { fprintf(stderr, "kernel_launch: hipFuncSetAttribute failed\n"); grid = -1; return; }
        int per_cu = 0;
        if (hipOccupancyMaxActiveBlocksPerMultiprocessor(&per_cu, (const void*)mk_fwd, NTHR, LDS_BYTES) != hipSuccess || per_cu < 1) fprintf(stderr, "kernel_launch: occupancy query says %d\n", per_cu);
        (void)hipGetLastError();
        if (cus < 256) { fprintf(stderr, "kernel_launch: built for a 256-CU device (got %d CUs)\n", cus); grid = -1; return; }
        grid = 256;
    }
    if (grid < 0) return;
    (void)hipMemsetAsync((char*)d_ws + WS_CTL, 0, CTL_ZERO_BYTES, stream);
    Params p{};
    for (int i = 0; i < 33; ++i) p.in[i] = (const float*)d_in[i];
    p.out = (float*)d_out; p.ws = (unsigned char*)d_ws;
#if MK_ONE_LAUNCH
    p.ph_lo = 0; p.ph_hi = PH_TOTAL;
    hipLaunchKernelGGL(mk_fwd, dim3(grid), dim3(NTHR), LDS_BYTES, stream, p);
#else
    for (int k = 0; k < PH_TOTAL; ++k) { p.ph_lo = k; p.ph_hi = k + 1; hipLaunchKernelGGL(mk_fwd, dim3(grid), dim3(NTHR), LDS_BYTES, stream, p); }
#endif
}
```

```cpp
#include <hip/hip_runtime.h>
#include <stdint.h>
#include <stdio.h>
#include <math.h>

#ifndef MK_ONE_LAUNCH
#define MK_ONE_LAUNCH 1
#endif

#define LAS __attribute__((address_space(3)))
#define GAS __attribute__((address_space(1)))
typedef unsigned short bf16_t;
typedef short bf16x8 __attribute__((ext_vector_type(8)));
typedef short s16x4 __attribute__((ext_vector_type(4)));
typedef float f32x2 __attribute__((ext_vector_type(2)));
typedef float f32x4 __attribute__((ext_vector_type(4)));
typedef float f32x16 __attribute__((ext_vector_type(16)));
typedef unsigned u32x2 __attribute__((ext_vector_type(2)));
typedef unsigned u32x4 __attribute__((ext_vector_type(4)));

constexpr int DM = 1024, NB = 8, SEQ = 8192, CTXL = 256, GRIDW = 64;
constexpr int NLAT = NB * SEQ, NCTX = NB * CTXL, NTOK = NLAT + NCTX;
constexpr int INC = 2480, INCP = 2560;
constexpr int C_ML = 0, C_G = 1024, C_MLA = 1040, C_POOL = 1456, C_CONV = 1712;
constexpr int NE = 64, NE1 = 65, TOPK = 6, NSLOT7 = 7, EFF = 256;
constexpr int NCHK = 66;
constexpr int NKT = 132;
constexpr float EPS = 1e-6f;
constexpr int NWAVES = 8, NTHR = 512;
constexpr int MOE_ROWS_MAX = 489472;
constexpr int MOE_TILES_MAX = MOE_ROWS_MAX / 256;

constexpr size_t MiB = 1u << 20;
constexpr size_t WS_CTL = 0, CTL_ZERO_BYTES = 1 * MiB;
constexpr size_t WS_MOD = 128 * 1024;
constexpr size_t WS_TAB = 1 * MiB;
constexpr size_t T_ROPE = WS_TAB;
constexpr size_t T_HIST = T_ROPE + 16384;
constexpr size_t T_TILEE = T_HIST + 65536;
constexpr size_t T_EIDX = T_TILEE + 8192;
constexpr size_t T_EW = T_EIDX + (size_t)NTOK * 6 * 4;
constexpr size_t T_SLOT = T_EW + (size_t)NTOK * 6 * 4;
constexpr size_t T_RTOK = T_SLOT + (size_t)NTOK * 8 * 4;
constexpr size_t T_RW = T_RTOK + (size_t)MOE_ROWS_MAX * 4;
constexpr size_t T_GATE = T_RW + (size_t)MOE_ROWS_MAX * 4;
constexpr size_t T_DN = T_GATE + (size_t)NTOK * 16 * 4;
constexpr size_t T_NST = T_DN + (size_t)4224 * 64 * 4;
constexpr size_t T_MLOC = T_NST + (size_t)4224 * 64 * 4;
constexpr size_t T_BEND = T_MLOC + 4224 * 4;
constexpr size_t T_MST = T_BEND + 4224 * 4;
constexpr size_t T_END = T_MST + 4224 * 4;
static_assert(T_END <= 17 * MiB, "tables");
constexpr size_t WS_WB = 17 * MiB;
constexpr size_t W_IN = WS_WB;
constexpr size_t W_GATE = W_IN + (size_t)INCP * 1024 * 2;
constexpr size_t W_BR = W_GATE + (size_t)4 * 1024 * 1024 * 2;
constexpr size_t W_OUT = W_BR + (size_t)4 * 1024 * 256 * 2;
constexpr size_t W_13 = W_OUT + (size_t)1024 * 1024 * 2;
constexpr size_t W_2 = W_13 + (size_t)NE1 * 512 * 1024 * 2;
constexpr size_t W_UQ = W_2 + (size_t)NE1 * 1024 * 256 * 2;
constexpr size_t W_UKV = W_UQ + (size_t)384 * 256 * 2;
constexpr size_t W_POOL = W_UKV + (size_t)512 * 128 * 2;
constexpr size_t W_RT = W_POOL + (size_t)4 * 64 * 64 * 2;
constexpr size_t W_END = W_RT + (size_t)64 * 1024 * 2;
static_assert(W_END <= 133 * MiB, "weights");
constexpr size_t WS_CTXS = 133 * MiB;
constexpr size_t WS_HX = 141 * MiB;
constexpr size_t WS_PX = 273 * MiB;
constexpr size_t WS_QB = 593 * MiB;
constexpr size_t WS_KT = 643 * MiB;
constexpr size_t WS_VT = 693 * MiB;
constexpr size_t WS_YC = 726 * MiB;
constexpr size_t WS_DC = 858 * MiB;
constexpr size_t WS_CST = 924 * MiB;
constexpr size_t WS_HX8 = 957 * MiB;
constexpr size_t WS_END = 1023 * MiB;
constexpr size_t WS_ACCM = WS_QB;
constexpr size_t WS_YB = WS_PX;
constexpr size_t WS_AMOE = WS_HX;
constexpr size_t WS_YS = WS_HX + 240 * MiB;
static_assert(WS_AMOE + (size_t)MOE_ROWS_MAX * 512 <= WS_YS && WS_YS + (size_t)MOE_ROWS_MAX * 1024 <= WS_HX8, "moe overlay");
static_assert(WS_YB + (size_t)NTOK * 4096 <= WS_QB && WS_ACCM + (size_t)NTOK * 2048 <= WS_YC, "merge overlay");

constexpr int CW_BAR = 4096;

constexpr int RING_BYTES = 131072;
constexpr int MISC_OFF = 160 * 1024 - 256;
constexpr int LDS_BYTES = 160 * 1024;

#ifndef MK_TSEC
#define MK_TSEC -1
#endif
#define TSEC_BEGIN(id, ldsb) do { if (MK_TSEC == (id) && blockIdx.x == 0 && threadIdx.x == 0) { volatile LAS unsigned long long* q_ = (volatile LAS unsigned long long*)((ldsb) + MISC_OFF + 128); q_[1] = __builtin_amdgcn_s_memrealtime(); } } while (0)
#define TSEC_END(id, ldsb) do { if ((MK_TSEC == (id) || ((id) == 499 && MK_TSEC >= 400 && MK_TSEC < 499)) && blockIdx.x == 0 && threadIdx.x == 0) { volatile LAS unsigned long long* q_ = (volatile LAS unsigned long long*)((ldsb) + MISC_OFF + 128); if (q_[1] != 0ull) { q_[0] += __builtin_amdgcn_s_memrealtime() - q_[1]; q_[1] = 0ull; } } } while (0)
typedef __bf16 bf16x2_t_ __attribute__((ext_vector_type(2)));
__device__ __forceinline__ unsigned pk2(float lo, float hi) { const f32x2 v = {lo, hi}; return __builtin_bit_cast(unsigned, __builtin_convertvector(v, bf16x2_t_)); }
__device__ __forceinline__ unsigned f2bf(float f) { return pk2(f, f) & 0xffffu; }
__device__ __forceinline__ float bf2f(unsigned short b) { return __builtin_bit_cast(float, ((unsigned)b) << 16); }
__device__ __forceinline__ float bflo(unsigned w) { return __builtin_bit_cast(float, w << 16); }
__device__ __forceinline__ float bfhi(unsigned w) { return __builtin_bit_cast(float, w & 0xffff0000u); }
__device__ __forceinline__ unsigned cvt_pk_bf16(float lo, float hi) { unsigned r; asm volatile("v_cvt_pk_bf16_f32 %0, %1, %2" : "=v"(r) : "v"(lo), "v"(hi)); return r; }
__device__ __forceinline__ unsigned pk4_fp8(float a, float b, float c, float d) { int r = __builtin_amdgcn_cvt_pk_fp8_f32(a, b, 0, false); r = __builtin_amdgcn_cvt_pk_fp8_f32(c, d, r, true); return (unsigned)r; }
__device__ __forceinline__ float sigmoidf_(float x) { return __builtin_amdgcn_rcpf(1.0f + __builtin_amdgcn_exp2f(x * -1.4426950408889634f)); }
template <int O> __device__ __forceinline__ float xor_lane(float v) { return __builtin_bit_cast(float, __builtin_amdgcn_ds_swizzle(__builtin_bit_cast(int, v), 0x1f | (O << 10))); }
__device__ __forceinline__ float half_sum(float v) { v += xor_lane<1>(v); v += xor_lane<2>(v); v += xor_lane<4>(v); v += xor_lane<8>(v); v += xor_lane<16>(v); return v; }
__device__ __forceinline__ float half_max(float v) { v = fmaxf(v, xor_lane<1>(v)); v = fmaxf(v, xor_lane<2>(v)); v = fmaxf(v, xor_lane<4>(v)); v = fmaxf(v, xor_lane<8>(v)); v = fmaxf(v, xor_lane<16>(v)); return v; }
__device__ __forceinline__ float wave_sum(float v) { v = half_sum(v); auto rr = __builtin_amdgcn_permlane32_swap(__builtin_bit_cast(unsigned, v), __builtin_bit_cast(unsigned, v), false, false);
    return __builtin_bit_cast(float, (unsigned)rr[0]) + __builtin_bit_cast(float, (unsigned)rr[1]); }
__device__ __forceinline__ float wave_max(float v) { v = half_max(v); auto rr = __builtin_amdgcn_permlane32_swap(__builtin_bit_cast(unsigned, v), __builtin_bit_cast(unsigned, v), false, false);
    return fmaxf(__builtin_bit_cast(float, (unsigned)rr[0]), __builtin_bit_cast(float, (unsigned)rr[1])); }
__device__ __forceinline__ float lane_up(float v, int o, int lane) { return __builtin_bit_cast(float, __builtin_amdgcn_ds_bpermute(((lane - o) & 63) << 2, __builtin_bit_cast(int, v))); }
__device__ __forceinline__ float lane_bcast(float v, int src) { return __builtin_bit_cast(float, __builtin_amdgcn_readlane(__builtin_bit_cast(int, v), src)); }
__device__ __forceinline__ float frcp(float x) { return __builtin_amdgcn_rcpf(x); }
__device__ __forceinline__ float frsq(float x) { return __builtin_amdgcn_rsqf(x); }
#define LDS_WAIT() asm volatile("s_waitcnt lgkmcnt(0)" ::: "memory")
#define LDS_BAR() asm volatile("s_waitcnt lgkmcnt(0)\n\ts_barrier" ::: "memory")
#define VM_WAIT() asm volatile("s_waitcnt vmcnt(0)" ::: "memory")

#define XB_TMO      128
#define XB_XCNT(j)  (256  + 64 * (j))
#define XB_XSUB(j)  (1280 + 64 * (j))
#define XB_XGEN(j)  (2304 + 64 * (j))
#define XB_TOP      3328
#define XB_TOPGEN   3392
#define XCD_BAR_WORDS 3456
#define XB_SPIN_CAP (1u << 22)

__device__ __forceinline__ unsigned xb_ld(unsigned* p)              { return __hip_atomic_load(p, __ATOMIC_RELAXED, __HIP_MEMORY_SCOPE_AGENT); }
__device__ __forceinline__ unsigned xb_add(unsigned* p, unsigned v) { return __hip_atomic_fetch_add(p, v, __ATOMIC_RELAXED, __HIP_MEMORY_SCOPE_AGENT); }
__device__ __forceinline__ unsigned xb_xcc_id() { return (unsigned)__builtin_amdgcn_s_getreg((3 << 11) | 20) & 0xFu; }
#define XB_SPIN(cond, bar) do { unsigned _sp = 0; while (cond) { __builtin_amdgcn_s_sleep(1); \
    if ((++_sp & 255u) == 0u) { if (xb_ld(&(bar)[XB_TMO])) break; if (_sp > XB_SPIN_CAP) { atomicAdd(&(bar)[XB_TMO], 1u); break; } } } } while (0)

struct XcdBarrier { unsigned* bar; unsigned x; volatile LAS unsigned* st; };

__device__ __forceinline__ XcdBarrier xcd_barrier_post(unsigned* bar, volatile LAS unsigned* st) {
    XcdBarrier b; b.bar = bar; b.x = xb_xcc_id(); b.st = st;
    if (threadIdx.x == 0) (void)xb_add(&bar[XB_XCNT(b.x)], 1u);
    return b;
}
__device__ __forceinline__ void xcd_barrier_complete(unsigned* bar, unsigned x, unsigned& nloc, unsigned& nx) {
    const unsigned G = gridDim.x * gridDim.y * gridDim.z;
    unsigned sum, cnt, mine, sp = 0u;
    for (;;) {
        sum = 0u; cnt = 0u; mine = 0u;
#pragma unroll
        for (unsigned j = 0; j < 16; ++j) { const unsigned c = xb_ld(&bar[XB_XCNT(j)]); sum += c; cnt += (c > 0u) ? 1u : 0u; mine = (j == x) ? c : mine; }
        if (sum == G) break;
        __builtin_amdgcn_s_sleep(1);
        if ((++sp & 255u) == 0u) { if (xb_ld(&bar[XB_TMO])) break; if (sp > XB_SPIN_CAP) { atomicAdd(&bar[XB_TMO], 1u); break; } }
    }
    nloc = mine > 0u ? mine : 1u; nx = cnt > 0u ? cnt : 1u;
}
__device__ __forceinline__ void xcd_barrier(const XcdBarrier& b) {
    asm volatile("s_waitcnt vmcnt(0)" ::: "memory");
    __syncthreads();
    if (threadIdx.x == 0) {
        unsigned* bar = b.bar;
        __builtin_amdgcn_s_waitcnt(0);
        unsigned nloc = b.st[0], nx = b.st[1];
        if (nloc == 0u) { xcd_barrier_complete(bar, b.x, nloc, nx); b.st[0] = nloc; b.st[1] = nx; }
        const unsigned old = xb_add(&bar[XB_XSUB(b.x)], 1u);
        const unsigned gen = old / nloc;
        if (old + 1u == (gen + 1u) * nloc) {
            __builtin_amdgcn_fence(__ATOMIC_RELEASE, "agent");
            asm volatile("s_waitcnt vmcnt(0)" ::: "memory");
            const unsigned og = xb_add(&bar[XB_TOP], 1u);
            const unsigned tg = og / nx;
            if (og + 1u == (tg + 1u) * nx) xb_add(&bar[XB_TOPGEN], 1u);
            else XB_SPIN(xb_ld(&bar[XB_TOPGEN]) == tg, bar);
            __builtin_amdgcn_fence(__ATOMIC_ACQUIRE, "agent");
            xb_add(&bar[XB_XGEN(b.x)], 1u);
            asm volatile("s_waitcnt vmcnt(0)" ::: "memory");
        } else {
            XB_SPIN(xb_ld(&bar[XB_XGEN(b.x)]) == gen, bar);
            __builtin_amdgcn_fence(__ATOMIC_ACQUIRE, "agent");
            asm volatile("s_waitcnt vmcnt(0)" ::: "memory");
        }
    }
    __syncthreads();
}

struct Params { const float* in[33]; float* out; unsigned char* ws; int ph_lo, ph_hi; };

struct Frame {
    LAS unsigned char* lds;
    unsigned char* ws;
    const float* const* in;
    float* out;
    int tid, lane, wave, bx, G;
};
enum { I_X = 0, I_C, I_CTX, I_CCTX, I_WMOD, I_BMOD, I_GMIX, I_GFFN, I_WIN, I_MLGB, I_MLHG, I_GCQ, I_GCKV, I_WUQ, I_WUKV, I_GQN, I_GKN, I_POOLW, I_POOLS,
       I_CONVW, I_CONVB, I_WGATE, I_BGATE, I_WBR, I_WOUT, I_WRT, I_BRT, I_W1, I_W3, I_W2, I_WS1, I_WS3, I_WS2 };

__device__ __forceinline__ const float* modp(const Frame& F, int l, int r, int which) { return (const float*)(F.ws + WS_MOD) + ((size_t)(l * 9 + r)) * 6144 + which * 1024; }
__device__ __forceinline__ int mod_row_of(int row) { return row < NLAT ? (row >> 13) : 8; }

__device__ __forceinline__ f32x4 up4_fp8(unsigned w) { const f32x2 lo = __builtin_amdgcn_cvt_pk_f32_fp8((int)w, false), hi = __builtin_amdgcn_cvt_pk_f32_fp8((int)w, true); return (f32x4){lo.x, lo.y, hi.x, hi.y}; }
namespace gg {
typedef int v4i_t __attribute__((ext_vector_type(4)));
constexpr int BM = 256, BK = 64, HALF = 128, HTB = HALF * BK * 2, STAGE_BYTES = 8 * HTB;
__device__ __forceinline__ int lds_byte(int r, int c) { const int st = (r >> 4) * 2 + (c >> 5), rr = r & 15, cc = c & 31, ob = rr * 64 + cc * 2; return st * 1024 + (ob ^ (((ob >> 9) & 1) << 5)); }
__device__ __forceinline__ void stage_rc(int b, int& R, int& C) { const int st = b / 1024, sb = b % 1024, swz = sb ^ (((sb >> 9) & 1) << 5); R = (st >> 1) * 16 + swz / 64; C = (st & 1) * 32 + (swz % 64) / 2; }
__device__ __forceinline__ int perm32(int rho) { const int n = rho >> 4, i = rho & 15; return 8 * (i >> 2) + 4 * n + (i & 3); }

struct Unit {
    const char* A; const char* B;
    unsigned lda, ldb;
    int nt;
    int ridx_off;
    int p0, p1, p2;
};

template <class Epi, class Sched>
__device__ __forceinline__ void gemm_phase(LAS unsigned char* lds, const Sched& S, const Epi& E) {
    int tid_ = threadIdx.x; asm volatile("" : "+v"(tid_));
    const int tid = tid_, wid = __builtin_amdgcn_readfirstlane(tid >> 6), lane = tid & 63, wr = wid >> 2, wc = wid & 3, fr = lane & 15, fq = lane >> 4;
    const size_t kstep = (size_t)(BK * 2);
    const unsigned ldsw = (unsigned)wid * 1024u;
    const int aoff = lds_byte(wr * 64 + fr, fq * 8), boff = lds_byte(wc * 32 + fr, fq * 8);
#define GG_SA(b, h) (((b) * 2 + (h)) * HTB)
#define GG_SB(b, h) ((4 + (b) * 2 + (h)) * HTB)
#define GG_STAGE(bufoff, gbase, v0, v1) do { \
        __builtin_amdgcn_global_load_lds((const unsigned*)((const char*)(gbase) + (v0)), (LAS unsigned*)(lds + (bufoff) + ldsw), 16, 0, 0); \
        __builtin_amdgcn_global_load_lds((const unsigned*)((const char*)(gbase) + (v1)), (LAS unsigned*)(lds + (bufoff) + ldsw + 8192), 16, 0, 0); } while (0)
#define GG_LDA(dst, b, h) do { _Pragma("unroll") for (int m = 0; m < 4; ++m) _Pragma("unroll") for (int k = 0; k < 2; ++k) dst[m][k] = *(const LAS bf16x8*)(lds + GG_SA(b, h) + aoff + m * 2048 + k * 1024); } while (0)
#define GG_LDB(dst, b, h) do { _Pragma("unroll") for (int n = 0; n < 2; ++n) _Pragma("unroll") for (int k = 0; k < 2; ++k) dst[n][k] = *(const LAS bf16x8*)(lds + GG_SB(b, h) + boff + n * 2048 + k * 1024); } while (0)
#define GG_MMA(ai, bj, At, Bt) do { __builtin_amdgcn_s_setprio(1); _Pragma("unroll") for (int m = 0; m < 4; ++m) _Pragma("unroll") for (int n = 0; n < 2; ++n) _Pragma("unroll") for (int k = 0; k < 2; ++k) \
        acc[ai][bj][m][n] = __builtin_amdgcn_mfma_f32_16x16x32_bf16(Bt[n][k], At[m][k], acc[ai][bj][m][n], 0, 0, 0); __builtin_amdgcn_s_setprio(0); } while (0)
#define GG_CAT8(x, y) __builtin_shufflevector(__builtin_bit_cast(v4i_t, x), __builtin_bit_cast(v4i_t, y), 0, 1, 2, 3, 4, 5, 6, 7)
#define GG_MMA8(ai, bj, At, Bt) do { __builtin_amdgcn_s_setprio(1); _Pragma("unroll") for (int m = 0; m < 4; ++m) _Pragma("unroll") for (int n = 0; n < 2; ++n) \
        acc[ai][bj][m][n] = __builtin_amdgcn_mfma_scale_f32_16x16x128_f8f6f4(GG_CAT8(Bt[n][0], Bt[n][1]), GG_CAT8(At[m][0], At[m][1]), acc[ai][bj][m][n], 0, 0, 0, (int)Epi::SCB, 0, 0x7f7f7f7f); __builtin_amdgcn_s_setprio(0); } while (0)
#define GG_MM(ai, bj, At, Bt) do { if constexpr (Epi::FP8) GG_MMA8(ai, bj, At, Bt); else GG_MMA(ai, bj, At, Bt); } while (0)
#define GG_WAIT_V(n) asm volatile("s_waitcnt vmcnt(" #n ")" ::: "memory")
#define GG_WAIT_L(n) asm volatile("s_waitcnt lgkmcnt(" #n ")" ::: "memory")
#define GG_BAR __builtin_amdgcn_s_barrier()
#define GG_SCHED __builtin_amdgcn_sched_barrier(0)
#define GG_OFFS(u) do { int R0_, C0_, R1_, C1_; stage_rc(tid * 16, R0_, C0_); stage_rc(tid * 16 + 8192, R1_, C1_); \
        if (Sched::GATHER) { const LAS int* rl_ = (const LAS int*)(lds + (u).ridx_off); vA0 = (unsigned)rl_[R0_] * (u).lda + C0_ * 2; vA1 = (unsigned)rl_[R1_] * (u).lda + C1_ * 2; \
                             vA2 = (unsigned)rl_[128 + R0_] * (u).lda + C0_ * 2; vA3 = (unsigned)rl_[128 + R1_] * (u).lda + C1_ * 2; hA = 0; } \
        else { vA0 = (unsigned)R0_ * (u).lda + C0_ * 2; vA1 = (unsigned)R1_ * (u).lda + C1_ * 2; vA2 = vA0; vA3 = vA1; hA = (size_t)128 * (u).lda; } \
        const int Rb0_ = Epi::PERM ? ((R0_ & ~31) + perm32(R0_ & 31)) : R0_, Rb1_ = Epi::PERM ? ((R1_ & ~31) + perm32(R1_ & 31)) : R1_; \
        vB0 = (unsigned)Rb0_ * (u).ldb + C0_ * 2; vB1 = (unsigned)Rb1_ * (u).ldb + C1_ * 2; hB = (size_t)128 * (u).ldb; } while (0)
    Unit cur, nxt; int ui = 0;
    if (!S.next(0, cur)) return;
    f32x4 acc[2][2][4][2];
#pragma unroll
    for (int a = 0; a < 2; ++a)
#pragma unroll
        for (int b = 0; b < 2; ++b)
#pragma unroll
            for (int m = 0; m < 4; ++m)
#pragma unroll
                for (int n = 0; n < 2; ++n) acc[a][b][m][n] = (f32x4){0.f, 0.f, 0.f, 0.f};
    bf16x8 At[4][2], B0[2][2], B1[2][2];
    unsigned vA0, vA1, vA2, vA3, vB0, vB1; size_t hA, hB;
    GG_OFFS(cur);
    const char* cA = cur.A; const char* cB = cur.B;
    GG_STAGE(GG_SB(0, 0), cB, vB0, vB1); GG_STAGE(GG_SB(0, 1), cB + hB, vB0, vB1); GG_STAGE(GG_SA(0, 0), cA, vA0, vA1); GG_STAGE(GG_SA(0, 1), cA + hA, vA2, vA3);
    if (wr == 1) GG_BAR;
    GG_WAIT_V(2); GG_BAR;
    GG_STAGE(GG_SB(1, 0), cB + kstep, vB0, vB1); GG_STAGE(GG_SA(1, 0), cA + kstep, vA0, vA1); GG_STAGE(GG_SB(1, 1), cB + hB + kstep, vB0, vB1);
    GG_WAIT_V(6); GG_BAR;
    for (;;) {
        const bool has_next = S.next(ui + 1, nxt);
        TSEC_BEGIN(100 + Epi::TID, lds);
        int nt_ = cur.nt; asm volatile("" : "+s"(nt_)); const int nt = nt_;
#pragma unroll 1
        for (int t = 0; t < nt; t += 2) {
            const bool last = (t == nt - 2);
            const char* a1 = cA + (size_t)(t + 1) * kstep;
            GG_LDB(B0, 0, 0); GG_LDB(B1, 0, 1); GG_SCHED; GG_LDA(At, 0, 0); GG_STAGE(GG_SA(1, 1), a1 + hA, vA2, vA3);
            GG_WAIT_V(8); GG_WAIT_L(0); GG_BAR; GG_MM(0, 0, At, B0); GG_MM(0, 1, At, B1); GG_BAR; GG_SCHED;
            if (last) { if (has_next) { GG_OFFS(nxt); cA = nxt.A - (size_t)nt * kstep; cB = nxt.B - (size_t)nt * kstep; } else { cA -= (size_t)nt * kstep; cB -= (size_t)nt * kstep; } }
            const char* a2 = cA + (size_t)(t + 2) * kstep; const char* b2 = cB + (size_t)(t + 2) * kstep; const char* a3 = a2 + kstep; const char* b3 = b2 + kstep;
            GG_LDA(At, 0, 1); GG_STAGE(GG_SB(0, 0), b2, vB0, vB1); GG_STAGE(GG_SB(0, 1), b2 + hB, vB0, vB1); GG_STAGE(GG_SA(0, 0), a2, vA0, vA1);
            GG_WAIT_V(8); GG_WAIT_L(0); GG_BAR; GG_MM(1, 0, At, B0); GG_MM(1, 1, At, B1); GG_BAR; GG_SCHED;
            GG_LDB(B0, 1, 0); GG_LDB(B1, 1, 1); GG_SCHED; GG_LDA(At, 1, 0); GG_STAGE(GG_SA(0, 1), a2 + hA, vA2, vA3);
            GG_WAIT_V(8); GG_WAIT_L(0); GG_BAR; GG_MM(0, 0, At, B0); GG_MM(0, 1, At, B1); GG_BAR; GG_SCHED;
            GG_LDA(At, 1, 1); GG_STAGE(GG_SB(1, 0), b3, vB0, vB1); GG_STAGE(GG_SB(1, 1), b3 + hB, vB0, vB1); GG_STAGE(GG_SA(1, 0), a3, vA0, vA1);
            GG_WAIT_V(8); GG_WAIT_L(0); GG_BAR; GG_MM(1, 0, At, B0); GG_MM(1, 1, At, B1); GG_BAR; GG_SCHED;
        }
        cA += (size_t)nt * kstep; cB += (size_t)nt * kstep;
        TSEC_END(100 + Epi::TID, lds);
        if (wr == 0) GG_BAR;
        TSEC_BEGIN(200 + Epi::TID, lds); { int t2_ = threadIdx.x; asm volatile("" : "+v"(t2_)); E(acc, cur, wr, wc, t2_ & 15, (t2_ & 63) >> 4); } TSEC_END(200 + Epi::TID, lds);
        if (!has_next) break;
#pragma unroll
        for (int a = 0; a < 2; ++a)
#pragma unroll
            for (int b = 0; b < 2; ++b)
#pragma unroll
                for (int m = 0; m < 4; ++m)
#pragma unroll
                    for (int n = 0; n < 2; ++n) acc[a][b][m][n] = (f32x4){0.f, 0.f, 0.f, 0.f};
        cur = nxt; ++ui;
        if (wr == 1) GG_BAR;
    }
    GG_WAIT_V(0);
    GG_BAR;
#undef GG_SA
#undef GG_SB
#undef GG_STAGE
#undef GG_LDA
#undef GG_LDB
#undef GG_MMA
#undef GG_MMA8
#undef GG_MM
#undef GG_CAT8
#undef GG_WAIT_V
#undef GG_WAIT_L
#undef GG_BAR
#undef GG_SCHED
#undef GG_OFFS
}
}

__device__ __forceinline__ int ld_i32_uniform(const int* p) { return __builtin_amdgcn_readfirstlane(__hip_atomic_load(p, __ATOMIC_RELAXED, __HIP_MEMORY_SCOPE_AGENT)); }
__device__ __forceinline__ void tile_order(int L, int nM, int nN, int& pm, int& pn) {
    const int nwg = nM * nN; int wgid = L;
    { const int q = nwg / 8, r = nwg % 8, xcd = wgid % 8, off = wgid / 8; wgid = (xcd < r ? xcd * (q + 1) : r * (q + 1) + (xcd - r) * q) + off; }
    const int nig = 8 * nN, gid = wgid / nig, fm = gid * 8, gsz = (nM - fm) < 8 ? (nM - fm) : 8;
    pm = fm + ((wgid % nig) % gsz); pn = (wgid % nig) / gsz;
}
struct SchedPlain {
    static constexpr bool GATHER = false;
    const char* A; const char* B; unsigned lda, ldb; int nt, nM, nN, G, c;
    __device__ __forceinline__ bool next(int i, gg::Unit& u) const {
        const int L = i * G + c; if (L >= nM * nN) return false;
        int pm, pn; tile_order(L, nM, nN, pm, pn);
        u.A = A + (size_t)pm * 256 * lda; u.B = B + (size_t)pn * 256 * ldb; u.lda = lda; u.ldb = ldb; u.nt = nt; u.ridx_off = 0; u.p0 = pm; u.p1 = pn; u.p2 = 0; return true;
    }
};
struct EpiWin {
    static constexpr bool PERM = true, FP8 = false; static constexpr int TID = 0; static constexpr unsigned SCB = 0x7f7f7f7fu;
    bf16_t* px; float* gate;
    __device__ __forceinline__ void operator()(const f32x4 (&acc)[2][2][4][2], const gg::Unit& u, int wr, int wc, int fr, int fq) const {
        const int row0 = u.p0 * 256 + wr * 64 + fr;
#pragma unroll
        for (int bj = 0; bj < 2; ++bj) {
            const int c0 = u.p1 * 256 + bj * 128 + wc * 32 + 8 * fq;
            if (c0 < INC) {
                const bool isg = (c0 >= C_G && c0 < C_MLA);
#pragma unroll
                for (int ai = 0; ai < 2; ++ai)
#pragma unroll
                    for (int m = 0; m < 4; ++m) { const int row = row0 + ai * 128 + m * 16; const f32x4 v0 = acc[ai][bj][m][0], v1 = acc[ai][bj][m][1];
                        u32x4 w; w.x = cvt_pk_bf16(v0[0], v0[1]); w.y = cvt_pk_bf16(v0[2], v0[3]); w.z = cvt_pk_bf16(v1[0], v1[1]); w.w = cvt_pk_bf16(v1[2], v1[3]);
                        *(u32x4*)(px + (size_t)row * INC + c0) = w;
                        if (isg) { float* gp = gate + (size_t)row * 16 + (c0 - C_G); *(f32x4*)gp = v0; *(f32x4*)(gp + 4) = v1; } }
            }
        }
    }
};
struct SchedYB {
    static constexpr bool GATHER = false;
    const char* yc; const char* wb; int pm0, nMh, G, c;
    __device__ __forceinline__ bool next(int i, gg::Unit& u) const {
        const int L = i * G + c; if (L >= nMh * 16) return false;
        int pm, q; tile_order(L, nMh, 16, pm, q); const int br = q >> 2, pn = q & 3;
        u.A = yc + (size_t)(pm0 + pm) * 256 * 2048 + br * 512; u.lda = 2048; u.B = wb + (size_t)br * (1024 * 512) + (size_t)pn * 256 * 512; u.ldb = 512; u.nt = 4; u.ridx_off = 0; u.p0 = pm; u.p1 = q; u.p2 = 0; return true;
    }
};
struct EpiMerge2 {
    static constexpr bool PERM = false, FP8 = true; static constexpr int TID = 4; static constexpr unsigned SCB = 0x79797979u;
    const unsigned char* yb; const float* bgate; unsigned char* accm; int pm0;
    __device__ __forceinline__ void operator()(const f32x4 (&acc)[2][2][4][2], const gg::Unit& u, int wr, int wc, int fr, int fq) const {
        const int c = u.p1 * 64 + 16 * wc + 4 * fq, r0 = wr * 64 + fr;
        f32x4 bv[2][2];
#pragma unroll
        for (int bj = 0; bj < 2; ++bj)
#pragma unroll
            for (int n = 0; n < 2; ++n) bv[bj][n] = *(const f32x4*)(bgate + (2 * bj + n) * 1024 + c);
#pragma unroll
        for (int ai = 0; ai < 2; ++ai) {
#pragma unroll
            for (int m = 0; m < 4; ++m) { const int rl = (u.p0 - pm0) * 256 + r0 + ai * 128 + m * 16; const unsigned char* yr = yb + (size_t)rl * 4096 + c;
                f32x4 t = {0.f, 0.f, 0.f, 0.f};
#pragma unroll
                for (int bj = 0; bj < 2; ++bj)
#pragma unroll
                    for (int n = 0; n < 2; ++n) { const f32x4 y = up4_fp8(*(const unsigned*)(yr + (2 * bj + n) * 1024)); const f32x4 g = acc[ai][bj][m][n] + bv[bj][n];
                        t[0] += sigmoidf_(g[0]) * y[0]; t[1] += sigmoidf_(g[1]) * y[1]; t[2] += sigmoidf_(g[2]) * y[2]; t[3] += sigmoidf_(g[3]) * y[3]; }
                *(unsigned*)(accm + (size_t)(u.p0 * 256 + r0 + ai * 128 + m * 16) * 1024 + c) = pk4_fp8(t[0], t[1], t[2], t[3]); } }
    }
};
struct EpiWout {
    static constexpr bool PERM = true, FP8 = true; static constexpr int TID = 1; static constexpr unsigned SCB = 0x79797979u;
    bf16_t* mrg; const float* gt;
    __device__ __forceinline__ void operator()(const f32x4 (&acc)[2][2][4][2], const gg::Unit& u, int wr, int wc, int fr, int fq) const {
        const int pm = u.p0; const int mrow = pm >= 256 ? 8 : (pm >> 5);
        const float* g = gt + (size_t)mrow * 6144;
        const int row0 = pm * 256 + wr * 64 + fr, col0 = u.p1 * 256 + wc * 32 + 8 * fq;
#pragma unroll
        for (int bj = 0; bj < 2; ++bj) { const f32x4 g0 = *(const f32x4*)(g + col0 + bj * 128), g1 = *(const f32x4*)(g + col0 + bj * 128 + 4);
#pragma unroll
            for (int ai = 0; ai < 2; ++ai)
#pragma unroll
                for (int m = 0; m < 4; ++m) { const f32x4 v0 = acc[ai][bj][m][0] * g0, v1 = acc[ai][bj][m][1] * g1;
                    u32x4 w; w.x = cvt_pk_bf16(v0[0], v0[1]); w.y = cvt_pk_bf16(v0[2], v0[3]); w.z = cvt_pk_bf16(v1[0], v1[1]); w.w = cvt_pk_bf16(v1[2], v1[3]);
                    *(u32x4*)(mrg + (size_t)(row0 + ai * 128 + m * 16) * 1024 + col0 + bj * 128) = w; } }
    }
};
constexpr int MOE_TAB_OFF = RING_BYTES, MOE_RIDX_OFF = RING_BYTES + 1024;
struct SchedMoe1 {
    static constexpr bool GATHER = true;
    const char* hx2; const char* w13; const LAS int* tab; int ntiles, G, c;
    __device__ __forceinline__ bool next(int i, gg::Unit& u) const {
        const int L = i * G + c; if (L >= ntiles * 2) return false;
        const int tile = L >> 1, pn = L & 1, e = __builtin_amdgcn_readfirstlane(tab[i]);
        u.A = hx2; u.lda = 1024; u.ridx_off = MOE_RIDX_OFF + i * 1024; u.B = w13 + (size_t)e * (512 * 1024) + (size_t)pn * 256 * 1024; u.ldb = 1024; u.nt = 8; u.p0 = tile; u.p1 = pn; u.p2 = e; return true;
    }
};
struct EpiMoe1 {
    static constexpr bool PERM = true, FP8 = true; static constexpr int TID = 5; static constexpr unsigned SCB = 0x79797979u;
    bf16_t* a; const float* roww;
    __device__ __forceinline__ void operator()(const f32x4 (&acc)[2][2][4][2], const gg::Unit& u, int wr, int wc, int fr, int fq) const {
        const int row0 = u.p0 * 256 + wr * 64 + fr, col = u.p1 * 128 + wc * 32 + 8 * fq;
#pragma unroll
        for (int ai = 0; ai < 2; ++ai)
#pragma unroll
            for (int m = 0; m < 4; ++m) { const int row = row0 + ai * 128 + m * 16; const float rw = roww[row];
                float t[8];
#pragma unroll
                for (int n = 0; n < 2; ++n)
#pragma unroll
                    for (int j = 0; j < 4; ++j) { const float g1 = acc[ai][0][m][n][j], g3 = acc[ai][1][m][n][j]; t[n * 4 + j] = g1 * sigmoidf_(g1) * g3 * rw; }
                u32x4 w; w.x = cvt_pk_bf16(t[0], t[1]); w.y = cvt_pk_bf16(t[2], t[3]); w.z = cvt_pk_bf16(t[4], t[5]); w.w = cvt_pk_bf16(t[6], t[7]);
                *(u32x4*)(a + (size_t)row * 256 + col) = w; }
    }
};
struct SchedMoe2 {
    static constexpr bool GATHER = false;
    const char* a; const char* w2; const LAS int* tab; int ntiles, G, c;
    __device__ __forceinline__ bool next(int i, gg::Unit& u) const {
        const int L = i * G + c; if (L >= ntiles * 4) return false;
        const int tile = L >> 2, pn = L & 3, e = __builtin_amdgcn_readfirstlane(tab[i]);
        u.A = a + (size_t)tile * 256 * 512; u.lda = 512; u.ridx_off = 0; u.B = w2 + (size_t)e * (1024 * 512) + (size_t)pn * 256 * 512; u.ldb = 512; u.nt = 4; u.p0 = tile; u.p1 = pn; u.p2 = e; return true;
    }
};
struct EpiBf16Plain {
    static constexpr bool PERM = true, FP8 = false; static constexpr int TID = 2; static constexpr unsigned SCB = 0x7f7f7f7fu;
    bf16_t* O; int ldc;
    __device__ __forceinline__ void operator()(const f32x4 (&acc)[2][2][4][2], const gg::Unit& u, int wr, int wc, int fr, int fq) const {
        const int row0 = u.p0 * 256 + wr * 64 + fr, col0 = u.p1 * 256 + wc * 32 + 8 * fq;
#pragma unroll
        for (int ai = 0; ai < 2; ++ai)
#pragma unroll
            for (int m = 0; m < 4; ++m)
#pragma unroll
                for (int bj = 0; bj < 2; ++bj) { const f32x4 v0 = acc[ai][bj][m][0], v1 = acc[ai][bj][m][1];
                    u32x4 w; w.x = cvt_pk_bf16(v0[0], v0[1]); w.y = cvt_pk_bf16(v0[2], v0[3]); w.z = cvt_pk_bf16(v1[0], v1[1]); w.w = cvt_pk_bf16(v1[2], v1[3]);
                    *(u32x4*)(O + (size_t)(row0 + ai * 128 + m * 16) * ldc + col0 + bj * 128) = w; }
    }
};
struct EpiF8Out {
    static constexpr bool PERM = true, FP8 = false; static constexpr int TID = 6; static constexpr unsigned SCB = 0x7f7f7f7fu;
    unsigned char* O; int ldc;
    __device__ __forceinline__ void operator()(const f32x4 (&acc)[2][2][4][2], const gg::Unit& u, int wr, int wc, int fr, int fq) const {
        const int row0 = u.p0 * 256 + wr * 64 + fr, col0 = u.p1 * 256 + wc * 32 + 8 * fq;
#pragma unroll
        for (int ai = 0; ai < 2; ++ai)
#pragma unroll
            for (int m = 0; m < 4; ++m)
#pragma unroll
                for (int bj = 0; bj < 2; ++bj) { const f32x4 v0 = acc[ai][bj][m][0], v1 = acc[ai][bj][m][1];
                    *(u32x2*)(O + (size_t)(row0 + ai * 128 + m * 16) * ldc + col0 + bj * 128) = (u32x2){pk4_fp8(v0[0], v0[1], v0[2], v0[3]), pk4_fp8(v1[0], v1[1], v1[2], v1[3])}; }
    }
};
struct EpiBf16F8 {
    static constexpr bool PERM = true, FP8 = true; static constexpr int TID = 3; static constexpr unsigned SCB = 0x77777777u;
    bf16_t* O; static constexpr int ldc = 1024;
    __device__ __forceinline__ void operator()(const f32x4 (&acc)[2][2][4][2], const gg::Unit& u, int wr, int wc, int fr, int fq) const {
        bf16_t* p = O + (size_t)(u.p0 * 256 + wr * 64 + fr) * ldc + u.p1 * 256 + wc * 32 + 8 * fq;
#pragma unroll
        for (int ai = 0; ai < 2; ++ai) {
#pragma unroll
            for (int m = 0; m < 4; ++m) {
#pragma unroll
                for (int bj = 0; bj < 2; ++bj) { const f32x4 v0 = acc[ai][bj][m][0], v1 = acc[ai][bj][m][1];
                    u32x4 w; w.x = cvt_pk_bf16(v0[0], v0[1]); w.y = cvt_pk_bf16(v0[2], v0[3]); w.z = cvt_pk_bf16(v1[0], v1[1]); w.w = cvt_pk_bf16(v1[2], v1[3]);
                    *(u32x4*)(p + bj * 128) = w; }
                p += 16 * ldc; asm volatile("" : "+v"(p)); }
            p += 64 * ldc; }
    }
};

__device__ __forceinline__ int crow(int r, int hi) { return (r & 3) + 8 * (r >> 2) + 4 * hi; }
__device__ __forceinline__ f32x16 mma32_ll(f32x16 acc, const LAS bf16_t* A, int lda, const LAS bf16_t* B, int ldb, int ksteps, int lane, int ks0 = 0) {
    const int r32 = lane & 31, hi = lane >> 5;
    for (int ks = ks0; ks < ksteps; ++ks) {
        const bf16x8 a = *(const LAS bf16x8*)(A + r32 * lda + ks * 16 + hi * 8);
        const bf16x8 b = *(const LAS bf16x8*)(B + r32 * ldb + ks * 16 + hi * 8);
        acc = __builtin_amdgcn_mfma_f32_32x32x16_bf16(a, b, acc, 0, 0, 0);
    }
    return acc;
}
template <int KS> __device__ __forceinline__ f32x16 mma32_lg(f32x16 acc, const LAS bf16_t* A, int lda, const bf16_t* B, int ldb, int lane) {
    const int r32 = lane & 31, hi = lane >> 5;
    bf16x8 b[KS];
#pragma unroll
    for (int ks = 0; ks < KS; ++ks) b[ks] = *(const bf16x8*)(B + (size_t)r32 * ldb + ks * 16 + hi * 8);
#pragma unroll
    for (int ks = 0; ks < KS; ++ks) { const bf16x8 a = *(const LAS bf16x8*)(A + r32 * lda + ks * 16 + hi * 8); acc = __builtin_amdgcn_mfma_f32_32x32x16_bf16(a, b[ks], acc, 0, 0, 0); }
    return acc;
}

__device__ __forceinline__ void ph_pre(const Frame& F) {
    LAS float* sv = (LAS float*)F.lds;
    LAS float* part = sv + 9 * 1024;
    float* mod = (float*)(F.ws + WS_MOD);
    for (int i = F.tid; i < 9 * 1024; i += NTHR) { const int r = i >> 10, k = i & 1023; const float c = (r < 8) ? F.in[I_C][r * 1024 + k] : F.in[I_CCTX][k]; sv[i] = c * sigmoidf_(c); }
    __syncthreads();
    for (int it = F.bx; it < 2 * 96; it += F.G) {
        const int l = it / 96, jc = it % 96, j = jc * 64 + F.lane, k0 = F.wave * 128;
        const float* w = F.in[I_WMOD] + ((size_t)l * 1024 + k0) * 6144 + j;
        float a[9];
#pragma unroll
        for (int r = 0; r < 9; ++r) a[r] = 0.f;
#pragma unroll 4
        for (int k = 0; k < 128; ++k) { const float wv = w[(size_t)k * 6144];
#pragma unroll
            for (int r = 0; r < 9; ++r) a[r] += sv[r * 1024 + k0 + k] * wv; }
#pragma unroll
        for (int r = 0; r < 9; ++r) part[(F.wave * 9 + r) * 64 + F.lane] = a[r];
        __syncthreads();
        for (int i = F.tid; i < 9 * 64; i += NTHR) { const int r = i >> 6, jj = i & 63; float s = F.in[I_BMOD][l * 6144 + jc * 64 + jj];
#pragma unroll
            for (int w8 = 0; w8 < 8; ++w8) s += part[(w8 * 9 + r) * 64 + jj];
            mod[((size_t)(l * 9 + r)) * 6144 + jc * 64 + jj] = s; }
        __syncthreads();
    }
    if (F.bx == F.G - 1) {
        float* rt = (float*)(F.ws + T_ROPE);
        for (int i = F.tid; i < 1024; i += NTHR) { const int pos = i >> 3, f = i & 7; const float inv = powf(10000.0f, -(float)f / 8.0f); const float ang = (float)pos * inv; rt[2 * i] = cosf(ang); rt[2 * i + 1] = sinf(ang); }
    }
}

struct ConvCursor { int base; int gw, ngw; };
__device__ __forceinline__ void conv_mat(const Frame& F, ConvCursor& cc, const float* src, int K, int N, bf16_t* dst, int ldd, int rbase, int rstep, int nbatch, size_t sbs, size_t dbs, int rq = 128, bool gperm = false, float f8scale = 0.f) {
    const int ktl = K / 64, ntl = (N + 127) / 128, per = ktl * ntl, total = per * nbatch;
    int t = cc.base + ((cc.gw - cc.base) % cc.ngw + cc.ngw) % cc.ngw;
    for (; t < cc.base + total; t += cc.ngw) {
        const int li = t - cc.base, bt = li / per, rem = li % per, kb = rem / ntl, nb = rem % ntl, k0 = kb * 64, n = nb * 128 + 2 * F.lane;
        if (n < N) {
            const float* s = src + bt * sbs + (size_t)k0 * N + n; bf16_t* d = dst + bt * dbs;
            f32x2 v[64];
#pragma unroll
            for (int i = 0; i < 64; ++i) v[i] = *(const f32x2*)(s + (size_t)i * N);
#pragma unroll
            for (int q = 0; q < 2; ++q) { const int nn = n + q; const int drow = gperm ? ((nn >> 6) * 256 + ((nn >> 4) & 3) * 32 + (nn & 15) + 128 * (bt >> 1) + 16 * (bt & 1)) : (rbase + (nn / rq) * rstep + (nn % rq));
                if (f8scale != 0.f) { unsigned char* d8 = (unsigned char*)dst + bt * dbs + (size_t)drow * ldd + k0;
#pragma unroll
                    for (int p = 0; p < 4; ++p) { u32x4 o; o.x = pk4_fp8(v[16 * p][q] * f8scale, v[16 * p + 1][q] * f8scale, v[16 * p + 2][q] * f8scale, v[16 * p + 3][q] * f8scale);
                        o.y = pk4_fp8(v[16 * p + 4][q] * f8scale, v[16 * p + 5][q] * f8scale, v[16 * p + 6][q] * f8scale, v[16 * p + 7][q] * f8scale);
                        o.z = pk4_fp8(v[16 * p + 8][q] * f8scale, v[16 * p + 9][q] * f8scale, v[16 * p + 10][q] * f8scale, v[16 * p + 11][q] * f8scale);
                        o.w = pk4_fp8(v[16 * p + 12][q] * f8scale, v[16 * p + 13][q] * f8scale, v[16 * p + 14][q] * f8scale, v[16 * p + 15][q] * f8scale);
                        *(u32x4*)(d8 + 16 * p) = o; }
                    continue; }
                bf16_t* dr = d + (size_t)drow * ldd + k0;
#pragma unroll
                for (int p = 0; p < 8; ++p) { u32x4 o; o.x = pk2(v[8 * p][q], v[8 * p + 1][q]); o.y = pk2(v[8 * p + 2][q], v[8 * p + 3][q]); o.z = pk2(v[8 * p + 4][q], v[8 * p + 5][q]); o.w = pk2(v[8 * p + 6][q], v[8 * p + 7][q]);
                    *(u32x4*)(dr + 8 * p) = o; } }
        }
    }
    cc.base += total;
}
__device__ __forceinline__ void ph_convert(const Frame& F, int l) {
    ConvCursor cc; cc.base = 0; cc.gw = F.bx * NWAVES + F.wave; cc.ngw = F.G * NWAVES;
    unsigned char* ws = F.ws;
    conv_mat(F, cc, F.in[I_WIN] + (size_t)l * 1024 * INC, 1024, INC, (bf16_t*)(ws + W_IN), 1024, 0, 128, 1, 0, 0);
    conv_mat(F, cc, F.in[I_WGATE] + (size_t)l * 4 * 1024 * 1024, 1024, 1024, (bf16_t*)(ws + W_GATE), 1024, 0, 128, 4, (size_t)1024 * 1024, 0, 128, true, 64.0f);
    conv_mat(F, cc, F.in[I_WBR] + (size_t)l * 4 * 256 * 1024, 256, 1024, (bf16_t*)(ws + W_BR), 256, 0, 128, 4, (size_t)256 * 1024, (size_t)1024 * 256);
    conv_mat(F, cc, F.in[I_WOUT] + (size_t)l * 1024 * 1024, 1024, 1024, (bf16_t*)(ws + W_OUT), 1024, 0, 128, 1, 0, 0, 128, false, 64.0f);
    conv_mat(F, cc, F.in[I_W1] + (size_t)l * 64 * 1024 * 256, 1024, 256, (bf16_t*)(ws + W_13), 1024, 0, 256, 64, (size_t)1024 * 256, (size_t)512 * 1024, 128, false, 64.0f);
    conv_mat(F, cc, F.in[I_W3] + (size_t)l * 64 * 1024 * 256, 1024, 256, (bf16_t*)(ws + W_13), 1024, 128, 256, 64, (size_t)1024 * 256, (size_t)512 * 1024, 128, false, 64.0f);
    conv_mat(F, cc, F.in[I_W2] + (size_t)l * 64 * 256 * 1024, 256, 1024, (bf16_t*)(ws + W_2), 256, 0, 128, 64, (size_t)256 * 1024, (size_t)1024 * 256);
    conv_mat(F, cc, F.in[I_WS1] + (size_t)l * 1024 * 256, 1024, 256, (bf16_t*)(ws + W_13 + (size_t)64 * 512 * 1024), 1024, 0, 256, 1, 0, 0, 128, false, 64.0f);
    conv_mat(F, cc, F.in[I_WS3] + (size_t)l * 1024 * 256, 1024, 256, (bf16_t*)(ws + W_13 + (size_t)64 * 512 * 1024), 1024, 128, 256, 1, 0, 0, 128, false, 64.0f);
    conv_mat(F, cc, F.in[I_WS2] + (size_t)l * 256 * 1024, 256, 1024, (bf16_t*)(ws + W_2) + (size_t)64 * 1024 * 256, 256, 0, 128, 1, 0, 0);
    conv_mat(F, cc, F.in[I_WUQ] + (size_t)l * 256 * 384, 256, 384, (bf16_t*)(ws + W_UQ), 256, 0, 128, 1, 0, 0);
    conv_mat(F, cc, F.in[I_WUKV] + (size_t)l * 128 * 512, 128, 512, (bf16_t*)(ws + W_UKV), 128, 0, 128, 1, 0, 0);
    conv_mat(F, cc, F.in[I_POOLW] + (size_t)l * 4 * 64 * 64, 64, 64, (bf16_t*)(ws + W_POOL), 64, 0, 128, 4, (size_t)64 * 64, (size_t)64 * 64);
    conv_mat(F, cc, F.in[I_WRT] + (size_t)l * 1024 * 64, 1024, 64, (bf16_t*)(ws + W_RT), 1024, 0, 128, 1, 0, 0);
    { u32x4* z = (u32x4*)((bf16_t*)(ws + W_IN) + (size_t)INC * 1024); const int n16 = (INCP - INC) * 1024 * 2 / 16;
      unsigned z0 = 0u; asm volatile("" : "+v"(z0));
      for (int i = F.bx * NTHR + F.tid; i < n16; i += F.G * NTHR) z[i] = (u32x4){z0, z0, z0, z0}; }
}

__device__ __forceinline__ void normmod_vals(int lane, const f32x4 (&v)[4], const float* g, const float* sc, const float* sh, f32x4 (&y)[4]) {
    float s = 0.f;
#pragma unroll
    for (int j = 0; j < 4; ++j) s += (v[j].x * v[j].x + v[j].y * v[j].y) + (v[j].z * v[j].z + v[j].w * v[j].w);
    const float rstd = frsq(wave_sum(s) * (1.f / 1024.f) + EPS);
#pragma unroll
    for (int j = 0; j < 4; ++j) { const f32x4 gv = ((const f32x4*)g)[lane + 64 * j], scv = ((const f32x4*)sc)[lane + 64 * j], shv = ((const f32x4*)sh)[lane + 64 * j];
        y[j] = v[j] * rstd * gv * (scv + 1.0f) + shv; }
}
__device__ __forceinline__ void normmod_row(int lane, const float* xrow, const float* g, const float* sc, const float* sh, f32x4 (&y)[4]) {
    const f32x4* xr = (const f32x4*)xrow + lane; f32x4 v[4]; float s = 0.f;
#pragma unroll
    for (int j = 0; j < 4; ++j) { v[j] = xr[64 * j]; s += (v[j].x * v[j].x + v[j].y * v[j].y) + (v[j].z * v[j].z + v[j].w * v[j].w); }
    const float rstd = frsq(wave_sum(s) * (1.f / 1024.f) + EPS);
#pragma unroll
    for (int j = 0; j < 4; ++j) { const f32x4 gv = ((const f32x4*)g)[lane + 64 * j], scv = ((const f32x4*)sc)[lane + 64 * j], shv = ((const f32x4*)sh)[lane + 64 * j];
        y[j] = v[j] * rstd * gv * (scv + 1.0f) + shv; }
}
__device__ __forceinline__ const float* stream_row(const Frame& F, int l, int row) {
    if (row < NLAT) return (l == 0 ? F.in[I_X] : F.out) + (size_t)row * 1024;
    return (l == 0 ? F.in[I_CTX] : (const float*)(F.ws + WS_CTXS)) + (size_t)(row - NLAT) * 1024;
}
__device__ __forceinline__ void ph_norm1(const Frame& F, int l) {
    const int gw = F.bx * NWAVES + F.wave, ngw = F.G * NWAVES;
    bf16_t* hx = (bf16_t*)(F.ws + WS_HX);
    for (int row0 = gw; row0 < NTOK; row0 += 2 * ngw) {
        const int row1 = row0 + ngw; const bool has1 = row1 < NTOK;
        f32x4 v0[4], v1[4];
        { const f32x4* x0 = (const f32x4*)stream_row(F, l, row0) + F.lane; const f32x4* x1 = (const f32x4*)stream_row(F, l, has1 ? row1 : row0) + F.lane;
#pragma unroll
          for (int j = 0; j < 4; ++j) { v0[j] = x0[64 * j]; v1[j] = x1[64 * j]; } }
#pragma unroll
        for (int k = 0; k < 2; ++k) { if (k == 1 && !has1) break; const int row = k ? row1 : row0; const int mr = mod_row_of(row); f32x4 y[4];
            normmod_vals(F.lane, k ? v1 : v0, F.in[I_GMIX] + l * 1024, modp(F, l, mr, 1), modp(F, l, mr, 0), y);
            u32x2* o = (u32x2*)(hx + (size_t)row * 1024) + F.lane; unsigned* o8 = (unsigned*)(F.ws + WS_HX8 + (size_t)row * 1024) + F.lane;
#pragma unroll
            for (int j = 0; j < 4; ++j) { o[64 * j] = (u32x2){pk2(y[j].x, y[j].y), pk2(y[j].z, y[j].w)}; o8[64 * j] = pk4_fp8(y[j].x, y[j].y, y[j].z, y[j].w); } }
    }
}

constexpr float QSCALE = 0.10206207261596577f * 1.4426950408889634f;
template <int KS> __device__ __forceinline__ void ld_bfrag(bf16x8* b, const bf16_t* B, int ldb, int lane) {
#pragma unroll
    for (int ks = 0; ks < KS; ++ks) b[ks] = *(const bf16x8*)(B + (size_t)(lane & 31) * ldb + ks * 16 + (lane >> 5) * 8);
}
template <int KS> __device__ __forceinline__ f32x16 mma32_lr(const LAS bf16_t* A, int lda, const bf16x8* b, int lane) {
    f32x16 acc = {};
#pragma unroll
    for (int ks = 0; ks < KS; ++ks) { const bf16x8 a = *(const LAS bf16x8*)(A + (lane & 31) * lda + ks * 16 + (lane >> 5) * 8); acc = __builtin_amdgcn_mfma_f32_32x32x16_bf16(a, b[ks], acc, 0, 0, 0); }
    return acc;
}
__device__ __forceinline__ f32x2 mla_rope_ld(const Frame& F, int unit) {
    const int row0 = unit * 32; const bool isctx = row0 >= NLAT; const int pos0 = isctx ? (row0 - NLAT) & 255 : row0 & 8191;
    const int pos = pos0 + (F.tid >> 4), pp = (F.tid & 8) ? (pos & 63) : (pos >> 6);
    return *(const f32x2*)((const float*)(F.ws + T_ROPE) + (pp * 8 + (F.tid & 7)) * 2);
}
struct MlaKvRegs { unsigned xk[4]; unsigned xr[4]; f32x2 rp; };
__device__ __forceinline__ MlaKvRegs mla_kv_load(const Frame& F, int unit) {
    MlaKvRegs R; const bf16_t* px = (const bf16_t*)(F.ws + WS_PX);
#pragma unroll
    for (int rr = 0; rr < 4; ++rr) { const bf16_t* p = px + (size_t)(unit * 32 + F.wave * 4 + rr) * INC + C_MLA;
        R.xk[rr] = *(const unsigned*)(p + 256 + 2 * F.lane); R.xr[rr] = *(const unsigned*)(p + 384 + 2 * (F.lane & 15)); }
    R.rp = mla_rope_ld(F, unit);
    return R;
}
__device__ __forceinline__ void mla_kv_unit(const Frame& F, int unit, const MlaKvRegs& R, const bf16x8* wkv, f32x2 gckv2, float g0, float g1, float g2) {
    LAS unsigned char* lds = F.lds;
    LAS bf16_t* AKV = (LAS bf16_t*)lds;
    LAS float* KR = (LAS float*)(lds + 8704);
    LAS f32x2* RP = (LAS f32x2*)(lds + 12800);
    LAS float* OUT = (LAS float*)(lds + 16896);
    LAS bf16_t* KB = (LAS bf16_t*)(lds + 83456);
    int tid_ = F.tid; asm volatile("" : "+v"(tid_));
    const int row0 = unit * 32, tid = tid_, lane = tid & 63, wave = F.wave, r32 = lane & 31, hi = lane >> 5;
    const bool isctx = row0 >= NLAT;
    const int b = isctx ? (row0 - NLAT) >> 8 : row0 >> 13, pos0 = isctx ? (row0 - NLAT) & 255 : row0 & 8191;
    LDS_BAR();
    RP[tid] = R.rp;
#pragma unroll
    for (int rr = 0; rr < 4; ++rr) { const int r = wave * 4 + rr; const unsigned w = R.xk[rr]; const float x0 = bflo(w), x1 = bfhi(w);
        const float sc = frsq(wave_sum(x0 * x0 + x1 * x1) * (1.f / 128.f) + EPS);
        *(LAS unsigned*)(AKV + r * 136 + 2 * lane) = pk2(x0 * sc * gckv2.x, x1 * sc * gckv2.y);
        if (lane < 16) *(LAS f32x2*)(KR + r * 32 + 2 * lane) = (f32x2){bflo(R.xr[rr]), bfhi(R.xr[rr])}; }
    LDS_BAR();
#pragma unroll
    for (int i = 0; i < 2; ++i) { const int nt = wave * 2 + i; const f32x16 acc = mma32_lr<8>(AKV, 136, wkv + 8 * i, lane);
#pragma unroll
        for (int r = 0; r < 16; ++r) OUT[crow(r, hi) * 520 + nt * 32 + r32] = acc[r]; }
    LDS_BAR();
#pragma unroll
    for (int it = 0; it < 8; ++it) { const int pr = wave * 16 + it * 2 + hi, r = pr >> 2, h = pr & 3; const LAS float* o = OUT + r * 520 + h * 128;
        float v0 = o[r32], v1 = o[32 + r32], v2 = KR[r * 32 + r32]; const float ss = half_sum(v0 * v0 + v1 * v1 + v2 * v2);
        const float sc = frsq(ss * (1.f / 96.f) + EPS);
        v0 *= sc * g0; v1 *= sc * g1; v2 *= sc * g2;
        const float pv = xor_lane<8>(v2);
        if (!isctx) { const f32x2 cssn = RP[(r * 2 + (r32 >> 4)) * 8 + (r32 & 7)]; v2 = (r32 & 8) ? (v2 * cssn.x + pv * cssn.y) : (v2 * cssn.x - pv * cssn.y); }
        LAS bf16_t* kb = KB + r * 392 + h * 96;
        kb[r32] = (bf16_t)f2bf(v0); kb[32 + r32] = (bf16_t)f2bf(v1); kb[64 + r32] = (bf16_t)f2bf(v2); }
    LDS_BAR();
    const int key0 = isctx ? pos0 : 256 + pos0, tile = key0 >> 6, kin = key0 & 63;
    for (int i = tid; i < 1536; i += NTHR) { const int r = i & 31, c = (i >> 5) % 12, h = i / 384;
        const u32x4 v = *(const LAS u32x4*)(KB + r * 392 + h * 96 + c * 8);
        *(u32x4*)((bf16_t*)(F.ws + WS_KT) + ((size_t)((b * 4 + h) * NKT + tile) * 12 + c) * 512 + (kin + r) * 8) = v; }
    for (int i = tid; i < 1024; i += NTHR) { const int p = i & 3, r = (i >> 2) & 31, dh = (i >> 7) & 1, h = i >> 8; const LAS float* o = OUT + r * 520 + h * 128 + 64 + dh * 32 + p * 8;
        u32x4 v; v.x = pk2(o[0], o[1]); v.y = pk2(o[2], o[3]); v.z = pk2(o[4], o[5]); v.w = pk2(o[6], o[7]);
        *(u32x4*)((bf16_t*)(F.ws + WS_VT) + ((size_t)((b * 4 + h) * NKT + tile) * 2 + dh) * 2048 + (kin + r) * 32 + p * 8) = v; }
}
struct MlaQRegs { u32x2 xq[4]; f32x2 rp; };
__device__ __forceinline__ MlaQRegs mla_q_load(const Frame& F, int unit) {
    MlaQRegs R; const bf16_t* px = (const bf16_t*)(F.ws + WS_PX);
#pragma unroll
    for (int rr = 0; rr < 4; ++rr) R.xq[rr] = *(const u32x2*)(px + (size_t)(unit * 32 + F.wave * 4 + rr) * INC + C_MLA + 4 * F.lane);
    R.rp = mla_rope_ld(F, unit);
    return R;
}
__device__ __forceinline__ void mla_q_unit(const Frame& F, int unit, const MlaQRegs& R, const bf16x8* wqf, f32x4 gcq4, float g0, float g1, float g2) {
    LAS unsigned char* lds = F.lds;
    LAS bf16_t* AQ = (LAS bf16_t*)lds;
    LAS f32x2* RP = (LAS f32x2*)(lds + 16896);
    LAS float* OQ = (LAS float*)(lds + 20992);
    int tid_ = F.tid; asm volatile("" : "+v"(tid_));
    const int row0 = unit * 32, tid = tid_, lane = tid & 63, wave = F.wave, r32 = lane & 31, hi = lane >> 5;
    const bool isctx = row0 >= NLAT;
    LDS_BAR();
    RP[tid] = R.rp;
#pragma unroll
    for (int rr = 0; rr < 4; ++rr) { const int r = wave * 4 + rr; const u32x2 w = R.xq[rr]; const float x0 = bflo(w.x), x1 = bfhi(w.x), x2 = bflo(w.y), x3 = bfhi(w.y);
        const float sc = frsq(wave_sum(x0 * x0 + x1 * x1 + x2 * x2 + x3 * x3) * (1.f / 256.f) + EPS);
        *(LAS u32x2*)(AQ + r * 264 + 4 * lane) = (u32x2){pk2(x0 * sc * gcq4.x, x1 * sc * gcq4.y), pk2(x2 * sc * gcq4.z, x3 * sc * gcq4.w)}; }
    LDS_BAR();
    { const f32x16 acc = mma32_lr<16>(AQ, 264, wqf, lane);
#pragma unroll
      for (int r = 0; r < 16; ++r) OQ[crow(r, hi) * 392 + wave * 32 + r32] = acc[r]; }
    if (wave < 4) { const f32x16 acc = mma32_lr<16>(AQ, 264, wqf + 16, lane);
#pragma unroll
      for (int r = 0; r < 16; ++r) OQ[crow(r, hi) * 392 + (8 + wave) * 32 + r32] = acc[r]; }
    LDS_BAR();
    bf16_t* qb = (bf16_t*)(F.ws + WS_QB);
#pragma unroll
    for (int it = 0; it < 8; ++it) { const int pr = wave * 16 + it * 2 + hi, r = pr >> 2, h = pr & 3; const LAS float* o = OQ + r * 392 + h * 96;
        float v0 = o[r32], v1 = o[32 + r32], v2 = o[64 + r32]; const float ss = half_sum(v0 * v0 + v1 * v1 + v2 * v2);
        const float sc = frsq(ss * (1.f / 96.f) + EPS);
        v0 *= sc * g0; v1 *= sc * g1; v2 *= sc * g2;
        const float pv = xor_lane<8>(v2);
        if (!isctx) { const f32x2 cssn = RP[(r * 2 + (r32 >> 4)) * 8 + (r32 & 7)]; v2 = (r32 & 8) ? (v2 * cssn.x + pv * cssn.y) : (v2 * cssn.x - pv * cssn.y); }
        bf16_t* q = qb + (size_t)(row0 + r) * 384 + h * 96;
        q[r32] = (bf16_t)f2bf(v0 * QSCALE); q[32 + r32] = (bf16_t)f2bf(v1 * QSCALE); q[64 + r32] = (bf16_t)f2bf(v2 * QSCALE); }
}
__device__ __forceinline__ void mla_prep(const Frame& F, int l) {
    const int lane = F.lane, wave = F.wave, r32 = lane & 31;
    { bf16x8 wkv[16]; const bf16_t* wukv = (const bf16_t*)(F.ws + W_UKV);
      ld_bfrag<8>(wkv, wukv + (size_t)(wave * 2) * 32 * 128, 128, lane); ld_bfrag<8>(wkv + 8, wukv + (size_t)(wave * 2 + 1) * 32 * 128, 128, lane);
      const f32x2 gckv2 = *(const f32x2*)(F.in[I_GCKV] + l * 128 + 2 * lane); const float* gkn = F.in[I_GKN] + l * 96; const float g0 = gkn[r32], g1 = gkn[32 + r32], g2 = gkn[64 + r32];
      const int nu = NTOK / 32;
      if (F.bx < nu) { MlaKvRegs R = mla_kv_load(F, F.bx);
          for (int u = F.bx; u < nu; u += F.G) { const MlaKvRegs Rn = mla_kv_load(F, (u + F.G < nu) ? u + F.G : u); mla_kv_unit(F, u, R, wkv, gckv2, g0, g1, g2); R = Rn; } } }
    { bf16x8 wqf[32]; const bf16_t* wuq = (const bf16_t*)(F.ws + W_UQ);
      ld_bfrag<16>(wqf, wuq + (size_t)wave * 32 * 256, 256, lane); if (wave < 4) ld_bfrag<16>(wqf + 16, wuq + (size_t)(8 + wave) * 32 * 256, 256, lane);
      const f32x4 gcq4 = *(const f32x4*)(F.in[I_GCQ] + l * 256 + 4 * lane); const float* gqn = F.in[I_GQN] + l * 96; const float g0 = gqn[r32], g1 = gqn[32 + r32], g2 = gqn[64 + r32];
      const int nu = (l == 0 ? NTOK : NLAT) / 32;
      if (F.bx < nu) { MlaQRegs R = mla_q_load(F, F.bx);
          for (int u = F.bx; u < nu; u += F.G) { const MlaQRegs Rn = mla_q_load(F, (u + F.G < nu) ? u + F.G : u); mla_q_unit(F, u, R, wqf, gcq4, g0, g1, g2); R = Rn; } } }
}

__device__ __forceinline__ void ml_chunk_pos(int dir, int j, bool& isctx, int& p0) {
    if (j < 2) { isctx = true; p0 = (dir == 0 ? j : 1 - j) * 128; } else { isctx = false; p0 = (dir == 0 ? (j - 2) : (63 - (j - 2))) * 128; }
}
__device__ __forceinline__ int ml_row(int b, bool isctx, int pos) { return isctx ? NLAT + b * 256 + pos : b * 8192 + pos; }
__device__ __forceinline__ float log_sigmoidf_(float x) { return fminf(x, 0.f) - log1pf(__expf(-fabsf(x))); }

struct P1Regs { u32x4 kv[4]; float gi, gf; };
__device__ __forceinline__ P1Regs ml_pass1_load(const Frame& F, int unit) {
    P1Regs R; const int j = unit % NCHK, dir = (unit / NCHK) & 1, h = (unit / (NCHK * 2)) & 3, b = unit / (NCHK * 8);
    bool isctx; int p0; ml_chunk_pos(dir, j, isctx, p0);
    const bf16_t* px = (const bf16_t*)(F.ws + WS_PX); const float* gate = (const float*)(F.ws + T_GATE); const int tid = F.tid;
#pragma unroll
    for (int q = 0; q < 4; ++q) { const int it = tid + q * NTHR, i = it & 127, c = (it >> 7) & 7, isv = it >> 10; const int pos = dir ? p0 + 127 - i : p0 + i;
        R.kv[q] = *(const u32x4*)(px + (size_t)ml_row(b, isctx, pos) * INC + (isv ? 512 : 256) + h * 64 + c * 8); }
    { const int i = tid & 127; const int pos = dir ? p0 + 127 - i : p0 + i; const float* g = gate + (size_t)ml_row(b, isctx, pos) * 16; R.gi = g[dir * 8 + h]; R.gf = g[dir * 8 + 4 + h]; }
    return R;
}
__device__ __forceinline__ void ml_pass1_unit(const Frame& F, int l, int unit, const P1Regs& R) {
    LAS float* LI = (LAS float*)F.lds; LAS float* LF = LI + 128; LAS float* WV = LI + 256;
    LAS bf16_t* KT = (LAS bf16_t*)(F.lds + 2048); LAS bf16_t* VT = KT + 64 * 136;
    const int dir = (unit / NCHK) & 1, h = (unit / (NCHK * 2)) & 3;
    const int tid = F.tid, lane = F.lane, wave = F.wave;
    const float* gb = F.in[I_MLGB] + l * 16;
    LDS_BAR();
    if (tid < 128) { LI[tid] = R.gi + gb[dir * 8 + h]; LF[tid] = log_sigmoidf_(R.gf + gb[dir * 8 + 4 + h]); }
    LDS_BAR();
    if (wave == 0) {
        const float a0 = LF[2 * lane], a1 = LF[2 * lane + 1]; float s = a0 + a1;
#pragma unroll
        for (int o = 1; o < 64; o <<= 1) { const float t = lane_up(s, o, lane); if (lane >= o) s += t; }
        const float bend = lane_bcast(s, 63);
        const float w0 = bend - (s - a1) + LI[2 * lane], w1 = bend - s + LI[2 * lane + 1];
        const float mloc = wave_max(fmaxf(w0, w1));
        WV[2 * lane] = __expf(w0 - mloc); WV[2 * lane + 1] = __expf(w1 - mloc);
        if (lane == 0) { ((float*)(F.ws + T_MLOC))[unit] = mloc; ((float*)(F.ws + T_BEND))[unit] = bend; }
    }
    LDS_BAR();
#pragma unroll
    for (int q = 0; q < 4; ++q) { const int it = tid + q * NTHR, i = it & 127, c = (it >> 7) & 7, isv = it >> 10; const u32x4 v = R.kv[q];
        const float sc = isv ? 1.0f : 0.125f * WV[i]; LAS bf16_t* d = (isv ? VT : KT) + (c * 8) * 136 + i;
        d[0] = (bf16_t)f2bf(bflo(v.x) * sc); d[136] = (bf16_t)f2bf(bfhi(v.x) * sc); d[272] = (bf16_t)f2bf(bflo(v.y) * sc); d[408] = (bf16_t)f2bf(bfhi(v.y) * sc);
        d[544] = (bf16_t)f2bf(bflo(v.z) * sc); d[680] = (bf16_t)f2bf(bfhi(v.z) * sc); d[816] = (bf16_t)f2bf(bflo(v.w) * sc); d[952] = (bf16_t)f2bf(bfhi(v.w) * sc); }
    LDS_BAR();
    if (wave < 4) { const int et = wave >> 1, dt = wave & 1; f32x16 acc = {}; acc = mma32_ll(acc, VT + et * 32 * 136, 136, KT + dt * 32 * 136, 136, 8, lane);
        float* dc = (float*)(F.ws + WS_DC) + (size_t)unit * 4096; const int r32 = lane & 31, hi = lane >> 5;
#pragma unroll
        for (int r = 0; r < 16; ++r) dc[(et * 32 + crow(r, hi)) * 64 + dt * 32 + r32] = acc[r];
    } else if (wave == 4) { float s = 0.f; for (int i = 0; i < 128; ++i) s += bf2f(KT[lane * 136 + i]); ((float*)(F.ws + T_DN))[(size_t)unit * 64 + lane] = s; }
}

__device__ __forceinline__ void ml_pass2(const Frame& F) {
    const float* dc = (const float*)(F.ws + WS_DC); const float* dn = (const float*)(F.ws + T_DN);
    const float* mloc = (const float*)(F.ws + T_MLOC); const float* bend = (const float*)(F.ws + T_BEND);
    bf16_t* cst = (bf16_t*)(F.ws + WS_CST); float* nst = (float*)(F.ws + T_NST); float* mst = (float*)(F.ws + T_MST);
    LAS float* ML = (LAS float*)F.lds; LAS float* BE = ML + 128;
    for (int it = F.bx; it < 64 * 8; it += F.G) { const int bhd = it >> 3, part = it & 7, u0 = bhd * NCHK, el = part * 512 + F.tid;
        const bool don = (part == 0 && F.tid < 64);
        float d[NCHK], dnv[NCHK];
#pragma unroll
        for (int j = 0; j < NCHK; ++j) d[j] = dc[(size_t)(u0 + j) * 4096 + el];
#pragma unroll
        for (int j = 0; j < NCHK; ++j) dnv[j] = don ? dn[(size_t)(u0 + j) * 64 + F.tid] : 0.f;
        __syncthreads();
        if (F.tid < NCHK) { ML[F.tid] = mloc[u0 + F.tid]; BE[F.tid] = bend[u0 + F.tid]; }
        __syncthreads();
        float C = 0.f, n = 0.f, m = 0.f;
#pragma unroll
        for (int j = 0; j < NCHK; ++j) { const int u = u0 + j; const float ml = ML[j], be = BE[j];
            cst[(size_t)u * 4096 + el] = (bf16_t)f2bf(C); if (don) nst[(size_t)u * 64 + F.tid] = n; if (part == 0 && F.tid == 0) mst[u] = m;
            const float mn = fmaxf(be + m, ml), dcy = __expf(be + m - mn), sc = __expf(ml - mn);
            C = dcy * C + sc * d[j]; n = dcy * n + sc * dnv[j]; m = mn; }
    }
    __syncthreads();
}

__device__ __forceinline__ void ml_pass3_unit(const Frame& F, int l, int b, int h, int pc) {
    LAS unsigned char* lds = F.lds;
    LAS bf16_t* Qs = (LAS bf16_t*)lds;
    LAS bf16_t* Ks = (LAS bf16_t*)(lds + 18432);
    LAS bf16_t* VTs = (LAS bf16_t*)(lds + 36864);
    LAS bf16_t* CTs = (LAS bf16_t*)(lds + 62976);
    LAS bf16_t* Wm = (LAS bf16_t*)(lds + 76800);
    LAS float* HS = (LAS float*)(lds + 111616);
    LAS float* VEC = (LAS float*)(lds + 144384);
    LAS float* DEN = VEC + 12 * 128;
    const int tid = F.tid, lane = F.lane, wave = F.wave, r32 = lane & 31, hi = lane >> 5;
    const bool isctx = pc < 2; const int p0 = isctx ? pc * 128 : (pc - 2) * 128;
    const float* gate = (const float*)(F.ws + T_GATE); const float* gb = F.in[I_MLGB] + l * 16;
    const bf16_t* px = (const bf16_t*)(F.ws + WS_PX);
    int unit_d[2];
#pragma unroll
    for (int dir = 0; dir < 2; ++dir) { const int j = isctx ? (dir == 0 ? pc : 1 - pc) : (dir == 0 ? pc : 2 + 63 - (pc - 2)); unit_d[dir] = ((b * 4 + h) * 2 + dir) * NCHK + j; }
    LDS_BAR();
    const u32x4 cst0 = *(const u32x4*)((const bf16_t*)(F.ws + WS_CST) + (size_t)unit_d[0] * 4096 + tid * 8), cst1 = *(const u32x4*)((const bf16_t*)(F.ws + WS_CST) + (size_t)unit_d[1] * 4096 + tid * 8);
    const float nv0 = (tid < 64) ? ((const float*)(F.ws + T_NST))[(size_t)unit_d[0] * 64 + tid] : 0.f, nv1 = (tid < 64) ? ((const float*)(F.ws + T_NST))[(size_t)unit_d[1] * 64 + tid] : 0.f;
    const float mst0 = ((const float*)(F.ws + T_MST))[unit_d[0]], mst1 = ((const float*)(F.ws + T_MST))[unit_d[1]];
    if (tid < 256) { const int dir = tid >> 7, i = tid & 127; const int pos = dir ? p0 + 127 - i : p0 + i; const float* g = gate + (size_t)ml_row(b, isctx, pos) * 16;
        VEC[(dir * 6 + 0) * 128 + i] = g[dir * 8 + h] + gb[dir * 8 + h]; VEC[(dir * 6 + 1) * 128 + i] = log_sigmoidf_(g[dir * 8 + 4 + h] + gb[dir * 8 + 4 + h]); }
    for (int it = tid; it < 3072; it += NTHR) { const int i = it & 127, c = (it >> 7) & 7, which = it >> 10;
        const u32x4 v = *(const u32x4*)(px + (size_t)ml_row(b, isctx, p0 + i) * INC + which * 256 + h * 64 + c * 8);
        if (which == 0) *(LAS u32x4*)(Qs + i * 72 + c * 8) = v;
        else if (which == 1) { u32x4 w; w.x = pk2(bflo(v.x) * 0.125f, bfhi(v.x) * 0.125f); w.y = pk2(bflo(v.y) * 0.125f, bfhi(v.y) * 0.125f); w.z = pk2(bflo(v.z) * 0.125f, bfhi(v.z) * 0.125f); w.w = pk2(bflo(v.w) * 0.125f, bfhi(v.w) * 0.125f);
            *(LAS u32x4*)(Ks + i * 72 + c * 8) = w; }
        else { LAS bf16_t* d = VTs + (c * 8) * 136 + i; d[0] = (bf16_t)(v.x & 0xffff); d[136] = (bf16_t)(v.x >> 16); d[272] = (bf16_t)(v.y & 0xffff); d[408] = (bf16_t)(v.y >> 16);
            d[544] = (bf16_t)(v.z & 0xffff); d[680] = (bf16_t)(v.z >> 16); d[816] = (bf16_t)(v.w & 0xffff); d[952] = (bf16_t)(v.w >> 16); } }
    for (int it = tid; it < 32 * 136; it += NTHR) VTs[64 * 136 + it] = (it < 128) ? (bf16_t)0x3f80 : (bf16_t)0;
    LDS_BAR();
    if (wave < 2) { const int dir = wave; LAS float* V0 = VEC + dir * 6 * 128; const float mst = dir ? mst1 : mst0;
        const float a0 = V0[128 + 2 * lane], a1 = V0[128 + 2 * lane + 1]; float s = a0 + a1;
#pragma unroll
        for (int o = 1; o < 64; o <<= 1) { const float t = lane_up(s, o, lane); if (lane >= o) s += t; }
        const float b0 = s - a1, b1 = s, c0 = V0[2 * lane] - b0, c1 = V0[2 * lane + 1] - b1;
        float pm = fmaxf(c0, c1);
#pragma unroll
        for (int o = 1; o < 64; o <<= 1) { const float t = lane_up(pm, o, lane); if (lane >= o) pm = fmaxf(pm, t); }
        float pprev = lane_up(pm, 1, lane); if (lane == 0) pprev = -INFINITY;
        const float M0 = fmaxf(mst, fmaxf(pprev, c0)), M1 = fmaxf(mst, pm);
        V0[256 + 2 * lane] = c0; V0[256 + 2 * lane + 1] = c1; V0[384 + 2 * lane] = M0; V0[384 + 2 * lane + 1] = M1;
        V0[512 + 2 * lane] = __expf(mst - M0); V0[512 + 2 * lane + 1] = __expf(mst - M1); V0[640 + 2 * lane] = __expf(-b0 - M0); V0[640 + 2 * lane + 1] = __expf(-b1 - M1);
    }
    const u32x4 og0 = *(const u32x4*)(px + (size_t)ml_row(b, isctx, p0 + (tid >> 3)) * INC + 768 + h * 64 + (tid & 7) * 8), og1 = *(const u32x4*)(px + (size_t)ml_row(b, isctx, p0 + 64 + (tid >> 3)) * INC + 768 + h * 64 + (tid & 7) * 8);
    for (int dir = 0; dir < 2; ++dir) {
        const LAS float* COLV = VEC + (dir * 6 + 2) * 128; const LAS float* MV = COLV + 128; const LAS float* AIN = COLV + 256; const LAS float* EINV = COLV + 384;
        const int rs = dir ? -72 : 72, rb = dir ? 127 : 0;
        LDS_BAR();
        *(LAS u32x4*)(CTs + (tid >> 3) * 72 + (tid & 7) * 8) = dir ? cst1 : cst0;
        if (tid < 72) CTs[64 * 72 + tid] = (tid < 64) ? (bf16_t)f2bf(dir ? nv1 : nv0) : (bf16_t)0;
        for (int q = wave; q < 16; q += 8) { const int ti = q >> 2, si = q & 3; const int sidx = si * 32 + r32, spos = dir ? 127 - sidx : sidx;
            if (si > ti) {
#pragma unroll
                for (int r = 0; r < 16; ++r) Wm[(ti * 32 + crow(r, hi)) * 136 + spos] = 0;
            } else { f32x16 acc = {}; acc = mma32_ll(acc, Qs + (rb + (dir ? -ti * 32 : ti * 32)) * 72, rs, Ks + (rb + (dir ? -si * 32 : si * 32)) * 72, rs, 4, lane); const float cv = COLV[sidx];
#pragma unroll
                for (int r = 0; r < 16; ++r) { const int t = ti * 32 + crow(r, hi); const float w = (sidx <= t) ? acc[r] * __expf(cv - MV[t]) : 0.f; Wm[t * 136 + spos] = (bf16_t)f2bf(w); } }
        }
        LDS_BAR();
        f32x16 tot[2];
#pragma unroll
        for (int k = 0; k < 2; ++k) { const int q = wave + 8 * k; if (q < 12) { const int ti = q / 3, nt = q % 3;
            f32x16 a1 = {}; a1 = mma32_ll(a1, Wm + ti * 32 * 136, 136, VTs + nt * 32 * 136, 136, dir ? 8 : (ti + 1) * 2, lane, dir ? 8 - (ti + 1) * 2 : 0);
            f32x16 a2 = {}; a2 = mma32_ll(a2, Qs + (rb + (dir ? -ti * 32 : ti * 32)) * 72, rs, CTs + nt * 32 * 72, 72, 4, lane);
#pragma unroll
            for (int r = 0; r < 16; ++r) a1[r] += AIN[ti * 32 + crow(r, hi)] * a2[r];
            tot[k] = a1;
            if (nt == 2 && r32 == 0) {
#pragma unroll
                for (int r = 0; r < 16; ++r) DEN[ti * 32 + crow(r, hi)] = a1[r]; } } }
        LDS_BAR();
#pragma unroll
        for (int k = 0; k < 2; ++k) { const int q = wave + 8 * k; if (q < 12) { const int ti = q / 3, nt = q % 3; if (nt < 2) {
#pragma unroll
            for (int r = 0; r < 16; ++r) { const int t = ti * 32 + crow(r, hi); const float hv = tot[k][r] * frcp(fmaxf(fabsf(DEN[t]), EINV[t])); const int p = dir ? 127 - t : t;
                if (dir == 0) HS[p * 64 + nt * 32 + r32] = hv; else HS[p * 64 + nt * 32 + r32] += hv; } } } }
    }
    LDS_BAR();
    { const int c8 = (tid & 7) * 8; bf16_t* yc = (bf16_t*)(F.ws + WS_YC);
      const f32x4 hg0 = *(const f32x4*)(F.in[I_MLHG] + l * 256 + h * 64 + c8), hg1 = *(const f32x4*)(F.in[I_MLHG] + l * 256 + h * 64 + c8 + 4);
#pragma unroll
      for (int half = 0; half < 2; ++half) { const int p = half * 64 + (tid >> 3); const u32x4 og = half ? og1 : og0;
        const f32x4 v0 = *(const LAS f32x4*)(HS + p * 64 + c8), v1 = *(const LAS f32x4*)(HS + p * 64 + c8 + 4);
        float ss = (v0.x * v0.x + v0.y * v0.y) + (v0.z * v0.z + v0.w * v0.w) + (v1.x * v1.x + v1.y * v1.y) + (v1.z * v1.z + v1.w * v1.w);
        ss += xor_lane<1>(ss); ss += xor_lane<2>(ss); ss += xor_lane<4>(ss);
        const float sc = frsq(ss * (1.f / 64.f) + EPS);
        const f32x4 y0 = v0 * sc * hg0 * (f32x4){sigmoidf_(bflo(og.x)), sigmoidf_(bfhi(og.x)), sigmoidf_(bflo(og.y)), sigmoidf_(bfhi(og.y))};
        const f32x4 y1 = v1 * sc * hg1 * (f32x4){sigmoidf_(bflo(og.z)), sigmoidf_(bfhi(og.z)), sigmoidf_(bflo(og.w)), sigmoidf_(bfhi(og.w))};
        *(u32x4*)(yc + (size_t)ml_row(b, isctx, p0 + p) * 1024 + h * 64 + c8) = (u32x4){pk2(y0.x, y0.y), pk2(y0.z, y0.w), pk2(y1.x, y1.y), pk2(y1.z, y1.w)}; } }
}

struct PoolRegs { u32x4 v[5]; };
__device__ __forceinline__ PoolRegs pool_load(const Frame& F, int unit) {
    PoolRegs R; const int row0 = unit * 64, tid = F.tid;
    const bool isctx = row0 >= NLAT; const int T = isctx ? 256 : 8192, t0 = isctx ? (row0 - NLAT) & 255 : row0 & 8191, rbase = row0 - t0;
    const bf16_t* px = (const bf16_t*)(F.ws + WS_PX);
#pragma unroll
    for (int q = 0; q < 5; ++q) { const int it = tid + q * NTHR, rr = it >> 5, c = it & 31, t = t0 - 8 + rr; R.v[q] = (u32x4){0u, 0u, 0u, 0u};
        if (t >= 0 && t < T) R.v[q] = *(const u32x4*)(px + (size_t)(rbase + t) * INC + C_POOL + c * 8); }
    return R;
}
__device__ __forceinline__ void pool_unit(const Frame& F, int l, int unit, const PoolRegs& R) {
    LAS float* U = (LAS float*)F.lds;
    LAS bf16_t* D = (LAS bf16_t*)(F.lds + 81920);
    const int row0 = unit * 64, tid = F.tid, lane = F.lane, wave = F.wave;
    const bool isctx = row0 >= NLAT; const int T = isctx ? 256 : 8192, t0 = isctx ? (row0 - NLAT) & 255 : row0 & 8191, rbase = row0 - t0;
    const bf16_t* px = (const bf16_t*)(F.ws + WS_PX);
    LDS_BAR();
    {
#pragma unroll
      for (int q = 0; q < 5; ++q) { const int it = tid + q * NTHR, rr = it >> 5, c = it & 31; LAS float* d = U + rr * 256 + c * 8; const u32x4 v = R.v[q];
          *(LAS f32x4*)d = (f32x4){bflo(v.x), bfhi(v.x), bflo(v.y), bfhi(v.y)}; *(LAS f32x4*)(d + 4) = (f32x4){bflo(v.z), bfhi(v.z), bflo(v.w), bfhi(v.w)}; } }
    LDS_BAR();
    { const int c = tid & 255, th = tid >> 8, g = c >> 6, hw = 1 << g, tt0 = th * 32;
      float sacc = 0.f;
      for (int u = tt0 - hw; u < tt0 + hw; ++u) sacc += U[(u + 8) * 256 + c];
#pragma unroll 4
      for (int k = 0; k < 32; ++k) { const int tt = tt0 + k, t = t0 + tt; const int lo = max(t - hw, 0), hi = min(t + hw, T);
          D[tt * 264 + c] = (bf16_t)f2bf(sacc * frcp((float)(hi - lo)) - U[(tt + 8) * 256 + c]);
          sacc += U[(tt + hw + 8) * 256 + c] - U[(tt - hw + 8) * 256 + c]; } }
    LDS_BAR();
    { const int g = wave >> 1, rt = wave & 1, r32 = lane & 31, hi = lane >> 5; bf16_t* yc = (bf16_t*)(F.ws + WS_YC); const float* ps = F.in[I_POOLS] + l * 256;
      for (int nt = 0; nt < 2; ++nt) { f32x16 acc = {}; acc = mma32_lg<4>(acc, D + rt * 32 * 264 + g * 64, 264, (const bf16_t*)(F.ws + W_POOL) + (size_t)(g * 64 + nt * 32) * 64, 64, lane);
          const int col = g * 64 + nt * 32 + r32; const float sc = ps[col];
#pragma unroll
          for (int r = 0; r < 16; ++r) yc[(size_t)(row0 + rt * 32 + crow(r, hi)) * 1024 + 512 + col] = (bf16_t)f2bf(acc[r] * sc); } }
}
__device__ __forceinline__ void conv_z(const bf16_t* p, float (&z)[8]) { const u32x4 u = *(const u32x4*)p, cc = *(const u32x4*)(p + 512);
    z[0] = bflo(u.x) * bflo(cc.x); z[1] = bfhi(u.x) * bfhi(cc.x); z[2] = bflo(u.y) * bflo(cc.y); z[3] = bfhi(u.y) * bfhi(cc.y);
    z[4] = bflo(u.z) * bflo(cc.z); z[5] = bfhi(u.z) * bfhi(cc.z); z[6] = bflo(u.w) * bflo(cc.w); z[7] = bfhi(u.w) * bfhi(cc.w); }
__device__ __forceinline__ void conv_all(const Frame& F, int l, int nrows) {
    const bf16_t* px = (const bf16_t*)(F.ws + WS_PX); bf16_t* yc = (bf16_t*)(F.ws + WS_YC);
    const int c = (F.tid & 31) * 8;
    float w0[8], w1[8], w2[8], cb[8];
#pragma unroll
    for (int e = 0; e < 8; ++e) { w0[e] = F.in[I_CONVW][l * 768 + c + e]; w1[e] = F.in[I_CONVW][l * 768 + 256 + c + e]; w2[e] = F.in[I_CONVW][l * 768 + 512 + c + e]; cb[e] = F.in[I_CONVB][l * 256 + c + e]; }
    for (int it = F.bx * NTHR + F.tid; it < (nrows / 16) * 32; it += F.G * NTHR) { const int row0 = (it >> 5) * 16;
        const bool isctx = row0 >= NLAT; const int T = isctx ? 256 : 8192, t0 = isctx ? (row0 - NLAT) & 255 : row0 & 8191;
        const bf16_t* p = px + (size_t)row0 * INC + C_CONV + c;
        float zp[8], zc[8], zn[8];
        if (t0 > 0) conv_z(p - INC, zp); else {
#pragma unroll
            for (int e = 0; e < 8; ++e) zp[e] = 0.f; }
        conv_z(p, zc);
#pragma unroll 4
        for (int r = 0; r < 16; ++r) { const bf16_t* pr = p + (size_t)r * INC;
            if (t0 + r + 1 < T) conv_z(pr + INC, zn); else {
#pragma unroll
                for (int e = 0; e < 8; ++e) zn[e] = 0.f; }
            const u32x4 bw = *(const u32x4*)(pr + 256); const float bx[8] = {bflo(bw.x), bfhi(bw.x), bflo(bw.y), bfhi(bw.y), bflo(bw.z), bfhi(bw.z), bflo(bw.w), bfhi(bw.w)};
            float y[8];
#pragma unroll
            for (int e = 0; e < 8; ++e) { y[e] = bx[e] * (cb[e] + w0[e] * zp[e] + w1[e] * zc[e] + w2[e] * zn[e]); zp[e] = zc[e]; zc[e] = zn[e]; }
            u32x4 o; o.x = pk2(y[0], y[1]); o.y = pk2(y[2], y[3]); o.z = pk2(y[4], y[5]); o.w = pk2(y[6], y[7]);
            *(u32x4*)(yc + (size_t)(row0 + r) * 1024 + 768 + c) = o; }
    }
}

namespace att {
constexpr int STAGE_B = 40960, KSUB = 12288, VOFF = 24576, VSUB = 8192, LDS_WS = 3 * STAGE_B, LDS_OST = LDS_WS + 2048;
constexpr float THR = 8.0f;
__device__ __forceinline__ void glds16(const void* gsrc, unsigned lds_dst) { unsigned keep;
    asm volatile("s_mov_b32 %0, m0\n\ts_mov_b32 m0, %2\n\ts_nop 0\n\tglobal_load_lds_dwordx4 %1, off\n\ts_mov_b32 m0, %0" : "=&s"(keep) : "v"(gsrc), "s"(lds_dst) : "memory"); }
#define ATT_WAIT_BAR(N) asm volatile("s_waitcnt vmcnt(" #N ") lgkmcnt(0)\n\ts_barrier" ::: "memory")
__device__ __forceinline__ void qkt(f32x16& p0, f32x16& p1, const LAS char* Kslot, const bf16x8* qr, int r32, int hi) {
    const LAS char* kb = Kslot + hi * 1024 + r32 * 16; p0 = f32x16{}; p1 = f32x16{};
#pragma unroll
    for (int d0 = 0; d0 < 6; ++d0) {
        const bf16x8 b0 = *(const LAS bf16x8*)(kb + d0 * 2048), b1 = *(const LAS bf16x8*)(kb + d0 * 2048 + 512);
        p0 = __builtin_amdgcn_mfma_f32_32x32x16_bf16(b0, qr[d0], p0, 0, 0, 0); p1 = __builtin_amdgcn_mfma_f32_32x32x16_bf16(b1, qr[d0], p1, 0, 0, 0); }
}
__device__ __forceinline__ float rowmax(const f32x16& p0, const f32x16& p1) {
    float a = fmaxf(p0[0], p1[0]);
#pragma unroll
    for (int r = 1; r < 16; ++r) a = fmaxf(a, fmaxf(p0[r], p1[r]));
    auto rr = __builtin_amdgcn_permlane32_swap(__float_as_uint(a), __float_as_uint(a), false, false);
    return fmaxf(__uint_as_float(rr[0]), __uint_as_float(rr[1]));
}
__device__ __forceinline__ void pv(f32x16* o, int vb, bf16x8 pa0, bf16x8 pa1, bf16x8 pa2, bf16x8 pa3) {
#pragma unroll
    for (int d0 = 0; d0 < 2; ++d0) { s16x4 lo[4], hi[4];
#pragma unroll
        for (int ks = 0; ks < 4; ++ks) {
            asm volatile("ds_read_b64_tr_b16 %0,%1 offset:%c2" : "=&v"(lo[ks]) : "v"(vb), "i"(d0 * 4096 + ks * 1024) : "memory");
            asm volatile("ds_read_b64_tr_b16 %0,%1 offset:%c2" : "=&v"(hi[ks]) : "v"(vb), "i"(d0 * 4096 + ks * 1024 + 512) : "memory"); }
        asm volatile("s_waitcnt lgkmcnt(0)" ::: "memory"); __builtin_amdgcn_sched_barrier(0);
#define ATT_PK(k) (bf16x8){lo[k][0], lo[k][1], lo[k][2], lo[k][3], hi[k][0], hi[k][1], hi[k][2], hi[k][3]}
        o[d0] = __builtin_amdgcn_mfma_f32_32x32x16_bf16(pa0, ATT_PK(0), o[d0], 0, 0, 0);
        o[d0] = __builtin_amdgcn_mfma_f32_32x32x16_bf16(pa1, ATT_PK(1), o[d0], 0, 0, 0);
        o[d0] = __builtin_amdgcn_mfma_f32_32x32x16_bf16(pa2, ATT_PK(2), o[d0], 0, 0, 0);
        o[d0] = __builtin_amdgcn_mfma_f32_32x32x16_bf16(pa3, ATT_PK(3), o[d0], 0, 0, 0);
#undef ATT_PK
    }
}
__device__ __forceinline__ void unit(const Frame& F, int bh, int qrow, int orow, int nst) {
    const int tid = F.tid, lane = F.lane, wid = F.wave, r32 = lane & 31, hi = lane >> 5, h = bh & 3;
    const unsigned lds0 = (unsigned)(uintptr_t)F.lds;
    const LAS char* ring = (const LAS char*)F.lds;
    LAS float* wsf = (LAS float*)(F.lds + LDS_WS) + wid * 64;
    const char* kg = (const char*)(F.ws + WS_KT) + (size_t)bh * NKT * 12288; const char* vg = (const char*)(F.ws + WS_VT) + (size_t)bh * NKT * 8192;
    const bf16_t* Qw = (const bf16_t*)(F.ws + WS_QB) + (size_t)(qrow + wid * 32) * 384 + h * 96;
#define ATT_DMA(t, slot) do { const char* ks_ = kg + (size_t)(t) * 24576 + wid * 1024 + lane * 16; const char* vs_ = vg + (size_t)(t) * 16384 + wid * 1024 + lane * 16; \
        const unsigned kd_ = lds0 + (slot) * STAGE_B + wid * 1024, vd_ = kd_ + VOFF; \
        glds16(ks_, (unsigned)__builtin_amdgcn_readfirstlane(kd_)); glds16(ks_ + 8192, (unsigned)__builtin_amdgcn_readfirstlane(kd_ + 8192)); glds16(ks_ + 16384, (unsigned)__builtin_amdgcn_readfirstlane(kd_ + 16384)); \
        glds16(vs_, (unsigned)__builtin_amdgcn_readfirstlane(vd_)); glds16(vs_ + 8192, (unsigned)__builtin_amdgcn_readfirstlane(vd_ + 8192)); } while (0)
    ATT_DMA(0, 0); if (nst > 1) ATT_DMA(1, 1);
    bf16x8 qr[6];
#pragma unroll
    for (int d0 = 0; d0 < 6; ++d0) qr[d0] = *(const bf16x8*)(Qw + (size_t)r32 * 384 + d0 * 16 + hi * 8);
    float mhat = 0.f, l_reg = 0.f; f32x16 o[2]; o[0] = f32x16{}; o[1] = f32x16{};
    const int vb0 = (int)lds0 + VOFF + ((lane >> 4) & 1) * 32 + (lane & 3) * 8 + (4 * hi + ((lane & 15) >> 2)) * 64;
    int slot = 0; bool first = true;
    for (int t = 0; t < nst; ++t) {
        if (t + 1 < nst) ATT_WAIT_BAR(5); else ATT_WAIT_BAR(0);
        if (t + 2 < nst) { const int s2 = (slot == 0) ? 2 : slot - 1; ATT_DMA(t + 2, s2); }
#pragma unroll
        for (int s = 0; s < 2; ++s) {
            f32x16 p0, p1; qkt(p0, p1, ring + slot * STAGE_B + s * KSUB, qr, r32, hi);
            const float rm = rowmax(p0, p1);
            if (first) { mhat = rm; first = false; }
            else if (__any(rm - mhat > THR)) { const float dl = fmaxf(rm - mhat, 0.f); mhat += dl; const float f = __builtin_amdgcn_exp2f(-dl); l_reg *= f;
                if (hi == 0) wsf[r32] = f; LDS_WAIT();
#pragma unroll
                for (int r = 0; r < 16; ++r) { const float fr_ = wsf[crow(r, hi)]; o[0][r] *= fr_; o[1][r] *= fr_; } }
            float sacc = 0.f;
#pragma unroll
            for (int r = 0; r < 16; ++r) { p0[r] = __builtin_amdgcn_exp2f(p0[r] - mhat); p1[r] = __builtin_amdgcn_exp2f(p1[r] - mhat); sacc += p0[r] + p1[r]; }
            l_reg += sacc;
            u32x4 pw0, pw1, pw2, pw3;
            pw0 = (u32x4){cvt_pk_bf16(p0[0], p0[1]), cvt_pk_bf16(p0[2], p0[3]), cvt_pk_bf16(p0[4], p0[5]), cvt_pk_bf16(p0[6], p0[7])};
            pw1 = (u32x4){cvt_pk_bf16(p0[8], p0[9]), cvt_pk_bf16(p0[10], p0[11]), cvt_pk_bf16(p0[12], p0[13]), cvt_pk_bf16(p0[14], p0[15])};
            pw2 = (u32x4){cvt_pk_bf16(p1[0], p1[1]), cvt_pk_bf16(p1[2], p1[3]), cvt_pk_bf16(p1[4], p1[5]), cvt_pk_bf16(p1[6], p1[7])};
            pw3 = (u32x4){cvt_pk_bf16(p1[8], p1[9]), cvt_pk_bf16(p1[10], p1[11]), cvt_pk_bf16(p1[12], p1[13]), cvt_pk_bf16(p1[14], p1[15])};
            __builtin_amdgcn_sched_barrier(0);
            pv(o, vb0 + slot * STAGE_B + s * VSUB, __builtin_bit_cast(bf16x8, pw0), __builtin_bit_cast(bf16x8, pw1), __builtin_bit_cast(bf16x8, pw2), __builtin_bit_cast(bf16x8, pw3));
        }
        slot = (slot == 2) ? 0 : slot + 1;
    }
    { auto rr = __builtin_amdgcn_permlane32_swap(__float_as_uint(l_reg), __float_as_uint(l_reg), false, false); l_reg = __uint_as_float(rr[0]) + __uint_as_float(rr[1]); }
    if (hi == 0) wsf[32 + r32] = l_reg; LDS_WAIT();
    float rli[16];
#pragma unroll
    for (int r = 0; r < 16; ++r) rli[r] = frcp(wsf[32 + crow(r, hi)]);
    LAS bf16_t* stg = (LAS bf16_t*)(F.lds + LDS_OST) + wid * 2048;
#pragma unroll
    for (int r = 0; r < 16; ++r) { const int orow_ = crow(r, hi);
#pragma unroll
        for (int d0 = 0; d0 < 2; ++d0) stg[orow_ * 64 + d0 * 32 + r32] = (bf16_t)f2bf(o[d0][r] * rli[r]); }
    LDS_WAIT();
    bf16_t* Ow = (bf16_t*)(F.ws + WS_YC) + (size_t)(orow + wid * 32) * 1024 + 256 + h * 64;
#pragma unroll
    for (int i = 0; i < 4; ++i) { const int row = i * 8 + (lane >> 3), ch = lane & 7; const u32x4 v = *(const LAS u32x4*)(stg + row * 64 + ch * 8); *(u32x4*)(Ow + (size_t)row * 1024 + ch * 8) = v; }
    asm volatile("s_waitcnt lgkmcnt(0)\n\ts_barrier" ::: "memory");
#undef ATT_DMA
}
}

namespace att2 {
constexpr int KSL = 12288, VSL = 8192, LDS_K = 0, LDS_V = 3 * KSL, LDS_WS = LDS_V + 3 * VSL, LDS_OST = LDS_WS + 2048;
#define A2_SBAR() __builtin_amdgcn_sched_barrier(0)
#define A2_WAIT_BAR(N) asm volatile("s_waitcnt vmcnt(" #N ") lgkmcnt(0)\n\ts_barrier" ::: "memory")
__device__ __forceinline__ void glds16s(const void* sbase, unsigned voff, unsigned lds_dst) { unsigned keep;
    asm volatile("s_mov_b32 %0, m0\n\ts_mov_b32 m0, %3\n\ts_nop 4\n\tglobal_load_lds_dwordx4 %1, %2\n\ts_mov_b32 m0, %0" : "=&s"(keep) : "v"(voff), "s"(sbase), "s"(lds_dst) : "memory"); }
__device__ __forceinline__ unsigned cvtpk_s(float lo, float hi) { typedef float f2 __attribute__((ext_vector_type(2))); typedef __bf16 b2 __attribute__((ext_vector_type(2))); f2 v = {lo, hi}; b2 b = __builtin_convertvector(v, b2); return __builtin_bit_cast(unsigned, b); }
typedef short v4i16_t __attribute__((ext_vector_type(4)));
__device__ __forceinline__ s16x4 vtr(const LAS char* p) { return __builtin_bit_cast(s16x4, __builtin_amdgcn_ds_read_tr16_b64_v4i16((LAS v4i16_t*)p)); }
__device__ __forceinline__ void kload2(bf16x8* kf, const LAS char* kp, int j) { kf[2 * j] = *(const LAS bf16x8*)(kp + j * 2048); kf[2 * j + 1] = *(const LAS bf16x8*)(kp + j * 2048 + 512); }

template <bool NOMAX> __device__ __forceinline__ void unit(const Frame& F, int bh, int qrow, int orow, int NT) {
    const int lane = F.lane, wid = F.wave, r32 = lane & 31, hi = lane >> 5, h = bh & 3;
    const unsigned lds0 = (unsigned)(uintptr_t)F.lds;
    const LAS char* shm3 = (const LAS char*)F.lds;
    LAS float* wsf = (LAS float*)(F.lds + LDS_WS) + wid * 64;
    const char* kg = (const char*)(F.ws + WS_KT) + (size_t)bh * NKT * 12288; const char* vg = (const char*)(F.ws + WS_VT) + (size_t)bh * NKT * 8192 + wid * 1024; const unsigned l16 = lane * 16;
    const bf16_t* Qw = (const bf16_t*)(F.ws + WS_QB) + (size_t)(qrow + wid * 32) * 384 + h * 96;
    const int kp2 = 8 + (wid & 3);
#define A2_DMA_K(t, sl) do { const char* s_ = kg + (size_t)(t) * 12288; const unsigned d_ = lds0 + LDS_K + (sl) * KSL; \
        glds16s(s_ + wid * 1024, l16, (unsigned)__builtin_amdgcn_readfirstlane(d_ + wid * 1024)); glds16s(s_ + kp2 * 1024, l16, (unsigned)__builtin_amdgcn_readfirstlane(d_ + kp2 * 1024)); } while (0)
#define A2_DMA_V(t, sl) glds16s(vg + (size_t)(t) * 8192, l16, (unsigned)__builtin_amdgcn_readfirstlane(lds0 + LDS_V + (sl) * VSL + wid * 1024))
    const LAS char* kp0 = shm3 + LDS_K + hi * 1024 + r32 * 16;
    const LAS char* vp0 = shm3 + LDS_V + ((lane >> 4) & 1) * 32 + (lane & 3) * 8 + (4 * hi + ((lane & 15) >> 2)) * 64;
    bf16x8 kf[12];
    A2_DMA_K(0, 0); A2_DMA_V(0, 0); A2_DMA_K(1, 1);
    bf16x8 qr[6];
#pragma unroll
    for (int d0 = 0; d0 < 6; ++d0) qr[d0] = *(const bf16x8*)(Qw + (size_t)r32 * 384 + d0 * 16 + hi * 8);
    float mhat = 0.f, l_reg = 0.f; f32x16 o[2]; o[0] = f32x16{}; o[1] = f32x16{};
    bool resc = false;
    f32x16 pA0, pA1, pB0, pB1;
    int sl_prev = 0, sl_cur = 0, sl_next = 1;
#define A2_ROT() do { sl_prev = sl_cur; sl_cur = sl_next; sl_next = (sl_next == 2) ? 0 : sl_next + 1; } while (0)
#define A2_RESC() do { if (!NOMAX && resc) { asm volatile("s_waitcnt lgkmcnt(0)" ::: "memory"); \
        _Pragma("unroll") for (int d_ = 0; d_ < 2; ++d_) _Pragma("unroll") for (int r = 0; r < 16; ++r) o[d_][r] *= wsf[crow(r, hi)]; } } while (0)
    A2_DMA_K(2, 2);
    A2_WAIT_BAR(5);
    { kload2(kf, kp0, 0); kload2(kf, kp0, 1); kload2(kf, kp0, 2); kload2(kf, kp0, 3); kload2(kf, kp0, 4); kload2(kf, kp0, 5);
      pA0 = f32x16{}; pA1 = f32x16{};
#pragma unroll
      for (int d0 = 0; d0 < 6; ++d0) { pA0 = __builtin_amdgcn_mfma_f32_32x32x16_bf16(kf[2 * d0], qr[d0], pA0, 0, 0, 0); pA1 = __builtin_amdgcn_mfma_f32_32x32x16_bf16(kf[2 * d0 + 1], qr[d0], pA1, 0, 0, 0); }
      if constexpr (!NOMAX) { float a = fmaxf(pA0[0], pA1[0]);
#pragma unroll
      for (int r = 1; r < 16; ++r) a = fmaxf(a, fmaxf(pA0[r], pA1[r]));
      { auto rr = __builtin_amdgcn_permlane32_swap(__float_as_uint(a), __float_as_uint(a), false, false); a = fmaxf(__uint_as_float(rr[0]), __uint_as_float(rr[1])); }
      mhat = a; }
#pragma unroll
      for (int r = 0; r < 16; ++r) { pA0[r] = __builtin_amdgcn_exp2f(pA0[r] - mhat); pA1[r] = __builtin_amdgcn_exp2f(pA1[r] - mhat); } }
    A2_WAIT_BAR(0);
    A2_DMA_K(3, 0); A2_DMA_V(1, 1);
    A2_ROT();
    { const LAS char* kp = kp0 + sl_cur * KSL; kload2(kf, kp, 0); kload2(kf, kp, 1); kload2(kf, kp, 2); kload2(kf, kp, 3); kload2(kf, kp, 4); kload2(kf, kp, 5); }
    A2_WAIT_BAR(3);
    s16x4 vlo[8], vhi[8]; u32x4 pw0, pw1, pw2, pw3;
#define A2_PKW(P, B) cvtpk_s(P[B], P[B + 1])
#define A2_PAF(k) __builtin_bit_cast(bf16x8, pw##k)
#define A2_VFR(i) (bf16x8){vlo[i][0], vlo[i][1], vlo[i][2], vlo[i][3], vhi[i][0], vhi[i][1], vhi[i][2], vhi[i][3]}
#define A2_PIN(x) asm volatile("" : "+v"(x))
#define A2_MX3(a, b, c) __builtin_fmaxf(__builtin_fmaxf((a), (b)), (c))
#define A2_GAPA(MF, A0, A1, A2, A3, W0, W1, PW) do { MF; sacc += A0; sacc += A1; sacc += A2; sacc += A3; A2_PIN(sacc); W0; W1; A2_PIN(PW); A2_SBAR(); } while (0)
#define A2_GAPM(MF) do { MF; A2_SBAR(); } while (0)
#define A2_EX(v) __builtin_amdgcn_exp2f(v)
#define A2_SH(v) (NOMAX ? (v) : (v) - mhat)
#define A2_GAPB(MF, X, B) do { MF; X[B] = A2_EX(A2_SH(X[B])); X[B + 1] = A2_EX(A2_SH(X[B + 1])); X[B + 2] = A2_EX(A2_SH(X[B + 2])); X[B + 3] = A2_EX(A2_SH(X[B + 3])); A2_PIN(X); A2_SBAR(); } while (0)
#define A2_VRD(i) do { vlo[i] = vtr(vp_ + (((i) >> 2) * 4096 + ((i) & 3) * 1024)); vhi[i] = vtr(vp_ + (((i) >> 2) * 4096 + ((i) & 3) * 1024 + 512)); } while (0)
#define A2_KRD(G, j) do { if (G) { kload2(kf, kp0 + sl_next * KSL, j); A2_SBAR(); } } while (0)
#define A2_MF(C, kk, qq, CI) C = __builtin_amdgcn_mfma_f32_32x32x16_bf16(kf[kk], qr[qq], CI, 0, 0, 0)
#define A2_STEP(C0, C1, P0, P1, t, GK, GV, GL) do { A2_SBAR(); \
    const LAS char* vp_ = vp0 + sl_prev * VSL; \
    A2_VRD(0); A2_SBAR(); float sacc = (P0[0] + P0[1]); \
    A2_GAPA(A2_MF(C0, 0, 0, (f32x16{})), P0[2], P0[3], P0[4], P0[5],     pw0[0] = A2_PKW(P0, 0), pw0[1] = A2_PKW(P0, 2), pw0); \
    A2_VRD(4); A2_SBAR(); A2_GAPA(A2_MF(C1, 1, 0, (f32x16{})), P0[6], P0[7], P0[8], P0[9],     pw0[2] = A2_PKW(P0, 4), pw0[3] = A2_PKW(P0, 6), pw0); \
    A2_VRD(1); A2_SBAR(); A2_GAPA(A2_MF(C0, 2, 1, C0),   P0[10], P0[11], P0[12], P0[13], pw1[0] = A2_PKW(P0, 8), pw1[1] = A2_PKW(P0, 10), pw1); \
    A2_VRD(5); A2_SBAR(); A2_GAPA(A2_MF(C1, 3, 1, C1),   P0[14], P0[15], P1[0], P1[1],   pw1[2] = A2_PKW(P0, 12), pw1[3] = A2_PKW(P0, 14), pw1); \
    A2_VRD(2); A2_SBAR(); A2_GAPA(A2_MF(C0, 4, 2, C0),   P1[2], P1[3], P1[4], P1[5],     pw2[0] = A2_PKW(P1, 0), pw2[1] = A2_PKW(P1, 2), pw2); \
    A2_VRD(6); A2_SBAR(); A2_GAPA(A2_MF(C1, 5, 2, C1),   P1[6], P1[7], P1[8], P1[9],     pw2[2] = A2_PKW(P1, 4), pw2[3] = A2_PKW(P1, 6), pw2); \
    A2_VRD(3); A2_SBAR(); A2_GAPA(A2_MF(C0, 6, 3, C0),   P1[10], P1[11], P1[12], P1[13], pw3[0] = A2_PKW(P1, 8), pw3[1] = A2_PKW(P1, 10), pw3); \
    A2_VRD(7); A2_SBAR(); A2_GAPA(A2_MF(C1, 7, 3, C1),   P1[14], P1[15], 0.f, 0.f,       pw3[2] = A2_PKW(P1, 12), pw3[3] = A2_PKW(P1, 14), pw3); \
    A2_GAPM(A2_MF(C0, 8, 4, C0)); A2_GAPM(A2_MF(C1, 9, 4, C1)); A2_GAPM(A2_MF(C0, 10, 5, C0)); A2_GAPM(A2_MF(C1, 11, 5, C1)); \
    l_reg += sacc; \
    if (GK) { A2_DMA_K((t) + 3, sl_cur); } if (GV) { A2_DMA_V((t) + 1, sl_next); } \
    if constexpr (!NOMAX) { float a = A2_MX3(C0[0], C0[1], C1[0]), b = A2_MX3(C0[2], C0[3], C1[1]); a = A2_MX3(a, C1[2], C1[3]); \
      _Pragma("unroll") for (int r = 4; r < 16; r += 4) { a = A2_MX3(a, C0[r], C0[r + 1]); b = A2_MX3(b, C0[r + 2], C0[r + 3]); a = A2_MX3(a, C1[r], C1[r + 1]); b = A2_MX3(b, C1[r + 2], C1[r + 3]); } \
      float rm = __builtin_fmaxf(a, b); { auto rr = __builtin_amdgcn_permlane32_swap(__float_as_uint(rm), __float_as_uint(rm), false, false); rm = __builtin_fmaxf(__uint_as_float(rr[0]), __uint_as_float(rr[1])); } \
      resc = false; \
      if (__builtin_expect(__any(rm - mhat > 8.0f), 0)) { const float dl = __builtin_fmaxf(rm - mhat, 0.f); mhat += dl; \
        const float f = __builtin_amdgcn_exp2f(-dl); l_reg *= f; if (hi == 0) wsf[r32] = f; resc = true; } } \
    A2_SBAR(); \
    A2_GAPB(o[0] = __builtin_amdgcn_mfma_f32_32x32x16_bf16(A2_PAF(0), A2_VFR(0), o[0], 0, 0, 0), C0, 0); \
    A2_KRD(GL, 0); A2_GAPB(o[1] = __builtin_amdgcn_mfma_f32_32x32x16_bf16(A2_PAF(0), A2_VFR(4), o[1], 0, 0, 0), C0, 4); \
    A2_KRD(GL, 1); A2_GAPB(o[0] = __builtin_amdgcn_mfma_f32_32x32x16_bf16(A2_PAF(1), A2_VFR(1), o[0], 0, 0, 0), C0, 8); \
    A2_KRD(GL, 2); A2_GAPB(o[1] = __builtin_amdgcn_mfma_f32_32x32x16_bf16(A2_PAF(1), A2_VFR(5), o[1], 0, 0, 0), C0, 12); \
    A2_KRD(GL, 3); A2_GAPB(o[0] = __builtin_amdgcn_mfma_f32_32x32x16_bf16(A2_PAF(2), A2_VFR(2), o[0], 0, 0, 0), C1, 0); \
    A2_KRD(GL, 4); A2_GAPB(o[1] = __builtin_amdgcn_mfma_f32_32x32x16_bf16(A2_PAF(2), A2_VFR(6), o[1], 0, 0, 0), C1, 4); \
    A2_KRD(GL, 5); A2_GAPB(o[0] = __builtin_amdgcn_mfma_f32_32x32x16_bf16(A2_PAF(3), A2_VFR(3), o[0], 0, 0, 0), C1, 8); \
    A2_GAPB(o[1] = __builtin_amdgcn_mfma_f32_32x32x16_bf16(A2_PAF(3), A2_VFR(7), o[1], 0, 0, 0), C1, 12); \
    } while (0)
    int t = 1;
    for (; t + 5 < NT; t += 2) {
        A2_STEP(pB0, pB1, pA0, pA1, t, true, true, true);     A2_WAIT_BAR(3); A2_RESC(); A2_ROT();
        A2_STEP(pA0, pA1, pB0, pB1, t + 1, true, true, true); A2_WAIT_BAR(3); A2_RESC(); A2_ROT();
    }
#define A2_ENDW(tt) do { if ((tt) + 3 < NT) { A2_WAIT_BAR(3); } else if ((tt) + 2 < NT) { A2_WAIT_BAR(1); } else { A2_WAIT_BAR(0); } } while (0)
    for (; t + 1 < NT; t += 2) {
        A2_STEP(pB0, pB1, pA0, pA1, t, (t + 3 < NT), (t + 1 < NT), (t + 1 < NT));     A2_ENDW(t);     A2_RESC(); A2_ROT();
        A2_STEP(pA0, pA1, pB0, pB1, t + 1, (t + 4 < NT), (t + 2 < NT), (t + 2 < NT)); A2_ENDW(t + 1); A2_RESC(); A2_ROT();
    }
    A2_STEP(pB0, pB1, pA0, pA1, NT - 1, false, false, false); A2_RESC();
    { float sacc = pB0[0] + pB0[1];
#pragma unroll
      for (int r = 2; r < 16; ++r) sacc += pB0[r];
#pragma unroll
      for (int r = 0; r < 16; ++r) sacc += pB1[r];
      l_reg += sacc;
      pw0 = (u32x4){A2_PKW(pB0, 0), A2_PKW(pB0, 2), A2_PKW(pB0, 4), A2_PKW(pB0, 6)}; pw1 = (u32x4){A2_PKW(pB0, 8), A2_PKW(pB0, 10), A2_PKW(pB0, 12), A2_PKW(pB0, 14)};
      pw2 = (u32x4){A2_PKW(pB1, 0), A2_PKW(pB1, 2), A2_PKW(pB1, 4), A2_PKW(pB1, 6)}; pw3 = (u32x4){A2_PKW(pB1, 8), A2_PKW(pB1, 10), A2_PKW(pB1, 12), A2_PKW(pB1, 14)};
      A2_SBAR();
      const int vb = (int)lds0 + LDS_V + ((lane >> 4) & 1) * 32 + (lane & 3) * 8 + (4 * hi + ((lane & 15) >> 2)) * 64 + sl_cur * VSL;
      att::pv(o, vb, A2_PAF(0), A2_PAF(1), A2_PAF(2), A2_PAF(3)); }
    { auto rr = __builtin_amdgcn_permlane32_swap(__float_as_uint(l_reg), __float_as_uint(l_reg), false, false); l_reg = __uint_as_float(rr[0]) + __uint_as_float(rr[1]); }
    if (hi == 0) wsf[32 + r32] = l_reg; LDS_WAIT();
    float rli[16];
#pragma unroll
    for (int r = 0; r < 16; ++r) rli[r] = __builtin_amdgcn_rcpf(wsf[32 + crow(r, hi)]);
    LAS bf16_t* stg = (LAS bf16_t*)(F.lds + LDS_OST) + wid * 2048;
#pragma unroll
    for (int r = 0; r < 16; ++r) { const int orow_ = crow(r, hi);
#pragma unroll
        for (int d0 = 0; d0 < 2; ++d0) stg[orow_ * 64 + d0 * 32 + r32] = (bf16_t)f2bf(o[d0][r] * rli[r]); }
    LDS_WAIT();
    bf16_t* Ow = (bf16_t*)(F.ws + WS_YC) + (size_t)(orow + wid * 32) * 1024 + 256 + h * 64;
#pragma unroll
    for (int i = 0; i < 4; ++i) { const int row = i * 8 + (lane >> 3), ch = lane & 7; const u32x4 v = *(const LAS u32x4*)(stg + row * 64 + ch * 8); *(u32x4*)(Ow + (size_t)row * 1024 + ch * 8) = v; }
    asm volatile("s_waitcnt lgkmcnt(0)\n\ts_barrier" ::: "memory");
}
}

__device__ __forceinline__ void ph_norm2_route(const Frame& F, int l, int ntok) {
    LAS bf16_t* A = (LAS bf16_t*)F.lds;
    LAS float* PART = (LAS float*)(F.lds + 66048);
    LAS float* LOG = (LAS float*)(F.lds + 131584);
    LAS int* HIST = (LAS int*)(F.lds + 139776);
    const int tid = F.tid, lane = F.lane, wave = F.wave, r32 = lane & 31, hi = lane >> 5;
    const int tpb = ntok / F.G, tok0 = F.bx * tpb;
    int* eidx = (int*)(F.ws + T_EIDX); float* ew = (float*)(F.ws + T_EW);
    const float* brt = F.in[I_BRT] + l * 64;
    if (tid < 64) HIST[tid] = 0;
    LAS f32x4* AV = (LAS f32x4*)(F.lds + 140288);
    LAS f32x4* SHV = AV + 512;
    const int mr_first = mod_row_of(tok0), mr_last = mod_row_of(tok0 + tpb - 1);
    { const int set = tid >> 8, idx = tid & 255, mrs = set ? mr_last : mr_first;
      const f32x4 gv = ((const f32x4*)(F.in[I_GFFN] + l * 1024))[idx], scv = ((const f32x4*)modp(F, l, mrs, 4))[idx];
      AV[tid] = gv * (scv + 1.0f); SHV[tid] = ((const f32x4*)modp(F, l, mrs, 3))[idx]; }
    bf16x8 wrt[2][8];
#pragma unroll
    for (int nt = 0; nt < 2; ++nt)
#pragma unroll
        for (int ks = 0; ks < 8; ++ks) wrt[nt][ks] = *(const bf16x8*)((const bf16_t*)(F.ws + W_RT) + (size_t)(nt * 32 + r32) * 1024 + wave * 128 + ks * 16 + hi * 8);
    f32x4 xn[4][4]; u32x2 mn[4][4];
#pragma unroll
    for (int rr = 0; rr < 4; ++rr) { const int t = min(wave * 4 + rr, tpb - 1); const f32x4* xr = (const f32x4*)stream_row(F, l, tok0 + t) + lane; const u32x2* mg = (const u32x2*)((const bf16_t*)(F.ws + WS_YC) + (size_t)(tok0 + t) * 1024) + lane;
#pragma unroll
        for (int j = 0; j < 4; ++j) { xn[rr][j] = xr[64 * j]; mn[rr][j] = mg[64 * j]; } }
    for (int b0 = 0; b0 < tpb; b0 += 32) {
        __syncthreads();
        { f32x4 v[4][4];
#pragma unroll
          for (int rr = 0; rr < 4; ++rr) {
#pragma unroll
                for (int j = 0; j < 4; ++j) { const u32x2 w = mn[rr][j]; v[rr][j] = xn[rr][j] + (f32x4){bflo(w.x), bfhi(w.x), bflo(w.y), bfhi(w.y)}; } }
#pragma unroll
          for (int rr = 0; rr < 4; ++rr) { const int r = wave * 4 + rr, t = b0 + r; LAS u32x2* a = (LAS u32x2*)(A + r * 1032) + lane;
            if (t < tpb) { const int row = tok0 + t, mr = mod_row_of(row); f32x4 y[4];
                f32x4* xo = (f32x4*)((row < NLAT) ? F.out + (size_t)row * 1024 : (float*)(F.ws + WS_CTXS) + (size_t)(row - NLAT) * 1024) + lane;
#pragma unroll
                for (int j = 0; j < 4; ++j) xo[64 * j] = v[rr][j];
                { float s2 = 0.f;
#pragma unroll
                  for (int j = 0; j < 4; ++j) s2 += (v[rr][j].x * v[rr][j].x + v[rr][j].y * v[rr][j].y) + (v[rr][j].z * v[rr][j].z + v[rr][j].w * v[rr][j].w);
                  const float rstd = frsq(wave_sum(s2) * (1.f / 1024.f) + EPS); const int vb = (mr == mr_first ? 0 : 256) + lane;
#pragma unroll
                  for (int j = 0; j < 4; ++j) y[j] = v[rr][j] * rstd * AV[vb + 64 * j] + SHV[vb + 64 * j]; }
                unsigned* o8 = (unsigned*)(F.ws + WS_HX8 + (size_t)row * 1024) + lane;
#pragma unroll
                for (int j = 0; j < 4; ++j) { a[64 * j] = (u32x2){pk2(y[j].x, y[j].y), pk2(y[j].z, y[j].w)}; o8[64 * j] = pk4_fp8(y[j].x, y[j].y, y[j].z, y[j].w); }
            } else {
#pragma unroll
                for (int j = 0; j < 4; ++j) a[64 * j] = (u32x2){0u, 0u}; } } }
        if (b0 + 32 < tpb) {
#pragma unroll
            for (int rr = 0; rr < 4; ++rr) { const int t = min(b0 + 32 + wave * 4 + rr, tpb - 1); const f32x4* xr = (const f32x4*)stream_row(F, l, tok0 + t) + lane; const u32x2* mg = (const u32x2*)((const bf16_t*)(F.ws + WS_YC) + (size_t)(tok0 + t) * 1024) + lane;
#pragma unroll
                for (int j = 0; j < 4; ++j) { xn[rr][j] = xr[64 * j]; mn[rr][j] = mg[64 * j]; } } }
        __syncthreads();
#pragma unroll
        for (int nt = 0; nt < 2; ++nt) { f32x16 acc = {};
#pragma unroll
            for (int ks = 0; ks < 8; ++ks) { const bf16x8 a = *(const LAS bf16x8*)(A + wave * 128 + r32 * 1032 + ks * 16 + hi * 8); acc = __builtin_amdgcn_mfma_f32_32x32x16_bf16(a, wrt[nt][ks], acc, 0, 0, 0); }
#pragma unroll
            for (int r = 0; r < 16; ++r) PART[(wave * 32 + crow(r, hi)) * 64 + nt * 32 + r32] = acc[r]; }
        __syncthreads();
        for (int i = tid; i < 2048; i += NTHR) { float s = 0.f;
#pragma unroll
            for (int w = 0; w < 8; ++w) s += PART[w * 2048 + i];
            LOG[i] = s; }
        __syncthreads();
        for (int rr = 0; rr < 4; ++rr) { const int r = wave * 4 + rr, t = b0 + r; if (t >= tpb) continue;
            const float sc = sigmoidf_(LOG[r * 64 + lane]); float v = sc + brt[lane]; float ssel = 0.f, mys = 0.f; int myi = 0;
#pragma unroll
            for (int k = 0; k < TOPK; ++k) { const float mx = wave_max(v); const unsigned long long bal = __ballot(v == mx); const int win = __ffsll((long long)bal) - 1;
                const float sw = lane_bcast(sc, win); ssel += sw; if (lane == k) { mys = sw; myi = win; } if (lane == win) v = -INFINITY; }
            if (lane < TOPK) { eidx[(size_t)(tok0 + t) * 6 + lane] = myi; ew[(size_t)(tok0 + t) * 6 + lane] = mys * frcp(ssel) * 2.5f; __hip_atomic_fetch_add(&HIST[myi], 1, __ATOMIC_RELAXED, __HIP_MEMORY_SCOPE_WORKGROUP); } }
    }
    __syncthreads();
    if (tid < 64) ((int*)(F.ws + T_HIST))[F.bx * 64 + tid] = HIST[tid];
}

__device__ __forceinline__ void ph_assign(const Frame& F, int ntok) {
    LAS int* BASE = (LAS int*)F.lds; LAS int* CUR = BASE + 64; LAS int* START = BASE + 128; LAS int* TOT = BASE + 192; LAS int* MISC = BASE + 256;
    const int tid = F.tid, hb = F.G, c = 0, tpb = ntok / F.G, ctok0 = 0, ctoks = ntok;
    const int* hist = (const int*)(F.ws + T_HIST); int* rtok = (int*)(F.ws + T_RTOK); float* rw = (float*)(F.ws + T_RW); int* slot = (int*)(F.ws + T_SLOT);
    int* tile_e = (int*)(F.ws + T_TILEE);
    __syncthreads();
    { LAS int* PT = BASE + 512; LAS int* PB = PT + 512;
      const int e = tid & 63, part = tid >> 6; int tot = 0, bef = 0;
#pragma unroll 8
      for (int k = 0; k < 32; ++k) { const int b = c * hb + part * 32 + k; if (b < (c + 1) * hb) { const int v = hist[b * 64 + e]; tot += v; if (b < F.bx) bef += v; } }
      PT[part * 64 + e] = tot; PB[part * 64 + e] = bef; }
    __syncthreads();
    if (tid < 64) { int tot = 0, bef = 0; for (int p8 = 0; p8 < 8; ++p8) { tot += BASE[512 + p8 * 64 + tid]; bef += BASE[1024 + p8 * 64 + tid]; } TOT[tid] = tot; BASE[tid] = bef; CUR[tid] = 0; }
    __syncthreads();
    if (tid == 0) { int s = 0; for (int e = 0; e < 64; ++e) { START[e] = s; s += (TOT[e] + 255) / 256 * 256; } MISC[0] = s; }
    __syncthreads();
    const int sstart = MISC[0];
    const int* eidx = (const int*)(F.ws + T_EIDX); const float* ew = (const float*)(F.ws + T_EW);
    for (int i = tid; i < tpb * 6; i += NTHR) { const int tok = F.bx * tpb + i / 6, k = i % 6; const int e = eidx[(size_t)tok * 6 + k];
        const int pos = START[e] + BASE[e] + __hip_atomic_fetch_add(&CUR[e], 1, __ATOMIC_RELAXED, __HIP_MEMORY_SCOPE_WORKGROUP); rtok[pos] = tok; rw[pos] = ew[(size_t)tok * 6 + k]; slot[(size_t)tok * 8 + k] = pos; }
    for (int i = tid; i < tpb; i += NTHR) { const int tok = F.bx * tpb + i, pos = sstart + (tok - ctok0); rtok[pos] = tok; rw[pos] = 1.0f; slot[(size_t)tok * 8 + 6] = pos; }
    if (F.bx == c * hb) {
        for (int e = 0; e < 64; ++e) { const int p0 = START[e] + TOT[e], p1 = START[e] + (TOT[e] + 255) / 256 * 256;
            for (int p = p0 + tid; p < p1; p += NTHR) { rtok[p] = ctok0; rw[p] = 0.f; }
            for (int tl = START[e] / 256 + tid; tl < p1 / 256; tl += NTHR) tile_e[tl] = e; }
        for (int tl = sstart / 256 + tid; tl < (sstart + ctoks) / 256; tl += NTHR) tile_e[tl] = 64;
        if (tid == 0) tile_e[2047] = (sstart + ctoks) / 256;
    }
}

template <bool FUSE_NORM> __device__ __forceinline__ void ph_combine(const Frame& F, int l, int c, int ntok) {
    const int lane = F.lane; const int tpb = ntok / F.G, tok0 = F.bx * tpb; (void)c;
    const int* slot = (const int*)(F.ws + T_SLOT); const unsigned char* ys = (const unsigned char*)(F.ws + WS_YS);
    int mr_cur = -1; f32x4 gtv[2][2], av[2][2], shv[2][2];
    for (int t = F.wave; t < tpb; t += NWAVES) { const int tok = tok0 + t, mr = mod_row_of(tok);
        if (mr != mr_cur) { mr_cur = mr; const float* gt = modp(F, l, mr, 5);
#pragma unroll
            for (int j = 0; j < 2; ++j)
#pragma unroll
                for (int h2 = 0; h2 < 2; ++h2) { const int c0 = 8 * lane + 512 * j + 4 * h2; gtv[j][h2] = *(const f32x4*)(gt + c0);
                    if constexpr (FUSE_NORM) { const f32x4 gv = *(const f32x4*)(F.in[I_GMIX] + 1024 + c0), scv = *(const f32x4*)(modp(F, 1, mr, 1) + c0); av[j][h2] = gv * (scv + 1.0f); shv[j][h2] = *(const f32x4*)(modp(F, 1, mr, 0) + c0); } } }
        float* xr = (tok < NLAT) ? F.out + (size_t)tok * 1024 : (float*)(F.ws + WS_CTXS) + (size_t)(tok - NLAT) * 1024;
        const int sv = slot[(size_t)tok * 8 + (lane & 7)];
        u32x2 y[7][2];
#pragma unroll
        for (int k = 0; k < 7; ++k) { const int sk = __builtin_amdgcn_readlane(sv, k); const u32x2* yr = (const u32x2*)(ys + (size_t)sk * 1024) + lane; y[k][0] = yr[0]; y[k][1] = yr[64]; }
        f32x4 xv[2][2];
#pragma unroll
        for (int j = 0; j < 2; ++j) { xv[j][0] = *(const f32x4*)(xr + 8 * lane + 512 * j); xv[j][1] = *(const f32x4*)(xr + 8 * lane + 512 * j + 4); }
#pragma unroll
        for (int j = 0; j < 2; ++j) { f32x4 a0 = {0.f, 0.f, 0.f, 0.f}, a1 = {0.f, 0.f, 0.f, 0.f};
#pragma unroll
            for (int k = 0; k < 7; ++k) { a0 += up4_fp8(y[k][j].x); a1 += up4_fp8(y[k][j].y); }
            xv[j][0] = xv[j][0] + gtv[j][0] * a0; xv[j][1] = xv[j][1] + gtv[j][1] * a1;
            *(f32x4*)(xr + 8 * lane + 512 * j) = xv[j][0]; *(f32x4*)(xr + 8 * lane + 512 * j + 4) = xv[j][1]; }
        if constexpr (FUSE_NORM) {
            float ss = 0.f;
#pragma unroll
            for (int j = 0; j < 2; ++j)
#pragma unroll
                for (int h2 = 0; h2 < 2; ++h2) { const f32x4 v = xv[j][h2]; ss += (v.x * v.x + v.y * v.y) + (v.z * v.z + v.w * v.w); }
            const float rstd = frsq(wave_sum(ss) * (1.f / 1024.f) + EPS);
            bf16_t* hx = (bf16_t*)(F.ws + WS_HX) + (size_t)tok * 1024; unsigned char* h8 = F.ws + WS_HX8 + (size_t)tok * 1024;
#pragma unroll
            for (int j = 0; j < 2; ++j) { const int c0 = 8 * lane + 512 * j; f32x4 y[2];
#pragma unroll
                for (int h2 = 0; h2 < 2; ++h2) y[h2] = xv[j][h2] * rstd * av[j][h2] + shv[j][h2];
                *(u32x4*)(hx + c0) = (u32x4){pk2(y[0].x, y[0].y), pk2(y[0].z, y[0].w), pk2(y[1].x, y[1].y), pk2(y[1].z, y[1].w)};
                *(u32x2*)(h8 + c0) = (u32x2){pk4_fp8(y[0].x, y[0].y, y[0].z, y[0].w), pk4_fp8(y[1].x, y[1].y, y[1].z, y[1].w)}; }
        }
    }
}
__device__ __forceinline__ Frame phase_frame(const Frame& F) {
    Frame Q = F; int t = threadIdx.x; asm volatile("" : "+v"(t)); Q.tid = t; Q.lane = t & 63; Q.wave = __builtin_amdgcn_readfirstlane(t >> 6);
    unsigned long long w = (unsigned long long)F.ws; asm volatile("" : "+s"(w)); Q.ws = (unsigned char*)(GAS unsigned char*)w;
    return Q;
}
constexpr int PH_PER_LAYER = 13, PH_TOTAL = 1 + 2 * PH_PER_LAYER;
__global__ void __launch_bounds__(NTHR, 2) mk_fwd(Params p) {
    extern __shared__ __attribute__((aligned(16))) unsigned char lds_raw[];
    Frame F0;
    F0.lds = (LAS unsigned char*)lds_raw; F0.ws = p.ws; F0.in = p.in; F0.out = p.out;
    F0.tid = threadIdx.x; F0.lane = F0.tid & 63; F0.wave = __builtin_amdgcn_readfirstlane(F0.tid >> 6); F0.bx = blockIdx.x; F0.G = gridDim.x;
    volatile LAS unsigned* MISC = (volatile LAS unsigned*)(F0.lds + MISC_OFF);
    if (F0.tid < 64) MISC[F0.tid] = 0u;
    __syncthreads();
    const int lo = p.ph_lo, hi = p.ph_hi;
    XcdBarrier bar; bar.bar = (unsigned*)(F0.ws + WS_CTL) + CW_BAR; bar.x = 0; bar.st = MISC + 8;
    if (hi - lo > 1) bar = xcd_barrier_post((unsigned*)(F0.ws + WS_CTL) + CW_BAR, MISC + 8);
#ifndef MK_SITE
#define MK_SITE -1
#endif
#define SITE(n) (MK_SITE < 0 || MK_SITE == (n))
#ifndef MK_REP_MASK
#define MK_REP_MASK 0
#endif
#define NREP(n) (((MK_REP_MASK >> (n)) & 1) ? 2 : 1)
#define RUN(k) (lo <= (k) && (k) < hi)
#define SEAM(k) do { if (RUN(k) && RUN((k) + 1)) { TSEC_BEGIN(300, F0.lds); xcd_barrier(bar); TSEC_END(300, F0.lds); } } while (0)
    int ph = 0;
    if (SITE(0) && RUN(ph)) TSEC_BEGIN(400 + 0, F0.lds); if (SITE(0) && RUN(ph)) for (int rep_ = 0; rep_ < NREP(0); ++rep_) { const Frame F = phase_frame(F0); ph_pre(F); }
    TSEC_END(400 + 99, F0.lds); SEAM(ph); ++ph;
    for (int l = 0; l < 2; ++l) {
        const int ntok = (l == 0) ? NTOK : NLAT, nM = ntok / 256;
        if (SITE(1) && RUN(ph)) TSEC_BEGIN(400 + 1, F0.lds); if (SITE(1) && RUN(ph)) for (int rep_ = 0; rep_ < NREP(1); ++rep_) { const Frame F = phase_frame(F0); ph_convert(F, l); __syncthreads(); if (l == 0) ph_norm1(F, l); }
        TSEC_END(400 + 99, F0.lds); SEAM(ph); ++ph;
        if (SITE(2) && RUN(ph)) TSEC_BEGIN(400 + 2, F0.lds); if (SITE(2) && RUN(ph)) for (int rep_ = 0; rep_ < NREP(2); ++rep_) { const Frame F = phase_frame(F0);
            SchedPlain S{(const char*)(F.ws + WS_HX), (const char*)(F.ws + W_IN), 2048u, 2048u, 16, NTOK / 256, INCP / 256, F.G, F.bx};
            EpiWin E{(bf16_t*)(F.ws + WS_PX), (float*)(F.ws + T_GATE)};
            gg::gemm_phase(F.lds, S, E);
        }
        TSEC_END(400 + 99, F0.lds); SEAM(ph); ++ph;
        if (SITE(3) && RUN(ph)) TSEC_BEGIN(400 + 3, F0.lds); if (SITE(3) && RUN(ph)) for (int rep_ = 0; rep_ < NREP(3); ++rep_) { const Frame F = phase_frame(F0);
            for (int r2 = 0; r2 < NREP(16); ++r2) mla_prep(F, l);
            for (int r2 = 0; r2 < NREP(17); ++r2) { P1Regs R = ml_pass1_load(F, F.bx);
                for (int u = F.bx; u < 64 * NCHK; u += F.G) { const P1Regs Rn = ml_pass1_load(F, (u + F.G < 64 * NCHK) ? u + F.G : u); ml_pass1_unit(F, l, u, R); R = Rn; } }
            for (int r2 = 0; r2 < NREP(18); ++r2) { PoolRegs R = pool_load(F, F.bx);
                for (int u = F.bx; u < ntok / 64; u += F.G) { const PoolRegs Rn = pool_load(F, (u + F.G < ntok / 64) ? u + F.G : u); pool_unit(F, l, u, R); R = Rn; } }
            for (int r2 = 0; r2 < NREP(19); ++r2) conv_all(F, l, ntok);
            __syncthreads();
        }
        TSEC_END(400 + 99, F0.lds); SEAM(ph); ++ph;
        if (SITE(4) && RUN(ph)) TSEC_BEGIN(400 + 4, F0.lds); if (SITE(4) && RUN(ph)) for (int rep_ = 0; rep_ < NREP(4); ++rep_) { const Frame F = phase_frame(F0);
            ml_pass2(F);
            float gq = 0.f, gk = 0.f; for (int d = 0; d < 96; ++d) { gq = fmaxf(gq, fabsf(F.in[I_GQN][l * 96 + d])); gk = fmaxf(gk, fabsf(F.in[I_GKN][l * 96 + d])); }
            const bool nomax = (14.2f * gq * gk <= 64.0f);
            const int nunits = 1024 + (l == 0 ? 32 : 0);
#define ATT_UNITS(NM) for (int i = 0; ; ++i) { const int L = i * F.G + F.bx; if (L >= nunits) break; \
                if (L < 1024) { const int bh = (L >> 8) * 8 + (L & 7), qb = (L & 255) >> 3, b = bh >> 2; att2::unit<NM>(F, bh, b * 8192 + qb * 256, b * 8192 + qb * 256, 132); } \
                else { const int bh = L - 1024, b = bh >> 2; att2::unit<NM>(F, bh, NLAT + b * 256, NLAT + b * 256, 4); } }
            if (nomax) { ATT_UNITS(true) } else { ATT_UNITS(false) }
#undef ATT_UNITS
        }
        TSEC_END(400 + 99, F0.lds); SEAM(ph); ++ph;
        if (SITE(5) && RUN(ph)) TSEC_BEGIN(400 + 5, F0.lds); if (SITE(5) && RUN(ph)) for (int rep_ = 0; rep_ < NREP(5); ++rep_) { const Frame F = phase_frame(F0);
            const int npc = (l == 0) ? 66 : 64, nun = 32 * npc;
            for (int u = F.bx; u < nun; u += F.G) { const int bh = u / npc, pc = u % npc + (l == 0 ? 0 : 2); ml_pass3_unit(F, l, bh >> 2, bh & 3, pc); }
            __syncthreads();
        }
        TSEC_END(400 + 99, F0.lds); SEAM(ph); ++ph;
        {
            const int nMh = nM, pm0 = 0;
            if (SITE(6) && RUN(ph)) TSEC_BEGIN(400 + 6, F0.lds); if (SITE(6) && RUN(ph)) for (int rep_ = 0; rep_ < NREP(6); ++rep_) { const Frame F = phase_frame(F0);
                SchedYB S{(const char*)(F.ws + WS_YC), (const char*)(F.ws + W_BR), pm0, nMh, F.G, F.bx};
                EpiF8Out E{F.ws + WS_YB, 4096};
                gg::gemm_phase(F.lds, S, E);
            }
            TSEC_END(400 + 99, F0.lds); SEAM(ph); ++ph;
            if (SITE(13) && RUN(ph)) TSEC_BEGIN(400 + 13, F0.lds); if (SITE(13) && RUN(ph)) for (int rep_ = 0; rep_ < NREP(13); ++rep_) { const Frame F = phase_frame(F0);
                SchedPlain S{(const char*)(F.ws + WS_HX8) + (size_t)pm0 * 256 * 1024, (const char*)(F.ws + W_GATE), 1024u, 1024u, 8, nMh, 16, F.G, F.bx};
                EpiMerge2 E{(const unsigned char*)(F.ws + WS_YB), F.in[I_BGATE] + l * 4096, F.ws + WS_ACCM + (size_t)pm0 * 256 * 1024, 0};
                gg::gemm_phase(F.lds, S, E);
            }
            TSEC_END(400 + 99, F0.lds); SEAM(ph); ++ph;
        }
        if (SITE(7) && RUN(ph)) TSEC_BEGIN(400 + 7, F0.lds); if (SITE(7) && RUN(ph)) for (int rep_ = 0; rep_ < NREP(7); ++rep_) { const Frame F = phase_frame(F0);
            SchedPlain S{(const char*)(F.ws + WS_ACCM), (const char*)(F.ws + W_OUT), 1024u, 1024u, 8, nM, 4, F.G, F.bx};
            EpiWout E{(bf16_t*)(F.ws + WS_YC), modp(F, l, 0, 2)};
            gg::gemm_phase(F.lds, S, E);
        }
        TSEC_END(400 + 99, F0.lds); SEAM(ph); ++ph;
        if (SITE(8) && RUN(ph)) TSEC_BEGIN(400 + 8, F0.lds); if (SITE(8) && RUN(ph)) for (int rep_ = 0; rep_ < NREP(8); ++rep_) { const Frame F = phase_frame(F0); ph_norm2_route(F, l, ntok); }
        TSEC_END(400 + 99, F0.lds); SEAM(ph); ++ph;
        if (SITE(9) && RUN(ph)) TSEC_BEGIN(400 + 9, F0.lds); if (SITE(9) && RUN(ph)) for (int rep_ = 0; rep_ < NREP(9); ++rep_) { const Frame F = phase_frame(F0); ph_assign(F, ntok); }
        TSEC_END(400 + 99, F0.lds); SEAM(ph); ++ph;
        if (SITE(10) && RUN(ph)) TSEC_BEGIN(400 + 10, F0.lds); if (SITE(10) && RUN(ph)) for (int rep_ = 0; rep_ < NREP(10); ++rep_) { const Frame F = phase_frame(F0);
            int* tile_e = (int*)(F.ws + T_TILEE); const int ntiles = ld_i32_uniform(tile_e + 2047);
            LAS int* tab = (LAS int*)(F.lds + MOE_TAB_OFF); const int* rtok = (const int*)(F.ws + T_RTOK);
            __syncthreads();
            for (int i = 0; i < 28; ++i) { const int L = i * F.G + F.bx; if (L >= ntiles * 2) break; const int tile = L >> 1;
                if (F.tid == 0) tab[i] = tile_e[tile]; if (F.tid < 256) tab[256 + i * 256 + F.tid] = rtok[tile * 256 + F.tid]; }
            __syncthreads();
            SchedMoe1 S{(const char*)(F.ws + WS_HX8), (const char*)(F.ws + W_13), tab, ntiles, F.G, F.bx};
            EpiMoe1 E{(bf16_t*)(F.ws + WS_AMOE), (const float*)(F.ws + T_RW)};
            gg::gemm_phase(F.lds, S, E);
        }
        TSEC_END(400 + 99, F0.lds); SEAM(ph); ++ph;
        if (SITE(11) && RUN(ph)) TSEC_BEGIN(400 + 11, F0.lds); if (SITE(11) && RUN(ph)) for (int rep_ = 0; rep_ < NREP(11); ++rep_) { const Frame F = phase_frame(F0);
            int* tile_e = (int*)(F.ws + T_TILEE); const int ntiles = ld_i32_uniform(tile_e + 2047);
            LAS int* tab = (LAS int*)(F.lds + MOE_TAB_OFF);
            __syncthreads();
            for (int i = F.tid; i < 64; i += NTHR) { const int L = i * F.G + F.bx; if (L < ntiles * 4) tab[i] = tile_e[L >> 2]; }
            __syncthreads();
            SchedMoe2 S{(const char*)(F.ws + WS_AMOE), (const char*)(F.ws + W_2), tab, ntiles, F.G, F.bx};
            EpiF8Out E{(unsigned char*)(F.ws + WS_YS), 1024};
            gg::gemm_phase(F.lds, S, E);
        }
        TSEC_END(400 + 99, F0.lds); SEAM(ph); ++ph;
        if (SITE(12) && RUN(ph)) TSEC_BEGIN(400 + 12, F0.lds); if (SITE(12) && RUN(ph)) for (int rep_ = 0; rep_ < NREP(12); ++rep_) { const Frame F = phase_frame(F0); if (l == 0) ph_combine<true>(F, l, 0, ntok); else ph_combine<false>(F, l, 0, ntok); }
        TSEC_END(400 + 99, F0.lds); SEAM(ph); ++ph;
    }
    if (MK_TSEC >= 0 && blockIdx.x == 0 && threadIdx.x == 0) { volatile LAS unsigned long long* q_ = (volatile LAS unsigned long long*)(F0.lds + MISC_OFF + 128);
        const unsigned long long t0 = __builtin_amdgcn_s_memrealtime(), d = q_[0] * 4ull; while (__builtin_amdgcn_s_memrealtime() - t0 < d) __builtin_amdgcn_s_sleep(8); }
#undef RUN
#undef SEAM
}

extern "C" void kernel_launch(void* const* d_in, const int* in_sizes, int n_in, void* d_out, int out_size, void* d_ws, size_t ws_size, hipStream_t stream) {
    static int grid = 0;
    if (grid == 0) {
        if (n_in != 33 || out_size != NLAT * DM || ws_size < WS_END) { fprintf(stderr, "kernel_launch: unexpected shapes (n_in %d, out %d, ws %zu < %zu)\n", n_in, out_size, ws_size, (size_t)WS_END); grid = -1; return; }
        int dev = 0, cus = 0;
        if (hipGetDevice(&dev) != hipSuccess || hipDeviceGetAttribute(&cus, hipDeviceAttributeMultiprocessorCount, dev) != hipSuccess) { grid = -1; return; }
        if (hipFuncSetAttribute((const void*)mk_fwd, hipFuncAttributeMaxDynamicSharedMemorySize, LDS_BYTES) != hipSuccess) { fprintf(stderr, "kernel_launch: hipFuncSetAttribute failed\n"); grid = -1; return; }
        int per_cu = 0;
        if (hipOccupancyMaxActiveBlocksPerMultiprocessor(&per_cu, (const void*)mk_fwd, NTHR, LDS_BYTES) != hipSuccess || per_cu < 1) fprintf(stderr, "kernel_launch: occupancy query says %d\n", per_cu);
        (void)hipGetLastError();
        if (cus < 256) { fprintf(stderr, "kernel_launch: built for a 256-CU device (got %d CUs)\n", cus); grid = -1; return; }
        grid = 256;
    }
    if (grid < 0) return;
    (void)hipMemsetAsync((char*)d_ws + WS_CTL, 0, CTL_ZERO_BYTES, stream);
    Params p{};
    for (int i = 0; i < 33; ++i) p.in[i] = (const float*)d_in[i];
    p.out = (float*)d_out; p.ws = (unsigned char*)d_ws;
#if MK_ONE_LAUNCH
    p.ph_lo = 0; p.ph_hi = PH_TOTAL;
    hipLaunchKernelGGL(mk_fwd, dim3(grid), dim3(NTHR), LDS_BYTES, stream, p);
#else
    for (int k = 0; k < PH_TOTAL; ++k) { p.ph_lo = k; p.ph_hi = k + 1; hipLaunchKernelGGL(mk_fwd, dim3(grid), dim3(NTHR), LDS_BYTES, stream, p); }
#endif
}
```

```cpp
#include <hip/hip_runtime.h>
#include <stdint.h>
#include <stdio.h>
#include <math.h>

#ifndef MK_ONE_LAUNCH
#define MK_ONE_LAUNCH 1
#endif

#define LAS __attribute__((address_space(3)))
#define GAS __attribute__((address_space(1)))
typedef unsigned short bf16_t;
typedef short bf16x8 __attribute__((ext_vector_type(8)));
typedef short s16x4 __attribute__((ext_vector_type(4)));
typedef float f32x2 __attribute__((ext_vector_type(2)));
typedef float f32x4 __attribute__((ext_vector_type(4)));
typedef float f32x16 __attribute__((ext_vector_type(16)));
typedef unsigned u32x2 __attribute__((ext_vector_type(2)));
typedef unsigned u32x4 __attribute__((ext_vector_type(4)));

constexpr int DM = 1024, NB = 8, SEQ = 8192, CTXL = 256, GRIDW = 64;
constexpr int NLAT = NB * SEQ, NCTX = NB * CTXL, NTOK = NLAT + NCTX;
constexpr int INC = 2480, INCP = 2560;
constexpr int C_ML = 0, C_G = 1024, C_MLA = 1040, C_POOL = 1456, C_CONV = 1712;
constexpr int NE = 64, NE1 = 65, TOPK = 6, NSLOT7 = 7, EFF = 256;
constexpr int NCHK = 66;
constexpr int NKT = 132;
constexpr float EPS = 1e-6f;
constexpr int NWAVES = 8, NTHR = 512;
constexpr int MOE_ROWS_MAX = 489472;
constexpr int MOE_TILES_MAX = MOE_ROWS_MAX / 256;

constexpr size_t MiB = 1u << 20;
constexpr size_t WS_CTL = 0, CTL_ZERO_BYTES = 1 * MiB;
constexpr size_t WS_MOD = 128 * 1024;
constexpr size_t WS_TAB = 1 * MiB;
constexpr size_t T_ROPE = WS_TAB;
constexpr size_t T_HIST = T_ROPE + 16384;
constexpr size_t T_TILEE = T_HIST + 65536;
constexpr size_t T_EIDX = T_TILEE + 8192;
constexpr size_t T_EW = T_EIDX + (size_t)NTOK * 6 * 4;
constexpr size_t T_SLOT = T_EW + (size_t)NTOK * 6 * 4;
constexpr size_t T_RTOK = T_SLOT + (size_t)NTOK * 8 * 4;
constexpr size_t T_RW = T_RTOK + (size_t)MOE_ROWS_MAX * 4;
constexpr size_t T_GATE = T_RW + (size_t)MOE_ROWS_MAX * 4;
constexpr size_t T_DN = T_GATE + (size_t)NTOK * 16 * 4;
constexpr size_t T_NST = T_DN + (size_t)4224 * 64 * 4;
constexpr size_t T_MLOC = T_NST + (size_t)4224 * 64 * 4;
constexpr size_t T_BEND = T_MLOC + 4224 * 4;
constexpr size_t T_MST = T_BEND + 4224 * 4;
constexpr size_t T_END = T_MST + 4224 * 4;
static_assert(T_END <= 17 * MiB, "tables");
constexpr size_t WS_WB = 17 * MiB;
constexpr size_t W_IN = WS_WB;
constexpr size_t W_GATE = W_IN + (size_t)INCP * 1024 * 2;
constexpr size_t W_BR = W_GATE + (size_t)4 * 1024 * 1024 * 2;
constexpr size_t W_OUT = W_BR + (size_t)4 * 1024 * 256 * 2;
constexpr size_t W_13 = W_OUT + (size_t)1024 * 1024 * 2;
constexpr size_t W_2 = W_13 + (size_t)NE1 * 512 * 1024 * 2;
constexpr size_t W_UQ = W_2 + (size_t)NE1 * 1024 * 256 * 2;
constexpr size_t W_UKV = W_UQ + (size_t)384 * 256 * 2;
constexpr size_t W_POOL = W_UKV + (size_t)512 * 128 * 2;
constexpr size_t W_RT = W_POOL + (size_t)4 * 64 * 64 * 2;
constexpr size_t W_END = W_RT + (size_t)64 * 1024 * 2;
static_assert(W_END <= 133 * MiB, "weights");
constexpr size_t WS_CTXS = 133 * MiB;
constexpr size_t WS_HX = 141 * MiB;
constexpr size_t WS_PX = 273 * MiB;
constexpr size_t WS_QB = 593 * MiB;
constexpr size_t WS_KT = 643 * MiB;
constexpr size_t WS_VT = 693 * MiB;
constexpr size_t WS_YC = 726 * MiB;
constexpr size_t WS_DC = 858 * MiB;
constexpr size_t WS_CST = 924 * MiB;
constexpr size_t WS_HX8 = 957 * MiB;
constexpr size_t WS_END = 1023 * MiB;
constexpr size_t WS_ACCM = WS_QB;
constexpr size_t WS_YB = WS_PX;
constexpr size_t WS_AMOE = WS_HX;
constexpr size_t WS_YS = WS_HX + 240 * MiB;
static_assert(WS_AMOE + (size_t)MOE_ROWS_MAX * 512 <= WS_YS && WS_YS + (size_t)MOE_ROWS_MAX * 1024 <= WS_HX8, "moe overlay");
static_assert(WS_YB + (size_t)NTOK * 4096 <= WS_QB && WS_ACCM + (size_t)NTOK * 2048 <= WS_YC, "merge overlay");

constexpr int CW_BAR = 4096;

constexpr int RING_BYTES = 131072;
constexpr int MISC_OFF = 160 * 1024 - 256;
constexpr int LDS_BYTES = 160 * 1024;

#ifndef MK_TSEC
#define MK_TSEC -1
#endif
#define TSEC_BEGIN(id, ldsb) do { if (MK_TSEC == (id) && blockIdx.x == 0 && threadIdx.x == 0) { volatile LAS unsigned long long* q_ = (volatile LAS unsigned long long*)((ldsb) + MISC_OFF + 128); q_[1] = __builtin_amdgcn_s_memrealtime(); } } while (0)
#define TSEC_END(id, ldsb) do { if ((MK_TSEC == (id) || ((id) == 499 && MK_TSEC >= 400 && MK_TSEC < 499)) && blockIdx.x == 0 && threadIdx.x == 0) { volatile LAS unsigned long long* q_ = (volatile LAS unsigned long long*)((ldsb) + MISC_OFF + 128); if (q_[1] != 0ull) { q_[0] += __builtin_amdgcn_s_memrealtime() - q_[1]; q_[1] = 0ull; } } } while (0)
typedef __bf16 bf16x2_t_ __attribute__((ext_vector_type(2)));
__device__ __forceinline__ unsigned pk2(float lo, float hi) { const f32x2 v = {lo, hi}; return __builtin_bit_cast(unsigned, __builtin_convertvector(v, bf16x2_t_)); }
__device__ __forceinline__ unsigned f2bf(float f) { return pk2(f, f) & 0xffffu; }
__device__ __forceinline__ float bf2f(unsigned short b) { return __builtin_bit_cast(float, ((unsigned)b) << 16); }
__device__ __forceinline__ float bflo(unsigned w) { return __builtin_bit_cast(float, w << 16); }
__device__ __forceinline__ float bfhi(unsigned w) { return __builtin_bit_cast(float, w & 0xffff0000u); }
__device__ __forceinline__ unsigned cvt_pk_bf16(float lo, float hi) { unsigned r; asm volatile("v_cvt_pk_bf16_f32 %0, %1, %2" : "=v"(r) : "v"(lo), "v"(hi)); return r; }
__device__ __forceinline__ unsigned pk4_fp8(float a, float b, float c, float d) { int r = __builtin_amdgcn_cvt_pk_fp8_f32(a, b, 0, false); r = __builtin_amdgcn_cvt_pk_fp8_f32(c, d, r, true); return (unsigned)r; }
__device__ __forceinline__ float sigmoidf_(float x) { return __builtin_amdgcn_rcpf(1.0f + __builtin_amdgcn_exp2f(x * -1.4426950408889634f)); }
template <int O> __device__ __forceinline__ float xor_lane(float v) { return __builtin_bit_cast(float, __builtin_amdgcn_ds_swizzle(__builtin_bit_cast(int, v), 0x1f | (O << 10))); }
__device__ __forceinline__ float half_sum(float v) { v += xor_lane<1>(v); v += xor_lane<2>(v); v += xor_lane<4>(v); v += xor_lane<8>(v); v += xor_lane<16>(v); return v; }
__device__ __forceinline__ float half_max(float v) { v = fmaxf(v, xor_lane<1>(v)); v = fmaxf(v, xor_lane<2>(v)); v = fmaxf(v, xor_lane<4>(v)); v = fmaxf(v, xor_lane<8>(v)); v = fmaxf(v, xor_lane<16>(v)); return v; }
__device__ __forceinline__ float wave_sum(float v) { v = half_sum(v); auto rr = __builtin_amdgcn_permlane32_swap(__builtin_bit_cast(unsigned, v), __builtin_bit_cast(unsigned, v), false, false);
    return __builtin_bit_cast(float, (unsigned)rr[0]) + __builtin_bit_cast(float, (unsigned)rr[1]); }
__device__ __forceinline__ float wave_max(float v) { v = half_max(v); auto rr = __builtin_amdgcn_permlane32_swap(__builtin_bit_cast(unsigned, v), __builtin_bit_cast(unsigned, v), false, false);
    return fmaxf(__builtin_bit_cast(float, (unsigned)rr[0]), __builtin_bit_cast(float, (unsigned)rr[1])); }
__device__ __forceinline__ float lane_up(float v, int o, int lane) { return __builtin_bit_cast(float, __builtin_amdgcn_ds_bpermute(((lane - o) & 63) << 2, __builtin_bit_cast(int, v))); }
__device__ __forceinline__ float lane_bcast(float v, int src) { return __builtin_bit_cast(float, __builtin_amdgcn_readlane(__builtin_bit_cast(int, v), src)); }
__device__ __forceinline__ float frcp(float x) { return __builtin_amdgcn_rcpf(x); }
__device__ __forceinline__ float frsq(float x) { return __builtin_amdgcn_rsqf(x); }
#define LDS_WAIT() asm volatile("s_waitcnt lgkmcnt(0)" ::: "memory")
#define LDS_BAR() asm volatile("s_waitcnt lgkmcnt(0)\n\ts_barrier" ::: "memory")
#define VM_WAIT() asm volatile("s_waitcnt vmcnt(0)" ::: "memory")

#define XB_TMO      128
#define XB_XCNT(j)  (256  + 64 * (j))
#define XB_XSUB(j)  (1280 + 64 * (j))
#define XB_XGEN(j)  (2304 + 64 * (j))
#define XB_TOP      3328
#define XB_TOPGEN   3392
#define XCD_BAR_WORDS 3456
#define XB_SPIN_CAP (1u << 22)

__device__ __forceinline__ unsigned xb_ld(unsigned* p)              { return __hip_atomic_load(p, __ATOMIC_RELAXED, __HIP_MEMORY_SCOPE_AGENT); }
__device__ __forceinline__ unsigned xb_add(unsigned* p, unsigned v) { return __hip_atomic_fetch_add(p, v, __ATOMIC_RELAXED, __HIP_MEMORY_SCOPE_AGENT); }
__device__ __forceinline__ unsigned xb_xcc_id() { return (unsigned)__builtin_amdgcn_s_getreg((3 << 11) | 20) & 0xFu; }
#define XB_SPIN(cond, bar) do { unsigned _sp = 0; while (cond) { __builtin_amdgcn_s_sleep(1); \
    if ((++_sp & 255u) == 0u) { if (xb_ld(&(bar)[XB_TMO])) break; if (_sp > XB_SPIN_CAP) { atomicAdd(&(bar)[XB_TMO], 1u); break; } } } } while (0)

struct XcdBarrier { unsigned* bar; unsigned x; volatile LAS unsigned* st; };

__device__ __forceinline__ XcdBarrier xcd_barrier_post(unsigned* bar, volatile LAS unsigned* st) {
    XcdBarrier b; b.bar = bar; b.x = xb_xcc_id(); b.st = st;
    if (threadIdx.x == 0) (void)xb_add(&bar[XB_XCNT(b.x)], 1u);
    return b;
}
__device__ __forceinline__ void xcd_barrier_complete(unsigned* bar, unsigned x, unsigned& nloc, unsigned& nx) {
    const unsigned G = gridDim.x * gridDim.y * gridDim.z;
    unsigned sum, cnt, mine, sp = 0u;
    for (;;) {
        sum = 0u; cnt = 0u; mine = 0u;
#pragma unroll
        for (unsigned j = 0; j < 16; ++j) { const unsigned c = xb_ld(&bar[XB_XCNT(j)]); sum += c; cnt += (c > 0u) ? 1u : 0u; mine = (j == x) ? c : mine; }
        if (sum == G) break;
        __builtin_amdgcn_s_sleep(1);
        if ((++sp & 255u) == 0u) { if (xb_ld(&bar[XB_TMO])) break; if (sp > XB_SPIN_CAP) { atomicAdd(&bar[XB_TMO], 1u); break; } }
    }
    nloc = mine > 0u ? mine : 1u; nx = cnt > 0u ? cnt : 1u;
}
__device__ __forceinline__ void xcd_barrier(const XcdBarrier& b) {
    asm volatile("s_waitcnt vmcnt(0)" ::: "memory");
    __syncthreads();
    if (threadIdx.x == 0) {
        unsigned* bar = b.bar;
        __builtin_amdgcn_s_waitcnt(0);
        unsigned nloc = b.st[0], nx = b.st[1];
        if (nloc == 0u) { xcd_barrier_complete(bar, b.x, nloc, nx); b.st[0] = nloc; b.st[1] = nx; }
        const unsigned old = xb_add(&bar[XB_XSUB(b.x)], 1u);
        const unsigned gen = old / nloc;
        if (old + 1u == (gen + 1u) * nloc) {
            __builtin_amdgcn_fence(__ATOMIC_RELEASE, "agent");
            asm volatile("s_waitcnt vmcnt(0)" ::: "memory");
            const unsigned og = xb_add(&bar[XB_TOP], 1u);
            const unsigned tg = og / nx;
            if (og + 1u == (tg + 1u) * nx) xb_add(&bar[XB_TOPGEN], 1u);
            else XB_SPIN(xb_ld(&bar[XB_TOPGEN]) == tg, bar);
            __builtin_amdgcn_fence(__ATOMIC_ACQUIRE, "agent");
            xb_add(&bar[XB_XGEN(b.x)], 1u);
            asm volatile("s_waitcnt vmcnt(0)" ::: "memory");
        } else {
            XB_SPIN(xb_ld(&bar[XB_XGEN(b.x)]) == gen, bar);
            __builtin_amdgcn_fence(__ATOMIC_ACQUIRE, "agent");
            asm volatile("s_waitcnt vmcnt(0)" ::: "memory");
        }
    }
    __syncthreads();
}

struct Params { const float* in[33]; float* out; unsigned char* ws; int ph_lo, ph_hi; };

struct Frame {
    LAS unsigned char* lds;
    unsigned char* ws;
    const float* const* in;
    float* out;
    int tid, lane, wave, bx, G;
};
enum { I_X = 0, I_C, I_CTX, I_CCTX, I_WMOD, I_BMOD, I_GMIX, I_GFFN, I_WIN, I_MLGB, I_MLHG, I_GCQ, I_GCKV, I_WUQ, I_WUKV, I_GQN, I_GKN, I_POOLW, I_POOLS,
       I_CONVW, I_CONVB, I_WGATE, I_BGATE, I_WBR, I_WOUT, I_WRT, I_BRT, I_W1, I_W3, I_W2, I_WS1, I_WS3, I_WS2 };

__device__ __forceinline__ const float* modp(const Frame& F, int l, int r, int which) { return (const float*)(F.ws + WS_MOD) + ((size_t)(l * 9 + r)) * 6144 + which * 1024; }
__device__ __forceinline__ int mod_row_of(int row) { return row < NLAT ? (row >> 13) : 8; }

__device__ __forceinline__ f32x4 up4_fp8(unsigned w) { const f32x2 lo = __builtin_amdgcn_cvt_pk_f32_fp8((int)w, false), hi = __builtin_amdgcn_cvt_pk_f32_fp8((int)w, true); return (f32x4){lo.x, lo.y, hi.x, hi.y}; }
namespace gg {
typedef int v4i_t __attribute__((ext_vector_type(4)));
constexpr int BM = 256, BK = 64, HALF = 128, HTB = HALF * BK * 2, STAGE_BYTES = 8 * HTB;
__device__ __forceinline__ int lds_byte(int r, int c) { const int st = (r >> 4) * 2 + (c >> 5), rr = r & 15, cc = c & 31, ob = rr * 64 + cc * 2; return st * 1024 + (ob ^ (((ob >> 9) & 1) << 5)); }
__device__ __forceinline__ void stage_rc(int b, int& R, int& C) { const int st = b / 1024, sb = b % 1024, swz = sb ^ (((sb >> 9) & 1) << 5); R = (st >> 1) * 16 + swz / 64; C = (st & 1) * 32 + (swz % 64) / 2; }
__device__ __forceinline__ int perm32(int rho) { const int n = rho >> 4, i = rho & 15; return 8 * (i >> 2) + 4 * n + (i & 3); }

struct Unit {
    const char* A; const char* B;
    unsigned lda, ldb;
    int nt;
    int ridx_off;
    int p0, p1, p2;
};

template <class E, class = void> struct ZPeel { static constexpr bool v = false; };
template <class E> struct ZPeel<E, decltype((void)E::ZPEEL)> { static constexpr bool v = E::ZPEEL; };
template <class Epi, class Sched>
__device__ __forceinline__ void gemm_phase(LAS unsigned char* lds, const Sched& S, const Epi& E) {
    int tid_ = threadIdx.x; asm volatile("" : "+v"(tid_));
    const int tid = tid_, wid = __builtin_amdgcn_readfirstlane(tid >> 6), lane = tid & 63, wr = wid >> 2, wc = wid & 3, fr = lane & 15, fq = lane >> 4;
    const size_t kstep = (size_t)(BK * 2);
    const unsigned ldsw = (unsigned)wid * 1024u;
    const int aoff = lds_byte(wr * 64 + fr, fq * 8), boff = lds_byte(wc * 32 + fr, fq * 8);
#define GG_SA(b, h) (((b) * 2 + (h)) * HTB)
#define GG_SB(b, h) ((4 + (b) * 2 + (h)) * HTB)
#define GG_STAGE(bufoff, gbase, v0, v1) do { \
        __builtin_amdgcn_global_load_lds((const unsigned*)((const char*)(gbase) + (v0)), (LAS unsigned*)(lds + (bufoff) + ldsw), 16, 0, 0); \
        __builtin_amdgcn_global_load_lds((const unsigned*)((const char*)(gbase) + (v1)), (LAS unsigned*)(lds + (bufoff) + ldsw + 8192), 16, 0, 0); } while (0)
#define GG_LDA(dst, b, h) do { _Pragma("unroll") for (int m = 0; m < 4; ++m) _Pragma("unroll") for (int k = 0; k < 2; ++k) dst[m][k] = *(const LAS bf16x8*)(lds + GG_SA(b, h) + aoff + m * 2048 + k * 1024); } while (0)
#define GG_LDB(dst, b, h) do { _Pragma("unroll") for (int n = 0; n < 2; ++n) _Pragma("unroll") for (int k = 0; k < 2; ++k) dst[n][k] = *(const LAS bf16x8*)(lds + GG_SB(b, h) + boff + n * 2048 + k * 1024); } while (0)
#define GG_MMA(ai, bj, At, Bt) do { __builtin_amdgcn_s_setprio(1); _Pragma("unroll") for (int m = 0; m < 4; ++m) _Pragma("unroll") for (int n = 0; n < 2; ++n) _Pragma("unroll") for (int k = 0; k < 2; ++k) \
        acc[ai][bj][m][n] = __builtin_amdgcn_mfma_f32_16x16x32_bf16(Bt[n][k], At[m][k], acc[ai][bj][m][n], 0, 0, 0); __builtin_amdgcn_s_setprio(0); } while (0)
#define GG_CAT8(x, y) __builtin_shufflevector(__builtin_bit_cast(v4i_t, x), __builtin_bit_cast(v4i_t, y), 0, 1, 2, 3, 4, 5, 6, 7)
#define GG_MMA8(ai, bj, At, Bt) do { __builtin_amdgcn_s_setprio(1); _Pragma("unroll") for (int m = 0; m < 4; ++m) _Pragma("unroll") for (int n = 0; n < 2; ++n) \
        acc[ai][bj][m][n] = __builtin_amdgcn_mfma_scale_f32_16x16x128_f8f6f4(GG_CAT8(Bt[n][0], Bt[n][1]), GG_CAT8(At[m][0], At[m][1]), acc[ai][bj][m][n], 0, 0, 0, (int)Epi::SCB, 0, 0x7f7f7f7f); __builtin_amdgcn_s_setprio(0); } while (0)
#define GG_MM(ai, bj, At, Bt) do { if constexpr (Epi::FP8) GG_MMA8(ai, bj, At, Bt); else GG_MMA(ai, bj, At, Bt); } while (0)
#define GG_MMZ8(ai, bj, At, Bt) do { __builtin_amdgcn_s_setprio(1); _Pragma("unroll") for (int m = 0; m < 4; ++m) _Pragma("unroll") for (int n = 0; n < 2; ++n) \
        acc[ai][bj][m][n] = __builtin_amdgcn_mfma_scale_f32_16x16x128_f8f6f4(GG_CAT8(Bt[n][0], Bt[n][1]), GG_CAT8(At[m][0], At[m][1]), (f32x4){0.f, 0.f, 0.f, 0.f}, 0, 0, 0, (int)Epi::SCB, 0, 0x7f7f7f7f); __builtin_amdgcn_s_setprio(0); } while (0)
#define GG_MM1(ai, bj, At, Bt) do { if constexpr (ZP && Epi::FP8) { if (t == 0) GG_MMZ8(ai, bj, At, Bt); else GG_MMA8(ai, bj, At, Bt); } else GG_MM(ai, bj, At, Bt); } while (0)
#define GG_WAIT_V(n) asm volatile("s_waitcnt vmcnt(" #n ")" ::: "memory")
#define GG_WAIT_L(n) asm volatile("s_waitcnt lgkmcnt(" #n ")" ::: "memory")
#define GG_BAR __builtin_amdgcn_s_barrier()
#define GG_SCHED __builtin_amdgcn_sched_barrier(0)
#define GG_OFFS(u) do { int R0_, C0_, R1_, C1_; stage_rc(tid * 16, R0_, C0_); stage_rc(tid * 16 + 8192, R1_, C1_); \
        if (Sched::GATHER) { const LAS int* rl_ = (const LAS int*)(lds + (u).ridx_off); vA0 = (unsigned)rl_[R0_] * (u).lda + C0_ * 2; vA1 = (unsigned)rl_[R1_] * (u).lda + C1_ * 2; \
                             vA2 = (unsigned)rl_[128 + R0_] * (u).lda + C0_ * 2; vA3 = (unsigned)rl_[128 + R1_] * (u).lda + C1_ * 2; hA = 0; } \
        else { vA0 = (unsigned)R0_ * (u).lda + C0_ * 2; vA1 = (unsigned)R1_ * (u).lda + C1_ * 2; vA2 = vA0; vA3 = vA1; hA = (size_t)128 * (u).lda; } \
        const int Rb0_ = Epi::PERM ? ((R0_ & ~31) + perm32(R0_ & 31)) : R0_, Rb1_ = Epi::PERM ? ((R1_ & ~31) + perm32(R1_ & 31)) : R1_; \
        vB0 = (unsigned)Rb0_ * (u).ldb + C0_ * 2; vB1 = (unsigned)Rb1_ * (u).ldb + C1_ * 2; hB = (size_t)128 * (u).ldb; } while (0)
    Unit cur, nxt; int ui = 0;
    if (!S.next(0, cur)) return;
    constexpr bool ZP = ZPeel<Epi>::v;
    f32x4 acc[2][2][4][2];
    if constexpr (!ZP) {
#pragma unroll
    for (int a = 0; a < 2; ++a)
#pragma unroll
        for (int b = 0; b < 2; ++b)
#pragma unroll
            for (int m = 0; m < 4; ++m)
#pragma unroll
                for (int n = 0; n < 2; ++n) acc[a][b][m][n] = (f32x4){0.f, 0.f, 0.f, 0.f};
    }
    bf16x8 At[4][2], B0[2][2], B1[2][2];
    unsigned vA0, vA1, vA2, vA3, vB0, vB1; size_t hA, hB;
    GG_OFFS(cur);
    const char* cA = cur.A; const char* cB = cur.B;
    GG_STAGE(GG_SB(0, 0), cB, vB0, vB1); GG_STAGE(GG_SB(0, 1), cB + hB, vB0, vB1); GG_STAGE(GG_SA(0, 0), cA, vA0, vA1); GG_STAGE(GG_SA(0, 1), cA + hA, vA2, vA3);
    if (wr == 1) GG_BAR;
    GG_WAIT_V(2); GG_BAR;
    GG_STAGE(GG_SB(1, 0), cB + kstep, vB0, vB1); GG_STAGE(GG_SA(1, 0), cA + kstep, vA0, vA1); GG_STAGE(GG_SB(1, 1), cB + hB + kstep, vB0, vB1);
    GG_WAIT_V(6); GG_BAR;
    for (;;) {
        const bool has_next = S.next(ui + 1, nxt);
        TSEC_BEGIN(100 + Epi::TID, lds);
        int nt_ = cur.nt; asm volatile("" : "+s"(nt_)); const int nt = nt_;
#pragma unroll 1
        for (int t = 0; t < nt; t += 2) {
            const bool last = (t == nt - 2);
            const char* a1 = cA + (size_t)(t + 1) * kstep;
            GG_LDB(B0, 0, 0); GG_LDB(B1, 0, 1); GG_SCHED; GG_LDA(At, 0, 0); GG_STAGE(GG_SA(1, 1), a1 + hA, vA2, vA3);
            GG_WAIT_V(8); GG_WAIT_L(0); GG_BAR; GG_MM1(0, 0, At, B0); GG_MM1(0, 1, At, B1); GG_BAR; GG_SCHED;
            if (last) { if (has_next) { GG_OFFS(nxt); cA = nxt.A - (size_t)nt * kstep; cB = nxt.B - (size_t)nt * kstep; } else { cA -= (size_t)nt * kstep; cB -= (size_t)nt * kstep; } }
            const char* a2 = cA + (size_t)(t + 2) * kstep; const char* b2 = cB + (size_t)(t + 2) * kstep; const char* a3 = a2 + kstep; const char* b3 = b2 + kstep;
            GG_LDA(At, 0, 1); GG_STAGE(GG_SB(0, 0), b2, vB0, vB1); GG_STAGE(GG_SB(0, 1), b2 + hB, vB0, vB1); GG_STAGE(GG_SA(0, 0), a2, vA0, vA1);
            GG_WAIT_V(8); GG_WAIT_L(0); GG_BAR; GG_MM1(1, 0, At, B0); GG_MM1(1, 1, At, B1); GG_BAR; GG_SCHED;
            GG_LDB(B0, 1, 0); GG_LDB(B1, 1, 1); GG_SCHED; GG_LDA(At, 1, 0); GG_STAGE(GG_SA(0, 1), a2 + hA, vA2, vA3);
            GG_WAIT_V(8); GG_WAIT_L(0); GG_BAR; GG_MM(0, 0, At, B0); GG_MM(0, 1, At, B1); GG_BAR; GG_SCHED;
            GG_LDA(At, 1, 1); GG_STAGE(GG_SB(1, 0), b3, vB0, vB1); GG_STAGE(GG_SB(1, 1), b3 + hB, vB0, vB1); GG_STAGE(GG_SA(1, 0), a3, vA0, vA1);
            GG_WAIT_V(8); GG_WAIT_L(0); GG_BAR; GG_MM(1, 0, At, B0); GG_MM(1, 1, At, B1); GG_BAR; GG_SCHED;
        }
        cA += (size_t)nt * kstep; cB += (size_t)nt * kstep;
        TSEC_END(100 + Epi::TID, lds);
        if (wr == 0) GG_BAR;
        TSEC_BEGIN(200 + Epi::TID, lds); { int t2_ = threadIdx.x; asm volatile("" : "+v"(t2_)); E(acc, cur, wr, wc, t2_ & 15, (t2_ & 63) >> 4); } TSEC_END(200 + Epi::TID, lds);
        if (!has_next) break;
        if constexpr (!ZP)
#pragma unroll
        for (int a = 0; a < 2; ++a)
#pragma unroll
            for (int b = 0; b < 2; ++b)
#pragma unroll
                for (int m = 0; m < 4; ++m)
#pragma unroll
                    for (int n = 0; n < 2; ++n) acc[a][b][m][n] = (f32x4){0.f, 0.f, 0.f, 0.f};
        cur = nxt; ++ui;
        if (wr == 1) GG_BAR;
    }
    GG_WAIT_V(0);
    GG_BAR;
#undef GG_SA
#undef GG_SB
#undef GG_STAGE
#undef GG_LDA
#undef GG_LDB
#undef GG_MMA
#undef GG_MMA8
#undef GG_MM
#undef GG_MM1
#undef GG_MMZ8
#undef GG_CAT8
#undef GG_WAIT_V
#undef GG_WAIT_L
#undef GG_BAR
#undef GG_SCHED
#undef GG_OFFS
}
}

__device__ __forceinline__ int ld_i32_uniform(const int* p) { return __builtin_amdgcn_readfirstlane(__hip_atomic_load(p, __ATOMIC_RELAXED, __HIP_MEMORY_SCOPE_AGENT)); }
__device__ __forceinline__ void tile_order(int L, int nM, int nN, int& pm, int& pn) {
    const int nwg = nM * nN; int wgid = L;
    { const int q = nwg / 8, r = nwg % 8, xcd = wgid % 8, off = wgid / 8; wgid = (xcd < r ? xcd * (q + 1) : r * (q + 1) + (xcd - r) * q) + off; }
    const int nig = 8 * nN, gid = wgid / nig, fm = gid * 8, gsz = (nM - fm) < 8 ? (nM - fm) : 8;
    pm = fm + ((wgid % nig) % gsz); pn = (wgid % nig) / gsz;
}
struct SchedPlain {
    static constexpr bool GATHER = false;
    const char* A; const char* B; unsigned lda, ldb; int nt, nM, nN, G, c;
    __device__ __forceinline__ bool next(int i, gg::Unit& u) const {
        const int L = i * G + c; if (L >= nM * nN) return false;
        int pm, pn; tile_order(L, nM, nN, pm, pn);
        u.A = A + (size_t)pm * 256 * lda; u.B = B + (size_t)pn * 256 * ldb; u.lda = lda; u.ldb = ldb; u.nt = nt; u.ridx_off = 0; u.p0 = pm; u.p1 = pn; u.p2 = 0; return true;
    }
};
struct EpiWin {
    static constexpr bool PERM = true, FP8 = false; static constexpr int TID = 0; static constexpr unsigned SCB = 0x7f7f7f7fu;
    bf16_t* px; float* gate;
    __device__ __forceinline__ void operator()(const f32x4 (&acc)[2][2][4][2], const gg::Unit& u, int wr, int wc, int fr, int fq) const {
        const int row0 = u.p0 * 256 + wr * 64 + fr;
#pragma unroll
        for (int bj = 0; bj < 2; ++bj) {
            const int c0 = u.p1 * 256 + bj * 128 + wc * 32 + 8 * fq;
            if (c0 < INC) {
                const bool isg = (c0 >= C_G && c0 < C_MLA);
#pragma unroll
                for (int ai = 0; ai < 2; ++ai)
#pragma unroll
                    for (int m = 0; m < 4; ++m) { const int row = row0 + ai * 128 + m * 16; const f32x4 v0 = acc[ai][bj][m][0], v1 = acc[ai][bj][m][1];
                        u32x4 w; w.x = cvt_pk_bf16(v0[0], v0[1]); w.y = cvt_pk_bf16(v0[2], v0[3]); w.z = cvt_pk_bf16(v1[0], v1[1]); w.w = cvt_pk_bf16(v1[2], v1[3]);
                        *(u32x4*)(px + (size_t)row * INC + c0) = w;
                        if (isg) { float* gp = gate + (size_t)row * 16 + (c0 - C_G); *(f32x4*)gp = v0; *(f32x4*)(gp + 4) = v1; } }
            }
        }
    }
};
struct SchedYB {
    static constexpr bool GATHER = false;
    const char* yc; const char* wb; int pm0, nMh, G, c;
    __device__ __forceinline__ bool next(int i, gg::Unit& u) const {
        const int L = i * G + c; if (L >= nMh * 16) return false;
        int pm, q; tile_order(L, nMh, 16, pm, q); const int br = q >> 2, pn = q & 3;
        u.A = yc + (size_t)(pm0 + pm) * 256 * 2048 + br * 512; u.lda = 2048; u.B = wb + (size_t)br * (1024 * 512) + (size_t)pn * 256 * 512; u.ldb = 512; u.nt = 4; u.ridx_off = 0; u.p0 = pm; u.p1 = q; u.p2 = 0; return true;
    }
};
struct EpiMerge2 {
    static constexpr bool PERM = false, FP8 = true; static constexpr int TID = 4; static constexpr unsigned SCB = 0x79797979u;
    const unsigned char* yb; const float* bgate; unsigned char* accm; int pm0;
    __device__ __forceinline__ void operator()(const f32x4 (&acc)[2][2][4][2], const gg::Unit& u, int wr, int wc, int fr, int fq) const {
        const int c = u.p1 * 64 + 16 * wc + 4 * fq, r0 = wr * 64 + fr;
        f32x4 bv[2][2];
#pragma unroll
        for (int bj = 0; bj < 2; ++bj)
#pragma unroll
            for (int n = 0; n < 2; ++n) bv[bj][n] = *(const f32x4*)(bgate + (2 * bj + n) * 1024 + c);
#pragma unroll
        for (int ai = 0; ai < 2; ++ai) {
#pragma unroll
            for (int m = 0; m < 4; ++m) { const int rl = (u.p0 - pm0) * 256 + r0 + ai * 128 + m * 16; const unsigned char* yr = yb + (size_t)rl * 4096 + c;
                f32x4 t = {0.f, 0.f, 0.f, 0.f};
#pragma unroll
                for (int bj = 0; bj < 2; ++bj)
#pragma unroll
                    for (int n = 0; n < 2; ++n) { const f32x4 y = up4_fp8(*(const unsigned*)(yr + (2 * bj + n) * 1024)); const f32x4 g = acc[ai][bj][m][n] + bv[bj][n];
                        t[0] += sigmoidf_(g[0]) * y[0]; t[1] += sigmoidf_(g[1]) * y[1]; t[2] += sigmoidf_(g[2]) * y[2]; t[3] += sigmoidf_(g[3]) * y[3]; }
                *(unsigned*)(accm + (size_t)(u.p0 * 256 + r0 + ai * 128 + m * 16) * 1024 + c) = pk4_fp8(t[0], t[1], t[2], t[3]); } }
    }
};
struct EpiWout {
    static constexpr bool PERM = true, FP8 = true; static constexpr int TID = 1; static constexpr unsigned SCB = 0x79797979u;
    bf16_t* mrg; const float* gt;
    __device__ __forceinline__ void operator()(const f32x4 (&acc)[2][2][4][2], const gg::Unit& u, int wr, int wc, int fr, int fq) const {
        const int pm = u.p0; const int mrow = pm >= 256 ? 8 : (pm >> 5);
        const float* g = gt + (size_t)mrow * 6144;
        const int row0 = pm * 256 + wr * 64 + fr, col0 = u.p1 * 256 + wc * 32 + 8 * fq;
#pragma unroll
        for (int bj = 0; bj < 2; ++bj) { const f32x4 g0 = *(const f32x4*)(g + col0 + bj * 128), g1 = *(const f32x4*)(g + col0 + bj * 128 + 4);
#pragma unroll
            for (int ai = 0; ai < 2; ++ai)
#pragma unroll
                for (int m = 0; m < 4; ++m) { const f32x4 v0 = acc[ai][bj][m][0] * g0, v1 = acc[ai][bj][m][1] * g1;
                    u32x4 w; w.x = cvt_pk_bf16(v0[0], v0[1]); w.y = cvt_pk_bf16(v0[2], v0[3]); w.z = cvt_pk_bf16(v1[0], v1[1]); w.w = cvt_pk_bf16(v1[2], v1[3]);
                    *(u32x4*)(mrg + (size_t)(row0 + ai * 128 + m * 16) * 1024 + col0 + bj * 128) = w; } }
    }
};
constexpr int MOE_TAB_OFF = RING_BYTES, MOE_RIDX_OFF = RING_BYTES + 1024;
struct SchedMoe1 {
    static constexpr bool GATHER = true;
    const char* hx2; const char* w13; const LAS int* tab; int ntiles, G, c;
    __device__ __forceinline__ bool next(int i, gg::Unit& u) const {
        const int L = i * G + c; if (L >= ntiles * 2) return false;
        const int tile = L >> 1, pn = L & 1, e = __builtin_amdgcn_readfirstlane(tab[i]);
        u.A = hx2; u.lda = 1024; u.ridx_off = MOE_RIDX_OFF + i * 1024; u.B = w13 + (size_t)e * (512 * 1024) + (size_t)pn * 256 * 1024; u.ldb = 1024; u.nt = 8; u.p0 = tile; u.p1 = pn; u.p2 = e; return true;
    }
};
struct EpiMoe1 {
    static constexpr bool PERM = true, FP8 = true; static constexpr int TID = 5; static constexpr unsigned SCB = 0x79797979u;
    unsigned char* a; const float* roww;
    __device__ __forceinline__ void operator()(const f32x4 (&acc)[2][2][4][2], const gg::Unit& u, int wr, int wc, int fr, int fq) const {
        const int row0 = u.p0 * 256 + wr * 64 + fr, col = u.p1 * 128 + wc * 32 + 8 * fq;
#pragma unroll
        for (int ai = 0; ai < 2; ++ai)
#pragma unroll
            for (int m = 0; m < 4; ++m) { const int row = row0 + ai * 128 + m * 16; const float rw = roww[row] * 8.0f;
                float t[8];
#pragma unroll
                for (int n = 0; n < 2; ++n)
#pragma unroll
                    for (int j = 0; j < 4; ++j) { const float g1 = acc[ai][0][m][n][j], g3 = acc[ai][1][m][n][j]; t[n * 4 + j] = g1 * sigmoidf_(g1) * g3 * rw; }
                *(u32x2*)(a + (size_t)row * 256 + col) = (u32x2){pk4_fp8(t[0], t[1], t[2], t[3]), pk4_fp8(t[4], t[5], t[6], t[7])}; }
    }
};
struct SchedMoe2 {
    static constexpr bool GATHER = false;
    const char* a; const char* w2; const LAS int* tab; int ntiles, G, c;
    __device__ __forceinline__ bool next(int i, gg::Unit& u) const {
        const int L = i * G + c; if (L >= ntiles * 4) return false;
        const int tile = L >> 2, pn = L & 3, e = __builtin_amdgcn_readfirstlane(tab[i]);
        u.A = a + (size_t)tile * 256 * 256; u.lda = 256; u.ridx_off = 0; u.B = w2 + (size_t)e * (1024 * 256) + (size_t)pn * 256 * 256; u.ldb = 256; u.nt = 2; u.p0 = tile; u.p1 = pn; u.p2 = e; return true;
    }
};
struct EpiBf16Plain {
    static constexpr bool PERM = true, FP8 = false; static constexpr int TID = 2; static constexpr unsigned SCB = 0x7f7f7f7fu;
    bf16_t* O; int ldc;
    __device__ __forceinline__ void operator()(const f32x4 (&acc)[2][2][4][2], const gg::Unit& u, int wr, int wc, int fr, int fq) const {
        const int row0 = u.p0 * 256 + wr * 64 + fr, col0 = u.p1 * 256 + wc * 32 + 8 * fq;
#pragma unroll
        for (int ai = 0; ai < 2; ++ai)
#pragma unroll
            for (int m = 0; m < 4; ++m)
#pragma unroll
                for (int bj = 0; bj < 2; ++bj) { const f32x4 v0 = acc[ai][bj][m][0], v1 = acc[ai][bj][m][1];
                    u32x4 w; w.x = cvt_pk_bf16(v0[0], v0[1]); w.y = cvt_pk_bf16(v0[2], v0[3]); w.z = cvt_pk_bf16(v1[0], v1[1]); w.w = cvt_pk_bf16(v1[2], v1[3]);
                    *(u32x4*)(O + (size_t)(row0 + ai * 128 + m * 16) * ldc + col0 + bj * 128) = w; }
    }
};
struct EpiF8Out {
    static constexpr bool PERM = true, FP8 = false; static constexpr int TID = 6; static constexpr unsigned SCB = 0x7f7f7f7fu;
    unsigned char* O; int ldc;
    __device__ __forceinline__ void operator()(const f32x4 (&acc)[2][2][4][2], const gg::Unit& u, int wr, int wc, int fr, int fq) const {
        const int row0 = u.p0 * 256 + wr * 64 + fr, col0 = u.p1 * 256 + wc * 32 + 8 * fq;
#pragma unroll
        for (int ai = 0; ai < 2; ++ai)
#pragma unroll
            for (int m = 0; m < 4; ++m)
#pragma unroll
                for (int bj = 0; bj < 2; ++bj) { const f32x4 v0 = acc[ai][bj][m][0], v1 = acc[ai][bj][m][1];
                    *(u32x2*)(O + (size_t)(row0 + ai * 128 + m * 16) * ldc + col0 + bj * 128) = (u32x2){pk4_fp8(v0[0], v0[1], v0[2], v0[3]), pk4_fp8(v1[0], v1[1], v1[2], v1[3])}; }
    }
};
struct EpiF8OutQ {
    static constexpr bool PERM = true, FP8 = true, ZPEEL = true; static constexpr int TID = 7; static constexpr unsigned SCB = 0x77777777u;
    unsigned char* O; int ldc;
    __device__ __forceinline__ void operator()(const f32x4 (&acc)[2][2][4][2], const gg::Unit& u, int wr, int wc, int fr, int fq) const {
        const int row0 = u.p0 * 256 + wr * 64 + fr, col0 = u.p1 * 256 + wc * 32 + 8 * fq;
#pragma unroll
        for (int ai = 0; ai < 2; ++ai)
#pragma unroll
            for (int m = 0; m < 4; ++m)
#pragma unroll
                for (int bj = 0; bj < 2; ++bj) { const f32x4 v0 = acc[ai][bj][m][0], v1 = acc[ai][bj][m][1];
                    *(u32x2*)(O + (size_t)(row0 + ai * 128 + m * 16) * ldc + col0 + bj * 128) = (u32x2){pk4_fp8(v0[0], v0[1], v0[2], v0[3]), pk4_fp8(v1[0], v1[1], v1[2], v1[3])}; }
    }
};
struct EpiBf16F8 {
    static constexpr bool PERM = true, FP8 = true; static constexpr int TID = 3; static constexpr unsigned SCB = 0x77777777u;
    bf16_t* O; static constexpr int ldc = 1024;
    __device__ __forceinline__ void operator()(const f32x4 (&acc)[2][2][4][2], const gg::Unit& u, int wr, int wc, int fr, int fq) const {
        bf16_t* p = O + (size_t)(u.p0 * 256 + wr * 64 + fr) * ldc + u.p1 * 256 + wc * 32 + 8 * fq;
#pragma unroll
        for (int ai = 0; ai < 2; ++ai) {
#pragma unroll
            for (int m = 0; m < 4; ++m) {
#pragma unroll
                for (int bj = 0; bj < 2; ++bj) { const f32x4 v0 = acc[ai][bj][m][0], v1 = acc[ai][bj][m][1];
                    u32x4 w; w.x = cvt_pk_bf16(v0[0], v0[1]); w.y = cvt_pk_bf16(v0[2], v0[3]); w.z = cvt_pk_bf16(v1[0], v1[1]); w.w = cvt_pk_bf16(v1[2], v1[3]);
                    *(u32x4*)(p + bj * 128) = w; }
                p += 16 * ldc; asm volatile("" : "+v"(p)); }
            p += 64 * ldc; }
    }
};

__device__ __forceinline__ int crow(int r, int hi) { return (r & 3) + 8 * (r >> 2) + 4 * hi; }
__device__ __forceinline__ f32x16 mma32_ll(f32x16 acc, const LAS bf16_t* A, int lda, const LAS bf16_t* B, int ldb, int ksteps, int lane, int ks0 = 0) {
    const int r32 = lane & 31, hi = lane >> 5;
    for (int ks = ks0; ks < ksteps; ++ks) {
        const bf16x8 a = *(const LAS bf16x8*)(A + r32 * lda + ks * 16 + hi * 8);
        const bf16x8 b = *(const LAS bf16x8*)(B + r32 * ldb + ks * 16 + hi * 8);
        acc = __builtin_amdgcn_mfma_f32_32x32x16_bf16(a, b, acc, 0, 0, 0);
    }
    return acc;
}
template <int KS> __device__ __forceinline__ f32x16 mma32_lg(f32x16 acc, const LAS bf16_t* A, int lda, const bf16_t* B, int ldb, int lane) {
    const int r32 = lane & 31, hi = lane >> 5;
    bf16x8 b[KS];
#pragma unroll
    for (int ks = 0; ks < KS; ++ks) b[ks] = *(const bf16x8*)(B + (size_t)r32 * ldb + ks * 16 + hi * 8);
#pragma unroll
    for (int ks = 0; ks < KS; ++ks) { const bf16x8 a = *(const LAS bf16x8*)(A + r32 * lda + ks * 16 + hi * 8); acc = __builtin_amdgcn_mfma_f32_32x32x16_bf16(a, b[ks], acc, 0, 0, 0); }
    return acc;
}

__device__ __forceinline__ void ph_pre(const Frame& F) {
    LAS float* sv = (LAS float*)F.lds;
    LAS float* part = sv + 9 * 1024;
    float* mod = (float*)(F.ws + WS_MOD);
    for (int i = F.tid; i < 9 * 1024; i += NTHR) { const int r = i >> 10, k = i & 1023; const float c = (r < 8) ? F.in[I_C][r * 1024 + k] : F.in[I_CCTX][k]; sv[i] = c * sigmoidf_(c); }
    __syncthreads();
    for (int it = F.bx; it < 2 * 96; it += F.G) {
        const int l = it / 96, jc = it % 96, j = jc * 64 + F.lane, k0 = F.wave * 128;
        const float* w = F.in[I_WMOD] + ((size_t)l * 1024 + k0) * 6144 + j;
        float a[9];
#pragma unroll
        for (int r = 0; r < 9; ++r) a[r] = 0.f;
#pragma unroll 4
        for (int k = 0; k < 128; ++k) { const float wv = w[(size_t)k * 6144];
#pragma unroll
            for (int r = 0; r < 9; ++r) a[r] += sv[r * 1024 + k0 + k] * wv; }
#pragma unroll
        for (int r = 0; r < 9; ++r) part[(F.wave * 9 + r) * 64 + F.lane] = a[r];
        __syncthreads();
        for (int i = F.tid; i < 9 * 64; i += NTHR) { const int r = i >> 6, jj = i & 63; float s = F.in[I_BMOD][l * 6144 + jc * 64 + jj];
#pragma unroll
            for (int w8 = 0; w8 < 8; ++w8) s += part[(w8 * 9 + r) * 64 + jj];
            mod[((size_t)(l * 9 + r)) * 6144 + jc * 64 + jj] = s; }
        __syncthreads();
    }
    if (F.bx == F.G - 1) {
        float* rt = (float*)(F.ws + T_ROPE);
        for (int i = F.tid; i < 1024; i += NTHR) { const int pos = i >> 3, f = i & 7; const float inv = powf(10000.0f, -(float)f / 8.0f); const float ang = (float)pos * inv; rt[2 * i] = cosf(ang); rt[2 * i + 1] = sinf(ang); }
    }
}

struct ConvCursor { int base; int gw, ngw; };
__device__ __forceinline__ void conv_mat(const Frame& F, ConvCursor& cc, const float* src, int K, int N, bf16_t* dst, int ldd, int rbase, int rstep, int nbatch, size_t sbs, size_t dbs, int rq = 128, bool gperm = false, float f8scale = 0.f) {
    const int ktl = K / 64, ntl = (N + 127) / 128, per = ktl * ntl, total = per * nbatch;
    int t = cc.base + ((cc.gw - cc.base) % cc.ngw + cc.ngw) % cc.ngw;
    for (; t < cc.base + total; t += cc.ngw) {
        const int li = t - cc.base, bt = li / per, rem = li % per, kb = rem / ntl, nb = rem % ntl, k0 = kb * 64, n = nb * 128 + 2 * F.lane;
        if (n < N) {
            const float* s = src + bt * sbs + (size_t)k0 * N + n; bf16_t* d = dst + bt * dbs;
            f32x2 v[64];
#pragma unroll
            for (int i = 0; i < 64; ++i) v[i] = *(const f32x2*)(s + (size_t)i * N);
#pragma unroll
            for (int q = 0; q < 2; ++q) { const int nn = n + q; const int drow = gperm ? ((nn >> 6) * 256 + ((nn >> 4) & 3) * 32 + (nn & 15) + 128 * (bt >> 1) + 16 * (bt & 1)) : (rbase + (nn / rq) * rstep + (nn % rq));
                if (f8scale != 0.f) { unsigned char* d8 = (unsigned char*)dst + bt * dbs + (size_t)drow * ldd + k0;
#pragma unroll
                    for (int p = 0; p < 4; ++p) { u32x4 o; o.x = pk4_fp8(v[16 * p][q] * f8scale, v[16 * p + 1][q] * f8scale, v[16 * p + 2][q] * f8scale, v[16 * p + 3][q] * f8scale);
                        o.y = pk4_fp8(v[16 * p + 4][q] * f8scale, v[16 * p + 5][q] * f8scale, v[16 * p + 6][q] * f8scale, v[16 * p + 7][q] * f8scale);
                        o.z = pk4_fp8(v[16 * p + 8][q] * f8scale, v[16 * p + 9][q] * f8scale, v[16 * p + 10][q] * f8scale, v[16 * p + 11][q] * f8scale);
                        o.w = pk4_fp8(v[16 * p + 12][q] * f8scale, v[16 * p + 13][q] * f8scale, v[16 * p + 14][q] * f8scale, v[16 * p + 15][q] * f8scale);
                        *(u32x4*)(d8 + 16 * p) = o; }
                    continue; }
                bf16_t* dr = d + (size_t)drow * ldd + k0;
#pragma unroll
                for (int p = 0; p < 8; ++p) { u32x4 o; o.x = pk2(v[8 * p][q], v[8 * p + 1][q]); o.y = pk2(v[8 * p + 2][q], v[8 * p + 3][q]); o.z = pk2(v[8 * p + 4][q], v[8 * p + 5][q]); o.w = pk2(v[8 * p + 6][q], v[8 * p + 7][q]);
                    *(u32x4*)(dr + 8 * p) = o; } }
        }
    }
    cc.base += total;
}
__device__ __forceinline__ void ph_convert(const Frame& F, int l) {
    ConvCursor cc; cc.base = 0; cc.gw = F.bx * NWAVES + F.wave; cc.ngw = F.G * NWAVES;
    unsigned char* ws = F.ws;
    conv_mat(F, cc, F.in[I_WIN] + (size_t)l * 1024 * INC, 1024, INC, (bf16_t*)(ws + W_IN), 1024, 0, 128, 1, 0, 0);
    conv_mat(F, cc, F.in[I_WGATE] + (size_t)l * 4 * 1024 * 1024, 1024, 1024, (bf16_t*)(ws + W_GATE), 1024, 0, 128, 4, (size_t)1024 * 1024, 0, 128, true, 64.0f);
    conv_mat(F, cc, F.in[I_WBR] + (size_t)l * 4 * 256 * 1024, 256, 1024, (bf16_t*)(ws + W_BR), 256, 0, 128, 4, (size_t)256 * 1024, (size_t)1024 * 256);
    conv_mat(F, cc, F.in[I_WOUT] + (size_t)l * 1024 * 1024, 1024, 1024, (bf16_t*)(ws + W_OUT), 1024, 0, 128, 1, 0, 0, 128, false, 64.0f);
    conv_mat(F, cc, F.in[I_W1] + (size_t)l * 64 * 1024 * 256, 1024, 256, (bf16_t*)(ws + W_13), 1024, 0, 256, 64, (size_t)1024 * 256, (size_t)512 * 1024, 128, false, 64.0f);
    conv_mat(F, cc, F.in[I_W3] + (size_t)l * 64 * 1024 * 256, 1024, 256, (bf16_t*)(ws + W_13), 1024, 128, 256, 64, (size_t)1024 * 256, (size_t)512 * 1024, 128, false, 64.0f);
    conv_mat(F, cc, F.in[I_W2] + (size_t)l * 64 * 256 * 1024, 256, 1024, (bf16_t*)(ws + W_2), 256, 0, 128, 64, (size_t)256 * 1024, (size_t)1024 * 256, 128, false, 32.0f);
    conv_mat(F, cc, F.in[I_WS1] + (size_t)l * 1024 * 256, 1024, 256, (bf16_t*)(ws + W_13 + (size_t)64 * 512 * 1024), 1024, 0, 256, 1, 0, 0, 128, false, 64.0f);
    conv_mat(F, cc, F.in[I_WS3] + (size_t)l * 1024 * 256, 1024, 256, (bf16_t*)(ws + W_13 + (size_t)64 * 512 * 1024), 1024, 128, 256, 1, 0, 0, 128, false, 64.0f);
    conv_mat(F, cc, F.in[I_WS2] + (size_t)l * 256 * 1024, 256, 1024, (bf16_t*)(ws + W_2 + (size_t)64 * 1024 * 256), 256, 0, 128, 1, 0, 0, 128, false, 32.0f);
    conv_mat(F, cc, F.in[I_WUQ] + (size_t)l * 256 * 384, 256, 384, (bf16_t*)(ws + W_UQ), 256, 0, 128, 1, 0, 0);
    conv_mat(F, cc, F.in[I_WUKV] + (size_t)l * 128 * 512, 128, 512, (bf16_t*)(ws + W_UKV), 128, 0, 128, 1, 0, 0);
    conv_mat(F, cc, F.in[I_POOLW] + (size_t)l * 4 * 64 * 64, 64, 64, (bf16_t*)(ws + W_POOL), 64, 0, 128, 4, (size_t)64 * 64, (size_t)64 * 64);
    conv_mat(F, cc, F.in[I_WRT] + (size_t)l * 1024 * 64, 1024, 64, (bf16_t*)(ws + W_RT), 1024, 0, 128, 1, 0, 0);
    { u32x4* z = (u32x4*)((bf16_t*)(ws + W_IN) + (size_t)INC * 1024); const int n16 = (INCP - INC) * 1024 * 2 / 16;
      unsigned z0 = 0u; asm volatile("" : "+v"(z0));
      for (int i = F.bx * NTHR + F.tid; i < n16; i += F.G * NTHR) z[i] = (u32x4){z0, z0, z0, z0}; }
}

__device__ __forceinline__ void normmod_vals(int lane, const f32x4 (&v)[4], const float* g, const float* sc, const float* sh, f32x4 (&y)[4]) {
    float s = 0.f;
#pragma unroll
    for (int j = 0; j < 4; ++j) s += (v[j].x * v[j].x + v[j].y * v[j].y) + (v[j].z * v[j].z + v[j].w * v[j].w);
    const float rstd = frsq(wave_sum(s) * (1.f / 1024.f) + EPS);
#pragma unroll
    for (int j = 0; j < 4; ++j) { const f32x4 gv = ((const f32x4*)g)[lane + 64 * j], scv = ((const f32x4*)sc)[lane + 64 * j], shv = ((const f32x4*)sh)[lane + 64 * j];
        y[j] = v[j] * rstd * gv * (scv + 1.0f) + shv; }
}
__device__ __forceinline__ void normmod_row(int lane, const float* xrow, const float* g, const float* sc, const float* sh, f32x4 (&y)[4]) {
    const f32x4* xr = (const f32x4*)xrow + lane; f32x4 v[4]; float s = 0.f;
#pragma unroll
    for (int j = 0; j < 4; ++j) { v[j] = xr[64 * j]; s += (v[j].x * v[j].x + v[j].y * v[j].y) + (v[j].z * v[j].z + v[j].w * v[j].w); }
    const float rstd = frsq(wave_sum(s) * (1.f / 1024.f) + EPS);
#pragma unroll
    for (int j = 0; j < 4; ++j) { const f32x4 gv = ((const f32x4*)g)[lane + 64 * j], scv = ((const f32x4*)sc)[lane + 64 * j], shv = ((const f32x4*)sh)[lane + 64 * j];
        y[j] = v[j] * rstd * gv * (scv + 1.0f) + shv; }
}
__device__ __forceinline__ const float* stream_row(const Frame& F, int l, int row) {
    if (row < NLAT) return (l == 0 ? F.in[I_X] : F.out) + (size_t)row * 1024;
    return (l == 0 ? F.in[I_CTX] : (const float*)(F.ws + WS_CTXS)) + (size_t)(row - NLAT) * 1024;
}
__device__ __forceinline__ void ph_norm1(const Frame& F, int l) {
    const int gw = F.bx * NWAVES + F.wave, ngw = F.G * NWAVES;
    bf16_t* hx = (bf16_t*)(F.ws + WS_HX);
    for (int row0 = gw; row0 < NTOK; row0 += 2 * ngw) {
        const int row1 = row0 + ngw; const bool has1 = row1 < NTOK;
        f32x4 v0[4], v1[4];
        { const f32x4* x0 = (const f32x4*)stream_row(F, l, row0) + F.lane; const f32x4* x1 = (const f32x4*)stream_row(F, l, has1 ? row1 : row0) + F.lane;
#pragma unroll
          for (int j = 0; j < 4; ++j) { v0[j] = x0[64 * j]; v1[j] = x1[64 * j]; } }
#pragma unroll
        for (int k = 0; k < 2; ++k) { if (k == 1 && !has1) break; const int row = k ? row1 : row0; const int mr = mod_row_of(row); f32x4 y[4];
            normmod_vals(F.lane, k ? v1 : v0, F.in[I_GMIX] + l * 1024, modp(F, l, mr, 1), modp(F, l, mr, 0), y);
            u32x2* o = (u32x2*)(hx + (size_t)row * 1024) + F.lane; unsigned* o8 = (unsigned*)(F.ws + WS_HX8 + (size_t)row * 1024) + F.lane;
#pragma unroll
            for (int j = 0; j < 4; ++j) { o[64 * j] = (u32x2){pk2(y[j].x, y[j].y), pk2(y[j].z, y[j].w)}; o8[64 * j] = pk4_fp8(y[j].x, y[j].y, y[j].z, y[j].w); } }
    }
}

constexpr float QSCALE = 0.10206207261596577f * 1.4426950408889634f;
template <int KS> __device__ __forceinline__ void ld_bfrag(bf16x8* b, const bf16_t* B, int ldb, int lane) {
#pragma unroll
    for (int ks = 0; ks < KS; ++ks) b[ks] = *(const bf16x8*)(B + (size_t)(lane & 31) * ldb + ks * 16 + (lane >> 5) * 8);
}
template <int KS> __device__ __forceinline__ f32x16 mma32_lr(const LAS bf16_t* A, int lda, const bf16x8* b, int lane) {
    f32x16 acc = {};
#pragma unroll
    for (int ks = 0; ks < KS; ++ks) { const bf16x8 a = *(const LAS bf16x8*)(A + (lane & 31) * lda + ks * 16 + (lane >> 5) * 8); acc = __builtin_amdgcn_mfma_f32_32x32x16_bf16(a, b[ks], acc, 0, 0, 0); }
    return acc;
}
__device__ __forceinline__ f32x2 mla_rope_ld(const Frame& F, int unit) {
    const int row0 = unit * 32; const bool isctx = row0 >= NLAT; const int pos0 = isctx ? (row0 - NLAT) & 255 : row0 & 8191;
    const int pos = pos0 + (F.tid >> 4), pp = (F.tid & 8) ? (pos & 63) : (pos >> 6);
    return *(const f32x2*)((const float*)(F.ws + T_ROPE) + (pp * 8 + (F.tid & 7)) * 2);
}
struct MlaKvRegs { unsigned xk[4]; unsigned xr[4]; f32x2 rp; };
__device__ __forceinline__ MlaKvRegs mla_kv_load(const Frame& F, int unit) {
    MlaKvRegs R; const bf16_t* px = (const bf16_t*)(F.ws + WS_PX);
#pragma unroll
    for (int rr = 0; rr < 4; ++rr) { const bf16_t* p = px + (size_t)(unit * 32 + F.wave * 4 + rr) * INC + C_MLA;
        R.xk[rr] = *(const unsigned*)(p + 256 + 2 * F.lane); R.xr[rr] = *(const unsigned*)(p + 384 + 2 * (F.lane & 15)); }
    R.rp = mla_rope_ld(F, unit);
    return R;
}
__device__ __forceinline__ void mla_kv_unit(const Frame& F, int unit, const MlaKvRegs& R, const bf16x8* wkv, f32x2 gckv2, float g0, float g1, float g2) {
    LAS unsigned char* lds = F.lds;
    LAS bf16_t* AKV = (LAS bf16_t*)lds;
    LAS float* KR = (LAS float*)(lds + 8704);
    LAS f32x2* RP = (LAS f32x2*)(lds + 12800);
    LAS float* OUT = (LAS float*)(lds + 16896);
    LAS bf16_t* KB = (LAS bf16_t*)(lds + 83456);
    int tid_ = F.tid; asm volatile("" : "+v"(tid_));
    const int row0 = unit * 32, tid = tid_, lane = tid & 63, wave = F.wave, r32 = lane & 31, hi = lane >> 5;
    const bool isctx = row0 >= NLAT;
    const int b = isctx ? (row0 - NLAT) >> 8 : row0 >> 13, pos0 = isctx ? (row0 - NLAT) & 255 : row0 & 8191;
    LDS_BAR();
    RP[tid] = R.rp;
#pragma unroll
    for (int rr = 0; rr < 4; ++rr) { const int r = wave * 4 + rr; const unsigned w = R.xk[rr]; const float x0 = bflo(w), x1 = bfhi(w);
        const float sc = frsq(wave_sum(x0 * x0 + x1 * x1) * (1.f / 128.f) + EPS);
        *(LAS unsigned*)(AKV + r * 136 + 2 * lane) = pk2(x0 * sc * gckv2.x, x1 * sc * gckv2.y);
        if (lane < 16) *(LAS f32x2*)(KR + r * 32 + 2 * lane) = (f32x2){bflo(R.xr[rr]), bfhi(R.xr[rr])}; }
    LDS_BAR();
#pragma unroll
    for (int i = 0; i < 2; ++i) { const int nt = wave * 2 + i; const f32x16 acc = mma32_lr<8>(AKV, 136, wkv + 8 * i, lane);
#pragma unroll
        for (int r = 0; r < 16; ++r) OUT[crow(r, hi) * 520 + nt * 32 + r32] = acc[r]; }
    LDS_BAR();
#pragma unroll
    for (int it = 0; it < 8; ++it) { const int pr = wave * 16 + it * 2 + hi, r = pr >> 2, h = pr & 3; const LAS float* o = OUT + r * 520 + h * 128;
        float v0 = o[r32], v1 = o[32 + r32], v2 = KR[r * 32 + r32]; const float ss = half_sum(v0 * v0 + v1 * v1 + v2 * v2);
        const float sc = frsq(ss * (1.f / 96.f) + EPS);
        v0 *= sc * g0; v1 *= sc * g1; v2 *= sc * g2;
        const float pv = xor_lane<8>(v2);
        if (!isctx) { const f32x2 cssn = RP[(r * 2 + (r32 >> 4)) * 8 + (r32 & 7)]; v2 = (r32 & 8) ? (v2 * cssn.x + pv * cssn.y) : (v2 * cssn.x - pv * cssn.y); }
        LAS bf16_t* kb = KB + r * 392 + h * 96;
        kb[r32] = (bf16_t)f2bf(v0); kb[32 + r32] = (bf16_t)f2bf(v1); kb[64 + r32] = (bf16_t)f2bf(v2); }
    LDS_BAR();
    const int key0 = isctx ? pos0 : 256 + pos0, tile = key0 >> 6, kin = key0 & 63;
    for (int i = tid; i < 1536; i += NTHR) { const int r = i & 31, c = (i >> 5) % 12, h = i / 384;
        const u32x4 v = *(const LAS u32x4*)(KB + r * 392 + h * 96 + c * 8);
        *(u32x4*)((bf16_t*)(F.ws + WS_KT) + ((size_t)((b * 4 + h) * NKT + tile) * 12 + c) * 512 + (kin + r) * 8) = v; }
    for (int i = tid; i < 1024; i += NTHR) { const int p = i & 3, r = (i >> 2) & 31, dh = (i >> 7) & 1, h = i >> 8; const LAS float* o = OUT + r * 520 + h * 128 + 64 + dh * 32 + p * 8;
        u32x4 v; v.x = pk2(o[0], o[1]); v.y = pk2(o[2], o[3]); v.z = pk2(o[4], o[5]); v.w = pk2(o[6], o[7]);
        *(u32x4*)((bf16_t*)(F.ws + WS_VT) + ((size_t)((b * 4 + h) * NKT + tile) * 2 + dh) * 2048 + (kin + r) * 32 + p * 8) = v; }
}
struct MlaQRegs { u32x2 xq[4]; f32x2 rp; };
__device__ __forceinline__ MlaQRegs mla_q_load(const Frame& F, int unit) {
    MlaQRegs R; const bf16_t* px = (const bf16_t*)(F.ws + WS_PX);
#pragma unroll
    for (int rr = 0; rr < 4; ++rr) R.xq[rr] = *(const u32x2*)(px + (size_t)(unit * 32 + F.wave * 4 + rr) * INC + C_MLA + 4 * F.lane);
    R.rp = mla_rope_ld(F, unit);
    return R;
}
__device__ __forceinline__ void mla_q_unit(const Frame& F, int unit, const MlaQRegs& R, const bf16x8* wqf, f32x4 gcq4, float g0, float g1, float g2) {
    LAS unsigned char* lds = F.lds;
    LAS bf16_t* AQ = (LAS bf16_t*)lds;
    LAS f32x2* RP = (LAS f32x2*)(lds + 16896);
    LAS float* OQ = (LAS float*)(lds + 20992);
    int tid_ = F.tid; asm volatile("" : "+v"(tid_));
    const int row0 = unit * 32, tid = tid_, lane = tid & 63, wave = F.wave, r32 = lane & 31, hi = lane >> 5;
    const bool isctx = row0 >= NLAT;
    LDS_BAR();
    RP[tid] = R.rp;
#pragma unroll
    for (int rr = 0; rr < 4; ++rr) { const int r = wave * 4 + rr; const u32x2 w = R.xq[rr]; const float x0 = bflo(w.x), x1 = bfhi(w.x), x2 = bflo(w.y), x3 = bfhi(w.y);
        const float sc = frsq(wave_sum(x0 * x0 + x1 * x1 + x2 * x2 + x3 * x3) * (1.f / 256.f) + EPS);
        *(LAS u32x2*)(AQ + r * 264 + 4 * lane) = (u32x2){pk2(x0 * sc * gcq4.x, x1 * sc * gcq4.y), pk2(x2 * sc * gcq4.z, x3 * sc * gcq4.w)}; }
    LDS_BAR();
    { const f32x16 acc = mma32_lr<16>(AQ, 264, wqf, lane);
#pragma unroll
      for (int r = 0; r < 16; ++r) OQ[crow(r, hi) * 392 + wave * 32 + r32] = acc[r]; }
    if (wave < 4) { const f32x16 acc = mma32_lr<16>(AQ, 264, wqf + 16, lane);
#pragma unroll
      for (int r = 0; r < 16; ++r) OQ[crow(r, hi) * 392 + (8 + wave) * 32 + r32] = acc[r]; }
    LDS_BAR();
    bf16_t* qb = (bf16_t*)(F.ws + WS_QB);
#pragma unroll
    for (int it = 0; it < 8; ++it) { const int pr = wave * 16 + it * 2 + hi, r = pr >> 2, h = pr & 3; const LAS float* o = OQ + r * 392 + h * 96;
        float v0 = o[r32], v1 = o[32 + r32], v2 = o[64 + r32]; const float ss = half_sum(v0 * v0 + v1 * v1 + v2 * v2);
        const float sc = frsq(ss * (1.f / 96.f) + EPS);
        v0 *= sc * g0; v1 *= sc * g1; v2 *= sc * g2;
        const float pv = xor_lane<8>(v2);
        if (!isctx) { const f32x2 cssn = RP[(r * 2 + (r32 >> 4)) * 8 + (r32 & 7)]; v2 = (r32 & 8) ? (v2 * cssn.x + pv * cssn.y) : (v2 * cssn.x - pv * cssn.y); }
        bf16_t* q = qb + (size_t)(row0 + r) * 384 + h * 96;
        q[r32] = (bf16_t)f2bf(v0 * QSCALE); q[32 + r32] = (bf16_t)f2bf(v1 * QSCALE); q[64 + r32] = (bf16_t)f2bf(v2 * QSCALE); }
}
__device__ __forceinline__ void mla_prep(const Frame& F, int l) {
    const int lane = F.lane, wave = F.wave, r32 = lane & 31;
    { bf16x8 wkv[16]; const bf16_t* wukv = (const bf16_t*)(F.ws + W_UKV);
      ld_bfrag<8>(wkv, wukv + (size_t)(wave * 2) * 32 * 128, 128, lane); ld_bfrag<8>(wkv + 8, wukv + (size_t)(wave * 2 + 1) * 32 * 128, 128, lane);
      const f32x2 gckv2 = *(const f32x2*)(F.in[I_GCKV] + l * 128 + 2 * lane); const float* gkn = F.in[I_GKN] + l * 96; const float g0 = gkn[r32], g1 = gkn[32 + r32], g2 = gkn[64 + r32];
      const int nu = NTOK / 32;
      if (F.bx < nu) { MlaKvRegs R = mla_kv_load(F, F.bx);
          for (int u = F.bx; u < nu; u += F.G) { const MlaKvRegs Rn = mla_kv_load(F, (u + F.G < nu) ? u + F.G : u); mla_kv_unit(F, u, R, wkv, gckv2, g0, g1, g2); R = Rn; } } }
    { bf16x8 wqf[32]; const bf16_t* wuq = (const bf16_t*)(F.ws + W_UQ);
      ld_bfrag<16>(wqf, wuq + (size_t)wave * 32 * 256, 256, lane); if (wave < 4) ld_bfrag<16>(wqf + 16, wuq + (size_t)(8 + wave) * 32 * 256, 256, lane);
      const f32x4 gcq4 = *(const f32x4*)(F.in[I_GCQ] + l * 256 + 4 * lane); const float* gqn = F.in[I_GQN] + l * 96; const float g0 = gqn[r32], g1 = gqn[32 + r32], g2 = gqn[64 + r32];
      const int nu = (l == 0 ? NTOK : NLAT) / 32;
      if (F.bx < nu) { MlaQRegs R = mla_q_load(F, F.bx);
          for (int u = F.bx; u < nu; u += F.G) { const MlaQRegs Rn = mla_q_load(F, (u + F.G < nu) ? u + F.G : u); mla_q_unit(F, u, R, wqf, gcq4, g0, g1, g2); R = Rn; } } }
}

__device__ __forceinline__ void ml_chunk_pos(int dir, int j, bool& isctx, int& p0) {
    if (j < 2) { isctx = true; p0 = (dir == 0 ? j : 1 - j) * 128; } else { isctx = false; p0 = (dir == 0 ? (j - 2) : (63 - (j - 2))) * 128; }
}
__device__ __forceinline__ int ml_row(int b, bool isctx, int pos) { return isctx ? NLAT + b * 256 + pos : b * 8192 + pos; }
__device__ __forceinline__ float log_sigmoidf_(float x) { return fminf(x, 0.f) - log1pf(__expf(-fabsf(x))); }

struct P1Regs { u32x4 kv[4]; float gi, gf; };
__device__ __forceinline__ P1Regs ml_pass1_load(const Frame& F, int unit) {
    P1Regs R; const int j = unit % NCHK, dir = (unit / NCHK) & 1, h = (unit / (NCHK * 2)) & 3, b = unit / (NCHK * 8);
    bool isctx; int p0; ml_chunk_pos(dir, j, isctx, p0);
    const bf16_t* px = (const bf16_t*)(F.ws + WS_PX); const float* gate = (const float*)(F.ws + T_GATE); const int tid = F.tid;
#pragma unroll
    for (int q = 0; q < 4; ++q) { const int it = tid + q * NTHR, i = it & 127, c = (it >> 7) & 7, isv = it >> 10; const int pos = dir ? p0 + 127 - i : p0 + i;
        R.kv[q] = *(const u32x4*)(px + (size_t)ml_row(b, isctx, pos) * INC + (isv ? 512 : 256) + h * 64 + c * 8); }
    { const int i = tid & 127; const int pos = dir ? p0 + 127 - i : p0 + i; const float* g = gate + (size_t)ml_row(b, isctx, pos) * 16; R.gi = g[dir * 8 + h]; R.gf = g[dir * 8 + 4 + h]; }
    return R;
}
__device__ __forceinline__ void ml_pass1_unit(const Frame& F, int l, int unit, const P1Regs& R) {
    LAS float* LI = (LAS float*)F.lds; LAS float* LF = LI + 128; LAS float* WV = LI + 256;
    LAS bf16_t* KT = (LAS bf16_t*)(F.lds + 2048); LAS bf16_t* VT = KT + 64 * 136;
    const int dir = (unit / NCHK) & 1, h = (unit / (NCHK * 2)) & 3;
    const int tid = F.tid, lane = F.lane, wave = F.wave;
    const float* gb = F.in[I_MLGB] + l * 16;
    LDS_BAR();
    if (tid < 128) { LI[tid] = R.gi + gb[dir * 8 + h]; LF[tid] = log_sigmoidf_(R.gf + gb[dir * 8 + 4 + h]); }
    LDS_BAR();
    if (wave == 0) {
        const float a0 = LF[2 * lane], a1 = LF[2 * lane + 1]; float s = a0 + a1;
#pragma unroll
        for (int o = 1; o < 64; o <<= 1) { const float t = lane_up(s, o, lane); if (lane >= o) s += t; }
        const float bend = lane_bcast(s, 63);
        const float w0 = bend - (s - a1) + LI[2 * lane], w1 = bend - s + LI[2 * lane + 1];
        const float mloc = wave_max(fmaxf(w0, w1));
        WV[2 * lane] = __expf(w0 - mloc); WV[2 * lane + 1] = __expf(w1 - mloc);
        if (lane == 0) { ((float*)(F.ws + T_MLOC))[unit] = mloc; ((float*)(F.ws + T_BEND))[unit] = bend; }
    }
    LDS_BAR();
#pragma unroll
    for (int q = 0; q < 4; ++q) { const int it = tid + q * NTHR, i = it & 127, c = (it >> 7) & 7, isv = it >> 10; const u32x4 v = R.kv[q];
        const float sc = isv ? 1.0f : 0.125f * WV[i]; LAS bf16_t* d = (isv ? VT : KT) + (c * 8) * 136 + i;
        d[0] = (bf16_t)f2bf(bflo(v.x) * sc); d[136] = (bf16_t)f2bf(bfhi(v.x) * sc); d[272] = (bf16_t)f2bf(bflo(v.y) * sc); d[408] = (bf16_t)f2bf(bfhi(v.y) * sc);
        d[544] = (bf16_t)f2bf(bflo(v.z) * sc); d[680] = (bf16_t)f2bf(bfhi(v.z) * sc); d[816] = (bf16_t)f2bf(bflo(v.w) * sc); d[952] = (bf16_t)f2bf(bfhi(v.w) * sc); }
    LDS_BAR();
    if (wave < 4) { const int et = wave >> 1, dt = wave & 1; f32x16 acc = {}; acc = mma32_ll(acc, VT + et * 32 * 136, 136, KT + dt * 32 * 136, 136, 8, lane);
        float* dc = (float*)(F.ws + WS_DC) + (size_t)unit * 4096; const int r32 = lane & 31, hi = lane >> 5;
#pragma unroll
        for (int r = 0; r < 16; ++r) dc[(et * 32 + crow(r, hi)) * 64 + dt * 32 + r32] = acc[r];
    } else if (wave == 4) { float s = 0.f; for (int i = 0; i < 128; ++i) s += bf2f(KT[lane * 136 + i]); ((float*)(F.ws + T_DN))[(size_t)unit * 64 + lane] = s; }
}

__device__ __forceinline__ void ml_pass2(const Frame& F) {
    const float* dc = (const float*)(F.ws + WS_DC); const float* dn = (const float*)(F.ws + T_DN);
    const float* mloc = (const float*)(F.ws + T_MLOC); const float* bend = (const float*)(F.ws + T_BEND);
    bf16_t* cst = (bf16_t*)(F.ws + WS_CST); float* nst = (float*)(F.ws + T_NST); float* mst = (float*)(F.ws + T_MST);
    LAS float* ML = (LAS float*)F.lds; LAS float* BE = ML + 128;
    for (int it = F.bx; it < 64 * 8; it += F.G) { const int bhd = it >> 3, part = it & 7, u0 = bhd * NCHK, el = part * 512 + F.tid;
        const bool don = (part == 0 && F.tid < 64);
        float d[NCHK], dnv[NCHK];
#pragma unroll
        for (int j = 0; j < NCHK; ++j) d[j] = dc[(size_t)(u0 + j) * 4096 + el];
#pragma unroll
        for (int j = 0; j < NCHK; ++j) dnv[j] = don ? dn[(size_t)(u0 + j) * 64 + F.tid] : 0.f;
        __syncthreads();
        if (F.tid < NCHK) { ML[F.tid] = mloc[u0 + F.tid]; BE[F.tid] = bend[u0 + F.tid]; }
        __syncthreads();
        float C = 0.f, n = 0.f, m = 0.f;
#pragma unroll
        for (int j = 0; j < NCHK; ++j) { const int u = u0 + j; const float ml = ML[j], be = BE[j];
            cst[(size_t)u * 4096 + el] = (bf16_t)f2bf(C); if (don) nst[(size_t)u * 64 + F.tid] = n; if (part == 0 && F.tid == 0) mst[u] = m;
            const float mn = fmaxf(be + m, ml), dcy = __expf(be + m - mn), sc = __expf(ml - mn);
            C = dcy * C + sc * d[j]; n = dcy * n + sc * dnv[j]; m = mn; }
    }
    __syncthreads();
}

__device__ __forceinline__ void ml_pass3_unit(const Frame& F, int l, int b, int h, int pc) {
    LAS unsigned char* lds = F.lds;
    LAS bf16_t* Qs = (LAS bf16_t*)lds;
    LAS bf16_t* Ks = (LAS bf16_t*)(lds + 18432);
    LAS bf16_t* VTs = (LAS bf16_t*)(lds + 36864);
    LAS bf16_t* CTs = (LAS bf16_t*)(lds + 62976);
    LAS bf16_t* Wm = (LAS bf16_t*)(lds + 76800);
    LAS float* HS = (LAS float*)(lds + 111616);
    LAS float* VEC = (LAS float*)(lds + 144384);
    LAS float* DEN = VEC + 12 * 128;
    const int tid = F.tid, lane = F.lane, wave = F.wave, r32 = lane & 31, hi = lane >> 5;
    const bool isctx = pc < 2; const int p0 = isctx ? pc * 128 : (pc - 2) * 128;
    const float* gate = (const float*)(F.ws + T_GATE); const float* gb = F.in[I_MLGB] + l * 16;
    const bf16_t* px = (const bf16_t*)(F.ws + WS_PX);
    int unit_d[2];
#pragma unroll
    for (int dir = 0; dir < 2; ++dir) { const int j = isctx ? (dir == 0 ? pc : 1 - pc) : (dir == 0 ? pc : 2 + 63 - (pc - 2)); unit_d[dir] = ((b * 4 + h) * 2 + dir) * NCHK + j; }
    LDS_BAR();
    const u32x4 cst0 = *(const u32x4*)((const bf16_t*)(F.ws + WS_CST) + (size_t)unit_d[0] * 4096 + tid * 8), cst1 = *(const u32x4*)((const bf16_t*)(F.ws + WS_CST) + (size_t)unit_d[1] * 4096 + tid * 8);
    const float nv0 = (tid < 64) ? ((const float*)(F.ws + T_NST))[(size_t)unit_d[0] * 64 + tid] : 0.f, nv1 = (tid < 64) ? ((const float*)(F.ws + T_NST))[(size_t)unit_d[1] * 64 + tid] : 0.f;
    const float mst0 = ((const float*)(F.ws + T_MST))[unit_d[0]], mst1 = ((const float*)(F.ws + T_MST))[unit_d[1]];
    if (tid < 256) { const int dir = tid >> 7, i = tid & 127; const int pos = dir ? p0 + 127 - i : p0 + i; const float* g = gate + (size_t)ml_row(b, isctx, pos) * 16;
        VEC[(dir * 6 + 0) * 128 + i] = g[dir * 8 + h] + gb[dir * 8 + h]; VEC[(dir * 6 + 1) * 128 + i] = log_sigmoidf_(g[dir * 8 + 4 + h] + gb[dir * 8 + 4 + h]); }
    for (int it = tid; it < 3072; it += NTHR) { const int i = it & 127, c = (it >> 7) & 7, which = it >> 10;
        const u32x4 v = *(const u32x4*)(px + (size_t)ml_row(b, isctx, p0 + i) * INC + which * 256 + h * 64 + c * 8);
        if (which == 0) *(LAS u32x4*)(Qs + i * 72 + c * 8) = v;
        else if (which == 1) { u32x4 w; w.x = pk2(bflo(v.x) * 0.125f, bfhi(v.x) * 0.125f); w.y = pk2(bflo(v.y) * 0.125f, bfhi(v.y) * 0.125f); w.z = pk2(bflo(v.z) * 0.125f, bfhi(v.z) * 0.125f); w.w = pk2(bflo(v.w) * 0.125f, bfhi(v.w) * 0.125f);
            *(LAS u32x4*)(Ks + i * 72 + c * 8) = w; }
        else { LAS bf16_t* d = VTs + (c * 8) * 136 + i; d[0] = (bf16_t)(v.x & 0xffff); d[136] = (bf16_t)(v.x >> 16); d[272] = (bf16_t)(v.y & 0xffff); d[408] = (bf16_t)(v.y >> 16);
            d[544] = (bf16_t)(v.z & 0xffff); d[680] = (bf16_t)(v.z >> 16); d[816] = (bf16_t)(v.w & 0xffff); d[952] = (bf16_t)(v.w >> 16); } }
    for (int it = tid; it < 32 * 136; it += NTHR) VTs[64 * 136 + it] = (it < 128) ? (bf16_t)0x3f80 : (bf16_t)0;
    LDS_BAR();
    if (wave < 2) { const int dir = wave; LAS float* V0 = VEC + dir * 6 * 128; const float mst = dir ? mst1 : mst0;
        const float a0 = V0[128 + 2 * lane], a1 = V0[128 + 2 * lane + 1]; float s = a0 + a1;
#pragma unroll
        for (int o = 1; o < 64; o <<= 1) { const float t = lane_up(s, o, lane); if (lane >= o) s += t; }
        const float b0 = s - a1, b1 = s, c0 = V0[2 * lane] - b0, c1 = V0[2 * lane + 1] - b1;
        float pm = fmaxf(c0, c1);
#pragma unroll
        for (int o = 1; o < 64; o <<= 1) { const float t = lane_up(pm, o, lane); if (lane >= o) pm = fmaxf(pm, t); }
        float pprev = lane_up(pm, 1, lane); if (lane == 0) pprev = -INFINITY;
        const float M0 = fmaxf(mst, fmaxf(pprev, c0)), M1 = fmaxf(mst, pm);
        V0[256 + 2 * lane] = c0; V0[256 + 2 * lane + 1] = c1; V0[384 + 2 * lane] = M0; V0[384 + 2 * lane + 1] = M1;
        V0[512 + 2 * lane] = __expf(mst - M0); V0[512 + 2 * lane + 1] = __expf(mst - M1); V0[640 + 2 * lane] = __expf(-b0 - M0); V0[640 + 2 * lane + 1] = __expf(-b1 - M1);
    }
    const u32x4 og0 = *(const u32x4*)(px + (size_t)ml_row(b, isctx, p0 + (tid >> 3)) * INC + 768 + h * 64 + (tid & 7) * 8), og1 = *(const u32x4*)(px + (size_t)ml_row(b, isctx, p0 + 64 + (tid >> 3)) * INC + 768 + h * 64 + (tid & 7) * 8);
    for (int dir = 0; dir < 2; ++dir) {
        const LAS float* COLV = VEC + (dir * 6 + 2) * 128; const LAS float* MV = COLV + 128; const LAS float* AIN = COLV + 256; const LAS float* EINV = COLV + 384;
        const int rs = dir ? -72 : 72, rb = dir ? 127 : 0;
        LDS_BAR();
        *(LAS u32x4*)(CTs + (tid >> 3) * 72 + (tid & 7) * 8) = dir ? cst1 : cst0;
        if (tid < 72) CTs[64 * 72 + tid] = (tid < 64) ? (bf16_t)f2bf(dir ? nv1 : nv0) : (bf16_t)0;
        for (int q = wave; q < 16; q += 8) { const int ti = q >> 2, si = q & 3; const int sidx = si * 32 + r32, spos = dir ? 127 - sidx : sidx;
            if (si > ti) {
#pragma unroll
                for (int r = 0; r < 16; ++r) Wm[(ti * 32 + crow(r, hi)) * 136 + spos] = 0;
            } else { f32x16 acc = {}; acc = mma32_ll(acc, Qs + (rb + (dir ? -ti * 32 : ti * 32)) * 72, rs, Ks + (rb + (dir ? -si * 32 : si * 32)) * 72, rs, 4, lane); const float cv = COLV[sidx];
#pragma unroll
                for (int r = 0; r < 16; ++r) { const int t = ti * 32 + crow(r, hi); const float w = (sidx <= t) ? acc[r] * __expf(cv - MV[t]) : 0.f; Wm[t * 136 + spos] = (bf16_t)f2bf(w); } }
        }
        LDS_BAR();
        f32x16 tot[2];
#pragma unroll
        for (int k = 0; k < 2; ++k) { const int q = wave + 8 * k; if (q < 12) { const int ti = q / 3, nt = q % 3;
            f32x16 a1 = {}; a1 = mma32_ll(a1, Wm + ti * 32 * 136, 136, VTs + nt * 32 * 136, 136, dir ? 8 : (ti + 1) * 2, lane, dir ? 8 - (ti + 1) * 2 : 0);
            f32x16 a2 = {}; a2 = mma32_ll(a2, Qs + (rb + (dir ? -ti * 32 : ti * 32)) * 72, rs, CTs + nt * 32 * 72, 72, 4, lane);
#pragma unroll
            for (int r = 0; r < 16; ++r) a1[r] += AIN[ti * 32 + crow(r, hi)] * a2[r];
            tot[k] = a1;
            if (nt == 2 && r32 == 0) {
#pragma unroll
                for (int r = 0; r < 16; ++r) DEN[ti * 32 + crow(r, hi)] = a1[r]; } } }
        LDS_BAR();
#pragma unroll
        for (int k = 0; k < 2; ++k) { const int q = wave + 8 * k; if (q < 12) { const int ti = q / 3, nt = q % 3; if (nt < 2) {
#pragma unroll
            for (int r = 0; r < 16; ++r) { const int t = ti * 32 + crow(r, hi); const float hv = tot[k][r] * frcp(fmaxf(fabsf(DEN[t]), EINV[t])); const int p = dir ? 127 - t : t;
                if (dir == 0) HS[p * 64 + nt * 32 + r32] = hv; else HS[p * 64 + nt * 32 + r32] += hv; } } } }
    }
    LDS_BAR();
    { const int c8 = (tid & 7) * 8; bf16_t* yc = (bf16_t*)(F.ws + WS_YC);
      const f32x4 hg0 = *(const f32x4*)(F.in[I_MLHG] + l * 256 + h * 64 + c8), hg1 = *(const f32x4*)(F.in[I_MLHG] + l * 256 + h * 64 + c8 + 4);
#pragma unroll
      for (int half = 0; half < 2; ++half) { const int p = half * 64 + (tid >> 3); const u32x4 og = half ? og1 : og0;
        const f32x4 v0 = *(const LAS f32x4*)(HS + p * 64 + c8), v1 = *(const LAS f32x4*)(HS + p * 64 + c8 + 4);
        float ss = (v0.x * v0.x + v0.y * v0.y) + (v0.z * v0.z + v0.w * v0.w) + (v1.x * v1.x + v1.y * v1.y) + (v1.z * v1.z + v1.w * v1.w);
        ss += xor_lane<1>(ss); ss += xor_lane<2>(ss); ss += xor_lane<4>(ss);
        const float sc = frsq(ss * (1.f / 64.f) + EPS);
        const f32x4 y0 = v0 * sc * hg0 * (f32x4){sigmoidf_(bflo(og.x)), sigmoidf_(bfhi(og.x)), sigmoidf_(bflo(og.y)), sigmoidf_(bfhi(og.y))};
        const f32x4 y1 = v1 * sc * hg1 * (f32x4){sigmoidf_(bflo(og.z)), sigmoidf_(bfhi(og.z)), sigmoidf_(bflo(og.w)), sigmoidf_(bfhi(og.w))};
        *(u32x4*)(yc + (size_t)ml_row(b, isctx, p0 + p) * 1024 + h * 64 + c8) = (u32x4){pk2(y0.x, y0.y), pk2(y0.z, y0.w), pk2(y1.x, y1.y), pk2(y1.z, y1.w)}; } }
}

struct PoolRegs { u32x4 v[5]; };
__device__ __forceinline__ PoolRegs pool_load(const Frame& F, int unit) {
    PoolRegs R; const int row0 = unit * 64, tid = F.tid;
    const bool isctx = row0 >= NLAT; const int T = isctx ? 256 : 8192, t0 = isctx ? (row0 - NLAT) & 255 : row0 & 8191, rbase = row0 - t0;
    const bf16_t* px = (const bf16_t*)(F.ws + WS_PX);
#pragma unroll
    for (int q = 0; q < 5; ++q) { const int it = tid + q * NTHR, rr = it >> 5, c = it & 31, t = t0 - 8 + rr; R.v[q] = (u32x4){0u, 0u, 0u, 0u};
        if (t >= 0 && t < T) R.v[q] = *(const u32x4*)(px + (size_t)(rbase + t) * INC + C_POOL + c * 8); }
    return R;
}
__device__ __forceinline__ void pool_unit(const Frame& F, int l, int unit, const PoolRegs& R) {
    LAS float* U = (LAS float*)F.lds;
    LAS bf16_t* D = (LAS bf16_t*)(F.lds + 81920);
    const int row0 = unit * 64, tid = F.tid, lane = F.lane, wave = F.wave;
    const bool isctx = row0 >= NLAT; const int T = isctx ? 256 : 8192, t0 = isctx ? (row0 - NLAT) & 255 : row0 & 8191, rbase = row0 - t0;
    const bf16_t* px = (const bf16_t*)(F.ws + WS_PX);
    LDS_BAR();
    {
#pragma unroll
      for (int q = 0; q < 5; ++q) { const int it = tid + q * NTHR, rr = it >> 5, c = it & 31; LAS float* d = U + rr * 256 + c * 8; const u32x4 v = R.v[q];
          *(LAS f32x4*)d = (f32x4){bflo(v.x), bfhi(v.x), bflo(v.y), bfhi(v.y)}; *(LAS f32x4*)(d + 4) = (f32x4){bflo(v.z), bfhi(v.z), bflo(v.w), bfhi(v.w)}; } }
    LDS_BAR();
    { const int c = tid & 255, th = tid >> 8, g = c >> 6, hw = 1 << g, tt0 = th * 32;
      float sacc = 0.f;
      for (int u = tt0 - hw; u < tt0 + hw; ++u) sacc += U[(u + 8) * 256 + c];
#pragma unroll 4
      for (int k = 0; k < 32; ++k) { const int tt = tt0 + k, t = t0 + tt; const int lo = max(t - hw, 0), hi = min(t + hw, T);
          D[tt * 264 + c] = (bf16_t)f2bf(sacc * frcp((float)(hi - lo)) - U[(tt + 8) * 256 + c]);
          sacc += U[(tt + hw + 8) * 256 + c] - U[(tt - hw + 8) * 256 + c]; } }
    LDS_BAR();
    { const int g = wave >> 1, rt = wave & 1, r32 = lane & 31, hi = lane >> 5; bf16_t* yc = (bf16_t*)(F.ws + WS_YC); const float* ps = F.in[I_POOLS] + l * 256;
      for (int nt = 0; nt < 2; ++nt) { f32x16 acc = {}; acc = mma32_lg<4>(acc, D + rt * 32 * 264 + g * 64, 264, (const bf16_t*)(F.ws + W_POOL) + (size_t)(g * 64 + nt * 32) * 64, 64, lane);
          const int col = g * 64 + nt * 32 + r32; const float sc = ps[col];
#pragma unroll
          for (int r = 0; r < 16; ++r) yc[(size_t)(row0 + rt * 32 + crow(r, hi)) * 1024 + 512 + col] = (bf16_t)f2bf(acc[r] * sc); } }
}
__device__ __forceinline__ void conv_z(const bf16_t* p, float (&z)[8]) { const u32x4 u = *(const u32x4*)p, cc = *(const u32x4*)(p + 512);
    z[0] = bflo(u.x) * bflo(cc.x); z[1] = bfhi(u.x) * bfhi(cc.x); z[2] = bflo(u.y) * bflo(cc.y); z[3] = bfhi(u.y) * bfhi(cc.y);
    z[4] = bflo(u.z) * bflo(cc.z); z[5] = bfhi(u.z) * bfhi(cc.z); z[6] = bflo(u.w) * bflo(cc.w); z[7] = bfhi(u.w) * bfhi(cc.w); }
__device__ __forceinline__ void conv_all(const Frame& F, int l, int nrows) {
    const bf16_t* px = (const bf16_t*)(F.ws + WS_PX); bf16_t* yc = (bf16_t*)(F.ws + WS_YC);
    const int c = (F.tid & 31) * 8;
    float w0[8], w1[8], w2[8], cb[8];
#pragma unroll
    for (int e = 0; e < 8; ++e) { w0[e] = F.in[I_CONVW][l * 768 + c + e]; w1[e] = F.in[I_CONVW][l * 768 + 256 + c + e]; w2[e] = F.in[I_CONVW][l * 768 + 512 + c + e]; cb[e] = F.in[I_CONVB][l * 256 + c + e]; }
    for (int it = F.bx * NTHR + F.tid; it < (nrows / 16) * 32; it += F.G * NTHR) { const int row0 = (it >> 5) * 16;
        const bool isctx = row0 >= NLAT; const int T = isctx ? 256 : 8192, t0 = isctx ? (row0 - NLAT) & 255 : row0 & 8191;
        const bf16_t* p = px + (size_t)row0 * INC + C_CONV + c;
        float zp[8], zc[8], zn[8];
        if (t0 > 0) conv_z(p - INC, zp); else {
#pragma unroll
            for (int e = 0; e < 8; ++e) zp[e] = 0.f; }
        conv_z(p, zc);
#pragma unroll 4
        for (int r = 0; r < 16; ++r) { const bf16_t* pr = p + (size_t)r * INC;
            if (t0 + r + 1 < T) conv_z(pr + INC, zn); else {
#pragma unroll
                for (int e = 0; e < 8; ++e) zn[e] = 0.f; }
            const u32x4 bw = *(const u32x4*)(pr + 256); const float bx[8] = {bflo(bw.x), bfhi(bw.x), bflo(bw.y), bfhi(bw.y), bflo(bw.z), bfhi(bw.z), bflo(bw.w), bfhi(bw.w)};
            float y[8];
#pragma unroll
            for (int e = 0; e < 8; ++e) { y[e] = bx[e] * (cb[e] + w0[e] * zp[e] + w1[e] * zc[e] + w2[e] * zn[e]); zp[e] = zc[e]; zc[e] = zn[e]; }
            u32x4 o; o.x = pk2(y[0], y[1]); o.y = pk2(y[2], y[3]); o.z = pk2(y[4], y[5]); o.w = pk2(y[6], y[7]);
            *(u32x4*)(yc + (size_t)(row0 + r) * 1024 + 768 + c) = o; }
    }
}

namespace att {
constexpr int STAGE_B = 40960, KSUB = 12288, VOFF = 24576, VSUB = 8192, LDS_WS = 3 * STAGE_B, LDS_OST = LDS_WS + 2048;
constexpr float THR = 8.0f;
__device__ __forceinline__ void glds16(const void* gsrc, unsigned lds_dst) { unsigned keep;
    asm volatile("s_mov_b32 %0, m0\n\ts_mov_b32 m0, %2\n\ts_nop 0\n\tglobal_load_lds_dwordx4 %1, off\n\ts_mov_b32 m0, %0" : "=&s"(keep) : "v"(gsrc), "s"(lds_dst) : "memory"); }
#define ATT_WAIT_BAR(N) asm volatile("s_waitcnt vmcnt(" #N ") lgkmcnt(0)\n\ts_barrier" ::: "memory")
__device__ __forceinline__ void qkt(f32x16& p0, f32x16& p1, const LAS char* Kslot, const bf16x8* qr, int r32, int hi) {
    const LAS char* kb = Kslot + hi * 1024 + r32 * 16; p0 = f32x16{}; p1 = f32x16{};
#pragma unroll
    for (int d0 = 0; d0 < 6; ++d0) {
        const bf16x8 b0 = *(const LAS bf16x8*)(kb + d0 * 2048), b1 = *(const LAS bf16x8*)(kb + d0 * 2048 + 512);
        p0 = __builtin_amdgcn_mfma_f32_32x32x16_bf16(b0, qr[d0], p0, 0, 0, 0); p1 = __builtin_amdgcn_mfma_f32_32x32x16_bf16(b1, qr[d0], p1, 0, 0, 0); }
}
__device__ __forceinline__ float rowmax(const f32x16& p0, const f32x16& p1) {
    float a = fmaxf(p0[0], p1[0]);
#pragma unroll
    for (int r = 1; r < 16; ++r) a = fmaxf(a, fmaxf(p0[r], p1[r]));
    auto rr = __builtin_amdgcn_permlane32_swap(__float_as_uint(a), __float_as_uint(a), false, false);
    return fmaxf(__uint_as_float(rr[0]), __uint_as_float(rr[1]));
}
__device__ __forceinline__ void pv(f32x16* o, int vb, bf16x8 pa0, bf16x8 pa1, bf16x8 pa2, bf16x8 pa3) {
#pragma unroll
    for (int d0 = 0; d0 < 2; ++d0) { s16x4 lo[4], hi[4];
#pragma unroll
        for (int ks = 0; ks < 4; ++ks) {
            asm volatile("ds_read_b64_tr_b16 %0,%1 offset:%c2" : "=&v"(lo[ks]) : "v"(vb), "i"(d0 * 4096 + ks * 1024) : "memory");
            asm volatile("ds_read_b64_tr_b16 %0,%1 offset:%c2" : "=&v"(hi[ks]) : "v"(vb), "i"(d0 * 4096 + ks * 1024 + 512) : "memory"); }
        asm volatile("s_waitcnt lgkmcnt(0)" ::: "memory"); __builtin_amdgcn_sched_barrier(0);
#define ATT_PK(k) (bf16x8){lo[k][0], lo[k][1], lo[k][2], lo[k][3], hi[k][0], hi[k][1], hi[k][2], hi[k][3]}
        o[d0] = __builtin_amdgcn_mfma_f32_32x32x16_bf16(pa0, ATT_PK(0), o[d0], 0, 0, 0);
        o[d0] = __builtin_amdgcn_mfma_f32_32x32x16_bf16(pa1, ATT_PK(1), o[d0], 0, 0, 0);
        o[d0] = __builtin_amdgcn_mfma_f32_32x32x16_bf16(pa2, ATT_PK(2), o[d0], 0, 0, 0);
        o[d0] = __builtin_amdgcn_mfma_f32_32x32x16_bf16(pa3, ATT_PK(3), o[d0], 0, 0, 0);
#undef ATT_PK
    }
}
__device__ __forceinline__ void unit(const Frame& F, int bh, int qrow, int orow, int nst) {
    const int tid = F.tid, lane = F.lane, wid = F.wave, r32 = lane & 31, hi = lane >> 5, h = bh & 3;
    const unsigned lds0 = (unsigned)(uintptr_t)F.lds;
    const LAS char* ring = (const LAS char*)F.lds;
    LAS float* wsf = (LAS float*)(F.lds + LDS_WS) + wid * 64;
    const char* kg = (const char*)(F.ws + WS_KT) + (size_t)bh * NKT * 12288; const char* vg = (const char*)(F.ws + WS_VT) + (size_t)bh * NKT * 8192;
    const bf16_t* Qw = (const bf16_t*)(F.ws + WS_QB) + (size_t)(qrow + wid * 32) * 384 + h * 96;
#define ATT_DMA(t, slot) do { const char* ks_ = kg + (size_t)(t) * 24576 + wid * 1024 + lane * 16; const char* vs_ = vg + (size_t)(t) * 16384 + wid * 1024 + lane * 16; \
        const unsigned kd_ = lds0 + (slot) * STAGE_B + wid * 1024, vd_ = kd_ + VOFF; \
        glds16(ks_, (unsigned)__builtin_amdgcn_readfirstlane(kd_)); glds16(ks_ + 8192, (unsigned)__builtin_amdgcn_readfirstlane(kd_ + 8192)); glds16(ks_ + 16384, (unsigned)__builtin_amdgcn_readfirstlane(kd_ + 16384)); \
        glds16(vs_, (unsigned)__builtin_amdgcn_readfirstlane(vd_)); glds16(vs_ + 8192, (unsigned)__builtin_amdgcn_readfirstlane(vd_ + 8192)); } while (0)
    ATT_DMA(0, 0); if (nst > 1) ATT_DMA(1, 1);
    bf16x8 qr[6];
#pragma unroll
    for (int d0 = 0; d0 < 6; ++d0) qr[d0] = *(const bf16x8*)(Qw + (size_t)r32 * 384 + d0 * 16 + hi * 8);
    float mhat = 0.f, l_reg = 0.f; f32x16 o[2]; o[0] = f32x16{}; o[1] = f32x16{};
    const int vb0 = (int)lds0 + VOFF + ((lane >> 4) & 1) * 32 + (lane & 3) * 8 + (4 * hi + ((lane & 15) >> 2)) * 64;
    int slot = 0; bool first = true;
    for (int t = 0; t < nst; ++t) {
        if (t + 1 < nst) ATT_WAIT_BAR(5); else ATT_WAIT_BAR(0);
        if (t + 2 < nst) { const int s2 = (slot == 0) ? 2 : slot - 1; ATT_DMA(t + 2, s2); }
#pragma unroll
        for (int s = 0; s < 2; ++s) {
            f32x16 p0, p1; qkt(p0, p1, ring + slot * STAGE_B + s * KSUB, qr, r32, hi);
            const float rm = rowmax(p0, p1);
            if (first) { mhat = rm; first = false; }
            else if (__any(rm - mhat > THR)) { const float dl = fmaxf(rm - mhat, 0.f); mhat += dl; const float f = __builtin_amdgcn_exp2f(-dl); l_reg *= f;
                if (hi == 0) wsf[r32] = f; LDS_WAIT();
#pragma unroll
                for (int r = 0; r < 16; ++r) { const float fr_ = wsf[crow(r, hi)]; o[0][r] *= fr_; o[1][r] *= fr_; } }
            float sacc = 0.f;
#pragma unroll
            for (int r = 0; r < 16; ++r) { p0[r] = __builtin_amdgcn_exp2f(p0[r] - mhat); p1[r] = __builtin_amdgcn_exp2f(p1[r] - mhat); sacc += p0[r] + p1[r]; }
            l_reg += sacc;
            u32x4 pw0, pw1, pw2, pw3;
            pw0 = (u32x4){cvt_pk_bf16(p0[0], p0[1]), cvt_pk_bf16(p0[2], p0[3]), cvt_pk_bf16(p0[4], p0[5]), cvt_pk_bf16(p0[6], p0[7])};
            pw1 = (u32x4){cvt_pk_bf16(p0[8], p0[9]), cvt_pk_bf16(p0[10], p0[11]), cvt_pk_bf16(p0[12], p0[13]), cvt_pk_bf16(p0[14], p0[15])};
            pw2 = (u32x4){cvt_pk_bf16(p1[0], p1[1]), cvt_pk_bf16(p1[2], p1[3]), cvt_pk_bf16(p1[4], p1[5]), cvt_pk_bf16(p1[6], p1[7])};
            pw3 = (u32x4){cvt_pk_bf16(p1[8], p1[9]), cvt_pk_bf16(p1[10], p1[11]), cvt_pk_bf16(p1[12], p1[13]), cvt_pk_bf16(p1[14], p1[15])};
            __builtin_amdgcn_sched_barrier(0);
            pv(o, vb0 + slot * STAGE_B + s * VSUB, __builtin_bit_cast(bf16x8, pw0), __builtin_bit_cast(bf16x8, pw1), __builtin_bit_cast(bf16x8, pw2), __builtin_bit_cast(bf16x8, pw3));
        }
        slot = (slot == 2) ? 0 : slot + 1;
    }
    { auto rr = __builtin_amdgcn_permlane32_swap(__float_as_uint(l_reg), __float_as_uint(l_reg), false, false); l_reg = __uint_as_float(rr[0]) + __uint_as_float(rr[1]); }
    if (hi == 0) wsf[32 + r32] = l_reg; LDS_WAIT();
    float rli[16];
#pragma unroll
    for (int r = 0; r < 16; ++r) rli[r] = frcp(wsf[32 + crow(r, hi)]);
    LAS bf16_t* stg = (LAS bf16_t*)(F.lds + LDS_OST) + wid * 2048;
#pragma unroll
    for (int r = 0; r < 16; ++r) { const int orow_ = crow(r, hi);
#pragma unroll
        for (int d0 = 0; d0 < 2; ++d0) stg[orow_ * 64 + d0 * 32 + r32] = (bf16_t)f2bf(o[d0][r] * rli[r]); }
    LDS_WAIT();
    bf16_t* Ow = (bf16_t*)(F.ws + WS_YC) + (size_t)(orow + wid * 32) * 1024 + 256 + h * 64;
#pragma unroll
    for (int i = 0; i < 4; ++i) { const int row = i * 8 + (lane >> 3), ch = lane & 7; const u32x4 v = *(const LAS u32x4*)(stg + row * 64 + ch * 8); *(u32x4*)(Ow + (size_t)row * 1024 + ch * 8) = v; }
    asm volatile("s_waitcnt lgkmcnt(0)\n\ts_barrier" ::: "memory");
#undef ATT_DMA
}
}

namespace att2 {
constexpr int KSL = 12288, VSL = 8192, LDS_K = 0, LDS_V = 3 * KSL, LDS_WS = LDS_V + 3 * VSL, LDS_OST = LDS_WS + 2048;
#define A2_SBAR() __builtin_amdgcn_sched_barrier(0)
#define A2_WAIT_BAR(N) asm volatile("s_waitcnt vmcnt(" #N ") lgkmcnt(0)\n\ts_barrier" ::: "memory")
__device__ __forceinline__ void glds16s(const void* sbase, unsigned voff, unsigned lds_dst) { unsigned keep;
    asm volatile("s_mov_b32 %0, m0\n\ts_mov_b32 m0, %3\n\ts_nop 4\n\tglobal_load_lds_dwordx4 %1, %2\n\ts_mov_b32 m0, %0" : "=&s"(keep) : "v"(voff), "s"(sbase), "s"(lds_dst) : "memory"); }
__device__ __forceinline__ unsigned cvtpk_s(float lo, float hi) { typedef float f2 __attribute__((ext_vector_type(2))); typedef __bf16 b2 __attribute__((ext_vector_type(2))); f2 v = {lo, hi}; b2 b = __builtin_convertvector(v, b2); return __builtin_bit_cast(unsigned, b); }
typedef short v4i16_t __attribute__((ext_vector_type(4)));
__device__ __forceinline__ s16x4 vtr(const LAS char* p) { return __builtin_bit_cast(s16x4, __builtin_amdgcn_ds_read_tr16_b64_v4i16((LAS v4i16_t*)p)); }
__device__ __forceinline__ void kload2(bf16x8* kf, const LAS char* kp, int j) { kf[2 * j] = *(const LAS bf16x8*)(kp + j * 2048); kf[2 * j + 1] = *(const LAS bf16x8*)(kp + j * 2048 + 512); }

template <bool NOMAX> __device__ __forceinline__ void unit(const Frame& F, int bh, int qrow, int orow, int NT) {
    const int lane = F.lane, wid = F.wave, r32 = lane & 31, hi = lane >> 5, h = bh & 3;
    const unsigned lds0 = (unsigned)(uintptr_t)F.lds;
    const LAS char* shm3 = (const LAS char*)F.lds;
    LAS float* wsf = (LAS float*)(F.lds + LDS_WS) + wid * 64;
    const char* kg = (const char*)(F.ws + WS_KT) + (size_t)bh * NKT * 12288; const char* vg = (const char*)(F.ws + WS_VT) + (size_t)bh * NKT * 8192 + wid * 1024; const unsigned l16 = lane * 16;
    const bf16_t* Qw = (const bf16_t*)(F.ws + WS_QB) + (size_t)(qrow + wid * 32) * 384 + h * 96;
    const int kp2 = 8 + (wid & 3);
#define A2_DMA_K(t, sl) do { const char* s_ = kg + (size_t)(t) * 12288; const unsigned d_ = lds0 + LDS_K + (sl) * KSL; \
        glds16s(s_ + wid * 1024, l16, (unsigned)__builtin_amdgcn_readfirstlane(d_ + wid * 1024)); glds16s(s_ + kp2 * 1024, l16, (unsigned)__builtin_amdgcn_readfirstlane(d_ + kp2 * 1024)); } while (0)
#define A2_DMA_V(t, sl) glds16s(vg + (size_t)(t) * 8192, l16, (unsigned)__builtin_amdgcn_readfirstlane(lds0 + LDS_V + (sl) * VSL + wid * 1024))
    const LAS char* kp0 = shm3 + LDS_K + hi * 1024 + r32 * 16;
    const LAS char* vp0 = shm3 + LDS_V + ((lane >> 4) & 1) * 32 + (lane & 3) * 8 + (4 * hi + ((lane & 15) >> 2)) * 64;
    bf16x8 kf[12];
    A2_DMA_K(0, 0); A2_DMA_V(0, 0); A2_DMA_K(1, 1);
    bf16x8 qr[6];
#pragma unroll
    for (int d0 = 0; d0 < 6; ++d0) qr[d0] = *(const bf16x8*)(Qw + (size_t)r32 * 384 + d0 * 16 + hi * 8);
    float mhat = 0.f, l_reg = 0.f; f32x16 o[2]; o[0] = f32x16{}; o[1] = f32x16{};
    bool resc = false;
    f32x16 pA0, pA1, pB0, pB1;
    int sl_prev = 0, sl_cur = 0, sl_next = 1;
#define A2_ROT() do { sl_prev = sl_cur; sl_cur = sl_next; sl_next = (sl_next == 2) ? 0 : sl_next + 1; } while (0)
#define A2_RESC() do { if (!NOMAX && resc) { asm volatile("s_waitcnt lgkmcnt(0)" ::: "memory"); \
        _Pragma("unroll") for (int d_ = 0; d_ < 2; ++d_) _Pragma("unroll") for (int r = 0; r < 16; ++r) o[d_][r] *= wsf[crow(r, hi)]; } } while (0)
    A2_DMA_K(2, 2);
    A2_WAIT_BAR(5);
    { kload2(kf, kp0, 0); kload2(kf, kp0, 1); kload2(kf, kp0, 2); kload2(kf, kp0, 3); kload2(kf, kp0, 4); kload2(kf, kp0, 5);
      pA0 = f32x16{}; pA1 = f32x16{};
#pragma unroll
      for (int d0 = 0; d0 < 6; ++d0) { pA0 = __builtin_amdgcn_mfma_f32_32x32x16_bf16(kf[2 * d0], qr[d0], pA0, 0, 0, 0); pA1 = __builtin_amdgcn_mfma_f32_32x32x16_bf16(kf[2 * d0 + 1], qr[d0], pA1, 0, 0, 0); }
      if constexpr (!NOMAX) { float a = fmaxf(pA0[0], pA1[0]);
#pragma unroll
      for (int r = 1; r < 16; ++r) a = fmaxf(a, fmaxf(pA0[r], pA1[r]));
      { auto rr = __builtin_amdgcn_permlane32_swap(__float_as_uint(a), __float_as_uint(a), false, false); a = fmaxf(__uint_as_float(rr[0]), __uint_as_float(rr[1])); }
      mhat = a; }
#pragma unroll
      for (int r = 0; r < 16; ++r) { pA0[r] = __builtin_amdgcn_exp2f(pA0[r] - mhat); pA1[r] = __builtin_amdgcn_exp2f(pA1[r] - mhat); } }
    A2_WAIT_BAR(0);
    A2_DMA_K(3, 0); A2_DMA_V(1, 1);
    A2_ROT();
    { const LAS char* kp = kp0 + sl_cur * KSL; kload2(kf, kp, 0); kload2(kf, kp, 1); kload2(kf, kp, 2); kload2(kf, kp, 3); kload2(kf, kp, 4); kload2(kf, kp, 5); }
    A2_WAIT_BAR(3);
    s16x4 vlo[8], vhi[8]; u32x4 pw0, pw1, pw2, pw3;
#define A2_PKW(P, B) cvtpk_s(P[B], P[B + 1])
#define A2_PAF(k) __builtin_bit_cast(bf16x8, pw##k)
#define A2_VFR(i) (bf16x8){vlo[i][0], vlo[i][1], vlo[i][2], vlo[i][3], vhi[i][0], vhi[i][1], vhi[i][2], vhi[i][3]}
#define A2_PIN(x) asm volatile("" : "+v"(x))
#define A2_MX3(a, b, c) __builtin_fmaxf(__builtin_fmaxf((a), (b)), (c))
#define A2_GAPA(MF, A0, A1, A2, A3, W0, W1, PW) do { MF; sacc += A0; sacc += A1; sacc += A2; sacc += A3; A2_PIN(sacc); W0; W1; A2_PIN(PW); A2_SBAR(); } while (0)
#define A2_GAPM(MF) do { MF; A2_SBAR(); } while (0)
#define A2_EX(v) __builtin_amdgcn_exp2f(v)
#define A2_SH(v) (NOMAX ? (v) : (v) - mhat)
#define A2_GAPB(MF, X, B) do { MF; X[B] = A2_EX(A2_SH(X[B])); X[B + 1] = A2_EX(A2_SH(X[B + 1])); X[B + 2] = A2_EX(A2_SH(X[B + 2])); X[B + 3] = A2_EX(A2_SH(X[B + 3])); A2_PIN(X); A2_SBAR(); } while (0)
#define A2_VRD(i) do { vlo[i] = vtr(vp_ + (((i) >> 2) * 4096 + ((i) & 3) * 1024)); vhi[i] = vtr(vp_ + (((i) >> 2) * 4096 + ((i) & 3) * 1024 + 512)); } while (0)
#define A2_KRD(G, j) do { if (G) { kload2(kf, kp0 + sl_next * KSL, j); A2_SBAR(); } } while (0)
#define A2_MF(C, kk, qq, CI) C = __builtin_amdgcn_mfma_f32_32x32x16_bf16(kf[kk], qr[qq], CI, 0, 0, 0)
#define A2_STEP(C0, C1, P0, P1, t, GK, GV, GL) do { A2_SBAR(); \
    const LAS char* vp_ = vp0 + sl_prev * VSL; \
    A2_VRD(0); A2_SBAR(); float sacc = (P0[0] + P0[1]); \
    A2_GAPA(A2_MF(C0, 0, 0, (f32x16{})), P0[2], P0[3], P0[4], P0[5],     pw0[0] = A2_PKW(P0, 0), pw0[1] = A2_PKW(P0, 2), pw0); \
    A2_VRD(4); A2_SBAR(); A2_GAPA(A2_MF(C1, 1, 0, (f32x16{})), P0[6], P0[7], P0[8], P0[9],     pw0[2] = A2_PKW(P0, 4), pw0[3] = A2_PKW(P0, 6), pw0); \
    A2_VRD(1); A2_SBAR(); A2_GAPA(A2_MF(C0, 2, 1, C0),   P0[10], P0[11], P0[12], P0[13], pw1[0] = A2_PKW(P0, 8), pw1[1] = A2_PKW(P0, 10), pw1); \
    A2_VRD(5); A2_SBAR(); A2_GAPA(A2_MF(C1, 3, 1, C1),   P0[14], P0[15], P1[0], P1[1],   pw1[2] = A2_PKW(P0, 12), pw1[3] = A2_PKW(P0, 14), pw1); \
    A2_VRD(2); A2_SBAR(); A2_GAPA(A2_MF(C0, 4, 2, C0),   P1[2], P1[3], P1[4], P1[5],     pw2[0] = A2_PKW(P1, 0), pw2[1] = A2_PKW(P1, 2), pw2); \
    A2_VRD(6); A2_SBAR(); A2_GAPA(A2_MF(C1, 5, 2, C1),   P1[6], P1[7], P1[8], P1[9],     pw2[2] = A2_PKW(P1, 4), pw2[3] = A2_PKW(P1, 6), pw2); \
    A2_VRD(3); A2_SBAR(); A2_GAPA(A2_MF(C0, 6, 3, C0),   P1[10], P1[11], P1[12], P1[13], pw3[0] = A2_PKW(P1, 8), pw3[1] = A2_PKW(P1, 10), pw3); \
    A2_VRD(7); A2_SBAR(); A2_GAPA(A2_MF(C1, 7, 3, C1),   P1[14], P1[15], 0.f, 0.f,       pw3[2] = A2_PKW(P1, 12), pw3[3] = A2_PKW(P1, 14), pw3); \
    A2_GAPM(A2_MF(C0, 8, 4, C0)); A2_GAPM(A2_MF(C1, 9, 4, C1)); A2_GAPM(A2_MF(C0, 10, 5, C0)); A2_GAPM(A2_MF(C1, 11, 5, C1)); \
    l_reg += sacc; \
    if (GK) { A2_DMA_K((t) + 3, sl_cur); } if (GV) { A2_DMA_V((t) + 1, sl_next); } \
    if constexpr (!NOMAX) { float a = A2_MX3(C0[0], C0[1], C1[0]), b = A2_MX3(C0[2], C0[3], C1[1]); a = A2_MX3(a, C1[2], C1[3]); \
      _Pragma("unroll") for (int r = 4; r < 16; r += 4) { a = A2_MX3(a, C0[r], C0[r + 1]); b = A2_MX3(b, C0[r + 2], C0[r + 3]); a = A2_MX3(a, C1[r], C1[r + 1]); b = A2_MX3(b, C1[r + 2], C1[r + 3]); } \
      float rm = __builtin_fmaxf(a, b); { auto rr = __builtin_amdgcn_permlane32_swap(__float_as_uint(rm), __float_as_uint(rm), false, false); rm = __builtin_fmaxf(__uint_as_float(rr[0]), __uint_as_float(rr[1])); } \
      resc = false; \
      if (__builtin_expect(__any(rm - mhat > 8.0f), 0)) { const float dl = __builtin_fmaxf(rm - mhat, 0.f); mhat += dl; \
        const float f = __builtin_amdgcn_exp2f(-dl); l_reg *= f; if (hi == 0) wsf[r32] = f; resc = true; } } \
    A2_SBAR(); \
    A2_GAPB(o[0] = __builtin_amdgcn_mfma_f32_32x32x16_bf16(A2_PAF(0), A2_VFR(0), o[0], 0, 0, 0), C0, 0); \
    A2_KRD(GL, 0); A2_GAPB(o[1] = __builtin_amdgcn_mfma_f32_32x32x16_bf16(A2_PAF(0), A2_VFR(4), o[1], 0, 0, 0), C0, 4); \
    A2_KRD(GL, 1); A2_GAPB(o[0] = __builtin_amdgcn_mfma_f32_32x32x16_bf16(A2_PAF(1), A2_VFR(1), o[0], 0, 0, 0), C0, 8); \
    A2_KRD(GL, 2); A2_GAPB(o[1] = __builtin_amdgcn_mfma_f32_32x32x16_bf16(A2_PAF(1), A2_VFR(5), o[1], 0, 0, 0), C0, 12); \
    A2_KRD(GL, 3); A2_GAPB(o[0] = __builtin_amdgcn_mfma_f32_32x32x16_bf16(A2_PAF(2), A2_VFR(2), o[0], 0, 0, 0), C1, 0); \
    A2_KRD(GL, 4); A2_GAPB(o[1] = __builtin_amdgcn_mfma_f32_32x32x16_bf16(A2_PAF(2), A2_VFR(6), o[1], 0, 0, 0), C1, 4); \
    A2_KRD(GL, 5); A2_GAPB(o[0] = __builtin_amdgcn_mfma_f32_32x32x16_bf16(A2_PAF(3), A2_VFR(3), o[0], 0, 0, 0), C1, 8); \
    A2_GAPB(o[1] = __builtin_amdgcn_mfma_f32_32x32x16_bf16(A2_PAF(3), A2_VFR(7), o[1], 0, 0, 0), C1, 12); \
    } while (0)
    int t = 1;
    for (; t + 5 < NT; t += 2) {
        A2_STEP(pB0, pB1, pA0, pA1, t, true, true, true);     A2_WAIT_BAR(3); A2_RESC(); A2_ROT();
        A2_STEP(pA0, pA1, pB0, pB1, t + 1, true, true, true); A2_WAIT_BAR(3); A2_RESC(); A2_ROT();
    }
#define A2_ENDW(tt) do { if ((tt) + 3 < NT) { A2_WAIT_BAR(3); } else if ((tt) + 2 < NT) { A2_WAIT_BAR(1); } else { A2_WAIT_BAR(0); } } while (0)
    for (; t + 1 < NT; t += 2) {
        A2_STEP(pB0, pB1, pA0, pA1, t, (t + 3 < NT), (t + 1 < NT), (t + 1 < NT));     A2_ENDW(t);     A2_RESC(); A2_ROT();
        A2_STEP(pA0, pA1, pB0, pB1, t + 1, (t + 4 < NT), (t + 2 < NT), (t + 2 < NT)); A2_ENDW(t + 1); A2_RESC(); A2_ROT();
    }
    A2_STEP(pB0, pB1, pA0, pA1, NT - 1, false, false, false); A2_RESC();
    { float sacc = pB0[0] + pB0[1];
#pragma unroll
      for (int r = 2; r < 16; ++r) sacc += pB0[r];
#pragma unroll
      for (int r = 0; r < 16; ++r) sacc += pB1[r];
      l_reg += sacc;
      pw0 = (u32x4){A2_PKW(pB0, 0), A2_PKW(pB0, 2), A2_PKW(pB0, 4), A2_PKW(pB0, 6)}; pw1 = (u32x4){A2_PKW(pB0, 8), A2_PKW(pB0, 10), A2_PKW(pB0, 12), A2_PKW(pB0, 14)};
      pw2 = (u32x4){A2_PKW(pB1, 0), A2_PKW(pB1, 2), A2_PKW(pB1, 4), A2_PKW(pB1, 6)}; pw3 = (u32x4){A2_PKW(pB1, 8), A2_PKW(pB1, 10), A2_PKW(pB1, 12), A2_PKW(pB1, 14)};
      A2_SBAR();
      const int vb = (int)lds0 + LDS_V + ((lane >> 4) & 1) * 32 + (lane & 3) * 8 + (4 * hi + ((lane & 15) >> 2)) * 64 + sl_cur * VSL;
      att::pv(o, vb, A2_PAF(0), A2_PAF(1), A2_PAF(2), A2_PAF(3)); }
    { auto rr = __builtin_amdgcn_permlane32_swap(__float_as_uint(l_reg), __float_as_uint(l_reg), false, false); l_reg = __uint_as_float(rr[0]) + __uint_as_float(rr[1]); }
    if (hi == 0) wsf[32 + r32] = l_reg; LDS_WAIT();
    float rli[16];
#pragma unroll
    for (int r = 0; r < 16; ++r) rli[r] = __builtin_amdgcn_rcpf(wsf[32 + crow(r, hi)]);
    LAS bf16_t* stg = (LAS bf16_t*)(F.lds + LDS_OST) + wid * 2048;
#pragma unroll
    for (int r = 0; r < 16; ++r) { const int orow_ = crow(r, hi);
#pragma unroll
        for (int d0 = 0; d0 < 2; ++d0) stg[orow_ * 64 + d0 * 32 + r32] = (bf16_t)f2bf(o[d0][r] * rli[r]); }
    LDS_WAIT();
    bf16_t* Ow = (bf16_t*)(F.ws + WS_YC) + (size_t)(orow + wid * 32) * 1024 + 256 + h * 64;
#pragma unroll
    for (int i = 0; i < 4; ++i) { const int row = i * 8 + (lane >> 3), ch = lane & 7; const u32x4 v = *(const LAS u32x4*)(stg + row * 64 + ch * 8); *(u32x4*)(Ow + (size_t)row * 1024 + ch * 8) = v; }
    asm volatile("s_waitcnt lgkmcnt(0)\n\ts_barrier" ::: "memory");
}
}

__device__ __forceinline__ void ph_norm2_route(const Frame& F, int l, int ntok) {
    LAS bf16_t* A = (LAS bf16_t*)F.lds;
    LAS float* PART = (LAS float*)(F.lds + 66048);
    LAS float* LOG = (LAS float*)(F.lds + 131584);
    LAS int* HIST = (LAS int*)(F.lds + 139776);
    const int tid = F.tid, lane = F.lane, wave = F.wave, r32 = lane & 31, hi = lane >> 5;
    const int tpb = ntok / F.G, tok0 = F.bx * tpb;
    int* eidx = (int*)(F.ws + T_EIDX); float* ew = (float*)(F.ws + T_EW);
    const float* brt = F.in[I_BRT] + l * 64;
    if (tid < 64) HIST[tid] = 0;
    LAS f32x4* AV = (LAS f32x4*)(F.lds + 140288);
    LAS f32x4* SHV = AV + 512;
    const int mr_first = mod_row_of(tok0), mr_last = mod_row_of(tok0 + tpb - 1);
    { const int set = tid >> 8, idx = tid & 255, mrs = set ? mr_last : mr_first;
      const f32x4 gv = ((const f32x4*)(F.in[I_GFFN] + l * 1024))[idx], scv = ((const f32x4*)modp(F, l, mrs, 4))[idx];
      AV[tid] = gv * (scv + 1.0f); SHV[tid] = ((const f32x4*)modp(F, l, mrs, 3))[idx]; }
    bf16x8 wrt[2][8];
#pragma unroll
    for (int nt = 0; nt < 2; ++nt)
#pragma unroll
        for (int ks = 0; ks < 8; ++ks) wrt[nt][ks] = *(const bf16x8*)((const bf16_t*)(F.ws + W_RT) + (size_t)(nt * 32 + r32) * 1024 + wave * 128 + ks * 16 + hi * 8);
    f32x4 xn[4][4]; u32x2 mn[4][4];
#pragma unroll
    for (int rr = 0; rr < 4; ++rr) { const int t = min(wave * 4 + rr, tpb - 1); const f32x4* xr = (const f32x4*)stream_row(F, l, tok0 + t) + lane; const u32x2* mg = (const u32x2*)((const bf16_t*)(F.ws + WS_YC) + (size_t)(tok0 + t) * 1024) + lane;
#pragma unroll
        for (int j = 0; j < 4; ++j) { xn[rr][j] = xr[64 * j]; mn[rr][j] = mg[64 * j]; } }
    for (int b0 = 0; b0 < tpb; b0 += 32) {
        __syncthreads();
        { f32x4 v[4][4];
#pragma unroll
          for (int rr = 0; rr < 4; ++rr) {
#pragma unroll
                for (int j = 0; j < 4; ++j) { const u32x2 w = mn[rr][j]; v[rr][j] = xn[rr][j] + (f32x4){bflo(w.x), bfhi(w.x), bflo(w.y), bfhi(w.y)}; } }
#pragma unroll
          for (int rr = 0; rr < 4; ++rr) { const int r = wave * 4 + rr, t = b0 + r; LAS u32x2* a = (LAS u32x2*)(A + r * 1032) + lane;
            if (t < tpb) { const int row = tok0 + t, mr = mod_row_of(row); f32x4 y[4];
                f32x4* xo = (f32x4*)((row < NLAT) ? F.out + (size_t)row * 1024 : (float*)(F.ws + WS_CTXS) + (size_t)(row - NLAT) * 1024) + lane;
#pragma unroll
                for (int j = 0; j < 4; ++j) xo[64 * j] = v[rr][j];
                { float s2 = 0.f;
#pragma unroll
                  for (int j = 0; j < 4; ++j) s2 += (v[rr][j].x * v[rr][j].x + v[rr][j].y * v[rr][j].y) + (v[rr][j].z * v[rr][j].z + v[rr][j].w * v[rr][j].w);
                  const float rstd = frsq(wave_sum(s2) * (1.f / 1024.f) + EPS); const int vb = (mr == mr_first ? 0 : 256) + lane;
#pragma unroll
                  for (int j = 0; j < 4; ++j) y[j] = v[rr][j] * rstd * AV[vb + 64 * j] + SHV[vb + 64 * j]; }
                unsigned* o8 = (unsigned*)(F.ws + WS_HX8 + (size_t)row * 1024) + lane;
#pragma unroll
                for (int j = 0; j < 4; ++j) { a[64 * j] = (u32x2){pk2(y[j].x, y[j].y), pk2(y[j].z, y[j].w)}; o8[64 * j] = pk4_fp8(y[j].x, y[j].y, y[j].z, y[j].w); }
            } else {
#pragma unroll
                for (int j = 0; j < 4; ++j) a[64 * j] = (u32x2){0u, 0u}; } } }
        if (b0 + 32 < tpb) {
#pragma unroll
            for (int rr = 0; rr < 4; ++rr) { const int t = min(b0 + 32 + wave * 4 + rr, tpb - 1); const f32x4* xr = (const f32x4*)stream_row(F, l, tok0 + t) + lane; const u32x2* mg = (const u32x2*)((const bf16_t*)(F.ws + WS_YC) + (size_t)(tok0 + t) * 1024) + lane;
#pragma unroll
                for (int j = 0; j < 4; ++j) { xn[rr][j] = xr[64 * j]; mn[rr][j] = mg[64 * j]; } } }
        __syncthreads();
#pragma unroll
        for (int nt = 0; nt < 2; ++nt) { f32x16 acc = {};
#pragma unroll
            for (int ks = 0; ks < 8; ++ks) { const bf16x8 a = *(const LAS bf16x8*)(A + wave * 128 + r32 * 1032 + ks * 16 + hi * 8); acc = __builtin_amdgcn_mfma_f32_32x32x16_bf16(a, wrt[nt][ks], acc, 0, 0, 0); }
#pragma unroll
            for (int r = 0; r < 16; ++r) PART[(wave * 32 + crow(r, hi)) * 64 + nt * 32 + r32] = acc[r]; }
        __syncthreads();
        for (int i = tid; i < 2048; i += NTHR) { float s = 0.f;
#pragma unroll
            for (int w = 0; w < 8; ++w) s += PART[w * 2048 + i];
            LOG[i] = s; }
        __syncthreads();
        for (int rr = 0; rr < 4; ++rr) { const int r = wave * 4 + rr, t = b0 + r; if (t >= tpb) continue;
            const float sc = sigmoidf_(LOG[r * 64 + lane]); float v = sc + brt[lane]; float ssel = 0.f, mys = 0.f; int myi = 0;
#pragma unroll
            for (int k = 0; k < TOPK; ++k) { const float mx = wave_max(v); const unsigned long long bal = __ballot(v == mx); const int win = __ffsll((long long)bal) - 1;
                const float sw = lane_bcast(sc, win); ssel += sw; if (lane == k) { mys = sw; myi = win; } if (lane == win) v = -INFINITY; }
            if (lane < TOPK) { eidx[(size_t)(tok0 + t) * 6 + lane] = myi; ew[(size_t)(tok0 + t) * 6 + lane] = mys * frcp(ssel) * 2.5f; __hip_atomic_fetch_add(&HIST[myi], 1, __ATOMIC_RELAXED, __HIP_MEMORY_SCOPE_WORKGROUP); } }
    }
    __syncthreads();
    if (tid < 64) ((int*)(F.ws + T_HIST))[F.bx * 64 + tid] = HIST[tid];
}

__device__ __forceinline__ void ph_assign(const Frame& F, int ntok) {
    LAS int* BASE = (LAS int*)F.lds; LAS int* CUR = BASE + 64; LAS int* START = BASE + 128; LAS int* TOT = BASE + 192; LAS int* MISC = BASE + 256;
    const int tid = F.tid, hb = F.G, c = 0, tpb = ntok / F.G, ctok0 = 0, ctoks = ntok;
    const int* hist = (const int*)(F.ws + T_HIST); int* rtok = (int*)(F.ws + T_RTOK); float* rw = (float*)(F.ws + T_RW); int* slot = (int*)(F.ws + T_SLOT);
    int* tile_e = (int*)(F.ws + T_TILEE);
    __syncthreads();
    { LAS int* PT = BASE + 512; LAS int* PB = PT + 512;
      const int e = tid & 63, part = tid >> 6; int tot = 0, bef = 0;
#pragma unroll 8
      for (int k = 0; k < 32; ++k) { const int b = c * hb + part * 32 + k; if (b < (c + 1) * hb) { const int v = hist[b * 64 + e]; tot += v; if (b < F.bx) bef += v; } }
      PT[part * 64 + e] = tot; PB[part * 64 + e] = bef; }
    __syncthreads();
    if (tid < 64) { int tot = 0, bef = 0; for (int p8 = 0; p8 < 8; ++p8) { tot += BASE[512 + p8 * 64 + tid]; bef += BASE[1024 + p8 * 64 + tid]; } TOT[tid] = tot; BASE[tid] = bef; CUR[tid] = 0; }
    __syncthreads();
    if (tid == 0) { int s = 0; for (int e = 0; e < 64; ++e) { START[e] = s; s += (TOT[e] + 255) / 256 * 256; } MISC[0] = s; }
    __syncthreads();
    const int sstart = MISC[0];
    const int* eidx = (const int*)(F.ws + T_EIDX); const float* ew = (const float*)(F.ws + T_EW);
    for (int i = tid; i < tpb * 6; i += NTHR) { const int tok = F.bx * tpb + i / 6, k = i % 6; const int e = eidx[(size_t)tok * 6 + k];
        const int pos = START[e] + BASE[e] + __hip_atomic_fetch_add(&CUR[e], 1, __ATOMIC_RELAXED, __HIP_MEMORY_SCOPE_WORKGROUP); rtok[pos] = tok; rw[pos] = ew[(size_t)tok * 6 + k]; slot[(size_t)tok * 8 + k] = pos; }
    for (int i = tid; i < tpb; i += NTHR) { const int tok = F.bx * tpb + i, pos = sstart + (tok - ctok0); rtok[pos] = tok; rw[pos] = 1.0f; slot[(size_t)tok * 8 + 6] = pos; }
    if (F.bx == c * hb) {
        for (int e = 0; e < 64; ++e) { const int p0 = START[e] + TOT[e], p1 = START[e] + (TOT[e] + 255) / 256 * 256;
            for (int p = p0 + tid; p < p1; p += NTHR) { rtok[p] = ctok0; rw[p] = 0.f; }
            for (int tl = START[e] / 256 + tid; tl < p1 / 256; tl += NTHR) tile_e[tl] = e; }
        for (int tl = sstart / 256 + tid; tl < (sstart + ctoks) / 256; tl += NTHR) tile_e[tl] = 64;
        if (tid == 0) tile_e[2047] = (sstart + ctoks) / 256;
    }
}

template <bool FUSE_NORM> __device__ __forceinline__ void ph_combine(const Frame& F, int l, int c, int ntok) {
    const int lane = F.lane; const int tpb = ntok / F.G, tok0 = F.bx * tpb; (void)c;
    const int* slot = (const int*)(F.ws + T_SLOT); const unsigned char* ys = (const unsigned char*)(F.ws + WS_YS);
    int mr_cur = -1; f32x4 gtv[2][2], av[2][2], shv[2][2];
    for (int t = F.wave; t < tpb; t += NWAVES) { const int tok = tok0 + t, mr = mod_row_of(tok);
        if (mr != mr_cur) { mr_cur = mr; const float* gt = modp(F, l, mr, 5);
#pragma unroll
            for (int j = 0; j < 2; ++j)
#pragma unroll
                for (int h2 = 0; h2 < 2; ++h2) { const int c0 = 8 * lane + 512 * j + 4 * h2; gtv[j][h2] = *(const f32x4*)(gt + c0);
                    if constexpr (FUSE_NORM) { const f32x4 gv = *(const f32x4*)(F.in[I_GMIX] + 1024 + c0), scv = *(const f32x4*)(modp(F, 1, mr, 1) + c0); av[j][h2] = gv * (scv + 1.0f); shv[j][h2] = *(const f32x4*)(modp(F, 1, mr, 0) + c0); } } }
        float* xr = (tok < NLAT) ? F.out + (size_t)tok * 1024 : (float*)(F.ws + WS_CTXS) + (size_t)(tok - NLAT) * 1024;
        const int sv = slot[(size_t)tok * 8 + (lane & 7)];
        u32x2 y[7][2];
#pragma unroll
        for (int k = 0; k < 7; ++k) { const int sk = __builtin_amdgcn_readlane(sv, k); const u32x2* yr = (const u32x2*)(ys + (size_t)sk * 1024) + lane; y[k][0] = yr[0]; y[k][1] = yr[64]; }
        f32x4 xv[2][2];
#pragma unroll
        for (int j = 0; j < 2; ++j) { xv[j][0] = *(const f32x4*)(xr + 8 * lane + 512 * j); xv[j][1] = *(const f32x4*)(xr + 8 * lane + 512 * j + 4); }
#pragma unroll
        for (int j = 0; j < 2; ++j) { f32x4 a0 = {0.f, 0.f, 0.f, 0.f}, a1 = {0.f, 0.f, 0.f, 0.f};
#pragma unroll
            for (int k = 0; k < 7; ++k) { a0 += up4_fp8(y[k][j].x); a1 += up4_fp8(y[k][j].y); }
            xv[j][0] = xv[j][0] + gtv[j][0] * a0; xv[j][1] = xv[j][1] + gtv[j][1] * a1;
            *(f32x4*)(xr + 8 * lane + 512 * j) = xv[j][0]; *(f32x4*)(xr + 8 * lane + 512 * j + 4) = xv[j][1]; }
        if constexpr (FUSE_NORM) {
            float ss = 0.f;
#pragma unroll
            for (int j = 0; j < 2; ++j)
#pragma unroll
                for (int h2 = 0; h2 < 2; ++h2) { const f32x4 v = xv[j][h2]; ss += (v.x * v.x + v.y * v.y) + (v.z * v.z + v.w * v.w); }
            const float rstd = frsq(wave_sum(ss) * (1.f / 1024.f) + EPS);
            bf16_t* hx = (bf16_t*)(F.ws + WS_HX) + (size_t)tok * 1024; unsigned char* h8 = F.ws + WS_HX8 + (size_t)tok * 1024;
#pragma unroll
            for (int j = 0; j < 2; ++j) { const int c0 = 8 * lane + 512 * j; f32x4 y[2];
#pragma unroll
                for (int h2 = 0; h2 < 2; ++h2) y[h2] = xv[j][h2] * rstd * av[j][h2] + shv[j][h2];
                *(u32x4*)(hx + c0) = (u32x4){pk2(y[0].x, y[0].y), pk2(y[0].z, y[0].w), pk2(y[1].x, y[1].y), pk2(y[1].z, y[1].w)};
                *(u32x2*)(h8 + c0) = (u32x2){pk4_fp8(y[0].x, y[0].y, y[0].z, y[0].w), pk4_fp8(y[1].x, y[1].y, y[1].z, y[1].w)}; }
        }
    }
}
__device__ __forceinline__ Frame phase_frame(const Frame& F) {
    Frame Q = F; int t = threadIdx.x; asm volatile("" : "+v"(t)); Q.tid = t; Q.lane = t & 63; Q.wave = __builtin_amdgcn_readfirstlane(t >> 6);
    unsigned long long w = (unsigned long long)F.ws; asm volatile("" : "+s"(w)); Q.ws = (unsigned char*)(GAS unsigned char*)w;
    return Q;
}
constexpr int PH_PER_LAYER = 13, PH_TOTAL = 1 + 2 * PH_PER_LAYER;
__global__ void __launch_bounds__(NTHR, 2) mk_fwd(Params p) {
    extern __shared__ __attribute__((aligned(16))) unsigned char lds_raw[];
    Frame F0;
    F0.lds = (LAS unsigned char*)lds_raw; F0.ws = p.ws; F0.in = p.in; F0.out = p.out;
    F0.tid = threadIdx.x; F0.lane = F0.tid & 63; F0.wave = __builtin_amdgcn_readfirstlane(F0.tid >> 6); F0.bx = blockIdx.x; F0.G = gridDim.x;
    volatile LAS unsigned* MISC = (volatile LAS unsigned*)(F0.lds + MISC_OFF);
    if (F0.tid < 64) MISC[F0.tid] = 0u;
    __syncthreads();
    const int lo = p.ph_lo, hi = p.ph_hi;
    XcdBarrier bar; bar.bar = (unsigned*)(F0.ws + WS_CTL) + CW_BAR; bar.x = 0; bar.st = MISC + 8;
    if (hi - lo > 1) bar = xcd_barrier_post((unsigned*)(F0.ws + WS_CTL) + CW_BAR, MISC + 8);
#ifndef MK_SITE
#define MK_SITE -1
#endif
#define SITE(n) (MK_SITE < 0 || MK_SITE == (n))
#ifndef MK_REP_MASK
#define MK_REP_MASK 0
#endif
#define NREP(n) (((MK_REP_MASK >> (n)) & 1) ? 2 : 1)
#define RUN(k) (lo <= (k) && (k) < hi)
#define SEAM(k) do { if (RUN(k) && RUN((k) + 1)) { TSEC_BEGIN(300, F0.lds); xcd_barrier(bar); TSEC_END(300, F0.lds); } } while (0)
    int ph = 0;
    if (SITE(0) && RUN(ph)) TSEC_BEGIN(400 + 0, F0.lds); if (SITE(0) && RUN(ph)) for (int rep_ = 0; rep_ < NREP(0); ++rep_) { const Frame F = phase_frame(F0); ph_pre(F); }
    TSEC_END(400 + 99, F0.lds); SEAM(ph); ++ph;
    for (int l = 0; l < 2; ++l) {
        const int ntok = (l == 0) ? NTOK : NLAT, nM = ntok / 256;
        if (SITE(1) && RUN(ph)) TSEC_BEGIN(400 + 1, F0.lds); if (SITE(1) && RUN(ph)) for (int rep_ = 0; rep_ < NREP(1); ++rep_) { const Frame F = phase_frame(F0); ph_convert(F, l); __syncthreads(); if (l == 0) ph_norm1(F, l); }
        TSEC_END(400 + 99, F0.lds); SEAM(ph); ++ph;
        if (SITE(2) && RUN(ph)) TSEC_BEGIN(400 + 2, F0.lds); if (SITE(2) && RUN(ph)) for (int rep_ = 0; rep_ < NREP(2); ++rep_) { const Frame F = phase_frame(F0);
            SchedPlain S{(const char*)(F.ws + WS_HX), (const char*)(F.ws + W_IN), 2048u, 2048u, 16, NTOK / 256, INCP / 256, F.G, F.bx};
            EpiWin E{(bf16_t*)(F.ws + WS_PX), (float*)(F.ws + T_GATE)};
            gg::gemm_phase(F.lds, S, E);
        }
        TSEC_END(400 + 99, F0.lds); SEAM(ph); ++ph;
        if (SITE(3) && RUN(ph)) TSEC_BEGIN(400 + 3, F0.lds); if (SITE(3) && RUN(ph)) for (int rep_ = 0; rep_ < NREP(3); ++rep_) { const Frame F = phase_frame(F0);
            for (int r2 = 0; r2 < NREP(16); ++r2) mla_prep(F, l);
            for (int r2 = 0; r2 < NREP(17); ++r2) { P1Regs R = ml_pass1_load(F, F.bx);
                for (int u = F.bx; u < 64 * NCHK; u += F.G) { const P1Regs Rn = ml_pass1_load(F, (u + F.G < 64 * NCHK) ? u + F.G : u); ml_pass1_unit(F, l, u, R); R = Rn; } }
            for (int r2 = 0; r2 < NREP(18); ++r2) { PoolRegs R = pool_load(F, F.bx);
                for (int u = F.bx; u < ntok / 64; u += F.G) { const PoolRegs Rn = pool_load(F, (u + F.G < ntok / 64) ? u + F.G : u); pool_unit(F, l, u, R); R = Rn; } }
            for (int r2 = 0; r2 < NREP(19); ++r2) conv_all(F, l, ntok);
            __syncthreads();
        }
        TSEC_END(400 + 99, F0.lds); SEAM(ph); ++ph;
        if (SITE(4) && RUN(ph)) TSEC_BEGIN(400 + 4, F0.lds); if (SITE(4) && RUN(ph)) for (int rep_ = 0; rep_ < NREP(4); ++rep_) { const Frame F = phase_frame(F0);
            ml_pass2(F);
            float gq = 0.f, gk = 0.f; for (int d = 0; d < 96; ++d) { gq = fmaxf(gq, fabsf(F.in[I_GQN][l * 96 + d])); gk = fmaxf(gk, fabsf(F.in[I_GKN][l * 96 + d])); }
            const bool nomax = (14.2f * gq * gk <= 64.0f);
            const int nunits = 1024 + (l == 0 ? 32 : 0);
#define ATT_UNITS(NM) for (int i = 0; ; ++i) { const int L = i * F.G + F.bx; if (L >= nunits) break; \
                if (L < 1024) { const int bh = (L >> 8) * 8 + (L & 7), qb = (L & 255) >> 3, b = bh >> 2; att2::unit<NM>(F, bh, b * 8192 + qb * 256, b * 8192 + qb * 256, 132); } \
                else { const int bh = L - 1024, b = bh >> 2; att2::unit<NM>(F, bh, NLAT + b * 256, NLAT + b * 256, 4); } }
            if (nomax) { ATT_UNITS(true) } else { ATT_UNITS(false) }
#undef ATT_UNITS
        }
        TSEC_END(400 + 99, F0.lds); SEAM(ph); ++ph;
        if (SITE(5) && RUN(ph)) TSEC_BEGIN(400 + 5, F0.lds); if (SITE(5) && RUN(ph)) for (int rep_ = 0; rep_ < NREP(5); ++rep_) { const Frame F = phase_frame(F0);
            const int npc = (l == 0) ? 66 : 64, nun = 32 * npc;
            for (int u = F.bx; u < nun; u += F.G) { const int bh = u / npc, pc = u % npc + (l == 0 ? 0 : 2); ml_pass3_unit(F, l, bh >> 2, bh & 3, pc); }
            __syncthreads();
        }
        TSEC_END(400 + 99, F0.lds); SEAM(ph); ++ph;
        {
            const int nMh = nM, pm0 = 0;
            if (SITE(6) && RUN(ph)) TSEC_BEGIN(400 + 6, F0.lds); if (SITE(6) && RUN(ph)) for (int rep_ = 0; rep_ < NREP(6); ++rep_) { const Frame F = phase_frame(F0);
                SchedYB S{(const char*)(F.ws + WS_YC), (const char*)(F.ws + W_BR), pm0, nMh, F.G, F.bx};
                EpiF8Out E{F.ws + WS_YB, 4096};
                gg::gemm_phase(F.lds, S, E);
            }
            TSEC_END(400 + 99, F0.lds); SEAM(ph); ++ph;
            if (SITE(13) && RUN(ph)) TSEC_BEGIN(400 + 13, F0.lds); if (SITE(13) && RUN(ph)) for (int rep_ = 0; rep_ < NREP(13); ++rep_) { const Frame F = phase_frame(F0);
                SchedPlain S{(const char*)(F.ws + WS_HX8) + (size_t)pm0 * 256 * 1024, (const char*)(F.ws + W_GATE), 1024u, 1024u, 8, nMh, 16, F.G, F.bx};
                EpiMerge2 E{(const unsigned char*)(F.ws + WS_YB), F.in[I_BGATE] + l * 4096, F.ws + WS_ACCM + (size_t)pm0 * 256 * 1024, 0};
                gg::gemm_phase(F.lds, S, E);
            }
            TSEC_END(400 + 99, F0.lds); SEAM(ph); ++ph;
        }
        if (SITE(7) && RUN(ph)) TSEC_BEGIN(400 + 7, F0.lds); if (SITE(7) && RUN(ph)) for (int rep_ = 0; rep_ < NREP(7); ++rep_) { const Frame F = phase_frame(F0);
            SchedPlain S{(const char*)(F.ws + WS_ACCM), (const char*)(F.ws + W_OUT), 1024u, 1024u, 8, nM, 4, F.G, F.bx};
            EpiWout E{(bf16_t*)(F.ws + WS_YC), modp(F, l, 0, 2)};
            gg::gemm_phase(F.lds, S, E);
        }
        TSEC_END(400 + 99, F0.lds); SEAM(ph); ++ph;
        if (SITE(8) && RUN(ph)) TSEC_BEGIN(400 + 8, F0.lds); if (SITE(8) && RUN(ph)) for (int rep_ = 0; rep_ < NREP(8); ++rep_) { const Frame F = phase_frame(F0); ph_norm2_route(F, l, ntok); }
        TSEC_END(400 + 99, F0.lds); SEAM(ph); ++ph;
        if (SITE(9) && RUN(ph)) TSEC_BEGIN(400 + 9, F0.lds); if (SITE(9) && RUN(ph)) for (int rep_ = 0; rep_ < NREP(9); ++rep_) { const Frame F = phase_frame(F0); ph_assign(F, ntok); }
        TSEC_END(400 + 99, F0.lds); SEAM(ph); ++ph;
        if (SITE(10) && RUN(ph)) TSEC_BEGIN(400 + 10, F0.lds); if (SITE(10) && RUN(ph)) for (int rep_ = 0; rep_ < NREP(10); ++rep_) { const Frame F = phase_frame(F0);
            int* tile_e = (int*)(F.ws + T_TILEE); const int ntiles = ld_i32_uniform(tile_e + 2047);
            LAS int* tab = (LAS int*)(F.lds + MOE_TAB_OFF); const int* rtok = (const int*)(F.ws + T_RTOK);
            __syncthreads();
            for (int i = 0; i < 28; ++i) { const int L = i * F.G + F.bx; if (L >= ntiles * 2) break; const int tile = L >> 1;
                if (F.tid == 0) tab[i] = tile_e[tile]; if (F.tid < 256) tab[256 + i * 256 + F.tid] = rtok[tile * 256 + F.tid]; }
            __syncthreads();
            SchedMoe1 S{(const char*)(F.ws + WS_HX8), (const char*)(F.ws + W_13), tab, ntiles, F.G, F.bx};
            EpiMoe1 E{F.ws + WS_AMOE, (const float*)(F.ws + T_RW)};
            gg::gemm_phase(F.lds, S, E);
        }
        TSEC_END(400 + 99, F0.lds); SEAM(ph); ++ph;
        if (SITE(11) && RUN(ph)) TSEC_BEGIN(400 + 11, F0.lds); if (SITE(11) && RUN(ph)) for (int rep_ = 0; rep_ < NREP(11); ++rep_) { const Frame F = phase_frame(F0);
            int* tile_e = (int*)(F.ws + T_TILEE); const int ntiles = ld_i32_uniform(tile_e + 2047);
            LAS int* tab = (LAS int*)(F.lds + MOE_TAB_OFF);
            __syncthreads();
            for (int i = F.tid; i < 64; i += NTHR) { const int L = i * F.G + F.bx; if (L < ntiles * 4) tab[i] = tile_e[L >> 2]; }
            __syncthreads();
            SchedMoe2 S{(const char*)(F.ws + WS_AMOE), (const char*)(F.ws + W_2), tab, ntiles, F.G, F.bx};
            EpiF8OutQ E{(unsigned char*)(F.ws + WS_YS), 1024};
            gg::gemm_phase(F.lds, S, E);
        }
        TSEC_END(400 + 99, F0.lds); SEAM(ph); ++ph;
        if (SITE(12) && RUN(ph)) TSEC_BEGIN(400 + 12, F0.lds); if (SITE(12) && RUN(ph)) for (int rep_ = 0; rep_ < NREP(12); ++rep_) { const Frame F = phase_frame(F0); if (l == 0) ph_combine<true>(F, l, 0, ntok); else ph_combine<false>(F, l, 0, ntok); }
        TSEC_END(400 + 99, F0.lds); SEAM(ph); ++ph;
    }
    if (MK_TSEC >= 0 && blockIdx.x == 0 && threadIdx.x == 0) { volatile LAS unsigned long long* q_ = (volatile LAS unsigned long long*)(F0.lds + MISC_OFF + 128);
        const unsigned long long t0 = __builtin_amdgcn_s_memrealtime(), d = q_[0] * 4ull; while (__builtin_amdgcn_s_memrealtime() - t0 < d) __builtin_amdgcn_s_sleep(8); }
#undef RUN
#undef SEAM
}

extern "C" void kernel_launch(void* const* d_in, const int* in_sizes, int n_in, void* d_out, int out_size, void* d_ws, size_t ws_size, hipStream_t stream) {
    static int grid = 0;
    if (grid == 0) {
        if (n_in != 33 || out_size != NLAT * DM || ws_size < WS_END) { fprintf(stderr, "kernel_launch: unexpected shapes (n_in %d, out %d, ws %zu < %zu)\n", n_in, out_size, ws_size, (size_t)WS_END); grid = -1; return; }
        int dev = 0, cus = 0;
        if (hipGetDevice(&dev) != hipSuccess || hipDeviceGetAttribute(&cus, hipDeviceAttributeMultiprocessorCount, dev) != hipSuccess) { grid = -1; return; }
        if (hipFuncSetAttribute((const void*)mk_fwd, hipFuncAttributeMaxDynamicSharedMemorySize, LDS_BYTES) != hipSuccess) { fprintf(stderr, "kernel_launch: hipFuncSetAttribute failed\n"); grid = -1; return; }
        int per_cu = 0;
        if (hipOccupancyMaxActiveBlocksPerMultiprocessor(&per_cu, (const void*)mk_fwd, NTHR, LDS_BYTES) != hipSuccess || per_cu < 1) fprintf(stderr, "kernel_launch: occupancy query says %d\n", per_cu);
        (void)hipGetLastError();
        if (cus < 256) { fprintf(stderr, "kernel_launch: built for a 256-CU device (got %d CUs)\n", cus); grid = -1; return; }
        grid = 256;
    }
    if (grid < 0) return;
    (void)hipMemsetAsync((char*)d_ws + WS_CTL, 0, CTL_ZERO_BYTES, stream);
    Params p{};
    for (int i = 0; i < 33; ++i) p.in[i] = (const float*)d_in[i];
    p.out = (float*)d_out; p.ws = (unsigned char*)d_ws;
#if MK_ONE_LAUNCH
    p.ph_lo = 0; p.ph_hi = PH_TOTAL;
    hipLaunchKernelGGL(mk_fwd, dim3(grid), dim3(NTHR), LDS_BYTES, stream, p);
#else
    for (int k = 0; k < PH_TOTAL; ++k) { p.ph_lo = k; p.ph_hi = k + 1; hipLaunchKernelGGL(mk_fwd, dim3(grid), dim3(NTHR), LDS_BYTES, stream, p); }
#endif
}
```

```cpp
#include <hip/hip_runtime.h>
#include <stdint.h>
#include <stdio.h>
#include <math.h>

#ifndef MK_ONE_LAUNCH
#define MK_ONE_LAUNCH 1
#endif

#define LAS __attribute__((address_space(3)))
#define GAS __attribute__((address_space(1)))
typedef unsigned short bf16_t;
typedef short bf16x8 __attribute__((ext_vector_type(8)));
typedef short s16x4 __attribute__((ext_vector_type(4)));
typedef float f32x2 __attribute__((ext_vector_type(2)));
typedef float f32x4 __attribute__((ext_vector_type(4)));
typedef float f32x16 __attribute__((ext_vector_type(16)));
typedef unsigned u32x2 __attribute__((ext_vector_type(2)));
typedef unsigned u32x4 __attribute__((ext_vector_type(4)));

constexpr int DM = 1024, NB = 8, SEQ = 8192, CTXL = 256, GRIDW = 64;
constexpr int NLAT = NB * SEQ, NCTX = NB * CTXL, NTOK = NLAT + NCTX;
constexpr int INC = 2480, INCP = 2560;
constexpr int C_ML = 0, C_G = 1024, C_MLA = 1040, C_POOL = 1456, C_CONV = 1712;
constexpr int NE = 64, NE1 = 65, TOPK = 6, NSLOT7 = 7, EFF = 256;
constexpr int NCHK = 66;
constexpr int NKT = 132;
constexpr float EPS = 1e-6f;
constexpr int NWAVES = 8, NTHR = 512;
constexpr int MOE_ROWS_MAX = 489472;
constexpr int MOE_TILES_MAX = MOE_ROWS_MAX / 256;

constexpr size_t MiB = 1u << 20;
constexpr size_t WS_CTL = 0, CTL_ZERO_BYTES = 1 * MiB;
constexpr size_t WS_MOD = 128 * 1024;
constexpr size_t WS_TAB = 1 * MiB;
constexpr size_t T_ROPE = WS_TAB;
constexpr size_t T_HIST = T_ROPE + 16384;
constexpr size_t T_TILEE = T_HIST + 65536;
constexpr size_t T_EIDX = T_TILEE + 8192;
constexpr size_t T_EW = T_EIDX + (size_t)NTOK * 6 * 4;
constexpr size_t T_SLOT = T_EW + (size_t)NTOK * 6 * 4;
constexpr size_t T_RTOK = T_SLOT + (size_t)NTOK * 8 * 4;
constexpr size_t T_RW = T_RTOK + (size_t)MOE_ROWS_MAX * 4;
constexpr size_t T_GATE = T_RW + (size_t)MOE_ROWS_MAX * 4;
constexpr size_t T_DN = T_GATE + (size_t)NTOK * 16 * 4;
constexpr size_t T_NST = T_DN + (size_t)4224 * 64 * 4;
constexpr size_t T_MLOC = T_NST + (size_t)4224 * 64 * 4;
constexpr size_t T_BEND = T_MLOC + 4224 * 4;
constexpr size_t T_MST = T_BEND + 4224 * 4;
constexpr size_t T_END = T_MST + 4224 * 4;
static_assert(T_END <= 17 * MiB, "tables");
constexpr size_t WS_WB = 17 * MiB;
constexpr size_t W_IN = WS_WB;
constexpr size_t W_GATE = W_IN + (size_t)INCP * 1024 * 2;
constexpr size_t W_BR = W_GATE + (size_t)4 * 1024 * 1024 * 2;
constexpr size_t W_OUT = W_BR + (size_t)4 * 1024 * 256 * 2;
constexpr size_t W_13 = W_OUT + (size_t)1024 * 1024 * 2;
constexpr size_t W_2 = W_13 + (size_t)NE1 * 512 * 1024 * 2;
constexpr size_t W_UQ = W_2 + (size_t)NE1 * 1024 * 256 * 2;
constexpr size_t W_UKV = W_UQ + (size_t)384 * 256 * 2;
constexpr size_t W_POOL = W_UKV + (size_t)512 * 128 * 2;
constexpr size_t W_RT = W_POOL + (size_t)4 * 64 * 64 * 2;
constexpr size_t W_END = W_RT + (size_t)64 * 1024 * 2;
static_assert(W_END <= 133 * MiB, "weights");
constexpr size_t WS_CTXS = 133 * MiB;
constexpr size_t WS_HX = 141 * MiB;
constexpr size_t WS_PX = 273 * MiB;
constexpr size_t WS_QB = 593 * MiB;
constexpr size_t WS_KT = 643 * MiB;
constexpr size_t WS_VT = 693 * MiB;
constexpr size_t WS_YC = 726 * MiB;
constexpr size_t WS_DC = 858 * MiB;
constexpr size_t WS_CST = 924 * MiB;
constexpr size_t WS_HX8 = 957 * MiB;
constexpr size_t WS_END = 1023 * MiB;
constexpr size_t WS_ACCM = WS_QB;
constexpr size_t WS_YB = WS_PX;
constexpr size_t WS_AMOE = WS_HX;
constexpr size_t WS_YS = WS_HX + 240 * MiB;
static_assert(WS_AMOE + (size_t)MOE_ROWS_MAX * 512 <= WS_YS && WS_YS + (size_t)MOE_ROWS_MAX * 1024 <= WS_HX8, "moe overlay");
static_assert(WS_YB + (size_t)NTOK * 4096 <= WS_QB && WS_ACCM + (size_t)NTOK * 2048 <= WS_YC, "merge overlay");

constexpr int CW_BAR = 4096;

constexpr int RING_BYTES = 131072;
constexpr int MISC_OFF = 160 * 1024 - 256;
constexpr int LDS_BYTES = 160 * 1024;

#ifndef MK_TSEC
#define MK_TSEC -1
#endif
#define TSEC_BEGIN(id, ldsb) do { if (MK_TSEC == (id) && blockIdx.x == 0 && threadIdx.x == 0) { volatile LAS unsigned long long* q_ = (volatile LAS unsigned long long*)((ldsb) + MISC_OFF + 128); q_[1] = __builtin_amdgcn_s_memrealtime(); } } while (0)
#define TSEC_END(id, ldsb) do { if ((MK_TSEC == (id) || ((id) == 499 && MK_TSEC >= 400 && MK_TSEC < 499)) && blockIdx.x == 0 && threadIdx.x == 0) { volatile LAS unsigned long long* q_ = (volatile LAS unsigned long long*)((ldsb) + MISC_OFF + 128); if (q_[1] != 0ull) { q_[0] += __builtin_amdgcn_s_memrealtime() - q_[1]; q_[1] = 0ull; } } } while (0)
typedef __bf16 bf16x2_t_ __attribute__((ext_vector_type(2)));
__device__ __forceinline__ unsigned pk2(float lo, float hi) { const f32x2 v = {lo, hi}; return __builtin_bit_cast(unsigned, __builtin_convertvector(v, bf16x2_t_)); }
__device__ __forceinline__ unsigned f2bf(float f) { return pk2(f, f) & 0xffffu; }
__device__ __forceinline__ float bf2f(unsigned short b) { return __builtin_bit_cast(float, ((unsigned)b) << 16); }
__device__ __forceinline__ float bflo(unsigned w) { return __builtin_bit_cast(float, w << 16); }
__device__ __forceinline__ float bfhi(unsigned w) { return __builtin_bit_cast(float, w & 0xffff0000u); }
__device__ __forceinline__ unsigned cvt_pk_bf16(float lo, float hi) { unsigned r; asm volatile("v_cvt_pk_bf16_f32 %0, %1, %2" : "=v"(r) : "v"(lo), "v"(hi)); return r; }
__device__ __forceinline__ unsigned pk4_fp8(float a, float b, float c, float d) { int r = __builtin_amdgcn_cvt_pk_fp8_f32(a, b, 0, false); r = __builtin_amdgcn_cvt_pk_fp8_f32(c, d, r, true); return (unsigned)r; }
__device__ __forceinline__ float sigmoidf_(float x) { return __builtin_amdgcn_rcpf(1.0f + __builtin_amdgcn_exp2f(x * -1.4426950408889634f)); }
template <int O> __device__ __forceinline__ float xor_lane(float v) { return __builtin_bit_cast(float, __builtin_amdgcn_ds_swizzle(__builtin_bit_cast(int, v), 0x1f | (O << 10))); }
__device__ __forceinline__ float half_sum(float v) { v += xor_lane<1>(v); v += xor_lane<2>(v); v += xor_lane<4>(v); v += xor_lane<8>(v); v += xor_lane<16>(v); return v; }
__device__ __forceinline__ float half_max(float v) { v = fmaxf(v, xor_lane<1>(v)); v = fmaxf(v, xor_lane<2>(v)); v = fmaxf(v, xor_lane<4>(v)); v = fmaxf(v, xor_lane<8>(v)); v = fmaxf(v, xor_lane<16>(v)); return v; }
__device__ __forceinline__ float wave_sum(float v) { v = half_sum(v); auto rr = __builtin_amdgcn_permlane32_swap(__builtin_bit_cast(unsigned, v), __builtin_bit_cast(unsigned, v), false, false);
    return __builtin_bit_cast(float, (unsigned)rr[0]) + __builtin_bit_cast(float, (unsigned)rr[1]); }
__device__ __forceinline__ float wave_max(float v) { v = half_max(v); auto rr = __builtin_amdgcn_permlane32_swap(__builtin_bit_cast(unsigned, v), __builtin_bit_cast(unsigned, v), false, false);
    return fmaxf(__builtin_bit_cast(float, (unsigned)rr[0]), __builtin_bit_cast(float, (unsigned)rr[1])); }
__device__ __forceinline__ float lane_up(float v, int o, int lane) { return __builtin_bit_cast(float, __builtin_amdgcn_ds_bpermute(((lane - o) & 63) << 2, __builtin_bit_cast(int, v))); }
__device__ __forceinline__ float lane_bcast(float v, int src) { return __builtin_bit_cast(float, __builtin_amdgcn_readlane(__builtin_bit_cast(int, v), src)); }
__device__ __forceinline__ float frcp(float x) { return __builtin_amdgcn_rcpf(x); }
__device__ __forceinline__ float frsq(float x) { return __builtin_amdgcn_rsqf(x); }
#define LDS_WAIT() asm volatile("s_waitcnt lgkmcnt(0)" ::: "memory")
#define LDS_BAR() asm volatile("s_waitcnt lgkmcnt(0)\n\ts_barrier" ::: "memory")
#define VM_WAIT() asm volatile("s_waitcnt vmcnt(0)" ::: "memory")

#define XB_TMO      128
#define XB_XCNT(j)  (256  + 64 * (j))
#define XB_XSUB(j)  (1280 + 64 * (j))
#define XB_XGEN(j)  (2304 + 64 * (j))
#define XB_TOP      3328
#define XB_TOPGEN   3392
#define XCD_BAR_WORDS 3456
#define XB_SPIN_CAP (1u << 22)

__device__ __forceinline__ unsigned xb_ld(unsigned* p)              { return __hip_atomic_load(p, __ATOMIC_RELAXED, __HIP_MEMORY_SCOPE_AGENT); }
__device__ __forceinline__ unsigned xb_add(unsigned* p, unsigned v) { return __hip_atomic_fetch_add(p, v, __ATOMIC_RELAXED, __HIP_MEMORY_SCOPE_AGENT); }
__device__ __forceinline__ unsigned xb_xcc_id() { return (unsigned)__builtin_amdgcn_s_getreg((3 << 11) | 20) & 0xFu; }
#define XB_SPIN(cond, bar) do { unsigned _sp = 0; while (cond) { __builtin_amdgcn_s_sleep(1); \
    if ((++_sp & 255u) == 0u) { if (xb_ld(&(bar)[XB_TMO])) break; if (_sp > XB_SPIN_CAP) { atomicAdd(&(bar)[XB_TMO], 1u); break; } } } } while (0)

struct XcdBarrier { unsigned* bar; unsigned x; volatile LAS unsigned* st; };

__device__ __forceinline__ XcdBarrier xcd_barrier_post(unsigned* bar, volatile LAS unsigned* st) {
    XcdBarrier b; b.bar = bar; b.x = xb_xcc_id(); b.st = st;
    if (threadIdx.x == 0) (void)xb_add(&bar[XB_XCNT(b.x)], 1u);
    return b;
}
__device__ __forceinline__ void xcd_barrier_complete(unsigned* bar, unsigned x, unsigned& nloc, unsigned& nx) {
    const unsigned G = gridDim.x * gridDim.y * gridDim.z;
    unsigned sum, cnt, mine, sp = 0u;
    for (;;) {
        sum = 0u; cnt = 0u; mine = 0u;
#pragma unroll
        for (unsigned j = 0; j < 16; ++j) { const unsigned c = xb_ld(&bar[XB_XCNT(j)]); sum += c; cnt += (c > 0u) ? 1u : 0u; mine = (j == x) ? c : mine; }
        if (sum == G) break;
        __builtin_amdgcn_s_sleep(1);
        if ((++sp & 255u) == 0u) { if (xb_ld(&bar[XB_TMO])) break; if (sp > XB_SPIN_CAP) { atomicAdd(&bar[XB_TMO], 1u); break; } }
    }
    nloc = mine > 0u ? mine : 1u; nx = cnt > 0u ? cnt : 1u;
}
__device__ __forceinline__ void xcd_barrier(const XcdBarrier& b) {
    asm volatile("s_waitcnt vmcnt(0)" ::: "memory");
    __syncthreads();
    if (threadIdx.x == 0) {
        unsigned* bar = b.bar;
        __builtin_amdgcn_s_waitcnt(0);
        unsigned nloc = b.st[0], nx = b.st[1];
        if (nloc == 0u) { xcd_barrier_complete(bar, b.x, nloc, nx); b.st[0] = nloc; b.st[1] = nx; }
        const unsigned old = xb_add(&bar[XB_XSUB(b.x)], 1u);
        const unsigned gen = old / nloc;
        if (old + 1u == (gen + 1u) * nloc) {
            __builtin_amdgcn_fence(__ATOMIC_RELEASE, "agent");
            asm volatile("s_waitcnt vmcnt(0)" ::: "memory");
            const unsigned og = xb_add(&bar[XB_TOP], 1u);
            const unsigned tg = og / nx;
            if (og + 1u == (tg + 1u) * nx) xb_add(&bar[XB_TOPGEN], 1u);
            else XB_SPIN(xb_ld(&bar[XB_TOPGEN]) == tg, bar);
            __builtin_amdgcn_fence(__ATOMIC_ACQUIRE, "agent");
            xb_add(&bar[XB_XGEN(b.x)], 1u);
            asm volatile("s_waitcnt vmcnt(0)" ::: "memory");
        } else {
            XB_SPIN(xb_ld(&bar[XB_XGEN(b.x)]) == gen, bar);
            __builtin_amdgcn_fence(__ATOMIC_ACQUIRE, "agent");
            asm volatile("s_waitcnt vmcnt(0)" ::: "memory");
        }
    }
    __syncthreads();
}

struct Params { const float* in[33]; float* out; unsigned char* ws; int ph_lo, ph_hi; };

struct Frame {
    LAS unsigned char* lds;
    unsigned char* ws;
    const float* const* in;
    float* out;
    int tid, lane, wave, bx, G;
};
enum { I_X = 0, I_C, I_CTX, I_CCTX, I_WMOD, I_BMOD, I_GMIX, I_GFFN, I_WIN, I_MLGB, I_MLHG, I_GCQ, I_GCKV, I_WUQ, I_WUKV, I_GQN, I_GKN, I_POOLW, I_POOLS,
       I_CONVW, I_CONVB, I_WGATE, I_BGATE, I_WBR, I_WOUT, I_WRT, I_BRT, I_W1, I_W3, I_W2, I_WS1, I_WS3, I_WS2 };

__device__ __forceinline__ const float* modp(const Frame& F, int l, int r, int which) { return (const float*)(F.ws + WS_MOD) + ((size_t)(l * 9 + r)) * 6144 + which * 1024; }
__device__ __forceinline__ int mod_row_of(int row) { return row < NLAT ? (row >> 13) : 8; }

__device__ __forceinline__ f32x4 up4_fp8(unsigned w) { const f32x2 lo = __builtin_amdgcn_cvt_pk_f32_fp8((int)w, false), hi = __builtin_amdgcn_cvt_pk_f32_fp8((int)w, true); return (f32x4){lo.x, lo.y, hi.x, hi.y}; }
namespace gg {
typedef int v4i_t __attribute__((ext_vector_type(4)));
constexpr int BM = 256, BK = 64, HALF = 128, HTB = HALF * BK * 2, STAGE_BYTES = 8 * HTB;
__device__ __forceinline__ int lds_byte(int r, int c) { const int st = (r >> 4) * 2 + (c >> 5), rr = r & 15, cc = c & 31, ob = rr * 64 + cc * 2; return st * 1024 + (ob ^ (((ob >> 9) & 1) << 5)); }
__device__ __forceinline__ void stage_rc(int b, int& R, int& C) { const int st = b / 1024, sb = b % 1024, swz = sb ^ (((sb >> 9) & 1) << 5); R = (st >> 1) * 16 + swz / 64; C = (st & 1) * 32 + (swz % 64) / 2; }
__device__ __forceinline__ int perm32(int rho) { const int n = rho >> 4, i = rho & 15; return 8 * (i >> 2) + 4 * n + (i & 3); }

struct Unit {
    const char* A; const char* B;
    unsigned lda, ldb;
    int nt;
    int ridx_off;
    int p0, p1, p2;
};

template <class E, class = void> struct ZPeel { static constexpr bool v = false; };
template <class E> struct ZPeel<E, decltype((void)E::ZPEEL)> { static constexpr bool v = E::ZPEEL; };
template <class Epi, class Sched>
__device__ __forceinline__ void gemm_phase(LAS unsigned char* lds, const Sched& S, const Epi& E) {
    int tid_ = threadIdx.x; asm volatile("" : "+v"(tid_));
    const int tid = tid_, wid = __builtin_amdgcn_readfirstlane(tid >> 6), lane = tid & 63, wr = wid >> 2, wc = wid & 3, fr = lane & 15, fq = lane >> 4;
    const size_t kstep = (size_t)(BK * 2);
    const unsigned ldsw = (unsigned)wid * 1024u;
    const int aoff = lds_byte(wr * 64 + fr, fq * 8), boff = lds_byte(wc * 32 + fr, fq * 8);
#define GG_SA(b, h) (((b) * 2 + (h)) * HTB)
#define GG_SB(b, h) ((4 + (b) * 2 + (h)) * HTB)
#define GG_STAGE(bufoff, gbase, v0, v1) do { \
        __builtin_amdgcn_global_load_lds((const unsigned*)((const char*)(gbase) + (v0)), (LAS unsigned*)(lds + (bufoff) + ldsw), 16, 0, 0); \
        __builtin_amdgcn_global_load_lds((const unsigned*)((const char*)(gbase) + (v1)), (LAS unsigned*)(lds + (bufoff) + ldsw + 8192), 16, 0, 0); } while (0)
#define GG_LDA(dst, b, h) do { _Pragma("unroll") for (int m = 0; m < 4; ++m) _Pragma("unroll") for (int k = 0; k < 2; ++k) dst[m][k] = *(const LAS bf16x8*)(lds + GG_SA(b, h) + aoff + m * 2048 + k * 1024); } while (0)
#define GG_LDB(dst, b, h) do { _Pragma("unroll") for (int n = 0; n < 2; ++n) _Pragma("unroll") for (int k = 0; k < 2; ++k) dst[n][k] = *(const LAS bf16x8*)(lds + GG_SB(b, h) + boff + n * 2048 + k * 1024); } while (0)
#define GG_MMA(ai, bj, At, Bt) do { __builtin_amdgcn_s_setprio(1); _Pragma("unroll") for (int m = 0; m < 4; ++m) _Pragma("unroll") for (int n = 0; n < 2; ++n) _Pragma("unroll") for (int k = 0; k < 2; ++k) \
        acc[ai][bj][m][n] = __builtin_amdgcn_mfma_f32_16x16x32_bf16(Bt[n][k], At[m][k], acc[ai][bj][m][n], 0, 0, 0); __builtin_amdgcn_s_setprio(0); } while (0)
#define GG_CAT8(x, y) __builtin_shufflevector(__builtin_bit_cast(v4i_t, x), __builtin_bit_cast(v4i_t, y), 0, 1, 2, 3, 4, 5, 6, 7)
#define GG_MMA8(ai, bj, At, Bt) do { __builtin_amdgcn_s_setprio(1); _Pragma("unroll") for (int m = 0; m < 4; ++m) _Pragma("unroll") for (int n = 0; n < 2; ++n) \
        acc[ai][bj][m][n] = __builtin_amdgcn_mfma_scale_f32_16x16x128_f8f6f4(GG_CAT8(Bt[n][0], Bt[n][1]), GG_CAT8(At[m][0], At[m][1]), acc[ai][bj][m][n], 0, 0, 0, (int)Epi::SCB, 0, 0x7f7f7f7f); __builtin_amdgcn_s_setprio(0); } while (0)
#define GG_MM(ai, bj, At, Bt) do { if constexpr (Epi::FP8) GG_MMA8(ai, bj, At, Bt); else GG_MMA(ai, bj, At, Bt); } while (0)
#define GG_MMZ8(ai, bj, At, Bt) do { __builtin_amdgcn_s_setprio(1); _Pragma("unroll") for (int m = 0; m < 4; ++m) _Pragma("unroll") for (int n = 0; n < 2; ++n) \
        acc[ai][bj][m][n] = __builtin_amdgcn_mfma_scale_f32_16x16x128_f8f6f4(GG_CAT8(Bt[n][0], Bt[n][1]), GG_CAT8(At[m][0], At[m][1]), (f32x4){0.f, 0.f, 0.f, 0.f}, 0, 0, 0, (int)Epi::SCB, 0, 0x7f7f7f7f); __builtin_amdgcn_s_setprio(0); } while (0)
#define GG_MM1(ai, bj, At, Bt) do { if constexpr (ZP && Epi::FP8) { if (t == 0) GG_MMZ8(ai, bj, At, Bt); else GG_MMA8(ai, bj, At, Bt); } else GG_MM(ai, bj, At, Bt); } while (0)
#define GG_WAIT_V(n) asm volatile("s_waitcnt vmcnt(" #n ")" ::: "memory")
#define GG_WAIT_L(n) asm volatile("s_waitcnt lgkmcnt(" #n ")" ::: "memory")
#define GG_BAR __builtin_amdgcn_s_barrier()
#define GG_SCHED __builtin_amdgcn_sched_barrier(0)
#define GG_OFFS(u) do { int R0_, C0_, R1_, C1_; stage_rc(tid * 16, R0_, C0_); stage_rc(tid * 16 + 8192, R1_, C1_); \
        if (Sched::GATHER) { const LAS int* rl_ = (const LAS int*)(lds + (u).ridx_off); vA0 = (unsigned)rl_[R0_] * (u).lda + C0_ * 2; vA1 = (unsigned)rl_[R1_] * (u).lda + C1_ * 2; \
                             vA2 = (unsigned)rl_[128 + R0_] * (u).lda + C0_ * 2; vA3 = (unsigned)rl_[128 + R1_] * (u).lda + C1_ * 2; hA = 0; } \
        else { vA0 = (unsigned)R0_ * (u).lda + C0_ * 2; vA1 = (unsigned)R1_ * (u).lda + C1_ * 2; vA2 = vA0; vA3 = vA1; hA = (size_t)128 * (u).lda; } \
        const int Rb0_ = Epi::PERM ? ((R0_ & ~31) + perm32(R0_ & 31)) : R0_, Rb1_ = Epi::PERM ? ((R1_ & ~31) + perm32(R1_ & 31)) : R1_; \
        vB0 = (unsigned)Rb0_ * (u).ldb + C0_ * 2; vB1 = (unsigned)Rb1_ * (u).ldb + C1_ * 2; hB = (size_t)128 * (u).ldb; } while (0)
    Unit cur, nxt; int ui = 0;
    if (!S.next(0, cur)) return;
    constexpr bool ZP = ZPeel<Epi>::v;
    f32x4 acc[2][2][4][2];
    if constexpr (!ZP) {
#pragma unroll
    for (int a = 0; a < 2; ++a)
#pragma unroll
        for (int b = 0; b < 2; ++b)
#pragma unroll
            for (int m = 0; m < 4; ++m)
#pragma unroll
                for (int n = 0; n < 2; ++n) acc[a][b][m][n] = (f32x4){0.f, 0.f, 0.f, 0.f};
    }
    bf16x8 At[4][2], B0[2][2], B1[2][2];
    unsigned vA0, vA1, vA2, vA3, vB0, vB1; size_t hA, hB;
    GG_OFFS(cur);
    const char* cA = cur.A; const char* cB = cur.B;
    GG_STAGE(GG_SB(0, 0), cB, vB0, vB1); GG_STAGE(GG_SB(0, 1), cB + hB, vB0, vB1); GG_STAGE(GG_SA(0, 0), cA, vA0, vA1); GG_STAGE(GG_SA(0, 1), cA + hA, vA2, vA3);
    if (wr == 1) GG_BAR;
    GG_WAIT_V(2); GG_BAR;
    GG_STAGE(GG_SB(1, 0), cB + kstep, vB0, vB1); GG_STAGE(GG_SA(1, 0), cA + kstep, vA0, vA1); GG_STAGE(GG_SB(1, 1), cB + hB + kstep, vB0, vB1);
    GG_WAIT_V(6); GG_BAR;
    for (;;) {
        const bool has_next = S.next(ui + 1, nxt);
        TSEC_BEGIN(100 + Epi::TID, lds);
        int nt_ = cur.nt; asm volatile("" : "+s"(nt_)); const int nt = nt_;
#pragma unroll 1
        for (int t = 0; t < nt; t += 2) {
            const bool last = (t == nt - 2);
            const char* a1 = cA + (size_t)(t + 1) * kstep;
            GG_LDB(B0, 0, 0); GG_LDB(B1, 0, 1); GG_SCHED; GG_LDA(At, 0, 0); GG_STAGE(GG_SA(1, 1), a1 + hA, vA2, vA3);
            GG_WAIT_V(8); GG_WAIT_L(0); GG_BAR; GG_MM1(0, 0, At, B0); GG_MM1(0, 1, At, B1); GG_BAR; GG_SCHED;
            if (last) { if (has_next) { GG_OFFS(nxt); cA = nxt.A - (size_t)nt * kstep; cB = nxt.B - (size_t)nt * kstep; } else { cA -= (size_t)nt * kstep; cB -= (size_t)nt * kstep; } }
            const char* a2 = cA + (size_t)(t + 2) * kstep; const char* b2 = cB + (size_t)(t + 2) * kstep; const char* a3 = a2 + kstep; const char* b3 = b2 + kstep;
            GG_LDA(At, 0, 1); GG_STAGE(GG_SB(0, 0), b2, vB0, vB1); GG_STAGE(GG_SB(0, 1), b2 + hB, vB0, vB1); GG_STAGE(GG_SA(0, 0), a2, vA0, vA1);
            GG_WAIT_V(8); GG_WAIT_L(0); GG_BAR; GG_MM1(1, 0, At, B0); GG_MM1(1, 1, At, B1); GG_BAR; GG_SCHED;
            GG_LDB(B0, 1, 0); GG_LDB(B1, 1, 1); GG_SCHED; GG_LDA(At, 1, 0); GG_STAGE(GG_SA(0, 1), a2 + hA, vA2, vA3);
            GG_WAIT_V(8); GG_WAIT_L(0); GG_BAR; GG_MM(0, 0, At, B0); GG_MM(0, 1, At, B1); GG_BAR; GG_SCHED;
            GG_LDA(At, 1, 1); GG_STAGE(GG_SB(1, 0), b3, vB0, vB1); GG_STAGE(GG_SB(1, 1), b3 + hB, vB0, vB1); GG_STAGE(GG_SA(1, 0), a3, vA0, vA1);
            GG_WAIT_V(8); GG_WAIT_L(0); GG_BAR; GG_MM(1, 0, At, B0); GG_MM(1, 1, At, B1); GG_BAR; GG_SCHED;
        }
        cA += (size_t)nt * kstep; cB += (size_t)nt * kstep;
        TSEC_END(100 + Epi::TID, lds);
        if (wr == 0) GG_BAR;
        TSEC_BEGIN(200 + Epi::TID, lds); { int t2_ = threadIdx.x; asm volatile("" : "+v"(t2_)); E(acc, cur, wr, wc, t2_ & 15, (t2_ & 63) >> 4); } TSEC_END(200 + Epi::TID, lds);
        if (!has_next) break;
        if constexpr (!ZP)
#pragma unroll
        for (int a = 0; a < 2; ++a)
#pragma unroll
            for (int b = 0; b < 2; ++b)
#pragma unroll
                for (int m = 0; m < 4; ++m)
#pragma unroll
                    for (int n = 0; n < 2; ++n) acc[a][b][m][n] = (f32x4){0.f, 0.f, 0.f, 0.f};
        cur = nxt; ++ui;
        if (wr == 1) GG_BAR;
    }
    GG_WAIT_V(0);
    GG_BAR;
#undef GG_SA
#undef GG_SB
#undef GG_STAGE
#undef GG_LDA
#undef GG_LDB
#undef GG_MMA
#undef GG_MMA8
#undef GG_MM
#undef GG_MM1
#undef GG_MMZ8
#undef GG_CAT8
#undef GG_WAIT_V
#undef GG_WAIT_L
#undef GG_BAR
#undef GG_SCHED
#undef GG_OFFS
}
}

__device__ __forceinline__ int ld_i32_uniform(const int* p) { return __builtin_amdgcn_readfirstlane(__hip_atomic_load(p, __ATOMIC_RELAXED, __HIP_MEMORY_SCOPE_AGENT)); }
__device__ __forceinline__ void tile_order(int L, int nM, int nN, int& pm, int& pn) {
    const int nwg = nM * nN; int wgid = L;
    { const int q = nwg / 8, r = nwg % 8, xcd = wgid % 8, off = wgid / 8; wgid = (xcd < r ? xcd * (q + 1) : r * (q + 1) + (xcd - r) * q) + off; }
    const int nig = 8 * nN, gid = wgid / nig, fm = gid * 8, gsz = (nM - fm) < 8 ? (nM - fm) : 8;
    pm = fm + ((wgid % nig) % gsz); pn = (wgid % nig) / gsz;
}
struct SchedPlain {
    static constexpr bool GATHER = false;
    const char* A; const char* B; unsigned lda, ldb; int nt, nM, nN, G, c;
    __device__ __forceinline__ bool next(int i, gg::Unit& u) const {
        const int L = i * G + c; if (L >= nM * nN) return false;
        int pm, pn; tile_order(L, nM, nN, pm, pn);
        u.A = A + (size_t)pm * 256 * lda; u.B = B + (size_t)pn * 256 * ldb; u.lda = lda; u.ldb = ldb; u.nt = nt; u.ridx_off = 0; u.p0 = pm; u.p1 = pn; u.p2 = 0; return true;
    }
};
struct EpiWin {
    static constexpr bool PERM = true, FP8 = true; static constexpr int TID = 0; static constexpr unsigned SCB = 0x79797979u;
    bf16_t* px; float* gate;
    __device__ __forceinline__ void operator()(const f32x4 (&acc)[2][2][4][2], const gg::Unit& u, int wr, int wc, int fr, int fq) const {
        const int row0 = u.p0 * 256 + wr * 64 + fr;
#pragma unroll
        for (int bj = 0; bj < 2; ++bj) {
            const int c0 = u.p1 * 256 + bj * 128 + wc * 32 + 8 * fq;
            if (c0 < INC) {
                const bool isg = (c0 >= C_G && c0 < C_MLA);
#pragma unroll
                for (int ai = 0; ai < 2; ++ai)
#pragma unroll
                    for (int m = 0; m < 4; ++m) { const int row = row0 + ai * 128 + m * 16; const f32x4 v0 = acc[ai][bj][m][0], v1 = acc[ai][bj][m][1];
                        u32x4 w; w.x = cvt_pk_bf16(v0[0], v0[1]); w.y = cvt_pk_bf16(v0[2], v0[3]); w.z = cvt_pk_bf16(v1[0], v1[1]); w.w = cvt_pk_bf16(v1[2], v1[3]);
                        *(u32x4*)(px + (size_t)row * INC + c0) = w;
                        if (isg) { float* gp = gate + (size_t)row * 16 + (c0 - C_G); *(f32x4*)gp = v0; *(f32x4*)(gp + 4) = v1; } }
            }
        }
    }
};
struct SchedYB {
    static constexpr bool GATHER = false;
    const char* yc; const char* wb; int pm0, nMh, G, c;
    __device__ __forceinline__ bool next(int i, gg::Unit& u) const {
        const int L = i * G + c; if (L >= nMh * 16) return false;
        int pm, q; tile_order(L, nMh, 16, pm, q); const int br = q >> 2, pn = q & 3;
        u.A = yc + (size_t)(pm0 + pm) * 256 * 2048 + br * 512; u.lda = 2048; u.B = wb + (size_t)br * (1024 * 512) + (size_t)pn * 256 * 512; u.ldb = 512; u.nt = 4; u.ridx_off = 0; u.p0 = pm; u.p1 = q; u.p2 = 0; return true;
    }
};
struct EpiMerge2 {
    static constexpr bool PERM = false, FP8 = true; static constexpr int TID = 4; static constexpr unsigned SCB = 0x79797979u;
    const unsigned char* yb; const float* bgate; unsigned char* accm; int pm0;
    __device__ __forceinline__ void operator()(const f32x4 (&acc)[2][2][4][2], const gg::Unit& u, int wr, int wc, int fr, int fq) const {
        const int c = u.p1 * 64 + 16 * wc + 4 * fq, r0 = wr * 64 + fr;
        f32x4 bv[2][2];
#pragma unroll
        for (int bj = 0; bj < 2; ++bj)
#pragma unroll
            for (int n = 0; n < 2; ++n) bv[bj][n] = *(const f32x4*)(bgate + (2 * bj + n) * 1024 + c);
#pragma unroll
        for (int ai = 0; ai < 2; ++ai) {
#pragma unroll
            for (int m = 0; m < 4; ++m) { const int rl = (u.p0 - pm0) * 256 + r0 + ai * 128 + m * 16; const unsigned char* yr = yb + (size_t)rl * 4096 + c;
                f32x4 t = {0.f, 0.f, 0.f, 0.f};
#pragma unroll
                for (int bj = 0; bj < 2; ++bj)
#pragma unroll
                    for (int n = 0; n < 2; ++n) { const f32x4 y = up4_fp8(*(const unsigned*)(yr + (2 * bj + n) * 1024)); const f32x4 g = acc[ai][bj][m][n] + bv[bj][n];
                        t[0] += sigmoidf_(g[0]) * y[0]; t[1] += sigmoidf_(g[1]) * y[1]; t[2] += sigmoidf_(g[2]) * y[2]; t[3] += sigmoidf_(g[3]) * y[3]; }
                *(unsigned*)(accm + (size_t)(u.p0 * 256 + r0 + ai * 128 + m * 16) * 1024 + c) = pk4_fp8(t[0], t[1], t[2], t[3]); } }
    }
};
struct EpiWout {
    static constexpr bool PERM = true, FP8 = true; static constexpr int TID = 1; static constexpr unsigned SCB = 0x79797979u;
    bf16_t* mrg; const float* gt;
    __device__ __forceinline__ void operator()(const f32x4 (&acc)[2][2][4][2], const gg::Unit& u, int wr, int wc, int fr, int fq) const {
        const int pm = u.p0; const int mrow = pm >= 256 ? 8 : (pm >> 5);
        const float* g = gt + (size_t)mrow * 6144;
        const int row0 = pm * 256 + wr * 64 + fr, col0 = u.p1 * 256 + wc * 32 + 8 * fq;
#pragma unroll
        for (int bj = 0; bj < 2; ++bj) { const f32x4 g0 = *(const f32x4*)(g + col0 + bj * 128), g1 = *(const f32x4*)(g + col0 + bj * 128 + 4);
#pragma unroll
            for (int ai = 0; ai < 2; ++ai)
#pragma unroll
                for (int m = 0; m < 4; ++m) { const f32x4 v0 = acc[ai][bj][m][0] * g0, v1 = acc[ai][bj][m][1] * g1;
                    u32x4 w; w.x = cvt_pk_bf16(v0[0], v0[1]); w.y = cvt_pk_bf16(v0[2], v0[3]); w.z = cvt_pk_bf16(v1[0], v1[1]); w.w = cvt_pk_bf16(v1[2], v1[3]);
                    *(u32x4*)(mrg + (size_t)(row0 + ai * 128 + m * 16) * 1024 + col0 + bj * 128) = w; } }
    }
};
constexpr int MOE_TAB_OFF = RING_BYTES, MOE_RIDX_OFF = RING_BYTES + 1024;
struct SchedMoe1 {
    static constexpr bool GATHER = true;
    const char* hx2; const char* w13; const LAS int* tab; int ntiles, G, c;
    __device__ __forceinline__ bool next(int i, gg::Unit& u) const {
        const int L = i * G + c; if (L >= ntiles * 2) return false;
        const int tile = L >> 1, pn = L & 1, e = __builtin_amdgcn_readfirstlane(tab[i]);
        u.A = hx2; u.lda = 1024; u.ridx_off = MOE_RIDX_OFF + i * 1024; u.B = w13 + (size_t)e * (512 * 1024) + (size_t)pn * 256 * 1024; u.ldb = 1024; u.nt = 8; u.p0 = tile; u.p1 = pn; u.p2 = e; return true;
    }
};
struct EpiMoe1 {
    static constexpr bool PERM = true, FP8 = true; static constexpr int TID = 5; static constexpr unsigned SCB = 0x79797979u;
    unsigned char* a; const float* roww;
    __device__ __forceinline__ void operator()(const f32x4 (&acc)[2][2][4][2], const gg::Unit& u, int wr, int wc, int fr, int fq) const {
        const int row0 = u.p0 * 256 + wr * 64 + fr, col = u.p1 * 128 + wc * 32 + 8 * fq;
#pragma unroll
        for (int ai = 0; ai < 2; ++ai)
#pragma unroll
            for (int m = 0; m < 4; ++m) { const int row = row0 + ai * 128 + m * 16; const float rw = roww[row] * 8.0f;
                float t[8];
#pragma unroll
                for (int n = 0; n < 2; ++n)
#pragma unroll
                    for (int j = 0; j < 4; ++j) { const float g1 = acc[ai][0][m][n][j], g3 = acc[ai][1][m][n][j]; t[n * 4 + j] = g1 * sigmoidf_(g1) * g3 * rw; }
                *(u32x2*)(a + (size_t)row * 256 + col) = (u32x2){pk4_fp8(t[0], t[1], t[2], t[3]), pk4_fp8(t[4], t[5], t[6], t[7])}; }
    }
};
struct SchedMoe2 {
    static constexpr bool GATHER = false;
    const char* a; const char* w2; const LAS int* tab; int ntiles, G, c;
    __device__ __forceinline__ bool next(int i, gg::Unit& u) const {
        const int L = i * G + c; if (L >= ntiles * 4) return false;
        const int tile = L >> 2, pn = L & 3, e = __builtin_amdgcn_readfirstlane(tab[i]);
        u.A = a + (size_t)tile * 256 * 256; u.lda = 256; u.ridx_off = 0; u.B = w2 + (size_t)e * (1024 * 256) + (size_t)pn * 256 * 256; u.ldb = 256; u.nt = 2; u.p0 = tile; u.p1 = pn; u.p2 = e; return true;
    }
};
struct EpiBf16Plain {
    static constexpr bool PERM = true, FP8 = false; static constexpr int TID = 2; static constexpr unsigned SCB = 0x7f7f7f7fu;
    bf16_t* O; int ldc;
    __device__ __forceinline__ void operator()(const f32x4 (&acc)[2][2][4][2], const gg::Unit& u, int wr, int wc, int fr, int fq) const {
        const int row0 = u.p0 * 256 + wr * 64 + fr, col0 = u.p1 * 256 + wc * 32 + 8 * fq;
#pragma unroll
        for (int ai = 0; ai < 2; ++ai)
#pragma unroll
            for (int m = 0; m < 4; ++m)
#pragma unroll
                for (int bj = 0; bj < 2; ++bj) { const f32x4 v0 = acc[ai][bj][m][0], v1 = acc[ai][bj][m][1];
                    u32x4 w; w.x = cvt_pk_bf16(v0[0], v0[1]); w.y = cvt_pk_bf16(v0[2], v0[3]); w.z = cvt_pk_bf16(v1[0], v1[1]); w.w = cvt_pk_bf16(v1[2], v1[3]);
                    *(u32x4*)(O + (size_t)(row0 + ai * 128 + m * 16) * ldc + col0 + bj * 128) = w; }
    }
};
struct EpiF8Out {
    static constexpr bool PERM = true, FP8 = false; static constexpr int TID = 6; static constexpr unsigned SCB = 0x7f7f7f7fu;
    unsigned char* O; int ldc;
    __device__ __forceinline__ void operator()(const f32x4 (&acc)[2][2][4][2], const gg::Unit& u, int wr, int wc, int fr, int fq) const {
        const int row0 = u.p0 * 256 + wr * 64 + fr, col0 = u.p1 * 256 + wc * 32 + 8 * fq;
#pragma unroll
        for (int ai = 0; ai < 2; ++ai)
#pragma unroll
            for (int m = 0; m < 4; ++m)
#pragma unroll
                for (int bj = 0; bj < 2; ++bj) { const f32x4 v0 = acc[ai][bj][m][0], v1 = acc[ai][bj][m][1];
                    *(u32x2*)(O + (size_t)(row0 + ai * 128 + m * 16) * ldc + col0 + bj * 128) = (u32x2){pk4_fp8(v0[0], v0[1], v0[2], v0[3]), pk4_fp8(v1[0], v1[1], v1[2], v1[3])}; }
    }
};
struct EpiF8OutQ {
    static constexpr bool PERM = true, FP8 = true, ZPEEL = true; static constexpr int TID = 7; static constexpr unsigned SCB = 0x77777777u;
    unsigned char* O; int ldc;
    __device__ __forceinline__ void operator()(const f32x4 (&acc)[2][2][4][2], const gg::Unit& u, int wr, int wc, int fr, int fq) const {
        const int row0 = u.p0 * 256 + wr * 64 + fr, col0 = u.p1 * 256 + wc * 32 + 8 * fq;
#pragma unroll
        for (int ai = 0; ai < 2; ++ai)
#pragma unroll
            for (int m = 0; m < 4; ++m)
#pragma unroll
                for (int bj = 0; bj < 2; ++bj) { const f32x4 v0 = acc[ai][bj][m][0], v1 = acc[ai][bj][m][1];
                    *(u32x2*)(O + (size_t)(row0 + ai * 128 + m * 16) * ldc + col0 + bj * 128) = (u32x2){pk4_fp8(v0[0], v0[1], v0[2], v0[3]), pk4_fp8(v1[0], v1[1], v1[2], v1[3])}; }
    }
};
struct EpiBf16F8 {
    static constexpr bool PERM = true, FP8 = true; static constexpr int TID = 3; static constexpr unsigned SCB = 0x77777777u;
    bf16_t* O; static constexpr int ldc = 1024;
    __device__ __forceinline__ void operator()(const f32x4 (&acc)[2][2][4][2], const gg::Unit& u, int wr, int wc, int fr, int fq) const {
        bf16_t* p = O + (size_t)(u.p0 * 256 + wr * 64 + fr) * ldc + u.p1 * 256 + wc * 32 + 8 * fq;
#pragma unroll
        for (int ai = 0; ai < 2; ++ai) {
#pragma unroll
            for (int m = 0; m < 4; ++m) {
#pragma unroll
                for (int bj = 0; bj < 2; ++bj) { const f32x4 v0 = acc[ai][bj][m][0], v1 = acc[ai][bj][m][1];
                    u32x4 w; w.x = cvt_pk_bf16(v0[0], v0[1]); w.y = cvt_pk_bf16(v0[2], v0[3]); w.z = cvt_pk_bf16(v1[0], v1[1]); w.w = cvt_pk_bf16(v1[2], v1[3]);
                    *(u32x4*)(p + bj * 128) = w; }
                p += 16 * ldc; asm volatile("" : "+v"(p)); }
            p += 64 * ldc; }
    }
};

__device__ __forceinline__ int crow(int r, int hi) { return (r & 3) + 8 * (r >> 2) + 4 * hi; }
__device__ __forceinline__ f32x16 mma32_ll(f32x16 acc, const LAS bf16_t* A, int lda, const LAS bf16_t* B, int ldb, int ksteps, int lane, int ks0 = 0) {
    const int r32 = lane & 31, hi = lane >> 5;
    for (int ks = ks0; ks < ksteps; ++ks) {
        const bf16x8 a = *(const LAS bf16x8*)(A + r32 * lda + ks * 16 + hi * 8);
        const bf16x8 b = *(const LAS bf16x8*)(B + r32 * ldb + ks * 16 + hi * 8);
        acc = __builtin_amdgcn_mfma_f32_32x32x16_bf16(a, b, acc, 0, 0, 0);
    }
    return acc;
}
template <int KS> __device__ __forceinline__ f32x16 mma32_lg(f32x16 acc, const LAS bf16_t* A, int lda, const bf16_t* B, int ldb, int lane) {
    const int r32 = lane & 31, hi = lane >> 5;
    bf16x8 b[KS];
#pragma unroll
    for (int ks = 0; ks < KS; ++ks) b[ks] = *(const bf16x8*)(B + (size_t)r32 * ldb + ks * 16 + hi * 8);
#pragma unroll
    for (int ks = 0; ks < KS; ++ks) { const bf16x8 a = *(const LAS bf16x8*)(A + r32 * lda + ks * 16 + hi * 8); acc = __builtin_amdgcn_mfma_f32_32x32x16_bf16(a, b[ks], acc, 0, 0, 0); }
    return acc;
}

__device__ __forceinline__ void ph_pre(const Frame& F) {
    LAS float* sv = (LAS float*)F.lds;
    LAS float* part = sv + 9 * 1024;
    float* mod = (float*)(F.ws + WS_MOD);
    for (int i = F.tid; i < 9 * 1024; i += NTHR) { const int r = i >> 10, k = i & 1023; const float c = (r < 8) ? F.in[I_C][r * 1024 + k] : F.in[I_CCTX][k]; sv[i] = c * sigmoidf_(c); }
    __syncthreads();
    for (int it = F.bx; it < 2 * 96; it += F.G) {
        const int l = it / 96, jc = it % 96, j = jc * 64 + F.lane, k0 = F.wave * 128;
        const float* w = F.in[I_WMOD] + ((size_t)l * 1024 + k0) * 6144 + j;
        float a[9];
#pragma unroll
        for (int r = 0; r < 9; ++r) a[r] = 0.f;
#pragma unroll 4
        for (int k = 0; k < 128; ++k) { const float wv = w[(size_t)k * 6144];
#pragma unroll
            for (int r = 0; r < 9; ++r) a[r] += sv[r * 1024 + k0 + k] * wv; }
#pragma unroll
        for (int r = 0; r < 9; ++r) part[(F.wave * 9 + r) * 64 + F.lane] = a[r];
        __syncthreads();
        for (int i = F.tid; i < 9 * 64; i += NTHR) { const int r = i >> 6, jj = i & 63; float s = F.in[I_BMOD][l * 6144 + jc * 64 + jj];
#pragma unroll
            for (int w8 = 0; w8 < 8; ++w8) s += part[(w8 * 9 + r) * 64 + jj];
            mod[((size_t)(l * 9 + r)) * 6144 + jc * 64 + jj] = s; }
        __syncthreads();
    }
    if (F.bx == F.G - 1) {
        float* rt = (float*)(F.ws + T_ROPE);
        for (int i = F.tid; i < 1024; i += NTHR) { const int pos = i >> 3, f = i & 7; const float inv = powf(10000.0f, -(float)f / 8.0f); const float ang = (float)pos * inv; rt[2 * i] = cosf(ang); rt[2 * i + 1] = sinf(ang); }
    }
}

struct ConvCursor { int base; int gw, ngw; };
__device__ __forceinline__ void conv_mat(const Frame& F, ConvCursor& cc, const float* src, int K, int N, bf16_t* dst, int ldd, int rbase, int rstep, int nbatch, size_t sbs, size_t dbs, int rq = 128, bool gperm = false, float f8scale = 0.f) {
    const int ktl = K / 64, ntl = (N + 127) / 128, per = ktl * ntl, total = per * nbatch;
    int t = cc.base + ((cc.gw - cc.base) % cc.ngw + cc.ngw) % cc.ngw;
    for (; t < cc.base + total; t += cc.ngw) {
        const int li = t - cc.base, bt = li / per, rem = li % per, kb = rem / ntl, nb = rem % ntl, k0 = kb * 64, n = nb * 128 + 2 * F.lane;
        if (n < N) {
            const float* s = src + bt * sbs + (size_t)k0 * N + n; bf16_t* d = dst + bt * dbs;
            f32x2 v[64];
#pragma unroll
            for (int i = 0; i < 64; ++i) v[i] = *(const f32x2*)(s + (size_t)i * N);
#pragma unroll
            for (int q = 0; q < 2; ++q) { const int nn = n + q; const int drow = gperm ? ((nn >> 6) * 256 + ((nn >> 4) & 3) * 32 + (nn & 15) + 128 * (bt >> 1) + 16 * (bt & 1)) : (rbase + (nn / rq) * rstep + (nn % rq));
                if (f8scale != 0.f) { unsigned char* d8 = (unsigned char*)dst + bt * dbs + (size_t)drow * ldd + k0;
#pragma unroll
                    for (int p = 0; p < 4; ++p) { u32x4 o; o.x = pk4_fp8(v[16 * p][q] * f8scale, v[16 * p + 1][q] * f8scale, v[16 * p + 2][q] * f8scale, v[16 * p + 3][q] * f8scale);
                        o.y = pk4_fp8(v[16 * p + 4][q] * f8scale, v[16 * p + 5][q] * f8scale, v[16 * p + 6][q] * f8scale, v[16 * p + 7][q] * f8scale);
                        o.z = pk4_fp8(v[16 * p + 8][q] * f8scale, v[16 * p + 9][q] * f8scale, v[16 * p + 10][q] * f8scale, v[16 * p + 11][q] * f8scale);
                        o.w = pk4_fp8(v[16 * p + 12][q] * f8scale, v[16 * p + 13][q] * f8scale, v[16 * p + 14][q] * f8scale, v[16 * p + 15][q] * f8scale);
                        *(u32x4*)(d8 + 16 * p) = o; }
                    continue; }
                bf16_t* dr = d + (size_t)drow * ldd + k0;
#pragma unroll
                for (int p = 0; p < 8; ++p) { u32x4 o; o.x = pk2(v[8 * p][q], v[8 * p + 1][q]); o.y = pk2(v[8 * p + 2][q], v[8 * p + 3][q]); o.z = pk2(v[8 * p + 4][q], v[8 * p + 5][q]); o.w = pk2(v[8 * p + 6][q], v[8 * p + 7][q]);
                    *(u32x4*)(dr + 8 * p) = o; } }
        }
    }
    cc.base += total;
}
__device__ __forceinline__ void ph_convert(const Frame& F, int l) {
    ConvCursor cc; cc.base = 0; cc.gw = F.bx * NWAVES + F.wave; cc.ngw = F.G * NWAVES;
    unsigned char* ws = F.ws;
    conv_mat(F, cc, F.in[I_WIN] + (size_t)l * 1024 * INC, 1024, INC, (bf16_t*)(ws + W_IN), 1024, 0, 128, 1, 0, 0, 128, false, 64.0f);
    conv_mat(F, cc, F.in[I_WGATE] + (size_t)l * 4 * 1024 * 1024, 1024, 1024, (bf16_t*)(ws + W_GATE), 1024, 0, 128, 4, (size_t)1024 * 1024, 0, 128, true, 64.0f);
    conv_mat(F, cc, F.in[I_WBR] + (size_t)l * 4 * 256 * 1024, 256, 1024, (bf16_t*)(ws + W_BR), 256, 0, 128, 4, (size_t)256 * 1024, (size_t)1024 * 256);
    conv_mat(F, cc, F.in[I_WOUT] + (size_t)l * 1024 * 1024, 1024, 1024, (bf16_t*)(ws + W_OUT), 1024, 0, 128, 1, 0, 0, 128, false, 64.0f);
    conv_mat(F, cc, F.in[I_W1] + (size_t)l * 64 * 1024 * 256, 1024, 256, (bf16_t*)(ws + W_13), 1024, 0, 256, 64, (size_t)1024 * 256, (size_t)512 * 1024, 128, false, 64.0f);
    conv_mat(F, cc, F.in[I_W3] + (size_t)l * 64 * 1024 * 256, 1024, 256, (bf16_t*)(ws + W_13), 1024, 128, 256, 64, (size_t)1024 * 256, (size_t)512 * 1024, 128, false, 64.0f);
    conv_mat(F, cc, F.in[I_W2] + (size_t)l * 64 * 256 * 1024, 256, 1024, (bf16_t*)(ws + W_2), 256, 0, 128, 64, (size_t)256 * 1024, (size_t)1024 * 256, 128, false, 32.0f);
    conv_mat(F, cc, F.in[I_WS1] + (size_t)l * 1024 * 256, 1024, 256, (bf16_t*)(ws + W_13 + (size_t)64 * 512 * 1024), 1024, 0, 256, 1, 0, 0, 128, false, 64.0f);
    conv_mat(F, cc, F.in[I_WS3] + (size_t)l * 1024 * 256, 1024, 256, (bf16_t*)(ws + W_13 + (size_t)64 * 512 * 1024), 1024, 128, 256, 1, 0, 0, 128, false, 64.0f);
    conv_mat(F, cc, F.in[I_WS2] + (size_t)l * 256 * 1024, 256, 1024, (bf16_t*)(ws + W_2 + (size_t)64 * 1024 * 256), 256, 0, 128, 1, 0, 0, 128, false, 32.0f);
    conv_mat(F, cc, F.in[I_WUQ] + (size_t)l * 256 * 384, 256, 384, (bf16_t*)(ws + W_UQ), 256, 0, 128, 1, 0, 0);
    conv_mat(F, cc, F.in[I_WUKV] + (size_t)l * 128 * 512, 128, 512, (bf16_t*)(ws + W_UKV), 128, 0, 128, 1, 0, 0);
    conv_mat(F, cc, F.in[I_POOLW] + (size_t)l * 4 * 64 * 64, 64, 64, (bf16_t*)(ws + W_POOL), 64, 0, 128, 4, (size_t)64 * 64, (size_t)64 * 64);
    conv_mat(F, cc, F.in[I_WRT] + (size_t)l * 1024 * 64, 1024, 64, (bf16_t*)(ws + W_RT), 1024, 0, 128, 1, 0, 0);
    { u32x4* z = (u32x4*)(ws + W_IN + (size_t)INC * 1024); const int n16 = (INCP - INC) * 1024 / 16;
      unsigned z0 = 0u; asm volatile("" : "+v"(z0));
      for (int i = F.bx * NTHR + F.tid; i < n16; i += F.G * NTHR) z[i] = (u32x4){z0, z0, z0, z0}; }
}

__device__ __forceinline__ void normmod_vals(int lane, const f32x4 (&v)[4], const float* g, const float* sc, const float* sh, f32x4 (&y)[4]) {
    float s = 0.f;
#pragma unroll
    for (int j = 0; j < 4; ++j) s += (v[j].x * v[j].x + v[j].y * v[j].y) + (v[j].z * v[j].z + v[j].w * v[j].w);
    const float rstd = frsq(wave_sum(s) * (1.f / 1024.f) + EPS);
#pragma unroll
    for (int j = 0; j < 4; ++j) { const f32x4 gv = ((const f32x4*)g)[lane + 64 * j], scv = ((const f32x4*)sc)[lane + 64 * j], shv = ((const f32x4*)sh)[lane + 64 * j];
        y[j] = v[j] * rstd * gv * (scv + 1.0f) + shv; }
}
__device__ __forceinline__ void normmod_row(int lane, const float* xrow, const float* g, const float* sc, const float* sh, f32x4 (&y)[4]) {
    const f32x4* xr = (const f32x4*)xrow + lane; f32x4 v[4]; float s = 0.f;
#pragma unroll
    for (int j = 0; j < 4; ++j) { v[j] = xr[64 * j]; s += (v[j].x * v[j].x + v[j].y * v[j].y) + (v[j].z * v[j].z + v[j].w * v[j].w); }
    const float rstd = frsq(wave_sum(s) * (1.f / 1024.f) + EPS);
#pragma unroll
    for (int j = 0; j < 4; ++j) { const f32x4 gv = ((const f32x4*)g)[lane + 64 * j], scv = ((const f32x4*)sc)[lane + 64 * j], shv = ((const f32x4*)sh)[lane + 64 * j];
        y[j] = v[j] * rstd * gv * (scv + 1.0f) + shv; }
}
__device__ __forceinline__ const float* stream_row(const Frame& F, int l, int row) {
    if (row < NLAT) return (l == 0 ? F.in[I_X] : F.out) + (size_t)row * 1024;
    return (l == 0 ? F.in[I_CTX] : (const float*)(F.ws + WS_CTXS)) + (size_t)(row - NLAT) * 1024;
}
__device__ __forceinline__ void ph_norm1(const Frame& F, int l) {
    const int gw = F.bx * NWAVES + F.wave, ngw = F.G * NWAVES;
    bf16_t* hx = (bf16_t*)(F.ws + WS_HX);
    for (int row0 = gw; row0 < NTOK; row0 += 2 * ngw) {
        const int row1 = row0 + ngw; const bool has1 = row1 < NTOK;
        f32x4 v0[4], v1[4];
        { const f32x4* x0 = (const f32x4*)stream_row(F, l, row0) + F.lane; const f32x4* x1 = (const f32x4*)stream_row(F, l, has1 ? row1 : row0) + F.lane;
#pragma unroll
          for (int j = 0; j < 4; ++j) { v0[j] = x0[64 * j]; v1[j] = x1[64 * j]; } }
#pragma unroll
        for (int k = 0; k < 2; ++k) { if (k == 1 && !has1) break; const int row = k ? row1 : row0; const int mr = mod_row_of(row); f32x4 y[4];
            normmod_vals(F.lane, k ? v1 : v0, F.in[I_GMIX] + l * 1024, modp(F, l, mr, 1), modp(F, l, mr, 0), y);
            u32x2* o = (u32x2*)(hx + (size_t)row * 1024) + F.lane; unsigned* o8 = (unsigned*)(F.ws + WS_HX8 + (size_t)row * 1024) + F.lane;
#pragma unroll
            for (int j = 0; j < 4; ++j) { o[64 * j] = (u32x2){pk2(y[j].x, y[j].y), pk2(y[j].z, y[j].w)}; o8[64 * j] = pk4_fp8(y[j].x, y[j].y, y[j].z, y[j].w); } }
    }
}

constexpr float QSCALE = 0.10206207261596577f * 1.4426950408889634f;
template <int KS> __device__ __forceinline__ void ld_bfrag(bf16x8* b, const bf16_t* B, int ldb, int lane) {
#pragma unroll
    for (int ks = 0; ks < KS; ++ks) b[ks] = *(const bf16x8*)(B + (size_t)(lane & 31) * ldb + ks * 16 + (lane >> 5) * 8);
}
template <int KS> __device__ __forceinline__ f32x16 mma32_lr(const LAS bf16_t* A, int lda, const bf16x8* b, int lane) {
    f32x16 acc = {};
#pragma unroll
    for (int ks = 0; ks < KS; ++ks) { const bf16x8 a = *(const LAS bf16x8*)(A + (lane & 31) * lda + ks * 16 + (lane >> 5) * 8); acc = __builtin_amdgcn_mfma_f32_32x32x16_bf16(a, b[ks], acc, 0, 0, 0); }
    return acc;
}
__device__ __forceinline__ f32x2 mla_rope_ld(const Frame& F, int unit) {
    const int row0 = unit * 32; const bool isctx = row0 >= NLAT; const int pos0 = isctx ? (row0 - NLAT) & 255 : row0 & 8191;
    const int pos = pos0 + (F.tid >> 4), pp = (F.tid & 8) ? (pos & 63) : (pos >> 6);
    return *(const f32x2*)((const float*)(F.ws + T_ROPE) + (pp * 8 + (F.tid & 7)) * 2);
}
struct MlaKvRegs { unsigned xk[4]; unsigned xr[4]; f32x2 rp; };
__device__ __forceinline__ MlaKvRegs mla_kv_load(const Frame& F, int unit) {
    MlaKvRegs R; const bf16_t* px = (const bf16_t*)(F.ws + WS_PX);
#pragma unroll
    for (int rr = 0; rr < 4; ++rr) { const bf16_t* p = px + (size_t)(unit * 32 + F.wave * 4 + rr) * INC + C_MLA;
        R.xk[rr] = *(const unsigned*)(p + 256 + 2 * F.lane); R.xr[rr] = *(const unsigned*)(p + 384 + 2 * (F.lane & 15)); }
    R.rp = mla_rope_ld(F, unit);
    return R;
}
__device__ __forceinline__ void mla_kv_unit(const Frame& F, int unit, const MlaKvRegs& R, const bf16x8* wkv, f32x2 gckv2, float g0, float g1, float g2) {
    LAS unsigned char* lds = F.lds;
    LAS bf16_t* AKV = (LAS bf16_t*)lds;
    LAS float* KR = (LAS float*)(lds + 8704);
    LAS f32x2* RP = (LAS f32x2*)(lds + 12800);
    LAS float* OUT = (LAS float*)(lds + 16896);
    LAS bf16_t* KB = (LAS bf16_t*)(lds + 83456);
    int tid_ = F.tid; asm volatile("" : "+v"(tid_));
    const int row0 = unit * 32, tid = tid_, lane = tid & 63, wave = F.wave, r32 = lane & 31, hi = lane >> 5;
    const bool isctx = row0 >= NLAT;
    const int b = isctx ? (row0 - NLAT) >> 8 : row0 >> 13, pos0 = isctx ? (row0 - NLAT) & 255 : row0 & 8191;
    LDS_BAR();
    RP[tid] = R.rp;
#pragma unroll
    for (int rr = 0; rr < 4; ++rr) { const int r = wave * 4 + rr; const unsigned w = R.xk[rr]; const float x0 = bflo(w), x1 = bfhi(w);
        const float sc = frsq(wave_sum(x0 * x0 + x1 * x1) * (1.f / 128.f) + EPS);
        *(LAS unsigned*)(AKV + r * 136 + 2 * lane) = pk2(x0 * sc * gckv2.x, x1 * sc * gckv2.y);
        if (lane < 16) *(LAS f32x2*)(KR + r * 32 + 2 * lane) = (f32x2){bflo(R.xr[rr]), bfhi(R.xr[rr])}; }
    LDS_BAR();
#pragma unroll
    for (int i = 0; i < 2; ++i) { const int nt = wave * 2 + i; const f32x16 acc = mma32_lr<8>(AKV, 136, wkv + 8 * i, lane);
#pragma unroll
        for (int r = 0; r < 16; ++r) OUT[crow(r, hi) * 520 + nt * 32 + r32] = acc[r]; }
    LDS_BAR();
#pragma unroll
    for (int it = 0; it < 8; ++it) { const int pr = wave * 16 + it * 2 + hi, r = pr >> 2, h = pr & 3; const LAS float* o = OUT + r * 520 + h * 128;
        float v0 = o[r32], v1 = o[32 + r32], v2 = KR[r * 32 + r32]; const float ss = half_sum(v0 * v0 + v1 * v1 + v2 * v2);
        const float sc = frsq(ss * (1.f / 96.f) + EPS);
        v0 *= sc * g0; v1 *= sc * g1; v2 *= sc * g2;
        const float pv = xor_lane<8>(v2);
        if (!isctx) { const f32x2 cssn = RP[(r * 2 + (r32 >> 4)) * 8 + (r32 & 7)]; v2 = (r32 & 8) ? (v2 * cssn.x + pv * cssn.y) : (v2 * cssn.x - pv * cssn.y); }
        LAS bf16_t* kb = KB + r * 392 + h * 96;
        kb[r32] = (bf16_t)f2bf(v0); kb[32 + r32] = (bf16_t)f2bf(v1); kb[64 + r32] = (bf16_t)f2bf(v2); }
    LDS_BAR();
    const int key0 = isctx ? pos0 : 256 + pos0, tile = key0 >> 6, kin = key0 & 63;
    for (int i = tid; i < 1536; i += NTHR) { const int r = i & 31, c = (i >> 5) % 12, h = i / 384;
        const u32x4 v = *(const LAS u32x4*)(KB + r * 392 + h * 96 + c * 8);
        *(u32x4*)((bf16_t*)(F.ws + WS_KT) + ((size_t)((b * 4 + h) * NKT + tile) * 12 + c) * 512 + (kin + r) * 8) = v; }
    for (int i = tid; i < 1024; i += NTHR) { const int p = i & 3, r = (i >> 2) & 31, dh = (i >> 7) & 1, h = i >> 8; const LAS float* o = OUT + r * 520 + h * 128 + 64 + dh * 32 + p * 8;
        u32x4 v; v.x = pk2(o[0], o[1]); v.y = pk2(o[2], o[3]); v.z = pk2(o[4], o[5]); v.w = pk2(o[6], o[7]);
        *(u32x4*)((bf16_t*)(F.ws + WS_VT) + ((size_t)((b * 4 + h) * NKT + tile) * 2 + dh) * 2048 + (kin + r) * 32 + p * 8) = v; }
}
struct MlaQRegs { u32x2 xq[4]; f32x2 rp; };
__device__ __forceinline__ MlaQRegs mla_q_load(const Frame& F, int unit) {
    MlaQRegs R; const bf16_t* px = (const bf16_t*)(F.ws + WS_PX);
#pragma unroll
    for (int rr = 0; rr < 4; ++rr) R.xq[rr] = *(const u32x2*)(px + (size_t)(unit * 32 + F.wave * 4 + rr) * INC + C_MLA + 4 * F.lane);
    R.rp = mla_rope_ld(F, unit);
    return R;
}
__device__ __forceinline__ void mla_q_unit(const Frame& F, int unit, const MlaQRegs& R, const bf16x8* wqf, f32x4 gcq4, float g0, float g1, float g2) {
    LAS unsigned char* lds = F.lds;
    LAS bf16_t* AQ = (LAS bf16_t*)lds;
    LAS f32x2* RP = (LAS f32x2*)(lds + 16896);
    LAS float* OQ = (LAS float*)(lds + 20992);
    int tid_ = F.tid; asm volatile("" : "+v"(tid_));
    const int row0 = unit * 32, tid = tid_, lane = tid & 63, wave = F.wave, r32 = lane & 31, hi = lane >> 5;
    const bool isctx = row0 >= NLAT;
    LDS_BAR();
    RP[tid] = R.rp;
#pragma unroll
    for (int rr = 0; rr < 4; ++rr) { const int r = wave * 4 + rr; const u32x2 w = R.xq[rr]; const float x0 = bflo(w.x), x1 = bfhi(w.x), x2 = bflo(w.y), x3 = bfhi(w.y);
        const float sc = frsq(wave_sum(x0 * x0 + x1 * x1 + x2 * x2 + x3 * x3) * (1.f / 256.f) + EPS);
        *(LAS u32x2*)(AQ + r * 264 + 4 * lane) = (u32x2){pk2(x0 * sc * gcq4.x, x1 * sc * gcq4.y), pk2(x2 * sc * gcq4.z, x3 * sc * gcq4.w)}; }
    LDS_BAR();
    { const f32x16 acc = mma32_lr<16>(AQ, 264, wqf, lane);
#pragma unroll
      for (int r = 0; r < 16; ++r) OQ[crow(r, hi) * 392 + wave * 32 + r32] = acc[r]; }
    if (wave < 4) { const f32x16 acc = mma32_lr<16>(AQ, 264, wqf + 16, lane);
#pragma unroll
      for (int r = 0; r < 16; ++r) OQ[crow(r, hi) * 392 + (8 + wave) * 32 + r32] = acc[r]; }
    LDS_BAR();
    bf16_t* qb = (bf16_t*)(F.ws + WS_QB);
#pragma unroll
    for (int it = 0; it < 8; ++it) { const int pr = wave * 16 + it * 2 + hi, r = pr >> 2, h = pr & 3; const LAS float* o = OQ + r * 392 + h * 96;
        float v0 = o[r32], v1 = o[32 + r32], v2 = o[64 + r32]; const float ss = half_sum(v0 * v0 + v1 * v1 + v2 * v2);
        const float sc = frsq(ss * (1.f / 96.f) + EPS);
        v0 *= sc * g0; v1 *= sc * g1; v2 *= sc * g2;
        const float pv = xor_lane<8>(v2);
        if (!isctx) { const f32x2 cssn = RP[(r * 2 + (r32 >> 4)) * 8 + (r32 & 7)]; v2 = (r32 & 8) ? (v2 * cssn.x + pv * cssn.y) : (v2 * cssn.x - pv * cssn.y); }
        bf16_t* q = qb + (size_t)(row0 + r) * 384 + h * 96;
        q[r32] = (bf16_t)f2bf(v0 * QSCALE); q[32 + r32] = (bf16_t)f2bf(v1 * QSCALE); q[64 + r32] = (bf16_t)f2bf(v2 * QSCALE); }
}
__device__ __forceinline__ void mla_prep(const Frame& F, int l) {
    const int lane = F.lane, wave = F.wave, r32 = lane & 31;
    { bf16x8 wkv[16]; const bf16_t* wukv = (const bf16_t*)(F.ws + W_UKV);
      ld_bfrag<8>(wkv, wukv + (size_t)(wave * 2) * 32 * 128, 128, lane); ld_bfrag<8>(wkv + 8, wukv + (size_t)(wave * 2 + 1) * 32 * 128, 128, lane);
      const f32x2 gckv2 = *(const f32x2*)(F.in[I_GCKV] + l * 128 + 2 * lane); const float* gkn = F.in[I_GKN] + l * 96; const float g0 = gkn[r32], g1 = gkn[32 + r32], g2 = gkn[64 + r32];
      const int nu = NTOK / 32;
      if (F.bx < nu) { MlaKvRegs R = mla_kv_load(F, F.bx);
          for (int u = F.bx; u < nu; u += F.G) { const MlaKvRegs Rn = mla_kv_load(F, (u + F.G < nu) ? u + F.G : u); mla_kv_unit(F, u, R, wkv, gckv2, g0, g1, g2); R = Rn; } } }
    { bf16x8 wqf[32]; const bf16_t* wuq = (const bf16_t*)(F.ws + W_UQ);
      ld_bfrag<16>(wqf, wuq + (size_t)wave * 32 * 256, 256, lane); if (wave < 4) ld_bfrag<16>(wqf + 16, wuq + (size_t)(8 + wave) * 32 * 256, 256, lane);
      const f32x4 gcq4 = *(const f32x4*)(F.in[I_GCQ] + l * 256 + 4 * lane); const float* gqn = F.in[I_GQN] + l * 96; const float g0 = gqn[r32], g1 = gqn[32 + r32], g2 = gqn[64 + r32];
      const int nu = (l == 0 ? NTOK : NLAT) / 32;
      if (F.bx < nu) { MlaQRegs R = mla_q_load(F, F.bx);
          for (int u = F.bx; u < nu; u += F.G) { const MlaQRegs Rn = mla_q_load(F, (u + F.G < nu) ? u + F.G : u); mla_q_unit(F, u, R, wqf, gcq4, g0, g1, g2); R = Rn; } } }
}

__device__ __forceinline__ void ml_chunk_pos(int dir, int j, bool& isctx, int& p0) {
    if (j < 2) { isctx = true; p0 = (dir == 0 ? j : 1 - j) * 128; } else { isctx = false; p0 = (dir == 0 ? (j - 2) : (63 - (j - 2))) * 128; }
}
__device__ __forceinline__ int ml_row(int b, bool isctx, int pos) { return isctx ? NLAT + b * 256 + pos : b * 8192 + pos; }
__device__ __forceinline__ float log_sigmoidf_(float x) { return fminf(x, 0.f) - log1pf(__expf(-fabsf(x))); }

struct P1Regs { u32x4 kv[4]; float gi, gf; };
__device__ __forceinline__ P1Regs ml_pass1_load(const Frame& F, int unit) {
    P1Regs R; const int j = unit % NCHK, dir = (unit / NCHK) & 1, h = (unit / (NCHK * 2)) & 3, b = unit / (NCHK * 8);
    bool isctx; int p0; ml_chunk_pos(dir, j, isctx, p0);
    const bf16_t* px = (const bf16_t*)(F.ws + WS_PX); const float* gate = (const float*)(F.ws + T_GATE); const int tid = F.tid;
#pragma unroll
    for (int q = 0; q < 4; ++q) { const int it = tid + q * NTHR, i = it & 127, c = (it >> 7) & 7, isv = it >> 10; const int pos = dir ? p0 + 127 - i : p0 + i;
        R.kv[q] = *(const u32x4*)(px + (size_t)ml_row(b, isctx, pos) * INC + (isv ? 512 : 256) + h * 64 + c * 8); }
    { const int i = tid & 127; const int pos = dir ? p0 + 127 - i : p0 + i; const float* g = gate + (size_t)ml_row(b, isctx, pos) * 16; R.gi = g[dir * 8 + h]; R.gf = g[dir * 8 + 4 + h]; }
    return R;
}
__device__ __forceinline__ void ml_pass1_unit(const Frame& F, int l, int unit, const P1Regs& R) {
    LAS float* LI = (LAS float*)F.lds; LAS float* LF = LI + 128; LAS float* WV = LI + 256;
    LAS bf16_t* KT = (LAS bf16_t*)(F.lds + 2048); LAS bf16_t* VT = KT + 64 * 136;
    const int dir = (unit / NCHK) & 1, h = (unit / (NCHK * 2)) & 3;
    const int tid = F.tid, lane = F.lane, wave = F.wave;
    const float* gb = F.in[I_MLGB] + l * 16;
    LDS_BAR();
    if (tid < 128) { LI[tid] = R.gi + gb[dir * 8 + h]; LF[tid] = log_sigmoidf_(R.gf + gb[dir * 8 + 4 + h]); }
    LDS_BAR();
    if (wave == 0) {
        const float a0 = LF[2 * lane], a1 = LF[2 * lane + 1]; float s = a0 + a1;
#pragma unroll
        for (int o = 1; o < 64; o <<= 1) { const float t = lane_up(s, o, lane); if (lane >= o) s += t; }
        const float bend = lane_bcast(s, 63);
        const float w0 = bend - (s - a1) + LI[2 * lane], w1 = bend - s + LI[2 * lane + 1];
        const float mloc = wave_max(fmaxf(w0, w1));
        WV[2 * lane] = __expf(w0 - mloc); WV[2 * lane + 1] = __expf(w1 - mloc);
        if (lane == 0) { ((float*)(F.ws + T_MLOC))[unit] = mloc; ((float*)(F.ws + T_BEND))[unit] = bend; }
    }
    LDS_BAR();
#pragma unroll
    for (int q = 0; q < 4; ++q) { const int it = tid + q * NTHR, i = it & 127, c = (it >> 7) & 7, isv = it >> 10; const u32x4 v = R.kv[q];
        const float sc = isv ? 1.0f : 0.125f * WV[i]; LAS bf16_t* d = (isv ? VT : KT) + (c * 8) * 136 + i;
        d[0] = (bf16_t)f2bf(bflo(v.x) * sc); d[136] = (bf16_t)f2bf(bfhi(v.x) * sc); d[272] = (bf16_t)f2bf(bflo(v.y) * sc); d[408] = (bf16_t)f2bf(bfhi(v.y) * sc);
        d[544] = (bf16_t)f2bf(bflo(v.z) * sc); d[680] = (bf16_t)f2bf(bfhi(v.z) * sc); d[816] = (bf16_t)f2bf(bflo(v.w) * sc); d[952] = (bf16_t)f2bf(bfhi(v.w) * sc); }
    LDS_BAR();
    if (wave < 4) { const int et = wave >> 1, dt = wave & 1; f32x16 acc = {}; acc = mma32_ll(acc, VT + et * 32 * 136, 136, KT + dt * 32 * 136, 136, 8, lane);
        float* dc = (float*)(F.ws + WS_DC) + (size_t)unit * 4096; const int r32 = lane & 31, hi = lane >> 5;
#pragma unroll
        for (int r = 0; r < 16; ++r) dc[(et * 32 + crow(r, hi)) * 64 + dt * 32 + r32] = acc[r];
    } else if (wave == 4) { float s = 0.f; for (int i = 0; i < 128; ++i) s += bf2f(KT[lane * 136 + i]); ((float*)(F.ws + T_DN))[(size_t)unit * 64 + lane] = s; }
}

__device__ __forceinline__ void ml_pass2(const Frame& F) {
    const float* dc = (const float*)(F.ws + WS_DC); const float* dn = (const float*)(F.ws + T_DN);
    const float* mloc = (const float*)(F.ws + T_MLOC); const float* bend = (const float*)(F.ws + T_BEND);
    bf16_t* cst = (bf16_t*)(F.ws + WS_CST); float* nst = (float*)(F.ws + T_NST); float* mst = (float*)(F.ws + T_MST);
    LAS float* ML = (LAS float*)F.lds; LAS float* BE = ML + 128;
    for (int it = F.bx; it < 64 * 8; it += F.G) { const int bhd = it >> 3, part = it & 7, u0 = bhd * NCHK, el = part * 512 + F.tid;
        const bool don = (part == 0 && F.tid < 64);
        float d[NCHK], dnv[NCHK];
#pragma unroll
        for (int j = 0; j < NCHK; ++j) d[j] = dc[(size_t)(u0 + j) * 4096 + el];
#pragma unroll
        for (int j = 0; j < NCHK; ++j) dnv[j] = don ? dn[(size_t)(u0 + j) * 64 + F.tid] : 0.f;
        __syncthreads();
        if (F.tid < NCHK) { ML[F.tid] = mloc[u0 + F.tid]; BE[F.tid] = bend[u0 + F.tid]; }
        __syncthreads();
        float C = 0.f, n = 0.f, m = 0.f;
#pragma unroll
        for (int j = 0; j < NCHK; ++j) { const int u = u0 + j; const float ml = ML[j], be = BE[j];
            cst[(size_t)u * 4096 + el] = (bf16_t)f2bf(C); if (don) nst[(size_t)u * 64 + F.tid] = n; if (part == 0 && F.tid == 0) mst[u] = m;
            const float mn = fmaxf(be + m, ml), dcy = __expf(be + m - mn), sc = __expf(ml - mn);
            C = dcy * C + sc * d[j]; n = dcy * n + sc * dnv[j]; m = mn; }
    }
    __syncthreads();
}

__device__ __forceinline__ void ml_pass3_unit(const Frame& F, int l, int b, int h, int pc) {
    LAS unsigned char* lds = F.lds;
    LAS bf16_t* Qs = (LAS bf16_t*)lds;
    LAS bf16_t* Ks = (LAS bf16_t*)(lds + 18432);
    LAS bf16_t* VTs = (LAS bf16_t*)(lds + 36864);
    LAS bf16_t* CTs = (LAS bf16_t*)(lds + 62976);
    LAS bf16_t* Wm = (LAS bf16_t*)(lds + 76800);
    LAS float* HS = (LAS float*)(lds + 111616);
    LAS float* VEC = (LAS float*)(lds + 144384);
    LAS float* DEN = VEC + 12 * 128;
    const int tid = F.tid, lane = F.lane, wave = F.wave, r32 = lane & 31, hi = lane >> 5;
    const bool isctx = pc < 2; const int p0 = isctx ? pc * 128 : (pc - 2) * 128;
    const float* gate = (const float*)(F.ws + T_GATE); const float* gb = F.in[I_MLGB] + l * 16;
    const bf16_t* px = (const bf16_t*)(F.ws + WS_PX);
    int unit_d[2];
#pragma unroll
    for (int dir = 0; dir < 2; ++dir) { const int j = isctx ? (dir == 0 ? pc : 1 - pc) : (dir == 0 ? pc : 2 + 63 - (pc - 2)); unit_d[dir] = ((b * 4 + h) * 2 + dir) * NCHK + j; }
    LDS_BAR();
    const u32x4 cst0 = *(const u32x4*)((const bf16_t*)(F.ws + WS_CST) + (size_t)unit_d[0] * 4096 + tid * 8), cst1 = *(const u32x4*)((const bf16_t*)(F.ws + WS_CST) + (size_t)unit_d[1] * 4096 + tid * 8);
    const float nv0 = (tid < 64) ? ((const float*)(F.ws + T_NST))[(size_t)unit_d[0] * 64 + tid] : 0.f, nv1 = (tid < 64) ? ((const float*)(F.ws + T_NST))[(size_t)unit_d[1] * 64 + tid] : 0.f;
    const float mst0 = ((const float*)(F.ws + T_MST))[unit_d[0]], mst1 = ((const float*)(F.ws + T_MST))[unit_d[1]];
    if (tid < 256) { const int dir = tid >> 7, i = tid & 127; const int pos = dir ? p0 + 127 - i : p0 + i; const float* g = gate + (size_t)ml_row(b, isctx, pos) * 16;
        VEC[(dir * 6 + 0) * 128 + i] = g[dir * 8 + h] + gb[dir * 8 + h]; VEC[(dir * 6 + 1) * 128 + i] = log_sigmoidf_(g[dir * 8 + 4 + h] + gb[dir * 8 + 4 + h]); }
    for (int it = tid; it < 3072; it += NTHR) { const int i = it & 127, c = (it >> 7) & 7, which = it >> 10;
        const u32x4 v = *(const u32x4*)(px + (size_t)ml_row(b, isctx, p0 + i) * INC + which * 256 + h * 64 + c * 8);
        if (which == 0) *(LAS u32x4*)(Qs + i * 72 + c * 8) = v;
        else if (which == 1) { u32x4 w; w.x = pk2(bflo(v.x) * 0.125f, bfhi(v.x) * 0.125f); w.y = pk2(bflo(v.y) * 0.125f, bfhi(v.y) * 0.125f); w.z = pk2(bflo(v.z) * 0.125f, bfhi(v.z) * 0.125f); w.w = pk2(bflo(v.w) * 0.125f, bfhi(v.w) * 0.125f);
            *(LAS u32x4*)(Ks + i * 72 + c * 8) = w; }
        else { LAS bf16_t* d = VTs + (c * 8) * 136 + i; d[0] = (bf16_t)(v.x & 0xffff); d[136] = (bf16_t)(v.x >> 16); d[272] = (bf16_t)(v.y & 0xffff); d[408] = (bf16_t)(v.y >> 16);
            d[544] = (bf16_t)(v.z & 0xffff); d[680] = (bf16_t)(v.z >> 16); d[816] = (bf16_t)(v.w & 0xffff); d[952] = (bf16_t)(v.w >> 16); } }
    for (int it = tid; it < 32 * 136; it += NTHR) VTs[64 * 136 + it] = (it < 128) ? (bf16_t)0x3f80 : (bf16_t)0;
    LDS_BAR();
    if (wave < 2) { const int dir = wave; LAS float* V0 = VEC + dir * 6 * 128; const float mst = dir ? mst1 : mst0;
        const float a0 = V0[128 + 2 * lane], a1 = V0[128 + 2 * lane + 1]; float s = a0 + a1;
#pragma unroll
        for (int o = 1; o < 64; o <<= 1) { const float t = lane_up(s, o, lane); if (lane >= o) s += t; }
        const float b0 = s - a1, b1 = s, c0 = V0[2 * lane] - b0, c1 = V0[2 * lane + 1] - b1;
        float pm = fmaxf(c0, c1);
#pragma unroll
        for (int o = 1; o < 64; o <<= 1) { const float t = lane_up(pm, o, lane); if (lane >= o) pm = fmaxf(pm, t); }
        float pprev = lane_up(pm, 1, lane); if (lane == 0) pprev = -INFINITY;
        const float M0 = fmaxf(mst, fmaxf(pprev, c0)), M1 = fmaxf(mst, pm);
        V0[256 + 2 * lane] = c0; V0[256 + 2 * lane + 1] = c1; V0[384 + 2 * lane] = M0; V0[384 + 2 * lane + 1] = M1;
        V0[512 + 2 * lane] = __expf(mst - M0); V0[512 + 2 * lane + 1] = __expf(mst - M1); V0[640 + 2 * lane] = __expf(-b0 - M0); V0[640 + 2 * lane + 1] = __expf(-b1 - M1);
    }
    const u32x4 og0 = *(const u32x4*)(px + (size_t)ml_row(b, isctx, p0 + (tid >> 3)) * INC + 768 + h * 64 + (tid & 7) * 8), og1 = *(const u32x4*)(px + (size_t)ml_row(b, isctx, p0 + 64 + (tid >> 3)) * INC + 768 + h * 64 + (tid & 7) * 8);
    for (int dir = 0; dir < 2; ++dir) {
        const LAS float* COLV = VEC + (dir * 6 + 2) * 128; const LAS float* MV = COLV + 128; const LAS float* AIN = COLV + 256; const LAS float* EINV = COLV + 384;
        const int rs = dir ? -72 : 72, rb = dir ? 127 : 0;
        LDS_BAR();
        *(LAS u32x4*)(CTs + (tid >> 3) * 72 + (tid & 7) * 8) = dir ? cst1 : cst0;
        if (tid < 72) CTs[64 * 72 + tid] = (tid < 64) ? (bf16_t)f2bf(dir ? nv1 : nv0) : (bf16_t)0;
        for (int q = wave; q < 16; q += 8) { const int ti = q >> 2, si = q & 3; const int sidx = si * 32 + r32, spos = dir ? 127 - sidx : sidx;
            if (si > ti) {
#pragma unroll
                for (int r = 0; r < 16; ++r) Wm[(ti * 32 + crow(r, hi)) * 136 + spos] = 0;
            } else { f32x16 acc = {}; acc = mma32_ll(acc, Qs + (rb + (dir ? -ti * 32 : ti * 32)) * 72, rs, Ks + (rb + (dir ? -si * 32 : si * 32)) * 72, rs, 4, lane); const float cv = COLV[sidx];
#pragma unroll
                for (int r = 0; r < 16; ++r) { const int t = ti * 32 + crow(r, hi); const float w = (sidx <= t) ? acc[r] * __expf(cv - MV[t]) : 0.f; Wm[t * 136 + spos] = (bf16_t)f2bf(w); } }
        }
        LDS_BAR();
        f32x16 tot[2];
#pragma unroll
        for (int k = 0; k < 2; ++k) { const int q = wave + 8 * k; if (q < 12) { const int ti = q / 3, nt = q % 3;
            f32x16 a1 = {}; a1 = mma32_ll(a1, Wm + ti * 32 * 136, 136, VTs + nt * 32 * 136, 136, dir ? 8 : (ti + 1) * 2, lane, dir ? 8 - (ti + 1) * 2 : 0);
            f32x16 a2 = {}; a2 = mma32_ll(a2, Qs + (rb + (dir ? -ti * 32 : ti * 32)) * 72, rs, CTs + nt * 32 * 72, 72, 4, lane);
#pragma unroll
            for (int r = 0; r < 16; ++r) a1[r] += AIN[ti * 32 + crow(r, hi)] * a2[r];
            tot[k] = a1;
            if (nt == 2 && r32 == 0) {
#pragma unroll
                for (int r = 0; r < 16; ++r) DEN[ti * 32 + crow(r, hi)] = a1[r]; } } }
        LDS_BAR();
#pragma unroll
        for (int k = 0; k < 2; ++k) { const int q = wave + 8 * k; if (q < 12) { const int ti = q / 3, nt = q % 3; if (nt < 2) {
#pragma unroll
            for (int r = 0; r < 16; ++r) { const int t = ti * 32 + crow(r, hi); const float hv = tot[k][r] * frcp(fmaxf(fabsf(DEN[t]), EINV[t])); const int p = dir ? 127 - t : t;
                if (dir == 0) HS[p * 64 + nt * 32 + r32] = hv; else HS[p * 64 + nt * 32 + r32] += hv; } } } }
    }
    LDS_BAR();
    { const int c8 = (tid & 7) * 8; bf16_t* yc = (bf16_t*)(F.ws + WS_YC);
      const f32x4 hg0 = *(const f32x4*)(F.in[I_MLHG] + l * 256 + h * 64 + c8), hg1 = *(const f32x4*)(F.in[I_MLHG] + l * 256 + h * 64 + c8 + 4);
#pragma unroll
      for (int half = 0; half < 2; ++half) { const int p = half * 64 + (tid >> 3); const u32x4 og = half ? og1 : og0;
        const f32x4 v0 = *(const LAS f32x4*)(HS + p * 64 + c8), v1 = *(const LAS f32x4*)(HS + p * 64 + c8 + 4);
        float ss = (v0.x * v0.x + v0.y * v0.y) + (v0.z * v0.z + v0.w * v0.w) + (v1.x * v1.x + v1.y * v1.y) + (v1.z * v1.z + v1.w * v1.w);
        ss += xor_lane<1>(ss); ss += xor_lane<2>(ss); ss += xor_lane<4>(ss);
        const float sc = frsq(ss * (1.f / 64.f) + EPS);
        const f32x4 y0 = v0 * sc * hg0 * (f32x4){sigmoidf_(bflo(og.x)), sigmoidf_(bfhi(og.x)), sigmoidf_(bflo(og.y)), sigmoidf_(bfhi(og.y))};
        const f32x4 y1 = v1 * sc * hg1 * (f32x4){sigmoidf_(bflo(og.z)), sigmoidf_(bfhi(og.z)), sigmoidf_(bflo(og.w)), sigmoidf_(bfhi(og.w))};
        *(u32x4*)(yc + (size_t)ml_row(b, isctx, p0 + p) * 1024 + h * 64 + c8) = (u32x4){pk2(y0.x, y0.y), pk2(y0.z, y0.w), pk2(y1.x, y1.y), pk2(y1.z, y1.w)}; } }
}

struct PoolRegs { u32x4 v[5]; };
__device__ __forceinline__ PoolRegs pool_load(const Frame& F, int unit) {
    PoolRegs R; const int row0 = unit * 64, tid = F.tid;
    const bool isctx = row0 >= NLAT; const int T = isctx ? 256 : 8192, t0 = isctx ? (row0 - NLAT) & 255 : row0 & 8191, rbase = row0 - t0;
    const bf16_t* px = (const bf16_t*)(F.ws + WS_PX);
#pragma unroll
    for (int q = 0; q < 5; ++q) { const int it = tid + q * NTHR, rr = it >> 5, c = it & 31, t = t0 - 8 + rr; R.v[q] = (u32x4){0u, 0u, 0u, 0u};
        if (t >= 0 && t < T) R.v[q] = *(const u32x4*)(px + (size_t)(rbase + t) * INC + C_POOL + c * 8); }
    return R;
}
__device__ __forceinline__ void pool_unit(const Frame& F, int l, int unit, const PoolRegs& R) {
    LAS float* U = (LAS float*)F.lds;
    LAS bf16_t* D = (LAS bf16_t*)(F.lds + 81920);
    const int row0 = unit * 64, tid = F.tid, lane = F.lane, wave = F.wave;
    const bool isctx = row0 >= NLAT; const int T = isctx ? 256 : 8192, t0 = isctx ? (row0 - NLAT) & 255 : row0 & 8191, rbase = row0 - t0;
    const bf16_t* px = (const bf16_t*)(F.ws + WS_PX);
    LDS_BAR();
    {
#pragma unroll
      for (int q = 0; q < 5; ++q) { const int it = tid + q * NTHR, rr = it >> 5, c = it & 31; LAS float* d = U + rr * 256 + c * 8; const u32x4 v = R.v[q];
          *(LAS f32x4*)d = (f32x4){bflo(v.x), bfhi(v.x), bflo(v.y), bfhi(v.y)}; *(LAS f32x4*)(d + 4) = (f32x4){bflo(v.z), bfhi(v.z), bflo(v.w), bfhi(v.w)}; } }
    LDS_BAR();
    { const int c = tid & 255, th = tid >> 8, g = c >> 6, hw = 1 << g, tt0 = th * 32;
      float sacc = 0.f;
      for (int u = tt0 - hw; u < tt0 + hw; ++u) sacc += U[(u + 8) * 256 + c];
#pragma unroll 4
      for (int k = 0; k < 32; ++k) { const int tt = tt0 + k, t = t0 + tt; const int lo = max(t - hw, 0), hi = min(t + hw, T);
          D[tt * 264 + c] = (bf16_t)f2bf(sacc * frcp((float)(hi - lo)) - U[(tt + 8) * 256 + c]);
          sacc += U[(tt + hw + 8) * 256 + c] - U[(tt - hw + 8) * 256 + c]; } }
    LDS_BAR();
    { const int g = wave >> 1, rt = wave & 1, r32 = lane & 31, hi = lane >> 5; bf16_t* yc = (bf16_t*)(F.ws + WS_YC); const float* ps = F.in[I_POOLS] + l * 256;
      for (int nt = 0; nt < 2; ++nt) { f32x16 acc = {}; acc = mma32_lg<4>(acc, D + rt * 32 * 264 + g * 64, 264, (const bf16_t*)(F.ws + W_POOL) + (size_t)(g * 64 + nt * 32) * 64, 64, lane);
          const int col = g * 64 + nt * 32 + r32; const float sc = ps[col];
#pragma unroll
          for (int r = 0; r < 16; ++r) yc[(size_t)(row0 + rt * 32 + crow(r, hi)) * 1024 + 512 + col] = (bf16_t)f2bf(acc[r] * sc); } }
}
__device__ __forceinline__ void conv_z(const bf16_t* p, float (&z)[8]) { const u32x4 u = *(const u32x4*)p, cc = *(const u32x4*)(p + 512);
    z[0] = bflo(u.x) * bflo(cc.x); z[1] = bfhi(u.x) * bfhi(cc.x); z[2] = bflo(u.y) * bflo(cc.y); z[3] = bfhi(u.y) * bfhi(cc.y);
    z[4] = bflo(u.z) * bflo(cc.z); z[5] = bfhi(u.z) * bfhi(cc.z); z[6] = bflo(u.w) * bflo(cc.w); z[7] = bfhi(u.w) * bfhi(cc.w); }
__device__ __forceinline__ void conv_all(const Frame& F, int l, int nrows) {
    const bf16_t* px = (const bf16_t*)(F.ws + WS_PX); bf16_t* yc = (bf16_t*)(F.ws + WS_YC);
    const int c = (F.tid & 31) * 8;
    float w0[8], w1[8], w2[8], cb[8];
#pragma unroll
    for (int e = 0; e < 8; ++e) { w0[e] = F.in[I_CONVW][l * 768 + c + e]; w1[e] = F.in[I_CONVW][l * 768 + 256 + c + e]; w2[e] = F.in[I_CONVW][l * 768 + 512 + c + e]; cb[e] = F.in[I_CONVB][l * 256 + c + e]; }
    for (int it = F.bx * NTHR + F.tid; it < (nrows / 16) * 32; it += F.G * NTHR) { const int row0 = (it >> 5) * 16;
        const bool isctx = row0 >= NLAT; const int T = isctx ? 256 : 8192, t0 = isctx ? (row0 - NLAT) & 255 : row0 & 8191;
        const bf16_t* p = px + (size_t)row0 * INC + C_CONV + c;
        float zp[8], zc[8], zn[8];
        if (t0 > 0) conv_z(p - INC, zp); else {
#pragma unroll
            for (int e = 0; e < 8; ++e) zp[e] = 0.f; }
        conv_z(p, zc);
#pragma unroll 4
        for (int r = 0; r < 16; ++r) { const bf16_t* pr = p + (size_t)r * INC;
            if (t0 + r + 1 < T) conv_z(pr + INC, zn); else {
#pragma unroll
                for (int e = 0; e < 8; ++e) zn[e] = 0.f; }
            const u32x4 bw = *(const u32x4*)(pr + 256); const float bx[8] = {bflo(bw.x), bfhi(bw.x), bflo(bw.y), bfhi(bw.y), bflo(bw.z), bfhi(bw.z), bflo(bw.w), bfhi(bw.w)};
            float y[8];
#pragma unroll
            for (int e = 0; e < 8; ++e) { y[e] = bx[e] * (cb[e] + w0[e] * zp[e] + w1[e] * zc[e] + w2[e] * zn[e]); zp[e] = zc[e]; zc[e] = zn[e]; }
            u32x4 o; o.x = pk2(y[0], y[1]); o.y = pk2(y[2], y[3]); o.z = pk2(y[4], y[5]); o.w = pk2(y[6], y[7]);
            *(u32x4*)(yc + (size_t)(row0 + r) * 1024 + 768 + c) = o; }
    }
}

namespace att {
constexpr int STAGE_B = 40960, KSUB = 12288, VOFF = 24576, VSUB = 8192, LDS_WS = 3 * STAGE_B, LDS_OST = LDS_WS + 2048;
constexpr float THR = 8.0f;
__device__ __forceinline__ void glds16(const void* gsrc, unsigned lds_dst) { unsigned keep;
    asm volatile("s_mov_b32 %0, m0\n\ts_mov_b32 m0, %2\n\ts_nop 0\n\tglobal_load_lds_dwordx4 %1, off\n\ts_mov_b32 m0, %0" : "=&s"(keep) : "v"(gsrc), "s"(lds_dst) : "memory"); }
#define ATT_WAIT_BAR(N) asm volatile("s_waitcnt vmcnt(" #N ") lgkmcnt(0)\n\ts_barrier" ::: "memory")
__device__ __forceinline__ void qkt(f32x16& p0, f32x16& p1, const LAS char* Kslot, const bf16x8* qr, int r32, int hi) {
    const LAS char* kb = Kslot + hi * 1024 + r32 * 16; p0 = f32x16{}; p1 = f32x16{};
#pragma unroll
    for (int d0 = 0; d0 < 6; ++d0) {
        const bf16x8 b0 = *(const LAS bf16x8*)(kb + d0 * 2048), b1 = *(const LAS bf16x8*)(kb + d0 * 2048 + 512);
        p0 = __builtin_amdgcn_mfma_f32_32x32x16_bf16(b0, qr[d0], p0, 0, 0, 0); p1 = __builtin_amdgcn_mfma_f32_32x32x16_bf16(b1, qr[d0], p1, 0, 0, 0); }
}
__device__ __forceinline__ float rowmax(const f32x16& p0, const f32x16& p1) {
    float a = fmaxf(p0[0], p1[0]);
#pragma unroll
    for (int r = 1; r < 16; ++r) a = fmaxf(a, fmaxf(p0[r], p1[r]));
    auto rr = __builtin_amdgcn_permlane32_swap(__float_as_uint(a), __float_as_uint(a), false, false);
    return fmaxf(__uint_as_float(rr[0]), __uint_as_float(rr[1]));
}
__device__ __forceinline__ void pv(f32x16* o, int vb, bf16x8 pa0, bf16x8 pa1, bf16x8 pa2, bf16x8 pa3) {
#pragma unroll
    for (int d0 = 0; d0 < 2; ++d0) { s16x4 lo[4], hi[4];
#pragma unroll
        for (int ks = 0; ks < 4; ++ks) {
            asm volatile("ds_read_b64_tr_b16 %0,%1 offset:%c2" : "=&v"(lo[ks]) : "v"(vb), "i"(d0 * 4096 + ks * 1024) : "memory");
            asm volatile("ds_read_b64_tr_b16 %0,%1 offset:%c2" : "=&v"(hi[ks]) : "v"(vb), "i"(d0 * 4096 + ks * 1024 + 512) : "memory"); }
        asm volatile("s_waitcnt lgkmcnt(0)" ::: "memory"); __builtin_amdgcn_sched_barrier(0);
#define ATT_PK(k) (bf16x8){lo[k][0], lo[k][1], lo[k][2], lo[k][3], hi[k][0], hi[k][1], hi[k][2], hi[k][3]}
        o[d0] = __builtin_amdgcn_mfma_f32_32x32x16_bf16(pa0, ATT_PK(0), o[d0], 0, 0, 0);
        o[d0] = __builtin_amdgcn_mfma_f32_32x32x16_bf16(pa1, ATT_PK(1), o[d0], 0, 0, 0);
        o[d0] = __builtin_amdgcn_mfma_f32_32x32x16_bf16(pa2, ATT_PK(2), o[d0], 0, 0, 0);
        o[d0] = __builtin_amdgcn_mfma_f32_32x32x16_bf16(pa3, ATT_PK(3), o[d0], 0, 0, 0);
#undef ATT_PK
    }
}
__device__ __forceinline__ void unit(const Frame& F, int bh, int qrow, int orow, int nst) {
    const int tid = F.tid, lane = F.lane, wid = F.wave, r32 = lane & 31, hi = lane >> 5, h = bh & 3;
    const unsigned lds0 = (unsigned)(uintptr_t)F.lds;
    const LAS char* ring = (const LAS char*)F.lds;
    LAS float* wsf = (LAS float*)(F.lds + LDS_WS) + wid * 64;
    const char* kg = (const char*)(F.ws + WS_KT) + (size_t)bh * NKT * 12288; const char* vg = (const char*)(F.ws + WS_VT) + (size_t)bh * NKT * 8192;
    const bf16_t* Qw = (const bf16_t*)(F.ws + WS_QB) + (size_t)(qrow + wid * 32) * 384 + h * 96;
#define ATT_DMA(t, slot) do { const char* ks_ = kg + (size_t)(t) * 24576 + wid * 1024 + lane * 16; const char* vs_ = vg + (size_t)(t) * 16384 + wid * 1024 + lane * 16; \
        const unsigned kd_ = lds0 + (slot) * STAGE_B + wid * 1024, vd_ = kd_ + VOFF; \
        glds16(ks_, (unsigned)__builtin_amdgcn_readfirstlane(kd_)); glds16(ks_ + 8192, (unsigned)__builtin_amdgcn_readfirstlane(kd_ + 8192)); glds16(ks_ + 16384, (unsigned)__builtin_amdgcn_readfirstlane(kd_ + 16384)); \
        glds16(vs_, (unsigned)__builtin_amdgcn_readfirstlane(vd_)); glds16(vs_ + 8192, (unsigned)__builtin_amdgcn_readfirstlane(vd_ + 8192)); } while (0)
    ATT_DMA(0, 0); if (nst > 1) ATT_DMA(1, 1);
    bf16x8 qr[6];
#pragma unroll
    for (int d0 = 0; d0 < 6; ++d0) qr[d0] = *(const bf16x8*)(Qw + (size_t)r32 * 384 + d0 * 16 + hi * 8);
    float mhat = 0.f, l_reg = 0.f; f32x16 o[2]; o[0] = f32x16{}; o[1] = f32x16{};
    const int vb0 = (int)lds0 + VOFF + ((lane >> 4) & 1) * 32 + (lane & 3) * 8 + (4 * hi + ((lane & 15) >> 2)) * 64;
    int slot = 0; bool first = true;
    for (int t = 0; t < nst; ++t) {
        if (t + 1 < nst) ATT_WAIT_BAR(5); else ATT_WAIT_BAR(0);
        if (t + 2 < nst) { const int s2 = (slot == 0) ? 2 : slot - 1; ATT_DMA(t + 2, s2); }
#pragma unroll
        for (int s = 0; s < 2; ++s) {
            f32x16 p0, p1; qkt(p0, p1, ring + slot * STAGE_B + s * KSUB, qr, r32, hi);
            const float rm = rowmax(p0, p1);
            if (first) { mhat = rm; first = false; }
            else if (__any(rm - mhat > THR)) { const float dl = fmaxf(rm - mhat, 0.f); mhat += dl; const float f = __builtin_amdgcn_exp2f(-dl); l_reg *= f;
                if (hi == 0) wsf[r32] = f; LDS_WAIT();
#pragma unroll
                for (int r = 0; r < 16; ++r) { const float fr_ = wsf[crow(r, hi)]; o[0][r] *= fr_; o[1][r] *= fr_; } }
            float sacc = 0.f;
#pragma unroll
            for (int r = 0; r < 16; ++r) { p0[r] = __builtin_amdgcn_exp2f(p0[r] - mhat); p1[r] = __builtin_amdgcn_exp2f(p1[r] - mhat); sacc += p0[r] + p1[r]; }
            l_reg += sacc;
            u32x4 pw0, pw1, pw2, pw3;
            pw0 = (u32x4){cvt_pk_bf16(p0[0], p0[1]), cvt_pk_bf16(p0[2], p0[3]), cvt_pk_bf16(p0[4], p0[5]), cvt_pk_bf16(p0[6], p0[7])};
            pw1 = (u32x4){cvt_pk_bf16(p0[8], p0[9]), cvt_pk_bf16(p0[10], p0[11]), cvt_pk_bf16(p0[12], p0[13]), cvt_pk_bf16(p0[14], p0[15])};
            pw2 = (u32x4){cvt_pk_bf16(p1[0], p1[1]), cvt_pk_bf16(p1[2], p1[3]), cvt_pk_bf16(p1[4], p1[5]), cvt_pk_bf16(p1[6], p1[7])};
            pw3 = (u32x4){cvt_pk_bf16(p1[8], p1[9]), cvt_pk_bf16(p1[10], p1[11]), cvt_pk_bf16(p1[12], p1[13]), cvt_pk_bf16(p1[14], p1[15])};
            __builtin_amdgcn_sched_barrier(0);
            pv(o, vb0 + slot * STAGE_B + s * VSUB, __builtin_bit_cast(bf16x8, pw0), __builtin_bit_cast(bf16x8, pw1), __builtin_bit_cast(bf16x8, pw2), __builtin_bit_cast(bf16x8, pw3));
        }
        slot = (slot == 2) ? 0 : slot + 1;
    }
    { auto rr = __builtin_amdgcn_permlane32_swap(__float_as_uint(l_reg), __float_as_uint(l_reg), false, false); l_reg = __uint_as_float(rr[0]) + __uint_as_float(rr[1]); }
    if (hi == 0) wsf[32 + r32] = l_reg; LDS_WAIT();
    float rli[16];
#pragma unroll
    for (int r = 0; r < 16; ++r) rli[r] = frcp(wsf[32 + crow(r, hi)]);
    LAS bf16_t* stg = (LAS bf16_t*)(F.lds + LDS_OST) + wid * 2048;
#pragma unroll
    for (int r = 0; r < 16; ++r) { const int orow_ = crow(r, hi);
#pragma unroll
        for (int d0 = 0; d0 < 2; ++d0) stg[orow_ * 64 + d0 * 32 + r32] = (bf16_t)f2bf(o[d0][r] * rli[r]); }
    LDS_WAIT();
    bf16_t* Ow = (bf16_t*)(F.ws + WS_YC) + (size_t)(orow + wid * 32) * 1024 + 256 + h * 64;
#pragma unroll
    for (int i = 0; i < 4; ++i) { const int row = i * 8 + (lane >> 3), ch = lane & 7; const u32x4 v = *(const LAS u32x4*)(stg + row * 64 + ch * 8); *(u32x4*)(Ow + (size_t)row * 1024 + ch * 8) = v; }
    asm volatile("s_waitcnt lgkmcnt(0)\n\ts_barrier" ::: "memory");
#undef ATT_DMA
}
}

namespace att2 {
constexpr int KSL = 12288, VSL = 8192, LDS_K = 0, LDS_V = 3 * KSL, LDS_WS = LDS_V + 3 * VSL, LDS_OST = LDS_WS + 2048;
#define A2_SBAR() __builtin_amdgcn_sched_barrier(0)
#define A2_WAIT_BAR(N) asm volatile("s_waitcnt vmcnt(" #N ") lgkmcnt(0)\n\ts_barrier" ::: "memory")
__device__ __forceinline__ void glds16s(const void* sbase, unsigned voff, unsigned lds_dst) { unsigned keep;
    asm volatile("s_mov_b32 %0, m0\n\ts_mov_b32 m0, %3\n\ts_nop 4\n\tglobal_load_lds_dwordx4 %1, %2\n\ts_mov_b32 m0, %0" : "=&s"(keep) : "v"(voff), "s"(sbase), "s"(lds_dst) : "memory"); }
__device__ __forceinline__ unsigned cvtpk_s(float lo, float hi) { typedef float f2 __attribute__((ext_vector_type(2))); typedef __bf16 b2 __attribute__((ext_vector_type(2))); f2 v = {lo, hi}; b2 b = __builtin_convertvector(v, b2); return __builtin_bit_cast(unsigned, b); }
typedef short v4i16_t __attribute__((ext_vector_type(4)));
__device__ __forceinline__ s16x4 vtr(const LAS char* p) { return __builtin_bit_cast(s16x4, __builtin_amdgcn_ds_read_tr16_b64_v4i16((LAS v4i16_t*)p)); }
__device__ __forceinline__ void kload2(bf16x8* kf, const LAS char* kp, int j) { kf[2 * j] = *(const LAS bf16x8*)(kp + j * 2048); kf[2 * j + 1] = *(const LAS bf16x8*)(kp + j * 2048 + 512); }

template <bool NOMAX> __device__ __forceinline__ void unit(const Frame& F, int bh, int qrow, int orow, int NT) {
    const int lane = F.lane, wid = F.wave, r32 = lane & 31, hi = lane >> 5, h = bh & 3;
    const unsigned lds0 = (unsigned)(uintptr_t)F.lds;
    const LAS char* shm3 = (const LAS char*)F.lds;
    LAS float* wsf = (LAS float*)(F.lds + LDS_WS) + wid * 64;
    const char* kg = (const char*)(F.ws + WS_KT) + (size_t)bh * NKT * 12288; const char* vg = (const char*)(F.ws + WS_VT) + (size_t)bh * NKT * 8192 + wid * 1024; const unsigned l16 = lane * 16;
    const bf16_t* Qw = (const bf16_t*)(F.ws + WS_QB) + (size_t)(qrow + wid * 32) * 384 + h * 96;
    const int kp2 = 8 + (wid & 3);
#define A2_DMA_K(t, sl) do { const char* s_ = kg + (size_t)(t) * 12288; const unsigned d_ = lds0 + LDS_K + (sl) * KSL; \
        glds16s(s_ + wid * 1024, l16, (unsigned)__builtin_amdgcn_readfirstlane(d_ + wid * 1024)); glds16s(s_ + kp2 * 1024, l16, (unsigned)__builtin_amdgcn_readfirstlane(d_ + kp2 * 1024)); } while (0)
#define A2_DMA_V(t, sl) glds16s(vg + (size_t)(t) * 8192, l16, (unsigned)__builtin_amdgcn_readfirstlane(lds0 + LDS_V + (sl) * VSL + wid * 1024))
    const LAS char* kp0 = shm3 + LDS_K + hi * 1024 + r32 * 16;
    const LAS char* vp0 = shm3 + LDS_V + ((lane >> 4) & 1) * 32 + (lane & 3) * 8 + (4 * hi + ((lane & 15) >> 2)) * 64;
    bf16x8 kf[12];
    A2_DMA_K(0, 0); A2_DMA_V(0, 0); A2_DMA_K(1, 1);
    bf16x8 qr[6];
#pragma unroll
    for (int d0 = 0; d0 < 6; ++d0) qr[d0] = *(const bf16x8*)(Qw + (size_t)r32 * 384 + d0 * 16 + hi * 8);
    float mhat = 0.f, l_reg = 0.f; f32x16 o[2]; o[0] = f32x16{}; o[1] = f32x16{};
    bool resc = false;
    f32x16 pA0, pA1, pB0, pB1;
    int sl_prev = 0, sl_cur = 0, sl_next = 1;
#define A2_ROT() do { sl_prev = sl_cur; sl_cur = sl_next; sl_next = (sl_next == 2) ? 0 : sl_next + 1; } while (0)
#define A2_RESC() do { if (!NOMAX && resc) { asm volatile("s_waitcnt lgkmcnt(0)" ::: "memory"); \
        _Pragma("unroll") for (int d_ = 0; d_ < 2; ++d_) _Pragma("unroll") for (int r = 0; r < 16; ++r) o[d_][r] *= wsf[crow(r, hi)]; } } while (0)
    A2_DMA_K(2, 2);
    A2_WAIT_BAR(5);
    { kload2(kf, kp0, 0); kload2(kf, kp0, 1); kload2(kf, kp0, 2); kload2(kf, kp0, 3); kload2(kf, kp0, 4); kload2(kf, kp0, 5);
      pA0 = f32x16{}; pA1 = f32x16{};
#pragma unroll
      for (int d0 = 0; d0 < 6; ++d0) { pA0 = __builtin_amdgcn_mfma_f32_32x32x16_bf16(kf[2 * d0], qr[d0], pA0, 0, 0, 0); pA1 = __builtin_amdgcn_mfma_f32_32x32x16_bf16(kf[2 * d0 + 1], qr[d0], pA1, 0, 0, 0); }
      if constexpr (!NOMAX) { float a = fmaxf(pA0[0], pA1[0]);
#pragma unroll
      for (int r = 1; r < 16; ++r) a = fmaxf(a, fmaxf(pA0[r], pA1[r]));
      { auto rr = __builtin_amdgcn_permlane32_swap(__float_as_uint(a), __float_as_uint(a), false, false); a = fmaxf(__uint_as_float(rr[0]), __uint_as_float(rr[1])); }
      mhat = a; }
#pragma unroll
      for (int r = 0; r < 16; ++r) { pA0[r] = __builtin_amdgcn_exp2f(pA0[r] - mhat); pA1[r] = __builtin_amdgcn_exp2f(pA1[r] - mhat); } }
    A2_WAIT_BAR(0);
    A2_DMA_K(3, 0); A2_DMA_V(1, 1);
    A2_ROT();
    { const LAS char* kp = kp0 + sl_cur * KSL; kload2(kf, kp, 0); kload2(kf, kp, 1); kload2(kf, kp, 2); kload2(kf, kp, 3); kload2(kf, kp, 4); kload2(kf, kp, 5); }
    A2_WAIT_BAR(3);
    s16x4 vlo[8], vhi[8]; u32x4 pw0, pw1, pw2, pw3;
#define A2_PKW(P, B) cvtpk_s(P[B], P[B + 1])
#define A2_PAF(k) __builtin_bit_cast(bf16x8, pw##k)
#define A2_VFR(i) (bf16x8){vlo[i][0], vlo[i][1], vlo[i][2], vlo[i][3], vhi[i][0], vhi[i][1], vhi[i][2], vhi[i][3]}
#define A2_PIN(x) asm volatile("" : "+v"(x))
#define A2_MX3(a, b, c) __builtin_fmaxf(__builtin_fmaxf((a), (b)), (c))
#define A2_GAPA(MF, A0, A1, A2, A3, W0, W1, PW) do { MF; sacc += A0; sacc += A1; sacc += A2; sacc += A3; A2_PIN(sacc); W0; W1; A2_PIN(PW); A2_SBAR(); } while (0)
#define A2_GAPM(MF) do { MF; A2_SBAR(); } while (0)
#define A2_EX(v) __builtin_amdgcn_exp2f(v)
#define A2_SH(v) (NOMAX ? (v) : (v) - mhat)
#define A2_GAPB(MF, X, B) do { MF; X[B] = A2_EX(A2_SH(X[B])); X[B + 1] = A2_EX(A2_SH(X[B + 1])); X[B + 2] = A2_EX(A2_SH(X[B + 2])); X[B + 3] = A2_EX(A2_SH(X[B + 3])); A2_PIN(X); A2_SBAR(); } while (0)
#define A2_VRD(i) do { vlo[i] = vtr(vp_ + (((i) >> 2) * 4096 + ((i) & 3) * 1024)); vhi[i] = vtr(vp_ + (((i) >> 2) * 4096 + ((i) & 3) * 1024 + 512)); } while (0)
#define A2_KRD(G, j) do { if (G) { kload2(kf, kp0 + sl_next * KSL, j); A2_SBAR(); } } while (0)
#define A2_MF(C, kk, qq, CI) C = __builtin_amdgcn_mfma_f32_32x32x16_bf16(kf[kk], qr[qq], CI, 0, 0, 0)
#define A2_STEP(C0, C1, P0, P1, t, GK, GV, GL) do { A2_SBAR(); \
    const LAS char* vp_ = vp0 + sl_prev * VSL; \
    A2_VRD(0); A2_SBAR(); float sacc = (P0[0] + P0[1]); \
    A2_GAPA(A2_MF(C0, 0, 0, (f32x16{})), P0[2], P0[3], P0[4], P0[5],     pw0[0] = A2_PKW(P0, 0), pw0[1] = A2_PKW(P0, 2), pw0); \
    A2_VRD(4); A2_SBAR(); A2_GAPA(A2_MF(C1, 1, 0, (f32x16{})), P0[6], P0[7], P0[8], P0[9],     pw0[2] = A2_PKW(P0, 4), pw0[3] = A2_PKW(P0, 6), pw0); \
    A2_VRD(1); A2_SBAR(); A2_GAPA(A2_MF(C0, 2, 1, C0),   P0[10], P0[11], P0[12], P0[13], pw1[0] = A2_PKW(P0, 8), pw1[1] = A2_PKW(P0, 10), pw1); \
    A2_VRD(5); A2_SBAR(); A2_GAPA(A2_MF(C1, 3, 1, C1),   P0[14], P0[15], P1[0], P1[1],   pw1[2] = A2_PKW(P0, 12), pw1[3] = A2_PKW(P0, 14), pw1); \
    A2_VRD(2); A2_SBAR(); A2_GAPA(A2_MF(C0, 4, 2, C0),   P1[2], P1[3], P1[4], P1[5],     pw2[0] = A2_PKW(P1, 0), pw2[1] = A2_PKW(P1, 2), pw2); \
    A2_VRD(6); A2_SBAR(); A2_GAPA(A2_MF(C1, 5, 2, C1),   P1[6], P1[7], P1[8], P1[9],     pw2[2] = A2_PKW(P1, 4), pw2[3] = A2_PKW(P1, 6), pw2); \
    A2_VRD(3); A2_SBAR(); A2_GAPA(A2_MF(C0, 6, 3, C0),   P1[10], P1[11], P1[12], P1[13], pw3[0] = A2_PKW(P1, 8), pw3[1] = A2_PKW(P1, 10), pw3); \
    A2_VRD(7); A2_SBAR(); A2_GAPA(A2_MF(C1, 7, 3, C1),   P1[14], P1[15], 0.f, 0.f,       pw3[2] = A2_PKW(P1, 12), pw3[3] = A2_PKW(P1, 14), pw3); \
    A2_GAPM(A2_MF(C0, 8, 4, C0)); A2_GAPM(A2_MF(C1, 9, 4, C1)); A2_GAPM(A2_MF(C0, 10, 5, C0)); A2_GAPM(A2_MF(C1, 11, 5, C1)); \
    l_reg += sacc; \
    if (GK) { A2_DMA_K((t) + 3, sl_cur); } if (GV) { A2_DMA_V((t) + 1, sl_next); } \
    if constexpr (!NOMAX) { float a = A2_MX3(C0[0], C0[1], C1[0]), b = A2_MX3(C0[2], C0[3], C1[1]); a = A2_MX3(a, C1[2], C1[3]); \
      _Pragma("unroll") for (int r = 4; r < 16; r += 4) { a = A2_MX3(a, C0[r], C0[r + 1]); b = A2_MX3(b, C0[r + 2], C0[r + 3]); a = A2_MX3(a, C1[r], C1[r + 1]); b = A2_MX3(b, C1[r + 2], C1[r + 3]); } \
      float rm = __builtin_fmaxf(a, b); { auto rr = __builtin_amdgcn_permlane32_swap(__float_as_uint(rm), __float_as_uint(rm), false, false); rm = __builtin_fmaxf(__uint_as_float(rr[0]), __uint_as_float(rr[1])); } \
      resc = false; \
      if (__builtin_expect(__any(rm - mhat > 8.0f), 0)) { const float dl = __builtin_fmaxf(rm - mhat, 0.f); mhat += dl; \
        const float f = __builtin_amdgcn_exp2f(-dl); l_reg *= f; if (hi == 0) wsf[r32] = f; resc = true; } } \
    A2_SBAR(); \
    A2_GAPB(o[0] = __builtin_amdgcn_mfma_f32_32x32x16_bf16(A2_PAF(0), A2_VFR(0), o[0], 0, 0, 0), C0, 0); \
    A2_KRD(GL, 0); A2_GAPB(o[1] = __builtin_amdgcn_mfma_f32_32x32x16_bf16(A2_PAF(0), A2_VFR(4), o[1], 0, 0, 0), C0, 4); \
    A2_KRD(GL, 1); A2_GAPB(o[0] = __builtin_amdgcn_mfma_f32_32x32x16_bf16(A2_PAF(1), A2_VFR(1), o[0], 0, 0, 0), C0, 8); \
    A2_KRD(GL, 2); A2_GAPB(o[1] = __builtin_amdgcn_mfma_f32_32x32x16_bf16(A2_PAF(1), A2_VFR(5), o[1], 0, 0, 0), C0, 12); \
    A2_KRD(GL, 3); A2_GAPB(o[0] = __builtin_amdgcn_mfma_f32_32x32x16_bf16(A2_PAF(2), A2_VFR(2), o[0], 0, 0, 0), C1, 0); \
    A2_KRD(GL, 4); A2_GAPB(o[1] = __builtin_amdgcn_mfma_f32_32x32x16_bf16(A2_PAF(2), A2_VFR(6), o[1], 0, 0, 0), C1, 4); \
    A2_KRD(GL, 5); A2_GAPB(o[0] = __builtin_amdgcn_mfma_f32_32x32x16_bf16(A2_PAF(3), A2_VFR(3), o[0], 0, 0, 0), C1, 8); \
    A2_GAPB(o[1] = __builtin_amdgcn_mfma_f32_32x32x16_bf16(A2_PAF(3), A2_VFR(7), o[1], 0, 0, 0), C1, 12); \
    } while (0)
    int t = 1;
    for (; t + 5 < NT; t += 2) {
        A2_STEP(pB0, pB1, pA0, pA1, t, true, true, true);     A2_WAIT_BAR(3); A2_RESC(); A2_ROT();
        A2_STEP(pA0, pA1, pB0, pB1, t + 1, true, true, true); A2_WAIT_BAR(3); A2_RESC(); A2_ROT();
    }
#define A2_ENDW(tt) do { if ((tt) + 3 < NT) { A2_WAIT_BAR(3); } else if ((tt) + 2 < NT) { A2_WAIT_BAR(1); } else { A2_WAIT_BAR(0); } } while (0)
    for (; t + 1 < NT; t += 2) {
        A2_STEP(pB0, pB1, pA0, pA1, t, (t + 3 < NT), (t + 1 < NT), (t + 1 < NT));     A2_ENDW(t);     A2_RESC(); A2_ROT();
        A2_STEP(pA0, pA1, pB0, pB1, t + 1, (t + 4 < NT), (t + 2 < NT), (t + 2 < NT)); A2_ENDW(t + 1); A2_RESC(); A2_ROT();
    }
    A2_STEP(pB0, pB1, pA0, pA1, NT - 1, false, false, false); A2_RESC();
    { float sacc = pB0[0] + pB0[1];
#pragma unroll
      for (int r = 2; r < 16; ++r) sacc += pB0[r];
#pragma unroll
      for (int r = 0; r < 16; ++r) sacc += pB1[r];
      l_reg += sacc;
      pw0 = (u32x4){A2_PKW(pB0, 0), A2_PKW(pB0, 2), A2_PKW(pB0, 4), A2_PKW(pB0, 6)}; pw1 = (u32x4){A2_PKW(pB0, 8), A2_PKW(pB0, 10), A2_PKW(pB0, 12), A2_PKW(pB0, 14)};
      pw2 = (u32x4){A2_PKW(pB1, 0), A2_PKW(pB1, 2), A2_PKW(pB1, 4), A2_PKW(pB1, 6)}; pw3 = (u32x4){A2_PKW(pB1, 8), A2_PKW(pB1, 10), A2_PKW(pB1, 12), A2_PKW(pB1, 14)};
      A2_SBAR();
      const int vb = (int)lds0 + LDS_V + ((lane >> 4) & 1) * 32 + (lane & 3) * 8 + (4 * hi + ((lane & 15) >> 2)) * 64 + sl_cur * VSL;
      att::pv(o, vb, A2_PAF(0), A2_PAF(1), A2_PAF(2), A2_PAF(3)); }
    { auto rr = __builtin_amdgcn_permlane32_swap(__float_as_uint(l_reg), __float_as_uint(l_reg), false, false); l_reg = __uint_as_float(rr[0]) + __uint_as_float(rr[1]); }
    if (hi == 0) wsf[32 + r32] = l_reg; LDS_WAIT();
    float rli[16];
#pragma unroll
    for (int r = 0; r < 16; ++r) rli[r] = __builtin_amdgcn_rcpf(wsf[32 + crow(r, hi)]);
    LAS bf16_t* stg = (LAS bf16_t*)(F.lds + LDS_OST) + wid * 2048;
#pragma unroll
    for (int r = 0; r < 16; ++r) { const int orow_ = crow(r, hi);
#pragma unroll
        for (int d0 = 0; d0 < 2; ++d0) stg[orow_ * 64 + d0 * 32 + r32] = (bf16_t)f2bf(o[d0][r] * rli[r]); }
    LDS_WAIT();
    bf16_t* Ow = (bf16_t*)(F.ws + WS_YC) + (size_t)(orow + wid * 32) * 1024 + 256 + h * 64;
#pragma unroll
    for (int i = 0; i < 4; ++i) { const int row = i * 8 + (lane >> 3), ch = lane & 7; const u32x4 v = *(const LAS u32x4*)(stg + row * 64 + ch * 8); *(u32x4*)(Ow + (size_t)row * 1024 + ch * 8) = v; }
    asm volatile("s_waitcnt lgkmcnt(0)\n\ts_barrier" ::: "memory");
}
}

__device__ __forceinline__ void ph_norm2_route(const Frame& F, int l, int ntok) {
    LAS bf16_t* A = (LAS bf16_t*)F.lds;
    LAS float* PART = (LAS float*)(F.lds + 66048);
    LAS float* LOG = (LAS float*)(F.lds + 131584);
    LAS int* HIST = (LAS int*)(F.lds + 139776);
    const int tid = F.tid, lane = F.lane, wave = F.wave, r32 = lane & 31, hi = lane >> 5;
    const int tpb = ntok / F.G, tok0 = F.bx * tpb;
    int* eidx = (int*)(F.ws + T_EIDX); float* ew = (float*)(F.ws + T_EW);
    const float* brt = F.in[I_BRT] + l * 64;
    if (tid < 64) HIST[tid] = 0;
    LAS f32x4* AV = (LAS f32x4*)(F.lds + 140288);
    LAS f32x4* SHV = AV + 512;
    const int mr_first = mod_row_of(tok0), mr_last = mod_row_of(tok0 + tpb - 1);
    { const int set = tid >> 8, idx = tid & 255, mrs = set ? mr_last : mr_first;
      const f32x4 gv = ((const f32x4*)(F.in[I_GFFN] + l * 1024))[idx], scv = ((const f32x4*)modp(F, l, mrs, 4))[idx];
      AV[tid] = gv * (scv + 1.0f); SHV[tid] = ((const f32x4*)modp(F, l, mrs, 3))[idx]; }
    bf16x8 wrt[2][8];
#pragma unroll
    for (int nt = 0; nt < 2; ++nt)
#pragma unroll
        for (int ks = 0; ks < 8; ++ks) wrt[nt][ks] = *(const bf16x8*)((const bf16_t*)(F.ws + W_RT) + (size_t)(nt * 32 + r32) * 1024 + wave * 128 + ks * 16 + hi * 8);
    f32x4 xn[4][4]; u32x2 mn[4][4];
#pragma unroll
    for (int rr = 0; rr < 4; ++rr) { const int t = min(wave * 4 + rr, tpb - 1); const f32x4* xr = (const f32x4*)stream_row(F, l, tok0 + t) + lane; const u32x2* mg = (const u32x2*)((const bf16_t*)(F.ws + WS_YC) + (size_t)(tok0 + t) * 1024) + lane;
#pragma unroll
        for (int j = 0; j < 4; ++j) { xn[rr][j] = xr[64 * j]; mn[rr][j] = mg[64 * j]; } }
    for (int b0 = 0; b0 < tpb; b0 += 32) {
        __syncthreads();
        { f32x4 v[4][4];
#pragma unroll
          for (int rr = 0; rr < 4; ++rr) {
#pragma unroll
                for (int j = 0; j < 4; ++j) { const u32x2 w = mn[rr][j]; v[rr][j] = xn[rr][j] + (f32x4){bflo(w.x), bfhi(w.x), bflo(w.y), bfhi(w.y)}; } }
#pragma unroll
          for (int rr = 0; rr < 4; ++rr) { const int r = wave * 4 + rr, t = b0 + r; LAS u32x2* a = (LAS u32x2*)(A + r * 1032) + lane;
            if (t < tpb) { const int row = tok0 + t, mr = mod_row_of(row); f32x4 y[4];
                f32x4* xo = (f32x4*)((row < NLAT) ? F.out + (size_t)row * 1024 : (float*)(F.ws + WS_CTXS) + (size_t)(row - NLAT) * 1024) + lane;
#pragma unroll
                for (int j = 0; j < 4; ++j) xo[64 * j] = v[rr][j];
                { float s2 = 0.f;
#pragma unroll
                  for (int j = 0; j < 4; ++j) s2 += (v[rr][j].x * v[rr][j].x + v[rr][j].y * v[rr][j].y) + (v[rr][j].z * v[rr][j].z + v[rr][j].w * v[rr][j].w);
                  const float rstd = frsq(wave_sum(s2) * (1.f / 1024.f) + EPS); const int vb = (mr == mr_first ? 0 : 256) + lane;
#pragma unroll
                  for (int j = 0; j < 4; ++j) y[j] = v[rr][j] * rstd * AV[vb + 64 * j] + SHV[vb + 64 * j]; }
                unsigned* o8 = (unsigned*)(F.ws + WS_HX8 + (size_t)row * 1024) + lane;
#pragma unroll
                for (int j = 0; j < 4; ++j) { a[64 * j] = (u32x2){pk2(y[j].x, y[j].y), pk2(y[j].z, y[j].w)}; o8[64 * j] = pk4_fp8(y[j].x, y[j].y, y[j].z, y[j].w); }
            } else {
#pragma unroll
                for (int j = 0; j < 4; ++j) a[64 * j] = (u32x2){0u, 0u}; } } }
        if (b0 + 32 < tpb) {
#pragma unroll
            for (int rr = 0; rr < 4; ++rr) { const int t = min(b0 + 32 + wave * 4 + rr, tpb - 1); const f32x4* xr = (const f32x4*)stream_row(F, l, tok0 + t) + lane; const u32x2* mg = (const u32x2*)((const bf16_t*)(F.ws + WS_YC) + (size_t)(tok0 + t) * 1024) + lane;
#pragma unroll
                for (int j = 0; j < 4; ++j) { xn[rr][j] = xr[64 * j]; mn[rr][j] = mg[64 * j]; } } }
        __syncthreads();
#pragma unroll
        for (int nt = 0; nt < 2; ++nt) { f32x16 acc = {};
#pragma unroll
            for (int ks = 0; ks < 8; ++ks) { const bf16x8 a = *(const LAS bf16x8*)(A + wave * 128 + r32 * 1032 + ks * 16 + hi * 8); acc = __builtin_amdgcn_mfma_f32_32x32x16_bf16(a, wrt[nt][ks], acc, 0, 0, 0); }
#pragma unroll
            for (int r = 0; r < 16; ++r) PART[(wave * 32 + crow(r, hi)) * 64 + nt * 32 + r32] = acc[r]; }
        __syncthreads();
        for (int i = tid; i < 2048; i += NTHR) { float s = 0.f;
#pragma unroll
            for (int w = 0; w < 8; ++w) s += PART[w * 2048 + i];
            LOG[i] = s; }
        __syncthreads();
        for (int rr = 0; rr < 4; ++rr) { const int r = wave * 4 + rr, t = b0 + r; if (t >= tpb) continue;
            const float sc = sigmoidf_(LOG[r * 64 + lane]); float v = sc + brt[lane]; float ssel = 0.f, mys = 0.f; int myi = 0;
#pragma unroll
            for (int k = 0; k < TOPK; ++k) { const float mx = wave_max(v); const unsigned long long bal = __ballot(v == mx); const int win = __ffsll((long long)bal) - 1;
                const float sw = lane_bcast(sc, win); ssel += sw; if (lane == k) { mys = sw; myi = win; } if (lane == win) v = -INFINITY; }
            if (lane < TOPK) { eidx[(size_t)(tok0 + t) * 6 + lane] = myi; ew[(size_t)(tok0 + t) * 6 + lane] = mys * frcp(ssel) * 2.5f; __hip_atomic_fetch_add(&HIST[myi], 1, __ATOMIC_RELAXED, __HIP_MEMORY_SCOPE_WORKGROUP); } }
    }
    __syncthreads();
    if (tid < 64) ((int*)(F.ws + T_HIST))[F.bx * 64 + tid] = HIST[tid];
}

__device__ __forceinline__ void ph_assign(const Frame& F, int ntok) {
    LAS int* BASE = (LAS int*)F.lds; LAS int* CUR = BASE + 64; LAS int* START = BASE + 128; LAS int* TOT = BASE + 192; LAS int* MISC = BASE + 256;
    const int tid = F.tid, hb = F.G, c = 0, tpb = ntok / F.G, ctok0 = 0, ctoks = ntok;
    const int* hist = (const int*)(F.ws + T_HIST); int* rtok = (int*)(F.ws + T_RTOK); float* rw = (float*)(F.ws + T_RW); int* slot = (int*)(F.ws + T_SLOT);
    int* tile_e = (int*)(F.ws + T_TILEE);
    __syncthreads();
    { LAS int* PT = BASE + 512; LAS int* PB = PT + 512;
      const int e = tid & 63, part = tid >> 6; int tot = 0, bef = 0;
#pragma unroll 8
      for (int k = 0; k < 32; ++k) { const int b = c * hb + part * 32 + k; if (b < (c + 1) * hb) { const int v = hist[b * 64 + e]; tot += v; if (b < F.bx) bef += v; } }
      PT[part * 64 + e] = tot; PB[part * 64 + e] = bef; }
    __syncthreads();
    if (tid < 64) { int tot = 0, bef = 0; for (int p8 = 0; p8 < 8; ++p8) { tot += BASE[512 + p8 * 64 + tid]; bef += BASE[1024 + p8 * 64 + tid]; } TOT[tid] = tot; BASE[tid] = bef; CUR[tid] = 0; }
    __syncthreads();
    if (tid == 0) { int s = 0; for (int e = 0; e < 64; ++e) { START[e] = s; s += (TOT[e] + 255) / 256 * 256; } MISC[0] = s; }
    __syncthreads();
    const int sstart = MISC[0];
    const int* eidx = (const int*)(F.ws + T_EIDX); const float* ew = (const float*)(F.ws + T_EW);
    for (int i = tid; i < tpb * 6; i += NTHR) { const int tok = F.bx * tpb + i / 6, k = i % 6; const int e = eidx[(size_t)tok * 6 + k];
        const int pos = START[e] + BASE[e] + __hip_atomic_fetch_add(&CUR[e], 1, __ATOMIC_RELAXED, __HIP_MEMORY_SCOPE_WORKGROUP); rtok[pos] = tok; rw[pos] = ew[(size_t)tok * 6 + k]; slot[(size_t)tok * 8 + k] = pos; }
    for (int i = tid; i < tpb; i += NTHR) { const int tok = F.bx * tpb + i, pos = sstart + (tok - ctok0); rtok[pos] = tok; rw[pos] = 1.0f; slot[(size_t)tok * 8 + 6] = pos; }
    if (F.bx == c * hb) {
        for (int e = 0; e < 64; ++e) { const int p0 = START[e] + TOT[e], p1 = START[e] + (TOT[e] + 255) / 256 * 256;
            for (int p = p0 + tid; p < p1; p += NTHR) { rtok[p] = ctok0; rw[p] = 0.f; }
            for (int tl = START[e] / 256 + tid; tl < p1 / 256; tl += NTHR) tile_e[tl] = e; }
        for (int tl = sstart / 256 + tid; tl < (sstart + ctoks) / 256; tl += NTHR) tile_e[tl] = 64;
        if (tid == 0) tile_e[2047] = (sstart + ctoks) / 256;
    }
}

template <bool FUSE_NORM> __device__ __forceinline__ void ph_combine(const Frame& F, int l, int c, int ntok) {
    const int lane = F.lane; const int tpb = ntok / F.G, tok0 = F.bx * tpb; (void)c;
    const int* slot = (const int*)(F.ws + T_SLOT); const unsigned char* ys = (const unsigned char*)(F.ws + WS_YS);
    int mr_cur = -1; f32x4 gtv[2][2], av[2][2], shv[2][2];
    for (int t = F.wave; t < tpb; t += NWAVES) { const int tok = tok0 + t, mr = mod_row_of(tok);
        if (mr != mr_cur) { mr_cur = mr; const float* gt = modp(F, l, mr, 5);
#pragma unroll
            for (int j = 0; j < 2; ++j)
#pragma unroll
                for (int h2 = 0; h2 < 2; ++h2) { const int c0 = 8 * lane + 512 * j + 4 * h2; gtv[j][h2] = *(const f32x4*)(gt + c0);
                    if constexpr (FUSE_NORM) { const f32x4 gv = *(const f32x4*)(F.in[I_GMIX] + 1024 + c0), scv = *(const f32x4*)(modp(F, 1, mr, 1) + c0); av[j][h2] = gv * (scv + 1.0f); shv[j][h2] = *(const f32x4*)(modp(F, 1, mr, 0) + c0); } } }
        float* xr = (tok < NLAT) ? F.out + (size_t)tok * 1024 : (float*)(F.ws + WS_CTXS) + (size_t)(tok - NLAT) * 1024;
        const int sv = slot[(size_t)tok * 8 + (lane & 7)];
        u32x2 y[7][2];
#pragma unroll
        for (int k = 0; k < 7; ++k) { const int sk = __builtin_amdgcn_readlane(sv, k); const u32x2* yr = (const u32x2*)(ys + (size_t)sk * 1024) + lane; y[k][0] = yr[0]; y[k][1] = yr[64]; }
        f32x4 xv[2][2];
#pragma unroll
        for (int j = 0; j < 2; ++j) { xv[j][0] = *(const f32x4*)(xr + 8 * lane + 512 * j); xv[j][1] = *(const f32x4*)(xr + 8 * lane + 512 * j + 4); }
#pragma unroll
        for (int j = 0; j < 2; ++j) { f32x4 a0 = {0.f, 0.f, 0.f, 0.f}, a1 = {0.f, 0.f, 0.f, 0.f};
#pragma unroll
            for (int k = 0; k < 7; ++k) { a0 += up4_fp8(y[k][j].x); a1 += up4_fp8(y[k][j].y); }
            xv[j][0] = xv[j][0] + gtv[j][0] * a0; xv[j][1] = xv[j][1] + gtv[j][1] * a1;
            *(f32x4*)(xr + 8 * lane + 512 * j) = xv[j][0]; *(f32x4*)(xr + 8 * lane + 512 * j + 4) = xv[j][1]; }
        if constexpr (FUSE_NORM) {
            float ss = 0.f;
#pragma unroll
            for (int j = 0; j < 2; ++j)
#pragma unroll
                for (int h2 = 0; h2 < 2; ++h2) { const f32x4 v = xv[j][h2]; ss += (v.x * v.x + v.y * v.y) + (v.z * v.z + v.w * v.w); }
            const float rstd = frsq(wave_sum(ss) * (1.f / 1024.f) + EPS);
            bf16_t* hx = (bf16_t*)(F.ws + WS_HX) + (size_t)tok * 1024; unsigned char* h8 = F.ws + WS_HX8 + (size_t)tok * 1024;
#pragma unroll
            for (int j = 0; j < 2; ++j) { const int c0 = 8 * lane + 512 * j; f32x4 y[2];
#pragma unroll
                for (int h2 = 0; h2 < 2; ++h2) y[h2] = xv[j][h2] * rstd * av[j][h2] + shv[j][h2];
                *(u32x4*)(hx + c0) = (u32x4){pk2(y[0].x, y[0].y), pk2(y[0].z, y[0].w), pk2(y[1].x, y[1].y), pk2(y[1].z, y[1].w)};
                *(u32x2*)(h8 + c0) = (u32x2){pk4_fp8(y[0].x, y[0].y, y[0].z, y[0].w), pk4_fp8(y[1].x, y[1].y, y[1].z, y[1].w)}; }
        }
    }
}
__device__ __forceinline__ Frame phase_frame(const Frame& F) {
    Frame Q = F; int t = threadIdx.x; asm volatile("" : "+v"(t)); Q.tid = t; Q.lane = t & 63; Q.wave = __builtin_amdgcn_readfirstlane(t >> 6);
    unsigned long long w = (unsigned long long)F.ws; asm volatile("" : "+s"(w)); Q.ws = (unsigned char*)(GAS unsigned char*)w;
    return Q;
}
constexpr int PH_PER_LAYER = 13, PH_TOTAL = 1 + 2 * PH_PER_LAYER;
__global__ void __launch_bounds__(NTHR, 2) mk_fwd(Params p) {
    extern __shared__ __attribute__((aligned(16))) unsigned char lds_raw[];
    Frame F0;
    F0.lds = (LAS unsigned char*)lds_raw; F0.ws = p.ws; F0.in = p.in; F0.out = p.out;
    F0.tid = threadIdx.x; F0.lane = F0.tid & 63; F0.wave = __builtin_amdgcn_readfirstlane(F0.tid >> 6); F0.bx = blockIdx.x; F0.G = gridDim.x;
    volatile LAS unsigned* MISC = (volatile LAS unsigned*)(F0.lds + MISC_OFF);
    if (F0.tid < 64) MISC[F0.tid] = 0u;
    __syncthreads();
    const int lo = p.ph_lo, hi = p.ph_hi;
    XcdBarrier bar; bar.bar = (unsigned*)(F0.ws + WS_CTL) + CW_BAR; bar.x = 0; bar.st = MISC + 8;
    if (hi - lo > 1) bar = xcd_barrier_post((unsigned*)(F0.ws + WS_CTL) + CW_BAR, MISC + 8);
#ifndef MK_SITE
#define MK_SITE -1
#endif
#define SITE(n) (MK_SITE < 0 || MK_SITE == (n))
#ifndef MK_REP_MASK
#define MK_REP_MASK 0
#endif
#define NREP(n) (((MK_REP_MASK >> (n)) & 1) ? 2 : 1)
#define RUN(k) (lo <= (k) && (k) < hi)
#define SEAM(k) do { if (RUN(k) && RUN((k) + 1)) { TSEC_BEGIN(300, F0.lds); xcd_barrier(bar); TSEC_END(300, F0.lds); } } while (0)
    int ph = 0;
    if (SITE(0) && RUN(ph)) TSEC_BEGIN(400 + 0, F0.lds); if (SITE(0) && RUN(ph)) for (int rep_ = 0; rep_ < NREP(0); ++rep_) { const Frame F = phase_frame(F0); ph_pre(F); }
    TSEC_END(400 + 99, F0.lds); SEAM(ph); ++ph;
    for (int l = 0; l < 2; ++l) {
        const int ntok = (l == 0) ? NTOK : NLAT, nM = ntok / 256;
        if (SITE(1) && RUN(ph)) TSEC_BEGIN(400 + 1, F0.lds); if (SITE(1) && RUN(ph)) for (int rep_ = 0; rep_ < NREP(1); ++rep_) { const Frame F = phase_frame(F0); ph_convert(F, l); __syncthreads(); if (l == 0) ph_norm1(F, l); }
        TSEC_END(400 + 99, F0.lds); SEAM(ph); ++ph;
        if (SITE(2) && RUN(ph)) TSEC_BEGIN(400 + 2, F0.lds); if (SITE(2) && RUN(ph)) for (int rep_ = 0; rep_ < NREP(2); ++rep_) { const Frame F = phase_frame(F0);
            SchedPlain S{(const char*)(F.ws + WS_HX8), (const char*)(F.ws + W_IN), 1024u, 1024u, 8, NTOK / 256, INCP / 256, F.G, F.bx};
            EpiWin E{(bf16_t*)(F.ws + WS_PX), (float*)(F.ws + T_GATE)};
            gg::gemm_phase(F.lds, S, E);
        }
        TSEC_END(400 + 99, F0.lds); SEAM(ph); ++ph;
        if (SITE(3) && RUN(ph)) TSEC_BEGIN(400 + 3, F0.lds); if (SITE(3) && RUN(ph)) for (int rep_ = 0; rep_ < NREP(3); ++rep_) { const Frame F = phase_frame(F0);
            for (int r2 = 0; r2 < NREP(16); ++r2) mla_prep(F, l);
            for (int r2 = 0; r2 < NREP(17); ++r2) { P1Regs R = ml_pass1_load(F, F.bx);
                for (int u = F.bx; u < 64 * NCHK; u += F.G) { const P1Regs Rn = ml_pass1_load(F, (u + F.G < 64 * NCHK) ? u + F.G : u); ml_pass1_unit(F, l, u, R); R = Rn; } }
            for (int r2 = 0; r2 < NREP(18); ++r2) { PoolRegs R = pool_load(F, F.bx);
                for (int u = F.bx; u < ntok / 64; u += F.G) { const PoolRegs Rn = pool_load(F, (u + F.G < ntok / 64) ? u + F.G : u); pool_unit(F, l, u, R); R = Rn; } }
            for (int r2 = 0; r2 < NREP(19); ++r2) conv_all(F, l, ntok);
            __syncthreads();
        }
        TSEC_END(400 + 99, F0.lds); SEAM(ph); ++ph;
        if (SITE(4) && RUN(ph)) TSEC_BEGIN(400 + 4, F0.lds); if (SITE(4) && RUN(ph)) for (int rep_ = 0; rep_ < NREP(4); ++rep_) { const Frame F = phase_frame(F0);
            ml_pass2(F);
            float gq = 0.f, gk = 0.f; for (int d = 0; d < 96; ++d) { gq = fmaxf(gq, fabsf(F.in[I_GQN][l * 96 + d])); gk = fmaxf(gk, fabsf(F.in[I_GKN][l * 96 + d])); }
            const bool nomax = (14.2f * gq * gk <= 64.0f);
            const int nunits = 1024 + (l == 0 ? 32 : 0);
#define ATT_UNITS(NM) for (int i = 0; ; ++i) { const int L = i * F.G + F.bx; if (L >= nunits) break; \
                if (L < 1024) { const int bh = (L >> 8) * 8 + (L & 7), qb = (L & 255) >> 3, b = bh >> 2; att2::unit<NM>(F, bh, b * 8192 + qb * 256, b * 8192 + qb * 256, 132); } \
                else { const int bh = L - 1024, b = bh >> 2; att2::unit<NM>(F, bh, NLAT + b * 256, NLAT + b * 256, 4); } }
            if (nomax) { ATT_UNITS(true) } else { ATT_UNITS(false) }
#undef ATT_UNITS
        }
        TSEC_END(400 + 99, F0.lds); SEAM(ph); ++ph;
        if (SITE(5) && RUN(ph)) TSEC_BEGIN(400 + 5, F0.lds); if (SITE(5) && RUN(ph)) for (int rep_ = 0; rep_ < NREP(5); ++rep_) { const Frame F = phase_frame(F0);
            const int npc = (l == 0) ? 66 : 64, nun = 32 * npc;
            for (int u = F.bx; u < nun; u += F.G) { const int bh = u / npc, pc = u % npc + (l == 0 ? 0 : 2); ml_pass3_unit(F, l, bh >> 2, bh & 3, pc); }
            __syncthreads();
        }
        TSEC_END(400 + 99, F0.lds); SEAM(ph); ++ph;
        {
            const int nMh = nM, pm0 = 0;
            if (SITE(6) && RUN(ph)) TSEC_BEGIN(400 + 6, F0.lds); if (SITE(6) && RUN(ph)) for (int rep_ = 0; rep_ < NREP(6); ++rep_) { const Frame F = phase_frame(F0);
                SchedYB S{(const char*)(F.ws + WS_YC), (const char*)(F.ws + W_BR), pm0, nMh, F.G, F.bx};
                EpiF8Out E{F.ws + WS_YB, 4096};
                gg::gemm_phase(F.lds, S, E);
            }
            TSEC_END(400 + 99, F0.lds); SEAM(ph); ++ph;
            if (SITE(13) && RUN(ph)) TSEC_BEGIN(400 + 13, F0.lds); if (SITE(13) && RUN(ph)) for (int rep_ = 0; rep_ < NREP(13); ++rep_) { const Frame F = phase_frame(F0);
                SchedPlain S{(const char*)(F.ws + WS_HX8) + (size_t)pm0 * 256 * 1024, (const char*)(F.ws + W_GATE), 1024u, 1024u, 8, nMh, 16, F.G, F.bx};
                EpiMerge2 E{(const unsigned char*)(F.ws + WS_YB), F.in[I_BGATE] + l * 4096, F.ws + WS_ACCM + (size_t)pm0 * 256 * 1024, 0};
                gg::gemm_phase(F.lds, S, E);
            }
            TSEC_END(400 + 99, F0.lds); SEAM(ph); ++ph;
        }
        if (SITE(7) && RUN(ph)) TSEC_BEGIN(400 + 7, F0.lds); if (SITE(7) && RUN(ph)) for (int rep_ = 0; rep_ < NREP(7); ++rep_) { const Frame F = phase_frame(F0);
            SchedPlain S{(const char*)(F.ws + WS_ACCM), (const char*)(F.ws + W_OUT), 1024u, 1024u, 8, nM, 4, F.G, F.bx};
            EpiWout E{(bf16_t*)(F.ws + WS_YC), modp(F, l, 0, 2)};
            gg::gemm_phase(F.lds, S, E);
        }
        TSEC_END(400 + 99, F0.lds); SEAM(ph); ++ph;
        if (SITE(8) && RUN(ph)) TSEC_BEGIN(400 + 8, F0.lds); if (SITE(8) && RUN(ph)) for (int rep_ = 0; rep_ < NREP(8); ++rep_) { const Frame F = phase_frame(F0); ph_norm2_route(F, l, ntok); }
        TSEC_END(400 + 99, F0.lds); SEAM(ph); ++ph;
        if (SITE(9) && RUN(ph)) TSEC_BEGIN(400 + 9, F0.lds); if (SITE(9) && RUN(ph)) for (int rep_ = 0; rep_ < NREP(9); ++rep_) { const Frame F = phase_frame(F0); ph_assign(F, ntok); }
        TSEC_END(400 + 99, F0.lds); SEAM(ph); ++ph;
        if (SITE(10) && RUN(ph)) TSEC_BEGIN(400 + 10, F0.lds); if (SITE(10) && RUN(ph)) for (int rep_ = 0; rep_ < NREP(10); ++rep_) { const Frame F = phase_frame(F0);
            int* tile_e = (int*)(F.ws + T_TILEE); const int ntiles = ld_i32_uniform(tile_e + 2047);
            LAS int* tab = (LAS int*)(F.lds + MOE_TAB_OFF); const int* rtok = (const int*)(F.ws + T_RTOK);
            __syncthreads();
            for (int i = 0; i < 28; ++i) { const int L = i * F.G + F.bx; if (L >= ntiles * 2) break; const int tile = L >> 1;
                if (F.tid == 0) tab[i] = tile_e[tile]; if (F.tid < 256) tab[256 + i * 256 + F.tid] = rtok[tile * 256 + F.tid]; }
            __syncthreads();
            SchedMoe1 S{(const char*)(F.ws + WS_HX8), (const char*)(F.ws + W_13), tab, ntiles, F.G, F.bx};
            EpiMoe1 E{F.ws + WS_AMOE, (const float*)(F.ws + T_RW)};
            gg::gemm_phase(F.lds, S, E);
        }
        TSEC_END(400 + 99, F0.lds); SEAM(ph); ++ph;
        if (SITE(11) && RUN(ph)) TSEC_BEGIN(400 + 11, F0.lds); if (SITE(11) && RUN(ph)) for (int rep_ = 0; rep_ < NREP(11); ++rep_) { const Frame F = phase_frame(F0);
            int* tile_e = (int*)(F.ws + T_TILEE); const int ntiles = ld_i32_uniform(tile_e + 2047);
            LAS int* tab = (LAS int*)(F.lds + MOE_TAB_OFF);
            __syncthreads();
            for (int i = F.tid; i < 64; i += NTHR) { const int L = i * F.G + F.bx; if (L < ntiles * 4) tab[i] = tile_e[L >> 2]; }
            __syncthreads();
            SchedMoe2 S{(const char*)(F.ws + WS_AMOE), (const char*)(F.ws + W_2), tab, ntiles, F.G, F.bx};
            EpiF8OutQ E{(unsigned char*)(F.ws + WS_YS), 1024};
            gg::gemm_phase(F.lds, S, E);
        }
        TSEC_END(400 + 99, F0.lds); SEAM(ph); ++ph;
        if (SITE(12) && RUN(ph)) TSEC_BEGIN(400 + 12, F0.lds); if (SITE(12) && RUN(ph)) for (int rep_ = 0; rep_ < NREP(12); ++rep_) { const Frame F = phase_frame(F0); if (l == 0) ph_combine<true>(F, l, 0, ntok); else ph_combine<false>(F, l, 0, ntok); }
        TSEC_END(400 + 99, F0.lds); SEAM(ph); ++ph;
    }
    if (MK_TSEC >= 0 && blockIdx.x == 0 && threadIdx.x == 0) { volatile LAS unsigned long long* q_ = (volatile LAS unsigned long long*)(F0.lds + MISC_OFF + 128);
        const unsigned long long t0 = __builtin_amdgcn_s_memrealtime(), d = q_[0] * 4ull; while (__builtin_amdgcn_s_memrealtime() - t0 < d) __builtin_amdgcn_s_sleep(8); }
#undef RUN
#undef SEAM
}

extern "C" void kernel_launch(void* const* d_in, const int* in_sizes, int n_in, void* d_out, int out_size, void* d_ws, size_t ws_size, hipStream_t stream) {
    static int grid = 0;
    if (grid == 0) {
        if (n_in != 33 || out_size != NLAT * DM || ws_size < WS_END) { fprintf(stderr, "kernel_launch: unexpected shapes (n_in %d, out %d, ws %zu < %zu)\n", n_in, out_size, ws_size, (size_t)WS_END); grid = -1; return; }
        int dev = 0, cus = 0;
        if (hipGetDevice(&dev) != hipSuccess || hipDeviceGetAttribute(&cus, hipDeviceAttributeMultiprocessorCount, dev) != hipSuccess) { grid = -1; return; }
        if (hipFuncSetAttribute((const void*)mk_fwd, hipFuncAttributeMaxDynamicSharedMemorySize, LDS_BYTES) != hipSuccess) { fprintf(stderr, "kernel_launch: hipFuncSetAttribute failed\n"); grid = -1; return; }
        int per_cu = 0;
        if (hipOccupancyMaxActiveBlocksPerMultiprocessor(&per_cu, (const void*)mk_fwd, NTHR, LDS_BYTES) != hipSuccess || per_cu < 1) fprintf(stderr, "kernel_launch: occupancy query says %d\n", per_cu);
        (void)hipGetLastError();
        if (cus < 256) { fprintf(stderr, "kernel_launch: built for a 256-CU device (got %d CUs)\n", cus); grid = -1; return; }
        grid = 256;
    }
    if (grid < 0) return;
    (void)hipMemsetAsync((char*)d_ws + WS_CTL, 0, CTL_ZERO_BYTES, stream);
    Params p{};
    for (int i = 0; i < 33; ++i) p.in[i] = (const float*)d_in[i];
    p.out = (float*)d_out; p.ws = (unsigned char*)d_ws;
#if MK_ONE_LAUNCH
    p.ph_lo = 0; p.ph_hi = PH_TOTAL;
    hipLaunchKernelGGL(mk_fwd, dim3(grid), dim3(NTHR), LDS_BYTES, stream, p);
#else
    for (int k = 0; k < PH_TOTAL; ++k) { p.ph_lo = k; p.ph_hi = k + 1; hipLaunchKernelGGL(mk_fwd, dim3(grid), dim3(NTHR), LDS_BYTES, stream, p); }
#endif
}
```

```cpp
#include <hip/hip_runtime.h>
#include <stdint.h>
#include <stdio.h>
#include <math.h>

#ifndef MK_ONE_LAUNCH
#define MK_ONE_LAUNCH 1
#endif

#define LAS __attribute__((address_space(3)))
#define GAS __attribute__((address_space(1)))
typedef unsigned short bf16_t;
typedef short bf16x8 __attribute__((ext_vector_type(8)));
typedef short s16x4 __attribute__((ext_vector_type(4)));
typedef float f32x2 __attribute__((ext_vector_type(2)));
typedef float f32x4 __attribute__((ext_vector_type(4)));
typedef float f32x16 __attribute__((ext_vector_type(16)));
typedef unsigned u32x2 __attribute__((ext_vector_type(2)));
typedef unsigned u32x4 __attribute__((ext_vector_type(4)));

constexpr int DM = 1024, NB = 8, SEQ = 8192, CTXL = 256, GRIDW = 64;
constexpr int NLAT = NB * SEQ, NCTX = NB * CTXL, NTOK = NLAT + NCTX;
constexpr int INC = 2480, INCP = 2560;
constexpr int C_ML = 0, C_G = 1024, C_MLA = 1040, C_POOL = 1456, C_CONV = 1712;
constexpr int NE = 64, NE1 = 65, TOPK = 6, NSLOT7 = 7, EFF = 256;
constexpr int NCHK = 66;
constexpr int NKT = 132;
constexpr float EPS = 1e-6f;
constexpr int NWAVES = 8, NTHR = 512;
constexpr int MOE_ROWS_MAX = 489472;
constexpr int MOE_TILES_MAX = MOE_ROWS_MAX / 256;

constexpr size_t MiB = 1u << 20;
constexpr size_t WS_CTL = 0, CTL_ZERO_BYTES = 1 * MiB;
constexpr size_t WS_MOD = 128 * 1024;
constexpr size_t WS_TAB = 1 * MiB;
constexpr size_t T_ROPE = WS_TAB;
constexpr size_t T_HIST = T_ROPE + 16384;
constexpr size_t T_TILEE = T_HIST + 65536;
constexpr size_t T_EIDX = T_TILEE + 8192;
constexpr size_t T_EW = T_EIDX + (size_t)NTOK * 6 * 4;
constexpr size_t T_SLOT = T_EW + (size_t)NTOK * 6 * 4;
constexpr size_t T_RTOK = T_SLOT + (size_t)NTOK * 8 * 4;
constexpr size_t T_RW = T_RTOK + (size_t)MOE_ROWS_MAX * 4;
constexpr size_t T_GATE = T_RW + (size_t)MOE_ROWS_MAX * 4;
constexpr size_t T_DN = T_GATE + (size_t)NTOK * 16 * 4;
constexpr size_t T_NST = T_DN + (size_t)4224 * 64 * 4;
constexpr size_t T_MLOC = T_NST + (size_t)4224 * 64 * 4;
constexpr size_t T_BEND = T_MLOC + 4224 * 4;
constexpr size_t T_MST = T_BEND + 4224 * 4;
constexpr size_t T_END = T_MST + 4224 * 4;
static_assert(T_END <= 17 * MiB, "tables");
constexpr size_t WS_WB = 17 * MiB;
constexpr size_t W_IN = WS_WB;
constexpr size_t W_GATE = W_IN + (size_t)INCP * 1024 * 2;
constexpr size_t W_BR = W_GATE + (size_t)4 * 1024 * 1024 * 2;
constexpr size_t W_OUT = W_BR + (size_t)4 * 1024 * 256 * 2;
constexpr size_t W_13 = W_OUT + (size_t)1024 * 1024 * 2;
constexpr size_t W_2 = W_13 + (size_t)NE1 * 512 * 1024 * 2;
constexpr size_t W_UQ = W_2 + (size_t)NE1 * 1024 * 256 * 2;
constexpr size_t W_UKV = W_UQ + (size_t)384 * 256 * 2;
constexpr size_t W_POOL = W_UKV + (size_t)512 * 128 * 2;
constexpr size_t W_RT = W_POOL + (size_t)4 * 64 * 64 * 2;
constexpr size_t W_END = W_RT + (size_t)64 * 1024 * 2;
static_assert(W_END <= 133 * MiB, "weights");
constexpr size_t WS_CTXS = 133 * MiB;
constexpr size_t WS_HX = 141 * MiB;
constexpr size_t WS_PX = 273 * MiB;
constexpr size_t WS_QB = 593 * MiB;
constexpr size_t WS_KT = 643 * MiB;
constexpr size_t WS_VT = 693 * MiB;
constexpr size_t WS_YC = 726 * MiB;
constexpr size_t WS_DC = 858 * MiB;
constexpr size_t WS_CST = 924 * MiB;
constexpr size_t WS_HX8 = 957 * MiB;
constexpr size_t WS_END = 1023 * MiB;
constexpr size_t WS_ACCM = WS_QB;
constexpr size_t WS_YB = WS_PX;
constexpr size_t WS_AMOE = WS_HX;
constexpr size_t WS_YS = WS_HX + 240 * MiB;
static_assert(WS_AMOE + (size_t)MOE_ROWS_MAX * 512 <= WS_YS && WS_YS + (size_t)MOE_ROWS_MAX * 1024 <= WS_HX8, "moe overlay");
static_assert(WS_YB + (size_t)NTOK * 4096 <= WS_QB && WS_ACCM + (size_t)NTOK * 2048 <= WS_YC, "merge overlay");

constexpr int CW_BAR = 4096;

constexpr int RING_BYTES = 131072;
constexpr int MISC_OFF = 160 * 1024 - 256;
constexpr int LDS_BYTES = 160 * 1024;

#ifndef MK_TSEC
#define MK_TSEC -1
#endif
#define TSEC_BEGIN(id, ldsb) do { if (MK_TSEC == (id) && blockIdx.x == 0 && threadIdx.x == 0) { volatile LAS unsigned long long* q_ = (volatile LAS unsigned long long*)((ldsb) + MISC_OFF + 128); q_[1] = __builtin_amdgcn_s_memrealtime(); } } while (0)
#define TSEC_END(id, ldsb) do { if ((MK_TSEC == (id) || ((id) == 499 && MK_TSEC >= 400 && MK_TSEC < 499)) && blockIdx.x == 0 && threadIdx.x == 0) { volatile LAS unsigned long long* q_ = (volatile LAS unsigned long long*)((ldsb) + MISC_OFF + 128); if (q_[1] != 0ull) { q_[0] += __builtin_amdgcn_s_memrealtime() - q_[1]; q_[1] = 0ull; } } } while (0)
typedef __bf16 bf16x2_t_ __attribute__((ext_vector_type(2)));
__device__ __forceinline__ unsigned pk2(float lo, float hi) { const f32x2 v = {lo, hi}; return __builtin_bit_cast(unsigned, __builtin_convertvector(v, bf16x2_t_)); }
__device__ __forceinline__ unsigned f2bf(float f) { return pk2(f, f) & 0xffffu; }
__device__ __forceinline__ float bf2f(unsigned short b) { return __builtin_bit_cast(float, ((unsigned)b) << 16); }
__device__ __forceinline__ float bflo(unsigned w) { return __builtin_bit_cast(float, w << 16); }
__device__ __forceinline__ float bfhi(unsigned w) { return __builtin_bit_cast(float, w & 0xffff0000u); }
__device__ __forceinline__ unsigned cvt_pk_bf16(float lo, float hi) { unsigned r; asm volatile("v_cvt_pk_bf16_f32 %0, %1, %2" : "=v"(r) : "v"(lo), "v"(hi)); return r; }
__device__ __forceinline__ unsigned pk4_fp8(float a, float b, float c, float d) { int r = __builtin_amdgcn_cvt_pk_fp8_f32(a, b, 0, false); r = __builtin_amdgcn_cvt_pk_fp8_f32(c, d, r, true); return (unsigned)r; }
__device__ __forceinline__ float sigmoidf_(float x) { return __builtin_amdgcn_rcpf(1.0f + __builtin_amdgcn_exp2f(x * -1.4426950408889634f)); }
template <int O> __device__ __forceinline__ float xor_lane(float v) { return __builtin_bit_cast(float, __builtin_amdgcn_ds_swizzle(__builtin_bit_cast(int, v), 0x1f | (O << 10))); }
__device__ __forceinline__ float half_sum(float v) { v += xor_lane<1>(v); v += xor_lane<2>(v); v += xor_lane<4>(v); v += xor_lane<8>(v); v += xor_lane<16>(v); return v; }
__device__ __forceinline__ float half_max(float v) { v = fmaxf(v, xor_lane<1>(v)); v = fmaxf(v, xor_lane<2>(v)); v = fmaxf(v, xor_lane<4>(v)); v = fmaxf(v, xor_lane<8>(v)); v = fmaxf(v, xor_lane<16>(v)); return v; }
__device__ __forceinline__ float wave_sum(float v) { v = half_sum(v); auto rr = __builtin_amdgcn_permlane32_swap(__builtin_bit_cast(unsigned, v), __builtin_bit_cast(unsigned, v), false, false);
    return __builtin_bit_cast(float, (unsigned)rr[0]) + __builtin_bit_cast(float, (unsigned)rr[1]); }
__device__ __forceinline__ float wave_max(float v) { v = half_max(v); auto rr = __builtin_amdgcn_permlane32_swap(__builtin_bit_cast(unsigned, v), __builtin_bit_cast(unsigned, v), false, false);
    return fmaxf(__builtin_bit_cast(float, (unsigned)rr[0]), __builtin_bit_cast(float, (unsigned)rr[1])); }
__device__ __forceinline__ float lane_up(float v, int o, int lane) { return __builtin_bit_cast(float, __builtin_amdgcn_ds_bpermute(((lane - o) & 63) << 2, __builtin_bit_cast(int, v))); }
__device__ __forceinline__ float lane_bcast(float v, int src) { return __builtin_bit_cast(float, __builtin_amdgcn_readlane(__builtin_bit_cast(int, v), src)); }
__device__ __forceinline__ float frcp(float x) { return __builtin_amdgcn_rcpf(x); }
__device__ __forceinline__ float frsq(float x) { return __builtin_amdgcn_rsqf(x); }
#define LDS_WAIT() asm volatile("s_waitcnt lgkmcnt(0)" ::: "memory")
#define LDS_BAR() asm volatile("s_waitcnt lgkmcnt(0)\n\ts_barrier" ::: "memory")
#define VM_WAIT() asm volatile("s_waitcnt vmcnt(0)" ::: "memory")

#define XB_TMO      128
#define XB_XCNT(j)  (256  + 64 * (j))
#define XB_XSUB(j)  (1280 + 64 * (j))
#define XB_XGEN(j)  (2304 + 64 * (j))
#define XB_TOP      3328
#define XB_TOPGEN   3392
#define XCD_BAR_WORDS 3456
#define XB_SPIN_CAP (1u << 22)

__device__ __forceinline__ unsigned xb_ld(unsigned* p)              { return __hip_atomic_load(p, __ATOMIC_RELAXED, __HIP_MEMORY_SCOPE_AGENT); }
__device__ __forceinline__ unsigned xb_add(unsigned* p, unsigned v) { return __hip_atomic_fetch_add(p, v, __ATOMIC_RELAXED, __HIP_MEMORY_SCOPE_AGENT); }
__device__ __forceinline__ unsigned xb_xcc_id() { return (unsigned)__builtin_amdgcn_s_getreg((3 << 11) | 20) & 0xFu; }
#define XB_SPIN(cond, bar) do { unsigned _sp = 0; while (cond) { __builtin_amdgcn_s_sleep(1); \
    if ((++_sp & 255u) == 0u) { if (xb_ld(&(bar)[XB_TMO])) break; if (_sp > XB_SPIN_CAP) { atomicAdd(&(bar)[XB_TMO], 1u); break; } } } } while (0)

struct XcdBarrier { unsigned* bar; unsigned x; volatile LAS unsigned* st; };

__device__ __forceinline__ XcdBarrier xcd_barrier_post(unsigned* bar, volatile LAS unsigned* st) {
    XcdBarrier b; b.bar = bar; b.x = xb_xcc_id(); b.st = st;
    if (threadIdx.x == 0) (void)xb_add(&bar[XB_XCNT(b.x)], 1u);
    return b;
}
__device__ __forceinline__ void xcd_barrier_complete(unsigned* bar, unsigned x, unsigned& nloc, unsigned& nx) {
    const unsigned G = gridDim.x * gridDim.y * gridDim.z;
    unsigned sum, cnt, mine, sp = 0u;
    for (;;) {
        sum = 0u; cnt = 0u; mine = 0u;
#pragma unroll
        for (unsigned j = 0; j < 16; ++j) { const unsigned c = xb_ld(&bar[XB_XCNT(j)]); sum += c; cnt += (c > 0u) ? 1u : 0u; mine = (j == x) ? c : mine; }
        if (sum == G) break;
        __builtin_amdgcn_s_sleep(1);
        if ((++sp & 255u) == 0u) { if (xb_ld(&bar[XB_TMO])) break; if (sp > XB_SPIN_CAP) { atomicAdd(&bar[XB_TMO], 1u); break; } }
    }
    nloc = mine > 0u ? mine : 1u; nx = cnt > 0u ? cnt : 1u;
}
__device__ __forceinline__ void xcd_barrier(const XcdBarrier& b) {
    asm volatile("s_waitcnt vmcnt(0)" ::: "memory");
    __syncthreads();
    if (threadIdx.x == 0) {
        unsigned* bar = b.bar;
        __builtin_amdgcn_s_waitcnt(0);
        unsigned nloc = b.st[0], nx = b.st[1];
        if (nloc == 0u) { xcd_barrier_complete(bar, b.x, nloc, nx); b.st[0] = nloc; b.st[1] = nx; }
        const unsigned old = xb_add(&bar[XB_XSUB(b.x)], 1u);
        const unsigned gen = old / nloc;
        if (old + 1u == (gen + 1u) * nloc) {
            __builtin_amdgcn_fence(__ATOMIC_RELEASE, "agent");
            asm volatile("s_waitcnt vmcnt(0)" ::: "memory");
            const unsigned og = xb_add(&bar[XB_TOP], 1u);
            const unsigned tg = og / nx;
            if (og + 1u == (tg + 1u) * nx) xb_add(&bar[XB_TOPGEN], 1u);
            else XB_SPIN(xb_ld(&bar[XB_TOPGEN]) == tg, bar);
            __builtin_amdgcn_fence(__ATOMIC_ACQUIRE, "agent");
            xb_add(&bar[XB_XGEN(b.x)], 1u);
            asm volatile("s_waitcnt vmcnt(0)" ::: "memory");
        } else {
            XB_SPIN(xb_ld(&bar[XB_XGEN(b.x)]) == gen, bar);
            __builtin_amdgcn_fence(__ATOMIC_ACQUIRE, "agent");
            asm volatile("s_waitcnt vmcnt(0)" ::: "memory");
        }
    }
    __syncthreads();
}

struct Params { const float* in[33]; float* out; unsigned char* ws; int ph_lo, ph_hi; };

struct Frame {
    LAS unsigned char* lds;
    unsigned char* ws;
    const float* const* in;
    float* out;
    int tid, lane, wave, bx, G;
};
enum { I_X = 0, I_C, I_CTX, I_CCTX, I_WMOD, I_BMOD, I_GMIX, I_GFFN, I_WIN, I_MLGB, I_MLHG, I_GCQ, I_GCKV, I_WUQ, I_WUKV, I_GQN, I_GKN, I_POOLW, I_POOLS,
       I_CONVW, I_CONVB, I_WGATE, I_BGATE, I_WBR, I_WOUT, I_WRT, I_BRT, I_W1, I_W3, I_W2, I_WS1, I_WS3, I_WS2 };

__device__ __forceinline__ const float* modp(const Frame& F, int l, int r, int which) { return (const float*)(F.ws + WS_MOD) + ((size_t)(l * 9 + r)) * 6144 + which * 1024; }
__device__ __forceinline__ int mod_row_of(int row) { return row < NLAT ? (row >> 13) : 8; }

__device__ __forceinline__ f32x4 up4_fp8(unsigned w) { const f32x2 lo = __builtin_amdgcn_cvt_pk_f32_fp8((int)w, false), hi = __builtin_amdgcn_cvt_pk_f32_fp8((int)w, true); return (f32x4){lo.x, lo.y, hi.x, hi.y}; }
namespace gg {
typedef int v4i_t __attribute__((ext_vector_type(4)));
constexpr int BM = 256, BK = 64, HALF = 128, HTB = HALF * BK * 2, STAGE_BYTES = 8 * HTB;
__device__ __forceinline__ int lds_byte(int r, int c) { const int st = (r >> 4) * 2 + (c >> 5), rr = r & 15, cc = c & 31, ob = rr * 64 + cc * 2; return st * 1024 + (ob ^ (((ob >> 9) & 1) << 5)); }
__device__ __forceinline__ void stage_rc(int b, int& R, int& C) { const int st = b / 1024, sb = b % 1024, swz = sb ^ (((sb >> 9) & 1) << 5); R = (st >> 1) * 16 + swz / 64; C = (st & 1) * 32 + (swz % 64) / 2; }
__device__ __forceinline__ int perm32(int rho) { const int n = rho >> 4, i = rho & 15; return 8 * (i >> 2) + 4 * n + (i & 3); }

struct Unit {
    const char* A; const char* B;
    unsigned lda, ldb;
    int nt;
    int ridx_off;
    int p0, p1, p2;
};

template <class E, class = void> struct ZPeel { static constexpr bool v = false; };
template <class E> struct ZPeel<E, decltype((void)E::ZPEEL)> { static constexpr bool v = E::ZPEEL; };
template <class Epi, class Sched>
__device__ __forceinline__ void gemm_phase(LAS unsigned char* lds, const Sched& S, const Epi& E) {
    int tid_ = threadIdx.x; asm volatile("" : "+v"(tid_));
    const int tid = tid_, wid = __builtin_amdgcn_readfirstlane(tid >> 6), lane = tid & 63, wr = wid >> 2, wc = wid & 3, fr = lane & 15, fq = lane >> 4;
    const size_t kstep = (size_t)(BK * 2);
    const unsigned ldsw = (unsigned)wid * 1024u;
    const int aoff = lds_byte(wr * 64 + fr, fq * 8), boff = lds_byte(wc * 32 + fr, fq * 8);
#define GG_SA(b, h) (((b) * 2 + (h)) * HTB)
#define GG_SB(b, h) ((4 + (b) * 2 + (h)) * HTB)
#define GG_STAGE(bufoff, gbase, v0, v1) do { \
        __builtin_amdgcn_global_load_lds((const unsigned*)((const char*)(gbase) + (v0)), (LAS unsigned*)(lds + (bufoff) + ldsw), 16, 0, 0); \
        __builtin_amdgcn_global_load_lds((const unsigned*)((const char*)(gbase) + (v1)), (LAS unsigned*)(lds + (bufoff) + ldsw + 8192), 16, 0, 0); } while (0)
#define GG_LDA(dst, b, h) do { _Pragma("unroll") for (int m = 0; m < 4; ++m) _Pragma("unroll") for (int k = 0; k < 2; ++k) dst[m][k] = *(const LAS bf16x8*)(lds + GG_SA(b, h) + aoff + m * 2048 + k * 1024); } while (0)
#define GG_LDB(dst, b, h) do { _Pragma("unroll") for (int n = 0; n < 2; ++n) _Pragma("unroll") for (int k = 0; k < 2; ++k) dst[n][k] = *(const LAS bf16x8*)(lds + GG_SB(b, h) + boff + n * 2048 + k * 1024); } while (0)
#define GG_MMA(ai, bj, At, Bt) do { __builtin_amdgcn_s_setprio(1); _Pragma("unroll") for (int m = 0; m < 4; ++m) _Pragma("unroll") for (int n = 0; n < 2; ++n) _Pragma("unroll") for (int k = 0; k < 2; ++k) \
        acc[ai][bj][m][n] = __builtin_amdgcn_mfma_f32_16x16x32_bf16(Bt[n][k], At[m][k], acc[ai][bj][m][n], 0, 0, 0); __builtin_amdgcn_s_setprio(0); } while (0)
#define GG_CAT8(x, y) __builtin_shufflevector(__builtin_bit_cast(v4i_t, x), __builtin_bit_cast(v4i_t, y), 0, 1, 2, 3, 4, 5, 6, 7)
#define GG_MMA8(ai, bj, At, Bt) do { __builtin_amdgcn_s_setprio(1); _Pragma("unroll") for (int m = 0; m < 4; ++m) _Pragma("unroll") for (int n = 0; n < 2; ++n) \
        acc[ai][bj][m][n] = __builtin_amdgcn_mfma_scale_f32_16x16x128_f8f6f4(GG_CAT8(Bt[n][0], Bt[n][1]), GG_CAT8(At[m][0], At[m][1]), acc[ai][bj][m][n], 0, 0, 0, (int)Epi::SCB, 0, 0x7f7f7f7f); __builtin_amdgcn_s_setprio(0); } while (0)
#define GG_MM(ai, bj, At, Bt) do { if constexpr (Epi::FP8) GG_MMA8(ai, bj, At, Bt); else GG_MMA(ai, bj, At, Bt); } while (0)
#define GG_MMZ8(ai, bj, At, Bt) do { __builtin_amdgcn_s_setprio(1); _Pragma("unroll") for (int m = 0; m < 4; ++m) _Pragma("unroll") for (int n = 0; n < 2; ++n) \
        acc[ai][bj][m][n] = __builtin_amdgcn_mfma_scale_f32_16x16x128_f8f6f4(GG_CAT8(Bt[n][0], Bt[n][1]), GG_CAT8(At[m][0], At[m][1]), (f32x4){0.f, 0.f, 0.f, 0.f}, 0, 0, 0, (int)Epi::SCB, 0, 0x7f7f7f7f); __builtin_amdgcn_s_setprio(0); } while (0)
#define GG_MM1(ai, bj, At, Bt) do { if constexpr (ZP && Epi::FP8) { if (t == 0) GG_MMZ8(ai, bj, At, Bt); else GG_MMA8(ai, bj, At, Bt); } else GG_MM(ai, bj, At, Bt); } while (0)
#define GG_WAIT_V(n) asm volatile("s_waitcnt vmcnt(" #n ")" ::: "memory")
#define GG_WAIT_L(n) asm volatile("s_waitcnt lgkmcnt(" #n ")" ::: "memory")
#define GG_BAR __builtin_amdgcn_s_barrier()
#define GG_SCHED __builtin_amdgcn_sched_barrier(0)
#define GG_OFFS(u) do { int R0_, C0_, R1_, C1_; stage_rc(tid * 16, R0_, C0_); stage_rc(tid * 16 + 8192, R1_, C1_); \
        if (Sched::GATHER) { const LAS int* rl_ = (const LAS int*)(lds + (u).ridx_off); vA0 = (unsigned)rl_[R0_] * (u).lda + C0_ * 2; vA1 = (unsigned)rl_[R1_] * (u).lda + C1_ * 2; \
                             vA2 = (unsigned)rl_[128 + R0_] * (u).lda + C0_ * 2; vA3 = (unsigned)rl_[128 + R1_] * (u).lda + C1_ * 2; hA = 0; } \
        else { vA0 = (unsigned)R0_ * (u).lda + C0_ * 2; vA1 = (unsigned)R1_ * (u).lda + C1_ * 2; vA2 = vA0; vA3 = vA1; hA = (size_t)128 * (u).lda; } \
        const int Rb0_ = Epi::PERM ? ((R0_ & ~31) + perm32(R0_ & 31)) : R0_, Rb1_ = Epi::PERM ? ((R1_ & ~31) + perm32(R1_ & 31)) : R1_; \
        vB0 = (unsigned)Rb0_ * (u).ldb + C0_ * 2; vB1 = (unsigned)Rb1_ * (u).ldb + C1_ * 2; hB = (size_t)128 * (u).ldb; } while (0)
    Unit cur, nxt; int ui = 0;
    if (!S.next(0, cur)) return;
    constexpr bool ZP = ZPeel<Epi>::v;
    f32x4 acc[2][2][4][2];
    if constexpr (!ZP) {
#pragma unroll
    for (int a = 0; a < 2; ++a)
#pragma unroll
        for (int b = 0; b < 2; ++b)
#pragma unroll
            for (int m = 0; m < 4; ++m)
#pragma unroll
                for (int n = 0; n < 2; ++n) acc[a][b][m][n] = (f32x4){0.f, 0.f, 0.f, 0.f};
    }
    bf16x8 At[4][2], B0[2][2], B1[2][2];
    unsigned vA0, vA1, vA2, vA3, vB0, vB1; size_t hA, hB;
    GG_OFFS(cur);
    const char* cA = cur.A; const char* cB = cur.B;
    GG_STAGE(GG_SB(0, 0), cB, vB0, vB1); GG_STAGE(GG_SB(0, 1), cB + hB, vB0, vB1); GG_STAGE(GG_SA(0, 0), cA, vA0, vA1); GG_STAGE(GG_SA(0, 1), cA + hA, vA2, vA3);
    if (wr == 1) GG_BAR;
    GG_WAIT_V(2); GG_BAR;
    GG_STAGE(GG_SB(1, 0), cB + kstep, vB0, vB1); GG_STAGE(GG_SA(1, 0), cA + kstep, vA0, vA1); GG_STAGE(GG_SB(1, 1), cB + hB + kstep, vB0, vB1);
    GG_WAIT_V(6); GG_BAR;
    for (;;) {
        const bool has_next = S.next(ui + 1, nxt);
        TSEC_BEGIN(100 + Epi::TID, lds);
        int nt_ = cur.nt; asm volatile("" : "+s"(nt_)); const int nt = nt_;
#pragma unroll 1
        for (int t = 0; t < nt; t += 2) {
            const bool last = (t == nt - 2);
            const char* a1 = cA + (size_t)(t + 1) * kstep;
            GG_LDB(B0, 0, 0); GG_LDB(B1, 0, 1); GG_SCHED; GG_LDA(At, 0, 0); GG_STAGE(GG_SA(1, 1), a1 + hA, vA2, vA3);
            GG_WAIT_V(8); GG_WAIT_L(0); GG_BAR; GG_MM1(0, 0, At, B0); GG_MM1(0, 1, At, B1); GG_BAR; GG_SCHED;
            if (last) { if (has_next) { GG_OFFS(nxt); cA = nxt.A - (size_t)nt * kstep; cB = nxt.B - (size_t)nt * kstep; } else { cA -= (size_t)nt * kstep; cB -= (size_t)nt * kstep; } }
            const char* a2 = cA + (size_t)(t + 2) * kstep; const char* b2 = cB + (size_t)(t + 2) * kstep; const char* a3 = a2 + kstep; const char* b3 = b2 + kstep;
            GG_LDA(At, 0, 1); GG_STAGE(GG_SB(0, 0), b2, vB0, vB1); GG_STAGE(GG_SB(0, 1), b2 + hB, vB0, vB1); GG_STAGE(GG_SA(0, 0), a2, vA0, vA1);
            GG_WAIT_V(8); GG_WAIT_L(0); GG_BAR; GG_MM1(1, 0, At, B0); GG_MM1(1, 1, At, B1); GG_BAR; GG_SCHED;
            GG_LDB(B0, 1, 0); GG_LDB(B1, 1, 1); GG_SCHED; GG_LDA(At, 1, 0); GG_STAGE(GG_SA(0, 1), a2 + hA, vA2, vA3);
            GG_WAIT_V(8); GG_WAIT_L(0); GG_BAR; GG_MM(0, 0, At, B0); GG_MM(0, 1, At, B1); GG_BAR; GG_SCHED;
            GG_LDA(At, 1, 1); GG_STAGE(GG_SB(1, 0), b3, vB0, vB1); GG_STAGE(GG_SB(1, 1), b3 + hB, vB0, vB1); GG_STAGE(GG_SA(1, 0), a3, vA0, vA1);
            GG_WAIT_V(8); GG_WAIT_L(0); GG_BAR; GG_MM(1, 0, At, B0); GG_MM(1, 1, At, B1); GG_BAR; GG_SCHED;
        }
        cA += (size_t)nt * kstep; cB += (size_t)nt * kstep;
        TSEC_END(100 + Epi::TID, lds);
        if (wr == 0) GG_BAR;
        TSEC_BEGIN(200 + Epi::TID, lds); { int t2_ = threadIdx.x; asm volatile("" : "+v"(t2_)); E(acc, cur, wr, wc, t2_ & 15, (t2_ & 63) >> 4); } TSEC_END(200 + Epi::TID, lds);
        if (!has_next) break;
        if constexpr (!ZP)
#pragma unroll
        for (int a = 0; a < 2; ++a)
#pragma unroll
            for (int b = 0; b < 2; ++b)
#pragma unroll
                for (int m = 0; m < 4; ++m)
#pragma unroll
                    for (int n = 0; n < 2; ++n) acc[a][b][m][n] = (f32x4){0.f, 0.f, 0.f, 0.f};
        cur = nxt; ++ui;
        if (wr == 1) GG_BAR;
    }
    GG_WAIT_V(0);
    GG_BAR;
#undef GG_SA
#undef GG_SB
#undef GG_STAGE
#undef GG_LDA
#undef GG_LDB
#undef GG_MMA
#undef GG_MMA8
#undef GG_MM
#undef GG_MM1
#undef GG_MMZ8
#undef GG_CAT8
#undef GG_WAIT_V
#undef GG_WAIT_L
#undef GG_BAR
#undef GG_SCHED
#undef GG_OFFS
}
}

__device__ __forceinline__ int ld_i32_uniform(const int* p) { return __builtin_amdgcn_readfirstlane(__hip_atomic_load(p, __ATOMIC_RELAXED, __HIP_MEMORY_SCOPE_AGENT)); }
__device__ __forceinline__ void tile_order(int L, int nM, int nN, int& pm, int& pn) {
    const int nwg = nM * nN; int wgid = L;
    { const int q = nwg / 8, r = nwg % 8, xcd = wgid % 8, off = wgid / 8; wgid = (xcd < r ? xcd * (q + 1) : r * (q + 1) + (xcd - r) * q) + off; }
    const int nig = 8 * nN, gid = wgid / nig, fm = gid * 8, gsz = (nM - fm) < 8 ? (nM - fm) : 8;
    pm = fm + ((wgid % nig) % gsz); pn = (wgid % nig) / gsz;
}
struct SchedPlain {
    static constexpr bool GATHER = false;
    const char* A; const char* B; unsigned lda, ldb; int nt, nM, nN, G, c;
    __device__ __forceinline__ bool next(int i, gg::Unit& u) const {
        const int L = i * G + c; if (L >= nM * nN) return false;
        int pm, pn; tile_order(L, nM, nN, pm, pn);
        u.A = A + (size_t)pm * 256 * lda; u.B = B + (size_t)pn * 256 * ldb; u.lda = lda; u.ldb = ldb; u.nt = nt; u.ridx_off = 0; u.p0 = pm; u.p1 = pn; u.p2 = 0; return true;
    }
};
struct EpiWin {
    static constexpr bool PERM = true, FP8 = true; static constexpr int TID = 0; static constexpr unsigned SCB = 0x79797979u;
    bf16_t* px; float* gate;
    __device__ __forceinline__ void operator()(const f32x4 (&acc)[2][2][4][2], const gg::Unit& u, int wr, int wc, int fr, int fq) const {
        const int row0 = u.p0 * 256 + wr * 64 + fr;
#pragma unroll
        for (int bj = 0; bj < 2; ++bj) {
            const int c0 = u.p1 * 256 + bj * 128 + wc * 32 + 8 * fq;
            if (c0 < INC) {
                const bool isg = (c0 >= C_G && c0 < C_MLA);
#pragma unroll
                for (int ai = 0; ai < 2; ++ai)
#pragma unroll
                    for (int m = 0; m < 4; ++m) { const int row = row0 + ai * 128 + m * 16; const f32x4 v0 = acc[ai][bj][m][0], v1 = acc[ai][bj][m][1];
                        u32x4 w; w.x = cvt_pk_bf16(v0[0], v0[1]); w.y = cvt_pk_bf16(v0[2], v0[3]); w.z = cvt_pk_bf16(v1[0], v1[1]); w.w = cvt_pk_bf16(v1[2], v1[3]);
                        *(u32x4*)(px + (size_t)row * INC + c0) = w;
                        if (isg) { float* gp = gate + (size_t)row * 16 + (c0 - C_G); *(f32x4*)gp = v0; *(f32x4*)(gp + 4) = v1; } }
            }
        }
    }
};
struct SchedYB {
    static constexpr bool GATHER = false;
    const char* yc; const char* wb; int pm0, nMh, G, c;
    __device__ __forceinline__ bool next(int i, gg::Unit& u) const {
        const int L = i * G + c; if (L >= nMh * 16) return false;
        int pm, q; tile_order(L, nMh, 16, pm, q); const int br = q >> 2, pn = q & 3;
        u.A = yc + (size_t)(pm0 + pm) * 256 * 2048 + br * 512; u.lda = 2048; u.B = wb + (size_t)br * (1024 * 512) + (size_t)pn * 256 * 512; u.ldb = 512; u.nt = 4; u.ridx_off = 0; u.p0 = pm; u.p1 = q; u.p2 = 0; return true;
    }
};
struct EpiMerge2 {
    static constexpr bool PERM = false, FP8 = true; static constexpr int TID = 4; static constexpr unsigned SCB = 0x79797979u;
    const unsigned char* yb; const float* bgate; unsigned char* accm; int pm0;
    __device__ __forceinline__ void operator()(const f32x4 (&acc)[2][2][4][2], const gg::Unit& u, int wr, int wc, int fr, int fq) const {
        const int c = u.p1 * 64 + 16 * wc + 4 * fq, r0 = wr * 64 + fr;
        constexpr float NL2E = -1.4426950408889634f;
        f32x4 bv[2][2];
#pragma unroll
        for (int bj = 0; bj < 2; ++bj)
#pragma unroll
            for (int n = 0; n < 2; ++n) bv[bj][n] = *(const f32x4*)(bgate + (2 * bj + n) * 1024 + c) * NL2E;
        u32x4 yw[2][4];
#pragma unroll
        for (int ai = 0; ai < 2; ++ai)
#pragma unroll
            for (int m = 0; m < 4; ++m) { const unsigned char* yr = yb + (size_t)((u.p0 - pm0) * 256 + r0 + ai * 128 + m * 16) * 4096 + c;
                yw[ai][m] = (u32x4){*(const unsigned*)yr, *(const unsigned*)(yr + 1024), *(const unsigned*)(yr + 2048), *(const unsigned*)(yr + 3072)}; }
#pragma unroll
        for (int ai = 0; ai < 2; ++ai) {
#pragma unroll
            for (int m = 0; m < 4; ++m) {
                f32x4 t = {0.f, 0.f, 0.f, 0.f};
#pragma unroll
                for (int bj = 0; bj < 2; ++bj)
#pragma unroll
                    for (int n = 0; n < 2; ++n) { const f32x4 y = up4_fp8(yw[ai][m][2 * bj + n]); const f32x4 x = acc[ai][bj][m][n] * NL2E + bv[bj][n];
                        const f32x4 d = (f32x4){__builtin_amdgcn_exp2f(x[0]), __builtin_amdgcn_exp2f(x[1]), __builtin_amdgcn_exp2f(x[2]), __builtin_amdgcn_exp2f(x[3])} + 1.0f;
                        t += (f32x4){__builtin_amdgcn_rcpf(d[0]), __builtin_amdgcn_rcpf(d[1]), __builtin_amdgcn_rcpf(d[2]), __builtin_amdgcn_rcpf(d[3])} * y; }
                *(unsigned*)(accm + (size_t)(u.p0 * 256 + r0 + ai * 128 + m * 16) * 1024 + c) = pk4_fp8(t[0], t[1], t[2], t[3]); } }
    }
};
struct EpiWout {
    static constexpr bool PERM = true, FP8 = true; static constexpr int TID = 1; static constexpr unsigned SCB = 0x79797979u;
    bf16_t* mrg; const float* gt;
    __device__ __forceinline__ void operator()(const f32x4 (&acc)[2][2][4][2], const gg::Unit& u, int wr, int wc, int fr, int fq) const {
        const int pm = u.p0; const int mrow = pm >= 256 ? 8 : (pm >> 5);
        const float* g = gt + (size_t)mrow * 6144;
        const int row0 = pm * 256 + wr * 64 + fr, col0 = u.p1 * 256 + wc * 32 + 8 * fq;
#pragma unroll
        for (int bj = 0; bj < 2; ++bj) { const f32x4 g0 = *(const f32x4*)(g + col0 + bj * 128), g1 = *(const f32x4*)(g + col0 + bj * 128 + 4);
#pragma unroll
            for (int ai = 0; ai < 2; ++ai)
#pragma unroll
                for (int m = 0; m < 4; ++m) { const f32x4 v0 = acc[ai][bj][m][0] * g0, v1 = acc[ai][bj][m][1] * g1;
                    u32x4 w; w.x = cvt_pk_bf16(v0[0], v0[1]); w.y = cvt_pk_bf16(v0[2], v0[3]); w.z = cvt_pk_bf16(v1[0], v1[1]); w.w = cvt_pk_bf16(v1[2], v1[3]);
                    *(u32x4*)(mrg + (size_t)(row0 + ai * 128 + m * 16) * 1024 + col0 + bj * 128) = w; } }
    }
};
constexpr int MOE_TAB_OFF = RING_BYTES, MOE_RIDX_OFF = RING_BYTES + 1024;
struct SchedMoe1 {
    static constexpr bool GATHER = true;
    const char* hx2; const char* w13; const LAS int* tab; int ntiles, G, c;
    __device__ __forceinline__ bool next(int i, gg::Unit& u) const {
        const int L = i * G + c; if (L >= ntiles * 2) return false;
        const int tile = L >> 1, pn = L & 1, e = __builtin_amdgcn_readfirstlane(tab[i]);
        u.A = hx2; u.lda = 1024; u.ridx_off = MOE_RIDX_OFF + i * 1024; u.B = w13 + (size_t)e * (512 * 1024) + (size_t)pn * 256 * 1024; u.ldb = 1024; u.nt = 8; u.p0 = tile; u.p1 = pn; u.p2 = e; return true;
    }
};
struct EpiMoe1 {
    static constexpr bool PERM = true, FP8 = true; static constexpr int TID = 5; static constexpr unsigned SCB = 0x79797979u;
    unsigned char* a; const float* roww;
    __device__ __forceinline__ void operator()(const f32x4 (&acc)[2][2][4][2], const gg::Unit& u, int wr, int wc, int fr, int fq) const {
        const int row0 = u.p0 * 256 + wr * 64 + fr, col = u.p1 * 128 + wc * 32 + 8 * fq;
#pragma unroll
        for (int ai = 0; ai < 2; ++ai)
#pragma unroll
            for (int m = 0; m < 4; ++m) { const int row = row0 + ai * 128 + m * 16; const float rw = roww[row] * 8.0f;
                float t[8];
#pragma unroll
                for (int n = 0; n < 2; ++n)
#pragma unroll
                    for (int j = 0; j < 4; ++j) { const float g1 = acc[ai][0][m][n][j], g3 = acc[ai][1][m][n][j]; t[n * 4 + j] = g1 * sigmoidf_(g1) * g3 * rw; }
                *(u32x2*)(a + (size_t)row * 256 + col) = (u32x2){pk4_fp8(t[0], t[1], t[2], t[3]), pk4_fp8(t[4], t[5], t[6], t[7])}; }
    }
};
struct SchedMoe2 {
    static constexpr bool GATHER = false;
    const char* a; const char* w2; const LAS int* tab; int ntiles, G, c;
    __device__ __forceinline__ bool next(int i, gg::Unit& u) const {
        const int L = i * G + c; if (L >= ntiles * 4) return false;
        const int tile = L >> 2, pn = L & 3, e = __builtin_amdgcn_readfirstlane(tab[i]);
        u.A = a + (size_t)tile * 256 * 256; u.lda = 256; u.ridx_off = 0; u.B = w2 + (size_t)e * (1024 * 256) + (size_t)pn * 256 * 256; u.ldb = 256; u.nt = 2; u.p0 = tile; u.p1 = pn; u.p2 = e; return true;
    }
};
struct EpiBf16Plain {
    static constexpr bool PERM = true, FP8 = false; static constexpr int TID = 2; static constexpr unsigned SCB = 0x7f7f7f7fu;
    bf16_t* O; int ldc;
    __device__ __forceinline__ void operator()(const f32x4 (&acc)[2][2][4][2], const gg::Unit& u, int wr, int wc, int fr, int fq) const {
        const int row0 = u.p0 * 256 + wr * 64 + fr, col0 = u.p1 * 256 + wc * 32 + 8 * fq;
#pragma unroll
        for (int ai = 0; ai < 2; ++ai)
#pragma unroll
            for (int m = 0; m < 4; ++m)
#pragma unroll
                for (int bj = 0; bj < 2; ++bj) { const f32x4 v0 = acc[ai][bj][m][0], v1 = acc[ai][bj][m][1];
                    u32x4 w; w.x = cvt_pk_bf16(v0[0], v0[1]); w.y = cvt_pk_bf16(v0[2], v0[3]); w.z = cvt_pk_bf16(v1[0], v1[1]); w.w = cvt_pk_bf16(v1[2], v1[3]);
                    *(u32x4*)(O + (size_t)(row0 + ai * 128 + m * 16) * ldc + col0 + bj * 128) = w; }
    }
};
struct EpiF8Out {
    static constexpr bool PERM = true, FP8 = false; static constexpr int TID = 6; static constexpr unsigned SCB = 0x7f7f7f7fu;
    unsigned char* O; int ldc;
    __device__ __forceinline__ void operator()(const f32x4 (&acc)[2][2][4][2], const gg::Unit& u, int wr, int wc, int fr, int fq) const {
        const int row0 = u.p0 * 256 + wr * 64 + fr, col0 = u.p1 * 256 + wc * 32 + 8 * fq;
#pragma unroll
        for (int ai = 0; ai < 2; ++ai)
#pragma unroll
            for (int m = 0; m < 4; ++m)
#pragma unroll
                for (int bj = 0; bj < 2; ++bj) { const f32x4 v0 = acc[ai][bj][m][0], v1 = acc[ai][bj][m][1];
                    *(u32x2*)(O + (size_t)(row0 + ai * 128 + m * 16) * ldc + col0 + bj * 128) = (u32x2){pk4_fp8(v0[0], v0[1], v0[2], v0[3]), pk4_fp8(v1[0], v1[1], v1[2], v1[3])}; }
    }
};
struct EpiF8OutQ {
    static constexpr bool PERM = true, FP8 = true, ZPEEL = true; static constexpr int TID = 7; static constexpr unsigned SCB = 0x77777777u;
    unsigned char* O; int ldc;
    __device__ __forceinline__ void operator()(const f32x4 (&acc)[2][2][4][2], const gg::Unit& u, int wr, int wc, int fr, int fq) const {
        const int row0 = u.p0 * 256 + wr * 64 + fr, col0 = u.p1 * 256 + wc * 32 + 8 * fq;
#pragma unroll
        for (int ai = 0; ai < 2; ++ai)
#pragma unroll
            for (int m = 0; m < 4; ++m)
#pragma unroll
                for (int bj = 0; bj < 2; ++bj) { const f32x4 v0 = acc[ai][bj][m][0], v1 = acc[ai][bj][m][1];
                    *(u32x2*)(O + (size_t)(row0 + ai * 128 + m * 16) * ldc + col0 + bj * 128) = (u32x2){pk4_fp8(v0[0], v0[1], v0[2], v0[3]), pk4_fp8(v1[0], v1[1], v1[2], v1[3])}; }
    }
};
struct EpiBf16F8 {
    static constexpr bool PERM = true, FP8 = true; static constexpr int TID = 3; static constexpr unsigned SCB = 0x77777777u;
    bf16_t* O; static constexpr int ldc = 1024;
    __device__ __forceinline__ void operator()(const f32x4 (&acc)[2][2][4][2], const gg::Unit& u, int wr, int wc, int fr, int fq) const {
        bf16_t* p = O + (size_t)(u.p0 * 256 + wr * 64 + fr) * ldc + u.p1 * 256 + wc * 32 + 8 * fq;
#pragma unroll
        for (int ai = 0; ai < 2; ++ai) {
#pragma unroll
            for (int m = 0; m < 4; ++m) {
#pragma unroll
                for (int bj = 0; bj < 2; ++bj) { const f32x4 v0 = acc[ai][bj][m][0], v1 = acc[ai][bj][m][1];
                    u32x4 w; w.x = cvt_pk_bf16(v0[0], v0[1]); w.y = cvt_pk_bf16(v0[2], v0[3]); w.z = cvt_pk_bf16(v1[0], v1[1]); w.w = cvt_pk_bf16(v1[2], v1[3]);
                    *(u32x4*)(p + bj * 128) = w; }
                p += 16 * ldc; asm volatile("" : "+v"(p)); }
            p += 64 * ldc; }
    }
};

__device__ __forceinline__ int crow(int r, int hi) { return (r & 3) + 8 * (r >> 2) + 4 * hi; }
__device__ __forceinline__ f32x16 mma32_ll(f32x16 acc, const LAS bf16_t* A, int lda, const LAS bf16_t* B, int ldb, int ksteps, int lane, int ks0 = 0) {
    const int r32 = lane & 31, hi = lane >> 5;
    for (int ks = ks0; ks < ksteps; ++ks) {
        const bf16x8 a = *(const LAS bf16x8*)(A + r32 * lda + ks * 16 + hi * 8);
        const bf16x8 b = *(const LAS bf16x8*)(B + r32 * ldb + ks * 16 + hi * 8);
        acc = __builtin_amdgcn_mfma_f32_32x32x16_bf16(a, b, acc, 0, 0, 0);
    }
    return acc;
}
template <int KS> __device__ __forceinline__ f32x16 mma32_lg(f32x16 acc, const LAS bf16_t* A, int lda, const bf16_t* B, int ldb, int lane) {
    const int r32 = lane & 31, hi = lane >> 5;
    bf16x8 b[KS];
#pragma unroll
    for (int ks = 0; ks < KS; ++ks) b[ks] = *(const bf16x8*)(B + (size_t)r32 * ldb + ks * 16 + hi * 8);
#pragma unroll
    for (int ks = 0; ks < KS; ++ks) { const bf16x8 a = *(const LAS bf16x8*)(A + r32 * lda + ks * 16 + hi * 8); acc = __builtin_amdgcn_mfma_f32_32x32x16_bf16(a, b[ks], acc, 0, 0, 0); }
    return acc;
}

__device__ __forceinline__ void ph_pre(const Frame& F) {
    LAS float* sv = (LAS float*)F.lds;
    LAS float* part = sv + 9 * 1024;
    float* mod = (float*)(F.ws + WS_MOD);
    for (int i = F.tid; i < 9 * 1024; i += NTHR) { const int r = i >> 10, k = i & 1023; const float c = (r < 8) ? F.in[I_C][r * 1024 + k] : F.in[I_CCTX][k]; sv[i] = c * sigmoidf_(c); }
    __syncthreads();
    for (int it = F.bx; it < 2 * 96; it += F.G) {
        const int l = it / 96, jc = it % 96, j = jc * 64 + F.lane, k0 = F.wave * 128;
        const float* w = F.in[I_WMOD] + ((size_t)l * 1024 + k0) * 6144 + j;
        float a[9];
#pragma unroll
        for (int r = 0; r < 9; ++r) a[r] = 0.f;
#pragma unroll 4
        for (int k = 0; k < 128; ++k) { const float wv = w[(size_t)k * 6144];
#pragma unroll
            for (int r = 0; r < 9; ++r) a[r] += sv[r * 1024 + k0 + k] * wv; }
#pragma unroll
        for (int r = 0; r < 9; ++r) part[(F.wave * 9 + r) * 64 + F.lane] = a[r];
        __syncthreads();
        for (int i = F.tid; i < 9 * 64; i += NTHR) { const int r = i >> 6, jj = i & 63; float s = F.in[I_BMOD][l * 6144 + jc * 64 + jj];
#pragma unroll
            for (int w8 = 0; w8 < 8; ++w8) s += part[(w8 * 9 + r) * 64 + jj];
            mod[((size_t)(l * 9 + r)) * 6144 + jc * 64 + jj] = s; }
        __syncthreads();
    }
    if (F.bx == F.G - 1) {
        float* rt = (float*)(F.ws + T_ROPE);
        for (int i = F.tid; i < 1024; i += NTHR) { const int pos = i >> 3, f = i & 7; const float inv = powf(10000.0f, -(float)f / 8.0f); const float ang = (float)pos * inv; rt[2 * i] = cosf(ang); rt[2 * i + 1] = sinf(ang); }
    }
}

struct ConvCursor { int base; int gw, ngw; };
__device__ __forceinline__ void conv_mat(const Frame& F, ConvCursor& cc, const float* src, int K, int N, bf16_t* dst, int ldd, int rbase, int rstep, int nbatch, size_t sbs, size_t dbs, int rq = 128, bool gperm = false, float f8scale = 0.f) {
    const int ktl = K / 64, ntl = (N + 127) / 128, per = ktl * ntl, total = per * nbatch;
    int t = cc.base + ((cc.gw - cc.base) % cc.ngw + cc.ngw) % cc.ngw;
    for (; t < cc.base + total; t += cc.ngw) {
        const int li = t - cc.base, bt = li / per, rem = li % per, kb = rem / ntl, nb = rem % ntl, k0 = kb * 64, n = nb * 128 + 2 * F.lane;
        if (n < N) {
            const float* s = src + bt * sbs + (size_t)k0 * N + n; bf16_t* d = dst + bt * dbs;
            f32x2 v[64];
#pragma unroll
            for (int i = 0; i < 64; ++i) v[i] = *(const f32x2*)(s + (size_t)i * N);
#pragma unroll
            for (int q = 0; q < 2; ++q) { const int nn = n + q; const int drow = gperm ? ((nn >> 6) * 256 + ((nn >> 4) & 3) * 32 + (nn & 15) + 128 * (bt >> 1) + 16 * (bt & 1)) : (rbase + (nn / rq) * rstep + (nn % rq));
                if (f8scale != 0.f) { unsigned char* d8 = (unsigned char*)dst + bt * dbs + (size_t)drow * ldd + k0;
#pragma unroll
                    for (int p = 0; p < 4; ++p) { u32x4 o; o.x = pk4_fp8(v[16 * p][q] * f8scale, v[16 * p + 1][q] * f8scale, v[16 * p + 2][q] * f8scale, v[16 * p + 3][q] * f8scale);
                        o.y = pk4_fp8(v[16 * p + 4][q] * f8scale, v[16 * p + 5][q] * f8scale, v[16 * p + 6][q] * f8scale, v[16 * p + 7][q] * f8scale);
                        o.z = pk4_fp8(v[16 * p + 8][q] * f8scale, v[16 * p + 9][q] * f8scale, v[16 * p + 10][q] * f8scale, v[16 * p + 11][q] * f8scale);
                        o.w = pk4_fp8(v[16 * p + 12][q] * f8scale, v[16 * p + 13][q] * f8scale, v[16 * p + 14][q] * f8scale, v[16 * p + 15][q] * f8scale);
                        *(u32x4*)(d8 + 16 * p) = o; }
                    continue; }
                bf16_t* dr = d + (size_t)drow * ldd + k0;
#pragma unroll
                for (int p = 0; p < 8; ++p) { u32x4 o; o.x = pk2(v[8 * p][q], v[8 * p + 1][q]); o.y = pk2(v[8 * p + 2][q], v[8 * p + 3][q]); o.z = pk2(v[8 * p + 4][q], v[8 * p + 5][q]); o.w = pk2(v[8 * p + 6][q], v[8 * p + 7][q]);
                    *(u32x4*)(dr + 8 * p) = o; } }
        }
    }
    cc.base += total;
}
__device__ __forceinline__ void ph_convert(const Frame& F, int l) {
    ConvCursor cc; cc.base = 0; cc.gw = F.bx * NWAVES + F.wave; cc.ngw = F.G * NWAVES;
    unsigned char* ws = F.ws;
    conv_mat(F, cc, F.in[I_WIN] + (size_t)l * 1024 * INC, 1024, INC, (bf16_t*)(ws + W_IN), 1024, 0, 128, 1, 0, 0, 128, false, 64.0f);
    conv_mat(F, cc, F.in[I_WGATE] + (size_t)l * 4 * 1024 * 1024, 1024, 1024, (bf16_t*)(ws + W_GATE), 1024, 0, 128, 4, (size_t)1024 * 1024, 0, 128, true, 64.0f);
    conv_mat(F, cc, F.in[I_WBR] + (size_t)l * 4 * 256 * 1024, 256, 1024, (bf16_t*)(ws + W_BR), 256, 0, 128, 4, (size_t)256 * 1024, (size_t)1024 * 256);
    conv_mat(F, cc, F.in[I_WOUT] + (size_t)l * 1024 * 1024, 1024, 1024, (bf16_t*)(ws + W_OUT), 1024, 0, 128, 1, 0, 0, 128, false, 64.0f);
    conv_mat(F, cc, F.in[I_W1] + (size_t)l * 64 * 1024 * 256, 1024, 256, (bf16_t*)(ws + W_13), 1024, 0, 256, 64, (size_t)1024 * 256, (size_t)512 * 1024, 128, false, 64.0f);
    conv_mat(F, cc, F.in[I_W3] + (size_t)l * 64 * 1024 * 256, 1024, 256, (bf16_t*)(ws + W_13), 1024, 128, 256, 64, (size_t)1024 * 256, (size_t)512 * 1024, 128, false, 64.0f);
    conv_mat(F, cc, F.in[I_W2] + (size_t)l * 64 * 256 * 1024, 256, 1024, (bf16_t*)(ws + W_2), 256, 0, 128, 64, (size_t)256 * 1024, (size_t)1024 * 256, 128, false, 32.0f);
    conv_mat(F, cc, F.in[I_WS1] + (size_t)l * 1024 * 256, 1024, 256, (bf16_t*)(ws + W_13 + (size_t)64 * 512 * 1024), 1024, 0, 256, 1, 0, 0, 128, false, 64.0f);
    conv_mat(F, cc, F.in[I_WS3] + (size_t)l * 1024 * 256, 1024, 256, (bf16_t*)(ws + W_13 + (size_t)64 * 512 * 1024), 1024, 128, 256, 1, 0, 0, 128, false, 64.0f);
    conv_mat(F, cc, F.in[I_WS2] + (size_t)l * 256 * 1024, 256, 1024, (bf16_t*)(ws + W_2 + (size_t)64 * 1024 * 256), 256, 0, 128, 1, 0, 0, 128, false, 32.0f);
    conv_mat(F, cc, F.in[I_WUQ] + (size_t)l * 256 * 384, 256, 384, (bf16_t*)(ws + W_UQ), 256, 0, 128, 1, 0, 0);
    conv_mat(F, cc, F.in[I_WUKV] + (size_t)l * 128 * 512, 128, 512, (bf16_t*)(ws + W_UKV), 128, 0, 128, 1, 0, 0);
    conv_mat(F, cc, F.in[I_POOLW] + (size_t)l * 4 * 64 * 64, 64, 64, (bf16_t*)(ws + W_POOL), 64, 0, 128, 4, (size_t)64 * 64, (size_t)64 * 64);
    conv_mat(F, cc, F.in[I_WRT] + (size_t)l * 1024 * 64, 1024, 64, (bf16_t*)(ws + W_RT), 1024, 0, 128, 1, 0, 0);
    { u32x4* z = (u32x4*)(ws + W_IN + (size_t)INC * 1024); const int n16 = (INCP - INC) * 1024 / 16;
      unsigned z0 = 0u; asm volatile("" : "+v"(z0));
      for (int i = F.bx * NTHR + F.tid; i < n16; i += F.G * NTHR) z[i] = (u32x4){z0, z0, z0, z0}; }
}

__device__ __forceinline__ void normmod_vals(int lane, const f32x4 (&v)[4], const float* g, const float* sc, const float* sh, f32x4 (&y)[4]) {
    float s = 0.f;
#pragma unroll
    for (int j = 0; j < 4; ++j) s += (v[j].x * v[j].x + v[j].y * v[j].y) + (v[j].z * v[j].z + v[j].w * v[j].w);
    const float rstd = frsq(wave_sum(s) * (1.f / 1024.f) + EPS);
#pragma unroll
    for (int j = 0; j < 4; ++j) { const f32x4 gv = ((const f32x4*)g)[lane + 64 * j], scv = ((const f32x4*)sc)[lane + 64 * j], shv = ((const f32x4*)sh)[lane + 64 * j];
        y[j] = v[j] * rstd * gv * (scv + 1.0f) + shv; }
}
__device__ __forceinline__ void normmod_row(int lane, const float* xrow, const float* g, const float* sc, const float* sh, f32x4 (&y)[4]) {
    const f32x4* xr = (const f32x4*)xrow + lane; f32x4 v[4]; float s = 0.f;
#pragma unroll
    for (int j = 0; j < 4; ++j) { v[j] = xr[64 * j]; s += (v[j].x * v[j].x + v[j].y * v[j].y) + (v[j].z * v[j].z + v[j].w * v[j].w); }
    const float rstd = frsq(wave_sum(s) * (1.f / 1024.f) + EPS);
#pragma unroll
    for (int j = 0; j < 4; ++j) { const f32x4 gv = ((const f32x4*)g)[lane + 64 * j], scv = ((const f32x4*)sc)[lane + 64 * j], shv = ((const f32x4*)sh)[lane + 64 * j];
        y[j] = v[j] * rstd * gv * (scv + 1.0f) + shv; }
}
__device__ __forceinline__ const float* stream_row(const Frame& F, int l, int row) {
    if (row < NLAT) return (l == 0 ? F.in[I_X] : F.out) + (size_t)row * 1024;
    return (l == 0 ? F.in[I_CTX] : (const float*)(F.ws + WS_CTXS)) + (size_t)(row - NLAT) * 1024;
}
__device__ __forceinline__ void ph_norm1(const Frame& F, int l) {
    const int gw = F.bx * NWAVES + F.wave, ngw = F.G * NWAVES;
    for (int row0 = gw; row0 < NTOK; row0 += 2 * ngw) {
        const int row1 = row0 + ngw; const bool has1 = row1 < NTOK;
        f32x4 v0[4], v1[4];
        { const f32x4* x0 = (const f32x4*)stream_row(F, l, row0) + F.lane; const f32x4* x1 = (const f32x4*)stream_row(F, l, has1 ? row1 : row0) + F.lane;
#pragma unroll
          for (int j = 0; j < 4; ++j) { v0[j] = x0[64 * j]; v1[j] = x1[64 * j]; } }
#pragma unroll
        for (int k = 0; k < 2; ++k) { if (k == 1 && !has1) break; const int row = k ? row1 : row0; const int mr = mod_row_of(row); f32x4 y[4];
            normmod_vals(F.lane, k ? v1 : v0, F.in[I_GMIX] + l * 1024, modp(F, l, mr, 1), modp(F, l, mr, 0), y);
            unsigned* o8 = (unsigned*)(F.ws + WS_HX8 + (size_t)row * 1024) + F.lane;
#pragma unroll
            for (int j = 0; j < 4; ++j) o8[64 * j] = pk4_fp8(y[j].x, y[j].y, y[j].z, y[j].w); }
    }
}

constexpr float QSCALE = 0.10206207261596577f * 1.4426950408889634f;
template <int KS> __device__ __forceinline__ void ld_bfrag(bf16x8* b, const bf16_t* B, int ldb, int lane) {
#pragma unroll
    for (int ks = 0; ks < KS; ++ks) b[ks] = *(const bf16x8*)(B + (size_t)(lane & 31) * ldb + ks * 16 + (lane >> 5) * 8);
}
template <int KS> __device__ __forceinline__ f32x16 mma32_lr(const LAS bf16_t* A, int lda, const bf16x8* b, int lane) {
    f32x16 acc = {};
#pragma unroll
    for (int ks = 0; ks < KS; ++ks) { const bf16x8 a = *(const LAS bf16x8*)(A + (lane & 31) * lda + ks * 16 + (lane >> 5) * 8); acc = __builtin_amdgcn_mfma_f32_32x32x16_bf16(a, b[ks], acc, 0, 0, 0); }
    return acc;
}
__device__ __forceinline__ f32x2 mla_rope_ld(const Frame& F, int unit) {
    const int row0 = unit * 32; const bool isctx = row0 >= NLAT; const int pos0 = isctx ? (row0 - NLAT) & 255 : row0 & 8191;
    const int pos = pos0 + (F.tid >> 4), pp = (F.tid & 8) ? (pos & 63) : (pos >> 6);
    return *(const f32x2*)((const float*)(F.ws + T_ROPE) + (pp * 8 + (F.tid & 7)) * 2);
}
struct MlaKvRegs { unsigned xk[4]; unsigned xr[4]; f32x2 rp; };
__device__ __forceinline__ MlaKvRegs mla_kv_load(const Frame& F, int unit) {
    MlaKvRegs R; const bf16_t* px = (const bf16_t*)(F.ws + WS_PX);
#pragma unroll
    for (int rr = 0; rr < 4; ++rr) { const bf16_t* p = px + (size_t)(unit * 32 + F.wave * 4 + rr) * INC + C_MLA;
        R.xk[rr] = *(const unsigned*)(p + 256 + 2 * F.lane); R.xr[rr] = *(const unsigned*)(p + 384 + 2 * (F.lane & 15)); }
    R.rp = mla_rope_ld(F, unit);
    return R;
}
__device__ __forceinline__ void mla_kv_unit(const Frame& F, int unit, const MlaKvRegs& R, const bf16x8* wkv, f32x2 gckv2, float g0, float g1, float g2) {
    LAS unsigned char* lds = F.lds;
    LAS bf16_t* AKV = (LAS bf16_t*)lds;
    LAS float* KR = (LAS float*)(lds + 8704);
    LAS f32x2* RP = (LAS f32x2*)(lds + 12800);
    LAS float* OUT = (LAS float*)(lds + 16896);
    LAS bf16_t* KB = (LAS bf16_t*)(lds + 83456);
    int tid_ = F.tid; asm volatile("" : "+v"(tid_));
    const int row0 = unit * 32, tid = tid_, lane = tid & 63, wave = F.wave, r32 = lane & 31, hi = lane >> 5;
    const bool isctx = row0 >= NLAT;
    const int b = isctx ? (row0 - NLAT) >> 8 : row0 >> 13, pos0 = isctx ? (row0 - NLAT) & 255 : row0 & 8191;
    LDS_BAR();
    RP[tid] = R.rp;
#pragma unroll
    for (int rr = 0; rr < 4; ++rr) { const int r = wave * 4 + rr; const unsigned w = R.xk[rr]; const float x0 = bflo(w), x1 = bfhi(w);
        const float sc = frsq(wave_sum(x0 * x0 + x1 * x1) * (1.f / 128.f) + EPS);
        *(LAS unsigned*)(AKV + r * 136 + 2 * lane) = pk2(x0 * sc * gckv2.x, x1 * sc * gckv2.y);
        if (lane < 16) *(LAS f32x2*)(KR + r * 32 + 2 * lane) = (f32x2){bflo(R.xr[rr]), bfhi(R.xr[rr])}; }
    LDS_BAR();
#pragma unroll
    for (int i = 0; i < 2; ++i) { const int nt = wave * 2 + i; const f32x16 acc = mma32_lr<8>(AKV, 136, wkv + 8 * i, lane);
#pragma unroll
        for (int r = 0; r < 16; ++r) OUT[crow(r, hi) * 520 + nt * 32 + r32] = acc[r]; }
    LDS_BAR();
#pragma unroll
    for (int it = 0; it < 8; ++it) { const int pr = wave * 16 + it * 2 + hi, r = pr >> 2, h = pr & 3; const LAS float* o = OUT + r * 520 + h * 128;
        float v0 = o[r32], v1 = o[32 + r32], v2 = KR[r * 32 + r32]; const float ss = half_sum(v0 * v0 + v1 * v1 + v2 * v2);
        const float sc = frsq(ss * (1.f / 96.f) + EPS);
        v0 *= sc * g0; v1 *= sc * g1; v2 *= sc * g2;
        const float pv = xor_lane<8>(v2);
        if (!isctx) { const f32x2 cssn = RP[(r * 2 + (r32 >> 4)) * 8 + (r32 & 7)]; v2 = (r32 & 8) ? (v2 * cssn.x + pv * cssn.y) : (v2 * cssn.x - pv * cssn.y); }
        LAS bf16_t* kb = KB + r * 392 + h * 96;
        kb[r32] = (bf16_t)f2bf(v0); kb[32 + r32] = (bf16_t)f2bf(v1); kb[64 + r32] = (bf16_t)f2bf(v2); }
    LDS_BAR();
    const int key0 = isctx ? pos0 : 256 + pos0, tile = key0 >> 6, kin = key0 & 63;
    for (int i = tid; i < 1536; i += NTHR) { const int r = i & 31, c = (i >> 5) % 12, h = i / 384;
        const u32x4 v = *(const LAS u32x4*)(KB + r * 392 + h * 96 + c * 8);
        *(u32x4*)((bf16_t*)(F.ws + WS_KT) + ((size_t)((b * 4 + h) * NKT + tile) * 12 + c) * 512 + (kin + r) * 8) = v; }
    for (int i = tid; i < 1024; i += NTHR) { const int p = i & 3, r = (i >> 2) & 31, dh = (i >> 7) & 1, h = i >> 8; const LAS float* o = OUT + r * 520 + h * 128 + 64 + dh * 32 + p * 8;
        u32x4 v; v.x = pk2(o[0], o[1]); v.y = pk2(o[2], o[3]); v.z = pk2(o[4], o[5]); v.w = pk2(o[6], o[7]);
        *(u32x4*)((bf16_t*)(F.ws + WS_VT) + ((size_t)((b * 4 + h) * NKT + tile) * 2 + dh) * 2048 + (kin + r) * 32 + p * 8) = v; }
}
struct MlaQRegs { u32x2 xq[4]; f32x2 rp; };
__device__ __forceinline__ MlaQRegs mla_q_load(const Frame& F, int unit) {
    MlaQRegs R; const bf16_t* px = (const bf16_t*)(F.ws + WS_PX);
#pragma unroll
    for (int rr = 0; rr < 4; ++rr) R.xq[rr] = *(const u32x2*)(px + (size_t)(unit * 32 + F.wave * 4 + rr) * INC + C_MLA + 4 * F.lane);
    R.rp = mla_rope_ld(F, unit);
    return R;
}
__device__ __forceinline__ void mla_q_unit(const Frame& F, int unit, const MlaQRegs& R, const bf16x8* wqf, f32x4 gcq4, float g0, float g1, float g2) {
    LAS unsigned char* lds = F.lds;
    LAS bf16_t* AQ = (LAS bf16_t*)lds;
    LAS f32x2* RP = (LAS f32x2*)(lds + 16896);
    LAS float* OQ = (LAS float*)(lds + 20992);
    int tid_ = F.tid; asm volatile("" : "+v"(tid_));
    const int row0 = unit * 32, tid = tid_, lane = tid & 63, wave = F.wave, r32 = lane & 31, hi = lane >> 5;
    const bool isctx = row0 >= NLAT;
    LDS_BAR();
    RP[tid] = R.rp;
#pragma unroll
    for (int rr = 0; rr < 4; ++rr) { const int r = wave * 4 + rr; const u32x2 w = R.xq[rr]; const float x0 = bflo(w.x), x1 = bfhi(w.x), x2 = bflo(w.y), x3 = bfhi(w.y);
        const float sc = frsq(wave_sum(x0 * x0 + x1 * x1 + x2 * x2 + x3 * x3) * (1.f / 256.f) + EPS);
        *(LAS u32x2*)(AQ + r * 264 + 4 * lane) = (u32x2){pk2(x0 * sc * gcq4.x, x1 * sc * gcq4.y), pk2(x2 * sc * gcq4.z, x3 * sc * gcq4.w)}; }
    LDS_BAR();
    { const f32x16 acc = mma32_lr<16>(AQ, 264, wqf, lane);
#pragma unroll
      for (int r = 0; r < 16; ++r) OQ[crow(r, hi) * 392 + wave * 32 + r32] = acc[r]; }
    if (wave < 4) { const f32x16 acc = mma32_lr<16>(AQ, 264, wqf + 16, lane);
#pragma unroll
      for (int r = 0; r < 16; ++r) OQ[crow(r, hi) * 392 + (8 + wave) * 32 + r32] = acc[r]; }
    LDS_BAR();
    bf16_t* qb = (bf16_t*)(F.ws + WS_QB);
#pragma unroll
    for (int it = 0; it < 8; ++it) { const int pr = wave * 16 + it * 2 + hi, r = pr >> 2, h = pr & 3; const LAS float* o = OQ + r * 392 + h * 96;
        float v0 = o[r32], v1 = o[32 + r32], v2 = o[64 + r32]; const float ss = half_sum(v0 * v0 + v1 * v1 + v2 * v2);
        const float sc = frsq(ss * (1.f / 96.f) + EPS);
        v0 *= sc * g0; v1 *= sc * g1; v2 *= sc * g2;
        const float pv = xor_lane<8>(v2);
        if (!isctx) { const f32x2 cssn = RP[(r * 2 + (r32 >> 4)) * 8 + (r32 & 7)]; v2 = (r32 & 8) ? (v2 * cssn.x + pv * cssn.y) : (v2 * cssn.x - pv * cssn.y); }
        bf16_t* q = qb + (size_t)(row0 + r) * 384 + h * 96;
        q[r32] = (bf16_t)f2bf(v0 * QSCALE); q[32 + r32] = (bf16_t)f2bf(v1 * QSCALE); q[64 + r32] = (bf16_t)f2bf(v2 * QSCALE); }
}
__device__ __forceinline__ void mla_prep(const Frame& F, int l) {
    const int lane = F.lane, wave = F.wave, r32 = lane & 31;
    { bf16x8 wkv[16]; const bf16_t* wukv = (const bf16_t*)(F.ws + W_UKV);
      ld_bfrag<8>(wkv, wukv + (size_t)(wave * 2) * 32 * 128, 128, lane); ld_bfrag<8>(wkv + 8, wukv + (size_t)(wave * 2 + 1) * 32 * 128, 128, lane);
      const f32x2 gckv2 = *(const f32x2*)(F.in[I_GCKV] + l * 128 + 2 * lane); const float* gkn = F.in[I_GKN] + l * 96; const float g0 = gkn[r32], g1 = gkn[32 + r32], g2 = gkn[64 + r32];
      const int nu = NTOK / 32;
      if (F.bx < nu) { MlaKvRegs R = mla_kv_load(F, F.bx);
          for (int u = F.bx; u < nu; u += F.G) { const MlaKvRegs Rn = mla_kv_load(F, (u + F.G < nu) ? u + F.G : u); mla_kv_unit(F, u, R, wkv, gckv2, g0, g1, g2); R = Rn; } } }
    { bf16x8 wqf[32]; const bf16_t* wuq = (const bf16_t*)(F.ws + W_UQ);
      ld_bfrag<16>(wqf, wuq + (size_t)wave * 32 * 256, 256, lane); if (wave < 4) ld_bfrag<16>(wqf + 16, wuq + (size_t)(8 + wave) * 32 * 256, 256, lane);
      const f32x4 gcq4 = *(const f32x4*)(F.in[I_GCQ] + l * 256 + 4 * lane); const float* gqn = F.in[I_GQN] + l * 96; const float g0 = gqn[r32], g1 = gqn[32 + r32], g2 = gqn[64 + r32];
      const int nu = (l == 0 ? NTOK : NLAT) / 32;
      if (F.bx < nu) { MlaQRegs R = mla_q_load(F, F.bx);
          for (int u = F.bx; u < nu; u += F.G) { const MlaQRegs Rn = mla_q_load(F, (u + F.G < nu) ? u + F.G : u); mla_q_unit(F, u, R, wqf, gcq4, g0, g1, g2); R = Rn; } } }
}

__device__ __forceinline__ void ml_chunk_pos(int dir, int j, bool& isctx, int& p0) {
    if (j < 2) { isctx = true; p0 = (dir == 0 ? j : 1 - j) * 128; } else { isctx = false; p0 = (dir == 0 ? (j - 2) : (63 - (j - 2))) * 128; }
}
__device__ __forceinline__ int ml_row(int b, bool isctx, int pos) { return isctx ? NLAT + b * 256 + pos : b * 8192 + pos; }
__device__ __forceinline__ float log_sigmoidf_(float x) { return fminf(x, 0.f) - log1pf(__expf(-fabsf(x))); }

struct P1Regs { u32x4 kv[4]; float gi, gf; };
__device__ __forceinline__ P1Regs ml_pass1_load(const Frame& F, int unit) {
    P1Regs R; const int j = unit % NCHK, dir = (unit / NCHK) & 1, h = (unit / (NCHK * 2)) & 3, b = unit / (NCHK * 8);
    bool isctx; int p0; ml_chunk_pos(dir, j, isctx, p0);
    const bf16_t* px = (const bf16_t*)(F.ws + WS_PX); const float* gate = (const float*)(F.ws + T_GATE); const int tid = F.tid;
#pragma unroll
    for (int q = 0; q < 4; ++q) { const int it = tid + q * NTHR, i = it & 127, c = (it >> 7) & 7, isv = it >> 10; const int pos = dir ? p0 + 127 - i : p0 + i;
        R.kv[q] = *(const u32x4*)(px + (size_t)ml_row(b, isctx, pos) * INC + (isv ? 512 : 256) + h * 64 + c * 8); }
    { const int i = tid & 127; const int pos = dir ? p0 + 127 - i : p0 + i; const float* g = gate + (size_t)ml_row(b, isctx, pos) * 16; R.gi = g[dir * 8 + h]; R.gf = g[dir * 8 + 4 + h]; }
    return R;
}
__device__ __forceinline__ void ml_pass1_unit(const Frame& F, int l, int unit, const P1Regs& R) {
    LAS float* LI = (LAS float*)F.lds; LAS float* LF = LI + 128; LAS float* WV = LI + 256;
    LAS bf16_t* KT = (LAS bf16_t*)(F.lds + 2048); LAS bf16_t* VT = KT + 64 * 136;
    const int dir = (unit / NCHK) & 1, h = (unit / (NCHK * 2)) & 3;
    const int tid = F.tid, lane = F.lane, wave = F.wave;
    const float* gb = F.in[I_MLGB] + l * 16;
    LDS_BAR();
    if (tid < 128) { LI[tid] = R.gi + gb[dir * 8 + h]; LF[tid] = log_sigmoidf_(R.gf + gb[dir * 8 + 4 + h]); }
    LDS_BAR();
    if (wave == 0) {
        const float a0 = LF[2 * lane], a1 = LF[2 * lane + 1]; float s = a0 + a1;
#pragma unroll
        for (int o = 1; o < 64; o <<= 1) { const float t = lane_up(s, o, lane); if (lane >= o) s += t; }
        const float bend = lane_bcast(s, 63);
        const float w0 = bend - (s - a1) + LI[2 * lane], w1 = bend - s + LI[2 * lane + 1];
        const float mloc = wave_max(fmaxf(w0, w1));
        WV[2 * lane] = __expf(w0 - mloc); WV[2 * lane + 1] = __expf(w1 - mloc);
        if (lane == 0) { ((float*)(F.ws + T_MLOC))[unit] = mloc; ((float*)(F.ws + T_BEND))[unit] = bend; }
    }
    LDS_BAR();
#pragma unroll
    for (int q = 0; q < 4; ++q) { const int it = tid + q * NTHR, i = it & 127, c = (it >> 7) & 7, isv = it >> 10; const u32x4 v = R.kv[q];
        const float sc = isv ? 1.0f : 0.125f * WV[i]; LAS bf16_t* d = (isv ? VT : KT) + (c * 8) * 136 + i;
        d[0] = (bf16_t)f2bf(bflo(v.x) * sc); d[136] = (bf16_t)f2bf(bfhi(v.x) * sc); d[272] = (bf16_t)f2bf(bflo(v.y) * sc); d[408] = (bf16_t)f2bf(bfhi(v.y) * sc);
        d[544] = (bf16_t)f2bf(bflo(v.z) * sc); d[680] = (bf16_t)f2bf(bfhi(v.z) * sc); d[816] = (bf16_t)f2bf(bflo(v.w) * sc); d[952] = (bf16_t)f2bf(bfhi(v.w) * sc); }
    LDS_BAR();
    if (wave < 4) { const int et = wave >> 1, dt = wave & 1; f32x16 acc = {}; acc = mma32_ll(acc, VT + et * 32 * 136, 136, KT + dt * 32 * 136, 136, 8, lane);
        float* dc = (float*)(F.ws + WS_DC) + (size_t)unit * 4096; const int r32 = lane & 31, hi = lane >> 5;
#pragma unroll
        for (int r = 0; r < 16; ++r) dc[(et * 32 + crow(r, hi)) * 64 + dt * 32 + r32] = acc[r];
    } else if (wave == 4) { float s = 0.f; for (int i = 0; i < 128; ++i) s += bf2f(KT[lane * 136 + i]); ((float*)(F.ws + T_DN))[(size_t)unit * 64 + lane] = s; }
}

__device__ __forceinline__ void ml_pass2(const Frame& F) {
    const float* dc = (const float*)(F.ws + WS_DC); const float* dn = (const float*)(F.ws + T_DN);
    const float* mloc = (const float*)(F.ws + T_MLOC); const float* bend = (const float*)(F.ws + T_BEND);
    bf16_t* cst = (bf16_t*)(F.ws + WS_CST); float* nst = (float*)(F.ws + T_NST); float* mst = (float*)(F.ws + T_MST);
    LAS float* ML = (LAS float*)F.lds; LAS float* BE = ML + 128;
    for (int it = F.bx; it < 64 * 8; it += F.G) { const int bhd = it >> 3, part = it & 7, u0 = bhd * NCHK, el = part * 512 + F.tid;
        const bool don = (part == 0 && F.tid < 64);
        float d[NCHK], dnv[NCHK];
#pragma unroll
        for (int j = 0; j < NCHK; ++j) d[j] = dc[(size_t)(u0 + j) * 4096 + el];
#pragma unroll
        for (int j = 0; j < NCHK; ++j) dnv[j] = don ? dn[(size_t)(u0 + j) * 64 + F.tid] : 0.f;
        __syncthreads();
        if (F.tid < NCHK) { ML[F.tid] = mloc[u0 + F.tid]; BE[F.tid] = bend[u0 + F.tid]; }
        __syncthreads();
        float C = 0.f, n = 0.f, m = 0.f;
#pragma unroll
        for (int j = 0; j < NCHK; ++j) { const int u = u0 + j; const float ml = ML[j], be = BE[j];
            cst[(size_t)u * 4096 + el] = (bf16_t)f2bf(C); if (don) nst[(size_t)u * 64 + F.tid] = n; if (part == 0 && F.tid == 0) mst[u] = m;
            const float mn = fmaxf(be + m, ml), dcy = __expf(be + m - mn), sc = __expf(ml - mn);
            C = dcy * C + sc * d[j]; n = dcy * n + sc * dnv[j]; m = mn; }
    }
    __syncthreads();
}

__device__ __forceinline__ void ml_pass3_unit(const Frame& F, int l, int b, int h, int pc) {
    LAS unsigned char* lds = F.lds;
    LAS bf16_t* Qs = (LAS bf16_t*)lds;
    LAS bf16_t* Ks = (LAS bf16_t*)(lds + 18432);
    LAS bf16_t* VTs = (LAS bf16_t*)(lds + 36864);
    LAS bf16_t* CTs = (LAS bf16_t*)(lds + 62976);
    LAS bf16_t* Wm = (LAS bf16_t*)(lds + 76800);
    LAS float* HS = (LAS float*)(lds + 111616);
    LAS float* VEC = (LAS float*)(lds + 144384);
    LAS float* DEN = VEC + 12 * 128;
    const int tid = F.tid, lane = F.lane, wave = F.wave, r32 = lane & 31, hi = lane >> 5;
    const bool isctx = pc < 2; const int p0 = isctx ? pc * 128 : (pc - 2) * 128;
    const float* gate = (const float*)(F.ws + T_GATE); const float* gb = F.in[I_MLGB] + l * 16;
    const bf16_t* px = (const bf16_t*)(F.ws + WS_PX);
    int unit_d[2];
#pragma unroll
    for (int dir = 0; dir < 2; ++dir) { const int j = isctx ? (dir == 0 ? pc : 1 - pc) : (dir == 0 ? pc : 2 + 63 - (pc - 2)); unit_d[dir] = ((b * 4 + h) * 2 + dir) * NCHK + j; }
    LDS_BAR();
    const u32x4 cst0 = *(const u32x4*)((const bf16_t*)(F.ws + WS_CST) + (size_t)unit_d[0] * 4096 + tid * 8), cst1 = *(const u32x4*)((const bf16_t*)(F.ws + WS_CST) + (size_t)unit_d[1] * 4096 + tid * 8);
    const float nv0 = (tid < 64) ? ((const float*)(F.ws + T_NST))[(size_t)unit_d[0] * 64 + tid] : 0.f, nv1 = (tid < 64) ? ((const float*)(F.ws + T_NST))[(size_t)unit_d[1] * 64 + tid] : 0.f;
    const float mst0 = ((const float*)(F.ws + T_MST))[unit_d[0]], mst1 = ((const float*)(F.ws + T_MST))[unit_d[1]];
    if (tid < 256) { const int dir = tid >> 7, i = tid & 127; const int pos = dir ? p0 + 127 - i : p0 + i; const float* g = gate + (size_t)ml_row(b, isctx, pos) * 16;
        VEC[(dir * 6 + 0) * 128 + i] = g[dir * 8 + h] + gb[dir * 8 + h]; VEC[(dir * 6 + 1) * 128 + i] = log_sigmoidf_(g[dir * 8 + 4 + h] + gb[dir * 8 + 4 + h]); }
    for (int it = tid; it < 3072; it += NTHR) { const int i = it & 127, c = (it >> 7) & 7, which = it >> 10;
        const u32x4 v = *(const u32x4*)(px + (size_t)ml_row(b, isctx, p0 + i) * INC + which * 256 + h * 64 + c * 8);
        if (which == 0) *(LAS u32x4*)(Qs + i * 72 + c * 8) = v;
        else if (which == 1) { u32x4 w; w.x = pk2(bflo(v.x) * 0.125f, bfhi(v.x) * 0.125f); w.y = pk2(bflo(v.y) * 0.125f, bfhi(v.y) * 0.125f); w.z = pk2(bflo(v.z) * 0.125f, bfhi(v.z) * 0.125f); w.w = pk2(bflo(v.w) * 0.125f, bfhi(v.w) * 0.125f);
            *(LAS u32x4*)(Ks + i * 72 + c * 8) = w; }
        else { LAS bf16_t* d = VTs + (c * 8) * 136 + i; d[0] = (bf16_t)(v.x & 0xffff); d[136] = (bf16_t)(v.x >> 16); d[272] = (bf16_t)(v.y & 0xffff); d[408] = (bf16_t)(v.y >> 16);
            d[544] = (bf16_t)(v.z & 0xffff); d[680] = (bf16_t)(v.z >> 16); d[816] = (bf16_t)(v.w & 0xffff); d[952] = (bf16_t)(v.w >> 16); } }
    for (int it = tid; it < 32 * 136; it += NTHR) VTs[64 * 136 + it] = (it < 128) ? (bf16_t)0x3f80 : (bf16_t)0;
    LDS_BAR();
    if (wave < 2) { const int dir = wave; LAS float* V0 = VEC + dir * 6 * 128; const float mst = dir ? mst1 : mst0;
        const float a0 = V0[128 + 2 * lane], a1 = V0[128 + 2 * lane + 1]; float s = a0 + a1;
#pragma unroll
        for (int o = 1; o < 64; o <<= 1) { const float t = lane_up(s, o, lane); if (lane >= o) s += t; }
        const float b0 = s - a1, b1 = s, c0 = V0[2 * lane] - b0, c1 = V0[2 * lane + 1] - b1;
        float pm = fmaxf(c0, c1);
#pragma unroll
        for (int o = 1; o < 64; o <<= 1) { const float t = lane_up(pm, o, lane); if (lane >= o) pm = fmaxf(pm, t); }
        float pprev = lane_up(pm, 1, lane); if (lane == 0) pprev = -INFINITY;
        const float M0 = fmaxf(mst, fmaxf(pprev, c0)), M1 = fmaxf(mst, pm);
        V0[256 + 2 * lane] = c0; V0[256 + 2 * lane + 1] = c1; V0[384 + 2 * lane] = M0; V0[384 + 2 * lane + 1] = M1;
        V0[512 + 2 * lane] = __expf(mst - M0); V0[512 + 2 * lane + 1] = __expf(mst - M1); V0[640 + 2 * lane] = __expf(-b0 - M0); V0[640 + 2 * lane + 1] = __expf(-b1 - M1);
    }
    const u32x4 og0 = *(const u32x4*)(px + (size_t)ml_row(b, isctx, p0 + (tid >> 3)) * INC + 768 + h * 64 + (tid & 7) * 8), og1 = *(const u32x4*)(px + (size_t)ml_row(b, isctx, p0 + 64 + (tid >> 3)) * INC + 768 + h * 64 + (tid & 7) * 8);
    for (int dir = 0; dir < 2; ++dir) {
        const LAS float* COLV = VEC + (dir * 6 + 2) * 128; const LAS float* MV = COLV + 128; const LAS float* AIN = COLV + 256; const LAS float* EINV = COLV + 384;
        const int rs = dir ? -72 : 72, rb = dir ? 127 : 0;
        LDS_BAR();
        *(LAS u32x4*)(CTs + (tid >> 3) * 72 + (tid & 7) * 8) = dir ? cst1 : cst0;
        if (tid < 72) CTs[64 * 72 + tid] = (tid < 64) ? (bf16_t)f2bf(dir ? nv1 : nv0) : (bf16_t)0;
        for (int q = wave; q < 16; q += 8) { const int ti = q >> 2, si = q & 3; const int sidx = si * 32 + r32, spos = dir ? 127 - sidx : sidx;
            if (si > ti) {
#pragma unroll
                for (int r = 0; r < 16; ++r) Wm[(ti * 32 + crow(r, hi)) * 136 + spos] = 0;
            } else { f32x16 acc = {}; acc = mma32_ll(acc, Qs + (rb + (dir ? -ti * 32 : ti * 32)) * 72, rs, Ks + (rb + (dir ? -si * 32 : si * 32)) * 72, rs, 4, lane); const float cv = COLV[sidx];
#pragma unroll
                for (int r = 0; r < 16; ++r) { const int t = ti * 32 + crow(r, hi); const float w = (sidx <= t) ? acc[r] * __expf(cv - MV[t]) : 0.f; Wm[t * 136 + spos] = (bf16_t)f2bf(w); } }
        }
        LDS_BAR();
        f32x16 tot[2];
#pragma unroll
        for (int k = 0; k < 2; ++k) { const int q = wave + 8 * k; if (q < 12) { const int ti = q / 3, nt = q % 3;
            f32x16 a1 = {}; a1 = mma32_ll(a1, Wm + ti * 32 * 136, 136, VTs + nt * 32 * 136, 136, dir ? 8 : (ti + 1) * 2, lane, dir ? 8 - (ti + 1) * 2 : 0);
            f32x16 a2 = {}; a2 = mma32_ll(a2, Qs + (rb + (dir ? -ti * 32 : ti * 32)) * 72, rs, CTs + nt * 32 * 72, 72, 4, lane);
#pragma unroll
            for (int r = 0; r < 16; ++r) a1[r] += AIN[ti * 32 + crow(r, hi)] * a2[r];
            tot[k] = a1;
            if (nt == 2 && r32 == 0) {
#pragma unroll
                for (int r = 0; r < 16; ++r) DEN[ti * 32 + crow(r, hi)] = a1[r]; } } }
        LDS_BAR();
#pragma unroll
        for (int k = 0; k < 2; ++k) { const int q = wave + 8 * k; if (q < 12) { const int ti = q / 3, nt = q % 3; if (nt < 2) {
#pragma unroll
            for (int r = 0; r < 16; ++r) { const int t = ti * 32 + crow(r, hi); const float hv = tot[k][r] * frcp(fmaxf(fabsf(DEN[t]), EINV[t])); const int p = dir ? 127 - t : t;
                if (dir == 0) HS[p * 64 + nt * 32 + r32] = hv; else HS[p * 64 + nt * 32 + r32] += hv; } } } }
    }
    LDS_BAR();
    { const int c8 = (tid & 7) * 8; bf16_t* yc = (bf16_t*)(F.ws + WS_YC);
      const f32x4 hg0 = *(const f32x4*)(F.in[I_MLHG] + l * 256 + h * 64 + c8), hg1 = *(const f32x4*)(F.in[I_MLHG] + l * 256 + h * 64 + c8 + 4);
#pragma unroll
      for (int half = 0; half < 2; ++half) { const int p = half * 64 + (tid >> 3); const u32x4 og = half ? og1 : og0;
        const f32x4 v0 = *(const LAS f32x4*)(HS + p * 64 + c8), v1 = *(const LAS f32x4*)(HS + p * 64 + c8 + 4);
        float ss = (v0.x * v0.x + v0.y * v0.y) + (v0.z * v0.z + v0.w * v0.w) + (v1.x * v1.x + v1.y * v1.y) + (v1.z * v1.z + v1.w * v1.w);
        ss += xor_lane<1>(ss); ss += xor_lane<2>(ss); ss += xor_lane<4>(ss);
        const float sc = frsq(ss * (1.f / 64.f) + EPS);
        const f32x4 y0 = v0 * sc * hg0 * (f32x4){sigmoidf_(bflo(og.x)), sigmoidf_(bfhi(og.x)), sigmoidf_(bflo(og.y)), sigmoidf_(bfhi(og.y))};
        const f32x4 y1 = v1 * sc * hg1 * (f32x4){sigmoidf_(bflo(og.z)), sigmoidf_(bfhi(og.z)), sigmoidf_(bflo(og.w)), sigmoidf_(bfhi(og.w))};
        *(u32x4*)(yc + (size_t)ml_row(b, isctx, p0 + p) * 1024 + h * 64 + c8) = (u32x4){pk2(y0.x, y0.y), pk2(y0.z, y0.w), pk2(y1.x, y1.y), pk2(y1.z, y1.w)}; } }
}

struct PoolRegs { u32x4 v[5]; };
__device__ __forceinline__ PoolRegs pool_load(const Frame& F, int unit) {
    PoolRegs R; const int row0 = unit * 64, tid = F.tid;
    const bool isctx = row0 >= NLAT; const int T = isctx ? 256 : 8192, t0 = isctx ? (row0 - NLAT) & 255 : row0 & 8191, rbase = row0 - t0;
    const bf16_t* px = (const bf16_t*)(F.ws + WS_PX);
#pragma unroll
    for (int q = 0; q < 5; ++q) { const int it = tid + q * NTHR, rr = it >> 5, c = it & 31, t = t0 - 8 + rr; R.v[q] = (u32x4){0u, 0u, 0u, 0u};
        if (t >= 0 && t < T) R.v[q] = *(const u32x4*)(px + (size_t)(rbase + t) * INC + C_POOL + c * 8); }
    return R;
}
__device__ __forceinline__ void pool_unit(const Frame& F, int l, int unit, const PoolRegs& R) {
    LAS float* U = (LAS float*)F.lds;
    LAS bf16_t* D = (LAS bf16_t*)(F.lds + 81920);
    const int row0 = unit * 64, tid = F.tid, lane = F.lane, wave = F.wave;
    const bool isctx = row0 >= NLAT; const int T = isctx ? 256 : 8192, t0 = isctx ? (row0 - NLAT) & 255 : row0 & 8191, rbase = row0 - t0;
    const bf16_t* px = (const bf16_t*)(F.ws + WS_PX);
    LDS_BAR();
    {
#pragma unroll
      for (int q = 0; q < 5; ++q) { const int it = tid + q * NTHR, rr = it >> 5, c = it & 31; LAS float* d = U + rr * 256 + c * 8; const u32x4 v = R.v[q];
          *(LAS f32x4*)d = (f32x4){bflo(v.x), bfhi(v.x), bflo(v.y), bfhi(v.y)}; *(LAS f32x4*)(d + 4) = (f32x4){bflo(v.z), bfhi(v.z), bflo(v.w), bfhi(v.w)}; } }
    LDS_BAR();
    { const int c = tid & 255, th = tid >> 8, g = c >> 6, hw = 1 << g, tt0 = th * 32;
      float sacc = 0.f;
      for (int u = tt0 - hw; u < tt0 + hw; ++u) sacc += U[(u + 8) * 256 + c];
#pragma unroll 4
      for (int k = 0; k < 32; ++k) { const int tt = tt0 + k, t = t0 + tt; const int lo = max(t - hw, 0), hi = min(t + hw, T);
          D[tt * 264 + c] = (bf16_t)f2bf(sacc * frcp((float)(hi - lo)) - U[(tt + 8) * 256 + c]);
          sacc += U[(tt + hw + 8) * 256 + c] - U[(tt - hw + 8) * 256 + c]; } }
    LDS_BAR();
    { const int g = wave >> 1, rt = wave & 1, r32 = lane & 31, hi = lane >> 5; bf16_t* yc = (bf16_t*)(F.ws + WS_YC); const float* ps = F.in[I_POOLS] + l * 256;
      for (int nt = 0; nt < 2; ++nt) { f32x16 acc = {}; acc = mma32_lg<4>(acc, D + rt * 32 * 264 + g * 64, 264, (const bf16_t*)(F.ws + W_POOL) + (size_t)(g * 64 + nt * 32) * 64, 64, lane);
          const int col = g * 64 + nt * 32 + r32; const float sc = ps[col];
#pragma unroll
          for (int r = 0; r < 16; ++r) yc[(size_t)(row0 + rt * 32 + crow(r, hi)) * 1024 + 512 + col] = (bf16_t)f2bf(acc[r] * sc); } }
}
__device__ __forceinline__ void conv_z(const bf16_t* p, float (&z)[8]) { const u32x4 u = *(const u32x4*)p, cc = *(const u32x4*)(p + 512);
    z[0] = bflo(u.x) * bflo(cc.x); z[1] = bfhi(u.x) * bfhi(cc.x); z[2] = bflo(u.y) * bflo(cc.y); z[3] = bfhi(u.y) * bfhi(cc.y);
    z[4] = bflo(u.z) * bflo(cc.z); z[5] = bfhi(u.z) * bfhi(cc.z); z[6] = bflo(u.w) * bflo(cc.w); z[7] = bfhi(u.w) * bfhi(cc.w); }
__device__ __forceinline__ void conv_all(const Frame& F, int l, int nrows) {
    const bf16_t* px = (const bf16_t*)(F.ws + WS_PX); bf16_t* yc = (bf16_t*)(F.ws + WS_YC);
    const int c = (F.tid & 31) * 8;
    float w0[8], w1[8], w2[8], cb[8];
#pragma unroll
    for (int e = 0; e < 8; ++e) { w0[e] = F.in[I_CONVW][l * 768 + c + e]; w1[e] = F.in[I_CONVW][l * 768 + 256 + c + e]; w2[e] = F.in[I_CONVW][l * 768 + 512 + c + e]; cb[e] = F.in[I_CONVB][l * 256 + c + e]; }
    for (int it = F.bx * NTHR + F.tid; it < (nrows / 16) * 32; it += F.G * NTHR) { const int row0 = (it >> 5) * 16;
        const bool isctx = row0 >= NLAT; const int T = isctx ? 256 : 8192, t0 = isctx ? (row0 - NLAT) & 255 : row0 & 8191;
        const bf16_t* p = px + (size_t)row0 * INC + C_CONV + c;
        float zp[8], zc[8], zn[8];
        if (t0 > 0) conv_z(p - INC, zp); else {
#pragma unroll
            for (int e = 0; e < 8; ++e) zp[e] = 0.f; }
        conv_z(p, zc);
#pragma unroll 4
        for (int r = 0; r < 16; ++r) { const bf16_t* pr = p + (size_t)r * INC;
            if (t0 + r + 1 < T) conv_z(pr + INC, zn); else {
#pragma unroll
                for (int e = 0; e < 8; ++e) zn[e] = 0.f; }
            const u32x4 bw = *(const u32x4*)(pr + 256); const float bx[8] = {bflo(bw.x), bfhi(bw.x), bflo(bw.y), bfhi(bw.y), bflo(bw.z), bfhi(bw.z), bflo(bw.w), bfhi(bw.w)};
            float y[8];
#pragma unroll
            for (int e = 0; e < 8; ++e) { y[e] = bx[e] * (cb[e] + w0[e] * zp[e] + w1[e] * zc[e] + w2[e] * zn[e]); zp[e] = zc[e]; zc[e] = zn[e]; }
            u32x4 o; o.x = pk2(y[0], y[1]); o.y = pk2(y[2], y[3]); o.z = pk2(y[4], y[5]); o.w = pk2(y[6], y[7]);
            *(u32x4*)(yc + (size_t)(row0 + r) * 1024 + 768 + c) = o; }
    }
}

namespace att {
constexpr int STAGE_B = 40960, KSUB = 12288, VOFF = 24576, VSUB = 8192, LDS_WS = 3 * STAGE_B, LDS_OST = LDS_WS + 2048;
constexpr float THR = 8.0f;
__device__ __forceinline__ void glds16(const void* gsrc, unsigned lds_dst) { unsigned keep;
    asm volatile("s_mov_b32 %0, m0\n\ts_mov_b32 m0, %2\n\ts_nop 0\n\tglobal_load_lds_dwordx4 %1, off\n\ts_mov_b32 m0, %0" : "=&s"(keep) : "v"(gsrc), "s"(lds_dst) : "memory"); }
#define ATT_WAIT_BAR(N) asm volatile("s_waitcnt vmcnt(" #N ") lgkmcnt(0)\n\ts_barrier" ::: "memory")
__device__ __forceinline__ void qkt(f32x16& p0, f32x16& p1, const LAS char* Kslot, const bf16x8* qr, int r32, int hi) {
    const LAS char* kb = Kslot + hi * 1024 + r32 * 16; p0 = f32x16{}; p1 = f32x16{};
#pragma unroll
    for (int d0 = 0; d0 < 6; ++d0) {
        const bf16x8 b0 = *(const LAS bf16x8*)(kb + d0 * 2048), b1 = *(const LAS bf16x8*)(kb + d0 * 2048 + 512);
        p0 = __builtin_amdgcn_mfma_f32_32x32x16_bf16(b0, qr[d0], p0, 0, 0, 0); p1 = __builtin_amdgcn_mfma_f32_32x32x16_bf16(b1, qr[d0], p1, 0, 0, 0); }
}
__device__ __forceinline__ float rowmax(const f32x16& p0, const f32x16& p1) {
    float a = fmaxf(p0[0], p1[0]);
#pragma unroll
    for (int r = 1; r < 16; ++r) a = fmaxf(a, fmaxf(p0[r], p1[r]));
    auto rr = __builtin_amdgcn_permlane32_swap(__float_as_uint(a), __float_as_uint(a), false, false);
    return fmaxf(__uint_as_float(rr[0]), __uint_as_float(rr[1]));
}
__device__ __forceinline__ void pv(f32x16* o, int vb, bf16x8 pa0, bf16x8 pa1, bf16x8 pa2, bf16x8 pa3) {
#pragma unroll
    for (int d0 = 0; d0 < 2; ++d0) { s16x4 lo[4], hi[4];
#pragma unroll
        for (int ks = 0; ks < 4; ++ks) {
            asm volatile("ds_read_b64_tr_b16 %0,%1 offset:%c2" : "=&v"(lo[ks]) : "v"(vb), "i"(d0 * 4096 + ks * 1024) : "memory");
            asm volatile("ds_read_b64_tr_b16 %0,%1 offset:%c2" : "=&v"(hi[ks]) : "v"(vb), "i"(d0 * 4096 + ks * 1024 + 512) : "memory"); }
        asm volatile("s_waitcnt lgkmcnt(0)" ::: "memory"); __builtin_amdgcn_sched_barrier(0);
#define ATT_PK(k) (bf16x8){lo[k][0], lo[k][1], lo[k][2], lo[k][3], hi[k][0], hi[k][1], hi[k][2], hi[k][3]}
        o[d0] = __builtin_amdgcn_mfma_f32_32x32x16_bf16(pa0, ATT_PK(0), o[d0], 0, 0, 0);
        o[d0] = __builtin_amdgcn_mfma_f32_32x32x16_bf16(pa1, ATT_PK(1), o[d0], 0, 0, 0);
        o[d0] = __builtin_amdgcn_mfma_f32_32x32x16_bf16(pa2, ATT_PK(2), o[d0], 0, 0, 0);
        o[d0] = __builtin_amdgcn_mfma_f32_32x32x16_bf16(pa3, ATT_PK(3), o[d0], 0, 0, 0);
#undef ATT_PK
    }
}
__device__ __forceinline__ void unit(const Frame& F, int bh, int qrow, int orow, int nst) {
    const int tid = F.tid, lane = F.lane, wid = F.wave, r32 = lane & 31, hi = lane >> 5, h = bh & 3;
    const unsigned lds0 = (unsigned)(uintptr_t)F.lds;
    const LAS char* ring = (const LAS char*)F.lds;
    LAS float* wsf = (LAS float*)(F.lds + LDS_WS) + wid * 64;
    const char* kg = (const char*)(F.ws + WS_KT) + (size_t)bh * NKT * 12288; const char* vg = (const char*)(F.ws + WS_VT) + (size_t)bh * NKT * 8192;
    const bf16_t* Qw = (const bf16_t*)(F.ws + WS_QB) + (size_t)(qrow + wid * 32) * 384 + h * 96;
#define ATT_DMA(t, slot) do { const char* ks_ = kg + (size_t)(t) * 24576 + wid * 1024 + lane * 16; const char* vs_ = vg + (size_t)(t) * 16384 + wid * 1024 + lane * 16; \
        const unsigned kd_ = lds0 + (slot) * STAGE_B + wid * 1024, vd_ = kd_ + VOFF; \
        glds16(ks_, (unsigned)__builtin_amdgcn_readfirstlane(kd_)); glds16(ks_ + 8192, (unsigned)__builtin_amdgcn_readfirstlane(kd_ + 8192)); glds16(ks_ + 16384, (unsigned)__builtin_amdgcn_readfirstlane(kd_ + 16384)); \
        glds16(vs_, (unsigned)__builtin_amdgcn_readfirstlane(vd_)); glds16(vs_ + 8192, (unsigned)__builtin_amdgcn_readfirstlane(vd_ + 8192)); } while (0)
    ATT_DMA(0, 0); if (nst > 1) ATT_DMA(1, 1);
    bf16x8 qr[6];
#pragma unroll
    for (int d0 = 0; d0 < 6; ++d0) qr[d0] = *(const bf16x8*)(Qw + (size_t)r32 * 384 + d0 * 16 + hi * 8);
    float mhat = 0.f, l_reg = 0.f; f32x16 o[2]; o[0] = f32x16{}; o[1] = f32x16{};
    const int vb0 = (int)lds0 + VOFF + ((lane >> 4) & 1) * 32 + (lane & 3) * 8 + (4 * hi + ((lane & 15) >> 2)) * 64;
    int slot = 0; bool first = true;
    for (int t = 0; t < nst; ++t) {
        if (t + 1 < nst) ATT_WAIT_BAR(5); else ATT_WAIT_BAR(0);
        if (t + 2 < nst) { const int s2 = (slot == 0) ? 2 : slot - 1; ATT_DMA(t + 2, s2); }
#pragma unroll
        for (int s = 0; s < 2; ++s) {
            f32x16 p0, p1; qkt(p0, p1, ring + slot * STAGE_B + s * KSUB, qr, r32, hi);
            const float rm = rowmax(p0, p1);
            if (first) { mhat = rm; first = false; }
            else if (__any(rm - mhat > THR)) { const float dl = fmaxf(rm - mhat, 0.f); mhat += dl; const float f = __builtin_amdgcn_exp2f(-dl); l_reg *= f;
                if (hi == 0) wsf[r32] = f; LDS_WAIT();
#pragma unroll
                for (int r = 0; r < 16; ++r) { const float fr_ = wsf[crow(r, hi)]; o[0][r] *= fr_; o[1][r] *= fr_; } }
            float sacc = 0.f;
#pragma unroll
            for (int r = 0; r < 16; ++r) { p0[r] = __builtin_amdgcn_exp2f(p0[r] - mhat); p1[r] = __builtin_amdgcn_exp2f(p1[r] - mhat); sacc += p0[r] + p1[r]; }
            l_reg += sacc;
            u32x4 pw0, pw1, pw2, pw3;
            pw0 = (u32x4){cvt_pk_bf16(p0[0], p0[1]), cvt_pk_bf16(p0[2], p0[3]), cvt_pk_bf16(p0[4], p0[5]), cvt_pk_bf16(p0[6], p0[7])};
            pw1 = (u32x4){cvt_pk_bf16(p0[8], p0[9]), cvt_pk_bf16(p0[10], p0[11]), cvt_pk_bf16(p0[12], p0[13]), cvt_pk_bf16(p0[14], p0[15])};
            pw2 = (u32x4){cvt_pk_bf16(p1[0], p1[1]), cvt_pk_bf16(p1[2], p1[3]), cvt_pk_bf16(p1[4], p1[5]), cvt_pk_bf16(p1[6], p1[7])};
            pw3 = (u32x4){cvt_pk_bf16(p1[8], p1[9]), cvt_pk_bf16(p1[10], p1[11]), cvt_pk_bf16(p1[12], p1[13]), cvt_pk_bf16(p1[14], p1[15])};
            __builtin_amdgcn_sched_barrier(0);
            pv(o, vb0 + slot * STAGE_B + s * VSUB, __builtin_bit_cast(bf16x8, pw0), __builtin_bit_cast(bf16x8, pw1), __builtin_bit_cast(bf16x8, pw2), __builtin_bit_cast(bf16x8, pw3));
        }
        slot = (slot == 2) ? 0 : slot + 1;
    }
    { auto rr = __builtin_amdgcn_permlane32_swap(__float_as_uint(l_reg), __float_as_uint(l_reg), false, false); l_reg = __uint_as_float(rr[0]) + __uint_as_float(rr[1]); }
    if (hi == 0) wsf[32 + r32] = l_reg; LDS_WAIT();
    float rli[16];
#pragma unroll
    for (int r = 0; r < 16; ++r) rli[r] = frcp(wsf[32 + crow(r, hi)]);
    LAS bf16_t* stg = (LAS bf16_t*)(F.lds + LDS_OST) + wid * 2048;
#pragma unroll
    for (int r = 0; r < 16; ++r) { const int orow_ = crow(r, hi);
#pragma unroll
        for (int d0 = 0; d0 < 2; ++d0) stg[orow_ * 64 + d0 * 32 + r32] = (bf16_t)f2bf(o[d0][r] * rli[r]); }
    LDS_WAIT();
    bf16_t* Ow = (bf16_t*)(F.ws + WS_YC) + (size_t)(orow + wid * 32) * 1024 + 256 + h * 64;
#pragma unroll
    for (int i = 0; i < 4; ++i) { const int row = i * 8 + (lane >> 3), ch = lane & 7; const u32x4 v = *(const LAS u32x4*)(stg + row * 64 + ch * 8); *(u32x4*)(Ow + (size_t)row * 1024 + ch * 8) = v; }
    asm volatile("s_waitcnt lgkmcnt(0)\n\ts_barrier" ::: "memory");
#undef ATT_DMA
}
}

namespace att2 {
constexpr int KSL = 12288, VSL = 8192, LDS_K = 0, LDS_V = 3 * KSL, LDS_WS = LDS_V + 3 * VSL, LDS_OST = LDS_WS + 2048;
#define A2_SBAR() __builtin_amdgcn_sched_barrier(0)
#define A2_WAIT_BAR(N) asm volatile("s_waitcnt vmcnt(" #N ") lgkmcnt(0)\n\ts_barrier" ::: "memory")
__device__ __forceinline__ void glds16s(const void* sbase, unsigned voff, unsigned lds_dst) { unsigned keep;
    asm volatile("s_mov_b32 %0, m0\n\ts_mov_b32 m0, %3\n\ts_nop 4\n\tglobal_load_lds_dwordx4 %1, %2\n\ts_mov_b32 m0, %0" : "=&s"(keep) : "v"(voff), "s"(sbase), "s"(lds_dst) : "memory"); }
__device__ __forceinline__ unsigned cvtpk_s(float lo, float hi) { typedef float f2 __attribute__((ext_vector_type(2))); typedef __bf16 b2 __attribute__((ext_vector_type(2))); f2 v = {lo, hi}; b2 b = __builtin_convertvector(v, b2); return __builtin_bit_cast(unsigned, b); }
typedef short v4i16_t __attribute__((ext_vector_type(4)));
__device__ __forceinline__ s16x4 vtr(const LAS char* p) { return __builtin_bit_cast(s16x4, __builtin_amdgcn_ds_read_tr16_b64_v4i16((LAS v4i16_t*)p)); }
__device__ __forceinline__ void kload2(bf16x8* kf, const LAS char* kp, int j) { kf[2 * j] = *(const LAS bf16x8*)(kp + j * 2048); kf[2 * j + 1] = *(const LAS bf16x8*)(kp + j * 2048 + 512); }

template <bool NOMAX> __device__ __forceinline__ void unit(const Frame& F, int bh, int qrow, int orow, int NT) {
    const int lane = F.lane, wid = F.wave, r32 = lane & 31, hi = lane >> 5, h = bh & 3;
    const unsigned lds0 = (unsigned)(uintptr_t)F.lds;
    const LAS char* shm3 = (const LAS char*)F.lds;
    LAS float* wsf = (LAS float*)(F.lds + LDS_WS) + wid * 64;
    const char* kg = (const char*)(F.ws + WS_KT) + (size_t)bh * NKT * 12288; const char* vg = (const char*)(F.ws + WS_VT) + (size_t)bh * NKT * 8192 + wid * 1024; const unsigned l16 = lane * 16;
    const bf16_t* Qw = (const bf16_t*)(F.ws + WS_QB) + (size_t)(qrow + wid * 32) * 384 + h * 96;
    const int kp2 = 8 + (wid & 3);
#define A2_DMA_K(t, sl) do { const char* s_ = kg + (size_t)(t) * 12288; const unsigned d_ = lds0 + LDS_K + (sl) * KSL; \
        glds16s(s_ + wid * 1024, l16, (unsigned)__builtin_amdgcn_readfirstlane(d_ + wid * 1024)); glds16s(s_ + kp2 * 1024, l16, (unsigned)__builtin_amdgcn_readfirstlane(d_ + kp2 * 1024)); } while (0)
#define A2_DMA_V(t, sl) glds16s(vg + (size_t)(t) * 8192, l16, (unsigned)__builtin_amdgcn_readfirstlane(lds0 + LDS_V + (sl) * VSL + wid * 1024))
    const LAS char* kp0 = shm3 + LDS_K + hi * 1024 + r32 * 16;
    const LAS char* vp0 = shm3 + LDS_V + ((lane >> 4) & 1) * 32 + (lane & 3) * 8 + (4 * hi + ((lane & 15) >> 2)) * 64;
    bf16x8 kf[12];
    A2_DMA_K(0, 0); A2_DMA_V(0, 0); A2_DMA_K(1, 1);
    bf16x8 qr[6];
#pragma unroll
    for (int d0 = 0; d0 < 6; ++d0) qr[d0] = *(const bf16x8*)(Qw + (size_t)r32 * 384 + d0 * 16 + hi * 8);
    float mhat = 0.f, l_reg = 0.f; f32x16 o[2]; o[0] = f32x16{}; o[1] = f32x16{};
    bool resc = false;
    f32x16 pA0, pA1, pB0, pB1;
    int sl_prev = 0, sl_cur = 0, sl_next = 1;
#define A2_ROT() do { sl_prev = sl_cur; sl_cur = sl_next; sl_next = (sl_next == 2) ? 0 : sl_next + 1; } while (0)
#define A2_RESC() do { if (!NOMAX && resc) { asm volatile("s_waitcnt lgkmcnt(0)" ::: "memory"); \
        _Pragma("unroll") for (int d_ = 0; d_ < 2; ++d_) _Pragma("unroll") for (int r = 0; r < 16; ++r) o[d_][r] *= wsf[crow(r, hi)]; } } while (0)
    A2_DMA_K(2, 2);
    A2_WAIT_BAR(5);
    { kload2(kf, kp0, 0); kload2(kf, kp0, 1); kload2(kf, kp0, 2); kload2(kf, kp0, 3); kload2(kf, kp0, 4); kload2(kf, kp0, 5);
      pA0 = f32x16{}; pA1 = f32x16{};
#pragma unroll
      for (int d0 = 0; d0 < 6; ++d0) { pA0 = __builtin_amdgcn_mfma_f32_32x32x16_bf16(kf[2 * d0], qr[d0], pA0, 0, 0, 0); pA1 = __builtin_amdgcn_mfma_f32_32x32x16_bf16(kf[2 * d0 + 1], qr[d0], pA1, 0, 0, 0); }
      if constexpr (!NOMAX) { float a = fmaxf(pA0[0], pA1[0]);
#pragma unroll
      for (int r = 1; r < 16; ++r) a = fmaxf(a, fmaxf(pA0[r], pA1[r]));
      { auto rr = __builtin_amdgcn_permlane32_swap(__float_as_uint(a), __float_as_uint(a), false, false); a = fmaxf(__uint_as_float(rr[0]), __uint_as_float(rr[1])); }
      mhat = a; }
#pragma unroll
      for (int r = 0; r < 16; ++r) { pA0[r] = __builtin_amdgcn_exp2f(pA0[r] - mhat); pA1[r] = __builtin_amdgcn_exp2f(pA1[r] - mhat); } }
    A2_WAIT_BAR(0);
    A2_DMA_K(3, 0); A2_DMA_V(1, 1);
    A2_ROT();
    { const LAS char* kp = kp0 + sl_cur * KSL; kload2(kf, kp, 0); kload2(kf, kp, 1); kload2(kf, kp, 2); kload2(kf, kp, 3); kload2(kf, kp, 4); kload2(kf, kp, 5); }
    A2_WAIT_BAR(3);
    s16x4 vlo[8], vhi[8]; u32x4 pw0, pw1, pw2, pw3;
#define A2_PKW(P, B) cvtpk_s(P[B], P[B + 1])
#define A2_PAF(k) __builtin_bit_cast(bf16x8, pw##k)
#define A2_VFR(i) (bf16x8){vlo[i][0], vlo[i][1], vlo[i][2], vlo[i][3], vhi[i][0], vhi[i][1], vhi[i][2], vhi[i][3]}
#define A2_PIN(x) asm volatile("" : "+v"(x))
#define A2_MX3(a, b, c) __builtin_fmaxf(__builtin_fmaxf((a), (b)), (c))
#define A2_GAPA(MF, A0, A1, A2, A3, W0, W1, PW) do { MF; sacc += A0; sacc += A1; sacc += A2; sacc += A3; A2_PIN(sacc); W0; W1; A2_PIN(PW); A2_SBAR(); } while (0)
#define A2_GAPM(MF) do { MF; A2_SBAR(); } while (0)
#define A2_EX(v) __builtin_amdgcn_exp2f(v)
#define A2_SH(v) (NOMAX ? (v) : (v) - mhat)
#define A2_GAPB(MF, X, B) do { MF; X[B] = A2_EX(A2_SH(X[B])); X[B + 1] = A2_EX(A2_SH(X[B + 1])); X[B + 2] = A2_EX(A2_SH(X[B + 2])); X[B + 3] = A2_EX(A2_SH(X[B + 3])); A2_PIN(X); A2_SBAR(); } while (0)
#define A2_VRD(i) do { vlo[i] = vtr(vp_ + (((i) >> 2) * 4096 + ((i) & 3) * 1024)); vhi[i] = vtr(vp_ + (((i) >> 2) * 4096 + ((i) & 3) * 1024 + 512)); } while (0)
#define A2_KRD(G, j) do { if (G) { kload2(kf, kp0 + sl_next * KSL, j); A2_SBAR(); } } while (0)
#define A2_MF(C, kk, qq, CI) C = __builtin_amdgcn_mfma_f32_32x32x16_bf16(kf[kk], qr[qq], CI, 0, 0, 0)
#define A2_STEP(C0, C1, P0, P1, t, GK, GV, GL) do { A2_SBAR(); \
    const LAS char* vp_ = vp0 + sl_prev * VSL; \
    A2_VRD(0); A2_SBAR(); float sacc = (P0[0] + P0[1]); \
    A2_GAPA(A2_MF(C0, 0, 0, (f32x16{})), P0[2], P0[3], P0[4], P0[5],     pw0[0] = A2_PKW(P0, 0), pw0[1] = A2_PKW(P0, 2), pw0); \
    A2_VRD(4); A2_SBAR(); A2_GAPA(A2_MF(C1, 1, 0, (f32x16{})), P0[6], P0[7], P0[8], P0[9],     pw0[2] = A2_PKW(P0, 4), pw0[3] = A2_PKW(P0, 6), pw0); \
    A2_VRD(1); A2_SBAR(); A2_GAPA(A2_MF(C0, 2, 1, C0),   P0[10], P0[11], P0[12], P0[13], pw1[0] = A2_PKW(P0, 8), pw1[1] = A2_PKW(P0, 10), pw1); \
    A2_VRD(5); A2_SBAR(); A2_GAPA(A2_MF(C1, 3, 1, C1),   P0[14], P0[15], P1[0], P1[1],   pw1[2] = A2_PKW(P0, 12), pw1[3] = A2_PKW(P0, 14), pw1); \
    A2_VRD(2); A2_SBAR(); A2_GAPA(A2_MF(C0, 4, 2, C0),   P1[2], P1[3], P1[4], P1[5],     pw2[0] = A2_PKW(P1, 0), pw2[1] = A2_PKW(P1, 2), pw2); \
    A2_VRD(6); A2_SBAR(); A2_GAPA(A2_MF(C1, 5, 2, C1),   P1[6], P1[7], P1[8], P1[9],     pw2[2] = A2_PKW(P1, 4), pw2[3] = A2_PKW(P1, 6), pw2); \
    A2_VRD(3); A2_SBAR(); A2_GAPA(A2_MF(C0, 6, 3, C0),   P1[10], P1[11], P1[12], P1[13], pw3[0] = A2_PKW(P1, 8), pw3[1] = A2_PKW(P1, 10), pw3); \
    A2_VRD(7); A2_SBAR(); A2_GAPA(A2_MF(C1, 7, 3, C1),   P1[14], P1[15], 0.f, 0.f,       pw3[2] = A2_PKW(P1, 12), pw3[3] = A2_PKW(P1, 14), pw3); \
    A2_GAPM(A2_MF(C0, 8, 4, C0)); A2_GAPM(A2_MF(C1, 9, 4, C1)); A2_GAPM(A2_MF(C0, 10, 5, C0)); A2_GAPM(A2_MF(C1, 11, 5, C1)); \
    l_reg += sacc; \
    if (GK) { A2_DMA_K((t) + 3, sl_cur); } if (GV) { A2_DMA_V((t) + 1, sl_next); } \
    if constexpr (!NOMAX) { float a = A2_MX3(C0[0], C0[1], C1[0]), b = A2_MX3(C0[2], C0[3], C1[1]); a = A2_MX3(a, C1[2], C1[3]); \
      _Pragma("unroll") for (int r = 4; r < 16; r += 4) { a = A2_MX3(a, C0[r], C0[r + 1]); b = A2_MX3(b, C0[r + 2], C0[r + 3]); a = A2_MX3(a, C1[r], C1[r + 1]); b = A2_MX3(b, C1[r + 2], C1[r + 3]); } \
      float rm = __builtin_fmaxf(a, b); { auto rr = __builtin_amdgcn_permlane32_swap(__float_as_uint(rm), __float_as_uint(rm), false, false); rm = __builtin_fmaxf(__uint_as_float(rr[0]), __uint_as_float(rr[1])); } \
      resc = false; \
      if (__builtin_expect(__any(rm - mhat > 8.0f), 0)) { const float dl = __builtin_fmaxf(rm - mhat, 0.f); mhat += dl; \
        const float f = __builtin_amdgcn_exp2f(-dl); l_reg *= f; if (hi == 0) wsf[r32] = f; resc = true; } } \
    A2_SBAR(); \
    A2_GAPB(o[0] = __builtin_amdgcn_mfma_f32_32x32x16_bf16(A2_PAF(0), A2_VFR(0), o[0], 0, 0, 0), C0, 0); \
    A2_KRD(GL, 0); A2_GAPB(o[1] = __builtin_amdgcn_mfma_f32_32x32x16_bf16(A2_PAF(0), A2_VFR(4), o[1], 0, 0, 0), C0, 4); \
    A2_KRD(GL, 1); A2_GAPB(o[0] = __builtin_amdgcn_mfma_f32_32x32x16_bf16(A2_PAF(1), A2_VFR(1), o[0], 0, 0, 0), C0, 8); \
    A2_KRD(GL, 2); A2_GAPB(o[1] = __builtin_amdgcn_mfma_f32_32x32x16_bf16(A2_PAF(1), A2_VFR(5), o[1], 0, 0, 0), C0, 12); \
    A2_KRD(GL, 3); A2_GAPB(o[0] = __builtin_amdgcn_mfma_f32_32x32x16_bf16(A2_PAF(2), A2_VFR(2), o[0], 0, 0, 0), C1, 0); \
    A2_KRD(GL, 4); A2_GAPB(o[1] = __builtin_amdgcn_mfma_f32_32x32x16_bf16(A2_PAF(2), A2_VFR(6), o[1], 0, 0, 0), C1, 4); \
    A2_KRD(GL, 5); A2_GAPB(o[0] = __builtin_amdgcn_mfma_f32_32x32x16_bf16(A2_PAF(3), A2_VFR(3), o[0], 0, 0, 0), C1, 8); \
    A2_GAPB(o[1] = __builtin_amdgcn_mfma_f32_32x32x16_bf16(A2_PAF(3), A2_VFR(7), o[1], 0, 0, 0), C1, 12); \
    } while (0)
    int t = 1;
    for (; t + 5 < NT; t += 2) {
        A2_STEP(pB0, pB1, pA0, pA1, t, true, true, true);     A2_WAIT_BAR(3); A2_RESC(); A2_ROT();
        A2_STEP(pA0, pA1, pB0, pB1, t + 1, true, true, true); A2_WAIT_BAR(3); A2_RESC(); A2_ROT();
    }
#define A2_ENDW(tt) do { if ((tt) + 3 < NT) { A2_WAIT_BAR(3); } else if ((tt) + 2 < NT) { A2_WAIT_BAR(1); } else { A2_WAIT_BAR(0); } } while (0)
    for (; t + 1 < NT; t += 2) {
        A2_STEP(pB0, pB1, pA0, pA1, t, (t + 3 < NT), (t + 1 < NT), (t + 1 < NT));     A2_ENDW(t);     A2_RESC(); A2_ROT();
        A2_STEP(pA0, pA1, pB0, pB1, t + 1, (t + 4 < NT), (t + 2 < NT), (t + 2 < NT)); A2_ENDW(t + 1); A2_RESC(); A2_ROT();
    }
    A2_STEP(pB0, pB1, pA0, pA1, NT - 1, false, false, false); A2_RESC();
    { float sacc = pB0[0] + pB0[1];
#pragma unroll
      for (int r = 2; r < 16; ++r) sacc += pB0[r];
#pragma unroll
      for (int r = 0; r < 16; ++r) sacc += pB1[r];
      l_reg += sacc;
      pw0 = (u32x4){A2_PKW(pB0, 0), A2_PKW(pB0, 2), A2_PKW(pB0, 4), A2_PKW(pB0, 6)}; pw1 = (u32x4){A2_PKW(pB0, 8), A2_PKW(pB0, 10), A2_PKW(pB0, 12), A2_PKW(pB0, 14)};
      pw2 = (u32x4){A2_PKW(pB1, 0), A2_PKW(pB1, 2), A2_PKW(pB1, 4), A2_PKW(pB1, 6)}; pw3 = (u32x4){A2_PKW(pB1, 8), A2_PKW(pB1, 10), A2_PKW(pB1, 12), A2_PKW(pB1, 14)};
      A2_SBAR();
      const int vb = (int)lds0 + LDS_V + ((lane >> 4) & 1) * 32 + (lane & 3) * 8 + (4 * hi + ((lane & 15) >> 2)) * 64 + sl_cur * VSL;
      att::pv(o, vb, A2_PAF(0), A2_PAF(1), A2_PAF(2), A2_PAF(3)); }
    { auto rr = __builtin_amdgcn_permlane32_swap(__float_as_uint(l_reg), __float_as_uint(l_reg), false, false); l_reg = __uint_as_float(rr[0]) + __uint_as_float(rr[1]); }
    if (hi == 0) wsf[32 + r32] = l_reg; LDS_WAIT();
    float rli[16];
#pragma unroll
    for (int r = 0; r < 16; ++r) rli[r] = __builtin_amdgcn_rcpf(wsf[32 + crow(r, hi)]);
    LAS bf16_t* stg = (LAS bf16_t*)(F.lds + LDS_OST) + wid * 2048;
#pragma unroll
    for (int r = 0; r < 16; ++r) { const int orow_ = crow(r, hi);
#pragma unroll
        for (int d0 = 0; d0 < 2; ++d0) stg[orow_ * 64 + d0 * 32 + r32] = (bf16_t)f2bf(o[d0][r] * rli[r]); }
    LDS_WAIT();
    bf16_t* Ow = (bf16_t*)(F.ws + WS_YC) + (size_t)(orow + wid * 32) * 1024 + 256 + h * 64;
#pragma unroll
    for (int i = 0; i < 4; ++i) { const int row = i * 8 + (lane >> 3), ch = lane & 7; const u32x4 v = *(const LAS u32x4*)(stg + row * 64 + ch * 8); *(u32x4*)(Ow + (size_t)row * 1024 + ch * 8) = v; }
    asm volatile("s_waitcnt lgkmcnt(0)\n\ts_barrier" ::: "memory");
}
}

__device__ __forceinline__ void ph_norm2_route(const Frame& F, int l, int ntok) {
    LAS bf16_t* A = (LAS bf16_t*)F.lds;
    LAS float* PART = (LAS float*)(F.lds + 66048);
    LAS float* LOG = (LAS float*)(F.lds + 131584);
    LAS int* HIST = (LAS int*)(F.lds + 139776);
    const int tid = F.tid, lane = F.lane, wave = F.wave, r32 = lane & 31, hi = lane >> 5;
    const int tpb = ntok / F.G, tok0 = F.bx * tpb;
    int* eidx = (int*)(F.ws + T_EIDX); float* ew = (float*)(F.ws + T_EW);
    const float* brt = F.in[I_BRT] + l * 64;
    if (tid < 64) HIST[tid] = 0;
    LAS f32x4* AV = (LAS f32x4*)(F.lds + 140288);
    LAS f32x4* SHV = AV + 512;
    const int mr_first = mod_row_of(tok0), mr_last = mod_row_of(tok0 + tpb - 1);
    { const int set = tid >> 8, idx = tid & 255, mrs = set ? mr_last : mr_first;
      const f32x4 gv = ((const f32x4*)(F.in[I_GFFN] + l * 1024))[idx], scv = ((const f32x4*)modp(F, l, mrs, 4))[idx];
      AV[tid] = gv * (scv + 1.0f); SHV[tid] = ((const f32x4*)modp(F, l, mrs, 3))[idx]; }
    bf16x8 wrt[2][8];
#pragma unroll
    for (int nt = 0; nt < 2; ++nt)
#pragma unroll
        for (int ks = 0; ks < 8; ++ks) wrt[nt][ks] = *(const bf16x8*)((const bf16_t*)(F.ws + W_RT) + (size_t)(nt * 32 + r32) * 1024 + wave * 128 + ks * 16 + hi * 8);
    f32x4 xn[4][4]; u32x2 mn[4][4];
#pragma unroll
    for (int rr = 0; rr < 4; ++rr) { const int t = min(wave * 4 + rr, tpb - 1); const f32x4* xr = (const f32x4*)stream_row(F, l, tok0 + t) + lane; const u32x2* mg = (const u32x2*)((const bf16_t*)(F.ws + WS_YC) + (size_t)(tok0 + t) * 1024) + lane;
#pragma unroll
        for (int j = 0; j < 4; ++j) { xn[rr][j] = xr[64 * j]; mn[rr][j] = mg[64 * j]; } }
    for (int b0 = 0; b0 < tpb; b0 += 32) {
        __syncthreads();
        { f32x4 v[4][4];
#pragma unroll
          for (int rr = 0; rr < 4; ++rr) {
#pragma unroll
                for (int j = 0; j < 4; ++j) { const u32x2 w = mn[rr][j]; v[rr][j] = xn[rr][j] + (f32x4){bflo(w.x), bfhi(w.x), bflo(w.y), bfhi(w.y)}; } }
#pragma unroll
          for (int rr = 0; rr < 4; ++rr) { const int r = wave * 4 + rr, t = b0 + r; LAS u32x2* a = (LAS u32x2*)(A + r * 1032) + lane;
            if (t < tpb) { const int row = tok0 + t, mr = mod_row_of(row); f32x4 y[4];
                f32x4* xo = (f32x4*)((row < NLAT) ? F.out + (size_t)row * 1024 : (float*)(F.ws + WS_CTXS) + (size_t)(row - NLAT) * 1024) + lane;
#pragma unroll
                for (int j = 0; j < 4; ++j) xo[64 * j] = v[rr][j];
                { float s2 = 0.f;
#pragma unroll
                  for (int j = 0; j < 4; ++j) s2 += (v[rr][j].x * v[rr][j].x + v[rr][j].y * v[rr][j].y) + (v[rr][j].z * v[rr][j].z + v[rr][j].w * v[rr][j].w);
                  const float rstd = frsq(wave_sum(s2) * (1.f / 1024.f) + EPS); const int vb = (mr == mr_first ? 0 : 256) + lane;
#pragma unroll
                  for (int j = 0; j < 4; ++j) y[j] = v[rr][j] * rstd * AV[vb + 64 * j] + SHV[vb + 64 * j]; }
                unsigned* o8 = (unsigned*)(F.ws + WS_HX8 + (size_t)row * 1024) + lane;
#pragma unroll
                for (int j = 0; j < 4; ++j) { a[64 * j] = (u32x2){pk2(y[j].x, y[j].y), pk2(y[j].z, y[j].w)}; o8[64 * j] = pk4_fp8(y[j].x, y[j].y, y[j].z, y[j].w); }
            } else {
#pragma unroll
                for (int j = 0; j < 4; ++j) a[64 * j] = (u32x2){0u, 0u}; } } }
        if (b0 + 32 < tpb) {
#pragma unroll
            for (int rr = 0; rr < 4; ++rr) { const int t = min(b0 + 32 + wave * 4 + rr, tpb - 1); const f32x4* xr = (const f32x4*)stream_row(F, l, tok0 + t) + lane; const u32x2* mg = (const u32x2*)((const bf16_t*)(F.ws + WS_YC) + (size_t)(tok0 + t) * 1024) + lane;
#pragma unroll
                for (int j = 0; j < 4; ++j) { xn[rr][j] = xr[64 * j]; mn[rr][j] = mg[64 * j]; } } }
        __syncthreads();
#pragma unroll
        for (int nt = 0; nt < 2; ++nt) { f32x16 acc = {};
#pragma unroll
            for (int ks = 0; ks < 8; ++ks) { const bf16x8 a = *(const LAS bf16x8*)(A + wave * 128 + r32 * 1032 + ks * 16 + hi * 8); acc = __builtin_amdgcn_mfma_f32_32x32x16_bf16(a, wrt[nt][ks], acc, 0, 0, 0); }
#pragma unroll
            for (int r = 0; r < 16; ++r) PART[(wave * 32 + crow(r, hi)) * 64 + nt * 32 + r32] = acc[r]; }
        __syncthreads();
        for (int i = tid; i < 2048; i += NTHR) { float s = 0.f;
#pragma unroll
            for (int w = 0; w < 8; ++w) s += PART[w * 2048 + i];
            LOG[i] = s; }
        __syncthreads();
        for (int rr = 0; rr < 4; ++rr) { const int r = wave * 4 + rr, t = b0 + r; if (t >= tpb) continue;
            const float sc = sigmoidf_(LOG[r * 64 + lane]); float v = sc + brt[lane]; float ssel = 0.f, mys = 0.f; int myi = 0;
#pragma unroll
            for (int k = 0; k < TOPK; ++k) { const float mx = wave_max(v); const unsigned long long bal = __ballot(v == mx); const int win = __ffsll((long long)bal) - 1;
                const float sw = lane_bcast(sc, win); ssel += sw; if (lane == k) { mys = sw; myi = win; } if (lane == win) v = -INFINITY; }
            if (lane < TOPK) { eidx[(size_t)(tok0 + t) * 6 + lane] = myi; ew[(size_t)(tok0 + t) * 6 + lane] = mys * frcp(ssel) * 2.5f; __hip_atomic_fetch_add(&HIST[myi], 1, __ATOMIC_RELAXED, __HIP_MEMORY_SCOPE_WORKGROUP); } }
    }
    __syncthreads();
    if (tid < 64) ((int*)(F.ws + T_HIST))[F.bx * 64 + tid] = HIST[tid];
}

__device__ __forceinline__ void ph_assign(const Frame& F, int ntok) {
    LAS int* BASE = (LAS int*)F.lds; LAS int* CUR = BASE + 64; LAS int* START = BASE + 128; LAS int* TOT = BASE + 192; LAS int* MISC = BASE + 256;
    const int tid = F.tid, hb = F.G, c = 0, tpb = ntok / F.G, ctok0 = 0, ctoks = ntok;
    const int* hist = (const int*)(F.ws + T_HIST); int* rtok = (int*)(F.ws + T_RTOK); float* rw = (float*)(F.ws + T_RW); int* slot = (int*)(F.ws + T_SLOT);
    int* tile_e = (int*)(F.ws + T_TILEE);
    __syncthreads();
    { LAS int* PT = BASE + 512; LAS int* PB = PT + 512;
      const int e = tid & 63, part = tid >> 6; int tot = 0, bef = 0;
#pragma unroll 8
      for (int k = 0; k < 32; ++k) { const int b = c * hb + part * 32 + k; if (b < (c + 1) * hb) { const int v = hist[b * 64 + e]; tot += v; if (b < F.bx) bef += v; } }
      PT[part * 64 + e] = tot; PB[part * 64 + e] = bef; }
    __syncthreads();
    if (tid < 64) { int tot = 0, bef = 0; for (int p8 = 0; p8 < 8; ++p8) { tot += BASE[512 + p8 * 64 + tid]; bef += BASE[1024 + p8 * 64 + tid]; } TOT[tid] = tot; BASE[tid] = bef; CUR[tid] = 0; }
    __syncthreads();
    if (tid == 0) { int s = 0; for (int e = 0; e < 64; ++e) { START[e] = s; s += (TOT[e] + 255) / 256 * 256; } MISC[0] = s; }
    __syncthreads();
    const int sstart = MISC[0];
    const int* eidx = (const int*)(F.ws + T_EIDX); const float* ew = (const float*)(F.ws + T_EW);
    for (int i = tid; i < tpb * 6; i += NTHR) { const int tok = F.bx * tpb + i / 6, k = i % 6; const int e = eidx[(size_t)tok * 6 + k];
        const int pos = START[e] + BASE[e] + __hip_atomic_fetch_add(&CUR[e], 1, __ATOMIC_RELAXED, __HIP_MEMORY_SCOPE_WORKGROUP); rtok[pos] = tok; rw[pos] = ew[(size_t)tok * 6 + k]; slot[(size_t)tok * 8 + k] = pos; }
    for (int i = tid; i < tpb; i += NTHR) { const int tok = F.bx * tpb + i, pos = sstart + (tok - ctok0); rtok[pos] = tok; rw[pos] = 1.0f; slot[(size_t)tok * 8 + 6] = pos; }
    if (F.bx == c * hb) {
        for (int e = 0; e < 64; ++e) { const int p0 = START[e] + TOT[e], p1 = START[e] + (TOT[e] + 255) / 256 * 256;
            for (int p = p0 + tid; p < p1; p += NTHR) { rtok[p] = ctok0; rw[p] = 0.f; }
            for (int tl = START[e] / 256 + tid; tl < p1 / 256; tl += NTHR) tile_e[tl] = e; }
        for (int tl = sstart / 256 + tid; tl < (sstart + ctoks) / 256; tl += NTHR) tile_e[tl] = 64;
        if (tid == 0) tile_e[2047] = (sstart + ctoks) / 256;
    }
}

template <bool FUSE_NORM> __device__ __forceinline__ void ph_combine(const Frame& F, int l, int c, int ntok) {
    const int lane = F.lane; const int tpb = ntok / F.G, tok0 = F.bx * tpb; (void)c;
    const int* slot = (const int*)(F.ws + T_SLOT); const unsigned char* ys = (const unsigned char*)(F.ws + WS_YS);
    int mr_cur = -1; f32x4 gtv[2][2], av[2][2], shv[2][2];
    for (int t = F.wave; t < tpb; t += NWAVES) { const int tok = tok0 + t, mr = mod_row_of(tok);
        if (mr != mr_cur) { mr_cur = mr; const float* gt = modp(F, l, mr, 5);
#pragma unroll
            for (int j = 0; j < 2; ++j)
#pragma unroll
                for (int h2 = 0; h2 < 2; ++h2) { const int c0 = 8 * lane + 512 * j + 4 * h2; gtv[j][h2] = *(const f32x4*)(gt + c0);
                    if constexpr (FUSE_NORM) { const f32x4 gv = *(const f32x4*)(F.in[I_GMIX] + 1024 + c0), scv = *(const f32x4*)(modp(F, 1, mr, 1) + c0); av[j][h2] = gv * (scv + 1.0f); shv[j][h2] = *(const f32x4*)(modp(F, 1, mr, 0) + c0); } } }
        float* xr = (tok < NLAT) ? F.out + (size_t)tok * 1024 : (float*)(F.ws + WS_CTXS) + (size_t)(tok - NLAT) * 1024;
        const int sv = slot[(size_t)tok * 8 + (lane & 7)];
        u32x2 y[7][2];
#pragma unroll
        for (int k = 0; k < 7; ++k) { const int sk = __builtin_amdgcn_readlane(sv, k); const u32x2* yr = (const u32x2*)(ys + (size_t)sk * 1024) + lane; y[k][0] = yr[0]; y[k][1] = yr[64]; }
        f32x4 xv[2][2];
#pragma unroll
        for (int j = 0; j < 2; ++j) { xv[j][0] = *(const f32x4*)(xr + 8 * lane + 512 * j); xv[j][1] = *(const f32x4*)(xr + 8 * lane + 512 * j + 4); }
#pragma unroll
        for (int j = 0; j < 2; ++j) { f32x4 a0 = {0.f, 0.f, 0.f, 0.f}, a1 = {0.f, 0.f, 0.f, 0.f};
#pragma unroll
            for (int k = 0; k < 7; ++k) { a0 += up4_fp8(y[k][j].x); a1 += up4_fp8(y[k][j].y); }
            xv[j][0] = xv[j][0] + gtv[j][0] * a0; xv[j][1] = xv[j][1] + gtv[j][1] * a1;
            *(f32x4*)(xr + 8 * lane + 512 * j) = xv[j][0]; *(f32x4*)(xr + 8 * lane + 512 * j + 4) = xv[j][1]; }
        if constexpr (FUSE_NORM) {
            float ss = 0.f;
#pragma unroll
            for (int j = 0; j < 2; ++j)
#pragma unroll
                for (int h2 = 0; h2 < 2; ++h2) { const f32x4 v = xv[j][h2]; ss += (v.x * v.x + v.y * v.y) + (v.z * v.z + v.w * v.w); }
            const float rstd = frsq(wave_sum(ss) * (1.f / 1024.f) + EPS);
            unsigned char* h8 = F.ws + WS_HX8 + (size_t)tok * 1024;
#pragma unroll
            for (int j = 0; j < 2; ++j) { const int c0 = 8 * lane + 512 * j; f32x4 y[2];
#pragma unroll
                for (int h2 = 0; h2 < 2; ++h2) y[h2] = xv[j][h2] * rstd * av[j][h2] + shv[j][h2];
                *(u32x2*)(h8 + c0) = (u32x2){pk4_fp8(y[0].x, y[0].y, y[0].z, y[0].w), pk4_fp8(y[1].x, y[1].y, y[1].z, y[1].w)}; }
        }
    }
}
__device__ __forceinline__ Frame phase_frame(const Frame& F) {
    Frame Q = F; int t = threadIdx.x; asm volatile("" : "+v"(t)); Q.tid = t; Q.lane = t & 63; Q.wave = __builtin_amdgcn_readfirstlane(t >> 6);
    unsigned long long w = (unsigned long long)F.ws; asm volatile("" : "+s"(w)); Q.ws = (unsigned char*)(GAS unsigned char*)w;
    return Q;
}
constexpr int PH_PER_LAYER = 13, PH_TOTAL = 1 + 2 * PH_PER_LAYER;
__global__ void __launch_bounds__(NTHR, 2) mk_fwd(Params p) {
    extern __shared__ __attribute__((aligned(16))) unsigned char lds_raw[];
    Frame F0;
    F0.lds = (LAS unsigned char*)lds_raw; F0.ws = p.ws; F0.in = p.in; F0.out = p.out;
    F0.tid = threadIdx.x; F0.lane = F0.tid & 63; F0.wave = __builtin_amdgcn_readfirstlane(F0.tid >> 6); F0.bx = blockIdx.x; F0.G = gridDim.x;
    volatile LAS unsigned* MISC = (volatile LAS unsigned*)(F0.lds + MISC_OFF);
    if (F0.tid < 64) MISC[F0.tid] = 0u;
    __syncthreads();
    const int lo = p.ph_lo, hi = p.ph_hi;
    XcdBarrier bar; bar.bar = (unsigned*)(F0.ws + WS_CTL) + CW_BAR; bar.x = 0; bar.st = MISC + 8;
    if (hi - lo > 1) bar = xcd_barrier_post((unsigned*)(F0.ws + WS_CTL) + CW_BAR, MISC + 8);
#ifndef MK_SITE
#define MK_SITE -1
#endif
#define SITE(n) (MK_SITE < 0 || MK_SITE == (n))
#ifndef MK_REP_MASK
#define MK_REP_MASK 0
#endif
#define NREP(n) (((MK_REP_MASK >> (n)) & 1) ? 2 : 1)
#define RUN(k) (lo <= (k) && (k) < hi)
#define SEAM(k) do { if (RUN(k) && RUN((k) + 1)) { TSEC_BEGIN(300, F0.lds); xcd_barrier(bar); TSEC_END(300, F0.lds); } } while (0)
    int ph = 0;
    if (SITE(0) && RUN(ph)) TSEC_BEGIN(400 + 0, F0.lds); if (SITE(0) && RUN(ph)) for (int rep_ = 0; rep_ < NREP(0); ++rep_) { const Frame F = phase_frame(F0); ph_pre(F); }
    TSEC_END(400 + 99, F0.lds); SEAM(ph); ++ph;
    for (int l = 0; l < 2; ++l) {
        const int ntok = (l == 0) ? NTOK : NLAT, nM = ntok / 256;
        if (SITE(1) && RUN(ph)) TSEC_BEGIN(400 + 1, F0.lds); if (SITE(1) && RUN(ph)) for (int rep_ = 0; rep_ < NREP(1); ++rep_) { const Frame F = phase_frame(F0); ph_convert(F, l); __syncthreads(); if (l == 0) ph_norm1(F, l); }
        TSEC_END(400 + 99, F0.lds); SEAM(ph); ++ph;
        if (SITE(2) && RUN(ph)) TSEC_BEGIN(400 + 2, F0.lds); if (SITE(2) && RUN(ph)) for (int rep_ = 0; rep_ < NREP(2); ++rep_) { const Frame F = phase_frame(F0);
            SchedPlain S{(const char*)(F.ws + WS_HX8), (const char*)(F.ws + W_IN), 1024u, 1024u, 8, NTOK / 256, INCP / 256, F.G, F.bx};
            EpiWin E{(bf16_t*)(F.ws + WS_PX), (float*)(F.ws + T_GATE)};
            gg::gemm_phase(F.lds, S, E);
        }
        TSEC_END(400 + 99, F0.lds); SEAM(ph); ++ph;
        if (SITE(3) && RUN(ph)) TSEC_BEGIN(400 + 3, F0.lds); if (SITE(3) && RUN(ph)) for (int rep_ = 0; rep_ < NREP(3); ++rep_) { const Frame F = phase_frame(F0);
            for (int r2 = 0; r2 < NREP(16); ++r2) mla_prep(F, l);
            for (int r2 = 0; r2 < NREP(17); ++r2) { P1Regs R = ml_pass1_load(F, F.bx);
                for (int u = F.bx; u < 64 * NCHK; u += F.G) { const P1Regs Rn = ml_pass1_load(F, (u + F.G < 64 * NCHK) ? u + F.G : u); ml_pass1_unit(F, l, u, R); R = Rn; } }
            for (int r2 = 0; r2 < NREP(18); ++r2) { PoolRegs R = pool_load(F, F.bx);
                for (int u = F.bx; u < ntok / 64; u += F.G) { const PoolRegs Rn = pool_load(F, (u + F.G < ntok / 64) ? u + F.G : u); pool_unit(F, l, u, R); R = Rn; } }
            for (int r2 = 0; r2 < NREP(19); ++r2) conv_all(F, l, ntok);
            __syncthreads();
        }
        TSEC_END(400 + 99, F0.lds); SEAM(ph); ++ph;
        if (SITE(4) && RUN(ph)) TSEC_BEGIN(400 + 4, F0.lds); if (SITE(4) && RUN(ph)) for (int rep_ = 0; rep_ < NREP(4); ++rep_) { const Frame F = phase_frame(F0);
            ml_pass2(F);
            float gq = 0.f, gk = 0.f; for (int d = 0; d < 96; ++d) { gq = fmaxf(gq, fabsf(F.in[I_GQN][l * 96 + d])); gk = fmaxf(gk, fabsf(F.in[I_GKN][l * 96 + d])); }
            const bool nomax = (14.2f * gq * gk <= 64.0f);
            const int nunits = 1024 + (l == 0 ? 32 : 0);
#define ATT_UNITS(NM) for (int i = 0; ; ++i) { const int L = i * F.G + F.bx; if (L >= nunits) break; \
                if (L < 1024) { const int bh = (L >> 8) * 8 + (L & 7), qb = (L & 255) >> 3, b = bh >> 2; att2::unit<NM>(F, bh, b * 8192 + qb * 256, b * 8192 + qb * 256, 132); } \
                else { const int bh = L - 1024, b = bh >> 2; att2::unit<NM>(F, bh, NLAT + b * 256, NLAT + b * 256, 4); } }
            if (nomax) { ATT_UNITS(true) } else { ATT_UNITS(false) }
#undef ATT_UNITS
        }
        TSEC_END(400 + 99, F0.lds); SEAM(ph); ++ph;
        if (SITE(5) && RUN(ph)) TSEC_BEGIN(400 + 5, F0.lds); if (SITE(5) && RUN(ph)) for (int rep_ = 0; rep_ < NREP(5); ++rep_) { const Frame F = phase_frame(F0);
            const int npc = (l == 0) ? 66 : 64, nun = 32 * npc;
            for (int u = F.bx; u < nun; u += F.G) { const int bh = u / npc, pc = u % npc + (l == 0 ? 0 : 2); ml_pass3_unit(F, l, bh >> 2, bh & 3, pc); }
            __syncthreads();
        }
        TSEC_END(400 + 99, F0.lds); SEAM(ph); ++ph;
        {
            const int nMh = nM, pm0 = 0;
            if (SITE(6) && RUN(ph)) TSEC_BEGIN(400 + 6, F0.lds); if (SITE(6) && RUN(ph)) for (int rep_ = 0; rep_ < NREP(6); ++rep_) { const Frame F = phase_frame(F0);
                SchedYB S{(const char*)(F.ws + WS_YC), (const char*)(F.ws + W_BR), pm0, nMh, F.G, F.bx};
                EpiF8Out E{F.ws + WS_YB, 4096};
                gg::gemm_phase(F.lds, S, E);
            }
            TSEC_END(400 + 99, F0.lds); SEAM(ph); ++ph;
            if (SITE(13) && RUN(ph)) TSEC_BEGIN(400 + 13, F0.lds); if (SITE(13) && RUN(ph)) for (int rep_ = 0; rep_ < NREP(13); ++rep_) { const Frame F = phase_frame(F0);
                SchedPlain S{(const char*)(F.ws + WS_HX8) + (size_t)pm0 * 256 * 1024, (const char*)(F.ws + W_GATE), 1024u, 1024u, 8, nMh, 16, F.G, F.bx};
                EpiMerge2 E{(const unsigned char*)(F.ws + WS_YB), F.in[I_BGATE] + l * 4096, F.ws + WS_ACCM + (size_t)pm0 * 256 * 1024, 0};
                gg::gemm_phase(F.lds, S, E);
            }
            TSEC_END(400 + 99, F0.lds); SEAM(ph); ++ph;
        }
        if (SITE(7) && RUN(ph)) TSEC_BEGIN(400 + 7, F0.lds); if (SITE(7) && RUN(ph)) for (int rep_ = 0; rep_ < NREP(7); ++rep_) { const Frame F = phase_frame(F0);
            SchedPlain S{(const char*)(F.ws + WS_ACCM), (const char*)(F.ws + W_OUT), 1024u, 1024u, 8, nM, 4, F.G, F.bx};
            EpiWout E{(bf16_t*)(F.ws + WS_YC), modp(F, l, 0, 2)};
            gg::gemm_phase(F.lds, S, E);
        }
        TSEC_END(400 + 99, F0.lds); SEAM(ph); ++ph;
        if (SITE(8) && RUN(ph)) TSEC_BEGIN(400 + 8, F0.lds); if (SITE(8) && RUN(ph)) for (int rep_ = 0; rep_ < NREP(8); ++rep_) { const Frame F = phase_frame(F0); ph_norm2_route(F, l, ntok); }
        TSEC_END(400 + 99, F0.lds); SEAM(ph); ++ph;
        if (SITE(9) && RUN(ph)) TSEC_BEGIN(400 + 9, F0.lds); if (SITE(9) && RUN(ph)) for (int rep_ = 0; rep_ < NREP(9); ++rep_) { const Frame F = phase_frame(F0); ph_assign(F, ntok); }
        TSEC_END(400 + 99, F0.lds); SEAM(ph); ++ph;
        if (SITE(10) && RUN(ph)) TSEC_BEGIN(400 + 10, F0.lds); if (SITE(10) && RUN(ph)) for (int rep_ = 0; rep_ < NREP(10); ++rep_) { const Frame F = phase_frame(F0);
            int* tile_e = (int*)(F.ws + T_TILEE); const int ntiles = ld_i32_uniform(tile_e + 2047);
            LAS int* tab = (LAS int*)(F.lds + MOE_TAB_OFF); const int* rtok = (const int*)(F.ws + T_RTOK);
            __syncthreads();
            for (int i = 0; i < 28; ++i) { const int L = i * F.G + F.bx; if (L >= ntiles * 2) break; const int tile = L >> 1;
                if (F.tid == 0) tab[i] = tile_e[tile]; if (F.tid < 256) tab[256 + i * 256 + F.tid] = rtok[tile * 256 + F.tid]; }
            __syncthreads();
            SchedMoe1 S{(const char*)(F.ws + WS_HX8), (const char*)(F.ws + W_13), tab, ntiles, F.G, F.bx};
            EpiMoe1 E{F.ws + WS_AMOE, (const float*)(F.ws + T_RW)};
            gg::gemm_phase(F.lds, S, E);
        }
        TSEC_END(400 + 99, F0.lds); SEAM(ph); ++ph;
        if (SITE(11) && RUN(ph)) TSEC_BEGIN(400 + 11, F0.lds); if (SITE(11) && RUN(ph)) for (int rep_ = 0; rep_ < NREP(11); ++rep_) { const Frame F = phase_frame(F0);
            int* tile_e = (int*)(F.ws + T_TILEE); const int ntiles = ld_i32_uniform(tile_e + 2047);
            LAS int* tab = (LAS int*)(F.lds + MOE_TAB_OFF);
            __syncthreads();
            for (int i = F.tid; i < 64; i += NTHR) { const int L = i * F.G + F.bx; if (L < ntiles * 4) tab[i] = tile_e[L >> 2]; }
            __syncthreads();
            SchedMoe2 S{(const char*)(F.ws + WS_AMOE), (const char*)(F.ws + W_2), tab, ntiles, F.G, F.bx};
            EpiF8OutQ E{(unsigned char*)(F.ws + WS_YS), 1024};
            gg::gemm_phase(F.lds, S, E);
        }
        TSEC_END(400 + 99, F0.lds); SEAM(ph); ++ph;
        if (SITE(12) && RUN(ph)) TSEC_BEGIN(400 + 12, F0.lds); if (SITE(12) && RUN(ph)) for (int rep_ = 0; rep_ < NREP(12); ++rep_) { const Frame F = phase_frame(F0); if (l == 0) ph_combine<true>(F, l, 0, ntok); else ph_combine<false>(F, l, 0, ntok); }
        TSEC_END(400 + 99, F0.lds); SEAM(ph); ++ph;
    }
    if (MK_TSEC >= 0 && blockIdx.x == 0 && threadIdx.x == 0) { volatile LAS unsigned long long* q_ = (volatile LAS unsigned long long*)(F0.lds + MISC_OFF + 128);
        const unsigned long long t0 = __builtin_amdgcn_s_memrealtime(), d = q_[0] * 4ull; while (__builtin_amdgcn_s_memrealtime() - t0 < d) __builtin_amdgcn_s_sleep(8); }
#undef RUN
#undef SEAM
}

extern "C" void kernel_launch(void* const* d_in, const int* in_sizes, int n_in, void* d_out, int out_size, void* d_ws, size_t ws_size, hipStream_t stream) {
    static int grid = 0;
    if (grid == 0) {
        if (n_in != 33 || out_size != NLAT * DM || ws_size < WS_END) { fprintf(stderr, "kernel_launch: unexpected shapes (n_in %d, out %d, ws %zu < %zu)\n", n_in, out_size, ws_size, (size_t)WS_END); grid = -1; return; }
        int dev = 0, cus = 0;
        if (hipGetDevice(&dev) != hipSuccess || hipDeviceGetAttribute(&cus, hipDeviceAttributeMultiprocessorCount, dev) != hipSuccess) { grid = -1; return; }
        if (hipFuncSetAttribute((const void*)mk_fwd, hipFuncAttributeMaxDynamicSharedMemorySize, LDS_BYTES) != hipSuccess) { fprintf(stderr, "kernel_launch: hipFuncSetAttribute failed\n"); grid = -1; return; }
        int per_cu = 0;
        if (hipOccupancyMaxActiveBlocksPerMultiprocessor(&per_cu, (const void*)mk_fwd, NTHR, LDS_BYTES) != hipSuccess || per_cu < 1) fprintf(stderr, "kernel_launch: occupancy query says %d\n", per_cu);
        (void)hipGetLastError();
        if (cus < 256) { fprintf(stderr, "kernel_launch: built for a 256-CU device (got %d CUs)\n", cus); grid = -1; return; }
        grid = 256;
    }
    if (grid < 0) return;
    (void)hipMemsetAsync((char*)d_ws + WS_CTL, 0, CTL_ZERO_BYTES, stream);
    Params p{};
    for (int i = 0; i < 33; ++i) p.in[i] = (const float*)d_in[i];
    p.out = (float*)d_out; p.ws = (unsigned char*)d_ws;
#if MK_ONE_LAUNCH
    p.ph_lo = 0; p.ph_hi = PH_TOTAL;
    hipLaunchKernelGGL(mk_fwd, dim3(grid), dim3(NTHR), LDS_BYTES, stream, p);
#else
    for (int k = 0; k < PH_TOTAL; ++k) { p.ph_lo = k; p.ph_hi = k + 1; hipLaunchKernelGGL(mk_fwd, dim3(grid), dim3(NTHR), LDS_BYTES, stream, p); }
#endif
}
```

```cpp
#include <hip/hip_runtime.h>
#include <stdint.h>
#include <stdio.h>
#include <math.h>

#ifndef MK_ONE_LAUNCH
#define MK_ONE_LAUNCH 1
#endif

#define LAS __attribute__((address_space(3)))
#define GAS __attribute__((address_space(1)))
typedef unsigned short bf16_t;
typedef short bf16x8 __attribute__((ext_vector_type(8)));
typedef short s16x4 __attribute__((ext_vector_type(4)));
typedef float f32x2 __attribute__((ext_vector_type(2)));
typedef float f32x4 __attribute__((ext_vector_type(4)));
typedef float f32x16 __attribute__((ext_vector_type(16)));
typedef unsigned u32x2 __attribute__((ext_vector_type(2)));
typedef unsigned u32x4 __attribute__((ext_vector_type(4)));

constexpr int DM = 1024, NB = 8, SEQ = 8192, CTXL = 256, GRIDW = 64;
constexpr int NLAT = NB * SEQ, NCTX = NB * CTXL, NTOK = NLAT + NCTX;
constexpr int INC = 2480, INCP = 2560;
constexpr int C_ML = 0, C_G = 1024, C_MLA = 1040, C_POOL = 1456, C_CONV = 1712;
constexpr int NE = 64, NE1 = 65, TOPK = 6, NSLOT7 = 7, EFF = 256;
constexpr int NCHK = 66;
constexpr int NKT = 132;
constexpr float EPS = 1e-6f;
constexpr int NWAVES = 8, NTHR = 512;
constexpr int MOE_ROWS_MAX = 489472;
constexpr int MOE_TILES_MAX = MOE_ROWS_MAX / 256;

constexpr size_t MiB = 1u << 20;
constexpr size_t WS_CTL = 0, CTL_ZERO_BYTES = 1 * MiB;
constexpr size_t WS_MOD = 128 * 1024;
constexpr size_t WS_TAB = 1 * MiB;
constexpr size_t T_ROPE = WS_TAB;
constexpr size_t T_HIST = T_ROPE + 16384;
constexpr size_t T_TILEE = T_HIST + 65536;
constexpr size_t T_EIDX = T_TILEE + 8192;
constexpr size_t T_EW = T_EIDX + (size_t)NTOK * 6 * 4;
constexpr size_t T_SLOT = T_EW + (size_t)NTOK * 6 * 4;
constexpr size_t T_RTOK = T_SLOT + (size_t)NTOK * 8 * 4;
constexpr size_t T_RW = T_RTOK + (size_t)MOE_ROWS_MAX * 4;
constexpr size_t T_GATE = T_RW + (size_t)MOE_ROWS_MAX * 4;
constexpr size_t T_DN = T_GATE + (size_t)NTOK * 16 * 4;
constexpr size_t T_NST = T_DN + (size_t)4224 * 64 * 4;
constexpr size_t T_MLOC = T_NST + (size_t)4224 * 64 * 4;
constexpr size_t T_BEND = T_MLOC + 4224 * 4;
constexpr size_t T_MST = T_BEND + 4224 * 4;
constexpr size_t T_END = T_MST + 4224 * 4;
static_assert(T_END <= 17 * MiB, "tables");
constexpr size_t WS_WB = 17 * MiB;
constexpr size_t W_IN = WS_WB;
constexpr size_t W_GATE = W_IN + (size_t)INCP * 1024 * 2;
constexpr size_t W_BR = W_GATE + (size_t)4 * 1024 * 1024 * 2;
constexpr size_t W_OUT = W_BR + (size_t)4 * 1024 * 256 * 2;
constexpr size_t W_13 = W_OUT + (size_t)1024 * 1024 * 2;
constexpr size_t W_2 = W_13 + (size_t)NE1 * 512 * 1024 * 2;
constexpr size_t W_UQ = W_2 + (size_t)NE1 * 1024 * 256 * 2;
constexpr size_t W_UKV = W_UQ + (size_t)384 * 256 * 2;
constexpr size_t W_POOL = W_UKV + (size_t)512 * 128 * 2;
constexpr size_t W_RT = W_POOL + (size_t)4 * 64 * 64 * 2;
constexpr size_t W_END = W_RT + (size_t)64 * 1024 * 2;
static_assert(W_END <= 133 * MiB, "weights");
constexpr size_t WS_CTXS = 133 * MiB;
constexpr size_t WS_HX = 141 * MiB;
constexpr size_t WS_PX = 273 * MiB;
constexpr size_t WS_QB = 593 * MiB;
constexpr size_t WS_KT = 643 * MiB;
constexpr size_t WS_VT = 693 * MiB;
constexpr size_t WS_YC = 726 * MiB;
constexpr size_t WS_DC = 858 * MiB;
constexpr size_t WS_CST = 924 * MiB;
constexpr size_t WS_HX8 = 957 * MiB;
constexpr size_t WS_END = 1023 * MiB;
constexpr size_t WS_ACCM = WS_QB;
constexpr size_t WS_YB = WS_PX;
constexpr size_t WS_AMOE = WS_HX;
constexpr size_t WS_YS = WS_HX + 240 * MiB;
static_assert(WS_AMOE + (size_t)MOE_ROWS_MAX * 512 <= WS_YS && WS_YS + (size_t)MOE_ROWS_MAX * 1024 <= WS_HX8, "moe overlay");
static_assert(WS_YB + (size_t)NTOK * 4096 <= WS_QB && WS_ACCM + (size_t)NTOK * 2048 <= WS_YC, "merge overlay");

constexpr int CW_BAR = 4096;

constexpr int RING_BYTES = 131072;
constexpr int MISC_OFF = 160 * 1024 - 256;
constexpr int LDS_BYTES = 160 * 1024;

#ifndef MK_TSEC
#define MK_TSEC -1
#endif
#define TSEC_BEGIN(id, ldsb) do { if (MK_TSEC == (id) && blockIdx.x == 0 && threadIdx.x == 0) { volatile LAS unsigned long long* q_ = (volatile LAS unsigned long long*)((ldsb) + MISC_OFF + 128); q_[1] = __builtin_amdgcn_s_memrealtime(); } } while (0)
#define TSEC_END(id, ldsb) do { if ((MK_TSEC == (id) || ((id) == 499 && MK_TSEC >= 400 && MK_TSEC < 499)) && blockIdx.x == 0 && threadIdx.x == 0) { volatile LAS unsigned long long* q_ = (volatile LAS unsigned long long*)((ldsb) + MISC_OFF + 128); if (q_[1] != 0ull) { q_[0] += __builtin_amdgcn_s_memrealtime() - q_[1]; q_[1] = 0ull; } } } while (0)
typedef __bf16 bf16x2_t_ __attribute__((ext_vector_type(2)));
__device__ __forceinline__ unsigned pk2(float lo, float hi) { const f32x2 v = {lo, hi}; return __builtin_bit_cast(unsigned, __builtin_convertvector(v, bf16x2_t_)); }
__device__ __forceinline__ unsigned f2bf(float f) { return pk2(f, f) & 0xffffu; }
__device__ __forceinline__ float bf2f(unsigned short b) { return __builtin_bit_cast(float, ((unsigned)b) << 16); }
__device__ __forceinline__ float bflo(unsigned w) { return __builtin_bit_cast(float, w << 16); }
__device__ __forceinline__ float bfhi(unsigned w) { return __builtin_bit_cast(float, w & 0xffff0000u); }
__device__ __forceinline__ unsigned cvt_pk_bf16(float lo, float hi) { unsigned r; asm volatile("v_cvt_pk_bf16_f32 %0, %1, %2" : "=v"(r) : "v"(lo), "v"(hi)); return r; }
__device__ __forceinline__ unsigned char f2f8(float a) { return (unsigned char)(__builtin_amdgcn_cvt_pk_fp8_f32(a, a, 0, false) & 0xff); }
__device__ __forceinline__ unsigned pk4_fp8(float a, float b, float c, float d) { int r = __builtin_amdgcn_cvt_pk_fp8_f32(a, b, 0, false); r = __builtin_amdgcn_cvt_pk_fp8_f32(c, d, r, true); return (unsigned)r; }
__device__ __forceinline__ float sigmoidf_(float x) { return __builtin_amdgcn_rcpf(1.0f + __builtin_amdgcn_exp2f(x * -1.4426950408889634f)); }
template <int O> __device__ __forceinline__ float xor_lane(float v) { return __builtin_bit_cast(float, __builtin_amdgcn_ds_swizzle(__builtin_bit_cast(int, v), 0x1f | (O << 10))); }
__device__ __forceinline__ float half_sum(float v) { v += xor_lane<1>(v); v += xor_lane<2>(v); v += xor_lane<4>(v); v += xor_lane<8>(v); v += xor_lane<16>(v); return v; }
__device__ __forceinline__ float half_max(float v) { v = fmaxf(v, xor_lane<1>(v)); v = fmaxf(v, xor_lane<2>(v)); v = fmaxf(v, xor_lane<4>(v)); v = fmaxf(v, xor_lane<8>(v)); v = fmaxf(v, xor_lane<16>(v)); return v; }
__device__ __forceinline__ float wave_sum(float v) { v = half_sum(v); auto rr = __builtin_amdgcn_permlane32_swap(__builtin_bit_cast(unsigned, v), __builtin_bit_cast(unsigned, v), false, false);
    return __builtin_bit_cast(float, (unsigned)rr[0]) + __builtin_bit_cast(float, (unsigned)rr[1]); }
__device__ __forceinline__ float wave_max(float v) { v = half_max(v); auto rr = __builtin_amdgcn_permlane32_swap(__builtin_bit_cast(unsigned, v), __builtin_bit_cast(unsigned, v), false, false);
    return fmaxf(__builtin_bit_cast(float, (unsigned)rr[0]), __builtin_bit_cast(float, (unsigned)rr[1])); }
__device__ __forceinline__ float lane_up(float v, int o, int lane) { return __builtin_bit_cast(float, __builtin_amdgcn_ds_bpermute(((lane - o) & 63) << 2, __builtin_bit_cast(int, v))); }
__device__ __forceinline__ float lane_bcast(float v, int src) { return __builtin_bit_cast(float, __builtin_amdgcn_readlane(__builtin_bit_cast(int, v), src)); }
__device__ __forceinline__ float frcp(float x) { return __builtin_amdgcn_rcpf(x); }
__device__ __forceinline__ float frsq(float x) { return __builtin_amdgcn_rsqf(x); }
#define LDS_WAIT() asm volatile("s_waitcnt lgkmcnt(0)" ::: "memory")
#define LDS_BAR() asm volatile("s_waitcnt lgkmcnt(0)\n\ts_barrier" ::: "memory")
#define VM_WAIT() asm volatile("s_waitcnt vmcnt(0)" ::: "memory")

#define XB_TMO      128
#define XB_XCNT(j)  (256  + 64 * (j))
#define XB_XSUB(j)  (1280 + 64 * (j))
#define XB_XGEN(j)  (2304 + 64 * (j))
#define XB_TOP      3328
#define XB_TOPGEN   3392
#define XCD_BAR_WORDS 3456
#define XB_SPIN_CAP (1u << 22)

__device__ __forceinline__ unsigned xb_ld(unsigned* p)              { return __hip_atomic_load(p, __ATOMIC_RELAXED, __HIP_MEMORY_SCOPE_AGENT); }
__device__ __forceinline__ unsigned xb_add(unsigned* p, unsigned v) { return __hip_atomic_fetch_add(p, v, __ATOMIC_RELAXED, __HIP_MEMORY_SCOPE_AGENT); }
__device__ __forceinline__ unsigned xb_xcc_id() { return (unsigned)__builtin_amdgcn_s_getreg((3 << 11) | 20) & 0xFu; }
#define XB_SPIN(cond, bar) do { unsigned _sp = 0; while (cond) { __builtin_amdgcn_s_sleep(1); \
    if ((++_sp & 255u) == 0u) { if (xb_ld(&(bar)[XB_TMO])) break; if (_sp > XB_SPIN_CAP) { atomicAdd(&(bar)[XB_TMO], 1u); break; } } } } while (0)

struct XcdBarrier { unsigned* bar; unsigned x; volatile LAS unsigned* st; };

__device__ __forceinline__ XcdBarrier xcd_barrier_post(unsigned* bar, volatile LAS unsigned* st) {
    XcdBarrier b; b.bar = bar; b.x = xb_xcc_id(); b.st = st;
    if (threadIdx.x == 0) (void)xb_add(&bar[XB_XCNT(b.x)], 1u);
    return b;
}
__device__ __forceinline__ void xcd_barrier_complete(unsigned* bar, unsigned x, unsigned& nloc, unsigned& nx) {
    const unsigned G = gridDim.x * gridDim.y * gridDim.z;
    unsigned sum, cnt, mine, sp = 0u;
    for (;;) {
        sum = 0u; cnt = 0u; mine = 0u;
#pragma unroll
        for (unsigned j = 0; j < 16; ++j) { const unsigned c = xb_ld(&bar[XB_XCNT(j)]); sum += c; cnt += (c > 0u) ? 1u : 0u; mine = (j == x) ? c : mine; }
        if (sum == G) break;
        __builtin_amdgcn_s_sleep(1);
        if ((++sp & 255u) == 0u) { if (xb_ld(&bar[XB_TMO])) break; if (sp > XB_SPIN_CAP) { atomicAdd(&bar[XB_TMO], 1u); break; } }
    }
    nloc = mine > 0u ? mine : 1u; nx = cnt > 0u ? cnt : 1u;
}
__device__ __forceinline__ void xcd_barrier(const XcdBarrier& b) {
    asm volatile("s_waitcnt vmcnt(0)" ::: "memory");
    __syncthreads();
    if (threadIdx.x == 0) {
        unsigned* bar = b.bar;
        __builtin_amdgcn_s_waitcnt(0);
        unsigned nloc = b.st[0], nx = b.st[1];
        if (nloc == 0u) { xcd_barrier_complete(bar, b.x, nloc, nx); b.st[0] = nloc; b.st[1] = nx; }
        const unsigned old = xb_add(&bar[XB_XSUB(b.x)], 1u);
        const unsigned gen = old / nloc;
        if (old + 1u == (gen + 1u) * nloc) {
            __builtin_amdgcn_fence(__ATOMIC_RELEASE, "agent");
            asm volatile("s_waitcnt vmcnt(0)" ::: "memory");
            const unsigned og = xb_add(&bar[XB_TOP], 1u);
            const unsigned tg = og / nx;
            if (og + 1u == (tg + 1u) * nx) xb_add(&bar[XB_TOPGEN], 1u);
            else XB_SPIN(xb_ld(&bar[XB_TOPGEN]) == tg, bar);
            __builtin_amdgcn_fence(__ATOMIC_ACQUIRE, "agent");
            xb_add(&bar[XB_XGEN(b.x)], 1u);
            asm volatile("s_waitcnt vmcnt(0)" ::: "memory");
        } else {
            XB_SPIN(xb_ld(&bar[XB_XGEN(b.x)]) == gen, bar);
            __builtin_amdgcn_fence(__ATOMIC_ACQUIRE, "agent");
            asm volatile("s_waitcnt vmcnt(0)" ::: "memory");
        }
    }
    __syncthreads();
}

struct Params { const float* in[33]; float* out; unsigned char* ws; int ph_lo, ph_hi; };

struct Frame {
    LAS unsigned char* lds;
    unsigned char* ws;
    const float* const* in;
    float* out;
    int tid, lane, wave, bx, G;
};
enum { I_X = 0, I_C, I_CTX, I_CCTX, I_WMOD, I_BMOD, I_GMIX, I_GFFN, I_WIN, I_MLGB, I_MLHG, I_GCQ, I_GCKV, I_WUQ, I_WUKV, I_GQN, I_GKN, I_POOLW, I_POOLS,
       I_CONVW, I_CONVB, I_WGATE, I_BGATE, I_WBR, I_WOUT, I_WRT, I_BRT, I_W1, I_W3, I_W2, I_WS1, I_WS3, I_WS2 };

__device__ __forceinline__ const float* modp(const Frame& F, int l, int r, int which) { return (const float*)(F.ws + WS_MOD) + ((size_t)(l * 9 + r)) * 6144 + which * 1024; }
__device__ __forceinline__ int mod_row_of(int row) { return row < NLAT ? (row >> 13) : 8; }

__device__ __forceinline__ f32x4 up4_fp8(unsigned w) { const f32x2 lo = __builtin_amdgcn_cvt_pk_f32_fp8((int)w, false), hi = __builtin_amdgcn_cvt_pk_f32_fp8((int)w, true); return (f32x4){lo.x, lo.y, hi.x, hi.y}; }
namespace gg {
typedef int v4i_t __attribute__((ext_vector_type(4)));
constexpr int BM = 256, BK = 64, HALF = 128, HTB = HALF * BK * 2, STAGE_BYTES = 8 * HTB;
__device__ __forceinline__ int lds_byte(int r, int c) { const int st = (r >> 4) * 2 + (c >> 5), rr = r & 15, cc = c & 31, ob = rr * 64 + cc * 2; return st * 1024 + (ob ^ (((ob >> 9) & 1) << 5)); }
__device__ __forceinline__ void stage_rc(int b, int& R, int& C) { const int st = b / 1024, sb = b % 1024, swz = sb ^ (((sb >> 9) & 1) << 5); R = (st >> 1) * 16 + swz / 64; C = (st & 1) * 32 + (swz % 64) / 2; }
__device__ __forceinline__ int perm32(int rho) { const int n = rho >> 4, i = rho & 15; return 8 * (i >> 2) + 4 * n + (i & 3); }

struct Unit {
    const char* A; const char* B;
    unsigned lda, ldb;
    int nt;
    int ridx_off;
    int p0, p1, p2;
};

template <class E, class = void> struct ZPeel { static constexpr bool v = false; };
template <class E> struct ZPeel<E, decltype((void)E::ZPEEL)> { static constexpr bool v = E::ZPEEL; };
template <class Epi, class Sched>
__device__ __forceinline__ void gemm_phase(LAS unsigned char* lds, const Sched& S, const Epi& E) {
    int tid_ = threadIdx.x; asm volatile("" : "+v"(tid_));
    const int tid = tid_, wid = __builtin_amdgcn_readfirstlane(tid >> 6), lane = tid & 63, wr = wid >> 2, wc = wid & 3, fr = lane & 15, fq = lane >> 4;
    const size_t kstep = (size_t)(BK * 2);
    const unsigned ldsw = (unsigned)wid * 1024u;
    const int aoff = lds_byte(wr * 64 + fr, fq * 8), boff = lds_byte(wc * 32 + fr, fq * 8);
#define GG_SA(b, h) (((b) * 2 + (h)) * HTB)
#define GG_SB(b, h) ((4 + (b) * 2 + (h)) * HTB)
#define GG_STAGE(bufoff, gbase, v0, v1) do { \
        __builtin_amdgcn_global_load_lds((const unsigned*)((const char*)(gbase) + (v0)), (LAS unsigned*)(lds + (bufoff) + ldsw), 16, 0, 0); \
        __builtin_amdgcn_global_load_lds((const unsigned*)((const char*)(gbase) + (v1)), (LAS unsigned*)(lds + (bufoff) + ldsw + 8192), 16, 0, 0); } while (0)
#define GG_LDA(dst, b, h) do { _Pragma("unroll") for (int m = 0; m < 4; ++m) _Pragma("unroll") for (int k = 0; k < 2; ++k) dst[m][k] = *(const LAS bf16x8*)(lds + GG_SA(b, h) + aoff + m * 2048 + k * 1024); } while (0)
#define GG_LDB(dst, b, h) do { _Pragma("unroll") for (int n = 0; n < 2; ++n) _Pragma("unroll") for (int k = 0; k < 2; ++k) dst[n][k] = *(const LAS bf16x8*)(lds + GG_SB(b, h) + boff + n * 2048 + k * 1024); } while (0)
#define GG_MMA(ai, bj, At, Bt) do { __builtin_amdgcn_s_setprio(1); _Pragma("unroll") for (int m = 0; m < 4; ++m) _Pragma("unroll") for (int n = 0; n < 2; ++n) _Pragma("unroll") for (int k = 0; k < 2; ++k) \
        acc[ai][bj][m][n] = __builtin_amdgcn_mfma_f32_16x16x32_bf16(Bt[n][k], At[m][k], acc[ai][bj][m][n], 0, 0, 0); __builtin_amdgcn_s_setprio(0); } while (0)
#define GG_CAT8(x, y) __builtin_shufflevector(__builtin_bit_cast(v4i_t, x), __builtin_bit_cast(v4i_t, y), 0, 1, 2, 3, 4, 5, 6, 7)
#define GG_MMA8(ai, bj, At, Bt) do { __builtin_amdgcn_s_setprio(1); _Pragma("unroll") for (int m = 0; m < 4; ++m) _Pragma("unroll") for (int n = 0; n < 2; ++n) \
        acc[ai][bj][m][n] = __builtin_amdgcn_mfma_scale_f32_16x16x128_f8f6f4(GG_CAT8(Bt[n][0], Bt[n][1]), GG_CAT8(At[m][0], At[m][1]), acc[ai][bj][m][n], 0, 0, 0, (int)Epi::SCB, 0, 0x7f7f7f7f); __builtin_amdgcn_s_setprio(0); } while (0)
#define GG_MM(ai, bj, At, Bt) do { if constexpr (Epi::FP8) GG_MMA8(ai, bj, At, Bt); else GG_MMA(ai, bj, At, Bt); } while (0)
#define GG_MMZ8(ai, bj, At, Bt) do { __builtin_amdgcn_s_setprio(1); _Pragma("unroll") for (int m = 0; m < 4; ++m) _Pragma("unroll") for (int n = 0; n < 2; ++n) \
        acc[ai][bj][m][n] = __builtin_amdgcn_mfma_scale_f32_16x16x128_f8f6f4(GG_CAT8(Bt[n][0], Bt[n][1]), GG_CAT8(At[m][0], At[m][1]), (f32x4){0.f, 0.f, 0.f, 0.f}, 0, 0, 0, (int)Epi::SCB, 0, 0x7f7f7f7f); __builtin_amdgcn_s_setprio(0); } while (0)
#define GG_MM1(ai, bj, At, Bt) do { if constexpr (ZP && Epi::FP8) { if (t == 0) GG_MMZ8(ai, bj, At, Bt); else GG_MMA8(ai, bj, At, Bt); } else GG_MM(ai, bj, At, Bt); } while (0)
#define GG_WAIT_V(n) asm volatile("s_waitcnt vmcnt(" #n ")" ::: "memory")
#define GG_WAIT_L(n) asm volatile("s_waitcnt lgkmcnt(" #n ")" ::: "memory")
#define GG_BAR __builtin_amdgcn_s_barrier()
#define GG_SCHED __builtin_amdgcn_sched_barrier(0)
#define GG_OFFS(u) do { int R0_, C0_, R1_, C1_; stage_rc(tid * 16, R0_, C0_); stage_rc(tid * 16 + 8192, R1_, C1_); \
        if (Sched::GATHER) { const LAS int* rl_ = (const LAS int*)(lds + (u).ridx_off); vA0 = (unsigned)rl_[R0_] * (u).lda + C0_ * 2; vA1 = (unsigned)rl_[R1_] * (u).lda + C1_ * 2; \
                             vA2 = (unsigned)rl_[128 + R0_] * (u).lda + C0_ * 2; vA3 = (unsigned)rl_[128 + R1_] * (u).lda + C1_ * 2; hA = 0; } \
        else { vA0 = (unsigned)R0_ * (u).lda + C0_ * 2; vA1 = (unsigned)R1_ * (u).lda + C1_ * 2; vA2 = vA0; vA3 = vA1; hA = (size_t)128 * (u).lda; } \
        const int Rb0_ = Epi::PERM ? ((R0_ & ~31) + perm32(R0_ & 31)) : R0_, Rb1_ = Epi::PERM ? ((R1_ & ~31) + perm32(R1_ & 31)) : R1_; \
        vB0 = (unsigned)Rb0_ * (u).ldb + C0_ * 2; vB1 = (unsigned)Rb1_ * (u).ldb + C1_ * 2; hB = (size_t)128 * (u).ldb; } while (0)
    Unit cur, nxt; int ui = 0;
    if (!S.next(0, cur)) return;
    constexpr bool ZP = ZPeel<Epi>::v;
    f32x4 acc[2][2][4][2];
    if constexpr (!ZP) {
#pragma unroll
    for (int a = 0; a < 2; ++a)
#pragma unroll
        for (int b = 0; b < 2; ++b)
#pragma unroll
            for (int m = 0; m < 4; ++m)
#pragma unroll
                for (int n = 0; n < 2; ++n) acc[a][b][m][n] = (f32x4){0.f, 0.f, 0.f, 0.f};
    }
    bf16x8 At[4][2], B0[2][2], B1[2][2];
    unsigned vA0, vA1, vA2, vA3, vB0, vB1; size_t hA, hB;
    GG_OFFS(cur);
    const char* cA = cur.A; const char* cB = cur.B;
    GG_STAGE(GG_SB(0, 0), cB, vB0, vB1); GG_STAGE(GG_SB(0, 1), cB + hB, vB0, vB1); GG_STAGE(GG_SA(0, 0), cA, vA0, vA1); GG_STAGE(GG_SA(0, 1), cA + hA, vA2, vA3);
    if (wr == 1) GG_BAR;
    GG_WAIT_V(2); GG_BAR;
    GG_STAGE(GG_SB(1, 0), cB + kstep, vB0, vB1); GG_STAGE(GG_SA(1, 0), cA + kstep, vA0, vA1); GG_STAGE(GG_SB(1, 1), cB + hB + kstep, vB0, vB1);
    GG_WAIT_V(6); GG_BAR;
    for (;;) {
        const bool has_next = S.next(ui + 1, nxt);
        TSEC_BEGIN(100 + Epi::TID, lds);
        int nt_ = cur.nt; asm volatile("" : "+s"(nt_)); const int nt = nt_;
#pragma unroll 1
        for (int t = 0; t < nt; t += 2) {
            const bool last = (t == nt - 2);
            const char* a1 = cA + (size_t)(t + 1) * kstep;
            GG_LDB(B0, 0, 0); GG_LDB(B1, 0, 1); GG_SCHED; GG_LDA(At, 0, 0); GG_STAGE(GG_SA(1, 1), a1 + hA, vA2, vA3);
            GG_WAIT_V(8); GG_WAIT_L(0); GG_BAR; GG_MM1(0, 0, At, B0); GG_MM1(0, 1, At, B1); GG_BAR; GG_SCHED;
            if (last) { if (has_next) { GG_OFFS(nxt); cA = nxt.A - (size_t)nt * kstep; cB = nxt.B - (size_t)nt * kstep; } else { cA -= (size_t)nt * kstep; cB -= (size_t)nt * kstep; } }
            const char* a2 = cA + (size_t)(t + 2) * kstep; const char* b2 = cB + (size_t)(t + 2) * kstep; const char* a3 = a2 + kstep; const char* b3 = b2 + kstep;
            GG_LDA(At, 0, 1); GG_STAGE(GG_SB(0, 0), b2, vB0, vB1); GG_STAGE(GG_SB(0, 1), b2 + hB, vB0, vB1); GG_STAGE(GG_SA(0, 0), a2, vA0, vA1);
            GG_WAIT_V(8); GG_WAIT_L(0); GG_BAR; GG_MM1(1, 0, At, B0); GG_MM1(1, 1, At, B1); GG_BAR; GG_SCHED;
            GG_LDB(B0, 1, 0); GG_LDB(B1, 1, 1); GG_SCHED; GG_LDA(At, 1, 0); GG_STAGE(GG_SA(0, 1), a2 + hA, vA2, vA3);
            GG_WAIT_V(8); GG_WAIT_L(0); GG_BAR; GG_MM(0, 0, At, B0); GG_MM(0, 1, At, B1); GG_BAR; GG_SCHED;
            GG_LDA(At, 1, 1); GG_STAGE(GG_SB(1, 0), b3, vB0, vB1); GG_STAGE(GG_SB(1, 1), b3 + hB, vB0, vB1); GG_STAGE(GG_SA(1, 0), a3, vA0, vA1);
            GG_WAIT_V(8); GG_WAIT_L(0); GG_BAR; GG_MM(1, 0, At, B0); GG_MM(1, 1, At, B1); GG_BAR; GG_SCHED;
        }
        cA += (size_t)nt * kstep; cB += (size_t)nt * kstep;
        TSEC_END(100 + Epi::TID, lds);
        if (wr == 0) GG_BAR;
        TSEC_BEGIN(200 + Epi::TID, lds); { int t2_ = threadIdx.x; asm volatile("" : "+v"(t2_)); E(acc, cur, wr, wc, t2_ & 15, (t2_ & 63) >> 4); } TSEC_END(200 + Epi::TID, lds);
        if (!has_next) break;
        if constexpr (!ZP)
#pragma unroll
        for (int a = 0; a < 2; ++a)
#pragma unroll
            for (int b = 0; b < 2; ++b)
#pragma unroll
                for (int m = 0; m < 4; ++m)
#pragma unroll
                    for (int n = 0; n < 2; ++n) acc[a][b][m][n] = (f32x4){0.f, 0.f, 0.f, 0.f};
        cur = nxt; ++ui;
        if (wr == 1) GG_BAR;
    }
    GG_WAIT_V(0);
    GG_BAR;
#undef GG_SA
#undef GG_SB
#undef GG_STAGE
#undef GG_LDA
#undef GG_LDB
#undef GG_MMA
#undef GG_MMA8
#undef GG_MM
#undef GG_MM1
#undef GG_MMZ8
#undef GG_CAT8
#undef GG_WAIT_V
#undef GG_WAIT_L
#undef GG_BAR
#undef GG_SCHED
#undef GG_OFFS
}
}

__device__ __forceinline__ int ld_i32_uniform(const int* p) { return __builtin_amdgcn_readfirstlane(__hip_atomic_load(p, __ATOMIC_RELAXED, __HIP_MEMORY_SCOPE_AGENT)); }
__device__ __forceinline__ void tile_order(int L, int nM, int nN, int& pm, int& pn) {
    const int nwg = nM * nN; int wgid = L;
    { const int q = nwg / 8, r = nwg % 8, xcd = wgid % 8, off = wgid / 8; wgid = (xcd < r ? xcd * (q + 1) : r * (q + 1) + (xcd - r) * q) + off; }
    const int nig = 8 * nN, gid = wgid / nig, fm = gid * 8, gsz = (nM - fm) < 8 ? (nM - fm) : 8;
    pm = fm + ((wgid % nig) % gsz); pn = (wgid % nig) / gsz;
}
struct SchedPlain {
    static constexpr bool GATHER = false;
    const char* A; const char* B; unsigned lda, ldb; int nt, nM, nN, G, c;
    __device__ __forceinline__ bool next(int i, gg::Unit& u) const {
        const int L = i * G + c; if (L >= nM * nN) return false;
        int pm, pn; tile_order(L, nM, nN, pm, pn);
        u.A = A + (size_t)pm * 256 * lda; u.B = B + (size_t)pn * 256 * ldb; u.lda = lda; u.ldb = ldb; u.nt = nt; u.ridx_off = 0; u.p0 = pm; u.p1 = pn; u.p2 = 0; return true;
    }
};
struct EpiWin {
    static constexpr bool PERM = true, FP8 = true; static constexpr int TID = 0; static constexpr unsigned SCB = 0x79797979u;
    bf16_t* px; float* gate;
    __device__ __forceinline__ void operator()(const f32x4 (&acc)[2][2][4][2], const gg::Unit& u, int wr, int wc, int fr, int fq) const {
        const int row0 = u.p0 * 256 + wr * 64 + fr;
#pragma unroll
        for (int bj = 0; bj < 2; ++bj) {
            const int c0 = u.p1 * 256 + bj * 128 + wc * 32 + 8 * fq;
            if (c0 < INC) {
                const bool isg = (c0 >= C_G && c0 < C_MLA);
#pragma unroll
                for (int ai = 0; ai < 2; ++ai)
#pragma unroll
                    for (int m = 0; m < 4; ++m) { const int row = row0 + ai * 128 + m * 16; const f32x4 v0 = acc[ai][bj][m][0], v1 = acc[ai][bj][m][1];
                        u32x4 w; w.x = cvt_pk_bf16(v0[0], v0[1]); w.y = cvt_pk_bf16(v0[2], v0[3]); w.z = cvt_pk_bf16(v1[0], v1[1]); w.w = cvt_pk_bf16(v1[2], v1[3]);
                        *(u32x4*)(px + (size_t)row * INC + c0) = w;
                        if (isg) { float* gp = gate + (size_t)row * 16 + (c0 - C_G); *(f32x4*)gp = v0; *(f32x4*)(gp + 4) = v1; } }
            }
        }
    }
};
struct SchedYB {
    static constexpr bool GATHER = false;
    const char* yc; const char* wb; int pm0, nMh, G, c;
    __device__ __forceinline__ bool next(int i, gg::Unit& u) const {
        const int L = i * G + c; if (L >= nMh * 16) return false;
        int pm, q; tile_order(L, nMh, 16, pm, q); const int br = q >> 2, pn = q & 3;
        u.A = yc + (size_t)(pm0 + pm) * 256 * 2048 + br * 512; u.lda = 2048; u.B = wb + (size_t)br * (1024 * 512) + (size_t)pn * 256 * 512; u.ldb = 512; u.nt = 4; u.ridx_off = 0; u.p0 = pm; u.p1 = q; u.p2 = 0; return true;
    }
};
struct EpiMerge2 {
    static constexpr bool PERM = false, FP8 = true; static constexpr int TID = 4; static constexpr unsigned SCB = 0x79797979u;
    const unsigned char* yb; const float* bgate; unsigned char* accm; int pm0;
    __device__ __forceinline__ void operator()(const f32x4 (&acc)[2][2][4][2], const gg::Unit& u, int wr, int wc, int fr, int fq) const {
        const int c = u.p1 * 64 + 16 * wc + 4 * fq, r0 = wr * 64 + fr;
        constexpr float NL2E = -1.4426950408889634f;
        f32x4 bv[2][2];
#pragma unroll
        for (int bj = 0; bj < 2; ++bj)
#pragma unroll
            for (int n = 0; n < 2; ++n) bv[bj][n] = *(const f32x4*)(bgate + (2 * bj + n) * 1024 + c) * NL2E;
        u32x4 yw[2][4];
#pragma unroll
        for (int ai = 0; ai < 2; ++ai)
#pragma unroll
            for (int m = 0; m < 4; ++m) { const unsigned char* yr = yb + (size_t)((u.p0 - pm0) * 256 + r0 + ai * 128 + m * 16) * 4096 + c;
                yw[ai][m] = (u32x4){*(const unsigned*)yr, *(const unsigned*)(yr + 1024), *(const unsigned*)(yr + 2048), *(const unsigned*)(yr + 3072)}; }
#pragma unroll
        for (int ai = 0; ai < 2; ++ai) {
#pragma unroll
            for (int m = 0; m < 4; ++m) {
                f32x4 t = {0.f, 0.f, 0.f, 0.f};
#pragma unroll
                for (int bj = 0; bj < 2; ++bj)
#pragma unroll
                    for (int n = 0; n < 2; ++n) { const f32x4 y = up4_fp8(yw[ai][m][2 * bj + n]); const f32x4 x = acc[ai][bj][m][n] * NL2E + bv[bj][n];
                        const f32x4 d = (f32x4){__builtin_amdgcn_exp2f(x[0]), __builtin_amdgcn_exp2f(x[1]), __builtin_amdgcn_exp2f(x[2]), __builtin_amdgcn_exp2f(x[3])} + 1.0f;
                        t += (f32x4){__builtin_amdgcn_rcpf(d[0]), __builtin_amdgcn_rcpf(d[1]), __builtin_amdgcn_rcpf(d[2]), __builtin_amdgcn_rcpf(d[3])} * y; }
                *(unsigned*)(accm + (size_t)(u.p0 * 256 + r0 + ai * 128 + m * 16) * 1024 + c) = pk4_fp8(t[0], t[1], t[2], t[3]); } }
    }
};
struct EpiWout {
    static constexpr bool PERM = true, FP8 = true; static constexpr int TID = 1; static constexpr unsigned SCB = 0x79797979u;
    bf16_t* mrg; const float* gt;
    __device__ __forceinline__ void operator()(const f32x4 (&acc)[2][2][4][2], const gg::Unit& u, int wr, int wc, int fr, int fq) const {
        const int pm = u.p0; const int mrow = pm >= 256 ? 8 : (pm >> 5);
        const float* g = gt + (size_t)mrow * 6144;
        const int row0 = pm * 256 + wr * 64 + fr, col0 = u.p1 * 256 + wc * 32 + 8 * fq;
#pragma unroll
        for (int bj = 0; bj < 2; ++bj) { const f32x4 g0 = *(const f32x4*)(g + col0 + bj * 128), g1 = *(const f32x4*)(g + col0 + bj * 128 + 4);
#pragma unroll
            for (int ai = 0; ai < 2; ++ai)
#pragma unroll
                for (int m = 0; m < 4; ++m) { const f32x4 v0 = acc[ai][bj][m][0] * g0, v1 = acc[ai][bj][m][1] * g1;
                    u32x4 w; w.x = cvt_pk_bf16(v0[0], v0[1]); w.y = cvt_pk_bf16(v0[2], v0[3]); w.z = cvt_pk_bf16(v1[0], v1[1]); w.w = cvt_pk_bf16(v1[2], v1[3]);
                    *(u32x4*)(mrg + (size_t)(row0 + ai * 128 + m * 16) * 1024 + col0 + bj * 128) = w; } }
    }
};
constexpr int MOE_TAB_OFF = RING_BYTES, MOE_RIDX_OFF = RING_BYTES + 1024;
struct SchedMoe1 {
    static constexpr bool GATHER = true;
    const char* hx2; const char* w13; const LAS int* tab; int ntiles, G, c;
    __device__ __forceinline__ bool next(int i, gg::Unit& u) const {
        const int L = i * G + c; if (L >= ntiles * 2) return false;
        const int tile = L >> 1, pn = L & 1, e = __builtin_amdgcn_readfirstlane(tab[i]);
        u.A = hx2; u.lda = 1024; u.ridx_off = MOE_RIDX_OFF + i * 1024; u.B = w13 + (size_t)e * (512 * 1024) + (size_t)pn * 256 * 1024; u.ldb = 1024; u.nt = 8; u.p0 = tile; u.p1 = pn; u.p2 = e; return true;
    }
};
struct EpiMoe1 {
    static constexpr bool PERM = true, FP8 = true; static constexpr int TID = 5; static constexpr unsigned SCB = 0x79797979u;
    unsigned char* a; const float* roww;
    __device__ __forceinline__ void operator()(const f32x4 (&acc)[2][2][4][2], const gg::Unit& u, int wr, int wc, int fr, int fq) const {
        const int row0 = u.p0 * 256 + wr * 64 + fr, col = u.p1 * 128 + wc * 32 + 8 * fq;
#pragma unroll
        for (int ai = 0; ai < 2; ++ai)
#pragma unroll
            for (int m = 0; m < 4; ++m) { const int row = row0 + ai * 128 + m * 16; const float rw = roww[row] * 8.0f;
                float t[8];
#pragma unroll
                for (int n = 0; n < 2; ++n)
#pragma unroll
                    for (int j = 0; j < 4; ++j) { const float g1 = acc[ai][0][m][n][j], g3 = acc[ai][1][m][n][j]; t[n * 4 + j] = g1 * sigmoidf_(g1) * g3 * rw; }
                *(u32x2*)(a + (size_t)row * 256 + col) = (u32x2){pk4_fp8(t[0], t[1], t[2], t[3]), pk4_fp8(t[4], t[5], t[6], t[7])}; }
    }
};
struct SchedMoe2 {
    static constexpr bool GATHER = false;
    const char* a; const char* w2; const LAS int* tab; int ntiles, G, c;
    __device__ __forceinline__ bool next(int i, gg::Unit& u) const {
        const int L = i * G + c; if (L >= ntiles * 4) return false;
        const int tile = L >> 2, pn = L & 3, e = __builtin_amdgcn_readfirstlane(tab[i]);
        u.A = a + (size_t)tile * 256 * 256; u.lda = 256; u.ridx_off = 0; u.B = w2 + (size_t)e * (1024 * 256) + (size_t)pn * 256 * 256; u.ldb = 256; u.nt = 2; u.p0 = tile; u.p1 = pn; u.p2 = e; return true;
    }
};
struct EpiBf16Plain {
    static constexpr bool PERM = true, FP8 = false; static constexpr int TID = 2; static constexpr unsigned SCB = 0x7f7f7f7fu;
    bf16_t* O; int ldc;
    __device__ __forceinline__ void operator()(const f32x4 (&acc)[2][2][4][2], const gg::Unit& u, int wr, int wc, int fr, int fq) const {
        const int row0 = u.p0 * 256 + wr * 64 + fr, col0 = u.p1 * 256 + wc * 32 + 8 * fq;
#pragma unroll
        for (int ai = 0; ai < 2; ++ai)
#pragma unroll
            for (int m = 0; m < 4; ++m)
#pragma unroll
                for (int bj = 0; bj < 2; ++bj) { const f32x4 v0 = acc[ai][bj][m][0], v1 = acc[ai][bj][m][1];
                    u32x4 w; w.x = cvt_pk_bf16(v0[0], v0[1]); w.y = cvt_pk_bf16(v0[2], v0[3]); w.z = cvt_pk_bf16(v1[0], v1[1]); w.w = cvt_pk_bf16(v1[2], v1[3]);
                    *(u32x4*)(O + (size_t)(row0 + ai * 128 + m * 16) * ldc + col0 + bj * 128) = w; }
    }
};
struct EpiF8Out {
    static constexpr bool PERM = true, FP8 = false; static constexpr int TID = 6; static constexpr unsigned SCB = 0x7f7f7f7fu;
    unsigned char* O; int ldc;
    __device__ __forceinline__ void operator()(const f32x4 (&acc)[2][2][4][2], const gg::Unit& u, int wr, int wc, int fr, int fq) const {
        const int row0 = u.p0 * 256 + wr * 64 + fr, col0 = u.p1 * 256 + wc * 32 + 8 * fq;
#pragma unroll
        for (int ai = 0; ai < 2; ++ai)
#pragma unroll
            for (int m = 0; m < 4; ++m)
#pragma unroll
                for (int bj = 0; bj < 2; ++bj) { const f32x4 v0 = acc[ai][bj][m][0], v1 = acc[ai][bj][m][1];
                    *(u32x2*)(O + (size_t)(row0 + ai * 128 + m * 16) * ldc + col0 + bj * 128) = (u32x2){pk4_fp8(v0[0], v0[1], v0[2], v0[3]), pk4_fp8(v1[0], v1[1], v1[2], v1[3])}; }
    }
};
struct EpiF8OutQ {
    static constexpr bool PERM = true, FP8 = true, ZPEEL = true; static constexpr int TID = 7; static constexpr unsigned SCB = 0x77777777u;
    unsigned char* O; int ldc;
    __device__ __forceinline__ void operator()(const f32x4 (&acc)[2][2][4][2], const gg::Unit& u, int wr, int wc, int fr, int fq) const {
        const int row0 = u.p0 * 256 + wr * 64 + fr, col0 = u.p1 * 256 + wc * 32 + 8 * fq;
#pragma unroll
        for (int ai = 0; ai < 2; ++ai)
#pragma unroll
            for (int m = 0; m < 4; ++m)
#pragma unroll
                for (int bj = 0; bj < 2; ++bj) { const f32x4 v0 = acc[ai][bj][m][0], v1 = acc[ai][bj][m][1];
                    *(u32x2*)(O + (size_t)(row0 + ai * 128 + m * 16) * ldc + col0 + bj * 128) = (u32x2){pk4_fp8(v0[0], v0[1], v0[2], v0[3]), pk4_fp8(v1[0], v1[1], v1[2], v1[3])}; }
    }
};
struct EpiBf16F8 {
    static constexpr bool PERM = true, FP8 = true; static constexpr int TID = 3; static constexpr unsigned SCB = 0x77777777u;
    bf16_t* O; static constexpr int ldc = 1024;
    __device__ __forceinline__ void operator()(const f32x4 (&acc)[2][2][4][2], const gg::Unit& u, int wr, int wc, int fr, int fq) const {
        bf16_t* p = O + (size_t)(u.p0 * 256 + wr * 64 + fr) * ldc + u.p1 * 256 + wc * 32 + 8 * fq;
#pragma unroll
        for (int ai = 0; ai < 2; ++ai) {
#pragma unroll
            for (int m = 0; m < 4; ++m) {
#pragma unroll
                for (int bj = 0; bj < 2; ++bj) { const f32x4 v0 = acc[ai][bj][m][0], v1 = acc[ai][bj][m][1];
                    u32x4 w; w.x = cvt_pk_bf16(v0[0], v0[1]); w.y = cvt_pk_bf16(v0[2], v0[3]); w.z = cvt_pk_bf16(v1[0], v1[1]); w.w = cvt_pk_bf16(v1[2], v1[3]);
                    *(u32x4*)(p + bj * 128) = w; }
                p += 16 * ldc; asm volatile("" : "+v"(p)); }
            p += 64 * ldc; }
    }
};

__device__ __forceinline__ int crow(int r, int hi) { return (r & 3) + 8 * (r >> 2) + 4 * hi; }
__device__ __forceinline__ f32x16 mma32_ll(f32x16 acc, const LAS bf16_t* A, int lda, const LAS bf16_t* B, int ldb, int ksteps, int lane, int ks0 = 0) {
    const int r32 = lane & 31, hi = lane >> 5;
    for (int ks = ks0; ks < ksteps; ++ks) {
        const bf16x8 a = *(const LAS bf16x8*)(A + r32 * lda + ks * 16 + hi * 8);
        const bf16x8 b = *(const LAS bf16x8*)(B + r32 * ldb + ks * 16 + hi * 8);
        acc = __builtin_amdgcn_mfma_f32_32x32x16_bf16(a, b, acc, 0, 0, 0);
    }
    return acc;
}
template <int KS> __device__ __forceinline__ f32x16 mma32_lg(f32x16 acc, const LAS bf16_t* A, int lda, const bf16_t* B, int ldb, int lane) {
    const int r32 = lane & 31, hi = lane >> 5;
    bf16x8 b[KS];
#pragma unroll
    for (int ks = 0; ks < KS; ++ks) b[ks] = *(const bf16x8*)(B + (size_t)r32 * ldb + ks * 16 + hi * 8);
#pragma unroll
    for (int ks = 0; ks < KS; ++ks) { const bf16x8 a = *(const LAS bf16x8*)(A + r32 * lda + ks * 16 + hi * 8); acc = __builtin_amdgcn_mfma_f32_32x32x16_bf16(a, b[ks], acc, 0, 0, 0); }
    return acc;
}

__device__ __forceinline__ void ph_pre(const Frame& F) {
    LAS float* sv = (LAS float*)F.lds;
    LAS float* part = sv + 9 * 1024;
    float* mod = (float*)(F.ws + WS_MOD);
    for (int i = F.tid; i < 9 * 1024; i += NTHR) { const int r = i >> 10, k = i & 1023; const float c = (r < 8) ? F.in[I_C][r * 1024 + k] : F.in[I_CCTX][k]; sv[i] = c * sigmoidf_(c); }
    __syncthreads();
    for (int it = F.bx; it < 2 * 96; it += F.G) {
        const int l = it / 96, jc = it % 96, j = jc * 64 + F.lane, k0 = F.wave * 128;
        const float* w = F.in[I_WMOD] + ((size_t)l * 1024 + k0) * 6144 + j;
        float a[9];
#pragma unroll
        for (int r = 0; r < 9; ++r) a[r] = 0.f;
#pragma unroll 4
        for (int k = 0; k < 128; ++k) { const float wv = w[(size_t)k * 6144];
#pragma unroll
            for (int r = 0; r < 9; ++r) a[r] += sv[r * 1024 + k0 + k] * wv; }
#pragma unroll
        for (int r = 0; r < 9; ++r) part[(F.wave * 9 + r) * 64 + F.lane] = a[r];
        __syncthreads();
        for (int i = F.tid; i < 9 * 64; i += NTHR) { const int r = i >> 6, jj = i & 63; float s = F.in[I_BMOD][l * 6144 + jc * 64 + jj];
#pragma unroll
            for (int w8 = 0; w8 < 8; ++w8) s += part[(w8 * 9 + r) * 64 + jj];
            mod[((size_t)(l * 9 + r)) * 6144 + jc * 64 + jj] = s; }
        __syncthreads();
    }
    if (F.bx == F.G - 1) {
        float* rt = (float*)(F.ws + T_ROPE);
        for (int i = F.tid; i < 1024; i += NTHR) { const int pos = i >> 3, f = i & 7; const float inv = powf(10000.0f, -(float)f / 8.0f); const float ang = (float)pos * inv; rt[2 * i] = cosf(ang); rt[2 * i + 1] = sinf(ang); }
    }
}

struct ConvCursor { int base; int gw, ngw; };
__device__ __forceinline__ void conv_mat(const Frame& F, ConvCursor& cc, const float* src, int K, int N, bf16_t* dst, int ldd, int rbase, int rstep, int nbatch, size_t sbs, size_t dbs, int rq = 128, bool gperm = false, float f8scale = 0.f) {
    const int ktl = K / 64, ntl = (N + 127) / 128, per = ktl * ntl, total = per * nbatch;
    int t = cc.base + ((cc.gw - cc.base) % cc.ngw + cc.ngw) % cc.ngw;
    for (; t < cc.base + total; t += cc.ngw) {
        const int li = t - cc.base, bt = li / per, rem = li % per, kb = rem / ntl, nb = rem % ntl, k0 = kb * 64, n = nb * 128 + 2 * F.lane;
        if (n < N) {
            const float* s = src + bt * sbs + (size_t)k0 * N + n; bf16_t* d = dst + bt * dbs;
            f32x2 v[64];
#pragma unroll
            for (int i = 0; i < 64; ++i) v[i] = *(const f32x2*)(s + (size_t)i * N);
#pragma unroll
            for (int q = 0; q < 2; ++q) { const int nn = n + q; const int drow = gperm ? ((nn >> 6) * 256 + ((nn >> 4) & 3) * 32 + (nn & 15) + 128 * (bt >> 1) + 16 * (bt & 1)) : (rbase + (nn / rq) * rstep + (nn % rq));
                if (f8scale != 0.f) { unsigned char* d8 = (unsigned char*)dst + bt * dbs + (size_t)drow * ldd + k0;
#pragma unroll
                    for (int p = 0; p < 4; ++p) { u32x4 o; o.x = pk4_fp8(v[16 * p][q] * f8scale, v[16 * p + 1][q] * f8scale, v[16 * p + 2][q] * f8scale, v[16 * p + 3][q] * f8scale);
                        o.y = pk4_fp8(v[16 * p + 4][q] * f8scale, v[16 * p + 5][q] * f8scale, v[16 * p + 6][q] * f8scale, v[16 * p + 7][q] * f8scale);
                        o.z = pk4_fp8(v[16 * p + 8][q] * f8scale, v[16 * p + 9][q] * f8scale, v[16 * p + 10][q] * f8scale, v[16 * p + 11][q] * f8scale);
                        o.w = pk4_fp8(v[16 * p + 12][q] * f8scale, v[16 * p + 13][q] * f8scale, v[16 * p + 14][q] * f8scale, v[16 * p + 15][q] * f8scale);
                        *(u32x4*)(d8 + 16 * p) = o; }
                    continue; }
                bf16_t* dr = d + (size_t)drow * ldd + k0;
#pragma unroll
                for (int p = 0; p < 8; ++p) { u32x4 o; o.x = pk2(v[8 * p][q], v[8 * p + 1][q]); o.y = pk2(v[8 * p + 2][q], v[8 * p + 3][q]); o.z = pk2(v[8 * p + 4][q], v[8 * p + 5][q]); o.w = pk2(v[8 * p + 6][q], v[8 * p + 7][q]);
                    *(u32x4*)(dr + 8 * p) = o; } }
        }
    }
    cc.base += total;
}
__device__ __forceinline__ void ph_convert(const Frame& F, int l) {
    ConvCursor cc; cc.base = 0; cc.gw = F.bx * NWAVES + F.wave; cc.ngw = F.G * NWAVES;
    unsigned char* ws = F.ws;
    conv_mat(F, cc, F.in[I_WIN] + (size_t)l * 1024 * INC, 1024, INC, (bf16_t*)(ws + W_IN), 1024, 0, 128, 1, 0, 0, 128, false, 64.0f);
    conv_mat(F, cc, F.in[I_WGATE] + (size_t)l * 4 * 1024 * 1024, 1024, 1024, (bf16_t*)(ws + W_GATE), 1024, 0, 128, 4, (size_t)1024 * 1024, 0, 128, true, 64.0f);
    conv_mat(F, cc, F.in[I_WBR] + (size_t)l * 4 * 256 * 1024, 256, 1024, (bf16_t*)(ws + W_BR), 256, 0, 128, 4, (size_t)256 * 1024, (size_t)1024 * 256);
    conv_mat(F, cc, F.in[I_WOUT] + (size_t)l * 1024 * 1024, 1024, 1024, (bf16_t*)(ws + W_OUT), 1024, 0, 128, 1, 0, 0, 128, false, 64.0f);
    conv_mat(F, cc, F.in[I_W1] + (size_t)l * 64 * 1024 * 256, 1024, 256, (bf16_t*)(ws + W_13), 1024, 0, 256, 64, (size_t)1024 * 256, (size_t)512 * 1024, 128, false, 64.0f);
    conv_mat(F, cc, F.in[I_W3] + (size_t)l * 64 * 1024 * 256, 1024, 256, (bf16_t*)(ws + W_13), 1024, 128, 256, 64, (size_t)1024 * 256, (size_t)512 * 1024, 128, false, 64.0f);
    conv_mat(F, cc, F.in[I_W2] + (size_t)l * 64 * 256 * 1024, 256, 1024, (bf16_t*)(ws + W_2), 256, 0, 128, 64, (size_t)256 * 1024, (size_t)1024 * 256, 128, false, 32.0f);
    conv_mat(F, cc, F.in[I_WS1] + (size_t)l * 1024 * 256, 1024, 256, (bf16_t*)(ws + W_13 + (size_t)64 * 512 * 1024), 1024, 0, 256, 1, 0, 0, 128, false, 64.0f);
    conv_mat(F, cc, F.in[I_WS3] + (size_t)l * 1024 * 256, 1024, 256, (bf16_t*)(ws + W_13 + (size_t)64 * 512 * 1024), 1024, 128, 256, 1, 0, 0, 128, false, 64.0f);
    conv_mat(F, cc, F.in[I_WS2] + (size_t)l * 256 * 1024, 256, 1024, (bf16_t*)(ws + W_2 + (size_t)64 * 1024 * 256), 256, 0, 128, 1, 0, 0, 128, false, 32.0f);
    conv_mat(F, cc, F.in[I_WUQ] + (size_t)l * 256 * 384, 256, 384, (bf16_t*)(ws + W_UQ), 256, 0, 128, 1, 0, 0);
    conv_mat(F, cc, F.in[I_WUKV] + (size_t)l * 128 * 512, 128, 512, (bf16_t*)(ws + W_UKV), 128, 0, 128, 1, 0, 0);
    conv_mat(F, cc, F.in[I_POOLW] + (size_t)l * 4 * 64 * 64, 64, 64, (bf16_t*)(ws + W_POOL), 64, 0, 128, 4, (size_t)64 * 64, (size_t)64 * 64);
    conv_mat(F, cc, F.in[I_WRT] + (size_t)l * 1024 * 64, 1024, 64, (bf16_t*)(ws + W_RT), 1024, 0, 128, 1, 0, 0);
    { u32x4* z = (u32x4*)(ws + W_IN + (size_t)INC * 1024); const int n16 = (INCP - INC) * 1024 / 16;
      unsigned z0 = 0u; asm volatile("" : "+v"(z0));
      for (int i = F.bx * NTHR + F.tid; i < n16; i += F.G * NTHR) z[i] = (u32x4){z0, z0, z0, z0}; }
}

__device__ __forceinline__ void normmod_vals(int lane, const f32x4 (&v)[4], const float* g, const float* sc, const float* sh, f32x4 (&y)[4]) {
    float s = 0.f;
#pragma unroll
    for (int j = 0; j < 4; ++j) s += (v[j].x * v[j].x + v[j].y * v[j].y) + (v[j].z * v[j].z + v[j].w * v[j].w);
    const float rstd = frsq(wave_sum(s) * (1.f / 1024.f) + EPS);
#pragma unroll
    for (int j = 0; j < 4; ++j) { const f32x4 gv = ((const f32x4*)g)[lane + 64 * j], scv = ((const f32x4*)sc)[lane + 64 * j], shv = ((const f32x4*)sh)[lane + 64 * j];
        y[j] = v[j] * rstd * gv * (scv + 1.0f) + shv; }
}
__device__ __forceinline__ void normmod_row(int lane, const float* xrow, const float* g, const float* sc, const float* sh, f32x4 (&y)[4]) {
    const f32x4* xr = (const f32x4*)xrow + lane; f32x4 v[4]; float s = 0.f;
#pragma unroll
    for (int j = 0; j < 4; ++j) { v[j] = xr[64 * j]; s += (v[j].x * v[j].x + v[j].y * v[j].y) + (v[j].z * v[j].z + v[j].w * v[j].w); }
    const float rstd = frsq(wave_sum(s) * (1.f / 1024.f) + EPS);
#pragma unroll
    for (int j = 0; j < 4; ++j) { const f32x4 gv = ((const f32x4*)g)[lane + 64 * j], scv = ((const f32x4*)sc)[lane + 64 * j], shv = ((const f32x4*)sh)[lane + 64 * j];
        y[j] = v[j] * rstd * gv * (scv + 1.0f) + shv; }
}
__device__ __forceinline__ const float* stream_row(const Frame& F, int l, int row) {
    if (row < NLAT) return (l == 0 ? F.in[I_X] : F.out) + (size_t)row * 1024;
    return (l == 0 ? F.in[I_CTX] : (const float*)(F.ws + WS_CTXS)) + (size_t)(row - NLAT) * 1024;
}
__device__ __forceinline__ void ph_norm1(const Frame& F, int l) {
    const int gw = F.bx * NWAVES + F.wave, ngw = F.G * NWAVES;
    for (int row0 = gw; row0 < NTOK; row0 += 2 * ngw) {
        const int row1 = row0 + ngw; const bool has1 = row1 < NTOK;
        f32x4 v0[4], v1[4];
        { const f32x4* x0 = (const f32x4*)stream_row(F, l, row0) + F.lane; const f32x4* x1 = (const f32x4*)stream_row(F, l, has1 ? row1 : row0) + F.lane;
#pragma unroll
          for (int j = 0; j < 4; ++j) { v0[j] = x0[64 * j]; v1[j] = x1[64 * j]; } }
#pragma unroll
        for (int k = 0; k < 2; ++k) { if (k == 1 && !has1) break; const int row = k ? row1 : row0; const int mr = mod_row_of(row); f32x4 y[4];
            normmod_vals(F.lane, k ? v1 : v0, F.in[I_GMIX] + l * 1024, modp(F, l, mr, 1), modp(F, l, mr, 0), y);
            unsigned* o8 = (unsigned*)(F.ws + WS_HX8 + (size_t)row * 1024) + F.lane;
#pragma unroll
            for (int j = 0; j < 4; ++j) o8[64 * j] = pk4_fp8(y[j].x, y[j].y, y[j].z, y[j].w); }
    }
}

constexpr float QSCALE = 0.10206207261596577f * 1.4426950408889634f;
template <int KS> __device__ __forceinline__ void ld_bfrag(bf16x8* b, const bf16_t* B, int ldb, int lane) {
#pragma unroll
    for (int ks = 0; ks < KS; ++ks) b[ks] = *(const bf16x8*)(B + (size_t)(lane & 31) * ldb + ks * 16 + (lane >> 5) * 8);
}
template <int KS> __device__ __forceinline__ f32x16 mma32_lr(const LAS bf16_t* A, int lda, const bf16x8* b, int lane) {
    f32x16 acc = {};
#pragma unroll
    for (int ks = 0; ks < KS; ++ks) { const bf16x8 a = *(const LAS bf16x8*)(A + (lane & 31) * lda + ks * 16 + (lane >> 5) * 8); acc = __builtin_amdgcn_mfma_f32_32x32x16_bf16(a, b[ks], acc, 0, 0, 0); }
    return acc;
}
__device__ __forceinline__ f32x2 mla_rope_ld(const Frame& F, int unit) {
    const int row0 = unit * 32; const bool isctx = row0 >= NLAT; const int pos0 = isctx ? (row0 - NLAT) & 255 : row0 & 8191;
    const int pos = pos0 + (F.tid >> 4), pp = (F.tid & 8) ? (pos & 63) : (pos >> 6);
    return *(const f32x2*)((const float*)(F.ws + T_ROPE) + (pp * 8 + (F.tid & 7)) * 2);
}
struct MlaKvRegs { unsigned xk[4]; unsigned xr[4]; f32x2 rp; };
__device__ __forceinline__ MlaKvRegs mla_kv_load(const Frame& F, int unit) {
    MlaKvRegs R; const bf16_t* px = (const bf16_t*)(F.ws + WS_PX);
#pragma unroll
    for (int rr = 0; rr < 4; ++rr) { const bf16_t* p = px + (size_t)(unit * 32 + F.wave * 4 + rr) * INC + C_MLA;
        R.xk[rr] = *(const unsigned*)(p + 256 + 2 * F.lane); R.xr[rr] = *(const unsigned*)(p + 384 + 2 * (F.lane & 15)); }
    R.rp = mla_rope_ld(F, unit);
    return R;
}
__device__ __forceinline__ void mla_kv_unit(const Frame& F, int unit, const MlaKvRegs& R, const bf16x8* wkv, f32x2 gckv2, float g0, float g1, float g2) {
    LAS unsigned char* lds = F.lds;
    LAS bf16_t* AKV = (LAS bf16_t*)lds;
    LAS float* KR = (LAS float*)(lds + 8704);
    LAS f32x2* RP = (LAS f32x2*)(lds + 12800);
    LAS float* OUT = (LAS float*)(lds + 16896);
    LAS unsigned char* KB = (LAS unsigned char*)(lds + 83456);
    int tid_ = F.tid; asm volatile("" : "+v"(tid_));
    const int row0 = unit * 32, tid = tid_, lane = tid & 63, wave = F.wave, r32 = lane & 31, hi = lane >> 5;
    const bool isctx = row0 >= NLAT;
    const int b = isctx ? (row0 - NLAT) >> 8 : row0 >> 13, pos0 = isctx ? (row0 - NLAT) & 255 : row0 & 8191;
    LDS_BAR();
    RP[tid] = R.rp;
#pragma unroll
    for (int rr = 0; rr < 4; ++rr) { const int r = wave * 4 + rr; const unsigned w = R.xk[rr]; const float x0 = bflo(w), x1 = bfhi(w);
        const float sc = frsq(wave_sum(x0 * x0 + x1 * x1) * (1.f / 128.f) + EPS);
        *(LAS unsigned*)(AKV + r * 136 + 2 * lane) = pk2(x0 * sc * gckv2.x, x1 * sc * gckv2.y);
        if (lane < 16) *(LAS f32x2*)(KR + r * 32 + 2 * lane) = (f32x2){bflo(R.xr[rr]), bfhi(R.xr[rr])}; }
    LDS_BAR();
#pragma unroll
    for (int i = 0; i < 2; ++i) { const int nt = wave * 2 + i; const f32x16 acc = mma32_lr<8>(AKV, 136, wkv + 8 * i, lane);
#pragma unroll
        for (int r = 0; r < 16; ++r) OUT[crow(r, hi) * 520 + nt * 32 + r32] = acc[r]; }
    LDS_BAR();
#pragma unroll
    for (int it = 0; it < 8; ++it) { const int pr = wave * 16 + it * 2 + hi, r = pr >> 2, h = pr & 3; const LAS float* o = OUT + r * 520 + h * 128;
        float v0 = o[r32], v1 = o[32 + r32], v2 = KR[r * 32 + r32]; const float ss = half_sum(v0 * v0 + v1 * v1 + v2 * v2);
        const float sc = frsq(ss * (1.f / 96.f) + EPS);
        v0 *= sc * g0; v1 *= sc * g1; v2 *= sc * g2;
        const float pv = xor_lane<8>(v2);
        if (!isctx) { const f32x2 cssn = RP[(r * 2 + (r32 >> 4)) * 8 + (r32 & 7)]; v2 = (r32 & 8) ? (v2 * cssn.x + pv * cssn.y) : (v2 * cssn.x - pv * cssn.y); }
        LAS unsigned char* kb = KB + r * 400 + h * 96;
        kb[r32] = f2f8(v0); kb[32 + r32] = f2f8(v1); kb[64 + r32] = f2f8(v2); }
    LDS_BAR();
    const int key0 = isctx ? pos0 : 256 + pos0, tile = key0 >> 6, kin = key0 & 63;
    for (int i = tid; i < 768; i += NTHR) { const int r = i & 31, c = (i >> 5) % 6, h = i / 192;
        const u32x4 v = *(const LAS u32x4*)(KB + r * 400 + h * 96 + c * 16);
        *(u32x4*)(F.ws + WS_KT + ((size_t)((b * 4 + h) * NKT + tile) * 6 + c) * 1024 + (kin + r) * 16) = v; }
    for (int i = tid; i < 1024; i += NTHR) { const int p = i & 3, r = (i >> 2) & 31, dh = (i >> 7) & 1, h = i >> 8; const LAS float* o = OUT + r * 520 + h * 128 + 64 + dh * 32 + p * 8;
        u32x4 v; v.x = pk2(o[0], o[1]); v.y = pk2(o[2], o[3]); v.z = pk2(o[4], o[5]); v.w = pk2(o[6], o[7]);
        *(u32x4*)((bf16_t*)(F.ws + WS_VT) + ((size_t)((b * 4 + h) * NKT + tile) * 2 + dh) * 2048 + (kin + r) * 32 + p * 8) = v; }
}
struct MlaQRegs { u32x2 xq[4]; f32x2 rp; };
__device__ __forceinline__ MlaQRegs mla_q_load(const Frame& F, int unit) {
    MlaQRegs R; const bf16_t* px = (const bf16_t*)(F.ws + WS_PX);
#pragma unroll
    for (int rr = 0; rr < 4; ++rr) R.xq[rr] = *(const u32x2*)(px + (size_t)(unit * 32 + F.wave * 4 + rr) * INC + C_MLA + 4 * F.lane);
    R.rp = mla_rope_ld(F, unit);
    return R;
}
__device__ __forceinline__ void mla_q_unit(const Frame& F, int unit, const MlaQRegs& R, const bf16x8* wqf, f32x4 gcq4, float g0, float g1, float g2) {
    LAS unsigned char* lds = F.lds;
    LAS bf16_t* AQ = (LAS bf16_t*)lds;
    LAS f32x2* RP = (LAS f32x2*)(lds + 16896);
    LAS float* OQ = (LAS float*)(lds + 20992);
    int tid_ = F.tid; asm volatile("" : "+v"(tid_));
    const int row0 = unit * 32, tid = tid_, lane = tid & 63, wave = F.wave, r32 = lane & 31, hi = lane >> 5;
    const bool isctx = row0 >= NLAT;
    LDS_BAR();
    RP[tid] = R.rp;
#pragma unroll
    for (int rr = 0; rr < 4; ++rr) { const int r = wave * 4 + rr; const u32x2 w = R.xq[rr]; const float x0 = bflo(w.x), x1 = bfhi(w.x), x2 = bflo(w.y), x3 = bfhi(w.y);
        const float sc = frsq(wave_sum(x0 * x0 + x1 * x1 + x2 * x2 + x3 * x3) * (1.f / 256.f) + EPS);
        *(LAS u32x2*)(AQ + r * 264 + 4 * lane) = (u32x2){pk2(x0 * sc * gcq4.x, x1 * sc * gcq4.y), pk2(x2 * sc * gcq4.z, x3 * sc * gcq4.w)}; }
    LDS_BAR();
    { const f32x16 acc = mma32_lr<16>(AQ, 264, wqf, lane);
#pragma unroll
      for (int r = 0; r < 16; ++r) OQ[crow(r, hi) * 392 + wave * 32 + r32] = acc[r]; }
    if (wave < 4) { const f32x16 acc = mma32_lr<16>(AQ, 264, wqf + 16, lane);
#pragma unroll
      for (int r = 0; r < 16; ++r) OQ[crow(r, hi) * 392 + (8 + wave) * 32 + r32] = acc[r]; }
    LDS_BAR();
    unsigned char* qb = F.ws + WS_QB;
#pragma unroll
    for (int it = 0; it < 8; ++it) { const int pr = wave * 16 + it * 2 + hi, r = pr >> 2, h = pr & 3; const LAS float* o = OQ + r * 392 + h * 96;
        float v0 = o[r32], v1 = o[32 + r32], v2 = o[64 + r32]; const float ss = half_sum(v0 * v0 + v1 * v1 + v2 * v2);
        const float sc = frsq(ss * (1.f / 96.f) + EPS);
        v0 *= sc * g0; v1 *= sc * g1; v2 *= sc * g2;
        const float pv = xor_lane<8>(v2);
        if (!isctx) { const f32x2 cssn = RP[(r * 2 + (r32 >> 4)) * 8 + (r32 & 7)]; v2 = (r32 & 8) ? (v2 * cssn.x + pv * cssn.y) : (v2 * cssn.x - pv * cssn.y); }
        unsigned char* q = qb + (size_t)(row0 + r) * 384 + h * 96;
        q[r32] = f2f8(v0 * (8.0f * QSCALE)); q[32 + r32] = f2f8(v1 * (8.0f * QSCALE)); q[64 + r32] = f2f8(v2 * (8.0f * QSCALE)); }
}
__device__ __forceinline__ void mla_prep(const Frame& F, int l) {
    const int lane = F.lane, wave = F.wave, r32 = lane & 31;
    { bf16x8 wkv[16]; const bf16_t* wukv = (const bf16_t*)(F.ws + W_UKV);
      ld_bfrag<8>(wkv, wukv + (size_t)(wave * 2) * 32 * 128, 128, lane); ld_bfrag<8>(wkv + 8, wukv + (size_t)(wave * 2 + 1) * 32 * 128, 128, lane);
      const f32x2 gckv2 = *(const f32x2*)(F.in[I_GCKV] + l * 128 + 2 * lane); const float* gkn = F.in[I_GKN] + l * 96; const float g0 = gkn[r32], g1 = gkn[32 + r32], g2 = gkn[64 + r32];
      const int nu = NTOK / 32;
      if (F.bx < nu) { MlaKvRegs R = mla_kv_load(F, F.bx);
          for (int u = F.bx; u < nu; u += F.G) { const MlaKvRegs Rn = mla_kv_load(F, (u + F.G < nu) ? u + F.G : u); mla_kv_unit(F, u, R, wkv, gckv2, g0, g1, g2); R = Rn; } } }
    { bf16x8 wqf[32]; const bf16_t* wuq = (const bf16_t*)(F.ws + W_UQ);
      ld_bfrag<16>(wqf, wuq + (size_t)wave * 32 * 256, 256, lane); if (wave < 4) ld_bfrag<16>(wqf + 16, wuq + (size_t)(8 + wave) * 32 * 256, 256, lane);
      const f32x4 gcq4 = *(const f32x4*)(F.in[I_GCQ] + l * 256 + 4 * lane); const float* gqn = F.in[I_GQN] + l * 96; const float g0 = gqn[r32], g1 = gqn[32 + r32], g2 = gqn[64 + r32];
      const int nu = (l == 0 ? NTOK : NLAT) / 32;
      if (F.bx < nu) { MlaQRegs R = mla_q_load(F, F.bx);
          for (int u = F.bx; u < nu; u += F.G) { const MlaQRegs Rn = mla_q_load(F, (u + F.G < nu) ? u + F.G : u); mla_q_unit(F, u, R, wqf, gcq4, g0, g1, g2); R = Rn; } } }
}

__device__ __forceinline__ void ml_chunk_pos(int dir, int j, bool& isctx, int& p0) {
    if (j < 2) { isctx = true; p0 = (dir == 0 ? j : 1 - j) * 128; } else { isctx = false; p0 = (dir == 0 ? (j - 2) : (63 - (j - 2))) * 128; }
}
__device__ __forceinline__ int ml_row(int b, bool isctx, int pos) { return isctx ? NLAT + b * 256 + pos : b * 8192 + pos; }
__device__ __forceinline__ float log_sigmoidf_(float x) { return fminf(x, 0.f) - log1pf(__expf(-fabsf(x))); }

struct P1Regs { u32x4 kv[4]; float gi, gf; };
__device__ __forceinline__ P1Regs ml_pass1_load(const Frame& F, int unit) {
    P1Regs R; const int j = unit % NCHK, dir = (unit / NCHK) & 1, h = (unit / (NCHK * 2)) & 3, b = unit / (NCHK * 8);
    bool isctx; int p0; ml_chunk_pos(dir, j, isctx, p0);
    const bf16_t* px = (const bf16_t*)(F.ws + WS_PX); const float* gate = (const float*)(F.ws + T_GATE); const int tid = F.tid;
#pragma unroll
    for (int q = 0; q < 4; ++q) { const int it = tid + q * NTHR, i = it & 127, c = (it >> 7) & 7, isv = it >> 10; const int pos = dir ? p0 + 127 - i : p0 + i;
        R.kv[q] = *(const u32x4*)(px + (size_t)ml_row(b, isctx, pos) * INC + (isv ? 512 : 256) + h * 64 + c * 8); }
    { const int i = tid & 127; const int pos = dir ? p0 + 127 - i : p0 + i; const float* g = gate + (size_t)ml_row(b, isctx, pos) * 16; R.gi = g[dir * 8 + h]; R.gf = g[dir * 8 + 4 + h]; }
    return R;
}
__device__ __forceinline__ void ml_pass1_unit(const Frame& F, int l, int unit, const P1Regs& R) {
    LAS float* LI = (LAS float*)F.lds; LAS float* LF = LI + 128; LAS float* WV = LI + 256;
    LAS bf16_t* KT = (LAS bf16_t*)(F.lds + 2048); LAS bf16_t* VT = KT + 64 * 136;
    const int dir = (unit / NCHK) & 1, h = (unit / (NCHK * 2)) & 3;
    const int tid = F.tid, lane = F.lane, wave = F.wave;
    const float* gb = F.in[I_MLGB] + l * 16;
    LDS_BAR();
    if (tid < 128) { LI[tid] = R.gi + gb[dir * 8 + h]; LF[tid] = log_sigmoidf_(R.gf + gb[dir * 8 + 4 + h]); }
    LDS_BAR();
    if (wave == 0) {
        const float a0 = LF[2 * lane], a1 = LF[2 * lane + 1]; float s = a0 + a1;
#pragma unroll
        for (int o = 1; o < 64; o <<= 1) { const float t = lane_up(s, o, lane); if (lane >= o) s += t; }
        const float bend = lane_bcast(s, 63);
        const float w0 = bend - (s - a1) + LI[2 * lane], w1 = bend - s + LI[2 * lane + 1];
        const float mloc = wave_max(fmaxf(w0, w1));
        WV[2 * lane] = __expf(w0 - mloc); WV[2 * lane + 1] = __expf(w1 - mloc);
        if (lane == 0) { ((float*)(F.ws + T_MLOC))[unit] = mloc; ((float*)(F.ws + T_BEND))[unit] = bend; }
    }
    LDS_BAR();
#pragma unroll
    for (int q = 0; q < 4; ++q) { const int it = tid + q * NTHR, i = it & 127, c = (it >> 7) & 7, isv = it >> 10; const u32x4 v = R.kv[q];
        const float sc = isv ? 1.0f : 0.125f * WV[i]; LAS bf16_t* d = (isv ? VT : KT) + (c * 8) * 136 + i;
        d[0] = (bf16_t)f2bf(bflo(v.x) * sc); d[136] = (bf16_t)f2bf(bfhi(v.x) * sc); d[272] = (bf16_t)f2bf(bflo(v.y) * sc); d[408] = (bf16_t)f2bf(bfhi(v.y) * sc);
        d[544] = (bf16_t)f2bf(bflo(v.z) * sc); d[680] = (bf16_t)f2bf(bfhi(v.z) * sc); d[816] = (bf16_t)f2bf(bflo(v.w) * sc); d[952] = (bf16_t)f2bf(bfhi(v.w) * sc); }
    LDS_BAR();
    if (wave < 4) { const int et = wave >> 1, dt = wave & 1; f32x16 acc = {}; acc = mma32_ll(acc, VT + et * 32 * 136, 136, KT + dt * 32 * 136, 136, 8, lane);
        float* dc = (float*)(F.ws + WS_DC) + (size_t)unit * 4096; const int r32 = lane & 31, hi = lane >> 5;
#pragma unroll
        for (int r = 0; r < 16; ++r) dc[(et * 32 + crow(r, hi)) * 64 + dt * 32 + r32] = acc[r];
    } else if (wave == 4) { float s = 0.f; for (int i = 0; i < 128; ++i) s += bf2f(KT[lane * 136 + i]); ((float*)(F.ws + T_DN))[(size_t)unit * 64 + lane] = s; }
}

__device__ __forceinline__ void ml_pass2(const Frame& F) {
    const float* dc = (const float*)(F.ws + WS_DC); const float* dn = (const float*)(F.ws + T_DN);
    const float* mloc = (const float*)(F.ws + T_MLOC); const float* bend = (const float*)(F.ws + T_BEND);
    bf16_t* cst = (bf16_t*)(F.ws + WS_CST); float* nst = (float*)(F.ws + T_NST); float* mst = (float*)(F.ws + T_MST);
    LAS float* ML = (LAS float*)F.lds; LAS float* BE = ML + 128;
    for (int it = F.bx; it < 64 * 8; it += F.G) { const int bhd = it >> 3, part = it & 7, u0 = bhd * NCHK, el = part * 512 + F.tid;
        const bool don = (part == 0 && F.tid < 64);
        float d[NCHK], dnv[NCHK];
#pragma unroll
        for (int j = 0; j < NCHK; ++j) d[j] = dc[(size_t)(u0 + j) * 4096 + el];
#pragma unroll
        for (int j = 0; j < NCHK; ++j) dnv[j] = don ? dn[(size_t)(u0 + j) * 64 + F.tid] : 0.f;
        __syncthreads();
        if (F.tid < NCHK) { ML[F.tid] = mloc[u0 + F.tid]; BE[F.tid] = bend[u0 + F.tid]; }
        __syncthreads();
        float C = 0.f, n = 0.f, m = 0.f;
#pragma unroll
        for (int j = 0; j < NCHK; ++j) { const int u = u0 + j; const float ml = ML[j], be = BE[j];
            cst[(size_t)u * 4096 + el] = (bf16_t)f2bf(C); if (don) nst[(size_t)u * 64 + F.tid] = n; if (part == 0 && F.tid == 0) mst[u] = m;
            const float mn = fmaxf(be + m, ml), dcy = __expf(be + m - mn), sc = __expf(ml - mn);
            C = dcy * C + sc * d[j]; n = dcy * n + sc * dnv[j]; m = mn; }
    }
    __syncthreads();
}

__device__ __forceinline__ void ml_pass3_unit(const Frame& F, int l, int b, int h, int pc) {
    LAS unsigned char* lds = F.lds;
    LAS bf16_t* Qs = (LAS bf16_t*)lds;
    LAS bf16_t* Ks = (LAS bf16_t*)(lds + 18432);
    LAS bf16_t* VTs = (LAS bf16_t*)(lds + 36864);
    LAS bf16_t* CTs = (LAS bf16_t*)(lds + 62976);
    LAS bf16_t* Wm = (LAS bf16_t*)(lds + 76800);
    LAS float* HS = (LAS float*)(lds + 111616);
    LAS float* VEC = (LAS float*)(lds + 144384);
    LAS float* DEN = VEC + 12 * 128;
    const int tid = F.tid, lane = F.lane, wave = F.wave, r32 = lane & 31, hi = lane >> 5;
    const bool isctx = pc < 2; const int p0 = isctx ? pc * 128 : (pc - 2) * 128;
    const float* gate = (const float*)(F.ws + T_GATE); const float* gb = F.in[I_MLGB] + l * 16;
    const bf16_t* px = (const bf16_t*)(F.ws + WS_PX);
    int unit_d[2];
#pragma unroll
    for (int dir = 0; dir < 2; ++dir) { const int j = isctx ? (dir == 0 ? pc : 1 - pc) : (dir == 0 ? pc : 2 + 63 - (pc - 2)); unit_d[dir] = ((b * 4 + h) * 2 + dir) * NCHK + j; }
    LDS_BAR();
    const u32x4 cst0 = *(const u32x4*)((const bf16_t*)(F.ws + WS_CST) + (size_t)unit_d[0] * 4096 + tid * 8), cst1 = *(const u32x4*)((const bf16_t*)(F.ws + WS_CST) + (size_t)unit_d[1] * 4096 + tid * 8);
    const float nv0 = (tid < 64) ? ((const float*)(F.ws + T_NST))[(size_t)unit_d[0] * 64 + tid] : 0.f, nv1 = (tid < 64) ? ((const float*)(F.ws + T_NST))[(size_t)unit_d[1] * 64 + tid] : 0.f;
    const float mst0 = ((const float*)(F.ws + T_MST))[unit_d[0]], mst1 = ((const float*)(F.ws + T_MST))[unit_d[1]];
    if (tid < 256) { const int dir = tid >> 7, i = tid & 127; const int pos = dir ? p0 + 127 - i : p0 + i; const float* g = gate + (size_t)ml_row(b, isctx, pos) * 16;
        VEC[(dir * 6 + 0) * 128 + i] = g[dir * 8 + h] + gb[dir * 8 + h]; VEC[(dir * 6 + 1) * 128 + i] = log_sigmoidf_(g[dir * 8 + 4 + h] + gb[dir * 8 + 4 + h]); }
    for (int it = tid; it < 3072; it += NTHR) { const int i = it & 127, c = (it >> 7) & 7, which = it >> 10;
        const u32x4 v = *(const u32x4*)(px + (size_t)ml_row(b, isctx, p0 + i) * INC + which * 256 + h * 64 + c * 8);
        if (which == 0) *(LAS u32x4*)(Qs + i * 72 + c * 8) = v;
        else if (which == 1) { u32x4 w; w.x = pk2(bflo(v.x) * 0.125f, bfhi(v.x) * 0.125f); w.y = pk2(bflo(v.y) * 0.125f, bfhi(v.y) * 0.125f); w.z = pk2(bflo(v.z) * 0.125f, bfhi(v.z) * 0.125f); w.w = pk2(bflo(v.w) * 0.125f, bfhi(v.w) * 0.125f);
            *(LAS u32x4*)(Ks + i * 72 + c * 8) = w; }
        else { LAS bf16_t* d = VTs + (c * 8) * 136 + i; d[0] = (bf16_t)(v.x & 0xffff); d[136] = (bf16_t)(v.x >> 16); d[272] = (bf16_t)(v.y & 0xffff); d[408] = (bf16_t)(v.y >> 16);
            d[544] = (bf16_t)(v.z & 0xffff); d[680] = (bf16_t)(v.z >> 16); d[816] = (bf16_t)(v.w & 0xffff); d[952] = (bf16_t)(v.w >> 16); } }
    for (int it = tid; it < 32 * 136; it += NTHR) VTs[64 * 136 + it] = (it < 128) ? (bf16_t)0x3f80 : (bf16_t)0;
    LDS_BAR();
    if (wave < 2) { const int dir = wave; LAS float* V0 = VEC + dir * 6 * 128; const float mst = dir ? mst1 : mst0;
        const float a0 = V0[128 + 2 * lane], a1 = V0[128 + 2 * lane + 1]; float s = a0 + a1;
#pragma unroll
        for (int o = 1; o < 64; o <<= 1) { const float t = lane_up(s, o, lane); if (lane >= o) s += t; }
        const float b0 = s - a1, b1 = s, c0 = V0[2 * lane] - b0, c1 = V0[2 * lane + 1] - b1;
        float pm = fmaxf(c0, c1);
#pragma unroll
        for (int o = 1; o < 64; o <<= 1) { const float t = lane_up(pm, o, lane); if (lane >= o) pm = fmaxf(pm, t); }
        float pprev = lane_up(pm, 1, lane); if (lane == 0) pprev = -INFINITY;
        const float M0 = fmaxf(mst, fmaxf(pprev, c0)), M1 = fmaxf(mst, pm);
        V0[256 + 2 * lane] = c0; V0[256 + 2 * lane + 1] = c1; V0[384 + 2 * lane] = M0; V0[384 + 2 * lane + 1] = M1;
        V0[512 + 2 * lane] = __expf(mst - M0); V0[512 + 2 * lane + 1] = __expf(mst - M1); V0[640 + 2 * lane] = __expf(-b0 - M0); V0[640 + 2 * lane + 1] = __expf(-b1 - M1);
    }
    const u32x4 og0 = *(const u32x4*)(px + (size_t)ml_row(b, isctx, p0 + (tid >> 3)) * INC + 768 + h * 64 + (tid & 7) * 8), og1 = *(const u32x4*)(px + (size_t)ml_row(b, isctx, p0 + 64 + (tid >> 3)) * INC + 768 + h * 64 + (tid & 7) * 8);
    for (int dir = 0; dir < 2; ++dir) {
        const LAS float* COLV = VEC + (dir * 6 + 2) * 128; const LAS float* MV = COLV + 128; const LAS float* AIN = COLV + 256; const LAS float* EINV = COLV + 384;
        const int rs = dir ? -72 : 72, rb = dir ? 127 : 0;
        LDS_BAR();
        *(LAS u32x4*)(CTs + (tid >> 3) * 72 + (tid & 7) * 8) = dir ? cst1 : cst0;
        if (tid < 72) CTs[64 * 72 + tid] = (tid < 64) ? (bf16_t)f2bf(dir ? nv1 : nv0) : (bf16_t)0;
        for (int q = wave; q < 16; q += 8) { const int ti = q >> 2, si = q & 3; const int sidx = si * 32 + r32, spos = dir ? 127 - sidx : sidx;
            if (si > ti) {
#pragma unroll
                for (int r = 0; r < 16; ++r) Wm[(ti * 32 + crow(r, hi)) * 136 + spos] = 0;
            } else { f32x16 acc = {}; acc = mma32_ll(acc, Qs + (rb + (dir ? -ti * 32 : ti * 32)) * 72, rs, Ks + (rb + (dir ? -si * 32 : si * 32)) * 72, rs, 4, lane); const float cv = COLV[sidx];
#pragma unroll
                for (int r = 0; r < 16; ++r) { const int t = ti * 32 + crow(r, hi); const float w = (sidx <= t) ? acc[r] * __expf(cv - MV[t]) : 0.f; Wm[t * 136 + spos] = (bf16_t)f2bf(w); } }
        }
        LDS_BAR();
        f32x16 tot[2];
#pragma unroll
        for (int k = 0; k < 2; ++k) { const int q = wave + 8 * k; if (q < 12) { const int ti = q / 3, nt = q % 3;
            f32x16 a1 = {}; a1 = mma32_ll(a1, Wm + ti * 32 * 136, 136, VTs + nt * 32 * 136, 136, dir ? 8 : (ti + 1) * 2, lane, dir ? 8 - (ti + 1) * 2 : 0);
            f32x16 a2 = {}; a2 = mma32_ll(a2, Qs + (rb + (dir ? -ti * 32 : ti * 32)) * 72, rs, CTs + nt * 32 * 72, 72, 4, lane);
#pragma unroll
            for (int r = 0; r < 16; ++r) a1[r] += AIN[ti * 32 + crow(r, hi)] * a2[r];
            tot[k] = a1;
            if (nt == 2 && r32 == 0) {
#pragma unroll
                for (int r = 0; r < 16; ++r) DEN[ti * 32 + crow(r, hi)] = a1[r]; } } }
        LDS_BAR();
#pragma unroll
        for (int k = 0; k < 2; ++k) { const int q = wave + 8 * k; if (q < 12) { const int ti = q / 3, nt = q % 3; if (nt < 2) {
#pragma unroll
            for (int r = 0; r < 16; ++r) { const int t = ti * 32 + crow(r, hi); const float hv = tot[k][r] * frcp(fmaxf(fabsf(DEN[t]), EINV[t])); const int p = dir ? 127 - t : t;
                if (dir == 0) HS[p * 64 + nt * 32 + r32] = hv; else HS[p * 64 + nt * 32 + r32] += hv; } } } }
    }
    LDS_BAR();
    { const int c8 = (tid & 7) * 8; bf16_t* yc = (bf16_t*)(F.ws + WS_YC);
      const f32x4 hg0 = *(const f32x4*)(F.in[I_MLHG] + l * 256 + h * 64 + c8), hg1 = *(const f32x4*)(F.in[I_MLHG] + l * 256 + h * 64 + c8 + 4);
#pragma unroll
      for (int half = 0; half < 2; ++half) { const int p = half * 64 + (tid >> 3); const u32x4 og = half ? og1 : og0;
        const f32x4 v0 = *(const LAS f32x4*)(HS + p * 64 + c8), v1 = *(const LAS f32x4*)(HS + p * 64 + c8 + 4);
        float ss = (v0.x * v0.x + v0.y * v0.y) + (v0.z * v0.z + v0.w * v0.w) + (v1.x * v1.x + v1.y * v1.y) + (v1.z * v1.z + v1.w * v1.w);
        ss += xor_lane<1>(ss); ss += xor_lane<2>(ss); ss += xor_lane<4>(ss);
        const float sc = frsq(ss * (1.f / 64.f) + EPS);
        const f32x4 y0 = v0 * sc * hg0 * (f32x4){sigmoidf_(bflo(og.x)), sigmoidf_(bfhi(og.x)), sigmoidf_(bflo(og.y)), sigmoidf_(bfhi(og.y))};
        const f32x4 y1 = v1 * sc * hg1 * (f32x4){sigmoidf_(bflo(og.z)), sigmoidf_(bfhi(og.z)), sigmoidf_(bflo(og.w)), sigmoidf_(bfhi(og.w))};
        *(u32x4*)(yc + (size_t)ml_row(b, isctx, p0 + p) * 1024 + h * 64 + c8) = (u32x4){pk2(y0.x, y0.y), pk2(y0.z, y0.w), pk2(y1.x, y1.y), pk2(y1.z, y1.w)}; } }
}

struct PoolRegs { u32x4 v[5]; };
__device__ __forceinline__ PoolRegs pool_load(const Frame& F, int unit) {
    PoolRegs R; const int row0 = unit * 64, tid = F.tid;
    const bool isctx = row0 >= NLAT; const int T = isctx ? 256 : 8192, t0 = isctx ? (row0 - NLAT) & 255 : row0 & 8191, rbase = row0 - t0;
    const bf16_t* px = (const bf16_t*)(F.ws + WS_PX);
#pragma unroll
    for (int q = 0; q < 5; ++q) { const int it = tid + q * NTHR, rr = it >> 5, c = it & 31, t = t0 - 8 + rr; R.v[q] = (u32x4){0u, 0u, 0u, 0u};
        if (t >= 0 && t < T) R.v[q] = *(const u32x4*)(px + (size_t)(rbase + t) * INC + C_POOL + c * 8); }
    return R;
}
__device__ __forceinline__ void pool_unit(const Frame& F, int l, int unit, const PoolRegs& R) {
    LAS float* U = (LAS float*)F.lds;
    LAS bf16_t* D = (LAS bf16_t*)(F.lds + 81920);
    const int row0 = unit * 64, tid = F.tid, lane = F.lane, wave = F.wave;
    const bool isctx = row0 >= NLAT; const int T = isctx ? 256 : 8192, t0 = isctx ? (row0 - NLAT) & 255 : row0 & 8191, rbase = row0 - t0;
    const bf16_t* px = (const bf16_t*)(F.ws + WS_PX);
    LDS_BAR();
    {
#pragma unroll
      for (int q = 0; q < 5; ++q) { const int it = tid + q * NTHR, rr = it >> 5, c = it & 31; LAS float* d = U + rr * 256 + c * 8; const u32x4 v = R.v[q];
          *(LAS f32x4*)d = (f32x4){bflo(v.x), bfhi(v.x), bflo(v.y), bfhi(v.y)}; *(LAS f32x4*)(d + 4) = (f32x4){bflo(v.z), bfhi(v.z), bflo(v.w), bfhi(v.w)}; } }
    LDS_BAR();
    { const int c = tid & 255, th = tid >> 8, g = c >> 6, hw = 1 << g, tt0 = th * 32;
      float sacc = 0.f;
      for (int u = tt0 - hw; u < tt0 + hw; ++u) sacc += U[(u + 8) * 256 + c];
#pragma unroll 4
      for (int k = 0; k < 32; ++k) { const int tt = tt0 + k, t = t0 + tt; const int lo = max(t - hw, 0), hi = min(t + hw, T);
          D[tt * 264 + c] = (bf16_t)f2bf(sacc * frcp((float)(hi - lo)) - U[(tt + 8) * 256 + c]);
          sacc += U[(tt + hw + 8) * 256 + c] - U[(tt - hw + 8) * 256 + c]; } }
    LDS_BAR();
    { const int g = wave >> 1, rt = wave & 1, r32 = lane & 31, hi = lane >> 5; bf16_t* yc = (bf16_t*)(F.ws + WS_YC); const float* ps = F.in[I_POOLS] + l * 256;
      for (int nt = 0; nt < 2; ++nt) { f32x16 acc = {}; acc = mma32_lg<4>(acc, D + rt * 32 * 264 + g * 64, 264, (const bf16_t*)(F.ws + W_POOL) + (size_t)(g * 64 + nt * 32) * 64, 64, lane);
          const int col = g * 64 + nt * 32 + r32; const float sc = ps[col];
#pragma unroll
          for (int r = 0; r < 16; ++r) yc[(size_t)(row0 + rt * 32 + crow(r, hi)) * 1024 + 512 + col] = (bf16_t)f2bf(acc[r] * sc); } }
}
__device__ __forceinline__ void conv_z(const bf16_t* p, float (&z)[8]) { const u32x4 u = *(const u32x4*)p, cc = *(const u32x4*)(p + 512);
    z[0] = bflo(u.x) * bflo(cc.x); z[1] = bfhi(u.x) * bfhi(cc.x); z[2] = bflo(u.y) * bflo(cc.y); z[3] = bfhi(u.y) * bfhi(cc.y);
    z[4] = bflo(u.z) * bflo(cc.z); z[5] = bfhi(u.z) * bfhi(cc.z); z[6] = bflo(u.w) * bflo(cc.w); z[7] = bfhi(u.w) * bfhi(cc.w); }
__device__ __forceinline__ void conv_all(const Frame& F, int l, int nrows) {
    const bf16_t* px = (const bf16_t*)(F.ws + WS_PX); bf16_t* yc = (bf16_t*)(F.ws + WS_YC);
    const int c = (F.tid & 31) * 8;
    float w0[8], w1[8], w2[8], cb[8];
#pragma unroll
    for (int e = 0; e < 8; ++e) { w0[e] = F.in[I_CONVW][l * 768 + c + e]; w1[e] = F.in[I_CONVW][l * 768 + 256 + c + e]; w2[e] = F.in[I_CONVW][l * 768 + 512 + c + e]; cb[e] = F.in[I_CONVB][l * 256 + c + e]; }
    for (int it = F.bx * NTHR + F.tid; it < (nrows / 16) * 32; it += F.G * NTHR) { const int row0 = (it >> 5) * 16;
        const bool isctx = row0 >= NLAT; const int T = isctx ? 256 : 8192, t0 = isctx ? (row0 - NLAT) & 255 : row0 & 8191;
        const bf16_t* p = px + (size_t)row0 * INC + C_CONV + c;
        float zp[8], zc[8], zn[8];
        if (t0 > 0) conv_z(p - INC, zp); else {
#pragma unroll
            for (int e = 0; e < 8; ++e) zp[e] = 0.f; }
        conv_z(p, zc);
#pragma unroll 4
        for (int r = 0; r < 16; ++r) { const bf16_t* pr = p + (size_t)r * INC;
            if (t0 + r + 1 < T) conv_z(pr + INC, zn); else {
#pragma unroll
                for (int e = 0; e < 8; ++e) zn[e] = 0.f; }
            const u32x4 bw = *(const u32x4*)(pr + 256); const float bx[8] = {bflo(bw.x), bfhi(bw.x), bflo(bw.y), bfhi(bw.y), bflo(bw.z), bfhi(bw.z), bflo(bw.w), bfhi(bw.w)};
            float y[8];
#pragma unroll
            for (int e = 0; e < 8; ++e) { y[e] = bx[e] * (cb[e] + w0[e] * zp[e] + w1[e] * zc[e] + w2[e] * zn[e]); zp[e] = zc[e]; zc[e] = zn[e]; }
            u32x4 o; o.x = pk2(y[0], y[1]); o.y = pk2(y[2], y[3]); o.z = pk2(y[4], y[5]); o.w = pk2(y[6], y[7]);
            *(u32x4*)(yc + (size_t)(row0 + r) * 1024 + 768 + c) = o; }
    }
}

namespace att {
constexpr int STAGE_B = 40960, KSUB = 12288, VOFF = 24576, VSUB = 8192, LDS_WS = 3 * STAGE_B, LDS_OST = LDS_WS + 2048;
constexpr float THR = 8.0f;
__device__ __forceinline__ void glds16(const void* gsrc, unsigned lds_dst) { unsigned keep;
    asm volatile("s_mov_b32 %0, m0\n\ts_mov_b32 m0, %2\n\ts_nop 0\n\tglobal_load_lds_dwordx4 %1, off\n\ts_mov_b32 m0, %0" : "=&s"(keep) : "v"(gsrc), "s"(lds_dst) : "memory"); }
#define ATT_WAIT_BAR(N) asm volatile("s_waitcnt vmcnt(" #N ") lgkmcnt(0)\n\ts_barrier" ::: "memory")
__device__ __forceinline__ void qkt(f32x16& p0, f32x16& p1, const LAS char* Kslot, const bf16x8* qr, int r32, int hi) {
    const LAS char* kb = Kslot + hi * 1024 + r32 * 16; p0 = f32x16{}; p1 = f32x16{};
#pragma unroll
    for (int d0 = 0; d0 < 6; ++d0) {
        const bf16x8 b0 = *(const LAS bf16x8*)(kb + d0 * 2048), b1 = *(const LAS bf16x8*)(kb + d0 * 2048 + 512);
        p0 = __builtin_amdgcn_mfma_f32_32x32x16_bf16(b0, qr[d0], p0, 0, 0, 0); p1 = __builtin_amdgcn_mfma_f32_32x32x16_bf16(b1, qr[d0], p1, 0, 0, 0); }
}
__device__ __forceinline__ float rowmax(const f32x16& p0, const f32x16& p1) {
    float a = fmaxf(p0[0], p1[0]);
#pragma unroll
    for (int r = 1; r < 16; ++r) a = fmaxf(a, fmaxf(p0[r], p1[r]));
    auto rr = __builtin_amdgcn_permlane32_swap(__float_as_uint(a), __float_as_uint(a), false, false);
    return fmaxf(__uint_as_float(rr[0]), __uint_as_float(rr[1]));
}
__device__ __forceinline__ void pv(f32x16* o, int vb, bf16x8 pa0, bf16x8 pa1, bf16x8 pa2, bf16x8 pa3) {
#pragma unroll
    for (int d0 = 0; d0 < 2; ++d0) { s16x4 lo[4], hi[4];
#pragma unroll
        for (int ks = 0; ks < 4; ++ks) {
            asm volatile("ds_read_b64_tr_b16 %0,%1 offset:%c2" : "=&v"(lo[ks]) : "v"(vb), "i"(d0 * 4096 + ks * 1024) : "memory");
            asm volatile("ds_read_b64_tr_b16 %0,%1 offset:%c2" : "=&v"(hi[ks]) : "v"(vb), "i"(d0 * 4096 + ks * 1024 + 512) : "memory"); }
        asm volatile("s_waitcnt lgkmcnt(0)" ::: "memory"); __builtin_amdgcn_sched_barrier(0);
#define ATT_PK(k) (bf16x8){lo[k][0], lo[k][1], lo[k][2], lo[k][3], hi[k][0], hi[k][1], hi[k][2], hi[k][3]}
        o[d0] = __builtin_amdgcn_mfma_f32_32x32x16_bf16(pa0, ATT_PK(0), o[d0], 0, 0, 0);
        o[d0] = __builtin_amdgcn_mfma_f32_32x32x16_bf16(pa1, ATT_PK(1), o[d0], 0, 0, 0);
        o[d0] = __builtin_amdgcn_mfma_f32_32x32x16_bf16(pa2, ATT_PK(2), o[d0], 0, 0, 0);
        o[d0] = __builtin_amdgcn_mfma_f32_32x32x16_bf16(pa3, ATT_PK(3), o[d0], 0, 0, 0);
#undef ATT_PK
    }
}
__device__ __forceinline__ void unit(const Frame& F, int bh, int qrow, int orow, int nst) {
    const int tid = F.tid, lane = F.lane, wid = F.wave, r32 = lane & 31, hi = lane >> 5, h = bh & 3;
    const unsigned lds0 = (unsigned)(uintptr_t)F.lds;
    const LAS char* ring = (const LAS char*)F.lds;
    LAS float* wsf = (LAS float*)(F.lds + LDS_WS) + wid * 64;
    const char* kg = (const char*)(F.ws + WS_KT) + (size_t)bh * NKT * 12288; const char* vg = (const char*)(F.ws + WS_VT) + (size_t)bh * NKT * 8192;
    const bf16_t* Qw = (const bf16_t*)(F.ws + WS_QB) + (size_t)(qrow + wid * 32) * 384 + h * 96;
#define ATT_DMA(t, slot) do { const char* ks_ = kg + (size_t)(t) * 24576 + wid * 1024 + lane * 16; const char* vs_ = vg + (size_t)(t) * 16384 + wid * 1024 + lane * 16; \
        const unsigned kd_ = lds0 + (slot) * STAGE_B + wid * 1024, vd_ = kd_ + VOFF; \
        glds16(ks_, (unsigned)__builtin_amdgcn_readfirstlane(kd_)); glds16(ks_ + 8192, (unsigned)__builtin_amdgcn_readfirstlane(kd_ + 8192)); glds16(ks_ + 16384, (unsigned)__builtin_amdgcn_readfirstlane(kd_ + 16384)); \
        glds16(vs_, (unsigned)__builtin_amdgcn_readfirstlane(vd_)); glds16(vs_ + 8192, (unsigned)__builtin_amdgcn_readfirstlane(vd_ + 8192)); } while (0)
    ATT_DMA(0, 0); if (nst > 1) ATT_DMA(1, 1);
    bf16x8 qr[6];
#pragma unroll
    for (int d0 = 0; d0 < 6; ++d0) qr[d0] = *(const bf16x8*)(Qw + (size_t)r32 * 384 + d0 * 16 + hi * 8);
    float mhat = 0.f, l_reg = 0.f; f32x16 o[2]; o[0] = f32x16{}; o[1] = f32x16{};
    const int vb0 = (int)lds0 + VOFF + ((lane >> 4) & 1) * 32 + (lane & 3) * 8 + (4 * hi + ((lane & 15) >> 2)) * 64;
    int slot = 0; bool first = true;
    for (int t = 0; t < nst; ++t) {
        if (t + 1 < nst) ATT_WAIT_BAR(5); else ATT_WAIT_BAR(0);
        if (t + 2 < nst) { const int s2 = (slot == 0) ? 2 : slot - 1; ATT_DMA(t + 2, s2); }
#pragma unroll
        for (int s = 0; s < 2; ++s) {
            f32x16 p0, p1; qkt(p0, p1, ring + slot * STAGE_B + s * KSUB, qr, r32, hi);
            const float rm = rowmax(p0, p1);
            if (first) { mhat = rm; first = false; }
            else if (__any(rm - mhat > THR)) { const float dl = fmaxf(rm - mhat, 0.f); mhat += dl; const float f = __builtin_amdgcn_exp2f(-dl); l_reg *= f;
                if (hi == 0) wsf[r32] = f; LDS_WAIT();
#pragma unroll
                for (int r = 0; r < 16; ++r) { const float fr_ = wsf[crow(r, hi)]; o[0][r] *= fr_; o[1][r] *= fr_; } }
            float sacc = 0.f;
#pragma unroll
            for (int r = 0; r < 16; ++r) { p0[r] = __builtin_amdgcn_exp2f(p0[r] - mhat); p1[r] = __builtin_amdgcn_exp2f(p1[r] - mhat); sacc += p0[r] + p1[r]; }
            l_reg += sacc;
            u32x4 pw0, pw1, pw2, pw3;
            pw0 = (u32x4){cvt_pk_bf16(p0[0], p0[1]), cvt_pk_bf16(p0[2], p0[3]), cvt_pk_bf16(p0[4], p0[5]), cvt_pk_bf16(p0[6], p0[7])};
            pw1 = (u32x4){cvt_pk_bf16(p0[8], p0[9]), cvt_pk_bf16(p0[10], p0[11]), cvt_pk_bf16(p0[12], p0[13]), cvt_pk_bf16(p0[14], p0[15])};
            pw2 = (u32x4){cvt_pk_bf16(p1[0], p1[1]), cvt_pk_bf16(p1[2], p1[3]), cvt_pk_bf16(p1[4], p1[5]), cvt_pk_bf16(p1[6], p1[7])};
            pw3 = (u32x4){cvt_pk_bf16(p1[8], p1[9]), cvt_pk_bf16(p1[10], p1[11]), cvt_pk_bf16(p1[12], p1[13]), cvt_pk_bf16(p1[14], p1[15])};
            __builtin_amdgcn_sched_barrier(0);
            pv(o, vb0 + slot * STAGE_B + s * VSUB, __builtin_bit_cast(bf16x8, pw0), __builtin_bit_cast(bf16x8, pw1), __builtin_bit_cast(bf16x8, pw2), __builtin_bit_cast(bf16x8, pw3));
        }
        slot = (slot == 2) ? 0 : slot + 1;
    }
    { auto rr = __builtin_amdgcn_permlane32_swap(__float_as_uint(l_reg), __float_as_uint(l_reg), false, false); l_reg = __uint_as_float(rr[0]) + __uint_as_float(rr[1]); }
    if (hi == 0) wsf[32 + r32] = l_reg; LDS_WAIT();
    float rli[16];
#pragma unroll
    for (int r = 0; r < 16; ++r) rli[r] = frcp(wsf[32 + crow(r, hi)]);
    LAS bf16_t* stg = (LAS bf16_t*)(F.lds + LDS_OST) + wid * 2048;
#pragma unroll
    for (int r = 0; r < 16; ++r) { const int orow_ = crow(r, hi);
#pragma unroll
        for (int d0 = 0; d0 < 2; ++d0) stg[orow_ * 64 + d0 * 32 + r32] = (bf16_t)f2bf(o[d0][r] * rli[r]); }
    LDS_WAIT();
    bf16_t* Ow = (bf16_t*)(F.ws + WS_YC) + (size_t)(orow + wid * 32) * 1024 + 256 + h * 64;
#pragma unroll
    for (int i = 0; i < 4; ++i) { const int row = i * 8 + (lane >> 3), ch = lane & 7; const u32x4 v = *(const LAS u32x4*)(stg + row * 64 + ch * 8); *(u32x4*)(Ow + (size_t)row * 1024 + ch * 8) = v; }
    asm volatile("s_waitcnt lgkmcnt(0)\n\ts_barrier" ::: "memory");
#undef ATT_DMA
}
}

namespace att2 {
constexpr int KSL = 12288, VSL = 8192, LDS_K = 0, LDS_V = 3 * KSL, LDS_WS = LDS_V + 3 * VSL, LDS_OST = LDS_WS + 2048;
#define A2_SBAR() __builtin_amdgcn_sched_barrier(0)
#define A2_WAIT_BAR(N) asm volatile("s_waitcnt vmcnt(" #N ") lgkmcnt(0)\n\ts_barrier" ::: "memory")
__device__ __forceinline__ void glds16s(const void* sbase, unsigned voff, unsigned lds_dst) { unsigned keep;
    asm volatile("s_mov_b32 %0, m0\n\ts_mov_b32 m0, %3\n\ts_nop 4\n\tglobal_load_lds_dwordx4 %1, %2\n\ts_mov_b32 m0, %0" : "=&s"(keep) : "v"(voff), "s"(sbase), "s"(lds_dst) : "memory"); }
__device__ __forceinline__ unsigned cvtpk_s(float lo, float hi) { typedef float f2 __attribute__((ext_vector_type(2))); typedef __bf16 b2 __attribute__((ext_vector_type(2))); f2 v = {lo, hi}; b2 b = __builtin_convertvector(v, b2); return __builtin_bit_cast(unsigned, b); }
typedef short v4i16_t __attribute__((ext_vector_type(4)));
__device__ __forceinline__ s16x4 vtr(const LAS char* p) { return __builtin_bit_cast(s16x4, __builtin_amdgcn_ds_read_tr16_b64_v4i16((LAS v4i16_t*)p)); }
typedef int v8i_t __attribute__((ext_vector_type(8)));
__device__ __forceinline__ v8i_t cat8(u32x4 a, u32x4 b) { return (v8i_t){(int)a.x, (int)a.y, (int)a.z, (int)a.w, (int)b.x, (int)b.y, (int)b.z, (int)b.w}; }
__device__ __forceinline__ v8i_t kfrag8(const LAS char* kp, int i, int hi) { const LAS char* p = kp + ((i & 1) ? 4096 : hi * 2048) + (i >> 1) * 512; return cat8(*(const LAS u32x4*)p, *(const LAS u32x4*)(p + 1024)); }

template <bool NOMAX> __device__ __forceinline__ void unit(const Frame& F, int bh, int qrow, int orow, int NT) {
    const int lane = F.lane, wid = F.wave, r32 = lane & 31, hi = lane >> 5, h = bh & 3;
    const unsigned lds0 = (unsigned)(uintptr_t)F.lds;
    const LAS char* shm3 = (const LAS char*)F.lds;
    LAS float* wsf = (LAS float*)(F.lds + LDS_WS) + wid * 64;
    const char* kg = (const char*)(F.ws + WS_KT) + (size_t)bh * NKT * 6144; const char* vg = (const char*)(F.ws + WS_VT) + (size_t)bh * NKT * 8192 + wid * 1024; const unsigned l16 = lane * 16;
    const unsigned char* Qw = (const unsigned char*)(F.ws + WS_QB) + (size_t)(qrow + wid * 32) * 384 + h * 96;
    const int kp2 = wid < 6 ? wid : wid - 2;
#define A2_DMA_K(t, sl) do { const char* s_ = kg + (size_t)(t) * 6144; const unsigned d_ = lds0 + LDS_K + (sl) * KSL; \
        glds16s(s_ + kp2 * 1024, l16, (unsigned)__builtin_amdgcn_readfirstlane(d_ + kp2 * 1024)); } while (0)
#define A2_MFQ(ki, qi, CI) __builtin_amdgcn_mfma_scale_f32_32x32x64_f8f6f4(kf[ki], qf[qi], CI, 0, 0, 0, 0x7c7c7c7c, 0, 0x7f7f7f7f)
#define A2_DMA_V(t, sl) glds16s(vg + (size_t)(t) * 8192, l16, (unsigned)__builtin_amdgcn_readfirstlane(lds0 + LDS_V + (sl) * VSL + wid * 1024))
    const LAS char* kp0 = shm3 + LDS_K + r32 * 16;
    const LAS char* vp0 = shm3 + LDS_V + ((lane >> 4) & 1) * 32 + (lane & 3) * 8 + (4 * hi + ((lane & 15) >> 2)) * 64;
    v8i_t kf[4];
    A2_DMA_K(0, 0); A2_DMA_V(0, 0); A2_DMA_K(1, 1);
    v8i_t qf[2];
    { const unsigned char* qp = Qw + (size_t)r32 * 384; const u32x4 z4 = {0u, 0u, 0u, 0u};
      qf[0] = cat8(*(const u32x4*)(qp + hi * 32), *(const u32x4*)(qp + hi * 32 + 16));
      const u32x4 c0 = *(const u32x4*)(qp + 64), c1 = *(const u32x4*)(qp + 80); qf[1] = cat8(hi ? z4 : c0, hi ? z4 : c1); }
    float mhat = 0.f, l_reg = 0.f; f32x16 o[2]; o[0] = f32x16{}; o[1] = f32x16{};
    bool resc = false;
    f32x16 pA0, pA1, pB0, pB1;
    int sl_prev = 0, sl_cur = 0, sl_next = 1;
#define A2_ROT() do { sl_prev = sl_cur; sl_cur = sl_next; sl_next = (sl_next == 2) ? 0 : sl_next + 1; } while (0)
#define A2_RESC() do { if (!NOMAX && resc) { asm volatile("s_waitcnt lgkmcnt(0)" ::: "memory"); \
        _Pragma("unroll") for (int d_ = 0; d_ < 2; ++d_) _Pragma("unroll") for (int r = 0; r < 16; ++r) o[d_][r] *= wsf[crow(r, hi)]; } } while (0)
    A2_DMA_K(2, 2);
    A2_WAIT_BAR(5);
    {
#pragma unroll
      for (int i = 0; i < 4; ++i) kf[i] = kfrag8(kp0, i, hi);
      pA0 = A2_MFQ(0, 0, (f32x16{})); pA0 = A2_MFQ(1, 1, pA0); pA1 = A2_MFQ(2, 0, (f32x16{})); pA1 = A2_MFQ(3, 1, pA1);
      if constexpr (!NOMAX) { float a = fmaxf(pA0[0], pA1[0]);
#pragma unroll
      for (int r = 1; r < 16; ++r) a = fmaxf(a, fmaxf(pA0[r], pA1[r]));
      { auto rr = __builtin_amdgcn_permlane32_swap(__float_as_uint(a), __float_as_uint(a), false, false); a = fmaxf(__uint_as_float(rr[0]), __uint_as_float(rr[1])); }
      mhat = a; }
#pragma unroll
      for (int r = 0; r < 16; ++r) { pA0[r] = __builtin_amdgcn_exp2f(pA0[r] - mhat); pA1[r] = __builtin_amdgcn_exp2f(pA1[r] - mhat); } }
    A2_WAIT_BAR(0);
    A2_DMA_K(3, 0); A2_DMA_V(1, 1);
    A2_ROT();
    { const LAS char* kp = kp0 + sl_cur * KSL;
#pragma unroll
      for (int i = 0; i < 4; ++i) kf[i] = kfrag8(kp, i, hi); }
    A2_WAIT_BAR(2);
    s16x4 vlo[8], vhi[8]; u32x4 pw0, pw1, pw2, pw3;
#define A2_PKW(P, B) cvtpk_s(P[B], P[B + 1])
#define A2_PAF(k) __builtin_bit_cast(bf16x8, pw##k)
#define A2_VFR(i) (bf16x8){vlo[i][0], vlo[i][1], vlo[i][2], vlo[i][3], vhi[i][0], vhi[i][1], vhi[i][2], vhi[i][3]}
#define A2_PIN(x) asm volatile("" : "+v"(x))
#define A2_MX3(a, b, c) __builtin_fmaxf(__builtin_fmaxf((a), (b)), (c))
#define A2_GAPA(MF, A0, A1, A2, A3, W0, W1, PW) do { MF; sacc += A0; sacc += A1; sacc += A2; sacc += A3; A2_PIN(sacc); W0; W1; A2_PIN(PW); A2_SBAR(); } while (0)
#define A2_GAPM(MF) do { MF; A2_SBAR(); } while (0)
#define A2_EX(v) __builtin_amdgcn_exp2f(v)
#define A2_SH(v) (NOMAX ? (v) : (v) - mhat)
#define A2_GAPB(MF, X, B) do { MF; X[B] = A2_EX(A2_SH(X[B])); X[B + 1] = A2_EX(A2_SH(X[B + 1])); X[B + 2] = A2_EX(A2_SH(X[B + 2])); X[B + 3] = A2_EX(A2_SH(X[B + 3])); A2_PIN(X); A2_SBAR(); } while (0)
#define A2_VRD(i) do { vlo[i] = vtr(vp_ + (((i) >> 2) * 4096 + ((i) & 3) * 1024)); vhi[i] = vtr(vp_ + (((i) >> 2) * 4096 + ((i) & 3) * 1024 + 512)); } while (0)
#define A2_KRD(G, j) do { if (G) { if ((j) < 4) kf[(j) < 4 ? (j) : 0] = kfrag8(kp0 + sl_next * KSL, (j) < 4 ? (j) : 0, hi); A2_SBAR(); } } while (0)
#define A2_MF(C, kk, qq, CI) C = A2_MFQ(kk, qq, CI)
#define A2_NOP ((void)0)
#define A2_STEP(C0, C1, P0, P1, t, GK, GV, GL) do { A2_SBAR(); \
    const LAS char* vp_ = vp0 + sl_prev * VSL; \
    A2_VRD(0); A2_SBAR(); float sacc = (P0[0] + P0[1]); \
    A2_GAPA(A2_MF(C0, 0, 0, (f32x16{})), P0[2], P0[3], P0[4], P0[5],     pw0[0] = A2_PKW(P0, 0), pw0[1] = A2_PKW(P0, 2), pw0); \
    A2_VRD(4); A2_SBAR(); A2_GAPA(A2_NOP, P0[6], P0[7], P0[8], P0[9],     pw0[2] = A2_PKW(P0, 4), pw0[3] = A2_PKW(P0, 6), pw0); \
    A2_VRD(1); A2_SBAR(); A2_GAPA(A2_MF(C1, 2, 0, (f32x16{})), P0[10], P0[11], P0[12], P0[13], pw1[0] = A2_PKW(P0, 8), pw1[1] = A2_PKW(P0, 10), pw1); \
    A2_VRD(5); A2_SBAR(); A2_GAPA(A2_NOP,   P0[14], P0[15], P1[0], P1[1],   pw1[2] = A2_PKW(P0, 12), pw1[3] = A2_PKW(P0, 14), pw1); \
    A2_VRD(2); A2_SBAR(); A2_GAPA(A2_MF(C0, 1, 1, C0),   P1[2], P1[3], P1[4], P1[5],     pw2[0] = A2_PKW(P1, 0), pw2[1] = A2_PKW(P1, 2), pw2); \
    A2_VRD(6); A2_SBAR(); A2_GAPA(A2_NOP,   P1[6], P1[7], P1[8], P1[9],     pw2[2] = A2_PKW(P1, 4), pw2[3] = A2_PKW(P1, 6), pw2); \
    A2_VRD(3); A2_SBAR(); A2_GAPA(A2_MF(C1, 3, 1, C1),   P1[10], P1[11], P1[12], P1[13], pw3[0] = A2_PKW(P1, 8), pw3[1] = A2_PKW(P1, 10), pw3); \
    A2_VRD(7); A2_SBAR(); A2_GAPA(A2_NOP,   P1[14], P1[15], 0.f, 0.f,       pw3[2] = A2_PKW(P1, 12), pw3[3] = A2_PKW(P1, 14), pw3); \
    l_reg += sacc; \
    if (GK) { A2_DMA_K((t) + 3, sl_cur); } if (GV) { A2_DMA_V((t) + 1, sl_next); } \
    if constexpr (!NOMAX) { float a = A2_MX3(C0[0], C0[1], C1[0]), b = A2_MX3(C0[2], C0[3], C1[1]); a = A2_MX3(a, C1[2], C1[3]); \
      _Pragma("unroll") for (int r = 4; r < 16; r += 4) { a = A2_MX3(a, C0[r], C0[r + 1]); b = A2_MX3(b, C0[r + 2], C0[r + 3]); a = A2_MX3(a, C1[r], C1[r + 1]); b = A2_MX3(b, C1[r + 2], C1[r + 3]); } \
      float rm = __builtin_fmaxf(a, b); { auto rr = __builtin_amdgcn_permlane32_swap(__float_as_uint(rm), __float_as_uint(rm), false, false); rm = __builtin_fmaxf(__uint_as_float(rr[0]), __uint_as_float(rr[1])); } \
      resc = false; \
      if (__builtin_expect(__any(rm - mhat > 8.0f), 0)) { const float dl = __builtin_fmaxf(rm - mhat, 0.f); mhat += dl; \
        const float f = __builtin_amdgcn_exp2f(-dl); l_reg *= f; if (hi == 0) wsf[r32] = f; resc = true; } } \
    A2_SBAR(); \
    A2_GAPB(o[0] = __builtin_amdgcn_mfma_f32_32x32x16_bf16(A2_PAF(0), A2_VFR(0), o[0], 0, 0, 0), C0, 0); \
    A2_KRD(GL, 0); A2_GAPB(o[1] = __builtin_amdgcn_mfma_f32_32x32x16_bf16(A2_PAF(0), A2_VFR(4), o[1], 0, 0, 0), C0, 4); \
    A2_KRD(GL, 1); A2_GAPB(o[0] = __builtin_amdgcn_mfma_f32_32x32x16_bf16(A2_PAF(1), A2_VFR(1), o[0], 0, 0, 0), C0, 8); \
    A2_KRD(GL, 2); A2_GAPB(o[1] = __builtin_amdgcn_mfma_f32_32x32x16_bf16(A2_PAF(1), A2_VFR(5), o[1], 0, 0, 0), C0, 12); \
    A2_KRD(GL, 3); A2_GAPB(o[0] = __builtin_amdgcn_mfma_f32_32x32x16_bf16(A2_PAF(2), A2_VFR(2), o[0], 0, 0, 0), C1, 0); \
    A2_KRD(GL, 4); A2_GAPB(o[1] = __builtin_amdgcn_mfma_f32_32x32x16_bf16(A2_PAF(2), A2_VFR(6), o[1], 0, 0, 0), C1, 4); \
    A2_KRD(GL, 5); A2_GAPB(o[0] = __builtin_amdgcn_mfma_f32_32x32x16_bf16(A2_PAF(3), A2_VFR(3), o[0], 0, 0, 0), C1, 8); \
    A2_GAPB(o[1] = __builtin_amdgcn_mfma_f32_32x32x16_bf16(A2_PAF(3), A2_VFR(7), o[1], 0, 0, 0), C1, 12); \
    } while (0)
    int t = 1;
    for (; t + 5 < NT; t += 2) {
        A2_STEP(pB0, pB1, pA0, pA1, t, true, true, true);     A2_WAIT_BAR(2); A2_RESC(); A2_ROT();
        A2_STEP(pA0, pA1, pB0, pB1, t + 1, true, true, true); A2_WAIT_BAR(2); A2_RESC(); A2_ROT();
    }
#define A2_ENDW(tt) do { if ((tt) + 3 < NT) { A2_WAIT_BAR(2); } else if ((tt) + 2 < NT) { A2_WAIT_BAR(1); } else { A2_WAIT_BAR(0); } } while (0)
    for (; t + 1 < NT; t += 2) {
        A2_STEP(pB0, pB1, pA0, pA1, t, (t + 3 < NT), (t + 1 < NT), (t + 1 < NT));     A2_ENDW(t);     A2_RESC(); A2_ROT();
        A2_STEP(pA0, pA1, pB0, pB1, t + 1, (t + 4 < NT), (t + 2 < NT), (t + 2 < NT)); A2_ENDW(t + 1); A2_RESC(); A2_ROT();
    }
    A2_STEP(pB0, pB1, pA0, pA1, NT - 1, false, false, false); A2_RESC();
    { float sacc = pB0[0] + pB0[1];
#pragma unroll
      for (int r = 2; r < 16; ++r) sacc += pB0[r];
#pragma unroll
      for (int r = 0; r < 16; ++r) sacc += pB1[r];
      l_reg += sacc;
      pw0 = (u32x4){A2_PKW(pB0, 0), A2_PKW(pB0, 2), A2_PKW(pB0, 4), A2_PKW(pB0, 6)}; pw1 = (u32x4){A2_PKW(pB0, 8), A2_PKW(pB0, 10), A2_PKW(pB0, 12), A2_PKW(pB0, 14)};
      pw2 = (u32x4){A2_PKW(pB1, 0), A2_PKW(pB1, 2), A2_PKW(pB1, 4), A2_PKW(pB1, 6)}; pw3 = (u32x4){A2_PKW(pB1, 8), A2_PKW(pB1, 10), A2_PKW(pB1, 12), A2_PKW(pB1, 14)};
      A2_SBAR();
      const int vb = (int)lds0 + LDS_V + ((lane >> 4) & 1) * 32 + (lane & 3) * 8 + (4 * hi + ((lane & 15) >> 2)) * 64 + sl_cur * VSL;
      att::pv(o, vb, A2_PAF(0), A2_PAF(1), A2_PAF(2), A2_PAF(3)); }
    { auto rr = __builtin_amdgcn_permlane32_swap(__float_as_uint(l_reg), __float_as_uint(l_reg), false, false); l_reg = __uint_as_float(rr[0]) + __uint_as_float(rr[1]); }
    if (hi == 0) wsf[32 + r32] = l_reg; LDS_WAIT();
    float rli[16];
#pragma unroll
    for (int r = 0; r < 16; ++r) rli[r] = __builtin_amdgcn_rcpf(wsf[32 + crow(r, hi)]);
    LAS bf16_t* stg = (LAS bf16_t*)(F.lds + LDS_OST) + wid * 2048;
#pragma unroll
    for (int r = 0; r < 16; ++r) { const int orow_ = crow(r, hi);
#pragma unroll
        for (int d0 = 0; d0 < 2; ++d0) stg[orow_ * 64 + d0 * 32 + r32] = (bf16_t)f2bf(o[d0][r] * rli[r]); }
    LDS_WAIT();
    bf16_t* Ow = (bf16_t*)(F.ws + WS_YC) + (size_t)(orow + wid * 32) * 1024 + 256 + h * 64;
#pragma unroll
    for (int i = 0; i < 4; ++i) { const int row = i * 8 + (lane >> 3), ch = lane & 7; const u32x4 v = *(const LAS u32x4*)(stg + row * 64 + ch * 8); *(u32x4*)(Ow + (size_t)row * 1024 + ch * 8) = v; }
    asm volatile("s_waitcnt lgkmcnt(0)\n\ts_barrier" ::: "memory");
}
}

__device__ __forceinline__ void ph_norm2_route(const Frame& F, int l, int ntok) {
    LAS bf16_t* A = (LAS bf16_t*)F.lds;
    LAS float* PART = (LAS float*)(F.lds + 66048);
    LAS float* LOG = (LAS float*)(F.lds + 131584);
    LAS int* HIST = (LAS int*)(F.lds + 139776);
    const int tid = F.tid, lane = F.lane, wave = F.wave, r32 = lane & 31, hi = lane >> 5;
    const int tpb = ntok / F.G, tok0 = F.bx * tpb;
    int* eidx = (int*)(F.ws + T_EIDX); float* ew = (float*)(F.ws + T_EW);
    const float* brt = F.in[I_BRT] + l * 64;
    if (tid < 64) HIST[tid] = 0;
    LAS f32x4* AV = (LAS f32x4*)(F.lds + 140288);
    LAS f32x4* SHV = AV + 512;
    const int mr_first = mod_row_of(tok0), mr_last = mod_row_of(tok0 + tpb - 1);
    { const int set = tid >> 8, idx = tid & 255, mrs = set ? mr_last : mr_first;
      const f32x4 gv = ((const f32x4*)(F.in[I_GFFN] + l * 1024))[idx], scv = ((const f32x4*)modp(F, l, mrs, 4))[idx];
      AV[tid] = gv * (scv + 1.0f); SHV[tid] = ((const f32x4*)modp(F, l, mrs, 3))[idx]; }
    bf16x8 wrt[2][8];
#pragma unroll
    for (int nt = 0; nt < 2; ++nt)
#pragma unroll
        for (int ks = 0; ks < 8; ++ks) wrt[nt][ks] = *(const bf16x8*)((const bf16_t*)(F.ws + W_RT) + (size_t)(nt * 32 + r32) * 1024 + wave * 128 + ks * 16 + hi * 8);
    f32x4 xn[4][4]; u32x2 mn[4][4];
#pragma unroll
    for (int rr = 0; rr < 4; ++rr) { const int t = min(wave * 4 + rr, tpb - 1); const f32x4* xr = (const f32x4*)stream_row(F, l, tok0 + t) + lane; const u32x2* mg = (const u32x2*)((const bf16_t*)(F.ws + WS_YC) + (size_t)(tok0 + t) * 1024) + lane;
#pragma unroll
        for (int j = 0; j < 4; ++j) { xn[rr][j] = xr[64 * j]; mn[rr][j] = mg[64 * j]; } }
    for (int b0 = 0; b0 < tpb; b0 += 32) {
        __syncthreads();
        { f32x4 v[4][4];
#pragma unroll
          for (int rr = 0; rr < 4; ++rr) {
#pragma unroll
                for (int j = 0; j < 4; ++j) { const u32x2 w = mn[rr][j]; v[rr][j] = xn[rr][j] + (f32x4){bflo(w.x), bfhi(w.x), bflo(w.y), bfhi(w.y)}; } }
#pragma unroll
          for (int rr = 0; rr < 4; ++rr) { const int r = wave * 4 + rr, t = b0 + r; LAS u32x2* a = (LAS u32x2*)(A + r * 1032) + lane;
            if (t < tpb) { const int row = tok0 + t, mr = mod_row_of(row); f32x4 y[4];
                f32x4* xo = (f32x4*)((row < NLAT) ? F.out + (size_t)row * 1024 : (float*)(F.ws + WS_CTXS) + (size_t)(row - NLAT) * 1024) + lane;
#pragma unroll
                for (int j = 0; j < 4; ++j) xo[64 * j] = v[rr][j];
                { float s2 = 0.f;
#pragma unroll
                  for (int j = 0; j < 4; ++j) s2 += (v[rr][j].x * v[rr][j].x + v[rr][j].y * v[rr][j].y) + (v[rr][j].z * v[rr][j].z + v[rr][j].w * v[rr][j].w);
                  const float rstd = frsq(wave_sum(s2) * (1.f / 1024.f) + EPS); const int vb = (mr == mr_first ? 0 : 256) + lane;
#pragma unroll
                  for (int j = 0; j < 4; ++j) y[j] = v[rr][j] * rstd * AV[vb + 64 * j] + SHV[vb + 64 * j]; }
                unsigned* o8 = (unsigned*)(F.ws + WS_HX8 + (size_t)row * 1024) + lane;
#pragma unroll
                for (int j = 0; j < 4; ++j) { a[64 * j] = (u32x2){pk2(y[j].x, y[j].y), pk2(y[j].z, y[j].w)}; o8[64 * j] = pk4_fp8(y[j].x, y[j].y, y[j].z, y[j].w); }
            } else {
#pragma unroll
                for (int j = 0; j < 4; ++j) a[64 * j] = (u32x2){0u, 0u}; } } }
        if (b0 + 32 < tpb) {
#pragma unroll
            for (int rr = 0; rr < 4; ++rr) { const int t = min(b0 + 32 + wave * 4 + rr, tpb - 1); const f32x4* xr = (const f32x4*)stream_row(F, l, tok0 + t) + lane; const u32x2* mg = (const u32x2*)((const bf16_t*)(F.ws + WS_YC) + (size_t)(tok0 + t) * 1024) + lane;
#pragma unroll
                for (int j = 0; j < 4; ++j) { xn[rr][j] = xr[64 * j]; mn[rr][j] = mg[64 * j]; } } }
        __syncthreads();
#pragma unroll
        for (int nt = 0; nt < 2; ++nt) { f32x16 acc = {};
#pragma unroll
            for (int ks = 0; ks < 8; ++ks) { const bf16x8 a = *(const LAS bf16x8*)(A + wave * 128 + r32 * 1032 + ks * 16 + hi * 8); acc = __builtin_amdgcn_mfma_f32_32x32x16_bf16(a, wrt[nt][ks], acc, 0, 0, 0); }
#pragma unroll
            for (int r = 0; r < 16; ++r) PART[(wave * 32 + crow(r, hi)) * 64 + nt * 32 + r32] = acc[r]; }
        __syncthreads();
        for (int i = tid; i < 2048; i += NTHR) { float s = 0.f;
#pragma unroll
            for (int w = 0; w < 8; ++w) s += PART[w * 2048 + i];
            LOG[i] = s; }
        __syncthreads();
        for (int rr = 0; rr < 4; ++rr) { const int r = wave * 4 + rr, t = b0 + r; if (t >= tpb) continue;
            const float sc = sigmoidf_(LOG[r * 64 + lane]); float v = sc + brt[lane]; float ssel = 0.f, mys = 0.f; int myi = 0;
#pragma unroll
            for (int k = 0; k < TOPK; ++k) { const float mx = wave_max(v); const unsigned long long bal = __ballot(v == mx); const int win = __ffsll((long long)bal) - 1;
                const float sw = lane_bcast(sc, win); ssel += sw; if (lane == k) { mys = sw; myi = win; } if (lane == win) v = -INFINITY; }
            if (lane < TOPK) { eidx[(size_t)(tok0 + t) * 6 + lane] = myi; ew[(size_t)(tok0 + t) * 6 + lane] = mys * frcp(ssel) * 2.5f; __hip_atomic_fetch_add(&HIST[myi], 1, __ATOMIC_RELAXED, __HIP_MEMORY_SCOPE_WORKGROUP); } }
    }
    __syncthreads();
    if (tid < 64) ((int*)(F.ws + T_HIST))[F.bx * 64 + tid] = HIST[tid];
}

__device__ __forceinline__ void ph_assign(const Frame& F, int ntok) {
    LAS int* BASE = (LAS int*)F.lds; LAS int* CUR = BASE + 64; LAS int* START = BASE + 128; LAS int* TOT = BASE + 192; LAS int* MISC = BASE + 256;
    const int tid = F.tid, hb = F.G, c = 0, tpb = ntok / F.G, ctok0 = 0, ctoks = ntok;
    const int* hist = (const int*)(F.ws + T_HIST); int* rtok = (int*)(F.ws + T_RTOK); float* rw = (float*)(F.ws + T_RW); int* slot = (int*)(F.ws + T_SLOT);
    int* tile_e = (int*)(F.ws + T_TILEE);
    __syncthreads();
    { LAS int* PT = BASE + 512; LAS int* PB = PT + 512;
      const int e = tid & 63, part = tid >> 6; int tot = 0, bef = 0;
#pragma unroll 8
      for (int k = 0; k < 32; ++k) { const int b = c * hb + part * 32 + k; if (b < (c + 1) * hb) { const int v = hist[b * 64 + e]; tot += v; if (b < F.bx) bef += v; } }
      PT[part * 64 + e] = tot; PB[part * 64 + e] = bef; }
    __syncthreads();
    if (tid < 64) { int tot = 0, bef = 0; for (int p8 = 0; p8 < 8; ++p8) { tot += BASE[512 + p8 * 64 + tid]; bef += BASE[1024 + p8 * 64 + tid]; } TOT[tid] = tot; BASE[tid] = bef; CUR[tid] = 0; }
    __syncthreads();
    if (tid == 0) { int s = 0; for (int e = 0; e < 64; ++e) { START[e] = s; s += (TOT[e] + 255) / 256 * 256; } MISC[0] = s; }
    __syncthreads();
    const int sstart = MISC[0];
    const int* eidx = (const int*)(F.ws + T_EIDX); const float* ew = (const float*)(F.ws + T_EW);
    for (int i = tid; i < tpb * 6; i += NTHR) { const int tok = F.bx * tpb + i / 6, k = i % 6; const int e = eidx[(size_t)tok * 6 + k];
        const int pos = START[e] + BASE[e] + __hip_atomic_fetch_add(&CUR[e], 1, __ATOMIC_RELAXED, __HIP_MEMORY_SCOPE_WORKGROUP); rtok[pos] = tok; rw[pos] = ew[(size_t)tok * 6 + k]; slot[(size_t)tok * 8 + k] = pos; }
    for (int i = tid; i < tpb; i += NTHR) { const int tok = F.bx * tpb + i, pos = sstart + (tok - ctok0); rtok[pos] = tok; rw[pos] = 1.0f; slot[(size_t)tok * 8 + 6] = pos; }
    if (F.bx == c * hb) {
        for (int e = 0; e < 64; ++e) { const int p0 = START[e] + TOT[e], p1 = START[e] + (TOT[e] + 255) / 256 * 256;
            for (int p = p0 + tid; p < p1; p += NTHR) { rtok[p] = ctok0; rw[p] = 0.f; }
            for (int tl = START[e] / 256 + tid; tl < p1 / 256; tl += NTHR) tile_e[tl] = e; }
        for (int tl = sstart / 256 + tid; tl < (sstart + ctoks) / 256; tl += NTHR) tile_e[tl] = 64;
        if (tid == 0) tile_e[2047] = (sstart + ctoks) / 256;
    }
}

template <bool FUSE_NORM> __device__ __forceinline__ void ph_combine(const Frame& F, int l, int c, int ntok) {
    const int lane = F.lane; const int tpb = ntok / F.G, tok0 = F.bx * tpb; (void)c;
    const int* slot = (const int*)(F.ws + T_SLOT); const unsigned char* ys = (const unsigned char*)(F.ws + WS_YS);
    int mr_cur = -1; f32x4 gtv[2][2], av[2][2], shv[2][2];
    for (int t = F.wave; t < tpb; t += NWAVES) { const int tok = tok0 + t, mr = mod_row_of(tok);
        if (mr != mr_cur) { mr_cur = mr; const float* gt = modp(F, l, mr, 5);
#pragma unroll
            for (int j = 0; j < 2; ++j)
#pragma unroll
                for (int h2 = 0; h2 < 2; ++h2) { const int c0 = 8 * lane + 512 * j + 4 * h2; gtv[j][h2] = *(const f32x4*)(gt + c0);
                    if constexpr (FUSE_NORM) { const f32x4 gv = *(const f32x4*)(F.in[I_GMIX] + 1024 + c0), scv = *(const f32x4*)(modp(F, 1, mr, 1) + c0); av[j][h2] = gv * (scv + 1.0f); shv[j][h2] = *(const f32x4*)(modp(F, 1, mr, 0) + c0); } } }
        float* xr = (tok < NLAT) ? F.out + (size_t)tok * 1024 : (float*)(F.ws + WS_CTXS) + (size_t)(tok - NLAT) * 1024;
        const int sv = slot[(size_t)tok * 8 + (lane & 7)];
        u32x2 y[7][2];
#pragma unroll
        for (int k = 0; k < 7; ++k) { const int sk = __builtin_amdgcn_readlane(sv, k); const u32x2* yr = (const u32x2*)(ys + (size_t)sk * 1024) + lane; y[k][0] = yr[0]; y[k][1] = yr[64]; }
        f32x4 xv[2][2];
#pragma unroll
        for (int j = 0; j < 2; ++j) { xv[j][0] = *(const f32x4*)(xr + 8 * lane + 512 * j); xv[j][1] = *(const f32x4*)(xr + 8 * lane + 512 * j + 4); }
#pragma unroll
        for (int j = 0; j < 2; ++j) { f32x4 a0 = {0.f, 0.f, 0.f, 0.f}, a1 = {0.f, 0.f, 0.f, 0.f};
#pragma unroll
            for (int k = 0; k < 7; ++k) { a0 += up4_fp8(y[k][j].x); a1 += up4_fp8(y[k][j].y); }
            xv[j][0] = xv[j][0] + gtv[j][0] * a0; xv[j][1] = xv[j][1] + gtv[j][1] * a1;
            *(f32x4*)(xr + 8 * lane + 512 * j) = xv[j][0]; *(f32x4*)(xr + 8 * lane + 512 * j + 4) = xv[j][1]; }
        if constexpr (FUSE_NORM) {
            float ss = 0.f;
#pragma unroll
            for (int j = 0; j < 2; ++j)
#pragma unroll
                for (int h2 = 0; h2 < 2; ++h2) { const f32x4 v = xv[j][h2]; ss += (v.x * v.x + v.y * v.y) + (v.z * v.z + v.w * v.w); }
            const float rstd = frsq(wave_sum(ss) * (1.f / 1024.f) + EPS);
            unsigned char* h8 = F.ws + WS_HX8 + (size_t)tok * 1024;
#pragma unroll
            for (int j = 0; j < 2; ++j) { const int c0 = 8 * lane + 512 * j; f32x4 y[2];
#pragma unroll
                for (int h2 = 0; h2 < 2; ++h2) y[h2] = xv[j][h2] * rstd * av[j][h2] + shv[j][h2];
                *(u32x2*)(h8 + c0) = (u32x2){pk4_fp8(y[0].x, y[0].y, y[0].z, y[0].w), pk4_fp8(y[1].x, y[1].y, y[1].z, y[1].w)}; }
        }
    }
}
__device__ __forceinline__ Frame phase_frame(const Frame& F) {
    Frame Q = F; int t = threadIdx.x; asm volatile("" : "+v"(t)); Q.tid = t; Q.lane = t & 63; Q.wave = __builtin_amdgcn_readfirstlane(t >> 6);
    unsigned long long w = (unsigned long long)F.ws; asm volatile("" : "+s"(w)); Q.ws = (unsigned char*)(GAS unsigned char*)w;
    return Q;
}
constexpr int PH_PER_LAYER = 13, PH_TOTAL = 1 + 2 * PH_PER_LAYER;
__global__ void __launch_bounds__(NTHR, 2) mk_fwd(Params p) {
    extern __shared__ __attribute__((aligned(16))) unsigned char lds_raw[];
    Frame F0;
    F0.lds = (LAS unsigned char*)lds_raw; F0.ws = p.ws; F0.in = p.in; F0.out = p.out;
    F0.tid = threadIdx.x; F0.lane = F0.tid & 63; F0.wave = __builtin_amdgcn_readfirstlane(F0.tid >> 6); F0.bx = blockIdx.x; F0.G = gridDim.x;
    volatile LAS unsigned* MISC = (volatile LAS unsigned*)(F0.lds + MISC_OFF);
    if (F0.tid < 64) MISC[F0.tid] = 0u;
    __syncthreads();
    const int lo = p.ph_lo, hi = p.ph_hi;
    XcdBarrier bar; bar.bar = (unsigned*)(F0.ws + WS_CTL) + CW_BAR; bar.x = 0; bar.st = MISC + 8;
    if (hi - lo > 1) bar = xcd_barrier_post((unsigned*)(F0.ws + WS_CTL) + CW_BAR, MISC + 8);
#ifndef MK_SITE
#define MK_SITE -1
#endif
#define SITE(n) (MK_SITE < 0 || MK_SITE == (n))
#ifndef MK_REP_MASK
#define MK_REP_MASK 0
#endif
#define NREP(n) (((MK_REP_MASK >> (n)) & 1) ? 2 : 1)
#define RUN(k) (lo <= (k) && (k) < hi)
#define SEAM(k) do { if (RUN(k) && RUN((k) + 1)) { TSEC_BEGIN(300, F0.lds); xcd_barrier(bar); TSEC_END(300, F0.lds); } } while (0)
    int ph = 0;
    if (SITE(0) && RUN(ph)) TSEC_BEGIN(400 + 0, F0.lds); if (SITE(0) && RUN(ph)) for (int rep_ = 0; rep_ < NREP(0); ++rep_) { const Frame F = phase_frame(F0); ph_pre(F); }
    TSEC_END(400 + 99, F0.lds); SEAM(ph); ++ph;
    for (int l = 0; l < 2; ++l) {
        const int ntok = (l == 0) ? NTOK : NLAT, nM = ntok / 256;
        if (SITE(1) && RUN(ph)) TSEC_BEGIN(400 + 1, F0.lds); if (SITE(1) && RUN(ph)) for (int rep_ = 0; rep_ < NREP(1); ++rep_) { const Frame F = phase_frame(F0); ph_convert(F, l); __syncthreads(); if (l == 0) ph_norm1(F, l); }
        TSEC_END(400 + 99, F0.lds); SEAM(ph); ++ph;
        if (SITE(2) && RUN(ph)) TSEC_BEGIN(400 + 2, F0.lds); if (SITE(2) && RUN(ph)) for (int rep_ = 0; rep_ < NREP(2); ++rep_) { const Frame F = phase_frame(F0);
            SchedPlain S{(const char*)(F.ws + WS_HX8), (const char*)(F.ws + W_IN), 1024u, 1024u, 8, NTOK / 256, INCP / 256, F.G, F.bx};
            EpiWin E{(bf16_t*)(F.ws + WS_PX), (float*)(F.ws + T_GATE)};
            gg::gemm_phase(F.lds, S, E);
        }
        TSEC_END(400 + 99, F0.lds); SEAM(ph); ++ph;
        if (SITE(3) && RUN(ph)) TSEC_BEGIN(400 + 3, F0.lds); if (SITE(3) && RUN(ph)) for (int rep_ = 0; rep_ < NREP(3); ++rep_) { const Frame F = phase_frame(F0);
            for (int r2 = 0; r2 < NREP(16); ++r2) mla_prep(F, l);
            for (int r2 = 0; r2 < NREP(17); ++r2) { P1Regs R = ml_pass1_load(F, F.bx);
                for (int u = F.bx; u < 64 * NCHK; u += F.G) { const P1Regs Rn = ml_pass1_load(F, (u + F.G < 64 * NCHK) ? u + F.G : u); ml_pass1_unit(F, l, u, R); R = Rn; } }
            for (int r2 = 0; r2 < NREP(18); ++r2) { PoolRegs R = pool_load(F, F.bx);
                for (int u = F.bx; u < ntok / 64; u += F.G) { const PoolRegs Rn = pool_load(F, (u + F.G < ntok / 64) ? u + F.G : u); pool_unit(F, l, u, R); R = Rn; } }
            for (int r2 = 0; r2 < NREP(19); ++r2) conv_all(F, l, ntok);
            __syncthreads();
        }
        TSEC_END(400 + 99, F0.lds); SEAM(ph); ++ph;
        if (SITE(4) && RUN(ph)) TSEC_BEGIN(400 + 4, F0.lds); if (SITE(4) && RUN(ph)) for (int rep_ = 0; rep_ < NREP(4); ++rep_) { const Frame F = phase_frame(F0);
            ml_pass2(F);
            float gq = 0.f, gk = 0.f; for (int d = 0; d < 96; ++d) { gq = fmaxf(gq, fabsf(F.in[I_GQN][l * 96 + d])); gk = fmaxf(gk, fabsf(F.in[I_GKN][l * 96 + d])); }
            const bool nomax = (14.2f * gq * gk <= 64.0f);
            const int nunits = 1024 + (l == 0 ? 32 : 0);
#define ATT_UNITS(NM) for (int i = 0; ; ++i) { const int L = i * F.G + F.bx; if (L >= nunits) break; \
                if (L < 1024) { const int bh = (L >> 8) * 8 + (L & 7), qb = (L & 255) >> 3, b = bh >> 2; att2::unit<NM>(F, bh, b * 8192 + qb * 256, b * 8192 + qb * 256, 132); } \
                else { const int bh = L - 1024, b = bh >> 2; att2::unit<NM>(F, bh, NLAT + b * 256, NLAT + b * 256, 4); } }
            if (nomax) { ATT_UNITS(true) } else { ATT_UNITS(false) }
#undef ATT_UNITS
        }
        TSEC_END(400 + 99, F0.lds); SEAM(ph); ++ph;
        if (SITE(5) && RUN(ph)) TSEC_BEGIN(400 + 5, F0.lds); if (SITE(5) && RUN(ph)) for (int rep_ = 0; rep_ < NREP(5); ++rep_) { const Frame F = phase_frame(F0);
            const int npc = (l == 0) ? 66 : 64, nun = 32 * npc;
            for (int u = F.bx; u < nun; u += F.G) { const int bh = u / npc, pc = u % npc + (l == 0 ? 0 : 2); ml_pass3_unit(F, l, bh >> 2, bh & 3, pc); }
            __syncthreads();
        }
        TSEC_END(400 + 99, F0.lds); SEAM(ph); ++ph;
        {
            const int nMh = nM, pm0 = 0;
            if (SITE(6) && RUN(ph)) TSEC_BEGIN(400 + 6, F0.lds); if (SITE(6) && RUN(ph)) for (int rep_ = 0; rep_ < NREP(6); ++rep_) { const Frame F = phase_frame(F0);
                SchedYB S{(const char*)(F.ws + WS_YC), (const char*)(F.ws + W_BR), pm0, nMh, F.G, F.bx};
                EpiF8Out E{F.ws + WS_YB, 4096};
                gg::gemm_phase(F.lds, S, E);
            }
            TSEC_END(400 + 99, F0.lds); SEAM(ph); ++ph;
            if (SITE(13) && RUN(ph)) TSEC_BEGIN(400 + 13, F0.lds); if (SITE(13) && RUN(ph)) for (int rep_ = 0; rep_ < NREP(13); ++rep_) { const Frame F = phase_frame(F0);
                SchedPlain S{(const char*)(F.ws + WS_HX8) + (size_t)pm0 * 256 * 1024, (const char*)(F.ws + W_GATE), 1024u, 1024u, 8, nMh, 16, F.G, F.bx};
                EpiMerge2 E{(const unsigned char*)(F.ws + WS_YB), F.in[I_BGATE] + l * 4096, F.ws + WS_ACCM + (size_t)pm0 * 256 * 1024, 0};
                gg::gemm_phase(F.lds, S, E);
            }
            TSEC_END(400 + 99, F0.lds); SEAM(ph); ++ph;
        }
        if (SITE(7) && RUN(ph)) TSEC_BEGIN(400 + 7, F0.lds); if (SITE(7) && RUN(ph)) for (int rep_ = 0; rep_ < NREP(7); ++rep_) { const Frame F = phase_frame(F0);
            SchedPlain S{(const char*)(F.ws + WS_ACCM), (const char*)(F.ws + W_OUT), 1024u, 1024u, 8, nM, 4, F.G, F.bx};
            EpiWout E{(bf16_t*)(F.ws + WS_YC), modp(F, l, 0, 2)};
            gg::gemm_phase(F.lds, S, E);
        }
        TSEC_END(400 + 99, F0.lds); SEAM(ph); ++ph;
        if (SITE(8) && RUN(ph)) TSEC_BEGIN(400 + 8, F0.lds); if (SITE(8) && RUN(ph)) for (int rep_ = 0; rep_ < NREP(8); ++rep_) { const Frame F = phase_frame(F0); ph_norm2_route(F, l, ntok); }
        TSEC_END(400 + 99, F0.lds); SEAM(ph); ++ph;
        if (SITE(9) && RUN(ph)) TSEC_BEGIN(400 + 9, F0.lds); if (SITE(9) && RUN(ph)) for (int rep_ = 0; rep_ < NREP(9); ++rep_) { const Frame F = phase_frame(F0); ph_assign(F, ntok); }
        TSEC_END(400 + 99, F0.lds); SEAM(ph); ++ph;
        if (SITE(10) && RUN(ph)) TSEC_BEGIN(400 + 10, F0.lds); if (SITE(10) && RUN(ph)) for (int rep_ = 0; rep_ < NREP(10); ++rep_) { const Frame F = phase_frame(F0);
            int* tile_e = (int*)(F.ws + T_TILEE); const int ntiles = ld_i32_uniform(tile_e + 2047);
            LAS int* tab = (LAS int*)(F.lds + MOE_TAB_OFF); const int* rtok = (const int*)(F.ws + T_RTOK);
            __syncthreads();
            for (int i = 0; i < 28; ++i) { const int L = i * F.G + F.bx; if (L >= ntiles * 2) break; const int tile = L >> 1;
                if (F.tid == 0) tab[i] = tile_e[tile]; if (F.tid < 256) tab[256 + i * 256 + F.tid] = rtok[tile * 256 + F.tid]; }
            __syncthreads();
            SchedMoe1 S{(const char*)(F.ws + WS_HX8), (const char*)(F.ws + W_13), tab, ntiles, F.G, F.bx};
            EpiMoe1 E{F.ws + WS_AMOE, (const float*)(F.ws + T_RW)};
            gg::gemm_phase(F.lds, S, E);
        }
        TSEC_END(400 + 99, F0.lds); SEAM(ph); ++ph;
        if (SITE(11) && RUN(ph)) TSEC_BEGIN(400 + 11, F0.lds); if (SITE(11) && RUN(ph)) for (int rep_ = 0; rep_ < NREP(11); ++rep_) { const Frame F = phase_frame(F0);
            int* tile_e = (int*)(F.ws + T_TILEE); const int ntiles = ld_i32_uniform(tile_e + 2047);
            LAS int* tab = (LAS int*)(F.lds + MOE_TAB_OFF);
            __syncthreads();
            for (int i = F.tid; i < 64; i += NTHR) { const int L = i * F.G + F.bx; if (L < ntiles * 4) tab[i] = tile_e[L >> 2]; }
            __syncthreads();
            SchedMoe2 S{(const char*)(F.ws + WS_AMOE), (const char*)(F.ws + W_2), tab, ntiles, F.G, F.bx};
            EpiF8OutQ E{(unsigned char*)(F.ws + WS_YS), 1024};
            gg::gemm_phase(F.lds, S, E);
        }
        TSEC_END(400 + 99, F0.lds); SEAM(ph); ++ph;
        if (SITE(12) && RUN(ph)) TSEC_BEGIN(400 + 12, F0.lds); if (SITE(12) && RUN(ph)) for (int rep_ = 0; rep_ < NREP(12); ++rep_) { const Frame F = phase_frame(F0); if (l == 0) ph_combine<true>(F, l, 0, ntok); else ph_combine<false>(F, l, 0, ntok); }
        TSEC_END(400 + 99, F0.lds); SEAM(ph); ++ph;
    }
    if (MK_TSEC >= 0 && blockIdx.x == 0 && threadIdx.x == 0) { volatile LAS unsigned long long* q_ = (volatile LAS unsigned long long*)(F0.lds + MISC_OFF + 128);
        const unsigned long long t0 = __builtin_amdgcn_s_memrealtime(), d = q_[0] * 4ull; while (__builtin_amdgcn_s_memrealtime() - t0 < d) __builtin_amdgcn_s_sleep(8); }
#undef RUN
#undef SEAM
}

extern "C" void kernel_launch(void* const* d_in, const int* in_sizes, int n_in, void* d_out, int out_size, void* d_ws, size_t ws_size, hipStream_t stream) {
    static int grid = 0;
    if (grid == 0) {
        if (n_in != 33 || out_size != NLAT * DM || ws_size < WS_END) { fprintf(stderr, "kernel_launch: unexpected shapes (n_in %d, out %d, ws %zu < %zu)\n", n_in, out_size, ws_size, (size_t)WS_END); grid = -1; return; }
        int dev = 0, cus = 0;
        if (hipGetDevice(&dev) != hipSuccess || hipDeviceGetAttribute(&cus, hipDeviceAttributeMultiprocessorCount, dev) != hipSuccess) { grid = -1; return; }
        if (hipFuncSetAttribute((const void*)mk_fwd, hipFuncAttributeMaxDynamicSharedMemorySize, LDS_BYTES) != hipSuccess) { fprintf(stderr, "kernel_launch: hipFuncSetAttribute failed\n"); grid = -1; return; }
        int per_cu = 0;
        if (hipOccupancyMaxActiveBlocksPerMultiprocessor(&per_cu, (const void*)mk_fwd, NTHR, LDS_BYTES) != hipSuccess || per_cu < 1) fprintf(stderr, "kernel_launch: occupancy query says %d\n", per_cu);
        (void)hipGetLastError();
        if (cus < 256) { fprintf(stderr, "kernel_launch: built for a 256-CU device (got %d CUs)\n", cus); grid = -1; return; }
        grid = 256;
    }
    if (grid < 0) return;
    (void)hipMemsetAsync((char*)d_ws + WS_CTL, 0, CTL_ZERO_BYTES, stream);
    Params p{};
    for (int i = 0; i < 33; ++i) p.in[i] = (const float*)d_in[i];
    p.out = (float*)d_out; p.ws = (unsigned char*)d_ws;
#if MK_ONE_LAUNCH
    p.ph_lo = 0; p.ph_hi = PH_TOTAL;
    hipLaunchKernelGGL(mk_fwd, dim3(grid), dim3(NTHR), LDS_BYTES, stream, p);
#else
    for (int k = 0; k < PH_TOTAL; ++k) { p.ph_lo = k; p.ph_hi = k + 1; hipLaunchKernelGGL(mk_fwd, dim3(grid), dim3(NTHR), LDS_BYTES, stream, p); }
#endif
}
```

```cpp
#include <hip/hip_runtime.h>
#include <stdint.h>
#include <stdio.h>
#include <math.h>

#ifndef MK_ONE_LAUNCH
#define MK_ONE_LAUNCH 1
#endif

#define LAS __attribute__((address_space(3)))
#define GAS __attribute__((address_space(1)))
typedef unsigned short bf16_t;
typedef short bf16x8 __attribute__((ext_vector_type(8)));
typedef short s16x4 __attribute__((ext_vector_type(4)));
typedef float f32x2 __attribute__((ext_vector_type(2)));
typedef float f32x4 __attribute__((ext_vector_type(4)));
typedef float f32x16 __attribute__((ext_vector_type(16)));
typedef unsigned u32x2 __attribute__((ext_vector_type(2)));
typedef unsigned u32x4 __attribute__((ext_vector_type(4)));

constexpr int DM = 1024, NB = 8, SEQ = 8192, CTXL = 256, GRIDW = 64;
constexpr int NLAT = NB * SEQ, NCTX = NB * CTXL, NTOK = NLAT + NCTX;
constexpr int INC = 2480, INCP = 2560;
constexpr int C_ML = 0, C_G = 1024, C_MLA = 1040, C_POOL = 1456, C_CONV = 1712;
constexpr int NE = 64, NE1 = 65, TOPK = 6, NSLOT7 = 7, EFF = 256;
constexpr int NCHK = 66;
constexpr int NKT = 132;
constexpr float EPS = 1e-6f;
constexpr int NWAVES = 8, NTHR = 512;
constexpr int MOE_ROWS_MAX = 489472;
constexpr int MOE_TILES_MAX = MOE_ROWS_MAX / 256;

constexpr size_t MiB = 1u << 20;
constexpr size_t WS_CTL = 0, CTL_ZERO_BYTES = 1 * MiB;
constexpr size_t WS_MOD = 128 * 1024;
constexpr size_t WS_TAB = 1 * MiB;
constexpr size_t T_ROPE = WS_TAB;
constexpr size_t T_HIST = T_ROPE + 16384;
constexpr size_t T_TILEE = T_HIST + 65536;
constexpr size_t T_EIDX = T_TILEE + 8192;
constexpr size_t T_EW = T_EIDX + (size_t)NTOK * 6 * 4;
constexpr size_t T_SLOT = T_EW + (size_t)NTOK * 6 * 4;
constexpr size_t T_RTOK = T_SLOT + (size_t)NTOK * 8 * 4;
constexpr size_t T_RW = T_RTOK + (size_t)MOE_ROWS_MAX * 4;
constexpr size_t T_GATE = T_RW + (size_t)MOE_ROWS_MAX * 4;
constexpr size_t T_DN = T_GATE + (size_t)NTOK * 16 * 4;
constexpr size_t T_NST = T_DN + (size_t)4224 * 64 * 4;
constexpr size_t T_MLOC = T_NST + (size_t)4224 * 64 * 4;
constexpr size_t T_BEND = T_MLOC + 4224 * 4;
constexpr size_t T_MST = T_BEND + 4224 * 4;
constexpr size_t T_END = T_MST + 4224 * 4;
static_assert(T_END <= 17 * MiB, "tables");
constexpr size_t WS_WB = 17 * MiB;
constexpr size_t W_IN = WS_WB;
constexpr size_t W_GATE = W_IN + (size_t)INCP * 1024 * 2;
constexpr size_t W_BR = W_GATE + (size_t)4 * 1024 * 1024 * 2;
constexpr size_t W_OUT = W_BR + (size_t)4 * 1024 * 256 * 2;
constexpr size_t W_13 = W_OUT + (size_t)1024 * 1024 * 2;
constexpr size_t W_2 = W_13 + (size_t)NE1 * 512 * 1024 * 2;
constexpr size_t W_UQ = W_2 + (size_t)NE1 * 1024 * 256 * 2;
constexpr size_t W_UKV = W_UQ + (size_t)384 * 256 * 2;
constexpr size_t W_POOL = W_UKV + (size_t)512 * 128 * 2;
constexpr size_t W_RT = W_POOL + (size_t)4 * 64 * 64 * 2;
constexpr size_t W_END = W_RT + (size_t)64 * 1024 * 2;
static_assert(W_END <= 133 * MiB, "weights");
constexpr size_t WS_CTXS = 133 * MiB;
constexpr size_t WS_HX = 141 * MiB;
constexpr size_t WS_PX = 273 * MiB;
constexpr size_t WS_QB = 593 * MiB;
constexpr size_t WS_KT = 643 * MiB;
constexpr size_t WS_VT = 693 * MiB;
constexpr size_t WS_YC = 726 * MiB;
constexpr size_t WS_DC = 858 * MiB;
constexpr size_t WS_CST = 924 * MiB;
constexpr size_t WS_HX8 = 957 * MiB;
constexpr size_t WS_END = 1023 * MiB;
constexpr size_t WS_ACCM = WS_QB;
constexpr size_t WS_YB = WS_PX;
constexpr size_t WS_AMOE = WS_HX;
constexpr size_t WS_YS = WS_HX + 240 * MiB;
static_assert(WS_AMOE + (size_t)MOE_ROWS_MAX * 512 <= WS_YS && WS_YS + (size_t)MOE_ROWS_MAX * 1024 <= WS_HX8, "moe overlay");
static_assert(WS_YB + (size_t)NTOK * 4096 <= WS_QB && WS_ACCM + (size_t)NTOK * 2048 <= WS_YC, "merge overlay");

constexpr int CW_BAR = 4096;

constexpr int RING_BYTES = 131072;
constexpr int MISC_OFF = 160 * 1024 - 256;
constexpr int LDS_BYTES = 160 * 1024;

#ifndef MK_TSEC
#define MK_TSEC -1
#endif
#define TSEC_BEGIN(id, ldsb) do { if (MK_TSEC == (id) && blockIdx.x == 0 && threadIdx.x == 0) { volatile LAS unsigned long long* q_ = (volatile LAS unsigned long long*)((ldsb) + MISC_OFF + 128); q_[1] = __builtin_amdgcn_s_memrealtime(); } } while (0)
#define TSEC_END(id, ldsb) do { if ((MK_TSEC == (id) || ((id) == 499 && MK_TSEC >= 400 && MK_TSEC < 499)) && blockIdx.x == 0 && threadIdx.x == 0) { volatile LAS unsigned long long* q_ = (volatile LAS unsigned long long*)((ldsb) + MISC_OFF + 128); if (q_[1] != 0ull) { q_[0] += __builtin_amdgcn_s_memrealtime() - q_[1]; q_[1] = 0ull; } } } while (0)
typedef __bf16 bf16x2_t_ __attribute__((ext_vector_type(2)));
__device__ __forceinline__ unsigned pk2(float lo, float hi) { const f32x2 v = {lo, hi}; return __builtin_bit_cast(unsigned, __builtin_convertvector(v, bf16x2_t_)); }
__device__ __forceinline__ unsigned f2bf(float f) { return pk2(f, f) & 0xffffu; }
__device__ __forceinline__ float bf2f(unsigned short b) { return __builtin_bit_cast(float, ((unsigned)b) << 16); }
__device__ __forceinline__ float bflo(unsigned w) { return __builtin_bit_cast(float, w << 16); }
__device__ __forceinline__ float bfhi(unsigned w) { return __builtin_bit_cast(float, w & 0xffff0000u); }
__device__ __forceinline__ unsigned cvt_pk_bf16(float lo, float hi) { unsigned r; asm volatile("v_cvt_pk_bf16_f32 %0, %1, %2" : "=v"(r) : "v"(lo), "v"(hi)); return r; }
__device__ __forceinline__ unsigned char f2f8(float a) { return (unsigned char)(__builtin_amdgcn_cvt_pk_fp8_f32(a, a, 0, false) & 0xff); }
__device__ __forceinline__ unsigned pk4_fp8(float a, float b, float c, float d) { int r = __builtin_amdgcn_cvt_pk_fp8_f32(a, b, 0, false); r = __builtin_amdgcn_cvt_pk_fp8_f32(c, d, r, true); return (unsigned)r; }
__device__ __forceinline__ float sigmoidf_(float x) { return __builtin_amdgcn_rcpf(1.0f + __builtin_amdgcn_exp2f(x * -1.4426950408889634f)); }
template <int O> __device__ __forceinline__ float xor_lane(float v) { return __builtin_bit_cast(float, __builtin_amdgcn_ds_swizzle(__builtin_bit_cast(int, v), 0x1f | (O << 10))); }
__device__ __forceinline__ float half_sum(float v) { v += xor_lane<1>(v); v += xor_lane<2>(v); v += xor_lane<4>(v); v += xor_lane<8>(v); v += xor_lane<16>(v); return v; }
__device__ __forceinline__ float half_max(float v) { v = fmaxf(v, xor_lane<1>(v)); v = fmaxf(v, xor_lane<2>(v)); v = fmaxf(v, xor_lane<4>(v)); v = fmaxf(v, xor_lane<8>(v)); v = fmaxf(v, xor_lane<16>(v)); return v; }
__device__ __forceinline__ float wave_sum(float v) { v = half_sum(v); auto rr = __builtin_amdgcn_permlane32_swap(__builtin_bit_cast(unsigned, v), __builtin_bit_cast(unsigned, v), false, false);
    return __builtin_bit_cast(float, (unsigned)rr[0]) + __builtin_bit_cast(float, (unsigned)rr[1]); }
__device__ __forceinline__ float wave_max(float v) { v = half_max(v); auto rr = __builtin_amdgcn_permlane32_swap(__builtin_bit_cast(unsigned, v), __builtin_bit_cast(unsigned, v), false, false);
    return fmaxf(__builtin_bit_cast(float, (unsigned)rr[0]), __builtin_bit_cast(float, (unsigned)rr[1])); }
__device__ __forceinline__ float lane_up(float v, int o, int lane) { return __builtin_bit_cast(float, __builtin_amdgcn_ds_bpermute(((lane - o) & 63) << 2, __builtin_bit_cast(int, v))); }
__device__ __forceinline__ float lane_bcast(float v, int src) { return __builtin_bit_cast(float, __builtin_amdgcn_readlane(__builtin_bit_cast(int, v), src)); }
__device__ __forceinline__ float frcp(float x) { return __builtin_amdgcn_rcpf(x); }
__device__ __forceinline__ float frsq(float x) { return __builtin_amdgcn_rsqf(x); }
#define LDS_WAIT() asm volatile("s_waitcnt lgkmcnt(0)" ::: "memory")
#define LDS_BAR() asm volatile("s_waitcnt lgkmcnt(0)\n\ts_barrier" ::: "memory")
#define VM_WAIT() asm volatile("s_waitcnt vmcnt(0)" ::: "memory")

#define XB_TMO      128
#define XB_XCNT(j)  (256  + 64 * (j))
#define XB_XSUB(j)  (1280 + 64 * (j))
#define XB_XGEN(j)  (2304 + 64 * (j))
#define XB_TOP      3328
#define XB_TOPGEN   3392
#define XCD_BAR_WORDS 3456
#define XB_SPIN_CAP (1u << 22)

__device__ __forceinline__ unsigned xb_ld(unsigned* p)              { return __hip_atomic_load(p, __ATOMIC_RELAXED, __HIP_MEMORY_SCOPE_AGENT); }
__device__ __forceinline__ unsigned xb_add(unsigned* p, unsigned v) { return __hip_atomic_fetch_add(p, v, __ATOMIC_RELAXED, __HIP_MEMORY_SCOPE_AGENT); }
__device__ __forceinline__ unsigned xb_xcc_id() { return (unsigned)__builtin_amdgcn_s_getreg((3 << 11) | 20) & 0xFu; }
#define XB_SPIN(cond, bar) do { unsigned _sp = 0; while (cond) { __builtin_amdgcn_s_sleep(1); \
    if ((++_sp & 255u) == 0u) { if (xb_ld(&(bar)[XB_TMO])) break; if (_sp > XB_SPIN_CAP) { atomicAdd(&(bar)[XB_TMO], 1u); break; } } } } while (0)

struct XcdBarrier { unsigned* bar; unsigned x; volatile LAS unsigned* st; };

__device__ __forceinline__ XcdBarrier xcd_barrier_post(unsigned* bar, volatile LAS unsigned* st) {
    XcdBarrier b; b.bar = bar; b.x = xb_xcc_id(); b.st = st;
    if (threadIdx.x == 0) (void)xb_add(&bar[XB_XCNT(b.x)], 1u);
    return b;
}
__device__ __forceinline__ void xcd_barrier_complete(unsigned* bar, unsigned x, unsigned& nloc, unsigned& nx) {
    const unsigned G = gridDim.x * gridDim.y * gridDim.z;
    unsigned sum, cnt, mine, sp = 0u;
    for (;;) {
        sum = 0u; cnt = 0u; mine = 0u;
#pragma unroll
        for (unsigned j = 0; j < 16; ++j) { const unsigned c = xb_ld(&bar[XB_XCNT(j)]); sum += c; cnt += (c > 0u) ? 1u : 0u; mine = (j == x) ? c : mine; }
        if (sum == G) break;
        __builtin_amdgcn_s_sleep(1);
        if ((++sp & 255u) == 0u) { if (xb_ld(&bar[XB_TMO])) break; if (sp > XB_SPIN_CAP) { atomicAdd(&bar[XB_TMO], 1u); break; } }
    }
    nloc = mine > 0u ? mine : 1u; nx = cnt > 0u ? cnt : 1u;
}
__device__ __forceinline__ void xcd_barrier(const XcdBarrier& b) {
    asm volatile("s_waitcnt vmcnt(0)" ::: "memory");
    __syncthreads();
    if (threadIdx.x == 0) {
        unsigned* bar = b.bar;
        __builtin_amdgcn_s_waitcnt(0);
        unsigned nloc = b.st[0], nx = b.st[1];
        if (nloc == 0u) { xcd_barrier_complete(bar, b.x, nloc, nx); b.st[0] = nloc; b.st[1] = nx; }
        const unsigned old = xb_add(&bar[XB_XSUB(b.x)], 1u);
        const unsigned gen = old / nloc;
        if (old + 1u == (gen + 1u) * nloc) {
            __builtin_amdgcn_fence(__ATOMIC_RELEASE, "agent");
            asm volatile("s_waitcnt vmcnt(0)" ::: "memory");
            const unsigned og = xb_add(&bar[XB_TOP], 1u);
            const unsigned tg = og / nx;
            if (og + 1u == (tg + 1u) * nx) xb_add(&bar[XB_TOPGEN], 1u);
            else XB_SPIN(xb_ld(&bar[XB_TOPGEN]) == tg, bar);
            __builtin_amdgcn_fence(__ATOMIC_ACQUIRE, "agent");
            xb_add(&bar[XB_XGEN(b.x)], 1u);
            asm volatile("s_waitcnt vmcnt(0)" ::: "memory");
        } else {
            XB_SPIN(xb_ld(&bar[XB_XGEN(b.x)]) == gen, bar);
            __builtin_amdgcn_fence(__ATOMIC_ACQUIRE, "agent");
            asm volatile("s_waitcnt vmcnt(0)" ::: "memory");
        }
    }
    __syncthreads();
}

struct Params { const float* in[33]; float* out; unsigned char* ws; int ph_lo, ph_hi; };

struct Frame {
    LAS unsigned char* lds;
    unsigned char* ws;
    const float* const* in;
    float* out;
    int tid, lane, wave, bx, G;
};
enum { I_X = 0, I_C, I_CTX, I_CCTX, I_WMOD, I_BMOD, I_GMIX, I_GFFN, I_WIN, I_MLGB, I_MLHG, I_GCQ, I_GCKV, I_WUQ, I_WUKV, I_GQN, I_GKN, I_POOLW, I_POOLS,
       I_CONVW, I_CONVB, I_WGATE, I_BGATE, I_WBR, I_WOUT, I_WRT, I_BRT, I_W1, I_W3, I_W2, I_WS1, I_WS3, I_WS2 };

__device__ __forceinline__ const float* modp(const Frame& F, int l, int r, int which) { return (const float*)(F.ws + WS_MOD) + ((size_t)(l * 9 + r)) * 6144 + which * 1024; }
__device__ __forceinline__ int mod_row_of(int row) { return row < NLAT ? (row >> 13) : 8; }

__device__ __forceinline__ f32x4 up4_fp8(unsigned w) { const f32x2 lo = __builtin_amdgcn_cvt_pk_f32_fp8((int)w, false), hi = __builtin_amdgcn_cvt_pk_f32_fp8((int)w, true); return (f32x4){lo.x, lo.y, hi.x, hi.y}; }
namespace gg {
typedef int v4i_t __attribute__((ext_vector_type(4)));
constexpr int BM = 256, BK = 64, HALF = 128, HTB = HALF * BK * 2, STAGE_BYTES = 8 * HTB;
__device__ __forceinline__ int lds_byte(int r, int c) { const int st = (r >> 4) * 2 + (c >> 5), rr = r & 15, cc = c & 31, ob = rr * 64 + cc * 2; return st * 1024 + (ob ^ (((ob >> 9) & 1) << 5)); }
__device__ __forceinline__ void stage_rc(int b, int& R, int& C) { const int st = b / 1024, sb = b % 1024, swz = sb ^ (((sb >> 9) & 1) << 5); R = (st >> 1) * 16 + swz / 64; C = (st & 1) * 32 + (swz % 64) / 2; }
__device__ __forceinline__ int perm32(int rho) { const int n = rho >> 4, i = rho & 15; return 8 * (i >> 2) + 4 * n + (i & 3); }

struct Unit {
    const char* A; const char* B;
    unsigned lda, ldb;
    int nt;
    int ridx_off;
    int p0, p1, p2;
};

template <class E, class = void> struct ZPeel { static constexpr bool v = false; };
template <class E> struct ZPeel<E, decltype((void)E::ZPEEL)> { static constexpr bool v = E::ZPEEL; };
template <class Epi, class Sched>
__device__ __forceinline__ void gemm_phase(LAS unsigned char* lds, const Sched& S, const Epi& E) {
    int tid_ = threadIdx.x; asm volatile("" : "+v"(tid_));
    const int tid = tid_, wid = __builtin_amdgcn_readfirstlane(tid >> 6), lane = tid & 63, wr = wid >> 2, wc = wid & 3, fr = lane & 15, fq = lane >> 4;
    const size_t kstep = (size_t)(BK * 2);
    const unsigned ldsw = (unsigned)wid * 1024u;
    const int aoff = lds_byte(wr * 64 + fr, fq * 8), boff = lds_byte(wc * 32 + fr, fq * 8);
#define GG_SA(b, h) (((b) * 2 + (h)) * HTB)
#define GG_SB(b, h) ((4 + (b) * 2 + (h)) * HTB)
#define GG_STAGE(bufoff, gbase, v0, v1) do { \
        __builtin_amdgcn_global_load_lds((const unsigned*)((const char*)(gbase) + (v0)), (LAS unsigned*)(lds + (bufoff) + ldsw), 16, 0, 0); \
        __builtin_amdgcn_global_load_lds((const unsigned*)((const char*)(gbase) + (v1)), (LAS unsigned*)(lds + (bufoff) + ldsw + 8192), 16, 0, 0); } while (0)
#define GG_LDA(dst, b, h) do { _Pragma("unroll") for (int m = 0; m < 4; ++m) _Pragma("unroll") for (int k = 0; k < 2; ++k) dst[m][k] = *(const LAS bf16x8*)(lds + GG_SA(b, h) + aoff + m * 2048 + k * 1024); } while (0)
#define GG_LDB(dst, b, h) do { _Pragma("unroll") for (int n = 0; n < 2; ++n) _Pragma("unroll") for (int k = 0; k < 2; ++k) dst[n][k] = *(const LAS bf16x8*)(lds + GG_SB(b, h) + boff + n * 2048 + k * 1024); } while (0)
#define GG_MMA(ai, bj, At, Bt) do { __builtin_amdgcn_s_setprio(1); _Pragma("unroll") for (int m = 0; m < 4; ++m) _Pragma("unroll") for (int n = 0; n < 2; ++n) _Pragma("unroll") for (int k = 0; k < 2; ++k) \
        acc[ai][bj][m][n] = __builtin_amdgcn_mfma_f32_16x16x32_bf16(Bt[n][k], At[m][k], acc[ai][bj][m][n], 0, 0, 0); __builtin_amdgcn_s_setprio(0); } while (0)
#define GG_CAT8(x, y) __builtin_shufflevector(__builtin_bit_cast(v4i_t, x), __builtin_bit_cast(v4i_t, y), 0, 1, 2, 3, 4, 5, 6, 7)
#define GG_MMA8(ai, bj, At, Bt) do { __builtin_amdgcn_s_setprio(1); _Pragma("unroll") for (int m = 0; m < 4; ++m) _Pragma("unroll") for (int n = 0; n < 2; ++n) \
        acc[ai][bj][m][n] = __builtin_amdgcn_mfma_scale_f32_16x16x128_f8f6f4(GG_CAT8(Bt[n][0], Bt[n][1]), GG_CAT8(At[m][0], At[m][1]), acc[ai][bj][m][n], 0, 0, 0, (int)Epi::SCB, 0, 0x7f7f7f7f); __builtin_amdgcn_s_setprio(0); } while (0)
#define GG_MM(ai, bj, At, Bt) do { if constexpr (Epi::FP8) GG_MMA8(ai, bj, At, Bt); else GG_MMA(ai, bj, At, Bt); } while (0)
#define GG_MMZ8(ai, bj, At, Bt) do { __builtin_amdgcn_s_setprio(1); _Pragma("unroll") for (int m = 0; m < 4; ++m) _Pragma("unroll") for (int n = 0; n < 2; ++n) \
        acc[ai][bj][m][n] = __builtin_amdgcn_mfma_scale_f32_16x16x128_f8f6f4(GG_CAT8(Bt[n][0], Bt[n][1]), GG_CAT8(At[m][0], At[m][1]), (f32x4){0.f, 0.f, 0.f, 0.f}, 0, 0, 0, (int)Epi::SCB, 0, 0x7f7f7f7f); __builtin_amdgcn_s_setprio(0); } while (0)
#define GG_MM1(ai, bj, At, Bt) do { if constexpr (ZP && Epi::FP8) { if (t == 0) GG_MMZ8(ai, bj, At, Bt); else GG_MMA8(ai, bj, At, Bt); } else GG_MM(ai, bj, At, Bt); } while (0)
#define GG_WAIT_V(n) asm volatile("s_waitcnt vmcnt(" #n ")" ::: "memory")
#define GG_WAIT_L(n) asm volatile("s_waitcnt lgkmcnt(" #n ")" ::: "memory")
#define GG_BAR __builtin_amdgcn_s_barrier()
#define GG_SCHED __builtin_amdgcn_sched_barrier(0)
#define GG_OFFS(u) do { int R0_, C0_, R1_, C1_; stage_rc(tid * 16, R0_, C0_); stage_rc(tid * 16 + 8192, R1_, C1_); \
        if (Sched::GATHER) { const LAS int* rl_ = (const LAS int*)(lds + (u).ridx_off); vA0 = (unsigned)rl_[R0_] * (u).lda + C0_ * 2; vA1 = (unsigned)rl_[R1_] * (u).lda + C1_ * 2; \
                             vA2 = (unsigned)rl_[128 + R0_] * (u).lda + C0_ * 2; vA3 = (unsigned)rl_[128 + R1_] * (u).lda + C1_ * 2; hA = 0; } \
        else { vA0 = (unsigned)R0_ * (u).lda + C0_ * 2; vA1 = (unsigned)R1_ * (u).lda + C1_ * 2; vA2 = vA0; vA3 = vA1; hA = (size_t)128 * (u).lda; } \
        const int Rb0_ = Epi::PERM ? ((R0_ & ~31) + perm32(R0_ & 31)) : R0_, Rb1_ = Epi::PERM ? ((R1_ & ~31) + perm32(R1_ & 31)) : R1_; \
        vB0 = (unsigned)Rb0_ * (u).ldb + C0_ * 2; vB1 = (unsigned)Rb1_ * (u).ldb + C1_ * 2; hB = (size_t)128 * (u).ldb; } while (0)
    Unit cur, nxt; int ui = 0;
    if (!S.next(0, cur)) return;
    constexpr bool ZP = ZPeel<Epi>::v;
    f32x4 acc[2][2][4][2];
    if constexpr (!ZP) {
#pragma unroll
    for (int a = 0; a < 2; ++a)
#pragma unroll
        for (int b = 0; b < 2; ++b)
#pragma unroll
            for (int m = 0; m < 4; ++m)
#pragma unroll
                for (int n = 0; n < 2; ++n) acc[a][b][m][n] = (f32x4){0.f, 0.f, 0.f, 0.f};
    }
    bf16x8 At[4][2], B0[2][2], B1[2][2];
    unsigned vA0, vA1, vA2, vA3, vB0, vB1; size_t hA, hB;
    GG_OFFS(cur);
    const char* cA = cur.A; const char* cB = cur.B;
    GG_STAGE(GG_SB(0, 0), cB, vB0, vB1); GG_STAGE(GG_SB(0, 1), cB + hB, vB0, vB1); GG_STAGE(GG_SA(0, 0), cA, vA0, vA1); GG_STAGE(GG_SA(0, 1), cA + hA, vA2, vA3);
    if (wr == 1) GG_BAR;
    GG_WAIT_V(2); GG_BAR;
    GG_STAGE(GG_SB(1, 0), cB + kstep, vB0, vB1); GG_STAGE(GG_SA(1, 0), cA + kstep, vA0, vA1); GG_STAGE(GG_SB(1, 1), cB + hB + kstep, vB0, vB1);
    GG_WAIT_V(6); GG_BAR;
    for (;;) {
        const bool has_next = S.next(ui + 1, nxt);
        TSEC_BEGIN(100 + Epi::TID, lds);
        int nt_ = cur.nt; asm volatile("" : "+s"(nt_)); const int nt = nt_;
#pragma unroll 1
        for (int t = 0; t < nt; t += 2) {
            const bool last = (t == nt - 2);
            const char* a1 = cA + (size_t)(t + 1) * kstep;
            GG_LDB(B0, 0, 0); GG_LDB(B1, 0, 1); GG_SCHED; GG_LDA(At, 0, 0); GG_STAGE(GG_SA(1, 1), a1 + hA, vA2, vA3);
            GG_WAIT_V(8); GG_WAIT_L(0); GG_BAR; GG_MM1(0, 0, At, B0); GG_MM1(0, 1, At, B1); GG_BAR; GG_SCHED;
            if (last) { if (has_next) { GG_OFFS(nxt); cA = nxt.A - (size_t)nt * kstep; cB = nxt.B - (size_t)nt * kstep; } else { cA -= (size_t)nt * kstep; cB -= (size_t)nt * kstep; } }
            const char* a2 = cA + (size_t)(t + 2) * kstep; const char* b2 = cB + (size_t)(t + 2) * kstep; const char* a3 = a2 + kstep; const char* b3 = b2 + kstep;
            GG_LDA(At, 0, 1); GG_STAGE(GG_SB(0, 0), b2, vB0, vB1); GG_STAGE(GG_SB(0, 1), b2 + hB, vB0, vB1); GG_STAGE(GG_SA(0, 0), a2, vA0, vA1);
            GG_WAIT_V(8); GG_WAIT_L(0); GG_BAR; GG_MM1(1, 0, At, B0); GG_MM1(1, 1, At, B1); GG_BAR; GG_SCHED;
            GG_LDB(B0, 1, 0); GG_LDB(B1, 1, 1); GG_SCHED; GG_LDA(At, 1, 0); GG_STAGE(GG_SA(0, 1), a2 + hA, vA2, vA3);
            GG_WAIT_V(8); GG_WAIT_L(0); GG_BAR; GG_MM(0, 0, At, B0); GG_MM(0, 1, At, B1); GG_BAR; GG_SCHED;
            GG_LDA(At, 1, 1); GG_STAGE(GG_SB(1, 0), b3, vB0, vB1); GG_STAGE(GG_SB(1, 1), b3 + hB, vB0, vB1); GG_STAGE(GG_SA(1, 0), a3, vA0, vA1);
            GG_WAIT_V(8); GG_WAIT_L(0); GG_BAR; GG_MM(1, 0, At, B0); GG_MM(1, 1, At, B1); GG_BAR; GG_SCHED;
        }
        cA += (size_t)nt * kstep; cB += (size_t)nt * kstep;
        TSEC_END(100 + Epi::TID, lds);
        if (wr == 0) GG_BAR;
        TSEC_BEGIN(200 + Epi::TID, lds); { int t2_ = threadIdx.x; asm volatile("" : "+v"(t2_)); E(acc, cur, wr, wc, t2_ & 15, (t2_ & 63) >> 4); } TSEC_END(200 + Epi::TID, lds);
        if (!has_next) break;
        if constexpr (!ZP)
#pragma unroll
        for (int a = 0; a < 2; ++a)
#pragma unroll
            for (int b = 0; b < 2; ++b)
#pragma unroll
                for (int m = 0; m < 4; ++m)
#pragma unroll
                    for (int n = 0; n < 2; ++n) acc[a][b][m][n] = (f32x4){0.f, 0.f, 0.f, 0.f};
        cur = nxt; ++ui;
        if (wr == 1) GG_BAR;
    }
    GG_WAIT_V(0);
    GG_BAR;
#undef GG_SA
#undef GG_SB
#undef GG_STAGE
#undef GG_LDA
#undef GG_LDB
#undef GG_MMA
#undef GG_MMA8
#undef GG_MM
#undef GG_MM1
#undef GG_MMZ8
#undef GG_CAT8
#undef GG_WAIT_V
#undef GG_WAIT_L
#undef GG_BAR
#undef GG_SCHED
#undef GG_OFFS
}
}

__device__ __forceinline__ int ld_i32_uniform(const int* p) { return __builtin_amdgcn_readfirstlane(__hip_atomic_load(p, __ATOMIC_RELAXED, __HIP_MEMORY_SCOPE_AGENT)); }
__device__ __forceinline__ void tile_order(int L, int nM, int nN, int& pm, int& pn) {
    const int nwg = nM * nN; int wgid = L;
    { const int q = nwg / 8, r = nwg % 8, xcd = wgid % 8, off = wgid / 8; wgid = (xcd < r ? xcd * (q + 1) : r * (q + 1) + (xcd - r) * q) + off; }
    const int nig = 8 * nN, gid = wgid / nig, fm = gid * 8, gsz = (nM - fm) < 8 ? (nM - fm) : 8;
    pm = fm + ((wgid % nig) % gsz); pn = (wgid % nig) / gsz;
}
struct SchedPlain {
    static constexpr bool GATHER = false;
    const char* A; const char* B; unsigned lda, ldb; int nt, nM, nN, G, c;
    __device__ __forceinline__ bool next(int i, gg::Unit& u) const {
        const int L = i * G + c; if (L >= nM * nN) return false;
        int pm, pn; tile_order(L, nM, nN, pm, pn);
        u.A = A + (size_t)pm * 256 * lda; u.B = B + (size_t)pn * 256 * ldb; u.lda = lda; u.ldb = ldb; u.nt = nt; u.ridx_off = 0; u.p0 = pm; u.p1 = pn; u.p2 = 0; return true;
    }
};
struct EpiWin {
    static constexpr bool PERM = true, FP8 = true; static constexpr int TID = 0; static constexpr unsigned SCB = 0x79797979u;
    bf16_t* px; float* gate;
    __device__ __forceinline__ void operator()(const f32x4 (&acc)[2][2][4][2], const gg::Unit& u, int wr, int wc, int fr, int fq) const {
        const int row0 = u.p0 * 256 + wr * 64 + fr;
#pragma unroll
        for (int bj = 0; bj < 2; ++bj) {
            const int c0 = u.p1 * 256 + bj * 128 + wc * 32 + 8 * fq;
            if (c0 < INC) {
                const bool isg = (c0 >= C_G && c0 < C_MLA);
#pragma unroll
                for (int ai = 0; ai < 2; ++ai)
#pragma unroll
                    for (int m = 0; m < 4; ++m) { const int row = row0 + ai * 128 + m * 16; const f32x4 v0 = acc[ai][bj][m][0], v1 = acc[ai][bj][m][1];
                        u32x4 w; w.x = cvt_pk_bf16(v0[0], v0[1]); w.y = cvt_pk_bf16(v0[2], v0[3]); w.z = cvt_pk_bf16(v1[0], v1[1]); w.w = cvt_pk_bf16(v1[2], v1[3]);
                        *(u32x4*)(px + (size_t)row * INC + c0) = w;
                        if (isg) { float* gp = gate + (size_t)row * 16 + (c0 - C_G); *(f32x4*)gp = v0; *(f32x4*)(gp + 4) = v1; } }
            }
        }
    }
};
struct SchedYB {
    static constexpr bool GATHER = false;
    const char* yc; const char* wb; int pm0, nMh, G, c;
    __device__ __forceinline__ bool next(int i, gg::Unit& u) const {
        const int L = i * G + c; if (L >= nMh * 16) return false;
        int pm, q; tile_order(L, nMh, 16, pm, q); const int br = q >> 2, pn = q & 3;
        u.A = yc + (size_t)(pm0 + pm) * 256 * 2048 + br * 512; u.lda = 2048; u.B = wb + (size_t)br * (1024 * 512) + (size_t)pn * 256 * 512; u.ldb = 512; u.nt = 4; u.ridx_off = 0; u.p0 = pm; u.p1 = q; u.p2 = 0; return true;
    }
};
struct EpiMerge2 {
    static constexpr bool PERM = false, FP8 = true; static constexpr int TID = 4; static constexpr unsigned SCB = 0x79797979u;
    const unsigned char* yb; const float* bgate; unsigned char* accm; int pm0;
    __device__ __forceinline__ void operator()(const f32x4 (&acc)[2][2][4][2], const gg::Unit& u, int wr, int wc, int fr, int fq) const {
        const int c = u.p1 * 64 + 16 * wc + 4 * fq, r0 = wr * 64 + fr;
        constexpr float NL2E = -1.4426950408889634f;
        f32x4 bv[2][2];
#pragma unroll
        for (int bj = 0; bj < 2; ++bj)
#pragma unroll
            for (int n = 0; n < 2; ++n) bv[bj][n] = *(const f32x4*)(bgate + (2 * bj + n) * 1024 + c) * NL2E;
        u32x4 yw[2][4];
#pragma unroll
        for (int ai = 0; ai < 2; ++ai)
#pragma unroll
            for (int m = 0; m < 4; ++m) { const unsigned char* yr = yb + (size_t)((u.p0 - pm0) * 256 + r0 + ai * 128 + m * 16) * 4096 + c;
                yw[ai][m] = (u32x4){*(const unsigned*)yr, *(const unsigned*)(yr + 1024), *(const unsigned*)(yr + 2048), *(const unsigned*)(yr + 3072)}; }
#pragma unroll
        for (int ai = 0; ai < 2; ++ai) {
#pragma unroll
            for (int m = 0; m < 4; ++m) {
                f32x4 t = {0.f, 0.f, 0.f, 0.f};
#pragma unroll
                for (int bj = 0; bj < 2; ++bj)
#pragma unroll
                    for (int n = 0; n < 2; ++n) { const f32x4 y = up4_fp8(yw[ai][m][2 * bj + n]); const f32x4 x = acc[ai][bj][m][n] * NL2E + bv[bj][n];
                        const f32x4 d = (f32x4){__builtin_amdgcn_exp2f(x[0]), __builtin_amdgcn_exp2f(x[1]), __builtin_amdgcn_exp2f(x[2]), __builtin_amdgcn_exp2f(x[3])} + 1.0f;
                        t += (f32x4){__builtin_amdgcn_rcpf(d[0]), __builtin_amdgcn_rcpf(d[1]), __builtin_amdgcn_rcpf(d[2]), __builtin_amdgcn_rcpf(d[3])} * y; }
                *(unsigned*)(accm + (size_t)(u.p0 * 256 + r0 + ai * 128 + m * 16) * 1024 + c) = pk4_fp8(t[0], t[1], t[2], t[3]); } }
    }
};
struct EpiWout {
    static constexpr bool PERM = true, FP8 = true; static constexpr int TID = 1; static constexpr unsigned SCB = 0x79797979u;
    bf16_t* mrg; const float* gt;
    __device__ __forceinline__ void operator()(const f32x4 (&acc)[2][2][4][2], const gg::Unit& u, int wr, int wc, int fr, int fq) const {
        const int pm = u.p0; const int mrow = pm >= 256 ? 8 : (pm >> 5);
        const float* g = gt + (size_t)mrow * 6144;
        const int row0 = pm * 256 + wr * 64 + fr, col0 = u.p1 * 256 + wc * 32 + 8 * fq;
#pragma unroll
        for (int bj = 0; bj < 2; ++bj) { const f32x4 g0 = *(const f32x4*)(g + col0 + bj * 128), g1 = *(const f32x4*)(g + col0 + bj * 128 + 4);
#pragma unroll
            for (int ai = 0; ai < 2; ++ai)
#pragma unroll
                for (int m = 0; m < 4; ++m) { const f32x4 v0 = acc[ai][bj][m][0] * g0, v1 = acc[ai][bj][m][1] * g1;
                    u32x4 w; w.x = cvt_pk_bf16(v0[0], v0[1]); w.y = cvt_pk_bf16(v0[2], v0[3]); w.z = cvt_pk_bf16(v1[0], v1[1]); w.w = cvt_pk_bf16(v1[2], v1[3]);
                    *(u32x4*)(mrg + (size_t)(row0 + ai * 128 + m * 16) * 1024 + col0 + bj * 128) = w; } }
    }
};
constexpr int MOE_TAB_OFF = RING_BYTES, MOE_RIDX_OFF = RING_BYTES + 1024;
struct SchedMoe1 {
    static constexpr bool GATHER = true;
    const char* hx2; const char* w13; const LAS int* tab; int ntiles, G, c;
    __device__ __forceinline__ bool next(int i, gg::Unit& u) const {
        const int L = i * G + c; if (L >= ntiles * 2) return false;
        const int tile = L >> 1, pn = L & 1, e = __builtin_amdgcn_readfirstlane(tab[i]);
        u.A = hx2; u.lda = 1024; u.ridx_off = MOE_RIDX_OFF + i * 1024; u.B = w13 + (size_t)e * (512 * 1024) + (size_t)pn * 256 * 1024; u.ldb = 1024; u.nt = 8; u.p0 = tile; u.p1 = pn; u.p2 = e; return true;
    }
};
struct EpiMoe1 {
    static constexpr bool PERM = true, FP8 = true; static constexpr int TID = 5; static constexpr unsigned SCB = 0x79797979u;
    unsigned char* a; const float* roww;
    __device__ __forceinline__ void operator()(const f32x4 (&acc)[2][2][4][2], const gg::Unit& u, int wr, int wc, int fr, int fq) const {
        const int row0 = u.p0 * 256 + wr * 64 + fr, col = u.p1 * 128 + wc * 32 + 8 * fq;
        float rwv[2][4];
#pragma unroll
        for (int ai = 0; ai < 2; ++ai)
#pragma unroll
            for (int m = 0; m < 4; ++m) rwv[ai][m] = roww[row0 + ai * 128 + m * 16] * 2.0f;
#pragma unroll
        for (int ai = 0; ai < 2; ++ai)
#pragma unroll
            for (int m = 0; m < 4; ++m) { const int row = row0 + ai * 128 + m * 16; f32x4 t[2];
#pragma unroll
                for (int n = 0; n < 2; ++n) { const f32x4 g1 = acc[ai][0][m][n], x = g1 * -1.4426950408889634f;
                    const f32x4 d = (f32x4){__builtin_amdgcn_exp2f(x[0]), __builtin_amdgcn_exp2f(x[1]), __builtin_amdgcn_exp2f(x[2]), __builtin_amdgcn_exp2f(x[3])} + 1.0f;
                    t[n] = (g1 * acc[ai][1][m][n] * rwv[ai][m]) * (f32x4){__builtin_amdgcn_rcpf(d[0]), __builtin_amdgcn_rcpf(d[1]), __builtin_amdgcn_rcpf(d[2]), __builtin_amdgcn_rcpf(d[3])}; }
                *(u32x2*)(a + (size_t)row * 256 + col) = (u32x2){pk4_fp8(t[0][0], t[0][1], t[0][2], t[0][3]), pk4_fp8(t[1][0], t[1][1], t[1][2], t[1][3])}; }
    }
};
struct SchedMoe2 {
    static constexpr bool GATHER = false;
    const char* a; const char* w2; const LAS int* tab; int ntiles, G, c;
    __device__ __forceinline__ bool next(int i, gg::Unit& u) const {
        const int L = i * G + c; if (L >= ntiles * 4) return false;
        const int tile = L >> 2, pn = L & 3, e = __builtin_amdgcn_readfirstlane(tab[i]);
        u.A = a + (size_t)tile * 256 * 256; u.lda = 256; u.ridx_off = 0; u.B = w2 + (size_t)e * (1024 * 256) + (size_t)pn * 256 * 256; u.ldb = 256; u.nt = 2; u.p0 = tile; u.p1 = pn; u.p2 = e; return true;
    }
};
struct EpiBf16Plain {
    static constexpr bool PERM = true, FP8 = false; static constexpr int TID = 2; static constexpr unsigned SCB = 0x7f7f7f7fu;
    bf16_t* O; int ldc;
    __device__ __forceinline__ void operator()(const f32x4 (&acc)[2][2][4][2], const gg::Unit& u, int wr, int wc, int fr, int fq) const {
        const int row0 = u.p0 * 256 + wr * 64 + fr, col0 = u.p1 * 256 + wc * 32 + 8 * fq;
#pragma unroll
        for (int ai = 0; ai < 2; ++ai)
#pragma unroll
            for (int m = 0; m < 4; ++m)
#pragma unroll
                for (int bj = 0; bj < 2; ++bj) { const f32x4 v0 = acc[ai][bj][m][0], v1 = acc[ai][bj][m][1];
                    u32x4 w; w.x = cvt_pk_bf16(v0[0], v0[1]); w.y = cvt_pk_bf16(v0[2], v0[3]); w.z = cvt_pk_bf16(v1[0], v1[1]); w.w = cvt_pk_bf16(v1[2], v1[3]);
                    *(u32x4*)(O + (size_t)(row0 + ai * 128 + m * 16) * ldc + col0 + bj * 128) = w; }
    }
};
struct EpiF8Out {
    static constexpr bool PERM = true, FP8 = false; static constexpr int TID = 6; static constexpr unsigned SCB = 0x7f7f7f7fu;
    unsigned char* O; int ldc;
    __device__ __forceinline__ void operator()(const f32x4 (&acc)[2][2][4][2], const gg::Unit& u, int wr, int wc, int fr, int fq) const {
        const int row0 = u.p0 * 256 + wr * 64 + fr, col0 = u.p1 * 256 + wc * 32 + 8 * fq;
#pragma unroll
        for (int ai = 0; ai < 2; ++ai)
#pragma unroll
            for (int m = 0; m < 4; ++m)
#pragma unroll
                for (int bj = 0; bj < 2; ++bj) { const f32x4 v0 = acc[ai][bj][m][0], v1 = acc[ai][bj][m][1];
                    *(u32x2*)(O + (size_t)(row0 + ai * 128 + m * 16) * ldc + col0 + bj * 128) = (u32x2){pk4_fp8(v0[0], v0[1], v0[2], v0[3]), pk4_fp8(v1[0], v1[1], v1[2], v1[3])}; }
    }
};
struct EpiF8OutQ {
    static constexpr bool PERM = true, FP8 = true, ZPEEL = true; static constexpr int TID = 7; static constexpr unsigned SCB = 0x79797979u;
    unsigned char* O; int ldc;
    __device__ __forceinline__ void operator()(const f32x4 (&acc)[2][2][4][2], const gg::Unit& u, int wr, int wc, int fr, int fq) const {
        const int row0 = u.p0 * 256 + wr * 64 + fr, col0 = u.p1 * 256 + wc * 32 + 8 * fq;
#pragma unroll
        for (int ai = 0; ai < 2; ++ai)
#pragma unroll
            for (int m = 0; m < 4; ++m)
#pragma unroll
                for (int bj = 0; bj < 2; ++bj) { const f32x4 v0 = acc[ai][bj][m][0], v1 = acc[ai][bj][m][1];
                    *(u32x2*)(O + (size_t)(row0 + ai * 128 + m * 16) * ldc + col0 + bj * 128) = (u32x2){pk4_fp8(v0[0], v0[1], v0[2], v0[3]), pk4_fp8(v1[0], v1[1], v1[2], v1[3])}; }
    }
};
struct EpiBf16F8 {
    static constexpr bool PERM = true, FP8 = true; static constexpr int TID = 3; static constexpr unsigned SCB = 0x77777777u;
    bf16_t* O; static constexpr int ldc = 1024;
    __device__ __forceinline__ void operator()(const f32x4 (&acc)[2][2][4][2], const gg::Unit& u, int wr, int wc, int fr, int fq) const {
        bf16_t* p = O + (size_t)(u.p0 * 256 + wr * 64 + fr) * ldc + u.p1 * 256 + wc * 32 + 8 * fq;
#pragma unroll
        for (int ai = 0; ai < 2; ++ai) {
#pragma unroll
            for (int m = 0; m < 4; ++m) {
#pragma unroll
                for (int bj = 0; bj < 2; ++bj) { const f32x4 v0 = acc[ai][bj][m][0], v1 = acc[ai][bj][m][1];
                    u32x4 w; w.x = cvt_pk_bf16(v0[0], v0[1]); w.y = cvt_pk_bf16(v0[2], v0[3]); w.z = cvt_pk_bf16(v1[0], v1[1]); w.w = cvt_pk_bf16(v1[2], v1[3]);
                    *(u32x4*)(p + bj * 128) = w; }
                p += 16 * ldc; asm volatile("" : "+v"(p)); }
            p += 64 * ldc; }
    }
};

__device__ __forceinline__ int crow(int r, int hi) { return (r & 3) + 8 * (r >> 2) + 4 * hi; }
__device__ __forceinline__ f32x16 mma32_ll(f32x16 acc, const LAS bf16_t* A, int lda, const LAS bf16_t* B, int ldb, int ksteps, int lane, int ks0 = 0) {
    const int r32 = lane & 31, hi = lane >> 5;
    for (int ks = ks0; ks < ksteps; ++ks) {
        const bf16x8 a = *(const LAS bf16x8*)(A + r32 * lda + ks * 16 + hi * 8);
        const bf16x8 b = *(const LAS bf16x8*)(B + r32 * ldb + ks * 16 + hi * 8);
        acc = __builtin_amdgcn_mfma_f32_32x32x16_bf16(a, b, acc, 0, 0, 0);
    }
    return acc;
}
template <int KS> __device__ __forceinline__ f32x16 mma32_lg(f32x16 acc, const LAS bf16_t* A, int lda, const bf16_t* B, int ldb, int lane) {
    const int r32 = lane & 31, hi = lane >> 5;
    bf16x8 b[KS];
#pragma unroll
    for (int ks = 0; ks < KS; ++ks) b[ks] = *(const bf16x8*)(B + (size_t)r32 * ldb + ks * 16 + hi * 8);
#pragma unroll
    for (int ks = 0; ks < KS; ++ks) { const bf16x8 a = *(const LAS bf16x8*)(A + r32 * lda + ks * 16 + hi * 8); acc = __builtin_amdgcn_mfma_f32_32x32x16_bf16(a, b[ks], acc, 0, 0, 0); }
    return acc;
}

__device__ __forceinline__ void ph_pre(const Frame& F) {
    LAS float* sv = (LAS float*)F.lds;
    LAS float* part = sv + 9 * 1024;
    float* mod = (float*)(F.ws + WS_MOD);
    for (int i = F.tid; i < 9 * 1024; i += NTHR) { const int r = i >> 10, k = i & 1023; const float c = (r < 8) ? F.in[I_C][r * 1024 + k] : F.in[I_CCTX][k]; sv[i] = c * sigmoidf_(c); }
    __syncthreads();
    for (int it = F.bx; it < 2 * 96; it += F.G) {
        const int l = it / 96, jc = it % 96, j = jc * 64 + F.lane, k0 = F.wave * 128;
        const float* w = F.in[I_WMOD] + ((size_t)l * 1024 + k0) * 6144 + j;
        float a[9];
#pragma unroll
        for (int r = 0; r < 9; ++r) a[r] = 0.f;
#pragma unroll 4
        for (int k = 0; k < 128; ++k) { const float wv = w[(size_t)k * 6144];
#pragma unroll
            for (int r = 0; r < 9; ++r) a[r] += sv[r * 1024 + k0 + k] * wv; }
#pragma unroll
        for (int r = 0; r < 9; ++r) part[(F.wave * 9 + r) * 64 + F.lane] = a[r];
        __syncthreads();
        for (int i = F.tid; i < 9 * 64; i += NTHR) { const int r = i >> 6, jj = i & 63; float s = F.in[I_BMOD][l * 6144 + jc * 64 + jj];
#pragma unroll
            for (int w8 = 0; w8 < 8; ++w8) s += part[(w8 * 9 + r) * 64 + jj];
            mod[((size_t)(l * 9 + r)) * 6144 + jc * 64 + jj] = s; }
        __syncthreads();
    }
    if (F.bx == F.G - 1) {
        float* rt = (float*)(F.ws + T_ROPE);
        for (int i = F.tid; i < 1024; i += NTHR) { const int pos = i >> 3, f = i & 7; const float inv = powf(10000.0f, -(float)f / 8.0f); const float ang = (float)pos * inv; rt[2 * i] = cosf(ang); rt[2 * i + 1] = sinf(ang); }
    }
}

struct ConvCursor { int base; int gw, ngw; };
__device__ __forceinline__ void conv_mat(const Frame& F, ConvCursor& cc, const float* src, int K, int N, bf16_t* dst, int ldd, int rbase, int rstep, int nbatch, size_t sbs, size_t dbs, int rq = 128, bool gperm = false, float f8scale = 0.f) {
    const int ktl = K / 64, ntl = (N + 127) / 128, per = ktl * ntl, total = per * nbatch;
    int t = cc.base + ((cc.gw - cc.base) % cc.ngw + cc.ngw) % cc.ngw;
    for (; t < cc.base + total; t += cc.ngw) {
        const int li = t - cc.base, bt = li / per, rem = li % per, kb = rem / ntl, nb = rem % ntl, k0 = kb * 64, n = nb * 128 + 2 * F.lane;
        if (n < N) {
            const float* s = src + bt * sbs + (size_t)k0 * N + n; bf16_t* d = dst + bt * dbs;
            f32x2 v[64];
#pragma unroll
            for (int i = 0; i < 64; ++i) v[i] = *(const f32x2*)(s + (size_t)i * N);
#pragma unroll
            for (int q = 0; q < 2; ++q) { const int nn = n + q; const int drow = gperm ? ((nn >> 6) * 256 + ((nn >> 4) & 3) * 32 + (nn & 15) + 128 * (bt >> 1) + 16 * (bt & 1)) : (rbase + (nn / rq) * rstep + (nn % rq));
                if (f8scale != 0.f) { unsigned char* d8 = (unsigned char*)dst + bt * dbs + (size_t)drow * ldd + k0;
#pragma unroll
                    for (int p = 0; p < 4; ++p) { u32x4 o; o.x = pk4_fp8(v[16 * p][q] * f8scale, v[16 * p + 1][q] * f8scale, v[16 * p + 2][q] * f8scale, v[16 * p + 3][q] * f8scale);
                        o.y = pk4_fp8(v[16 * p + 4][q] * f8scale, v[16 * p + 5][q] * f8scale, v[16 * p + 6][q] * f8scale, v[16 * p + 7][q] * f8scale);
                        o.z = pk4_fp8(v[16 * p + 8][q] * f8scale, v[16 * p + 9][q] * f8scale, v[16 * p + 10][q] * f8scale, v[16 * p + 11][q] * f8scale);
                        o.w = pk4_fp8(v[16 * p + 12][q] * f8scale, v[16 * p + 13][q] * f8scale, v[16 * p + 14][q] * f8scale, v[16 * p + 15][q] * f8scale);
                        *(u32x4*)(d8 + 16 * p) = o; }
                    continue; }
                bf16_t* dr = d + (size_t)drow * ldd + k0;
#pragma unroll
                for (int p = 0; p < 8; ++p) { u32x4 o; o.x = pk2(v[8 * p][q], v[8 * p + 1][q]); o.y = pk2(v[8 * p + 2][q], v[8 * p + 3][q]); o.z = pk2(v[8 * p + 4][q], v[8 * p + 5][q]); o.w = pk2(v[8 * p + 6][q], v[8 * p + 7][q]);
                    *(u32x4*)(dr + 8 * p) = o; } }
        }
    }
    cc.base += total;
}
__device__ __forceinline__ void ph_convert(const Frame& F, int l) {
    ConvCursor cc; cc.base = 0; cc.gw = F.bx * NWAVES + F.wave; cc.ngw = F.G * NWAVES;
    unsigned char* ws = F.ws;
    conv_mat(F, cc, F.in[I_WIN] + (size_t)l * 1024 * INC, 1024, INC, (bf16_t*)(ws + W_IN), 1024, 0, 128, 1, 0, 0, 128, false, 64.0f);
    conv_mat(F, cc, F.in[I_WGATE] + (size_t)l * 4 * 1024 * 1024, 1024, 1024, (bf16_t*)(ws + W_GATE), 1024, 0, 128, 4, (size_t)1024 * 1024, 0, 128, true, 64.0f);
    conv_mat(F, cc, F.in[I_WBR] + (size_t)l * 4 * 256 * 1024, 256, 1024, (bf16_t*)(ws + W_BR), 256, 0, 128, 4, (size_t)256 * 1024, (size_t)1024 * 256);
    conv_mat(F, cc, F.in[I_WOUT] + (size_t)l * 1024 * 1024, 1024, 1024, (bf16_t*)(ws + W_OUT), 1024, 0, 128, 1, 0, 0, 128, false, 64.0f);
    conv_mat(F, cc, F.in[I_W1] + (size_t)l * 64 * 1024 * 256, 1024, 256, (bf16_t*)(ws + W_13), 1024, 0, 256, 64, (size_t)1024 * 256, (size_t)512 * 1024, 128, false, 64.0f);
    conv_mat(F, cc, F.in[I_W3] + (size_t)l * 64 * 1024 * 256, 1024, 256, (bf16_t*)(ws + W_13), 1024, 128, 256, 64, (size_t)1024 * 256, (size_t)512 * 1024, 128, false, 64.0f);
    conv_mat(F, cc, F.in[I_W2] + (size_t)l * 64 * 256 * 1024, 256, 1024, (bf16_t*)(ws + W_2), 256, 0, 128, 64, (size_t)256 * 1024, (size_t)1024 * 256, 128, false, 32.0f);
    conv_mat(F, cc, F.in[I_WS1] + (size_t)l * 1024 * 256, 1024, 256, (bf16_t*)(ws + W_13 + (size_t)64 * 512 * 1024), 1024, 0, 256, 1, 0, 0, 128, false, 64.0f);
    conv_mat(F, cc, F.in[I_WS3] + (size_t)l * 1024 * 256, 1024, 256, (bf16_t*)(ws + W_13 + (size_t)64 * 512 * 1024), 1024, 128, 256, 1, 0, 0, 128, false, 64.0f);
    conv_mat(F, cc, F.in[I_WS2] + (size_t)l * 256 * 1024, 256, 1024, (bf16_t*)(ws + W_2 + (size_t)64 * 1024 * 256), 256, 0, 128, 1, 0, 0, 128, false, 32.0f);
    conv_mat(F, cc, F.in[I_WUQ] + (size_t)l * 256 * 384, 256, 384, (bf16_t*)(ws + W_UQ), 256, 0, 128, 1, 0, 0);
    conv_mat(F, cc, F.in[I_WUKV] + (size_t)l * 128 * 512, 128, 512, (bf16_t*)(ws + W_UKV), 128, 0, 128, 1, 0, 0);
    conv_mat(F, cc, F.in[I_POOLW] + (size_t)l * 4 * 64 * 64, 64, 64, (bf16_t*)(ws + W_POOL), 64, 0, 128, 4, (size_t)64 * 64, (size_t)64 * 64);
    conv_mat(F, cc, F.in[I_WRT] + (size_t)l * 1024 * 64, 1024, 64, (bf16_t*)(ws + W_RT), 1024, 0, 128, 1, 0, 0);
    { u32x4* z = (u32x4*)(ws + W_IN + (size_t)INC * 1024); const int n16 = (INCP - INC) * 1024 / 16;
      unsigned z0 = 0u; asm volatile("" : "+v"(z0));
      for (int i = F.bx * NTHR + F.tid; i < n16; i += F.G * NTHR) z[i] = (u32x4){z0, z0, z0, z0}; }
}

__device__ __forceinline__ void normmod_vals(int lane, const f32x4 (&v)[4], const float* g, const float* sc, const float* sh, f32x4 (&y)[4]) {
    float s = 0.f;
#pragma unroll
    for (int j = 0; j < 4; ++j) s += (v[j].x * v[j].x + v[j].y * v[j].y) + (v[j].z * v[j].z + v[j].w * v[j].w);
    const float rstd = frsq(wave_sum(s) * (1.f / 1024.f) + EPS);
#pragma unroll
    for (int j = 0; j < 4; ++j) { const f32x4 gv = ((const f32x4*)g)[lane + 64 * j], scv = ((const f32x4*)sc)[lane + 64 * j], shv = ((const f32x4*)sh)[lane + 64 * j];
        y[j] = v[j] * rstd * gv * (scv + 1.0f) + shv; }
}
__device__ __forceinline__ void normmod_row(int lane, const float* xrow, const float* g, const float* sc, const float* sh, f32x4 (&y)[4]) {
    const f32x4* xr = (const f32x4*)xrow + lane; f32x4 v[4]; float s = 0.f;
#pragma unroll
    for (int j = 0; j < 4; ++j) { v[j] = xr[64 * j]; s += (v[j].x * v[j].x + v[j].y * v[j].y) + (v[j].z * v[j].z + v[j].w * v[j].w); }
    const float rstd = frsq(wave_sum(s) * (1.f / 1024.f) + EPS);
#pragma unroll
    for (int j = 0; j < 4; ++j) { const f32x4 gv = ((const f32x4*)g)[lane + 64 * j], scv = ((const f32x4*)sc)[lane + 64 * j], shv = ((const f32x4*)sh)[lane + 64 * j];
        y[j] = v[j] * rstd * gv * (scv + 1.0f) + shv; }
}
__device__ __forceinline__ const float* stream_row(const Frame& F, int l, int row) {
    if (row < NLAT) return (l == 0 ? F.in[I_X] : F.out) + (size_t)row * 1024;
    return (l == 0 ? F.in[I_CTX] : (const float*)(F.ws + WS_CTXS)) + (size_t)(row - NLAT) * 1024;
}
__device__ __forceinline__ void ph_norm1(const Frame& F, int l) {
    const int gw = F.bx * NWAVES + F.wave, ngw = F.G * NWAVES;
    for (int row0 = gw; row0 < NTOK; row0 += 2 * ngw) {
        const int row1 = row0 + ngw; const bool has1 = row1 < NTOK;
        f32x4 v0[4], v1[4];
        { const f32x4* x0 = (const f32x4*)stream_row(F, l, row0) + F.lane; const f32x4* x1 = (const f32x4*)stream_row(F, l, has1 ? row1 : row0) + F.lane;
#pragma unroll
          for (int j = 0; j < 4; ++j) { v0[j] = x0[64 * j]; v1[j] = x1[64 * j]; } }
#pragma unroll
        for (int k = 0; k < 2; ++k) { if (k == 1 && !has1) break; const int row = k ? row1 : row0; const int mr = mod_row_of(row); f32x4 y[4];
            normmod_vals(F.lane, k ? v1 : v0, F.in[I_GMIX] + l * 1024, modp(F, l, mr, 1), modp(F, l, mr, 0), y);
            unsigned* o8 = (unsigned*)(F.ws + WS_HX8 + (size_t)row * 1024) + F.lane;
#pragma unroll
            for (int j = 0; j < 4; ++j) o8[64 * j] = pk4_fp8(y[j].x, y[j].y, y[j].z, y[j].w); }
    }
}

constexpr float QSCALE = 0.10206207261596577f * 1.4426950408889634f;
template <int KS> __device__ __forceinline__ void ld_bfrag(bf16x8* b, const bf16_t* B, int ldb, int lane) {
#pragma unroll
    for (int ks = 0; ks < KS; ++ks) b[ks] = *(const bf16x8*)(B + (size_t)(lane & 31) * ldb + ks * 16 + (lane >> 5) * 8);
}
template <int KS> __device__ __forceinline__ f32x16 mma32_lr(const LAS bf16_t* A, int lda, const bf16x8* b, int lane) {
    f32x16 acc = {};
#pragma unroll
    for (int ks = 0; ks < KS; ++ks) { const bf16x8 a = *(const LAS bf16x8*)(A + (lane & 31) * lda + ks * 16 + (lane >> 5) * 8); acc = __builtin_amdgcn_mfma_f32_32x32x16_bf16(a, b[ks], acc, 0, 0, 0); }
    return acc;
}
__device__ __forceinline__ f32x2 mla_rope_ld(const Frame& F, int unit) {
    const int row0 = unit * 32; const bool isctx = row0 >= NLAT; const int pos0 = isctx ? (row0 - NLAT) & 255 : row0 & 8191;
    const int pos = pos0 + (F.tid >> 4), pp = (F.tid & 8) ? (pos & 63) : (pos >> 6);
    return *(const f32x2*)((const float*)(F.ws + T_ROPE) + (pp * 8 + (F.tid & 7)) * 2);
}
struct MlaKvRegs { unsigned xk[4]; unsigned xr[4]; f32x2 rp; };
__device__ __forceinline__ MlaKvRegs mla_kv_load(const Frame& F, int unit) {
    MlaKvRegs R; const bf16_t* px = (const bf16_t*)(F.ws + WS_PX);
#pragma unroll
    for (int rr = 0; rr < 4; ++rr) { const bf16_t* p = px + (size_t)(unit * 32 + F.wave * 4 + rr) * INC + C_MLA;
        R.xk[rr] = *(const unsigned*)(p + 256 + 2 * F.lane); R.xr[rr] = *(const unsigned*)(p + 384 + 2 * (F.lane & 15)); }
    R.rp = mla_rope_ld(F, unit);
    return R;
}
__device__ __forceinline__ void mla_kv_unit(const Frame& F, int unit, const MlaKvRegs& R, const bf16x8* wkv, f32x2 gckv2, float g0, float g1, float g2) {
    LAS unsigned char* lds = F.lds;
    LAS bf16_t* AKV = (LAS bf16_t*)lds;
    LAS float* KR = (LAS float*)(lds + 8704);
    LAS f32x2* RP = (LAS f32x2*)(lds + 12800);
    LAS float* OUT = (LAS float*)(lds + 16896);
    LAS unsigned char* KB = (LAS unsigned char*)(lds + 83456);
    int tid_ = F.tid; asm volatile("" : "+v"(tid_));
    const int row0 = unit * 32, tid = tid_, lane = tid & 63, wave = F.wave, r32 = lane & 31, hi = lane >> 5;
    const bool isctx = row0 >= NLAT;
    const int b = isctx ? (row0 - NLAT) >> 8 : row0 >> 13, pos0 = isctx ? (row0 - NLAT) & 255 : row0 & 8191;
    LDS_BAR();
    RP[tid] = R.rp;
#pragma unroll
    for (int rr = 0; rr < 4; ++rr) { const int r = wave * 4 + rr; const unsigned w = R.xk[rr]; const float x0 = bflo(w), x1 = bfhi(w);
        const float sc = frsq(wave_sum(x0 * x0 + x1 * x1) * (1.f / 128.f) + EPS);
        *(LAS unsigned*)(AKV + r * 136 + 2 * lane) = pk2(x0 * sc * gckv2.x, x1 * sc * gckv2.y);
        if (lane < 16) *(LAS f32x2*)(KR + r * 32 + 2 * lane) = (f32x2){bflo(R.xr[rr]), bfhi(R.xr[rr])}; }
    LDS_BAR();
#pragma unroll
    for (int i = 0; i < 2; ++i) { const int nt = wave * 2 + i; const f32x16 acc = mma32_lr<8>(AKV, 136, wkv + 8 * i, lane);
#pragma unroll
        for (int r = 0; r < 16; ++r) OUT[crow(r, hi) * 520 + nt * 32 + r32] = acc[r]; }
    LDS_BAR();
#pragma unroll
    for (int it = 0; it < 8; ++it) { const int pr = wave * 16 + it * 2 + hi, r = pr >> 2, h = pr & 3; const LAS float* o = OUT + r * 520 + h * 128;
        float v0 = o[r32], v1 = o[32 + r32], v2 = KR[r * 32 + r32]; const float ss = half_sum(v0 * v0 + v1 * v1 + v2 * v2);
        const float sc = frsq(ss * (1.f / 96.f) + EPS);
        v0 *= sc * g0; v1 *= sc * g1; v2 *= sc * g2;
        const float pv = xor_lane<8>(v2);
        if (!isctx) { const f32x2 cssn = RP[(r * 2 + (r32 >> 4)) * 8 + (r32 & 7)]; v2 = (r32 & 8) ? (v2 * cssn.x + pv * cssn.y) : (v2 * cssn.x - pv * cssn.y); }
        LAS unsigned char* kb = KB + r * 400 + h * 96;
        kb[r32] = f2f8(v0); kb[32 + r32] = f2f8(v1); kb[64 + r32] = f2f8(v2); }
    LDS_BAR();
    const int key0 = isctx ? pos0 : 256 + pos0, tile = key0 >> 6, kin = key0 & 63;
    for (int i = tid; i < 768; i += NTHR) { const int r = i & 31, c = (i >> 5) % 6, h = i / 192;
        const u32x4 v = *(const LAS u32x4*)(KB + r * 400 + h * 96 + c * 16);
        *(u32x4*)(F.ws + WS_KT + ((size_t)((b * 4 + h) * NKT + tile) * 6 + c) * 1024 + (kin + r) * 16) = v; }
    for (int i = tid; i < 1024; i += NTHR) { const int p = i & 3, r = (i >> 2) & 31, dh = (i >> 7) & 1, h = i >> 8; const LAS float* o = OUT + r * 520 + h * 128 + 64 + dh * 32 + p * 8;
        u32x4 v; v.x = pk2(o[0], o[1]); v.y = pk2(o[2], o[3]); v.z = pk2(o[4], o[5]); v.w = pk2(o[6], o[7]);
        *(u32x4*)((bf16_t*)(F.ws + WS_VT) + ((size_t)((b * 4 + h) * NKT + tile) * 2 + dh) * 2048 + (kin + r) * 32 + p * 8) = v; }
}
struct MlaQRegs { u32x2 xq[4]; f32x2 rp; };
__device__ __forceinline__ MlaQRegs mla_q_load(const Frame& F, int unit) {
    MlaQRegs R; const bf16_t* px = (const bf16_t*)(F.ws + WS_PX);
#pragma unroll
    for (int rr = 0; rr < 4; ++rr) R.xq[rr] = *(const u32x2*)(px + (size_t)(unit * 32 + F.wave * 4 + rr) * INC + C_MLA + 4 * F.lane);
    R.rp = mla_rope_ld(F, unit);
    return R;
}
__device__ __forceinline__ void mla_q_unit(const Frame& F, int unit, const MlaQRegs& R, const bf16x8* wqf, f32x4 gcq4, float g0, float g1, float g2) {
    LAS unsigned char* lds = F.lds;
    LAS bf16_t* AQ = (LAS bf16_t*)lds;
    LAS f32x2* RP = (LAS f32x2*)(lds + 16896);
    LAS float* OQ = (LAS float*)(lds + 20992);
    int tid_ = F.tid; asm volatile("" : "+v"(tid_));
    const int row0 = unit * 32, tid = tid_, lane = tid & 63, wave = F.wave, r32 = lane & 31, hi = lane >> 5;
    const bool isctx = row0 >= NLAT;
    LDS_BAR();
    RP[tid] = R.rp;
#pragma unroll
    for (int rr = 0; rr < 4; ++rr) { const int r = wave * 4 + rr; const u32x2 w = R.xq[rr]; const float x0 = bflo(w.x), x1 = bfhi(w.x), x2 = bflo(w.y), x3 = bfhi(w.y);
        const float sc = frsq(wave_sum(x0 * x0 + x1 * x1 + x2 * x2 + x3 * x3) * (1.f / 256.f) + EPS);
        *(LAS u32x2*)(AQ + r * 264 + 4 * lane) = (u32x2){pk2(x0 * sc * gcq4.x, x1 * sc * gcq4.y), pk2(x2 * sc * gcq4.z, x3 * sc * gcq4.w)}; }
    LDS_BAR();
    { const f32x16 acc = mma32_lr<16>(AQ, 264, wqf, lane);
#pragma unroll
      for (int r = 0; r < 16; ++r) OQ[crow(r, hi) * 392 + wave * 32 + r32] = acc[r]; }
    if (wave < 4) { const f32x16 acc = mma32_lr<16>(AQ, 264, wqf + 16, lane);
#pragma unroll
      for (int r = 0; r < 16; ++r) OQ[crow(r, hi) * 392 + (8 + wave) * 32 + r32] = acc[r]; }
    LDS_BAR();
    unsigned char* qb = F.ws + WS_QB;
#pragma unroll
    for (int it = 0; it < 8; ++it) { const int pr = wave * 16 + it * 2 + hi, r = pr >> 2, h = pr & 3; const LAS float* o = OQ + r * 392 + h * 96;
        float v0 = o[r32], v1 = o[32 + r32], v2 = o[64 + r32]; const float ss = half_sum(v0 * v0 + v1 * v1 + v2 * v2);
        const float sc = frsq(ss * (1.f / 96.f) + EPS);
        v0 *= sc * g0; v1 *= sc * g1; v2 *= sc * g2;
        const float pv = xor_lane<8>(v2);
        if (!isctx) { const f32x2 cssn = RP[(r * 2 + (r32 >> 4)) * 8 + (r32 & 7)]; v2 = (r32 & 8) ? (v2 * cssn.x + pv * cssn.y) : (v2 * cssn.x - pv * cssn.y); }
        unsigned char* q = qb + (size_t)(row0 + r) * 384 + h * 96;
        q[r32] = f2f8(v0 * (8.0f * QSCALE)); q[32 + r32] = f2f8(v1 * (8.0f * QSCALE)); q[64 + r32] = f2f8(v2 * (8.0f * QSCALE)); }
}
__device__ __forceinline__ void mla_prep(const Frame& F, int l) {
    const int lane = F.lane, wave = F.wave, r32 = lane & 31;
    { bf16x8 wkv[16]; const bf16_t* wukv = (const bf16_t*)(F.ws + W_UKV);
      ld_bfrag<8>(wkv, wukv + (size_t)(wave * 2) * 32 * 128, 128, lane); ld_bfrag<8>(wkv + 8, wukv + (size_t)(wave * 2 + 1) * 32 * 128, 128, lane);
      const f32x2 gckv2 = *(const f32x2*)(F.in[I_GCKV] + l * 128 + 2 * lane); const float* gkn = F.in[I_GKN] + l * 96; const float g0 = gkn[r32], g1 = gkn[32 + r32], g2 = gkn[64 + r32];
      const int nu = NTOK / 32;
      if (F.bx < nu) { MlaKvRegs R = mla_kv_load(F, F.bx);
          for (int u = F.bx; u < nu; u += F.G) { const MlaKvRegs Rn = mla_kv_load(F, (u + F.G < nu) ? u + F.G : u); mla_kv_unit(F, u, R, wkv, gckv2, g0, g1, g2); R = Rn; } } }
    { bf16x8 wqf[32]; const bf16_t* wuq = (const bf16_t*)(F.ws + W_UQ);
      ld_bfrag<16>(wqf, wuq + (size_t)wave * 32 * 256, 256, lane); if (wave < 4) ld_bfrag<16>(wqf + 16, wuq + (size_t)(8 + wave) * 32 * 256, 256, lane);
      const f32x4 gcq4 = *(const f32x4*)(F.in[I_GCQ] + l * 256 + 4 * lane); const float* gqn = F.in[I_GQN] + l * 96; const float g0 = gqn[r32], g1 = gqn[32 + r32], g2 = gqn[64 + r32];
      const int nu = (l == 0 ? NTOK : NLAT) / 32;
      if (F.bx < nu) { MlaQRegs R = mla_q_load(F, F.bx);
          for (int u = F.bx; u < nu; u += F.G) { const MlaQRegs Rn = mla_q_load(F, (u + F.G < nu) ? u + F.G : u); mla_q_unit(F, u, R, wqf, gcq4, g0, g1, g2); R = Rn; } } }
}

__device__ __forceinline__ void ml_chunk_pos(int dir, int j, bool& isctx, int& p0) {
    if (j < 2) { isctx = true; p0 = (dir == 0 ? j : 1 - j) * 128; } else { isctx = false; p0 = (dir == 0 ? (j - 2) : (63 - (j - 2))) * 128; }
}
__device__ __forceinline__ int ml_row(int b, bool isctx, int pos) { return isctx ? NLAT + b * 256 + pos : b * 8192 + pos; }
__device__ __forceinline__ float log_sigmoidf_(float x) { return fminf(x, 0.f) - log1pf(__expf(-fabsf(x))); }

struct P1Regs { u32x4 kv[4]; float gi, gf; };
__device__ __forceinline__ P1Regs ml_pass1_load(const Frame& F, int unit) {
    P1Regs R; const int j = unit % NCHK, dir = (unit / NCHK) & 1, h = (unit / (NCHK * 2)) & 3, b = unit / (NCHK * 8);
    bool isctx; int p0; ml_chunk_pos(dir, j, isctx, p0);
    const bf16_t* px = (const bf16_t*)(F.ws + WS_PX); const float* gate = (const float*)(F.ws + T_GATE); const int tid = F.tid;
#pragma unroll
    for (int q = 0; q < 4; ++q) { const int it = tid + q * NTHR, i = it & 127, c = (it >> 7) & 7, isv = it >> 10; const int pos = dir ? p0 + 127 - i : p0 + i;
        R.kv[q] = *(const u32x4*)(px + (size_t)ml_row(b, isctx, pos) * INC + (isv ? 512 : 256) + h * 64 + c * 8); }
    { const int i = tid & 127; const int pos = dir ? p0 + 127 - i : p0 + i; const float* g = gate + (size_t)ml_row(b, isctx, pos) * 16; R.gi = g[dir * 8 + h]; R.gf = g[dir * 8 + 4 + h]; }
    return R;
}
__device__ __forceinline__ void ml_pass1_unit(const Frame& F, int l, int unit, const P1Regs& R) {
    LAS float* LI = (LAS float*)F.lds; LAS float* LF = LI + 128; LAS float* WV = LI + 256;
    LAS bf16_t* KT = (LAS bf16_t*)(F.lds + 2048); LAS bf16_t* VT = KT + 64 * 136;
    const int dir = (unit / NCHK) & 1, h = (unit / (NCHK * 2)) & 3;
    const int tid = F.tid, lane = F.lane, wave = F.wave;
    const float* gb = F.in[I_MLGB] + l * 16;
    LDS_BAR();
    if (tid < 128) { LI[tid] = R.gi + gb[dir * 8 + h]; LF[tid] = log_sigmoidf_(R.gf + gb[dir * 8 + 4 + h]); }
    LDS_BAR();
    if (wave == 0) {
        const float a0 = LF[2 * lane], a1 = LF[2 * lane + 1]; float s = a0 + a1;
#pragma unroll
        for (int o = 1; o < 64; o <<= 1) { const float t = lane_up(s, o, lane); if (lane >= o) s += t; }
        const float bend = lane_bcast(s, 63);
        const float w0 = bend - (s - a1) + LI[2 * lane], w1 = bend - s + LI[2 * lane + 1];
        const float mloc = wave_max(fmaxf(w0, w1));
        WV[2 * lane] = __expf(w0 - mloc); WV[2 * lane + 1] = __expf(w1 - mloc);
        if (lane == 0) { ((float*)(F.ws + T_MLOC))[unit] = mloc; ((float*)(F.ws + T_BEND))[unit] = bend; }
    }
    LDS_BAR();
#pragma unroll
    for (int q = 0; q < 4; ++q) { const int it = tid + q * NTHR, i = it & 127, c = (it >> 7) & 7, isv = it >> 10; const u32x4 v = R.kv[q];
        const float sc = isv ? 1.0f : 0.125f * WV[i]; LAS bf16_t* d = (isv ? VT : KT) + (c * 8) * 136 + i;
        d[0] = (bf16_t)f2bf(bflo(v.x) * sc); d[136] = (bf16_t)f2bf(bfhi(v.x) * sc); d[272] = (bf16_t)f2bf(bflo(v.y) * sc); d[408] = (bf16_t)f2bf(bfhi(v.y) * sc);
        d[544] = (bf16_t)f2bf(bflo(v.z) * sc); d[680] = (bf16_t)f2bf(bfhi(v.z) * sc); d[816] = (bf16_t)f2bf(bflo(v.w) * sc); d[952] = (bf16_t)f2bf(bfhi(v.w) * sc); }
    LDS_BAR();
    if (wave < 4) { const int et = wave >> 1, dt = wave & 1; f32x16 acc = {}; acc = mma32_ll(acc, VT + et * 32 * 136, 136, KT + dt * 32 * 136, 136, 8, lane);
        float* dc = (float*)(F.ws + WS_DC) + (size_t)unit * 4096; const int r32 = lane & 31, hi = lane >> 5;
#pragma unroll
        for (int r = 0; r < 16; ++r) dc[(et * 32 + crow(r, hi)) * 64 + dt * 32 + r32] = acc[r];
    } else if (wave == 4) { float s = 0.f; for (int i = 0; i < 128; ++i) s += bf2f(KT[lane * 136 + i]); ((float*)(F.ws + T_DN))[(size_t)unit * 64 + lane] = s; }
}

__device__ __forceinline__ void ml_pass2(const Frame& F) {
    const float* dc = (const float*)(F.ws + WS_DC); const float* dn = (const float*)(F.ws + T_DN);
    const float* mloc = (const float*)(F.ws + T_MLOC); const float* bend = (const float*)(F.ws + T_BEND);
    bf16_t* cst = (bf16_t*)(F.ws + WS_CST); float* nst = (float*)(F.ws + T_NST); float* mst = (float*)(F.ws + T_MST);
    LAS float* ML = (LAS float*)F.lds; LAS float* BE = ML + 128;
    for (int it = F.bx; it < 64 * 8; it += F.G) { const int bhd = it >> 3, part = it & 7, u0 = bhd * NCHK, el = part * 512 + F.tid;
        const bool don = (part == 0 && F.tid < 64);
        float d[NCHK], dnv[NCHK];
#pragma unroll
        for (int j = 0; j < NCHK; ++j) d[j] = dc[(size_t)(u0 + j) * 4096 + el];
#pragma unroll
        for (int j = 0; j < NCHK; ++j) dnv[j] = don ? dn[(size_t)(u0 + j) * 64 + F.tid] : 0.f;
        __syncthreads();
        if (F.tid < NCHK) { ML[F.tid] = mloc[u0 + F.tid]; BE[F.tid] = bend[u0 + F.tid]; }
        __syncthreads();
        float C = 0.f, n = 0.f, m = 0.f;
#pragma unroll
        for (int j = 0; j < NCHK; ++j) { const int u = u0 + j; const float ml = ML[j], be = BE[j];
            cst[(size_t)u * 4096 + el] = (bf16_t)f2bf(C); if (don) nst[(size_t)u * 64 + F.tid] = n; if (part == 0 && F.tid == 0) mst[u] = m;
            const float mn = fmaxf(be + m, ml), dcy = __expf(be + m - mn), sc = __expf(ml - mn);
            C = dcy * C + sc * d[j]; n = dcy * n + sc * dnv[j]; m = mn; }
    }
    __syncthreads();
}

__device__ __forceinline__ void ml_pass3_unit(const Frame& F, int l, int b, int h, int pc) {
    LAS unsigned char* lds = F.lds;
    LAS bf16_t* Qs = (LAS bf16_t*)lds;
    LAS bf16_t* Ks = (LAS bf16_t*)(lds + 18432);
    LAS bf16_t* VTs = (LAS bf16_t*)(lds + 36864);
    LAS bf16_t* CTs = (LAS bf16_t*)(lds + 62976);
    LAS bf16_t* Wm = (LAS bf16_t*)(lds + 76800);
    LAS float* HS = (LAS float*)(lds + 111616);
    LAS float* VEC = (LAS float*)(lds + 144384);
    LAS float* DEN = VEC + 12 * 128;
    const int tid = F.tid, lane = F.lane, wave = F.wave, r32 = lane & 31, hi = lane >> 5;
    const bool isctx = pc < 2; const int p0 = isctx ? pc * 128 : (pc - 2) * 128;
    const float* gate = (const float*)(F.ws + T_GATE); const float* gb = F.in[I_MLGB] + l * 16;
    const bf16_t* px = (const bf16_t*)(F.ws + WS_PX);
    int unit_d[2];
#pragma unroll
    for (int dir = 0; dir < 2; ++dir) { const int j = isctx ? (dir == 0 ? pc : 1 - pc) : (dir == 0 ? pc : 2 + 63 - (pc - 2)); unit_d[dir] = ((b * 4 + h) * 2 + dir) * NCHK + j; }
    LDS_BAR();
    const u32x4 cst0 = *(const u32x4*)((const bf16_t*)(F.ws + WS_CST) + (size_t)unit_d[0] * 4096 + tid * 8), cst1 = *(const u32x4*)((const bf16_t*)(F.ws + WS_CST) + (size_t)unit_d[1] * 4096 + tid * 8);
    const float nv0 = (tid < 64) ? ((const float*)(F.ws + T_NST))[(size_t)unit_d[0] * 64 + tid] : 0.f, nv1 = (tid < 64) ? ((const float*)(F.ws + T_NST))[(size_t)unit_d[1] * 64 + tid] : 0.f;
    const float mst0 = ((const float*)(F.ws + T_MST))[unit_d[0]], mst1 = ((const float*)(F.ws + T_MST))[unit_d[1]];
    if (tid < 256) { const int dir = tid >> 7, i = tid & 127; const int pos = dir ? p0 + 127 - i : p0 + i; const float* g = gate + (size_t)ml_row(b, isctx, pos) * 16;
        VEC[(dir * 6 + 0) * 128 + i] = g[dir * 8 + h] + gb[dir * 8 + h]; VEC[(dir * 6 + 1) * 128 + i] = log_sigmoidf_(g[dir * 8 + 4 + h] + gb[dir * 8 + 4 + h]); }
    for (int it = tid; it < 3072; it += NTHR) { const int i = it & 127, c = (it >> 7) & 7, which = it >> 10;
        const u32x4 v = *(const u32x4*)(px + (size_t)ml_row(b, isctx, p0 + i) * INC + which * 256 + h * 64 + c * 8);
        if (which == 0) *(LAS u32x4*)(Qs + i * 72 + c * 8) = v;
        else if (which == 1) { u32x4 w; w.x = pk2(bflo(v.x) * 0.125f, bfhi(v.x) * 0.125f); w.y = pk2(bflo(v.y) * 0.125f, bfhi(v.y) * 0.125f); w.z = pk2(bflo(v.z) * 0.125f, bfhi(v.z) * 0.125f); w.w = pk2(bflo(v.w) * 0.125f, bfhi(v.w) * 0.125f);
            *(LAS u32x4*)(Ks + i * 72 + c * 8) = w; }
        else { LAS bf16_t* d = VTs + (c * 8) * 136 + i; d[0] = (bf16_t)(v.x & 0xffff); d[136] = (bf16_t)(v.x >> 16); d[272] = (bf16_t)(v.y & 0xffff); d[408] = (bf16_t)(v.y >> 16);
            d[544] = (bf16_t)(v.z & 0xffff); d[680] = (bf16_t)(v.z >> 16); d[816] = (bf16_t)(v.w & 0xffff); d[952] = (bf16_t)(v.w >> 16); } }
    for (int it = tid; it < 32 * 136; it += NTHR) VTs[64 * 136 + it] = (it < 128) ? (bf16_t)0x3f80 : (bf16_t)0;
    LDS_BAR();
    if (wave < 2) { const int dir = wave; LAS float* V0 = VEC + dir * 6 * 128; const float mst = dir ? mst1 : mst0;
        const float a0 = V0[128 + 2 * lane], a1 = V0[128 + 2 * lane + 1]; float s = a0 + a1;
#pragma unroll
        for (int o = 1; o < 64; o <<= 1) { const float t = lane_up(s, o, lane); if (lane >= o) s += t; }
        const float b0 = s - a1, b1 = s, c0 = V0[2 * lane] - b0, c1 = V0[2 * lane + 1] - b1;
        float pm = fmaxf(c0, c1);
#pragma unroll
        for (int o = 1; o < 64; o <<= 1) { const float t = lane_up(pm, o, lane); if (lane >= o) pm = fmaxf(pm, t); }
        float pprev = lane_up(pm, 1, lane); if (lane == 0) pprev = -INFINITY;
        const float M0 = fmaxf(mst, fmaxf(pprev, c0)), M1 = fmaxf(mst, pm);
        V0[256 + 2 * lane] = c0; V0[256 + 2 * lane + 1] = c1; V0[384 + 2 * lane] = M0; V0[384 + 2 * lane + 1] = M1;
        V0[512 + 2 * lane] = __expf(mst - M0); V0[512 + 2 * lane + 1] = __expf(mst - M1); V0[640 + 2 * lane] = __expf(-b0 - M0); V0[640 + 2 * lane + 1] = __expf(-b1 - M1);
    }
    const u32x4 og0 = *(const u32x4*)(px + (size_t)ml_row(b, isctx, p0 + (tid >> 3)) * INC + 768 + h * 64 + (tid & 7) * 8), og1 = *(const u32x4*)(px + (size_t)ml_row(b, isctx, p0 + 64 + (tid >> 3)) * INC + 768 + h * 64 + (tid & 7) * 8);
    for (int dir = 0; dir < 2; ++dir) {
        const LAS float* COLV = VEC + (dir * 6 + 2) * 128; const LAS float* MV = COLV + 128; const LAS float* AIN = COLV + 256; const LAS float* EINV = COLV + 384;
        const int rs = dir ? -72 : 72, rb = dir ? 127 : 0;
        LDS_BAR();
        *(LAS u32x4*)(CTs + (tid >> 3) * 72 + (tid & 7) * 8) = dir ? cst1 : cst0;
        if (tid < 72) CTs[64 * 72 + tid] = (tid < 64) ? (bf16_t)f2bf(dir ? nv1 : nv0) : (bf16_t)0;
        for (int q = wave; q < 16; q += 8) { const int ti = q >> 2, si = q & 3; const int sidx = si * 32 + r32, spos = dir ? 127 - sidx : sidx;
            if (si > ti) {
#pragma unroll
                for (int r = 0; r < 16; ++r) Wm[(ti * 32 + crow(r, hi)) * 136 + spos] = 0;
            } else { f32x16 acc = {}; acc = mma32_ll(acc, Qs + (rb + (dir ? -ti * 32 : ti * 32)) * 72, rs, Ks + (rb + (dir ? -si * 32 : si * 32)) * 72, rs, 4, lane); const float cv = COLV[sidx];
#pragma unroll
                for (int r = 0; r < 16; ++r) { const int t = ti * 32 + crow(r, hi); const float w = (sidx <= t) ? acc[r] * __expf(cv - MV[t]) : 0.f; Wm[t * 136 + spos] = (bf16_t)f2bf(w); } }
        }
        LDS_BAR();
        f32x16 tot[2];
#pragma unroll
        for (int k = 0; k < 2; ++k) { const int q = wave + 8 * k; if (q < 12) { const int ti = q / 3, nt = q % 3;
            f32x16 a1 = {}; a1 = mma32_ll(a1, Wm + ti * 32 * 136, 136, VTs + nt * 32 * 136, 136, dir ? 8 : (ti + 1) * 2, lane, dir ? 8 - (ti + 1) * 2 : 0);
            f32x16 a2 = {}; a2 = mma32_ll(a2, Qs + (rb + (dir ? -ti * 32 : ti * 32)) * 72, rs, CTs + nt * 32 * 72, 72, 4, lane);
#pragma unroll
            for (int r = 0; r < 16; ++r) a1[r] += AIN[ti * 32 + crow(r, hi)] * a2[r];
            tot[k] = a1;
            if (nt == 2 && r32 == 0) {
#pragma unroll
                for (int r = 0; r < 16; ++r) DEN[ti * 32 + crow(r, hi)] = a1[r]; } } }
        LDS_BAR();
#pragma unroll
        for (int k = 0; k < 2; ++k) { const int q = wave + 8 * k; if (q < 12) { const int ti = q / 3, nt = q % 3; if (nt < 2) {
#pragma unroll
            for (int r = 0; r < 16; ++r) { const int t = ti * 32 + crow(r, hi); const float hv = tot[k][r] * frcp(fmaxf(fabsf(DEN[t]), EINV[t])); const int p = dir ? 127 - t : t;
                if (dir == 0) HS[p * 64 + nt * 32 + r32] = hv; else HS[p * 64 + nt * 32 + r32] += hv; } } } }
    }
    LDS_BAR();
    { const int c8 = (tid & 7) * 8; bf16_t* yc = (bf16_t*)(F.ws + WS_YC);
      const f32x4 hg0 = *(const f32x4*)(F.in[I_MLHG] + l * 256 + h * 64 + c8), hg1 = *(const f32x4*)(F.in[I_MLHG] + l * 256 + h * 64 + c8 + 4);
#pragma unroll
      for (int half = 0; half < 2; ++half) { const int p = half * 64 + (tid >> 3); const u32x4 og = half ? og1 : og0;
        const f32x4 v0 = *(const LAS f32x4*)(HS + p * 64 + c8), v1 = *(const LAS f32x4*)(HS + p * 64 + c8 + 4);
        float ss = (v0.x * v0.x + v0.y * v0.y) + (v0.z * v0.z + v0.w * v0.w) + (v1.x * v1.x + v1.y * v1.y) + (v1.z * v1.z + v1.w * v1.w);
        ss += xor_lane<1>(ss); ss += xor_lane<2>(ss); ss += xor_lane<4>(ss);
        const float sc = frsq(ss * (1.f / 64.f) + EPS);
        const f32x4 y0 = v0 * sc * hg0 * (f32x4){sigmoidf_(bflo(og.x)), sigmoidf_(bfhi(og.x)), sigmoidf_(bflo(og.y)), sigmoidf_(bfhi(og.y))};
        const f32x4 y1 = v1 * sc * hg1 * (f32x4){sigmoidf_(bflo(og.z)), sigmoidf_(bfhi(og.z)), sigmoidf_(bflo(og.w)), sigmoidf_(bfhi(og.w))};
        *(u32x4*)(yc + (size_t)ml_row(b, isctx, p0 + p) * 1024 + h * 64 + c8) = (u32x4){pk2(y0.x, y0.y), pk2(y0.z, y0.w), pk2(y1.x, y1.y), pk2(y1.z, y1.w)}; } }
}

struct PoolRegs { u32x4 v[5]; };
__device__ __forceinline__ PoolRegs pool_load(const Frame& F, int unit) {
    PoolRegs R; const int row0 = unit * 64, tid = F.tid;
    const bool isctx = row0 >= NLAT; const int T = isctx ? 256 : 8192, t0 = isctx ? (row0 - NLAT) & 255 : row0 & 8191, rbase = row0 - t0;
    const bf16_t* px = (const bf16_t*)(F.ws + WS_PX);
#pragma unroll
    for (int q = 0; q < 5; ++q) { const int it = tid + q * NTHR, rr = it >> 5, c = it & 31, t = t0 - 8 + rr; R.v[q] = (u32x4){0u, 0u, 0u, 0u};
        if (t >= 0 && t < T) R.v[q] = *(const u32x4*)(px + (size_t)(rbase + t) * INC + C_POOL + c * 8); }
    return R;
}
__device__ __forceinline__ void pool_unit(const Frame& F, int l, int unit, const PoolRegs& R) {
    LAS float* U = (LAS float*)F.lds;
    LAS bf16_t* D = (LAS bf16_t*)(F.lds + 81920);
    const int row0 = unit * 64, tid = F.tid, lane = F.lane, wave = F.wave;
    const bool isctx = row0 >= NLAT; const int T = isctx ? 256 : 8192, t0 = isctx ? (row0 - NLAT) & 255 : row0 & 8191, rbase = row0 - t0;
    const bf16_t* px = (const bf16_t*)(F.ws + WS_PX);
    LDS_BAR();
    {
#pragma unroll
      for (int q = 0; q < 5; ++q) { const int it = tid + q * NTHR, rr = it >> 5, c = it & 31; LAS float* d = U + rr * 256 + c * 8; const u32x4 v = R.v[q];
          *(LAS f32x4*)d = (f32x4){bflo(v.x), bfhi(v.x), bflo(v.y), bfhi(v.y)}; *(LAS f32x4*)(d + 4) = (f32x4){bflo(v.z), bfhi(v.z), bflo(v.w), bfhi(v.w)}; } }
    LDS_BAR();
    { const int c = tid & 255, th = tid >> 8, g = c >> 6, hw = 1 << g, tt0 = th * 32;
      float sacc = 0.f;
      for (int u = tt0 - hw; u < tt0 + hw; ++u) sacc += U[(u + 8) * 256 + c];
#pragma unroll 4
      for (int k = 0; k < 32; ++k) { const int tt = tt0 + k, t = t0 + tt; const int lo = max(t - hw, 0), hi = min(t + hw, T);
          D[tt * 264 + c] = (bf16_t)f2bf(sacc * frcp((float)(hi - lo)) - U[(tt + 8) * 256 + c]);
          sacc += U[(tt + hw + 8) * 256 + c] - U[(tt - hw + 8) * 256 + c]; } }
    LDS_BAR();
    { const int g = wave >> 1, rt = wave & 1, r32 = lane & 31, hi = lane >> 5; bf16_t* yc = (bf16_t*)(F.ws + WS_YC); const float* ps = F.in[I_POOLS] + l * 256;
      for (int nt = 0; nt < 2; ++nt) { f32x16 acc = {}; acc = mma32_lg<4>(acc, D + rt * 32 * 264 + g * 64, 264, (const bf16_t*)(F.ws + W_POOL) + (size_t)(g * 64 + nt * 32) * 64, 64, lane);
          const int col = g * 64 + nt * 32 + r32; const float sc = ps[col];
#pragma unroll
          for (int r = 0; r < 16; ++r) yc[(size_t)(row0 + rt * 32 + crow(r, hi)) * 1024 + 512 + col] = (bf16_t)f2bf(acc[r] * sc); } }
}
__device__ __forceinline__ void conv_z(const bf16_t* p, float (&z)[8]) { const u32x4 u = *(const u32x4*)p, cc = *(const u32x4*)(p + 512);
    z[0] = bflo(u.x) * bflo(cc.x); z[1] = bfhi(u.x) * bfhi(cc.x); z[2] = bflo(u.y) * bflo(cc.y); z[3] = bfhi(u.y) * bfhi(cc.y);
    z[4] = bflo(u.z) * bflo(cc.z); z[5] = bfhi(u.z) * bfhi(cc.z); z[6] = bflo(u.w) * bflo(cc.w); z[7] = bfhi(u.w) * bfhi(cc.w); }
__device__ __forceinline__ void conv_all(const Frame& F, int l, int nrows) {
    const bf16_t* px = (const bf16_t*)(F.ws + WS_PX); bf16_t* yc = (bf16_t*)(F.ws + WS_YC);
    const int c = (F.tid & 31) * 8;
    float w0[8], w1[8], w2[8], cb[8];
#pragma unroll
    for (int e = 0; e < 8; ++e) { w0[e] = F.in[I_CONVW][l * 768 + c + e]; w1[e] = F.in[I_CONVW][l * 768 + 256 + c + e]; w2[e] = F.in[I_CONVW][l * 768 + 512 + c + e]; cb[e] = F.in[I_CONVB][l * 256 + c + e]; }
    for (int it = F.bx * NTHR + F.tid; it < (nrows / 16) * 32; it += F.G * NTHR) { const int row0 = (it >> 5) * 16;
        const bool isctx = row0 >= NLAT; const int T = isctx ? 256 : 8192, t0 = isctx ? (row0 - NLAT) & 255 : row0 & 8191;
        const bf16_t* p = px + (size_t)row0 * INC + C_CONV + c;
        float zp[8], zc[8], zn[8];
        if (t0 > 0) conv_z(p - INC, zp); else {
#pragma unroll
            for (int e = 0; e < 8; ++e) zp[e] = 0.f; }
        conv_z(p, zc);
#pragma unroll 4
        for (int r = 0; r < 16; ++r) { const bf16_t* pr = p + (size_t)r * INC;
            if (t0 + r + 1 < T) conv_z(pr + INC, zn); else {
#pragma unroll
                for (int e = 0; e < 8; ++e) zn[e] = 0.f; }
            const u32x4 bw = *(const u32x4*)(pr + 256); const float bx[8] = {bflo(bw.x), bfhi(bw.x), bflo(bw.y), bfhi(bw.y), bflo(bw.z), bfhi(bw.z), bflo(bw.w), bfhi(bw.w)};
            float y[8];
#pragma unroll
            for (int e = 0; e < 8; ++e) { y[e] = bx[e] * (cb[e] + w0[e] * zp[e] + w1[e] * zc[e] + w2[e] * zn[e]); zp[e] = zc[e]; zc[e] = zn[e]; }
            u32x4 o; o.x = pk2(y[0], y[1]); o.y = pk2(y[2], y[3]); o.z = pk2(y[4], y[5]); o.w = pk2(y[6], y[7]);
            *(u32x4*)(yc + (size_t)(row0 + r) * 1024 + 768 + c) = o; }
    }
}

namespace att {
constexpr int STAGE_B = 40960, KSUB = 12288, VOFF = 24576, VSUB = 8192, LDS_WS = 3 * STAGE_B, LDS_OST = LDS_WS + 2048;
constexpr float THR = 8.0f;
__device__ __forceinline__ void glds16(const void* gsrc, unsigned lds_dst) { unsigned keep;
    asm volatile("s_mov_b32 %0, m0\n\ts_mov_b32 m0, %2\n\ts_nop 0\n\tglobal_load_lds_dwordx4 %1, off\n\ts_mov_b32 m0, %0" : "=&s"(keep) : "v"(gsrc), "s"(lds_dst) : "memory"); }
#define ATT_WAIT_BAR(N) asm volatile("s_waitcnt vmcnt(" #N ") lgkmcnt(0)\n\ts_barrier" ::: "memory")
__device__ __forceinline__ void qkt(f32x16& p0, f32x16& p1, const LAS char* Kslot, const bf16x8* qr, int r32, int hi) {
    const LAS char* kb = Kslot + hi * 1024 + r32 * 16; p0 = f32x16{}; p1 = f32x16{};
#pragma unroll
    for (int d0 = 0; d0 < 6; ++d0) {
        const bf16x8 b0 = *(const LAS bf16x8*)(kb + d0 * 2048), b1 = *(const LAS bf16x8*)(kb + d0 * 2048 + 512);
        p0 = __builtin_amdgcn_mfma_f32_32x32x16_bf16(b0, qr[d0], p0, 0, 0, 0); p1 = __builtin_amdgcn_mfma_f32_32x32x16_bf16(b1, qr[d0], p1, 0, 0, 0); }
}
__device__ __forceinline__ float rowmax(const f32x16& p0, const f32x16& p1) {
    float a = fmaxf(p0[0], p1[0]);
#pragma unroll
    for (int r = 1; r < 16; ++r) a = fmaxf(a, fmaxf(p0[r], p1[r]));
    auto rr = __builtin_amdgcn_permlane32_swap(__float_as_uint(a), __float_as_uint(a), false, false);
    return fmaxf(__uint_as_float(rr[0]), __uint_as_float(rr[1]));
}
__device__ __forceinline__ void pv(f32x16* o, int vb, bf16x8 pa0, bf16x8 pa1, bf16x8 pa2, bf16x8 pa3) {
#pragma unroll
    for (int d0 = 0; d0 < 2; ++d0) { s16x4 lo[4], hi[4];
#pragma unroll
        for (int ks = 0; ks < 4; ++ks) {
            asm volatile("ds_read_b64_tr_b16 %0,%1 offset:%c2" : "=&v"(lo[ks]) : "v"(vb), "i"(d0 * 4096 + ks * 1024) : "memory");
            asm volatile("ds_read_b64_tr_b16 %0,%1 offset:%c2" : "=&v"(hi[ks]) : "v"(vb), "i"(d0 * 4096 + ks * 1024 + 512) : "memory"); }
        asm volatile("s_waitcnt lgkmcnt(0)" ::: "memory"); __builtin_amdgcn_sched_barrier(0);
#define ATT_PK(k) (bf16x8){lo[k][0], lo[k][1], lo[k][2], lo[k][3], hi[k][0], hi[k][1], hi[k][2], hi[k][3]}
        o[d0] = __builtin_amdgcn_mfma_f32_32x32x16_bf16(pa0, ATT_PK(0), o[d0], 0, 0, 0);
        o[d0] = __builtin_amdgcn_mfma_f32_32x32x16_bf16(pa1, ATT_PK(1), o[d0], 0, 0, 0);
        o[d0] = __builtin_amdgcn_mfma_f32_32x32x16_bf16(pa2, ATT_PK(2), o[d0], 0, 0, 0);
        o[d0] = __builtin_amdgcn_mfma_f32_32x32x16_bf16(pa3, ATT_PK(3), o[d0], 0, 0, 0);
#undef ATT_PK
    }
}
__device__ __forceinline__ void unit(const Frame& F, int bh, int qrow, int orow, int nst) {
    const int tid = F.tid, lane = F.lane, wid = F.wave, r32 = lane & 31, hi = lane >> 5, h = bh & 3;
    const unsigned lds0 = (unsigned)(uintptr_t)F.lds;
    const LAS char* ring = (const LAS char*)F.lds;
    LAS float* wsf = (LAS float*)(F.lds + LDS_WS) + wid * 64;
    const char* kg = (const char*)(F.ws + WS_KT) + (size_t)bh * NKT * 12288; const char* vg = (const char*)(F.ws + WS_VT) + (size_t)bh * NKT * 8192;
    const bf16_t* Qw = (const bf16_t*)(F.ws + WS_QB) + (size_t)(qrow + wid * 32) * 384 + h * 96;
#define ATT_DMA(t, slot) do { const char* ks_ = kg + (size_t)(t) * 24576 + wid * 1024 + lane * 16; const char* vs_ = vg + (size_t)(t) * 16384 + wid * 1024 + lane * 16; \
        const unsigned kd_ = lds0 + (slot) * STAGE_B + wid * 1024, vd_ = kd_ + VOFF; \
        glds16(ks_, (unsigned)__builtin_amdgcn_readfirstlane(kd_)); glds16(ks_ + 8192, (unsigned)__builtin_amdgcn_readfirstlane(kd_ + 8192)); glds16(ks_ + 16384, (unsigned)__builtin_amdgcn_readfirstlane(kd_ + 16384)); \
        glds16(vs_, (unsigned)__builtin_amdgcn_readfirstlane(vd_)); glds16(vs_ + 8192, (unsigned)__builtin_amdgcn_readfirstlane(vd_ + 8192)); } while (0)
    ATT_DMA(0, 0); if (nst > 1) ATT_DMA(1, 1);
    bf16x8 qr[6];
#pragma unroll
    for (int d0 = 0; d0 < 6; ++d0) qr[d0] = *(const bf16x8*)(Qw + (size_t)r32 * 384 + d0 * 16 + hi * 8);
    float mhat = 0.f, l_reg = 0.f; f32x16 o[2]; o[0] = f32x16{}; o[1] = f32x16{};
    const int vb0 = (int)lds0 + VOFF + ((lane >> 4) & 1) * 32 + (lane & 3) * 8 + (4 * hi + ((lane & 15) >> 2)) * 64;
    int slot = 0; bool first = true;
    for (int t = 0; t < nst; ++t) {
        if (t + 1 < nst) ATT_WAIT_BAR(5); else ATT_WAIT_BAR(0);
        if (t + 2 < nst) { const int s2 = (slot == 0) ? 2 : slot - 1; ATT_DMA(t + 2, s2); }
#pragma unroll
        for (int s = 0; s < 2; ++s) {
            f32x16 p0, p1; qkt(p0, p1, ring + slot * STAGE_B + s * KSUB, qr, r32, hi);
            const float rm = rowmax(p0, p1);
            if (first) { mhat = rm; first = false; }
            else if (__any(rm - mhat > THR)) { const float dl = fmaxf(rm - mhat, 0.f); mhat += dl; const float f = __builtin_amdgcn_exp2f(-dl); l_reg *= f;
                if (hi == 0) wsf[r32] = f; LDS_WAIT();
#pragma unroll
                for (int r = 0; r < 16; ++r) { const float fr_ = wsf[crow(r, hi)]; o[0][r] *= fr_; o[1][r] *= fr_; } }
            float sacc = 0.f;
#pragma unroll
            for (int r = 0; r < 16; ++r) { p0[r] = __builtin_amdgcn_exp2f(p0[r] - mhat); p1[r] = __builtin_amdgcn_exp2f(p1[r] - mhat); sacc += p0[r] + p1[r]; }
            l_reg += sacc;
            u32x4 pw0, pw1, pw2, pw3;
            pw0 = (u32x4){cvt_pk_bf16(p0[0], p0[1]), cvt_pk_bf16(p0[2], p0[3]), cvt_pk_bf16(p0[4], p0[5]), cvt_pk_bf16(p0[6], p0[7])};
            pw1 = (u32x4){cvt_pk_bf16(p0[8], p0[9]), cvt_pk_bf16(p0[10], p0[11]), cvt_pk_bf16(p0[12], p0[13]), cvt_pk_bf16(p0[14], p0[15])};
            pw2 = (u32x4){cvt_pk_bf16(p1[0], p1[1]), cvt_pk_bf16(p1[2], p1[3]), cvt_pk_bf16(p1[4], p1[5]), cvt_pk_bf16(p1[6], p1[7])};
            pw3 = (u32x4){cvt_pk_bf16(p1[8], p1[9]), cvt_pk_bf16(p1[10], p1[11]), cvt_pk_bf16(p1[12], p1[13]), cvt_pk_bf16(p1[14], p1[15])};
            __builtin_amdgcn_sched_barrier(0);
            pv(o, vb0 + slot * STAGE_B + s * VSUB, __builtin_bit_cast(bf16x8, pw0), __builtin_bit_cast(bf16x8, pw1), __builtin_bit_cast(bf16x8, pw2), __builtin_bit_cast(bf16x8, pw3));
        }
        slot = (slot == 2) ? 0 : slot + 1;
    }
    { auto rr = __builtin_amdgcn_permlane32_swap(__float_as_uint(l_reg), __float_as_uint(l_reg), false, false); l_reg = __uint_as_float(rr[0]) + __uint_as_float(rr[1]); }
    if (hi == 0) wsf[32 + r32] = l_reg; LDS_WAIT();
    float rli[16];
#pragma unroll
    for (int r = 0; r < 16; ++r) rli[r] = frcp(wsf[32 + crow(r, hi)]);
    LAS bf16_t* stg = (LAS bf16_t*)(F.lds + LDS_OST) + wid * 2048;
#pragma unroll
    for (int r = 0; r < 16; ++r) { const int orow_ = crow(r, hi);
#pragma unroll
        for (int d0 = 0; d0 < 2; ++d0) stg[orow_ * 64 + d0 * 32 + r32] = (bf16_t)f2bf(o[d0][r] * rli[r]); }
    LDS_WAIT();
    bf16_t* Ow = (bf16_t*)(F.ws + WS_YC) + (size_t)(orow + wid * 32) * 1024 + 256 + h * 64;
#pragma unroll
    for (int i = 0; i < 4; ++i) { const int row = i * 8 + (lane >> 3), ch = lane & 7; const u32x4 v = *(const LAS u32x4*)(stg + row * 64 + ch * 8); *(u32x4*)(Ow + (size_t)row * 1024 + ch * 8) = v; }
    asm volatile("s_waitcnt lgkmcnt(0)\n\ts_barrier" ::: "memory");
#undef ATT_DMA
}
}

namespace att2 {
constexpr int KSL = 12288, VSL = 8192, LDS_K = 0, LDS_V = 3 * KSL, LDS_WS = LDS_V + 3 * VSL, LDS_OST = LDS_WS + 2048;
#define A2_SBAR() __builtin_amdgcn_sched_barrier(0)
#define A2_WAIT_BAR(N) asm volatile("s_waitcnt vmcnt(" #N ") lgkmcnt(0)\n\ts_barrier" ::: "memory")
__device__ __forceinline__ void glds16s(const void* sbase, unsigned voff, unsigned lds_dst) { unsigned keep;
    asm volatile("s_mov_b32 %0, m0\n\ts_mov_b32 m0, %3\n\ts_nop 4\n\tglobal_load_lds_dwordx4 %1, %2\n\ts_mov_b32 m0, %0" : "=&s"(keep) : "v"(voff), "s"(sbase), "s"(lds_dst) : "memory"); }
__device__ __forceinline__ unsigned cvtpk_s(float lo, float hi) { typedef float f2 __attribute__((ext_vector_type(2))); typedef __bf16 b2 __attribute__((ext_vector_type(2))); f2 v = {lo, hi}; b2 b = __builtin_convertvector(v, b2); return __builtin_bit_cast(unsigned, b); }
typedef short v4i16_t __attribute__((ext_vector_type(4)));
__device__ __forceinline__ s16x4 vtr(const LAS char* p) { return __builtin_bit_cast(s16x4, __builtin_amdgcn_ds_read_tr16_b64_v4i16((LAS v4i16_t*)p)); }
typedef int v8i_t __attribute__((ext_vector_type(8)));
__device__ __forceinline__ v8i_t cat8(u32x4 a, u32x4 b) { return (v8i_t){(int)a.x, (int)a.y, (int)a.z, (int)a.w, (int)b.x, (int)b.y, (int)b.z, (int)b.w}; }
__device__ __forceinline__ v8i_t kfrag8(const LAS char* kp, int i, int hi) { const LAS char* p = kp + ((i & 1) ? 4096 : hi * 2048) + (i >> 1) * 512; return cat8(*(const LAS u32x4*)p, *(const LAS u32x4*)(p + 1024)); }

template <bool NOMAX> __device__ __forceinline__ void unit(const Frame& F, int bh, int qrow, int orow, int NT) {
    const int lane = F.lane, wid = F.wave, r32 = lane & 31, hi = lane >> 5, h = bh & 3;
    const unsigned lds0 = (unsigned)(uintptr_t)F.lds;
    const LAS char* shm3 = (const LAS char*)F.lds;
    LAS float* wsf = (LAS float*)(F.lds + LDS_WS) + wid * 64;
    const char* kg = (const char*)(F.ws + WS_KT) + (size_t)bh * NKT * 6144; const char* vg = (const char*)(F.ws + WS_VT) + (size_t)bh * NKT * 8192 + wid * 1024; const unsigned l16 = lane * 16;
    const unsigned char* Qw = (const unsigned char*)(F.ws + WS_QB) + (size_t)(qrow + wid * 32) * 384 + h * 96;
    const int kp2 = wid < 6 ? wid : wid - 2;
#define A2_DMA_K(t, sl) do { const char* s_ = kg + (size_t)(t) * 6144; const unsigned d_ = lds0 + LDS_K + (sl) * KSL; \
        glds16s(s_ + kp2 * 1024, l16, (unsigned)__builtin_amdgcn_readfirstlane(d_ + kp2 * 1024)); } while (0)
#define A2_MFQ(ki, qi, CI) __builtin_amdgcn_mfma_scale_f32_32x32x64_f8f6f4(kf[ki], qf[qi], CI, 0, 0, 0, 0x7c7c7c7c, 0, 0x7f7f7f7f)
#define A2_DMA_V(t, sl) glds16s(vg + (size_t)(t) * 8192, l16, (unsigned)__builtin_amdgcn_readfirstlane(lds0 + LDS_V + (sl) * VSL + wid * 1024))
    const LAS char* kp0 = shm3 + LDS_K + r32 * 16;
    const LAS char* vp0 = shm3 + LDS_V + ((lane >> 4) & 1) * 32 + (lane & 3) * 8 + (4 * hi + ((lane & 15) >> 2)) * 64;
    v8i_t kf[4];
    A2_DMA_K(0, 0); A2_DMA_V(0, 0); A2_DMA_K(1, 1);
    v8i_t qf[2];
    { const unsigned char* qp = Qw + (size_t)r32 * 384; const u32x4 z4 = {0u, 0u, 0u, 0u};
      qf[0] = cat8(*(const u32x4*)(qp + hi * 32), *(const u32x4*)(qp + hi * 32 + 16));
      const u32x4 c0 = *(const u32x4*)(qp + 64), c1 = *(const u32x4*)(qp + 80); qf[1] = cat8(hi ? z4 : c0, hi ? z4 : c1); }
    float mhat = 0.f, l_reg = 0.f; f32x16 o[2]; o[0] = f32x16{}; o[1] = f32x16{};
    bool resc = false;
    f32x16 pA0, pA1, pB0, pB1;
    int sl_prev = 0, sl_cur = 0, sl_next = 1;
#define A2_ROT() do { sl_prev = sl_cur; sl_cur = sl_next; sl_next = (sl_next == 2) ? 0 : sl_next + 1; } while (0)
#define A2_RESC() do { if (!NOMAX && resc) { asm volatile("s_waitcnt lgkmcnt(0)" ::: "memory"); \
        _Pragma("unroll") for (int d_ = 0; d_ < 2; ++d_) _Pragma("unroll") for (int r = 0; r < 16; ++r) o[d_][r] *= wsf[crow(r, hi)]; } } while (0)
    A2_DMA_K(2, 2);
    A2_WAIT_BAR(5);
    {
#pragma unroll
      for (int i = 0; i < 4; ++i) kf[i] = kfrag8(kp0, i, hi);
      pA0 = A2_MFQ(0, 0, (f32x16{})); pA0 = A2_MFQ(1, 1, pA0); pA1 = A2_MFQ(2, 0, (f32x16{})); pA1 = A2_MFQ(3, 1, pA1);
      if constexpr (!NOMAX) { float a = fmaxf(pA0[0], pA1[0]);
#pragma unroll
      for (int r = 1; r < 16; ++r) a = fmaxf(a, fmaxf(pA0[r], pA1[r]));
      { auto rr = __builtin_amdgcn_permlane32_swap(__float_as_uint(a), __float_as_uint(a), false, false); a = fmaxf(__uint_as_float(rr[0]), __uint_as_float(rr[1])); }
      mhat = a; }
#pragma unroll
      for (int r = 0; r < 16; ++r) { pA0[r] = __builtin_amdgcn_exp2f(pA0[r] - mhat); pA1[r] = __builtin_amdgcn_exp2f(pA1[r] - mhat); } }
    A2_WAIT_BAR(0);
    A2_DMA_K(3, 0); A2_DMA_V(1, 1);
    A2_ROT();
    { const LAS char* kp = kp0 + sl_cur * KSL;
#pragma unroll
      for (int i = 0; i < 4; ++i) kf[i] = kfrag8(kp, i, hi); }
    A2_WAIT_BAR(2);
    s16x4 vlo[8], vhi[8]; u32x4 pw0, pw1, pw2, pw3;
#define A2_PKW(P, B) cvtpk_s(P[B], P[B + 1])
#define A2_PAF(k) __builtin_bit_cast(bf16x8, pw##k)
#define A2_VFR(i) (bf16x8){vlo[i][0], vlo[i][1], vlo[i][2], vlo[i][3], vhi[i][0], vhi[i][1], vhi[i][2], vhi[i][3]}
#define A2_PIN(x) asm volatile("" : "+v"(x))
#define A2_MX3(a, b, c) __builtin_fmaxf(__builtin_fmaxf((a), (b)), (c))
#define A2_GAPA(MF, A0, A1, A2, A3, W0, W1, PW) do { MF; sacc += A0; sacc += A1; sacc += A2; sacc += A3; A2_PIN(sacc); W0; W1; A2_PIN(PW); A2_SBAR(); } while (0)
#define A2_GAPM(MF) do { MF; A2_SBAR(); } while (0)
#define A2_EX(v) __builtin_amdgcn_exp2f(v)
#define A2_SH(v) (NOMAX ? (v) : (v) - mhat)
#define A2_GAPB(MF, X, B) do { MF; X[B] = A2_EX(A2_SH(X[B])); X[B + 1] = A2_EX(A2_SH(X[B + 1])); X[B + 2] = A2_EX(A2_SH(X[B + 2])); X[B + 3] = A2_EX(A2_SH(X[B + 3])); A2_PIN(X); A2_SBAR(); } while (0)
#define A2_VRD(i) do { vlo[i] = vtr(vp_ + (((i) >> 2) * 4096 + ((i) & 3) * 1024)); vhi[i] = vtr(vp_ + (((i) >> 2) * 4096 + ((i) & 3) * 1024 + 512)); } while (0)
#define A2_KRD(G, j) do { if (G) { if ((j) < 4) kf[(j) < 4 ? (j) : 0] = kfrag8(kp0 + sl_next * KSL, (j) < 4 ? (j) : 0, hi); A2_SBAR(); } } while (0)
#define A2_MF(C, kk, qq, CI) C = A2_MFQ(kk, qq, CI)
#define A2_NOP ((void)0)
#define A2_STEP(C0, C1, P0, P1, t, GK, GV, GL) do { A2_SBAR(); \
    const LAS char* vp_ = vp0 + sl_prev * VSL; \
    A2_VRD(0); A2_SBAR(); float sacc = (P0[0] + P0[1]); \
    A2_GAPA(A2_MF(C0, 0, 0, (f32x16{})), P0[2], P0[3], P0[4], P0[5],     pw0[0] = A2_PKW(P0, 0), pw0[1] = A2_PKW(P0, 2), pw0); \
    A2_VRD(4); A2_SBAR(); A2_GAPA(A2_NOP, P0[6], P0[7], P0[8], P0[9],     pw0[2] = A2_PKW(P0, 4), pw0[3] = A2_PKW(P0, 6), pw0); \
    A2_VRD(1); A2_SBAR(); A2_GAPA(A2_MF(C1, 2, 0, (f32x16{})), P0[10], P0[11], P0[12], P0[13], pw1[0] = A2_PKW(P0, 8), pw1[1] = A2_PKW(P0, 10), pw1); \
    A2_VRD(5); A2_SBAR(); A2_GAPA(A2_NOP,   P0[14], P0[15], P1[0], P1[1],   pw1[2] = A2_PKW(P0, 12), pw1[3] = A2_PKW(P0, 14), pw1); \
    A2_VRD(2); A2_SBAR(); A2_GAPA(A2_MF(C0, 1, 1, C0),   P1[2], P1[3], P1[4], P1[5],     pw2[0] = A2_PKW(P1, 0), pw2[1] = A2_PKW(P1, 2), pw2); \
    A2_VRD(6); A2_SBAR(); A2_GAPA(A2_NOP,   P1[6], P1[7], P1[8], P1[9],     pw2[2] = A2_PKW(P1, 4), pw2[3] = A2_PKW(P1, 6), pw2); \
    A2_VRD(3); A2_SBAR(); A2_GAPA(A2_MF(C1, 3, 1, C1),   P1[10], P1[11], P1[12], P1[13], pw3[0] = A2_PKW(P1, 8), pw3[1] = A2_PKW(P1, 10), pw3); \
    A2_VRD(7); A2_SBAR(); A2_GAPA(A2_NOP,   P1[14], P1[15], 0.f, 0.f,       pw3[2] = A2_PKW(P1, 12), pw3[3] = A2_PKW(P1, 14), pw3); \
    l_reg += sacc; \
    if (GK) { A2_DMA_K((t) + 3, sl_cur); } if (GV) { A2_DMA_V((t) + 1, sl_next); } \
    if constexpr (!NOMAX) { float a = A2_MX3(C0[0], C0[1], C1[0]), b = A2_MX3(C0[2], C0[3], C1[1]); a = A2_MX3(a, C1[2], C1[3]); \
      _Pragma("unroll") for (int r = 4; r < 16; r += 4) { a = A2_MX3(a, C0[r], C0[r + 1]); b = A2_MX3(b, C0[r + 2], C0[r + 3]); a = A2_MX3(a, C1[r], C1[r + 1]); b = A2_MX3(b, C1[r + 2], C1[r + 3]); } \
      float rm = __builtin_fmaxf(a, b); { auto rr = __builtin_amdgcn_permlane32_swap(__float_as_uint(rm), __float_as_uint(rm), false, false); rm = __builtin_fmaxf(__uint_as_float(rr[0]), __uint_as_float(rr[1])); } \
      resc = false; \
      if (__builtin_expect(__any(rm - mhat > 8.0f), 0)) { const float dl = __builtin_fmaxf(rm - mhat, 0.f); mhat += dl; \
        const float f = __builtin_amdgcn_exp2f(-dl); l_reg *= f; if (hi == 0) wsf[r32] = f; resc = true; } } \
    A2_SBAR(); \
    A2_GAPB(o[0] = __builtin_amdgcn_mfma_f32_32x32x16_bf16(A2_PAF(0), A2_VFR(0), o[0], 0, 0, 0), C0, 0); \
    A2_KRD(GL, 0); A2_GAPB(o[1] = __builtin_amdgcn_mfma_f32_32x32x16_bf16(A2_PAF(0), A2_VFR(4), o[1], 0, 0, 0), C0, 4); \
    A2_KRD(GL, 1); A2_GAPB(o[0] = __builtin_amdgcn_mfma_f32_32x32x16_bf16(A2_PAF(1), A2_VFR(1), o[0], 0, 0, 0), C0, 8); \
    A2_KRD(GL, 2); A2_GAPB(o[1] = __builtin_amdgcn_mfma_f32_32x32x16_bf16(A2_PAF(1), A2_VFR(5), o[1], 0, 0, 0), C0, 12); \
    A2_KRD(GL, 3); A2_GAPB(o[0] = __builtin_amdgcn_mfma_f32_32x32x16_bf16(A2_PAF(2), A2_VFR(2), o[0], 0, 0, 0), C1, 0); \
    A2_KRD(GL, 4); A2_GAPB(o[1] = __builtin_amdgcn_mfma_f32_32x32x16_bf16(A2_PAF(2), A2_VFR(6), o[1], 0, 0, 0), C1, 4); \
    A2_KRD(GL, 5); A2_GAPB(o[0] = __builtin_amdgcn_mfma_f32_32x32x16_bf16(A2_PAF(3), A2_VFR(3), o[0], 0, 0, 0), C1, 8); \
    A2_GAPB(o[1] = __builtin_amdgcn_mfma_f32_32x32x16_bf16(A2_PAF(3), A2_VFR(7), o[1], 0, 0, 0), C1, 12); \
    } while (0)
    int t = 1;
    for (; t + 5 < NT; t += 2) {
        A2_STEP(pB0, pB1, pA0, pA1, t, true, true, true);     A2_WAIT_BAR(2); A2_RESC(); A2_ROT();
        A2_STEP(pA0, pA1, pB0, pB1, t + 1, true, true, true); A2_WAIT_BAR(2); A2_RESC(); A2_ROT();
    }
#define A2_ENDW(tt) do { if ((tt) + 3 < NT) { A2_WAIT_BAR(2); } else if ((tt) + 2 < NT) { A2_WAIT_BAR(1); } else { A2_WAIT_BAR(0); } } while (0)
    for (; t + 1 < NT; t += 2) {
        A2_STEP(pB0, pB1, pA0, pA1, t, (t + 3 < NT), (t + 1 < NT), (t + 1 < NT));     A2_ENDW(t);     A2_RESC(); A2_ROT();
        A2_STEP(pA0, pA1, pB0, pB1, t + 1, (t + 4 < NT), (t + 2 < NT), (t + 2 < NT)); A2_ENDW(t + 1); A2_RESC(); A2_ROT();
    }
    A2_STEP(pB0, pB1, pA0, pA1, NT - 1, false, false, false); A2_RESC();
    { float sacc = pB0[0] + pB0[1];
#pragma unroll
      for (int r = 2; r < 16; ++r) sacc += pB0[r];
#pragma unroll
      for (int r = 0; r < 16; ++r) sacc += pB1[r];
      l_reg += sacc;
      pw0 = (u32x4){A2_PKW(pB0, 0), A2_PKW(pB0, 2), A2_PKW(pB0, 4), A2_PKW(pB0, 6)}; pw1 = (u32x4){A2_PKW(pB0, 8), A2_PKW(pB0, 10), A2_PKW(pB0, 12), A2_PKW(pB0, 14)};
      pw2 = (u32x4){A2_PKW(pB1, 0), A2_PKW(pB1, 2), A2_PKW(pB1, 4), A2_PKW(pB1, 6)}; pw3 = (u32x4){A2_PKW(pB1, 8), A2_PKW(pB1, 10), A2_PKW(pB1, 12), A2_PKW(pB1, 14)};
      A2_SBAR();
      const int vb = (int)lds0 + LDS_V + ((lane >> 4) & 1) * 32 + (lane & 3) * 8 + (4 * hi + ((lane & 15) >> 2)) * 64 + sl_cur * VSL;
      att::pv(o, vb, A2_PAF(0), A2_PAF(1), A2_PAF(2), A2_PAF(3)); }
    { auto rr = __builtin_amdgcn_permlane32_swap(__float_as_uint(l_reg), __float_as_uint(l_reg), false, false); l_reg = __uint_as_float(rr[0]) + __uint_as_float(rr[1]); }
    if (hi == 0) wsf[32 + r32] = l_reg; LDS_WAIT();
    float rli[16];
#pragma unroll
    for (int r = 0; r < 16; ++r) rli[r] = __builtin_amdgcn_rcpf(wsf[32 + crow(r, hi)]);
    LAS bf16_t* stg = (LAS bf16_t*)(F.lds + LDS_OST) + wid * 2048;
#pragma unroll
    for (int r = 0; r < 16; ++r) { const int orow_ = crow(r, hi);
#pragma unroll
        for (int d0 = 0; d0 < 2; ++d0) stg[orow_ * 64 + d0 * 32 + r32] = (bf16_t)f2bf(o[d0][r] * rli[r]); }
    LDS_WAIT();
    bf16_t* Ow = (bf16_t*)(F.ws + WS_YC) + (size_t)(orow + wid * 32) * 1024 + 256 + h * 64;
#pragma unroll
    for (int i = 0; i < 4; ++i) { const int row = i * 8 + (lane >> 3), ch = lane & 7; const u32x4 v = *(const LAS u32x4*)(stg + row * 64 + ch * 8); *(u32x4*)(Ow + (size_t)row * 1024 + ch * 8) = v; }
    asm volatile("s_waitcnt lgkmcnt(0)\n\ts_barrier" ::: "memory");
}
}

__device__ __forceinline__ void ph_norm2_route(const Frame& F, int l, int ntok) {
    LAS bf16_t* A = (LAS bf16_t*)F.lds;
    LAS float* PART = (LAS float*)(F.lds + 66048);
    LAS float* LOG = (LAS float*)(F.lds + 131584);
    LAS int* HIST = (LAS int*)(F.lds + 139776);
    const int tid = F.tid, lane = F.lane, wave = F.wave, r32 = lane & 31, hi = lane >> 5;
    const int tpb = ntok / F.G, tok0 = F.bx * tpb;
    int* eidx = (int*)(F.ws + T_EIDX); float* ew = (float*)(F.ws + T_EW);
    const float* brt = F.in[I_BRT] + l * 64;
    if (tid < 64) HIST[tid] = 0;
    LAS f32x4* AV = (LAS f32x4*)(F.lds + 140288);
    LAS f32x4* SHV = AV + 512;
    const int mr_first = mod_row_of(tok0), mr_last = mod_row_of(tok0 + tpb - 1);
    { const int set = tid >> 8, idx = tid & 255, mrs = set ? mr_last : mr_first;
      const f32x4 gv = ((const f32x4*)(F.in[I_GFFN] + l * 1024))[idx], scv = ((const f32x4*)modp(F, l, mrs, 4))[idx];
      AV[tid] = gv * (scv + 1.0f); SHV[tid] = ((const f32x4*)modp(F, l, mrs, 3))[idx]; }
    bf16x8 wrt[2][8];
#pragma unroll
    for (int nt = 0; nt < 2; ++nt)
#pragma unroll
        for (int ks = 0; ks < 8; ++ks) wrt[nt][ks] = *(const bf16x8*)((const bf16_t*)(F.ws + W_RT) + (size_t)(nt * 32 + r32) * 1024 + wave * 128 + ks * 16 + hi * 8);
    f32x4 xn[4][4]; u32x2 mn[4][4];
#pragma unroll
    for (int rr = 0; rr < 4; ++rr) { const int t = min(wave * 4 + rr, tpb - 1); const f32x4* xr = (const f32x4*)stream_row(F, l, tok0 + t) + lane; const u32x2* mg = (const u32x2*)((const bf16_t*)(F.ws + WS_YC) + (size_t)(tok0 + t) * 1024) + lane;
#pragma unroll
        for (int j = 0; j < 4; ++j) { xn[rr][j] = xr[64 * j]; mn[rr][j] = mg[64 * j]; } }
    for (int b0 = 0; b0 < tpb; b0 += 32) {
        __syncthreads();
        { f32x4 v[4][4];
#pragma unroll
          for (int rr = 0; rr < 4; ++rr) {
#pragma unroll
                for (int j = 0; j < 4; ++j) { const u32x2 w = mn[rr][j]; v[rr][j] = xn[rr][j] + (f32x4){bflo(w.x), bfhi(w.x), bflo(w.y), bfhi(w.y)}; } }
#pragma unroll
          for (int rr = 0; rr < 4; ++rr) { const int r = wave * 4 + rr, t = b0 + r; LAS u32x2* a = (LAS u32x2*)(A + r * 1032) + lane;
            if (t < tpb) { const int row = tok0 + t, mr = mod_row_of(row); f32x4 y[4];
                f32x4* xo = (f32x4*)((row < NLAT) ? F.out + (size_t)row * 1024 : (float*)(F.ws + WS_CTXS) + (size_t)(row - NLAT) * 1024) + lane;
#pragma unroll
                for (int j = 0; j < 4; ++j) xo[64 * j] = v[rr][j];
                { float s2 = 0.f;
#pragma unroll
                  for (int j = 0; j < 4; ++j) s2 += (v[rr][j].x * v[rr][j].x + v[rr][j].y * v[rr][j].y) + (v[rr][j].z * v[rr][j].z + v[rr][j].w * v[rr][j].w);
                  const float rstd = frsq(wave_sum(s2) * (1.f / 1024.f) + EPS); const int vb = (mr == mr_first ? 0 : 256) + lane;
#pragma unroll
                  for (int j = 0; j < 4; ++j) y[j] = v[rr][j] * rstd * AV[vb + 64 * j] + SHV[vb + 64 * j]; }
                unsigned* o8 = (unsigned*)(F.ws + WS_HX8 + (size_t)row * 1024) + lane;
#pragma unroll
                for (int j = 0; j < 4; ++j) { a[64 * j] = (u32x2){pk2(y[j].x, y[j].y), pk2(y[j].z, y[j].w)}; o8[64 * j] = pk4_fp8(y[j].x, y[j].y, y[j].z, y[j].w); }
            } else {
#pragma unroll
                for (int j = 0; j < 4; ++j) a[64 * j] = (u32x2){0u, 0u}; } } }
        if (b0 + 32 < tpb) {
#pragma unroll
            for (int rr = 0; rr < 4; ++rr) { const int t = min(b0 + 32 + wave * 4 + rr, tpb - 1); const f32x4* xr = (const f32x4*)stream_row(F, l, tok0 + t) + lane; const u32x2* mg = (const u32x2*)((const bf16_t*)(F.ws + WS_YC) + (size_t)(tok0 + t) * 1024) + lane;
#pragma unroll
                for (int j = 0; j < 4; ++j) { xn[rr][j] = xr[64 * j]; mn[rr][j] = mg[64 * j]; } } }
        __syncthreads();
#pragma unroll
        for (int nt = 0; nt < 2; ++nt) { f32x16 acc = {};
#pragma unroll
            for (int ks = 0; ks < 8; ++ks) { const bf16x8 a = *(const LAS bf16x8*)(A + wave * 128 + r32 * 1032 + ks * 16 + hi * 8); acc = __builtin_amdgcn_mfma_f32_32x32x16_bf16(a, wrt[nt][ks], acc, 0, 0, 0); }
#pragma unroll
            for (int r = 0; r < 16; ++r) PART[(wave * 32 + crow(r, hi)) * 64 + nt * 32 + r32] = acc[r]; }
        __syncthreads();
        for (int i = tid; i < 2048; i += NTHR) { float s = 0.f;
#pragma unroll
            for (int w = 0; w < 8; ++w) s += PART[w * 2048 + i];
            LOG[i] = s; }
        __syncthreads();
        for (int rr = 0; rr < 4; ++rr) { const int r = wave * 4 + rr, t = b0 + r; if (t >= tpb) continue;
            const float sc = sigmoidf_(LOG[r * 64 + lane]); float v = sc + brt[lane]; float ssel = 0.f, mys = 0.f; int myi = 0;
#pragma unroll
            for (int k = 0; k < TOPK; ++k) { const float mx = wave_max(v); const unsigned long long bal = __ballot(v == mx); const int win = __ffsll((long long)bal) - 1;
                const float sw = lane_bcast(sc, win); ssel += sw; if (lane == k) { mys = sw; myi = win; } if (lane == win) v = -INFINITY; }
            if (lane < TOPK) { eidx[(size_t)(tok0 + t) * 6 + lane] = myi; ew[(size_t)(tok0 + t) * 6 + lane] = mys * frcp(ssel) * 2.5f; __hip_atomic_fetch_add(&HIST[myi], 1, __ATOMIC_RELAXED, __HIP_MEMORY_SCOPE_WORKGROUP); } }
    }
    __syncthreads();
    if (tid < 64) ((int*)(F.ws + T_HIST))[F.bx * 64 + tid] = HIST[tid];
}

__device__ __forceinline__ void ph_assign(const Frame& F, int ntok) {
    LAS int* BASE = (LAS int*)F.lds; LAS int* CUR = BASE + 64; LAS int* START = BASE + 128; LAS int* TOT = BASE + 192; LAS int* MISC = BASE + 256;
    const int tid = F.tid, hb = F.G, c = 0, tpb = ntok / F.G, ctok0 = 0, ctoks = ntok;
    const int* hist = (const int*)(F.ws + T_HIST); int* rtok = (int*)(F.ws + T_RTOK); float* rw = (float*)(F.ws + T_RW); int* slot = (int*)(F.ws + T_SLOT);
    int* tile_e = (int*)(F.ws + T_TILEE);
    __syncthreads();
    { LAS int* PT = BASE + 512; LAS int* PB = PT + 512;
      const int e = tid & 63, part = tid >> 6; int tot = 0, bef = 0;
#pragma unroll 8
      for (int k = 0; k < 32; ++k) { const int b = c * hb + part * 32 + k; if (b < (c + 1) * hb) { const int v = hist[b * 64 + e]; tot += v; if (b < F.bx) bef += v; } }
      PT[part * 64 + e] = tot; PB[part * 64 + e] = bef; }
    __syncthreads();
    if (tid < 64) { int tot = 0, bef = 0; for (int p8 = 0; p8 < 8; ++p8) { tot += BASE[512 + p8 * 64 + tid]; bef += BASE[1024 + p8 * 64 + tid]; } TOT[tid] = tot; BASE[tid] = bef; CUR[tid] = 0; }
    __syncthreads();
    if (tid == 0) { int s = 0; for (int e = 0; e < 64; ++e) { START[e] = s; s += (TOT[e] + 255) / 256 * 256; } MISC[0] = s; }
    __syncthreads();
    const int sstart = MISC[0];
    const int* eidx = (const int*)(F.ws + T_EIDX); const float* ew = (const float*)(F.ws + T_EW);
    for (int i = tid; i < tpb * 6; i += NTHR) { const int tok = F.bx * tpb + i / 6, k = i % 6; const int e = eidx[(size_t)tok * 6 + k];
        const int pos = START[e] + BASE[e] + __hip_atomic_fetch_add(&CUR[e], 1, __ATOMIC_RELAXED, __HIP_MEMORY_SCOPE_WORKGROUP); rtok[pos] = tok; rw[pos] = ew[(size_t)tok * 6 + k]; slot[(size_t)tok * 8 + k] = pos; }
    for (int i = tid; i < tpb; i += NTHR) { const int tok = F.bx * tpb + i, pos = sstart + (tok - ctok0); rtok[pos] = tok; rw[pos] = 1.0f; slot[(size_t)tok * 8 + 6] = pos; }
    if (F.bx == c * hb) {
        for (int e = 0; e < 64; ++e) { const int p0 = START[e] + TOT[e], p1 = START[e] + (TOT[e] + 255) / 256 * 256;
            for (int p = p0 + tid; p < p1; p += NTHR) { rtok[p] = ctok0; rw[p] = 0.f; }
            for (int tl = START[e] / 256 + tid; tl < p1 / 256; tl += NTHR) tile_e[tl] = e; }
        for (int tl = sstart / 256 + tid; tl < (sstart + ctoks) / 256; tl += NTHR) tile_e[tl] = 64;
        if (tid == 0) tile_e[2047] = (sstart + ctoks) / 256;
    }
}

template <bool FUSE_NORM> __device__ __forceinline__ void ph_combine(const Frame& F, int l, int c, int ntok) {
    const int lane = F.lane; const int tpb = ntok / F.G, tok0 = F.bx * tpb; (void)c;
    const int* slot = (const int*)(F.ws + T_SLOT); const unsigned char* ys = (const unsigned char*)(F.ws + WS_YS);
    int mr_cur = -1; f32x4 gtv[2][2], av[2][2], shv[2][2];
    for (int t = F.wave; t < tpb; t += NWAVES) { const int tok = tok0 + t, mr = mod_row_of(tok);
        if (mr != mr_cur) { mr_cur = mr; const float* gt = modp(F, l, mr, 5);
#pragma unroll
            for (int j = 0; j < 2; ++j)
#pragma unroll
                for (int h2 = 0; h2 < 2; ++h2) { const int c0 = 8 * lane + 512 * j + 4 * h2; gtv[j][h2] = *(const f32x4*)(gt + c0);
                    if constexpr (FUSE_NORM) { const f32x4 gv = *(const f32x4*)(F.in[I_GMIX] + 1024 + c0), scv = *(const f32x4*)(modp(F, 1, mr, 1) + c0); av[j][h2] = gv * (scv + 1.0f); shv[j][h2] = *(const f32x4*)(modp(F, 1, mr, 0) + c0); } } }
        float* xr = (tok < NLAT) ? F.out + (size_t)tok * 1024 : (float*)(F.ws + WS_CTXS) + (size_t)(tok - NLAT) * 1024;
        const int sv = slot[(size_t)tok * 8 + (lane & 7)];
        u32x2 y[7][2];
#pragma unroll
        for (int k = 0; k < 7; ++k) { const int sk = __builtin_amdgcn_readlane(sv, k); const u32x2* yr = (const u32x2*)(ys + (size_t)sk * 1024) + lane; y[k][0] = yr[0]; y[k][1] = yr[64]; }
        f32x4 xv[2][2];
#pragma unroll
        for (int j = 0; j < 2; ++j) { xv[j][0] = *(const f32x4*)(xr + 8 * lane + 512 * j); xv[j][1] = *(const f32x4*)(xr + 8 * lane + 512 * j + 4); }
#pragma unroll
        for (int j = 0; j < 2; ++j) { f32x4 a0 = {0.f, 0.f, 0.f, 0.f}, a1 = {0.f, 0.f, 0.f, 0.f};
#pragma unroll
            for (int k = 0; k < 7; ++k) { a0 += up4_fp8(y[k][j].x); a1 += up4_fp8(y[k][j].y); }
            xv[j][0] = xv[j][0] + gtv[j][0] * a0; xv[j][1] = xv[j][1] + gtv[j][1] * a1;
            *(f32x4*)(xr + 8 * lane + 512 * j) = xv[j][0]; *(f32x4*)(xr + 8 * lane + 512 * j + 4) = xv[j][1]; }
        if constexpr (FUSE_NORM) {
            float ss = 0.f;
#pragma unroll
            for (int j = 0; j < 2; ++j)
#pragma unroll
                for (int h2 = 0; h2 < 2; ++h2) { const f32x4 v = xv[j][h2]; ss += (v.x * v.x + v.y * v.y) + (v.z * v.z + v.w * v.w); }
            const float rstd = frsq(wave_sum(ss) * (1.f / 1024.f) + EPS);
            unsigned char* h8 = F.ws + WS_HX8 + (size_t)tok * 1024;
#pragma unroll
            for (int j = 0; j < 2; ++j) { const int c0 = 8 * lane + 512 * j; f32x4 y[2];
#pragma unroll
                for (int h2 = 0; h2 < 2; ++h2) y[h2] = xv[j][h2] * rstd * av[j][h2] + shv[j][h2];
                *(u32x2*)(h8 + c0) = (u32x2){pk4_fp8(y[0].x, y[0].y, y[0].z, y[0].w), pk4_fp8(y[1].x, y[1].y, y[1].z, y[1].w)}; }
        }
    }
}
__device__ __forceinline__ Frame phase_frame(const Frame& F) {
    Frame Q = F; int t = threadIdx.x; asm volatile("" : "+v"(t)); Q.tid = t; Q.lane = t & 63; Q.wave = __builtin_amdgcn_readfirstlane(t >> 6);
    unsigned long long w = (unsigned long long)F.ws; asm volatile("" : "+s"(w)); Q.ws = (unsigned char*)(GAS unsigned char*)w;
    return Q;
}
constexpr int PH_PER_LAYER = 13, PH_TOTAL = 1 + 2 * PH_PER_LAYER;
__global__ void __launch_bounds__(NTHR, 2) mk_fwd(Params p) {
    extern __shared__ __attribute__((aligned(16))) unsigned char lds_raw[];
    Frame F0;
    F0.lds = (LAS unsigned char*)lds_raw; F0.ws = p.ws; F0.in = p.in; F0.out = p.out;
    F0.tid = threadIdx.x; F0.lane = F0.tid & 63; F0.wave = __builtin_amdgcn_readfirstlane(F0.tid >> 6); F0.bx = blockIdx.x; F0.G = gridDim.x;
    volatile LAS unsigned* MISC = (volatile LAS unsigned*)(F0.lds + MISC_OFF);
    if (F0.tid < 64) MISC[F0.tid] = 0u;
    __syncthreads();
    const int lo = p.ph_lo, hi = p.ph_hi;
    XcdBarrier bar; bar.bar = (unsigned*)(F0.ws + WS_CTL) + CW_BAR; bar.x = 0; bar.st = MISC + 8;
    if (hi - lo > 1) bar = xcd_barrier_post((unsigned*)(F0.ws + WS_CTL) + CW_BAR, MISC + 8);
#ifndef MK_SITE
#define MK_SITE -1
#endif
#define SITE(n) (MK_SITE < 0 || MK_SITE == (n))
#ifndef MK_REP_MASK
#define MK_REP_MASK 0
#endif
#define NREP(n) (((MK_REP_MASK >> (n)) & 1) ? 2 : 1)
#define RUN(k) (lo <= (k) && (k) < hi)
#define SEAM(k) do { if (RUN(k) && RUN((k) + 1)) { TSEC_BEGIN(300, F0.lds); xcd_barrier(bar); TSEC_END(300, F0.lds); } } while (0)
    int ph = 0;
    if (SITE(0) && RUN(ph)) TSEC_BEGIN(400 + 0, F0.lds); if (SITE(0) && RUN(ph)) for (int rep_ = 0; rep_ < NREP(0); ++rep_) { const Frame F = phase_frame(F0); ph_pre(F); }
    TSEC_END(400 + 99, F0.lds); SEAM(ph); ++ph;
    for (int l = 0; l < 2; ++l) {
        const int ntok = (l == 0) ? NTOK : NLAT, nM = ntok / 256;
        if (SITE(1) && RUN(ph)) TSEC_BEGIN(400 + 1, F0.lds); if (SITE(1) && RUN(ph)) for (int rep_ = 0; rep_ < NREP(1); ++rep_) { const Frame F = phase_frame(F0); ph_convert(F, l); __syncthreads(); if (l == 0) ph_norm1(F, l); }
        TSEC_END(400 + 99, F0.lds); SEAM(ph); ++ph;
        if (SITE(2) && RUN(ph)) TSEC_BEGIN(400 + 2, F0.lds); if (SITE(2) && RUN(ph)) for (int rep_ = 0; rep_ < NREP(2); ++rep_) { const Frame F = phase_frame(F0);
            SchedPlain S{(const char*)(F.ws + WS_HX8), (const char*)(F.ws + W_IN), 1024u, 1024u, 8, NTOK / 256, INCP / 256, F.G, F.bx};
            EpiWin E{(bf16_t*)(F.ws + WS_PX), (float*)(F.ws + T_GATE)};
            gg::gemm_phase(F.lds, S, E);
        }
        TSEC_END(400 + 99, F0.lds); SEAM(ph); ++ph;
        if (SITE(3) && RUN(ph)) TSEC_BEGIN(400 + 3, F0.lds); if (SITE(3) && RUN(ph)) for (int rep_ = 0; rep_ < NREP(3); ++rep_) { const Frame F = phase_frame(F0);
            for (int r2 = 0; r2 < NREP(16); ++r2) mla_prep(F, l);
            for (int r2 = 0; r2 < NREP(17); ++r2) { P1Regs R = ml_pass1_load(F, F.bx);
                for (int u = F.bx; u < 64 * NCHK; u += F.G) { const P1Regs Rn = ml_pass1_load(F, (u + F.G < 64 * NCHK) ? u + F.G : u); ml_pass1_unit(F, l, u, R); R = Rn; } }
            for (int r2 = 0; r2 < NREP(18); ++r2) { PoolRegs R = pool_load(F, F.bx);
                for (int u = F.bx; u < ntok / 64; u += F.G) { const PoolRegs Rn = pool_load(F, (u + F.G < ntok / 64) ? u + F.G : u); pool_unit(F, l, u, R); R = Rn; } }
            for (int r2 = 0; r2 < NREP(19); ++r2) conv_all(F, l, ntok);
            __syncthreads();
        }
        TSEC_END(400 + 99, F0.lds); SEAM(ph); ++ph;
        if (SITE(4) && RUN(ph)) TSEC_BEGIN(400 + 4, F0.lds); if (SITE(4) && RUN(ph)) for (int rep_ = 0; rep_ < NREP(4); ++rep_) { const Frame F = phase_frame(F0);
            ml_pass2(F);
            float gq = 0.f, gk = 0.f; for (int d = 0; d < 96; ++d) { gq = fmaxf(gq, fabsf(F.in[I_GQN][l * 96 + d])); gk = fmaxf(gk, fabsf(F.in[I_GKN][l * 96 + d])); }
            const bool nomax = (14.2f * gq * gk <= 64.0f);
            const int nunits = 1024 + (l == 0 ? 32 : 0);
#define ATT_UNITS(NM) for (int i = 0; ; ++i) { const int L = i * F.G + F.bx; if (L >= nunits) break; \
                if (L < 1024) { const int bh = (L >> 8) * 8 + (L & 7), qb = (L & 255) >> 3, b = bh >> 2; att2::unit<NM>(F, bh, b * 8192 + qb * 256, b * 8192 + qb * 256, 132); } \
                else { const int bh = L - 1024, b = bh >> 2; att2::unit<NM>(F, bh, NLAT + b * 256, NLAT + b * 256, 4); } }
            if (nomax) { ATT_UNITS(true) } else { ATT_UNITS(false) }
#undef ATT_UNITS
        }
        TSEC_END(400 + 99, F0.lds); SEAM(ph); ++ph;
        if (SITE(5) && RUN(ph)) TSEC_BEGIN(400 + 5, F0.lds); if (SITE(5) && RUN(ph)) for (int rep_ = 0; rep_ < NREP(5); ++rep_) { const Frame F = phase_frame(F0);
            const int npc = (l == 0) ? 66 : 64, nun = 32 * npc;
            for (int u = F.bx; u < nun; u += F.G) { const int bh = u / npc, pc = u % npc + (l == 0 ? 0 : 2); ml_pass3_unit(F, l, bh >> 2, bh & 3, pc); }
            __syncthreads();
        }
        TSEC_END(400 + 99, F0.lds); SEAM(ph); ++ph;
        {
            const int nMh = nM, pm0 = 0;
            if (SITE(6) && RUN(ph)) TSEC_BEGIN(400 + 6, F0.lds); if (SITE(6) && RUN(ph)) for (int rep_ = 0; rep_ < NREP(6); ++rep_) { const Frame F = phase_frame(F0);
                SchedYB S{(const char*)(F.ws + WS_YC), (const char*)(F.ws + W_BR), pm0, nMh, F.G, F.bx};
                EpiF8Out E{F.ws + WS_YB, 4096};
                gg::gemm_phase(F.lds, S, E);
            }
            TSEC_END(400 + 99, F0.lds); SEAM(ph); ++ph;
            if (SITE(13) && RUN(ph)) TSEC_BEGIN(400 + 13, F0.lds); if (SITE(13) && RUN(ph)) for (int rep_ = 0; rep_ < NREP(13); ++rep_) { const Frame F = phase_frame(F0);
                SchedPlain S{(const char*)(F.ws + WS_HX8) + (size_t)pm0 * 256 * 1024, (const char*)(F.ws + W_GATE), 1024u, 1024u, 8, nMh, 16, F.G, F.bx};
                EpiMerge2 E{(const unsigned char*)(F.ws + WS_YB), F.in[I_BGATE] + l * 4096, F.ws + WS_ACCM + (size_t)pm0 * 256 * 1024, 0};
                gg::gemm_phase(F.lds, S, E);
            }
            TSEC_END(400 + 99, F0.lds); SEAM(ph); ++ph;
        }
        if (SITE(7) && RUN(ph)) TSEC_BEGIN(400 + 7, F0.lds); if (SITE(7) && RUN(ph)) for (int rep_ = 0; rep_ < NREP(7); ++rep_) { const Frame F = phase_frame(F0);
            SchedPlain S{(const char*)(F.ws + WS_ACCM), (const char*)(F.ws + W_OUT), 1024u, 1024u, 8, nM, 4, F.G, F.bx};
            EpiWout E{(bf16_t*)(F.ws + WS_YC), modp(F, l, 0, 2)};
            gg::gemm_phase(F.lds, S, E);
        }
        TSEC_END(400 + 99, F0.lds); SEAM(ph); ++ph;
        if (SITE(8) && RUN(ph)) TSEC_BEGIN(400 + 8, F0.lds); if (SITE(8) && RUN(ph)) for (int rep_ = 0; rep_ < NREP(8); ++rep_) { const Frame F = phase_frame(F0); ph_norm2_route(F, l, ntok); }
        TSEC_END(400 + 99, F0.lds); SEAM(ph); ++ph;
        if (SITE(9) && RUN(ph)) TSEC_BEGIN(400 + 9, F0.lds); if (SITE(9) && RUN(ph)) for (int rep_ = 0; rep_ < NREP(9); ++rep_) { const Frame F = phase_frame(F0); ph_assign(F, ntok); }
        TSEC_END(400 + 99, F0.lds); SEAM(ph); ++ph;
        if (SITE(10) && RUN(ph)) TSEC_BEGIN(400 + 10, F0.lds); if (SITE(10) && RUN(ph)) for (int rep_ = 0; rep_ < NREP(10); ++rep_) { const Frame F = phase_frame(F0);
            int* tile_e = (int*)(F.ws + T_TILEE); const int ntiles = ld_i32_uniform(tile_e + 2047);
            LAS int* tab = (LAS int*)(F.lds + MOE_TAB_OFF); const int* rtok = (const int*)(F.ws + T_RTOK);
            __syncthreads();
            for (int i = 0; i < 28; ++i) { const int L = i * F.G + F.bx; if (L >= ntiles * 2) break; const int tile = L >> 1;
                if (F.tid == 0) tab[i] = tile_e[tile]; if (F.tid < 256) tab[256 + i * 256 + F.tid] = rtok[tile * 256 + F.tid]; }
            __syncthreads();
            SchedMoe1 S{(const char*)(F.ws + WS_HX8), (const char*)(F.ws + W_13), tab, ntiles, F.G, F.bx};
            EpiMoe1 E{F.ws + WS_AMOE, (const float*)(F.ws + T_RW)};
            gg::gemm_phase(F.lds, S, E);
        }
        TSEC_END(400 + 99, F0.lds); SEAM(ph); ++ph;
        if (SITE(11) && RUN(ph)) TSEC_BEGIN(400 + 11, F0.lds); if (SITE(11) && RUN(ph)) for (int rep_ = 0; rep_ < NREP(11); ++rep_) { const Frame F = phase_frame(F0);
            int* tile_e = (int*)(F.ws + T_TILEE); const int ntiles = ld_i32_uniform(tile_e + 2047);
            LAS int* tab = (LAS int*)(F.lds + MOE_TAB_OFF);
            __syncthreads();
            for (int i = F.tid; i < 64; i += NTHR) { const int L = i * F.G + F.bx; if (L < ntiles * 4) tab[i] = tile_e[L >> 2]; }
            __syncthreads();
            SchedMoe2 S{(const char*)(F.ws + WS_AMOE), (const char*)(F.ws + W_2), tab, ntiles, F.G, F.bx};
            EpiF8OutQ E{(unsigned char*)(F.ws + WS_YS), 1024};
            gg::gemm_phase(F.lds, S, E);
        }
        TSEC_END(400 + 99, F0.lds); SEAM(ph); ++ph;
        if (SITE(12) && RUN(ph)) TSEC_BEGIN(400 + 12, F0.lds); if (SITE(12) && RUN(ph)) for (int rep_ = 0; rep_ < NREP(12); ++rep_) { const Frame F = phase_frame(F0); if (l == 0) ph_combine<true>(F, l, 0, ntok); else ph_combine<false>(F, l, 0, ntok); }
        TSEC_END(400 + 99, F0.lds); SEAM(ph); ++ph;
    }
    if (MK_TSEC >= 0 && blockIdx.x == 0 && threadIdx.x == 0) { volatile LAS unsigned long long* q_ = (volatile LAS unsigned long long*)(F0.lds + MISC_OFF + 128);
        const unsigned long long t0 = __builtin_amdgcn_s_memrealtime(), d = q_[0] * 4ull; while (__builtin_amdgcn_s_memrealtime() - t0 < d) __builtin_amdgcn_s_sleep(8); }
#undef RUN
#undef SEAM
}

extern "C" void kernel_launch(void* const* d_in, const int* in_sizes, int n_in, void* d_out, int out_size, void* d_ws, size_t ws_size, hipStream_t stream) {
    static int grid = 0;
    if (grid == 0) {
        if (n_in != 33 || out_size != NLAT * DM || ws_size < WS_END) { fprintf(stderr, "kernel_launch: unexpected shapes (n_in %d, out %d, ws %zu < %zu)\n", n_in, out_size, ws_size, (size_t)WS_END); grid = -1; return; }
        int dev = 0, cus = 0;
        if (hipGetDevice(&dev) != hipSuccess || hipDeviceGetAttribute(&cus, hipDeviceAttributeMultiprocessorCount, dev) != hipSuccess) { grid = -1; return; }
        if (hipFuncSetAttribute((const void*)mk_fwd, hipFuncAttributeMaxDynamicSharedMemorySize, LDS_BYTES) != hipSuccess) { fprintf(stderr, "kernel_launch: hipFuncSetAttribute failed\n"); grid = -1; return; }
        int per_cu = 0;
        if (hipOccupancyMaxActiveBlocksPerMultiprocessor(&per_cu, (const void*)mk_fwd, NTHR, LDS_BYTES) != hipSuccess || per_cu < 1) fprintf(stderr, "kernel_launch: occupancy query says %d\n", per_cu);
        (void)hipGetLastError();
        if (cus < 256) { fprintf(stderr, "kernel_launch: built for a 256-CU device (got %d CUs)\n", cus); grid = -1; return; }
        grid = 256;
    }
    if (grid < 0) return;
    (void)hipMemsetAsync((char*)d_ws + WS_CTL, 0, CTL_ZERO_BYTES, stream);
    Params p{};
    for (int i = 0; i < 33; ++i) p.in[i] = (const float*)d_in[i];
    p.out = (float*)d_out; p.ws = (unsigned char*)d_ws;
#if MK_ONE_LAUNCH
    p.ph_lo = 0; p.ph_hi = PH_TOTAL;
    hipLaunchKernelGGL(mk_fwd, dim3(grid), dim3(NTHR), LDS_BYTES, stream, p);
#else
    for (int k = 0; k < PH_TOTAL; ++k) { p.ph_lo = k; p.ph_hi = k + 1; hipLaunchKernelGGL(mk_fwd, dim3(grid), dim3(NTHR), LDS_BYTES, stream, p); }
#endif
}
```

```cpp
#include <hip/hip_runtime.h>
#include <stdint.h>
#include <stdio.h>
#include <math.h>

#ifndef MK_ONE_LAUNCH
#define MK_ONE_LAUNCH 1
#endif

#define LAS __attribute__((address_space(3)))
#define GAS __attribute__((address_space(1)))
typedef unsigned short bf16_t;
typedef short bf16x8 __attribute__((ext_vector_type(8)));
typedef short s16x4 __attribute__((ext_vector_type(4)));
typedef float f32x2 __attribute__((ext_vector_type(2)));
typedef float f32x4 __attribute__((ext_vector_type(4)));
typedef float f32x16 __attribute__((ext_vector_type(16)));
typedef unsigned u32x2 __attribute__((ext_vector_type(2)));
typedef unsigned u32x4 __attribute__((ext_vector_type(4)));

constexpr int DM = 1024, NB = 8, SEQ = 8192, CTXL = 256, GRIDW = 64;
constexpr int NLAT = NB * SEQ, NCTX = NB * CTXL, NTOK = NLAT + NCTX;
constexpr int INC = 2480, INCP = 2560;
constexpr int C_ML = 0, C_G = 1024, C_MLA = 1040, C_POOL = 1456, C_CONV = 1712;
constexpr int NE = 64, NE1 = 65, TOPK = 6, NSLOT7 = 7, EFF = 256;
constexpr int NCHK = 66;
constexpr int NKT = 132;
constexpr float EPS = 1e-6f;
constexpr int NWAVES = 8, NTHR = 512;
constexpr int MOE_ROWS_MAX = 489472;
constexpr int MOE_TILES_MAX = MOE_ROWS_MAX / 256;

constexpr size_t MiB = 1u << 20;
constexpr size_t WS_CTL = 0, CTL_ZERO_BYTES = 1 * MiB;
constexpr size_t WS_MOD = 128 * 1024;
constexpr size_t WS_TAB = 1 * MiB;
constexpr size_t T_ROPE = WS_TAB;
constexpr size_t T_HIST = T_ROPE + 16384;
constexpr size_t T_TILEE = T_HIST + 65536;
constexpr size_t T_EIDX = T_TILEE + 8192;
constexpr size_t T_EW = T_EIDX + (size_t)NTOK * 6 * 4;
constexpr size_t T_SLOT = T_EW + (size_t)NTOK * 6 * 4;
constexpr size_t T_RTOK = T_SLOT + (size_t)NTOK * 8 * 4;
constexpr size_t T_RW = T_RTOK + (size_t)MOE_ROWS_MAX * 4;
constexpr size_t T_GATE = T_RW + (size_t)MOE_ROWS_MAX * 4;
constexpr size_t T_DN = T_GATE + (size_t)NTOK * 16 * 4;
constexpr size_t T_NST = T_DN + (size_t)4224 * 64 * 4;
constexpr size_t T_MLOC = T_NST + (size_t)4224 * 64 * 4;
constexpr size_t T_BEND = T_MLOC + 4224 * 4;
constexpr size_t T_MST = T_BEND + 4224 * 4;
constexpr size_t T_END = T_MST + 4224 * 4;
static_assert(T_END <= 17 * MiB, "tables");
constexpr size_t WS_WB = 17 * MiB;
constexpr size_t W_IN = WS_WB;
constexpr size_t W_GATE = W_IN + (size_t)INCP * 1024 * 2;
constexpr size_t W_BR = W_GATE + (size_t)4 * 1024 * 1024 * 2;
constexpr size_t W_OUT = W_BR + (size_t)4 * 1024 * 256 * 2;
constexpr size_t W_13 = W_OUT + (size_t)1024 * 1024 * 2;
constexpr size_t W_2 = W_13 + (size_t)NE1 * 512 * 1024 * 2;
constexpr size_t W_UQ = W_2 + (size_t)NE1 * 1024 * 256 * 2;
constexpr size_t W_UKV = W_UQ + (size_t)384 * 256 * 2;
constexpr size_t W_POOL = W_UKV + (size_t)512 * 128 * 2;
constexpr size_t W_RT = W_POOL + (size_t)4 * 64 * 64 * 2;
constexpr size_t W_END = W_RT + (size_t)64 * 1024 * 2;
static_assert(W_END <= 133 * MiB, "weights");
constexpr size_t WS_CTXS = 133 * MiB;
constexpr size_t WS_HX = 141 * MiB;
constexpr size_t WS_PX = 273 * MiB;
constexpr size_t WS_QB = 593 * MiB;
constexpr size_t WS_KT = 643 * MiB;
constexpr size_t WS_VT = 693 * MiB;
constexpr size_t WS_YC = 726 * MiB;
constexpr size_t WS_DC = 858 * MiB;
constexpr size_t WS_CST = 924 * MiB;
constexpr size_t WS_HX8 = 957 * MiB;
constexpr size_t WS_END = 1023 * MiB;
constexpr size_t WS_ACCM = WS_QB;
constexpr size_t WS_YB = WS_PX;
constexpr size_t WS_AMOE = WS_HX;
constexpr size_t WS_YS = WS_HX + 240 * MiB;
static_assert(WS_AMOE + (size_t)MOE_ROWS_MAX * 512 <= WS_YS && WS_YS + (size_t)MOE_ROWS_MAX * 1024 <= WS_HX8, "moe overlay");
static_assert(WS_YB + (size_t)NTOK * 4096 <= WS_QB && WS_ACCM + (size_t)NTOK * 2048 <= WS_YC, "merge overlay");

constexpr int CW_BAR = 4096;

constexpr int RING_BYTES = 131072;
constexpr int MISC_OFF = 160 * 1024 - 256;
constexpr int LDS_BYTES = 160 * 1024;

#ifndef MK_TSEC
#define MK_TSEC -1
#endif
#define TSEC_BEGIN(id, ldsb) do { if (MK_TSEC == (id) && blockIdx.x == 0 && threadIdx.x == 0) { volatile LAS unsigned long long* q_ = (volatile LAS unsigned long long*)((ldsb) + MISC_OFF + 128); q_[1] = __builtin_amdgcn_s_memrealtime(); } } while (0)
#define TSEC_END(id, ldsb) do { if ((MK_TSEC == (id) || ((id) == 499 && MK_TSEC >= 400 && MK_TSEC < 499)) && blockIdx.x == 0 && threadIdx.x == 0) { volatile LAS unsigned long long* q_ = (volatile LAS unsigned long long*)((ldsb) + MISC_OFF + 128); if (q_[1] != 0ull) { q_[0] += __builtin_amdgcn_s_memrealtime() - q_[1]; q_[1] = 0ull; } } } while (0)
typedef __bf16 bf16x2_t_ __attribute__((ext_vector_type(2)));
__device__ __forceinline__ unsigned pk2(float lo, float hi) { const f32x2 v = {lo, hi}; return __builtin_bit_cast(unsigned, __builtin_convertvector(v, bf16x2_t_)); }
__device__ __forceinline__ unsigned f2bf(float f) { return pk2(f, f) & 0xffffu; }
__device__ __forceinline__ float bf2f(unsigned short b) { return __builtin_bit_cast(float, ((unsigned)b) << 16); }
__device__ __forceinline__ float bflo(unsigned w) { return __builtin_bit_cast(float, w << 16); }
__device__ __forceinline__ float bfhi(unsigned w) { return __builtin_bit_cast(float, w & 0xffff0000u); }
__device__ __forceinline__ unsigned cvt_pk_bf16(float lo, float hi) { unsigned r; asm volatile("v_cvt_pk_bf16_f32 %0, %1, %2" : "=v"(r) : "v"(lo), "v"(hi)); return r; }
__device__ __forceinline__ unsigned char f2f8(float a) { return (unsigned char)(__builtin_amdgcn_cvt_pk_fp8_f32(a, a, 0, false) & 0xff); }
__device__ __forceinline__ unsigned pk4_fp8(float a, float b, float c, float d) { int r = __builtin_amdgcn_cvt_pk_fp8_f32(a, b, 0, false); r = __builtin_amdgcn_cvt_pk_fp8_f32(c, d, r, true); return (unsigned)r; }
__device__ __forceinline__ float sigmoidf_(float x) { return __builtin_amdgcn_rcpf(1.0f + __builtin_amdgcn_exp2f(x * -1.4426950408889634f)); }
template <int O> __device__ __forceinline__ float xor_lane(float v) { return __builtin_bit_cast(float, __builtin_amdgcn_ds_swizzle(__builtin_bit_cast(int, v), 0x1f | (O << 10))); }
__device__ __forceinline__ float half_sum(float v) { v += xor_lane<1>(v); v += xor_lane<2>(v); v += xor_lane<4>(v); v += xor_lane<8>(v); v += xor_lane<16>(v); return v; }
__device__ __forceinline__ float half_max(float v) { v = fmaxf(v, xor_lane<1>(v)); v = fmaxf(v, xor_lane<2>(v)); v = fmaxf(v, xor_lane<4>(v)); v = fmaxf(v, xor_lane<8>(v)); v = fmaxf(v, xor_lane<16>(v)); return v; }
__device__ __forceinline__ float wave_sum(float v) { v = half_sum(v); auto rr = __builtin_amdgcn_permlane32_swap(__builtin_bit_cast(unsigned, v), __builtin_bit_cast(unsigned, v), false, false);
    return __builtin_bit_cast(float, (unsigned)rr[0]) + __builtin_bit_cast(float, (unsigned)rr[1]); }
__device__ __forceinline__ float wave_max(float v) { v = half_max(v); auto rr = __builtin_amdgcn_permlane32_swap(__builtin_bit_cast(unsigned, v), __builtin_bit_cast(unsigned, v), false, false);
    return fmaxf(__builtin_bit_cast(float, (unsigned)rr[0]), __builtin_bit_cast(float, (unsigned)rr[1])); }
__device__ __forceinline__ float lane_up(float v, int o, int lane) { return __builtin_bit_cast(float, __builtin_amdgcn_ds_bpermute(((lane - o) & 63) << 2, __builtin_bit_cast(int, v))); }
__device__ __forceinline__ float lane_bcast(float v, int src) { return __builtin_bit_cast(float, __builtin_amdgcn_readlane(__builtin_bit_cast(int, v), src)); }
__device__ __forceinline__ float frcp(float x) { return __builtin_amdgcn_rcpf(x); }
__device__ __forceinline__ float frsq(float x) { return __builtin_amdgcn_rsqf(x); }
#define LDS_WAIT() asm volatile("s_waitcnt lgkmcnt(0)" ::: "memory")
#define LDS_BAR() asm volatile("s_waitcnt lgkmcnt(0)\n\ts_barrier" ::: "memory")
#define VM_WAIT() asm volatile("s_waitcnt vmcnt(0)" ::: "memory")

#define XB_TMO      128
#define XB_XCNT(j)  (256  + 64 * (j))
#define XB_XSUB(j)  (1280 + 64 * (j))
#define XB_XGEN(j)  (2304 + 64 * (j))
#define XB_TOP      3328
#define XB_TOPGEN   3392
#define XCD_BAR_WORDS 3456
#define XB_SPIN_CAP (1u << 22)

__device__ __forceinline__ unsigned xb_ld(unsigned* p)              { return __hip_atomic_load(p, __ATOMIC_RELAXED, __HIP_MEMORY_SCOPE_AGENT); }
__device__ __forceinline__ unsigned xb_add(unsigned* p, unsigned v) { return __hip_atomic_fetch_add(p, v, __ATOMIC_RELAXED, __HIP_MEMORY_SCOPE_AGENT); }
__device__ __forceinline__ unsigned xb_xcc_id() { return (unsigned)__builtin_amdgcn_s_getreg((3 << 11) | 20) & 0xFu; }
#define XB_SPIN(cond, bar) do { unsigned _sp = 0; while (cond) { __builtin_amdgcn_s_sleep(1); \
    if ((++_sp & 255u) == 0u) { if (xb_ld(&(bar)[XB_TMO])) break; if (_sp > XB_SPIN_CAP) { atomicAdd(&(bar)[XB_TMO], 1u); break; } } } } while (0)

struct XcdBarrier { unsigned* bar; unsigned x; volatile LAS unsigned* st; };

__device__ __forceinline__ XcdBarrier xcd_barrier_post(unsigned* bar, volatile LAS unsigned* st) {
    XcdBarrier b; b.bar = bar; b.x = xb_xcc_id(); b.st = st;
    if (threadIdx.x == 0) (void)xb_add(&bar[XB_XCNT(b.x)], 1u);
    return b;
}
__device__ __forceinline__ void xcd_barrier_complete(unsigned* bar, unsigned x, unsigned& nloc, unsigned& nx) {
    const unsigned G = gridDim.x * gridDim.y * gridDim.z;
    unsigned sum, cnt, mine, sp = 0u;
    for (;;) {
        sum = 0u; cnt = 0u; mine = 0u;
#pragma unroll
        for (unsigned j = 0; j < 16; ++j) { const unsigned c = xb_ld(&bar[XB_XCNT(j)]); sum += c; cnt += (c > 0u) ? 1u : 0u; mine = (j == x) ? c : mine; }
        if (sum == G) break;
        __builtin_amdgcn_s_sleep(1);
        if ((++sp & 255u) == 0u) { if (xb_ld(&bar[XB_TMO])) break; if (sp > XB_SPIN_CAP) { atomicAdd(&bar[XB_TMO], 1u); break; } }
    }
    nloc = mine > 0u ? mine : 1u; nx = cnt > 0u ? cnt : 1u;
}
__device__ __forceinline__ void xcd_barrier(const XcdBarrier& b) {
    asm volatile("s_waitcnt vmcnt(0)" ::: "memory");
    __syncthreads();
    if (threadIdx.x == 0) {
        unsigned* bar = b.bar;
        __builtin_amdgcn_s_waitcnt(0);
        unsigned nloc = b.st[0], nx = b.st[1];
        if (nloc == 0u) { xcd_barrier_complete(bar, b.x, nloc, nx); b.st[0] = nloc; b.st[1] = nx; }
        const unsigned old = xb_add(&bar[XB_XSUB(b.x)], 1u);
        const unsigned gen = old / nloc;
        if (old + 1u == (gen + 1u) * nloc) {
            __builtin_amdgcn_fence(__ATOMIC_RELEASE, "agent");
            asm volatile("s_waitcnt vmcnt(0)" ::: "memory");
            const unsigned og = xb_add(&bar[XB_TOP], 1u);
            const unsigned tg = og / nx;
            if (og + 1u == (tg + 1u) * nx) xb_add(&bar[XB_TOPGEN], 1u);
            else XB_SPIN(xb_ld(&bar[XB_TOPGEN]) == tg, bar);
            __builtin_amdgcn_fence(__ATOMIC_ACQUIRE, "agent");
            xb_add(&bar[XB_XGEN(b.x)], 1u);
            asm volatile("s_waitcnt vmcnt(0)" ::: "memory");
        } else {
            XB_SPIN(xb_ld(&bar[XB_XGEN(b.x)]) == gen, bar);
            __builtin_amdgcn_fence(__ATOMIC_ACQUIRE, "agent");
            asm volatile("s_waitcnt vmcnt(0)" ::: "memory");
        }
    }
    __syncthreads();
}

struct Params { const float* in[33]; float* out; unsigned char* ws; int ph_lo, ph_hi; };

struct Frame {
    LAS unsigned char* lds;
    unsigned char* ws;
    const float* const* in;
    float* out;
    int tid, lane, wave, bx, G;
};
enum { I_X = 0, I_C, I_CTX, I_CCTX, I_WMOD, I_BMOD, I_GMIX, I_GFFN, I_WIN, I_MLGB, I_MLHG, I_GCQ, I_GCKV, I_WUQ, I_WUKV, I_GQN, I_GKN, I_POOLW, I_POOLS,
       I_CONVW, I_CONVB, I_WGATE, I_BGATE, I_WBR, I_WOUT, I_WRT, I_BRT, I_W1, I_W3, I_W2, I_WS1, I_WS3, I_WS2 };

__device__ __forceinline__ const float* modp(const Frame& F, int l, int r, int which) { return (const float*)(F.ws + WS_MOD) + ((size_t)(l * 9 + r)) * 6144 + which * 1024; }
__device__ __forceinline__ int mod_row_of(int row) { return row < NLAT ? (row >> 13) : 8; }

__device__ __forceinline__ f32x4 up4_fp8(unsigned w) { const f32x2 lo = __builtin_amdgcn_cvt_pk_f32_fp8((int)w, false), hi = __builtin_amdgcn_cvt_pk_f32_fp8((int)w, true); return (f32x4){lo.x, lo.y, hi.x, hi.y}; }
namespace gg {
typedef int v4i_t __attribute__((ext_vector_type(4)));
constexpr int BM = 256, BK = 64, HALF = 128, HTB = HALF * BK * 2, STAGE_BYTES = 8 * HTB;
__device__ __forceinline__ int lds_byte(int r, int c) { const int st = (r >> 4) * 2 + (c >> 5), rr = r & 15, cc = c & 31, ob = rr * 64 + cc * 2; return st * 1024 + (ob ^ (((ob >> 9) & 1) << 5)); }
__device__ __forceinline__ void stage_rc(int b, int& R, int& C) { const int st = b / 1024, sb = b % 1024, swz = sb ^ (((sb >> 9) & 1) << 5); R = (st >> 1) * 16 + swz / 64; C = (st & 1) * 32 + (swz % 64) / 2; }
__device__ __forceinline__ int perm32(int rho) { const int n = rho >> 4, i = rho & 15; return 8 * (i >> 2) + 4 * n + (i & 3); }
__device__ __forceinline__ int perm16(int R) { return 64 * (R >> 5) + 16 * ((R >> 2) & 3) + 4 * ((R >> 4) & 1) + (R & 3); }

struct Unit {
    const char* A; const char* B;
    unsigned lda, ldb;
    int nt;
    int ridx_off;
    int p0, p1, p2;
};

template <class E, class = void> struct Perm16 { static constexpr bool v = false; };
template <class E> struct Perm16<E, decltype((void)E::PERM16)> { static constexpr bool v = E::PERM16; };
template <class E, class = void> struct ZPeel { static constexpr bool v = false; };
template <class E> struct ZPeel<E, decltype((void)E::ZPEEL)> { static constexpr bool v = E::ZPEEL; };
template <class Epi, class Sched>
__device__ __forceinline__ void gemm_phase(LAS unsigned char* lds, const Sched& S, const Epi& E) {
    int tid_ = threadIdx.x; asm volatile("" : "+v"(tid_));
    const int tid = tid_, wid = __builtin_amdgcn_readfirstlane(tid >> 6), lane = tid & 63, wr = wid >> 2, wc = wid & 3, fr = lane & 15, fq = lane >> 4;
    const size_t kstep = (size_t)(BK * 2);
    const unsigned ldsw = (unsigned)wid * 1024u;
    const int aoff = lds_byte(wr * 64 + fr, fq * 8), boff = lds_byte(wc * 32 + fr, fq * 8);
#define GG_SA(b, h) (((b) * 2 + (h)) * HTB)
#define GG_SB(b, h) ((4 + (b) * 2 + (h)) * HTB)
#define GG_STAGE(bufoff, gbase, v0, v1) do { \
        __builtin_amdgcn_global_load_lds((const unsigned*)((const char*)(gbase) + (v0)), (LAS unsigned*)(lds + (bufoff) + ldsw), 16, 0, 0); \
        __builtin_amdgcn_global_load_lds((const unsigned*)((const char*)(gbase) + (v1)), (LAS unsigned*)(lds + (bufoff) + ldsw + 8192), 16, 0, 0); } while (0)
#define GG_LDA(dst, b, h) do { _Pragma("unroll") for (int m = 0; m < 4; ++m) _Pragma("unroll") for (int k = 0; k < 2; ++k) dst[m][k] = *(const LAS bf16x8*)(lds + GG_SA(b, h) + aoff + m * 2048 + k * 1024); } while (0)
#define GG_LDB(dst, b, h) do { _Pragma("unroll") for (int n = 0; n < 2; ++n) _Pragma("unroll") for (int k = 0; k < 2; ++k) dst[n][k] = *(const LAS bf16x8*)(lds + GG_SB(b, h) + boff + n * 2048 + k * 1024); } while (0)
#define GG_MMA(ai, bj, At, Bt) do { __builtin_amdgcn_s_setprio(1); _Pragma("unroll") for (int m = 0; m < 4; ++m) _Pragma("unroll") for (int n = 0; n < 2; ++n) _Pragma("unroll") for (int k = 0; k < 2; ++k) \
        acc[ai][bj][m][n] = __builtin_amdgcn_mfma_f32_16x16x32_bf16(Bt[n][k], At[m][k], acc[ai][bj][m][n], 0, 0, 0); __builtin_amdgcn_s_setprio(0); } while (0)
#define GG_CAT8(x, y) __builtin_shufflevector(__builtin_bit_cast(v4i_t, x), __builtin_bit_cast(v4i_t, y), 0, 1, 2, 3, 4, 5, 6, 7)
#define GG_MMA8(ai, bj, At, Bt) do { __builtin_amdgcn_s_setprio(1); _Pragma("unroll") for (int m = 0; m < 4; ++m) _Pragma("unroll") for (int n = 0; n < 2; ++n) \
        acc[ai][bj][m][n] = __builtin_amdgcn_mfma_scale_f32_16x16x128_f8f6f4(GG_CAT8(Bt[n][0], Bt[n][1]), GG_CAT8(At[m][0], At[m][1]), acc[ai][bj][m][n], 0, 0, 0, (int)Epi::SCB, 0, 0x7f7f7f7f); __builtin_amdgcn_s_setprio(0); } while (0)
#define GG_MM(ai, bj, At, Bt) do { if constexpr (Epi::FP8) GG_MMA8(ai, bj, At, Bt); else GG_MMA(ai, bj, At, Bt); } while (0)
#define GG_MMZ8(ai, bj, At, Bt) do { __builtin_amdgcn_s_setprio(1); _Pragma("unroll") for (int m = 0; m < 4; ++m) _Pragma("unroll") for (int n = 0; n < 2; ++n) \
        acc[ai][bj][m][n] = __builtin_amdgcn_mfma_scale_f32_16x16x128_f8f6f4(GG_CAT8(Bt[n][0], Bt[n][1]), GG_CAT8(At[m][0], At[m][1]), (f32x4){0.f, 0.f, 0.f, 0.f}, 0, 0, 0, (int)Epi::SCB, 0, 0x7f7f7f7f); __builtin_amdgcn_s_setprio(0); } while (0)
#define GG_MM1(ai, bj, At, Bt) do { if constexpr (ZP && Epi::FP8) { if (t == 0) GG_MMZ8(ai, bj, At, Bt); else GG_MMA8(ai, bj, At, Bt); } else GG_MM(ai, bj, At, Bt); } while (0)
#define GG_WAIT_V(n) asm volatile("s_waitcnt vmcnt(" #n ")" ::: "memory")
#define GG_WAIT_L(n) asm volatile("s_waitcnt lgkmcnt(" #n ")" ::: "memory")
#define GG_BAR __builtin_amdgcn_s_barrier()
#define GG_SCHED __builtin_amdgcn_sched_barrier(0)
#define GG_OFFS(u) do { int R0_, C0_, R1_, C1_; stage_rc(tid * 16, R0_, C0_); stage_rc(tid * 16 + 8192, R1_, C1_); \
        if (Sched::GATHER) { const LAS int* rl_ = (const LAS int*)(lds + (u).ridx_off); vA0 = (unsigned)rl_[R0_] * (u).lda + C0_ * 2; vA1 = (unsigned)rl_[R1_] * (u).lda + C1_ * 2; \
                             vA2 = (unsigned)rl_[128 + R0_] * (u).lda + C0_ * 2; vA3 = (unsigned)rl_[128 + R1_] * (u).lda + C1_ * 2; hA = 0; } \
        else { vA0 = (unsigned)R0_ * (u).lda + C0_ * 2; vA1 = (unsigned)R1_ * (u).lda + C1_ * 2; vA2 = vA0; vA3 = vA1; hA = (size_t)128 * (u).lda; } \
        const int Rb0_ = Perm16<Epi>::v ? perm16(R0_) : (Epi::PERM ? ((R0_ & ~31) + perm32(R0_ & 31)) : R0_), Rb1_ = Perm16<Epi>::v ? perm16(R1_) : (Epi::PERM ? ((R1_ & ~31) + perm32(R1_ & 31)) : R1_); \
        vB0 = (unsigned)Rb0_ * (u).ldb + C0_ * 2; vB1 = (unsigned)Rb1_ * (u).ldb + C1_ * 2; hB = (size_t)(Perm16<Epi>::v ? 8 : 128) * (u).ldb; } while (0)
    Unit cur, nxt; int ui = 0;
    if (!S.next(0, cur)) return;
    constexpr bool ZP = ZPeel<Epi>::v;
    f32x4 acc[2][2][4][2];
    if constexpr (!ZP) {
#pragma unroll
    for (int a = 0; a < 2; ++a)
#pragma unroll
        for (int b = 0; b < 2; ++b)
#pragma unroll
            for (int m = 0; m < 4; ++m)
#pragma unroll
                for (int n = 0; n < 2; ++n) acc[a][b][m][n] = (f32x4){0.f, 0.f, 0.f, 0.f};
    }
    bf16x8 At[4][2], B0[2][2], B1[2][2];
    unsigned vA0, vA1, vA2, vA3, vB0, vB1; size_t hA, hB;
    GG_OFFS(cur);
    const char* cA = cur.A; const char* cB = cur.B;
    GG_STAGE(GG_SB(0, 0), cB, vB0, vB1); GG_STAGE(GG_SB(0, 1), cB + hB, vB0, vB1); GG_STAGE(GG_SA(0, 0), cA, vA0, vA1); GG_STAGE(GG_SA(0, 1), cA + hA, vA2, vA3);
    if (wr == 1) GG_BAR;
    GG_WAIT_V(2); GG_BAR;
    GG_STAGE(GG_SB(1, 0), cB + kstep, vB0, vB1); GG_STAGE(GG_SA(1, 0), cA + kstep, vA0, vA1); GG_STAGE(GG_SB(1, 1), cB + hB + kstep, vB0, vB1);
    GG_WAIT_V(6); GG_BAR;
    for (;;) {
        const bool has_next = S.next(ui + 1, nxt);
        TSEC_BEGIN(100 + Epi::TID, lds);
        int nt_ = cur.nt; asm volatile("" : "+s"(nt_)); const int nt = nt_;
#pragma unroll 1
        for (int t = 0; t < nt; t += 2) {
            const bool last = (t == nt - 2);
            const char* a1 = cA + (size_t)(t + 1) * kstep;
            GG_LDB(B0, 0, 0); GG_LDB(B1, 0, 1); GG_SCHED; GG_LDA(At, 0, 0); GG_STAGE(GG_SA(1, 1), a1 + hA, vA2, vA3);
            GG_WAIT_V(8); GG_WAIT_L(0); GG_BAR; GG_MM1(0, 0, At, B0); GG_MM1(0, 1, At, B1); GG_BAR; GG_SCHED;
            if (last) { if (has_next) { GG_OFFS(nxt); cA = nxt.A - (size_t)nt * kstep; cB = nxt.B - (size_t)nt * kstep; } else { cA -= (size_t)nt * kstep; cB -= (size_t)nt * kstep; } }
            const char* a2 = cA + (size_t)(t + 2) * kstep; const char* b2 = cB + (size_t)(t + 2) * kstep; const char* a3 = a2 + kstep; const char* b3 = b2 + kstep;
            GG_LDA(At, 0, 1); GG_STAGE(GG_SB(0, 0), b2, vB0, vB1); GG_STAGE(GG_SB(0, 1), b2 + hB, vB0, vB1); GG_STAGE(GG_SA(0, 0), a2, vA0, vA1);
            GG_WAIT_V(8); GG_WAIT_L(0); GG_BAR; GG_MM1(1, 0, At, B0); GG_MM1(1, 1, At, B1); GG_BAR; GG_SCHED;
            GG_LDB(B0, 1, 0); GG_LDB(B1, 1, 1); GG_SCHED; GG_LDA(At, 1, 0); GG_STAGE(GG_SA(0, 1), a2 + hA, vA2, vA3);
            GG_WAIT_V(8); GG_WAIT_L(0); GG_BAR; GG_MM(0, 0, At, B0); GG_MM(0, 1, At, B1); GG_BAR; GG_SCHED;
            GG_LDA(At, 1, 1); GG_STAGE(GG_SB(1, 0), b3, vB0, vB1); GG_STAGE(GG_SB(1, 1), b3 + hB, vB0, vB1); GG_STAGE(GG_SA(1, 0), a3, vA0, vA1);
            GG_WAIT_V(8); GG_WAIT_L(0); GG_BAR; GG_MM(1, 0, At, B0); GG_MM(1, 1, At, B1); GG_BAR; GG_SCHED;
        }
        cA += (size_t)nt * kstep; cB += (size_t)nt * kstep;
        TSEC_END(100 + Epi::TID, lds);
        if (wr == 0) GG_BAR;
        TSEC_BEGIN(200 + Epi::TID, lds); { int t2_ = threadIdx.x; asm volatile("" : "+v"(t2_)); E(acc, cur, wr, wc, t2_ & 15, (t2_ & 63) >> 4); } TSEC_END(200 + Epi::TID, lds);
        if (!has_next) break;
        if constexpr (!ZP)
#pragma unroll
        for (int a = 0; a < 2; ++a)
#pragma unroll
            for (int b = 0; b < 2; ++b)
#pragma unroll
                for (int m = 0; m < 4; ++m)
#pragma unroll
                    for (int n = 0; n < 2; ++n) acc[a][b][m][n] = (f32x4){0.f, 0.f, 0.f, 0.f};
        cur = nxt; ++ui;
        if (wr == 1) GG_BAR;
    }
    GG_WAIT_V(0);
    GG_BAR;
#undef GG_SA
#undef GG_SB
#undef GG_STAGE
#undef GG_LDA
#undef GG_LDB
#undef GG_MMA
#undef GG_MMA8
#undef GG_MM
#undef GG_MM1
#undef GG_MMZ8
#undef GG_CAT8
#undef GG_WAIT_V
#undef GG_WAIT_L
#undef GG_BAR
#undef GG_SCHED
#undef GG_OFFS
}
}

__device__ __forceinline__ int ld_i32_uniform(const int* p) { return __builtin_amdgcn_readfirstlane(__hip_atomic_load(p, __ATOMIC_RELAXED, __HIP_MEMORY_SCOPE_AGENT)); }
__device__ __forceinline__ void tile_order(int L, int nM, int nN, int& pm, int& pn) {
    const int nwg = nM * nN; int wgid = L;
    { const int q = nwg / 8, r = nwg % 8, xcd = wgid % 8, off = wgid / 8; wgid = (xcd < r ? xcd * (q + 1) : r * (q + 1) + (xcd - r) * q) + off; }
    const int nig = 8 * nN, gid = wgid / nig, fm = gid * 8, gsz = (nM - fm) < 8 ? (nM - fm) : 8;
    pm = fm + ((wgid % nig) % gsz); pn = (wgid % nig) / gsz;
}
struct SchedPlain {
    static constexpr bool GATHER = false;
    const char* A; const char* B; unsigned lda, ldb; int nt, nM, nN, G, c;
    __device__ __forceinline__ bool next(int i, gg::Unit& u) const {
        const int L = i * G + c; if (L >= nM * nN) return false;
        int pm, pn; tile_order(L, nM, nN, pm, pn);
        u.A = A + (size_t)pm * 256 * lda; u.B = B + (size_t)pn * 256 * ldb; u.lda = lda; u.ldb = ldb; u.nt = nt; u.ridx_off = 0; u.p0 = pm; u.p1 = pn; u.p2 = 0; return true;
    }
};
struct EpiWin {
    static constexpr bool PERM = true, FP8 = true; static constexpr int TID = 0; static constexpr unsigned SCB = 0x79797979u;
    bf16_t* px; float* gate;
    __device__ __forceinline__ void operator()(const f32x4 (&acc)[2][2][4][2], const gg::Unit& u, int wr, int wc, int fr, int fq) const {
        const int row0 = u.p0 * 256 + wr * 64 + fr;
#pragma unroll
        for (int bj = 0; bj < 2; ++bj) {
            const int c0 = u.p1 * 256 + bj * 128 + wc * 32 + 8 * fq;
            if (c0 < INC) {
                const bool isg = (c0 >= C_G && c0 < C_MLA);
#pragma unroll
                for (int ai = 0; ai < 2; ++ai)
#pragma unroll
                    for (int m = 0; m < 4; ++m) { const int row = row0 + ai * 128 + m * 16; const f32x4 v0 = acc[ai][bj][m][0], v1 = acc[ai][bj][m][1];
                        u32x4 w; w.x = cvt_pk_bf16(v0[0], v0[1]); w.y = cvt_pk_bf16(v0[2], v0[3]); w.z = cvt_pk_bf16(v1[0], v1[1]); w.w = cvt_pk_bf16(v1[2], v1[3]);
                        *(u32x4*)(px + (size_t)row * INC + c0) = w;
                        if (isg) { float* gp = gate + (size_t)row * 16 + (c0 - C_G); *(f32x4*)gp = v0; *(f32x4*)(gp + 4) = v1; } }
            }
        }
    }
};
struct SchedYB {
    static constexpr bool GATHER = false;
    const char* yc; const char* wb; int pm0, nMh, G, c;
    __device__ __forceinline__ bool next(int i, gg::Unit& u) const {
        const int L = i * G + c; if (L >= nMh * 16) return false;
        int pm, q; tile_order(L, nMh, 16, pm, q); const int br = q >> 2, pn = q & 3;
        u.A = yc + (size_t)(pm0 + pm) * 256 * 2048 + br * 512; u.lda = 2048; u.B = wb + (size_t)br * (1024 * 512) + (size_t)pn * 256 * 512; u.ldb = 512; u.nt = 4; u.ridx_off = 0; u.p0 = pm; u.p1 = q; u.p2 = 0; return true;
    }
};
struct EpiMerge2 {
    static constexpr bool PERM = false, FP8 = true; static constexpr int TID = 4; static constexpr unsigned SCB = 0x79797979u;
    const unsigned char* yb; const float* bgate; unsigned char* accm; int pm0;
    __device__ __forceinline__ void operator()(const f32x4 (&acc)[2][2][4][2], const gg::Unit& u, int wr, int wc, int fr, int fq) const {
        const int c = u.p1 * 64 + 16 * wc + 4 * fq, r0 = wr * 64 + fr;
        constexpr float NL2E = -1.4426950408889634f;
        f32x4 bv[2][2];
#pragma unroll
        for (int bj = 0; bj < 2; ++bj)
#pragma unroll
            for (int n = 0; n < 2; ++n) bv[bj][n] = *(const f32x4*)(bgate + (2 * bj + n) * 1024 + c) * NL2E;
        u32x4 yw[2][4];
#pragma unroll
        for (int ai = 0; ai < 2; ++ai)
#pragma unroll
            for (int m = 0; m < 4; ++m) { const unsigned char* yr = yb + (size_t)((u.p0 - pm0) * 256 + r0 + ai * 128 + m * 16) * 4096 + c;
                yw[ai][m] = (u32x4){*(const unsigned*)yr, *(const unsigned*)(yr + 1024), *(const unsigned*)(yr + 2048), *(const unsigned*)(yr + 3072)}; }
#pragma unroll
        for (int ai = 0; ai < 2; ++ai) {
#pragma unroll
            for (int m = 0; m < 4; ++m) {
                f32x4 t = {0.f, 0.f, 0.f, 0.f};
#pragma unroll
                for (int bj = 0; bj < 2; ++bj)
#pragma unroll
                    for (int n = 0; n < 2; ++n) { const f32x4 y = up4_fp8(yw[ai][m][2 * bj + n]); const f32x4 x = acc[ai][bj][m][n] * NL2E + bv[bj][n];
                        const f32x4 d = (f32x4){__builtin_amdgcn_exp2f(x[0]), __builtin_amdgcn_exp2f(x[1]), __builtin_amdgcn_exp2f(x[2]), __builtin_amdgcn_exp2f(x[3])} + 1.0f;
                        t += (f32x4){__builtin_amdgcn_rcpf(d[0]), __builtin_amdgcn_rcpf(d[1]), __builtin_amdgcn_rcpf(d[2]), __builtin_amdgcn_rcpf(d[3])} * y; }
                *(unsigned*)(accm + (size_t)(u.p0 * 256 + r0 + ai * 128 + m * 16) * 1024 + c) = pk4_fp8(t[0], t[1], t[2], t[3]); } }
    }
};
struct EpiWout {
    static constexpr bool PERM = true, FP8 = true; static constexpr int TID = 1; static constexpr unsigned SCB = 0x79797979u;
    bf16_t* mrg; const float* gt;
    __device__ __forceinline__ void operator()(const f32x4 (&acc)[2][2][4][2], const gg::Unit& u, int wr, int wc, int fr, int fq) const {
        const int pm = u.p0; const int mrow = pm >= 256 ? 8 : (pm >> 5);
        const float* g = gt + (size_t)mrow * 6144;
        const int row0 = pm * 256 + wr * 64 + fr, col0 = u.p1 * 256 + wc * 32 + 8 * fq;
#pragma unroll
        for (int bj = 0; bj < 2; ++bj) { const f32x4 g0 = *(const f32x4*)(g + col0 + bj * 128), g1 = *(const f32x4*)(g + col0 + bj * 128 + 4);
#pragma unroll
            for (int ai = 0; ai < 2; ++ai)
#pragma unroll
                for (int m = 0; m < 4; ++m) { const f32x4 v0 = acc[ai][bj][m][0] * g0, v1 = acc[ai][bj][m][1] * g1;
                    u32x4 w; w.x = cvt_pk_bf16(v0[0], v0[1]); w.y = cvt_pk_bf16(v0[2], v0[3]); w.z = cvt_pk_bf16(v1[0], v1[1]); w.w = cvt_pk_bf16(v1[2], v1[3]);
                    *(u32x4*)(mrg + (size_t)(row0 + ai * 128 + m * 16) * 1024 + col0 + bj * 128) = w; } }
    }
};
constexpr int MOE_TAB_OFF = RING_BYTES, MOE_RIDX_OFF = RING_BYTES + 1024;
struct SchedMoe1 {
    static constexpr bool GATHER = true;
    const char* hx2; const char* w13; const LAS int* tab; int ntiles, G, c;
    __device__ __forceinline__ bool next(int i, gg::Unit& u) const {
        const int L = i * G + c; if (L >= ntiles * 2) return false;
        const int tile = L >> 1, pn = L & 1, e = __builtin_amdgcn_readfirstlane(tab[i]);
        u.A = hx2; u.lda = 1024; u.ridx_off = MOE_RIDX_OFF + i * 1024; u.B = w13 + (size_t)e * (512 * 1024) + (size_t)pn * 256 * 1024; u.ldb = 1024; u.nt = 8; u.p0 = tile; u.p1 = pn; u.p2 = e; return true;
    }
};
struct EpiMoe1 {
    static constexpr bool PERM = true, FP8 = true; static constexpr int TID = 5; static constexpr unsigned SCB = 0x79797979u;
    unsigned char* a; const float* roww;
    __device__ __forceinline__ void operator()(const f32x4 (&acc)[2][2][4][2], const gg::Unit& u, int wr, int wc, int fr, int fq) const {
        const int row0 = u.p0 * 256 + wr * 64 + fr, col = u.p1 * 128 + wc * 32 + 8 * fq;
        float rwv[2][4];
#pragma unroll
        for (int ai = 0; ai < 2; ++ai)
#pragma unroll
            for (int m = 0; m < 4; ++m) rwv[ai][m] = roww[row0 + ai * 128 + m * 16] * 2.0f;
#pragma unroll
        for (int ai = 0; ai < 2; ++ai)
#pragma unroll
            for (int m = 0; m < 4; ++m) { const int row = row0 + ai * 128 + m * 16; f32x4 t[2];
#pragma unroll
                for (int n = 0; n < 2; ++n) { const f32x4 g1 = acc[ai][0][m][n], x = g1 * -1.4426950408889634f;
                    const f32x4 d = (f32x4){__builtin_amdgcn_exp2f(x[0]), __builtin_amdgcn_exp2f(x[1]), __builtin_amdgcn_exp2f(x[2]), __builtin_amdgcn_exp2f(x[3])} + 1.0f;
                    t[n] = (g1 * acc[ai][1][m][n] * rwv[ai][m]) * (f32x4){__builtin_amdgcn_rcpf(d[0]), __builtin_amdgcn_rcpf(d[1]), __builtin_amdgcn_rcpf(d[2]), __builtin_amdgcn_rcpf(d[3])}; }
                *(u32x2*)(a + (size_t)row * 256 + col) = (u32x2){pk4_fp8(t[0][0], t[0][1], t[0][2], t[0][3]), pk4_fp8(t[1][0], t[1][1], t[1][2], t[1][3])}; }
    }
};
struct SchedMoe2 {
    static constexpr bool GATHER = false;
    const char* a; const char* w2; const LAS int* tab; int ntiles, G, c;
    __device__ __forceinline__ bool next(int i, gg::Unit& u) const {
        const int L = i * G + c; if (L >= ntiles * 4) return false;
        const int tile = L >> 2, pn = L & 3, e = __builtin_amdgcn_readfirstlane(tab[i]);
        u.A = a + (size_t)tile * 256 * 256; u.lda = 256; u.ridx_off = 0; u.B = w2 + (size_t)e * (1024 * 256) + (size_t)pn * 256 * 256; u.ldb = 256; u.nt = 2; u.p0 = tile; u.p1 = pn; u.p2 = e; return true;
    }
};
struct EpiBf16Plain {
    static constexpr bool PERM = true, FP8 = false; static constexpr int TID = 2; static constexpr unsigned SCB = 0x7f7f7f7fu;
    bf16_t* O; int ldc;
    __device__ __forceinline__ void operator()(const f32x4 (&acc)[2][2][4][2], const gg::Unit& u, int wr, int wc, int fr, int fq) const {
        const int row0 = u.p0 * 256 + wr * 64 + fr, col0 = u.p1 * 256 + wc * 32 + 8 * fq;
#pragma unroll
        for (int ai = 0; ai < 2; ++ai)
#pragma unroll
            for (int m = 0; m < 4; ++m)
#pragma unroll
                for (int bj = 0; bj < 2; ++bj) { const f32x4 v0 = acc[ai][bj][m][0], v1 = acc[ai][bj][m][1];
                    u32x4 w; w.x = cvt_pk_bf16(v0[0], v0[1]); w.y = cvt_pk_bf16(v0[2], v0[3]); w.z = cvt_pk_bf16(v1[0], v1[1]); w.w = cvt_pk_bf16(v1[2], v1[3]);
                    *(u32x4*)(O + (size_t)(row0 + ai * 128 + m * 16) * ldc + col0 + bj * 128) = w; }
    }
};
struct EpiF8Out {
    static constexpr bool PERM = false, PERM16 = true, FP8 = false; static constexpr int TID = 6; static constexpr unsigned SCB = 0x7f7f7f7fu;
    unsigned char* O; int ldc;
    __device__ __forceinline__ void operator()(const f32x4 (&acc)[2][2][4][2], const gg::Unit& u, int wr, int wc, int fr, int fq) const {
        const int row0 = u.p0 * 256 + wr * 64 + fr, col0 = u.p1 * 256 + wc * 64 + 16 * fq;
#pragma unroll
        for (int ai = 0; ai < 2; ++ai)
#pragma unroll
            for (int m = 0; m < 4; ++m) { const f32x4 a0 = acc[ai][0][m][0], a1 = acc[ai][0][m][1], a2 = acc[ai][1][m][0], a3 = acc[ai][1][m][1];
                *(u32x4*)(O + (size_t)(row0 + ai * 128 + m * 16) * ldc + col0) = (u32x4){pk4_fp8(a0[0], a0[1], a0[2], a0[3]), pk4_fp8(a1[0], a1[1], a1[2], a1[3]), pk4_fp8(a2[0], a2[1], a2[2], a2[3]), pk4_fp8(a3[0], a3[1], a3[2], a3[3])}; }
    }
};
struct EpiF8OutQ {
    static constexpr bool PERM = false, PERM16 = true, FP8 = true, ZPEEL = true; static constexpr int TID = 7; static constexpr unsigned SCB = 0x79797979u;
    unsigned char* O; int ldc;
    __device__ __forceinline__ void operator()(const f32x4 (&acc)[2][2][4][2], const gg::Unit& u, int wr, int wc, int fr, int fq) const {
        const int row0 = u.p0 * 256 + wr * 64 + fr, col0 = u.p1 * 256 + wc * 64 + 16 * fq;
#pragma unroll
        for (int ai = 0; ai < 2; ++ai)
#pragma unroll
            for (int m = 0; m < 4; ++m) { const f32x4 a0 = acc[ai][0][m][0], a1 = acc[ai][0][m][1], a2 = acc[ai][1][m][0], a3 = acc[ai][1][m][1];
                *(u32x4*)(O + (size_t)(row0 + ai * 128 + m * 16) * ldc + col0) = (u32x4){pk4_fp8(a0[0], a0[1], a0[2], a0[3]), pk4_fp8(a1[0], a1[1], a1[2], a1[3]), pk4_fp8(a2[0], a2[1], a2[2], a2[3]), pk4_fp8(a3[0], a3[1], a3[2], a3[3])}; }
    }
};
struct EpiBf16F8 {
    static constexpr bool PERM = true, FP8 = true; static constexpr int TID = 3; static constexpr unsigned SCB = 0x77777777u;
    bf16_t* O; static constexpr int ldc = 1024;
    __device__ __forceinline__ void operator()(const f32x4 (&acc)[2][2][4][2], const gg::Unit& u, int wr, int wc, int fr, int fq) const {
        bf16_t* p = O + (size_t)(u.p0 * 256 + wr * 64 + fr) * ldc + u.p1 * 256 + wc * 32 + 8 * fq;
#pragma unroll
        for (int ai = 0; ai < 2; ++ai) {
#pragma unroll
            for (int m = 0; m < 4; ++m) {
#pragma unroll
                for (int bj = 0; bj < 2; ++bj) { const f32x4 v0 = acc[ai][bj][m][0], v1 = acc[ai][bj][m][1];
                    u32x4 w; w.x = cvt_pk_bf16(v0[0], v0[1]); w.y = cvt_pk_bf16(v0[2], v0[3]); w.z = cvt_pk_bf16(v1[0], v1[1]); w.w = cvt_pk_bf16(v1[2], v1[3]);
                    *(u32x4*)(p + bj * 128) = w; }
                p += 16 * ldc; asm volatile("" : "+v"(p)); }
            p += 64 * ldc; }
    }
};

__device__ __forceinline__ int crow(int r, int hi) { return (r & 3) + 8 * (r >> 2) + 4 * hi; }
__device__ __forceinline__ f32x16 mma32_ll(f32x16 acc, const LAS bf16_t* A, int lda, const LAS bf16_t* B, int ldb, int ksteps, int lane, int ks0 = 0) {
    const int r32 = lane & 31, hi = lane >> 5;
    for (int ks = ks0; ks < ksteps; ++ks) {
        const bf16x8 a = *(const LAS bf16x8*)(A + r32 * lda + ks * 16 + hi * 8);
        const bf16x8 b = *(const LAS bf16x8*)(B + r32 * ldb + ks * 16 + hi * 8);
        acc = __builtin_amdgcn_mfma_f32_32x32x16_bf16(a, b, acc, 0, 0, 0);
    }
    return acc;
}
template <int KS> __device__ __forceinline__ f32x16 mma32_lg(f32x16 acc, const LAS bf16_t* A, int lda, const bf16_t* B, int ldb, int lane) {
    const int r32 = lane & 31, hi = lane >> 5;
    bf16x8 b[KS];
#pragma unroll
    for (int ks = 0; ks < KS; ++ks) b[ks] = *(const bf16x8*)(B + (size_t)r32 * ldb + ks * 16 + hi * 8);
#pragma unroll
    for (int ks = 0; ks < KS; ++ks) { const bf16x8 a = *(const LAS bf16x8*)(A + r32 * lda + ks * 16 + hi * 8); acc = __builtin_amdgcn_mfma_f32_32x32x16_bf16(a, b[ks], acc, 0, 0, 0); }
    return acc;
}

__device__ __forceinline__ void ph_pre(const Frame& F) {
    LAS float* sv = (LAS float*)F.lds;
    LAS float* part = sv + 9 * 1024;
    float* mod = (float*)(F.ws + WS_MOD);
    for (int i = F.tid; i < 9 * 1024; i += NTHR) { const int r = i >> 10, k = i & 1023; const float c = (r < 8) ? F.in[I_C][r * 1024 + k] : F.in[I_CCTX][k]; sv[i] = c * sigmoidf_(c); }
    __syncthreads();
    for (int it = F.bx; it < 2 * 96; it += F.G) {
        const int l = it / 96, jc = it % 96, j = jc * 64 + F.lane, k0 = F.wave * 128;
        const float* w = F.in[I_WMOD] + ((size_t)l * 1024 + k0) * 6144 + j;
        float a[9];
#pragma unroll
        for (int r = 0; r < 9; ++r) a[r] = 0.f;
#pragma unroll 4
        for (int k = 0; k < 128; ++k) { const float wv = w[(size_t)k * 6144];
#pragma unroll
            for (int r = 0; r < 9; ++r) a[r] += sv[r * 1024 + k0 + k] * wv; }
#pragma unroll
        for (int r = 0; r < 9; ++r) part[(F.wave * 9 + r) * 64 + F.lane] = a[r];
        __syncthreads();
        for (int i = F.tid; i < 9 * 64; i += NTHR) { const int r = i >> 6, jj = i & 63; float s = F.in[I_BMOD][l * 6144 + jc * 64 + jj];
#pragma unroll
            for (int w8 = 0; w8 < 8; ++w8) s += part[(w8 * 9 + r) * 64 + jj];
            mod[((size_t)(l * 9 + r)) * 6144 + jc * 64 + jj] = s; }
        __syncthreads();
    }
    if (F.bx == F.G - 1) {
        float* rt = (float*)(F.ws + T_ROPE);
        for (int i = F.tid; i < 1024; i += NTHR) { const int pos = i >> 3, f = i & 7; const float inv = powf(10000.0f, -(float)f / 8.0f); const float ang = (float)pos * inv; rt[2 * i] = cosf(ang); rt[2 * i + 1] = sinf(ang); }
    }
}

struct ConvCursor { int base; int gw, ngw; };
__device__ __forceinline__ void conv_mat(const Frame& F, ConvCursor& cc, const float* src, int K, int N, bf16_t* dst, int ldd, int rbase, int rstep, int nbatch, size_t sbs, size_t dbs, int rq = 128, bool gperm = false, float f8scale = 0.f) {
    const int ktl = K / 64, ntl = (N + 127) / 128, per = ktl * ntl, total = per * nbatch;
    int t = cc.base + ((cc.gw - cc.base) % cc.ngw + cc.ngw) % cc.ngw;
    for (; t < cc.base + total; t += cc.ngw) {
        const int li = t - cc.base, bt = li / per, rem = li % per, kb = rem / ntl, nb = rem % ntl, k0 = kb * 64, n = nb * 128 + 2 * F.lane;
        if (n < N) {
            const float* s = src + bt * sbs + (size_t)k0 * N + n; bf16_t* d = dst + bt * dbs;
            f32x2 v[64];
#pragma unroll
            for (int i = 0; i < 64; ++i) v[i] = *(const f32x2*)(s + (size_t)i * N);
#pragma unroll
            for (int q = 0; q < 2; ++q) { const int nn = n + q; const int drow = gperm ? ((nn >> 6) * 256 + ((nn >> 4) & 3) * 32 + (nn & 15) + 128 * (bt >> 1) + 16 * (bt & 1)) : (rbase + (nn / rq) * rstep + (nn % rq));
                if (f8scale != 0.f) { unsigned char* d8 = (unsigned char*)dst + bt * dbs + (size_t)drow * ldd + k0;
#pragma unroll
                    for (int p = 0; p < 4; ++p) { u32x4 o; o.x = pk4_fp8(v[16 * p][q] * f8scale, v[16 * p + 1][q] * f8scale, v[16 * p + 2][q] * f8scale, v[16 * p + 3][q] * f8scale);
                        o.y = pk4_fp8(v[16 * p + 4][q] * f8scale, v[16 * p + 5][q] * f8scale, v[16 * p + 6][q] * f8scale, v[16 * p + 7][q] * f8scale);
                        o.z = pk4_fp8(v[16 * p + 8][q] * f8scale, v[16 * p + 9][q] * f8scale, v[16 * p + 10][q] * f8scale, v[16 * p + 11][q] * f8scale);
                        o.w = pk4_fp8(v[16 * p + 12][q] * f8scale, v[16 * p + 13][q] * f8scale, v[16 * p + 14][q] * f8scale, v[16 * p + 15][q] * f8scale);
                        *(u32x4*)(d8 + 16 * p) = o; }
                    continue; }
                bf16_t* dr = d + (size_t)drow * ldd + k0;
#pragma unroll
                for (int p = 0; p < 8; ++p) { u32x4 o; o.x = pk2(v[8 * p][q], v[8 * p + 1][q]); o.y = pk2(v[8 * p + 2][q], v[8 * p + 3][q]); o.z = pk2(v[8 * p + 4][q], v[8 * p + 5][q]); o.w = pk2(v[8 * p + 6][q], v[8 * p + 7][q]);
                    *(u32x4*)(dr + 8 * p) = o; } }
        }
    }
    cc.base += total;
}
__device__ __forceinline__ void ph_convert(const Frame& F, int l) {
    ConvCursor cc; cc.base = 0; cc.gw = F.bx * NWAVES + F.wave; cc.ngw = F.G * NWAVES;
    unsigned char* ws = F.ws;
    conv_mat(F, cc, F.in[I_WIN] + (size_t)l * 1024 * INC, 1024, INC, (bf16_t*)(ws + W_IN), 1024, 0, 128, 1, 0, 0, 128, false, 64.0f);
    conv_mat(F, cc, F.in[I_WGATE] + (size_t)l * 4 * 1024 * 1024, 1024, 1024, (bf16_t*)(ws + W_GATE), 1024, 0, 128, 4, (size_t)1024 * 1024, 0, 128, true, 64.0f);
    conv_mat(F, cc, F.in[I_WBR] + (size_t)l * 4 * 256 * 1024, 256, 1024, (bf16_t*)(ws + W_BR), 256, 0, 128, 4, (size_t)256 * 1024, (size_t)1024 * 256);
    conv_mat(F, cc, F.in[I_WOUT] + (size_t)l * 1024 * 1024, 1024, 1024, (bf16_t*)(ws + W_OUT), 1024, 0, 128, 1, 0, 0, 128, false, 64.0f);
    conv_mat(F, cc, F.in[I_W1] + (size_t)l * 64 * 1024 * 256, 1024, 256, (bf16_t*)(ws + W_13), 1024, 0, 256, 64, (size_t)1024 * 256, (size_t)512 * 1024, 128, false, 64.0f);
    conv_mat(F, cc, F.in[I_W3] + (size_t)l * 64 * 1024 * 256, 1024, 256, (bf16_t*)(ws + W_13), 1024, 128, 256, 64, (size_t)1024 * 256, (size_t)512 * 1024, 128, false, 64.0f);
    conv_mat(F, cc, F.in[I_W2] + (size_t)l * 64 * 256 * 1024, 256, 1024, (bf16_t*)(ws + W_2), 256, 0, 128, 64, (size_t)256 * 1024, (size_t)1024 * 256, 128, false, 32.0f);
    conv_mat(F, cc, F.in[I_WS1] + (size_t)l * 1024 * 256, 1024, 256, (bf16_t*)(ws + W_13 + (size_t)64 * 512 * 1024), 1024, 0, 256, 1, 0, 0, 128, false, 64.0f);
    conv_mat(F, cc, F.in[I_WS3] + (size_t)l * 1024 * 256, 1024, 256, (bf16_t*)(ws + W_13 + (size_t)64 * 512 * 1024), 1024, 128, 256, 1, 0, 0, 128, false, 64.0f);
    conv_mat(F, cc, F.in[I_WS2] + (size_t)l * 256 * 1024, 256, 1024, (bf16_t*)(ws + W_2 + (size_t)64 * 1024 * 256), 256, 0, 128, 1, 0, 0, 128, false, 32.0f);
    conv_mat(F, cc, F.in[I_WUQ] + (size_t)l * 256 * 384, 256, 384, (bf16_t*)(ws + W_UQ), 256, 0, 128, 1, 0, 0);
    conv_mat(F, cc, F.in[I_WUKV] + (size_t)l * 128 * 512, 128, 512, (bf16_t*)(ws + W_UKV), 128, 0, 128, 1, 0, 0);
    conv_mat(F, cc, F.in[I_POOLW] + (size_t)l * 4 * 64 * 64, 64, 64, (bf16_t*)(ws + W_POOL), 64, 0, 128, 4, (size_t)64 * 64, (size_t)64 * 64);
    conv_mat(F, cc, F.in[I_WRT] + (size_t)l * 1024 * 64, 1024, 64, (bf16_t*)(ws + W_RT), 1024, 0, 128, 1, 0, 0);
    { u32x4* z = (u32x4*)(ws + W_IN + (size_t)INC * 1024); const int n16 = (INCP - INC) * 1024 / 16;
      unsigned z0 = 0u; asm volatile("" : "+v"(z0));
      for (int i = F.bx * NTHR + F.tid; i < n16; i += F.G * NTHR) z[i] = (u32x4){z0, z0, z0, z0}; }
}

__device__ __forceinline__ void normmod_vals(int lane, const f32x4 (&v)[4], const float* g, const float* sc, const float* sh, f32x4 (&y)[4]) {
    float s = 0.f;
#pragma unroll
    for (int j = 0; j < 4; ++j) s += (v[j].x * v[j].x + v[j].y * v[j].y) + (v[j].z * v[j].z + v[j].w * v[j].w);
    const float rstd = frsq(wave_sum(s) * (1.f / 1024.f) + EPS);
#pragma unroll
    for (int j = 0; j < 4; ++j) { const f32x4 gv = ((const f32x4*)g)[lane + 64 * j], scv = ((const f32x4*)sc)[lane + 64 * j], shv = ((const f32x4*)sh)[lane + 64 * j];
        y[j] = v[j] * rstd * gv * (scv + 1.0f) + shv; }
}
__device__ __forceinline__ void normmod_row(int lane, const float* xrow, const float* g, const float* sc, const float* sh, f32x4 (&y)[4]) {
    const f32x4* xr = (const f32x4*)xrow + lane; f32x4 v[4]; float s = 0.f;
#pragma unroll
    for (int j = 0; j < 4; ++j) { v[j] = xr[64 * j]; s += (v[j].x * v[j].x + v[j].y * v[j].y) + (v[j].z * v[j].z + v[j].w * v[j].w); }
    const float rstd = frsq(wave_sum(s) * (1.f / 1024.f) + EPS);
#pragma unroll
    for (int j = 0; j < 4; ++j) { const f32x4 gv = ((const f32x4*)g)[lane + 64 * j], scv = ((const f32x4*)sc)[lane + 64 * j], shv = ((const f32x4*)sh)[lane + 64 * j];
        y[j] = v[j] * rstd * gv * (scv + 1.0f) + shv; }
}
__device__ __forceinline__ const float* stream_row(const Frame& F, int l, int row) {
    if (row < NLAT) return (l == 0 ? F.in[I_X] : F.out) + (size_t)row * 1024;
    return (l == 0 ? F.in[I_CTX] : (const float*)(F.ws + WS_CTXS)) + (size_t)(row - NLAT) * 1024;
}
__device__ __forceinline__ void ph_norm1(const Frame& F, int l) {
    const int gw = F.bx * NWAVES + F.wave, ngw = F.G * NWAVES;
    for (int row0 = gw; row0 < NTOK; row0 += 2 * ngw) {
        const int row1 = row0 + ngw; const bool has1 = row1 < NTOK;
        f32x4 v0[4], v1[4];
        { const f32x4* x0 = (const f32x4*)stream_row(F, l, row0) + F.lane; const f32x4* x1 = (const f32x4*)stream_row(F, l, has1 ? row1 : row0) + F.lane;
#pragma unroll
          for (int j = 0; j < 4; ++j) { v0[j] = x0[64 * j]; v1[j] = x1[64 * j]; } }
#pragma unroll
        for (int k = 0; k < 2; ++k) { if (k == 1 && !has1) break; const int row = k ? row1 : row0; const int mr = mod_row_of(row); f32x4 y[4];
            normmod_vals(F.lane, k ? v1 : v0, F.in[I_GMIX] + l * 1024, modp(F, l, mr, 1), modp(F, l, mr, 0), y);
            unsigned* o8 = (unsigned*)(F.ws + WS_HX8 + (size_t)row * 1024) + F.lane;
#pragma unroll
            for (int j = 0; j < 4; ++j) o8[64 * j] = pk4_fp8(y[j].x, y[j].y, y[j].z, y[j].w); }
    }
}

constexpr float QSCALE = 0.10206207261596577f * 1.4426950408889634f;
template <int KS> __device__ __forceinline__ void ld_bfrag(bf16x8* b, const bf16_t* B, int ldb, int lane) {
#pragma unroll
    for (int ks = 0; ks < KS; ++ks) b[ks] = *(const bf16x8*)(B + (size_t)(lane & 31) * ldb + ks * 16 + (lane >> 5) * 8);
}
template <int KS> __device__ __forceinline__ f32x16 mma32_lr(const LAS bf16_t* A, int lda, const bf16x8* b, int lane) {
    f32x16 acc = {};
#pragma unroll
    for (int ks = 0; ks < KS; ++ks) { const bf16x8 a = *(const LAS bf16x8*)(A + (lane & 31) * lda + ks * 16 + (lane >> 5) * 8); acc = __builtin_amdgcn_mfma_f32_32x32x16_bf16(a, b[ks], acc, 0, 0, 0); }
    return acc;
}
__device__ __forceinline__ f32x2 mla_rope_ld(const Frame& F, int unit) {
    const int row0 = unit * 32; const bool isctx = row0 >= NLAT; const int pos0 = isctx ? (row0 - NLAT) & 255 : row0 & 8191;
    const int pos = pos0 + (F.tid >> 4), pp = (F.tid & 8) ? (pos & 63) : (pos >> 6);
    return *(const f32x2*)((const float*)(F.ws + T_ROPE) + (pp * 8 + (F.tid & 7)) * 2);
}
struct MlaKvRegs { unsigned xk[4]; unsigned xr[4]; f32x2 rp; };
__device__ __forceinline__ MlaKvRegs mla_kv_load(const Frame& F, int unit) {
    MlaKvRegs R; const bf16_t* px = (const bf16_t*)(F.ws + WS_PX);
#pragma unroll
    for (int rr = 0; rr < 4; ++rr) { const bf16_t* p = px + (size_t)(unit * 32 + F.wave * 4 + rr) * INC + C_MLA;
        R.xk[rr] = *(const unsigned*)(p + 256 + 2 * F.lane); R.xr[rr] = *(const unsigned*)(p + 384 + 2 * (F.lane & 15)); }
    R.rp = mla_rope_ld(F, unit);
    return R;
}
__device__ __forceinline__ void mla_kv_unit(const Frame& F, int unit, const MlaKvRegs& R, const bf16x8* wkv, f32x2 gckv2, float g0, float g1, float g2) {
    LAS unsigned char* lds = F.lds;
    LAS bf16_t* AKV = (LAS bf16_t*)lds;
    LAS float* KR = (LAS float*)(lds + 8704);
    LAS f32x2* RP = (LAS f32x2*)(lds + 12800);
    LAS float* OUT = (LAS float*)(lds + 16896);
    LAS unsigned char* KB = (LAS unsigned char*)(lds + 83456);
    int tid_ = F.tid; asm volatile("" : "+v"(tid_));
    const int row0 = unit * 32, tid = tid_, lane = tid & 63, wave = F.wave, r32 = lane & 31, hi = lane >> 5;
    const bool isctx = row0 >= NLAT;
    const int b = isctx ? (row0 - NLAT) >> 8 : row0 >> 13, pos0 = isctx ? (row0 - NLAT) & 255 : row0 & 8191;
    LDS_BAR();
    RP[tid] = R.rp;
#pragma unroll
    for (int rr = 0; rr < 4; ++rr) { const int r = wave * 4 + rr; const unsigned w = R.xk[rr]; const float x0 = bflo(w), x1 = bfhi(w);
        const float sc = frsq(wave_sum(x0 * x0 + x1 * x1) * (1.f / 128.f) + EPS);
        *(LAS unsigned*)(AKV + r * 136 + 2 * lane) = pk2(x0 * sc * gckv2.x, x1 * sc * gckv2.y);
        if (lane < 16) *(LAS f32x2*)(KR + r * 32 + 2 * lane) = (f32x2){bflo(R.xr[rr]), bfhi(R.xr[rr])}; }
    LDS_BAR();
#pragma unroll
    for (int i = 0; i < 2; ++i) { const int nt = wave * 2 + i; const f32x16 acc = mma32_lr<8>(AKV, 136, wkv + 8 * i, lane);
#pragma unroll
        for (int r = 0; r < 16; ++r) OUT[crow(r, hi) * 520 + nt * 32 + r32] = acc[r]; }
    LDS_BAR();
#pragma unroll
    for (int it = 0; it < 8; ++it) { const int pr = wave * 16 + it * 2 + hi, r = pr >> 2, h = pr & 3; const LAS float* o = OUT + r * 520 + h * 128;
        float v0 = o[r32], v1 = o[32 + r32], v2 = KR[r * 32 + r32]; const float ss = half_sum(v0 * v0 + v1 * v1 + v2 * v2);
        const float sc = frsq(ss * (1.f / 96.f) + EPS);
        v0 *= sc * g0; v1 *= sc * g1; v2 *= sc * g2;
        const float pv = xor_lane<8>(v2);
        if (!isctx) { const f32x2 cssn = RP[(r * 2 + (r32 >> 4)) * 8 + (r32 & 7)]; v2 = (r32 & 8) ? (v2 * cssn.x + pv * cssn.y) : (v2 * cssn.x - pv * cssn.y); }
        LAS unsigned char* kb = KB + r * 400 + h * 96;
        kb[r32] = f2f8(v0); kb[32 + r32] = f2f8(v1); kb[64 + r32] = f2f8(v2); }
    LDS_BAR();
    const int key0 = isctx ? pos0 : 256 + pos0, tile = key0 >> 6, kin = key0 & 63;
    for (int i = tid; i < 768; i += NTHR) { const int r = i & 31, c = (i >> 5) % 6, h = i / 192;
        const u32x4 v = *(const LAS u32x4*)(KB + r * 400 + h * 96 + c * 16);
        *(u32x4*)(F.ws + WS_KT + ((size_t)((b * 4 + h) * NKT + tile) * 6 + c) * 1024 + (kin + r) * 16) = v; }
    for (int i = tid; i < 1024; i += NTHR) { const int p = i & 3, r = (i >> 2) & 31, dh = (i >> 7) & 1, h = i >> 8; const LAS float* o = OUT + r * 520 + h * 128 + 64 + dh * 32 + p * 8;
        u32x4 v; v.x = pk2(o[0], o[1]); v.y = pk2(o[2], o[3]); v.z = pk2(o[4], o[5]); v.w = pk2(o[6], o[7]);
        *(u32x4*)((bf16_t*)(F.ws + WS_VT) + ((size_t)((b * 4 + h) * NKT + tile) * 2 + dh) * 2048 + (kin + r) * 32 + p * 8) = v; }
}
struct MlaQRegs { u32x2 xq[4]; f32x2 rp; };
__device__ __forceinline__ MlaQRegs mla_q_load(const Frame& F, int unit) {
    MlaQRegs R; const bf16_t* px = (const bf16_t*)(F.ws + WS_PX);
#pragma unroll
    for (int rr = 0; rr < 4; ++rr) R.xq[rr] = *(const u32x2*)(px + (size_t)(unit * 32 + F.wave * 4 + rr) * INC + C_MLA + 4 * F.lane);
    R.rp = mla_rope_ld(F, unit);
    return R;
}
__device__ __forceinline__ void mla_q_unit(const Frame& F, int unit, const MlaQRegs& R, const bf16x8* wqf, f32x4 gcq4, float g0, float g1, float g2) {
    LAS unsigned char* lds = F.lds;
    LAS bf16_t* AQ = (LAS bf16_t*)lds;
    LAS f32x2* RP = (LAS f32x2*)(lds + 16896);
    LAS float* OQ = (LAS float*)(lds + 20992);
    int tid_ = F.tid; asm volatile("" : "+v"(tid_));
    const int row0 = unit * 32, tid = tid_, lane = tid & 63, wave = F.wave, r32 = lane & 31, hi = lane >> 5;
    const bool isctx = row0 >= NLAT;
    LDS_BAR();
    RP[tid] = R.rp;
#pragma unroll
    for (int rr = 0; rr < 4; ++rr) { const int r = wave * 4 + rr; const u32x2 w = R.xq[rr]; const float x0 = bflo(w.x), x1 = bfhi(w.x), x2 = bflo(w.y), x3 = bfhi(w.y);
        const float sc = frsq(wave_sum(x0 * x0 + x1 * x1 + x2 * x2 + x3 * x3) * (1.f / 256.f) + EPS);
        *(LAS u32x2*)(AQ + r * 264 + 4 * lane) = (u32x2){pk2(x0 * sc * gcq4.x, x1 * sc * gcq4.y), pk2(x2 * sc * gcq4.z, x3 * sc * gcq4.w)}; }
    LDS_BAR();
    { const f32x16 acc = mma32_lr<16>(AQ, 264, wqf, lane);
#pragma unroll
      for (int r = 0; r < 16; ++r) OQ[crow(r, hi) * 392 + wave * 32 + r32] = acc[r]; }
    if (wave < 4) { const f32x16 acc = mma32_lr<16>(AQ, 264, wqf + 16, lane);
#pragma unroll
      for (int r = 0; r < 16; ++r) OQ[crow(r, hi) * 392 + (8 + wave) * 32 + r32] = acc[r]; }
    LDS_BAR();
    unsigned char* qb = F.ws + WS_QB;
#pragma unroll
    for (int it = 0; it < 8; ++it) { const int pr = wave * 16 + it * 2 + hi, r = pr >> 2, h = pr & 3; const LAS float* o = OQ + r * 392 + h * 96;
        float v0 = o[r32], v1 = o[32 + r32], v2 = o[64 + r32]; const float ss = half_sum(v0 * v0 + v1 * v1 + v2 * v2);
        const float sc = frsq(ss * (1.f / 96.f) + EPS);
        v0 *= sc * g0; v1 *= sc * g1; v2 *= sc * g2;
        const float pv = xor_lane<8>(v2);
        if (!isctx) { const f32x2 cssn = RP[(r * 2 + (r32 >> 4)) * 8 + (r32 & 7)]; v2 = (r32 & 8) ? (v2 * cssn.x + pv * cssn.y) : (v2 * cssn.x - pv * cssn.y); }
        unsigned char* q = qb + (size_t)(row0 + r) * 384 + h * 96;
        q[r32] = f2f8(v0 * (8.0f * QSCALE)); q[32 + r32] = f2f8(v1 * (8.0f * QSCALE)); q[64 + r32] = f2f8(v2 * (8.0f * QSCALE)); }
}
__device__ __forceinline__ void mla_prep(const Frame& F, int l) {
    const int lane = F.lane, wave = F.wave, r32 = lane & 31;
    { bf16x8 wkv[16]; const bf16_t* wukv = (const bf16_t*)(F.ws + W_UKV);
      ld_bfrag<8>(wkv, wukv + (size_t)(wave * 2) * 32 * 128, 128, lane); ld_bfrag<8>(wkv + 8, wukv + (size_t)(wave * 2 + 1) * 32 * 128, 128, lane);
      const f32x2 gckv2 = *(const f32x2*)(F.in[I_GCKV] + l * 128 + 2 * lane); const float* gkn = F.in[I_GKN] + l * 96; const float g0 = gkn[r32], g1 = gkn[32 + r32], g2 = gkn[64 + r32];
      const int nu = NTOK / 32;
      if (F.bx < nu) { MlaKvRegs R = mla_kv_load(F, F.bx);
          for (int u = F.bx; u < nu; u += F.G) { const MlaKvRegs Rn = mla_kv_load(F, (u + F.G < nu) ? u + F.G : u); mla_kv_unit(F, u, R, wkv, gckv2, g0, g1, g2); R = Rn; } } }
    { bf16x8 wqf[32]; const bf16_t* wuq = (const bf16_t*)(F.ws + W_UQ);
      ld_bfrag<16>(wqf, wuq + (size_t)wave * 32 * 256, 256, lane); if (wave < 4) ld_bfrag<16>(wqf + 16, wuq + (size_t)(8 + wave) * 32 * 256, 256, lane);
      const f32x4 gcq4 = *(const f32x4*)(F.in[I_GCQ] + l * 256 + 4 * lane); const float* gqn = F.in[I_GQN] + l * 96; const float g0 = gqn[r32], g1 = gqn[32 + r32], g2 = gqn[64 + r32];
      const int nu = (l == 0 ? NTOK : NLAT) / 32;
      if (F.bx < nu) { MlaQRegs R = mla_q_load(F, F.bx);
          for (int u = F.bx; u < nu; u += F.G) { const MlaQRegs Rn = mla_q_load(F, (u + F.G < nu) ? u + F.G : u); mla_q_unit(F, u, R, wqf, gcq4, g0, g1, g2); R = Rn; } } }
}

__device__ __forceinline__ void ml_chunk_pos(int dir, int j, bool& isctx, int& p0) {
    if (j < 2) { isctx = true; p0 = (dir == 0 ? j : 1 - j) * 128; } else { isctx = false; p0 = (dir == 0 ? (j - 2) : (63 - (j - 2))) * 128; }
}
__device__ __forceinline__ int ml_row(int b, bool isctx, int pos) { return isctx ? NLAT + b * 256 + pos : b * 8192 + pos; }
__device__ __forceinline__ float log_sigmoidf_(float x) { return fminf(x, 0.f) - log1pf(__expf(-fabsf(x))); }

struct P1Regs { u32x4 kv[4]; float gi, gf; };
__device__ __forceinline__ P1Regs ml_pass1_load(const Frame& F, int unit) {
    P1Regs R; const int j = unit % NCHK, dir = (unit / NCHK) & 1, h = (unit / (NCHK * 2)) & 3, b = unit / (NCHK * 8);
    bool isctx; int p0; ml_chunk_pos(dir, j, isctx, p0);
    const bf16_t* px = (const bf16_t*)(F.ws + WS_PX); const float* gate = (const float*)(F.ws + T_GATE); const int tid = F.tid;
#pragma unroll
    for (int q = 0; q < 4; ++q) { const int it = tid + q * NTHR, i = it & 127, c = (it >> 7) & 7, isv = it >> 10; const int pos = dir ? p0 + 127 - i : p0 + i;
        R.kv[q] = *(const u32x4*)(px + (size_t)ml_row(b, isctx, pos) * INC + (isv ? 512 : 256) + h * 64 + c * 8); }
    { const int i = tid & 127; const int pos = dir ? p0 + 127 - i : p0 + i; const float* g = gate + (size_t)ml_row(b, isctx, pos) * 16; R.gi = g[dir * 8 + h]; R.gf = g[dir * 8 + 4 + h]; }
    return R;
}
__device__ __forceinline__ void ml_pass1_unit(const Frame& F, int l, int unit, const P1Regs& R) {
    LAS float* LI = (LAS float*)F.lds; LAS float* LF = LI + 128; LAS float* WV = LI + 256;
    LAS bf16_t* KT = (LAS bf16_t*)(F.lds + 2048); LAS bf16_t* VT = KT + 64 * 136;
    const int dir = (unit / NCHK) & 1, h = (unit / (NCHK * 2)) & 3;
    const int tid = F.tid, lane = F.lane, wave = F.wave;
    const float* gb = F.in[I_MLGB] + l * 16;
    LDS_BAR();
    if (tid < 128) { LI[tid] = R.gi + gb[dir * 8 + h]; LF[tid] = log_sigmoidf_(R.gf + gb[dir * 8 + 4 + h]); }
    LDS_BAR();
    if (wave == 0) {
        const float a0 = LF[2 * lane], a1 = LF[2 * lane + 1]; float s = a0 + a1;
#pragma unroll
        for (int o = 1; o < 64; o <<= 1) { const float t = lane_up(s, o, lane); if (lane >= o) s += t; }
        const float bend = lane_bcast(s, 63);
        const float w0 = bend - (s - a1) + LI[2 * lane], w1 = bend - s + LI[2 * lane + 1];
        const float mloc = wave_max(fmaxf(w0, w1));
        WV[2 * lane] = __expf(w0 - mloc); WV[2 * lane + 1] = __expf(w1 - mloc);
        if (lane == 0) { ((float*)(F.ws + T_MLOC))[unit] = mloc; ((float*)(F.ws + T_BEND))[unit] = bend; }
    }
    LDS_BAR();
#pragma unroll
    for (int q = 0; q < 4; ++q) { const int it = tid + q * NTHR, i = it & 127, c = (it >> 7) & 7, isv = it >> 10; const u32x4 v = R.kv[q];
        const float sc = isv ? 1.0f : 0.125f * WV[i]; LAS bf16_t* d = (isv ? VT : KT) + (c * 8) * 136 + i;
        d[0] = (bf16_t)f2bf(bflo(v.x) * sc); d[136] = (bf16_t)f2bf(bfhi(v.x) * sc); d[272] = (bf16_t)f2bf(bflo(v.y) * sc); d[408] = (bf16_t)f2bf(bfhi(v.y) * sc);
        d[544] = (bf16_t)f2bf(bflo(v.z) * sc); d[680] = (bf16_t)f2bf(bfhi(v.z) * sc); d[816] = (bf16_t)f2bf(bflo(v.w) * sc); d[952] = (bf16_t)f2bf(bfhi(v.w) * sc); }
    LDS_BAR();
    if (wave < 4) { const int et = wave >> 1, dt = wave & 1; f32x16 acc = {}; acc = mma32_ll(acc, VT + et * 32 * 136, 136, KT + dt * 32 * 136, 136, 8, lane);
        float* dc = (float*)(F.ws + WS_DC) + (size_t)unit * 4096; const int r32 = lane & 31, hi = lane >> 5;
#pragma unroll
        for (int r = 0; r < 16; ++r) dc[(et * 32 + crow(r, hi)) * 64 + dt * 32 + r32] = acc[r];
    } else if (wave == 4) { float s = 0.f; for (int i = 0; i < 128; ++i) s += bf2f(KT[lane * 136 + i]); ((float*)(F.ws + T_DN))[(size_t)unit * 64 + lane] = s; }
}

__device__ __forceinline__ void ml_pass2(const Frame& F) {
    const float* dc = (const float*)(F.ws + WS_DC); const float* dn = (const float*)(F.ws + T_DN);
    const float* mloc = (const float*)(F.ws + T_MLOC); const float* bend = (const float*)(F.ws + T_BEND);
    bf16_t* cst = (bf16_t*)(F.ws + WS_CST); float* nst = (float*)(F.ws + T_NST); float* mst = (float*)(F.ws + T_MST);
    LAS float* ML = (LAS float*)F.lds; LAS float* BE = ML + 128;
    for (int it = F.bx; it < 64 * 8; it += F.G) { const int bhd = it >> 3, part = it & 7, u0 = bhd * NCHK, el = part * 512 + F.tid;
        const bool don = (part == 0 && F.tid < 64);
        float d[NCHK], dnv[NCHK];
#pragma unroll
        for (int j = 0; j < NCHK; ++j) d[j] = dc[(size_t)(u0 + j) * 4096 + el];
#pragma unroll
        for (int j = 0; j < NCHK; ++j) dnv[j] = don ? dn[(size_t)(u0 + j) * 64 + F.tid] : 0.f;
        __syncthreads();
        if (F.tid < NCHK) { ML[F.tid] = mloc[u0 + F.tid]; BE[F.tid] = bend[u0 + F.tid]; }
        __syncthreads();
        float C = 0.f, n = 0.f, m = 0.f;
#pragma unroll
        for (int j = 0; j < NCHK; ++j) { const int u = u0 + j; const float ml = ML[j], be = BE[j];
            cst[(size_t)u * 4096 + el] = (bf16_t)f2bf(C); if (don) nst[(size_t)u * 64 + F.tid] = n; if (part == 0 && F.tid == 0) mst[u] = m;
            const float mn = fmaxf(be + m, ml), dcy = __expf(be + m - mn), sc = __expf(ml - mn);
            C = dcy * C + sc * d[j]; n = dcy * n + sc * dnv[j]; m = mn; }
    }
    __syncthreads();
}

__device__ __forceinline__ void ml_pass3_unit(const Frame& F, int l, int b, int h, int pc) {
    LAS unsigned char* lds = F.lds;
    LAS bf16_t* Qs = (LAS bf16_t*)lds;
    LAS bf16_t* Ks = (LAS bf16_t*)(lds + 18432);
    LAS bf16_t* VTs = (LAS bf16_t*)(lds + 36864);
    LAS bf16_t* CTs = (LAS bf16_t*)(lds + 62976);
    LAS bf16_t* Wm = (LAS bf16_t*)(lds + 76800);
    LAS float* HS = (LAS float*)(lds + 111616);
    LAS float* VEC = (LAS float*)(lds + 144384);
    LAS float* DEN = VEC + 12 * 128;
    const int tid = F.tid, lane = F.lane, wave = F.wave, r32 = lane & 31, hi = lane >> 5;
    const bool isctx = pc < 2; const int p0 = isctx ? pc * 128 : (pc - 2) * 128;
    const float* gate = (const float*)(F.ws + T_GATE); const float* gb = F.in[I_MLGB] + l * 16;
    const bf16_t* px = (const bf16_t*)(F.ws + WS_PX);
    int unit_d[2];
#pragma unroll
    for (int dir = 0; dir < 2; ++dir) { const int j = isctx ? (dir == 0 ? pc : 1 - pc) : (dir == 0 ? pc : 2 + 63 - (pc - 2)); unit_d[dir] = ((b * 4 + h) * 2 + dir) * NCHK + j; }
    LDS_BAR();
    const u32x4 cst0 = *(const u32x4*)((const bf16_t*)(F.ws + WS_CST) + (size_t)unit_d[0] * 4096 + tid * 8), cst1 = *(const u32x4*)((const bf16_t*)(F.ws + WS_CST) + (size_t)unit_d[1] * 4096 + tid * 8);
    const float nv0 = (tid < 64) ? ((const float*)(F.ws + T_NST))[(size_t)unit_d[0] * 64 + tid] : 0.f, nv1 = (tid < 64) ? ((const float*)(F.ws + T_NST))[(size_t)unit_d[1] * 64 + tid] : 0.f;
    const float mst0 = ((const float*)(F.ws + T_MST))[unit_d[0]], mst1 = ((const float*)(F.ws + T_MST))[unit_d[1]];
    if (tid < 256) { const int dir = tid >> 7, i = tid & 127; const int pos = dir ? p0 + 127 - i : p0 + i; const float* g = gate + (size_t)ml_row(b, isctx, pos) * 16;
        VEC[(dir * 6 + 0) * 128 + i] = g[dir * 8 + h] + gb[dir * 8 + h]; VEC[(dir * 6 + 1) * 128 + i] = log_sigmoidf_(g[dir * 8 + 4 + h] + gb[dir * 8 + 4 + h]); }
    for (int it = tid; it < 3072; it += NTHR) { const int i = it & 127, c = (it >> 7) & 7, which = it >> 10;
        const u32x4 v = *(const u32x4*)(px + (size_t)ml_row(b, isctx, p0 + i) * INC + which * 256 + h * 64 + c * 8);
        if (which == 0) *(LAS u32x4*)(Qs + i * 72 + c * 8) = v;
        else if (which == 1) { u32x4 w; w.x = pk2(bflo(v.x) * 0.125f, bfhi(v.x) * 0.125f); w.y = pk2(bflo(v.y) * 0.125f, bfhi(v.y) * 0.125f); w.z = pk2(bflo(v.z) * 0.125f, bfhi(v.z) * 0.125f); w.w = pk2(bflo(v.w) * 0.125f, bfhi(v.w) * 0.125f);
            *(LAS u32x4*)(Ks + i * 72 + c * 8) = w; }
        else { LAS bf16_t* d = VTs + (c * 8) * 136 + i; d[0] = (bf16_t)(v.x & 0xffff); d[136] = (bf16_t)(v.x >> 16); d[272] = (bf16_t)(v.y & 0xffff); d[408] = (bf16_t)(v.y >> 16);
            d[544] = (bf16_t)(v.z & 0xffff); d[680] = (bf16_t)(v.z >> 16); d[816] = (bf16_t)(v.w & 0xffff); d[952] = (bf16_t)(v.w >> 16); } }
    for (int it = tid; it < 32 * 136; it += NTHR) VTs[64 * 136 + it] = (it < 128) ? (bf16_t)0x3f80 : (bf16_t)0;
    LDS_BAR();
    if (wave < 2) { const int dir = wave; LAS float* V0 = VEC + dir * 6 * 128; const float mst = dir ? mst1 : mst0;
        const float a0 = V0[128 + 2 * lane], a1 = V0[128 + 2 * lane + 1]; float s = a0 + a1;
#pragma unroll
        for (int o = 1; o < 64; o <<= 1) { const float t = lane_up(s, o, lane); if (lane >= o) s += t; }
        const float b0 = s - a1, b1 = s, c0 = V0[2 * lane] - b0, c1 = V0[2 * lane + 1] - b1;
        float pm = fmaxf(c0, c1);
#pragma unroll
        for (int o = 1; o < 64; o <<= 1) { const float t = lane_up(pm, o, lane); if (lane >= o) pm = fmaxf(pm, t); }
        float pprev = lane_up(pm, 1, lane); if (lane == 0) pprev = -INFINITY;
        const float M0 = fmaxf(mst, fmaxf(pprev, c0)), M1 = fmaxf(mst, pm);
        V0[256 + 2 * lane] = c0; V0[256 + 2 * lane + 1] = c1; V0[384 + 2 * lane] = M0; V0[384 + 2 * lane + 1] = M1;
        V0[512 + 2 * lane] = __expf(mst - M0); V0[512 + 2 * lane + 1] = __expf(mst - M1); V0[640 + 2 * lane] = __expf(-b0 - M0); V0[640 + 2 * lane + 1] = __expf(-b1 - M1);
    }
    const u32x4 og0 = *(const u32x4*)(px + (size_t)ml_row(b, isctx, p0 + (tid >> 3)) * INC + 768 + h * 64 + (tid & 7) * 8), og1 = *(const u32x4*)(px + (size_t)ml_row(b, isctx, p0 + 64 + (tid >> 3)) * INC + 768 + h * 64 + (tid & 7) * 8);
    for (int dir = 0; dir < 2; ++dir) {
        const LAS float* COLV = VEC + (dir * 6 + 2) * 128; const LAS float* MV = COLV + 128; const LAS float* AIN = COLV + 256; const LAS float* EINV = COLV + 384;
        const int rs = dir ? -72 : 72, rb = dir ? 127 : 0;
        LDS_BAR();
        *(LAS u32x4*)(CTs + (tid >> 3) * 72 + (tid & 7) * 8) = dir ? cst1 : cst0;
        if (tid < 72) CTs[64 * 72 + tid] = (tid < 64) ? (bf16_t)f2bf(dir ? nv1 : nv0) : (bf16_t)0;
        for (int q = wave; q < 16; q += 8) { const int ti = q >> 2, si = q & 3; const int sidx = si * 32 + r32, spos = dir ? 127 - sidx : sidx;
            if (si > ti) {
#pragma unroll
                for (int r = 0; r < 16; ++r) Wm[(ti * 32 + crow(r, hi)) * 136 + spos] = 0;
            } else { f32x16 acc = {}; acc = mma32_ll(acc, Qs + (rb + (dir ? -ti * 32 : ti * 32)) * 72, rs, Ks + (rb + (dir ? -si * 32 : si * 32)) * 72, rs, 4, lane); const float cv = COLV[sidx];
#pragma unroll
                for (int r = 0; r < 16; ++r) { const int t = ti * 32 + crow(r, hi); const float w = (sidx <= t) ? acc[r] * __expf(cv - MV[t]) : 0.f; Wm[t * 136 + spos] = (bf16_t)f2bf(w); } }
        }
        LDS_BAR();
        f32x16 tot[2];
#pragma unroll
        for (int k = 0; k < 2; ++k) { const int q = wave + 8 * k; if (q < 12) { const int ti = q / 3, nt = q % 3;
            f32x16 a1 = {}; a1 = mma32_ll(a1, Wm + ti * 32 * 136, 136, VTs + nt * 32 * 136, 136, dir ? 8 : (ti + 1) * 2, lane, dir ? 8 - (ti + 1) * 2 : 0);
            f32x16 a2 = {}; a2 = mma32_ll(a2, Qs + (rb + (dir ? -ti * 32 : ti * 32)) * 72, rs, CTs + nt * 32 * 72, 72, 4, lane);
#pragma unroll
            for (int r = 0; r < 16; ++r) a1[r] += AIN[ti * 32 + crow(r, hi)] * a2[r];
            tot[k] = a1;
            if (nt == 2 && r32 == 0) {
#pragma unroll
                for (int r = 0; r < 16; ++r) DEN[ti * 32 + crow(r, hi)] = a1[r]; } } }
        LDS_BAR();
#pragma unroll
        for (int k = 0; k < 2; ++k) { const int q = wave + 8 * k; if (q < 12) { const int ti = q / 3, nt = q % 3; if (nt < 2) {
#pragma unroll
            for (int r = 0; r < 16; ++r) { const int t = ti * 32 + crow(r, hi); const float hv = tot[k][r] * frcp(fmaxf(fabsf(DEN[t]), EINV[t])); const int p = dir ? 127 - t : t;
                if (dir == 0) HS[p * 64 + nt * 32 + r32] = hv; else HS[p * 64 + nt * 32 + r32] += hv; } } } }
    }
    LDS_BAR();
    { const int c8 = (tid & 7) * 8; bf16_t* yc = (bf16_t*)(F.ws + WS_YC);
      const f32x4 hg0 = *(const f32x4*)(F.in[I_MLHG] + l * 256 + h * 64 + c8), hg1 = *(const f32x4*)(F.in[I_MLHG] + l * 256 + h * 64 + c8 + 4);
#pragma unroll
      for (int half = 0; half < 2; ++half) { const int p = half * 64 + (tid >> 3); const u32x4 og = half ? og1 : og0;
        const f32x4 v0 = *(const LAS f32x4*)(HS + p * 64 + c8), v1 = *(const LAS f32x4*)(HS + p * 64 + c8 + 4);
        float ss = (v0.x * v0.x + v0.y * v0.y) + (v0.z * v0.z + v0.w * v0.w) + (v1.x * v1.x + v1.y * v1.y) + (v1.z * v1.z + v1.w * v1.w);
        ss += xor_lane<1>(ss); ss += xor_lane<2>(ss); ss += xor_lane<4>(ss);
        const float sc = frsq(ss * (1.f / 64.f) + EPS);
        const f32x4 y0 = v0 * sc * hg0 * (f32x4){sigmoidf_(bflo(og.x)), sigmoidf_(bfhi(og.x)), sigmoidf_(bflo(og.y)), sigmoidf_(bfhi(og.y))};
        const f32x4 y1 = v1 * sc * hg1 * (f32x4){sigmoidf_(bflo(og.z)), sigmoidf_(bfhi(og.z)), sigmoidf_(bflo(og.w)), sigmoidf_(bfhi(og.w))};
        *(u32x4*)(yc + (size_t)ml_row(b, isctx, p0 + p) * 1024 + h * 64 + c8) = (u32x4){pk2(y0.x, y0.y), pk2(y0.z, y0.w), pk2(y1.x, y1.y), pk2(y1.z, y1.w)}; } }
}

struct PoolRegs { u32x4 v[5]; };
__device__ __forceinline__ PoolRegs pool_load(const Frame& F, int unit) {
    PoolRegs R; const int row0 = unit * 64, tid = F.tid;
    const bool isctx = row0 >= NLAT; const int T = isctx ? 256 : 8192, t0 = isctx ? (row0 - NLAT) & 255 : row0 & 8191, rbase = row0 - t0;
    const bf16_t* px = (const bf16_t*)(F.ws + WS_PX);
#pragma unroll
    for (int q = 0; q < 5; ++q) { const int it = tid + q * NTHR, rr = it >> 5, c = it & 31, t = t0 - 8 + rr; R.v[q] = (u32x4){0u, 0u, 0u, 0u};
        if (t >= 0 && t < T) R.v[q] = *(const u32x4*)(px + (size_t)(rbase + t) * INC + C_POOL + c * 8); }
    return R;
}
__device__ __forceinline__ void pool_unit(const Frame& F, int l, int unit, const PoolRegs& R) {
    LAS float* U = (LAS float*)F.lds;
    LAS bf16_t* D = (LAS bf16_t*)(F.lds + 81920);
    const int row0 = unit * 64, tid = F.tid, lane = F.lane, wave = F.wave;
    const bool isctx = row0 >= NLAT; const int T = isctx ? 256 : 8192, t0 = isctx ? (row0 - NLAT) & 255 : row0 & 8191, rbase = row0 - t0;
    const bf16_t* px = (const bf16_t*)(F.ws + WS_PX);
    LDS_BAR();
    {
#pragma unroll
      for (int q = 0; q < 5; ++q) { const int it = tid + q * NTHR, rr = it >> 5, c = it & 31; LAS float* d = U + rr * 256 + c * 8; const u32x4 v = R.v[q];
          *(LAS f32x4*)d = (f32x4){bflo(v.x), bfhi(v.x), bflo(v.y), bfhi(v.y)}; *(LAS f32x4*)(d + 4) = (f32x4){bflo(v.z), bfhi(v.z), bflo(v.w), bfhi(v.w)}; } }
    LDS_BAR();
    { const int c = tid & 255, th = tid >> 8, g = c >> 6, hw = 1 << g, tt0 = th * 32;
      float sacc = 0.f;
      for (int u = tt0 - hw; u < tt0 + hw; ++u) sacc += U[(u + 8) * 256 + c];
#pragma unroll 4
      for (int k = 0; k < 32; ++k) { const int tt = tt0 + k, t = t0 + tt; const int lo = max(t - hw, 0), hi = min(t + hw, T);
          D[tt * 264 + c] = (bf16_t)f2bf(sacc * frcp((float)(hi - lo)) - U[(tt + 8) * 256 + c]);
          sacc += U[(tt + hw + 8) * 256 + c] - U[(tt - hw + 8) * 256 + c]; } }
    LDS_BAR();
    { const int g = wave >> 1, rt = wave & 1, r32 = lane & 31, hi = lane >> 5; bf16_t* yc = (bf16_t*)(F.ws + WS_YC); const float* ps = F.in[I_POOLS] + l * 256;
      for (int nt = 0; nt < 2; ++nt) { f32x16 acc = {}; acc = mma32_lg<4>(acc, D + rt * 32 * 264 + g * 64, 264, (const bf16_t*)(F.ws + W_POOL) + (size_t)(g * 64 + nt * 32) * 64, 64, lane);
          const int col = g * 64 + nt * 32 + r32; const float sc = ps[col];
#pragma unroll
          for (int r = 0; r < 16; ++r) yc[(size_t)(row0 + rt * 32 + crow(r, hi)) * 1024 + 512 + col] = (bf16_t)f2bf(acc[r] * sc); } }
}
__device__ __forceinline__ void conv_z(const bf16_t* p, float (&z)[8]) { const u32x4 u = *(const u32x4*)p, cc = *(const u32x4*)(p + 512);
    z[0] = bflo(u.x) * bflo(cc.x); z[1] = bfhi(u.x) * bfhi(cc.x); z[2] = bflo(u.y) * bflo(cc.y); z[3] = bfhi(u.y) * bfhi(cc.y);
    z[4] = bflo(u.z) * bflo(cc.z); z[5] = bfhi(u.z) * bfhi(cc.z); z[6] = bflo(u.w) * bflo(cc.w); z[7] = bfhi(u.w) * bfhi(cc.w); }
__device__ __forceinline__ void conv_all(const Frame& F, int l, int nrows) {
    const bf16_t* px = (const bf16_t*)(F.ws + WS_PX); bf16_t* yc = (bf16_t*)(F.ws + WS_YC);
    const int c = (F.tid & 31) * 8;
    float w0[8], w1[8], w2[8], cb[8];
#pragma unroll
    for (int e = 0; e < 8; ++e) { w0[e] = F.in[I_CONVW][l * 768 + c + e]; w1[e] = F.in[I_CONVW][l * 768 + 256 + c + e]; w2[e] = F.in[I_CONVW][l * 768 + 512 + c + e]; cb[e] = F.in[I_CONVB][l * 256 + c + e]; }
    for (int it = F.bx * NTHR + F.tid; it < (nrows / 16) * 32; it += F.G * NTHR) { const int row0 = (it >> 5) * 16;
        const bool isctx = row0 >= NLAT; const int T = isctx ? 256 : 8192, t0 = isctx ? (row0 - NLAT) & 255 : row0 & 8191;
        const bf16_t* p = px + (size_t)row0 * INC + C_CONV + c;
        float zp[8], zc[8], zn[8];
        if (t0 > 0) conv_z(p - INC, zp); else {
#pragma unroll
            for (int e = 0; e < 8; ++e) zp[e] = 0.f; }
        conv_z(p, zc);
#pragma unroll 4
        for (int r = 0; r < 16; ++r) { const bf16_t* pr = p + (size_t)r * INC;
            if (t0 + r + 1 < T) conv_z(pr + INC, zn); else {
#pragma unroll
                for (int e = 0; e < 8; ++e) zn[e] = 0.f; }
            const u32x4 bw = *(const u32x4*)(pr + 256); const float bx[8] = {bflo(bw.x), bfhi(bw.x), bflo(bw.y), bfhi(bw.y), bflo(bw.z), bfhi(bw.z), bflo(bw.w), bfhi(bw.w)};
            float y[8];
#pragma unroll
            for (int e = 0; e < 8; ++e) { y[e] = bx[e] * (cb[e] + w0[e] * zp[e] + w1[e] * zc[e] + w2[e] * zn[e]); zp[e] = zc[e]; zc[e] = zn[e]; }
            u32x4 o; o.x = pk2(y[0], y[1]); o.y = pk2(y[2], y[3]); o.z = pk2(y[4], y[5]); o.w = pk2(y[6], y[7]);
            *(u32x4*)(yc + (size_t)(row0 + r) * 1024 + 768 + c) = o; }
    }
}

namespace att {
constexpr int STAGE_B = 40960, KSUB = 12288, VOFF = 24576, VSUB = 8192, LDS_WS = 3 * STAGE_B, LDS_OST = LDS_WS + 2048;
constexpr float THR = 8.0f;
__device__ __forceinline__ void glds16(const void* gsrc, unsigned lds_dst) { unsigned keep;
    asm volatile("s_mov_b32 %0, m0\n\ts_mov_b32 m0, %2\n\ts_nop 0\n\tglobal_load_lds_dwordx4 %1, off\n\ts_mov_b32 m0, %0" : "=&s"(keep) : "v"(gsrc), "s"(lds_dst) : "memory"); }
#define ATT_WAIT_BAR(N) asm volatile("s_waitcnt vmcnt(" #N ") lgkmcnt(0)\n\ts_barrier" ::: "memory")
__device__ __forceinline__ void qkt(f32x16& p0, f32x16& p1, const LAS char* Kslot, const bf16x8* qr, int r32, int hi) {
    const LAS char* kb = Kslot + hi * 1024 + r32 * 16; p0 = f32x16{}; p1 = f32x16{};
#pragma unroll
    for (int d0 = 0; d0 < 6; ++d0) {
        const bf16x8 b0 = *(const LAS bf16x8*)(kb + d0 * 2048), b1 = *(const LAS bf16x8*)(kb + d0 * 2048 + 512);
        p0 = __builtin_amdgcn_mfma_f32_32x32x16_bf16(b0, qr[d0], p0, 0, 0, 0); p1 = __builtin_amdgcn_mfma_f32_32x32x16_bf16(b1, qr[d0], p1, 0, 0, 0); }
}
__device__ __forceinline__ float rowmax(const f32x16& p0, const f32x16& p1) {
    float a = fmaxf(p0[0], p1[0]);
#pragma unroll
    for (int r = 1; r < 16; ++r) a = fmaxf(a, fmaxf(p0[r], p1[r]));
    auto rr = __builtin_amdgcn_permlane32_swap(__float_as_uint(a), __float_as_uint(a), false, false);
    return fmaxf(__uint_as_float(rr[0]), __uint_as_float(rr[1]));
}
__device__ __forceinline__ void pv(f32x16* o, int vb, bf16x8 pa0, bf16x8 pa1, bf16x8 pa2, bf16x8 pa3) {
#pragma unroll
    for (int d0 = 0; d0 < 2; ++d0) { s16x4 lo[4], hi[4];
#pragma unroll
        for (int ks = 0; ks < 4; ++ks) {
            asm volatile("ds_read_b64_tr_b16 %0,%1 offset:%c2" : "=&v"(lo[ks]) : "v"(vb), "i"(d0 * 4096 + ks * 1024) : "memory");
            asm volatile("ds_read_b64_tr_b16 %0,%1 offset:%c2" : "=&v"(hi[ks]) : "v"(vb), "i"(d0 * 4096 + ks * 1024 + 512) : "memory"); }
        asm volatile("s_waitcnt lgkmcnt(0)" ::: "memory"); __builtin_amdgcn_sched_barrier(0);
#define ATT_PK(k) (bf16x8){lo[k][0], lo[k][1], lo[k][2], lo[k][3], hi[k][0], hi[k][1], hi[k][2], hi[k][3]}
        o[d0] = __builtin_amdgcn_mfma_f32_32x32x16_bf16(pa0, ATT_PK(0), o[d0], 0, 0, 0);
        o[d0] = __builtin_amdgcn_mfma_f32_32x32x16_bf16(pa1, ATT_PK(1), o[d0], 0, 0, 0);
        o[d0] = __builtin_amdgcn_mfma_f32_32x32x16_bf16(pa2, ATT_PK(2), o[d0], 0, 0, 0);
        o[d0] = __builtin_amdgcn_mfma_f32_32x32x16_bf16(pa3, ATT_PK(3), o[d0], 0, 0, 0);
#undef ATT_PK
    }
}
__device__ __forceinline__ void unit(const Frame& F, int bh, int qrow, int orow, int nst) {
    const int tid = F.tid, lane = F.lane, wid = F.wave, r32 = lane & 31, hi = lane >> 5, h = bh & 3;
    const unsigned lds0 = (unsigned)(uintptr_t)F.lds;
    const LAS char* ring = (const LAS char*)F.lds;
    LAS float* wsf = (LAS float*)(F.lds + LDS_WS) + wid * 64;
    const char* kg = (const char*)(F.ws + WS_KT) + (size_t)bh * NKT * 12288; const char* vg = (const char*)(F.ws + WS_VT) + (size_t)bh * NKT * 8192;
    const bf16_t* Qw = (const bf16_t*)(F.ws + WS_QB) + (size_t)(qrow + wid * 32) * 384 + h * 96;
#define ATT_DMA(t, slot) do { const char* ks_ = kg + (size_t)(t) * 24576 + wid * 1024 + lane * 16; const char* vs_ = vg + (size_t)(t) * 16384 + wid * 1024 + lane * 16; \
        const unsigned kd_ = lds0 + (slot) * STAGE_B + wid * 1024, vd_ = kd_ + VOFF; \
        glds16(ks_, (unsigned)__builtin_amdgcn_readfirstlane(kd_)); glds16(ks_ + 8192, (unsigned)__builtin_amdgcn_readfirstlane(kd_ + 8192)); glds16(ks_ + 16384, (unsigned)__builtin_amdgcn_readfirstlane(kd_ + 16384)); \
        glds16(vs_, (unsigned)__builtin_amdgcn_readfirstlane(vd_)); glds16(vs_ + 8192, (unsigned)__builtin_amdgcn_readfirstlane(vd_ + 8192)); } while (0)
    ATT_DMA(0, 0); if (nst > 1) ATT_DMA(1, 1);
    bf16x8 qr[6];
#pragma unroll
    for (int d0 = 0; d0 < 6; ++d0) qr[d0] = *(const bf16x8*)(Qw + (size_t)r32 * 384 + d0 * 16 + hi * 8);
    float mhat = 0.f, l_reg = 0.f; f32x16 o[2]; o[0] = f32x16{}; o[1] = f32x16{};
    const int vb0 = (int)lds0 + VOFF + ((lane >> 4) & 1) * 32 + (lane & 3) * 8 + (4 * hi + ((lane & 15) >> 2)) * 64;
    int slot = 0; bool first = true;
    for (int t = 0; t < nst; ++t) {
        if (t + 1 < nst) ATT_WAIT_BAR(5); else ATT_WAIT_BAR(0);
        if (t + 2 < nst) { const int s2 = (slot == 0) ? 2 : slot - 1; ATT_DMA(t + 2, s2); }
#pragma unroll
        for (int s = 0; s < 2; ++s) {
            f32x16 p0, p1; qkt(p0, p1, ring + slot * STAGE_B + s * KSUB, qr, r32, hi);
            const float rm = rowmax(p0, p1);
            if (first) { mhat = rm; first = false; }
            else if (__any(rm - mhat > THR)) { const float dl = fmaxf(rm - mhat, 0.f); mhat += dl; const float f = __builtin_amdgcn_exp2f(-dl); l_reg *= f;
                if (hi == 0) wsf[r32] = f; LDS_WAIT();
#pragma unroll
                for (int r = 0; r < 16; ++r) { const float fr_ = wsf[crow(r, hi)]; o[0][r] *= fr_; o[1][r] *= fr_; } }
            float sacc = 0.f;
#pragma unroll
            for (int r = 0; r < 16; ++r) { p0[r] = __builtin_amdgcn_exp2f(p0[r] - mhat); p1[r] = __builtin_amdgcn_exp2f(p1[r] - mhat); sacc += p0[r] + p1[r]; }
            l_reg += sacc;
            u32x4 pw0, pw1, pw2, pw3;
            pw0 = (u32x4){cvt_pk_bf16(p0[0], p0[1]), cvt_pk_bf16(p0[2], p0[3]), cvt_pk_bf16(p0[4], p0[5]), cvt_pk_bf16(p0[6], p0[7])};
            pw1 = (u32x4){cvt_pk_bf16(p0[8], p0[9]), cvt_pk_bf16(p0[10], p0[11]), cvt_pk_bf16(p0[12], p0[13]), cvt_pk_bf16(p0[14], p0[15])};
            pw2 = (u32x4){cvt_pk_bf16(p1[0], p1[1]), cvt_pk_bf16(p1[2], p1[3]), cvt_pk_bf16(p1[4], p1[5]), cvt_pk_bf16(p1[6], p1[7])};
            pw3 = (u32x4){cvt_pk_bf16(p1[8], p1[9]), cvt_pk_bf16(p1[10], p1[11]), cvt_pk_bf16(p1[12], p1[13]), cvt_pk_bf16(p1[14], p1[15])};
            __builtin_amdgcn_sched_barrier(0);
            pv(o, vb0 + slot * STAGE_B + s * VSUB, __builtin_bit_cast(bf16x8, pw0), __builtin_bit_cast(bf16x8, pw1), __builtin_bit_cast(bf16x8, pw2), __builtin_bit_cast(bf16x8, pw3));
        }
        slot = (slot == 2) ? 0 : slot + 1;
    }
    { auto rr = __builtin_amdgcn_permlane32_swap(__float_as_uint(l_reg), __float_as_uint(l_reg), false, false); l_reg = __uint_as_float(rr[0]) + __uint_as_float(rr[1]); }
    if (hi == 0) wsf[32 + r32] = l_reg; LDS_WAIT();
    float rli[16];
#pragma unroll
    for (int r = 0; r < 16; ++r) rli[r] = frcp(wsf[32 + crow(r, hi)]);
    LAS bf16_t* stg = (LAS bf16_t*)(F.lds + LDS_OST) + wid * 2048;
#pragma unroll
    for (int r = 0; r < 16; ++r) { const int orow_ = crow(r, hi);
#pragma unroll
        for (int d0 = 0; d0 < 2; ++d0) stg[orow_ * 64 + d0 * 32 + r32] = (bf16_t)f2bf(o[d0][r] * rli[r]); }
    LDS_WAIT();
    bf16_t* Ow = (bf16_t*)(F.ws + WS_YC) + (size_t)(orow + wid * 32) * 1024 + 256 + h * 64;
#pragma unroll
    for (int i = 0; i < 4; ++i) { const int row = i * 8 + (lane >> 3), ch = lane & 7; const u32x4 v = *(const LAS u32x4*)(stg + row * 64 + ch * 8); *(u32x4*)(Ow + (size_t)row * 1024 + ch * 8) = v; }
    asm volatile("s_waitcnt lgkmcnt(0)\n\ts_barrier" ::: "memory");
#undef ATT_DMA
}
}

namespace att2 {
constexpr int KSL = 12288, VSL = 8192, LDS_K = 0, LDS_V = 3 * KSL, LDS_WS = LDS_V + 3 * VSL, LDS_OST = LDS_WS + 2048;
#define A2_SBAR() __builtin_amdgcn_sched_barrier(0)
#define A2_WAIT_BAR(N) asm volatile("s_waitcnt vmcnt(" #N ") lgkmcnt(0)\n\ts_barrier" ::: "memory")
__device__ __forceinline__ void glds16s(const void* sbase, unsigned voff, unsigned lds_dst) { unsigned keep;
    asm volatile("s_mov_b32 %0, m0\n\ts_mov_b32 m0, %3\n\ts_nop 4\n\tglobal_load_lds_dwordx4 %1, %2\n\ts_mov_b32 m0, %0" : "=&s"(keep) : "v"(voff), "s"(sbase), "s"(lds_dst) : "memory"); }
__device__ __forceinline__ unsigned cvtpk_s(float lo, float hi) { typedef float f2 __attribute__((ext_vector_type(2))); typedef __bf16 b2 __attribute__((ext_vector_type(2))); f2 v = {lo, hi}; b2 b = __builtin_convertvector(v, b2); return __builtin_bit_cast(unsigned, b); }
typedef short v4i16_t __attribute__((ext_vector_type(4)));
__device__ __forceinline__ s16x4 vtr(const LAS char* p) { return __builtin_bit_cast(s16x4, __builtin_amdgcn_ds_read_tr16_b64_v4i16((LAS v4i16_t*)p)); }
typedef int v8i_t __attribute__((ext_vector_type(8)));
__device__ __forceinline__ v8i_t cat8(u32x4 a, u32x4 b) { return (v8i_t){(int)a.x, (int)a.y, (int)a.z, (int)a.w, (int)b.x, (int)b.y, (int)b.z, (int)b.w}; }
__device__ __forceinline__ v8i_t kfrag8(const LAS char* kp, int i, int hi) { const LAS char* p = kp + ((i & 1) ? 4096 : hi * 2048) + (i >> 1) * 512; return cat8(*(const LAS u32x4*)p, *(const LAS u32x4*)(p + 1024)); }

template <bool NOMAX> __device__ __forceinline__ void unit(const Frame& F, int bh, int qrow, int orow, int NT) {
    const int lane = F.lane, wid = F.wave, r32 = lane & 31, hi = lane >> 5, h = bh & 3;
    const unsigned lds0 = (unsigned)(uintptr_t)F.lds;
    const LAS char* shm3 = (const LAS char*)F.lds;
    LAS float* wsf = (LAS float*)(F.lds + LDS_WS) + wid * 64;
    const char* kg = (const char*)(F.ws + WS_KT) + (size_t)bh * NKT * 6144; const char* vg = (const char*)(F.ws + WS_VT) + (size_t)bh * NKT * 8192 + wid * 1024; const unsigned l16 = lane * 16;
    const unsigned char* Qw = (const unsigned char*)(F.ws + WS_QB) + (size_t)(qrow + wid * 32) * 384 + h * 96;
    const int kp2 = wid < 6 ? wid : wid - 2;
#define A2_DMA_K(t, sl) do { const char* s_ = kg + (size_t)(t) * 6144; const unsigned d_ = lds0 + LDS_K + (sl) * KSL; \
        glds16s(s_ + kp2 * 1024, l16, (unsigned)__builtin_amdgcn_readfirstlane(d_ + kp2 * 1024)); } while (0)
#define A2_MFQ(ki, qi, CI) __builtin_amdgcn_mfma_scale_f32_32x32x64_f8f6f4(kf[ki], qf[qi], CI, 0, 0, 0, 0x7c7c7c7c, 0, 0x7f7f7f7f)
#define A2_DMA_V(t, sl) glds16s(vg + (size_t)(t) * 8192, l16, (unsigned)__builtin_amdgcn_readfirstlane(lds0 + LDS_V + (sl) * VSL + wid * 1024))
    const LAS char* kp0 = shm3 + LDS_K + r32 * 16;
    const LAS char* vp0 = shm3 + LDS_V + ((lane >> 4) & 1) * 32 + (lane & 3) * 8 + (4 * hi + ((lane & 15) >> 2)) * 64;
    v8i_t kf[4];
    A2_DMA_K(0, 0); A2_DMA_V(0, 0); A2_DMA_K(1, 1);
    v8i_t qf[2];
    { const unsigned char* qp = Qw + (size_t)r32 * 384; const u32x4 z4 = {0u, 0u, 0u, 0u};
      qf[0] = cat8(*(const u32x4*)(qp + hi * 32), *(const u32x4*)(qp + hi * 32 + 16));
      const u32x4 c0 = *(const u32x4*)(qp + 64), c1 = *(const u32x4*)(qp + 80); qf[1] = cat8(hi ? z4 : c0, hi ? z4 : c1); }
    float mhat = 0.f, l_reg = 0.f; f32x16 o[2]; o[0] = f32x16{}; o[1] = f32x16{};
    bool resc = false;
    f32x16 pA0, pA1, pB0, pB1;
    int sl_prev = 0, sl_cur = 0, sl_next = 1;
#define A2_ROT() do { sl_prev = sl_cur; sl_cur = sl_next; sl_next = (sl_next == 2) ? 0 : sl_next + 1; } while (0)
#define A2_RESC() do { if (!NOMAX && resc) { asm volatile("s_waitcnt lgkmcnt(0)" ::: "memory"); \
        _Pragma("unroll") for (int d_ = 0; d_ < 2; ++d_) _Pragma("unroll") for (int r = 0; r < 16; ++r) o[d_][r] *= wsf[crow(r, hi)]; } } while (0)
    A2_DMA_K(2, 2);
    A2_WAIT_BAR(5);
    {
#pragma unroll
      for (int i = 0; i < 4; ++i) kf[i] = kfrag8(kp0, i, hi);
      pA0 = A2_MFQ(0, 0, (f32x16{})); pA0 = A2_MFQ(1, 1, pA0); pA1 = A2_MFQ(2, 0, (f32x16{})); pA1 = A2_MFQ(3, 1, pA1);
      if constexpr (!NOMAX) { float a = fmaxf(pA0[0], pA1[0]);
#pragma unroll
      for (int r = 1; r < 16; ++r) a = fmaxf(a, fmaxf(pA0[r], pA1[r]));
      { auto rr = __builtin_amdgcn_permlane32_swap(__float_as_uint(a), __float_as_uint(a), false, false); a = fmaxf(__uint_as_float(rr[0]), __uint_as_float(rr[1])); }
      mhat = a; }
#pragma unroll
      for (int r = 0; r < 16; ++r) { pA0[r] = __builtin_amdgcn_exp2f(pA0[r] - mhat); pA1[r] = __builtin_amdgcn_exp2f(pA1[r] - mhat); } }
    A2_WAIT_BAR(0);
    A2_DMA_K(3, 0); A2_DMA_V(1, 1);
    A2_ROT();
    { const LAS char* kp = kp0 + sl_cur * KSL;
#pragma unroll
      for (int i = 0; i < 4; ++i) kf[i] = kfrag8(kp, i, hi); }
    A2_WAIT_BAR(2);
    s16x4 vlo[8], vhi[8]; u32x4 pw0, pw1, pw2, pw3;
#define A2_PKW(P, B) cvtpk_s(P[B], P[B + 1])
#define A2_PAF(k) __builtin_bit_cast(bf16x8, pw##k)
#define A2_VFR(i) (bf16x8){vlo[i][0], vlo[i][1], vlo[i][2], vlo[i][3], vhi[i][0], vhi[i][1], vhi[i][2], vhi[i][3]}
#define A2_PIN(x) asm volatile("" : "+v"(x))
#define A2_MX3(a, b, c) __builtin_fmaxf(__builtin_fmaxf((a), (b)), (c))
#define A2_GAPA(MF, A0, A1, A2, A3, W0, W1, PW) do { MF; sacc += A0; sacc += A1; sacc += A2; sacc += A3; A2_PIN(sacc); W0; W1; A2_PIN(PW); A2_SBAR(); } while (0)
#define A2_GAPM(MF) do { MF; A2_SBAR(); } while (0)
#define A2_EX(v) __builtin_amdgcn_exp2f(v)
#define A2_SH(v) (NOMAX ? (v) : (v) - mhat)
#define A2_GAPB(MF, X, B) do { MF; X[B] = A2_EX(A2_SH(X[B])); X[B + 1] = A2_EX(A2_SH(X[B + 1])); X[B + 2] = A2_EX(A2_SH(X[B + 2])); X[B + 3] = A2_EX(A2_SH(X[B + 3])); A2_PIN(X); A2_SBAR(); } while (0)
#define A2_VRD(i) do { vlo[i] = vtr(vp_ + (((i) >> 2) * 4096 + ((i) & 3) * 1024)); vhi[i] = vtr(vp_ + (((i) >> 2) * 4096 + ((i) & 3) * 1024 + 512)); } while (0)
#define A2_KRD(G, j) do { if (G) { if ((j) < 4) kf[(j) < 4 ? (j) : 0] = kfrag8(kp0 + sl_next * KSL, (j) < 4 ? (j) : 0, hi); A2_SBAR(); } } while (0)
#define A2_MF(C, kk, qq, CI) C = A2_MFQ(kk, qq, CI)
#define A2_NOP ((void)0)
#define A2_STEP(C0, C1, P0, P1, t, GK, GV, GL) do { A2_SBAR(); \
    const LAS char* vp_ = vp0 + sl_prev * VSL; \
    A2_VRD(0); A2_SBAR(); float sacc = (P0[0] + P0[1]); \
    A2_GAPA(A2_MF(C0, 0, 0, (f32x16{})), P0[2], P0[3], P0[4], P0[5],     pw0[0] = A2_PKW(P0, 0), pw0[1] = A2_PKW(P0, 2), pw0); \
    A2_VRD(4); A2_SBAR(); A2_GAPA(A2_NOP, P0[6], P0[7], P0[8], P0[9],     pw0[2] = A2_PKW(P0, 4), pw0[3] = A2_PKW(P0, 6), pw0); \
    A2_VRD(1); A2_SBAR(); A2_GAPA(A2_MF(C1, 2, 0, (f32x16{})), P0[10], P0[11], P0[12], P0[13], pw1[0] = A2_PKW(P0, 8), pw1[1] = A2_PKW(P0, 10), pw1); \
    A2_VRD(5); A2_SBAR(); A2_GAPA(A2_NOP,   P0[14], P0[15], P1[0], P1[1],   pw1[2] = A2_PKW(P0, 12), pw1[3] = A2_PKW(P0, 14), pw1); \
    A2_VRD(2); A2_SBAR(); A2_GAPA(A2_MF(C0, 1, 1, C0),   P1[2], P1[3], P1[4], P1[5],     pw2[0] = A2_PKW(P1, 0), pw2[1] = A2_PKW(P1, 2), pw2); \
    A2_VRD(6); A2_SBAR(); A2_GAPA(A2_NOP,   P1[6], P1[7], P1[8], P1[9],     pw2[2] = A2_PKW(P1, 4), pw2[3] = A2_PKW(P1, 6), pw2); \
    A2_VRD(3); A2_SBAR(); A2_GAPA(A2_MF(C1, 3, 1, C1),   P1[10], P1[11], P1[12], P1[13], pw3[0] = A2_PKW(P1, 8), pw3[1] = A2_PKW(P1, 10), pw3); \
    A2_VRD(7); A2_SBAR(); A2_GAPA(A2_NOP,   P1[14], P1[15], 0.f, 0.f,       pw3[2] = A2_PKW(P1, 12), pw3[3] = A2_PKW(P1, 14), pw3); \
    l_reg += sacc; \
    if (GK) { A2_DMA_K((t) + 3, sl_cur); } if (GV) { A2_DMA_V((t) + 1, sl_next); } \
    if constexpr (!NOMAX) { float a = A2_MX3(C0[0], C0[1], C1[0]), b = A2_MX3(C0[2], C0[3], C1[1]); a = A2_MX3(a, C1[2], C1[3]); \
      _Pragma("unroll") for (int r = 4; r < 16; r += 4) { a = A2_MX3(a, C0[r], C0[r + 1]); b = A2_MX3(b, C0[r + 2], C0[r + 3]); a = A2_MX3(a, C1[r], C1[r + 1]); b = A2_MX3(b, C1[r + 2], C1[r + 3]); } \
      float rm = __builtin_fmaxf(a, b); { auto rr = __builtin_amdgcn_permlane32_swap(__float_as_uint(rm), __float_as_uint(rm), false, false); rm = __builtin_fmaxf(__uint_as_float(rr[0]), __uint_as_float(rr[1])); } \
      resc = false; \
      if (__builtin_expect(__any(rm - mhat > 8.0f), 0)) { const float dl = __builtin_fmaxf(rm - mhat, 0.f); mhat += dl; \
        const float f = __builtin_amdgcn_exp2f(-dl); l_reg *= f; if (hi == 0) wsf[r32] = f; resc = true; } } \
    A2_SBAR(); \
    A2_GAPB(o[0] = __builtin_amdgcn_mfma_f32_32x32x16_bf16(A2_PAF(0), A2_VFR(0), o[0], 0, 0, 0), C0, 0); \
    A2_KRD(GL, 0); A2_GAPB(o[1] = __builtin_amdgcn_mfma_f32_32x32x16_bf16(A2_PAF(0), A2_VFR(4), o[1], 0, 0, 0), C0, 4); \
    A2_KRD(GL, 1); A2_GAPB(o[0] = __builtin_amdgcn_mfma_f32_32x32x16_bf16(A2_PAF(1), A2_VFR(1), o[0], 0, 0, 0), C0, 8); \
    A2_KRD(GL, 2); A2_GAPB(o[1] = __builtin_amdgcn_mfma_f32_32x32x16_bf16(A2_PAF(1), A2_VFR(5), o[1], 0, 0, 0), C0, 12); \
    A2_KRD(GL, 3); A2_GAPB(o[0] = __builtin_amdgcn_mfma_f32_32x32x16_bf16(A2_PAF(2), A2_VFR(2), o[0], 0, 0, 0), C1, 0); \
    A2_KRD(GL, 4); A2_GAPB(o[1] = __builtin_amdgcn_mfma_f32_32x32x16_bf16(A2_PAF(2), A2_VFR(6), o[1], 0, 0, 0), C1, 4); \
    A2_KRD(GL, 5); A2_GAPB(o[0] = __builtin_amdgcn_mfma_f32_32x32x16_bf16(A2_PAF(3), A2_VFR(3), o[0], 0, 0, 0), C1, 8); \
    A2_GAPB(o[1] = __builtin_amdgcn_mfma_f32_32x32x16_bf16(A2_PAF(3), A2_VFR(7), o[1], 0, 0, 0), C1, 12); \
    } while (0)
    int t = 1;
    for (; t + 5 < NT; t += 2) {
        A2_STEP(pB0, pB1, pA0, pA1, t, true, true, true);     A2_WAIT_BAR(2); A2_RESC(); A2_ROT();
        A2_STEP(pA0, pA1, pB0, pB1, t + 1, true, true, true); A2_WAIT_BAR(2); A2_RESC(); A2_ROT();
    }
#define A2_ENDW(tt) do { if ((tt) + 3 < NT) { A2_WAIT_BAR(2); } else if ((tt) + 2 < NT) { A2_WAIT_BAR(1); } else { A2_WAIT_BAR(0); } } while (0)
    for (; t + 1 < NT; t += 2) {
        A2_STEP(pB0, pB1, pA0, pA1, t, (t + 3 < NT), (t + 1 < NT), (t + 1 < NT));     A2_ENDW(t);     A2_RESC(); A2_ROT();
        A2_STEP(pA0, pA1, pB0, pB1, t + 1, (t + 4 < NT), (t + 2 < NT), (t + 2 < NT)); A2_ENDW(t + 1); A2_RESC(); A2_ROT();
    }
    A2_STEP(pB0, pB1, pA0, pA1, NT - 1, false, false, false); A2_RESC();
    { float sacc = pB0[0] + pB0[1];
#pragma unroll
      for (int r = 2; r < 16; ++r) sacc += pB0[r];
#pragma unroll
      for (int r = 0; r < 16; ++r) sacc += pB1[r];
      l_reg += sacc;
      pw0 = (u32x4){A2_PKW(pB0, 0), A2_PKW(pB0, 2), A2_PKW(pB0, 4), A2_PKW(pB0, 6)}; pw1 = (u32x4){A2_PKW(pB0, 8), A2_PKW(pB0, 10), A2_PKW(pB0, 12), A2_PKW(pB0, 14)};
      pw2 = (u32x4){A2_PKW(pB1, 0), A2_PKW(pB1, 2), A2_PKW(pB1, 4), A2_PKW(pB1, 6)}; pw3 = (u32x4){A2_PKW(pB1, 8), A2_PKW(pB1, 10), A2_PKW(pB1, 12), A2_PKW(pB1, 14)};
      A2_SBAR();
      const int vb = (int)lds0 + LDS_V + ((lane >> 4) & 1) * 32 + (lane & 3) * 8 + (4 * hi + ((lane & 15) >> 2)) * 64 + sl_cur * VSL;
      att::pv(o, vb, A2_PAF(0), A2_PAF(1), A2_PAF(2), A2_PAF(3)); }
    { auto rr = __builtin_amdgcn_permlane32_swap(__float_as_uint(l_reg), __float_as_uint(l_reg), false, false); l_reg = __uint_as_float(rr[0]) + __uint_as_float(rr[1]); }
    if (hi == 0) wsf[32 + r32] = l_reg; LDS_WAIT();
    float rli[16];
#pragma unroll
    for (int r = 0; r < 16; ++r) rli[r] = __builtin_amdgcn_rcpf(wsf[32 + crow(r, hi)]);
    LAS bf16_t* stg = (LAS bf16_t*)(F.lds + LDS_OST) + wid * 2048;
#pragma unroll
    for (int r = 0; r < 16; ++r) { const int orow_ = crow(r, hi);
#pragma unroll
        for (int d0 = 0; d0 < 2; ++d0) stg[orow_ * 64 + d0 * 32 + r32] = (bf16_t)f2bf(o[d0][r] * rli[r]); }
    LDS_WAIT();
    bf16_t* Ow = (bf16_t*)(F.ws + WS_YC) + (size_t)(orow + wid * 32) * 1024 + 256 + h * 64;
#pragma unroll
    for (int i = 0; i < 4; ++i) { const int row = i * 8 + (lane >> 3), ch = lane & 7; const u32x4 v = *(const LAS u32x4*)(stg + row * 64 + ch * 8); *(u32x4*)(Ow + (size_t)row * 1024 + ch * 8) = v; }
    asm volatile("s_waitcnt lgkmcnt(0)\n\ts_barrier" ::: "memory");
}
}

__device__ __forceinline__ void ph_norm2_route(const Frame& F, int l, int ntok) {
    LAS bf16_t* A = (LAS bf16_t*)F.lds;
    LAS float* PART = (LAS float*)(F.lds + 66048);
    LAS float* LOG = (LAS float*)(F.lds + 131584);
    LAS int* HIST = (LAS int*)(F.lds + 139776);
    const int tid = F.tid, lane = F.lane, wave = F.wave, r32 = lane & 31, hi = lane >> 5;
    const int tpb = ntok / F.G, tok0 = F.bx * tpb;
    int* eidx = (int*)(F.ws + T_EIDX); float* ew = (float*)(F.ws + T_EW);
    const float* brt = F.in[I_BRT] + l * 64;
    if (tid < 64) HIST[tid] = 0;
    LAS f32x4* AV = (LAS f32x4*)(F.lds + 140288);
    LAS f32x4* SHV = AV + 512;
    const int mr_first = mod_row_of(tok0), mr_last = mod_row_of(tok0 + tpb - 1);
    { const int set = tid >> 8, idx = tid & 255, mrs = set ? mr_last : mr_first;
      const f32x4 gv = ((const f32x4*)(F.in[I_GFFN] + l * 1024))[idx], scv = ((const f32x4*)modp(F, l, mrs, 4))[idx];
      AV[tid] = gv * (scv + 1.0f); SHV[tid] = ((const f32x4*)modp(F, l, mrs, 3))[idx]; }
    bf16x8 wrt[2][8];
#pragma unroll
    for (int nt = 0; nt < 2; ++nt)
#pragma unroll
        for (int ks = 0; ks < 8; ++ks) wrt[nt][ks] = *(const bf16x8*)((const bf16_t*)(F.ws + W_RT) + (size_t)(nt * 32 + r32) * 1024 + wave * 128 + ks * 16 + hi * 8);
    f32x4 xn[4][4]; u32x2 mn[4][4];
#pragma unroll
    for (int rr = 0; rr < 4; ++rr) { const int t = min(wave * 4 + rr, tpb - 1); const f32x4* xr = (const f32x4*)stream_row(F, l, tok0 + t) + lane; const u32x2* mg = (const u32x2*)((const bf16_t*)(F.ws + WS_YC) + (size_t)(tok0 + t) * 1024) + lane;
#pragma unroll
        for (int j = 0; j < 4; ++j) { xn[rr][j] = xr[64 * j]; mn[rr][j] = mg[64 * j]; } }
    for (int b0 = 0; b0 < tpb; b0 += 32) {
        __syncthreads();
        { f32x4 v[4][4];
#pragma unroll
          for (int rr = 0; rr < 4; ++rr) {
#pragma unroll
                for (int j = 0; j < 4; ++j) { const u32x2 w = mn[rr][j]; v[rr][j] = xn[rr][j] + (f32x4){bflo(w.x), bfhi(w.x), bflo(w.y), bfhi(w.y)}; } }
#pragma unroll
          for (int rr = 0; rr < 4; ++rr) { const int r = wave * 4 + rr, t = b0 + r; LAS u32x2* a = (LAS u32x2*)(A + r * 1032) + lane;
            if (t < tpb) { const int row = tok0 + t, mr = mod_row_of(row); f32x4 y[4];
                f32x4* xo = (f32x4*)((row < NLAT) ? F.out + (size_t)row * 1024 : (float*)(F.ws + WS_CTXS) + (size_t)(row - NLAT) * 1024) + lane;
#pragma unroll
                for (int j = 0; j < 4; ++j) xo[64 * j] = v[rr][j];
                { float s2 = 0.f;
#pragma unroll
                  for (int j = 0; j < 4; ++j) s2 += (v[rr][j].x * v[rr][j].x + v[rr][j].y * v[rr][j].y) + (v[rr][j].z * v[rr][j].z + v[rr][j].w * v[rr][j].w);
                  const float rstd = frsq(wave_sum(s2) * (1.f / 1024.f) + EPS); const int vb = (mr == mr_first ? 0 : 256) + lane;
#pragma unroll
                  for (int j = 0; j < 4; ++j) y[j] = v[rr][j] * rstd * AV[vb + 64 * j] + SHV[vb + 64 * j]; }
                unsigned* o8 = (unsigned*)(F.ws + WS_HX8 + (size_t)row * 1024) + lane;
#pragma unroll
                for (int j = 0; j < 4; ++j) { a[64 * j] = (u32x2){pk2(y[j].x, y[j].y), pk2(y[j].z, y[j].w)}; o8[64 * j] = pk4_fp8(y[j].x, y[j].y, y[j].z, y[j].w); }
            } else {
#pragma unroll
                for (int j = 0; j < 4; ++j) a[64 * j] = (u32x2){0u, 0u}; } } }
        if (b0 + 32 < tpb) {
#pragma unroll
            for (int rr = 0; rr < 4; ++rr) { const int t = min(b0 + 32 + wave * 4 + rr, tpb - 1); const f32x4* xr = (const f32x4*)stream_row(F, l, tok0 + t) + lane; const u32x2* mg = (const u32x2*)((const bf16_t*)(F.ws + WS_YC) + (size_t)(tok0 + t) * 1024) + lane;
#pragma unroll
                for (int j = 0; j < 4; ++j) { xn[rr][j] = xr[64 * j]; mn[rr][j] = mg[64 * j]; } } }
        __syncthreads();
#pragma unroll
        for (int nt = 0; nt < 2; ++nt) { f32x16 acc = {};
#pragma unroll
            for (int ks = 0; ks < 8; ++ks) { const bf16x8 a = *(const LAS bf16x8*)(A + wave * 128 + r32 * 1032 + ks * 16 + hi * 8); acc = __builtin_amdgcn_mfma_f32_32x32x16_bf16(a, wrt[nt][ks], acc, 0, 0, 0); }
#pragma unroll
            for (int r = 0; r < 16; ++r) PART[(wave * 32 + crow(r, hi)) * 64 + nt * 32 + r32] = acc[r]; }
        __syncthreads();
        for (int i = tid; i < 2048; i += NTHR) { float s = 0.f;
#pragma unroll
            for (int w = 0; w < 8; ++w) s += PART[w * 2048 + i];
            LOG[i] = s; }
        __syncthreads();
        for (int rr = 0; rr < 4; ++rr) { const int r = wave * 4 + rr, t = b0 + r; if (t >= tpb) continue;
            const float sc = sigmoidf_(LOG[r * 64 + lane]); float v = sc + brt[lane]; float ssel = 0.f, mys = 0.f; int myi = 0;
#pragma unroll
            for (int k = 0; k < TOPK; ++k) { const float mx = wave_max(v); const unsigned long long bal = __ballot(v == mx); const int win = __ffsll((long long)bal) - 1;
                const float sw = lane_bcast(sc, win); ssel += sw; if (lane == k) { mys = sw; myi = win; } if (lane == win) v = -INFINITY; }
            if (lane < TOPK) { eidx[(size_t)(tok0 + t) * 6 + lane] = myi; ew[(size_t)(tok0 + t) * 6 + lane] = mys * frcp(ssel) * 2.5f; __hip_atomic_fetch_add(&HIST[myi], 1, __ATOMIC_RELAXED, __HIP_MEMORY_SCOPE_WORKGROUP); } }
    }
    __syncthreads();
    if (tid < 64) ((int*)(F.ws + T_HIST))[F.bx * 64 + tid] = HIST[tid];
}

__device__ __forceinline__ void ph_assign(const Frame& F, int ntok) {
    LAS int* BASE = (LAS int*)F.lds; LAS int* CUR = BASE + 64; LAS int* START = BASE + 128; LAS int* TOT = BASE + 192; LAS int* MISC = BASE + 256;
    const int tid = F.tid, hb = F.G, c = 0, tpb = ntok / F.G, ctok0 = 0, ctoks = ntok;
    const int* hist = (const int*)(F.ws + T_HIST); int* rtok = (int*)(F.ws + T_RTOK); float* rw = (float*)(F.ws + T_RW); int* slot = (int*)(F.ws + T_SLOT);
    int* tile_e = (int*)(F.ws + T_TILEE);
    __syncthreads();
    { LAS int* PT = BASE + 512; LAS int* PB = PT + 512;
      const int e = tid & 63, part = tid >> 6; int tot = 0, bef = 0;
#pragma unroll 8
      for (int k = 0; k < 32; ++k) { const int b = c * hb + part * 32 + k; if (b < (c + 1) * hb) { const int v = hist[b * 64 + e]; tot += v; if (b < F.bx) bef += v; } }
      PT[part * 64 + e] = tot; PB[part * 64 + e] = bef; }
    __syncthreads();
    if (tid < 64) { int tot = 0, bef = 0; for (int p8 = 0; p8 < 8; ++p8) { tot += BASE[512 + p8 * 64 + tid]; bef += BASE[1024 + p8 * 64 + tid]; } TOT[tid] = tot; BASE[tid] = bef; CUR[tid] = 0; }
    __syncthreads();
    if (tid == 0) { int s = 0; for (int e = 0; e < 64; ++e) { START[e] = s; s += (TOT[e] + 255) / 256 * 256; } MISC[0] = s; }
    __syncthreads();
    const int sstart = MISC[0];
    const int* eidx = (const int*)(F.ws + T_EIDX); const float* ew = (const float*)(F.ws + T_EW);
    for (int i = tid; i < tpb * 6; i += NTHR) { const int tok = F.bx * tpb + i / 6, k = i % 6; const int e = eidx[(size_t)tok * 6 + k];
        const int pos = START[e] + BASE[e] + __hip_atomic_fetch_add(&CUR[e], 1, __ATOMIC_RELAXED, __HIP_MEMORY_SCOPE_WORKGROUP); rtok[pos] = tok; rw[pos] = ew[(size_t)tok * 6 + k]; slot[(size_t)tok * 8 + k] = pos; }
    for (int i = tid; i < tpb; i += NTHR) { const int tok = F.bx * tpb + i, pos = sstart + (tok - ctok0); rtok[pos] = tok; rw[pos] = 1.0f; slot[(size_t)tok * 8 + 6] = pos; }
    if (F.bx == c * hb) {
        for (int e = 0; e < 64; ++e) { const int p0 = START[e] + TOT[e], p1 = START[e] + (TOT[e] + 255) / 256 * 256;
            for (int p = p0 + tid; p < p1; p += NTHR) { rtok[p] = ctok0; rw[p] = 0.f; }
            for (int tl = START[e] / 256 + tid; tl < p1 / 256; tl += NTHR) tile_e[tl] = e; }
        for (int tl = sstart / 256 + tid; tl < (sstart + ctoks) / 256; tl += NTHR) tile_e[tl] = 64;
        if (tid == 0) tile_e[2047] = (sstart + ctoks) / 256;
    }
}

template <bool FUSE_NORM> __device__ __forceinline__ void ph_combine(const Frame& F, int l, int c, int ntok) {
    const int lane = F.lane; const int tpb = ntok / F.G, tok0 = F.bx * tpb; (void)c;
    const int* slot = (const int*)(F.ws + T_SLOT); const unsigned char* ys = (const unsigned char*)(F.ws + WS_YS);
    int mr_cur = -1; f32x4 gtv[2][2], av[2][2], shv[2][2];
    for (int t = F.wave; t < tpb; t += NWAVES) { const int tok = tok0 + t, mr = mod_row_of(tok);
        if (mr != mr_cur) { mr_cur = mr; const float* gt = modp(F, l, mr, 5);
#pragma unroll
            for (int j = 0; j < 2; ++j)
#pragma unroll
                for (int h2 = 0; h2 < 2; ++h2) { const int c0 = 8 * lane + 512 * j + 4 * h2; gtv[j][h2] = *(const f32x4*)(gt + c0);
                    if constexpr (FUSE_NORM) { const f32x4 gv = *(const f32x4*)(F.in[I_GMIX] + 1024 + c0), scv = *(const f32x4*)(modp(F, 1, mr, 1) + c0); av[j][h2] = gv * (scv + 1.0f); shv[j][h2] = *(const f32x4*)(modp(F, 1, mr, 0) + c0); } } }
        float* xr = (tok < NLAT) ? F.out + (size_t)tok * 1024 : (float*)(F.ws + WS_CTXS) + (size_t)(tok - NLAT) * 1024;
        const int sv = slot[(size_t)tok * 8 + (lane & 7)];
        u32x2 y[7][2];
#pragma unroll
        for (int k = 0; k < 7; ++k) { const int sk = __builtin_amdgcn_readlane(sv, k); const u32x2* yr = (const u32x2*)(ys + (size_t)sk * 1024) + lane; y[k][0] = yr[0]; y[k][1] = yr[64]; }
        f32x4 xv[2][2];
#pragma unroll
        for (int j = 0; j < 2; ++j) { xv[j][0] = *(const f32x4*)(xr + 8 * lane + 512 * j); xv[j][1] = *(const f32x4*)(xr + 8 * lane + 512 * j + 4); }
#pragma unroll
        for (int j = 0; j < 2; ++j) { f32x4 a0 = {0.f, 0.f, 0.f, 0.f}, a1 = {0.f, 0.f, 0.f, 0.f};
#pragma unroll
            for (int k = 0; k < 7; ++k) { a0 += up4_fp8(y[k][j].x); a1 += up4_fp8(y[k][j].y); }
            xv[j][0] = xv[j][0] + gtv[j][0] * a0; xv[j][1] = xv[j][1] + gtv[j][1] * a1;
            *(f32x4*)(xr + 8 * lane + 512 * j) = xv[j][0]; *(f32x4*)(xr + 8 * lane + 512 * j + 4) = xv[j][1]; }
        if constexpr (FUSE_NORM) {
            float ss = 0.f;
#pragma unroll
            for (int j = 0; j < 2; ++j)
#pragma unroll
                for (int h2 = 0; h2 < 2; ++h2) { const f32x4 v = xv[j][h2]; ss += (v.x * v.x + v.y * v.y) + (v.z * v.z + v.w * v.w); }
            const float rstd = frsq(wave_sum(ss) * (1.f / 1024.f) + EPS);
            unsigned char* h8 = F.ws + WS_HX8 + (size_t)tok * 1024;
#pragma unroll
            for (int j = 0; j < 2; ++j) { const int c0 = 8 * lane + 512 * j; f32x4 y[2];
#pragma unroll
                for (int h2 = 0; h2 < 2; ++h2) y[h2] = xv[j][h2] * rstd * av[j][h2] + shv[j][h2];
                *(u32x2*)(h8 + c0) = (u32x2){pk4_fp8(y[0].x, y[0].y, y[0].z, y[0].w), pk4_fp8(y[1].x, y[1].y, y[1].z, y[1].w)}; }
        }
    }
}
__device__ __forceinline__ Frame phase_frame(const Frame& F) {
    Frame Q = F; int t = threadIdx.x; asm volatile("" : "+v"(t)); Q.tid = t; Q.lane = t & 63; Q.wave = __builtin_amdgcn_readfirstlane(t >> 6);
    unsigned long long w = (unsigned long long)F.ws; asm volatile("" : "+s"(w)); Q.ws = (unsigned char*)(GAS unsigned char*)w;
    return Q;
}
constexpr int PH_PER_LAYER = 13, PH_TOTAL = 1 + 2 * PH_PER_LAYER;
__global__ void __launch_bounds__(NTHR, 2) mk_fwd(Params p) {
    extern __shared__ __attribute__((aligned(16))) unsigned char lds_raw[];
    Frame F0;
    F0.lds = (LAS unsigned char*)lds_raw; F0.ws = p.ws; F0.in = p.in; F0.out = p.out;
    F0.tid = threadIdx.x; F0.lane = F0.tid & 63; F0.wave = __builtin_amdgcn_readfirstlane(F0.tid >> 6); F0.bx = blockIdx.x; F0.G = gridDim.x;
    volatile LAS unsigned* MISC = (volatile LAS unsigned*)(F0.lds + MISC_OFF);
    if (F0.tid < 64) MISC[F0.tid] = 0u;
    __syncthreads();
    const int lo = p.ph_lo, hi = p.ph_hi;
    XcdBarrier bar; bar.bar = (unsigned*)(F0.ws + WS_CTL) + CW_BAR; bar.x = 0; bar.st = MISC + 8;
    if (hi - lo > 1) bar = xcd_barrier_post((unsigned*)(F0.ws + WS_CTL) + CW_BAR, MISC + 8);
#ifndef MK_SITE
#define MK_SITE -1
#endif
#define SITE(n) (MK_SITE < 0 || MK_SITE == (n))
#ifndef MK_REP_MASK
#define MK_REP_MASK 0
#endif
#define NREP(n) (((MK_REP_MASK >> (n)) & 1) ? 2 : 1)
#define RUN(k) (lo <= (k) && (k) < hi)
#define SEAM(k) do { if (RUN(k) && RUN((k) + 1)) { TSEC_BEGIN(300, F0.lds); xcd_barrier(bar); TSEC_END(300, F0.lds); } } while (0)
    int ph = 0;
    if (SITE(0) && RUN(ph)) TSEC_BEGIN(400 + 0, F0.lds); if (SITE(0) && RUN(ph)) for (int rep_ = 0; rep_ < NREP(0); ++rep_) { const Frame F = phase_frame(F0); ph_pre(F); }
    TSEC_END(400 + 99, F0.lds); SEAM(ph); ++ph;
    for (int l = 0; l < 2; ++l) {
        const int ntok = (l == 0) ? NTOK : NLAT, nM = ntok / 256;
        if (SITE(1) && RUN(ph)) TSEC_BEGIN(400 + 1, F0.lds); if (SITE(1) && RUN(ph)) for (int rep_ = 0; rep_ < NREP(1); ++rep_) { const Frame F = phase_frame(F0); ph_convert(F, l); __syncthreads(); if (l == 0) ph_norm1(F, l); }
        TSEC_END(400 + 99, F0.lds); SEAM(ph); ++ph;
        if (SITE(2) && RUN(ph)) TSEC_BEGIN(400 + 2, F0.lds); if (SITE(2) && RUN(ph)) for (int rep_ = 0; rep_ < NREP(2); ++rep_) { const Frame F = phase_frame(F0);
            SchedPlain S{(const char*)(F.ws + WS_HX8), (const char*)(F.ws + W_IN), 1024u, 1024u, 8, NTOK / 256, INCP / 256, F.G, F.bx};
            EpiWin E{(bf16_t*)(F.ws + WS_PX), (float*)(F.ws + T_GATE)};
            gg::gemm_phase(F.lds, S, E);
        }
        TSEC_END(400 + 99, F0.lds); SEAM(ph); ++ph;
        if (SITE(3) && RUN(ph)) TSEC_BEGIN(400 + 3, F0.lds); if (SITE(3) && RUN(ph)) for (int rep_ = 0; rep_ < NREP(3); ++rep_) { const Frame F = phase_frame(F0);
            for (int r2 = 0; r2 < NREP(16); ++r2) mla_prep(F, l);
            for (int r2 = 0; r2 < NREP(17); ++r2) { P1Regs R = ml_pass1_load(F, F.bx);
                for (int u = F.bx; u < 64 * NCHK; u += F.G) { const P1Regs Rn = ml_pass1_load(F, (u + F.G < 64 * NCHK) ? u + F.G : u); ml_pass1_unit(F, l, u, R); R = Rn; } }
            for (int r2 = 0; r2 < NREP(18); ++r2) { PoolRegs R = pool_load(F, F.bx);
                for (int u = F.bx; u < ntok / 64; u += F.G) { const PoolRegs Rn = pool_load(F, (u + F.G < ntok / 64) ? u + F.G : u); pool_unit(F, l, u, R); R = Rn; } }
            for (int r2 = 0; r2 < NREP(19); ++r2) conv_all(F, l, ntok);
            __syncthreads();
        }
        TSEC_END(400 + 99, F0.lds); SEAM(ph); ++ph;
        if (SITE(4) && RUN(ph)) TSEC_BEGIN(400 + 4, F0.lds); if (SITE(4) && RUN(ph)) for (int rep_ = 0; rep_ < NREP(4); ++rep_) { const Frame F = phase_frame(F0);
            ml_pass2(F);
            float gq = 0.f, gk = 0.f; for (int d = 0; d < 96; ++d) { gq = fmaxf(gq, fabsf(F.in[I_GQN][l * 96 + d])); gk = fmaxf(gk, fabsf(F.in[I_GKN][l * 96 + d])); }
            const bool nomax = (14.2f * gq * gk <= 64.0f);
            const int nunits = 1024 + (l == 0 ? 32 : 0);
#define ATT_UNITS(NM) for (int i = 0; ; ++i) { const int L = i * F.G + F.bx; if (L >= nunits) break; \
                if (L < 1024) { const int bh = (L >> 8) * 8 + (L & 7), qb = (L & 255) >> 3, b = bh >> 2; att2::unit<NM>(F, bh, b * 8192 + qb * 256, b * 8192 + qb * 256, 132); } \
                else { const int bh = L - 1024, b = bh >> 2; att2::unit<NM>(F, bh, NLAT + b * 256, NLAT + b * 256, 4); } }
            if (nomax) { ATT_UNITS(true) } else { ATT_UNITS(false) }
#undef ATT_UNITS
        }
        TSEC_END(400 + 99, F0.lds); SEAM(ph); ++ph;
        if (SITE(5) && RUN(ph)) TSEC_BEGIN(400 + 5, F0.lds); if (SITE(5) && RUN(ph)) for (int rep_ = 0; rep_ < NREP(5); ++rep_) { const Frame F = phase_frame(F0);
            const int npc = (l == 0) ? 66 : 64, nun = 32 * npc;
            for (int u = F.bx; u < nun; u += F.G) { const int bh = u / npc, pc = u % npc + (l == 0 ? 0 : 2); ml_pass3_unit(F, l, bh >> 2, bh & 3, pc); }
            __syncthreads();
        }
        TSEC_END(400 + 99, F0.lds); SEAM(ph); ++ph;
        {
            const int nMh = nM, pm0 = 0;
            if (SITE(6) && RUN(ph)) TSEC_BEGIN(400 + 6, F0.lds); if (SITE(6) && RUN(ph)) for (int rep_ = 0; rep_ < NREP(6); ++rep_) { const Frame F = phase_frame(F0);
                SchedYB S{(const char*)(F.ws + WS_YC), (const char*)(F.ws + W_BR), pm0, nMh, F.G, F.bx};
                EpiF8Out E{F.ws + WS_YB, 4096};
                gg::gemm_phase(F.lds, S, E);
            }
            TSEC_END(400 + 99, F0.lds); SEAM(ph); ++ph;
            if (SITE(13) && RUN(ph)) TSEC_BEGIN(400 + 13, F0.lds); if (SITE(13) && RUN(ph)) for (int rep_ = 0; rep_ < NREP(13); ++rep_) { const Frame F = phase_frame(F0);
                SchedPlain S{(const char*)(F.ws + WS_HX8) + (size_t)pm0 * 256 * 1024, (const char*)(F.ws + W_GATE), 1024u, 1024u, 8, nMh, 16, F.G, F.bx};
                EpiMerge2 E{(const unsigned char*)(F.ws + WS_YB), F.in[I_BGATE] + l * 4096, F.ws + WS_ACCM + (size_t)pm0 * 256 * 1024, 0};
                gg::gemm_phase(F.lds, S, E);
            }
            TSEC_END(400 + 99, F0.lds); SEAM(ph); ++ph;
        }
        if (SITE(7) && RUN(ph)) TSEC_BEGIN(400 + 7, F0.lds); if (SITE(7) && RUN(ph)) for (int rep_ = 0; rep_ < NREP(7); ++rep_) { const Frame F = phase_frame(F0);
            SchedPlain S{(const char*)(F.ws + WS_ACCM), (const char*)(F.ws + W_OUT), 1024u, 1024u, 8, nM, 4, F.G, F.bx};
            EpiWout E{(bf16_t*)(F.ws + WS_YC), modp(F, l, 0, 2)};
            gg::gemm_phase(F.lds, S, E);
        }
        TSEC_END(400 + 99, F0.lds); SEAM(ph); ++ph;
        if (SITE(8) && RUN(ph)) TSEC_BEGIN(400 + 8, F0.lds); if (SITE(8) && RUN(ph)) for (int rep_ = 0; rep_ < NREP(8); ++rep_) { const Frame F = phase_frame(F0); ph_norm2_route(F, l, ntok); }
        TSEC_END(400 + 99, F0.lds); SEAM(ph); ++ph;
        if (SITE(9) && RUN(ph)) TSEC_BEGIN(400 + 9, F0.lds); if (SITE(9) && RUN(ph)) for (int rep_ = 0; rep_ < NREP(9); ++rep_) { const Frame F = phase_frame(F0); ph_assign(F, ntok); }
        TSEC_END(400 + 99, F0.lds); SEAM(ph); ++ph;
        if (SITE(10) && RUN(ph)) TSEC_BEGIN(400 + 10, F0.lds); if (SITE(10) && RUN(ph)) for (int rep_ = 0; rep_ < NREP(10); ++rep_) { const Frame F = phase_frame(F0);
            int* tile_e = (int*)(F.ws + T_TILEE); const int ntiles = ld_i32_uniform(tile_e + 2047);
            LAS int* tab = (LAS int*)(F.lds + MOE_TAB_OFF); const int* rtok = (const int*)(F.ws + T_RTOK);
            __syncthreads();
            for (int i = 0; i < 28; ++i) { const int L = i * F.G + F.bx; if (L >= ntiles * 2) break; const int tile = L >> 1;
                if (F.tid == 0) tab[i] = tile_e[tile]; if (F.tid < 256) tab[256 + i * 256 + F.tid] = rtok[tile * 256 + F.tid]; }
            __syncthreads();
            SchedMoe1 S{(const char*)(F.ws + WS_HX8), (const char*)(F.ws + W_13), tab, ntiles, F.G, F.bx};
            EpiMoe1 E{F.ws + WS_AMOE, (const float*)(F.ws + T_RW)};
            gg::gemm_phase(F.lds, S, E);
        }
        TSEC_END(400 + 99, F0.lds); SEAM(ph); ++ph;
        if (SITE(11) && RUN(ph)) TSEC_BEGIN(400 + 11, F0.lds); if (SITE(11) && RUN(ph)) for (int rep_ = 0; rep_ < NREP(11); ++rep_) { const Frame F = phase_frame(F0);
            int* tile_e = (int*)(F.ws + T_TILEE); const int ntiles = ld_i32_uniform(tile_e + 2047);
            LAS int* tab = (LAS int*)(F.lds + MOE_TAB_OFF);
            __syncthreads();
            for (int i = F.tid; i < 64; i += NTHR) { const int L = i * F.G + F.bx; if (L < ntiles * 4) tab[i] = tile_e[L >> 2]; }
            __syncthreads();
            SchedMoe2 S{(const char*)(F.ws + WS_AMOE), (const char*)(F.ws + W_2), tab, ntiles, F.G, F.bx};
            EpiF8OutQ E{(unsigned char*)(F.ws + WS_YS), 1024};
            gg::gemm_phase(F.lds, S, E);
        }
        TSEC_END(400 + 99, F0.lds); SEAM(ph); ++ph;
        if (SITE(12) && RUN(ph)) TSEC_BEGIN(400 + 12, F0.lds); if (SITE(12) && RUN(ph)) for (int rep_ = 0; rep_ < NREP(12); ++rep_) { const Frame F = phase_frame(F0); if (l == 0) ph_combine<true>(F, l, 0, ntok); else ph_combine<false>(F, l, 0, ntok); }
        TSEC_END(400 + 99, F0.lds); SEAM(ph); ++ph;
    }
    if (MK_TSEC >= 0 && blockIdx.x == 0 && threadIdx.x == 0) { volatile LAS unsigned long long* q_ = (volatile LAS unsigned long long*)(F0.lds + MISC_OFF + 128);
        const unsigned long long t0 = __builtin_amdgcn_s_memrealtime(), d = q_[0] * 4ull; while (__builtin_amdgcn_s_memrealtime() - t0 < d) __builtin_amdgcn_s_sleep(8); }
#undef RUN
#undef SEAM
}

extern "C" void kernel_launch(void* const* d_in, const int* in_sizes, int n_in, void* d_out, int out_size, void* d_ws, size_t ws_size, hipStream_t stream) {
    static int grid = 0;
    if (grid == 0) {
        if (n_in != 33 || out_size != NLAT * DM || ws_size < WS_END) { fprintf(stderr, "kernel_launch: unexpected shapes (n_in %d, out %d, ws %zu < %zu)\n", n_in, out_size, ws_size, (size_t)WS_END); grid = -1; return; }
        int dev = 0, cus = 0;
        if (hipGetDevice(&dev) != hipSuccess || hipDeviceGetAttribute(&cus, hipDeviceAttributeMultiprocessorCount, dev) != hipSuccess) { grid = -1; return; }
        if (hipFuncSetAttribute((const void*)mk_fwd, hipFuncAttributeMaxDynamicSharedMemorySize, LDS_BYTES) != hipSuccess) { fprintf(stderr, "kernel_launch: hipFuncSetAttribute failed\n"); grid = -1; return; }
        int per_cu = 0;
        if (hipOccupancyMaxActiveBlocksPerMultiprocessor(&per_cu, (const void*)mk_fwd, NTHR, LDS_BYTES) != hipSuccess || per_cu < 1) fprintf(stderr, "kernel_launch: occupancy query says %d\n", per_cu);
        (void)hipGetLastError();
        if (cus < 256) { fprintf(stderr, "kernel_launch: built for a 256-CU device (got %d CUs)\n", cus); grid = -1; return; }
        grid = 256;
    }
    if (grid < 0) return;
    (void)hipMemsetAsync((char*)d_ws + WS_CTL, 0, CTL_ZERO_BYTES, stream);
    Params p{};
    for (int i = 0; i < 33; ++i) p.in[i] = (const float*)d_in[i];
    p.out = (float*)d_out; p.ws = (unsigned char*)d_ws;
#if MK_ONE_LAUNCH
    p.ph_lo = 0; p.ph_hi = PH_TOTAL;
    hipLaunchKernelGGL(mk_fwd, dim3(grid), dim3(NTHR), LDS_BYTES, stream, p);
#else
    for (int k = 0; k < PH_TOTAL; ++k) { p.ph_lo = k; p.ph_hi = k + 1; hipLaunchKernelGGL(mk_fwd, dim3(grid), dim3(NTHR), LDS_BYTES, stream, p); }
#endif
}
```

```cpp
#include <hip/hip_runtime.h>
#include <stdint.h>
#include <stdio.h>
#include <math.h>

#ifndef MK_ONE_LAUNCH
#define MK_ONE_LAUNCH 1
#endif

#define LAS __attribute__((address_space(3)))
#define GAS __attribute__((address_space(1)))
typedef unsigned short bf16_t;
typedef short bf16x8 __attribute__((ext_vector_type(8)));
typedef short s16x4 __attribute__((ext_vector_type(4)));
typedef float f32x2 __attribute__((ext_vector_type(2)));
typedef float f32x4 __attribute__((ext_vector_type(4)));
typedef float f32x16 __attribute__((ext_vector_type(16)));
typedef unsigned u32x2 __attribute__((ext_vector_type(2)));
typedef unsigned u32x4 __attribute__((ext_vector_type(4)));

constexpr int DM = 1024, NB = 8, SEQ = 8192, CTXL = 256, GRIDW = 64;
constexpr int NLAT = NB * SEQ, NCTX = NB * CTXL, NTOK = NLAT + NCTX;
constexpr int INC = 2480, INCP = 2560;
constexpr int C_ML = 0, C_G = 1024, C_MLA = 1040, C_POOL = 1456, C_CONV = 1712;
constexpr int NE = 64, NE1 = 65, TOPK = 6, NSLOT7 = 7, EFF = 256;
constexpr int NCHK = 66;
constexpr int NKT = 132;
constexpr float EPS = 1e-6f;
constexpr int NWAVES = 8, NTHR = 512;
constexpr int MOE_ROWS_MAX = 489472;
constexpr int MOE_TILES_MAX = MOE_ROWS_MAX / 256;

constexpr size_t MiB = 1u << 20;
constexpr size_t WS_CTL = 0, CTL_ZERO_BYTES = 1 * MiB;
constexpr size_t WS_MOD = 128 * 1024;
constexpr size_t WS_TAB = 1 * MiB;
constexpr size_t T_ROPE = WS_TAB;
constexpr size_t T_HIST = T_ROPE + 16384;
constexpr size_t T_TILEE = T_HIST + 65536;
constexpr size_t T_EIDX = T_TILEE + 8192;
constexpr size_t T_EW = T_EIDX + (size_t)NTOK * 6 * 4;
constexpr size_t T_SLOT = T_EW + (size_t)NTOK * 6 * 4;
constexpr size_t T_RTOK = T_SLOT + (size_t)NTOK * 8 * 4;
constexpr size_t T_RW = T_RTOK + (size_t)MOE_ROWS_MAX * 4;
constexpr size_t T_GATE = T_RW + (size_t)MOE_ROWS_MAX * 4;
constexpr size_t T_DN = T_GATE + (size_t)NTOK * 16 * 4;
constexpr size_t T_NST = T_DN + (size_t)4224 * 64 * 4;
constexpr size_t T_MLOC = T_NST + (size_t)4224 * 64 * 4;
constexpr size_t T_BEND = T_MLOC + 4224 * 4;
constexpr size_t T_MST = T_BEND + 4224 * 4;
constexpr size_t T_END = T_MST + 4224 * 4;
static_assert(T_END <= 17 * MiB, "tables");
constexpr size_t WS_WB = 17 * MiB;
constexpr size_t W_IN = WS_WB;
constexpr size_t W_GATE = W_IN + (size_t)INCP * 1024 * 2;
constexpr size_t W_BR = W_GATE + (size_t)4 * 1024 * 1024 * 2;
constexpr size_t W_OUT = W_BR + (size_t)4 * 1024 * 256 * 2;
constexpr size_t W_13 = W_OUT + (size_t)1024 * 1024 * 2;
constexpr size_t W_2 = W_13 + (size_t)NE1 * 512 * 1024 * 2;
constexpr size_t W_UQ = W_2 + (size_t)NE1 * 1024 * 256 * 2;
constexpr size_t W_UKV = W_UQ + (size_t)384 * 256 * 2;
constexpr size_t W_POOL = W_UKV + (size_t)512 * 128 * 2;
constexpr size_t W_RT = W_POOL + (size_t)4 * 64 * 64 * 2;
constexpr size_t W_END = W_RT + (size_t)64 * 1024 * 2;
static_assert(W_END <= 133 * MiB, "weights");
constexpr size_t WS_CTXS = 133 * MiB;
constexpr size_t WS_HX = 141 * MiB;
constexpr size_t WS_PX = 273 * MiB;
constexpr size_t WS_QB = 593 * MiB;
constexpr size_t WS_KT = 643 * MiB;
constexpr size_t WS_VT = 693 * MiB;
constexpr size_t WS_YC = 726 * MiB;
constexpr size_t WS_DC = 858 * MiB;
constexpr size_t WS_CST = 924 * MiB;
constexpr size_t WS_HX8 = 957 * MiB;
constexpr size_t WS_END = 1023 * MiB;
constexpr size_t WS_ACCM = WS_QB;
constexpr size_t WS_YB = WS_PX;
constexpr size_t WS_AMOE = WS_HX;
constexpr size_t WS_YS = WS_HX + 240 * MiB;
static_assert(WS_AMOE + (size_t)MOE_ROWS_MAX * 512 <= WS_YS && WS_YS + (size_t)MOE_ROWS_MAX * 1024 <= WS_HX8, "moe overlay");
static_assert(WS_YB + (size_t)NTOK * 4096 <= WS_QB && WS_ACCM + (size_t)NTOK * 2048 <= WS_YC, "merge overlay");

constexpr int CW_BAR = 4096;

constexpr int RING_BYTES = 131072;
constexpr int MISC_OFF = 160 * 1024 - 256;
constexpr int LDS_BYTES = 160 * 1024;

#ifndef MK_TSEC
#define MK_TSEC -1
#endif
#define TSEC_BEGIN(id, ldsb) do { if (MK_TSEC == (id) && blockIdx.x == 0 && threadIdx.x == 0) { volatile LAS unsigned long long* q_ = (volatile LAS unsigned long long*)((ldsb) + MISC_OFF + 128); q_[1] = __builtin_amdgcn_s_memrealtime(); } } while (0)
#define TSEC_END(id, ldsb) do { if ((MK_TSEC == (id) || ((id) == 499 && MK_TSEC >= 400 && MK_TSEC < 499)) && blockIdx.x == 0 && threadIdx.x == 0) { volatile LAS unsigned long long* q_ = (volatile LAS unsigned long long*)((ldsb) + MISC_OFF + 128); if (q_[1] != 0ull) { q_[0] += __builtin_amdgcn_s_memrealtime() - q_[1]; q_[1] = 0ull; } } } while (0)
typedef __bf16 bf16x2_t_ __attribute__((ext_vector_type(2)));
__device__ __forceinline__ unsigned pk2(float lo, float hi) { const f32x2 v = {lo, hi}; return __builtin_bit_cast(unsigned, __builtin_convertvector(v, bf16x2_t_)); }
__device__ __forceinline__ unsigned f2bf(float f) { return pk2(f, f) & 0xffffu; }
__device__ __forceinline__ float bf2f(unsigned short b) { return __builtin_bit_cast(float, ((unsigned)b) << 16); }
__device__ __forceinline__ float bflo(unsigned w) { return __builtin_bit_cast(float, w << 16); }
__device__ __forceinline__ float bfhi(unsigned w) { return __builtin_bit_cast(float, w & 0xffff0000u); }
__device__ __forceinline__ unsigned cvt_pk_bf16(float lo, float hi) { unsigned r; asm volatile("v_cvt_pk_bf16_f32 %0, %1, %2" : "=v"(r) : "v"(lo), "v"(hi)); return r; }
__device__ __forceinline__ unsigned char f2f8(float a) { return (unsigned char)(__builtin_amdgcn_cvt_pk_fp8_f32(a, a, 0, false) & 0xff); }
__device__ __forceinline__ unsigned pk4_fp8(float a, float b, float c, float d) { int r = __builtin_amdgcn_cvt_pk_fp8_f32(a, b, 0, false); r = __builtin_amdgcn_cvt_pk_fp8_f32(c, d, r, true); return (unsigned)r; }
__device__ __forceinline__ float sigmoidf_(float x) { return __builtin_amdgcn_rcpf(1.0f + __builtin_amdgcn_exp2f(x * -1.4426950408889634f)); }
template <int O> __device__ __forceinline__ float xor_lane(float v) { return __builtin_bit_cast(float, __builtin_amdgcn_ds_swizzle(__builtin_bit_cast(int, v), 0x1f | (O << 10))); }
__device__ __forceinline__ float half_sum(float v) { v += xor_lane<1>(v); v += xor_lane<2>(v); v += xor_lane<4>(v); v += xor_lane<8>(v); v += xor_lane<16>(v); return v; }
__device__ __forceinline__ float half_max(float v) { v = fmaxf(v, xor_lane<1>(v)); v = fmaxf(v, xor_lane<2>(v)); v = fmaxf(v, xor_lane<4>(v)); v = fmaxf(v, xor_lane<8>(v)); v = fmaxf(v, xor_lane<16>(v)); return v; }
__device__ __forceinline__ float wave_sum(float v) { v = half_sum(v); auto rr = __builtin_amdgcn_permlane32_swap(__builtin_bit_cast(unsigned, v), __builtin_bit_cast(unsigned, v), false, false);
    return __builtin_bit_cast(float, (unsigned)rr[0]) + __builtin_bit_cast(float, (unsigned)rr[1]); }
__device__ __forceinline__ float wave_max(float v) { v = half_max(v); auto rr = __builtin_amdgcn_permlane32_swap(__builtin_bit_cast(unsigned, v), __builtin_bit_cast(unsigned, v), false, false);
    return fmaxf(__builtin_bit_cast(float, (unsigned)rr[0]), __builtin_bit_cast(float, (unsigned)rr[1])); }
__device__ __forceinline__ float lane_up(float v, int o, int lane) { return __builtin_bit_cast(float, __builtin_amdgcn_ds_bpermute(((lane - o) & 63) << 2, __builtin_bit_cast(int, v))); }
__device__ __forceinline__ float lane_bcast(float v, int src) { return __builtin_bit_cast(float, __builtin_amdgcn_readlane(__builtin_bit_cast(int, v), src)); }
__device__ __forceinline__ float frcp(float x) { return __builtin_amdgcn_rcpf(x); }
__device__ __forceinline__ float frsq(float x) { return __builtin_amdgcn_rsqf(x); }
#define LDS_WAIT() asm volatile("s_waitcnt lgkmcnt(0)" ::: "memory")
#define LDS_BAR() asm volatile("s_waitcnt lgkmcnt(0)\n\ts_barrier" ::: "memory")
#define VM_WAIT() asm volatile("s_waitcnt vmcnt(0)" ::: "memory")

#define XB_TMO      128
#define XB_XCNT(j)  (256  + 64 * (j))
#define XB_XSUB(j)  (1280 + 64 * (j))
#define XB_XGEN(j)  (2304 + 64 * (j))
#define XB_TOP      3328
#define XB_TOPGEN   3392
#define XCD_BAR_WORDS 3456
#define XB_SPIN_CAP (1u << 22)

__device__ __forceinline__ unsigned xb_ld(unsigned* p)              { return __hip_atomic_load(p, __ATOMIC_RELAXED, __HIP_MEMORY_SCOPE_AGENT); }
__device__ __forceinline__ unsigned xb_add(unsigned* p, unsigned v) { return __hip_atomic_fetch_add(p, v, __ATOMIC_RELAXED, __HIP_MEMORY_SCOPE_AGENT); }
__device__ __forceinline__ unsigned xb_xcc_id() { return (unsigned)__builtin_amdgcn_s_getreg((3 << 11) | 20) & 0xFu; }
#define XB_SPIN(cond, bar) do { unsigned _sp = 0; while (cond) { __builtin_amdgcn_s_sleep(1); \
    if ((++_sp & 255u) == 0u) { if (xb_ld(&(bar)[XB_TMO])) break; if (_sp > XB_SPIN_CAP) { atomicAdd(&(bar)[XB_TMO], 1u); break; } } } } while (0)

struct XcdBarrier { unsigned* bar; unsigned x; volatile LAS unsigned* st; };

__device__ __forceinline__ XcdBarrier xcd_barrier_post(unsigned* bar, volatile LAS unsigned* st) {
    XcdBarrier b; b.bar = bar; b.x = xb_xcc_id(); b.st = st;
    if (threadIdx.x == 0) (void)xb_add(&bar[XB_XCNT(b.x)], 1u);
    return b;
}
__device__ __forceinline__ void xcd_barrier_complete(unsigned* bar, unsigned x, unsigned& nloc, unsigned& nx) {
    const unsigned G = gridDim.x * gridDim.y * gridDim.z;
    unsigned sum, cnt, mine, sp = 0u;
    for (;;) {
        sum = 0u; cnt = 0u; mine = 0u;
#pragma unroll
        for (unsigned j = 0; j < 16; ++j) { const unsigned c = xb_ld(&bar[XB_XCNT(j)]); sum += c; cnt += (c > 0u) ? 1u : 0u; mine = (j == x) ? c : mine; }
        if (sum == G) break;
        __builtin_amdgcn_s_sleep(1);
        if ((++sp & 255u) == 0u) { if (xb_ld(&bar[XB_TMO])) break; if (sp > XB_SPIN_CAP) { atomicAdd(&bar[XB_TMO], 1u); break; } }
    }
    nloc = mine > 0u ? mine : 1u; nx = cnt > 0u ? cnt : 1u;
}
__device__ __forceinline__ void xcd_barrier(const XcdBarrier& b) {
    asm volatile("s_waitcnt vmcnt(0)" ::: "memory");
    __syncthreads();
    if (threadIdx.x == 0) {
        unsigned* bar = b.bar;
        __builtin_amdgcn_s_waitcnt(0);
        unsigned nloc = b.st[0], nx = b.st[1];
        if (nloc == 0u) { xcd_barrier_complete(bar, b.x, nloc, nx); b.st[0] = nloc; b.st[1] = nx; }
        const unsigned old = xb_add(&bar[XB_XSUB(b.x)], 1u);
        const unsigned gen = old / nloc;
        if (old + 1u == (gen + 1u) * nloc) {
            __builtin_amdgcn_fence(__ATOMIC_RELEASE, "agent");
            asm volatile("s_waitcnt vmcnt(0)" ::: "memory");
            const unsigned og = xb_add(&bar[XB_TOP], 1u);
            const unsigned tg = og / nx;
            if (og + 1u == (tg + 1u) * nx) xb_add(&bar[XB_TOPGEN], 1u);
            else XB_SPIN(xb_ld(&bar[XB_TOPGEN]) == tg, bar);
            __builtin_amdgcn_fence(__ATOMIC_ACQUIRE, "agent");
            xb_add(&bar[XB_XGEN(b.x)], 1u);
            asm volatile("s_waitcnt vmcnt(0)" ::: "memory");
        } else {
            XB_SPIN(xb_ld(&bar[XB_XGEN(b.x)]) == gen, bar);
            __builtin_amdgcn_fence(__ATOMIC_ACQUIRE, "agent");
            asm volatile("s_waitcnt vmcnt(0)" ::: "memory");
        }
    }
    __syncthreads();
}

struct Params { const float* in[33]; float* out; unsigned char* ws; int ph_lo, ph_hi; };

struct Frame {
    LAS unsigned char* lds;
    unsigned char* ws;
    const float* const* in;
    float* out;
    int tid, lane, wave, bx, G;
};
enum { I_X = 0, I_C, I_CTX, I_CCTX, I_WMOD, I_BMOD, I_GMIX, I_GFFN, I_WIN, I_MLGB, I_MLHG, I_GCQ, I_GCKV, I_WUQ, I_WUKV, I_GQN, I_GKN, I_POOLW, I_POOLS,
       I_CONVW, I_CONVB, I_WGATE, I_BGATE, I_WBR, I_WOUT, I_WRT, I_BRT, I_W1, I_W3, I_W2, I_WS1, I_WS3, I_WS2 };

__device__ __forceinline__ const float* modp(const Frame& F, int l, int r, int which) { return (const float*)(F.ws + WS_MOD) + ((size_t)(l * 9 + r)) * 6144 + which * 1024; }
__device__ __forceinline__ int mod_row_of(int row) { return row < NLAT ? (row >> 13) : 8; }

__device__ __forceinline__ f32x4 up4_fp8(unsigned w) { const f32x2 lo = __builtin_amdgcn_cvt_pk_f32_fp8((int)w, false), hi = __builtin_amdgcn_cvt_pk_f32_fp8((int)w, true); return (f32x4){lo.x, lo.y, hi.x, hi.y}; }
namespace gg {
typedef int v4i_t __attribute__((ext_vector_type(4)));
constexpr int BM = 256, BK = 64, HALF = 128, HTB = HALF * BK * 2, STAGE_BYTES = 8 * HTB;
__device__ __forceinline__ int lds_byte(int r, int c) { const int st = (r >> 4) * 2 + (c >> 5), rr = r & 15, cc = c & 31, ob = rr * 64 + cc * 2; return st * 1024 + (ob ^ (((ob >> 9) & 1) << 5)); }
__device__ __forceinline__ void stage_rc(int b, int& R, int& C) { const int st = b / 1024, sb = b % 1024, swz = sb ^ (((sb >> 9) & 1) << 5); R = (st >> 1) * 16 + swz / 64; C = (st & 1) * 32 + (swz % 64) / 2; }
__device__ __forceinline__ int perm32(int rho) { const int n = rho >> 4, i = rho & 15; return 8 * (i >> 2) + 4 * n + (i & 3); }
__device__ __forceinline__ int perm16(int R) { return 64 * (R >> 5) + 16 * ((R >> 2) & 3) + 4 * ((R >> 4) & 1) + (R & 3); }

struct Unit {
    const char* A; const char* B;
    unsigned lda, ldb;
    int nt;
    int ridx_off;
    int p0, p1, p2;
};

template <class E, class = void> struct Perm16 { static constexpr bool v = false; };
template <class E> struct Perm16<E, decltype((void)E::PERM16)> { static constexpr bool v = E::PERM16; };
template <class E, class = void> struct ZPeel { static constexpr bool v = false; };
template <class E> struct ZPeel<E, decltype((void)E::ZPEEL)> { static constexpr bool v = E::ZPEEL; };
template <class Epi, class Sched>
__device__ __forceinline__ void gemm_phase(LAS unsigned char* lds, const Sched& S, const Epi& E) {
    int tid_ = threadIdx.x; asm volatile("" : "+v"(tid_));
    const int tid = tid_, wid = __builtin_amdgcn_readfirstlane(tid >> 6), lane = tid & 63, wr = wid >> 2, wc = wid & 3, fr = lane & 15, fq = lane >> 4;
    const size_t kstep = (size_t)(BK * 2);
    const unsigned ldsw = (unsigned)wid * 1024u;
    const int aoff = lds_byte(wr * 64 + fr, fq * 8), boff = lds_byte(wc * 32 + fr, fq * 8);
#define GG_SA(b, h) (((b) * 2 + (h)) * HTB)
#define GG_SB(b, h) ((4 + (b) * 2 + (h)) * HTB)
#define GG_STAGE(bufoff, gbase, v0, v1) do { \
        __builtin_amdgcn_global_load_lds((const unsigned*)((const char*)(gbase) + (v0)), (LAS unsigned*)(lds + (bufoff) + ldsw), 16, 0, 0); \
        __builtin_amdgcn_global_load_lds((const unsigned*)((const char*)(gbase) + (v1)), (LAS unsigned*)(lds + (bufoff) + ldsw + 8192), 16, 0, 0); } while (0)
#define GG_LDA(dst, b, h) do { _Pragma("unroll") for (int m = 0; m < 4; ++m) _Pragma("unroll") for (int k = 0; k < 2; ++k) dst[m][k] = *(const LAS bf16x8*)(lds + GG_SA(b, h) + aoff + m * 2048 + k * 1024); } while (0)
#define GG_LDB(dst, b, h) do { _Pragma("unroll") for (int n = 0; n < 2; ++n) _Pragma("unroll") for (int k = 0; k < 2; ++k) dst[n][k] = *(const LAS bf16x8*)(lds + GG_SB(b, h) + boff + n * 2048 + k * 1024); } while (0)
#define GG_MMA(ai, bj, At, Bt) do { __builtin_amdgcn_s_setprio(1); _Pragma("unroll") for (int m = 0; m < 4; ++m) _Pragma("unroll") for (int n = 0; n < 2; ++n) _Pragma("unroll") for (int k = 0; k < 2; ++k) \
        acc[ai][bj][m][n] = __builtin_amdgcn_mfma_f32_16x16x32_bf16(Bt[n][k], At[m][k], acc[ai][bj][m][n], 0, 0, 0); __builtin_amdgcn_s_setprio(0); } while (0)
#define GG_CAT8(x, y) __builtin_shufflevector(__builtin_bit_cast(v4i_t, x), __builtin_bit_cast(v4i_t, y), 0, 1, 2, 3, 4, 5, 6, 7)
#define GG_MMA8(ai, bj, At, Bt) do { __builtin_amdgcn_s_setprio(1); _Pragma("unroll") for (int m = 0; m < 4; ++m) _Pragma("unroll") for (int n = 0; n < 2; ++n) \
        acc[ai][bj][m][n] = __builtin_amdgcn_mfma_scale_f32_16x16x128_f8f6f4(GG_CAT8(Bt[n][0], Bt[n][1]), GG_CAT8(At[m][0], At[m][1]), acc[ai][bj][m][n], 0, 0, 0, (int)Epi::SCB, 0, 0x7f7f7f7f); __builtin_amdgcn_s_setprio(0); } while (0)
#define GG_MM(ai, bj, At, Bt) do { if constexpr (Epi::FP8) GG_MMA8(ai, bj, At, Bt); else GG_MMA(ai, bj, At, Bt); } while (0)
#define GG_MMZ8(ai, bj, At, Bt) do { __builtin_amdgcn_s_setprio(1); _Pragma("unroll") for (int m = 0; m < 4; ++m) _Pragma("unroll") for (int n = 0; n < 2; ++n) \
        acc[ai][bj][m][n] = __builtin_amdgcn_mfma_scale_f32_16x16x128_f8f6f4(GG_CAT8(Bt[n][0], Bt[n][1]), GG_CAT8(At[m][0], At[m][1]), (f32x4){0.f, 0.f, 0.f, 0.f}, 0, 0, 0, (int)Epi::SCB, 0, 0x7f7f7f7f); __builtin_amdgcn_s_setprio(0); } while (0)
#define GG_MM1(ai, bj, At, Bt) do { if constexpr (ZP && Epi::FP8) { if (t == 0) GG_MMZ8(ai, bj, At, Bt); else GG_MMA8(ai, bj, At, Bt); } else GG_MM(ai, bj, At, Bt); } while (0)
#define GG_WAIT_V(n) asm volatile("s_waitcnt vmcnt(" #n ")" ::: "memory")
#define GG_WAIT_L(n) asm volatile("s_waitcnt lgkmcnt(" #n ")" ::: "memory")
#define GG_BAR __builtin_amdgcn_s_barrier()
#define GG_SCHED __builtin_amdgcn_sched_barrier(0)
#define GG_OFFS(u) do { int R0_, C0_, R1_, C1_; stage_rc(tid * 16, R0_, C0_); stage_rc(tid * 16 + 8192, R1_, C1_); \
        if (Sched::GATHER) { const LAS int* rl_ = (const LAS int*)(lds + (u).ridx_off); vA0 = (unsigned)rl_[R0_] * (u).lda + C0_ * 2; vA1 = (unsigned)rl_[R1_] * (u).lda + C1_ * 2; \
                             vA2 = (unsigned)rl_[128 + R0_] * (u).lda + C0_ * 2; vA3 = (unsigned)rl_[128 + R1_] * (u).lda + C1_ * 2; hA = 0; } \
        else { vA0 = (unsigned)R0_ * (u).lda + C0_ * 2; vA1 = (unsigned)R1_ * (u).lda + C1_ * 2; vA2 = vA0; vA3 = vA1; hA = (size_t)128 * (u).lda; } \
        const int Rb0_ = Perm16<Epi>::v ? perm16(R0_) : (Epi::PERM ? ((R0_ & ~31) + perm32(R0_ & 31)) : R0_), Rb1_ = Perm16<Epi>::v ? perm16(R1_) : (Epi::PERM ? ((R1_ & ~31) + perm32(R1_ & 31)) : R1_); \
        vB0 = (unsigned)Rb0_ * (u).ldb + C0_ * 2; vB1 = (unsigned)Rb1_ * (u).ldb + C1_ * 2; hB = (size_t)(Perm16<Epi>::v ? 8 : 128) * (u).ldb; } while (0)
    Unit cur, nxt; int ui = 0;
    if (!S.next(0, cur)) return;
    constexpr bool ZP = ZPeel<Epi>::v;
    f32x4 acc[2][2][4][2];
    if constexpr (!ZP) {
#pragma unroll
    for (int a = 0; a < 2; ++a)
#pragma unroll
        for (int b = 0; b < 2; ++b)
#pragma unroll
            for (int m = 0; m < 4; ++m)
#pragma unroll
                for (int n = 0; n < 2; ++n) acc[a][b][m][n] = (f32x4){0.f, 0.f, 0.f, 0.f};
    }
    bf16x8 At[4][2], B0[2][2], B1[2][2];
    unsigned vA0, vA1, vA2, vA3, vB0, vB1; size_t hA, hB;
    GG_OFFS(cur);
    const char* cA = cur.A; const char* cB = cur.B;
    GG_STAGE(GG_SB(0, 0), cB, vB0, vB1); GG_STAGE(GG_SB(0, 1), cB + hB, vB0, vB1); GG_STAGE(GG_SA(0, 0), cA, vA0, vA1); GG_STAGE(GG_SA(0, 1), cA + hA, vA2, vA3);
    if (wr == 1) GG_BAR;
    GG_WAIT_V(2); GG_BAR;
    GG_STAGE(GG_SB(1, 0), cB + kstep, vB0, vB1); GG_STAGE(GG_SA(1, 0), cA + kstep, vA0, vA1); GG_STAGE(GG_SB(1, 1), cB + hB + kstep, vB0, vB1);
    GG_WAIT_V(6); GG_BAR;
    for (;;) {
        const bool has_next = S.next(ui + 1, nxt);
        TSEC_BEGIN(100 + Epi::TID, lds);
        int nt_ = cur.nt; asm volatile("" : "+s"(nt_)); const int nt = nt_;
#pragma unroll 1
        for (int t = 0; t < nt; t += 2) {
            const bool last = (t == nt - 2);
            const char* a1 = cA + (size_t)(t + 1) * kstep;
            GG_LDB(B0, 0, 0); GG_LDB(B1, 0, 1); GG_SCHED; GG_LDA(At, 0, 0); GG_STAGE(GG_SA(1, 1), a1 + hA, vA2, vA3);
            GG_WAIT_V(8); GG_WAIT_L(0); GG_BAR; GG_MM1(0, 0, At, B0); GG_MM1(0, 1, At, B1); GG_BAR; GG_SCHED;
            if (last) { if (has_next) { GG_OFFS(nxt); cA = nxt.A - (size_t)nt * kstep; cB = nxt.B - (size_t)nt * kstep; } else { cA -= (size_t)nt * kstep; cB -= (size_t)nt * kstep; } }
            const char* a2 = cA + (size_t)(t + 2) * kstep; const char* b2 = cB + (size_t)(t + 2) * kstep; const char* a3 = a2 + kstep; const char* b3 = b2 + kstep;
            GG_LDA(At, 0, 1); GG_STAGE(GG_SB(0, 0), b2, vB0, vB1); GG_STAGE(GG_SB(0, 1), b2 + hB, vB0, vB1); GG_STAGE(GG_SA(0, 0), a2, vA0, vA1);
            GG_WAIT_V(8); GG_WAIT_L(0); GG_BAR; GG_MM1(1, 0, At, B0); GG_MM1(1, 1, At, B1); GG_BAR; GG_SCHED;
            GG_LDB(B0, 1, 0); GG_LDB(B1, 1, 1); GG_SCHED; GG_LDA(At, 1, 0); GG_STAGE(GG_SA(0, 1), a2 + hA, vA2, vA3);
            GG_WAIT_V(8); GG_WAIT_L(0); GG_BAR; GG_MM(0, 0, At, B0); GG_MM(0, 1, At, B1); GG_BAR; GG_SCHED;
            GG_LDA(At, 1, 1); GG_STAGE(GG_SB(1, 0), b3, vB0, vB1); GG_STAGE(GG_SB(1, 1), b3 + hB, vB0, vB1); GG_STAGE(GG_SA(1, 0), a3, vA0, vA1);
            GG_WAIT_V(8); GG_WAIT_L(0); GG_BAR; GG_MM(1, 0, At, B0); GG_MM(1, 1, At, B1); GG_BAR; GG_SCHED;
        }
        cA += (size_t)nt * kstep; cB += (size_t)nt * kstep;
        TSEC_END(100 + Epi::TID, lds);
        if (wr == 0) GG_BAR;
        TSEC_BEGIN(200 + Epi::TID, lds); { int t2_ = threadIdx.x; asm volatile("" : "+v"(t2_)); E(acc, cur, wr, wc, t2_ & 15, (t2_ & 63) >> 4); } TSEC_END(200 + Epi::TID, lds);
        if (!has_next) break;
        if constexpr (!ZP)
#pragma unroll
        for (int a = 0; a < 2; ++a)
#pragma unroll
            for (int b = 0; b < 2; ++b)
#pragma unroll
                for (int m = 0; m < 4; ++m)
#pragma unroll
                    for (int n = 0; n < 2; ++n) acc[a][b][m][n] = (f32x4){0.f, 0.f, 0.f, 0.f};
        cur = nxt; ++ui;
        if (wr == 1) GG_BAR;
    }
    GG_WAIT_V(0);
    GG_BAR;
#undef GG_SA
#undef GG_SB
#undef GG_STAGE
#undef GG_LDA
#undef GG_LDB
#undef GG_MMA
#undef GG_MMA8
#undef GG_MM
#undef GG_MM1
#undef GG_MMZ8
#undef GG_CAT8
#undef GG_WAIT_V
#undef GG_WAIT_L
#undef GG_BAR
#undef GG_SCHED
#undef GG_OFFS
}
}

__device__ __forceinline__ int ld_i32_uniform(const int* p) { return __builtin_amdgcn_readfirstlane(__hip_atomic_load(p, __ATOMIC_RELAXED, __HIP_MEMORY_SCOPE_AGENT)); }
__device__ __forceinline__ void tile_order(int L, int nM, int nN, int& pm, int& pn) {
    const int nwg = nM * nN; int wgid = L;
    { const int q = nwg / 8, r = nwg % 8, xcd = wgid % 8, off = wgid / 8; wgid = (xcd < r ? xcd * (q + 1) : r * (q + 1) + (xcd - r) * q) + off; }
    const int nig = 8 * nN, gid = wgid / nig, fm = gid * 8, gsz = (nM - fm) < 8 ? (nM - fm) : 8;
    pm = fm + ((wgid % nig) % gsz); pn = (wgid % nig) / gsz;
}
struct SchedPlain {
    static constexpr bool GATHER = false;
    const char* A; const char* B; unsigned lda, ldb; int nt, nM, nN, G, c;
    __device__ __forceinline__ bool next(int i, gg::Unit& u) const {
        const int L = i * G + c; if (L >= nM * nN) return false;
        int pm, pn; tile_order(L, nM, nN, pm, pn);
        u.A = A + (size_t)pm * 256 * lda; u.B = B + (size_t)pn * 256 * ldb; u.lda = lda; u.ldb = ldb; u.nt = nt; u.ridx_off = 0; u.p0 = pm; u.p1 = pn; u.p2 = 0; return true;
    }
};
struct EpiWin {
    static constexpr bool PERM = true, FP8 = true; static constexpr int TID = 0; static constexpr unsigned SCB = 0x79797979u;
    bf16_t* px; float* gate;
    __device__ __forceinline__ void operator()(const f32x4 (&acc)[2][2][4][2], const gg::Unit& u, int wr, int wc, int fr, int fq) const {
        const int row0 = u.p0 * 256 + wr * 64 + fr;
#pragma unroll
        for (int bj = 0; bj < 2; ++bj) {
            const int c0 = u.p1 * 256 + bj * 128 + wc * 32 + 8 * fq;
            if (c0 < INC) {
                const bool isg = (c0 >= C_G && c0 < C_MLA);
#pragma unroll
                for (int ai = 0; ai < 2; ++ai)
#pragma unroll
                    for (int m = 0; m < 4; ++m) { const int row = row0 + ai * 128 + m * 16; const f32x4 v0 = acc[ai][bj][m][0], v1 = acc[ai][bj][m][1];
                        u32x4 w; w.x = cvt_pk_bf16(v0[0], v0[1]); w.y = cvt_pk_bf16(v0[2], v0[3]); w.z = cvt_pk_bf16(v1[0], v1[1]); w.w = cvt_pk_bf16(v1[2], v1[3]);
                        *(u32x4*)(px + (size_t)row * INC + c0) = w;
                        if (isg) { float* gp = gate + (size_t)row * 16 + (c0 - C_G); *(f32x4*)gp = v0; *(f32x4*)(gp + 4) = v1; } }
            }
        }
    }
};
struct SchedYB {
    static constexpr bool GATHER = false;
    const char* yc; const char* wb; int pm0, nMh, G, c;
    __device__ __forceinline__ bool next(int i, gg::Unit& u) const {
        const int L = i * G + c; if (L >= nMh * 16) return false;
        int pm, q; tile_order(L, nMh, 16, pm, q); const int br = q >> 2, pn = q & 3;
        u.A = yc + (size_t)(pm0 + pm) * 256 * 2048 + br * 512; u.lda = 2048; u.B = wb + (size_t)br * (1024 * 512) + (size_t)pn * 256 * 512; u.ldb = 512; u.nt = 4; u.ridx_off = 0; u.p0 = pm; u.p1 = q; u.p2 = 0; return true;
    }
};
struct EpiMerge2 {
    static constexpr bool PERM = false, FP8 = true; static constexpr int TID = 4; static constexpr unsigned SCB = 0x79797979u;
    const unsigned char* yb; const float* bgate; unsigned char* accm; int pm0;
    __device__ __forceinline__ void operator()(const f32x4 (&acc)[2][2][4][2], const gg::Unit& u, int wr, int wc, int fr, int fq) const {
        const int c = u.p1 * 64 + 16 * wc + 4 * fq, r0 = wr * 64 + fr;
        constexpr float NL2E = -1.4426950408889634f;
        f32x4 bv[2][2];
#pragma unroll
        for (int bj = 0; bj < 2; ++bj)
#pragma unroll
            for (int n = 0; n < 2; ++n) bv[bj][n] = *(const f32x4*)(bgate + (2 * bj + n) * 1024 + c) * NL2E;
        u32x4 yw[2][4];
#pragma unroll
        for (int ai = 0; ai < 2; ++ai)
#pragma unroll
            for (int m = 0; m < 4; ++m) { const unsigned char* yr = yb + (size_t)((u.p0 - pm0) * 256 + r0 + ai * 128 + m * 16) * 4096 + c;
                yw[ai][m] = (u32x4){*(const unsigned*)yr, *(const unsigned*)(yr + 1024), *(const unsigned*)(yr + 2048), *(const unsigned*)(yr + 3072)}; }
#pragma unroll
        for (int ai = 0; ai < 2; ++ai) {
#pragma unroll
            for (int m = 0; m < 4; ++m) {
                f32x4 t = {0.f, 0.f, 0.f, 0.f};
#pragma unroll
                for (int bj = 0; bj < 2; ++bj)
#pragma unroll
                    for (int n = 0; n < 2; ++n) { const f32x4 y = up4_fp8(yw[ai][m][2 * bj + n]); const f32x4 x = acc[ai][bj][m][n] * NL2E + bv[bj][n];
                        const f32x4 d = (f32x4){__builtin_amdgcn_exp2f(x[0]), __builtin_amdgcn_exp2f(x[1]), __builtin_amdgcn_exp2f(x[2]), __builtin_amdgcn_exp2f(x[3])} + 1.0f;
                        t += (f32x4){__builtin_amdgcn_rcpf(d[0]), __builtin_amdgcn_rcpf(d[1]), __builtin_amdgcn_rcpf(d[2]), __builtin_amdgcn_rcpf(d[3])} * y; }
                *(unsigned*)(accm + (size_t)(u.p0 * 256 + r0 + ai * 128 + m * 16) * 1024 + c) = pk4_fp8(t[0], t[1], t[2], t[3]); } }
    }
};
struct EpiWout {
    static constexpr bool PERM = true, FP8 = true; static constexpr int TID = 1; static constexpr unsigned SCB = 0x79797979u;
    bf16_t* mrg; const float* gt;
    __device__ __forceinline__ void operator()(const f32x4 (&acc)[2][2][4][2], const gg::Unit& u, int wr, int wc, int fr, int fq) const {
        const int pm = u.p0; const int mrow = pm >= 256 ? 8 : (pm >> 5);
        const float* g = gt + (size_t)mrow * 6144;
        const int row0 = pm * 256 + wr * 64 + fr, col0 = u.p1 * 256 + wc * 32 + 8 * fq;
#pragma unroll
        for (int bj = 0; bj < 2; ++bj) { const f32x4 g0 = *(const f32x4*)(g + col0 + bj * 128), g1 = *(const f32x4*)(g + col0 + bj * 128 + 4);
#pragma unroll
            for (int ai = 0; ai < 2; ++ai)
#pragma unroll
                for (int m = 0; m < 4; ++m) { const f32x4 v0 = acc[ai][bj][m][0] * g0, v1 = acc[ai][bj][m][1] * g1;
                    u32x4 w; w.x = cvt_pk_bf16(v0[0], v0[1]); w.y = cvt_pk_bf16(v0[2], v0[3]); w.z = cvt_pk_bf16(v1[0], v1[1]); w.w = cvt_pk_bf16(v1[2], v1[3]);
                    *(u32x4*)(mrg + (size_t)(row0 + ai * 128 + m * 16) * 1024 + col0 + bj * 128) = w; } }
    }
};
constexpr int MOE_TAB_OFF = RING_BYTES, MOE_RIDX_OFF = RING_BYTES + 1024;
struct SchedMoe1 {
    static constexpr bool GATHER = true;
    const char* hx2; const char* w13; const LAS int* tab; int ntiles, G, c;
    __device__ __forceinline__ bool next(int i, gg::Unit& u) const {
        const int L = i * G + c; if (L >= ntiles * 2) return false;
        const int tile = L >> 1, pn = L & 1, e = __builtin_amdgcn_readfirstlane(tab[i]);
        u.A = hx2; u.lda = 1024; u.ridx_off = MOE_RIDX_OFF + i * 1024; u.B = w13 + (size_t)e * (512 * 1024) + (size_t)pn * 256 * 1024; u.ldb = 1024; u.nt = 8; u.p0 = tile; u.p1 = pn; u.p2 = e; return true;
    }
};
struct EpiMoe1 {
    static constexpr bool PERM = true, FP8 = true; static constexpr int TID = 5; static constexpr unsigned SCB = 0x79797979u;
    unsigned char* a; const float* roww;
    __device__ __forceinline__ void operator()(const f32x4 (&acc)[2][2][4][2], const gg::Unit& u, int wr, int wc, int fr, int fq) const {
        const int row0 = u.p0 * 256 + wr * 64 + fr, col = u.p1 * 128 + wc * 32 + 8 * fq;
        float rwv[2][4];
#pragma unroll
        for (int ai = 0; ai < 2; ++ai)
#pragma unroll
            for (int m = 0; m < 4; ++m) rwv[ai][m] = roww[row0 + ai * 128 + m * 16] * 2.0f;
#pragma unroll
        for (int ai = 0; ai < 2; ++ai)
#pragma unroll
            for (int m = 0; m < 4; ++m) { const int row = row0 + ai * 128 + m * 16; f32x4 t[2];
#pragma unroll
                for (int n = 0; n < 2; ++n) { const f32x4 g1 = acc[ai][0][m][n], x = g1 * -1.4426950408889634f;
                    const f32x4 d = (f32x4){__builtin_amdgcn_exp2f(x[0]), __builtin_amdgcn_exp2f(x[1]), __builtin_amdgcn_exp2f(x[2]), __builtin_amdgcn_exp2f(x[3])} + 1.0f;
                    t[n] = (g1 * acc[ai][1][m][n] * rwv[ai][m]) * (f32x4){__builtin_amdgcn_rcpf(d[0]), __builtin_amdgcn_rcpf(d[1]), __builtin_amdgcn_rcpf(d[2]), __builtin_amdgcn_rcpf(d[3])}; }
                *(u32x2*)(a + (size_t)row * 256 + col) = (u32x2){pk4_fp8(t[0][0], t[0][1], t[0][2], t[0][3]), pk4_fp8(t[1][0], t[1][1], t[1][2], t[1][3])}; }
    }
};
struct SchedMoe2 {
    static constexpr bool GATHER = false;
    const char* a; const char* w2; const LAS int* tab; int ntiles, G, c;
    __device__ __forceinline__ bool next(int i, gg::Unit& u) const {
        const int L = i * G + c; if (L >= ntiles * 4) return false;
        const int tile = L >> 2, pn = L & 3, e = __builtin_amdgcn_readfirstlane(tab[i]);
        u.A = a + (size_t)tile * 256 * 256; u.lda = 256; u.ridx_off = 0; u.B = w2 + (size_t)e * (1024 * 256) + (size_t)pn * 256 * 256; u.ldb = 256; u.nt = 2; u.p0 = tile; u.p1 = pn; u.p2 = e; return true;
    }
};
struct EpiBf16Plain {
    static constexpr bool PERM = true, FP8 = false; static constexpr int TID = 2; static constexpr unsigned SCB = 0x7f7f7f7fu;
    bf16_t* O; int ldc;
    __device__ __forceinline__ void operator()(const f32x4 (&acc)[2][2][4][2], const gg::Unit& u, int wr, int wc, int fr, int fq) const {
        const int row0 = u.p0 * 256 + wr * 64 + fr, col0 = u.p1 * 256 + wc * 32 + 8 * fq;
#pragma unroll
        for (int ai = 0; ai < 2; ++ai)
#pragma unroll
            for (int m = 0; m < 4; ++m)
#pragma unroll
                for (int bj = 0; bj < 2; ++bj) { const f32x4 v0 = acc[ai][bj][m][0], v1 = acc[ai][bj][m][1];
                    u32x4 w; w.x = cvt_pk_bf16(v0[0], v0[1]); w.y = cvt_pk_bf16(v0[2], v0[3]); w.z = cvt_pk_bf16(v1[0], v1[1]); w.w = cvt_pk_bf16(v1[2], v1[3]);
                    *(u32x4*)(O + (size_t)(row0 + ai * 128 + m * 16) * ldc + col0 + bj * 128) = w; }
    }
};
struct EpiF8Out {
    static constexpr bool PERM = false, PERM16 = true, FP8 = false; static constexpr int TID = 6; static constexpr unsigned SCB = 0x7f7f7f7fu;
    unsigned char* O; int ldc;
    __device__ __forceinline__ void operator()(const f32x4 (&acc)[2][2][4][2], const gg::Unit& u, int wr, int wc, int fr, int fq) const {
        const int row0 = u.p0 * 256 + wr * 64 + fr, col0 = u.p1 * 256 + wc * 64 + 16 * fq;
#pragma unroll
        for (int ai = 0; ai < 2; ++ai)
#pragma unroll
            for (int m = 0; m < 4; ++m) { const f32x4 a0 = acc[ai][0][m][0], a1 = acc[ai][0][m][1], a2 = acc[ai][1][m][0], a3 = acc[ai][1][m][1];
                *(u32x4*)(O + (size_t)(row0 + ai * 128 + m * 16) * ldc + col0) = (u32x4){pk4_fp8(a0[0], a0[1], a0[2], a0[3]), pk4_fp8(a1[0], a1[1], a1[2], a1[3]), pk4_fp8(a2[0], a2[1], a2[2], a2[3]), pk4_fp8(a3[0], a3[1], a3[2], a3[3])}; }
    }
};
struct EpiF8OutQ {
    static constexpr bool PERM = false, PERM16 = true, FP8 = true, ZPEEL = true; static constexpr int TID = 7; static constexpr unsigned SCB = 0x79797979u;
    unsigned char* O; int ldc;
    __device__ __forceinline__ void operator()(const f32x4 (&acc)[2][2][4][2], const gg::Unit& u, int wr, int wc, int fr, int fq) const {
        const int row0 = u.p0 * 256 + wr * 64 + fr, col0 = u.p1 * 256 + wc * 64 + 16 * fq;
#pragma unroll
        for (int ai = 0; ai < 2; ++ai)
#pragma unroll
            for (int m = 0; m < 4; ++m) { const f32x4 a0 = acc[ai][0][m][0], a1 = acc[ai][0][m][1], a2 = acc[ai][1][m][0], a3 = acc[ai][1][m][1];
                *(u32x4*)(O + (size_t)(row0 + ai * 128 + m * 16) * ldc + col0) = (u32x4){pk4_fp8(a0[0], a0[1], a0[2], a0[3]), pk4_fp8(a1[0], a1[1], a1[2], a1[3]), pk4_fp8(a2[0], a2[1], a2[2], a2[3]), pk4_fp8(a3[0], a3[1], a3[2], a3[3])}; }
    }
};
struct EpiBf16F8 {
    static constexpr bool PERM = true, FP8 = true; static constexpr int TID = 3; static constexpr unsigned SCB = 0x77777777u;
    bf16_t* O; static constexpr int ldc = 1024;
    __device__ __forceinline__ void operator()(const f32x4 (&acc)[2][2][4][2], const gg::Unit& u, int wr, int wc, int fr, int fq) const {
        bf16_t* p = O + (size_t)(u.p0 * 256 + wr * 64 + fr) * ldc + u.p1 * 256 + wc * 32 + 8 * fq;
#pragma unroll
        for (int ai = 0; ai < 2; ++ai) {
#pragma unroll
            for (int m = 0; m < 4; ++m) {
#pragma unroll
                for (int bj = 0; bj < 2; ++bj) { const f32x4 v0 = acc[ai][bj][m][0], v1 = acc[ai][bj][m][1];
                    u32x4 w; w.x = cvt_pk_bf16(v0[0], v0[1]); w.y = cvt_pk_bf16(v0[2], v0[3]); w.z = cvt_pk_bf16(v1[0], v1[1]); w.w = cvt_pk_bf16(v1[2], v1[3]);
                    *(u32x4*)(p + bj * 128) = w; }
                p += 16 * ldc; asm volatile("" : "+v"(p)); }
            p += 64 * ldc; }
    }
};

__device__ __forceinline__ int crow(int r, int hi) { return (r & 3) + 8 * (r >> 2) + 4 * hi; }
__device__ __forceinline__ f32x16 mma32_ll(f32x16 acc, const LAS bf16_t* A, int lda, const LAS bf16_t* B, int ldb, int ksteps, int lane, int ks0 = 0) {
    const int r32 = lane & 31, hi = lane >> 5;
    for (int ks = ks0; ks < ksteps; ++ks) {
        const bf16x8 a = *(const LAS bf16x8*)(A + r32 * lda + ks * 16 + hi * 8);
        const bf16x8 b = *(const LAS bf16x8*)(B + r32 * ldb + ks * 16 + hi * 8);
        acc = __builtin_amdgcn_mfma_f32_32x32x16_bf16(a, b, acc, 0, 0, 0);
    }
    return acc;
}
template <int KS> __device__ __forceinline__ f32x16 mma32_lg(f32x16 acc, const LAS bf16_t* A, int lda, const bf16_t* B, int ldb, int lane) {
    const int r32 = lane & 31, hi = lane >> 5;
    bf16x8 b[KS];
#pragma unroll
    for (int ks = 0; ks < KS; ++ks) b[ks] = *(const bf16x8*)(B + (size_t)r32 * ldb + ks * 16 + hi * 8);
#pragma unroll
    for (int ks = 0; ks < KS; ++ks) { const bf16x8 a = *(const LAS bf16x8*)(A + r32 * lda + ks * 16 + hi * 8); acc = __builtin_amdgcn_mfma_f32_32x32x16_bf16(a, b[ks], acc, 0, 0, 0); }
    return acc;
}

__device__ __forceinline__ void ph_pre(const Frame& F) {
    LAS float* sv = (LAS float*)F.lds;
    LAS float* part = sv + 9 * 1024;
    float* mod = (float*)(F.ws + WS_MOD);
    for (int i = F.tid; i < 9 * 1024; i += NTHR) { const int r = i >> 10, k = i & 1023; const float c = (r < 8) ? F.in[I_C][r * 1024 + k] : F.in[I_CCTX][k]; sv[i] = c * sigmoidf_(c); }
    __syncthreads();
    for (int it = F.bx; it < 2 * 96; it += F.G) {
        const int l = it / 96, jc = it % 96, j = jc * 64 + F.lane, k0 = F.wave * 128;
        const float* w = F.in[I_WMOD] + ((size_t)l * 1024 + k0) * 6144 + j;
        float a[9];
#pragma unroll
        for (int r = 0; r < 9; ++r) a[r] = 0.f;
#pragma unroll 4
        for (int k = 0; k < 128; ++k) { const float wv = w[(size_t)k * 6144];
#pragma unroll
            for (int r = 0; r < 9; ++r) a[r] += sv[r * 1024 + k0 + k] * wv; }
#pragma unroll
        for (int r = 0; r < 9; ++r) part[(F.wave * 9 + r) * 64 + F.lane] = a[r];
        __syncthreads();
        for (int i = F.tid; i < 9 * 64; i += NTHR) { const int r = i >> 6, jj = i & 63; float s = F.in[I_BMOD][l * 6144 + jc * 64 + jj];
#pragma unroll
            for (int w8 = 0; w8 < 8; ++w8) s += part[(w8 * 9 + r) * 64 + jj];
            mod[((size_t)(l * 9 + r)) * 6144 + jc * 64 + jj] = s; }
        __syncthreads();
    }
    if (F.bx == F.G - 1) {
        float* rt = (float*)(F.ws + T_ROPE);
        for (int i = F.tid; i < 1024; i += NTHR) { const int pos = i >> 3, f = i & 7; const float inv = powf(10000.0f, -(float)f / 8.0f); const float ang = (float)pos * inv; rt[2 * i] = cosf(ang); rt[2 * i + 1] = sinf(ang); }
    }
}

struct ConvCursor { int base; int gw, ngw; };
__device__ __forceinline__ void conv_mat(const Frame& F, ConvCursor& cc, const float* src, int K, int N, bf16_t* dst, int ldd, int rbase, int rstep, int nbatch, size_t sbs, size_t dbs, int rq = 128, bool gperm = false, float f8scale = 0.f) {
    const int ktl = K / 64, ntl = (N + 127) / 128, per = ktl * ntl, total = per * nbatch;
    int t = cc.base + ((cc.gw - cc.base) % cc.ngw + cc.ngw) % cc.ngw;
    for (; t < cc.base + total; t += cc.ngw) {
        const int li = t - cc.base, bt = li / per, rem = li % per, kb = rem / ntl, nb = rem % ntl, k0 = kb * 64, n = nb * 128 + 2 * F.lane;
        if (n < N) {
            const float* s = src + bt * sbs + (size_t)k0 * N + n; bf16_t* d = dst + bt * dbs;
            f32x2 v[64];
#pragma unroll
            for (int i = 0; i < 64; ++i) v[i] = *(const f32x2*)(s + (size_t)i * N);
#pragma unroll
            for (int q = 0; q < 2; ++q) { const int nn = n + q; const int drow = gperm ? ((nn >> 6) * 256 + ((nn >> 4) & 3) * 32 + (nn & 15) + 128 * (bt >> 1) + 16 * (bt & 1)) : (rbase + (nn / rq) * rstep + (nn % rq));
                if (f8scale != 0.f) { unsigned char* d8 = (unsigned char*)dst + bt * dbs + (size_t)drow * ldd + k0;
#pragma unroll
                    for (int p = 0; p < 4; ++p) { u32x4 o; o.x = pk4_fp8(v[16 * p][q] * f8scale, v[16 * p + 1][q] * f8scale, v[16 * p + 2][q] * f8scale, v[16 * p + 3][q] * f8scale);
                        o.y = pk4_fp8(v[16 * p + 4][q] * f8scale, v[16 * p + 5][q] * f8scale, v[16 * p + 6][q] * f8scale, v[16 * p + 7][q] * f8scale);
                        o.z = pk4_fp8(v[16 * p + 8][q] * f8scale, v[16 * p + 9][q] * f8scale, v[16 * p + 10][q] * f8scale, v[16 * p + 11][q] * f8scale);
                        o.w = pk4_fp8(v[16 * p + 12][q] * f8scale, v[16 * p + 13][q] * f8scale, v[16 * p + 14][q] * f8scale, v[16 * p + 15][q] * f8scale);
                        *(u32x4*)(d8 + 16 * p) = o; }
                    continue; }
                bf16_t* dr = d + (size_t)drow * ldd + k0;
#pragma unroll
                for (int p = 0; p < 8; ++p) { u32x4 o; o.x = pk2(v[8 * p][q], v[8 * p + 1][q]); o.y = pk2(v[8 * p + 2][q], v[8 * p + 3][q]); o.z = pk2(v[8 * p + 4][q], v[8 * p + 5][q]); o.w = pk2(v[8 * p + 6][q], v[8 * p + 7][q]);
                    *(u32x4*)(dr + 8 * p) = o; } }
        }
    }
    cc.base += total;
}
__device__ __forceinline__ void ph_convert(const Frame& F, int l) {
    ConvCursor cc; cc.base = 0; cc.gw = F.bx * NWAVES + F.wave; cc.ngw = F.G * NWAVES;
    unsigned char* ws = F.ws;
    conv_mat(F, cc, F.in[I_WIN] + (size_t)l * 1024 * INC, 1024, INC, (bf16_t*)(ws + W_IN), 1024, 0, 128, 1, 0, 0, 128, false, 64.0f);
    conv_mat(F, cc, F.in[I_WGATE] + (size_t)l * 4 * 1024 * 1024, 1024, 1024, (bf16_t*)(ws + W_GATE), 1024, 0, 128, 4, (size_t)1024 * 1024, 0, 128, true, 64.0f);
    conv_mat(F, cc, F.in[I_WBR] + (size_t)l * 4 * 256 * 1024, 256, 1024, (bf16_t*)(ws + W_BR), 256, 0, 128, 4, (size_t)256 * 1024, (size_t)1024 * 256);
    conv_mat(F, cc, F.in[I_WOUT] + (size_t)l * 1024 * 1024, 1024, 1024, (bf16_t*)(ws + W_OUT), 1024, 0, 128, 1, 0, 0, 128, false, 64.0f);
    conv_mat(F, cc, F.in[I_W1] + (size_t)l * 64 * 1024 * 256, 1024, 256, (bf16_t*)(ws + W_13), 1024, 0, 256, 64, (size_t)1024 * 256, (size_t)512 * 1024, 128, false, 64.0f);
    conv_mat(F, cc, F.in[I_W3] + (size_t)l * 64 * 1024 * 256, 1024, 256, (bf16_t*)(ws + W_13), 1024, 128, 256, 64, (size_t)1024 * 256, (size_t)512 * 1024, 128, false, 64.0f);
    conv_mat(F, cc, F.in[I_W2] + (size_t)l * 64 * 256 * 1024, 256, 1024, (bf16_t*)(ws + W_2), 256, 0, 128, 64, (size_t)256 * 1024, (size_t)1024 * 256, 128, false, 32.0f);
    conv_mat(F, cc, F.in[I_WS1] + (size_t)l * 1024 * 256, 1024, 256, (bf16_t*)(ws + W_13 + (size_t)64 * 512 * 1024), 1024, 0, 256, 1, 0, 0, 128, false, 64.0f);
    conv_mat(F, cc, F.in[I_WS3] + (size_t)l * 1024 * 256, 1024, 256, (bf16_t*)(ws + W_13 + (size_t)64 * 512 * 1024), 1024, 128, 256, 1, 0, 0, 128, false, 64.0f);
    conv_mat(F, cc, F.in[I_WS2] + (size_t)l * 256 * 1024, 256, 1024, (bf16_t*)(ws + W_2 + (size_t)64 * 1024 * 256), 256, 0, 128, 1, 0, 0, 128, false, 32.0f);
    conv_mat(F, cc, F.in[I_WUQ] + (size_t)l * 256 * 384, 256, 384, (bf16_t*)(ws + W_UQ), 256, 0, 128, 1, 0, 0);
    conv_mat(F, cc, F.in[I_WUKV] + (size_t)l * 128 * 512, 128, 512, (bf16_t*)(ws + W_UKV), 128, 0, 128, 1, 0, 0);
    conv_mat(F, cc, F.in[I_POOLW] + (size_t)l * 4 * 64 * 64, 64, 64, (bf16_t*)(ws + W_POOL), 64, 0, 128, 4, (size_t)64 * 64, (size_t)64 * 64);
    conv_mat(F, cc, F.in[I_WRT] + (size_t)l * 1024 * 64, 1024, 64, (bf16_t*)(ws + W_RT), 1024, 0, 128, 1, 0, 0);
    { u32x4* z = (u32x4*)(ws + W_IN + (size_t)INC * 1024); const int n16 = (INCP - INC) * 1024 / 16;
      unsigned z0 = 0u; asm volatile("" : "+v"(z0));
      for (int i = F.bx * NTHR + F.tid; i < n16; i += F.G * NTHR) z[i] = (u32x4){z0, z0, z0, z0}; }
}

__device__ __forceinline__ void normmod_vals(int lane, const f32x4 (&v)[4], const float* g, const float* sc, const float* sh, f32x4 (&y)[4]) {
    float s = 0.f;
#pragma unroll
    for (int j = 0; j < 4; ++j) s += (v[j].x * v[j].x + v[j].y * v[j].y) + (v[j].z * v[j].z + v[j].w * v[j].w);
    const float rstd = frsq(wave_sum(s) * (1.f / 1024.f) + EPS);
#pragma unroll
    for (int j = 0; j < 4; ++j) { const f32x4 gv = ((const f32x4*)g)[lane + 64 * j], scv = ((const f32x4*)sc)[lane + 64 * j], shv = ((const f32x4*)sh)[lane + 64 * j];
        y[j] = v[j] * rstd * gv * (scv + 1.0f) + shv; }
}
__device__ __forceinline__ void normmod_row(int lane, const float* xrow, const float* g, const float* sc, const float* sh, f32x4 (&y)[4]) {
    const f32x4* xr = (const f32x4*)xrow + lane; f32x4 v[4]; float s = 0.f;
#pragma unroll
    for (int j = 0; j < 4; ++j) { v[j] = xr[64 * j]; s += (v[j].x * v[j].x + v[j].y * v[j].y) + (v[j].z * v[j].z + v[j].w * v[j].w); }
    const float rstd = frsq(wave_sum(s) * (1.f / 1024.f) + EPS);
#pragma unroll
    for (int j = 0; j < 4; ++j) { const f32x4 gv = ((const f32x4*)g)[lane + 64 * j], scv = ((const f32x4*)sc)[lane + 64 * j], shv = ((const f32x4*)sh)[lane + 64 * j];
        y[j] = v[j] * rstd * gv * (scv + 1.0f) + shv; }
}
__device__ __forceinline__ const float* stream_row(const Frame& F, int l, int row) {
    if (row < NLAT) return (l == 0 ? F.in[I_X] : F.out) + (size_t)row * 1024;
    return (l == 0 ? F.in[I_CTX] : (const float*)(F.ws + WS_CTXS)) + (size_t)(row - NLAT) * 1024;
}
__device__ __forceinline__ void ph_norm1(const Frame& F, int l) {
    const int gw = F.bx * NWAVES + F.wave, ngw = F.G * NWAVES;
    for (int row0 = gw; row0 < NTOK; row0 += 2 * ngw) {
        const int row1 = row0 + ngw; const bool has1 = row1 < NTOK;
        f32x4 v0[4], v1[4];
        { const f32x4* x0 = (const f32x4*)stream_row(F, l, row0) + F.lane; const f32x4* x1 = (const f32x4*)stream_row(F, l, has1 ? row1 : row0) + F.lane;
#pragma unroll
          for (int j = 0; j < 4; ++j) { v0[j] = x0[64 * j]; v1[j] = x1[64 * j]; } }
#pragma unroll
        for (int k = 0; k < 2; ++k) { if (k == 1 && !has1) break; const int row = k ? row1 : row0; const int mr = mod_row_of(row); f32x4 y[4];
            normmod_vals(F.lane, k ? v1 : v0, F.in[I_GMIX] + l * 1024, modp(F, l, mr, 1), modp(F, l, mr, 0), y);
            unsigned* o8 = (unsigned*)(F.ws + WS_HX8 + (size_t)row * 1024) + F.lane;
#pragma unroll
            for (int j = 0; j < 4; ++j) o8[64 * j] = pk4_fp8(y[j].x, y[j].y, y[j].z, y[j].w); }
    }
}

constexpr float QSCALE = 0.10206207261596577f * 1.4426950408889634f;
template <int KS> __device__ __forceinline__ void ld_bfrag(bf16x8* b, const bf16_t* B, int ldb, int lane) {
#pragma unroll
    for (int ks = 0; ks < KS; ++ks) b[ks] = *(const bf16x8*)(B + (size_t)(lane & 31) * ldb + ks * 16 + (lane >> 5) * 8);
}
template <int KS> __device__ __forceinline__ f32x16 mma32_lr(const LAS bf16_t* A, int lda, const bf16x8* b, int lane) {
    f32x16 acc = {};
#pragma unroll
    for (int ks = 0; ks < KS; ++ks) { const bf16x8 a = *(const LAS bf16x8*)(A + (lane & 31) * lda + ks * 16 + (lane >> 5) * 8); acc = __builtin_amdgcn_mfma_f32_32x32x16_bf16(a, b[ks], acc, 0, 0, 0); }
    return acc;
}
__device__ __forceinline__ f32x2 mla_rope_ld(const Frame& F, int unit) {
    const int row0 = unit * 32; const bool isctx = row0 >= NLAT; const int pos0 = isctx ? (row0 - NLAT) & 255 : row0 & 8191;
    const int pos = pos0 + (F.tid >> 4), pp = (F.tid & 8) ? (pos & 63) : (pos >> 6);
    return *(const f32x2*)((const float*)(F.ws + T_ROPE) + (pp * 8 + (F.tid & 7)) * 2);
}
struct MlaKvRegs { unsigned xk[4]; unsigned xr[4]; f32x2 rp; };
__device__ __forceinline__ MlaKvRegs mla_kv_load(const Frame& F, int unit) {
    MlaKvRegs R; const bf16_t* px = (const bf16_t*)(F.ws + WS_PX);
#pragma unroll
    for (int rr = 0; rr < 4; ++rr) { const bf16_t* p = px + (size_t)(unit * 32 + F.wave * 4 + rr) * INC + C_MLA;
        R.xk[rr] = *(const unsigned*)(p + 256 + 2 * F.lane); R.xr[rr] = *(const unsigned*)(p + 384 + 2 * (F.lane & 15)); }
    R.rp = mla_rope_ld(F, unit);
    return R;
}
__device__ __forceinline__ void mla_kv_unit(const Frame& F, int unit, const MlaKvRegs& R, const bf16x8* wkv, f32x2 gckv2, float g0, float g1, float g2) {
    LAS unsigned char* lds = F.lds;
    LAS bf16_t* AKV = (LAS bf16_t*)lds;
    LAS float* KR = (LAS float*)(lds + 8704);
    LAS f32x2* RP = (LAS f32x2*)(lds + 12800);
    LAS float* OUT = (LAS float*)(lds + 16896);
    LAS unsigned char* KB = (LAS unsigned char*)(lds + 83456);
    int tid_ = F.tid; asm volatile("" : "+v"(tid_));
    const int row0 = unit * 32, tid = tid_, lane = tid & 63, wave = F.wave, r32 = lane & 31, hi = lane >> 5;
    const bool isctx = row0 >= NLAT;
    const int b = isctx ? (row0 - NLAT) >> 8 : row0 >> 13, pos0 = isctx ? (row0 - NLAT) & 255 : row0 & 8191;
    LDS_BAR();
    RP[tid] = R.rp;
#pragma unroll
    for (int rr = 0; rr < 4; ++rr) { const int r = wave * 4 + rr; const unsigned w = R.xk[rr]; const float x0 = bflo(w), x1 = bfhi(w);
        const float sc = frsq(wave_sum(x0 * x0 + x1 * x1) * (1.f / 128.f) + EPS);
        *(LAS unsigned*)(AKV + r * 136 + 2 * lane) = pk2(x0 * sc * gckv2.x, x1 * sc * gckv2.y);
        if (lane < 16) *(LAS f32x2*)(KR + r * 32 + 2 * lane) = (f32x2){bflo(R.xr[rr]), bfhi(R.xr[rr])}; }
    LDS_BAR();
#pragma unroll
    for (int i = 0; i < 2; ++i) { const int nt = wave * 2 + i; const f32x16 acc = mma32_lr<8>(AKV, 136, wkv + 8 * i, lane);
#pragma unroll
        for (int r = 0; r < 16; ++r) OUT[crow(r, hi) * 520 + nt * 32 + r32] = acc[r]; }
    LDS_BAR();
#pragma unroll
    for (int it = 0; it < 8; ++it) { const int pr = wave * 16 + it * 2 + hi, r = pr >> 2, h = pr & 3; const LAS float* o = OUT + r * 520 + h * 128;
        float v0 = o[r32], v1 = o[32 + r32], v2 = KR[r * 32 + r32]; const float ss = half_sum(v0 * v0 + v1 * v1 + v2 * v2);
        const float sc = frsq(ss * (1.f / 96.f) + EPS);
        v0 *= sc * g0; v1 *= sc * g1; v2 *= sc * g2;
        const float pv = xor_lane<8>(v2);
        if (!isctx) { const f32x2 cssn = RP[(r * 2 + (r32 >> 4)) * 8 + (r32 & 7)]; v2 = (r32 & 8) ? (v2 * cssn.x + pv * cssn.y) : (v2 * cssn.x - pv * cssn.y); }
        LAS unsigned char* kb = KB + r * 400 + h * 96;
        kb[r32] = f2f8(v0); kb[32 + r32] = f2f8(v1); kb[64 + r32] = f2f8(v2); }
    LDS_BAR();
    const int key0 = isctx ? pos0 : 256 + pos0, tile = key0 >> 6, kin = key0 & 63;
    for (int i = tid; i < 768; i += NTHR) { const int r = i & 31, c = (i >> 5) % 6, h = i / 192;
        const u32x4 v = *(const LAS u32x4*)(KB + r * 400 + h * 96 + c * 16);
        *(u32x4*)(F.ws + WS_KT + ((size_t)((b * 4 + h) * NKT + tile) * 6 + c) * 1024 + (kin + r) * 16) = v; }
    for (int i = tid; i < 1024; i += NTHR) { const int p = i & 3, r = (i >> 2) & 31, dh = (i >> 7) & 1, h = i >> 8; const LAS float* o = OUT + r * 520 + h * 128 + 64 + dh * 32 + p * 8;
        u32x4 v; v.x = pk2(o[0], o[1]); v.y = pk2(o[2], o[3]); v.z = pk2(o[4], o[5]); v.w = pk2(o[6], o[7]);
        *(u32x4*)((bf16_t*)(F.ws + WS_VT) + ((size_t)((b * 4 + h) * NKT + tile) * 2 + dh) * 2048 + (kin + r) * 32 + p * 8) = v; }
}
struct MlaQRegs { u32x2 xq[4]; f32x2 rp; };
__device__ __forceinline__ MlaQRegs mla_q_load(const Frame& F, int unit) {
    MlaQRegs R; const bf16_t* px = (const bf16_t*)(F.ws + WS_PX);
#pragma unroll
    for (int rr = 0; rr < 4; ++rr) R.xq[rr] = *(const u32x2*)(px + (size_t)(unit * 32 + F.wave * 4 + rr) * INC + C_MLA + 4 * F.lane);
    R.rp = mla_rope_ld(F, unit);
    return R;
}
__device__ __forceinline__ void mla_q_unit(const Frame& F, int unit, const MlaQRegs& R, const bf16x8* wqf, f32x4 gcq4, float g0, float g1, float g2) {
    LAS unsigned char* lds = F.lds;
    LAS bf16_t* AQ = (LAS bf16_t*)lds;
    LAS f32x2* RP = (LAS f32x2*)(lds + 16896);
    LAS float* OQ = (LAS float*)(lds + 20992);
    int tid_ = F.tid; asm volatile("" : "+v"(tid_));
    const int row0 = unit * 32, tid = tid_, lane = tid & 63, wave = F.wave, r32 = lane & 31, hi = lane >> 5;
    const bool isctx = row0 >= NLAT;
    LDS_BAR();
    RP[tid] = R.rp;
#pragma unroll
    for (int rr = 0; rr < 4; ++rr) { const int r = wave * 4 + rr; const u32x2 w = R.xq[rr]; const float x0 = bflo(w.x), x1 = bfhi(w.x), x2 = bflo(w.y), x3 = bfhi(w.y);
        const float sc = frsq(wave_sum(x0 * x0 + x1 * x1 + x2 * x2 + x3 * x3) * (1.f / 256.f) + EPS);
        *(LAS u32x2*)(AQ + r * 264 + 4 * lane) = (u32x2){pk2(x0 * sc * gcq4.x, x1 * sc * gcq4.y), pk2(x2 * sc * gcq4.z, x3 * sc * gcq4.w)}; }
    LDS_BAR();
    { const f32x16 acc = mma32_lr<16>(AQ, 264, wqf, lane);
#pragma unroll
      for (int r = 0; r < 16; ++r) OQ[crow(r, hi) * 392 + wave * 32 + r32] = acc[r]; }
    if (wave < 4) { const f32x16 acc = mma32_lr<16>(AQ, 264, wqf + 16, lane);
#pragma unroll
      for (int r = 0; r < 16; ++r) OQ[crow(r, hi) * 392 + (8 + wave) * 32 + r32] = acc[r]; }
    LDS_BAR();
    unsigned char* qb = F.ws + WS_QB;
#pragma unroll
    for (int it = 0; it < 8; ++it) { const int pr = wave * 16 + it * 2 + hi, r = pr >> 2, h = pr & 3; const LAS float* o = OQ + r * 392 + h * 96;
        float v0 = o[r32], v1 = o[32 + r32], v2 = o[64 + r32]; const float ss = half_sum(v0 * v0 + v1 * v1 + v2 * v2);
        const float sc = frsq(ss * (1.f / 96.f) + EPS);
        v0 *= sc * g0; v1 *= sc * g1; v2 *= sc * g2;
        const float pv = xor_lane<8>(v2);
        if (!isctx) { const f32x2 cssn = RP[(r * 2 + (r32 >> 4)) * 8 + (r32 & 7)]; v2 = (r32 & 8) ? (v2 * cssn.x + pv * cssn.y) : (v2 * cssn.x - pv * cssn.y); }
        unsigned char* q = qb + (size_t)(row0 + r) * 384 + h * 96;
        q[r32] = f2f8(v0 * (8.0f * QSCALE)); q[32 + r32] = f2f8(v1 * (8.0f * QSCALE)); q[64 + r32] = f2f8(v2 * (8.0f * QSCALE)); }
}
__device__ __forceinline__ void mla_prep(const Frame& F, int l) {
    const int lane = F.lane, wave = F.wave, r32 = lane & 31;
    { bf16x8 wkv[16]; const bf16_t* wukv = (const bf16_t*)(F.ws + W_UKV);
      ld_bfrag<8>(wkv, wukv + (size_t)(wave * 2) * 32 * 128, 128, lane); ld_bfrag<8>(wkv + 8, wukv + (size_t)(wave * 2 + 1) * 32 * 128, 128, lane);
      const f32x2 gckv2 = *(const f32x2*)(F.in[I_GCKV] + l * 128 + 2 * lane); const float* gkn = F.in[I_GKN] + l * 96; const float g0 = gkn[r32], g1 = gkn[32 + r32], g2 = gkn[64 + r32];
      const int nu = NTOK / 32;
      if (F.bx < nu) { MlaKvRegs R = mla_kv_load(F, F.bx);
          for (int u = F.bx; u < nu; u += F.G) { const MlaKvRegs Rn = mla_kv_load(F, (u + F.G < nu) ? u + F.G : u); mla_kv_unit(F, u, R, wkv, gckv2, g0, g1, g2); R = Rn; } } }
    { bf16x8 wqf[32]; const bf16_t* wuq = (const bf16_t*)(F.ws + W_UQ);
      ld_bfrag<16>(wqf, wuq + (size_t)wave * 32 * 256, 256, lane); if (wave < 4) ld_bfrag<16>(wqf + 16, wuq + (size_t)(8 + wave) * 32 * 256, 256, lane);
      const f32x4 gcq4 = *(const f32x4*)(F.in[I_GCQ] + l * 256 + 4 * lane); const float* gqn = F.in[I_GQN] + l * 96; const float g0 = gqn[r32], g1 = gqn[32 + r32], g2 = gqn[64 + r32];
      const int nu = (l == 0 ? NTOK : NLAT) / 32;
      if (F.bx < nu) { MlaQRegs R = mla_q_load(F, F.bx);
          for (int u = F.bx; u < nu; u += F.G) { const MlaQRegs Rn = mla_q_load(F, (u + F.G < nu) ? u + F.G : u); mla_q_unit(F, u, R, wqf, gcq4, g0, g1, g2); R = Rn; } } }
}

__device__ __forceinline__ void ml_chunk_pos(int dir, int j, bool& isctx, int& p0) {
    if (j < 2) { isctx = true; p0 = (dir == 0 ? j : 1 - j) * 128; } else { isctx = false; p0 = (dir == 0 ? (j - 2) : (63 - (j - 2))) * 128; }
}
__device__ __forceinline__ int ml_row(int b, bool isctx, int pos) { return isctx ? NLAT + b * 256 + pos : b * 8192 + pos; }
__device__ __forceinline__ float log_sigmoidf_(float x) { return fminf(x, 0.f) - log1pf(__expf(-fabsf(x))); }

struct P1Regs { u32x4 kv[4]; float gi, gf; };
__device__ __forceinline__ P1Regs ml_pass1_load(const Frame& F, int unit) {
    P1Regs R; const int j = unit % NCHK, dir = (unit / NCHK) & 1, h = (unit / (NCHK * 2)) & 3, b = unit / (NCHK * 8);
    bool isctx; int p0; ml_chunk_pos(dir, j, isctx, p0);
    const bf16_t* px = (const bf16_t*)(F.ws + WS_PX); const float* gate = (const float*)(F.ws + T_GATE); const int tid = F.tid;
#pragma unroll
    for (int q = 0; q < 4; ++q) { const int it = tid + q * NTHR, i = it & 127, c = (it >> 7) & 7, isv = it >> 10; const int pos = dir ? p0 + 127 - i : p0 + i;
        R.kv[q] = *(const u32x4*)(px + (size_t)ml_row(b, isctx, pos) * INC + (isv ? 512 : 256) + h * 64 + c * 8); }
    { const int i = tid & 127; const int pos = dir ? p0 + 127 - i : p0 + i; const float* g = gate + (size_t)ml_row(b, isctx, pos) * 16; R.gi = g[dir * 8 + h]; R.gf = g[dir * 8 + 4 + h]; }
    return R;
}
__device__ __forceinline__ void ml_pass1_unit(const Frame& F, int l, int unit, const P1Regs& R) {
    LAS float* LI = (LAS float*)F.lds; LAS float* LF = LI + 128; LAS float* WV = LI + 256;
    LAS bf16_t* KT = (LAS bf16_t*)(F.lds + 2048); LAS bf16_t* VT = KT + 64 * 136;
    const int dir = (unit / NCHK) & 1, h = (unit / (NCHK * 2)) & 3;
    const int tid = F.tid, lane = F.lane, wave = F.wave;
    const float* gb = F.in[I_MLGB] + l * 16;
    LDS_BAR();
    if (tid < 128) { LI[tid] = R.gi + gb[dir * 8 + h]; LF[tid] = log_sigmoidf_(R.gf + gb[dir * 8 + 4 + h]); }
    LDS_BAR();
    if (wave == 0) {
        const float a0 = LF[2 * lane], a1 = LF[2 * lane + 1]; float s = a0 + a1;
#pragma unroll
        for (int o = 1; o < 64; o <<= 1) { const float t = lane_up(s, o, lane); if (lane >= o) s += t; }
        const float bend = lane_bcast(s, 63);
        const float w0 = bend - (s - a1) + LI[2 * lane], w1 = bend - s + LI[2 * lane + 1];
        const float mloc = wave_max(fmaxf(w0, w1));
        WV[2 * lane] = __expf(w0 - mloc); WV[2 * lane + 1] = __expf(w1 - mloc);
        if (lane == 0) { ((float*)(F.ws + T_MLOC))[unit] = mloc; ((float*)(F.ws + T_BEND))[unit] = bend; }
    }
    LDS_BAR();
#pragma unroll
    for (int q = 0; q < 4; ++q) { const int it = tid + q * NTHR, i = it & 127, c = (it >> 7) & 7, isv = it >> 10; const u32x4 v = R.kv[q];
        const float sc = isv ? 1.0f : 0.125f * WV[i]; LAS bf16_t* d = (isv ? VT : KT) + (c * 8) * 136 + i;
        d[0] = (bf16_t)f2bf(bflo(v.x) * sc); d[136] = (bf16_t)f2bf(bfhi(v.x) * sc); d[272] = (bf16_t)f2bf(bflo(v.y) * sc); d[408] = (bf16_t)f2bf(bfhi(v.y) * sc);
        d[544] = (bf16_t)f2bf(bflo(v.z) * sc); d[680] = (bf16_t)f2bf(bfhi(v.z) * sc); d[816] = (bf16_t)f2bf(bflo(v.w) * sc); d[952] = (bf16_t)f2bf(bfhi(v.w) * sc); }
    LDS_BAR();
    if (wave < 4) { const int et = wave >> 1, dt = wave & 1; f32x16 acc = {}; acc = mma32_ll(acc, VT + et * 32 * 136, 136, KT + dt * 32 * 136, 136, 8, lane);
        float* dc = (float*)(F.ws + WS_DC) + (size_t)unit * 4096; const int r32 = lane & 31, hi = lane >> 5;
#pragma unroll
        for (int r = 0; r < 16; ++r) dc[(et * 32 + crow(r, hi)) * 64 + dt * 32 + r32] = acc[r];
    } else if (wave == 4) { float s = 0.f; for (int i = 0; i < 128; ++i) s += bf2f(KT[lane * 136 + i]); ((float*)(F.ws + T_DN))[(size_t)unit * 64 + lane] = s; }
}

__device__ __forceinline__ void ml_pass2(const Frame& F) {
    const float* dc = (const float*)(F.ws + WS_DC); const float* dn = (const float*)(F.ws + T_DN);
    const float* mloc = (const float*)(F.ws + T_MLOC); const float* bend = (const float*)(F.ws + T_BEND);
    bf16_t* cst = (bf16_t*)(F.ws + WS_CST); float* nst = (float*)(F.ws + T_NST); float* mst = (float*)(F.ws + T_MST);
    LAS float* ML = (LAS float*)F.lds; LAS float* BE = ML + 128;
    for (int it = F.bx; it < 64 * 8; it += F.G) { const int bhd = it >> 3, part = it & 7, u0 = bhd * NCHK, el = part * 512 + F.tid;
        const bool don = (part == 0 && F.tid < 64);
        float d[NCHK], dnv[NCHK];
#pragma unroll
        for (int j = 0; j < NCHK; ++j) d[j] = dc[(size_t)(u0 + j) * 4096 + el];
#pragma unroll
        for (int j = 0; j < NCHK; ++j) dnv[j] = don ? dn[(size_t)(u0 + j) * 64 + F.tid] : 0.f;
        __syncthreads();
        if (F.tid < NCHK) { ML[F.tid] = mloc[u0 + F.tid]; BE[F.tid] = bend[u0 + F.tid]; }
        __syncthreads();
        float C = 0.f, n = 0.f, m = 0.f;
#pragma unroll
        for (int j = 0; j < NCHK; ++j) { const int u = u0 + j; const float ml = ML[j], be = BE[j];
            cst[(size_t)u * 4096 + el] = (bf16_t)f2bf(C); if (don) nst[(size_t)u * 64 + F.tid] = n; if (part == 0 && F.tid == 0) mst[u] = m;
            const float mn = fmaxf(be + m, ml), dcy = __expf(be + m - mn), sc = __expf(ml - mn);
            C = dcy * C + sc * d[j]; n = dcy * n + sc * dnv[j]; m = mn; }
    }
    __syncthreads();
}

__device__ __forceinline__ void ml_pass3_unit(const Frame& F, int l, int b, int h, int pc) {
    LAS unsigned char* lds = F.lds;
    LAS bf16_t* Qs = (LAS bf16_t*)lds;
    LAS bf16_t* Ks = (LAS bf16_t*)(lds + 18432);
    LAS bf16_t* VTs = (LAS bf16_t*)(lds + 36864);
    LAS bf16_t* CTs = (LAS bf16_t*)(lds + 62976);
    LAS bf16_t* Wm = (LAS bf16_t*)(lds + 76800);
    LAS float* HS = (LAS float*)(lds + 111616);
    LAS float* VEC = (LAS float*)(lds + 144384);
    LAS float* DEN = VEC + 12 * 128;
    const int tid = F.tid, lane = F.lane, wave = F.wave, r32 = lane & 31, hi = lane >> 5;
    const bool isctx = pc < 2; const int p0 = isctx ? pc * 128 : (pc - 2) * 128;
    const float* gate = (const float*)(F.ws + T_GATE); const float* gb = F.in[I_MLGB] + l * 16;
    const bf16_t* px = (const bf16_t*)(F.ws + WS_PX);
    int unit_d[2];
#pragma unroll
    for (int dir = 0; dir < 2; ++dir) { const int j = isctx ? (dir == 0 ? pc : 1 - pc) : (dir == 0 ? pc : 2 + 63 - (pc - 2)); unit_d[dir] = ((b * 4 + h) * 2 + dir) * NCHK + j; }
    LDS_BAR();
    const u32x4 cst0 = *(const u32x4*)((const bf16_t*)(F.ws + WS_CST) + (size_t)unit_d[0] * 4096 + tid * 8), cst1 = *(const u32x4*)((const bf16_t*)(F.ws + WS_CST) + (size_t)unit_d[1] * 4096 + tid * 8);
    const float nv0 = (tid < 64) ? ((const float*)(F.ws + T_NST))[(size_t)unit_d[0] * 64 + tid] : 0.f, nv1 = (tid < 64) ? ((const float*)(F.ws + T_NST))[(size_t)unit_d[1] * 64 + tid] : 0.f;
    const float mst0 = ((const float*)(F.ws + T_MST))[unit_d[0]], mst1 = ((const float*)(F.ws + T_MST))[unit_d[1]];
    if (tid < 256) { const int dir = tid >> 7, i = tid & 127; const int pos = dir ? p0 + 127 - i : p0 + i; const float* g = gate + (size_t)ml_row(b, isctx, pos) * 16;
        VEC[(dir * 6 + 0) * 128 + i] = g[dir * 8 + h] + gb[dir * 8 + h]; VEC[(dir * 6 + 1) * 128 + i] = log_sigmoidf_(g[dir * 8 + 4 + h] + gb[dir * 8 + 4 + h]); }
    for (int it = tid; it < 3072; it += NTHR) { const int i = it & 127, c = (it >> 7) & 7, which = it >> 10;
        const u32x4 v = *(const u32x4*)(px + (size_t)ml_row(b, isctx, p0 + i) * INC + which * 256 + h * 64 + c * 8);
        if (which == 0) *(LAS u32x4*)(Qs + i * 72 + c * 8) = v;
        else if (which == 1) { u32x4 w; w.x = pk2(bflo(v.x) * 0.125f, bfhi(v.x) * 0.125f); w.y = pk2(bflo(v.y) * 0.125f, bfhi(v.y) * 0.125f); w.z = pk2(bflo(v.z) * 0.125f, bfhi(v.z) * 0.125f); w.w = pk2(bflo(v.w) * 0.125f, bfhi(v.w) * 0.125f);
            *(LAS u32x4*)(Ks + i * 72 + c * 8) = w; }
        else { LAS bf16_t* d = VTs + (c * 8) * 136 + i; d[0] = (bf16_t)(v.x & 0xffff); d[136] = (bf16_t)(v.x >> 16); d[272] = (bf16_t)(v.y & 0xffff); d[408] = (bf16_t)(v.y >> 16);
            d[544] = (bf16_t)(v.z & 0xffff); d[680] = (bf16_t)(v.z >> 16); d[816] = (bf16_t)(v.w & 0xffff); d[952] = (bf16_t)(v.w >> 16); } }
    for (int it = tid; it < 32 * 136; it += NTHR) VTs[64 * 136 + it] = (it < 128) ? (bf16_t)0x3f80 : (bf16_t)0;
    LDS_BAR();
    if (wave < 2) { const int dir = wave; LAS float* V0 = VEC + dir * 6 * 128; const float mst = dir ? mst1 : mst0;
        const float a0 = V0[128 + 2 * lane], a1 = V0[128 + 2 * lane + 1]; float s = a0 + a1;
#pragma unroll
        for (int o = 1; o < 64; o <<= 1) { const float t = lane_up(s, o, lane); if (lane >= o) s += t; }
        const float b0 = s - a1, b1 = s, c0 = V0[2 * lane] - b0, c1 = V0[2 * lane + 1] - b1;
        float pm = fmaxf(c0, c1);
#pragma unroll
        for (int o = 1; o < 64; o <<= 1) { const float t = lane_up(pm, o, lane); if (lane >= o) pm = fmaxf(pm, t); }
        float pprev = lane_up(pm, 1, lane); if (lane == 0) pprev = -INFINITY;
        const float M0 = fmaxf(mst, fmaxf(pprev, c0)), M1 = fmaxf(mst, pm);
        V0[256 + 2 * lane] = c0; V0[256 + 2 * lane + 1] = c1; V0[384 + 2 * lane] = M0; V0[384 + 2 * lane + 1] = M1;
        V0[512 + 2 * lane] = __expf(mst - M0); V0[512 + 2 * lane + 1] = __expf(mst - M1); V0[640 + 2 * lane] = __expf(-b0 - M0); V0[640 + 2 * lane + 1] = __expf(-b1 - M1);
    }
    const u32x4 og0 = *(const u32x4*)(px + (size_t)ml_row(b, isctx, p0 + (tid >> 3)) * INC + 768 + h * 64 + (tid & 7) * 8), og1 = *(const u32x4*)(px + (size_t)ml_row(b, isctx, p0 + 64 + (tid >> 3)) * INC + 768 + h * 64 + (tid & 7) * 8);
    for (int dir = 0; dir < 2; ++dir) {
        const LAS float* COLV = VEC + (dir * 6 + 2) * 128; const LAS float* MV = COLV + 128; const LAS float* AIN = COLV + 256; const LAS float* EINV = COLV + 384;
        const int rs = dir ? -72 : 72, rb = dir ? 127 : 0;
        LDS_BAR();
        *(LAS u32x4*)(CTs + (tid >> 3) * 72 + (tid & 7) * 8) = dir ? cst1 : cst0;
        if (tid < 72) CTs[64 * 72 + tid] = (tid < 64) ? (bf16_t)f2bf(dir ? nv1 : nv0) : (bf16_t)0;
        for (int q = wave; q < 16; q += 8) { const int ti = q >> 2, si = q & 3; const int sidx = si * 32 + r32, spos = dir ? 127 - sidx : sidx;
            if (si > ti) {
#pragma unroll
                for (int r = 0; r < 16; ++r) Wm[(ti * 32 + crow(r, hi)) * 136 + spos] = 0;
            } else { f32x16 acc = {}; acc = mma32_ll(acc, Qs + (rb + (dir ? -ti * 32 : ti * 32)) * 72, rs, Ks + (rb + (dir ? -si * 32 : si * 32)) * 72, rs, 4, lane); const float cv = COLV[sidx];
#pragma unroll
                for (int r = 0; r < 16; ++r) { const int t = ti * 32 + crow(r, hi); const float w = (sidx <= t) ? acc[r] * __expf(cv - MV[t]) : 0.f; Wm[t * 136 + spos] = (bf16_t)f2bf(w); } }
        }
        LDS_BAR();
        f32x16 tot[2];
#pragma unroll
        for (int k = 0; k < 2; ++k) { const int q = wave + 8 * k; if (q < 12) { const int ti = q / 3, nt = q % 3;
            f32x16 a1 = {}; a1 = mma32_ll(a1, Wm + ti * 32 * 136, 136, VTs + nt * 32 * 136, 136, dir ? 8 : (ti + 1) * 2, lane, dir ? 8 - (ti + 1) * 2 : 0);
            f32x16 a2 = {}; a2 = mma32_ll(a2, Qs + (rb + (dir ? -ti * 32 : ti * 32)) * 72, rs, CTs + nt * 32 * 72, 72, 4, lane);
#pragma unroll
            for (int r = 0; r < 16; ++r) a1[r] += AIN[ti * 32 + crow(r, hi)] * a2[r];
            tot[k] = a1;
            if (nt == 2 && r32 == 0) {
#pragma unroll
                for (int r = 0; r < 16; ++r) DEN[ti * 32 + crow(r, hi)] = a1[r]; } } }
        LDS_BAR();
#pragma unroll
        for (int k = 0; k < 2; ++k) { const int q = wave + 8 * k; if (q < 12) { const int ti = q / 3, nt = q % 3; if (nt < 2) {
#pragma unroll
            for (int r = 0; r < 16; ++r) { const int t = ti * 32 + crow(r, hi); const float hv = tot[k][r] * frcp(fmaxf(fabsf(DEN[t]), EINV[t])); const int p = dir ? 127 - t : t;
                if (dir == 0) HS[p * 64 + nt * 32 + r32] = hv; else HS[p * 64 + nt * 32 + r32] += hv; } } } }
    }
    LDS_BAR();
    { const int c8 = (tid & 7) * 8; bf16_t* yc = (bf16_t*)(F.ws + WS_YC);
      const f32x4 hg0 = *(const f32x4*)(F.in[I_MLHG] + l * 256 + h * 64 + c8), hg1 = *(const f32x4*)(F.in[I_MLHG] + l * 256 + h * 64 + c8 + 4);
#pragma unroll
      for (int half = 0; half < 2; ++half) { const int p = half * 64 + (tid >> 3); const u32x4 og = half ? og1 : og0;
        const f32x4 v0 = *(const LAS f32x4*)(HS + p * 64 + c8), v1 = *(const LAS f32x4*)(HS + p * 64 + c8 + 4);
        float ss = (v0.x * v0.x + v0.y * v0.y) + (v0.z * v0.z + v0.w * v0.w) + (v1.x * v1.x + v1.y * v1.y) + (v1.z * v1.z + v1.w * v1.w);
        ss += xor_lane<1>(ss); ss += xor_lane<2>(ss); ss += xor_lane<4>(ss);
        const float sc = frsq(ss * (1.f / 64.f) + EPS);
        const f32x4 y0 = v0 * sc * hg0 * (f32x4){sigmoidf_(bflo(og.x)), sigmoidf_(bfhi(og.x)), sigmoidf_(bflo(og.y)), sigmoidf_(bfhi(og.y))};
        const f32x4 y1 = v1 * sc * hg1 * (f32x4){sigmoidf_(bflo(og.z)), sigmoidf_(bfhi(og.z)), sigmoidf_(bflo(og.w)), sigmoidf_(bfhi(og.w))};
        *(u32x4*)(yc + (size_t)ml_row(b, isctx, p0 + p) * 1024 + h * 64 + c8) = (u32x4){pk2(y0.x, y0.y), pk2(y0.z, y0.w), pk2(y1.x, y1.y), pk2(y1.z, y1.w)}; } }
}

struct PoolRegs { u32x4 v[5]; };
__device__ __forceinline__ PoolRegs pool_load(const Frame& F, int unit) {
    PoolRegs R; const int row0 = unit * 64, tid = F.tid;
    const bool isctx = row0 >= NLAT; const int T = isctx ? 256 : 8192, t0 = isctx ? (row0 - NLAT) & 255 : row0 & 8191, rbase = row0 - t0;
    const bf16_t* px = (const bf16_t*)(F.ws + WS_PX);
#pragma unroll
    for (int q = 0; q < 5; ++q) { const int it = tid + q * NTHR, rr = it >> 5, c = it & 31, t = t0 - 8 + rr; R.v[q] = (u32x4){0u, 0u, 0u, 0u};
        if (t >= 0 && t < T) R.v[q] = *(const u32x4*)(px + (size_t)(rbase + t) * INC + C_POOL + c * 8); }
    return R;
}
__device__ __forceinline__ void pool_unit(const Frame& F, int l, int unit, const PoolRegs& R) {
    LAS float* U = (LAS float*)F.lds;
    LAS bf16_t* D = (LAS bf16_t*)(F.lds + 81920);
    const int row0 = unit * 64, tid = F.tid, lane = F.lane, wave = F.wave;
    const bool isctx = row0 >= NLAT; const int T = isctx ? 256 : 8192, t0 = isctx ? (row0 - NLAT) & 255 : row0 & 8191, rbase = row0 - t0;
    const bf16_t* px = (const bf16_t*)(F.ws + WS_PX);
    LDS_BAR();
    {
#pragma unroll
      for (int q = 0; q < 5; ++q) { const int it = tid + q * NTHR, rr = it >> 5, c = it & 31; LAS float* d = U + rr * 256 + c * 8; const u32x4 v = R.v[q];
          *(LAS f32x4*)d = (f32x4){bflo(v.x), bfhi(v.x), bflo(v.y), bfhi(v.y)}; *(LAS f32x4*)(d + 4) = (f32x4){bflo(v.z), bfhi(v.z), bflo(v.w), bfhi(v.w)}; } }
    LDS_BAR();
    { const int c = tid & 255, th = tid >> 8, g = c >> 6, hw = 1 << g, tt0 = th * 32;
      float sacc = 0.f;
      for (int u = tt0 - hw; u < tt0 + hw; ++u) sacc += U[(u + 8) * 256 + c];
#pragma unroll 4
      for (int k = 0; k < 32; ++k) { const int tt = tt0 + k, t = t0 + tt; const int lo = max(t - hw, 0), hi = min(t + hw, T);
          D[tt * 264 + c] = (bf16_t)f2bf(sacc * frcp((float)(hi - lo)) - U[(tt + 8) * 256 + c]);
          sacc += U[(tt + hw + 8) * 256 + c] - U[(tt - hw + 8) * 256 + c]; } }
    LDS_BAR();
    { const int g = wave >> 1, rt = wave & 1, r32 = lane & 31, hi = lane >> 5; bf16_t* yc = (bf16_t*)(F.ws + WS_YC); const float* ps = F.in[I_POOLS] + l * 256;
      for (int nt = 0; nt < 2; ++nt) { f32x16 acc = {}; acc = mma32_lg<4>(acc, D + rt * 32 * 264 + g * 64, 264, (const bf16_t*)(F.ws + W_POOL) + (size_t)(g * 64 + nt * 32) * 64, 64, lane);
          const int col = g * 64 + nt * 32 + r32; const float sc = ps[col];
#pragma unroll
          for (int r = 0; r < 16; ++r) yc[(size_t)(row0 + rt * 32 + crow(r, hi)) * 1024 + 512 + col] = (bf16_t)f2bf(acc[r] * sc); } }
}
__device__ __forceinline__ void conv_z(const bf16_t* p, float (&z)[8]) { const u32x4 u = *(const u32x4*)p, cc = *(const u32x4*)(p + 512);
    z[0] = bflo(u.x) * bflo(cc.x); z[1] = bfhi(u.x) * bfhi(cc.x); z[2] = bflo(u.y) * bflo(cc.y); z[3] = bfhi(u.y) * bfhi(cc.y);
    z[4] = bflo(u.z) * bflo(cc.z); z[5] = bfhi(u.z) * bfhi(cc.z); z[6] = bflo(u.w) * bflo(cc.w); z[7] = bfhi(u.w) * bfhi(cc.w); }
__device__ __forceinline__ void conv_all(const Frame& F, int l, int nrows) {
    const bf16_t* px = (const bf16_t*)(F.ws + WS_PX); bf16_t* yc = (bf16_t*)(F.ws + WS_YC);
    const int c = (F.tid & 31) * 8;
    float w0[8], w1[8], w2[8], cb[8];
#pragma unroll
    for (int e = 0; e < 8; ++e) { w0[e] = F.in[I_CONVW][l * 768 + c + e]; w1[e] = F.in[I_CONVW][l * 768 + 256 + c + e]; w2[e] = F.in[I_CONVW][l * 768 + 512 + c + e]; cb[e] = F.in[I_CONVB][l * 256 + c + e]; }
    for (int it = F.bx * NTHR + F.tid; it < (nrows / 16) * 32; it += F.G * NTHR) { const int row0 = (it >> 5) * 16;
        const bool isctx = row0 >= NLAT; const int T = isctx ? 256 : 8192, t0 = isctx ? (row0 - NLAT) & 255 : row0 & 8191;
        const bf16_t* p = px + (size_t)row0 * INC + C_CONV + c;
        float zp[8], zc[8], zn[8];
        if (t0 > 0) conv_z(p - INC, zp); else {
#pragma unroll
            for (int e = 0; e < 8; ++e) zp[e] = 0.f; }
        conv_z(p, zc);
#pragma unroll 4
        for (int r = 0; r < 16; ++r) { const bf16_t* pr = p + (size_t)r * INC;
            if (t0 + r + 1 < T) conv_z(pr + INC, zn); else {
#pragma unroll
                for (int e = 0; e < 8; ++e) zn[e] = 0.f; }
            const u32x4 bw = *(const u32x4*)(pr + 256); const float bx[8] = {bflo(bw.x), bfhi(bw.x), bflo(bw.y), bfhi(bw.y), bflo(bw.z), bfhi(bw.z), bflo(bw.w), bfhi(bw.w)};
            float y[8];
#pragma unroll
            for (int e = 0; e < 8; ++e) { y[e] = bx[e] * (cb[e] + w0[e] * zp[e] + w1[e] * zc[e] + w2[e] * zn[e]); zp[e] = zc[e]; zc[e] = zn[e]; }
            u32x4 o; o.x = pk2(y[0], y[1]); o.y = pk2(y[2], y[3]); o.z = pk2(y[4], y[5]); o.w = pk2(y[6], y[7]);
            *(u32x4*)(yc + (size_t)(row0 + r) * 1024 + 768 + c) = o; }
    }
}

namespace att {
constexpr int STAGE_B = 40960, KSUB = 12288, VOFF = 24576, VSUB = 8192, LDS_WS = 3 * STAGE_B, LDS_OST = LDS_WS + 2048;
constexpr float THR = 8.0f;
__device__ __forceinline__ void glds16(const void* gsrc, unsigned lds_dst) { unsigned keep;
    asm volatile("s_mov_b32 %0, m0\n\ts_mov_b32 m0, %2\n\ts_nop 0\n\tglobal_load_lds_dwordx4 %1, off\n\ts_mov_b32 m0, %0" : "=&s"(keep) : "v"(gsrc), "s"(lds_dst) : "memory"); }
#define ATT_WAIT_BAR(N) asm volatile("s_waitcnt vmcnt(" #N ") lgkmcnt(0)\n\ts_barrier" ::: "memory")
__device__ __forceinline__ void qkt(f32x16& p0, f32x16& p1, const LAS char* Kslot, const bf16x8* qr, int r32, int hi) {
    const LAS char* kb = Kslot + hi * 1024 + r32 * 16; p0 = f32x16{}; p1 = f32x16{};
#pragma unroll
    for (int d0 = 0; d0 < 6; ++d0) {
        const bf16x8 b0 = *(const LAS bf16x8*)(kb + d0 * 2048), b1 = *(const LAS bf16x8*)(kb + d0 * 2048 + 512);
        p0 = __builtin_amdgcn_mfma_f32_32x32x16_bf16(b0, qr[d0], p0, 0, 0, 0); p1 = __builtin_amdgcn_mfma_f32_32x32x16_bf16(b1, qr[d0], p1, 0, 0, 0); }
}
__device__ __forceinline__ float rowmax(const f32x16& p0, const f32x16& p1) {
    float a = fmaxf(p0[0], p1[0]);
#pragma unroll
    for (int r = 1; r < 16; ++r) a = fmaxf(a, fmaxf(p0[r], p1[r]));
    auto rr = __builtin_amdgcn_permlane32_swap(__float_as_uint(a), __float_as_uint(a), false, false);
    return fmaxf(__uint_as_float(rr[0]), __uint_as_float(rr[1]));
}
__device__ __forceinline__ void pv(f32x16* o, int vb, bf16x8 pa0, bf16x8 pa1, bf16x8 pa2, bf16x8 pa3) {
#pragma unroll
    for (int d0 = 0; d0 < 2; ++d0) { s16x4 lo[4], hi[4];
#pragma unroll
        for (int ks = 0; ks < 4; ++ks) {
            asm volatile("ds_read_b64_tr_b16 %0,%1 offset:%c2" : "=&v"(lo[ks]) : "v"(vb), "i"(d0 * 4096 + ks * 1024) : "memory");
            asm volatile("ds_read_b64_tr_b16 %0,%1 offset:%c2" : "=&v"(hi[ks]) : "v"(vb), "i"(d0 * 4096 + ks * 1024 + 512) : "memory"); }
        asm volatile("s_waitcnt lgkmcnt(0)" ::: "memory"); __builtin_amdgcn_sched_barrier(0);
#define ATT_PK(k) (bf16x8){lo[k][0], lo[k][1], lo[k][2], lo[k][3], hi[k][0], hi[k][1], hi[k][2], hi[k][3]}
        o[d0] = __builtin_amdgcn_mfma_f32_32x32x16_bf16(pa0, ATT_PK(0), o[d0], 0, 0, 0);
        o[d0] = __builtin_amdgcn_mfma_f32_32x32x16_bf16(pa1, ATT_PK(1), o[d0], 0, 0, 0);
        o[d0] = __builtin_amdgcn_mfma_f32_32x32x16_bf16(pa2, ATT_PK(2), o[d0], 0, 0, 0);
        o[d0] = __builtin_amdgcn_mfma_f32_32x32x16_bf16(pa3, ATT_PK(3), o[d0], 0, 0, 0);
#undef ATT_PK
    }
}
__device__ __forceinline__ void unit(const Frame& F, int bh, int qrow, int orow, int nst) {
    const int tid = F.tid, lane = F.lane, wid = F.wave, r32 = lane & 31, hi = lane >> 5, h = bh & 3;
    const unsigned lds0 = (unsigned)(uintptr_t)F.lds;
    const LAS char* ring = (const LAS char*)F.lds;
    LAS float* wsf = (LAS float*)(F.lds + LDS_WS) + wid * 64;
    const char* kg = (const char*)(F.ws + WS_KT) + (size_t)bh * NKT * 12288; const char* vg = (const char*)(F.ws + WS_VT) + (size_t)bh * NKT * 8192;
    const bf16_t* Qw = (const bf16_t*)(F.ws + WS_QB) + (size_t)(qrow + wid * 32) * 384 + h * 96;
#define ATT_DMA(t, slot) do { const char* ks_ = kg + (size_t)(t) * 24576 + wid * 1024 + lane * 16; const char* vs_ = vg + (size_t)(t) * 16384 + wid * 1024 + lane * 16; \
        const unsigned kd_ = lds0 + (slot) * STAGE_B + wid * 1024, vd_ = kd_ + VOFF; \
        glds16(ks_, (unsigned)__builtin_amdgcn_readfirstlane(kd_)); glds16(ks_ + 8192, (unsigned)__builtin_amdgcn_readfirstlane(kd_ + 8192)); glds16(ks_ + 16384, (unsigned)__builtin_amdgcn_readfirstlane(kd_ + 16384)); \
        glds16(vs_, (unsigned)__builtin_amdgcn_readfirstlane(vd_)); glds16(vs_ + 8192, (unsigned)__builtin_amdgcn_readfirstlane(vd_ + 8192)); } while (0)
    ATT_DMA(0, 0); if (nst > 1) ATT_DMA(1, 1);
    bf16x8 qr[6];
#pragma unroll
    for (int d0 = 0; d0 < 6; ++d0) qr[d0] = *(const bf16x8*)(Qw + (size_t)r32 * 384 + d0 * 16 + hi * 8);
    float mhat = 0.f, l_reg = 0.f; f32x16 o[2]; o[0] = f32x16{}; o[1] = f32x16{};
    const int vb0 = (int)lds0 + VOFF + ((lane >> 4) & 1) * 32 + (lane & 3) * 8 + (4 * hi + ((lane & 15) >> 2)) * 64;
    int slot = 0; bool first = true;
    for (int t = 0; t < nst; ++t) {
        if (t + 1 < nst) ATT_WAIT_BAR(5); else ATT_WAIT_BAR(0);
        if (t + 2 < nst) { const int s2 = (slot == 0) ? 2 : slot - 1; ATT_DMA(t + 2, s2); }
#pragma unroll
        for (int s = 0; s < 2; ++s) {
            f32x16 p0, p1; qkt(p0, p1, ring + slot * STAGE_B + s * KSUB, qr, r32, hi);
            const float rm = rowmax(p0, p1);
            if (first) { mhat = rm; first = false; }
            else if (__any(rm - mhat > THR)) { const float dl = fmaxf(rm - mhat, 0.f); mhat += dl; const float f = __builtin_amdgcn_exp2f(-dl); l_reg *= f;
                if (hi == 0) wsf[r32] = f; LDS_WAIT();
#pragma unroll
                for (int r = 0; r < 16; ++r) { const float fr_ = wsf[crow(r, hi)]; o[0][r] *= fr_; o[1][r] *= fr_; } }
            float sacc = 0.f;
#pragma unroll
            for (int r = 0; r < 16; ++r) { p0[r] = __builtin_amdgcn_exp2f(p0[r] - mhat); p1[r] = __builtin_amdgcn_exp2f(p1[r] - mhat); sacc += p0[r] + p1[r]; }
            l_reg += sacc;
            u32x4 pw0, pw1, pw2, pw3;
            pw0 = (u32x4){cvt_pk_bf16(p0[0], p0[1]), cvt_pk_bf16(p0[2], p0[3]), cvt_pk_bf16(p0[4], p0[5]), cvt_pk_bf16(p0[6], p0[7])};
            pw1 = (u32x4){cvt_pk_bf16(p0[8], p0[9]), cvt_pk_bf16(p0[10], p0[11]), cvt_pk_bf16(p0[12], p0[13]), cvt_pk_bf16(p0[14], p0[15])};
            pw2 = (u32x4){cvt_pk_bf16(p1[0], p1[1]), cvt_pk_bf16(p1[2], p1[3]), cvt_pk_bf16(p1[4], p1[5]), cvt_pk_bf16(p1[6], p1[7])};
            pw3 = (u32x4){cvt_pk_bf16(p1[8], p1[9]), cvt_pk_bf16(p1[10], p1[11]), cvt_pk_bf16(p1[12], p1[13]), cvt_pk_bf16(p1[14], p1[15])};
            __builtin_amdgcn_sched_barrier(0);
            pv(o, vb0 + slot * STAGE_B + s * VSUB, __builtin_bit_cast(bf16x8, pw0), __builtin_bit_cast(bf16x8, pw1), __builtin_bit_cast(bf16x8, pw2), __builtin_bit_cast(bf16x8, pw3));
        }
        slot = (slot == 2) ? 0 : slot + 1;
    }
    { auto rr = __builtin_amdgcn_permlane32_swap(__float_as_uint(l_reg), __float_as_uint(l_reg), false, false); l_reg = __uint_as_float(rr[0]) + __uint_as_float(rr[1]); }
    if (hi == 0) wsf[32 + r32] = l_reg; LDS_WAIT();
    float rli[16];
#pragma unroll
    for (int r = 0; r < 16; ++r) rli[r] = frcp(wsf[32 + crow(r, hi)]);
    LAS bf16_t* stg = (LAS bf16_t*)(F.lds + LDS_OST) + wid * 2048;
#pragma unroll
    for (int r = 0; r < 16; ++r) { const int orow_ = crow(r, hi);
#pragma unroll
        for (int d0 = 0; d0 < 2; ++d0) stg[orow_ * 64 + d0 * 32 + r32] = (bf16_t)f2bf(o[d0][r] * rli[r]); }
    LDS_WAIT();
    bf16_t* Ow = (bf16_t*)(F.ws + WS_YC) + (size_t)(orow + wid * 32) * 1024 + 256 + h * 64;
#pragma unroll
    for (int i = 0; i < 4; ++i) { const int row = i * 8 + (lane >> 3), ch = lane & 7; const u32x4 v = *(const LAS u32x4*)(stg + row * 64 + ch * 8); *(u32x4*)(Ow + (size_t)row * 1024 + ch * 8) = v; }
    asm volatile("s_waitcnt lgkmcnt(0)\n\ts_barrier" ::: "memory");
#undef ATT_DMA
}
}

namespace att2 {
constexpr int KSL = 12288, VSL = 8192, LDS_K = 0, LDS_V = 3 * KSL, LDS_WS = LDS_V + 3 * VSL, LDS_OST = LDS_WS + 2048;
#define A2_SBAR() __builtin_amdgcn_sched_barrier(0)
#define A2_WAIT_BAR(N) asm volatile("s_waitcnt vmcnt(" #N ") lgkmcnt(0)\n\ts_barrier" ::: "memory")
__device__ __forceinline__ void glds16s(const void* sbase, unsigned voff, unsigned lds_dst) { unsigned keep;
    asm volatile("s_mov_b32 %0, m0\n\ts_mov_b32 m0, %3\n\ts_nop 4\n\tglobal_load_lds_dwordx4 %1, %2\n\ts_mov_b32 m0, %0" : "=&s"(keep) : "v"(voff), "s"(sbase), "s"(lds_dst) : "memory"); }
__device__ __forceinline__ unsigned cvtpk_s(float lo, float hi) { typedef float f2 __attribute__((ext_vector_type(2))); typedef __bf16 b2 __attribute__((ext_vector_type(2))); f2 v = {lo, hi}; b2 b = __builtin_convertvector(v, b2); return __builtin_bit_cast(unsigned, b); }
typedef short v4i16_t __attribute__((ext_vector_type(4)));
__device__ __forceinline__ s16x4 vtr(const LAS char* p) { return __builtin_bit_cast(s16x4, __builtin_amdgcn_ds_read_tr16_b64_v4i16((LAS v4i16_t*)p)); }
typedef int v8i_t __attribute__((ext_vector_type(8)));
__device__ __forceinline__ v8i_t cat8(u32x4 a, u32x4 b) { return (v8i_t){(int)a.x, (int)a.y, (int)a.z, (int)a.w, (int)b.x, (int)b.y, (int)b.z, (int)b.w}; }
__device__ __forceinline__ v8i_t kfrag8(const LAS char* kp, int i, int hi) { const LAS char* p = kp + ((i & 1) ? 4096 : hi * 2048) + (i >> 1) * 512; return cat8(*(const LAS u32x4*)p, *(const LAS u32x4*)(p + 1024)); }

template <bool NOMAX> __device__ __forceinline__ void unit(const Frame& F, int bh, int qrow, int orow, int NT) {
    const int lane = F.lane, wid = F.wave, r32 = lane & 31, hi = lane >> 5, h = bh & 3;
    const unsigned lds0 = (unsigned)(uintptr_t)F.lds;
    const LAS char* shm3 = (const LAS char*)F.lds;
    LAS float* wsf = (LAS float*)(F.lds + LDS_WS) + wid * 64;
    const char* kg = (const char*)(F.ws + WS_KT) + (size_t)bh * NKT * 6144; const char* vg = (const char*)(F.ws + WS_VT) + (size_t)bh * NKT * 8192 + wid * 1024; const unsigned l16 = lane * 16;
    const unsigned char* Qw = (const unsigned char*)(F.ws + WS_QB) + (size_t)(qrow + wid * 32) * 384 + h * 96;
    const int kp2 = wid < 6 ? wid : wid - 2;
#define A2_DMA_K(t, sl) do { const char* s_ = kg + (size_t)(t) * 6144; const unsigned d_ = lds0 + LDS_K + (sl) * KSL; \
        glds16s(s_ + kp2 * 1024, l16, (unsigned)__builtin_amdgcn_readfirstlane(d_ + kp2 * 1024)); } while (0)
#define A2_MFQ(ki, qi, CI) __builtin_amdgcn_mfma_scale_f32_32x32x64_f8f6f4(kf[ki], qf[qi], CI, 0, 0, 0, 0x7c7c7c7c, 0, 0x7f7f7f7f)
#define A2_DMA_V(t, sl) glds16s(vg + (size_t)(t) * 8192, l16, (unsigned)__builtin_amdgcn_readfirstlane(lds0 + LDS_V + (sl) * VSL + wid * 1024))
    const LAS char* kp0 = shm3 + LDS_K + r32 * 16;
    const LAS char* vp0 = shm3 + LDS_V + ((lane >> 4) & 1) * 32 + (lane & 3) * 8 + (4 * hi + ((lane & 15) >> 2)) * 64;
    v8i_t kf[4];
    A2_DMA_K(0, 0); A2_DMA_V(0, 0); A2_DMA_K(1, 1);
    v8i_t qf[2];
    { const unsigned char* qp = Qw + (size_t)r32 * 384; const u32x4 z4 = {0u, 0u, 0u, 0u};
      qf[0] = cat8(*(const u32x4*)(qp + hi * 32), *(const u32x4*)(qp + hi * 32 + 16));
      const u32x4 c0 = *(const u32x4*)(qp + 64), c1 = *(const u32x4*)(qp + 80); qf[1] = cat8(hi ? z4 : c0, hi ? z4 : c1); }
    float mhat = 0.f, l_reg = 0.f; f32x16 o[2]; o[0] = f32x16{}; o[1] = f32x16{};
    bool resc = false;
    f32x16 pA0, pA1, pB0, pB1;
    int sl_prev = 0, sl_cur = 0, sl_next = 1;
#define A2_ROT() do { sl_prev = sl_cur; sl_cur = sl_next; sl_next = (sl_next == 2) ? 0 : sl_next + 1; } while (0)
#define A2_RESC() do { if (!NOMAX && resc) { asm volatile("s_waitcnt lgkmcnt(0)" ::: "memory"); \
        _Pragma("unroll") for (int d_ = 0; d_ < 2; ++d_) _Pragma("unroll") for (int r = 0; r < 16; ++r) o[d_][r] *= wsf[crow(r, hi)]; } } while (0)
    A2_DMA_K(2, 2);
    A2_WAIT_BAR(5);
    {
#pragma unroll
      for (int i = 0; i < 4; ++i) kf[i] = kfrag8(kp0, i, hi);
      pA0 = A2_MFQ(0, 0, (f32x16{})); pA0 = A2_MFQ(1, 1, pA0); pA1 = A2_MFQ(2, 0, (f32x16{})); pA1 = A2_MFQ(3, 1, pA1);
      if constexpr (!NOMAX) { float a = fmaxf(pA0[0], pA1[0]);
#pragma unroll
      for (int r = 1; r < 16; ++r) a = fmaxf(a, fmaxf(pA0[r], pA1[r]));
      { auto rr = __builtin_amdgcn_permlane32_swap(__float_as_uint(a), __float_as_uint(a), false, false); a = fmaxf(__uint_as_float(rr[0]), __uint_as_float(rr[1])); }
      mhat = a; }
#pragma unroll
      for (int r = 0; r < 16; ++r) { pA0[r] = __builtin_amdgcn_exp2f(pA0[r] - mhat); pA1[r] = __builtin_amdgcn_exp2f(pA1[r] - mhat); } }
    A2_WAIT_BAR(0);
    A2_DMA_K(3, 0); A2_DMA_V(1, 1);
    A2_ROT();
    { const LAS char* kp = kp0 + sl_cur * KSL;
#pragma unroll
      for (int i = 0; i < 4; ++i) kf[i] = kfrag8(kp, i, hi); }
    A2_WAIT_BAR(2);
    s16x4 vlo[8], vhi[8]; u32x4 pw0, pw1, pw2, pw3;
#define A2_PKW(P, B) cvtpk_s(P[B], P[B + 1])
#define A2_PAF(k) __builtin_bit_cast(bf16x8, pw##k)
#define A2_VFR(i) (bf16x8){vlo[i][0], vlo[i][1], vlo[i][2], vlo[i][3], vhi[i][0], vhi[i][1], vhi[i][2], vhi[i][3]}
#define A2_PIN(x) asm volatile("" : "+v"(x))
#define A2_MX3(a, b, c) __builtin_fmaxf(__builtin_fmaxf((a), (b)), (c))
#define A2_GAPA(MF, A0, A1, A2, A3, W0, W1, PW) do { MF; sacc += A0; sacc += A1; sacc += A2; sacc += A3; A2_PIN(sacc); W0; W1; A2_PIN(PW); A2_SBAR(); } while (0)
#define A2_GAPM(MF) do { MF; A2_SBAR(); } while (0)
#define A2_EX(v) __builtin_amdgcn_exp2f(v)
#define A2_SH(v) (NOMAX ? (v) : (v) - mhat)
#define A2_GAPB(MF, X, B) do { MF; X[B] = A2_EX(A2_SH(X[B])); X[B + 1] = A2_EX(A2_SH(X[B + 1])); X[B + 2] = A2_EX(A2_SH(X[B + 2])); X[B + 3] = A2_EX(A2_SH(X[B + 3])); A2_PIN(X); A2_SBAR(); } while (0)
#define A2_VRD(i) do { vlo[i] = vtr(vp_ + (((i) >> 2) * 4096 + ((i) & 3) * 1024)); vhi[i] = vtr(vp_ + (((i) >> 2) * 4096 + ((i) & 3) * 1024 + 512)); } while (0)
#define A2_KRD(G, j) do { if (G) { if ((j) < 4) kf[(j) < 4 ? (j) : 0] = kfrag8(kp0 + sl_next * KSL, (j) < 4 ? (j) : 0, hi); A2_SBAR(); } } while (0)
#define A2_MF(C, kk, qq, CI) C = A2_MFQ(kk, qq, CI)
#define A2_NOP ((void)0)
#define A2_STEP(C0, C1, P0, P1, t, GK, GV, GL) do { A2_SBAR(); \
    const LAS char* vp_ = vp0 + sl_prev * VSL; \
    A2_VRD(0); A2_SBAR(); float sacc = (P0[0] + P0[1]); \
    A2_GAPA(A2_MF(C0, 0, 0, (f32x16{})), P0[2], P0[3], P0[4], P0[5],     pw0[0] = A2_PKW(P0, 0), pw0[1] = A2_PKW(P0, 2), pw0); \
    A2_VRD(4); A2_SBAR(); A2_GAPA(A2_NOP, P0[6], P0[7], P0[8], P0[9],     pw0[2] = A2_PKW(P0, 4), pw0[3] = A2_PKW(P0, 6), pw0); \
    A2_VRD(1); A2_SBAR(); A2_GAPA(A2_MF(C1, 2, 0, (f32x16{})), P0[10], P0[11], P0[12], P0[13], pw1[0] = A2_PKW(P0, 8), pw1[1] = A2_PKW(P0, 10), pw1); \
    A2_VRD(5); A2_SBAR(); A2_GAPA(A2_NOP,   P0[14], P0[15], P1[0], P1[1],   pw1[2] = A2_PKW(P0, 12), pw1[3] = A2_PKW(P0, 14), pw1); \
    A2_VRD(2); A2_SBAR(); A2_GAPA(A2_MF(C0, 1, 1, C0),   P1[2], P1[3], P1[4], P1[5],     pw2[0] = A2_PKW(P1, 0), pw2[1] = A2_PKW(P1, 2), pw2); \
    A2_VRD(6); A2_SBAR(); A2_GAPA(A2_NOP,   P1[6], P1[7], P1[8], P1[9],     pw2[2] = A2_PKW(P1, 4), pw2[3] = A2_PKW(P1, 6), pw2); \
    A2_VRD(3); A2_SBAR(); A2_GAPA(A2_MF(C1, 3, 1, C1),   P1[10], P1[11], P1[12], P1[13], pw3[0] = A2_PKW(P1, 8), pw3[1] = A2_PKW(P1, 10), pw3); \
    A2_VRD(7); A2_SBAR(); A2_GAPA(A2_NOP,   P1[14], P1[15], 0.f, 0.f,       pw3[2] = A2_PKW(P1, 12), pw3[3] = A2_PKW(P1, 14), pw3); \
    l_reg += sacc; \
    if (GK) { A2_DMA_K((t) + 3, sl_cur); } if (GV) { A2_DMA_V((t) + 1, sl_next); } \
    if constexpr (!NOMAX) { float a = A2_MX3(C0[0], C0[1], C1[0]), b = A2_MX3(C0[2], C0[3], C1[1]); a = A2_MX3(a, C1[2], C1[3]); \
      _Pragma("unroll") for (int r = 4; r < 16; r += 4) { a = A2_MX3(a, C0[r], C0[r + 1]); b = A2_MX3(b, C0[r + 2], C0[r + 3]); a = A2_MX3(a, C1[r], C1[r + 1]); b = A2_MX3(b, C1[r + 2], C1[r + 3]); } \
      float rm = __builtin_fmaxf(a, b); { auto rr = __builtin_amdgcn_permlane32_swap(__float_as_uint(rm), __float_as_uint(rm), false, false); rm = __builtin_fmaxf(__uint_as_float(rr[0]), __uint_as_float(rr[1])); } \
      resc = false; \
      if (__builtin_expect(__any(rm - mhat > 8.0f), 0)) { const float dl = __builtin_fmaxf(rm - mhat, 0.f); mhat += dl; \
        const float f = __builtin_amdgcn_exp2f(-dl); l_reg *= f; if (hi == 0) wsf[r32] = f; resc = true; } } \
    A2_SBAR(); \
    A2_GAPB(o[0] = __builtin_amdgcn_mfma_f32_32x32x16_bf16(A2_PAF(0), A2_VFR(0), o[0], 0, 0, 0), C0, 0); \
    A2_KRD(GL, 0); A2_GAPB(o[1] = __builtin_amdgcn_mfma_f32_32x32x16_bf16(A2_PAF(0), A2_VFR(4), o[1], 0, 0, 0), C0, 4); \
    A2_KRD(GL, 1); A2_GAPB(o[0] = __builtin_amdgcn_mfma_f32_32x32x16_bf16(A2_PAF(1), A2_VFR(1), o[0], 0, 0, 0), C0, 8); \
    A2_KRD(GL, 2); A2_GAPB(o[1] = __builtin_amdgcn_mfma_f32_32x32x16_bf16(A2_PAF(1), A2_VFR(5), o[1], 0, 0, 0), C0, 12); \
    A2_KRD(GL, 3); A2_GAPB(o[0] = __builtin_amdgcn_mfma_f32_32x32x16_bf16(A2_PAF(2), A2_VFR(2), o[0], 0, 0, 0), C1, 0); \
    A2_KRD(GL, 4); A2_GAPB(o[1] = __builtin_amdgcn_mfma_f32_32x32x16_bf16(A2_PAF(2), A2_VFR(6), o[1], 0, 0, 0), C1, 4); \
    A2_KRD(GL, 5); A2_GAPB(o[0] = __builtin_amdgcn_mfma_f32_32x32x16_bf16(A2_PAF(3), A2_VFR(3), o[0], 0, 0, 0), C1, 8); \
    A2_GAPB(o[1] = __builtin_amdgcn_mfma_f32_32x32x16_bf16(A2_PAF(3), A2_VFR(7), o[1], 0, 0, 0), C1, 12); \
    } while (0)
    int t = 1;
    for (; t + 5 < NT; t += 2) {
        A2_STEP(pB0, pB1, pA0, pA1, t, true, true, true);     A2_WAIT_BAR(2); A2_RESC(); A2_ROT();
        A2_STEP(pA0, pA1, pB0, pB1, t + 1, true, true, true); A2_WAIT_BAR(2); A2_RESC(); A2_ROT();
    }
#define A2_ENDW(tt) do { if ((tt) + 3 < NT) { A2_WAIT_BAR(2); } else if ((tt) + 2 < NT) { A2_WAIT_BAR(1); } else { A2_WAIT_BAR(0); } } while (0)
    for (; t + 1 < NT; t += 2) {
        A2_STEP(pB0, pB1, pA0, pA1, t, (t + 3 < NT), (t + 1 < NT), (t + 1 < NT));     A2_ENDW(t);     A2_RESC(); A2_ROT();
        A2_STEP(pA0, pA1, pB0, pB1, t + 1, (t + 4 < NT), (t + 2 < NT), (t + 2 < NT)); A2_ENDW(t + 1); A2_RESC(); A2_ROT();
    }
    A2_STEP(pB0, pB1, pA0, pA1, NT - 1, false, false, false); A2_RESC();
    { float sacc = pB0[0] + pB0[1];
#pragma unroll
      for (int r = 2; r < 16; ++r) sacc += pB0[r];
#pragma unroll
      for (int r = 0; r < 16; ++r) sacc += pB1[r];
      l_reg += sacc;
      pw0 = (u32x4){A2_PKW(pB0, 0), A2_PKW(pB0, 2), A2_PKW(pB0, 4), A2_PKW(pB0, 6)}; pw1 = (u32x4){A2_PKW(pB0, 8), A2_PKW(pB0, 10), A2_PKW(pB0, 12), A2_PKW(pB0, 14)};
      pw2 = (u32x4){A2_PKW(pB1, 0), A2_PKW(pB1, 2), A2_PKW(pB1, 4), A2_PKW(pB1, 6)}; pw3 = (u32x4){A2_PKW(pB1, 8), A2_PKW(pB1, 10), A2_PKW(pB1, 12), A2_PKW(pB1, 14)};
      A2_SBAR();
      const int vb = (int)lds0 + LDS_V + ((lane >> 4) & 1) * 32 + (lane & 3) * 8 + (4 * hi + ((lane & 15) >> 2)) * 64 + sl_cur * VSL;
      att::pv(o, vb, A2_PAF(0), A2_PAF(1), A2_PAF(2), A2_PAF(3)); }
    { auto rr = __builtin_amdgcn_permlane32_swap(__float_as_uint(l_reg), __float_as_uint(l_reg), false, false); l_reg = __uint_as_float(rr[0]) + __uint_as_float(rr[1]); }
    if (hi == 0) wsf[32 + r32] = l_reg; LDS_WAIT();
    float rli[16];
#pragma unroll
    for (int r = 0; r < 16; ++r) rli[r] = __builtin_amdgcn_rcpf(wsf[32 + crow(r, hi)]);
    LAS bf16_t* stg = (LAS bf16_t*)(F.lds + LDS_OST) + wid * 2048;
#pragma unroll
    for (int r = 0; r < 16; ++r) { const int orow_ = crow(r, hi);
#pragma unroll
        for (int d0 = 0; d0 < 2; ++d0) stg[orow_ * 64 + d0 * 32 + r32] = (bf16_t)f2bf(o[d0][r] * rli[r]); }
    LDS_WAIT();
    bf16_t* Ow = (bf16_t*)(F.ws + WS_YC) + (size_t)(orow + wid * 32) * 1024 + 256 + h * 64;
#pragma unroll
    for (int i = 0; i < 4; ++i) { const int row = i * 8 + (lane >> 3), ch = lane & 7; const u32x4 v = *(const LAS u32x4*)(stg + row * 64 + ch * 8); *(u32x4*)(Ow + (size_t)row * 1024 + ch * 8) = v; }
    asm volatile("s_waitcnt lgkmcnt(0)\n\ts_barrier" ::: "memory");
}
}

__device__ __forceinline__ void ph_norm2_route(const Frame& F, int l, int ntok) {
    LAS bf16_t* A = (LAS bf16_t*)F.lds;
    LAS float* PART = (LAS float*)(F.lds + 66048);
    LAS float* LOG = (LAS float*)(F.lds + 131584);
    LAS int* HIST = (LAS int*)(F.lds + 139776);
    const int tid = F.tid, lane = F.lane, wave = F.wave, r32 = lane & 31, hi = lane >> 5;
    const int tpb = ntok / F.G, tok0 = F.bx * tpb;
    int* eidx = (int*)(F.ws + T_EIDX); float* ew = (float*)(F.ws + T_EW);
    const float* brt = F.in[I_BRT] + l * 64;
    if (tid < 64) HIST[tid] = 0;
    LAS f32x4* AV = (LAS f32x4*)(F.lds + 140288);
    LAS f32x4* SHV = AV + 512;
    const int mr_first = mod_row_of(tok0), mr_last = mod_row_of(tok0 + tpb - 1);
    { const int set = tid >> 8, idx = tid & 255, mrs = set ? mr_last : mr_first;
      const f32x4 gv = ((const f32x4*)(F.in[I_GFFN] + l * 1024))[idx], scv = ((const f32x4*)modp(F, l, mrs, 4))[idx];
      AV[tid] = gv * (scv + 1.0f); SHV[tid] = ((const f32x4*)modp(F, l, mrs, 3))[idx]; }
    bf16x8 wrt[2][8];
#pragma unroll
    for (int nt = 0; nt < 2; ++nt)
#pragma unroll
        for (int ks = 0; ks < 8; ++ks) wrt[nt][ks] = *(const bf16x8*)((const bf16_t*)(F.ws + W_RT) + (size_t)(nt * 32 + r32) * 1024 + wave * 128 + ks * 16 + hi * 8);
    f32x4 xn[4][4]; u32x2 mn[4][4];
#pragma unroll
    for (int rr = 0; rr < 4; ++rr) { const int t = min(wave * 4 + rr, tpb - 1); const f32x4* xr = (const f32x4*)stream_row(F, l, tok0 + t) + lane; const u32x2* mg = (const u32x2*)((const bf16_t*)(F.ws + WS_YC) + (size_t)(tok0 + t) * 1024) + lane;
#pragma unroll
        for (int j = 0; j < 4; ++j) { xn[rr][j] = xr[64 * j]; mn[rr][j] = mg[64 * j]; } }
    for (int b0 = 0; b0 < tpb; b0 += 32) {
        __syncthreads();
        { f32x4 v[4][4];
#pragma unroll
          for (int rr = 0; rr < 4; ++rr) {
#pragma unroll
                for (int j = 0; j < 4; ++j) { const u32x2 w = mn[rr][j]; v[rr][j] = xn[rr][j] + (f32x4){bflo(w.x), bfhi(w.x), bflo(w.y), bfhi(w.y)}; } }
#pragma unroll
          for (int rr = 0; rr < 4; ++rr) { const int r = wave * 4 + rr, t = b0 + r; LAS u32x2* a = (LAS u32x2*)(A + r * 1032) + lane;
            if (t < tpb) { const int row = tok0 + t, mr = mod_row_of(row); f32x4 y[4];
                f32x4* xo = (f32x4*)((row < NLAT) ? F.out + (size_t)row * 1024 : (float*)(F.ws + WS_CTXS) + (size_t)(row - NLAT) * 1024) + lane;
#pragma unroll
                for (int j = 0; j < 4; ++j) xo[64 * j] = v[rr][j];
                { float s2 = 0.f;
#pragma unroll
                  for (int j = 0; j < 4; ++j) s2 += (v[rr][j].x * v[rr][j].x + v[rr][j].y * v[rr][j].y) + (v[rr][j].z * v[rr][j].z + v[rr][j].w * v[rr][j].w);
                  const float rstd = frsq(wave_sum(s2) * (1.f / 1024.f) + EPS); const int vb = (mr == mr_first ? 0 : 256) + lane;
#pragma unroll
                  for (int j = 0; j < 4; ++j) y[j] = v[rr][j] * rstd * AV[vb + 64 * j] + SHV[vb + 64 * j]; }
                unsigned* o8 = (unsigned*)(F.ws + WS_HX8 + (size_t)row * 1024) + lane;
#pragma unroll
                for (int j = 0; j < 4; ++j) { a[64 * j] = (u32x2){pk2(y[j].x, y[j].y), pk2(y[j].z, y[j].w)}; o8[64 * j] = pk4_fp8(y[j].x, y[j].y, y[j].z, y[j].w); }
            } else {
#pragma unroll
                for (int j = 0; j < 4; ++j) a[64 * j] = (u32x2){0u, 0u}; } } }
        if (b0 + 32 < tpb) {
#pragma unroll
            for (int rr = 0; rr < 4; ++rr) { const int t = min(b0 + 32 + wave * 4 + rr, tpb - 1); const f32x4* xr = (const f32x4*)stream_row(F, l, tok0 + t) + lane; const u32x2* mg = (const u32x2*)((const bf16_t*)(F.ws + WS_YC) + (size_t)(tok0 + t) * 1024) + lane;
#pragma unroll
                for (int j = 0; j < 4; ++j) { xn[rr][j] = xr[64 * j]; mn[rr][j] = mg[64 * j]; } } }
        __syncthreads();
#pragma unroll
        for (int nt = 0; nt < 2; ++nt) { f32x16 acc = {};
#pragma unroll
            for (int ks = 0; ks < 8; ++ks) { const bf16x8 a = *(const LAS bf16x8*)(A + wave * 128 + r32 * 1032 + ks * 16 + hi * 8); acc = __builtin_amdgcn_mfma_f32_32x32x16_bf16(a, wrt[nt][ks], acc, 0, 0, 0); }
#pragma unroll
            for (int r = 0; r < 16; ++r) PART[(wave * 32 + crow(r, hi)) * 64 + nt * 32 + r32] = acc[r]; }
        __syncthreads();
        for (int i = tid; i < 2048; i += NTHR) { float s = 0.f;
#pragma unroll
            for (int w = 0; w < 8; ++w) s += PART[w * 2048 + i];
            LOG[i] = s; }
        __syncthreads();
        for (int rr = 0; rr < 4; ++rr) { const int r = wave * 4 + rr, t = b0 + r; if (t >= tpb) continue;
            const float sc = sigmoidf_(LOG[r * 64 + lane]); float v = sc + brt[lane]; float ssel = 0.f, mys = 0.f; int myi = 0;
#pragma unroll
            for (int k = 0; k < TOPK; ++k) { const float mx = wave_max(v); const unsigned long long bal = __ballot(v == mx); const int win = __ffsll((long long)bal) - 1;
                const float sw = lane_bcast(sc, win); ssel += sw; if (lane == k) { mys = sw; myi = win; } if (lane == win) v = -INFINITY; }
            if (lane < TOPK) { eidx[(size_t)(tok0 + t) * 6 + lane] = myi; ew[(size_t)(tok0 + t) * 6 + lane] = mys * frcp(ssel) * 2.5f; __hip_atomic_fetch_add(&HIST[myi], 1, __ATOMIC_RELAXED, __HIP_MEMORY_SCOPE_WORKGROUP); } }
    }
    __syncthreads();
    if (tid < 64) ((int*)(F.ws + T_HIST))[F.bx * 64 + tid] = HIST[tid];
}

__device__ __forceinline__ void ph_assign(const Frame& F, int ntok) {
    LAS int* BASE = (LAS int*)F.lds; LAS int* CUR = BASE + 64; LAS int* START = BASE + 128; LAS int* TOT = BASE + 192; LAS int* MISC = BASE + 256;
    const int tid = F.tid, hb = F.G, c = 0, tpb = ntok / F.G, ctok0 = 0, ctoks = ntok;
    const int* hist = (const int*)(F.ws + T_HIST); int* rtok = (int*)(F.ws + T_RTOK); float* rw = (float*)(F.ws + T_RW); int* slot = (int*)(F.ws + T_SLOT);
    int* tile_e = (int*)(F.ws + T_TILEE);
    __syncthreads();
    { LAS int* PT = BASE + 512; LAS int* PB = PT + 512;
      const int e = tid & 63, part = tid >> 6; int tot = 0, bef = 0;
#pragma unroll 8
      for (int k = 0; k < 32; ++k) { const int b = c * hb + part * 32 + k; if (b < (c + 1) * hb) { const int v = hist[b * 64 + e]; tot += v; if (b < F.bx) bef += v; } }
      PT[part * 64 + e] = tot; PB[part * 64 + e] = bef; }
    __syncthreads();
    if (tid < 64) { int tot = 0, bef = 0; for (int p8 = 0; p8 < 8; ++p8) { tot += BASE[512 + p8 * 64 + tid]; bef += BASE[1024 + p8 * 64 + tid]; } TOT[tid] = tot; BASE[tid] = bef; CUR[tid] = 0; }
    __syncthreads();
    if (tid == 0) { int s = 0; for (int e = 0; e < 64; ++e) { START[e] = s; s += (TOT[e] + 255) / 256 * 256; } MISC[0] = s; }
    __syncthreads();
    const int sstart = MISC[0];
    const int* eidx = (const int*)(F.ws + T_EIDX); const float* ew = (const float*)(F.ws + T_EW);
    for (int i = tid; i < tpb * 6; i += NTHR) { const int tok = F.bx * tpb + i / 6, k = i % 6; const int e = eidx[(size_t)tok * 6 + k];
        const int pos = START[e] + BASE[e] + __hip_atomic_fetch_add(&CUR[e], 1, __ATOMIC_RELAXED, __HIP_MEMORY_SCOPE_WORKGROUP); rtok[pos] = tok; rw[pos] = ew[(size_t)tok * 6 + k]; slot[(size_t)tok * 8 + k] = pos; }
    for (int i = tid; i < tpb; i += NTHR) { const int tok = F.bx * tpb + i, pos = sstart + (tok - ctok0); rtok[pos] = tok; rw[pos] = 1.0f; slot[(size_t)tok * 8 + 6] = pos; }
    if (F.bx == c * hb) {
        for (int e = 0; e < 64; ++e) { const int p0 = START[e] + TOT[e], p1 = START[e] + (TOT[e] + 255) / 256 * 256;
            for (int p = p0 + tid; p < p1; p += NTHR) { rtok[p] = ctok0; rw[p] = 0.f; }
            for (int tl = START[e] / 256 + tid; tl < p1 / 256; tl += NTHR) tile_e[tl] = e; }
        for (int tl = sstart / 256 + tid; tl < (sstart + ctoks) / 256; tl += NTHR) tile_e[tl] = 64;
        if (tid == 0) tile_e[2047] = (sstart + ctoks) / 256;
    }
}

template <bool FUSE_NORM> __device__ __forceinline__ void ph_combine(const Frame& F, int l, int c, int ntok) {
    const int lane = F.lane; const int tpb = ntok / F.G, tok0 = F.bx * tpb; (void)c;
    const int* slot = (const int*)(F.ws + T_SLOT); const unsigned char* ys = (const unsigned char*)(F.ws + WS_YS);
    int mr_cur = -1; f32x4 gtv[2][2], av[2][2], shv[2][2];
    for (int t = F.wave; t < tpb; t += NWAVES) { const int tok = tok0 + t, mr = mod_row_of(tok);
        if (mr != mr_cur) { mr_cur = mr; const float* gt = modp(F, l, mr, 5);
#pragma unroll
            for (int j = 0; j < 2; ++j)
#pragma unroll
                for (int h2 = 0; h2 < 2; ++h2) { const int c0 = 8 * lane + 512 * j + 4 * h2; gtv[j][h2] = *(const f32x4*)(gt + c0);
                    if constexpr (FUSE_NORM) { const f32x4 gv = *(const f32x4*)(F.in[I_GMIX] + 1024 + c0), scv = *(const f32x4*)(modp(F, 1, mr, 1) + c0); av[j][h2] = gv * (scv + 1.0f); shv[j][h2] = *(const f32x4*)(modp(F, 1, mr, 0) + c0); } } }
        float* xr = (tok < NLAT) ? F.out + (size_t)tok * 1024 : (float*)(F.ws + WS_CTXS) + (size_t)(tok - NLAT) * 1024;
        const int sv = slot[(size_t)tok * 8 + (lane & 7)];
        u32x2 y[7][2];
#pragma unroll
        for (int k = 0; k < 7; ++k) { const int sk = __builtin_amdgcn_readlane(sv, k); const u32x2* yr = (const u32x2*)(ys + (size_t)sk * 1024) + lane; y[k][0] = yr[0]; y[k][1] = yr[64]; }
        f32x4 xv[2][2];
#pragma unroll
        for (int j = 0; j < 2; ++j) { xv[j][0] = *(const f32x4*)(xr + 8 * lane + 512 * j); xv[j][1] = *(const f32x4*)(xr + 8 * lane + 512 * j + 4); }
#pragma unroll
        for (int j = 0; j < 2; ++j) { f32x4 a0 = {0.f, 0.f, 0.f, 0.f}, a1 = {0.f, 0.f, 0.f, 0.f};
#pragma unroll
            for (int k = 0; k < 7; ++k) { a0 += up4_fp8(y[k][j].x); a1 += up4_fp8(y[k][j].y); }
            xv[j][0] = xv[j][0] + gtv[j][0] * a0; xv[j][1] = xv[j][1] + gtv[j][1] * a1;
            *(f32x4*)(xr + 8 * lane + 512 * j) = xv[j][0]; *(f32x4*)(xr + 8 * lane + 512 * j + 4) = xv[j][1]; }
        if constexpr (FUSE_NORM) {
            float ss = 0.f;
#pragma unroll
            for (int j = 0; j < 2; ++j)
#pragma unroll
                for (int h2 = 0; h2 < 2; ++h2) { const f32x4 v = xv[j][h2]; ss += (v.x * v.x + v.y * v.y) + (v.z * v.z + v.w * v.w); }
            const float rstd = frsq(wave_sum(ss) * (1.f / 1024.f) + EPS);
            unsigned char* h8 = F.ws + WS_HX8 + (size_t)tok * 1024;
#pragma unroll
            for (int j = 0; j < 2; ++j) { const int c0 = 8 * lane + 512 * j; f32x4 y[2];
#pragma unroll
                for (int h2 = 0; h2 < 2; ++h2) y[h2] = xv[j][h2] * rstd * av[j][h2] + shv[j][h2];
                *(u32x2*)(h8 + c0) = (u32x2){pk4_fp8(y[0].x, y[0].y, y[0].z, y[0].w), pk4_fp8(y[1].x, y[1].y, y[1].z, y[1].w)}; }
        }
    }
}
__device__ __forceinline__ Frame phase_frame(const Frame& F) {
    Frame Q = F; int t = threadIdx.x; asm volatile("" : "+v"(t)); Q.tid = t; Q.lane = t & 63; Q.wave = __builtin_amdgcn_readfirstlane(t >> 6);
    unsigned long long w = (unsigned long long)F.ws; asm volatile("" : "+s"(w)); Q.ws = (unsigned char*)(GAS unsigned char*)w;
    return Q;
}
constexpr int PH_PER_LAYER = 13, PH_TOTAL = 1 + 2 * PH_PER_LAYER;
__global__ void __launch_bounds__(NTHR, 2) mk_fwd(Params p) {
    extern __shared__ __attribute__((aligned(16))) unsigned char lds_raw[];
    Frame F0;
    F0.lds = (LAS unsigned char*)lds_raw; F0.ws = p.ws; F0.in = p.in; F0.out = p.out;
    F0.tid = threadIdx.x; F0.lane = F0.tid & 63; F0.wave = __builtin_amdgcn_readfirstlane(F0.tid >> 6); F0.bx = blockIdx.x; F0.G = gridDim.x;
    volatile LAS unsigned* MISC = (volatile LAS unsigned*)(F0.lds + MISC_OFF);
    if (F0.tid < 64) MISC[F0.tid] = 0u;
    __syncthreads();
    const int lo = p.ph_lo, hi = p.ph_hi;
    XcdBarrier bar; bar.bar = (unsigned*)(F0.ws + WS_CTL) + CW_BAR; bar.x = 0; bar.st = MISC + 8;
    if (hi - lo > 1) bar = xcd_barrier_post((unsigned*)(F0.ws + WS_CTL) + CW_BAR, MISC + 8);
#ifndef MK_SITE
#define MK_SITE -1
#endif
#define SITE(n) (MK_SITE < 0 || MK_SITE == (n))
#ifndef MK_REP_MASK
#define MK_REP_MASK 0
#endif
#define NREP(n) (((MK_REP_MASK >> (n)) & 1) ? 2 : 1)
#define RUN(k) (lo <= (k) && (k) < hi)
#define SEAM(k) do { if (RUN(k) && RUN((k) + 1)) { TSEC_BEGIN(300, F0.lds); xcd_barrier(bar); TSEC_END(300, F0.lds); } } while (0)
    int ph = 0;
    if (SITE(0) && RUN(ph)) TSEC_BEGIN(400 + 0, F0.lds); if (SITE(0) && RUN(ph)) for (int rep_ = 0; rep_ < NREP(0); ++rep_) { const Frame F = phase_frame(F0); ph_pre(F); }
    TSEC_END(400 + 99, F0.lds); SEAM(ph); ++ph;
    for (int l = 0; l < 2; ++l) {
        const int ntok = (l == 0) ? NTOK : NLAT, nM = ntok / 256;
        if (SITE(1) && RUN(ph)) TSEC_BEGIN(400 + 1, F0.lds); if (SITE(1) && RUN(ph)) for (int rep_ = 0; rep_ < NREP(1); ++rep_) { const Frame F = phase_frame(F0); ph_convert(F, l); __syncthreads(); if (l == 0) ph_norm1(F, l); }
        TSEC_END(400 + 99, F0.lds); SEAM(ph); ++ph;
        if (SITE(2) && RUN(ph)) TSEC_BEGIN(400 + 2, F0.lds); if (SITE(2) && RUN(ph)) for (int rep_ = 0; rep_ < NREP(2); ++rep_) { const Frame F = phase_frame(F0);
            SchedPlain S{(const char*)(F.ws + WS_HX8), (const char*)(F.ws + W_IN), 1024u, 1024u, 8, NTOK / 256, INCP / 256, F.G, F.bx};
            EpiWin E{(bf16_t*)(F.ws + WS_PX), (float*)(F.ws + T_GATE)};
            gg::gemm_phase(F.lds, S, E);
        }
        TSEC_END(400 + 99, F0.lds); SEAM(ph); ++ph;
        if (SITE(3) && RUN(ph)) TSEC_BEGIN(400 + 3, F0.lds); if (SITE(3) && RUN(ph)) for (int rep_ = 0; rep_ < NREP(3); ++rep_) { const Frame F = phase_frame(F0);
            for (int r2 = 0; r2 < NREP(16); ++r2) mla_prep(F, l);
            for (int r2 = 0; r2 < NREP(17); ++r2) { const int b1 = (F.bx + F.G / 2) % F.G; P1Regs R = ml_pass1_load(F, b1);
                for (int u = b1; u < 64 * NCHK; u += F.G) { const P1Regs Rn = ml_pass1_load(F, (u + F.G < 64 * NCHK) ? u + F.G : u); ml_pass1_unit(F, l, u, R); R = Rn; } }
            for (int r2 = 0; r2 < NREP(18); ++r2) { const int b2 = (F.bx + 3 * F.G / 4) % F.G; PoolRegs R = pool_load(F, b2);
                for (int u = b2; u < ntok / 64; u += F.G) { const PoolRegs Rn = pool_load(F, (u + F.G < ntok / 64) ? u + F.G : u); pool_unit(F, l, u, R); R = Rn; } }
            for (int r2 = 0; r2 < NREP(19); ++r2) conv_all(F, l, ntok);
            __syncthreads();
        }
        TSEC_END(400 + 99, F0.lds); SEAM(ph); ++ph;
        if (SITE(4) && RUN(ph)) TSEC_BEGIN(400 + 4, F0.lds); if (SITE(4) && RUN(ph)) for (int rep_ = 0; rep_ < NREP(4); ++rep_) { const Frame F = phase_frame(F0);
            ml_pass2(F);
            float gq = 0.f, gk = 0.f; for (int d = 0; d < 96; ++d) { gq = fmaxf(gq, fabsf(F.in[I_GQN][l * 96 + d])); gk = fmaxf(gk, fabsf(F.in[I_GKN][l * 96 + d])); }
            const bool nomax = (14.2f * gq * gk <= 64.0f);
            const int nunits = 1024 + (l == 0 ? 32 : 0);
#define ATT_UNITS(NM) for (int i = 0; ; ++i) { const int L = i * F.G + F.bx; if (L >= nunits) break; \
                if (L < 1024) { const int bh = (L >> 8) * 8 + (L & 7), qb = (L & 255) >> 3, b = bh >> 2; att2::unit<NM>(F, bh, b * 8192 + qb * 256, b * 8192 + qb * 256, 132); } \
                else { const int bh = L - 1024, b = bh >> 2; att2::unit<NM>(F, bh, NLAT + b * 256, NLAT + b * 256, 4); } }
            if (nomax) { ATT_UNITS(true) } else { ATT_UNITS(false) }
#undef ATT_UNITS
        }
        TSEC_END(400 + 99, F0.lds); SEAM(ph); ++ph;
        if (SITE(5) && RUN(ph)) TSEC_BEGIN(400 + 5, F0.lds); if (SITE(5) && RUN(ph)) for (int rep_ = 0; rep_ < NREP(5); ++rep_) { const Frame F = phase_frame(F0);
            const int npc = (l == 0) ? 66 : 64, nun = 32 * npc;
            for (int u = F.bx; u < nun; u += F.G) { const int bh = u / npc, pc = u % npc + (l == 0 ? 0 : 2); ml_pass3_unit(F, l, bh >> 2, bh & 3, pc); }
            __syncthreads();
        }
        TSEC_END(400 + 99, F0.lds); SEAM(ph); ++ph;
        {
            const int nMh = nM, pm0 = 0;
            if (SITE(6) && RUN(ph)) TSEC_BEGIN(400 + 6, F0.lds); if (SITE(6) && RUN(ph)) for (int rep_ = 0; rep_ < NREP(6); ++rep_) { const Frame F = phase_frame(F0);
                SchedYB S{(const char*)(F.ws + WS_YC), (const char*)(F.ws + W_BR), pm0, nMh, F.G, F.bx};
                EpiF8Out E{F.ws + WS_YB, 4096};
                gg::gemm_phase(F.lds, S, E);
            }
            TSEC_END(400 + 99, F0.lds); SEAM(ph); ++ph;
            if (SITE(13) && RUN(ph)) TSEC_BEGIN(400 + 13, F0.lds); if (SITE(13) && RUN(ph)) for (int rep_ = 0; rep_ < NREP(13); ++rep_) { const Frame F = phase_frame(F0);
                SchedPlain S{(const char*)(F.ws + WS_HX8) + (size_t)pm0 * 256 * 1024, (const char*)(F.ws + W_GATE), 1024u, 1024u, 8, nMh, 16, F.G, F.bx};
                EpiMerge2 E{(const unsigned char*)(F.ws + WS_YB), F.in[I_BGATE] + l * 4096, F.ws + WS_ACCM + (size_t)pm0 * 256 * 1024, 0};
                gg::gemm_phase(F.lds, S, E);
            }
            TSEC_END(400 + 99, F0.lds); SEAM(ph); ++ph;
        }
        if (SITE(7) && RUN(ph)) TSEC_BEGIN(400 + 7, F0.lds); if (SITE(7) && RUN(ph)) for (int rep_ = 0; rep_ < NREP(7); ++rep_) { const Frame F = phase_frame(F0);
            SchedPlain S{(const char*)(F.ws + WS_ACCM), (const char*)(F.ws + W_OUT), 1024u, 1024u, 8, nM, 4, F.G, F.bx};
            EpiWout E{(bf16_t*)(F.ws + WS_YC), modp(F, l, 0, 2)};
            gg::gemm_phase(F.lds, S, E);
        }
        TSEC_END(400 + 99, F0.lds); SEAM(ph); ++ph;
        if (SITE(8) && RUN(ph)) TSEC_BEGIN(400 + 8, F0.lds); if (SITE(8) && RUN(ph)) for (int rep_ = 0; rep_ < NREP(8); ++rep_) { const Frame F = phase_frame(F0); ph_norm2_route(F, l, ntok); }
        TSEC_END(400 + 99, F0.lds); SEAM(ph); ++ph;
        if (SITE(9) && RUN(ph)) TSEC_BEGIN(400 + 9, F0.lds); if (SITE(9) && RUN(ph)) for (int rep_ = 0; rep_ < NREP(9); ++rep_) { const Frame F = phase_frame(F0); ph_assign(F, ntok); }
        TSEC_END(400 + 99, F0.lds); SEAM(ph); ++ph;
        if (SITE(10) && RUN(ph)) TSEC_BEGIN(400 + 10, F0.lds); if (SITE(10) && RUN(ph)) for (int rep_ = 0; rep_ < NREP(10); ++rep_) { const Frame F = phase_frame(F0);
            int* tile_e = (int*)(F.ws + T_TILEE); const int ntiles = ld_i32_uniform(tile_e + 2047);
            LAS int* tab = (LAS int*)(F.lds + MOE_TAB_OFF); const int* rtok = (const int*)(F.ws + T_RTOK);
            __syncthreads();
            for (int i = 0; i < 28; ++i) { const int L = i * F.G + F.bx; if (L >= ntiles * 2) break; const int tile = L >> 1;
                if (F.tid == 0) tab[i] = tile_e[tile]; if (F.tid < 256) tab[256 + i * 256 + F.tid] = rtok[tile * 256 + F.tid]; }
            __syncthreads();
            SchedMoe1 S{(const char*)(F.ws + WS_HX8), (const char*)(F.ws + W_13), tab, ntiles, F.G, F.bx};
            EpiMoe1 E{F.ws + WS_AMOE, (const float*)(F.ws + T_RW)};
            gg::gemm_phase(F.lds, S, E);
        }
        TSEC_END(400 + 99, F0.lds); SEAM(ph); ++ph;
        if (SITE(11) && RUN(ph)) TSEC_BEGIN(400 + 11, F0.lds); if (SITE(11) && RUN(ph)) for (int rep_ = 0; rep_ < NREP(11); ++rep_) { const Frame F = phase_frame(F0);
            int* tile_e = (int*)(F.ws + T_TILEE); const int ntiles = ld_i32_uniform(tile_e + 2047);
            LAS int* tab = (LAS int*)(F.lds + MOE_TAB_OFF);
            __syncthreads();
            for (int i = F.tid; i < 64; i += NTHR) { const int L = i * F.G + F.bx; if (L < ntiles * 4) tab[i] = tile_e[L >> 2]; }
            __syncthreads();
            SchedMoe2 S{(const char*)(F.ws + WS_AMOE), (const char*)(F.ws + W_2), tab, ntiles, F.G, F.bx};
            EpiF8OutQ E{(unsigned char*)(F.ws + WS_YS), 1024};
            gg::gemm_phase(F.lds, S, E);
        }
        TSEC_END(400 + 99, F0.lds); SEAM(ph); ++ph;
        if (SITE(12) && RUN(ph)) TSEC_BEGIN(400 + 12, F0.lds); if (SITE(12) && RUN(ph)) for (int rep_ = 0; rep_ < NREP(12); ++rep_) { const Frame F = phase_frame(F0); if (l == 0) ph_combine<true>(F, l, 0, ntok); else ph_combine<false>(F, l, 0, ntok); }
        TSEC_END(400 + 99, F0.lds); SEAM(ph); ++ph;
    }
    if (MK_TSEC >= 0 && blockIdx.x == 0 && threadIdx.x == 0) { volatile LAS unsigned long long* q_ = (volatile LAS unsigned long long*)(F0.lds + MISC_OFF + 128);
        const unsigned long long t0 = __builtin_amdgcn_s_memrealtime(), d = q_[0] * 4ull; while (__builtin_amdgcn_s_memrealtime() - t0 < d) __builtin_amdgcn_s_sleep(8); }
#undef RUN
#undef SEAM
}

extern "C" void kernel_launch(void* const* d_in, const int* in_sizes, int n_in, void* d_out, int out_size, void* d_ws, size_t ws_size, hipStream_t stream) {
    static int grid = 0;
    if (grid == 0) {
        if (n_in != 33 || out_size != NLAT * DM || ws_size < WS_END) { fprintf(stderr, "kernel_launch: unexpected shapes (n_in %d, out %d, ws %zu < %zu)\n", n_in, out_size, ws_size, (size_t)WS_END); grid = -1; return; }
        int dev = 0, cus = 0;
        if (hipGetDevice(&dev) != hipSuccess || hipDeviceGetAttribute(&cus, hipDeviceAttributeMultiprocessorCount, dev) != hipSuccess) { grid = -1; return; }
        if (hipFuncSetAttribute((const void*)mk_fwd, hipFuncAttributeMaxDynamicSharedMemorySize, LDS_BYTES) != hipSuccess) { fprintf(stderr, "kernel_launch: hipFuncSetAttribute failed\n"); grid = -1; return; }
        int per_cu = 0;
        if (hipOccupancyMaxActiveBlocksPerMultiprocessor(&per_cu, (const void*)mk_fwd, NTHR, LDS_BYTES) != hipSuccess || per_cu < 1) fprintf(stderr, "kernel_launch: occupancy query says %d\n", per_cu);
        (void)hipGetLastError();
        if (cus < 256) { fprintf(stderr, "kernel_launch: built for a 256-CU device (got %d CUs)\n", cus); grid = -1; return; }
        grid = 256;
    }
    if (grid < 0) return;
    (void)hipMemsetAsync((char*)d_ws + WS_CTL, 0, CTL_ZERO_BYTES, stream);
    Params p{};
    for (int i = 0; i < 33; ++i) p.in[i] = (const float*)d_in[i];
    p.out = (float*)d_out; p.ws = (unsigned char*)d_ws;
#if MK_ONE_LAUNCH
    p.ph_lo = 0; p.ph_hi = PH_TOTAL;
    hipLaunchKernelGGL(mk_fwd, dim3(grid), dim3(NTHR), LDS_BYTES, stream, p);
#else
    for (int k = 0; k < PH_TOTAL; ++k) { p.ph_lo = k; p.ph_hi = k + 1; hipLaunchKernelGGL(mk_fwd, dim3(grid), dim3(NTHR), LDS_BYTES, stream, p); }
#endif
}
```
